# Optimizing an MI355X kernel written in HIP

```python
import math
import jax, jax.numpy as jnp
from jax import lax
import numpy as np

D_MODEL = 1024
BATCH = 2
SEQ = 8192
DEPTH = 1
DEC_BATCH = 128
DEC_SEQ = 8
PAST_LEN = 16384
PAGE_SIZE = 128

DN_HEADS = 4
DN_DK = 128
DN_DV = 128
DN_CONV = 4
DN_CHUNK = 64
SWA_HEADS = 8
SWA_KV_HEADS = 2
SWA_GROUP = SWA_HEADS // SWA_KV_HEADS
SWA_HD = 64
WINDOW = 128
SWA_BLOCK = 128
N_BUCKETS = 32
MAX_DISTANCE = 128
D_FF = 2816
FFN_CONV = 3
EPS = 1e-6
NEG_INF = -1e30

DN_QK = DN_HEADS * DN_DK
DN_V = DN_HEADS * DN_DV
DN_CONV_CH = 2 * DN_QK + DN_V
SWA_Q = SWA_HEADS * SWA_HD
SWA_KV = SWA_KV_HEADS * SWA_HD
D_MIX = DN_V + SWA_Q
IN_SPLITS = (DN_CONV_CH, DN_V, DN_HEADS, DN_HEADS, SWA_Q, SWA_KV, SWA_KV)
IN_COLS = sum(IN_SPLITS)

kernel_name = 'hymba_gdn_swa_convffn_step'


def _split_cols(t, sizes):
    idx = [int(i) for i in np.cumsum(sizes)[:-1]]
    return jnp.split(t, idx, axis=-1)


def _rmsnorm(x, w):
    xf = x.astype(jnp.float32)
    y = xf * lax.rsqrt(jnp.mean(xf * xf, axis=-1, keepdims=True) + EPS)
    return (y * w.astype(jnp.float32)).astype(x.dtype)


def _l2norm(t):
    t = t.astype(jnp.float32)
    return t * lax.rsqrt(jnp.sum(t * t, axis=-1, keepdims=True) + EPS)


def _causal_dwconv(x, buf, w):
    width = w.shape[0]
    L = x.shape[1]
    xp = jnp.concatenate([buf.astype(x.dtype), x], axis=1)
    out = xp[:, 0:L] * w[0]
    for j in range(1, width):
        out = out + xp[:, j:j + L] * w[j]
    return out, xp[:, L:]


def _t5_bucket(dist):
    d = jnp.maximum(dist, 0)
    exact = N_BUCKETS // 2
    logv = jnp.log(jnp.maximum(d, 1).astype(jnp.float32) / exact) / math.log(MAX_DISTANCE / exact)
    large = jnp.minimum(exact + (logv * (N_BUCKETS - exact)).astype(jnp.int32), N_BUCKETS - 1)
    return jnp.where(d < exact, d, large)


def _gated_delta_chunked(q, k, v, g, beta, S0):
    B, L, H, dk = q.shape
    dv = v.shape[-1]
    C = min(DN_CHUNK, L)
    pad = (-L) % C
    if pad:
        pw = lambda t: jnp.pad(t, [(0, 0), (0, pad)] + [(0, 0)] * (t.ndim - 2))
        q, k, v, g, beta = pw(q), pw(k), pw(v), pw(g), pw(beta)
    NC = (L + pad) // C

    def chunks(t):
        return jnp.moveaxis(t.reshape((B, NC, C) + t.shape[2:]), 3, 1)

    qc, kc, vc, gc, bc = chunks(q), chunks(k), chunks(v), chunks(g), chunks(beta)
    G = jnp.cumsum(gc, axis=-1)
    incl = jnp.tril(jnp.ones((C, C), bool))
    strict = jnp.tril(jnp.ones((C, C), bool), -1)
    decay = jnp.where(incl, jnp.exp(jnp.where(incl, G[..., :, None] - G[..., None, :], 0.0)), 0.0)
    kk = jnp.einsum('bhnid,bhnjd->bhnij', kc, kc)
    A = jnp.where(strict, bc[..., :, None] * kk * decay, 0.0)
    eye = jnp.eye(C, dtype=jnp.float32)
    T = lax.linalg.triangular_solve(A + eye, jnp.broadcast_to(eye, A.shape),
                                    left_side=True, lower=True, unit_diagonal=True)
    eG = jnp.exp(G)
    w_v = jnp.einsum('bhnij,bhnjd->bhnid', T, vc * bc[..., None])
    w_k = jnp.einsum('bhnij,bhnjd->bhnid', T, kc * (bc * eG)[..., None])
    qk = jnp.einsum('bhnid,bhnjd->bhnij', qc, kc) * decay
    q_dec = qc * eG[..., None]
    k_tail = kc * jnp.exp(G[..., -1:] - G)[..., None]
    c_dec = jnp.exp(G[..., -1])
    xs = tuple(jnp.moveaxis(t, 2, 0) for t in (w_v, w_k, qk, q_dec, k_tail, c_dec))

    def step(S, inp):
        wv, wk, qk_i, qd, kt, cd = inp
        u = wv - jnp.einsum('bhik,bhkv->bhiv', wk, S)
        o = jnp.einsum('bhik,bhkv->bhiv', qd, S) + jnp.einsum('bhij,bhjv->bhiv', qk_i, u)
        S = S * cd[..., None, None] + jnp.einsum('bhik,bhiv->bhkv', kt, u)
        return S, o

    S_fin, o = lax.scan(step, S0, xs)
    o = jnp.moveaxis(jnp.moveaxis(o, 0, 2), 1, 3).reshape(B, NC * C, H, dv)[:, :L]
    return o, S_fin


def _deltanet_mixer(qkv, z, b_raw, a_raw, conv_buf, S0, conv_w, A_log, dt_bias, norm_w):
    B, L, _ = qkv.shape
    c_out, new_buf = _causal_dwconv(qkv, conv_buf, conv_w)
    c_out = jax.nn.silu(c_out)
    q, k, v = jnp.split(c_out, [DN_QK, 2 * DN_QK], axis=-1)
    q = _l2norm(q.reshape(B, L, DN_HEADS, DN_DK)) * (DN_DK ** -0.5)
    k = _l2norm(k.reshape(B, L, DN_HEADS, DN_DK))
    v = v.reshape(B, L, DN_HEADS, DN_DV).astype(jnp.float32)
    beta = jax.nn.sigmoid(b_raw.astype(jnp.float32))
    g = -jnp.exp(A_log.astype(jnp.float32)) * jax.nn.softplus(a_raw.astype(jnp.float32) + dt_bias.astype(jnp.float32))
    o, S = _gated_delta_chunked(q, k, v, g, beta, S0.astype(jnp.float32))
    o = _rmsnorm(o, norm_w) * jax.nn.silu(z.reshape(B, L, DN_HEADS, DN_DV).astype(jnp.float32))
    return o.reshape(B, L, DN_V).astype(qkv.dtype), new_buf, S.astype(S0.dtype)


def _swa_attend(q, k, v, q_pos, k_pos, sinks, rel_bias):
    s = jnp.einsum('bnihgd,bnjhd->bnhgij', q, k).astype(jnp.float32) * (SWA_HD ** -0.5)
    dist = q_pos[:, :, None] - k_pos[:, None, :]
    valid = (dist >= 0) & (dist < WINDOW) & (k_pos[:, None, :] >= 0)
    nb, lq, lk = dist.shape
    bias = rel_bias.astype(jnp.float32)[_t5_bucket(dist)]
    bias = jnp.transpose(bias.reshape(nb, lq, lk, SWA_KV_HEADS, SWA_GROUP), (0, 3, 4, 1, 2))
    s = jnp.where(valid[:, None, None], s + bias, NEG_INF)
    sink = sinks.astype(jnp.float32).reshape(SWA_KV_HEADS, SWA_GROUP)[:, :, None, None]
    m = jnp.maximum(jnp.max(s, axis=-1, keepdims=True), sink)
    p = jnp.exp(s - m)
    p = p / (jnp.sum(p, axis=-1, keepdims=True) + jnp.exp(sink - m))
    return jnp.einsum('bnhgij,bnjhd->bnihgd', p.astype(v.dtype), v)


def _swa_prompt(q, k, v, sinks, rel_bias):
    B, L = q.shape[:2]
    NB = L // SWA_BLOCK
    qb = q.reshape(B, NB, SWA_BLOCK, SWA_KV_HEADS, SWA_GROUP, SWA_HD)
    kb = k.reshape(B, NB, SWA_BLOCK, SWA_KV_HEADS, SWA_HD)
    vb = v.reshape(B, NB, SWA_BLOCK, SWA_KV_HEADS, SWA_HD)

    def with_prev(t):
        prev = jnp.concatenate([jnp.zeros_like(t[:, :1]), t[:, :-1]], axis=1)
        return jnp.concatenate([prev, t], axis=2)

    blk = jnp.arange(NB, dtype=jnp.int32)[:, None] * SWA_BLOCK
    q_pos = blk + jnp.arange(SWA_BLOCK, dtype=jnp.int32)[None]
    k_pos = blk + jnp.arange(-SWA_BLOCK, SWA_BLOCK, dtype=jnp.int32)[None]
    o = _swa_attend(qb, with_prev(kb), with_prev(vb), q_pos, k_pos, sinks, rel_bias)
    n_buf = min(WINDOW, L)
    return o.reshape(B, L, SWA_Q), k[:, L - n_buf:], v[:, L - n_buf:]


def _swa_sample(q, k, v, k_buf, v_buf, sinks, rel_bias):
    B, L = q.shape[:2]
    n_buf = k_buf.shape[1]
    keys = jnp.concatenate([k_buf.astype(k.dtype), k], axis=1)
    vals = jnp.concatenate([v_buf.astype(v.dtype), v], axis=1)
    q_pos = (PAST_LEN + jnp.arange(L, dtype=jnp.int32))[None]
    k_pos = (PAST_LEN - n_buf + jnp.arange(n_buf + L, dtype=jnp.int32))[None]
    o = _swa_attend(q[:, None], keys[:, None], vals[:, None], q_pos, k_pos, sinks, rel_bias)
    return o.reshape(B, L, SWA_Q), keys[:, L:], vals[:, L:]


def _trunk(x, c, states, layer_w, rel_bias, final_norm_w):
    (w_ada, b_ada, norm_mix_w, w_in, dn_conv_w, dn_A_log, dn_dt_bias, dn_norm_w,
     swa_sinks, w_out, norm_ffn_w, ffn_w_up, ffn_conv_w, ffn_conv_b, ffn_w_down) = layer_w
    B, L, _ = x.shape
    is_sample = states is not None
    outs = ([], [], [], [], [])
    for i in range(DEPTH):
        mod = jnp.einsum('bd,de->be', jax.nn.silu(c), w_ada[i]) + b_ada[i]
        sh1, sc1, g1, sh2, sc2, g2 = jnp.split(mod[:, None, :], 6, axis=-1)
        h = _rmsnorm(x, norm_mix_w[i]) * (1 + sc1) + sh1
        proj = jnp.einsum('bld,de->ble', h, w_in[i])
        qkv, z, b_raw, a_raw, sq, sk, sv = _split_cols(proj, IN_SPLITS)
        if is_sample:
            dn_buf, S0, k_buf, v_buf, f_buf = (s[i] for s in states)
        else:
            dn_buf = jnp.zeros((B, DN_CONV - 1, DN_CONV_CH), x.dtype)
            S0 = jnp.zeros((B, DN_HEADS, DN_DK, DN_DV), jnp.float32)
            f_buf = jnp.zeros((B, FFN_CONV - 1, 2 * D_FF), x.dtype)
        o_dn, n_dn_buf, n_S = _deltanet_mixer(qkv, z, b_raw, a_raw, dn_buf, S0, dn_conv_w[i],
                                              dn_A_log[i], dn_dt_bias[i], dn_norm_w[i])
        sq = sq.reshape(B, L, SWA_KV_HEADS, SWA_GROUP, SWA_HD)
        sk = sk.reshape(B, L, SWA_KV_HEADS, SWA_HD)
        sv = sv.reshape(B, L, SWA_KV_HEADS, SWA_HD)
        if is_sample:
            o_swa, n_k, n_v = _swa_sample(sq, sk, sv, k_buf, v_buf, swa_sinks[i], rel_bias)
        else:
            o_swa, n_k, n_v = _swa_prompt(sq, sk, sv, swa_sinks[i], rel_bias)
        mix = jnp.concatenate([o_dn, o_swa.astype(o_dn.dtype)], axis=-1)
        x = x + g1 * jnp.einsum('ble,ed->bld', mix, w_out[i])
        h = _rmsnorm(x, norm_ffn_w[i]) * (1 + sc2) + sh2
        u = jnp.einsum('bld,df->blf', h, ffn_w_up[i])
        u_c, n_f_buf = _causal_dwconv(u, f_buf, ffn_conv_w[i])
        gate, up = jnp.split(u_c + ffn_conv_b[i], 2, axis=-1)
        x = x + g2 * jnp.einsum('blf,fd->bld', jax.nn.silu(gate) * up, ffn_w_down[i])
        for lst, val in zip(outs, (n_dn_buf, n_S, n_k, n_v, n_f_buf)):
            lst.append(val)
    y = _rmsnorm(x, final_norm_w)
    return y, [jnp.stack(lst) for lst in outs]


def setup_inputs(seed: int = 0) -> dict:
    key = jax.random.key(seed)
    ks = jax.random.split(key, 32)
    f32 = jnp.float32
    nrm = lambda k, shape, s: jax.random.normal(k, shape, f32) * s
    n_buf = min(WINDOW, PAST_LEN)
    dt = jnp.exp(jax.random.uniform(ks[20], (DEPTH, DN_HEADS), f32, math.log(1e-3), math.log(1e-1)))
    return {
        'x_prompt': nrm(ks[0], (BATCH, SEQ, D_MODEL), 1.0),
        'x_sample': nrm(ks[1], (DEC_BATCH, DEC_SEQ, D_MODEL), 1.0),
        'state_dn_conv': nrm(ks[2], (DEPTH, DEC_BATCH, DN_CONV - 1, DN_CONV_CH), 1.0),
        'state_dn_ssm': nrm(ks[3], (DEPTH, DEC_BATCH, DN_HEADS, DN_DK, DN_DV), DN_DK ** -0.5),
        'cache_swa_k': nrm(ks[4], (DEPTH, DEC_BATCH, n_buf, SWA_KV_HEADS, SWA_HD), 1.0),
        'cache_swa_v': nrm(ks[5], (DEPTH, DEC_BATCH, n_buf, SWA_KV_HEADS, SWA_HD), 1.0),
        'state_ffn_conv': nrm(ks[6], (DEPTH, DEC_BATCH, FFN_CONV - 1, 2 * D_FF), 1.0),
        'c_prompt': nrm(ks[7], (BATCH, D_MODEL), 1.0),
        'c_sample': nrm(ks[8], (DEC_BATCH, D_MODEL), 1.0),
        'rel_bias': nrm(ks[9], (N_BUCKETS, SWA_HEADS), 0.5),
        'final_norm_w': 1.0 + nrm(ks[10], (D_MODEL,), 0.05),
        'w_ada': nrm(ks[11], (DEPTH, D_MODEL, 6 * D_MODEL), 0.5 * D_MODEL ** -0.5),
        'b_ada': nrm(ks[12], (DEPTH, 6 * D_MODEL), 0.02),
        'norm_mix_w': 1.0 + nrm(ks[13], (DEPTH, D_MODEL), 0.05),
        'w_in': nrm(ks[14], (DEPTH, D_MODEL, IN_COLS), D_MODEL ** -0.5),
        'dn_conv_w': nrm(ks[15], (DEPTH, DN_CONV, DN_CONV_CH), DN_CONV ** -0.5),
        'dn_A_log': jnp.log(jax.random.uniform(ks[16], (DEPTH, DN_HEADS), f32, 1.0, 16.0)),
        'dn_dt_bias': dt + jnp.log(-jnp.expm1(-dt)),
        'dn_norm_w': 1.0 + nrm(ks[17], (DEPTH, DN_DV), 0.05),
        'swa_sinks': nrm(ks[18], (DEPTH, SWA_HEADS), 0.5),
        'w_out': nrm(ks[19], (DEPTH, D_MIX, D_MODEL), D_MIX ** -0.5),
        'norm_ffn_w': 1.0 + nrm(ks[21], (DEPTH, D_MODEL), 0.05),
        'ffn_w_up': nrm(ks[22], (DEPTH, D_MODEL, 2 * D_FF), D_MODEL ** -0.5),
        'ffn_conv_w': nrm(ks[23], (DEPTH, FFN_CONV, 2 * D_FF), FFN_CONV ** -0.5),
        'ffn_conv_b': nrm(ks[24], (DEPTH, 2 * D_FF), 0.02),
        'ffn_w_down': nrm(ks[25], (DEPTH, D_FF, D_MODEL), D_FF ** -0.5),
    }


def reference(x_prompt, x_sample, state_dn_conv, state_dn_ssm, cache_swa_k, cache_swa_v, state_ffn_conv,
              c_prompt, c_sample, rel_bias, final_norm_w, w_ada, b_ada, norm_mix_w, w_in, dn_conv_w,
              dn_A_log, dn_dt_bias, dn_norm_w, swa_sinks, w_out, norm_ffn_w, ffn_w_up, ffn_conv_w,
              ffn_conv_b, ffn_w_down):
    layer_w = (w_ada, b_ada, norm_mix_w, w_in, dn_conv_w, dn_A_log, dn_dt_bias, dn_norm_w,
               swa_sinks, w_out, norm_ffn_w, ffn_w_up, ffn_conv_w, ffn_conv_b, ffn_w_down)
    y_prompt, (p_dn_conv, p_dn_ssm, p_swa_k, p_swa_v, p_ffn_conv) = _trunk(
        x_prompt, c_prompt, None, layer_w, rel_bias, final_norm_w)
    sample_states = (state_dn_conv, state_dn_ssm, cache_swa_k, cache_swa_v, state_ffn_conv)
    y_sample, (s_dn_conv, s_dn_ssm, s_swa_k, s_swa_v, s_ffn_conv) = _trunk(
        x_sample, c_sample, sample_states, layer_w, rel_bias, final_norm_w)
    return (y_prompt, y_sample, p_dn_conv, s_dn_conv, p_dn_ssm, s_dn_ssm, p_swa_k, s_swa_k,
            p_swa_v, s_swa_v, p_ffn_conv, s_ffn_conv)
```

```cpp
#include <hip/hip_runtime.h>
#include <hip/hip_cooperative_groups.h>
#include <cstdio>
#include <cstdint>
#define HD __device__ __forceinline__
#ifndef CFG_D_MODEL
#define CFG_D_MODEL 1024
#endif
#ifndef CFG_SEQ
#define CFG_SEQ 8192
#endif
#ifndef CFG_DEC_BATCH
#define CFG_DEC_BATCH 128
#endif
#ifndef CFG_D_FF
#define CFG_D_FF 2816
#endif

constexpr int D = CFG_D_MODEL, BATCH = 2, SEQ = CFG_SEQ, DEC_BATCH = CFG_DEC_BATCH, DEC_SEQ = 8, DFF = CFG_D_FF;
constexpr int TP = BATCH * SEQ, TS = DEC_BATCH * DEC_SEQ, T = TP + TS, NCB = BATCH + DEC_BATCH;
constexpr int IN_COLS = 2824, PLD = 2816;
constexpr int PC_QKV = 0, PC_Z = 1536, PC_SQ = 2048, PC_SK = 2560, PC_SV = 2688;
constexpr int WC_BA = 2048;
constexpr float EPS = 1e-6f;

constexpr long O_Y = 0;
constexpr long O_PDC = (long)T * D;
constexpr long O_SDC = O_PDC + (long)BATCH * 3 * 1536;
constexpr long O_PSSM = O_SDC + (long)DEC_BATCH * 3 * 1536;
constexpr long O_SSSM = O_PSSM + (long)BATCH * 4 * 128 * 128;
constexpr long O_PK = O_SSSM + (long)DEC_BATCH * 4 * 128 * 128;
constexpr long O_SK = O_PK + (long)BATCH * 128 * 128;
constexpr long O_PV = O_SK + (long)DEC_BATCH * 128 * 128;
constexpr long O_SV = O_PV + (long)BATCH * 128 * 128;
constexpr long O_PFC = O_SV + (long)DEC_BATCH * 128 * 128;
constexpr long O_SFC = O_PFC + (long)BATCH * 2 * 2 * DFF;
constexpr long O_END = O_SFC + (long)DEC_BATCH * 2 * 2 * DFF;

constexpr size_t al256(size_t x) { return (x + 255) & ~(size_t)255; }
constexpr size_t WS_CTL = 0;
constexpr size_t WS_MOD = 1u << 20;
constexpr size_t WS_BG = al256(WS_MOD + (size_t)NCB * 6 * D * 4);
constexpr size_t WS_WT_IN = al256(WS_BG + (size_t)T * 8 * 4);
constexpr size_t WS_WT_OUT = al256(WS_WT_IN + (size_t)PLD * D * 2);
constexpr size_t WS_WT_UP = al256(WS_WT_OUT + (size_t)D * 1024 * 2);
constexpr size_t WS_WT_DN = al256(WS_WT_UP + (size_t)2 * DFF * D * 2);
constexpr size_t WS_H = al256(WS_WT_DN + (size_t)D * DFF * 2);
constexpr size_t WS_PROJ = al256(WS_H + (size_t)T * (D > 1024 ? D : 1024) * 2);
constexpr size_t WS_QKVC = al256(WS_PROJ + (size_t)T * PLD * 2);
constexpr size_t WS_MIX = al256(WS_QKVC + (size_t)T * 1536 * 2);
constexpr size_t WS_FREE = al256(WS_MIX + (size_t)T * 1024 * 2);
constexpr size_t WS_ODN = WS_H, WS_ACT = WS_PROJ;

typedef unsigned short bf16_t;
HD unsigned f2bf_bits(float f) { unsigned u = __builtin_bit_cast(unsigned, f); return (u + 0x7fffu + ((u >> 16) & 1u)) >> 16; }
HD bf16_t f2bf(float f) { return (bf16_t)f2bf_bits(f); }
HD float bf2f(bf16_t b) { return __builtin_bit_cast(float, (unsigned)b << 16); }
HD float silu_f(float x) { return x / (1.0f + expf(-x)); }
HD float sigmoid_f(float x) { return 1.0f / (1.0f + expf(-x)); }
HD float softplus_f(float x) { return x > 20.f ? x : log1pf(expf(x)); }

struct P {
    const float *x_prompt, *x_sample, *state_dn_conv, *state_dn_ssm, *cache_k, *cache_v, *state_ffn, *c_prompt, *c_sample, *rel_bias,
        *final_norm_w, *w_ada, *b_ada, *norm_mix_w, *w_in, *dn_conv_w, *dn_A_log, *dn_dt_bias, *dn_norm_w, *swa_sinks, *w_out, *norm_ffn_w,
        *w_up, *ffn_conv_w, *ffn_conv_b, *w_down;
    float* out; unsigned char* ws;
};

HD const float* xrow(const P& p, int m) { return m < TP ? p.x_prompt + (size_t)m * D : p.x_sample + (size_t)(m - TP) * D; }
HD int cb_of(int m) { return m < TP ? m / SEQ : BATCH + (m - TP) / DEC_SEQ; }
HD int t_of(int m) { return m < TP ? m % SEQ : (m - TP) % DEC_SEQ; }
HD float* ws_f(const P& p, size_t off) { return (float*)(p.ws + off); }
HD bf16_t* ws_h(const P& p, size_t off) { return (bf16_t*)(p.ws + off); }

HD int t5_bucket(int d) {
    if (d < 16) return d;
    const float logv = logf((float)d / 16.0f) / 2.0794415416798357f;
    int b = 16 + (int)(logv * 16.0f);
    return b < 31 ? b : 31;
}

constexpr long N_R0A = (long)NCB * 6 * D;
HD void r0a_body(long idx, const P& p) {
    const int cb = (int)(idx / (6 * D)), e = (int)(idx % (6 * D));
    const float* c = cb < BATCH ? p.c_prompt + (size_t)cb * D : p.c_sample + (size_t)(cb - BATCH) * D;
    float acc = 0.f;
    for (int d = 0; d < D; ++d) acc += silu_f(c[d]) * p.w_ada[(size_t)d * 6 * D + e];
    ws_f(p, WS_MOD)[idx] = acc + p.b_ada[e];
}
constexpr long N_R1 = T;
template <int WHICH> HD void r1_body(long idx, const P& p) {
    const int m = (int)idx, cb = cb_of(m);
    const float* xr = WHICH == 0 ? xrow(p, m) : p.out + O_Y + (size_t)m * D;
    const float* nw = WHICH == 0 ? p.norm_mix_w : p.norm_ffn_w;
    const float* mod = ws_f(p, WS_MOD) + (size_t)cb * 6 * D;
    const float* sh = mod + (WHICH == 0 ? 0 : 3 * D); const float* sc = mod + (WHICH == 0 ? D : 4 * D);
    float ss = 0.f;
    for (int k = 0; k < D; ++k) ss += xr[k] * xr[k];
    const float rstd = 1.0f / sqrtf(ss / (float)D + EPS);
    float ba[8];
#pragma unroll
    for (int j = 0; j < 8; ++j) ba[j] = 0.f;
    bf16_t* H = ws_h(p, WS_H) + (size_t)m * D;
    for (int k = 0; k < D; ++k) {
        const float h = xr[k] * rstd * nw[k] * (1.0f + sc[k]) + sh[k];
        H[k] = f2bf(h);
        if (WHICH == 0) {
#pragma unroll
            for (int j = 0; j < 8; ++j) ba[j] += h * p.w_in[(size_t)k * IN_COLS + WC_BA + j];
        }
    }
    if (WHICH == 0) {
        float* bg = ws_f(p, WS_BG) + (size_t)m * 8;
#pragma unroll
        for (int j = 0; j < 4; ++j) {
            bg[j] = sigmoid_f(ba[j]);
            bg[4 + j] = -expf(p.dn_A_log[j]) * softplus_f(ba[4 + j] + p.dn_dt_bias[j]);
        }
    }
}
constexpr long N_R2 = (long)(T / 8) * PLD;
HD void r2_body(long idx, const P& p) {
    const int mg = (int)(idx / PLD), n = (int)(idx % PLD), oc = n < WC_BA ? n : n + 8;
    const bf16_t* H = ws_h(p, WS_H) + (size_t)mg * 8 * D;
    float acc[8];
#pragma unroll
    for (int i = 0; i < 8; ++i) acc[i] = 0.f;
    for (int k = 0; k < D; ++k) {
        const float w = bf2f(f2bf(p.w_in[(size_t)k * IN_COLS + oc]));
#pragma unroll
        for (int i = 0; i < 8; ++i) acc[i] += bf2f(H[(size_t)i * D + k]) * w;
    }
    bf16_t* PR = ws_h(p, WS_PROJ);
#pragma unroll
    for (int i = 0; i < 8; ++i) PR[(size_t)(mg * 8 + i) * PLD + n] = f2bf(acc[i]);
}
constexpr long N_R2B_1 = (long)BATCH * 3 * 1536, N_R2B_2 = (long)DEC_BATCH * 3 * 1536, N_R2B_3 = (long)BATCH * 128 * 128, N_R2B_4 = (long)DEC_BATCH * 128 * 128;
constexpr long N_R2B = N_R2B_1 + N_R2B_2 + 2 * (N_R2B_3 + N_R2B_4);
HD void r2b_body(long idx, const P& p) {
    const bf16_t* PR = ws_h(p, WS_PROJ);
    long r = idx;
    if (r < N_R2B_1) { const int b = (int)(r / (3 * 1536)), j = (int)(r / 1536 % 3), c = (int)(r % 1536);
        p.out[O_PDC + r] = bf2f(PR[(size_t)(b * SEQ + SEQ - 3 + j) * PLD + PC_QKV + c]); return; }
    r -= N_R2B_1;
    if (r < N_R2B_2) { const int b = (int)(r / (3 * 1536)), j = (int)(r / 1536 % 3), c = (int)(r % 1536);
        p.out[O_SDC + r] = bf2f(PR[(size_t)(TP + b * DEC_SEQ + DEC_SEQ - 3 + j) * PLD + PC_QKV + c]); return; }
    r -= N_R2B_2;
    for (int kv = 0; kv < 2; ++kv) {
        const int pc = kv == 0 ? PC_SK : PC_SV; const float* cache = kv == 0 ? p.cache_k : p.cache_v;
        if (r < N_R2B_3) { const int b = (int)(r / (128 * 128)), j = (int)(r / 128 % 128), c = (int)(r % 128);
            p.out[(kv == 0 ? O_PK : O_PV) + r] = bf2f(PR[(size_t)(b * SEQ + SEQ - 128 + j) * PLD + pc + c]); return; }
        r -= N_R2B_3;
        if (r < N_R2B_4) { const int b = (int)(r / (128 * 128)), j = (int)(r / 128 % 128), c = (int)(r % 128);
            float v;
            if (j < 128 - DEC_SEQ) v = cache[((size_t)b * 128 + j + DEC_SEQ) * 128 + c];
            else v = bf2f(PR[(size_t)(TP + b * DEC_SEQ + (j - (128 - DEC_SEQ))) * PLD + pc + c]);
            p.out[(kv == 0 ? O_SK : O_SV) + r] = v; return; }
        r -= N_R2B_4;
    }
}
constexpr long N_R3 = (long)T * 12;
HD float r3_conv(const P& p, int m, int t, int ch) {
    const bf16_t* PR = ws_h(p, WS_PROJ);
    float acc = 0.f;
#pragma unroll
    for (int j = 0; j < 4; ++j) {
        const int tt = t - 3 + j; float xv;
        if (tt >= 0) xv = bf2f(PR[(size_t)(m - (t - tt)) * PLD + PC_QKV + ch]);
        else xv = m < TP ? 0.f : p.state_dn_conv[((size_t)((m - TP) / DEC_SEQ) * 3 + (3 + tt)) * 1536 + ch];
        acc += p.dn_conv_w[j * 1536 + ch] * xv;
    }
    return silu_f(acc);
}
HD void r3_body(long idx, const P& p) {
    const int m = (int)(idx / 12), grp = (int)(idx % 12), part = grp / 4, cbase = grp * 128, t = t_of(m);
    float scale = 1.f;
    if (part < 2) {
        float ss = 0.f;
        for (int c = 0; c < 128; ++c) { const float v = r3_conv(p, m, t, cbase + c); ss += v * v; }
        scale = 1.0f / sqrtf(ss + EPS);
        if (part == 0) scale *= 0.08838834764831845f;
    }
    bf16_t* Q = ws_h(p, WS_QKVC) + (size_t)m * 1536 + cbase;
    for (int c = 0; c < 128; ++c) Q[c] = f2bf(r3_conv(p, m, t, cbase + c) * scale);
}
constexpr long N_R4 = (long)NCB * 4 * 128;
HD void r4_body(long idx, const P& p) {
    const int seq = (int)(idx / 512), h = (int)(idx / 128 % 4), v = (int)(idx % 128);
    const bool smp = seq >= BATCH; const int b = smp ? seq - BATCH : seq;
    float* S = p.out + (smp ? O_SSSM : O_PSSM) + ((size_t)b * 4 + h) * 128 * 128 + v;
    const float* S0 = smp ? p.state_dn_ssm + ((size_t)b * 4 + h) * 128 * 128 + v : nullptr;
    for (int k = 0; k < 128; ++k) S[(size_t)k * 128] = smp ? S0[(size_t)k * 128] : 0.f;
    const int L = smp ? DEC_SEQ : SEQ, m0 = smp ? TP + b * DEC_SEQ : b * SEQ;
    const bf16_t* QK = ws_h(p, WS_QKVC); const float* BG = ws_f(p, WS_BG); float* ODN = ws_f(p, WS_ODN);
    for (int t = 0; t < L; ++t) {
        const int m = m0 + t;
        const bf16_t* q = QK + (size_t)m * 1536 + h * 128; const bf16_t* kk = q + 512; const float vv = bf2f(q[1024 + v]);
        const float beta = BG[(size_t)m * 8 + h], eg = expf(BG[(size_t)m * 8 + 4 + h]);
        float kS = 0.f;
        for (int k = 0; k < 128; ++k) kS += bf2f(kk[k]) * (S[(size_t)k * 128] * eg);
        const float u = beta * (vv - kS);
        float o = 0.f;
        for (int k = 0; k < 128; ++k) { const float s = S[(size_t)k * 128] * eg + bf2f(kk[k]) * u; S[(size_t)k * 128] = s; o += bf2f(q[k]) * s; }
        ODN[(size_t)m * 512 + h * 128 + v] = o;
    }
}
constexpr long N_R5 = (long)T * 4;
HD void r5_body(long idx, const P& p) {
    const int m = (int)(idx / 4), h = (int)(idx % 4);
    const float* o = ws_f(p, WS_ODN) + (size_t)m * 512 + h * 128;
    float ss = 0.f;
    for (int v = 0; v < 128; ++v) ss += o[v] * o[v];
    const float rstd = 1.0f / sqrtf(ss / 128.0f + EPS);
    const bf16_t* z = ws_h(p, WS_PROJ) + (size_t)m * PLD + PC_Z + h * 128;
    bf16_t* mix = ws_h(p, WS_MIX) + (size_t)m * 1024 + h * 128;
    for (int v = 0; v < 128; ++v) mix[v] = f2bf(o[v] * rstd * p.dn_norm_w[v] * silu_f(bf2f(z[v])));
}
constexpr long N_R6 = (long)T * 8 * 8;
HD void r6_body(long idx, const P& p) {
    const int m = (int)(idx / 64), hq = (int)(idx / 8 % 8), dg = (int)(idx % 8), kvh = hq / 4, t = t_of(m);
    const bool smp = m >= TP; const int b = smp ? (m - TP) / DEC_SEQ : 0;
    const bf16_t* PR = ws_h(p, WS_PROJ);
    const bf16_t* q = PR + (size_t)m * PLD + PC_SQ + hq * 64;
    const float sink = p.swa_sinks[hq];
    const int nk = smp ? 128 : (t < 127 ? t + 1 : 128);
    float mx = sink;
    for (int pass = 0; pass < 2; ++pass) {
        float den = 0.f, acc[8];
#pragma unroll
        for (int i = 0; i < 8; ++i) acc[i] = 0.f;
        for (int jj = 0; jj < nk; ++jj) {
            int dist; const float* kf = nullptr; const float* vf = nullptr; const bf16_t* kb = nullptr; const bf16_t* vb = nullptr;
            if (smp) { const int j = t + 1 + jj; dist = 128 + t - j;
                if (j < 128) { kf = p.cache_k + ((size_t)b * 128 + j) * 128 + kvh * 64; vf = p.cache_v + ((size_t)b * 128 + j) * 128 + kvh * 64; }
                else { const size_t mm = (size_t)(TP + b * DEC_SEQ + (j - 128)); kb = PR + mm * PLD + PC_SK + kvh * 64; vb = PR + mm * PLD + PC_SV + kvh * 64; } }
            else { dist = nk - 1 - jj; const size_t mm = (size_t)(m - dist); kb = PR + mm * PLD + PC_SK + kvh * 64; vb = PR + mm * PLD + PC_SV + kvh * 64; }
            float s = 0.f;
            for (int d = 0; d < 64; ++d) s += bf2f(q[d]) * (kf ? kf[d] : bf2f(kb[d]));
            s = s * 0.125f + p.rel_bias[t5_bucket(dist) * 8 + hq];
            if (pass == 0) { mx = s > mx ? s : mx; }
            else { const float pr = expf(s - mx); den += pr;
#pragma unroll
                for (int i = 0; i < 8; ++i) acc[i] += pr * (vf ? vf[dg * 8 + i] : bf2f(vb[dg * 8 + i])); }
        }
        if (pass == 1) { den += expf(sink - mx); bf16_t* mix = ws_h(p, WS_MIX) + (size_t)m * 1024 + 512 + hq * 64 + dg * 8;
#pragma unroll
            for (int i = 0; i < 8; ++i) mix[i] = f2bf(acc[i] / den); }
    }
}
constexpr long N_R7 = (long)(T / 8) * D;
HD void r7_body(long idx, const P& p) {
    const int mg = (int)(idx / D), d = (int)(idx % D);
    const bf16_t* MX = ws_h(p, WS_MIX) + (size_t)mg * 8 * 1024;
    float acc[8];
#pragma unroll
    for (int i = 0; i < 8; ++i) acc[i] = 0.f;
    for (int e = 0; e < 1024; ++e) { const float w = bf2f(f2bf(p.w_out[(size_t)e * D + d]));
#pragma unroll
        for (int i = 0; i < 8; ++i) acc[i] += bf2f(MX[(size_t)i * 1024 + e]) * w; }
#pragma unroll
    for (int i = 0; i < 8; ++i) { const int m = mg * 8 + i; const float g1 = ws_f(p, WS_MOD)[(size_t)cb_of(m) * 6 * D + 2 * D + d];
        p.out[O_Y + (size_t)m * D + d] = xrow(p, m)[d] + g1 * acc[i]; }
}
constexpr long N_R9 = (long)(T / 8) * DFF;
HD void r9_body(long idx, const P& p) {
    const int mg = (int)(idx / DFF), f = (int)(idx % DFF), m0 = mg * 8, t0 = t_of(m0);
    const bool smp = m0 >= TP; const int b = smp ? (m0 - TP) / DEC_SEQ : m0 / SEQ;
    const bf16_t* H = ws_h(p, WS_H);
    float ug[10], uu[10];
#pragma unroll
    for (int i = 0; i < 10; ++i) { ug[i] = 0.f; uu[i] = 0.f; }
    const bool halo = (!smp && t0 > 0);
    for (int k = 0; k < D; ++k) {
        const float wg = bf2f(f2bf(p.w_up[(size_t)k * 2 * DFF + f])), wu = bf2f(f2bf(p.w_up[(size_t)k * 2 * DFF + DFF + f]));
#pragma unroll
        for (int i = 0; i < 10; ++i) { if (i < 2 && !halo) continue; const float h = bf2f(H[(size_t)(m0 - 2 + i) * D + k]); ug[i] += h * wg; uu[i] += h * wu; }
    }
    if (smp) {
#pragma unroll
        for (int i = 0; i < 2; ++i) { ug[i] = p.state_ffn[((size_t)b * 2 + i) * 2 * DFF + f]; uu[i] = p.state_ffn[((size_t)b * 2 + i) * 2 * DFF + DFF + f]; }
    }
    const float w0g = p.ffn_conv_w[f], w1g = p.ffn_conv_w[2 * DFF + f], w2g = p.ffn_conv_w[4 * DFF + f], bgt = p.ffn_conv_b[f];
    const float w0u = p.ffn_conv_w[DFF + f], w1u = p.ffn_conv_w[3 * DFF + f], w2u = p.ffn_conv_w[5 * DFF + f], bup = p.ffn_conv_b[DFF + f];
    bf16_t* ACT = ws_h(p, WS_ACT);
#pragma unroll
    for (int i = 0; i < 8; ++i) {
        const float gc = w0g * ug[i] + w1g * ug[i + 1] + w2g * ug[i + 2] + bgt, uc = w0u * uu[i] + w1u * uu[i + 1] + w2u * uu[i + 2] + bup;
        ACT[(size_t)(m0 + i) * DFF + f] = f2bf(silu_f(gc) * uc);
    }
    if (smp) {
#pragma unroll
        for (int j = 0; j < 2; ++j) { float* o = p.out + O_SFC + ((size_t)b * 2 + j) * 2 * DFF; o[f] = ug[8 + j]; o[DFF + f] = uu[8 + j]; }
    } else if (t0 == SEQ - 8) {
#pragma unroll
        for (int j = 0; j < 2; ++j) { float* o = p.out + O_PFC + ((size_t)b * 2 + j) * 2 * DFF; o[f] = ug[8 + j]; o[DFF + f] = uu[8 + j]; }
    }
}
constexpr long N_R10 = (long)(T / 8) * D;
HD void r10_body(long idx, const P& p) {
    const int mg = (int)(idx / D), d = (int)(idx % D);
    const bf16_t* A = ws_h(p, WS_ACT) + (size_t)mg * 8 * DFF;
    float acc[8];
#pragma unroll
    for (int i = 0; i < 8; ++i) acc[i] = 0.f;
    for (int f = 0; f < DFF; ++f) { const float w = bf2f(f2bf(p.w_down[(size_t)f * D + d]));
#pragma unroll
        for (int i = 0; i < 8; ++i) acc[i] += bf2f(A[(size_t)i * DFF + f]) * w; }
#pragma unroll
    for (int i = 0; i < 8; ++i) { const int m = mg * 8 + i; const float g2 = ws_f(p, WS_MOD)[(size_t)cb_of(m) * 6 * D + 5 * D + d];
        float* o = p.out + O_Y + (size_t)m * D + d; *o = *o + g2 * acc[i]; }
}
constexpr long N_R11 = T, N_R8 = T;
HD void r11_body(long idx, const P& p) {
    float* xr = p.out + O_Y + (size_t)idx * D;
    float ss = 0.f;
    for (int k = 0; k < D; ++k) ss += xr[k] * xr[k];
    const float rstd = 1.0f / sqrtf(ss / (float)D + EPS);
    for (int k = 0; k < D; ++k) xr[k] = xr[k] * rstd * p.final_norm_w[k];
}
template <void (*BODY)(long, const P&)> __global__ void __launch_bounds__(256) run_k(long n, P p) {
    for (long i = blockIdx.x * 256L + threadIdx.x; i < n; i += (long)gridDim.x * 256) BODY(i, p);
}
template <void (*BODY)(long, const P&)> static void launch_body(long n, const P& p, hipStream_t s) {
    long blocks = (n + 255) / 256; if (blocks > 65536 * 4) blocks = 65536 * 4;
    hipLaunchKernelGGL(run_k<BODY>, dim3((unsigned)blocks), dim3(256), 0, s, n, p);
}
static void fill_params(P& p, void* const* d_in, void* d_out, void* d_ws) {
    const float** pp = (const float**)&p;
    for (int i = 0; i < 26; ++i) pp[i] = (const float*)d_in[i];
    p.out = (float*)d_out; p.ws = (unsigned char*)d_ws;
}
static void launch_reference(const P& p, hipStream_t s) {
    launch_body<r0a_body>(N_R0A, p, s); launch_body<r1_body<0>>(N_R1, p, s); launch_body<r2_body>(N_R2, p, s); launch_body<r2b_body>(N_R2B, p, s);
    launch_body<r3_body>(N_R3, p, s); launch_body<r4_body>(N_R4, p, s); launch_body<r5_body>(N_R5, p, s); launch_body<r6_body>(N_R6, p, s);
    launch_body<r7_body>(N_R7, p, s); launch_body<r1_body<1>>(N_R8, p, s); launch_body<r9_body>(N_R9, p, s); launch_body<r10_body>(N_R10, p, s);
    launch_body<r11_body>(N_R11, p, s);
}
extern "C" void kernel_launch(void* const* d_in, const int* in_sizes, int n_in, void* d_out, int out_size, void* d_ws, size_t ws_size, hipStream_t stream) {
    if (n_in != 26 || (long)out_size != O_END || ws_size < WS_FREE) { fprintf(stderr, "kernel_launch: unexpected shapes n_in=%d out=%d ws=%zu (need %zu)\n", n_in, out_size, ws_size, (size_t)WS_FREE); return; }
    P p{}; fill_params(p, d_in, d_out, d_ws);
    launch_reference(p, stream);
}
```

```cpp
#include <hip/hip_runtime.h>
#include <hip/hip_cooperative_groups.h>
#include <cstdio>
#include <cstdint>
#define HD __device__ __forceinline__
#ifndef CFG_D_MODEL
#define CFG_D_MODEL 1024
#endif
#ifndef CFG_SEQ
#define CFG_SEQ 8192
#endif
#ifndef CFG_DEC_BATCH
#define CFG_DEC_BATCH 128
#endif
#ifndef CFG_D_FF
#define CFG_D_FF 2816
#endif

constexpr int D = CFG_D_MODEL, BATCH = 2, SEQ = CFG_SEQ, DEC_BATCH = CFG_DEC_BATCH, DEC_SEQ = 8, DFF = CFG_D_FF;
constexpr int TP = BATCH * SEQ, TS = DEC_BATCH * DEC_SEQ, T = TP + TS, NCB = BATCH + DEC_BATCH;
constexpr int IN_COLS = 2824, PLD = 2816;
constexpr int PC_QKV = 0, PC_Z = 1536, PC_SQ = 2048, PC_SK = 2560, PC_SV = 2688;
constexpr int WC_BA = 2048;
constexpr float EPS = 1e-6f;

constexpr long O_Y = 0;
constexpr long O_PDC = (long)T * D;
constexpr long O_SDC = O_PDC + (long)BATCH * 3 * 1536;
constexpr long O_PSSM = O_SDC + (long)DEC_BATCH * 3 * 1536;
constexpr long O_SSSM = O_PSSM + (long)BATCH * 4 * 128 * 128;
constexpr long O_PK = O_SSSM + (long)DEC_BATCH * 4 * 128 * 128;
constexpr long O_SK = O_PK + (long)BATCH * 128 * 128;
constexpr long O_PV = O_SK + (long)DEC_BATCH * 128 * 128;
constexpr long O_SV = O_PV + (long)BATCH * 128 * 128;
constexpr long O_PFC = O_SV + (long)DEC_BATCH * 128 * 128;
constexpr long O_SFC = O_PFC + (long)BATCH * 2 * 2 * DFF;
constexpr long O_END = O_SFC + (long)DEC_BATCH * 2 * 2 * DFF;

constexpr size_t al256(size_t x) { return (x + 255) & ~(size_t)255; }
constexpr size_t WS_CTL = 0;
constexpr size_t WS_MOD = 1u << 20;
constexpr size_t WS_BG = al256(WS_MOD + (size_t)NCB * 6 * D * 4);
constexpr size_t WS_WT_IN = al256(WS_BG + (size_t)T * 8 * 4);
constexpr size_t WS_WT_OUT = al256(WS_WT_IN + (size_t)PLD * D * 2);
constexpr size_t WS_WT_UP = al256(WS_WT_OUT + (size_t)D * 1024 * 2);
constexpr size_t WS_WT_DN = al256(WS_WT_UP + (size_t)2 * DFF * D * 2);
constexpr size_t WS_H = al256(WS_WT_DN + (size_t)D * DFF * 2);
constexpr int NCHUNK = SEQ / 64, NUNIT = BATCH * 4 * NCHUNK;
constexpr int DNF_AB_UNIT = 57344, DNF_WV_UNIT = 32768;
constexpr size_t WS_DNF_WV = WS_H;
constexpr size_t WS_DNF_AB = al256(WS_H + (size_t)T * (D > 1024 ? D : 1024) * 2);
constexpr size_t WS_DNF_CD = al256(WS_DNF_AB + (size_t)NUNIT * DNF_AB_UNIT);
constexpr size_t WS_QKVC = WS_DNF_AB;
constexpr size_t WS_PROJ = al256((WS_DNF_CD + (size_t)NUNIT * 4) > (WS_QKVC + (size_t)T * 1536 * 2) ? (WS_DNF_CD + (size_t)NUNIT * 4) : (WS_QKVC + (size_t)T * 1536 * 2));
constexpr size_t WS_MIX = al256(WS_PROJ + (size_t)T * PLD * 2);
constexpr size_t WS_FREE = al256(WS_MIX + (size_t)T * 1024 * 2);
constexpr size_t WS_ODN = WS_H, WS_ACT = WS_PROJ;
static_assert((size_t)NUNIT * DNF_WV_UNIT <= (size_t)T * 1024 * 2, "Wv tiles overlay H");

typedef unsigned short bf16_t;
HD unsigned f2bf_bits(float f) { unsigned u = __builtin_bit_cast(unsigned, f); return (u + 0x7fffu + ((u >> 16) & 1u)) >> 16; }
HD bf16_t f2bf(float f) { return (bf16_t)f2bf_bits(f); }
HD float bf2f(bf16_t b) { return __builtin_bit_cast(float, (unsigned)b << 16); }
HD float silu_f(float x) { return x / (1.0f + expf(-x)); }
HD float sigmoid_f(float x) { return 1.0f / (1.0f + expf(-x)); }
HD float softplus_f(float x) { return x > 20.f ? x : log1pf(expf(x)); }

struct P {
    const float *x_prompt, *x_sample, *state_dn_conv, *state_dn_ssm, *cache_k, *cache_v, *state_ffn, *c_prompt, *c_sample, *rel_bias,
        *final_norm_w, *w_ada, *b_ada, *norm_mix_w, *w_in, *dn_conv_w, *dn_A_log, *dn_dt_bias, *dn_norm_w, *swa_sinks, *w_out, *norm_ffn_w,
        *w_up, *ffn_conv_w, *ffn_conv_b, *w_down;
    float* out; unsigned char* ws;
};

HD const float* xrow(const P& p, int m) { return m < TP ? p.x_prompt + (size_t)m * D : p.x_sample + (size_t)(m - TP) * D; }
HD int cb_of(int m) { return m < TP ? m / SEQ : BATCH + (m - TP) / DEC_SEQ; }
HD int t_of(int m) { return m < TP ? m % SEQ : (m - TP) % DEC_SEQ; }
HD float* ws_f(const P& p, size_t off) { return (float*)(p.ws + off); }
HD bf16_t* ws_h(const P& p, size_t off) { return (bf16_t*)(p.ws + off); }

HD int t5_bucket(int d) {
    if (d < 16) return d;
    const float logv = logf((float)d / 16.0f) / 2.0794415416798357f;
    int b = 16 + (int)(logv * 16.0f);
    return b < 31 ? b : 31;
}

constexpr long N_R0A = (long)NCB * 6 * D;
HD void r0a_body(long idx, const P& p) {
    const int cb = (int)(idx / (6 * D)), e = (int)(idx % (6 * D));
    const float* c = cb < BATCH ? p.c_prompt + (size_t)cb * D : p.c_sample + (size_t)(cb - BATCH) * D;
    float acc = 0.f;
    for (int d = 0; d < D; ++d) acc += silu_f(c[d]) * p.w_ada[(size_t)d * 6 * D + e];
    ws_f(p, WS_MOD)[idx] = acc + p.b_ada[e];
}
constexpr long N_R1 = T;
template <int WHICH> HD void r1_body(long idx, const P& p) {
    const int m = (int)idx, cb = cb_of(m);
    const float* xr = WHICH == 0 ? xrow(p, m) : p.out + O_Y + (size_t)m * D;
    const float* nw = WHICH == 0 ? p.norm_mix_w : p.norm_ffn_w;
    const float* mod = ws_f(p, WS_MOD) + (size_t)cb * 6 * D;
    const float* sh = mod + (WHICH == 0 ? 0 : 3 * D); const float* sc = mod + (WHICH == 0 ? D : 4 * D);
    float ss = 0.f;
    for (int k = 0; k < D; ++k) ss += xr[k] * xr[k];
    const float rstd = 1.0f / sqrtf(ss / (float)D + EPS);
    float ba[8];
#pragma unroll
    for (int j = 0; j < 8; ++j) ba[j] = 0.f;
    bf16_t* H = ws_h(p, WS_H) + (size_t)m * D;
    for (int k = 0; k < D; ++k) {
        const float h = xr[k] * rstd * nw[k] * (1.0f + sc[k]) + sh[k];
        H[k] = f2bf(h);
        if (WHICH == 0) {
#pragma unroll
            for (int j = 0; j < 8; ++j) ba[j] += h * p.w_in[(size_t)k * IN_COLS + WC_BA + j];
        }
    }
    if (WHICH == 0) {
        float* bg = ws_f(p, WS_BG) + (size_t)m * 8;
#pragma unroll
        for (int j = 0; j < 4; ++j) {
            bg[j] = sigmoid_f(ba[j]);
            bg[4 + j] = -expf(p.dn_A_log[j]) * softplus_f(ba[4 + j] + p.dn_dt_bias[j]);
        }
    }
}
constexpr long N_R2 = (long)(T / 8) * PLD;
HD void r2_body(long idx, const P& p) {
    const int mg = (int)(idx / PLD), n = (int)(idx % PLD), oc = n < WC_BA ? n : n + 8;
    const bf16_t* H = ws_h(p, WS_H) + (size_t)mg * 8 * D;
    float acc[8];
#pragma unroll
    for (int i = 0; i < 8; ++i) acc[i] = 0.f;
    for (int k = 0; k < D; ++k) {
        const float w = bf2f(f2bf(p.w_in[(size_t)k * IN_COLS + oc]));
#pragma unroll
        for (int i = 0; i < 8; ++i) acc[i] += bf2f(H[(size_t)i * D + k]) * w;
    }
    bf16_t* PR = ws_h(p, WS_PROJ);
#pragma unroll
    for (int i = 0; i < 8; ++i) PR[(size_t)(mg * 8 + i) * PLD + n] = f2bf(acc[i]);
}
constexpr long N_R2B_1 = (long)BATCH * 3 * 1536, N_R2B_2 = (long)DEC_BATCH * 3 * 1536, N_R2B_3 = (long)BATCH * 128 * 128, N_R2B_4 = (long)DEC_BATCH * 128 * 128;
constexpr long N_R2B = N_R2B_1 + N_R2B_2 + 2 * (N_R2B_3 + N_R2B_4);
HD void r2b_body(long idx, const P& p) {
    const bf16_t* PR = ws_h(p, WS_PROJ);
    long r = idx;
    if (r < N_R2B_1) { const int b = (int)(r / (3 * 1536)), j = (int)(r / 1536 % 3), c = (int)(r % 1536);
        p.out[O_PDC + r] = bf2f(PR[(size_t)(b * SEQ + SEQ - 3 + j) * PLD + PC_QKV + c]); return; }
    r -= N_R2B_1;
    if (r < N_R2B_2) { const int b = (int)(r / (3 * 1536)), j = (int)(r / 1536 % 3), c = (int)(r % 1536);
        p.out[O_SDC + r] = bf2f(PR[(size_t)(TP + b * DEC_SEQ + DEC_SEQ - 3 + j) * PLD + PC_QKV + c]); return; }
    r -= N_R2B_2;
    for (int kv = 0; kv < 2; ++kv) {
        const int pc = kv == 0 ? PC_SK : PC_SV; const float* cache = kv == 0 ? p.cache_k : p.cache_v;
        if (r < N_R2B_3) { const int b = (int)(r / (128 * 128)), j = (int)(r / 128 % 128), c = (int)(r % 128);
            p.out[(kv == 0 ? O_PK : O_PV) + r] = bf2f(PR[(size_t)(b * SEQ + SEQ - 128 + j) * PLD + pc + c]); return; }
        r -= N_R2B_3;
        if (r < N_R2B_4) { const int b = (int)(r / (128 * 128)), j = (int)(r / 128 % 128), c = (int)(r % 128);
            float v;
            if (j < 128 - DEC_SEQ) v = cache[((size_t)b * 128 + j + DEC_SEQ) * 128 + c];
            else v = bf2f(PR[(size_t)(TP + b * DEC_SEQ + (j - (128 - DEC_SEQ))) * PLD + pc + c]);
            p.out[(kv == 0 ? O_SK : O_SV) + r] = v; return; }
        r -= N_R2B_4;
    }
}
constexpr long N_R3 = (long)T * 12;
HD float r3_conv(const P& p, int m, int t, int ch) {
    const bf16_t* PR = ws_h(p, WS_PROJ);
    float acc = 0.f;
#pragma unroll
    for (int j = 0; j < 4; ++j) {
        const int tt = t - 3 + j; float xv;
        if (tt >= 0) xv = bf2f(PR[(size_t)(m - (t - tt)) * PLD + PC_QKV + ch]);
        else xv = m < TP ? 0.f : p.state_dn_conv[((size_t)((m - TP) / DEC_SEQ) * 3 + (3 + tt)) * 1536 + ch];
        acc += p.dn_conv_w[j * 1536 + ch] * xv;
    }
    return silu_f(acc);
}
HD void r3_body(long idx, const P& p) {
    const int m = (int)(idx / 12), grp = (int)(idx % 12), part = grp / 4, cbase = grp * 128, t = t_of(m);
    float scale = 1.f;
    if (part < 2) {
        float ss = 0.f;
        for (int c = 0; c < 128; ++c) { const float v = r3_conv(p, m, t, cbase + c); ss += v * v; }
        scale = 1.0f / sqrtf(ss + EPS);
        if (part == 0) scale *= 0.08838834764831845f;
    }
    bf16_t* Q = ws_h(p, WS_QKVC) + (size_t)m * 1536 + cbase;
    for (int c = 0; c < 128; ++c) Q[c] = f2bf(r3_conv(p, m, t, cbase + c) * scale);
}
constexpr long N_R4 = (long)NCB * 4 * 128;
HD void r4_body(long idx, const P& p) {
    const int seq = (int)(idx / 512), h = (int)(idx / 128 % 4), v = (int)(idx % 128);
    const bool smp = seq >= BATCH; const int b = smp ? seq - BATCH : seq;
    float* S = p.out + (smp ? O_SSSM : O_PSSM) + ((size_t)b * 4 + h) * 128 * 128 + v;
    const float* S0 = smp ? p.state_dn_ssm + ((size_t)b * 4 + h) * 128 * 128 + v : nullptr;
    for (int k = 0; k < 128; ++k) S[(size_t)k * 128] = smp ? S0[(size_t)k * 128] : 0.f;
    const int L = smp ? DEC_SEQ : SEQ, m0 = smp ? TP + b * DEC_SEQ : b * SEQ;
    const bf16_t* QK = ws_h(p, WS_QKVC); const float* BG = ws_f(p, WS_BG); float* ODN = ws_f(p, WS_ODN);
    for (int t = 0; t < L; ++t) {
        const int m = m0 + t;
        const bf16_t* q = QK + (size_t)m * 1536 + h * 128; const bf16_t* kk = q + 512; const float vv = bf2f(q[1024 + v]);
        const float beta = BG[(size_t)m * 8 + h], eg = expf(BG[(size_t)m * 8 + 4 + h]);
        float kS = 0.f;
        for (int k = 0; k < 128; ++k) kS += bf2f(kk[k]) * (S[(size_t)k * 128] * eg);
        const float u = beta * (vv - kS);
        float o = 0.f;
        for (int k = 0; k < 128; ++k) { const float s = S[(size_t)k * 128] * eg + bf2f(kk[k]) * u; S[(size_t)k * 128] = s; o += bf2f(q[k]) * s; }
        ODN[(size_t)m * 512 + h * 128 + v] = o;
    }
}
constexpr long N_R5 = (long)T * 4;
HD void r5_body(long idx, const P& p) {
    const int m = (int)(idx / 4), h = (int)(idx % 4);
    const float* o = ws_f(p, WS_ODN) + (size_t)m * 512 + h * 128;
    float ss = 0.f;
    for (int v = 0; v < 128; ++v) ss += o[v] * o[v];
    const float rstd = 1.0f / sqrtf(ss / 128.0f + EPS);
    const bf16_t* z = ws_h(p, WS_PROJ) + (size_t)m * PLD + PC_Z + h * 128;
    bf16_t* mix = ws_h(p, WS_MIX) + (size_t)m * 1024 + h * 128;
    for (int v = 0; v < 128; ++v) mix[v] = f2bf(o[v] * rstd * p.dn_norm_w[v] * silu_f(bf2f(z[v])));
}
constexpr long N_R6 = (long)T * 8 * 8;
HD void r6_body(long idx, const P& p) {
    const int m = (int)(idx / 64), hq = (int)(idx / 8 % 8), dg = (int)(idx % 8), kvh = hq / 4, t = t_of(m);
    const bool smp = m >= TP; const int b = smp ? (m - TP) / DEC_SEQ : 0;
    const bf16_t* PR = ws_h(p, WS_PROJ);
    const bf16_t* q = PR + (size_t)m * PLD + PC_SQ + hq * 64;
    const float sink = p.swa_sinks[hq];
    const int nk = smp ? 128 : (t < 127 ? t + 1 : 128);
    float mx = sink;
    for (int pass = 0; pass < 2; ++pass) {
        float den = 0.f, acc[8];
#pragma unroll
        for (int i = 0; i < 8; ++i) acc[i] = 0.f;
        for (int jj = 0; jj < nk; ++jj) {
            int dist; const float* kf = nullptr; const float* vf = nullptr; const bf16_t* kb = nullptr; const bf16_t* vb = nullptr;
            if (smp) { const int j = t + 1 + jj; dist = 128 + t - j;
                if (j < 128) { kf = p.cache_k + ((size_t)b * 128 + j) * 128 + kvh * 64; vf = p.cache_v + ((size_t)b * 128 + j) * 128 + kvh * 64; }
                else { const size_t mm = (size_t)(TP + b * DEC_SEQ + (j - 128)); kb = PR + mm * PLD + PC_SK + kvh * 64; vb = PR + mm * PLD + PC_SV + kvh * 64; } }
            else { dist = nk - 1 - jj; const size_t mm = (size_t)(m - dist); kb = PR + mm * PLD + PC_SK + kvh * 64; vb = PR + mm * PLD + PC_SV + kvh * 64; }
            float s = 0.f;
            for (int d = 0; d < 64; ++d) s += bf2f(q[d]) * (kf ? kf[d] : bf2f(kb[d]));
            s = s * 0.125f + p.rel_bias[t5_bucket(dist) * 8 + hq];
            if (pass == 0) { mx = s > mx ? s : mx; }
            else { const float pr = expf(s - mx); den += pr;
#pragma unroll
                for (int i = 0; i < 8; ++i) acc[i] += pr * (vf ? vf[dg * 8 + i] : bf2f(vb[dg * 8 + i])); }
        }
        if (pass == 1) { den += expf(sink - mx); bf16_t* mix = ws_h(p, WS_MIX) + (size_t)m * 1024 + 512 + hq * 64 + dg * 8;
#pragma unroll
            for (int i = 0; i < 8; ++i) mix[i] = f2bf(acc[i] / den); }
    }
}
constexpr long N_R7 = (long)(T / 8) * D;
HD void r7_body(long idx, const P& p) {
    const int mg = (int)(idx / D), d = (int)(idx % D);
    const bf16_t* MX = ws_h(p, WS_MIX) + (size_t)mg * 8 * 1024;
    float acc[8];
#pragma unroll
    for (int i = 0; i < 8; ++i) acc[i] = 0.f;
    for (int e = 0; e < 1024; ++e) { const float w = bf2f(f2bf(p.w_out[(size_t)e * D + d]));
#pragma unroll
        for (int i = 0; i < 8; ++i) acc[i] += bf2f(MX[(size_t)i * 1024 + e]) * w; }
#pragma unroll
    for (int i = 0; i < 8; ++i) { const int m = mg * 8 + i; const float g1 = ws_f(p, WS_MOD)[(size_t)cb_of(m) * 6 * D + 2 * D + d];
        p.out[O_Y + (size_t)m * D + d] = xrow(p, m)[d] + g1 * acc[i]; }
}
constexpr long N_R9 = (long)(T / 8) * DFF;
HD void r9_body(long idx, const P& p) {
    const int mg = (int)(idx / DFF), f = (int)(idx % DFF), m0 = mg * 8, t0 = t_of(m0);
    const bool smp = m0 >= TP; const int b = smp ? (m0 - TP) / DEC_SEQ : m0 / SEQ;
    const bf16_t* H = ws_h(p, WS_H);
    float ug[10], uu[10];
#pragma unroll
    for (int i = 0; i < 10; ++i) { ug[i] = 0.f; uu[i] = 0.f; }
    const bool halo = (!smp && t0 > 0);
    for (int k = 0; k < D; ++k) {
        const float wg = bf2f(f2bf(p.w_up[(size_t)k * 2 * DFF + f])), wu = bf2f(f2bf(p.w_up[(size_t)k * 2 * DFF + DFF + f]));
#pragma unroll
        for (int i = 0; i < 10; ++i) { if (i < 2 && !halo) continue; const float h = bf2f(H[(size_t)(m0 - 2 + i) * D + k]); ug[i] += h * wg; uu[i] += h * wu; }
    }
    if (smp) {
#pragma unroll
        for (int i = 0; i < 2; ++i) { ug[i] = p.state_ffn[((size_t)b * 2 + i) * 2 * DFF + f]; uu[i] = p.state_ffn[((size_t)b * 2 + i) * 2 * DFF + DFF + f]; }
    }
    const float w0g = p.ffn_conv_w[f], w1g = p.ffn_conv_w[2 * DFF + f], w2g = p.ffn_conv_w[4 * DFF + f], bgt = p.ffn_conv_b[f];
    const float w0u = p.ffn_conv_w[DFF + f], w1u = p.ffn_conv_w[3 * DFF + f], w2u = p.ffn_conv_w[5 * DFF + f], bup = p.ffn_conv_b[DFF + f];
    bf16_t* ACT = ws_h(p, WS_ACT);
#pragma unroll
    for (int i = 0; i < 8; ++i) {
        const float gc = w0g * ug[i] + w1g * ug[i + 1] + w2g * ug[i + 2] + bgt, uc = w0u * uu[i] + w1u * uu[i + 1] + w2u * uu[i + 2] + bup;
        ACT[(size_t)(m0 + i) * DFF + f] = f2bf(silu_f(gc) * uc);
    }
    if (smp) {
#pragma unroll
        for (int j = 0; j < 2; ++j) { float* o = p.out + O_SFC + ((size_t)b * 2 + j) * 2 * DFF; o[f] = ug[8 + j]; o[DFF + f] = uu[8 + j]; }
    } else if (t0 == SEQ - 8) {
#pragma unroll
        for (int j = 0; j < 2; ++j) { float* o = p.out + O_PFC + ((size_t)b * 2 + j) * 2 * DFF; o[f] = ug[8 + j]; o[DFF + f] = uu[8 + j]; }
    }
}
constexpr long N_R10 = (long)(T / 8) * D;
HD void r10_body(long idx, const P& p) {
    const int mg = (int)(idx / D), d = (int)(idx % D);
    const bf16_t* A = ws_h(p, WS_ACT) + (size_t)mg * 8 * DFF;
    float acc[8];
#pragma unroll
    for (int i = 0; i < 8; ++i) acc[i] = 0.f;
    for (int f = 0; f < DFF; ++f) { const float w = bf2f(f2bf(p.w_down[(size_t)f * D + d]));
#pragma unroll
        for (int i = 0; i < 8; ++i) acc[i] += bf2f(A[(size_t)i * DFF + f]) * w; }
#pragma unroll
    for (int i = 0; i < 8; ++i) { const int m = mg * 8 + i; const float g2 = ws_f(p, WS_MOD)[(size_t)cb_of(m) * 6 * D + 5 * D + d];
        float* o = p.out + O_Y + (size_t)m * D + d; *o = *o + g2 * acc[i]; }
}
constexpr long N_R11 = T, N_R8 = T;
HD void r11_body(long idx, const P& p) {
    float* xr = p.out + O_Y + (size_t)idx * D;
    float ss = 0.f;
    for (int k = 0; k < D; ++k) ss += xr[k] * xr[k];
    const float rstd = 1.0f / sqrtf(ss / (float)D + EPS);
    for (int k = 0; k < D; ++k) xr[k] = xr[k] * rstd * p.final_norm_w[k];
}
#define LAS __attribute__((address_space(3)))
typedef float f32x4 __attribute__((ext_vector_type(4)));
typedef unsigned u32x4 __attribute__((ext_vector_type(4)));
typedef unsigned u32x2 __attribute__((ext_vector_type(2)));
constexpr int NWAVES = 8, NTHR = 512;
constexpr int LDS_BYTES = 147456;
__device__ __forceinline__ int otid() { int t = threadIdx.x; asm volatile("" : "+v"(t)); return t; }
__device__ __forceinline__ float wave_sum(float v) {
#pragma unroll
    for (int o = 1; o < 64; o <<= 1) v += __shfl_xor(v, o);
    return v;
}
__device__ __forceinline__ unsigned pk2(float lo, float hi) { return f2bf_bits(lo) | (f2bf_bits(hi) << 16); }

__device__ __forceinline__ void transpose_item(const float* W, int ldw, int K, bf16_t* WT, int dst_n0, int src_n0, int k0, LAS float* scr, int lane) {
#pragma unroll 8
    for (int i = 0; i < 32; ++i) { const int kk = 2 * i + (lane >> 5); scr[kk * 33 + (lane & 31)] = W[(size_t)(k0 + kk) * ldw + src_n0 + (lane & 31)]; }
    asm volatile("s_waitcnt lgkmcnt(0)" ::: "memory");
    const int c = lane & 7;
#pragma unroll
    for (int j = 0; j < 4; ++j) { const int n = (lane >> 3) + 8 * j; const LAS float* s = scr + (8 * c) * 33 + n;
        u32x4 o; o.x = pk2(s[0 * 33], s[1 * 33]); o.y = pk2(s[2 * 33], s[3 * 33]); o.z = pk2(s[4 * 33], s[5 * 33]); o.w = pk2(s[6 * 33], s[7 * 33]);
        *(u32x4*)(WT + (size_t)(dst_n0 + n) * K + k0 + 8 * c) = o; }
    asm volatile("s_waitcnt lgkmcnt(0)" ::: "memory");
}
constexpr int TI_IN = (PLD / 32) * (D / 64), TI_OUT = (D / 32) * (1024 / 64), TI_UP = (2 * DFF / 32) * (D / 64), TI_DN = (D / 32) * (DFF / 64), TI_ALL = TI_IN + TI_OUT + TI_UP + TI_DN;
__device__ __forceinline__ void phase_transposes(const P& p, LAS unsigned char* lds) {
    const int tid_ = otid(), lane = tid_ & 63, wave = tid_ >> 6;
    LAS float* scr = (LAS float*)(lds + wave * 16384);
    const int gw = blockIdx.x * NWAVES + wave, NGW = gridDim.x * NWAVES;
    for (int it = gw; it < TI_ALL; it += NGW) {
        int r = it;
        if (r < TI_IN) { const int nb = r % (PLD / 32), kb = r / (PLD / 32), n0 = nb * 32; transpose_item(p.w_in, IN_COLS, D, ws_h(p, WS_WT_IN), n0, n0 < WC_BA ? n0 : n0 + 8, kb * 64, scr, lane); continue; } r -= TI_IN;
        if (r < TI_OUT) { const int nb = r % (D / 32), kb = r / (D / 32), n0 = nb * 32; transpose_item(p.w_out, D, 1024, ws_h(p, WS_WT_OUT), n0, n0, kb * 64, scr, lane); continue; } r -= TI_OUT;
        if (r < TI_UP) { const int nb = r % (2 * DFF / 32), kb = r / (2 * DFF / 32), n0 = nb * 32;
            const int pn = n0 >> 8, bj = (n0 >> 7) & 1, c = n0 & 127; transpose_item(p.w_up, 2 * DFF, D, ws_h(p, WS_WT_UP), n0, bj * DFF + 128 * pn + c, kb * 64, scr, lane); continue; } r -= TI_UP;
        { const int nb = r % (D / 32), kb = r / (D / 32), n0 = nb * 32; transpose_item(p.w_down, D, DFF, ws_h(p, WS_WT_DN), n0, n0, kb * 64, scr, lane); }
    }
}
__device__ __forceinline__ void phase_mod(const P& p, LAS unsigned char* lds) {
    constexpr int KC = 128, NCG = 6 * D / 32, RPT = (NCB + 15) / 16;
    LAS float* sc = (LAS float*)lds;
    const int tid = otid(), col = tid & 31, rg = tid >> 5;
    for (int cg = blockIdx.x; cg < NCG; cg += gridDim.x) {
        const int e = cg * 32 + col;
        float acc[RPT];
#pragma unroll
        for (int i = 0; i < RPT; ++i) acc[i] = 0.f;
        for (int k0 = 0; k0 < D; k0 += KC) {
            __syncthreads();
            for (int i = tid; i < NCB * KC; i += NTHR) { const int r = i / KC, k = i % KC; const float* c = r < BATCH ? p.c_prompt + (size_t)r * D : p.c_sample + (size_t)(r - BATCH) * D; sc[i] = silu_f(c[k0 + k]); }
            __syncthreads();
            for (int k = 0; k < KC; k += 4) {
                float w[4];
#pragma unroll
                for (int j = 0; j < 4; ++j) w[j] = p.w_ada[(size_t)(k0 + k + j) * 6 * D + e];
#pragma unroll
                for (int i = 0; i < RPT; ++i) { const int r = rg + 16 * i; if (r < NCB) { const f32x4 s = *(const LAS f32x4*)(sc + r * KC + k); acc[i] += s[0] * w[0] + s[1] * w[1] + s[2] * w[2] + s[3] * w[3]; } }
            }
        }
#pragma unroll
        for (int i = 0; i < RPT; ++i) { const int r = rg + 16 * i; if (r < NCB) ws_f(p, WS_MOD)[(size_t)r * 6 * D + e] = acc[i] + p.b_ada[e]; }
    }
    __syncthreads();
}
template <int WHICH> __device__ __forceinline__ void phase_norm(const P& p) {
    static_assert(D == 1024, "one wave per 1024-float row");
    const int tid_ = otid(), lane = tid_ & 63, wave = tid_ >> 6;
    const int gw = blockIdx.x * NWAVES + wave, NGW = gridDim.x * NWAVES;
    for (int m = gw; m < T; m += NGW) {
        const float* xr = WHICH == 0 ? xrow(p, m) : p.out + O_Y + (size_t)m * D;
        f32x4 v[4]; float ss = 0.f;
#pragma unroll
        for (int j = 0; j < 4; ++j) { v[j] = ((const f32x4*)xr)[lane + 64 * j]; ss += (v[j][0] * v[j][0] + v[j][1] * v[j][1]) + (v[j][2] * v[j][2] + v[j][3] * v[j][3]); }
        const float rstd = 1.0f / sqrtf(wave_sum(ss) * (1.0f / D) + EPS);
        if (WHICH == 2) {
#pragma unroll
            for (int j = 0; j < 4; ++j) { const f32x4 w = ((const f32x4*)p.final_norm_w)[lane + 64 * j]; ((f32x4*)(p.out + O_Y + (size_t)m * D))[lane + 64 * j] = v[j] * rstd * w; }
            continue;
        }
        const int cb = cb_of(m);
        const float* mod = ws_f(p, WS_MOD) + (size_t)cb * 6 * D;
        const float* nw = WHICH == 0 ? p.norm_mix_w : p.norm_ffn_w; const float* sh = mod + (WHICH == 0 ? 0 : 3 * D); const float* sc = mod + (WHICH == 0 ? D : 4 * D);
        float ba[8];
#pragma unroll
        for (int j = 0; j < 8; ++j) ba[j] = 0.f;
        unsigned long long* o8 = (unsigned long long*)(ws_h(p, WS_H) + (size_t)m * D);
#pragma unroll
        for (int j = 0; j < 4; ++j) {
            const f32x4 w = ((const f32x4*)nw)[lane + 64 * j], s1 = ((const f32x4*)sc)[lane + 64 * j], s0 = ((const f32x4*)sh)[lane + 64 * j];
            f32x4 h = v[j] * rstd * w * (s1 + 1.0f) + s0;
            o8[lane + 64 * j] = (unsigned long long)pk2(h[0], h[1]) | ((unsigned long long)pk2(h[2], h[3]) << 32);
            if (WHICH == 0) {
#pragma unroll
                for (int e = 0; e < 4; ++e) { const int k = 4 * (lane + 64 * j) + e; const float* wr = p.w_in + (size_t)k * IN_COLS + WC_BA; const f32x4 wa = *(const f32x4*)wr, wb = *(const f32x4*)(wr + 4);
                    ba[0] += h[e] * wa[0]; ba[1] += h[e] * wa[1]; ba[2] += h[e] * wa[2]; ba[3] += h[e] * wa[3]; ba[4] += h[e] * wb[0]; ba[5] += h[e] * wb[1]; ba[6] += h[e] * wb[2]; ba[7] += h[e] * wb[3]; }
            }
        }
        if (WHICH == 0) {
#pragma unroll
            for (int j = 0; j < 8; ++j) ba[j] = wave_sum(ba[j]);
            float mine = 0.f;
#pragma unroll
            for (int j = 0; j < 8; ++j) mine = (lane == j) ? ba[j] : mine;
            if (lane < 8) { float* bg = ws_f(p, WS_BG) + (size_t)m * 8; const int j = lane & 3;
                bg[lane] = lane < 4 ? sigmoid_f(mine) : -expf(p.dn_A_log[j]) * softplus_f(mine + p.dn_dt_bias[j]); }
        }
    }
}
namespace pg8 {
#define PG8_LAS __attribute__((address_space(3)))
typedef unsigned short bf16_t;
typedef short bf16x8 __attribute__((ext_vector_type(8)));
typedef float f32x4 __attribute__((ext_vector_type(4)));
typedef unsigned u32x4 __attribute__((ext_vector_type(4)));
constexpr int BM = 256, BK = 64, HALF = 128, HTB = HALF * BK * 2  , STAGE_BYTES = 8 * HTB, NXCD = 8, WGM = 8;

__host__ __device__ __forceinline__ int lds_byte(int r, int c) { const int st = (r >> 4) * 2 + (c >> 5), rr = r & 15, cc = c & 31, ob = rr * 64 + cc * 2; return st * 1024 + (ob ^ (((ob >> 9) & 1) << 5)); }
__host__ __device__ __forceinline__ void stage_rc(int b, int& R, int& C) { const int st = b / 1024, sb = b % 1024, swz = sb ^ (((sb >> 9) & 1) << 5); R = (st >> 1) * 16 + swz / 64; C = (st & 1) * 32 + (swz % 64) / 2; }
__host__ __device__ __forceinline__ int perm32(int rho) { const int n = rho >> 4, i = rho & 15; return 8 * (i >> 2) + 4 * n + (i & 3); }

struct Unit { int pm, pn; };
struct Gemm { const bf16_t* A; const bf16_t* Bt; int M, N, K; };

struct StaticOrder {
    int nM, nN, nwg, G, c;
    __host__ __device__ void init(int M, int N, int G_, int c_) { nM = M / BM; nN = N / BM; nwg = nM * nN; G = G_; c = c_; }
    __host__ __device__ bool next(int i, Unit& u) const {
        const long L = (long)i * G + c; if (L >= nwg) return false;
        int wgid = (int)L; { const int q = nwg / NXCD, r = nwg % NXCD, xcd = wgid % NXCD, off = wgid / NXCD; wgid = (xcd < r ? xcd * (q + 1) : r * (q + 1) + (xcd - r) * q) + off; }
        const int nig = WGM * nN, gid = wgid / nig, fm = gid * WGM, gsz = (nM - fm) < WGM ? (nM - fm) : WGM;
        u.pm = fm + ((wgid % nig) % gsz); u.pn = (wgid % nig) / gsz; return true;
    }
    __device__ __forceinline__ void a_ready(const Unit&) const {}
    __device__ __forceinline__ void done(const Unit&) const {}
};

__device__ __forceinline__ unsigned cvt_pk_bf16(float lo, float hi) { unsigned r; asm volatile("v_cvt_pk_bf16_f32 %0, %1, %2" : "=v"(r) : "v"(lo), "v"(hi)); return r; }
struct EpiStoreBf16 {
    static constexpr bool PERM = true, AFTER_DRAIN = false;
    bf16_t* O; int ldc;
    __device__ __forceinline__ void operator()(const f32x4 (&acc)[2][2][4][2], const Unit& u, int wr, int wc, int fr, int fq) const {
        const int row0 = u.pm * BM + wr * 64 + fr, col0 = u.pn * BM + wc * 32 + 8 * fq;
#pragma unroll
        for (int ai = 0; ai < 2; ++ai)
#pragma unroll
            for (int m = 0; m < 4; ++m) { bf16_t* rowp = O + (size_t)(row0 + ai * HALF + m * 16) * ldc + col0;
#pragma unroll
                for (int bj = 0; bj < 2; ++bj) { const f32x4 v0 = acc[ai][bj][m][0], v1 = acc[ai][bj][m][1];
                    u32x4 w; w.x = cvt_pk_bf16(v0[0], v0[1]); w.y = cvt_pk_bf16(v0[2], v0[3]); w.z = cvt_pk_bf16(v1[0], v1[1]); w.w = cvt_pk_bf16(v1[2], v1[3]);
                    *(u32x4*)(rowp + bj * HALF) = w; } }
    }
};
struct EpiGateRes {
    static constexpr bool PERM = false, AFTER_DRAIN = false;
    const float* base_p; const float* base_s; float* out; const float* gate;
    __device__ __forceinline__ void operator()(const f32x4 (&acc)[2][2][4][2], const Unit& u, int wr, int wc, int fr, int fq) const {
        const int row0 = u.pm * BM + wr * 64 + fr, col0 = u.pn * BM + wc * 32 + 4 * fq;
        const bool smp = row0 >= TP; const float* base = smp ? base_s - (size_t)TP * D : base_p;
#pragma unroll
        for (int ai = 0; ai < 2; ++ai)
#pragma unroll
            for (int m = 0; m < 4; ++m) { const int r = row0 + ai * HALF + m * 16; const int cb = smp ? BATCH + ((r - TP) >> 3) : r / SEQ;
                const float* gp = gate + (size_t)cb * 6 * D + col0; const size_t off = (size_t)r * D + col0;
#pragma unroll
                for (int bj = 0; bj < 2; ++bj)
#pragma unroll
                    for (int n = 0; n < 2; ++n) { const f32x4 gv = *(const f32x4*)(gp + bj * HALF + n * 16), bs = *(const f32x4*)(base + off + bj * HALF + n * 16);
                        *(f32x4*)(out + off + bj * HALF + n * 16) = bs + gv * acc[ai][bj][m][n]; } }
    }
};
template <class Epi, class Sched, bool ALIGN_EPI = false, bool SP2 = false>
__device__ __forceinline__ void gemm_phase(PG8_LAS unsigned char* lds, const Gemm g, const Sched& S, const Epi& E) {
    const int tid = otid(), wid = __builtin_amdgcn_readfirstlane(tid >> 6), lane = tid & 63, wr = wid >> 2, wc = wid & 3, fr = lane & 15, fq = lane >> 4;
    const int K = g.K, nt = K / BK;
    unsigned voffA[2], voffB[2];
#pragma unroll
    for (int i = 0; i < 2; ++i) { int R, C; stage_rc(tid * 16 + i * 8192, R, C); const int Rb = Epi::PERM ? ((R & ~31) + perm32(R & 31)) : R;
        voffA[i] = (unsigned)(R * K + C) * 2u; voffB[i] = (unsigned)(Rb * K + C) * 2u; }
    const size_t kstep = (size_t)(BK * 2);
    const size_t hstep = (size_t)HALF * K * 2;
    const size_t tstep = 2 * hstep;
    const unsigned ldsw = (unsigned)wid * 1024u;
    const int aoff = lds_byte(wr * 64 + fr, fq * 8), boff = lds_byte(wc * 32 + fr, fq * 8);
#define PG8_SA(b, h) (((b) * 2 + (h)) * HTB)
#define PG8_SB(b, h) ((4 + (b) * 2 + (h)) * HTB)
#define PG8_STAGE(bufoff, gbase, voff) do { _Pragma("unroll") for (int _i = 0; _i < 2; ++_i) \
        __builtin_amdgcn_global_load_lds((const unsigned*)((const char*)(gbase) + (voff)[_i]), (PG8_LAS unsigned*)(lds + (bufoff) + ldsw + _i * 8192), 16, 0, 0); } while (0)
#define PG8_LDA(dst, b, h) do { _Pragma("unroll") for (int m = 0; m < 4; ++m) _Pragma("unroll") for (int k = 0; k < 2; ++k) dst[m][k] = *(const PG8_LAS bf16x8*)(lds + PG8_SA(b, h) + aoff + m * 2048 + k * 1024); } while (0)
#define PG8_LDB(dst, b, h) do { _Pragma("unroll") for (int n = 0; n < 2; ++n) _Pragma("unroll") for (int k = 0; k < 2; ++k) dst[n][k] = *(const PG8_LAS bf16x8*)(lds + PG8_SB(b, h) + boff + n * 2048 + k * 1024); } while (0)
#define PG8_MMA(ai, bj, At, Bt) do { __builtin_amdgcn_s_setprio(1); _Pragma("unroll") for (int m = 0; m < 4; ++m) _Pragma("unroll") for (int n = 0; n < 2; ++n) _Pragma("unroll") for (int k = 0; k < 2; ++k) \
        acc[ai][bj][m][n] = __builtin_amdgcn_mfma_f32_16x16x32_bf16(Bt[n][k], At[m][k], acc[ai][bj][m][n], 0, 0, 0); __builtin_amdgcn_s_setprio(0); } while (0)
#define PG8_WAIT_V(n) asm volatile("s_waitcnt vmcnt(" #n ")" ::: "memory")
#define PG8_WAIT_L(n) asm volatile("s_waitcnt lgkmcnt(" #n ")" ::: "memory")
#define PG8_BAR __builtin_amdgcn_s_barrier()
#define PG8_SCHED __builtin_amdgcn_sched_barrier(0)
    Unit cur, nxt; int ui = 0;
    if (!S.next(0, cur)) return;
    f32x4 acc[2][2][4][2];
#pragma unroll
    for (int a = 0; a < 2; ++a)
#pragma unroll
        for (int b = 0; b < 2; ++b)
#pragma unroll
            for (int m = 0; m < 4; ++m)
#pragma unroll
                for (int n = 0; n < 2; ++n) acc[a][b][m][n] = (f32x4){0.f, 0.f, 0.f, 0.f};
    bf16x8 At[4][2], B0[2][2], B1[2][2];
    const char* cA = (const char*)g.A + (size_t)cur.pm * tstep; const char* cB = (const char*)g.Bt + (size_t)cur.pn * tstep;
    S.a_ready(cur);
    if constexpr (SP2) {
        PG8_STAGE(PG8_SB(0, 0), cB, voffB); PG8_STAGE(PG8_SB(0, 1), cB + hstep, voffB); PG8_STAGE(PG8_SA(0, 0), cA, voffA); PG8_STAGE(PG8_SA(0, 1), cA + hstep, voffA);
        if (wr == 1) PG8_BAR;
        PG8_WAIT_V(2); PG8_BAR;
        PG8_STAGE(PG8_SB(1, 0), cB + kstep, voffB); PG8_STAGE(PG8_SA(1, 0), cA + kstep, voffA); PG8_STAGE(PG8_SB(1, 1), cB + hstep + kstep, voffB);
        PG8_WAIT_V(6); PG8_BAR;
    } else {
        PG8_STAGE(PG8_SB(0, 0), cB, voffB); PG8_STAGE(PG8_SA(0, 0), cA, voffA); PG8_STAGE(PG8_SB(0, 1), cB + hstep, voffB); PG8_STAGE(PG8_SA(0, 1), cA + hstep, voffA);
        if (wr == 1) PG8_BAR;
        PG8_WAIT_V(4); PG8_BAR;
        PG8_STAGE(PG8_SB(1, 0), cB + kstep, voffB); PG8_STAGE(PG8_SA(1, 0), cA + kstep, voffA); PG8_STAGE(PG8_SB(1, 1), cB + hstep + kstep, voffB);
        PG8_WAIT_V(6); PG8_BAR;
    }
    for (;;) {
        const bool has_next = S.next(ui + 1, nxt);
        const char* nA = has_next ? (const char*)g.A + (size_t)nxt.pm * tstep : cA; const char* nB = has_next ? (const char*)g.Bt + (size_t)nxt.pn * tstep : cB;
        for (int t = 0; t < nt; t += 2) {
            const bool last = (t == nt - 2);
            const char* a1 = cA + (size_t)(t + 1) * kstep;
            const char* a2 = last ? nA : cA + (size_t)(t + 2) * kstep; const char* b2 = last ? nB : cB + (size_t)(t + 2) * kstep;
            const char* a3 = a2 + kstep; const char* b3 = b2 + kstep;
            if (last && has_next) S.a_ready(nxt);
            if constexpr (SP2) {
            PG8_LDB(B0, 0, 0); PG8_LDB(B1, 0, 1); PG8_SCHED; PG8_LDA(At, 0, 0); PG8_STAGE(PG8_SA(1, 1), a1 + hstep, voffA);
            PG8_WAIT_V(8); PG8_WAIT_L(0); PG8_BAR; PG8_MMA(0, 0, At, B0); PG8_MMA(0, 1, At, B1); PG8_BAR; PG8_SCHED;
            PG8_LDA(At, 0, 1); PG8_STAGE(PG8_SB(0, 0), b2, voffB); PG8_STAGE(PG8_SB(0, 1), b2 + hstep, voffB); PG8_STAGE(PG8_SA(0, 0), a2, voffA);
            PG8_WAIT_V(8); PG8_WAIT_L(0); PG8_BAR; PG8_MMA(1, 0, At, B0); PG8_MMA(1, 1, At, B1); PG8_BAR; PG8_SCHED;
            PG8_LDB(B0, 1, 0); PG8_LDB(B1, 1, 1); PG8_SCHED; PG8_LDA(At, 1, 0); PG8_STAGE(PG8_SA(0, 1), a2 + hstep, voffA);
            PG8_WAIT_V(8); PG8_WAIT_L(0); PG8_BAR; PG8_MMA(0, 0, At, B0); PG8_MMA(0, 1, At, B1); PG8_BAR; PG8_SCHED;
            PG8_LDA(At, 1, 1); PG8_STAGE(PG8_SB(1, 0), b3, voffB); PG8_STAGE(PG8_SB(1, 1), b3 + hstep, voffB); PG8_STAGE(PG8_SA(1, 0), a3, voffA);
            PG8_WAIT_V(8); PG8_WAIT_L(0); PG8_BAR; PG8_MMA(1, 0, At, B0); PG8_MMA(1, 1, At, B1); PG8_BAR; PG8_SCHED;
            } else {
            PG8_LDB(B0, 0, 0); PG8_SCHED; PG8_LDA(At, 0, 0); PG8_STAGE(PG8_SA(1, 1), a1 + hstep, voffA);
            PG8_WAIT_L(8); PG8_BAR; PG8_WAIT_L(0); PG8_MMA(0, 0, At, B0); PG8_BAR; PG8_SCHED;
            PG8_LDB(B1, 0, 1); PG8_STAGE(PG8_SB(0, 0), b2, voffB);
            PG8_BAR; PG8_WAIT_L(0); PG8_MMA(0, 1, At, B1); PG8_BAR;
            PG8_LDA(At, 0, 1); PG8_STAGE(PG8_SA(0, 0), a2, voffA);
            PG8_BAR; PG8_WAIT_L(0); PG8_MMA(1, 0, At, B0); PG8_BAR; PG8_SCHED;
            PG8_STAGE(PG8_SB(0, 1), b2 + hstep, voffB);
            PG8_WAIT_V(6); PG8_BAR; PG8_MMA(1, 1, At, B1); PG8_BAR;
            PG8_LDB(B0, 1, 0); PG8_SCHED; PG8_LDA(At, 1, 0); PG8_STAGE(PG8_SA(0, 1), a2 + hstep, voffA);
            PG8_WAIT_L(8); PG8_BAR; PG8_WAIT_L(0); PG8_MMA(0, 0, At, B0); PG8_BAR; PG8_SCHED;
            PG8_LDB(B1, 1, 1); PG8_STAGE(PG8_SB(1, 0), b3, voffB);
            PG8_BAR; PG8_WAIT_L(0); PG8_MMA(0, 1, At, B1); PG8_BAR;
            PG8_LDA(At, 1, 1); PG8_STAGE(PG8_SA(1, 0), a3, voffA);
            PG8_BAR; PG8_WAIT_L(0); PG8_MMA(1, 0, At, B0); PG8_BAR; PG8_SCHED;
            PG8_STAGE(PG8_SB(1, 1), b3 + hstep, voffB);
            PG8_WAIT_V(6); PG8_BAR; PG8_MMA(1, 1, At, B1); PG8_BAR;
            }
        }
        if constexpr (ALIGN_EPI) { if (wr == 0) PG8_BAR; }
        if constexpr (!Epi::AFTER_DRAIN) { E(acc, cur, wr, wc, fr, fq); S.done(cur); }
        if (!has_next) break;
#pragma unroll
        for (int a = 0; a < 2; ++a)
#pragma unroll
            for (int b = 0; b < 2; ++b)
#pragma unroll
                for (int m = 0; m < 4; ++m)
#pragma unroll
                    for (int n = 0; n < 2; ++n) acc[a][b][m][n] = (f32x4){0.f, 0.f, 0.f, 0.f};
        cur = nxt; cA = nA; cB = nB; ++ui;
        if constexpr (ALIGN_EPI) { if (wr == 1) PG8_BAR; }
    }
    PG8_WAIT_V(0);
    if constexpr (!ALIGN_EPI) { if (wr == 0) PG8_BAR; }
    PG8_BAR;
    if constexpr (Epi::AFTER_DRAIN) { E.fused(acc, cur, wr, wc, fr, fq, lds, wid, lane); S.done(cur); }
#undef PG8_SA
#undef PG8_SB
#undef PG8_STAGE
#undef PG8_LDA
#undef PG8_LDB
#undef PG8_MMA
#undef PG8_WAIT_V
#undef PG8_WAIT_L
#undef PG8_BAR
#undef PG8_SCHED
}
}
typedef short bf16x8 __attribute__((ext_vector_type(8)));
constexpr int FR_NWK = 0, FR_QD = 16, FR_KTT = 32, FR_QK = 48, FR_N = 56;
__device__ __forceinline__ int kperm(int g, int j) { return j < 4 ? 4 * g + j : 16 + 4 * g + (j - 4); }

constexpr int DP_KP = 136;
constexpr int DP_QS = 0, DP_KS = DP_QS + 64 * DP_KP * 2, DP_RHS = DP_KS + 64 * DP_KP * 2, DP_AM = DP_RHS + 64 * 256 * 4, DP_AMP = 68,
              DP_QKM = DP_AM + 64 * DP_AMP * 4, DP_QKP = 72, DP_GS = DP_QKM + 64 * DP_QKP * 2, DP_END = DP_GS + 4 * 64 * 4, DP_NWK = DP_RHS;
static_assert(DP_END <= 131072, "dnprep LDS");

__device__ __forceinline__ void phase_dnprep(const P& p, LAS unsigned char* lds) {
    const int tid = otid(), lane_ = tid & 63, wave = tid >> 6;
    LAS bf16_t* QS = (LAS bf16_t*)(lds + DP_QS); LAS bf16_t* KS = (LAS bf16_t*)(lds + DP_KS); LAS float* RHS = (LAS float*)(lds + DP_RHS);
    LAS float* AM = (LAS float*)(lds + DP_AM); LAS bf16_t* QKM = (LAS bf16_t*)(lds + DP_QKM); LAS float* GS = (LAS float*)(lds + DP_GS);
    LAS bf16_t* NWKS = (LAS bf16_t*)(lds + DP_NWK);
    const bf16_t* PR = ws_h(p, WS_PROJ); const float* BG = ws_f(p, WS_BG);
    for (int uid = blockIdx.x; uid < NUNIT; uid += gridDim.x) {
        const int n = uid % NCHUNK, bh = uid / NCHUNK, h = bh & 3, b = bh >> 2, m0 = b * SEQ + n * 64;
        int lane = lane_; asm volatile("" : "+v"(lane));
        const int r16 = lane & 15, g4 = lane >> 4;
        if (wave == 0) {
            float x = BG[(size_t)(m0 + lane) * 8 + 4 + h];
#pragma unroll
            for (int o = 1; o < 64; o <<= 1) { const float t = __shfl_up(x, o); if (lane >= o) x += t; }
            const float gl = __shfl(x, 63);
            GS[lane] = x; GS[64 + lane] = BG[(size_t)(m0 + lane) * 8 + h]; GS[128 + lane] = expf(x); GS[192 + lane] = expf(gl - x);
            if (lane == 0) ws_f(p, WS_DNF_CD)[uid] = expf(gl);
        }
        __syncthreads();
        {
            float cw[3][4][2];
#pragma unroll
            for (int part = 0; part < 3; ++part)
#pragma unroll
                for (int j = 0; j < 4; ++j) { const float* w = p.dn_conv_w + j * 1536 + part * 512 + h * 128 + 2 * lane; cw[part][j][0] = w[0]; cw[part][j][1] = w[1]; }
            float xs[3][11][2];
#pragma unroll
            for (int rr = 0; rr < 11; ++rr) { const int t = n * 64 + wave * 8 + rr - 3;
#pragma unroll
                for (int part = 0; part < 3; ++part) { unsigned v = 0u; if (t >= 0) v = *(const unsigned*)(PR + (size_t)(m0 + wave * 8 + rr - 3) * PLD + part * 512 + h * 128 + 2 * lane);
                    xs[part][rr][0] = __builtin_bit_cast(float, v << 16); xs[part][rr][1] = __builtin_bit_cast(float, v & 0xffff0000u); } }
#pragma unroll
            for (int i = 0; i < 8; ++i) { const int row = wave * 8 + i;
                float c[3][2];
#pragma unroll
                for (int part = 0; part < 3; ++part)
#pragma unroll
                    for (int e = 0; e < 2; ++e) { float a = 0.f;
#pragma unroll
                        for (int j = 0; j < 4; ++j) a += cw[part][j][e] * xs[part][i + j][e];
                        c[part][e] = silu_f(a); }
                const float sq = wave_sum(c[0][0] * c[0][0] + c[0][1] * c[0][1]), sk = wave_sum(c[1][0] * c[1][0] + c[1][1] * c[1][1]);
                const float rq = 0.08838834764831845f / sqrtf(sq + EPS), rk = 1.0f / sqrtf(sk + EPS);
                const float beta = GS[64 + row], eg = GS[128 + row];
                const float q0 = c[0][0] * rq, q1 = c[0][1] * rq, k0 = c[1][0] * rk, k1 = c[1][1] * rk;
                *(LAS unsigned*)(QS + row * DP_KP + 2 * lane) = pk2(q0, q1);
                *(LAS unsigned*)(KS + row * DP_KP + 2 * lane) = pk2(k0, k1);
                RHS[row * 256 + 2 * lane] = beta * c[2][0]; RHS[row * 256 + 2 * lane + 1] = beta * c[2][1];
                RHS[row * 256 + 128 + 2 * lane] = beta * eg * k0; RHS[row * 256 + 128 + 2 * lane + 1] = beta * eg * k1; }
        }
        __syncthreads();
        {
            const int ti = wave >> 1;
            f32x4 akk[2], aqk[2];
#pragma unroll
            for (int c = 0; c < 2; ++c) { akk[c] = (f32x4){0.f, 0.f, 0.f, 0.f}; aqk[c] = (f32x4){0.f, 0.f, 0.f, 0.f}; }
#pragma unroll
            for (int kb = 0; kb < 4; ++kb) {
                const bf16x8 ak = *(const LAS bf16x8*)(KS + (16 * ti + r16) * DP_KP + 32 * kb + 8 * g4), aq = *(const LAS bf16x8*)(QS + (16 * ti + r16) * DP_KP + 32 * kb + 8 * g4);
#pragma unroll
                for (int c = 0; c < 2; ++c) { const int tj = 2 * (wave & 1) + c; const bf16x8 bk = *(const LAS bf16x8*)(KS + (16 * tj + r16) * DP_KP + 32 * kb + 8 * g4);
                    akk[c] = __builtin_amdgcn_mfma_f32_16x16x32_bf16(ak, bk, akk[c], 0, 0, 0); aqk[c] = __builtin_amdgcn_mfma_f32_16x16x32_bf16(aq, bk, aqk[c], 0, 0, 0); }
            }
#pragma unroll
            for (int c = 0; c < 2; ++c) { const int tj = 2 * (wave & 1) + c, J = 16 * tj + r16; const float gj = GS[J];
#pragma unroll
                for (int i = 0; i < 4; ++i) { const int I = 16 * ti + 4 * g4 + i; const float dec = I >= J ? expf(GS[I] - gj) : 0.f;
                    AM[I * DP_AMP + J] = I > J ? GS[64 + I] * akk[c][i] * dec : 0.f; QKM[I * DP_QKP + J] = f2bf(aqk[c][i] * dec); } }
        }
        __syncthreads();
        unsigned char* abu = p.ws + WS_DNF_AB + (size_t)uid * DNF_AB_UNIT;
        float x[64];
        if (wave < 4) {
#pragma unroll
            for (int i = 0; i < 64; ++i) x[i] = RHS[i * 256 + tid];
        }
        __syncthreads();
        if (wave < 4) {
#pragma unroll
            for (int i = 1; i < 64; ++i) { float acc = x[i];
#pragma unroll
                for (int j4 = 0; j4 < (i + 3) / 4; ++j4) { const f32x4 a = *(const LAS f32x4*)(AM + i * DP_AMP + 4 * j4);
#pragma unroll
                    for (int e = 0; e < 4; ++e) if (4 * j4 + e < i) acc -= a[e] * x[4 * j4 + e]; }
                x[i] = acc; asm volatile("" ::: "memory"); }
            if (tid < 128) {
                float* wv = (float*)(p.ws + WS_DNF_WV + (size_t)uid * DNF_WV_UNIT) + (size_t)(tid >> 4) * 4 * 256 + (tid & 15) * 4;
#pragma unroll
                for (int mt = 0; mt < 4; ++mt)
#pragma unroll
                    for (int g = 0; g < 4; ++g) *(f32x4*)(wv + mt * 256 + g * 64) = (f32x4){x[16 * mt + 4 * g], x[16 * mt + 4 * g + 1], x[16 * mt + 4 * g + 2], x[16 * mt + 4 * g + 3]};
            } else {
#pragma unroll
                for (int i = 0; i < 64; ++i) NWKS[i * DP_KP + (tid - 128)] = f2bf(-x[i]);
            }
        } else {
            for (int f = FR_QD + (wave - 4); f < FR_N; f += 4) {
                u32x4 o;
                if (f < FR_KTT) { const int mt = (f - FR_QD) >> 2, kb = (f - FR_QD) & 3, row = 16 * mt + r16; const float sc = GS[128 + row];
                    const u32x2 lo = *(const LAS u32x2*)(QS + row * DP_KP + 32 * kb + 4 * g4), hi = *(const LAS u32x2*)(QS + row * DP_KP + 32 * kb + 16 + 4 * g4);
                    const unsigned w[4] = {lo.x, lo.y, hi.x, hi.y}; unsigned r[4];
#pragma unroll
                    for (int e = 0; e < 4; ++e) r[e] = pk2(__builtin_bit_cast(float, w[e] << 16) * sc, __builtin_bit_cast(float, w[e] & 0xffff0000u) * sc);
                    o = (u32x4){r[0], r[1], r[2], r[3]};
                } else if (f < FR_QK) { const int kt = (f - FR_KTT) >> 1, tb = (f - FR_KTT) & 1; float v[8];
#pragma unroll
                    for (int j = 0; j < 8; ++j) { const int tok = 32 * tb + kperm(g4, j); v[j] = bf2f(KS[tok * DP_KP + 16 * kt + r16]) * GS[192 + tok]; }
                    o = (u32x4){pk2(v[0], v[1]), pk2(v[2], v[3]), pk2(v[4], v[5]), pk2(v[6], v[7])};
                } else { const int mt = (f - FR_QK) >> 1, tb = (f - FR_QK) & 1, row = 16 * mt + r16;
                    const u32x2 lo = *(const LAS u32x2*)(QKM + row * DP_QKP + 32 * tb + 4 * g4), hi = *(const LAS u32x2*)(QKM + row * DP_QKP + 32 * tb + 16 + 4 * g4);
                    o = (u32x4){lo.x, lo.y, hi.x, hi.y}; }
                *(u32x4*)(abu + (size_t)f * 1024 + lane * 16) = o;
            }
        }
        __syncthreads();
        for (int f = FR_NWK + wave; f < FR_QD; f += 8) { const int mt = f >> 2, kb = f & 3, row = 16 * mt + r16;
            const u32x2 lo = *(const LAS u32x2*)(NWKS + row * DP_KP + 32 * kb + 4 * g4), hi = *(const LAS u32x2*)(NWKS + row * DP_KP + 32 * kb + 16 + 4 * g4);
            *(u32x4*)(abu + (size_t)f * 1024 + lane * 16) = (u32x4){lo.x, lo.y, hi.x, hi.y}; }
        __syncthreads();
    }
}

constexpr size_t O_ODN = O_Y;
typedef float f32x2_t __attribute__((ext_vector_type(2))); typedef __bf16 bf16x2_t __attribute__((ext_vector_type(2)));
__device__ __forceinline__ unsigned cvtpk_c(float lo, float hi) { const f32x2_t v = {lo, hi}; const bf16x2_t b = __builtin_convertvector(v, bf16x2_t); return __builtin_bit_cast(unsigned, b); }
__device__ __forceinline__ bf16x8 pack8(const f32x4 a, const f32x4 b) {
    return __builtin_bit_cast(bf16x8, (u32x4){cvtpk_c(a[0], a[1]), cvtpk_c(a[2], a[3]), cvtpk_c(b[0], b[1]), cvtpk_c(b[2], b[3])});
}
__device__ __forceinline__ void phase_dnscan(const P& p, LAS unsigned char* lds) {
    if (blockIdx.x >= BATCH * 4 * 2) return;
    const int tid = otid(), lane = tid & 63, wave = tid >> 6, r16 = lane & 15, g4 = lane >> 4;
    const int bh = blockIdx.x >> 1, vh = blockIdx.x & 1, h = bh & 3, b = bh >> 2, vs = vh * 4 + (wave & 3), v0 = vs * 16;
    const unsigned char* ab = p.ws + WS_DNF_AB + (size_t)bh * NCHUNK * DNF_AB_UNIT;
    const float* wvb = (const float*)(p.ws + WS_DNF_WV + (size_t)bh * NCHUNK * DNF_WV_UNIT) + (size_t)vs * 4 * 256 + lane * 4;
    const float* cdp = ws_f(p, WS_DNF_CD) + (size_t)bh * NCHUNK;
    float* odn = p.out + O_ODN;
#define DN_STAGE(n_, buf_) do { for (int f_ = wave; f_ < FR_N; f_ += 8) \
        __builtin_amdgcn_global_load_lds((const unsigned*)(ab + (size_t)(n_) * DNF_AB_UNIT + f_ * 1024 + lane * 16), (LAS unsigned*)(lds + (buf_) * DNF_AB_UNIT + f_ * 1024), 16, 0, 0); } while (0)
    f32x4 S[8], wv[4];
#pragma unroll
    for (int t = 0; t < 8; ++t) S[t] = (f32x4){0.f, 0.f, 0.f, 0.f};
    DN_STAGE(0, 0);
#pragma unroll
    for (int mt = 0; mt < 4; ++mt) wv[mt] = *(const f32x4*)(wvb + mt * 256);
    asm volatile("s_waitcnt vmcnt(0)" ::: "memory");
    __syncthreads();
    for (int n = 0; n < NCHUNK; ++n) {
        const int buf = n & 1;
        if (n + 1 < NCHUNK) DN_STAGE(n + 1, buf ^ 1);
        if (wave < 4) {
            const LAS unsigned char* fb = lds + buf * DNF_AB_UNIT + lane * 16;
            f32x4 u[4], o[4], wvn[4];
            if (n + 1 < NCHUNK) {
#pragma unroll
                for (int mt = 0; mt < 4; ++mt) wvn[mt] = *(const f32x4*)(wvb + (size_t)(n + 1) * (DNF_WV_UNIT / 4) + mt * 256);
            }
            const float cd = cdp[n];
            bf16x8 Sb[4];
#pragma unroll
            for (int kb = 0; kb < 4; ++kb) Sb[kb] = pack8(S[2 * kb], S[2 * kb + 1]);
#pragma unroll
            for (int mt = 0; mt < 4; ++mt) { u[mt] = wv[mt]; o[mt] = (f32x4){0.f, 0.f, 0.f, 0.f};
#pragma unroll
                for (int kb = 0; kb < 4; ++kb) {
                    u[mt] = __builtin_amdgcn_mfma_f32_16x16x32_bf16(*(const LAS bf16x8*)(fb + (FR_NWK + mt * 4 + kb) * 1024), Sb[kb], u[mt], 0, 0, 0);
                    o[mt] = __builtin_amdgcn_mfma_f32_16x16x32_bf16(*(const LAS bf16x8*)(fb + (FR_QD + mt * 4 + kb) * 1024), Sb[kb], o[mt], 0, 0, 0); } }
            bf16x8 Ub[2];
#pragma unroll
            for (int tb = 0; tb < 2; ++tb) Ub[tb] = pack8(u[2 * tb], u[2 * tb + 1]);
#pragma unroll
            for (int kt = 0; kt < 8; ++kt) { S[kt] = S[kt] * cd;
#pragma unroll
                for (int tb = 0; tb < 2; ++tb) S[kt] = __builtin_amdgcn_mfma_f32_16x16x32_bf16(*(const LAS bf16x8*)(fb + (FR_KTT + kt * 2 + tb) * 1024), Ub[tb], S[kt], 0, 0, 0); }
#pragma unroll
            for (int mt = 0; mt < 4; ++mt) {
#pragma unroll
                for (int tb = 0; tb < 2; ++tb) o[mt] = __builtin_amdgcn_mfma_f32_16x16x32_bf16(*(const LAS bf16x8*)(fb + (FR_QK + mt * 2 + tb) * 1024), Ub[tb], o[mt], 0, 0, 0);
                float* op = odn + (size_t)(b * SEQ + n * 64 + 16 * mt + 4 * g4) * 512 + h * 128 + v0 + r16;
#pragma unroll
                for (int i = 0; i < 4; ++i) op[(size_t)i * 512] = o[mt][i]; }
            if (n + 1 < NCHUNK) {
#pragma unroll
                for (int mt = 0; mt < 4; ++mt) wv[mt] = wvn[mt];
            }
        }
        asm volatile("s_waitcnt vmcnt(0)" ::: "memory");
        __syncthreads();
    }
    if (wave < 4) {
        float* so = p.out + O_PSSM + (size_t)bh * 128 * 128 + v0 + r16;
#pragma unroll
        for (int kt = 0; kt < 8; ++kt)
#pragma unroll
            for (int i = 0; i < 4; ++i) so[(size_t)(16 * kt + 4 * g4 + i) * 128] = S[kt][i];
    }
}
__device__ __forceinline__ void phase_dngate(const P& p) {
    const int tid_ = otid(), lane = tid_ & 63, wave = tid_ >> 6;
    const int gw = blockIdx.x * NWAVES + wave, NGW = gridDim.x * NWAVES;
    const f32x4 nw0 = *(const f32x4*)(p.dn_norm_w + (lane & 15) * 8), nw1 = *(const f32x4*)(p.dn_norm_w + (lane & 15) * 8 + 4);
    for (int m = gw; m < TP; m += NGW) {
        const float* o = p.out + O_ODN + (size_t)m * 512 + lane * 8;
        const f32x4 a = *(const f32x4*)o, c = *(const f32x4*)(o + 4);
        float ss = (a[0] * a[0] + a[1] * a[1]) + (a[2] * a[2] + a[3] * a[3]) + (c[0] * c[0] + c[1] * c[1]) + (c[2] * c[2] + c[3] * c[3]);
#pragma unroll
        for (int off = 1; off < 16; off <<= 1) ss += __shfl_xor(ss, off);
        const float rstd = 1.0f / sqrtf(ss * (1.0f / 128.0f) + EPS);
        const u32x4 z = *(const u32x4*)(ws_h(p, WS_PROJ) + (size_t)m * PLD + PC_Z + lane * 8);
        const unsigned zw[4] = {z.x, z.y, z.z, z.w}; const float ov[8] = {a[0], a[1], a[2], a[3], c[0], c[1], c[2], c[3]}; const float nwv[8] = {nw0[0], nw0[1], nw0[2], nw0[3], nw1[0], nw1[1], nw1[2], nw1[3]};
        unsigned r[4];
#pragma unroll
        for (int e = 0; e < 4; ++e) { const float z0 = __builtin_bit_cast(float, zw[e] << 16), z1 = __builtin_bit_cast(float, zw[e] & 0xffff0000u);
            r[e] = pk2(ov[2 * e] * rstd * nwv[2 * e] * silu_f(z0), ov[2 * e + 1] * rstd * nwv[2 * e + 1] * silu_f(z1)); }
        *(u32x4*)(ws_h(p, WS_MIX) + (size_t)m * 1024 + lane * 8) = (u32x4){r[0], r[1], r[2], r[3]};
    }
}
__device__ __forceinline__ void phase_dnsample(const P& p, LAS unsigned char* lds) {
    const int tid = otid(), lane = tid & 63, us = tid >> 8, w4 = (tid >> 6) & 3, kh = lane >> 5, col_ = w4 * 32 + (lane & 31);
    LAS float* QH = (LAS float*)lds + us * 4352;
    LAS float* KH = QH + 1024; LAS float* VH = QH + 2048; LAS float* OH = QH + 3072; LAS float* RED = QH + 4096;
    const bf16_t* PR = ws_h(p, WS_PROJ); const float* BG = ws_f(p, WS_BG);
    for (int ub = blockIdx.x; ub < DEC_BATCH * 2; ub += gridDim.x) {
        const int uidx = ub * 2 + us, b = uidx >> 2, h = uidx & 3, m0 = TP + b * DEC_SEQ;
        int col = col_; asm volatile("" : "+v"(col));
        {
            float x0[11], x1[11];
            const int ch0 = kh * 512 + h * 128 + col;
#pragma unroll
            for (int rr = 0; rr < 11; ++rr) {
                if (rr < 3) { const float* st = p.state_dn_conv + ((size_t)b * 3 + rr) * 1536; x0[rr] = st[ch0]; x1[rr] = st[1024 + h * 128 + col]; }
                else { const bf16_t* pr = PR + (size_t)(m0 + rr - 3) * PLD; x0[rr] = bf2f(pr[ch0]); x1[rr] = bf2f(pr[1024 + h * 128 + col]); } }
            float w0[4], w1[4];
#pragma unroll
            for (int j = 0; j < 4; ++j) { w0[j] = p.dn_conv_w[j * 1536 + ch0]; w1[j] = p.dn_conv_w[j * 1536 + 1024 + h * 128 + col]; }
#pragma unroll
            for (int t = 0; t < 8; ++t) { float a = 0.f, d = 0.f;
#pragma unroll
                for (int j = 0; j < 4; ++j) { a += w0[j] * x0[t + j]; d += w1[j] * x1[t + j]; }
                a = silu_f(a); d = silu_f(d);
                if (kh == 0) { QH[t * 128 + col] = a; VH[t * 128 + col] = d; } else KH[t * 128 + col] = a;
                const float sq = wave_sum(kh == 0 ? a * a : 0.f), sk = wave_sum(kh == 1 ? a * a : 0.f);
                if (lane == 0) { RED[w4 * 16 + t] = sq; RED[w4 * 16 + 8 + t] = sk; } }
        }
        __syncthreads();
#pragma unroll
        for (int t = 0; t < 8; ++t) {
            if (kh == 0) { const float sq = (RED[t] + RED[16 + t]) + (RED[32 + t] + RED[48 + t]); QH[t * 128 + col] *= 0.08838834764831845f / sqrtf(sq + EPS); }
            else { const float sk = (RED[8 + t] + RED[24 + t]) + (RED[40 + t] + RED[56 + t]); KH[t * 128 + col] *= 1.0f / sqrtf(sk + EPS); } }
        __syncthreads();
        float S[64];
        const float* S0 = p.state_dn_ssm + ((size_t)b * 4 + h) * 128 * 128 + (size_t)kh * 64 * 128 + col;
#pragma unroll
        for (int k = 0; k < 64; ++k) { S[k] = *S0; S0 += 128; if ((k & 7) == 7) asm volatile("" : "+v"(S0)); }
#pragma unroll 1
        for (int t = 0; t < 8; ++t) {
            const float beta = BG[(size_t)(m0 + t) * 8 + h], eg = expf(BG[(size_t)(m0 + t) * 8 + 4 + h]);
            const LAS float* kp = KH + t * 128 + kh * 64; const LAS float* qp = QH + t * 128 + kh * 64;
            float kS = 0.f;
#pragma unroll
            for (int k4 = 0; k4 < 16; ++k4) { const f32x4 kk = *(const LAS f32x4*)(kp + 4 * k4);
#pragma unroll
                for (int e = 0; e < 4; ++e) { S[4 * k4 + e] *= eg; kS += kk[e] * S[4 * k4 + e]; } }
            kS += __shfl_xor(kS, 32);
            const float u = beta * (VH[t * 128 + col] - kS);
            float o = 0.f;
#pragma unroll
            for (int k4 = 0; k4 < 16; ++k4) { const f32x4 kk = *(const LAS f32x4*)(kp + 4 * k4), qq = *(const LAS f32x4*)(qp + 4 * k4);
#pragma unroll
                for (int e = 0; e < 4; ++e) { S[4 * k4 + e] += kk[e] * u; o += qq[e] * S[4 * k4 + e]; } }
            o += __shfl_xor(o, 32);
            if (kh == 0) OH[t * 128 + col] = o;
        }
        float* So = p.out + O_SSSM + ((size_t)b * 4 + h) * 128 * 128 + (size_t)kh * 64 * 128 + col;
#pragma unroll
        for (int k = 0; k < 64; ++k) { *So = S[k]; So += 128; if ((k & 7) == 7) asm volatile("" : "+v"(So)); }
        __syncthreads();
#pragma unroll
        for (int t = 0; t < 8; ++t) { const float o = kh == 0 ? OH[t * 128 + col] : 0.f; const float s = wave_sum(o * o); if (lane == 0) RED[w4 * 16 + t] = s; }
        __syncthreads();
        if (kh == 0) {
            const float nw = p.dn_norm_w[col];
#pragma unroll
            for (int t = 0; t < 8; ++t) { const float rstd = 1.0f / sqrtf(((RED[t] + RED[16 + t]) + (RED[32 + t] + RED[48 + t])) * (1.0f / 128.0f) + EPS);
                const float z = bf2f(PR[(size_t)(m0 + t) * PLD + PC_Z + h * 128 + col]);
                ws_h(p, WS_MIX)[(size_t)(m0 + t) * 1024 + h * 128 + col] = f2bf(OH[t * 128 + col] * rstd * nw * silu_f(z)); }
        }
        __syncthreads();
    }
}
constexpr size_t WS_EDGE = WS_FREE;
constexpr size_t WS_HEAD = al256(WS_EDGE + (size_t)(T / 256) * 2 * 2 * DFF * 4);
constexpr size_t WS_END = al256(WS_HEAD + (size_t)(T / 256) * 2 * 2 * DFF * 4);
constexpr int EX_OFF = 131072;
namespace pg8 {
typedef unsigned u32x2v __attribute__((ext_vector_type(2)));
__device__ __forceinline__ float dpp_shr1(float old, float src) { return __builtin_bit_cast(float, __builtin_amdgcn_update_dpp(__builtin_bit_cast(int, old), __builtin_bit_cast(int, src), 0x111, 0xf, 0xf, false)); }
__device__ __forceinline__ float dpp_shr2(float old, float src) { return __builtin_bit_cast(float, __builtin_amdgcn_update_dpp(__builtin_bit_cast(int, old), __builtin_bit_cast(int, src), 0x112, 0xf, 0xf, false)); }
__device__ __forceinline__ float dpp_ror1(float src) { return __builtin_bit_cast(float, __builtin_amdgcn_update_dpp(0, __builtin_bit_cast(int, src), 0x121, 0xf, 0xf, false)); }
__device__ __forceinline__ float dpp_ror2(float src) { return __builtin_bit_cast(float, __builtin_amdgcn_update_dpp(0, __builtin_bit_cast(int, src), 0x122, 0xf, 0xf, false)); }
struct EpiFfnUp {
    static constexpr bool PERM = false, AFTER_DRAIN = false;
    bf16_t* ACT; float* edge; float* head; const float* cw; const float* cb; const float* state; float* out_pfc; float* out_sfc; PG8_LAS unsigned char* lds;
    __device__ __forceinline__ void operator()(const f32x4 (&acc)[2][2][4][2], const Unit& u, int wr, int wc, int fr, int fq) const {
        PG8_LAS float* EX = (PG8_LAS float*)(lds + EX_OFF);
        const bool smp = u.pm >= TP / BM;
        const int cl = wc * 32 + 4 * fq;
        if (fr >= 14) {
#pragma unroll
            for (int ai = 0; ai < 2; ++ai)
#pragma unroll
                for (int bj = 0; bj < 2; ++bj)
#pragma unroll
                    for (int n = 0; n < 2; ++n) *(PG8_LAS f32x4*)(EX + ((2 * ai + wr) * 2 + (fr - 14)) * 256 + bj * HALF + cl + 16 * n) = acc[ai][bj][3][n];
            if (wr == 1) {
#pragma unroll
                for (int bj = 0; bj < 2; ++bj)
#pragma unroll
                    for (int n = 0; n < 2; ++n) { const int oc = bj * DFF + u.pn * HALF + cl + 16 * n;
                        *(f32x4*)(edge + ((size_t)u.pm * 2 + (fr - 14)) * 2 * DFF + oc) = acc[1][bj][3][n];
                        if (!smp && (u.pm & (SEQ / BM - 1)) == SEQ / BM - 1) *(f32x4*)(out_pfc + ((size_t)(u.pm / (SEQ / BM)) * 2 + (fr - 14)) * 2 * DFF + oc) = acc[1][bj][3][n]; }
            }
        }
        if (fr < 2 && wr == 0) {
#pragma unroll
            for (int bj = 0; bj < 2; ++bj)
#pragma unroll
                for (int n = 0; n < 2; ++n) *(f32x4*)(head + ((size_t)u.pm * 2 + fr) * 2 * DFF + bj * DFF + u.pn * HALF + cl + 16 * n) = acc[0][bj][0][n];
        }
        asm volatile("s_waitcnt lgkmcnt(0)" ::: "memory"); __builtin_amdgcn_s_barrier(); asm volatile("" ::: "memory");
#pragma unroll
        for (int n = 0; n < 2; ++n) {
            const int f0 = u.pn * HALF + cl + 16 * n;
            f32x4 wg[3], wu[3], bg, bu;
#pragma unroll
            for (int j = 0; j < 3; ++j) { wg[j] = *(const f32x4*)(cw + (size_t)j * 2 * DFF + f0); wu[j] = *(const f32x4*)(cw + (size_t)j * 2 * DFF + DFF + f0); }
            bg = *(const f32x4*)(cb + f0); bu = *(const f32x4*)(cb + DFF + f0);
#pragma unroll
            for (int ai = 0; ai < 2; ++ai) {
                const int s = 2 * ai + wr;
                f32x4 pg = (f32x4){0.f, 0.f, 0.f, 0.f}, pu = pg;
                if (!smp && s > 0 && fr >= 14) { pg = *(const PG8_LAS f32x4*)(EX + ((s - 1) * 2 + (fr - 14)) * 256 + cl + 16 * n); pu = *(const PG8_LAS f32x4*)(EX + ((s - 1) * 2 + (fr - 14)) * 256 + HALF + cl + 16 * n); }
#pragma unroll
                for (int m = 0; m < 4; ++m) {
                    const f32x4 cg = acc[ai][0][m][n], cu = acc[ai][1][m][n];
                    const int row = u.pm * BM + ai * HALF + wr * 64 + m * 16 + fr;
                    f32x4 g1, g2, u1, u2;
#pragma unroll
                    for (int e = 0; e < 4; ++e) { g1[e] = dpp_shr1(dpp_ror1(pg[e]), cg[e]); g2[e] = dpp_shr2(dpp_ror2(pg[e]), cg[e]); u1[e] = dpp_shr1(dpp_ror1(pu[e]), cu[e]); u2[e] = dpp_shr2(dpp_ror2(pu[e]), cu[e]); }
                    if (smp) {
                        const int t = fr & 7, b = (row - TP) >> 3;
                        if (t < 2) { const float* st = state + (size_t)b * 2 * 2 * DFF + f0; const f32x4 s1g = *(const f32x4*)(st + 2 * DFF), s1u = *(const f32x4*)(st + 2 * DFF + DFF);
                            if (t == 0) { g1 = s1g; u1 = s1u; g2 = *(const f32x4*)st; u2 = *(const f32x4*)(st + DFF); } else { g2 = s1g; u2 = s1u; } }
                        if (t >= 6) { float* o = out_sfc + ((size_t)b * 2 + (t - 6)) * 2 * DFF + f0; *(f32x4*)o = cg; *(f32x4*)(o + DFF) = cu; }
                    }
                    const f32x4 gc = wg[0] * g2 + wg[1] * g1 + wg[2] * cg + bg, uc = wu[0] * u2 + wu[1] * u1 + wu[2] * cu + bu;
                    u32x2v w;
                    { const float a0 = gc[0] / (1.0f + __expf(-gc[0])) * uc[0], a1 = gc[1] / (1.0f + __expf(-gc[1])) * uc[1], a2 = gc[2] / (1.0f + __expf(-gc[2])) * uc[2], a3 = gc[3] / (1.0f + __expf(-gc[3])) * uc[3];
                      w.x = cvt_pk_bf16(a0, a1); w.y = cvt_pk_bf16(a2, a3); }
                    *(u32x2v*)(ACT + (size_t)row * DFF + f0) = w;
                    pg = cg; pu = cu;
                }
            }
        }
    }
};
}
__device__ __forceinline__ void phase_ffn_fix(const P& p) {
    constexpr int TPS = SEQ / 256;
    const long n = (long)(BATCH * TPS) * DFF;
    const float* edge = ws_f(p, WS_EDGE); const float* head = ws_f(p, WS_HEAD);
    for (long i = blockIdx.x * (long)NTHR + otid(); i < n; i += (long)gridDim.x * NTHR) {
        const int pm = (int)(i / DFF), f = (int)(i % DFF);
        if (pm % TPS == 0) continue;
        float r0[2], r1[2];
#pragma unroll
        for (int gu = 0; gu < 2; ++gu) { const int c = gu * DFF + f;
            const float um2 = edge[((size_t)(pm - 1) * 2 + 0) * 2 * DFF + c], um1 = edge[((size_t)(pm - 1) * 2 + 1) * 2 * DFF + c], u0 = head[((size_t)pm * 2 + 0) * 2 * DFF + c], u1 = head[((size_t)pm * 2 + 1) * 2 * DFF + c];
            const float w0 = p.ffn_conv_w[c], w1 = p.ffn_conv_w[2 * DFF + c], w2 = p.ffn_conv_w[4 * DFF + c], bb = p.ffn_conv_b[c];
            r0[gu] = w0 * um2 + w1 * um1 + w2 * u0 + bb; r1[gu] = w0 * um1 + w1 * u0 + w2 * u1 + bb; }
        bf16_t* ACT = ws_h(p, WS_ACT) + (size_t)pm * 256 * DFF + f;
        ACT[0] = f2bf(silu_f(r0[0]) * r0[1]); ACT[DFF] = f2bf(silu_f(r1[0]) * r1[1]);
    }
}
constexpr int SW_KP = 72;
__device__ __forceinline__ void swa_qtile(const LAS bf16_t* KS, const LAS bf16_t* VT, int vtp, int qt, const bf16_t* qptr, int qrow_mask, const LAS float* BT, float sink, bool first, bf16_t* optr, int nvalid_q, int lane) {
    const int r16 = lane & 15, g4 = lane >> 4, kt0 = qt;
    bf16x8 bq[2];
#pragma unroll
    for (int ks = 0; ks < 2; ++ks) bq[ks] = *(const bf16x8*)(qptr + (size_t)(r16 & qrow_mask) * PLD + 32 * ks + 8 * g4);
    f32x4 s[10];
#pragma unroll
    for (int t = 0; t < 9; ++t) { f32x4 a = (f32x4){0.f, 0.f, 0.f, 0.f};
#pragma unroll
        for (int ks = 0; ks < 2; ++ks) a = __builtin_amdgcn_mfma_f32_16x16x32_bf16(*(const LAS bf16x8*)(KS + (16 * (kt0 + t) + r16) * SW_KP + 32 * ks + 8 * g4), bq[ks], a, 0, 0, 0);
        s[t] = a; }
    float mx = sink;
#pragma unroll
    for (int t = 0; t < 9; ++t)
#pragma unroll
        for (int e = 0; e < 4; ++e) { const int jj = 16 * (kt0 + t) + 4 * g4 + e, d = 128 + 16 * qt + r16 - jj; const bool ok = d >= 0 && d <= 127 && !(first && jj < 128);
            const float v = ok ? s[t][e] * 0.125f + BT[ok ? d : 0] : -1e30f; s[t][e] = v; mx = fmaxf(mx, v); }
    mx = fmaxf(mx, __shfl_xor(mx, 16)); mx = fmaxf(mx, __shfl_xor(mx, 32));
    float l = 0.f;
#pragma unroll
    for (int t = 0; t < 9; ++t)
#pragma unroll
        for (int e = 0; e < 4; ++e) { const float pv = __expf(s[t][e] - mx); s[t][e] = pv; l += pv; }
    s[9] = (f32x4){0.f, 0.f, 0.f, 0.f};
    l += __shfl_xor(l, 16); l += __shfl_xor(l, 32);
    l += __expf(sink - mx);
    const float rl = 1.0f / l;
    bf16x8 pb[5];
#pragma unroll
    for (int q = 0; q < 5; ++q) pb[q] = pack8(s[2 * q], s[2 * q + 1]);
#pragma unroll
    for (int dt = 0; dt < 4; ++dt) { f32x4 o = (f32x4){0.f, 0.f, 0.f, 0.f};
#pragma unroll
        for (int q = 0; q < 5; ++q) { const LAS bf16_t* vp = VT + (16 * dt + r16) * vtp + 16 * (kt0 + 2 * q) + 4 * g4;
            const u32x2 lo = *(const LAS u32x2*)vp, hi = *(const LAS u32x2*)(vp + 16);
            o = __builtin_amdgcn_mfma_f32_16x16x32_bf16(__builtin_bit_cast(bf16x8, (u32x4){lo.x, lo.y, hi.x, hi.y}), pb[q], o, 0, 0, 0); }
        if (r16 < nvalid_q) *(u32x2*)(optr + (size_t)r16 * 1024 + 16 * dt + 4 * g4) = (u32x2){cvtpk_c(o[0] * rl, o[1] * rl), cvtpk_c(o[2] * rl, o[3] * rl)}; }
}
constexpr int SWP_VTP = 272, SWS_NK = 144, SWS_VTP = 168;
constexpr int SW_KS = 0, SW_VT = 43008, SW_BT = 86016, SW_END = SW_BT + 8 * 128 * 4;
static_assert(256 * SW_KP * 2 <= SW_VT && SW_VT + 64 * SWP_VTP * 2 <= SW_BT && 2 * SWS_NK * SW_KP * 2 <= SW_VT && SW_VT + 2 * 64 * SWS_VTP * 2 <= SW_BT, "swa LDS map");
__device__ __forceinline__ void phase_swa(const P& p, LAS unsigned char* lds) {
    const int tid = otid(), lane = tid & 63, wave = tid >> 6;
    LAS bf16_t* KS = (LAS bf16_t*)(lds + SW_KS); LAS bf16_t* VT = (LAS bf16_t*)(lds + SW_VT); LAS float* BT = (LAS float*)(lds + SW_BT);
    const bf16_t* PR = ws_h(p, WS_PROJ); bf16_t* MX = ws_h(p, WS_MIX);
    constexpr int NQB = SEQ / 128, NPU = BATCH * NQB * 2, NU = NPU + DEC_BATCH;
    for (int i = tid; i < 8 * 128; i += NTHR) BT[i] = p.rel_bias[t5_bucket(i & 127) * 8 + (i >> 7)];
    for (int u = blockIdx.x; u < NU; u += gridDim.x) {
        __syncthreads();
        if (u < NPU) {
            const int kvh = u & 1, qb = (u >> 1) % NQB, b = (u >> 1) / NQB, m0 = b * SEQ + qb * 128; const bool first = qb == 0;
            for (int it = tid; it < 256 * 8; it += NTHR) { const int jj = it >> 3, c = it & 7; u32x4 v = (u32x4){0u, 0u, 0u, 0u};
                if (!(first && jj < 128)) v = *(const u32x4*)(PR + (size_t)(m0 - 128 + jj) * PLD + PC_SK + kvh * 64 + 8 * c);
                *(LAS u32x4*)(KS + jj * SW_KP + 8 * c) = v; }
            for (int it = tid; it < 272 * 8; it += NTHR) { const int jj = it % 272, c = it / 272; u32x4 v = (u32x4){0u, 0u, 0u, 0u};
                if (jj < 256 && !(first && jj < 128)) v = *(const u32x4*)(PR + (size_t)(m0 - 128 + jj) * PLD + PC_SV + kvh * 64 + 8 * c);
                const unsigned w[4] = {v.x, v.y, v.z, v.w};
#pragma unroll
                for (int e = 0; e < 4; ++e) { VT[(8 * c + 2 * e) * SWP_VTP + jj] = (bf16_t)(w[e] & 0xffffu); VT[(8 * c + 2 * e + 1) * SWP_VTP + jj] = (bf16_t)(w[e] >> 16); } }
            __syncthreads();
            const int hq = kvh * 4 + (wave >> 1), qh = wave & 1;
#pragma unroll 1
            for (int q4 = 0; q4 < 4; ++q4) { const int qt = 4 * qh + q4;
                swa_qtile(KS, VT, SWP_VTP, qt, PR + (size_t)(m0 + 16 * qt) * PLD + PC_SQ + hq * 64, 15, BT + hq * 128, p.swa_sinks[hq], first, MX + (size_t)(m0 + 16 * qt) * 1024 + 512 + hq * 64, 16, lane); }
        } else {
            const int b = u - NPU, m0 = TP + b * DEC_SEQ;
            for (int it = tid; it < 2 * SWS_NK * 8; it += NTHR) { const int kvh = it / (SWS_NK * 8), r = it % (SWS_NK * 8), jj = r >> 3, c = r & 7; u32x4 v = (u32x4){0u, 0u, 0u, 0u};
                if (jj < 128) { const float* src = p.cache_k + ((size_t)b * 128 + jj) * 128 + kvh * 64 + 8 * c; const f32x4 a = *(const f32x4*)src, d = *(const f32x4*)(src + 4);
                    v = (u32x4){pk2(a[0], a[1]), pk2(a[2], a[3]), pk2(d[0], d[1]), pk2(d[2], d[3])}; }
                else if (jj < 128 + DEC_SEQ) v = *(const u32x4*)(PR + (size_t)(m0 + jj - 128) * PLD + PC_SK + kvh * 64 + 8 * c);
                *(LAS u32x4*)(KS + (kvh * SWS_NK + jj) * SW_KP + 8 * c) = v; }
            for (int it = tid; it < 2 * SWS_VTP * 8; it += NTHR) { const int kvh = it / (SWS_VTP * 8), r = it % (SWS_VTP * 8), jj = r % SWS_VTP, c = r / SWS_VTP; float f[8];
#pragma unroll
                for (int e = 0; e < 8; ++e) f[e] = 0.f;
                if (jj < 128) { const float* src = p.cache_v + ((size_t)b * 128 + jj) * 128 + kvh * 64 + 8 * c; const f32x4 a = *(const f32x4*)src, d = *(const f32x4*)(src + 4);
                    f[0] = a[0]; f[1] = a[1]; f[2] = a[2]; f[3] = a[3]; f[4] = d[0]; f[5] = d[1]; f[6] = d[2]; f[7] = d[3]; }
                else if (jj < 128 + DEC_SEQ) { const bf16_t* src = PR + (size_t)(m0 + jj - 128) * PLD + PC_SV + kvh * 64 + 8 * c;
#pragma unroll
                    for (int e = 0; e < 8; ++e) f[e] = bf2f(src[e]); }
#pragma unroll
                for (int e = 0; e < 8; ++e) VT[(kvh * 64 + 8 * c + e) * SWS_VTP + jj] = f2bf(f[e]); }
            __syncthreads();
            const int kvh = wave >> 2, hq = kvh * 4 + (wave & 3);
            swa_qtile(KS + kvh * SWS_NK * SW_KP, VT + kvh * 64 * SWS_VTP, SWS_VTP, 0, PR + (size_t)m0 * PLD + PC_SQ + hq * 64, 7, BT + hq * 128, p.swa_sinks[hq], false, MX + (size_t)m0 * 1024 + 512 + hq * 64, 8, lane);
        }
    }
    __syncthreads();
}
static void fill_params(P& p, void* const* d_in, void* d_out, void* d_ws) {
    const float** pp = (const float**)&p;
    for (int i = 0; i < 26; ++i) pp[i] = (const float*)d_in[i];
    p.out = (float*)d_out; p.ws = (unsigned char*)d_ws;
}
namespace cg = cooperative_groups;
__global__ void __launch_bounds__(512, 2) fwd_megakernel(P p) {
    extern __shared__ __attribute__((aligned(16))) unsigned char lds_raw[];
    LAS unsigned char* lds = (LAS unsigned char*)lds_raw;
    cg::grid_group grid = cg::this_grid();
    phase_mod(p, lds); phase_transposes(p, lds);
    grid.sync();
    phase_norm<0>(p);
    grid.sync();
    { pg8::StaticOrder S; pg8::Gemm g{ws_h(p, WS_H), ws_h(p, WS_WT_IN), T, PLD, D}; S.init(T, PLD, gridDim.x, blockIdx.x); pg8::EpiStoreBf16 E{ws_h(p, WS_PROJ), PLD};
      pg8::gemm_phase<pg8::EpiStoreBf16, pg8::StaticOrder, true, true>(lds, g, S, E); }
    grid.sync();
    for (long i = blockIdx.x * (long)NTHR + otid(); i < N_R2B; i += (long)gridDim.x * NTHR) r2b_body(i, p);
    phase_dnprep(p, lds);
    phase_dnsample(p, lds);
    phase_swa(p, lds);
    grid.sync();
    phase_dnscan(p, lds);
    grid.sync();
    phase_dngate(p);
    grid.sync();
    { pg8::StaticOrder S; pg8::Gemm g{ws_h(p, WS_MIX), ws_h(p, WS_WT_OUT), T, D, 1024}; S.init(T, D, gridDim.x, blockIdx.x); pg8::EpiGateRes E{p.x_prompt, p.x_sample, p.out + O_Y, ws_f(p, WS_MOD) + 2 * D};
      pg8::gemm_phase<pg8::EpiGateRes, pg8::StaticOrder, true, true>(lds, g, S, E); }
    grid.sync();
    phase_norm<1>(p);
    grid.sync();
    { pg8::StaticOrder S; pg8::Gemm g{ws_h(p, WS_H), ws_h(p, WS_WT_UP), T, 2 * DFF, D}; S.init(T, 2 * DFF, gridDim.x, blockIdx.x);
      pg8::EpiFfnUp E{ws_h(p, WS_ACT), ws_f(p, WS_EDGE), ws_f(p, WS_HEAD), p.ffn_conv_w, p.ffn_conv_b, p.state_ffn, p.out + O_PFC, p.out + O_SFC, lds};
      pg8::gemm_phase<pg8::EpiFfnUp, pg8::StaticOrder, true, true>(lds, g, S, E); }
    grid.sync();
    phase_ffn_fix(p);
    grid.sync();
    { pg8::StaticOrder S; pg8::Gemm g{ws_h(p, WS_ACT), ws_h(p, WS_WT_DN), T, D, DFF}; S.init(T, D, gridDim.x, blockIdx.x); pg8::EpiGateRes E{p.out + O_Y, p.out + O_Y + (size_t)TP * D, p.out + O_Y, ws_f(p, WS_MOD) + 5 * D};
      pg8::gemm_phase<pg8::EpiGateRes, pg8::StaticOrder, true, true>(lds, g, S, E); }
    grid.sync();
    phase_norm<2>(p);
}
extern "C" void kernel_launch(void* const* d_in, const int* in_sizes, int n_in, void* d_out, int out_size, void* d_ws, size_t ws_size, hipStream_t stream) {
    static int grid_blocks = 0;
    if (grid_blocks == 0) {
        if (n_in != 26 || (long)out_size != O_END || ws_size < WS_END) { fprintf(stderr, "kernel_launch: unexpected shapes n_in=%d out=%d ws=%zu (need %zu)\n", n_in, out_size, ws_size, (size_t)WS_END); grid_blocks = -1; return; }
        int dev = 0, cus = 0, per_cu = 0;
        if (hipGetDevice(&dev) != hipSuccess || hipDeviceGetAttribute(&cus, hipDeviceAttributeMultiprocessorCount, dev) != hipSuccess) { grid_blocks = -1; return; }
        if (hipFuncSetAttribute((const void*)fwd_megakernel, hipFuncAttributeMaxDynamicSharedMemorySize, LDS_BYTES) != hipSuccess) { fprintf(stderr, "kernel_launch: hipFuncSetAttribute failed\n"); grid_blocks = -1; return; }
        if (hipOccupancyMaxActiveBlocksPerMultiprocessor(&per_cu, (const void*)fwd_megakernel, NTHR, LDS_BYTES) != hipSuccess || per_cu < 1) { fprintf(stderr, "kernel_launch: occupancy query says %d\n", per_cu); grid_blocks = -1; return; }
        grid_blocks = cus;
        fprintf(stderr, "kernel_launch: grid %d (cus %d, per_cu %d)\n", grid_blocks, cus, per_cu);
    }
    if (grid_blocks < 0) return;
    P p{}; fill_params(p, d_in, d_out, d_ws);
    void* args[] = {&p};
    const hipError_t e = hipLaunchCooperativeKernel((const void*)fwd_megakernel, dim3(grid_blocks), dim3(NTHR), args, LDS_BYTES, stream);
    if (e != hipSuccess) fprintf(stderr, "cooperative launch failed: %s (grid %d)\n", hipGetErrorString(e), grid_blocks);
}
```

```cpp
#define PROBE_MASK 0
#define PROBE_XSYNC 0
#include <hip/hip_runtime.h>
#include <hip/hip_cooperative_groups.h>
#include <cstdio>
#include <cstdint>
#define HD __device__ __forceinline__
#ifndef CFG_D_MODEL
#define CFG_D_MODEL 1024
#endif
#ifndef CFG_SEQ
#define CFG_SEQ 8192
#endif
#ifndef CFG_DEC_BATCH
#define CFG_DEC_BATCH 128
#endif
#ifndef CFG_D_FF
#define CFG_D_FF 2816
#endif

constexpr int D = CFG_D_MODEL, BATCH = 2, SEQ = CFG_SEQ, DEC_BATCH = CFG_DEC_BATCH, DEC_SEQ = 8, DFF = CFG_D_FF;
constexpr int TP = BATCH * SEQ, TS = DEC_BATCH * DEC_SEQ, T = TP + TS, NCB = BATCH + DEC_BATCH;
constexpr int IN_COLS = 2824, PLD = 2816;
constexpr int PC_QKV = 0, PC_Z = 1536, PC_SQ = 2048, PC_SK = 2560, PC_SV = 2688;
constexpr int WC_BA = 2048;
constexpr float EPS = 1e-6f;

constexpr long O_Y = 0;
constexpr long O_PDC = (long)T * D;
constexpr long O_SDC = O_PDC + (long)BATCH * 3 * 1536;
constexpr long O_PSSM = O_SDC + (long)DEC_BATCH * 3 * 1536;
constexpr long O_SSSM = O_PSSM + (long)BATCH * 4 * 128 * 128;
constexpr long O_PK = O_SSSM + (long)DEC_BATCH * 4 * 128 * 128;
constexpr long O_SK = O_PK + (long)BATCH * 128 * 128;
constexpr long O_PV = O_SK + (long)DEC_BATCH * 128 * 128;
constexpr long O_SV = O_PV + (long)BATCH * 128 * 128;
constexpr long O_PFC = O_SV + (long)DEC_BATCH * 128 * 128;
constexpr long O_SFC = O_PFC + (long)BATCH * 2 * 2 * DFF;
constexpr long O_END = O_SFC + (long)DEC_BATCH * 2 * 2 * DFF;

constexpr size_t al256(size_t x) { return (x + 255) & ~(size_t)255; }
constexpr size_t WS_CTL = 0;
constexpr size_t WS_MOD = 1u << 20;
constexpr size_t WS_BG = al256(WS_MOD + (size_t)NCB * 6 * D * 4);
constexpr size_t WS_WT_IN = al256(WS_BG + (size_t)T * 8 * 4);
constexpr size_t WS_WT_OUT = al256(WS_WT_IN + (size_t)PLD * D * 2);
constexpr size_t WS_WT_UP = al256(WS_WT_OUT + (size_t)D * 1024 * 2);
constexpr size_t WS_WT_DN = al256(WS_WT_UP + (size_t)2 * DFF * D * 2);
constexpr size_t WS_H = al256(WS_WT_DN + (size_t)D * DFF * 2);
constexpr int NCHUNK = SEQ / 64, NUNIT = BATCH * 4 * NCHUNK;
constexpr int DNF_AB_UNIT = 57344, DNF_WV_UNIT = 32768;
constexpr size_t WS_DNF_WV = WS_H;
constexpr size_t WS_DNF_AB = al256(WS_H + (size_t)T * (D > 1024 ? D : 1024) * 2);
constexpr size_t WS_DNF_CD = al256(WS_DNF_AB + (size_t)NUNIT * DNF_AB_UNIT);
constexpr size_t WS_QKVC = WS_DNF_AB;
constexpr size_t WS_PROJ = al256((WS_DNF_CD + (size_t)NUNIT * 4) > (WS_QKVC + (size_t)T * 1536 * 2) ? (WS_DNF_CD + (size_t)NUNIT * 4) : (WS_QKVC + (size_t)T * 1536 * 2));
constexpr size_t WS_MIX = al256(WS_PROJ + (size_t)T * PLD * 2);
constexpr size_t WS_FREE = al256(WS_MIX + (size_t)T * 1024 * 2);
constexpr size_t WS_ODN = WS_H, WS_ACT = WS_PROJ;
static_assert((size_t)NUNIT * DNF_WV_UNIT <= (size_t)T * 1024 * 2, "Wv tiles overlay H");

typedef unsigned short bf16_t;
HD unsigned f2bf_bits(float f) { unsigned u = __builtin_bit_cast(unsigned, f); return (u + 0x7fffu + ((u >> 16) & 1u)) >> 16; }
HD bf16_t f2bf(float f) { return (bf16_t)f2bf_bits(f); }
HD float bf2f(bf16_t b) { return __builtin_bit_cast(float, (unsigned)b << 16); }
HD float silu_f(float x) { return x / (1.0f + expf(-x)); }
HD float sigmoid_f(float x) { return 1.0f / (1.0f + expf(-x)); }
HD float softplus_f(float x) { return x > 20.f ? x : log1pf(expf(x)); }

struct P {
    const float *x_prompt, *x_sample, *state_dn_conv, *state_dn_ssm, *cache_k, *cache_v, *state_ffn, *c_prompt, *c_sample, *rel_bias,
        *final_norm_w, *w_ada, *b_ada, *norm_mix_w, *w_in, *dn_conv_w, *dn_A_log, *dn_dt_bias, *dn_norm_w, *swa_sinks, *w_out, *norm_ffn_w,
        *w_up, *ffn_conv_w, *ffn_conv_b, *w_down;
    float* out; unsigned char* ws;
};

HD const float* xrow(const P& p, int m) { return m < TP ? p.x_prompt + (size_t)m * D : p.x_sample + (size_t)(m - TP) * D; }
HD int cb_of(int m) { return m < TP ? m / SEQ : BATCH + (m - TP) / DEC_SEQ; }
HD int t_of(int m) { return m < TP ? m % SEQ : (m - TP) % DEC_SEQ; }
HD float* ws_f(const P& p, size_t off) { return (float*)(p.ws + off); }
HD bf16_t* ws_h(const P& p, size_t off) { return (bf16_t*)(p.ws + off); }

HD int t5_bucket(int d) {
    if (d < 16) return d;
    const float logv = logf((float)d / 16.0f) / 2.0794415416798357f;
    int b = 16 + (int)(logv * 16.0f);
    return b < 31 ? b : 31;
}

constexpr long N_R0A = (long)NCB * 6 * D;
HD void r0a_body(long idx, const P& p) {
    const int cb = (int)(idx / (6 * D)), e = (int)(idx % (6 * D));
    const float* c = cb < BATCH ? p.c_prompt + (size_t)cb * D : p.c_sample + (size_t)(cb - BATCH) * D;
    float acc = 0.f;
    for (int d = 0; d < D; ++d) acc += silu_f(c[d]) * p.w_ada[(size_t)d * 6 * D + e];
    ws_f(p, WS_MOD)[idx] = acc + p.b_ada[e];
}
constexpr long N_R1 = T;
template <int WHICH> HD void r1_body(long idx, const P& p) {
    const int m = (int)idx, cb = cb_of(m);
    const float* xr = WHICH == 0 ? xrow(p, m) : p.out + O_Y + (size_t)m * D;
    const float* nw = WHICH == 0 ? p.norm_mix_w : p.norm_ffn_w;
    const float* mod = ws_f(p, WS_MOD) + (size_t)cb * 6 * D;
    const float* sh = mod + (WHICH == 0 ? 0 : 3 * D); const float* sc = mod + (WHICH == 0 ? D : 4 * D);
    float ss = 0.f;
    for (int k = 0; k < D; ++k) ss += xr[k] * xr[k];
    const float rstd = 1.0f / sqrtf(ss / (float)D + EPS);
    float ba[8];
#pragma unroll
    for (int j = 0; j < 8; ++j) ba[j] = 0.f;
    bf16_t* H = ws_h(p, WS_H) + (size_t)m * D;
    for (int k = 0; k < D; ++k) {
        const float h = xr[k] * rstd * nw[k] * (1.0f + sc[k]) + sh[k];
        H[k] = f2bf(h);
        if (WHICH == 0) {
#pragma unroll
            for (int j = 0; j < 8; ++j) ba[j] += h * p.w_in[(size_t)k * IN_COLS + WC_BA + j];
        }
    }
    if (WHICH == 0) {
        float* bg = ws_f(p, WS_BG) + (size_t)m * 8;
#pragma unroll
        for (int j = 0; j < 4; ++j) {
            bg[j] = sigmoid_f(ba[j]);
            bg[4 + j] = -expf(p.dn_A_log[j]) * softplus_f(ba[4 + j] + p.dn_dt_bias[j]);
        }
    }
}
constexpr long N_R2 = (long)(T / 8) * PLD;
HD void r2_body(long idx, const P& p) {
    const int mg = (int)(idx / PLD), n = (int)(idx % PLD), oc = n < WC_BA ? n : n + 8;
    const bf16_t* H = ws_h(p, WS_H) + (size_t)mg * 8 * D;
    float acc[8];
#pragma unroll
    for (int i = 0; i < 8; ++i) acc[i] = 0.f;
    for (int k = 0; k < D; ++k) {
        const float w = bf2f(f2bf(p.w_in[(size_t)k * IN_COLS + oc]));
#pragma unroll
        for (int i = 0; i < 8; ++i) acc[i] += bf2f(H[(size_t)i * D + k]) * w;
    }
    bf16_t* PR = ws_h(p, WS_PROJ);
#pragma unroll
    for (int i = 0; i < 8; ++i) PR[(size_t)(mg * 8 + i) * PLD + n] = f2bf(acc[i]);
}
constexpr long N_R2B_1 = (long)BATCH * 3 * 1536, N_R2B_2 = (long)DEC_BATCH * 3 * 1536, N_R2B_3 = (long)BATCH * 128 * 128, N_R2B_4 = (long)DEC_BATCH * 128 * 128;
constexpr long N_R2B = N_R2B_1 + N_R2B_2 + 2 * (N_R2B_3 + N_R2B_4);
HD void r2b_body(long idx, const P& p) {
    const bf16_t* PR = ws_h(p, WS_PROJ);
    long r = idx;
    if (r < N_R2B_1) { const int b = (int)(r / (3 * 1536)), j = (int)(r / 1536 % 3), c = (int)(r % 1536);
        p.out[O_PDC + r] = bf2f(PR[(size_t)(b * SEQ + SEQ - 3 + j) * PLD + PC_QKV + c]); return; }
    r -= N_R2B_1;
    if (r < N_R2B_2) { const int b = (int)(r / (3 * 1536)), j = (int)(r / 1536 % 3), c = (int)(r % 1536);
        p.out[O_SDC + r] = bf2f(PR[(size_t)(TP + b * DEC_SEQ + DEC_SEQ - 3 + j) * PLD + PC_QKV + c]); return; }
    r -= N_R2B_2;
    for (int kv = 0; kv < 2; ++kv) {
        const int pc = kv == 0 ? PC_SK : PC_SV; const float* cache = kv == 0 ? p.cache_k : p.cache_v;
        if (r < N_R2B_3) { const int b = (int)(r / (128 * 128)), j = (int)(r / 128 % 128), c = (int)(r % 128);
            p.out[(kv == 0 ? O_PK : O_PV) + r] = bf2f(PR[(size_t)(b * SEQ + SEQ - 128 + j) * PLD + pc + c]); return; }
        r -= N_R2B_3;
        if (r < N_R2B_4) { const int b = (int)(r / (128 * 128)), j = (int)(r / 128 % 128), c = (int)(r % 128);
            float v;
            if (j < 128 - DEC_SEQ) v = cache[((size_t)b * 128 + j + DEC_SEQ) * 128 + c];
            else v = bf2f(PR[(size_t)(TP + b * DEC_SEQ + (j - (128 - DEC_SEQ))) * PLD + pc + c]);
            p.out[(kv == 0 ? O_SK : O_SV) + r] = v; return; }
        r -= N_R2B_4;
    }
}
constexpr long N_R3 = (long)T * 12;
HD float r3_conv(const P& p, int m, int t, int ch) {
    const bf16_t* PR = ws_h(p, WS_PROJ);
    float acc = 0.f;
#pragma unroll
    for (int j = 0; j < 4; ++j) {
        const int tt = t - 3 + j; float xv;
        if (tt >= 0) xv = bf2f(PR[(size_t)(m - (t - tt)) * PLD + PC_QKV + ch]);
        else xv = m < TP ? 0.f : p.state_dn_conv[((size_t)((m - TP) / DEC_SEQ) * 3 + (3 + tt)) * 1536 + ch];
        acc += p.dn_conv_w[j * 1536 + ch] * xv;
    }
    return silu_f(acc);
}
HD void r3_body(long idx, const P& p) {
    const int m = (int)(idx / 12), grp = (int)(idx % 12), part = grp / 4, cbase = grp * 128, t = t_of(m);
    float scale = 1.f;
    if (part < 2) {
        float ss = 0.f;
        for (int c = 0; c < 128; ++c) { const float v = r3_conv(p, m, t, cbase + c); ss += v * v; }
        scale = 1.0f / sqrtf(ss + EPS);
        if (part == 0) scale *= 0.08838834764831845f;
    }
    bf16_t* Q = ws_h(p, WS_QKVC) + (size_t)m * 1536 + cbase;
    for (int c = 0; c < 128; ++c) Q[c] = f2bf(r3_conv(p, m, t, cbase + c) * scale);
}
constexpr long N_R4 = (long)NCB * 4 * 128;
HD void r4_body(long idx, const P& p) {
    const int seq = (int)(idx / 512), h = (int)(idx / 128 % 4), v = (int)(idx % 128);
    const bool smp = seq >= BATCH; const int b = smp ? seq - BATCH : seq;
    float* S = p.out + (smp ? O_SSSM : O_PSSM) + ((size_t)b * 4 + h) * 128 * 128 + v;
    const float* S0 = smp ? p.state_dn_ssm + ((size_t)b * 4 + h) * 128 * 128 + v : nullptr;
    for (int k = 0; k < 128; ++k) S[(size_t)k * 128] = smp ? S0[(size_t)k * 128] : 0.f;
    const int L = smp ? DEC_SEQ : SEQ, m0 = smp ? TP + b * DEC_SEQ : b * SEQ;
    const bf16_t* QK = ws_h(p, WS_QKVC); const float* BG = ws_f(p, WS_BG); float* ODN = ws_f(p, WS_ODN);
    for (int t = 0; t < L; ++t) {
        const int m = m0 + t;
        const bf16_t* q = QK + (size_t)m * 1536 + h * 128; const bf16_t* kk = q + 512; const float vv = bf2f(q[1024 + v]);
        const float beta = BG[(size_t)m * 8 + h], eg = expf(BG[(size_t)m * 8 + 4 + h]);
        float kS = 0.f;
        for (int k = 0; k < 128; ++k) kS += bf2f(kk[k]) * (S[(size_t)k * 128] * eg);
        const float u = beta * (vv - kS);
        float o = 0.f;
        for (int k = 0; k < 128; ++k) { const float s = S[(size_t)k * 128] * eg + bf2f(kk[k]) * u; S[(size_t)k * 128] = s; o += bf2f(q[k]) * s; }
        ODN[(size_t)m * 512 + h * 128 + v] = o;
    }
}
constexpr long N_R5 = (long)T * 4;
HD void r5_body(long idx, const P& p) {
    const int m = (int)(idx / 4), h = (int)(idx % 4);
    const float* o = ws_f(p, WS_ODN) + (size_t)m * 512 + h * 128;
    float ss = 0.f;
    for (int v = 0; v < 128; ++v) ss += o[v] * o[v];
    const float rstd = 1.0f / sqrtf(ss / 128.0f + EPS);
    const bf16_t* z = ws_h(p, WS_PROJ) + (size_t)m * PLD + PC_Z + h * 128;
    bf16_t* mix = ws_h(p, WS_MIX) + (size_t)m * 1024 + h * 128;
    for (int v = 0; v < 128; ++v) mix[v] = f2bf(o[v] * rstd * p.dn_norm_w[v] * silu_f(bf2f(z[v])));
}
constexpr long N_R6 = (long)T * 8 * 8;
HD void r6_body(long idx, const P& p) {
    const int m = (int)(idx / 64), hq = (int)(idx / 8 % 8), dg = (int)(idx % 8), kvh = hq / 4, t = t_of(m);
    const bool smp = m >= TP; const int b = smp ? (m - TP) / DEC_SEQ : 0;
    const bf16_t* PR = ws_h(p, WS_PROJ);
    const bf16_t* q = PR + (size_t)m * PLD + PC_SQ + hq * 64;
    const float sink = p.swa_sinks[hq];
    const int nk = smp ? 128 : (t < 127 ? t + 1 : 128);
    float mx = sink;
    for (int pass = 0; pass < 2; ++pass) {
        float den = 0.f, acc[8];
#pragma unroll
        for (int i = 0; i < 8; ++i) acc[i] = 0.f;
        for (int jj = 0; jj < nk; ++jj) {
            int dist; const float* kf = nullptr; const float* vf = nullptr; const bf16_t* kb = nullptr; const bf16_t* vb = nullptr;
            if (smp) { const int j = t + 1 + jj; dist = 128 + t - j;
                if (j < 128) { kf = p.cache_k + ((size_t)b * 128 + j) * 128 + kvh * 64; vf = p.cache_v + ((size_t)b * 128 + j) * 128 + kvh * 64; }
                else { const size_t mm = (size_t)(TP + b * DEC_SEQ + (j - 128)); kb = PR + mm * PLD + PC_SK + kvh * 64; vb = PR + mm * PLD + PC_SV + kvh * 64; } }
            else { dist = nk - 1 - jj; const size_t mm = (size_t)(m - dist); kb = PR + mm * PLD + PC_SK + kvh * 64; vb = PR + mm * PLD + PC_SV + kvh * 64; }
            float s = 0.f;
            for (int d = 0; d < 64; ++d) s += bf2f(q[d]) * (kf ? kf[d] : bf2f(kb[d]));
            s = s * 0.125f + p.rel_bias[t5_bucket(dist) * 8 + hq];
            if (pass == 0) { mx = s > mx ? s : mx; }
            else { const float pr = expf(s - mx); den += pr;
#pragma unroll
                for (int i = 0; i < 8; ++i) acc[i] += pr * (vf ? vf[dg * 8 + i] : bf2f(vb[dg * 8 + i])); }
        }
        if (pass == 1) { den += expf(sink - mx); bf16_t* mix = ws_h(p, WS_MIX) + (size_t)m * 1024 + 512 + hq * 64 + dg * 8;
#pragma unroll
            for (int i = 0; i < 8; ++i) mix[i] = f2bf(acc[i] / den); }
    }
}
constexpr long N_R7 = (long)(T / 8) * D;
HD void r7_body(long idx, const P& p) {
    const int mg = (int)(idx / D), d = (int)(idx % D);
    const bf16_t* MX = ws_h(p, WS_MIX) + (size_t)mg * 8 * 1024;
    float acc[8];
#pragma unroll
    for (int i = 0; i < 8; ++i) acc[i] = 0.f;
    for (int e = 0; e < 1024; ++e) { const float w = bf2f(f2bf(p.w_out[(size_t)e * D + d]));
#pragma unroll
        for (int i = 0; i < 8; ++i) acc[i] += bf2f(MX[(size_t)i * 1024 + e]) * w; }
#pragma unroll
    for (int i = 0; i < 8; ++i) { const int m = mg * 8 + i; const float g1 = ws_f(p, WS_MOD)[(size_t)cb_of(m) * 6 * D + 2 * D + d];
        p.out[O_Y + (size_t)m * D + d] = xrow(p, m)[d] + g1 * acc[i]; }
}
constexpr long N_R9 = (long)(T / 8) * DFF;
HD void r9_body(long idx, const P& p) {
    const int mg = (int)(idx / DFF), f = (int)(idx % DFF), m0 = mg * 8, t0 = t_of(m0);
    const bool smp = m0 >= TP; const int b = smp ? (m0 - TP) / DEC_SEQ : m0 / SEQ;
    const bf16_t* H = ws_h(p, WS_H);
    float ug[10], uu[10];
#pragma unroll
    for (int i = 0; i < 10; ++i) { ug[i] = 0.f; uu[i] = 0.f; }
    const bool halo = (!smp && t0 > 0);
    for (int k = 0; k < D; ++k) {
        const float wg = bf2f(f2bf(p.w_up[(size_t)k * 2 * DFF + f])), wu = bf2f(f2bf(p.w_up[(size_t)k * 2 * DFF + DFF + f]));
#pragma unroll
        for (int i = 0; i < 10; ++i) { if (i < 2 && !halo) continue; const float h = bf2f(H[(size_t)(m0 - 2 + i) * D + k]); ug[i] += h * wg; uu[i] += h * wu; }
    }
    if (smp) {
#pragma unroll
        for (int i = 0; i < 2; ++i) { ug[i] = p.state_ffn[((size_t)b * 2 + i) * 2 * DFF + f]; uu[i] = p.state_ffn[((size_t)b * 2 + i) * 2 * DFF + DFF + f]; }
    }
    const float w0g = p.ffn_conv_w[f], w1g = p.ffn_conv_w[2 * DFF + f], w2g = p.ffn_conv_w[4 * DFF + f], bgt = p.ffn_conv_b[f];
    const float w0u = p.ffn_conv_w[DFF + f], w1u = p.ffn_conv_w[3 * DFF + f], w2u = p.ffn_conv_w[5 * DFF + f], bup = p.ffn_conv_b[DFF + f];
    bf16_t* ACT = ws_h(p, WS_ACT);
#pragma unroll
    for (int i = 0; i < 8; ++i) {
        const float gc = w0g * ug[i] + w1g * ug[i + 1] + w2g * ug[i + 2] + bgt, uc = w0u * uu[i] + w1u * uu[i + 1] + w2u * uu[i + 2] + bup;
        ACT[(size_t)(m0 + i) * DFF + f] = f2bf(silu_f(gc) * uc);
    }
    if (smp) {
#pragma unroll
        for (int j = 0; j < 2; ++j) { float* o = p.out + O_SFC + ((size_t)b * 2 + j) * 2 * DFF; o[f] = ug[8 + j]; o[DFF + f] = uu[8 + j]; }
    } else if (t0 == SEQ - 8) {
#pragma unroll
        for (int j = 0; j < 2; ++j) { float* o = p.out + O_PFC + ((size_t)b * 2 + j) * 2 * DFF; o[f] = ug[8 + j]; o[DFF + f] = uu[8 + j]; }
    }
}
constexpr long N_R10 = (long)(T / 8) * D;
HD void r10_body(long idx, const P& p) {
    const int mg = (int)(idx / D), d = (int)(idx % D);
    const bf16_t* A = ws_h(p, WS_ACT) + (size_t)mg * 8 * DFF;
    float acc[8];
#pragma unroll
    for (int i = 0; i < 8; ++i) acc[i] = 0.f;
    for (int f = 0; f < DFF; ++f) { const float w = bf2f(f2bf(p.w_down[(size_t)f * D + d]));
#pragma unroll
        for (int i = 0; i < 8; ++i) acc[i] += bf2f(A[(size_t)i * DFF + f]) * w; }
#pragma unroll
    for (int i = 0; i < 8; ++i) { const int m = mg * 8 + i; const float g2 = ws_f(p, WS_MOD)[(size_t)cb_of(m) * 6 * D + 5 * D + d];
        float* o = p.out + O_Y + (size_t)m * D + d; *o = *o + g2 * acc[i]; }
}
constexpr long N_R11 = T, N_R8 = T;
HD void r11_body(long idx, const P& p) {
    float* xr = p.out + O_Y + (size_t)idx * D;
    float ss = 0.f;
    for (int k = 0; k < D; ++k) ss += xr[k] * xr[k];
    const float rstd = 1.0f / sqrtf(ss / (float)D + EPS);
    for (int k = 0; k < D; ++k) xr[k] = xr[k] * rstd * p.final_norm_w[k];
}
#define LAS __attribute__((address_space(3)))
typedef float f32x4 __attribute__((ext_vector_type(4)));
typedef unsigned u32x4 __attribute__((ext_vector_type(4)));
typedef unsigned u32x2 __attribute__((ext_vector_type(2)));
constexpr int NWAVES = 8, NTHR = 512;
constexpr int LDS_BYTES = 147456;
__device__ __forceinline__ int otid() { int t = threadIdx.x; asm volatile("" : "+v"(t)); return t; }
__device__ __forceinline__ float wave_sum(float v) {
#pragma unroll
    for (int o = 1; o < 64; o <<= 1) v += __shfl_xor(v, o);
    return v;
}
__device__ __forceinline__ unsigned pk2(float lo, float hi) { return f2bf_bits(lo) | (f2bf_bits(hi) << 16); }

__device__ __forceinline__ void transpose_item(const float* W, int ldw, int K, bf16_t* WT, int dst_n0, int src_n0, int k0, LAS float* scr, int lane) {
#pragma unroll
    for (int i = 0; i < 32; ++i) { const int kk = 2 * i + (lane >> 5); scr[kk * 33 + (lane & 31)] = W[(size_t)(k0 + kk) * ldw + src_n0 + (lane & 31)]; }
    asm volatile("s_waitcnt lgkmcnt(0)" ::: "memory");
    const int c = lane & 7;
#pragma unroll
    for (int j = 0; j < 4; ++j) { const int n = (lane >> 3) + 8 * j; const LAS float* s = scr + (8 * c) * 33 + n;
        u32x4 o; o.x = pk2(s[0 * 33], s[1 * 33]); o.y = pk2(s[2 * 33], s[3 * 33]); o.z = pk2(s[4 * 33], s[5 * 33]); o.w = pk2(s[6 * 33], s[7 * 33]);
        *(u32x4*)(WT + (size_t)(dst_n0 + n) * K + k0 + 8 * c) = o; }
    asm volatile("s_waitcnt lgkmcnt(0)" ::: "memory");
}
constexpr int TI_IN = (PLD / 32) * (D / 64), TI_OUT = (D / 32) * (1024 / 64), TI_UP = (2 * DFF / 32) * (D / 64), TI_DN = (D / 32) * (DFF / 64), TI_ALL = TI_IN + TI_OUT + TI_UP + TI_DN;
__device__ __forceinline__ void phase_transposes(const P& p, LAS unsigned char* lds) {
    const int tid_ = otid(), lane = tid_ & 63, wave = tid_ >> 6;
    LAS float* scr = (LAS float*)(lds + wave * 16384);
    const int gw = blockIdx.x * NWAVES + wave, NGW = gridDim.x * NWAVES;
    for (int it = gw; it < TI_ALL; it += NGW) {
        int r = it;
        if (r < TI_IN) { const int nb = r % (PLD / 32), kb = r / (PLD / 32), n0 = nb * 32; transpose_item(p.w_in, IN_COLS, D, ws_h(p, WS_WT_IN), n0, n0 < WC_BA ? n0 : n0 + 8, kb * 64, scr, lane); continue; } r -= TI_IN;
        if (r < TI_OUT) { const int nb = r % (D / 32), kb = r / (D / 32), n0 = nb * 32; transpose_item(p.w_out, D, 1024, ws_h(p, WS_WT_OUT), n0, n0, kb * 64, scr, lane); continue; } r -= TI_OUT;
        if (r < TI_UP) { const int nb = r % (2 * DFF / 32), kb = r / (2 * DFF / 32), n0 = nb * 32;
            const int pn = n0 >> 8, bj = (n0 >> 7) & 1, c = n0 & 127; transpose_item(p.w_up, 2 * DFF, D, ws_h(p, WS_WT_UP), n0, bj * DFF + 128 * pn + c, kb * 64, scr, lane); continue; } r -= TI_UP;
        { const int nb = r % (D / 32), kb = r / (D / 32), n0 = nb * 32; transpose_item(p.w_down, D, DFF, ws_h(p, WS_WT_DN), n0, n0, kb * 64, scr, lane); }
    }
}
typedef short bf16x8m __attribute__((ext_vector_type(8)));
__device__ __forceinline__ void split8(const float (&x)[8], bf16x8m& hi, bf16x8m& lo) {
    unsigned h[4], l[4];
#pragma unroll
    for (int e = 0; e < 4; ++e) { const unsigned h0 = f2bf_bits(x[2 * e]), h1 = f2bf_bits(x[2 * e + 1]);
        const float r0 = x[2 * e] - __builtin_bit_cast(float, h0 << 16), r1 = x[2 * e + 1] - __builtin_bit_cast(float, h1 << 16);
        h[e] = h0 | (h1 << 16); l[e] = f2bf_bits(r0) | (f2bf_bits(r1) << 16); }
    hi = __builtin_bit_cast(bf16x8m, (u32x4){h[0], h[1], h[2], h[3]}); lo = __builtin_bit_cast(bf16x8m, (u32x4){l[0], l[1], l[2], l[3]});
}
__device__ __forceinline__ void phase_mod(const P& p, LAS unsigned char* lds) {
    constexpr int KC = 256, NCG = 6 * D / 32, NCH = D / KC, NMT = (NCB + 15) / 16;
    static_assert(NMT <= 16, "two m-tiles per wave at most");
    LAS float* WB = (LAS float*)lds;
    const int tid = otid(), lane = tid & 63, wave = tid >> 6, r16 = lane & 15, g4 = lane >> 4;
    for (int cg = blockIdx.x; cg < NCG; cg += gridDim.x) {
        f32x4 acc[2][2];
#pragma unroll
        for (int s = 0; s < 2; ++s)
#pragma unroll
            for (int nt = 0; nt < 2; ++nt) acc[s][nt] = (f32x4){0.f, 0.f, 0.f, 0.f};
        f32x4 wreg[4];
#pragma unroll
        for (int j = 0; j < 4; ++j) { const int idx = tid + NTHR * j; wreg[j] = *(const f32x4*)(p.w_ada + (size_t)(idx >> 3) * 6 * D + cg * 32 + 4 * (idx & 7)); }
        __syncthreads();
        for (int ch = 0; ch < NCH; ++ch) {
            LAS float* wb = WB + (ch & 1) * KC * 32;
#pragma unroll
            for (int j = 0; j < 4; ++j) { const int idx = tid + NTHR * j; *(LAS f32x4*)(wb + (idx >> 3) * 32 + 4 * (idx & 7)) = wreg[j]; }
            if (ch + 1 < NCH) {
#pragma unroll
                for (int j = 0; j < 4; ++j) { const int idx = tid + NTHR * j; wreg[j] = *(const f32x4*)(p.w_ada + (size_t)((ch + 1) * KC + (idx >> 3)) * 6 * D + cg * 32 + 4 * (idx & 7)); }
            }
            __syncthreads();
#pragma unroll 2
            for (int ks = 0; ks < KC / 32; ++ks) {
                bf16x8m bh[2], bl[2];
#pragma unroll
                for (int nt = 0; nt < 2; ++nt) { float x[8];
#pragma unroll
                    for (int j = 0; j < 8; ++j) x[j] = wb[(32 * ks + 8 * g4 + j) * 32 + 16 * nt + r16];
                    split8(x, bh[nt], bl[nt]); }
#pragma unroll
                for (int s = 0; s < 2; ++s) { const int mt = wave + 8 * s; if (mt >= NMT) continue;
                    const int row = 16 * mt + r16; float x[8];
                    if (row < NCB) { const float* c = (row < BATCH ? p.c_prompt + (size_t)row * D : p.c_sample + (size_t)(row - BATCH) * D) + ch * KC + 32 * ks + 8 * g4;
                        const f32x4 a = *(const f32x4*)c, d = *(const f32x4*)(c + 4);
                        x[0] = silu_f(a[0]); x[1] = silu_f(a[1]); x[2] = silu_f(a[2]); x[3] = silu_f(a[3]); x[4] = silu_f(d[0]); x[5] = silu_f(d[1]); x[6] = silu_f(d[2]); x[7] = silu_f(d[3]); }
                    else {
#pragma unroll
                        for (int j = 0; j < 8; ++j) x[j] = 0.f; }
                    bf16x8m ah, al; split8(x, ah, al);
#pragma unroll
                    for (int nt = 0; nt < 2; ++nt) {
                        acc[s][nt] = __builtin_amdgcn_mfma_f32_16x16x32_bf16(ah, bh[nt], acc[s][nt], 0, 0, 0);
                        acc[s][nt] = __builtin_amdgcn_mfma_f32_16x16x32_bf16(ah, bl[nt], acc[s][nt], 0, 0, 0);
                        acc[s][nt] = __builtin_amdgcn_mfma_f32_16x16x32_bf16(al, bh[nt], acc[s][nt], 0, 0, 0); } }
            }
        }
#pragma unroll
        for (int s = 0; s < 2; ++s) { const int mt = wave + 8 * s; if (mt >= NMT) continue;
#pragma unroll
            for (int nt = 0; nt < 2; ++nt) { const int e = cg * 32 + 16 * nt + r16; const float bb = p.b_ada[e];
#pragma unroll
                for (int i = 0; i < 4; ++i) { const int row = 16 * mt + 4 * g4 + i; if (row < NCB) ws_f(p, WS_MOD)[(size_t)row * 6 * D + e] = acc[s][nt][i] + bb; } } }
    }
    __syncthreads();
}
template <int WHICH> __device__ __forceinline__ void phase_norm(const P& p) {
    static_assert(D == 1024, "one wave per 1024-float row");
    const int tid_ = otid(), lane = tid_ & 63, wave = tid_ >> 6;
    const int gw = blockIdx.x * NWAVES + wave, NGW = gridDim.x * NWAVES;
    const float* nwp = WHICH == 0 ? p.norm_mix_w : (WHICH == 1 ? p.norm_ffn_w : p.final_norm_w);
    f32x4 nwv[4];
#pragma unroll
    for (int j = 0; j < 4; ++j) nwv[j] = ((const f32x4*)nwp)[lane + 64 * j];
    f32x4 wba[WHICH == 0 ? 16 : 1][2];
    if (WHICH == 0) {
#pragma unroll
        for (int j = 0; j < 4; ++j)
#pragma unroll
            for (int e = 0; e < 4; ++e) { const float* wr = p.w_in + (size_t)(4 * (lane + 64 * j) + e) * IN_COLS + WC_BA; wba[4 * j + e][0] = *(const f32x4*)wr; wba[4 * j + e][1] = *(const f32x4*)(wr + 4); }
    }
    f32x4 v[4];
    if (gw < T) { const float* xr = WHICH == 0 ? xrow(p, gw) : p.out + O_Y + (size_t)gw * D;
#pragma unroll
        for (int j = 0; j < 4; ++j) v[j] = ((const f32x4*)xr)[lane + 64 * j]; }
    for (int m = gw; m < T; m += NGW) {
        f32x4 vn[4]; const int mn = m + NGW;
        if (mn < T) { const float* xr = WHICH == 0 ? xrow(p, mn) : p.out + O_Y + (size_t)mn * D;
#pragma unroll
            for (int j = 0; j < 4; ++j) vn[j] = ((const f32x4*)xr)[lane + 64 * j]; }
        float ss = 0.f;
#pragma unroll
        for (int j = 0; j < 4; ++j) ss += (v[j][0] * v[j][0] + v[j][1] * v[j][1]) + (v[j][2] * v[j][2] + v[j][3] * v[j][3]);
        const float rstd = 1.0f / sqrtf(wave_sum(ss) * (1.0f / D) + EPS);
        if (WHICH == 2) {
#pragma unroll
            for (int j = 0; j < 4; ++j) ((f32x4*)(p.out + O_Y + (size_t)m * D))[lane + 64 * j] = v[j] * rstd * nwv[j];
        } else {
            const int cb = cb_of(m);
            const float* mod = ws_f(p, WS_MOD) + (size_t)cb * 6 * D;
            const float* sh = mod + (WHICH == 0 ? 0 : 3 * D); const float* sc = mod + (WHICH == 0 ? D : 4 * D);
            float ba[8];
#pragma unroll
            for (int j = 0; j < 8; ++j) ba[j] = 0.f;
            unsigned long long* o8 = (unsigned long long*)(ws_h(p, WS_H) + (size_t)m * D);
#pragma unroll
            for (int j = 0; j < 4; ++j) {
                const f32x4 s1 = ((const f32x4*)sc)[lane + 64 * j], s0 = ((const f32x4*)sh)[lane + 64 * j];
                const f32x4 h = v[j] * rstd * nwv[j] * (s1 + 1.0f) + s0;
                o8[lane + 64 * j] = (unsigned long long)pk2(h[0], h[1]) | ((unsigned long long)pk2(h[2], h[3]) << 32);
                if (WHICH == 0) {
#pragma unroll
                    for (int e = 0; e < 4; ++e) { const f32x4 wa = wba[4 * j + e][0], wb = wba[4 * j + e][1];
                        ba[0] += h[e] * wa[0]; ba[1] += h[e] * wa[1]; ba[2] += h[e] * wa[2]; ba[3] += h[e] * wa[3]; ba[4] += h[e] * wb[0]; ba[5] += h[e] * wb[1]; ba[6] += h[e] * wb[2]; ba[7] += h[e] * wb[3]; }
                }
            }
            if (WHICH == 0) {
#pragma unroll
                for (int j = 0; j < 8; ++j) ba[j] = wave_sum(ba[j]);
                float mine = 0.f;
#pragma unroll
                for (int j = 0; j < 8; ++j) mine = (lane == j) ? ba[j] : mine;
                if (lane < 8) { float* bg = ws_f(p, WS_BG) + (size_t)m * 8; const int j = lane & 3;
                    bg[lane] = lane < 4 ? sigmoid_f(mine) : -expf(p.dn_A_log[j]) * softplus_f(mine + p.dn_dt_bias[j]); }
            }
        }
#pragma unroll
        for (int j = 0; j < 4; ++j) v[j] = vn[j];
    }
}
#define XB_TMO      128
#define XB_XCNT(j)  (256  + 64 * (j))
#define XB_XSUB(j)  (1280 + 64 * (j))
#define XB_XGEN(j)  (2304 + 64 * (j))
#define XB_TOP      3328
#define XB_TOPGEN   3392
#define XCD_BAR_WORDS 3456
#define XB_SPIN_CAP (1u << 18)

__device__ __forceinline__ unsigned xb_ld(unsigned* p)              { return __hip_atomic_load(p, __ATOMIC_RELAXED, __HIP_MEMORY_SCOPE_AGENT); }
__device__ __forceinline__ unsigned xb_add(unsigned* p, unsigned v) { return __hip_atomic_fetch_add(p, v, __ATOMIC_RELAXED, __HIP_MEMORY_SCOPE_AGENT); }
__device__ __forceinline__ unsigned xb_xcc_id() { return (unsigned)__builtin_amdgcn_s_getreg((3 << 11) | 20) & 0xFu; }
#define XB_SPIN(cond, bar) do { unsigned _sp = 0; while (cond) { __builtin_amdgcn_s_sleep(1); \
    if ((++_sp & 255u) == 0u) { if (xb_ld(&(bar)[XB_TMO])) break; if (_sp > XB_SPIN_CAP) { atomicAdd(&(bar)[XB_TMO], 1u); break; } } } } while (0)

struct XcdBarrier {
    unsigned* bar; unsigned x;
    volatile LAS unsigned* st;
};

__device__ __forceinline__ XcdBarrier xcd_barrier_post(unsigned* bar, volatile LAS unsigned* st) {
    XcdBarrier b; b.bar = bar; b.x = xb_xcc_id(); b.st = st;
    if (threadIdx.x == 0) (void)xb_add(&bar[XB_XCNT(b.x)], 1u);
    return b;
}
__device__ __forceinline__ void xcd_barrier_complete(unsigned* bar, unsigned x, unsigned& nloc, unsigned& nx) {
    const unsigned G = gridDim.x * gridDim.y * gridDim.z;
    unsigned sum, cnt, mine, sp = 0u;
    for (;;) {
        sum = 0u; cnt = 0u; mine = 0u;
#pragma unroll
        for (unsigned j = 0; j < 16; ++j) { const unsigned c = xb_ld(&bar[XB_XCNT(j)]); sum += c; cnt += (c > 0u) ? 1u : 0u; mine = (j == x) ? c : mine; }
        if (sum == G) break;
        __builtin_amdgcn_s_sleep(1);
        if ((++sp & 255u) == 0u) { if (xb_ld(&bar[XB_TMO])) break; if (sp > XB_SPIN_CAP) { atomicAdd(&bar[XB_TMO], 1u); break; } }
    }
    nloc = mine > 0u ? mine : 1u; nx = cnt > 0u ? cnt : 1u;
}

__device__ __forceinline__ void xcd_barrier(const XcdBarrier& b) {
    asm volatile("s_waitcnt vmcnt(0)" ::: "memory");
    __syncthreads();
    if (threadIdx.x == 0) {
        unsigned* bar = b.bar;
        __builtin_amdgcn_s_waitcnt(0);
        unsigned nloc = b.st[0], nx = b.st[1];
        if (nloc == 0u) { xcd_barrier_complete(bar, b.x, nloc, nx); b.st[0] = nloc; b.st[1] = nx; }
        const unsigned old = xb_add(&bar[XB_XSUB(b.x)], 1u);
        const unsigned gen = old / nloc;
        if (old + 1u == (gen + 1u) * nloc) {
            __builtin_amdgcn_fence(__ATOMIC_RELEASE, "agent");
            asm volatile("s_waitcnt vmcnt(0)" ::: "memory");
            const unsigned og = xb_add(&bar[XB_TOP], 1u);
            const unsigned tg = og / nx;
            if (og + 1u == (tg + 1u) * nx) xb_add(&bar[XB_TOPGEN], 1u);
            else XB_SPIN(xb_ld(&bar[XB_TOPGEN]) == tg, bar);
            __builtin_amdgcn_fence(__ATOMIC_ACQUIRE, "agent");
            xb_add(&bar[XB_XGEN(b.x)], 1u);
            asm volatile("s_waitcnt vmcnt(0)" ::: "memory");
        } else {
            XB_SPIN(xb_ld(&bar[XB_XGEN(b.x)]) == gen, bar);
            __builtin_amdgcn_fence(__ATOMIC_ACQUIRE, "agent");
            asm volatile("s_waitcnt vmcnt(0)" ::: "memory");
        }
    }
    __syncthreads();
}
namespace pg8 {
#define PG8_LAS __attribute__((address_space(3)))
typedef unsigned short bf16_t;
typedef short bf16x8 __attribute__((ext_vector_type(8)));
typedef float f32x4 __attribute__((ext_vector_type(4)));
typedef unsigned u32x4 __attribute__((ext_vector_type(4)));
constexpr int BM = 256, BK = 64, HALF = 128, HTB = HALF * BK * 2  , STAGE_BYTES = 8 * HTB, NXCD = 8, WGM = 8;

__host__ __device__ __forceinline__ int lds_byte(int r, int c) { const int st = (r >> 4) * 2 + (c >> 5), rr = r & 15, cc = c & 31, ob = rr * 64 + cc * 2; return st * 1024 + (ob ^ (((ob >> 9) & 1) << 5)); }
__host__ __device__ __forceinline__ void stage_rc(int b, int& R, int& C) { const int st = b / 1024, sb = b % 1024, swz = sb ^ (((sb >> 9) & 1) << 5); R = (st >> 1) * 16 + swz / 64; C = (st & 1) * 32 + (swz % 64) / 2; }
__host__ __device__ __forceinline__ int perm32(int rho) { const int n = rho >> 4, i = rho & 15; return 8 * (i >> 2) + 4 * n + (i & 3); }

struct Unit { int pm, pn; };
struct Gemm { const bf16_t* A; const bf16_t* Bt; int M, N, K; };

struct StaticOrder {
    int nM, nN, nwg, G, c;
    __host__ __device__ void init(int M, int N, int G_, int c_) { nM = M / BM; nN = N / BM; nwg = nM * nN; G = G_; c = c_; }
    __host__ __device__ bool next(int i, Unit& u) const {
        const long L = (long)i * G + c; if (L >= nwg) return false;
        int wgid = (int)L; { const int q = nwg / NXCD, r = nwg % NXCD, xcd = wgid % NXCD, off = wgid / NXCD; wgid = (xcd < r ? xcd * (q + 1) : r * (q + 1) + (xcd - r) * q) + off; }
        const int nig = WGM * nN, gid = wgid / nig, fm = gid * WGM, gsz = (nM - fm) < WGM ? (nM - fm) : WGM;
        u.pm = fm + ((wgid % nig) % gsz); u.pn = (wgid % nig) / gsz; return true;
    }
    __device__ __forceinline__ void a_ready(const Unit&) const {}
    __device__ __forceinline__ void done(const Unit&) const {}
};

__device__ __forceinline__ unsigned cvt_pk_bf16(float lo, float hi) { unsigned r; asm volatile("v_cvt_pk_bf16_f32 %0, %1, %2" : "=v"(r) : "v"(lo), "v"(hi)); return r; }
struct EpiStoreBf16 {
    static constexpr bool PERM = true, AFTER_DRAIN = false;
    bf16_t* O; int ldc;
    __device__ __forceinline__ void operator()(const f32x4 (&acc)[2][2][4][2], const Unit& u, int wr, int wc, int fr, int fq) const {
        const int row0 = u.pm * BM + wr * 64 + fr, col0 = u.pn * BM + wc * 32 + 8 * fq;
#pragma unroll
        for (int ai = 0; ai < 2; ++ai)
#pragma unroll
            for (int m = 0; m < 4; ++m) { bf16_t* rowp = O + (size_t)(row0 + ai * HALF + m * 16) * ldc + col0;
#pragma unroll
                for (int bj = 0; bj < 2; ++bj) { const f32x4 v0 = acc[ai][bj][m][0], v1 = acc[ai][bj][m][1];
                    u32x4 w; w.x = cvt_pk_bf16(v0[0], v0[1]); w.y = cvt_pk_bf16(v0[2], v0[3]); w.z = cvt_pk_bf16(v1[0], v1[1]); w.w = cvt_pk_bf16(v1[2], v1[3]);
                    *(u32x4*)(rowp + bj * HALF) = w; } }
    }
};
struct EpiGateRes {
    static constexpr bool PERM = false, AFTER_DRAIN = false;
    const float* base_p; const float* base_s; float* out; const float* gate;
    __device__ __forceinline__ void operator()(const f32x4 (&acc)[2][2][4][2], const Unit& u, int wr, int wc, int fr, int fq) const {
        const int row0 = u.pm * BM + wr * 64 + fr, col0 = u.pn * BM + wc * 32 + 4 * fq;
        const bool smp = row0 >= TP; const float* base = smp ? base_s - (size_t)TP * D : base_p;
#pragma unroll
        for (int ai = 0; ai < 2; ++ai)
#pragma unroll
            for (int m = 0; m < 4; ++m) { const int r = row0 + ai * HALF + m * 16; const int cb = smp ? BATCH + ((r - TP) >> 3) : r / SEQ;
                const float* gp = gate + (size_t)cb * 6 * D + col0; const size_t off = (size_t)r * D + col0;
#pragma unroll
                for (int bj = 0; bj < 2; ++bj)
#pragma unroll
                    for (int n = 0; n < 2; ++n) { const f32x4 gv = *(const f32x4*)(gp + bj * HALF + n * 16), bs = *(const f32x4*)(base + off + bj * HALF + n * 16);
                        *(f32x4*)(out + off + bj * HALF + n * 16) = bs + gv * acc[ai][bj][m][n]; } }
    }
};
template <class Epi, class Sched, bool ALIGN_EPI = false, bool SP2 = false>
__device__ __forceinline__ void gemm_phase(PG8_LAS unsigned char* lds, const Gemm g, const Sched& S, const Epi& E) {
    const int tid = otid(), wid = __builtin_amdgcn_readfirstlane(tid >> 6), lane = tid & 63, wr = wid >> 2, wc = wid & 3, fr = lane & 15, fq = lane >> 4;
    const int K = g.K, nt = K / BK;
    unsigned voffA[2], voffB[2];
#pragma unroll
    for (int i = 0; i < 2; ++i) { int R, C; stage_rc(tid * 16 + i * 8192, R, C); const int Rb = Epi::PERM ? ((R & ~31) + perm32(R & 31)) : R;
        voffA[i] = (unsigned)(R * K + C) * 2u; voffB[i] = (unsigned)(Rb * K + C) * 2u; }
    const size_t kstep = (size_t)(BK * 2);
    const size_t hstep = (size_t)HALF * K * 2;
    const size_t tstep = 2 * hstep;
    const unsigned ldsw = (unsigned)wid * 1024u;
    const int aoff = lds_byte(wr * 64 + fr, fq * 8), boff = lds_byte(wc * 32 + fr, fq * 8);
#define PG8_SA(b, h) (((b) * 2 + (h)) * HTB)
#define PG8_SB(b, h) ((4 + (b) * 2 + (h)) * HTB)
#define PG8_STAGE(bufoff, gbase, voff) do { _Pragma("unroll") for (int _i = 0; _i < 2; ++_i) \
        __builtin_amdgcn_global_load_lds((const unsigned*)((const char*)(gbase) + (voff)[_i]), (PG8_LAS unsigned*)(lds + (bufoff) + ldsw + _i * 8192), 16, 0, 0); } while (0)
#define PG8_LDA(dst, b, h) do { _Pragma("unroll") for (int m = 0; m < 4; ++m) _Pragma("unroll") for (int k = 0; k < 2; ++k) dst[m][k] = *(const PG8_LAS bf16x8*)(lds + PG8_SA(b, h) + aoff + m * 2048 + k * 1024); } while (0)
#define PG8_LDB(dst, b, h) do { _Pragma("unroll") for (int n = 0; n < 2; ++n) _Pragma("unroll") for (int k = 0; k < 2; ++k) dst[n][k] = *(const PG8_LAS bf16x8*)(lds + PG8_SB(b, h) + boff + n * 2048 + k * 1024); } while (0)
#define PG8_MMA(ai, bj, At, Bt) do { __builtin_amdgcn_s_setprio(1); _Pragma("unroll") for (int m = 0; m < 4; ++m) _Pragma("unroll") for (int n = 0; n < 2; ++n) _Pragma("unroll") for (int k = 0; k < 2; ++k) \
        acc[ai][bj][m][n] = __builtin_amdgcn_mfma_f32_16x16x32_bf16(Bt[n][k], At[m][k], acc[ai][bj][m][n], 0, 0, 0); __builtin_amdgcn_s_setprio(0); } while (0)
#define PG8_WAIT_V(n) asm volatile("s_waitcnt vmcnt(" #n ")" ::: "memory")
#define PG8_WAIT_L(n) asm volatile("s_waitcnt lgkmcnt(" #n ")" ::: "memory")
#define PG8_BAR __builtin_amdgcn_s_barrier()
#define PG8_SCHED __builtin_amdgcn_sched_barrier(0)
    Unit cur, nxt; int ui = 0;
    if (!S.next(0, cur)) return;
    f32x4 acc[2][2][4][2];
#pragma unroll
    for (int a = 0; a < 2; ++a)
#pragma unroll
        for (int b = 0; b < 2; ++b)
#pragma unroll
            for (int m = 0; m < 4; ++m)
#pragma unroll
                for (int n = 0; n < 2; ++n) acc[a][b][m][n] = (f32x4){0.f, 0.f, 0.f, 0.f};
    bf16x8 At[4][2], B0[2][2], B1[2][2];
    const char* cA = (const char*)g.A + (size_t)cur.pm * tstep; const char* cB = (const char*)g.Bt + (size_t)cur.pn * tstep;
    S.a_ready(cur);
    if constexpr (SP2) {
        PG8_STAGE(PG8_SB(0, 0), cB, voffB); PG8_STAGE(PG8_SB(0, 1), cB + hstep, voffB); PG8_STAGE(PG8_SA(0, 0), cA, voffA); PG8_STAGE(PG8_SA(0, 1), cA + hstep, voffA);
        if (wr == 1) PG8_BAR;
        PG8_WAIT_V(2); PG8_BAR;
        PG8_STAGE(PG8_SB(1, 0), cB + kstep, voffB); PG8_STAGE(PG8_SA(1, 0), cA + kstep, voffA); PG8_STAGE(PG8_SB(1, 1), cB + hstep + kstep, voffB);
        PG8_WAIT_V(6); PG8_BAR;
    } else {
        PG8_STAGE(PG8_SB(0, 0), cB, voffB); PG8_STAGE(PG8_SA(0, 0), cA, voffA); PG8_STAGE(PG8_SB(0, 1), cB + hstep, voffB); PG8_STAGE(PG8_SA(0, 1), cA + hstep, voffA);
        if (wr == 1) PG8_BAR;
        PG8_WAIT_V(4); PG8_BAR;
        PG8_STAGE(PG8_SB(1, 0), cB + kstep, voffB); PG8_STAGE(PG8_SA(1, 0), cA + kstep, voffA); PG8_STAGE(PG8_SB(1, 1), cB + hstep + kstep, voffB);
        PG8_WAIT_V(6); PG8_BAR;
    }
    for (;;) {
        const bool has_next = S.next(ui + 1, nxt);
        const char* nA = has_next ? (const char*)g.A + (size_t)nxt.pm * tstep : cA; const char* nB = has_next ? (const char*)g.Bt + (size_t)nxt.pn * tstep : cB;
        for (int t = 0; t < nt; t += 2) {
            const bool last = (t == nt - 2);
            const char* a1 = cA + (size_t)(t + 1) * kstep;
            const char* a2 = last ? nA : cA + (size_t)(t + 2) * kstep; const char* b2 = last ? nB : cB + (size_t)(t + 2) * kstep;
            const char* a3 = a2 + kstep; const char* b3 = b2 + kstep;
            if (last && has_next) S.a_ready(nxt);
            if constexpr (SP2) {
            PG8_LDB(B0, 0, 0); PG8_LDB(B1, 0, 1); PG8_SCHED; PG8_LDA(At, 0, 0); PG8_STAGE(PG8_SA(1, 1), a1 + hstep, voffA);
            PG8_WAIT_V(8); PG8_WAIT_L(0); PG8_BAR; PG8_MMA(0, 0, At, B0); PG8_MMA(0, 1, At, B1); PG8_BAR; PG8_SCHED;
            PG8_LDA(At, 0, 1); PG8_STAGE(PG8_SB(0, 0), b2, voffB); PG8_STAGE(PG8_SB(0, 1), b2 + hstep, voffB); PG8_STAGE(PG8_SA(0, 0), a2, voffA);
            PG8_WAIT_V(8); PG8_WAIT_L(0); PG8_BAR; PG8_MMA(1, 0, At, B0); PG8_MMA(1, 1, At, B1); PG8_BAR; PG8_SCHED;
            PG8_LDB(B0, 1, 0); PG8_LDB(B1, 1, 1); PG8_SCHED; PG8_LDA(At, 1, 0); PG8_STAGE(PG8_SA(0, 1), a2 + hstep, voffA);
            PG8_WAIT_V(8); PG8_WAIT_L(0); PG8_BAR; PG8_MMA(0, 0, At, B0); PG8_MMA(0, 1, At, B1); PG8_BAR; PG8_SCHED;
            PG8_LDA(At, 1, 1); PG8_STAGE(PG8_SB(1, 0), b3, voffB); PG8_STAGE(PG8_SB(1, 1), b3 + hstep, voffB); PG8_STAGE(PG8_SA(1, 0), a3, voffA);
            PG8_WAIT_V(8); PG8_WAIT_L(0); PG8_BAR; PG8_MMA(1, 0, At, B0); PG8_MMA(1, 1, At, B1); PG8_BAR; PG8_SCHED;
            } else {
            PG8_LDB(B0, 0, 0); PG8_SCHED; PG8_LDA(At, 0, 0); PG8_STAGE(PG8_SA(1, 1), a1 + hstep, voffA);
            PG8_WAIT_L(8); PG8_BAR; PG8_WAIT_L(0); PG8_MMA(0, 0, At, B0); PG8_BAR; PG8_SCHED;
            PG8_LDB(B1, 0, 1); PG8_STAGE(PG8_SB(0, 0), b2, voffB);
            PG8_BAR; PG8_WAIT_L(0); PG8_MMA(0, 1, At, B1); PG8_BAR;
            PG8_LDA(At, 0, 1); PG8_STAGE(PG8_SA(0, 0), a2, voffA);
            PG8_BAR; PG8_WAIT_L(0); PG8_MMA(1, 0, At, B0); PG8_BAR; PG8_SCHED;
            PG8_STAGE(PG8_SB(0, 1), b2 + hstep, voffB);
            PG8_WAIT_V(6); PG8_BAR; PG8_MMA(1, 1, At, B1); PG8_BAR;
            PG8_LDB(B0, 1, 0); PG8_SCHED; PG8_LDA(At, 1, 0); PG8_STAGE(PG8_SA(0, 1), a2 + hstep, voffA);
            PG8_WAIT_L(8); PG8_BAR; PG8_WAIT_L(0); PG8_MMA(0, 0, At, B0); PG8_BAR; PG8_SCHED;
            PG8_LDB(B1, 1, 1); PG8_STAGE(PG8_SB(1, 0), b3, voffB);
            PG8_BAR; PG8_WAIT_L(0); PG8_MMA(0, 1, At, B1); PG8_BAR;
            PG8_LDA(At, 1, 1); PG8_STAGE(PG8_SA(1, 0), a3, voffA);
            PG8_BAR; PG8_WAIT_L(0); PG8_MMA(1, 0, At, B0); PG8_BAR; PG8_SCHED;
            PG8_STAGE(PG8_SB(1, 1), b3 + hstep, voffB);
            PG8_WAIT_V(6); PG8_BAR; PG8_MMA(1, 1, At, B1); PG8_BAR;
            }
        }
        if constexpr (ALIGN_EPI) { if (wr == 0) PG8_BAR; }
        if constexpr (!Epi::AFTER_DRAIN) { E(acc, cur, wr, wc, fr, fq); S.done(cur); }
        if (!has_next) break;
#pragma unroll
        for (int a = 0; a < 2; ++a)
#pragma unroll
            for (int b = 0; b < 2; ++b)
#pragma unroll
                for (int m = 0; m < 4; ++m)
#pragma unroll
                    for (int n = 0; n < 2; ++n) acc[a][b][m][n] = (f32x4){0.f, 0.f, 0.f, 0.f};
        cur = nxt; cA = nA; cB = nB; ++ui;
        if constexpr (ALIGN_EPI) { if (wr == 1) PG8_BAR; }
    }
    PG8_WAIT_V(0);
    if constexpr (!ALIGN_EPI) { if (wr == 0) PG8_BAR; }
    PG8_BAR;
    if constexpr (Epi::AFTER_DRAIN) { E.fused(acc, cur, wr, wc, fr, fq, lds, wid, lane); S.done(cur); }
#undef PG8_SA
#undef PG8_SB
#undef PG8_STAGE
#undef PG8_LDA
#undef PG8_LDB
#undef PG8_MMA
#undef PG8_WAIT_V
#undef PG8_WAIT_L
#undef PG8_BAR
#undef PG8_SCHED
}
}
typedef short bf16x8 __attribute__((ext_vector_type(8)));
constexpr int FR_NWK = 0, FR_QD = 16, FR_KTT = 32, FR_QK = 48, FR_N = 56;
__device__ __forceinline__ int kperm(int g, int j) { return j < 4 ? 4 * g + j : 16 + 4 * g + (j - 4); }

constexpr int DP_KP = 136;
constexpr int DP_QS = 0, DP_KS = DP_QS + 64 * DP_KP * 2, DP_RHS = DP_KS + 64 * DP_KP * 2, DP_AM = DP_RHS + 64 * 256 * 4, DP_AMP = 68,
              DP_QKM = DP_AM + 64 * DP_AMP * 4, DP_QKP = 72, DP_GS = DP_QKM + 64 * DP_QKP * 2, DP_END = DP_GS + 4 * 64 * 4, DP_NWK = DP_RHS;
static_assert(DP_END <= 131072, "dnprep LDS");

__device__ __forceinline__ void phase_dnprep(const P& p, LAS unsigned char* lds) {
    const int tid = otid(), lane_ = tid & 63, wave = tid >> 6;
    LAS bf16_t* QS = (LAS bf16_t*)(lds + DP_QS); LAS bf16_t* KS = (LAS bf16_t*)(lds + DP_KS); LAS float* RHS = (LAS float*)(lds + DP_RHS);
    LAS float* AM = (LAS float*)(lds + DP_AM); LAS bf16_t* QKM = (LAS bf16_t*)(lds + DP_QKM); LAS float* GS = (LAS float*)(lds + DP_GS);
    LAS bf16_t* NWKS = (LAS bf16_t*)(lds + DP_NWK);
    const bf16_t* PR = ws_h(p, WS_PROJ); const float* BG = ws_f(p, WS_BG);
    for (int uid = blockIdx.x; uid < NUNIT; uid += gridDim.x) {
        const int n = uid % NCHUNK, bh = uid / NCHUNK, h = bh & 3, b = bh >> 2, m0 = b * SEQ + n * 64;
        int lane = lane_; asm volatile("" : "+v"(lane));
        const int r16 = lane & 15, g4 = lane >> 4;
        if (wave == 0) {
            float x = BG[(size_t)(m0 + lane) * 8 + 4 + h];
#pragma unroll
            for (int o = 1; o < 64; o <<= 1) { const float t = __shfl_up(x, o); if (lane >= o) x += t; }
            const float gl = __shfl(x, 63);
            GS[lane] = x; GS[64 + lane] = BG[(size_t)(m0 + lane) * 8 + h]; GS[128 + lane] = expf(x); GS[192 + lane] = expf(gl - x);
            if (lane == 0) ws_f(p, WS_DNF_CD)[uid] = expf(gl);
        }
        __syncthreads();
        {
            float cw[3][4][2];
#pragma unroll
            for (int part = 0; part < 3; ++part)
#pragma unroll
                for (int j = 0; j < 4; ++j) { const float* w = p.dn_conv_w + j * 1536 + part * 512 + h * 128 + 2 * lane; cw[part][j][0] = w[0]; cw[part][j][1] = w[1]; }
            float xs[3][11][2];
#pragma unroll
            for (int rr = 0; rr < 11; ++rr) { const int t = n * 64 + wave * 8 + rr - 3;
#pragma unroll
                for (int part = 0; part < 3; ++part) { unsigned v = 0u; if (t >= 0) v = *(const unsigned*)(PR + (size_t)(m0 + wave * 8 + rr - 3) * PLD + part * 512 + h * 128 + 2 * lane);
                    xs[part][rr][0] = __builtin_bit_cast(float, v << 16); xs[part][rr][1] = __builtin_bit_cast(float, v & 0xffff0000u); } }
#pragma unroll
            for (int i = 0; i < 8; ++i) { const int row = wave * 8 + i;
                float c[3][2];
#pragma unroll
                for (int part = 0; part < 3; ++part)
#pragma unroll
                    for (int e = 0; e < 2; ++e) { float a = 0.f;
#pragma unroll
                        for (int j = 0; j < 4; ++j) a += cw[part][j][e] * xs[part][i + j][e];
                        c[part][e] = silu_f(a); }
                const float sq = wave_sum(c[0][0] * c[0][0] + c[0][1] * c[0][1]), sk = wave_sum(c[1][0] * c[1][0] + c[1][1] * c[1][1]);
                const float rq = 0.08838834764831845f / sqrtf(sq + EPS), rk = 1.0f / sqrtf(sk + EPS);
                const float beta = GS[64 + row], eg = GS[128 + row];
                const float q0 = c[0][0] * rq, q1 = c[0][1] * rq, k0 = c[1][0] * rk, k1 = c[1][1] * rk;
                *(LAS unsigned*)(QS + row * DP_KP + 2 * lane) = pk2(q0, q1);
                *(LAS unsigned*)(KS + row * DP_KP + 2 * lane) = pk2(k0, k1);
                RHS[row * 256 + 2 * lane] = beta * c[2][0]; RHS[row * 256 + 2 * lane + 1] = beta * c[2][1];
                RHS[row * 256 + 128 + 2 * lane] = beta * eg * k0; RHS[row * 256 + 128 + 2 * lane + 1] = beta * eg * k1; }
        }
        __syncthreads();
        {
            const int ti = wave >> 1;
            f32x4 akk[2], aqk[2];
#pragma unroll
            for (int c = 0; c < 2; ++c) { akk[c] = (f32x4){0.f, 0.f, 0.f, 0.f}; aqk[c] = (f32x4){0.f, 0.f, 0.f, 0.f}; }
#pragma unroll
            for (int kb = 0; kb < 4; ++kb) {
                const bf16x8 ak = *(const LAS bf16x8*)(KS + (16 * ti + r16) * DP_KP + 32 * kb + 8 * g4), aq = *(const LAS bf16x8*)(QS + (16 * ti + r16) * DP_KP + 32 * kb + 8 * g4);
#pragma unroll
                for (int c = 0; c < 2; ++c) { const int tj = 2 * (wave & 1) + c; const bf16x8 bk = *(const LAS bf16x8*)(KS + (16 * tj + r16) * DP_KP + 32 * kb + 8 * g4);
                    akk[c] = __builtin_amdgcn_mfma_f32_16x16x32_bf16(ak, bk, akk[c], 0, 0, 0); aqk[c] = __builtin_amdgcn_mfma_f32_16x16x32_bf16(aq, bk, aqk[c], 0, 0, 0); }
            }
#pragma unroll
            for (int c = 0; c < 2; ++c) { const int tj = 2 * (wave & 1) + c, J = 16 * tj + r16; const float gj = GS[J];
#pragma unroll
                for (int i = 0; i < 4; ++i) { const int I = 16 * ti + 4 * g4 + i; const float dec = I >= J ? expf(GS[I] - gj) : 0.f;
                    AM[I * DP_AMP + J] = I > J ? GS[64 + I] * akk[c][i] * dec : 0.f; QKM[I * DP_QKP + J] = f2bf(aqk[c][i] * dec); } }
        }
        __syncthreads();
        unsigned char* abu = p.ws + WS_DNF_AB + (size_t)uid * DNF_AB_UNIT;
        float x[64];
        if (wave < 4) {
#pragma unroll
            for (int i = 0; i < 64; ++i) x[i] = RHS[i * 256 + tid];
        }
        __syncthreads();
        if (wave < 4) {
#pragma unroll
            for (int i = 1; i < 64; ++i) { float acc = x[i];
#pragma unroll
                for (int j4 = 0; j4 < (i + 3) / 4; ++j4) { const f32x4 a = *(const LAS f32x4*)(AM + i * DP_AMP + 4 * j4);
#pragma unroll
                    for (int e = 0; e < 4; ++e) if (4 * j4 + e < i) acc -= a[e] * x[4 * j4 + e]; }
                x[i] = acc; asm volatile("" ::: "memory"); }
            if (tid < 128) {
                float* wv = (float*)(p.ws + WS_DNF_WV + (size_t)uid * DNF_WV_UNIT) + (size_t)(tid >> 4) * 4 * 256 + (tid & 15) * 4;
#pragma unroll
                for (int mt = 0; mt < 4; ++mt)
#pragma unroll
                    for (int g = 0; g < 4; ++g) *(f32x4*)(wv + mt * 256 + g * 64) = (f32x4){x[16 * mt + 4 * g], x[16 * mt + 4 * g + 1], x[16 * mt + 4 * g + 2], x[16 * mt + 4 * g + 3]};
            } else {
#pragma unroll
                for (int i = 0; i < 64; ++i) NWKS[i * DP_KP + (tid - 128)] = f2bf(-x[i]);
            }
        } else {
            for (int f = FR_QD + (wave - 4); f < FR_N; f += 4) {
                u32x4 o;
                if (f < FR_KTT) { const int mt = (f - FR_QD) >> 2, kb = (f - FR_QD) & 3, row = 16 * mt + r16; const float sc = GS[128 + row];
                    const u32x2 lo = *(const LAS u32x2*)(QS + row * DP_KP + 32 * kb + 4 * g4), hi = *(const LAS u32x2*)(QS + row * DP_KP + 32 * kb + 16 + 4 * g4);
                    const unsigned w[4] = {lo.x, lo.y, hi.x, hi.y}; unsigned r[4];
#pragma unroll
                    for (int e = 0; e < 4; ++e) r[e] = pk2(__builtin_bit_cast(float, w[e] << 16) * sc, __builtin_bit_cast(float, w[e] & 0xffff0000u) * sc);
                    o = (u32x4){r[0], r[1], r[2], r[3]};
                } else if (f < FR_QK) { const int kt = (f - FR_KTT) >> 1, tb = (f - FR_KTT) & 1; float v[8];
#pragma unroll
                    for (int j = 0; j < 8; ++j) { const int tok = 32 * tb + kperm(g4, j); v[j] = bf2f(KS[tok * DP_KP + 16 * kt + r16]) * GS[192 + tok]; }
                    o = (u32x4){pk2(v[0], v[1]), pk2(v[2], v[3]), pk2(v[4], v[5]), pk2(v[6], v[7])};
                } else { const int mt = (f - FR_QK) >> 1, tb = (f - FR_QK) & 1, row = 16 * mt + r16;
                    const u32x2 lo = *(const LAS u32x2*)(QKM + row * DP_QKP + 32 * tb + 4 * g4), hi = *(const LAS u32x2*)(QKM + row * DP_QKP + 32 * tb + 16 + 4 * g4);
                    o = (u32x4){lo.x, lo.y, hi.x, hi.y}; }
                *(u32x4*)(abu + (size_t)f * 1024 + lane * 16) = o;
            }
        }
        __syncthreads();
        for (int f = FR_NWK + wave; f < FR_QD; f += 8) { const int mt = f >> 2, kb = f & 3, row = 16 * mt + r16;
            const u32x2 lo = *(const LAS u32x2*)(NWKS + row * DP_KP + 32 * kb + 4 * g4), hi = *(const LAS u32x2*)(NWKS + row * DP_KP + 32 * kb + 16 + 4 * g4);
            *(u32x4*)(abu + (size_t)f * 1024 + lane * 16) = (u32x4){lo.x, lo.y, hi.x, hi.y}; }
        __syncthreads();
    }
}

constexpr size_t O_ODN = O_Y;
typedef float f32x2_t __attribute__((ext_vector_type(2))); typedef __bf16 bf16x2_t __attribute__((ext_vector_type(2)));
__device__ __forceinline__ unsigned cvtpk_c(float lo, float hi) { const f32x2_t v = {lo, hi}; const bf16x2_t b = __builtin_convertvector(v, bf16x2_t); return __builtin_bit_cast(unsigned, b); }
__device__ __forceinline__ bf16x8 pack8(const f32x4 a, const f32x4 b) {
    return __builtin_bit_cast(bf16x8, (u32x4){cvtpk_c(a[0], a[1]), cvtpk_c(a[2], a[3]), cvtpk_c(b[0], b[1]), cvtpk_c(b[2], b[3])});
}
__device__ __forceinline__ void phase_dnscan(const P& p, LAS unsigned char* lds) {
    if (blockIdx.x >= BATCH * 4 * 2) return;
    const int tid = otid(), lane = tid & 63, wave = tid >> 6, r16 = lane & 15, g4 = lane >> 4;
    const int bh = blockIdx.x >> 1, vh = blockIdx.x & 1, h = bh & 3, b = bh >> 2, vs = vh * 4 + (wave & 3), v0 = vs * 16;
    const unsigned char* ab = p.ws + WS_DNF_AB + (size_t)bh * NCHUNK * DNF_AB_UNIT;
    const float* wvb = (const float*)(p.ws + WS_DNF_WV + (size_t)bh * NCHUNK * DNF_WV_UNIT) + (size_t)vs * 4 * 256 + lane * 4;
    const float* cdp = ws_f(p, WS_DNF_CD) + (size_t)bh * NCHUNK;
    float* odn = p.out + O_ODN;
#define DN_STAGE(n_, buf_) do { for (int f_ = wave; f_ < FR_N; f_ += 8) \
        __builtin_amdgcn_global_load_lds((const unsigned*)(ab + (size_t)(n_) * DNF_AB_UNIT + f_ * 1024 + lane * 16), (LAS unsigned*)(lds + (buf_) * DNF_AB_UNIT + f_ * 1024), 16, 0, 0); } while (0)
    f32x4 S[8], wv[4];
#pragma unroll
    for (int t = 0; t < 8; ++t) S[t] = (f32x4){0.f, 0.f, 0.f, 0.f};
    DN_STAGE(0, 0);
#pragma unroll
    for (int mt = 0; mt < 4; ++mt) wv[mt] = *(const f32x4*)(wvb + mt * 256);
    asm volatile("s_waitcnt vmcnt(0)" ::: "memory");
    __syncthreads();
    for (int n = 0; n < NCHUNK; ++n) {
        const int buf = n & 1;
        if (n + 1 < NCHUNK) DN_STAGE(n + 1, buf ^ 1);
        if (wave < 4) {
            const LAS unsigned char* fb = lds + buf * DNF_AB_UNIT + lane * 16;
            f32x4 u[4], o[4], wvn[4];
            if (n + 1 < NCHUNK) {
#pragma unroll
                for (int mt = 0; mt < 4; ++mt) wvn[mt] = *(const f32x4*)(wvb + (size_t)(n + 1) * (DNF_WV_UNIT / 4) + mt * 256);
            }
            const float cd = cdp[n];
            bf16x8 Sb[4];
#pragma unroll
            for (int kb = 0; kb < 4; ++kb) Sb[kb] = pack8(S[2 * kb], S[2 * kb + 1]);
#pragma unroll
            for (int mt = 0; mt < 4; ++mt) { u[mt] = wv[mt]; o[mt] = (f32x4){0.f, 0.f, 0.f, 0.f};
#pragma unroll
                for (int kb = 0; kb < 4; ++kb) {
                    u[mt] = __builtin_amdgcn_mfma_f32_16x16x32_bf16(*(const LAS bf16x8*)(fb + (FR_NWK + mt * 4 + kb) * 1024), Sb[kb], u[mt], 0, 0, 0);
                    o[mt] = __builtin_amdgcn_mfma_f32_16x16x32_bf16(*(const LAS bf16x8*)(fb + (FR_QD + mt * 4 + kb) * 1024), Sb[kb], o[mt], 0, 0, 0); } }
            bf16x8 Ub[2];
#pragma unroll
            for (int tb = 0; tb < 2; ++tb) Ub[tb] = pack8(u[2 * tb], u[2 * tb + 1]);
#pragma unroll
            for (int kt = 0; kt < 8; ++kt) { S[kt] = S[kt] * cd;
#pragma unroll
                for (int tb = 0; tb < 2; ++tb) S[kt] = __builtin_amdgcn_mfma_f32_16x16x32_bf16(*(const LAS bf16x8*)(fb + (FR_KTT + kt * 2 + tb) * 1024), Ub[tb], S[kt], 0, 0, 0); }
#pragma unroll
            for (int mt = 0; mt < 4; ++mt) {
#pragma unroll
                for (int tb = 0; tb < 2; ++tb) o[mt] = __builtin_amdgcn_mfma_f32_16x16x32_bf16(*(const LAS bf16x8*)(fb + (FR_QK + mt * 2 + tb) * 1024), Ub[tb], o[mt], 0, 0, 0);
                float* op = odn + (size_t)(b * SEQ + n * 64 + 16 * mt + 4 * g4) * 512 + h * 128 + v0 + r16;
#pragma unroll
                for (int i = 0; i < 4; ++i) op[(size_t)i * 512] = o[mt][i]; }
            if (n + 1 < NCHUNK) {
#pragma unroll
                for (int mt = 0; mt < 4; ++mt) wv[mt] = wvn[mt];
            }
        }
        asm volatile("s_waitcnt vmcnt(0)" ::: "memory");
        __syncthreads();
    }
    if (wave < 4) {
        float* so = p.out + O_PSSM + (size_t)bh * 128 * 128 + v0 + r16;
#pragma unroll
        for (int kt = 0; kt < 8; ++kt)
#pragma unroll
            for (int i = 0; i < 4; ++i) so[(size_t)(16 * kt + 4 * g4 + i) * 128] = S[kt][i];
    }
}
__device__ __forceinline__ void phase_dngate(const P& p) {
    const int tid_ = otid(), lane = tid_ & 63, wave = tid_ >> 6;
    const int gw = blockIdx.x * NWAVES + wave, NGW = gridDim.x * NWAVES;
    const f32x4 nw0 = *(const f32x4*)(p.dn_norm_w + (lane & 15) * 8), nw1 = *(const f32x4*)(p.dn_norm_w + (lane & 15) * 8 + 4);
    for (int m = gw; m < TP; m += NGW) {
        const float* o = p.out + O_ODN + (size_t)m * 512 + lane * 8;
        const f32x4 a = *(const f32x4*)o, c = *(const f32x4*)(o + 4);
        float ss = (a[0] * a[0] + a[1] * a[1]) + (a[2] * a[2] + a[3] * a[3]) + (c[0] * c[0] + c[1] * c[1]) + (c[2] * c[2] + c[3] * c[3]);
#pragma unroll
        for (int off = 1; off < 16; off <<= 1) ss += __shfl_xor(ss, off);
        const float rstd = 1.0f / sqrtf(ss * (1.0f / 128.0f) + EPS);
        const u32x4 z = *(const u32x4*)(ws_h(p, WS_PROJ) + (size_t)m * PLD + PC_Z + lane * 8);
        const unsigned zw[4] = {z.x, z.y, z.z, z.w}; const float ov[8] = {a[0], a[1], a[2], a[3], c[0], c[1], c[2], c[3]}; const float nwv[8] = {nw0[0], nw0[1], nw0[2], nw0[3], nw1[0], nw1[1], nw1[2], nw1[3]};
        unsigned r[4];
#pragma unroll
        for (int e = 0; e < 4; ++e) { const float z0 = __builtin_bit_cast(float, zw[e] << 16), z1 = __builtin_bit_cast(float, zw[e] & 0xffff0000u);
            r[e] = pk2(ov[2 * e] * rstd * nwv[2 * e] * silu_f(z0), ov[2 * e + 1] * rstd * nwv[2 * e + 1] * silu_f(z1)); }
        *(u32x4*)(ws_h(p, WS_MIX) + (size_t)m * 1024 + lane * 8) = (u32x4){r[0], r[1], r[2], r[3]};
    }
}
__device__ __forceinline__ void phase_dnsample(const P& p, LAS unsigned char* lds) {
    const int tid = otid(), lane = tid & 63, us = tid >> 8, w4 = (tid >> 6) & 3, kh = lane >> 5, col_ = w4 * 32 + (lane & 31);
    LAS float* QH = (LAS float*)lds + us * 4352;
    LAS float* KH = QH + 1024; LAS float* VH = QH + 2048; LAS float* OH = QH + 3072; LAS float* RED = QH + 4096;
    const bf16_t* PR = ws_h(p, WS_PROJ); const float* BG = ws_f(p, WS_BG);
    for (int ub = blockIdx.x; ub < DEC_BATCH * 2; ub += gridDim.x) {
        const int uidx = ub * 2 + us, b = uidx >> 2, h = uidx & 3, m0 = TP + b * DEC_SEQ;
        int col = col_; asm volatile("" : "+v"(col));
        {
            float x0[11], x1[11];
            const int ch0 = kh * 512 + h * 128 + col;
#pragma unroll
            for (int rr = 0; rr < 11; ++rr) {
                if (rr < 3) { const float* st = p.state_dn_conv + ((size_t)b * 3 + rr) * 1536; x0[rr] = st[ch0]; x1[rr] = st[1024 + h * 128 + col]; }
                else { const bf16_t* pr = PR + (size_t)(m0 + rr - 3) * PLD; x0[rr] = bf2f(pr[ch0]); x1[rr] = bf2f(pr[1024 + h * 128 + col]); } }
            float w0[4], w1[4];
#pragma unroll
            for (int j = 0; j < 4; ++j) { w0[j] = p.dn_conv_w[j * 1536 + ch0]; w1[j] = p.dn_conv_w[j * 1536 + 1024 + h * 128 + col]; }
#pragma unroll
            for (int t = 0; t < 8; ++t) { float a = 0.f, d = 0.f;
#pragma unroll
                for (int j = 0; j < 4; ++j) { a += w0[j] * x0[t + j]; d += w1[j] * x1[t + j]; }
                a = silu_f(a); d = silu_f(d);
                if (kh == 0) { QH[t * 128 + col] = a; VH[t * 128 + col] = d; } else KH[t * 128 + col] = a;
                const float sq = wave_sum(kh == 0 ? a * a : 0.f), sk = wave_sum(kh == 1 ? a * a : 0.f);
                if (lane == 0) { RED[w4 * 16 + t] = sq; RED[w4 * 16 + 8 + t] = sk; } }
        }
        __syncthreads();
#pragma unroll
        for (int t = 0; t < 8; ++t) {
            if (kh == 0) { const float sq = (RED[t] + RED[16 + t]) + (RED[32 + t] + RED[48 + t]); QH[t * 128 + col] *= 0.08838834764831845f / sqrtf(sq + EPS); }
            else { const float sk = (RED[8 + t] + RED[24 + t]) + (RED[40 + t] + RED[56 + t]); KH[t * 128 + col] *= 1.0f / sqrtf(sk + EPS); } }
        __syncthreads();
        float S[64];
        const float* S0 = p.state_dn_ssm + ((size_t)b * 4 + h) * 128 * 128 + (size_t)kh * 64 * 128 + col;
#pragma unroll
        for (int k = 0; k < 64; ++k) { S[k] = *S0; S0 += 128; if ((k & 7) == 7) asm volatile("" : "+v"(S0)); }
#pragma unroll 1
        for (int t = 0; t < 8; ++t) {
            const float beta = BG[(size_t)(m0 + t) * 8 + h], eg = expf(BG[(size_t)(m0 + t) * 8 + 4 + h]);
            const LAS float* kp = KH + t * 128 + kh * 64; const LAS float* qp = QH + t * 128 + kh * 64;
            float kS = 0.f;
#pragma unroll
            for (int k4 = 0; k4 < 16; ++k4) { const f32x4 kk = *(const LAS f32x4*)(kp + 4 * k4);
#pragma unroll
                for (int e = 0; e < 4; ++e) { S[4 * k4 + e] *= eg; kS += kk[e] * S[4 * k4 + e]; } }
            kS += __shfl_xor(kS, 32);
            const float u = beta * (VH[t * 128 + col] - kS);
            float o = 0.f;
#pragma unroll
            for (int k4 = 0; k4 < 16; ++k4) { const f32x4 kk = *(const LAS f32x4*)(kp + 4 * k4), qq = *(const LAS f32x4*)(qp + 4 * k4);
#pragma unroll
                for (int e = 0; e < 4; ++e) { S[4 * k4 + e] += kk[e] * u; o += qq[e] * S[4 * k4 + e]; } }
            o += __shfl_xor(o, 32);
            if (kh == 0) OH[t * 128 + col] = o;
        }
        float* So = p.out + O_SSSM + ((size_t)b * 4 + h) * 128 * 128 + (size_t)kh * 64 * 128 + col;
#pragma unroll
        for (int k = 0; k < 64; ++k) { *So = S[k]; So += 128; if ((k & 7) == 7) asm volatile("" : "+v"(So)); }
        __syncthreads();
#pragma unroll
        for (int t = 0; t < 8; ++t) { const float o = kh == 0 ? OH[t * 128 + col] : 0.f; const float s = wave_sum(o * o); if (lane == 0) RED[w4 * 16 + t] = s; }
        __syncthreads();
        if (kh == 0) {
            const float nw = p.dn_norm_w[col];
#pragma unroll
            for (int t = 0; t < 8; ++t) { const float rstd = 1.0f / sqrtf(((RED[t] + RED[16 + t]) + (RED[32 + t] + RED[48 + t])) * (1.0f / 128.0f) + EPS);
                const float z = bf2f(PR[(size_t)(m0 + t) * PLD + PC_Z + h * 128 + col]);
                ws_h(p, WS_MIX)[(size_t)(m0 + t) * 1024 + h * 128 + col] = f2bf(OH[t * 128 + col] * rstd * nw * silu_f(z)); }
        }
        __syncthreads();
    }
}
constexpr size_t WS_EDGE = WS_FREE;
constexpr size_t WS_HEAD = al256(WS_EDGE + (size_t)(T / 256) * 2 * 2 * DFF * 4);
constexpr size_t WS_END = al256(WS_HEAD + (size_t)(T / 256) * 2 * 2 * DFF * 4);
constexpr int EX_OFF = 131072;
namespace pg8 {
typedef unsigned u32x2v __attribute__((ext_vector_type(2)));
__device__ __forceinline__ float dpp_shr1(float old, float src) { return __builtin_bit_cast(float, __builtin_amdgcn_update_dpp(__builtin_bit_cast(int, old), __builtin_bit_cast(int, src), 0x111, 0xf, 0xf, false)); }
__device__ __forceinline__ float dpp_shr2(float old, float src) { return __builtin_bit_cast(float, __builtin_amdgcn_update_dpp(__builtin_bit_cast(int, old), __builtin_bit_cast(int, src), 0x112, 0xf, 0xf, false)); }
__device__ __forceinline__ float dpp_ror1(float src) { return __builtin_bit_cast(float, __builtin_amdgcn_update_dpp(0, __builtin_bit_cast(int, src), 0x121, 0xf, 0xf, false)); }
__device__ __forceinline__ float dpp_ror2(float src) { return __builtin_bit_cast(float, __builtin_amdgcn_update_dpp(0, __builtin_bit_cast(int, src), 0x122, 0xf, 0xf, false)); }
struct EpiFfnUp {
    static constexpr bool PERM = false, AFTER_DRAIN = false;
    bf16_t* ACT; float* edge; float* head; const float* cw; const float* cb; const float* state; float* out_pfc; float* out_sfc; PG8_LAS unsigned char* lds;
    __device__ __forceinline__ void operator()(const f32x4 (&acc)[2][2][4][2], const Unit& u, int wr, int wc, int fr, int fq) const {
        PG8_LAS float* EX = (PG8_LAS float*)(lds + EX_OFF);
        const bool smp = u.pm >= TP / BM;
        const int cl = wc * 32 + 4 * fq;
        if (fr >= 14) {
#pragma unroll
            for (int ai = 0; ai < 2; ++ai)
#pragma unroll
                for (int bj = 0; bj < 2; ++bj)
#pragma unroll
                    for (int n = 0; n < 2; ++n) *(PG8_LAS f32x4*)(EX + ((2 * ai + wr) * 2 + (fr - 14)) * 256 + bj * HALF + cl + 16 * n) = acc[ai][bj][3][n];
            if (wr == 1) {
#pragma unroll
                for (int bj = 0; bj < 2; ++bj)
#pragma unroll
                    for (int n = 0; n < 2; ++n) { const int oc = bj * DFF + u.pn * HALF + cl + 16 * n;
                        *(f32x4*)(edge + ((size_t)u.pm * 2 + (fr - 14)) * 2 * DFF + oc) = acc[1][bj][3][n];
                        if (!smp && (u.pm & (SEQ / BM - 1)) == SEQ / BM - 1) *(f32x4*)(out_pfc + ((size_t)(u.pm / (SEQ / BM)) * 2 + (fr - 14)) * 2 * DFF + oc) = acc[1][bj][3][n]; }
            }
        }
        if (fr < 2 && wr == 0) {
#pragma unroll
            for (int bj = 0; bj < 2; ++bj)
#pragma unroll
                for (int n = 0; n < 2; ++n) *(f32x4*)(head + ((size_t)u.pm * 2 + fr) * 2 * DFF + bj * DFF + u.pn * HALF + cl + 16 * n) = acc[0][bj][0][n];
        }
        asm volatile("s_waitcnt lgkmcnt(0)" ::: "memory"); __builtin_amdgcn_s_barrier(); asm volatile("" ::: "memory");
#pragma unroll
        for (int n = 0; n < 2; ++n) {
            const int f0 = u.pn * HALF + cl + 16 * n;
            f32x4 wg[3], wu[3], bg, bu;
#pragma unroll
            for (int j = 0; j < 3; ++j) { wg[j] = *(const f32x4*)(cw + (size_t)j * 2 * DFF + f0); wu[j] = *(const f32x4*)(cw + (size_t)j * 2 * DFF + DFF + f0); }
            bg = *(const f32x4*)(cb + f0); bu = *(const f32x4*)(cb + DFF + f0);
#pragma unroll
            for (int ai = 0; ai < 2; ++ai) {
                const int s = 2 * ai + wr;
                f32x4 pg = (f32x4){0.f, 0.f, 0.f, 0.f}, pu = pg;
                if (!smp && s > 0 && fr >= 14) { pg = *(const PG8_LAS f32x4*)(EX + ((s - 1) * 2 + (fr - 14)) * 256 + cl + 16 * n); pu = *(const PG8_LAS f32x4*)(EX + ((s - 1) * 2 + (fr - 14)) * 256 + HALF + cl + 16 * n); }
#pragma unroll
                for (int m = 0; m < 4; ++m) {
                    const f32x4 cg = acc[ai][0][m][n], cu = acc[ai][1][m][n];
                    const int row = u.pm * BM + ai * HALF + wr * 64 + m * 16 + fr;
                    f32x4 g1, g2, u1, u2;
#pragma unroll
                    for (int e = 0; e < 4; ++e) { g1[e] = dpp_shr1(dpp_ror1(pg[e]), cg[e]); g2[e] = dpp_shr2(dpp_ror2(pg[e]), cg[e]); u1[e] = dpp_shr1(dpp_ror1(pu[e]), cu[e]); u2[e] = dpp_shr2(dpp_ror2(pu[e]), cu[e]); }
                    if (smp) {
                        const int t = fr & 7, b = (row - TP) >> 3;
                        if (t < 2) { const float* st = state + (size_t)b * 2 * 2 * DFF + f0; const f32x4 s1g = *(const f32x4*)(st + 2 * DFF), s1u = *(const f32x4*)(st + 2 * DFF + DFF);
                            if (t == 0) { g1 = s1g; u1 = s1u; g2 = *(const f32x4*)st; u2 = *(const f32x4*)(st + DFF); } else { g2 = s1g; u2 = s1u; } }
                        if (t >= 6) { float* o = out_sfc + ((size_t)b * 2 + (t - 6)) * 2 * DFF + f0; *(f32x4*)o = cg; *(f32x4*)(o + DFF) = cu; }
                    }
                    const f32x4 gc = wg[0] * g2 + wg[1] * g1 + wg[2] * cg + bg, uc = wu[0] * u2 + wu[1] * u1 + wu[2] * cu + bu;
                    u32x2v w;
                    { const float a0 = gc[0] / (1.0f + __expf(-gc[0])) * uc[0], a1 = gc[1] / (1.0f + __expf(-gc[1])) * uc[1], a2 = gc[2] / (1.0f + __expf(-gc[2])) * uc[2], a3 = gc[3] / (1.0f + __expf(-gc[3])) * uc[3];
                      w.x = cvt_pk_bf16(a0, a1); w.y = cvt_pk_bf16(a2, a3); }
                    *(u32x2v*)(ACT + (size_t)row * DFF + f0) = w;
                    pg = cg; pu = cu;
                }
            }
        }
    }
};
}
__device__ __forceinline__ void phase_ffn_fix(const P& p) {
    constexpr int TPS = SEQ / 256;
    const long n = (long)(BATCH * TPS) * DFF;
    const float* edge = ws_f(p, WS_EDGE); const float* head = ws_f(p, WS_HEAD);
    for (long i = blockIdx.x * (long)NTHR + otid(); i < n; i += (long)gridDim.x * NTHR) {
        const int pm = (int)(i / DFF), f = (int)(i % DFF);
        if (pm % TPS == 0) continue;
        float r0[2], r1[2];
#pragma unroll
        for (int gu = 0; gu < 2; ++gu) { const int c = gu * DFF + f;
            const float um2 = edge[((size_t)(pm - 1) * 2 + 0) * 2 * DFF + c], um1 = edge[((size_t)(pm - 1) * 2 + 1) * 2 * DFF + c], u0 = head[((size_t)pm * 2 + 0) * 2 * DFF + c], u1 = head[((size_t)pm * 2 + 1) * 2 * DFF + c];
            const float w0 = p.ffn_conv_w[c], w1 = p.ffn_conv_w[2 * DFF + c], w2 = p.ffn_conv_w[4 * DFF + c], bb = p.ffn_conv_b[c];
            r0[gu] = w0 * um2 + w1 * um1 + w2 * u0 + bb; r1[gu] = w0 * um1 + w1 * u0 + w2 * u1 + bb; }
        bf16_t* ACT = ws_h(p, WS_ACT) + (size_t)pm * 256 * DFF + f;
        ACT[0] = f2bf(silu_f(r0[0]) * r0[1]); ACT[DFF] = f2bf(silu_f(r1[0]) * r1[1]);
    }
}
constexpr int SW_KP = 72;
__device__ __forceinline__ void swa_qtile(const LAS bf16_t* KS, const LAS bf16_t* VT, int vtp, int qt, const bf16_t* qptr, int qrow_mask, const LAS float* BT, float sink, bool first, bf16_t* optr, int nvalid_q, int lane) {
    const int r16 = lane & 15, g4 = lane >> 4, kt0 = qt;
    bf16x8 bq[2];
#pragma unroll
    for (int ks = 0; ks < 2; ++ks) bq[ks] = *(const bf16x8*)(qptr + (size_t)(r16 & qrow_mask) * PLD + 32 * ks + 8 * g4);
    f32x4 s[10];
#pragma unroll
    for (int t = 0; t < 9; ++t) { f32x4 a = (f32x4){0.f, 0.f, 0.f, 0.f};
#pragma unroll
        for (int ks = 0; ks < 2; ++ks) a = __builtin_amdgcn_mfma_f32_16x16x32_bf16(*(const LAS bf16x8*)(KS + (16 * (kt0 + t) + r16) * SW_KP + 32 * ks + 8 * g4), bq[ks], a, 0, 0, 0);
        s[t] = a; }
    float mx = sink;
#pragma unroll
    for (int t = 0; t < 9; ++t)
#pragma unroll
        for (int e = 0; e < 4; ++e) { const int jj = 16 * (kt0 + t) + 4 * g4 + e, d = 128 + 16 * qt + r16 - jj; const bool ok = d >= 0 && d <= 127 && !(first && jj < 128);
            const float v = ok ? s[t][e] * 0.125f + BT[ok ? d : 0] : -1e30f; s[t][e] = v; mx = fmaxf(mx, v); }
    mx = fmaxf(mx, __shfl_xor(mx, 16)); mx = fmaxf(mx, __shfl_xor(mx, 32));
    float l = 0.f;
#pragma unroll
    for (int t = 0; t < 9; ++t)
#pragma unroll
        for (int e = 0; e < 4; ++e) { const float pv = __expf(s[t][e] - mx); s[t][e] = pv; l += pv; }
    s[9] = (f32x4){0.f, 0.f, 0.f, 0.f};
    l += __shfl_xor(l, 16); l += __shfl_xor(l, 32);
    l += __expf(sink - mx);
    const float rl = 1.0f / l;
    bf16x8 pb[5];
#pragma unroll
    for (int q = 0; q < 5; ++q) pb[q] = pack8(s[2 * q], s[2 * q + 1]);
#pragma unroll
    for (int dt = 0; dt < 4; ++dt) { f32x4 o = (f32x4){0.f, 0.f, 0.f, 0.f};
#pragma unroll
        for (int q = 0; q < 5; ++q) { const LAS bf16_t* vp = VT + (16 * dt + r16) * vtp + 16 * (kt0 + 2 * q) + 4 * g4;
            const u32x2 lo = *(const LAS u32x2*)vp, hi = *(const LAS u32x2*)(vp + 16);
            o = __builtin_amdgcn_mfma_f32_16x16x32_bf16(__builtin_bit_cast(bf16x8, (u32x4){lo.x, lo.y, hi.x, hi.y}), pb[q], o, 0, 0, 0); }
        if (r16 < nvalid_q) *(u32x2*)(optr + (size_t)r16 * 1024 + 16 * dt + 4 * g4) = (u32x2){cvtpk_c(o[0] * rl, o[1] * rl), cvtpk_c(o[2] * rl, o[3] * rl)}; }
}
constexpr int SWP_VTP = 272, SWS_NK = 144, SWS_VTP = 168;
constexpr int SW_KS = 0, SW_VT = 43008, SW_BT = 86016, SW_END = SW_BT + 8 * 128 * 4;
static_assert(256 * SW_KP * 2 <= SW_VT && SW_VT + 64 * SWP_VTP * 2 <= SW_BT && 2 * SWS_NK * SW_KP * 2 <= SW_VT && SW_VT + 2 * 64 * SWS_VTP * 2 <= SW_BT, "swa LDS map");
__device__ __forceinline__ void phase_swa(const P& p, LAS unsigned char* lds) {
    const int tid = otid(), lane = tid & 63, wave = tid >> 6;
    LAS bf16_t* KS = (LAS bf16_t*)(lds + SW_KS); LAS bf16_t* VT = (LAS bf16_t*)(lds + SW_VT); LAS float* BT = (LAS float*)(lds + SW_BT);
    const bf16_t* PR = ws_h(p, WS_PROJ); bf16_t* MX = ws_h(p, WS_MIX);
    constexpr int NQB = SEQ / 128, NPU = BATCH * NQB * 2, NU = NPU + DEC_BATCH;
    for (int i = tid; i < 8 * 128; i += NTHR) BT[i] = p.rel_bias[t5_bucket(i & 127) * 8 + (i >> 7)];
    for (int u = blockIdx.x; u < NU; u += gridDim.x) {
        __syncthreads();
        if (u < NPU) {
            const int kvh = u & 1, qb = (u >> 1) % NQB, b = (u >> 1) / NQB, m0 = b * SEQ + qb * 128; const bool first = qb == 0;
            for (int it = tid; it < 256 * 8; it += NTHR) { const int jj = it >> 3, c = it & 7; u32x4 v = (u32x4){0u, 0u, 0u, 0u};
                if (!(first && jj < 128)) v = *(const u32x4*)(PR + (size_t)(m0 - 128 + jj) * PLD + PC_SK + kvh * 64 + 8 * c);
                *(LAS u32x4*)(KS + jj * SW_KP + 8 * c) = v; }
            for (int it = tid; it < 272 * 8; it += NTHR) { const int jj = it % 272, c = it / 272; u32x4 v = (u32x4){0u, 0u, 0u, 0u};
                if (jj < 256 && !(first && jj < 128)) v = *(const u32x4*)(PR + (size_t)(m0 - 128 + jj) * PLD + PC_SV + kvh * 64 + 8 * c);
                const unsigned w[4] = {v.x, v.y, v.z, v.w};
#pragma unroll
                for (int e = 0; e < 4; ++e) { VT[(8 * c + 2 * e) * SWP_VTP + jj] = (bf16_t)(w[e] & 0xffffu); VT[(8 * c + 2 * e + 1) * SWP_VTP + jj] = (bf16_t)(w[e] >> 16); } }
            __syncthreads();
            const int hq = kvh * 4 + (wave >> 1), qh = wave & 1;
#pragma unroll 1
            for (int q4 = 0; q4 < 4; ++q4) { const int qt = 4 * qh + q4;
                swa_qtile(KS, VT, SWP_VTP, qt, PR + (size_t)(m0 + 16 * qt) * PLD + PC_SQ + hq * 64, 15, BT + hq * 128, p.swa_sinks[hq], first, MX + (size_t)(m0 + 16 * qt) * 1024 + 512 + hq * 64, 16, lane); }
        } else {
            const int b = u - NPU, m0 = TP + b * DEC_SEQ;
            for (int it = tid; it < 2 * SWS_NK * 8; it += NTHR) { const int kvh = it / (SWS_NK * 8), r = it % (SWS_NK * 8), jj = r >> 3, c = r & 7; u32x4 v = (u32x4){0u, 0u, 0u, 0u};
                if (jj < 128) { const float* src = p.cache_k + ((size_t)b * 128 + jj) * 128 + kvh * 64 + 8 * c; const f32x4 a = *(const f32x4*)src, d = *(const f32x4*)(src + 4);
                    v = (u32x4){pk2(a[0], a[1]), pk2(a[2], a[3]), pk2(d[0], d[1]), pk2(d[2], d[3])}; }
                else if (jj < 128 + DEC_SEQ) v = *(const u32x4*)(PR + (size_t)(m0 + jj - 128) * PLD + PC_SK + kvh * 64 + 8 * c);
                *(LAS u32x4*)(KS + (kvh * SWS_NK + jj) * SW_KP + 8 * c) = v; }
            for (int it = tid; it < 2 * SWS_VTP * 8; it += NTHR) { const int kvh = it / (SWS_VTP * 8), r = it % (SWS_VTP * 8), jj = r % SWS_VTP, c = r / SWS_VTP; float f[8];
#pragma unroll
                for (int e = 0; e < 8; ++e) f[e] = 0.f;
                if (jj < 128) { const float* src = p.cache_v + ((size_t)b * 128 + jj) * 128 + kvh * 64 + 8 * c; const f32x4 a = *(const f32x4*)src, d = *(const f32x4*)(src + 4);
                    f[0] = a[0]; f[1] = a[1]; f[2] = a[2]; f[3] = a[3]; f[4] = d[0]; f[5] = d[1]; f[6] = d[2]; f[7] = d[3]; }
                else if (jj < 128 + DEC_SEQ) { const bf16_t* src = PR + (size_t)(m0 + jj - 128) * PLD + PC_SV + kvh * 64 + 8 * c;
#pragma unroll
                    for (int e = 0; e < 8; ++e) f[e] = bf2f(src[e]); }
#pragma unroll
                for (int e = 0; e < 8; ++e) VT[(kvh * 64 + 8 * c + e) * SWS_VTP + jj] = f2bf(f[e]); }
            __syncthreads();
            const int kvh = wave >> 2, hq = kvh * 4 + (wave & 3);
            swa_qtile(KS + kvh * SWS_NK * SW_KP, VT + kvh * 64 * SWS_VTP, SWS_VTP, 0, PR + (size_t)m0 * PLD + PC_SQ + hq * 64, 7, BT + hq * 128, p.swa_sinks[hq], false, MX + (size_t)m0 * 1024 + 512 + hq * 64, 8, lane);
        }
    }
    __syncthreads();
}
static void fill_params(P& p, void* const* d_in, void* d_out, void* d_ws) {
    const float** pp = (const float**)&p;
    for (int i = 0; i < 26; ++i) pp[i] = (const float*)d_in[i];
    p.out = (float*)d_out; p.ws = (unsigned char*)d_ws;
}
namespace cg = cooperative_groups;
constexpr int CW_BAR = 1024;
constexpr size_t CTL_ZERO_BYTES = 65536;

#ifndef PROBE_MASK
#define PROBE_MASK 0
#endif
#ifndef PROBE_K
#define PROBE_K 4
#endif
#ifndef PROBE_XSYNC
#define PROBE_XSYNC 0
#endif
#if PROBE_MASK
#define PROBE_DECL unsigned long long pr_prev = __builtin_amdgcn_s_memrealtime(), pr_acc = 0ull
#define PROBE_STAMP(k) do { const unsigned long long now_ = __builtin_amdgcn_s_memrealtime(); if ((PROBE_MASK >> (k)) & 1) pr_acc += now_ - pr_prev; pr_prev = now_; } while (0)
#define PROBE_END() do { xcd_barrier(bar); PROBE_STAMP(11); if (blockIdx.x == 0 && threadIdx.x == 0) { const unsigned long long t0_ = __builtin_amdgcn_s_memrealtime(); while (__builtin_amdgcn_s_memrealtime() - t0_ < (unsigned long long)PROBE_K * pr_acc) __builtin_amdgcn_s_sleep(8); } } while (0)
#else
#define PROBE_DECL
#define PROBE_STAMP(k)
#define PROBE_END() do { for (int i_ = 0; i_ < PROBE_XSYNC; ++i_) xcd_barrier(bar); } while (0)
#endif
__global__ void __launch_bounds__(512, 2) fwd_megakernel(P p) {
    extern __shared__ __attribute__((aligned(16))) unsigned char lds_raw[];
    LAS unsigned char* lds = (LAS unsigned char*)lds_raw;
    cg::grid_group grid = cg::this_grid();
    PROBE_DECL;
    volatile LAS unsigned* MISC = (volatile LAS unsigned*)(lds + LDS_BYTES - 64);
    if (threadIdx.x < 16) MISC[threadIdx.x] = 0u;
    __syncthreads();
    const XcdBarrier bar = xcd_barrier_post((unsigned*)(p.ws + WS_CTL) + CW_BAR, MISC);
    phase_mod(p, lds); phase_transposes(p, lds);
    grid.sync(); PROBE_STAMP(0);
    phase_norm<0>(p);
    xcd_barrier(bar); PROBE_STAMP(1);
    { pg8::StaticOrder S; pg8::Gemm g{ws_h(p, WS_H), ws_h(p, WS_WT_IN), T, PLD, D}; S.init(T, PLD, gridDim.x, blockIdx.x); pg8::EpiStoreBf16 E{ws_h(p, WS_PROJ), PLD};
      pg8::gemm_phase<pg8::EpiStoreBf16, pg8::StaticOrder, true, true>(lds, g, S, E); }
    xcd_barrier(bar); PROBE_STAMP(2);
    for (long i = blockIdx.x * (long)NTHR + otid(); i < N_R2B; i += (long)gridDim.x * NTHR) r2b_body(i, p);
    phase_dnprep(p, lds);
    phase_dnsample(p, lds);
    phase_swa(p, lds);
    xcd_barrier(bar); PROBE_STAMP(3);
    phase_dnscan(p, lds);
    xcd_barrier(bar); PROBE_STAMP(4);
    phase_dngate(p);
    xcd_barrier(bar); PROBE_STAMP(5);
    { pg8::StaticOrder S; pg8::Gemm g{ws_h(p, WS_MIX), ws_h(p, WS_WT_OUT), T, D, 1024}; S.init(T, D, gridDim.x, blockIdx.x); pg8::EpiGateRes E{p.x_prompt, p.x_sample, p.out + O_Y, ws_f(p, WS_MOD) + 2 * D};
      pg8::gemm_phase<pg8::EpiGateRes, pg8::StaticOrder, true, true>(lds, g, S, E); }
    xcd_barrier(bar); PROBE_STAMP(6);
    phase_norm<1>(p);
    xcd_barrier(bar); PROBE_STAMP(7);
    { pg8::StaticOrder S; pg8::Gemm g{ws_h(p, WS_H), ws_h(p, WS_WT_UP), T, 2 * DFF, D}; S.init(T, 2 * DFF, gridDim.x, blockIdx.x);
      pg8::EpiFfnUp E{ws_h(p, WS_ACT), ws_f(p, WS_EDGE), ws_f(p, WS_HEAD), p.ffn_conv_w, p.ffn_conv_b, p.state_ffn, p.out + O_PFC, p.out + O_SFC, lds};
      pg8::gemm_phase<pg8::EpiFfnUp, pg8::StaticOrder, true, true>(lds, g, S, E); }
    xcd_barrier(bar); PROBE_STAMP(8);
    phase_ffn_fix(p);
    xcd_barrier(bar); PROBE_STAMP(9);
    { pg8::StaticOrder S; pg8::Gemm g{ws_h(p, WS_ACT), ws_h(p, WS_WT_DN), T, D, DFF}; S.init(T, D, gridDim.x, blockIdx.x); pg8::EpiGateRes E{p.out + O_Y, p.out + O_Y + (size_t)TP * D, p.out + O_Y, ws_f(p, WS_MOD) + 5 * D};
      pg8::gemm_phase<pg8::EpiGateRes, pg8::StaticOrder, true, true>(lds, g, S, E); }
    xcd_barrier(bar); PROBE_STAMP(10);
    phase_norm<2>(p);
    PROBE_END();
}
extern "C" void kernel_launch(void* const* d_in, const int* in_sizes, int n_in, void* d_out, int out_size, void* d_ws, size_t ws_size, hipStream_t stream) {
    static int grid_blocks = 0;
    if (grid_blocks == 0) {
        if (n_in != 26 || (long)out_size != O_END || ws_size < WS_END) { fprintf(stderr, "kernel_launch: unexpected shapes n_in=%d out=%d ws=%zu (need %zu)\n", n_in, out_size, ws_size, (size_t)WS_END); grid_blocks = -1; return; }
        int dev = 0, cus = 0, per_cu = 0;
        if (hipGetDevice(&dev) != hipSuccess || hipDeviceGetAttribute(&cus, hipDeviceAttributeMultiprocessorCount, dev) != hipSuccess) { grid_blocks = -1; return; }
        if (hipFuncSetAttribute((const void*)fwd_megakernel, hipFuncAttributeMaxDynamicSharedMemorySize, LDS_BYTES) != hipSuccess) { fprintf(stderr, "kernel_launch: hipFuncSetAttribute failed\n"); grid_blocks = -1; return; }
        if (hipOccupancyMaxActiveBlocksPerMultiprocessor(&per_cu, (const void*)fwd_megakernel, NTHR, LDS_BYTES) != hipSuccess || per_cu < 1) { fprintf(stderr, "kernel_launch: occupancy query says %d\n", per_cu); grid_blocks = -1; return; }
        grid_blocks = cus;
        fprintf(stderr, "kernel_launch: grid %d (cus %d, per_cu %d)\n", grid_blocks, cus, per_cu);
    }
    if (grid_blocks < 0) return;
    P p{}; fill_params(p, d_in, d_out, d_ws);
    if (hipMemsetAsync((char*)d_ws + WS_CTL, 0, CTL_ZERO_BYTES, stream) != hipSuccess) { fprintf(stderr, "kernel_launch: memset of the control words failed\n"); return; }
    void* args[] = {&p};
    const hipError_t e = hipLaunchCooperativeKernel((const void*)fwd_megakernel, dim3(grid_blocks), dim3(NTHR), args, LDS_BYTES, stream);
    if (e != hipSuccess) fprintf(stderr, "cooperative launch failed: %s (grid %d)\n", hipGetErrorString(e), grid_blocks);
}
```

```cpp
#define PROBE_MASK 0
#define PROBE_XSYNC 0
#include <hip/hip_runtime.h>
#include <hip/hip_cooperative_groups.h>
#include <cstdio>
#include <cstdint>
#define HD __device__ __forceinline__
#if defined(PROBE_MASK) && PROBE_MASK
#define DPS(k) do { const unsigned long long now_ = __builtin_amdgcn_s_memrealtime(); if ((PROBE_MASK >> (k)) & 1) pr_acc += now_ - pr_prev; pr_prev = now_; } while (0)
#endif
#ifndef CFG_D_MODEL
#define CFG_D_MODEL 1024
#endif
#ifndef CFG_SEQ
#define CFG_SEQ 8192
#endif
#ifndef CFG_DEC_BATCH
#define CFG_DEC_BATCH 128
#endif
#ifndef CFG_D_FF
#define CFG_D_FF 2816
#endif

constexpr int D = CFG_D_MODEL, BATCH = 2, SEQ = CFG_SEQ, DEC_BATCH = CFG_DEC_BATCH, DEC_SEQ = 8, DFF = CFG_D_FF;
constexpr int TP = BATCH * SEQ, TS = DEC_BATCH * DEC_SEQ, T = TP + TS, NCB = BATCH + DEC_BATCH;
constexpr int IN_COLS = 2824, PLD = 2816;
constexpr int PC_QKV = 0, PC_Z = 1536, PC_SQ = 2048, PC_SK = 2560, PC_SV = 2688;
constexpr int WC_BA = 2048;
constexpr float EPS = 1e-6f;

constexpr long O_Y = 0;
constexpr long O_PDC = (long)T * D;
constexpr long O_SDC = O_PDC + (long)BATCH * 3 * 1536;
constexpr long O_PSSM = O_SDC + (long)DEC_BATCH * 3 * 1536;
constexpr long O_SSSM = O_PSSM + (long)BATCH * 4 * 128 * 128;
constexpr long O_PK = O_SSSM + (long)DEC_BATCH * 4 * 128 * 128;
constexpr long O_SK = O_PK + (long)BATCH * 128 * 128;
constexpr long O_PV = O_SK + (long)DEC_BATCH * 128 * 128;
constexpr long O_SV = O_PV + (long)BATCH * 128 * 128;
constexpr long O_PFC = O_SV + (long)DEC_BATCH * 128 * 128;
constexpr long O_SFC = O_PFC + (long)BATCH * 2 * 2 * DFF;
constexpr long O_END = O_SFC + (long)DEC_BATCH * 2 * 2 * DFF;

constexpr size_t al256(size_t x) { return (x + 255) & ~(size_t)255; }
constexpr size_t WS_CTL = 0;
constexpr size_t WS_MOD = 1u << 20;
constexpr size_t WS_BG = al256(WS_MOD + (size_t)NCB * 6 * D * 4);
constexpr size_t WS_WBAT = al256(WS_BG + (size_t)T * 8 * 4);
constexpr size_t WS_WT_IN = al256(WS_WBAT + (size_t)8 * D * 4);
constexpr size_t WS_WT_OUT = al256(WS_WT_IN + (size_t)PLD * D * 2);
constexpr size_t WS_WT_UP = al256(WS_WT_OUT + (size_t)D * 1024 * 2);
constexpr size_t WS_WT_DN = al256(WS_WT_UP + (size_t)2 * DFF * D * 2);
constexpr size_t WS_H = al256(WS_WT_DN + (size_t)D * DFF * 2);
constexpr int NCHUNK = SEQ / 64, NUNIT = BATCH * 4 * NCHUNK;
constexpr int DNF_AB_UNIT = 57344, DNF_WV_UNIT = 32768;
constexpr size_t WS_DNF_WV = WS_H;
constexpr size_t WS_DNF_AB = al256(WS_H + (size_t)T * (D > 1024 ? D : 1024) * 2);
constexpr size_t WS_DNF_CD = al256(WS_DNF_AB + (size_t)NUNIT * DNF_AB_UNIT);
constexpr size_t WS_QKVC = WS_DNF_AB;
constexpr size_t WS_PROJ = al256((WS_DNF_CD + (size_t)NUNIT * 4) > (WS_QKVC + (size_t)T * 1536 * 2) ? (WS_DNF_CD + (size_t)NUNIT * 4) : (WS_QKVC + (size_t)T * 1536 * 2));
constexpr size_t WS_MIX = al256(WS_PROJ + (size_t)T * PLD * 2);
constexpr size_t WS_FREE = al256(WS_MIX + (size_t)T * 1024 * 2);
constexpr size_t WS_ODN = WS_H, WS_ACT = WS_PROJ;
static_assert((size_t)NUNIT * DNF_WV_UNIT <= (size_t)T * 1024 * 2, "Wv tiles overlay H");

typedef unsigned short bf16_t;
HD unsigned f2bf_bits(float f) { unsigned u = __builtin_bit_cast(unsigned, f); return (u + 0x7fffu + ((u >> 16) & 1u)) >> 16; }
HD bf16_t f2bf(float f) { return (bf16_t)f2bf_bits(f); }
HD float bf2f(bf16_t b) { return __builtin_bit_cast(float, (unsigned)b << 16); }
HD float silu_f(float x) { return x / (1.0f + expf(-x)); }
HD float sigmoid_f(float x) { return 1.0f / (1.0f + expf(-x)); }
HD float softplus_f(float x) { return x > 20.f ? x : log1pf(expf(x)); }

struct P {
    const float *x_prompt, *x_sample, *state_dn_conv, *state_dn_ssm, *cache_k, *cache_v, *state_ffn, *c_prompt, *c_sample, *rel_bias,
        *final_norm_w, *w_ada, *b_ada, *norm_mix_w, *w_in, *dn_conv_w, *dn_A_log, *dn_dt_bias, *dn_norm_w, *swa_sinks, *w_out, *norm_ffn_w,
        *w_up, *ffn_conv_w, *ffn_conv_b, *w_down;
    float* out; unsigned char* ws;
};

HD const float* xrow(const P& p, int m) { return m < TP ? p.x_prompt + (size_t)m * D : p.x_sample + (size_t)(m - TP) * D; }
HD int cb_of(int m) { return m < TP ? m / SEQ : BATCH + (m - TP) / DEC_SEQ; }
HD int t_of(int m) { return m < TP ? m % SEQ : (m - TP) % DEC_SEQ; }
HD float* ws_f(const P& p, size_t off) { return (float*)(p.ws + off); }
HD bf16_t* ws_h(const P& p, size_t off) { return (bf16_t*)(p.ws + off); }

HD int t5_bucket(int d) {
    if (d < 16) return d;
    const float logv = logf((float)d / 16.0f) / 2.0794415416798357f;
    int b = 16 + (int)(logv * 16.0f);
    return b < 31 ? b : 31;
}

constexpr long N_R0A = (long)NCB * 6 * D;
HD void r0a_body(long idx, const P& p) {
    const int cb = (int)(idx / (6 * D)), e = (int)(idx % (6 * D));
    const float* c = cb < BATCH ? p.c_prompt + (size_t)cb * D : p.c_sample + (size_t)(cb - BATCH) * D;
    float acc = 0.f;
    for (int d = 0; d < D; ++d) acc += silu_f(c[d]) * p.w_ada[(size_t)d * 6 * D + e];
    ws_f(p, WS_MOD)[idx] = acc + p.b_ada[e];
}
constexpr long N_R1 = T;
template <int WHICH> HD void r1_body(long idx, const P& p) {
    const int m = (int)idx, cb = cb_of(m);
    const float* xr = WHICH == 0 ? xrow(p, m) : p.out + O_Y + (size_t)m * D;
    const float* nw = WHICH == 0 ? p.norm_mix_w : p.norm_ffn_w;
    const float* mod = ws_f(p, WS_MOD) + (size_t)cb * 6 * D;
    const float* sh = mod + (WHICH == 0 ? 0 : 3 * D); const float* sc = mod + (WHICH == 0 ? D : 4 * D);
    float ss = 0.f;
    for (int k = 0; k < D; ++k) ss += xr[k] * xr[k];
    const float rstd = 1.0f / sqrtf(ss / (float)D + EPS);
    float ba[8];
#pragma unroll
    for (int j = 0; j < 8; ++j) ba[j] = 0.f;
    bf16_t* H = ws_h(p, WS_H) + (size_t)m * D;
    for (int k = 0; k < D; ++k) {
        const float h = xr[k] * rstd * nw[k] * (1.0f + sc[k]) + sh[k];
        H[k] = f2bf(h);
        if (WHICH == 0) {
#pragma unroll
            for (int j = 0; j < 8; ++j) ba[j] += h * p.w_in[(size_t)k * IN_COLS + WC_BA + j];
        }
    }
    if (WHICH == 0) {
        float* bg = ws_f(p, WS_BG) + (size_t)m * 8;
#pragma unroll
        for (int j = 0; j < 4; ++j) {
            bg[j] = sigmoid_f(ba[j]);
            bg[4 + j] = -expf(p.dn_A_log[j]) * softplus_f(ba[4 + j] + p.dn_dt_bias[j]);
        }
    }
}
constexpr long N_R2 = (long)(T / 8) * PLD;
HD void r2_body(long idx, const P& p) {
    const int mg = (int)(idx / PLD), n = (int)(idx % PLD), oc = n < WC_BA ? n : n + 8;
    const bf16_t* H = ws_h(p, WS_H) + (size_t)mg * 8 * D;
    float acc[8];
#pragma unroll
    for (int i = 0; i < 8; ++i) acc[i] = 0.f;
    for (int k = 0; k < D; ++k) {
        const float w = bf2f(f2bf(p.w_in[(size_t)k * IN_COLS + oc]));
#pragma unroll
        for (int i = 0; i < 8; ++i) acc[i] += bf2f(H[(size_t)i * D + k]) * w;
    }
    bf16_t* PR = ws_h(p, WS_PROJ);
#pragma unroll
    for (int i = 0; i < 8; ++i) PR[(size_t)(mg * 8 + i) * PLD + n] = f2bf(acc[i]);
}
constexpr long N_R2B_1 = (long)BATCH * 3 * 1536, N_R2B_2 = (long)DEC_BATCH * 3 * 1536, N_R2B_3 = (long)BATCH * 128 * 128, N_R2B_4 = (long)DEC_BATCH * 128 * 128;
constexpr long N_R2B = N_R2B_1 + N_R2B_2 + 2 * (N_R2B_3 + N_R2B_4);
HD void r2b_body(long idx, const P& p) {
    const bf16_t* PR = ws_h(p, WS_PROJ);
    long r = idx;
    if (r < N_R2B_1) { const int b = (int)(r / (3 * 1536)), j = (int)(r / 1536 % 3), c = (int)(r % 1536);
        p.out[O_PDC + r] = bf2f(PR[(size_t)(b * SEQ + SEQ - 3 + j) * PLD + PC_QKV + c]); return; }
    r -= N_R2B_1;
    if (r < N_R2B_2) { const int b = (int)(r / (3 * 1536)), j = (int)(r / 1536 % 3), c = (int)(r % 1536);
        p.out[O_SDC + r] = bf2f(PR[(size_t)(TP + b * DEC_SEQ + DEC_SEQ - 3 + j) * PLD + PC_QKV + c]); return; }
    r -= N_R2B_2;
    for (int kv = 0; kv < 2; ++kv) {
        const int pc = kv == 0 ? PC_SK : PC_SV; const float* cache = kv == 0 ? p.cache_k : p.cache_v;
        if (r < N_R2B_3) { const int b = (int)(r / (128 * 128)), j = (int)(r / 128 % 128), c = (int)(r % 128);
            p.out[(kv == 0 ? O_PK : O_PV) + r] = bf2f(PR[(size_t)(b * SEQ + SEQ - 128 + j) * PLD + pc + c]); return; }
        r -= N_R2B_3;
        if (r < N_R2B_4) { const int b = (int)(r / (128 * 128)), j = (int)(r / 128 % 128), c = (int)(r % 128);
            float v;
            if (j < 128 - DEC_SEQ) v = cache[((size_t)b * 128 + j + DEC_SEQ) * 128 + c];
            else v = bf2f(PR[(size_t)(TP + b * DEC_SEQ + (j - (128 - DEC_SEQ))) * PLD + pc + c]);
            p.out[(kv == 0 ? O_SK : O_SV) + r] = v; return; }
        r -= N_R2B_4;
    }
}
constexpr long N_R3 = (long)T * 12;
HD float r3_conv(const P& p, int m, int t, int ch) {
    const bf16_t* PR = ws_h(p, WS_PROJ);
    float acc = 0.f;
#pragma unroll
    for (int j = 0; j < 4; ++j) {
        const int tt = t - 3 + j; float xv;
        if (tt >= 0) xv = bf2f(PR[(size_t)(m - (t - tt)) * PLD + PC_QKV + ch]);
        else xv = m < TP ? 0.f : p.state_dn_conv[((size_t)((m - TP) / DEC_SEQ) * 3 + (3 + tt)) * 1536 + ch];
        acc += p.dn_conv_w[j * 1536 + ch] * xv;
    }
    return silu_f(acc);
}
HD void r3_body(long idx, const P& p) {
    const int m = (int)(idx / 12), grp = (int)(idx % 12), part = grp / 4, cbase = grp * 128, t = t_of(m);
    float scale = 1.f;
    if (part < 2) {
        float ss = 0.f;
        for (int c = 0; c < 128; ++c) { const float v = r3_conv(p, m, t, cbase + c); ss += v * v; }
        scale = 1.0f / sqrtf(ss + EPS);
        if (part == 0) scale *= 0.08838834764831845f;
    }
    bf16_t* Q = ws_h(p, WS_QKVC) + (size_t)m * 1536 + cbase;
    for (int c = 0; c < 128; ++c) Q[c] = f2bf(r3_conv(p, m, t, cbase + c) * scale);
}
constexpr long N_R4 = (long)NCB * 4 * 128;
HD void r4_body(long idx, const P& p) {
    const int seq = (int)(idx / 512), h = (int)(idx / 128 % 4), v = (int)(idx % 128);
    const bool smp = seq >= BATCH; const int b = smp ? seq - BATCH : seq;
    float* S = p.out + (smp ? O_SSSM : O_PSSM) + ((size_t)b * 4 + h) * 128 * 128 + v;
    const float* S0 = smp ? p.state_dn_ssm + ((size_t)b * 4 + h) * 128 * 128 + v : nullptr;
    for (int k = 0; k < 128; ++k) S[(size_t)k * 128] = smp ? S0[(size_t)k * 128] : 0.f;
    const int L = smp ? DEC_SEQ : SEQ, m0 = smp ? TP + b * DEC_SEQ : b * SEQ;
    const bf16_t* QK = ws_h(p, WS_QKVC); const float* BG = ws_f(p, WS_BG); float* ODN = ws_f(p, WS_ODN);
    for (int t = 0; t < L; ++t) {
        const int m = m0 + t;
        const bf16_t* q = QK + (size_t)m * 1536 + h * 128; const bf16_t* kk = q + 512; const float vv = bf2f(q[1024 + v]);
        const float beta = BG[(size_t)m * 8 + h], eg = expf(BG[(size_t)m * 8 + 4 + h]);
        float kS = 0.f;
        for (int k = 0; k < 128; ++k) kS += bf2f(kk[k]) * (S[(size_t)k * 128] * eg);
        const float u = beta * (vv - kS);
        float o = 0.f;
        for (int k = 0; k < 128; ++k) { const float s = S[(size_t)k * 128] * eg + bf2f(kk[k]) * u; S[(size_t)k * 128] = s; o += bf2f(q[k]) * s; }
        ODN[(size_t)m * 512 + h * 128 + v] = o;
    }
}
constexpr long N_R5 = (long)T * 4;
HD void r5_body(long idx, const P& p) {
    const int m = (int)(idx / 4), h = (int)(idx % 4);
    const float* o = ws_f(p, WS_ODN) + (size_t)m * 512 + h * 128;
    float ss = 0.f;
    for (int v = 0; v < 128; ++v) ss += o[v] * o[v];
    const float rstd = 1.0f / sqrtf(ss / 128.0f + EPS);
    const bf16_t* z = ws_h(p, WS_PROJ) + (size_t)m * PLD + PC_Z + h * 128;
    bf16_t* mix = ws_h(p, WS_MIX) + (size_t)m * 1024 + h * 128;
    for (int v = 0; v < 128; ++v) mix[v] = f2bf(o[v] * rstd * p.dn_norm_w[v] * silu_f(bf2f(z[v])));
}
constexpr long N_R6 = (long)T * 8 * 8;
HD void r6_body(long idx, const P& p) {
    const int m = (int)(idx / 64), hq = (int)(idx / 8 % 8), dg = (int)(idx % 8), kvh = hq / 4, t = t_of(m);
    const bool smp = m >= TP; const int b = smp ? (m - TP) / DEC_SEQ : 0;
    const bf16_t* PR = ws_h(p, WS_PROJ);
    const bf16_t* q = PR + (size_t)m * PLD + PC_SQ + hq * 64;
    const float sink = p.swa_sinks[hq];
    const int nk = smp ? 128 : (t < 127 ? t + 1 : 128);
    float mx = sink;
    for (int pass = 0; pass < 2; ++pass) {
        float den = 0.f, acc[8];
#pragma unroll
        for (int i = 0; i < 8; ++i) acc[i] = 0.f;
        for (int jj = 0; jj < nk; ++jj) {
            int dist; const float* kf = nullptr; const float* vf = nullptr; const bf16_t* kb = nullptr; const bf16_t* vb = nullptr;
            if (smp) { const int j = t + 1 + jj; dist = 128 + t - j;
                if (j < 128) { kf = p.cache_k + ((size_t)b * 128 + j) * 128 + kvh * 64; vf = p.cache_v + ((size_t)b * 128 + j) * 128 + kvh * 64; }
                else { const size_t mm = (size_t)(TP + b * DEC_SEQ + (j - 128)); kb = PR + mm * PLD + PC_SK + kvh * 64; vb = PR + mm * PLD + PC_SV + kvh * 64; } }
            else { dist = nk - 1 - jj; const size_t mm = (size_t)(m - dist); kb = PR + mm * PLD + PC_SK + kvh * 64; vb = PR + mm * PLD + PC_SV + kvh * 64; }
            float s = 0.f;
            for (int d = 0; d < 64; ++d) s += bf2f(q[d]) * (kf ? kf[d] : bf2f(kb[d]));
            s = s * 0.125f + p.rel_bias[t5_bucket(dist) * 8 + hq];
            if (pass == 0) { mx = s > mx ? s : mx; }
            else { const float pr = expf(s - mx); den += pr;
#pragma unroll
                for (int i = 0; i < 8; ++i) acc[i] += pr * (vf ? vf[dg * 8 + i] : bf2f(vb[dg * 8 + i])); }
        }
        if (pass == 1) { den += expf(sink - mx); bf16_t* mix = ws_h(p, WS_MIX) + (size_t)m * 1024 + 512 + hq * 64 + dg * 8;
#pragma unroll
            for (int i = 0; i < 8; ++i) mix[i] = f2bf(acc[i] / den); }
    }
}
constexpr long N_R7 = (long)(T / 8) * D;
HD void r7_body(long idx, const P& p) {
    const int mg = (int)(idx / D), d = (int)(idx % D);
    const bf16_t* MX = ws_h(p, WS_MIX) + (size_t)mg * 8 * 1024;
    float acc[8];
#pragma unroll
    for (int i = 0; i < 8; ++i) acc[i] = 0.f;
    for (int e = 0; e < 1024; ++e) { const float w = bf2f(f2bf(p.w_out[(size_t)e * D + d]));
#pragma unroll
        for (int i = 0; i < 8; ++i) acc[i] += bf2f(MX[(size_t)i * 1024 + e]) * w; }
#pragma unroll
    for (int i = 0; i < 8; ++i) { const int m = mg * 8 + i; const float g1 = ws_f(p, WS_MOD)[(size_t)cb_of(m) * 6 * D + 2 * D + d];
        p.out[O_Y + (size_t)m * D + d] = xrow(p, m)[d] + g1 * acc[i]; }
}
constexpr long N_R9 = (long)(T / 8) * DFF;
HD void r9_body(long idx, const P& p) {
    const int mg = (int)(idx / DFF), f = (int)(idx % DFF), m0 = mg * 8, t0 = t_of(m0);
    const bool smp = m0 >= TP; const int b = smp ? (m0 - TP) / DEC_SEQ : m0 / SEQ;
    const bf16_t* H = ws_h(p, WS_H);
    float ug[10], uu[10];
#pragma unroll
    for (int i = 0; i < 10; ++i) { ug[i] = 0.f; uu[i] = 0.f; }
    const bool halo = (!smp && t0 > 0);
    for (int k = 0; k < D; ++k) {
        const float wg = bf2f(f2bf(p.w_up[(size_t)k * 2 * DFF + f])), wu = bf2f(f2bf(p.w_up[(size_t)k * 2 * DFF + DFF + f]));
#pragma unroll
        for (int i = 0; i < 10; ++i) { if (i < 2 && !halo) continue; const float h = bf2f(H[(size_t)(m0 - 2 + i) * D + k]); ug[i] += h * wg; uu[i] += h * wu; }
    }
    if (smp) {
#pragma unroll
        for (int i = 0; i < 2; ++i) { ug[i] = p.state_ffn[((size_t)b * 2 + i) * 2 * DFF + f]; uu[i] = p.state_ffn[((size_t)b * 2 + i) * 2 * DFF + DFF + f]; }
    }
    const float w0g = p.ffn_conv_w[f], w1g = p.ffn_conv_w[2 * DFF + f], w2g = p.ffn_conv_w[4 * DFF + f], bgt = p.ffn_conv_b[f];
    const float w0u = p.ffn_conv_w[DFF + f], w1u = p.ffn_conv_w[3 * DFF + f], w2u = p.ffn_conv_w[5 * DFF + f], bup = p.ffn_conv_b[DFF + f];
    bf16_t* ACT = ws_h(p, WS_ACT);
#pragma unroll
    for (int i = 0; i < 8; ++i) {
        const float gc = w0g * ug[i] + w1g * ug[i + 1] + w2g * ug[i + 2] + bgt, uc = w0u * uu[i] + w1u * uu[i + 1] + w2u * uu[i + 2] + bup;
        ACT[(size_t)(m0 + i) * DFF + f] = f2bf(silu_f(gc) * uc);
    }
    if (smp) {
#pragma unroll
        for (int j = 0; j < 2; ++j) { float* o = p.out + O_SFC + ((size_t)b * 2 + j) * 2 * DFF; o[f] = ug[8 + j]; o[DFF + f] = uu[8 + j]; }
    } else if (t0 == SEQ - 8) {
#pragma unroll
        for (int j = 0; j < 2; ++j) { float* o = p.out + O_PFC + ((size_t)b * 2 + j) * 2 * DFF; o[f] = ug[8 + j]; o[DFF + f] = uu[8 + j]; }
    }
}
constexpr long N_R10 = (long)(T / 8) * D;
HD void r10_body(long idx, const P& p) {
    const int mg = (int)(idx / D), d = (int)(idx % D);
    const bf16_t* A = ws_h(p, WS_ACT) + (size_t)mg * 8 * DFF;
    float acc[8];
#pragma unroll
    for (int i = 0; i < 8; ++i) acc[i] = 0.f;
    for (int f = 0; f < DFF; ++f) { const float w = bf2f(f2bf(p.w_down[(size_t)f * D + d]));
#pragma unroll
        for (int i = 0; i < 8; ++i) acc[i] += bf2f(A[(size_t)i * DFF + f]) * w; }
#pragma unroll
    for (int i = 0; i < 8; ++i) { const int m = mg * 8 + i; const float g2 = ws_f(p, WS_MOD)[(size_t)cb_of(m) * 6 * D + 5 * D + d];
        float* o = p.out + O_Y + (size_t)m * D + d; *o = *o + g2 * acc[i]; }
}
constexpr long N_R11 = T, N_R8 = T;
HD void r11_body(long idx, const P& p) {
    float* xr = p.out + O_Y + (size_t)idx * D;
    float ss = 0.f;
    for (int k = 0; k < D; ++k) ss += xr[k] * xr[k];
    const float rstd = 1.0f / sqrtf(ss / (float)D + EPS);
    for (int k = 0; k < D; ++k) xr[k] = xr[k] * rstd * p.final_norm_w[k];
}
#define LAS __attribute__((address_space(3)))
typedef float f32x4 __attribute__((ext_vector_type(4)));
typedef unsigned u32x4 __attribute__((ext_vector_type(4)));
typedef unsigned u32x2 __attribute__((ext_vector_type(2)));
constexpr int NWAVES = 8, NTHR = 512;
constexpr int LDS_BYTES = 163840;
__device__ __forceinline__ int otid() { int t = threadIdx.x; asm volatile("" : "+v"(t)); return t; }
__device__ __forceinline__ float wave_sum(float v) {
#pragma unroll
    for (int o = 1; o < 64; o <<= 1) v += __shfl_xor(v, o);
    return v;
}
__device__ __forceinline__ unsigned pk2(float lo, float hi) { return f2bf_bits(lo) | (f2bf_bits(hi) << 16); }

__device__ __forceinline__ void transpose_item(const float* W, int ldw, int K, bf16_t* WT, int dst_n0, int src_n0, int k0, LAS float* scr, int lane) {
#pragma unroll
    for (int i = 0; i < 32; ++i) { const int kk = 2 * i + (lane >> 5); scr[kk * 33 + (lane & 31)] = W[(size_t)(k0 + kk) * ldw + src_n0 + (lane & 31)]; }
    asm volatile("s_waitcnt lgkmcnt(0)" ::: "memory");
    const int c = lane & 7;
#pragma unroll
    for (int j = 0; j < 4; ++j) { const int n = (lane >> 3) + 8 * j; const LAS float* s = scr + (8 * c) * 33 + n;
        u32x4 o; o.x = pk2(s[0 * 33], s[1 * 33]); o.y = pk2(s[2 * 33], s[3 * 33]); o.z = pk2(s[4 * 33], s[5 * 33]); o.w = pk2(s[6 * 33], s[7 * 33]);
        *(u32x4*)(WT + (size_t)(dst_n0 + n) * K + k0 + 8 * c) = o; }
    asm volatile("s_waitcnt lgkmcnt(0)" ::: "memory");
}
constexpr int TI_IN = (PLD / 32) * (D / 64), TI_OUT = (D / 32) * (1024 / 64), TI_UP = (2 * DFF / 32) * (D / 64), TI_DN = (D / 32) * (DFF / 64), TI_ALL = TI_IN + TI_OUT + TI_UP + TI_DN;
__device__ __forceinline__ void phase_transposes(const P& p, LAS unsigned char* lds) {
    const int tid_ = otid(), lane = tid_ & 63, wave = tid_ >> 6;
    if (blockIdx.x == gridDim.x - 1) { for (int i = tid_; i < 8 * D; i += NTHR) ws_f(p, WS_WBAT)[i] = p.w_in[(size_t)(i % D) * IN_COLS + WC_BA + i / D]; }
    LAS float* scr = (LAS float*)(lds + wave * 16384);
    const int gw = blockIdx.x * NWAVES + wave, NGW = gridDim.x * NWAVES;
    for (int it = gw; it < TI_ALL; it += NGW) {
        int r = it;
        if (r < TI_IN) { const int nb = r % (PLD / 32), kb = r / (PLD / 32), n0 = nb * 32; transpose_item(p.w_in, IN_COLS, D, ws_h(p, WS_WT_IN), n0, n0 < WC_BA ? n0 : n0 + 8, kb * 64, scr, lane); continue; } r -= TI_IN;
        if (r < TI_OUT) { const int nb = r % (D / 32), kb = r / (D / 32), n0 = nb * 32; transpose_item(p.w_out, D, 1024, ws_h(p, WS_WT_OUT), n0, n0, kb * 64, scr, lane); continue; } r -= TI_OUT;
        if (r < TI_UP) { const int nb = r % (2 * DFF / 32), kb = r / (2 * DFF / 32), n0 = nb * 32;
            const int pn = n0 >> 8, bj = (n0 >> 7) & 1, c = n0 & 127; transpose_item(p.w_up, 2 * DFF, D, ws_h(p, WS_WT_UP), n0, bj * DFF + 128 * pn + c, kb * 64, scr, lane); continue; } r -= TI_UP;
        { const int nb = r % (D / 32), kb = r / (D / 32), n0 = nb * 32; transpose_item(p.w_down, D, DFF, ws_h(p, WS_WT_DN), n0, n0, kb * 64, scr, lane); }
    }
}
typedef short bf16x8m __attribute__((ext_vector_type(8)));
__device__ __forceinline__ void split8(const float (&x)[8], bf16x8m& hi, bf16x8m& lo) {
    unsigned h[4], l[4];
#pragma unroll
    for (int e = 0; e < 4; ++e) { const unsigned h0 = f2bf_bits(x[2 * e]), h1 = f2bf_bits(x[2 * e + 1]);
        const float r0 = x[2 * e] - __builtin_bit_cast(float, h0 << 16), r1 = x[2 * e + 1] - __builtin_bit_cast(float, h1 << 16);
        h[e] = h0 | (h1 << 16); l[e] = f2bf_bits(r0) | (f2bf_bits(r1) << 16); }
    hi = __builtin_bit_cast(bf16x8m, (u32x4){h[0], h[1], h[2], h[3]}); lo = __builtin_bit_cast(bf16x8m, (u32x4){l[0], l[1], l[2], l[3]});
}
__device__ __forceinline__ void phase_mod(const P& p, LAS unsigned char* lds) {
    constexpr int KC = 256, NCG = 6 * D / 32, NCH = D / KC, NMT = (NCB + 15) / 16;
    static_assert(NMT <= 16, "two m-tiles per wave at most");
    LAS float* WB = (LAS float*)lds;
    const int tid = otid(), lane = tid & 63, wave = tid >> 6, r16 = lane & 15, g4 = lane >> 4;
    for (int cg = blockIdx.x; cg < NCG; cg += gridDim.x) {
        f32x4 acc[2][2];
#pragma unroll
        for (int s = 0; s < 2; ++s)
#pragma unroll
            for (int nt = 0; nt < 2; ++nt) acc[s][nt] = (f32x4){0.f, 0.f, 0.f, 0.f};
        f32x4 wreg[4];
#pragma unroll
        for (int j = 0; j < 4; ++j) { const int idx = tid + NTHR * j; wreg[j] = *(const f32x4*)(p.w_ada + (size_t)(idx >> 3) * 6 * D + cg * 32 + 4 * (idx & 7)); }
        __syncthreads();
        for (int ch = 0; ch < NCH; ++ch) {
            LAS float* wb = WB + (ch & 1) * KC * 32;
#pragma unroll
            for (int j = 0; j < 4; ++j) { const int idx = tid + NTHR * j; *(LAS f32x4*)(wb + (idx >> 3) * 32 + 4 * (idx & 7)) = wreg[j]; }
            if (ch + 1 < NCH) {
#pragma unroll
                for (int j = 0; j < 4; ++j) { const int idx = tid + NTHR * j; wreg[j] = *(const f32x4*)(p.w_ada + (size_t)((ch + 1) * KC + (idx >> 3)) * 6 * D + cg * 32 + 4 * (idx & 7)); }
            }
            __syncthreads();
#pragma unroll 2
            for (int ks = 0; ks < KC / 32; ++ks) {
                bf16x8m bh[2], bl[2];
#pragma unroll
                for (int nt = 0; nt < 2; ++nt) { float x[8];
#pragma unroll
                    for (int j = 0; j < 8; ++j) x[j] = wb[(32 * ks + 8 * g4 + j) * 32 + 16 * nt + r16];
                    split8(x, bh[nt], bl[nt]); }
#pragma unroll
                for (int s = 0; s < 2; ++s) { const int mt = wave + 8 * s; if (mt >= NMT) continue;
                    const int row = 16 * mt + r16; float x[8];
                    if (row < NCB) { const float* c = (row < BATCH ? p.c_prompt + (size_t)row * D : p.c_sample + (size_t)(row - BATCH) * D) + ch * KC + 32 * ks + 8 * g4;
                        const f32x4 a = *(const f32x4*)c, d = *(const f32x4*)(c + 4);
                        x[0] = silu_f(a[0]); x[1] = silu_f(a[1]); x[2] = silu_f(a[2]); x[3] = silu_f(a[3]); x[4] = silu_f(d[0]); x[5] = silu_f(d[1]); x[6] = silu_f(d[2]); x[7] = silu_f(d[3]); }
                    else {
#pragma unroll
                        for (int j = 0; j < 8; ++j) x[j] = 0.f; }
                    bf16x8m ah, al; split8(x, ah, al);
#pragma unroll
                    for (int nt = 0; nt < 2; ++nt) {
                        acc[s][nt] = __builtin_amdgcn_mfma_f32_16x16x32_bf16(ah, bh[nt], acc[s][nt], 0, 0, 0);
                        acc[s][nt] = __builtin_amdgcn_mfma_f32_16x16x32_bf16(ah, bl[nt], acc[s][nt], 0, 0, 0);
                        acc[s][nt] = __builtin_amdgcn_mfma_f32_16x16x32_bf16(al, bh[nt], acc[s][nt], 0, 0, 0); } }
            }
        }
#pragma unroll
        for (int s = 0; s < 2; ++s) { const int mt = wave + 8 * s; if (mt >= NMT) continue;
#pragma unroll
            for (int nt = 0; nt < 2; ++nt) { const int e = cg * 32 + 16 * nt + r16; const float bb = p.b_ada[e];
#pragma unroll
                for (int i = 0; i < 4; ++i) { const int row = 16 * mt + 4 * g4 + i; if (row < NCB) ws_f(p, WS_MOD)[(size_t)row * 6 * D + e] = acc[s][nt][i] + bb; } } }
    }
    __syncthreads();
}
template <int WHICH> __device__ __forceinline__ void phase_norm(const P& p) {
    static_assert(D == 1024, "one wave per 1024-float row");
    const int tid_ = otid(), lane = tid_ & 63, wave = tid_ >> 6;
    const int gw = blockIdx.x * NWAVES + wave, NGW = gridDim.x * NWAVES;
    const float* nwp = WHICH == 0 ? p.norm_mix_w : (WHICH == 1 ? p.norm_ffn_w : p.final_norm_w);
    f32x4 nwv[4];
#pragma unroll
    for (int j = 0; j < 4; ++j) nwv[j] = ((const f32x4*)nwp)[lane + 64 * j];
    f32x4 wbt[WHICH == 0 ? 8 : 1][4];
    if (WHICH == 0) {
#pragma unroll
        for (int c = 0; c < 8; ++c)
#pragma unroll
            for (int j = 0; j < 4; ++j) wbt[c][j] = ((const f32x4*)(ws_f(p, WS_WBAT) + c * D))[lane + 64 * j];
    }
    f32x4 v[4];
    if (gw < T) { const float* xr = WHICH == 0 ? xrow(p, gw) : p.out + O_Y + (size_t)gw * D;
#pragma unroll
        for (int j = 0; j < 4; ++j) v[j] = ((const f32x4*)xr)[lane + 64 * j]; }
    for (int m = gw; m < T; m += NGW) {
        f32x4 vn[4]; const int mn = m + NGW;
        if (mn < T) { const float* xr = WHICH == 0 ? xrow(p, mn) : p.out + O_Y + (size_t)mn * D;
#pragma unroll
            for (int j = 0; j < 4; ++j) vn[j] = ((const f32x4*)xr)[lane + 64 * j]; }
        float ss = 0.f;
#pragma unroll
        for (int j = 0; j < 4; ++j) ss += (v[j][0] * v[j][0] + v[j][1] * v[j][1]) + (v[j][2] * v[j][2] + v[j][3] * v[j][3]);
        const float rstd = 1.0f / sqrtf(wave_sum(ss) * (1.0f / D) + EPS);
        if (WHICH == 2) {
#pragma unroll
            for (int j = 0; j < 4; ++j) ((f32x4*)(p.out + O_Y + (size_t)m * D))[lane + 64 * j] = v[j] * rstd * nwv[j];
        } else {
            const int cb = cb_of(m);
            const float* mod = ws_f(p, WS_MOD) + (size_t)cb * 6 * D;
            const float* sh = mod + (WHICH == 0 ? 0 : 3 * D); const float* sc = mod + (WHICH == 0 ? D : 4 * D);
            float ba[8];
#pragma unroll
            for (int j = 0; j < 8; ++j) ba[j] = 0.f;
            unsigned long long* o8 = (unsigned long long*)(ws_h(p, WS_H) + (size_t)m * D);
#pragma unroll
            for (int j = 0; j < 4; ++j) {
                const f32x4 s1 = ((const f32x4*)sc)[lane + 64 * j], s0 = ((const f32x4*)sh)[lane + 64 * j];
                const f32x4 h = v[j] * rstd * nwv[j] * (s1 + 1.0f) + s0;
                o8[lane + 64 * j] = (unsigned long long)pk2(h[0], h[1]) | ((unsigned long long)pk2(h[2], h[3]) << 32);
                if (WHICH == 0) {
#pragma unroll
                    for (int c = 0; c < 8; ++c) ba[c] += (h[0] * wbt[c][j][0] + h[1] * wbt[c][j][1]) + (h[2] * wbt[c][j][2] + h[3] * wbt[c][j][3]);
                }
            }
            if (WHICH == 0) {
#pragma unroll
                for (int j = 0; j < 8; ++j) ba[j] = wave_sum(ba[j]);
                float mine = 0.f;
#pragma unroll
                for (int j = 0; j < 8; ++j) mine = (lane == j) ? ba[j] : mine;
                if (lane < 8) { float* bg = ws_f(p, WS_BG) + (size_t)m * 8; const int j = lane & 3;
                    bg[lane] = lane < 4 ? sigmoid_f(mine) : -expf(p.dn_A_log[j]) * softplus_f(mine + p.dn_dt_bias[j]); }
            }
        }
#pragma unroll
        for (int j = 0; j < 4; ++j) v[j] = vn[j];
    }
}

constexpr long SO_1 = (long)BATCH * 3 * 1536 / 4, SO_2 = (long)DEC_BATCH * 3 * 1536 / 4, SO_3 = (long)BATCH * 128 * 128 / 4, SO_4 = (long)DEC_BATCH * 128 * 128 / 4, SO_N = SO_1 + SO_2 + 2 * (SO_3 + SO_4);
__device__ __forceinline__ void so_item(const P& p, long it, f32x4& val, float*& dst) {
    const bf16_t* PR = ws_h(p, WS_PROJ); const bf16_t* src = nullptr; const float* fsrc = nullptr;
    long r = it;
    if (r < SO_1) { const int b = (int)(r / (3 * 384)), j = (int)(r / 384 % 3), c = (int)(r % 384) * 4; src = PR + (size_t)(b * SEQ + SEQ - 3 + j) * PLD + PC_QKV + c; dst = p.out + O_PDC + r * 4; }
    else if ((r -= SO_1) < SO_2) { const int b = (int)(r / (3 * 384)), j = (int)(r / 384 % 3), c = (int)(r % 384) * 4; src = PR + (size_t)(TP + b * DEC_SEQ + DEC_SEQ - 3 + j) * PLD + PC_QKV + c; dst = p.out + O_SDC + r * 4; }
    else { r -= SO_2; const int kv = r >= SO_3 + SO_4; if (kv) r -= SO_3 + SO_4; const int pc = kv ? PC_SV : PC_SK; const float* cache = kv ? p.cache_v : p.cache_k;
        if (r < SO_3) { const int b = (int)(r / (128 * 32)), j = (int)(r / 32 % 128), c = (int)(r % 32) * 4; src = PR + (size_t)(b * SEQ + SEQ - 128 + j) * PLD + pc + c; dst = p.out + (kv ? O_PV : O_PK) + r * 4; }
        else { r -= SO_3; const int b = (int)(r / (128 * 32)), j = (int)(r / 32 % 128), c = (int)(r % 32) * 4; dst = p.out + (kv ? O_SV : O_SK) + r * 4;
            if (j < 128 - DEC_SEQ) fsrc = cache + ((size_t)b * 128 + j + DEC_SEQ) * 128 + c; else src = PR + (size_t)(TP + b * DEC_SEQ + (j - (128 - DEC_SEQ))) * PLD + pc + c; } }
    if (fsrc) val = *(const f32x4*)fsrc;
    else { const u32x2 w = *(const u32x2*)src; val = (f32x4){__builtin_bit_cast(float, w.x << 16), __builtin_bit_cast(float, w.x & 0xffff0000u), __builtin_bit_cast(float, w.y << 16), __builtin_bit_cast(float, w.y & 0xffff0000u)}; }
}
__device__ __forceinline__ void phase_state_out(const P& p) {
    const long gt = blockIdx.x * (long)NTHR + otid(), gs = (long)gridDim.x * NTHR;
    for (long it = gt; it < SO_N; it += 4 * gs) {
        f32x4 v[4]; float* d[4];
#pragma unroll
        for (int u = 0; u < 4; ++u) if (it + u * gs < SO_N) so_item(p, it + u * gs, v[u], d[u]);
#pragma unroll
        for (int u = 0; u < 4; ++u) if (it + u * gs < SO_N) *(f32x4*)d[u] = v[u];
    }
}
#define XB_TMO      128
#define XB_XCNT(j)  (256  + 64 * (j))
#define XB_XSUB(j)  (1280 + 64 * (j))
#define XB_XGEN(j)  (2304 + 64 * (j))
#define XB_TOP      3328
#define XB_TOPGEN   3392
#define XCD_BAR_WORDS 3456
#define XB_SPIN_CAP (1u << 18)

__device__ __forceinline__ unsigned xb_ld(unsigned* p)              { return __hip_atomic_load(p, __ATOMIC_RELAXED, __HIP_MEMORY_SCOPE_AGENT); }
__device__ __forceinline__ unsigned xb_add(unsigned* p, unsigned v) { return __hip_atomic_fetch_add(p, v, __ATOMIC_RELAXED, __HIP_MEMORY_SCOPE_AGENT); }
__device__ __forceinline__ unsigned xb_xcc_id() { return (unsigned)__builtin_amdgcn_s_getreg((3 << 11) | 20) & 0xFu; }
#define XB_SPIN(cond, bar) do { unsigned _sp = 0; while (cond) { __builtin_amdgcn_s_sleep(1); \
    if ((++_sp & 255u) == 0u) { if (xb_ld(&(bar)[XB_TMO])) break; if (_sp > XB_SPIN_CAP) { atomicAdd(&(bar)[XB_TMO], 1u); break; } } } } while (0)

struct XcdBarrier {
    unsigned* bar; unsigned x;
    volatile LAS unsigned* st;
};

__device__ __forceinline__ XcdBarrier xcd_barrier_post(unsigned* bar, volatile LAS unsigned* st) {
    XcdBarrier b; b.bar = bar; b.x = xb_xcc_id(); b.st = st;
    if (threadIdx.x == 0) (void)xb_add(&bar[XB_XCNT(b.x)], 1u);
    return b;
}
__device__ __forceinline__ void xcd_barrier_complete(unsigned* bar, unsigned x, unsigned& nloc, unsigned& nx) {
    const unsigned G = gridDim.x * gridDim.y * gridDim.z;
    unsigned sum, cnt, mine, sp = 0u;
    for (;;) {
        sum = 0u; cnt = 0u; mine = 0u;
#pragma unroll
        for (unsigned j = 0; j < 16; ++j) { const unsigned c = xb_ld(&bar[XB_XCNT(j)]); sum += c; cnt += (c > 0u) ? 1u : 0u; mine = (j == x) ? c : mine; }
        if (sum == G) break;
        __builtin_amdgcn_s_sleep(1);
        if ((++sp & 255u) == 0u) { if (xb_ld(&bar[XB_TMO])) break; if (sp > XB_SPIN_CAP) { atomicAdd(&bar[XB_TMO], 1u); break; } }
    }
    nloc = mine > 0u ? mine : 1u; nx = cnt > 0u ? cnt : 1u;
}

__device__ __forceinline__ void xcd_barrier(const XcdBarrier& b) {
    asm volatile("s_waitcnt vmcnt(0)" ::: "memory");
    __syncthreads();
    if (threadIdx.x == 0) {
        unsigned* bar = b.bar;
        __builtin_amdgcn_s_waitcnt(0);
        unsigned nloc = b.st[0], nx = b.st[1];
        if (nloc == 0u) { xcd_barrier_complete(bar, b.x, nloc, nx); b.st[0] = nloc; b.st[1] = nx; }
        const unsigned old = xb_add(&bar[XB_XSUB(b.x)], 1u);
        const unsigned gen = old / nloc;
        if (old + 1u == (gen + 1u) * nloc) {
            __builtin_amdgcn_fence(__ATOMIC_RELEASE, "agent");
            asm volatile("s_waitcnt vmcnt(0)" ::: "memory");
            const unsigned og = xb_add(&bar[XB_TOP], 1u);
            const unsigned tg = og / nx;
            if (og + 1u == (tg + 1u) * nx) xb_add(&bar[XB_TOPGEN], 1u);
            else XB_SPIN(xb_ld(&bar[XB_TOPGEN]) == tg, bar);
            __builtin_amdgcn_fence(__ATOMIC_ACQUIRE, "agent");
            xb_add(&bar[XB_XGEN(b.x)], 1u);
            asm volatile("s_waitcnt vmcnt(0)" ::: "memory");
        } else {
            XB_SPIN(xb_ld(&bar[XB_XGEN(b.x)]) == gen, bar);
            __builtin_amdgcn_fence(__ATOMIC_ACQUIRE, "agent");
            asm volatile("s_waitcnt vmcnt(0)" ::: "memory");
        }
    }
    __syncthreads();
}
namespace pg8 {
#define PG8_LAS __attribute__((address_space(3)))
typedef unsigned short bf16_t;
typedef short bf16x8 __attribute__((ext_vector_type(8)));
typedef float f32x4 __attribute__((ext_vector_type(4)));
typedef unsigned u32x4 __attribute__((ext_vector_type(4)));
constexpr int BM = 256, BK = 64, HALF = 128, HTB = HALF * BK * 2  , STAGE_BYTES = 8 * HTB, NXCD = 8, WGM = 8;

__host__ __device__ __forceinline__ int lds_byte(int r, int c) { const int st = (r >> 4) * 2 + (c >> 5), rr = r & 15, cc = c & 31, ob = rr * 64 + cc * 2; return st * 1024 + (ob ^ (((ob >> 9) & 1) << 5)); }
__host__ __device__ __forceinline__ void stage_rc(int b, int& R, int& C) { const int st = b / 1024, sb = b % 1024, swz = sb ^ (((sb >> 9) & 1) << 5); R = (st >> 1) * 16 + swz / 64; C = (st & 1) * 32 + (swz % 64) / 2; }
__host__ __device__ __forceinline__ int perm32(int rho) { const int n = rho >> 4, i = rho & 15; return 8 * (i >> 2) + 4 * n + (i & 3); }

struct Unit { int pm, pn; };
struct Gemm { const bf16_t* A; const bf16_t* Bt; int M, N, K; };

struct StaticOrder {
    int nM, nN, nwg, G, c;
    __host__ __device__ void init(int M, int N, int G_, int c_) { nM = M / BM; nN = N / BM; nwg = nM * nN; G = G_; c = c_; }
    __host__ __device__ bool next(int i, Unit& u) const {
        const long L = (long)i * G + c; if (L >= nwg) return false;
        int wgid = (int)L; { const int q = nwg / NXCD, r = nwg % NXCD, xcd = wgid % NXCD, off = wgid / NXCD; wgid = (xcd < r ? xcd * (q + 1) : r * (q + 1) + (xcd - r) * q) + off; }
        const int nig = WGM * nN, gid = wgid / nig, fm = gid * WGM, gsz = (nM - fm) < WGM ? (nM - fm) : WGM;
        u.pm = fm + ((wgid % nig) % gsz); u.pn = (wgid % nig) / gsz; return true;
    }
    __device__ __forceinline__ void a_ready(const Unit&) const {}
    __device__ __forceinline__ void done(const Unit&) const {}
};

__device__ __forceinline__ unsigned cvt_pk_bf16(float lo, float hi) { unsigned r; asm volatile("v_cvt_pk_bf16_f32 %0, %1, %2" : "=v"(r) : "v"(lo), "v"(hi)); return r; }
struct EpiStoreBf16 {
    static constexpr bool PERM = true, AFTER_DRAIN = false;
    bf16_t* O; int ldc;
    __device__ __forceinline__ void operator()(const f32x4 (&acc)[2][2][4][2], const Unit& u, int wr, int wc, int fr, int fq) const {
        const int row0 = u.pm * BM + wr * 64 + fr, col0 = u.pn * BM + wc * 32 + 8 * fq;
#pragma unroll
        for (int ai = 0; ai < 2; ++ai)
#pragma unroll
            for (int m = 0; m < 4; ++m) { bf16_t* rowp = O + (size_t)(row0 + ai * HALF + m * 16) * ldc + col0;
#pragma unroll
                for (int bj = 0; bj < 2; ++bj) { const f32x4 v0 = acc[ai][bj][m][0], v1 = acc[ai][bj][m][1];
                    u32x4 w; w.x = cvt_pk_bf16(v0[0], v0[1]); w.y = cvt_pk_bf16(v0[2], v0[3]); w.z = cvt_pk_bf16(v1[0], v1[1]); w.w = cvt_pk_bf16(v1[2], v1[3]);
                    *(u32x4*)(rowp + bj * HALF) = w; } }
    }
};
struct EpiGateRes {
    static constexpr bool PERM = false, AFTER_DRAIN = false;
    const float* base_p; const float* base_s; float* out; const float* gate;
    __device__ __forceinline__ void operator()(const f32x4 (&acc)[2][2][4][2], const Unit& u, int wr, int wc, int fr, int fq) const {
        const int row0 = u.pm * BM + wr * 64 + fr, col0 = u.pn * BM + wc * 32 + 4 * fq;
        const bool smp = row0 >= TP; const float* base = smp ? base_s - (size_t)TP * D : base_p;
#pragma unroll
        for (int ai = 0; ai < 2; ++ai)
#pragma unroll
            for (int m = 0; m < 4; ++m) { const int r = row0 + ai * HALF + m * 16; const int cb = smp ? BATCH + ((r - TP) >> 3) : r / SEQ;
                const float* gp = gate + (size_t)cb * 6 * D + col0; const size_t off = (size_t)r * D + col0;
#pragma unroll
                for (int bj = 0; bj < 2; ++bj)
#pragma unroll
                    for (int n = 0; n < 2; ++n) { const f32x4 gv = *(const f32x4*)(gp + bj * HALF + n * 16), bs = *(const f32x4*)(base + off + bj * HALF + n * 16);
                        *(f32x4*)(out + off + bj * HALF + n * 16) = bs + gv * acc[ai][bj][m][n]; } }
    }
};
template <class Epi, class Sched, bool ALIGN_EPI = false, bool SP2 = false>
__device__ __forceinline__ void gemm_phase(PG8_LAS unsigned char* lds, const Gemm g, const Sched& S, const Epi& E) {
    const int tid = otid(), wid = __builtin_amdgcn_readfirstlane(tid >> 6), lane = tid & 63, wr = wid >> 2, wc = wid & 3, fr = lane & 15, fq = lane >> 4;
    const int K = g.K, nt = K / BK;
    unsigned voffA[2], voffB[2];
#pragma unroll
    for (int i = 0; i < 2; ++i) { int R, C; stage_rc(tid * 16 + i * 8192, R, C); const int Rb = Epi::PERM ? ((R & ~31) + perm32(R & 31)) : R;
        voffA[i] = (unsigned)(R * K + C) * 2u; voffB[i] = (unsigned)(Rb * K + C) * 2u; }
    const size_t kstep = (size_t)(BK * 2);
    const size_t hstep = (size_t)HALF * K * 2;
    const size_t tstep = 2 * hstep;
    const unsigned ldsw = (unsigned)wid * 1024u;
    const int aoff = lds_byte(wr * 64 + fr, fq * 8), boff = lds_byte(wc * 32 + fr, fq * 8);
#define PG8_SA(b, h) (((b) * 2 + (h)) * HTB)
#define PG8_SB(b, h) ((4 + (b) * 2 + (h)) * HTB)
#define PG8_STAGE(bufoff, gbase, voff) do { _Pragma("unroll") for (int _i = 0; _i < 2; ++_i) \
        __builtin_amdgcn_global_load_lds((const unsigned*)((const char*)(gbase) + (voff)[_i]), (PG8_LAS unsigned*)(lds + (bufoff) + ldsw + _i * 8192), 16, 0, 0); } while (0)
#define PG8_LDA(dst, b, h) do { _Pragma("unroll") for (int m = 0; m < 4; ++m) _Pragma("unroll") for (int k = 0; k < 2; ++k) dst[m][k] = *(const PG8_LAS bf16x8*)(lds + PG8_SA(b, h) + aoff + m * 2048 + k * 1024); } while (0)
#define PG8_LDB(dst, b, h) do { _Pragma("unroll") for (int n = 0; n < 2; ++n) _Pragma("unroll") for (int k = 0; k < 2; ++k) dst[n][k] = *(const PG8_LAS bf16x8*)(lds + PG8_SB(b, h) + boff + n * 2048 + k * 1024); } while (0)
#define PG8_MMA(ai, bj, At, Bt) do { __builtin_amdgcn_s_setprio(1); _Pragma("unroll") for (int m = 0; m < 4; ++m) _Pragma("unroll") for (int n = 0; n < 2; ++n) _Pragma("unroll") for (int k = 0; k < 2; ++k) \
        acc[ai][bj][m][n] = __builtin_amdgcn_mfma_f32_16x16x32_bf16(Bt[n][k], At[m][k], acc[ai][bj][m][n], 0, 0, 0); __builtin_amdgcn_s_setprio(0); } while (0)
#define PG8_WAIT_V(n) asm volatile("s_waitcnt vmcnt(" #n ")" ::: "memory")
#define PG8_WAIT_L(n) asm volatile("s_waitcnt lgkmcnt(" #n ")" ::: "memory")
#define PG8_BAR __builtin_amdgcn_s_barrier()
#define PG8_SCHED __builtin_amdgcn_sched_barrier(0)
    Unit cur, nxt; int ui = 0;
    if (!S.next(0, cur)) return;
    f32x4 acc[2][2][4][2];
#pragma unroll
    for (int a = 0; a < 2; ++a)
#pragma unroll
        for (int b = 0; b < 2; ++b)
#pragma unroll
            for (int m = 0; m < 4; ++m)
#pragma unroll
                for (int n = 0; n < 2; ++n) acc[a][b][m][n] = (f32x4){0.f, 0.f, 0.f, 0.f};
    bf16x8 At[4][2], B0[2][2], B1[2][2];
    const char* cA = (const char*)g.A + (size_t)cur.pm * tstep; const char* cB = (const char*)g.Bt + (size_t)cur.pn * tstep;
    S.a_ready(cur);
    if constexpr (SP2) {
        PG8_STAGE(PG8_SB(0, 0), cB, voffB); PG8_STAGE(PG8_SB(0, 1), cB + hstep, voffB); PG8_STAGE(PG8_SA(0, 0), cA, voffA); PG8_STAGE(PG8_SA(0, 1), cA + hstep, voffA);
        if (wr == 1) PG8_BAR;
        PG8_WAIT_V(2); PG8_BAR;
        PG8_STAGE(PG8_SB(1, 0), cB + kstep, voffB); PG8_STAGE(PG8_SA(1, 0), cA + kstep, voffA); PG8_STAGE(PG8_SB(1, 1), cB + hstep + kstep, voffB);
        PG8_WAIT_V(6); PG8_BAR;
    } else {
        PG8_STAGE(PG8_SB(0, 0), cB, voffB); PG8_STAGE(PG8_SA(0, 0), cA, voffA); PG8_STAGE(PG8_SB(0, 1), cB + hstep, voffB); PG8_STAGE(PG8_SA(0, 1), cA + hstep, voffA);
        if (wr == 1) PG8_BAR;
        PG8_WAIT_V(4); PG8_BAR;
        PG8_STAGE(PG8_SB(1, 0), cB + kstep, voffB); PG8_STAGE(PG8_SA(1, 0), cA + kstep, voffA); PG8_STAGE(PG8_SB(1, 1), cB + hstep + kstep, voffB);
        PG8_WAIT_V(6); PG8_BAR;
    }
    for (;;) {
        const bool has_next = S.next(ui + 1, nxt);
        const char* nA = has_next ? (const char*)g.A + (size_t)nxt.pm * tstep : cA; const char* nB = has_next ? (const char*)g.Bt + (size_t)nxt.pn * tstep : cB;
        for (int t = 0; t < nt; t += 2) {
            const bool last = (t == nt - 2);
            const char* a1 = cA + (size_t)(t + 1) * kstep;
            const char* a2 = last ? nA : cA + (size_t)(t + 2) * kstep; const char* b2 = last ? nB : cB + (size_t)(t + 2) * kstep;
            const char* a3 = a2 + kstep; const char* b3 = b2 + kstep;
            if (last && has_next) S.a_ready(nxt);
            if constexpr (SP2) {
            PG8_LDB(B0, 0, 0); PG8_LDB(B1, 0, 1); PG8_SCHED; PG8_LDA(At, 0, 0); PG8_STAGE(PG8_SA(1, 1), a1 + hstep, voffA);
            PG8_WAIT_V(8); PG8_WAIT_L(0); PG8_BAR; PG8_MMA(0, 0, At, B0); PG8_MMA(0, 1, At, B1); PG8_BAR; PG8_SCHED;
            PG8_LDA(At, 0, 1); PG8_STAGE(PG8_SB(0, 0), b2, voffB); PG8_STAGE(PG8_SB(0, 1), b2 + hstep, voffB); PG8_STAGE(PG8_SA(0, 0), a2, voffA);
            PG8_WAIT_V(8); PG8_WAIT_L(0); PG8_BAR; PG8_MMA(1, 0, At, B0); PG8_MMA(1, 1, At, B1); PG8_BAR; PG8_SCHED;
            PG8_LDB(B0, 1, 0); PG8_LDB(B1, 1, 1); PG8_SCHED; PG8_LDA(At, 1, 0); PG8_STAGE(PG8_SA(0, 1), a2 + hstep, voffA);
            PG8_WAIT_V(8); PG8_WAIT_L(0); PG8_BAR; PG8_MMA(0, 0, At, B0); PG8_MMA(0, 1, At, B1); PG8_BAR; PG8_SCHED;
            PG8_LDA(At, 1, 1); PG8_STAGE(PG8_SB(1, 0), b3, voffB); PG8_STAGE(PG8_SB(1, 1), b3 + hstep, voffB); PG8_STAGE(PG8_SA(1, 0), a3, voffA);
            PG8_WAIT_V(8); PG8_WAIT_L(0); PG8_BAR; PG8_MMA(1, 0, At, B0); PG8_MMA(1, 1, At, B1); PG8_BAR; PG8_SCHED;
            } else {
            PG8_LDB(B0, 0, 0); PG8_SCHED; PG8_LDA(At, 0, 0); PG8_STAGE(PG8_SA(1, 1), a1 + hstep, voffA);
            PG8_WAIT_L(8); PG8_BAR; PG8_WAIT_L(0); PG8_MMA(0, 0, At, B0); PG8_BAR; PG8_SCHED;
            PG8_LDB(B1, 0, 1); PG8_STAGE(PG8_SB(0, 0), b2, voffB);
            PG8_BAR; PG8_WAIT_L(0); PG8_MMA(0, 1, At, B1); PG8_BAR;
            PG8_LDA(At, 0, 1); PG8_STAGE(PG8_SA(0, 0), a2, voffA);
            PG8_BAR; PG8_WAIT_L(0); PG8_MMA(1, 0, At, B0); PG8_BAR; PG8_SCHED;
            PG8_STAGE(PG8_SB(0, 1), b2 + hstep, voffB);
            PG8_WAIT_V(6); PG8_BAR; PG8_MMA(1, 1, At, B1); PG8_BAR;
            PG8_LDB(B0, 1, 0); PG8_SCHED; PG8_LDA(At, 1, 0); PG8_STAGE(PG8_SA(0, 1), a2 + hstep, voffA);
            PG8_WAIT_L(8); PG8_BAR; PG8_WAIT_L(0); PG8_MMA(0, 0, At, B0); PG8_BAR; PG8_SCHED;
            PG8_LDB(B1, 1, 1); PG8_STAGE(PG8_SB(1, 0), b3, voffB);
            PG8_BAR; PG8_WAIT_L(0); PG8_MMA(0, 1, At, B1); PG8_BAR;
            PG8_LDA(At, 1, 1); PG8_STAGE(PG8_SA(1, 0), a3, voffA);
            PG8_BAR; PG8_WAIT_L(0); PG8_MMA(1, 0, At, B0); PG8_BAR; PG8_SCHED;
            PG8_STAGE(PG8_SB(1, 1), b3 + hstep, voffB);
            PG8_WAIT_V(6); PG8_BAR; PG8_MMA(1, 1, At, B1); PG8_BAR;
            }
        }
        if constexpr (ALIGN_EPI) { if (wr == 0) PG8_BAR; }
        if constexpr (!Epi::AFTER_DRAIN) { E(acc, cur, wr, wc, fr, fq); S.done(cur); }
        if (!has_next) break;
#pragma unroll
        for (int a = 0; a < 2; ++a)
#pragma unroll
            for (int b = 0; b < 2; ++b)
#pragma unroll
                for (int m = 0; m < 4; ++m)
#pragma unroll
                    for (int n = 0; n < 2; ++n) acc[a][b][m][n] = (f32x4){0.f, 0.f, 0.f, 0.f};
        cur = nxt; cA = nA; cB = nB; ++ui;
        if constexpr (ALIGN_EPI) { if (wr == 1) PG8_BAR; }
    }
    PG8_WAIT_V(0);
    if constexpr (!ALIGN_EPI) { if (wr == 0) PG8_BAR; }
    PG8_BAR;
    if constexpr (Epi::AFTER_DRAIN) { E.fused(acc, cur, wr, wc, fr, fq, lds, wid, lane); S.done(cur); }
#undef PG8_SA
#undef PG8_SB
#undef PG8_STAGE
#undef PG8_LDA
#undef PG8_LDB
#undef PG8_MMA
#undef PG8_WAIT_V
#undef PG8_WAIT_L
#undef PG8_BAR
#undef PG8_SCHED
}
}
typedef short bf16x8 __attribute__((ext_vector_type(8)));
constexpr int FR_NWK = 0, FR_QD = 16, FR_KTT = 32, FR_QK = 48, FR_N = 56;
__device__ __forceinline__ int kperm(int g, int j) { return j < 4 ? 4 * g + j : 16 + 4 * g + (j - 4); }

typedef float f32x2_t __attribute__((ext_vector_type(2))); typedef __bf16 bf16x2_t __attribute__((ext_vector_type(2)));
__device__ __forceinline__ unsigned cvtpk_c(float lo, float hi) { const f32x2_t v = {lo, hi}; const bf16x2_t b = __builtin_convertvector(v, bf16x2_t); return __builtin_bit_cast(unsigned, b); }
__device__ __forceinline__ bf16x8 pack8(const f32x4 a, const f32x4 b) {
    return __builtin_bit_cast(bf16x8, (u32x4){cvtpk_c(a[0], a[1]), cvtpk_c(a[2], a[3]), cvtpk_c(b[0], b[1]), cvtpk_c(b[2], b[3])});
}
constexpr int DP_KP = 136;
constexpr int DP_RP = 72;
constexpr int DP_QS = 0, DP_KS = DP_QS + 64 * DP_KP * 2, DP_RHST = DP_KS + 64 * DP_KP * 2, DP_AM = DP_RHST + 256 * DP_RP * 2, DP_AMP = 68,
              DP_QKM = DP_AM + 64 * DP_AMP * 4, DP_QKP = 72, DP_GS = DP_QKM + 64 * DP_QKP * 2, DP_DM = DP_GS + 4 * 64 * 4, DP_DMP = 20,
              DP_TB = DP_DM + 64 * DP_DMP * 4, DP_END = DP_TB + 64 * DP_RP * 2;
static_assert(DP_END <= 131072 && DP_AM % 16 == 0 && DP_DM % 16 == 0 && DP_TB % 16 == 0 && DP_RHST % 16 == 0, "dnprep LDS");
#ifndef DPS
#define DPS(k)
#endif
__device__ __forceinline__ void phase_dnprep(const P& p, LAS unsigned char* lds, unsigned long long& pr_prev, unsigned long long& pr_acc) {
    const int tid_ = otid();
    LAS bf16_t* QS = (LAS bf16_t*)(lds + DP_QS); LAS bf16_t* KS = (LAS bf16_t*)(lds + DP_KS); LAS bf16_t* RHST = (LAS bf16_t*)(lds + DP_RHST);
    LAS float* AM = (LAS float*)(lds + DP_AM); LAS bf16_t* QKM = (LAS bf16_t*)(lds + DP_QKM); LAS float* GS = (LAS float*)(lds + DP_GS);
    LAS float* DM = (LAS float*)(lds + DP_DM); LAS bf16_t* TB = (LAS bf16_t*)(lds + DP_TB);
    const bf16_t* PR = ws_h(p, WS_PROJ); const float* BG = ws_f(p, WS_BG);
    for (int i = tid_; i < 64 * DP_RP / 2; i += NTHR) ((LAS unsigned*)TB)[i] = 0u;
    float pgx = 0.f, pbx = 0.f, cw[3][4][2]; unsigned xr[3][11];
#define DP_FETCH(uid_, ln_, wv_) do { const int n_ = (uid_) % NCHUNK, bh_ = (uid_) / NCHUNK, h_ = bh_ & 3, m0_ = (bh_ >> 2) * SEQ + n_ * 64; \
        if ((wv_) == 0) { pgx = BG[(size_t)(m0_ + (ln_)) * 8 + 4 + h_]; pbx = BG[(size_t)(m0_ + (ln_)) * 8 + h_]; } \
        _Pragma("unroll") for (int part = 0; part < 3; ++part) _Pragma("unroll") for (int j = 0; j < 4; ++j) { const float* w = p.dn_conv_w + j * 1536 + part * 512 + h_ * 128 + 2 * (ln_); cw[part][j][0] = w[0]; cw[part][j][1] = w[1]; } \
        _Pragma("unroll") for (int rr = 0; rr < 11; ++rr) { const int t_ = n_ * 64 + (wv_) * 8 + rr - 3; \
            _Pragma("unroll") for (int part = 0; part < 3; ++part) { unsigned v_ = 0u; if (t_ >= 0) v_ = *(const unsigned*)(PR + (size_t)(m0_ + (wv_) * 8 + rr - 3) * PLD + part * 512 + h_ * 128 + 2 * (ln_)); xr[part][rr] = v_; } } } while (0)
    if ((int)blockIdx.x < NUNIT) { int t0 = tid_; asm volatile("" : "+v"(t0)); DP_FETCH((int)blockIdx.x, t0 & 63, t0 >> 6); }
    for (int uid = blockIdx.x; uid < NUNIT; uid += gridDim.x) {
        const int n = uid % NCHUNK;
        int tid = tid_; asm volatile("" : "+v"(tid));
        const int lane = tid & 63, wave = tid >> 6, r16 = lane & 15, g4 = lane >> 4;
        unsigned char* abu = p.ws + WS_DNF_AB + (size_t)uid * DNF_AB_UNIT;
        if (wave == 0) {
            float x = pgx;
#pragma unroll
            for (int o = 1; o < 64; o <<= 1) { const float t = __shfl_up(x, o); if (lane >= o) x += t; }
            const float gl = __shfl(x, 63);
            GS[lane] = x; GS[64 + lane] = pbx; GS[128 + lane] = __expf(x); GS[192 + lane] = __expf(gl - x);
            if (lane == 0) ws_f(p, WS_DNF_CD)[uid] = __expf(gl);
        }
        __syncthreads();
        {
            float c[8][3][2], ssum[16];
#pragma unroll
            for (int i = 0; i < 8; ++i) {
#pragma unroll
                for (int part = 0; part < 3; ++part)
#pragma unroll
                    for (int e = 0; e < 2; ++e) { float a = 0.f;
#pragma unroll
                        for (int j = 0; j < 4; ++j) a += cw[part][j][e] * (e == 0 ? __builtin_bit_cast(float, xr[part][i + j] << 16) : __builtin_bit_cast(float, xr[part][i + j] & 0xffff0000u));
                        c[i][part][e] = a * __builtin_amdgcn_rcpf(1.0f + __expf(-a)); }
                ssum[2 * i] = c[i][0][0] * c[i][0][0] + c[i][0][1] * c[i][0][1]; ssum[2 * i + 1] = c[i][1][0] * c[i][1][0] + c[i][1][1] * c[i][1][1]; }
#pragma unroll
            for (int o = 1; o < 64; o <<= 1) {
#pragma unroll
                for (int q = 0; q < 16; ++q) ssum[q] += __shfl_xor(ssum[q], o); }
#pragma unroll
            for (int i = 0; i < 8; ++i) { const int row = wave * 8 + i;
                const float rq = 0.08838834764831845f * __builtin_amdgcn_rsqf(ssum[2 * i] + EPS), rk = __builtin_amdgcn_rsqf(ssum[2 * i + 1] + EPS);
                const float beta = GS[64 + row], eg = GS[128 + row];
                const float q0 = c[i][0][0] * rq, q1 = c[i][0][1] * rq, k0 = c[i][1][0] * rk, k1 = c[i][1][1] * rk;
                *(LAS unsigned*)(QS + row * DP_KP + 2 * lane) = pk2(q0, q1);
                *(LAS unsigned*)(KS + row * DP_KP + 2 * lane) = pk2(k0, k1);
                RHST[(2 * lane) * DP_RP + row] = f2bf(beta * c[i][2][0]); RHST[(2 * lane + 1) * DP_RP + row] = f2bf(beta * c[i][2][1]);
                RHST[(128 + 2 * lane) * DP_RP + row] = f2bf(beta * eg * k0); RHST[(128 + 2 * lane + 1) * DP_RP + row] = f2bf(beta * eg * k1); }
        }
        if (uid + (int)gridDim.x < NUNIT) DP_FETCH(uid + (int)gridDim.x, lane, wave);
        __syncthreads(); DPS(16);
        {
            const int ti = wave >> 1;
            f32x4 akk[2], aqk[2];
#pragma unroll
            for (int c = 0; c < 2; ++c) { akk[c] = (f32x4){0.f, 0.f, 0.f, 0.f}; aqk[c] = (f32x4){0.f, 0.f, 0.f, 0.f}; }
#pragma unroll
            for (int kb = 0; kb < 4; ++kb) {
                const bf16x8 ak = *(const LAS bf16x8*)(KS + (16 * ti + r16) * DP_KP + 32 * kb + 8 * g4), aq = *(const LAS bf16x8*)(QS + (16 * ti + r16) * DP_KP + 32 * kb + 8 * g4);
#pragma unroll
                for (int c = 0; c < 2; ++c) { const int tj = 2 * (wave & 1) + c; const bf16x8 bk = *(const LAS bf16x8*)(KS + (16 * tj + r16) * DP_KP + 32 * kb + 8 * g4);
                    akk[c] = __builtin_amdgcn_mfma_f32_16x16x32_bf16(ak, bk, akk[c], 0, 0, 0); aqk[c] = __builtin_amdgcn_mfma_f32_16x16x32_bf16(aq, bk, aqk[c], 0, 0, 0); }
            }
#pragma unroll
            for (int c = 0; c < 2; ++c) { const int tj = 2 * (wave & 1) + c, J = 16 * tj + r16; const float gj = GS[J];
#pragma unroll
                for (int i = 0; i < 4; ++i) { const int I = 16 * ti + 4 * g4 + i; const float dec = I >= J ? __expf(GS[I] - gj) : 0.f;
                    AM[I * DP_AMP + J] = I > J ? GS[64 + I] * akk[c][i] * dec : 0.f; QKM[I * DP_QKP + J] = f2bf(aqk[c][i] * dec); } }
        }
        __syncthreads(); DPS(17);
        if (wave == 0) {
            const int bb = g4, cc = r16; float t[16];
            f32x4 tr[16][4];
#pragma unroll
            for (int i = 1; i < 16; ++i)
#pragma unroll
                for (int j4 = 0; j4 < (i + 3) / 4; ++j4) tr[i][j4] = *(const LAS f32x4*)(AM + (16 * bb + i) * DP_AMP + 16 * bb + 4 * j4);
            __builtin_amdgcn_sched_barrier(0);
#pragma unroll
            for (int i = 0; i < 16; ++i) { float acc = (i == cc) ? 1.f : 0.f;
#pragma unroll
                for (int j = 0; j < i; ++j) acc -= tr[i][j >> 2][j & 3] * t[j];
                t[i] = acc; }
#pragma unroll
            for (int i = 0; i < 16; ++i) { DM[(16 * bb + i) * DP_DMP + cc] = t[i]; TB[(16 * bb + i) * DP_RP + 16 * bb + cc] = f2bf(t[i]); }
        } else if (wave >= 4) {
            for (int f = FR_QD + (wave - 4); f < FR_N; f += 4) {
                u32x4 o;
                if (f < FR_KTT) { const int mt = (f - FR_QD) >> 2, kb = (f - FR_QD) & 3, row = 16 * mt + r16; const float sc = GS[128 + row];
                    const u32x2 lo = *(const LAS u32x2*)(QS + row * DP_KP + 32 * kb + 4 * g4), hi = *(const LAS u32x2*)(QS + row * DP_KP + 32 * kb + 16 + 4 * g4);
                    const unsigned w[4] = {lo.x, lo.y, hi.x, hi.y}; unsigned r[4];
#pragma unroll
                    for (int e = 0; e < 4; ++e) r[e] = cvtpk_c(__builtin_bit_cast(float, w[e] << 16) * sc, __builtin_bit_cast(float, w[e] & 0xffff0000u) * sc);
                    o = (u32x4){r[0], r[1], r[2], r[3]};
                } else if (f < FR_QK) { const int kt = (f - FR_KTT) >> 1, tb = (f - FR_KTT) & 1; float v[8];
#pragma unroll
                    for (int j = 0; j < 8; ++j) { const int tok = 32 * tb + kperm(g4, j); v[j] = bf2f(KS[tok * DP_KP + 16 * kt + r16]) * GS[192 + tok]; }
                    o = (u32x4){cvtpk_c(v[0], v[1]), cvtpk_c(v[2], v[3]), cvtpk_c(v[4], v[5]), cvtpk_c(v[6], v[7])};
                } else { const int mt = (f - FR_QK) >> 1, tb = (f - FR_QK) & 1, row = 16 * mt + r16;
                    const u32x2 lo = *(const LAS u32x2*)(QKM + row * DP_QKP + 32 * tb + 4 * g4), hi = *(const LAS u32x2*)(QKM + row * DP_QKP + 32 * tb + 16 + 4 * g4);
                    o = (u32x4){lo.x, lo.y, hi.x, hi.y}; }
                *(u32x4*)(abu + (size_t)f * 1024 + lane * 16) = o;
            }
        }
        __syncthreads(); DPS(18);
        if (wave < 3) {
            const int j = wave; f32x4 Tk[4];
#pragma unroll
            for (int kk = 0; kk < 4; ++kk) Tk[j][kk] = DM[(16 * j + 4 * g4 + kk) * DP_DMP + r16];
#pragma unroll
            for (int i = 1; i < 4; ++i) if (i > j) {
                f32x4 acc = (f32x4){0.f, 0.f, 0.f, 0.f};
#pragma unroll
                for (int k = 0; k < 3; ++k) if (k >= j && k < i) { const f32x4 a = *(const LAS f32x4*)(AM + (16 * i + r16) * DP_AMP + 16 * k + 4 * g4);
#pragma unroll
                    for (int kk = 0; kk < 4; ++kk) acc = __builtin_amdgcn_mfma_f32_16x16x4f32(a[kk], Tk[k][kk], acc, 0, 0, 0); }
                const f32x4 dd = *(const LAS f32x4*)(DM + (16 * i + r16) * DP_DMP + 4 * g4);
                f32x4 res = (f32x4){0.f, 0.f, 0.f, 0.f};
#pragma unroll
                for (int kk = 0; kk < 4; ++kk) res = __builtin_amdgcn_mfma_f32_16x16x4f32(dd[kk], acc[kk], res, 0, 0, 0);
                Tk[i] = -res;
#pragma unroll
                for (int e = 0; e < 4; ++e) TB[(16 * i + 4 * g4 + e) * DP_RP + 16 * j + r16] = f2bf(Tk[i][e]); }
        }
        __syncthreads(); DPS(19);
        {
            const int mt = wave & 3, half = wave >> 2;
            bf16x8 tf[2];
#pragma unroll
            for (int kb = 0; kb < 2; ++kb) tf[kb] = *(const LAS bf16x8*)(TB + (16 * mt + r16) * DP_RP + 32 * kb + 8 * g4);
            if (half == 0) {
                float* wv = (float*)(p.ws + WS_DNF_WV + (size_t)uid * DNF_WV_UNIT) + (size_t)mt * 256 + lane * 4;
#pragma unroll
                for (int vt = 0; vt < 8; ++vt) { f32x4 acc = (f32x4){0.f, 0.f, 0.f, 0.f};
#pragma unroll
                    for (int kb = 0; kb < 2; ++kb) acc = __builtin_amdgcn_mfma_f32_16x16x32_bf16(tf[kb], *(const LAS bf16x8*)(RHST + (16 * vt + r16) * DP_RP + 32 * kb + 8 * g4), acc, 0, 0, 0);
                    *(f32x4*)(wv + (size_t)vt * 1024) = acc; }
            } else {
#pragma unroll
                for (int kbp = 0; kbp < 4; ++kbp) { f32x4 xt[2];
#pragma unroll
                    for (int c2 = 0; c2 < 2; ++c2) { xt[c2] = (f32x4){0.f, 0.f, 0.f, 0.f};
#pragma unroll
                        for (int kb = 0; kb < 2; ++kb) xt[c2] = __builtin_amdgcn_mfma_f32_16x16x32_bf16(*(const LAS bf16x8*)(RHST + (128 + 16 * (2 * kbp + c2) + r16) * DP_RP + 32 * kb + 8 * g4), tf[kb], xt[c2], 0, 0, 0); }
                    *(u32x4*)(abu + (size_t)(FR_NWK + mt * 4 + kbp) * 1024 + lane * 16) = __builtin_bit_cast(u32x4, pack8(-xt[0], -xt[1])); }
            }
        }
        __syncthreads(); DPS(20);
    }
#undef DP_FETCH
}

constexpr size_t O_ODN = O_Y;
#define DN_SB() __builtin_amdgcn_sched_barrier(0)
__device__ __forceinline__ void dn_consume(const LAS unsigned char* fb, int wl, f32x4 (&S)[8], float cd, float* op) {
    f32x4 u[4], o[4];
    bf16x8 fa[16], fq[16], Sb[4], Ub[2];
#pragma unroll
    for (int mt = 0; mt < 4; ++mt) u[mt] = *(const LAS f32x4*)(fb + (FR_N + wl * 4 + mt) * 1024);
#pragma unroll
    for (int f = 0; f < 16; ++f) fa[f] = *(const LAS bf16x8*)(fb + (FR_NWK + f) * 1024);
#pragma unroll
    for (int f = 0; f < 16; ++f) fq[f] = *(const LAS bf16x8*)(fb + (FR_QD + f) * 1024);
    DN_SB();
#pragma unroll
    for (int kb = 0; kb < 4; ++kb) Sb[kb] = pack8(S[2 * kb], S[2 * kb + 1]);
#pragma unroll
    for (int mt = 0; mt < 4; ++mt)
#pragma unroll
        for (int kb = 0; kb < 4; ++kb) u[mt] = __builtin_amdgcn_mfma_f32_16x16x32_bf16(fa[mt * 4 + kb], Sb[kb], u[mt], 0, 0, 0);
    DN_SB();
#pragma unroll
    for (int f = 0; f < 16; ++f) fa[f] = *(const LAS bf16x8*)(fb + (FR_KTT + f) * 1024);
    DN_SB();
#pragma unroll
    for (int mt = 0; mt < 4; ++mt) { o[mt] = (f32x4){0.f, 0.f, 0.f, 0.f};
#pragma unroll
        for (int kb = 0; kb < 4; ++kb) o[mt] = __builtin_amdgcn_mfma_f32_16x16x32_bf16(fq[mt * 4 + kb], Sb[kb], o[mt], 0, 0, 0); }
    DN_SB();
#pragma unroll
    for (int f = 0; f < 8; ++f) fq[f] = *(const LAS bf16x8*)(fb + (FR_QK + f) * 1024);
#pragma unroll
    for (int tb = 0; tb < 2; ++tb) Ub[tb] = pack8(u[2 * tb], u[2 * tb + 1]);
#pragma unroll
    for (int kt = 0; kt < 8; ++kt) S[kt] = S[kt] * cd;
    DN_SB();
#pragma unroll
    for (int kt = 0; kt < 8; ++kt)
#pragma unroll
        for (int tb = 0; tb < 2; ++tb) S[kt] = __builtin_amdgcn_mfma_f32_16x16x32_bf16(fa[kt * 2 + tb], Ub[tb], S[kt], 0, 0, 0);
#pragma unroll
    for (int mt = 0; mt < 4; ++mt) {
#pragma unroll
        for (int tb = 0; tb < 2; ++tb) o[mt] = __builtin_amdgcn_mfma_f32_16x16x32_bf16(fq[mt * 2 + tb], Ub[tb], o[mt], 0, 0, 0);
#pragma unroll
        for (int i = 0; i < 4; ++i) op[(size_t)(16 * mt + i) * 512] = o[mt][i]; }
}
constexpr int DN_SBUF = 73728;
__device__ __forceinline__ void phase_dnscan(const P& p, LAS unsigned char* lds) {
    if (blockIdx.x >= BATCH * 4 * 2) return;
    const int tid = otid(), lane = tid & 63, wave = __builtin_amdgcn_readfirstlane(tid >> 6), r16 = lane & 15, g4 = lane >> 4;
    const int bh = blockIdx.x >> 1, vh = blockIdx.x & 1, h = bh & 3, b = bh >> 2, wl = wave & 3, vs = vh * 4 + wl, v0 = vs * 16;
    const float* cdp = ws_f(p, WS_DNF_CD) + (size_t)bh * NCHUNK;
    float* odn = p.out + O_ODN;
#define DN_BAR() do { asm volatile("s_waitcnt lgkmcnt(0)" ::: "memory"); __builtin_amdgcn_s_barrier(); asm volatile("" ::: "memory"); } while (0)
    if (wave >= 4) {
        const unsigned char* ab = p.ws + WS_DNF_AB + (size_t)bh * NCHUNK * DNF_AB_UNIT + lane * 16;
        const unsigned char* wvb = p.ws + WS_DNF_WV + (size_t)bh * NCHUNK * DNF_WV_UNIT + (size_t)vh * 16 * 1024 + lane * 16;
        u32x4 R[3][18];
#define DN_SRC(n_, q_) ((q_) < FR_N ? ab + (size_t)(n_) * DNF_AB_UNIT + (q_) * 1024 : wvb + (size_t)(n_) * DNF_WV_UNIT + ((q_) - FR_N) * 1024)
#define DN_LD(n_, s_) do { if ((n_) < NCHUNK) { _Pragma("unroll") for (int i_ = 0; i_ < 18; ++i_) R[s_][i_] = *(const u32x4*)DN_SRC(n_, wl * 18 + i_); } } while (0)
#define DN_ST(n_, s_) do { if ((n_) < NCHUNK) { LAS unsigned char* d_ = lds + ((n_) & 1) * DN_SBUF + wl * 18 * 1024 + lane * 16; _Pragma("unroll") for (int i_ = 0; i_ < 18; ++i_) *(LAS u32x4*)(d_ + i_ * 1024) = R[s_][i_]; } } while (0)
        DN_LD(0, 0); DN_LD(1, 1); DN_LD(2, 2); DN_ST(0, 0);
        DN_BAR();
#define DN_LSTEP(n_, s_) do { const int n = (n_); if (n < NCHUNK) { DN_LD(n + 3, s_); DN_ST(n + 1, ((s_) + 1) % 3); DN_BAR(); } } while (0)
        for (int n3 = 0; n3 < NCHUNK; n3 += 3) { DN_LSTEP(n3, 0); DN_LSTEP(n3 + 1, 1); DN_LSTEP(n3 + 2, 2); }
#undef DN_LSTEP
#undef DN_LD
#undef DN_ST
#undef DN_SRC
        return;
    }
    f32x4 S[8];
#pragma unroll
    for (int t = 0; t < 8; ++t) S[t] = (f32x4){0.f, 0.f, 0.f, 0.f};
    float cd = cdp[0];
    DN_BAR();
    for (int n = 0; n < NCHUNK; ++n) {
        const float cdn = cdp[n + 1 < NCHUNK ? n + 1 : n];
        dn_consume(lds + (n & 1) * DN_SBUF + lane * 16, wl, S, cd, odn + (size_t)(b * SEQ + n * 64 + 4 * g4) * 512 + h * 128 + v0 + r16);
        cd = cdn;
        DN_BAR();
    }
#undef DN_BAR
    {
        float* so = p.out + O_PSSM + (size_t)bh * 128 * 128 + v0 + r16;
#pragma unroll
        for (int kt = 0; kt < 8; ++kt)
#pragma unroll
            for (int i = 0; i < 4; ++i) so[(size_t)(16 * kt + 4 * g4 + i) * 128] = S[kt][i];
    }
}
__device__ __forceinline__ void phase_dngate(const P& p) {
    const int tid_ = otid(), lane = tid_ & 63, wave = tid_ >> 6;
    const int gw = blockIdx.x * NWAVES + wave, NGW = gridDim.x * NWAVES;
    const f32x4 nw0 = *(const f32x4*)(p.dn_norm_w + (lane & 15) * 8), nw1 = *(const f32x4*)(p.dn_norm_w + (lane & 15) * 8 + 4);
    f32x4 a, c; u32x4 z;
#define DG_LOAD(m_) do { const float* o_ = p.out + O_ODN + (size_t)(m_) * 512 + lane * 8; a = *(const f32x4*)o_; c = *(const f32x4*)(o_ + 4); z = *(const u32x4*)(ws_h(p, WS_PROJ) + (size_t)(m_) * PLD + PC_Z + lane * 8); } while (0)
    if (gw < TP) DG_LOAD(gw);
    for (int m = gw; m < TP; m += NGW) {
        const f32x4 a0 = a, c0 = c; const u32x4 z0 = z;
        if (m + NGW < TP) DG_LOAD(m + NGW);
        float ss = (a0[0] * a0[0] + a0[1] * a0[1]) + (a0[2] * a0[2] + a0[3] * a0[3]) + (c0[0] * c0[0] + c0[1] * c0[1]) + (c0[2] * c0[2] + c0[3] * c0[3]);
#pragma unroll
        for (int off = 1; off < 16; off <<= 1) ss += __shfl_xor(ss, off);
        const float rstd = 1.0f / sqrtf(ss * (1.0f / 128.0f) + EPS);
        const unsigned zw[4] = {z0.x, z0.y, z0.z, z0.w}; const float ov[8] = {a0[0], a0[1], a0[2], a0[3], c0[0], c0[1], c0[2], c0[3]}; const float nwv[8] = {nw0[0], nw0[1], nw0[2], nw0[3], nw1[0], nw1[1], nw1[2], nw1[3]};
        unsigned r[4];
#pragma unroll
        for (int e = 0; e < 4; ++e) { const float z0f = __builtin_bit_cast(float, zw[e] << 16), z1f = __builtin_bit_cast(float, zw[e] & 0xffff0000u);
            r[e] = pk2(ov[2 * e] * rstd * nwv[2 * e] * silu_f(z0f), ov[2 * e + 1] * rstd * nwv[2 * e + 1] * silu_f(z1f)); }
        *(u32x4*)(ws_h(p, WS_MIX) + (size_t)m * 1024 + lane * 8) = (u32x4){r[0], r[1], r[2], r[3]};
    }
#undef DG_LOAD
}
__device__ __forceinline__ void phase_dnsample(const P& p, LAS unsigned char* lds) {
    const int tid = otid(), lane = tid & 63, us = tid >> 8, w4 = (tid >> 6) & 3, kh = lane >> 5, col_ = w4 * 32 + (lane & 31);
    LAS float* QH = (LAS float*)lds + us * 4352;
    LAS float* KH = QH + 1024; LAS float* VH = QH + 2048; LAS float* OH = QH + 3072; LAS float* RED = QH + 4096;
    const bf16_t* PR = ws_h(p, WS_PROJ); const float* BG = ws_f(p, WS_BG);
    for (int ub = blockIdx.x; ub < DEC_BATCH * 2; ub += gridDim.x) {
        const int uidx = ub * 2 + us, b = uidx >> 2, h = uidx & 3, m0 = TP + b * DEC_SEQ;
        int col = col_; asm volatile("" : "+v"(col));
        {
            float x0[11], x1[11];
            const int ch0 = kh * 512 + h * 128 + col;
#pragma unroll
            for (int rr = 0; rr < 11; ++rr) {
                if (rr < 3) { const float* st = p.state_dn_conv + ((size_t)b * 3 + rr) * 1536; x0[rr] = st[ch0]; x1[rr] = st[1024 + h * 128 + col]; }
                else { const bf16_t* pr = PR + (size_t)(m0 + rr - 3) * PLD; x0[rr] = bf2f(pr[ch0]); x1[rr] = bf2f(pr[1024 + h * 128 + col]); } }
            float w0[4], w1[4];
#pragma unroll
            for (int j = 0; j < 4; ++j) { w0[j] = p.dn_conv_w[j * 1536 + ch0]; w1[j] = p.dn_conv_w[j * 1536 + 1024 + h * 128 + col]; }
#pragma unroll
            for (int t = 0; t < 8; ++t) { float a = 0.f, d = 0.f;
#pragma unroll
                for (int j = 0; j < 4; ++j) { a += w0[j] * x0[t + j]; d += w1[j] * x1[t + j]; }
                a = silu_f(a); d = silu_f(d);
                if (kh == 0) { QH[t * 128 + col] = a; VH[t * 128 + col] = d; } else KH[t * 128 + col] = a;
                const float sq = wave_sum(kh == 0 ? a * a : 0.f), sk = wave_sum(kh == 1 ? a * a : 0.f);
                if (lane == 0) { RED[w4 * 16 + t] = sq; RED[w4 * 16 + 8 + t] = sk; } }
        }
        __syncthreads();
#pragma unroll
        for (int t = 0; t < 8; ++t) {
            if (kh == 0) { const float sq = (RED[t] + RED[16 + t]) + (RED[32 + t] + RED[48 + t]); QH[t * 128 + col] *= 0.08838834764831845f / sqrtf(sq + EPS); }
            else { const float sk = (RED[8 + t] + RED[24 + t]) + (RED[40 + t] + RED[56 + t]); KH[t * 128 + col] *= 1.0f / sqrtf(sk + EPS); } }
        __syncthreads();
        float S[64];
        const float* S0 = p.state_dn_ssm + ((size_t)b * 4 + h) * 128 * 128 + (size_t)kh * 64 * 128 + col;
#pragma unroll
        for (int k = 0; k < 64; ++k) { S[k] = *S0; S0 += 128; if ((k & 7) == 7) asm volatile("" : "+v"(S0)); }
#pragma unroll 1
        for (int t = 0; t < 8; ++t) {
            const float beta = BG[(size_t)(m0 + t) * 8 + h], eg = expf(BG[(size_t)(m0 + t) * 8 + 4 + h]);
            const LAS float* kp = KH + t * 128 + kh * 64; const LAS float* qp = QH + t * 128 + kh * 64;
            float kS = 0.f;
#pragma unroll
            for (int k4 = 0; k4 < 16; ++k4) { const f32x4 kk = *(const LAS f32x4*)(kp + 4 * k4);
#pragma unroll
                for (int e = 0; e < 4; ++e) { S[4 * k4 + e] *= eg; kS += kk[e] * S[4 * k4 + e]; } }
            kS += __shfl_xor(kS, 32);
            const float u = beta * (VH[t * 128 + col] - kS);
            float o = 0.f;
#pragma unroll
            for (int k4 = 0; k4 < 16; ++k4) { const f32x4 kk = *(const LAS f32x4*)(kp + 4 * k4), qq = *(const LAS f32x4*)(qp + 4 * k4);
#pragma unroll
                for (int e = 0; e < 4; ++e) { S[4 * k4 + e] += kk[e] * u; o += qq[e] * S[4 * k4 + e]; } }
            o += __shfl_xor(o, 32);
            if (kh == 0) OH[t * 128 + col] = o;
        }
        float* So = p.out + O_SSSM + ((size_t)b * 4 + h) * 128 * 128 + (size_t)kh * 64 * 128 + col;
#pragma unroll
        for (int k = 0; k < 64; ++k) { *So = S[k]; So += 128; if ((k & 7) == 7) asm volatile("" : "+v"(So)); }
        __syncthreads();
#pragma unroll
        for (int t = 0; t < 8; ++t) { const float o = kh == 0 ? OH[t * 128 + col] : 0.f; const float s = wave_sum(o * o); if (lane == 0) RED[w4 * 16 + t] = s; }
        __syncthreads();
        if (kh == 0) {
            const float nw = p.dn_norm_w[col];
#pragma unroll
            for (int t = 0; t < 8; ++t) { const float rstd = 1.0f / sqrtf(((RED[t] + RED[16 + t]) + (RED[32 + t] + RED[48 + t])) * (1.0f / 128.0f) + EPS);
                const float z = bf2f(PR[(size_t)(m0 + t) * PLD + PC_Z + h * 128 + col]);
                ws_h(p, WS_MIX)[(size_t)(m0 + t) * 1024 + h * 128 + col] = f2bf(OH[t * 128 + col] * rstd * nw * silu_f(z)); }
        }
        __syncthreads();
    }
}
constexpr size_t WS_EDGE = WS_FREE;
constexpr size_t WS_HEAD = al256(WS_EDGE + (size_t)(T / 256) * 2 * 2 * DFF * 4);
constexpr size_t WS_END = al256(WS_HEAD + (size_t)(T / 256) * 2 * 2 * DFF * 4);
constexpr int EX_OFF = 131072;
namespace pg8 {
typedef unsigned u32x2v __attribute__((ext_vector_type(2)));
__device__ __forceinline__ float dpp_shr1(float old, float src) { return __builtin_bit_cast(float, __builtin_amdgcn_update_dpp(__builtin_bit_cast(int, old), __builtin_bit_cast(int, src), 0x111, 0xf, 0xf, false)); }
__device__ __forceinline__ float dpp_shr2(float old, float src) { return __builtin_bit_cast(float, __builtin_amdgcn_update_dpp(__builtin_bit_cast(int, old), __builtin_bit_cast(int, src), 0x112, 0xf, 0xf, false)); }
__device__ __forceinline__ float dpp_ror1(float src) { return __builtin_bit_cast(float, __builtin_amdgcn_update_dpp(0, __builtin_bit_cast(int, src), 0x121, 0xf, 0xf, false)); }
__device__ __forceinline__ float dpp_ror2(float src) { return __builtin_bit_cast(float, __builtin_amdgcn_update_dpp(0, __builtin_bit_cast(int, src), 0x122, 0xf, 0xf, false)); }
struct EpiFfnUp {
    static constexpr bool PERM = false, AFTER_DRAIN = false;
    bf16_t* ACT; float* edge; float* head; const float* cw; const float* cb; const float* state; float* out_pfc; float* out_sfc; PG8_LAS unsigned char* lds;
    __device__ __forceinline__ void operator()(const f32x4 (&acc)[2][2][4][2], const Unit& u, int wr, int wc, int fr, int fq) const {
        PG8_LAS float* EX = (PG8_LAS float*)(lds + EX_OFF);
        const bool smp = u.pm >= TP / BM;
        const int cl = wc * 32 + 4 * fq;
        if (fr >= 14) {
#pragma unroll
            for (int ai = 0; ai < 2; ++ai)
#pragma unroll
                for (int bj = 0; bj < 2; ++bj)
#pragma unroll
                    for (int n = 0; n < 2; ++n) *(PG8_LAS f32x4*)(EX + ((2 * ai + wr) * 2 + (fr - 14)) * 256 + bj * HALF + cl + 16 * n) = acc[ai][bj][3][n];
            if (wr == 1) {
#pragma unroll
                for (int bj = 0; bj < 2; ++bj)
#pragma unroll
                    for (int n = 0; n < 2; ++n) { const int oc = bj * DFF + u.pn * HALF + cl + 16 * n;
                        *(f32x4*)(edge + ((size_t)u.pm * 2 + (fr - 14)) * 2 * DFF + oc) = acc[1][bj][3][n];
                        if (!smp && (u.pm & (SEQ / BM - 1)) == SEQ / BM - 1) *(f32x4*)(out_pfc + ((size_t)(u.pm / (SEQ / BM)) * 2 + (fr - 14)) * 2 * DFF + oc) = acc[1][bj][3][n]; }
            }
        }
        if (fr < 2 && wr == 0) {
#pragma unroll
            for (int bj = 0; bj < 2; ++bj)
#pragma unroll
                for (int n = 0; n < 2; ++n) *(f32x4*)(head + ((size_t)u.pm * 2 + fr) * 2 * DFF + bj * DFF + u.pn * HALF + cl + 16 * n) = acc[0][bj][0][n];
        }
        asm volatile("s_waitcnt lgkmcnt(0)" ::: "memory"); __builtin_amdgcn_s_barrier(); asm volatile("" ::: "memory");
#pragma unroll
        for (int n = 0; n < 2; ++n) {
            const int f0 = u.pn * HALF + cl + 16 * n;
            f32x4 wg[3], wu[3], bg, bu;
#pragma unroll
            for (int j = 0; j < 3; ++j) { wg[j] = *(const f32x4*)(cw + (size_t)j * 2 * DFF + f0); wu[j] = *(const f32x4*)(cw + (size_t)j * 2 * DFF + DFF + f0); }
            bg = *(const f32x4*)(cb + f0); bu = *(const f32x4*)(cb + DFF + f0);
#pragma unroll
            for (int ai = 0; ai < 2; ++ai) {
                const int s = 2 * ai + wr;
                f32x4 pg = (f32x4){0.f, 0.f, 0.f, 0.f}, pu = pg;
                if (!smp && s > 0 && fr >= 14) { pg = *(const PG8_LAS f32x4*)(EX + ((s - 1) * 2 + (fr - 14)) * 256 + cl + 16 * n); pu = *(const PG8_LAS f32x4*)(EX + ((s - 1) * 2 + (fr - 14)) * 256 + HALF + cl + 16 * n); }
#pragma unroll
                for (int m = 0; m < 4; ++m) {
                    const f32x4 cg = acc[ai][0][m][n], cu = acc[ai][1][m][n];
                    const int row = u.pm * BM + ai * HALF + wr * 64 + m * 16 + fr;
                    f32x4 g1, g2, u1, u2;
#pragma unroll
                    for (int e = 0; e < 4; ++e) { g1[e] = dpp_shr1(dpp_ror1(pg[e]), cg[e]); g2[e] = dpp_shr2(dpp_ror2(pg[e]), cg[e]); u1[e] = dpp_shr1(dpp_ror1(pu[e]), cu[e]); u2[e] = dpp_shr2(dpp_ror2(pu[e]), cu[e]); }
                    if (smp) {
                        const int t = fr & 7, b = (row - TP) >> 3;
                        if (t < 2) { const float* st = state + (size_t)b * 2 * 2 * DFF + f0; const f32x4 s1g = *(const f32x4*)(st + 2 * DFF), s1u = *(const f32x4*)(st + 2 * DFF + DFF);
                            if (t == 0) { g1 = s1g; u1 = s1u; g2 = *(const f32x4*)st; u2 = *(const f32x4*)(st + DFF); } else { g2 = s1g; u2 = s1u; } }
                        if (t >= 6) { float* o = out_sfc + ((size_t)b * 2 + (t - 6)) * 2 * DFF + f0; *(f32x4*)o = cg; *(f32x4*)(o + DFF) = cu; }
                    }
                    const f32x4 gc = wg[0] * g2 + wg[1] * g1 + wg[2] * cg + bg, uc = wu[0] * u2 + wu[1] * u1 + wu[2] * cu + bu;
                    u32x2v w;
                    { const float a0 = gc[0] / (1.0f + __expf(-gc[0])) * uc[0], a1 = gc[1] / (1.0f + __expf(-gc[1])) * uc[1], a2 = gc[2] / (1.0f + __expf(-gc[2])) * uc[2], a3 = gc[3] / (1.0f + __expf(-gc[3])) * uc[3];
                      w.x = cvt_pk_bf16(a0, a1); w.y = cvt_pk_bf16(a2, a3); }
                    *(u32x2v*)(ACT + (size_t)row * DFF + f0) = w;
                    pg = cg; pu = cu;
                }
            }
        }
    }
};
}
__device__ __forceinline__ void phase_ffn_fix(const P& p) {
    constexpr int TPS = SEQ / 256;
    const long n = (long)(BATCH * TPS) * DFF;
    const float* edge = ws_f(p, WS_EDGE); const float* head = ws_f(p, WS_HEAD);
    for (long i = blockIdx.x * (long)NTHR + otid(); i < n; i += (long)gridDim.x * NTHR) {
        const int pm = (int)(i / DFF), f = (int)(i % DFF);
        if (pm % TPS == 0) continue;
        float r0[2], r1[2];
#pragma unroll
        for (int gu = 0; gu < 2; ++gu) { const int c = gu * DFF + f;
            const float um2 = edge[((size_t)(pm - 1) * 2 + 0) * 2 * DFF + c], um1 = edge[((size_t)(pm - 1) * 2 + 1) * 2 * DFF + c], u0 = head[((size_t)pm * 2 + 0) * 2 * DFF + c], u1 = head[((size_t)pm * 2 + 1) * 2 * DFF + c];
            const float w0 = p.ffn_conv_w[c], w1 = p.ffn_conv_w[2 * DFF + c], w2 = p.ffn_conv_w[4 * DFF + c], bb = p.ffn_conv_b[c];
            r0[gu] = w0 * um2 + w1 * um1 + w2 * u0 + bb; r1[gu] = w0 * um1 + w1 * u0 + w2 * u1 + bb; }
        bf16_t* ACT = ws_h(p, WS_ACT) + (size_t)pm * 256 * DFF + f;
        ACT[0] = f2bf(silu_f(r0[0]) * r0[1]); ACT[DFF] = f2bf(silu_f(r1[0]) * r1[1]);
    }
}
constexpr int SW_KP = 72;
__device__ __forceinline__ void swa_qtile(const LAS bf16_t* KS, const LAS bf16_t* VT, int vtp, int qt, const bf16_t* qptr, int qrow_mask, const LAS float* BT, float sink, bool first, bf16_t* optr, int nvalid_q, int lane) {
    const int r16 = lane & 15, g4 = lane >> 4, kt0 = qt;
    bf16x8 bq[2];
#pragma unroll
    for (int ks = 0; ks < 2; ++ks) bq[ks] = *(const bf16x8*)(qptr + (size_t)(r16 & qrow_mask) * PLD + 32 * ks + 8 * g4);
    f32x4 s[10];
#pragma unroll
    for (int t = 0; t < 9; ++t) { f32x4 a = (f32x4){0.f, 0.f, 0.f, 0.f};
#pragma unroll
        for (int ks = 0; ks < 2; ++ks) a = __builtin_amdgcn_mfma_f32_16x16x32_bf16(*(const LAS bf16x8*)(KS + (16 * (kt0 + t) + r16) * SW_KP + 32 * ks + 8 * g4), bq[ks], a, 0, 0, 0);
        s[t] = a; }
    float mx = sink;
#pragma unroll
    for (int t = 0; t < 9; ++t)
#pragma unroll
        for (int e = 0; e < 4; ++e) { const int jj = 16 * (kt0 + t) + 4 * g4 + e, d = 128 + 16 * qt + r16 - jj; const bool ok = d >= 0 && d <= 127 && !(first && jj < 128);
            const float v = ok ? s[t][e] * 0.125f + BT[ok ? d : 0] : -1e30f; s[t][e] = v; mx = fmaxf(mx, v); }
    mx = fmaxf(mx, __shfl_xor(mx, 16)); mx = fmaxf(mx, __shfl_xor(mx, 32));
    float l = 0.f;
#pragma unroll
    for (int t = 0; t < 9; ++t)
#pragma unroll
        for (int e = 0; e < 4; ++e) { const float pv = __expf(s[t][e] - mx); s[t][e] = pv; l += pv; }
    s[9] = (f32x4){0.f, 0.f, 0.f, 0.f};
    l += __shfl_xor(l, 16); l += __shfl_xor(l, 32);
    l += __expf(sink - mx);
    const float rl = 1.0f / l;
    bf16x8 pb[5];
#pragma unroll
    for (int q = 0; q < 5; ++q) pb[q] = pack8(s[2 * q], s[2 * q + 1]);
#pragma unroll
    for (int dt = 0; dt < 4; ++dt) { f32x4 o = (f32x4){0.f, 0.f, 0.f, 0.f};
#pragma unroll
        for (int q = 0; q < 5; ++q) { const LAS bf16_t* vp = VT + (16 * dt + r16) * vtp + 16 * (kt0 + 2 * q) + 4 * g4;
            const u32x2 lo = *(const LAS u32x2*)vp, hi = *(const LAS u32x2*)(vp + 16);
            o = __builtin_amdgcn_mfma_f32_16x16x32_bf16(__builtin_bit_cast(bf16x8, (u32x4){lo.x, lo.y, hi.x, hi.y}), pb[q], o, 0, 0, 0); }
        if (r16 < nvalid_q) *(u32x2*)(optr + (size_t)r16 * 1024 + 16 * dt + 4 * g4) = (u32x2){cvtpk_c(o[0] * rl, o[1] * rl), cvtpk_c(o[2] * rl, o[3] * rl)}; }
}
constexpr int SWP_VTP = 272, SWS_NK = 144, SWS_VTP = 168;
constexpr int SW_KS = 0, SW_VT = 43008, SW_BT = 86016, SW_END = SW_BT + 8 * 128 * 4;
static_assert(256 * SW_KP * 2 <= SW_VT && SW_VT + 64 * SWP_VTP * 2 <= SW_BT && 2 * SWS_NK * SW_KP * 2 <= SW_VT && SW_VT + 2 * 64 * SWS_VTP * 2 <= SW_BT, "swa LDS map");
__device__ __forceinline__ void phase_swa(const P& p, LAS unsigned char* lds) {
    const int tid = otid(), lane = tid & 63, wave = tid >> 6;
    LAS bf16_t* KS = (LAS bf16_t*)(lds + SW_KS); LAS bf16_t* VT = (LAS bf16_t*)(lds + SW_VT); LAS float* BT = (LAS float*)(lds + SW_BT);
    const bf16_t* PR = ws_h(p, WS_PROJ); bf16_t* MX = ws_h(p, WS_MIX);
    constexpr int NQB = SEQ / 128, NPU = BATCH * NQB * 2, NU = NPU + DEC_BATCH;
    for (int i = tid; i < 8 * 128; i += NTHR) BT[i] = p.rel_bias[t5_bucket(i & 127) * 8 + (i >> 7)];
    for (int u = blockIdx.x; u < NU; u += gridDim.x) {
        __syncthreads();
        if (u < NPU) {
            const int kvh = u & 1, qb = (u >> 1) % NQB, b = (u >> 1) / NQB, m0 = b * SEQ + qb * 128; const bool first = qb == 0;
            for (int it = tid; it < 256 * 8; it += NTHR) { const int jj = it >> 3, c = it & 7; u32x4 v = (u32x4){0u, 0u, 0u, 0u};
                if (!(first && jj < 128)) v = *(const u32x4*)(PR + (size_t)(m0 - 128 + jj) * PLD + PC_SK + kvh * 64 + 8 * c);
                *(LAS u32x4*)(KS + jj * SW_KP + 8 * c) = v; }
            for (int it = tid; it < 272 * 8; it += NTHR) { const int jj = it % 272, c = it / 272; u32x4 v = (u32x4){0u, 0u, 0u, 0u};
                if (jj < 256 && !(first && jj < 128)) v = *(const u32x4*)(PR + (size_t)(m0 - 128 + jj) * PLD + PC_SV + kvh * 64 + 8 * c);
                const unsigned w[4] = {v.x, v.y, v.z, v.w};
#pragma unroll
                for (int e = 0; e < 4; ++e) { VT[(8 * c + 2 * e) * SWP_VTP + jj] = (bf16_t)(w[e] & 0xffffu); VT[(8 * c + 2 * e + 1) * SWP_VTP + jj] = (bf16_t)(w[e] >> 16); } }
            __syncthreads();
            const int hq = kvh * 4 + (wave >> 1), qh = wave & 1;
#pragma unroll 1
            for (int q4 = 0; q4 < 4; ++q4) { const int qt = 4 * qh + q4;
                swa_qtile(KS, VT, SWP_VTP, qt, PR + (size_t)(m0 + 16 * qt) * PLD + PC_SQ + hq * 64, 15, BT + hq * 128, p.swa_sinks[hq], first, MX + (size_t)(m0 + 16 * qt) * 1024 + 512 + hq * 64, 16, lane); }
        } else {
            const int b = u - NPU, m0 = TP + b * DEC_SEQ;
            for (int it = tid; it < 2 * SWS_NK * 8; it += NTHR) { const int kvh = it / (SWS_NK * 8), r = it % (SWS_NK * 8), jj = r >> 3, c = r & 7; u32x4 v = (u32x4){0u, 0u, 0u, 0u};
                if (jj < 128) { const float* src = p.cache_k + ((size_t)b * 128 + jj) * 128 + kvh * 64 + 8 * c; const f32x4 a = *(const f32x4*)src, d = *(const f32x4*)(src + 4);
                    v = (u32x4){pk2(a[0], a[1]), pk2(a[2], a[3]), pk2(d[0], d[1]), pk2(d[2], d[3])}; }
                else if (jj < 128 + DEC_SEQ) v = *(const u32x4*)(PR + (size_t)(m0 + jj - 128) * PLD + PC_SK + kvh * 64 + 8 * c);
                *(LAS u32x4*)(KS + (kvh * SWS_NK + jj) * SW_KP + 8 * c) = v; }
            for (int it = tid; it < 2 * SWS_VTP * 8; it += NTHR) { const int kvh = it / (SWS_VTP * 8), r = it % (SWS_VTP * 8), jj = r % SWS_VTP, c = r / SWS_VTP; float f[8];
#pragma unroll
                for (int e = 0; e < 8; ++e) f[e] = 0.f;
                if (jj < 128) { const float* src = p.cache_v + ((size_t)b * 128 + jj) * 128 + kvh * 64 + 8 * c; const f32x4 a = *(const f32x4*)src, d = *(const f32x4*)(src + 4);
                    f[0] = a[0]; f[1] = a[1]; f[2] = a[2]; f[3] = a[3]; f[4] = d[0]; f[5] = d[1]; f[6] = d[2]; f[7] = d[3]; }
                else if (jj < 128 + DEC_SEQ) { const bf16_t* src = PR + (size_t)(m0 + jj - 128) * PLD + PC_SV + kvh * 64 + 8 * c;
#pragma unroll
                    for (int e = 0; e < 8; ++e) f[e] = bf2f(src[e]); }
#pragma unroll
                for (int e = 0; e < 8; ++e) VT[(kvh * 64 + 8 * c + e) * SWS_VTP + jj] = f2bf(f[e]); }
            __syncthreads();
            const int kvh = wave >> 2, hq = kvh * 4 + (wave & 3);
            swa_qtile(KS + kvh * SWS_NK * SW_KP, VT + kvh * 64 * SWS_VTP, SWS_VTP, 0, PR + (size_t)m0 * PLD + PC_SQ + hq * 64, 7, BT + hq * 128, p.swa_sinks[hq], false, MX + (size_t)m0 * 1024 + 512 + hq * 64, 8, lane);
        }
    }
    __syncthreads();
}
static void fill_params(P& p, void* const* d_in, void* d_out, void* d_ws) {
    const float** pp = (const float**)&p;
    for (int i = 0; i < 26; ++i) pp[i] = (const float*)d_in[i];
    p.out = (float*)d_out; p.ws = (unsigned char*)d_ws;
}
namespace cg = cooperative_groups;
constexpr int CW_BAR = 1024;
constexpr size_t CTL_ZERO_BYTES = 65536;

#ifndef PROBE_MASK
#define PROBE_MASK 0
#endif
#ifndef PROBE_K
#define PROBE_K 4
#endif
#ifndef PROBE_XSYNC
#define PROBE_XSYNC 0
#endif
#if PROBE_MASK
#define PROBE_SUB(k) do { xcd_barrier(bar); PROBE_STAMP(k); } while (0)
#define PROBE_DECL unsigned long long pr_prev = __builtin_amdgcn_s_memrealtime(), pr_acc = 0ull
#define PROBE_STAMP(k) do { const unsigned long long now_ = __builtin_amdgcn_s_memrealtime(); if ((PROBE_MASK >> (k)) & 1) pr_acc += now_ - pr_prev; pr_prev = now_; } while (0)
#define PROBE_END() do { xcd_barrier(bar); PROBE_STAMP(11); if (blockIdx.x == 0 && threadIdx.x == 0) { const unsigned long long t0_ = __builtin_amdgcn_s_memrealtime(); while (__builtin_amdgcn_s_memrealtime() - t0_ < (unsigned long long)PROBE_K * pr_acc) __builtin_amdgcn_s_sleep(8); } } while (0)
#else
#define PROBE_DECL unsigned long long pr_prev = 0ull, pr_acc = 0ull
#define PROBE_SUB(k)
#define PROBE_STAMP(k)
#define PROBE_END() do { for (int i_ = 0; i_ < PROBE_XSYNC; ++i_) xcd_barrier(bar); } while (0)
#endif
__global__ void __launch_bounds__(512, 2) fwd_megakernel(P p) {
    extern __shared__ __attribute__((aligned(16))) unsigned char lds_raw[];
    LAS unsigned char* lds = (LAS unsigned char*)lds_raw;
    cg::grid_group grid = cg::this_grid();
    PROBE_DECL;
    volatile LAS unsigned* MISC = (volatile LAS unsigned*)(lds + LDS_BYTES - 64);
    if (threadIdx.x < 16) MISC[threadIdx.x] = 0u;
    __syncthreads();
    const XcdBarrier bar = xcd_barrier_post((unsigned*)(p.ws + WS_CTL) + CW_BAR, MISC);
    phase_mod(p, lds); phase_transposes(p, lds);
    grid.sync(); PROBE_STAMP(0);
    phase_norm<0>(p);
    xcd_barrier(bar); PROBE_STAMP(1);
    { pg8::StaticOrder S; pg8::Gemm g{ws_h(p, WS_H), ws_h(p, WS_WT_IN), T, PLD, D}; S.init(T, PLD, gridDim.x, blockIdx.x); pg8::EpiStoreBf16 E{ws_h(p, WS_PROJ), PLD};
      pg8::gemm_phase<pg8::EpiStoreBf16, pg8::StaticOrder, true, true>(lds, g, S, E); }
    xcd_barrier(bar); PROBE_STAMP(2);
    phase_state_out(p);
    PROBE_STAMP(21);
    phase_dnprep(p, lds, pr_prev, pr_acc);
    PROBE_SUB(12);
    phase_dnsample(p, lds);
    PROBE_SUB(13);
    phase_swa(p, lds);
    xcd_barrier(bar); PROBE_STAMP(3);
    phase_dnscan(p, lds);
    xcd_barrier(bar); PROBE_STAMP(4);
    phase_dngate(p);
    xcd_barrier(bar); PROBE_STAMP(5);
    { pg8::StaticOrder S; pg8::Gemm g{ws_h(p, WS_MIX), ws_h(p, WS_WT_OUT), T, D, 1024}; S.init(T, D, gridDim.x, blockIdx.x); pg8::EpiGateRes E{p.x_prompt, p.x_sample, p.out + O_Y, ws_f(p, WS_MOD) + 2 * D};
      pg8::gemm_phase<pg8::EpiGateRes, pg8::StaticOrder, true, true>(lds, g, S, E); }
    xcd_barrier(bar); PROBE_STAMP(6);
    phase_norm<1>(p);
    xcd_barrier(bar); PROBE_STAMP(7);
    { pg8::StaticOrder S; pg8::Gemm g{ws_h(p, WS_H), ws_h(p, WS_WT_UP), T, 2 * DFF, D}; S.init(T, 2 * DFF, gridDim.x, blockIdx.x);
      pg8::EpiFfnUp E{ws_h(p, WS_ACT), ws_f(p, WS_EDGE), ws_f(p, WS_HEAD), p.ffn_conv_w, p.ffn_conv_b, p.state_ffn, p.out + O_PFC, p.out + O_SFC, lds};
      pg8::gemm_phase<pg8::EpiFfnUp, pg8::StaticOrder, true, true>(lds, g, S, E); }
    xcd_barrier(bar); PROBE_STAMP(8);
    phase_ffn_fix(p);
    xcd_barrier(bar); PROBE_STAMP(9);
    { pg8::StaticOrder S; pg8::Gemm g{ws_h(p, WS_ACT), ws_h(p, WS_WT_DN), T, D, DFF}; S.init(T, D, gridDim.x, blockIdx.x); pg8::EpiGateRes E{p.out + O_Y, p.out + O_Y + (size_t)TP * D, p.out + O_Y, ws_f(p, WS_MOD) + 5 * D};
      pg8::gemm_phase<pg8::EpiGateRes, pg8::StaticOrder, true, true>(lds, g, S, E); }
    xcd_barrier(bar); PROBE_STAMP(10);
    phase_norm<2>(p);
    PROBE_END();
}
extern "C" void kernel_launch(void* const* d_in, const int* in_sizes, int n_in, void* d_out, int out_size, void* d_ws, size_t ws_size, hipStream_t stream) {
    static int grid_blocks = 0;
    if (grid_blocks == 0) {
        if (n_in != 26 || (long)out_size != O_END || ws_size < WS_END) { fprintf(stderr, "kernel_launch: unexpected shapes n_in=%d out=%d ws=%zu (need %zu)\n", n_in, out_size, ws_size, (size_t)WS_END); grid_blocks = -1; return; }
        int dev = 0, cus = 0, per_cu = 0;
        if (hipGetDevice(&dev) != hipSuccess || hipDeviceGetAttribute(&cus, hipDeviceAttributeMultiprocessorCount, dev) != hipSuccess) { grid_blocks = -1; return; }
        if (hipFuncSetAttribute((const void*)fwd_megakernel, hipFuncAttributeMaxDynamicSharedMemorySize, LDS_BYTES) != hipSuccess) { fprintf(stderr, "kernel_launch: hipFuncSetAttribute failed\n"); grid_blocks = -1; return; }
        if (hipOccupancyMaxActiveBlocksPerMultiprocessor(&per_cu, (const void*)fwd_megakernel, NTHR, LDS_BYTES) != hipSuccess || per_cu < 1) { fprintf(stderr, "kernel_launch: occupancy query says %d\n", per_cu); grid_blocks = -1; return; }
        grid_blocks = cus;
        fprintf(stderr, "kernel_launch: grid %d (cus %d, per_cu %d)\n", grid_blocks, cus, per_cu);
    }
    if (grid_blocks < 0) return;
    P p{}; fill_params(p, d_in, d_out, d_ws);
    if (hipMemsetAsync((char*)d_ws + WS_CTL, 0, CTL_ZERO_BYTES, stream) != hipSuccess) { fprintf(stderr, "kernel_launch: memset of the control words failed\n"); return; }
    void* args[] = {&p};
    const hipError_t e = hipLaunchCooperativeKernel((const void*)fwd_megakernel, dim3(grid_blocks), dim3(NTHR), args, LDS_BYTES, stream);
    if (e != hipSuccess) fprintf(stderr, "cooperative launch failed: %s (grid %d)\n", hipGetErrorString(e), grid_blocks);
}
```

```cpp
#define PROBE_MASK 0
#define PROBE_XSYNC 0
#include <hip/hip_runtime.h>
#include <hip/hip_cooperative_groups.h>
#include <cstdio>
#include <cstdint>
#define HD __device__ __forceinline__
#if defined(PROBE_MASK) && PROBE_MASK
#define DPS(k) do { const unsigned long long now_ = __builtin_amdgcn_s_memrealtime(); if ((PROBE_MASK >> (k)) & 1) pr_acc += now_ - pr_prev; pr_prev = now_; } while (0)
#endif
#ifndef CFG_D_MODEL
#define CFG_D_MODEL 1024
#endif
#ifndef CFG_SEQ
#define CFG_SEQ 8192
#endif
#ifndef CFG_DEC_BATCH
#define CFG_DEC_BATCH 128
#endif
#ifndef CFG_D_FF
#define CFG_D_FF 2816
#endif

constexpr int D = CFG_D_MODEL, BATCH = 2, SEQ = CFG_SEQ, DEC_BATCH = CFG_DEC_BATCH, DEC_SEQ = 8, DFF = CFG_D_FF;
constexpr int TP = BATCH * SEQ, TS = DEC_BATCH * DEC_SEQ, T = TP + TS, NCB = BATCH + DEC_BATCH;
constexpr int IN_COLS = 2824, PLD = 2816;
constexpr int PC_QKV = 0, PC_Z = 1536, PC_SQ = 2048, PC_SK = 2560, PC_SV = 2688;
constexpr int WC_BA = 2048;
constexpr float EPS = 1e-6f;

constexpr long O_Y = 0;
constexpr long O_PDC = (long)T * D;
constexpr long O_SDC = O_PDC + (long)BATCH * 3 * 1536;
constexpr long O_PSSM = O_SDC + (long)DEC_BATCH * 3 * 1536;
constexpr long O_SSSM = O_PSSM + (long)BATCH * 4 * 128 * 128;
constexpr long O_PK = O_SSSM + (long)DEC_BATCH * 4 * 128 * 128;
constexpr long O_SK = O_PK + (long)BATCH * 128 * 128;
constexpr long O_PV = O_SK + (long)DEC_BATCH * 128 * 128;
constexpr long O_SV = O_PV + (long)BATCH * 128 * 128;
constexpr long O_PFC = O_SV + (long)DEC_BATCH * 128 * 128;
constexpr long O_SFC = O_PFC + (long)BATCH * 2 * 2 * DFF;
constexpr long O_END = O_SFC + (long)DEC_BATCH * 2 * 2 * DFF;

constexpr size_t al256(size_t x) { return (x + 255) & ~(size_t)255; }
constexpr size_t WS_CTL = 0;
constexpr size_t WS_MOD = 1u << 20;
constexpr size_t WS_BG = al256(WS_MOD + (size_t)NCB * 6 * D * 4);
constexpr size_t WS_WBAT = al256(WS_BG + (size_t)T * 8 * 4);
constexpr size_t WS_WT_IN = al256(WS_WBAT + (size_t)8 * D * 4);
constexpr size_t WS_WT_OUT = al256(WS_WT_IN + (size_t)PLD * D * 2);
constexpr size_t WS_WT_UP = al256(WS_WT_OUT + (size_t)D * 1024 * 2);
constexpr size_t WS_WT_DN = al256(WS_WT_UP + (size_t)2 * DFF * D * 2);
constexpr size_t WS_H = al256(WS_WT_DN + (size_t)D * DFF * 2);
constexpr int NCHUNK = SEQ / 64, NUNIT = BATCH * 4 * NCHUNK;
constexpr int DNF_AB_UNIT = 57344, DNF_WV_UNIT = 32768;
constexpr size_t WS_DNF_WV = WS_H;
constexpr size_t WS_DNF_AB = al256(WS_H + (size_t)T * (D > 1024 ? D : 1024) * 2);
constexpr size_t WS_DNF_CD = al256(WS_DNF_AB + (size_t)NUNIT * DNF_AB_UNIT);
constexpr size_t WS_QKVC = WS_DNF_AB;
constexpr size_t WS_PROJ = al256((WS_DNF_CD + (size_t)NUNIT * 4) > (WS_QKVC + (size_t)T * 1536 * 2) ? (WS_DNF_CD + (size_t)NUNIT * 4) : (WS_QKVC + (size_t)T * 1536 * 2));
constexpr size_t WS_MIX = al256(WS_PROJ + (size_t)T * PLD * 2);
constexpr size_t WS_FREE = al256(WS_MIX + (size_t)T * 1024 * 2);
constexpr size_t WS_ODN = WS_H, WS_ACT = WS_PROJ;
static_assert((size_t)NUNIT * DNF_WV_UNIT <= (size_t)T * 1024 * 2, "Wv tiles overlay H");

typedef unsigned short bf16_t;
HD unsigned f2bf_bits(float f) { unsigned u = __builtin_bit_cast(unsigned, f); return (u + 0x7fffu + ((u >> 16) & 1u)) >> 16; }
HD bf16_t f2bf(float f) { return (bf16_t)f2bf_bits(f); }
HD float bf2f(bf16_t b) { return __builtin_bit_cast(float, (unsigned)b << 16); }
HD float silu_f(float x) { return x / (1.0f + expf(-x)); }
HD float sigmoid_f(float x) { return 1.0f / (1.0f + expf(-x)); }
HD float softplus_f(float x) { return x > 20.f ? x : log1pf(expf(x)); }

struct P {
    const float *x_prompt, *x_sample, *state_dn_conv, *state_dn_ssm, *cache_k, *cache_v, *state_ffn, *c_prompt, *c_sample, *rel_bias,
        *final_norm_w, *w_ada, *b_ada, *norm_mix_w, *w_in, *dn_conv_w, *dn_A_log, *dn_dt_bias, *dn_norm_w, *swa_sinks, *w_out, *norm_ffn_w,
        *w_up, *ffn_conv_w, *ffn_conv_b, *w_down;
    float* out; unsigned char* ws;
};

HD const float* xrow(const P& p, int m) { return m < TP ? p.x_prompt + (size_t)m * D : p.x_sample + (size_t)(m - TP) * D; }
HD int cb_of(int m) { return m < TP ? m / SEQ : BATCH + (m - TP) / DEC_SEQ; }
HD int t_of(int m) { return m < TP ? m % SEQ : (m - TP) % DEC_SEQ; }
HD float* ws_f(const P& p, size_t off) { return (float*)(p.ws + off); }
HD bf16_t* ws_h(const P& p, size_t off) { return (bf16_t*)(p.ws + off); }

HD int t5_bucket(int d) {
    if (d < 16) return d;
    const float logv = logf((float)d / 16.0f) / 2.0794415416798357f;
    int b = 16 + (int)(logv * 16.0f);
    return b < 31 ? b : 31;
}

constexpr long N_R0A = (long)NCB * 6 * D;
HD void r0a_body(long idx, const P& p) {
    const int cb = (int)(idx / (6 * D)), e = (int)(idx % (6 * D));
    const float* c = cb < BATCH ? p.c_prompt + (size_t)cb * D : p.c_sample + (size_t)(cb - BATCH) * D;
    float acc = 0.f;
    for (int d = 0; d < D; ++d) acc += silu_f(c[d]) * p.w_ada[(size_t)d * 6 * D + e];
    ws_f(p, WS_MOD)[idx] = acc + p.b_ada[e];
}
constexpr long N_R1 = T;
template <int WHICH> HD void r1_body(long idx, const P& p) {
    const int m = (int)idx, cb = cb_of(m);
    const float* xr = WHICH == 0 ? xrow(p, m) : p.out + O_Y + (size_t)m * D;
    const float* nw = WHICH == 0 ? p.norm_mix_w : p.norm_ffn_w;
    const float* mod = ws_f(p, WS_MOD) + (size_t)cb * 6 * D;
    const float* sh = mod + (WHICH == 0 ? 0 : 3 * D); const float* sc = mod + (WHICH == 0 ? D : 4 * D);
    float ss = 0.f;
    for (int k = 0; k < D; ++k) ss += xr[k] * xr[k];
    const float rstd = 1.0f / sqrtf(ss / (float)D + EPS);
    float ba[8];
#pragma unroll
    for (int j = 0; j < 8; ++j) ba[j] = 0.f;
    bf16_t* H = ws_h(p, WS_H) + (size_t)m * D;
    for (int k = 0; k < D; ++k) {
        const float h = xr[k] * rstd * nw[k] * (1.0f + sc[k]) + sh[k];
        H[k] = f2bf(h);
        if (WHICH == 0) {
#pragma unroll
            for (int j = 0; j < 8; ++j) ba[j] += h * p.w_in[(size_t)k * IN_COLS + WC_BA + j];
        }
    }
    if (WHICH == 0) {
        float* bg = ws_f(p, WS_BG) + (size_t)m * 8;
#pragma unroll
        for (int j = 0; j < 4; ++j) {
            bg[j] = sigmoid_f(ba[j]);
            bg[4 + j] = -expf(p.dn_A_log[j]) * softplus_f(ba[4 + j] + p.dn_dt_bias[j]);
        }
    }
}
constexpr long N_R2 = (long)(T / 8) * PLD;
HD void r2_body(long idx, const P& p) {
    const int mg = (int)(idx / PLD), n = (int)(idx % PLD), oc = n < WC_BA ? n : n + 8;
    const bf16_t* H = ws_h(p, WS_H) + (size_t)mg * 8 * D;
    float acc[8];
#pragma unroll
    for (int i = 0; i < 8; ++i) acc[i] = 0.f;
    for (int k = 0; k < D; ++k) {
        const float w = bf2f(f2bf(p.w_in[(size_t)k * IN_COLS + oc]));
#pragma unroll
        for (int i = 0; i < 8; ++i) acc[i] += bf2f(H[(size_t)i * D + k]) * w;
    }
    bf16_t* PR = ws_h(p, WS_PROJ);
#pragma unroll
    for (int i = 0; i < 8; ++i) PR[(size_t)(mg * 8 + i) * PLD + n] = f2bf(acc[i]);
}
constexpr long N_R2B_1 = (long)BATCH * 3 * 1536, N_R2B_2 = (long)DEC_BATCH * 3 * 1536, N_R2B_3 = (long)BATCH * 128 * 128, N_R2B_4 = (long)DEC_BATCH * 128 * 128;
constexpr long N_R2B = N_R2B_1 + N_R2B_2 + 2 * (N_R2B_3 + N_R2B_4);
HD void r2b_body(long idx, const P& p) {
    const bf16_t* PR = ws_h(p, WS_PROJ);
    long r = idx;
    if (r < N_R2B_1) { const int b = (int)(r / (3 * 1536)), j = (int)(r / 1536 % 3), c = (int)(r % 1536);
        p.out[O_PDC + r] = bf2f(PR[(size_t)(b * SEQ + SEQ - 3 + j) * PLD + PC_QKV + c]); return; }
    r -= N_R2B_1;
    if (r < N_R2B_2) { const int b = (int)(r / (3 * 1536)), j = (int)(r / 1536 % 3), c = (int)(r % 1536);
        p.out[O_SDC + r] = bf2f(PR[(size_t)(TP + b * DEC_SEQ + DEC_SEQ - 3 + j) * PLD + PC_QKV + c]); return; }
    r -= N_R2B_2;
    for (int kv = 0; kv < 2; ++kv) {
        const int pc = kv == 0 ? PC_SK : PC_SV; const float* cache = kv == 0 ? p.cache_k : p.cache_v;
        if (r < N_R2B_3) { const int b = (int)(r / (128 * 128)), j = (int)(r / 128 % 128), c = (int)(r % 128);
            p.out[(kv == 0 ? O_PK : O_PV) + r] = bf2f(PR[(size_t)(b * SEQ + SEQ - 128 + j) * PLD + pc + c]); return; }
        r -= N_R2B_3;
        if (r < N_R2B_4) { const int b = (int)(r / (128 * 128)), j = (int)(r / 128 % 128), c = (int)(r % 128);
            float v;
            if (j < 128 - DEC_SEQ) v = cache[((size_t)b * 128 + j + DEC_SEQ) * 128 + c];
            else v = bf2f(PR[(size_t)(TP + b * DEC_SEQ + (j - (128 - DEC_SEQ))) * PLD + pc + c]);
            p.out[(kv == 0 ? O_SK : O_SV) + r] = v; return; }
        r -= N_R2B_4;
    }
}
constexpr long N_R3 = (long)T * 12;
HD float r3_conv(const P& p, int m, int t, int ch) {
    const bf16_t* PR = ws_h(p, WS_PROJ);
    float acc = 0.f;
#pragma unroll
    for (int j = 0; j < 4; ++j) {
        const int tt = t - 3 + j; float xv;
        if (tt >= 0) xv = bf2f(PR[(size_t)(m - (t - tt)) * PLD + PC_QKV + ch]);
        else xv = m < TP ? 0.f : p.state_dn_conv[((size_t)((m - TP) / DEC_SEQ) * 3 + (3 + tt)) * 1536 + ch];
        acc += p.dn_conv_w[j * 1536 + ch] * xv;
    }
    return silu_f(acc);
}
HD void r3_body(long idx, const P& p) {
    const int m = (int)(idx / 12), grp = (int)(idx % 12), part = grp / 4, cbase = grp * 128, t = t_of(m);
    float scale = 1.f;
    if (part < 2) {
        float ss = 0.f;
        for (int c = 0; c < 128; ++c) { const float v = r3_conv(p, m, t, cbase + c); ss += v * v; }
        scale = 1.0f / sqrtf(ss + EPS);
        if (part == 0) scale *= 0.08838834764831845f;
    }
    bf16_t* Q = ws_h(p, WS_QKVC) + (size_t)m * 1536 + cbase;
    for (int c = 0; c < 128; ++c) Q[c] = f2bf(r3_conv(p, m, t, cbase + c) * scale);
}
constexpr long N_R4 = (long)NCB * 4 * 128;
HD void r4_body(long idx, const P& p) {
    const int seq = (int)(idx / 512), h = (int)(idx / 128 % 4), v = (int)(idx % 128);
    const bool smp = seq >= BATCH; const int b = smp ? seq - BATCH : seq;
    float* S = p.out + (smp ? O_SSSM : O_PSSM) + ((size_t)b * 4 + h) * 128 * 128 + v;
    const float* S0 = smp ? p.state_dn_ssm + ((size_t)b * 4 + h) * 128 * 128 + v : nullptr;
    for (int k = 0; k < 128; ++k) S[(size_t)k * 128] = smp ? S0[(size_t)k * 128] : 0.f;
    const int L = smp ? DEC_SEQ : SEQ, m0 = smp ? TP + b * DEC_SEQ : b * SEQ;
    const bf16_t* QK = ws_h(p, WS_QKVC); const float* BG = ws_f(p, WS_BG); float* ODN = ws_f(p, WS_ODN);
    for (int t = 0; t < L; ++t) {
        const int m = m0 + t;
        const bf16_t* q = QK + (size_t)m * 1536 + h * 128; const bf16_t* kk = q + 512; const float vv = bf2f(q[1024 + v]);
        const float beta = BG[(size_t)m * 8 + h], eg = expf(BG[(size_t)m * 8 + 4 + h]);
        float kS = 0.f;
        for (int k = 0; k < 128; ++k) kS += bf2f(kk[k]) * (S[(size_t)k * 128] * eg);
        const float u = beta * (vv - kS);
        float o = 0.f;
        for (int k = 0; k < 128; ++k) { const float s = S[(size_t)k * 128] * eg + bf2f(kk[k]) * u; S[(size_t)k * 128] = s; o += bf2f(q[k]) * s; }
        ODN[(size_t)m * 512 + h * 128 + v] = o;
    }
}
constexpr long N_R5 = (long)T * 4;
HD void r5_body(long idx, const P& p) {
    const int m = (int)(idx / 4), h = (int)(idx % 4);
    const float* o = ws_f(p, WS_ODN) + (size_t)m * 512 + h * 128;
    float ss = 0.f;
    for (int v = 0; v < 128; ++v) ss += o[v] * o[v];
    const float rstd = 1.0f / sqrtf(ss / 128.0f + EPS);
    const bf16_t* z = ws_h(p, WS_PROJ) + (size_t)m * PLD + PC_Z + h * 128;
    bf16_t* mix = ws_h(p, WS_MIX) + (size_t)m * 1024 + h * 128;
    for (int v = 0; v < 128; ++v) mix[v] = f2bf(o[v] * rstd * p.dn_norm_w[v] * silu_f(bf2f(z[v])));
}
constexpr long N_R6 = (long)T * 8 * 8;
HD void r6_body(long idx, const P& p) {
    const int m = (int)(idx / 64), hq = (int)(idx / 8 % 8), dg = (int)(idx % 8), kvh = hq / 4, t = t_of(m);
    const bool smp = m >= TP; const int b = smp ? (m - TP) / DEC_SEQ : 0;
    const bf16_t* PR = ws_h(p, WS_PROJ);
    const bf16_t* q = PR + (size_t)m * PLD + PC_SQ + hq * 64;
    const float sink = p.swa_sinks[hq];
    const int nk = smp ? 128 : (t < 127 ? t + 1 : 128);
    float mx = sink;
    for (int pass = 0; pass < 2; ++pass) {
        float den = 0.f, acc[8];
#pragma unroll
        for (int i = 0; i < 8; ++i) acc[i] = 0.f;
        for (int jj = 0; jj < nk; ++jj) {
            int dist; const float* kf = nullptr; const float* vf = nullptr; const bf16_t* kb = nullptr; const bf16_t* vb = nullptr;
            if (smp) { const int j = t + 1 + jj; dist = 128 + t - j;
                if (j < 128) { kf = p.cache_k + ((size_t)b * 128 + j) * 128 + kvh * 64; vf = p.cache_v + ((size_t)b * 128 + j) * 128 + kvh * 64; }
                else { const size_t mm = (size_t)(TP + b * DEC_SEQ + (j - 128)); kb = PR + mm * PLD + PC_SK + kvh * 64; vb = PR + mm * PLD + PC_SV + kvh * 64; } }
            else { dist = nk - 1 - jj; const size_t mm = (size_t)(m - dist); kb = PR + mm * PLD + PC_SK + kvh * 64; vb = PR + mm * PLD + PC_SV + kvh * 64; }
            float s = 0.f;
            for (int d = 0; d < 64; ++d) s += bf2f(q[d]) * (kf ? kf[d] : bf2f(kb[d]));
            s = s * 0.125f + p.rel_bias[t5_bucket(dist) * 8 + hq];
            if (pass == 0) { mx = s > mx ? s : mx; }
            else { const float pr = expf(s - mx); den += pr;
#pragma unroll
                for (int i = 0; i < 8; ++i) acc[i] += pr * (vf ? vf[dg * 8 + i] : bf2f(vb[dg * 8 + i])); }
        }
        if (pass == 1) { den += expf(sink - mx); bf16_t* mix = ws_h(p, WS_MIX) + (size_t)m * 1024 + 512 + hq * 64 + dg * 8;
#pragma unroll
            for (int i = 0; i < 8; ++i) mix[i] = f2bf(acc[i] / den); }
    }
}
constexpr long N_R7 = (long)(T / 8) * D;
HD void r7_body(long idx, const P& p) {
    const int mg = (int)(idx / D), d = (int)(idx % D);
    const bf16_t* MX = ws_h(p, WS_MIX) + (size_t)mg * 8 * 1024;
    float acc[8];
#pragma unroll
    for (int i = 0; i < 8; ++i) acc[i] = 0.f;
    for (int e = 0; e < 1024; ++e) { const float w = bf2f(f2bf(p.w_out[(size_t)e * D + d]));
#pragma unroll
        for (int i = 0; i < 8; ++i) acc[i] += bf2f(MX[(size_t)i * 1024 + e]) * w; }
#pragma unroll
    for (int i = 0; i < 8; ++i) { const int m = mg * 8 + i; const float g1 = ws_f(p, WS_MOD)[(size_t)cb_of(m) * 6 * D + 2 * D + d];
        p.out[O_Y + (size_t)m * D + d] = xrow(p, m)[d] + g1 * acc[i]; }
}
constexpr long N_R9 = (long)(T / 8) * DFF;
HD void r9_body(long idx, const P& p) {
    const int mg = (int)(idx / DFF), f = (int)(idx % DFF), m0 = mg * 8, t0 = t_of(m0);
    const bool smp = m0 >= TP; const int b = smp ? (m0 - TP) / DEC_SEQ : m0 / SEQ;
    const bf16_t* H = ws_h(p, WS_H);
    float ug[10], uu[10];
#pragma unroll
    for (int i = 0; i < 10; ++i) { ug[i] = 0.f; uu[i] = 0.f; }
    const bool halo = (!smp && t0 > 0);
    for (int k = 0; k < D; ++k) {
        const float wg = bf2f(f2bf(p.w_up[(size_t)k * 2 * DFF + f])), wu = bf2f(f2bf(p.w_up[(size_t)k * 2 * DFF + DFF + f]));
#pragma unroll
        for (int i = 0; i < 10; ++i) { if (i < 2 && !halo) continue; const float h = bf2f(H[(size_t)(m0 - 2 + i) * D + k]); ug[i] += h * wg; uu[i] += h * wu; }
    }
    if (smp) {
#pragma unroll
        for (int i = 0; i < 2; ++i) { ug[i] = p.state_ffn[((size_t)b * 2 + i) * 2 * DFF + f]; uu[i] = p.state_ffn[((size_t)b * 2 + i) * 2 * DFF + DFF + f]; }
    }
    const float w0g = p.ffn_conv_w[f], w1g = p.ffn_conv_w[2 * DFF + f], w2g = p.ffn_conv_w[4 * DFF + f], bgt = p.ffn_conv_b[f];
    const float w0u = p.ffn_conv_w[DFF + f], w1u = p.ffn_conv_w[3 * DFF + f], w2u = p.ffn_conv_w[5 * DFF + f], bup = p.ffn_conv_b[DFF + f];
    bf16_t* ACT = ws_h(p, WS_ACT);
#pragma unroll
    for (int i = 0; i < 8; ++i) {
        const float gc = w0g * ug[i] + w1g * ug[i + 1] + w2g * ug[i + 2] + bgt, uc = w0u * uu[i] + w1u * uu[i + 1] + w2u * uu[i + 2] + bup;
        ACT[(size_t)(m0 + i) * DFF + f] = f2bf(silu_f(gc) * uc);
    }
    if (smp) {
#pragma unroll
        for (int j = 0; j < 2; ++j) { float* o = p.out + O_SFC + ((size_t)b * 2 + j) * 2 * DFF; o[f] = ug[8 + j]; o[DFF + f] = uu[8 + j]; }
    } else if (t0 == SEQ - 8) {
#pragma unroll
        for (int j = 0; j < 2; ++j) { float* o = p.out + O_PFC + ((size_t)b * 2 + j) * 2 * DFF; o[f] = ug[8 + j]; o[DFF + f] = uu[8 + j]; }
    }
}
constexpr long N_R10 = (long)(T / 8) * D;
HD void r10_body(long idx, const P& p) {
    const int mg = (int)(idx / D), d = (int)(idx % D);
    const bf16_t* A = ws_h(p, WS_ACT) + (size_t)mg * 8 * DFF;
    float acc[8];
#pragma unroll
    for (int i = 0; i < 8; ++i) acc[i] = 0.f;
    for (int f = 0; f < DFF; ++f) { const float w = bf2f(f2bf(p.w_down[(size_t)f * D + d]));
#pragma unroll
        for (int i = 0; i < 8; ++i) acc[i] += bf2f(A[(size_t)i * DFF + f]) * w; }
#pragma unroll
    for (int i = 0; i < 8; ++i) { const int m = mg * 8 + i; const float g2 = ws_f(p, WS_MOD)[(size_t)cb_of(m) * 6 * D + 5 * D + d];
        float* o = p.out + O_Y + (size_t)m * D + d; *o = *o + g2 * acc[i]; }
}
constexpr long N_R11 = T, N_R8 = T;
HD void r11_body(long idx, const P& p) {
    float* xr = p.out + O_Y + (size_t)idx * D;
    float ss = 0.f;
    for (int k = 0; k < D; ++k) ss += xr[k] * xr[k];
    const float rstd = 1.0f / sqrtf(ss / (float)D + EPS);
    for (int k = 0; k < D; ++k) xr[k] = xr[k] * rstd * p.final_norm_w[k];
}
#define LAS __attribute__((address_space(3)))
typedef float f32x4 __attribute__((ext_vector_type(4)));
typedef unsigned u32x4 __attribute__((ext_vector_type(4)));
typedef unsigned u32x2 __attribute__((ext_vector_type(2)));
constexpr int NWAVES = 8, NTHR = 512;
constexpr int LDS_BYTES = 163840;
__device__ __forceinline__ int otid() { int t = threadIdx.x; asm volatile("" : "+v"(t)); return t; }
__device__ __forceinline__ float wave_sum(float v) {
#pragma unroll
    for (int o = 1; o < 64; o <<= 1) v += __shfl_xor(v, o);
    return v;
}
__device__ __forceinline__ unsigned pk2(float lo, float hi) { return f2bf_bits(lo) | (f2bf_bits(hi) << 16); }

__device__ __forceinline__ void transpose_item(const float* W, int ldw, int K, bf16_t* WT, int dst_n0, int src_n0, int k0, LAS float* scr, int lane) {
#pragma unroll
    for (int i = 0; i < 32; ++i) { const int kk = 2 * i + (lane >> 5); scr[kk * 33 + (lane & 31)] = W[(size_t)(k0 + kk) * ldw + src_n0 + (lane & 31)]; }
    asm volatile("s_waitcnt lgkmcnt(0)" ::: "memory");
    const int c = lane & 7;
#pragma unroll
    for (int j = 0; j < 4; ++j) { const int n = (lane >> 3) + 8 * j; const LAS float* s = scr + (8 * c) * 33 + n;
        u32x4 o; o.x = pk2(s[0 * 33], s[1 * 33]); o.y = pk2(s[2 * 33], s[3 * 33]); o.z = pk2(s[4 * 33], s[5 * 33]); o.w = pk2(s[6 * 33], s[7 * 33]);
        *(u32x4*)(WT + (size_t)(dst_n0 + n) * K + k0 + 8 * c) = o; }
    asm volatile("s_waitcnt lgkmcnt(0)" ::: "memory");
}
constexpr int TI_IN = (PLD / 32) * (D / 64), TI_OUT = (D / 32) * (1024 / 64), TI_UP = (2 * DFF / 32) * (D / 64), TI_DN = (D / 32) * (DFF / 64), TI_ALL = TI_IN + TI_OUT + TI_UP + TI_DN;
__device__ __forceinline__ void phase_transposes(const P& p, LAS unsigned char* lds) {
    const int tid_ = otid(), lane = tid_ & 63, wave = tid_ >> 6;
    if (blockIdx.x == gridDim.x - 1) { for (int i = tid_; i < 8 * D; i += NTHR) ws_f(p, WS_WBAT)[i] = p.w_in[(size_t)(i % D) * IN_COLS + WC_BA + i / D]; }
    LAS float* scr = (LAS float*)(lds + wave * 16384);
    const int gw = blockIdx.x * NWAVES + wave, NGW = gridDim.x * NWAVES;
    for (int it = gw; it < TI_ALL; it += NGW) {
        int r = it;
        if (r < TI_IN) { const int nb = r % (PLD / 32), kb = r / (PLD / 32), n0 = nb * 32; transpose_item(p.w_in, IN_COLS, D, ws_h(p, WS_WT_IN), n0, n0 < WC_BA ? n0 : n0 + 8, kb * 64, scr, lane); continue; } r -= TI_IN;
        if (r < TI_OUT) { const int nb = r % (D / 32), kb = r / (D / 32), n0 = nb * 32; transpose_item(p.w_out, D, 1024, ws_h(p, WS_WT_OUT), n0, n0, kb * 64, scr, lane); continue; } r -= TI_OUT;
        if (r < TI_UP) { const int nb = r % (2 * DFF / 32), kb = r / (2 * DFF / 32), n0 = nb * 32;
            const int pn = n0 >> 8, bj = (n0 >> 7) & 1, c = n0 & 127; transpose_item(p.w_up, 2 * DFF, D, ws_h(p, WS_WT_UP), n0, bj * DFF + 128 * pn + c, kb * 64, scr, lane); continue; } r -= TI_UP;
        { const int nb = r % (D / 32), kb = r / (D / 32), n0 = nb * 32; transpose_item(p.w_down, D, DFF, ws_h(p, WS_WT_DN), n0, n0, kb * 64, scr, lane); }
    }
}
typedef short bf16x8m __attribute__((ext_vector_type(8)));
__device__ __forceinline__ void split8(const float (&x)[8], bf16x8m& hi, bf16x8m& lo) {
    unsigned h[4], l[4];
#pragma unroll
    for (int e = 0; e < 4; ++e) { const unsigned h0 = f2bf_bits(x[2 * e]), h1 = f2bf_bits(x[2 * e + 1]);
        const float r0 = x[2 * e] - __builtin_bit_cast(float, h0 << 16), r1 = x[2 * e + 1] - __builtin_bit_cast(float, h1 << 16);
        h[e] = h0 | (h1 << 16); l[e] = f2bf_bits(r0) | (f2bf_bits(r1) << 16); }
    hi = __builtin_bit_cast(bf16x8m, (u32x4){h[0], h[1], h[2], h[3]}); lo = __builtin_bit_cast(bf16x8m, (u32x4){l[0], l[1], l[2], l[3]});
}
__device__ __forceinline__ void phase_mod(const P& p, LAS unsigned char* lds) {
    constexpr int KC = 256, NCG = 6 * D / 32, NCH = D / KC, NMT = (NCB + 15) / 16;
    static_assert(NMT <= 16, "two m-tiles per wave at most");
    LAS float* WB = (LAS float*)lds;
    const int tid = otid(), lane = tid & 63, wave = tid >> 6, r16 = lane & 15, g4 = lane >> 4;
    for (int cg = blockIdx.x; cg < NCG; cg += gridDim.x) {
        f32x4 acc[2][2];
#pragma unroll
        for (int s = 0; s < 2; ++s)
#pragma unroll
            for (int nt = 0; nt < 2; ++nt) acc[s][nt] = (f32x4){0.f, 0.f, 0.f, 0.f};
        f32x4 wreg[4];
#pragma unroll
        for (int j = 0; j < 4; ++j) { const int idx = tid + NTHR * j; wreg[j] = *(const f32x4*)(p.w_ada + (size_t)(idx >> 3) * 6 * D + cg * 32 + 4 * (idx & 7)); }
        __syncthreads();
        for (int ch = 0; ch < NCH; ++ch) {
            LAS float* wb = WB + (ch & 1) * KC * 32;
#pragma unroll
            for (int j = 0; j < 4; ++j) { const int idx = tid + NTHR * j; *(LAS f32x4*)(wb + (idx >> 3) * 32 + 4 * (idx & 7)) = wreg[j]; }
            if (ch + 1 < NCH) {
#pragma unroll
                for (int j = 0; j < 4; ++j) { const int idx = tid + NTHR * j; wreg[j] = *(const f32x4*)(p.w_ada + (size_t)((ch + 1) * KC + (idx >> 3)) * 6 * D + cg * 32 + 4 * (idx & 7)); }
            }
            __syncthreads();
#pragma unroll 2
            for (int ks = 0; ks < KC / 32; ++ks) {
                bf16x8m bh[2], bl[2];
#pragma unroll
                for (int nt = 0; nt < 2; ++nt) { float x[8];
#pragma unroll
                    for (int j = 0; j < 8; ++j) x[j] = wb[(32 * ks + 8 * g4 + j) * 32 + 16 * nt + r16];
                    split8(x, bh[nt], bl[nt]); }
#pragma unroll
                for (int s = 0; s < 2; ++s) { const int mt = wave + 8 * s; if (mt >= NMT) continue;
                    const int row = 16 * mt + r16; float x[8];
                    if (row < NCB) { const float* c = (row < BATCH ? p.c_prompt + (size_t)row * D : p.c_sample + (size_t)(row - BATCH) * D) + ch * KC + 32 * ks + 8 * g4;
                        const f32x4 a = *(const f32x4*)c, d = *(const f32x4*)(c + 4);
                        x[0] = silu_f(a[0]); x[1] = silu_f(a[1]); x[2] = silu_f(a[2]); x[3] = silu_f(a[3]); x[4] = silu_f(d[0]); x[5] = silu_f(d[1]); x[6] = silu_f(d[2]); x[7] = silu_f(d[3]); }
                    else {
#pragma unroll
                        for (int j = 0; j < 8; ++j) x[j] = 0.f; }
                    bf16x8m ah, al; split8(x, ah, al);
#pragma unroll
                    for (int nt = 0; nt < 2; ++nt) {
                        acc[s][nt] = __builtin_amdgcn_mfma_f32_16x16x32_bf16(ah, bh[nt], acc[s][nt], 0, 0, 0);
                        acc[s][nt] = __builtin_amdgcn_mfma_f32_16x16x32_bf16(ah, bl[nt], acc[s][nt], 0, 0, 0);
                        acc[s][nt] = __builtin_amdgcn_mfma_f32_16x16x32_bf16(al, bh[nt], acc[s][nt], 0, 0, 0); } }
            }
        }
#pragma unroll
        for (int s = 0; s < 2; ++s) { const int mt = wave + 8 * s; if (mt >= NMT) continue;
#pragma unroll
            for (int nt = 0; nt < 2; ++nt) { const int e = cg * 32 + 16 * nt + r16; const float bb = p.b_ada[e];
#pragma unroll
                for (int i = 0; i < 4; ++i) { const int row = 16 * mt + 4 * g4 + i; if (row < NCB) ws_f(p, WS_MOD)[(size_t)row * 6 * D + e] = acc[s][nt][i] + bb; } } }
    }
    __syncthreads();
}
template <int WHICH> __device__ __forceinline__ void phase_norm(const P& p) {
    static_assert(D == 1024, "one wave per 1024-float row");
    const int tid_ = otid(), lane = tid_ & 63, wave = tid_ >> 6;
    const int gw = blockIdx.x * NWAVES + wave, NGW = gridDim.x * NWAVES;
    const float* nwp = WHICH == 0 ? p.norm_mix_w : (WHICH == 1 ? p.norm_ffn_w : p.final_norm_w);
    f32x4 nwv[4];
#pragma unroll
    for (int j = 0; j < 4; ++j) nwv[j] = ((const f32x4*)nwp)[lane + 64 * j];
    f32x4 wbt[WHICH == 0 ? 8 : 1][4];
    if (WHICH == 0) {
#pragma unroll
        for (int c = 0; c < 8; ++c)
#pragma unroll
            for (int j = 0; j < 4; ++j) wbt[c][j] = ((const f32x4*)(ws_f(p, WS_WBAT) + c * D))[lane + 64 * j];
    }
    f32x4 v[4];
    if (gw < T) { const float* xr = WHICH == 0 ? xrow(p, gw) : p.out + O_Y + (size_t)gw * D;
#pragma unroll
        for (int j = 0; j < 4; ++j) v[j] = ((const f32x4*)xr)[lane + 64 * j]; }
    for (int m = gw; m < T; m += NGW) {
        f32x4 vn[4]; const int mn = m + NGW;
        if (mn < T) { const float* xr = WHICH == 0 ? xrow(p, mn) : p.out + O_Y + (size_t)mn * D;
#pragma unroll
            for (int j = 0; j < 4; ++j) vn[j] = ((const f32x4*)xr)[lane + 64 * j]; }
        float ss = 0.f;
#pragma unroll
        for (int j = 0; j < 4; ++j) ss += (v[j][0] * v[j][0] + v[j][1] * v[j][1]) + (v[j][2] * v[j][2] + v[j][3] * v[j][3]);
        const float rstd = 1.0f / sqrtf(wave_sum(ss) * (1.0f / D) + EPS);
        if (WHICH == 2) {
#pragma unroll
            for (int j = 0; j < 4; ++j) ((f32x4*)(p.out + O_Y + (size_t)m * D))[lane + 64 * j] = v[j] * rstd * nwv[j];
        } else {
            const int cb = cb_of(m);
            const float* mod = ws_f(p, WS_MOD) + (size_t)cb * 6 * D;
            const float* sh = mod + (WHICH == 0 ? 0 : 3 * D); const float* sc = mod + (WHICH == 0 ? D : 4 * D);
            float ba[8];
#pragma unroll
            for (int j = 0; j < 8; ++j) ba[j] = 0.f;
            unsigned long long* o8 = (unsigned long long*)(ws_h(p, WS_H) + (size_t)m * D);
#pragma unroll
            for (int j = 0; j < 4; ++j) {
                const f32x4 s1 = ((const f32x4*)sc)[lane + 64 * j], s0 = ((const f32x4*)sh)[lane + 64 * j];
                const f32x4 h = v[j] * rstd * nwv[j] * (s1 + 1.0f) + s0;
                o8[lane + 64 * j] = (unsigned long long)pk2(h[0], h[1]) | ((unsigned long long)pk2(h[2], h[3]) << 32);
                if (WHICH == 0) {
#pragma unroll
                    for (int c = 0; c < 8; ++c) ba[c] += (h[0] * wbt[c][j][0] + h[1] * wbt[c][j][1]) + (h[2] * wbt[c][j][2] + h[3] * wbt[c][j][3]);
                }
            }
            if (WHICH == 0) {
#pragma unroll
                for (int j = 0; j < 8; ++j) ba[j] = wave_sum(ba[j]);
                float mine = 0.f;
#pragma unroll
                for (int j = 0; j < 8; ++j) mine = (lane == j) ? ba[j] : mine;
                if (lane < 8) { float* bg = ws_f(p, WS_BG) + (size_t)m * 8; const int j = lane & 3;
                    bg[lane] = lane < 4 ? sigmoid_f(mine) : -expf(p.dn_A_log[j]) * softplus_f(mine + p.dn_dt_bias[j]); }
            }
        }
#pragma unroll
        for (int j = 0; j < 4; ++j) v[j] = vn[j];
    }
}

constexpr long SO_1 = (long)BATCH * 3 * 1536 / 4, SO_2 = (long)DEC_BATCH * 3 * 1536 / 4, SO_3 = (long)BATCH * 128 * 128 / 4, SO_4 = (long)DEC_BATCH * 128 * 128 / 4, SO_N = SO_1 + SO_2 + 2 * (SO_3 + SO_4);
__device__ __forceinline__ void so_item(const P& p, long it, f32x4& val, float*& dst) {
    const bf16_t* PR = ws_h(p, WS_PROJ); const bf16_t* src = nullptr; const float* fsrc = nullptr;
    long r = it;
    if (r < SO_1) { const int b = (int)(r / (3 * 384)), j = (int)(r / 384 % 3), c = (int)(r % 384) * 4; src = PR + (size_t)(b * SEQ + SEQ - 3 + j) * PLD + PC_QKV + c; dst = p.out + O_PDC + r * 4; }
    else if ((r -= SO_1) < SO_2) { const int b = (int)(r / (3 * 384)), j = (int)(r / 384 % 3), c = (int)(r % 384) * 4; src = PR + (size_t)(TP + b * DEC_SEQ + DEC_SEQ - 3 + j) * PLD + PC_QKV + c; dst = p.out + O_SDC + r * 4; }
    else { r -= SO_2; const int kv = r >= SO_3 + SO_4; if (kv) r -= SO_3 + SO_4; const int pc = kv ? PC_SV : PC_SK; const float* cache = kv ? p.cache_v : p.cache_k;
        if (r < SO_3) { const int b = (int)(r / (128 * 32)), j = (int)(r / 32 % 128), c = (int)(r % 32) * 4; src = PR + (size_t)(b * SEQ + SEQ - 128 + j) * PLD + pc + c; dst = p.out + (kv ? O_PV : O_PK) + r * 4; }
        else { r -= SO_3; const int b = (int)(r / (128 * 32)), j = (int)(r / 32 % 128), c = (int)(r % 32) * 4; dst = p.out + (kv ? O_SV : O_SK) + r * 4;
            if (j < 128 - DEC_SEQ) fsrc = cache + ((size_t)b * 128 + j + DEC_SEQ) * 128 + c; else src = PR + (size_t)(TP + b * DEC_SEQ + (j - (128 - DEC_SEQ))) * PLD + pc + c; } }
    if (fsrc) val = *(const f32x4*)fsrc;
    else { const u32x2 w = *(const u32x2*)src; val = (f32x4){__builtin_bit_cast(float, w.x << 16), __builtin_bit_cast(float, w.x & 0xffff0000u), __builtin_bit_cast(float, w.y << 16), __builtin_bit_cast(float, w.y & 0xffff0000u)}; }
}
__device__ __forceinline__ void phase_state_out(const P& p) {
    const long gt = blockIdx.x * (long)NTHR + otid(), gs = (long)gridDim.x * NTHR;
    for (long it = gt; it < SO_N; it += 4 * gs) {
        f32x4 v[4]; float* d[4];
#pragma unroll
        for (int u = 0; u < 4; ++u) if (it + u * gs < SO_N) so_item(p, it + u * gs, v[u], d[u]);
#pragma unroll
        for (int u = 0; u < 4; ++u) if (it + u * gs < SO_N) *(f32x4*)d[u] = v[u];
    }
}
#define XB_TMO      128
#define XB_XCNT(j)  (256  + 64 * (j))
#define XB_XSUB(j)  (1280 + 64 * (j))
#define XB_XGEN(j)  (2304 + 64 * (j))
#define XB_TOP      3328
#define XB_TOPGEN   3392
#define XCD_BAR_WORDS 3456
#define XB_SPIN_CAP (1u << 18)

__device__ __forceinline__ unsigned xb_ld(unsigned* p)              { return __hip_atomic_load(p, __ATOMIC_RELAXED, __HIP_MEMORY_SCOPE_AGENT); }
__device__ __forceinline__ unsigned xb_add(unsigned* p, unsigned v) { return __hip_atomic_fetch_add(p, v, __ATOMIC_RELAXED, __HIP_MEMORY_SCOPE_AGENT); }
__device__ __forceinline__ unsigned xb_xcc_id() { return (unsigned)__builtin_amdgcn_s_getreg((3 << 11) | 20) & 0xFu; }
#define XB_SPIN(cond, bar) do { unsigned _sp = 0; while (cond) { __builtin_amdgcn_s_sleep(1); \
    if ((++_sp & 255u) == 0u) { if (xb_ld(&(bar)[XB_TMO])) break; if (_sp > XB_SPIN_CAP) { atomicAdd(&(bar)[XB_TMO], 1u); break; } } } } while (0)

struct XcdBarrier {
    unsigned* bar; unsigned x;
    volatile LAS unsigned* st;
};

__device__ __forceinline__ XcdBarrier xcd_barrier_post(unsigned* bar, volatile LAS unsigned* st) {
    XcdBarrier b; b.bar = bar; b.x = xb_xcc_id(); b.st = st;
    if (threadIdx.x == 0) (void)xb_add(&bar[XB_XCNT(b.x)], 1u);
    return b;
}
__device__ __forceinline__ void xcd_barrier_complete(unsigned* bar, unsigned x, unsigned& nloc, unsigned& nx) {
    const unsigned G = gridDim.x * gridDim.y * gridDim.z;
    unsigned sum, cnt, mine, sp = 0u;
    for (;;) {
        sum = 0u; cnt = 0u; mine = 0u;
#pragma unroll
        for (unsigned j = 0; j < 16; ++j) { const unsigned c = xb_ld(&bar[XB_XCNT(j)]); sum += c; cnt += (c > 0u) ? 1u : 0u; mine = (j == x) ? c : mine; }
        if (sum == G) break;
        __builtin_amdgcn_s_sleep(1);
        if ((++sp & 255u) == 0u) { if (xb_ld(&bar[XB_TMO])) break; if (sp > XB_SPIN_CAP) { atomicAdd(&bar[XB_TMO], 1u); break; } }
    }
    nloc = mine > 0u ? mine : 1u; nx = cnt > 0u ? cnt : 1u;
}

__device__ __forceinline__ void xcd_barrier(const XcdBarrier& b) {
    asm volatile("s_waitcnt vmcnt(0)" ::: "memory");
    __syncthreads();
    if (threadIdx.x == 0) {
        unsigned* bar = b.bar;
        __builtin_amdgcn_s_waitcnt(0);
        unsigned nloc = b.st[0], nx = b.st[1];
        if (nloc == 0u) { xcd_barrier_complete(bar, b.x, nloc, nx); b.st[0] = nloc; b.st[1] = nx; }
        const unsigned old = xb_add(&bar[XB_XSUB(b.x)], 1u);
        const unsigned gen = old / nloc;
        if (old + 1u == (gen + 1u) * nloc) {
            __builtin_amdgcn_fence(__ATOMIC_RELEASE, "agent");
            asm volatile("s_waitcnt vmcnt(0)" ::: "memory");
            const unsigned og = xb_add(&bar[XB_TOP], 1u);
            const unsigned tg = og / nx;
            if (og + 1u == (tg + 1u) * nx) xb_add(&bar[XB_TOPGEN], 1u);
            else XB_SPIN(xb_ld(&bar[XB_TOPGEN]) == tg, bar);
            __builtin_amdgcn_fence(__ATOMIC_ACQUIRE, "agent");
            xb_add(&bar[XB_XGEN(b.x)], 1u);
            asm volatile("s_waitcnt vmcnt(0)" ::: "memory");
        } else {
            XB_SPIN(xb_ld(&bar[XB_XGEN(b.x)]) == gen, bar);
            __builtin_amdgcn_fence(__ATOMIC_ACQUIRE, "agent");
            asm volatile("s_waitcnt vmcnt(0)" ::: "memory");
        }
    }
    __syncthreads();
}
namespace pg8 {
#define PG8_LAS __attribute__((address_space(3)))
typedef unsigned short bf16_t;
typedef short bf16x8 __attribute__((ext_vector_type(8)));
typedef float f32x4 __attribute__((ext_vector_type(4)));
typedef unsigned u32x4 __attribute__((ext_vector_type(4)));
constexpr int BM = 256, BK = 64, HALF = 128, HTB = HALF * BK * 2  , STAGE_BYTES = 8 * HTB, NXCD = 8, WGM = 8;

__host__ __device__ __forceinline__ int lds_byte(int r, int c) { const int st = (r >> 4) * 2 + (c >> 5), rr = r & 15, cc = c & 31, ob = rr * 64 + cc * 2; return st * 1024 + (ob ^ (((ob >> 9) & 1) << 5)); }
__host__ __device__ __forceinline__ void stage_rc(int b, int& R, int& C) { const int st = b / 1024, sb = b % 1024, swz = sb ^ (((sb >> 9) & 1) << 5); R = (st >> 1) * 16 + swz / 64; C = (st & 1) * 32 + (swz % 64) / 2; }
__host__ __device__ __forceinline__ int perm32(int rho) { const int n = rho >> 4, i = rho & 15; return 8 * (i >> 2) + 4 * n + (i & 3); }

struct Unit { int pm, pn; };
struct Gemm { const bf16_t* A; const bf16_t* Bt; int M, N, K; };

struct StaticOrder {
    int nM, nN, nwg, G, c;
    __host__ __device__ void init(int M, int N, int G_, int c_) { nM = M / BM; nN = N / BM; nwg = nM * nN; G = G_; c = c_; }
    __host__ __device__ bool next(int i, Unit& u) const {
        const long L = (long)i * G + c; if (L >= nwg) return false;
        int wgid = (int)L; { const int q = nwg / NXCD, r = nwg % NXCD, xcd = wgid % NXCD, off = wgid / NXCD; wgid = (xcd < r ? xcd * (q + 1) : r * (q + 1) + (xcd - r) * q) + off; }
        const int nig = WGM * nN, gid = wgid / nig, fm = gid * WGM, gsz = (nM - fm) < WGM ? (nM - fm) : WGM;
        u.pm = fm + ((wgid % nig) % gsz); u.pn = (wgid % nig) / gsz; return true;
    }
    __device__ __forceinline__ void a_ready(const Unit&) const {}
    __device__ __forceinline__ void done(const Unit&) const {}
};

__device__ __forceinline__ unsigned cvt_pk_bf16(float lo, float hi) { unsigned r; asm volatile("v_cvt_pk_bf16_f32 %0, %1, %2" : "=v"(r) : "v"(lo), "v"(hi)); return r; }
struct EpiStoreBf16 {
    static constexpr bool PERM = true, AFTER_DRAIN = false;
    bf16_t* O; int ldc;
    __device__ __forceinline__ void operator()(const f32x4 (&acc)[2][2][4][2], const Unit& u, int wr, int wc, int fr, int fq) const {
        const int row0 = u.pm * BM + wr * 64 + fr, col0 = u.pn * BM + wc * 32 + 8 * fq;
#pragma unroll
        for (int ai = 0; ai < 2; ++ai)
#pragma unroll
            for (int m = 0; m < 4; ++m) { bf16_t* rowp = O + (size_t)(row0 + ai * HALF + m * 16) * ldc + col0;
#pragma unroll
                for (int bj = 0; bj < 2; ++bj) { const f32x4 v0 = acc[ai][bj][m][0], v1 = acc[ai][bj][m][1];
                    u32x4 w; w.x = cvt_pk_bf16(v0[0], v0[1]); w.y = cvt_pk_bf16(v0[2], v0[3]); w.z = cvt_pk_bf16(v1[0], v1[1]); w.w = cvt_pk_bf16(v1[2], v1[3]);
                    *(u32x4*)(rowp + bj * HALF) = w; } }
    }
};
struct EpiGateRes {
    static constexpr bool PERM = false, AFTER_DRAIN = false;
    const float* base_p; const float* base_s; float* out; const float* gate;
    __device__ __forceinline__ void operator()(const f32x4 (&acc)[2][2][4][2], const Unit& u, int wr, int wc, int fr, int fq) const {
        const int row0 = u.pm * BM + wr * 64 + fr, col0 = u.pn * BM + wc * 32 + 4 * fq;
        const bool smp = row0 >= TP; const float* base = smp ? base_s - (size_t)TP * D : base_p;
#pragma unroll
        for (int ai = 0; ai < 2; ++ai)
#pragma unroll
            for (int m = 0; m < 4; ++m) { const int r = row0 + ai * HALF + m * 16; const int cb = smp ? BATCH + ((r - TP) >> 3) : r / SEQ;
                const float* gp = gate + (size_t)cb * 6 * D + col0; const size_t off = (size_t)r * D + col0;
#pragma unroll
                for (int bj = 0; bj < 2; ++bj)
#pragma unroll
                    for (int n = 0; n < 2; ++n) { const f32x4 gv = *(const f32x4*)(gp + bj * HALF + n * 16), bs = *(const f32x4*)(base + off + bj * HALF + n * 16);
                        *(f32x4*)(out + off + bj * HALF + n * 16) = bs + gv * acc[ai][bj][m][n]; } }
    }
};
template <class Epi, class Sched, bool ALIGN_EPI = false, bool SP2 = false>
__device__ __forceinline__ void gemm_phase(PG8_LAS unsigned char* lds, const Gemm g, const Sched& S, const Epi& E) {
    const int tid = otid(), wid = __builtin_amdgcn_readfirstlane(tid >> 6), lane = tid & 63, wr = wid >> 2, wc = wid & 3, fr = lane & 15, fq = lane >> 4;
    const int K = g.K, nt = K / BK;
    unsigned voffA[2], voffB[2];
#pragma unroll
    for (int i = 0; i < 2; ++i) { int R, C; stage_rc(tid * 16 + i * 8192, R, C); const int Rb = Epi::PERM ? ((R & ~31) + perm32(R & 31)) : R;
        voffA[i] = (unsigned)(R * K + C) * 2u; voffB[i] = (unsigned)(Rb * K + C) * 2u; }
    const size_t kstep = (size_t)(BK * 2);
    const size_t hstep = (size_t)HALF * K * 2;
    const size_t tstep = 2 * hstep;
    const unsigned ldsw = (unsigned)wid * 1024u;
    const int aoff = lds_byte(wr * 64 + fr, fq * 8), boff = lds_byte(wc * 32 + fr, fq * 8);
#define PG8_SA(b, h) (((b) * 2 + (h)) * HTB)
#define PG8_SB(b, h) ((4 + (b) * 2 + (h)) * HTB)
#define PG8_STAGE(bufoff, gbase, voff) do { _Pragma("unroll") for (int _i = 0; _i < 2; ++_i) \
        __builtin_amdgcn_global_load_lds((const unsigned*)((const char*)(gbase) + (voff)[_i]), (PG8_LAS unsigned*)(lds + (bufoff) + ldsw + _i * 8192), 16, 0, 0); } while (0)
#define PG8_LDA(dst, b, h) do { _Pragma("unroll") for (int m = 0; m < 4; ++m) _Pragma("unroll") for (int k = 0; k < 2; ++k) dst[m][k] = *(const PG8_LAS bf16x8*)(lds + PG8_SA(b, h) + aoff + m * 2048 + k * 1024); } while (0)
#define PG8_LDB(dst, b, h) do { _Pragma("unroll") for (int n = 0; n < 2; ++n) _Pragma("unroll") for (int k = 0; k < 2; ++k) dst[n][k] = *(const PG8_LAS bf16x8*)(lds + PG8_SB(b, h) + boff + n * 2048 + k * 1024); } while (0)
#define PG8_MMA(ai, bj, At, Bt) do { __builtin_amdgcn_s_setprio(1); _Pragma("unroll") for (int m = 0; m < 4; ++m) _Pragma("unroll") for (int n = 0; n < 2; ++n) _Pragma("unroll") for (int k = 0; k < 2; ++k) \
        acc[ai][bj][m][n] = __builtin_amdgcn_mfma_f32_16x16x32_bf16(Bt[n][k], At[m][k], acc[ai][bj][m][n], 0, 0, 0); __builtin_amdgcn_s_setprio(0); } while (0)
#define PG8_WAIT_V(n) asm volatile("s_waitcnt vmcnt(" #n ")" ::: "memory")
#define PG8_WAIT_L(n) asm volatile("s_waitcnt lgkmcnt(" #n ")" ::: "memory")
#define PG8_BAR __builtin_amdgcn_s_barrier()
#define PG8_SCHED __builtin_amdgcn_sched_barrier(0)
    Unit cur, nxt; int ui = 0;
    if (!S.next(0, cur)) return;
    f32x4 acc[2][2][4][2];
#pragma unroll
    for (int a = 0; a < 2; ++a)
#pragma unroll
        for (int b = 0; b < 2; ++b)
#pragma unroll
            for (int m = 0; m < 4; ++m)
#pragma unroll
                for (int n = 0; n < 2; ++n) acc[a][b][m][n] = (f32x4){0.f, 0.f, 0.f, 0.f};
    bf16x8 At[4][2], B0[2][2], B1[2][2];
    const char* cA = (const char*)g.A + (size_t)cur.pm * tstep; const char* cB = (const char*)g.Bt + (size_t)cur.pn * tstep;
    S.a_ready(cur);
    if constexpr (SP2) {
        PG8_STAGE(PG8_SB(0, 0), cB, voffB); PG8_STAGE(PG8_SB(0, 1), cB + hstep, voffB); PG8_STAGE(PG8_SA(0, 0), cA, voffA); PG8_STAGE(PG8_SA(0, 1), cA + hstep, voffA);
        if (wr == 1) PG8_BAR;
        PG8_WAIT_V(2); PG8_BAR;
        PG8_STAGE(PG8_SB(1, 0), cB + kstep, voffB); PG8_STAGE(PG8_SA(1, 0), cA + kstep, voffA); PG8_STAGE(PG8_SB(1, 1), cB + hstep + kstep, voffB);
        PG8_WAIT_V(6); PG8_BAR;
    } else {
        PG8_STAGE(PG8_SB(0, 0), cB, voffB); PG8_STAGE(PG8_SA(0, 0), cA, voffA); PG8_STAGE(PG8_SB(0, 1), cB + hstep, voffB); PG8_STAGE(PG8_SA(0, 1), cA + hstep, voffA);
        if (wr == 1) PG8_BAR;
        PG8_WAIT_V(4); PG8_BAR;
        PG8_STAGE(PG8_SB(1, 0), cB + kstep, voffB); PG8_STAGE(PG8_SA(1, 0), cA + kstep, voffA); PG8_STAGE(PG8_SB(1, 1), cB + hstep + kstep, voffB);
        PG8_WAIT_V(6); PG8_BAR;
    }
    for (;;) {
        const bool has_next = S.next(ui + 1, nxt);
        const char* nA = has_next ? (const char*)g.A + (size_t)nxt.pm * tstep : cA; const char* nB = has_next ? (const char*)g.Bt + (size_t)nxt.pn * tstep : cB;
        for (int t = 0; t < nt; t += 2) {
            const bool last = (t == nt - 2);
            const char* a1 = cA + (size_t)(t + 1) * kstep;
            const char* a2 = last ? nA : cA + (size_t)(t + 2) * kstep; const char* b2 = last ? nB : cB + (size_t)(t + 2) * kstep;
            const char* a3 = a2 + kstep; const char* b3 = b2 + kstep;
            if (last && has_next) S.a_ready(nxt);
            if constexpr (SP2) {
            PG8_LDB(B0, 0, 0); PG8_LDB(B1, 0, 1); PG8_SCHED; PG8_LDA(At, 0, 0); PG8_STAGE(PG8_SA(1, 1), a1 + hstep, voffA);
            PG8_WAIT_V(8); PG8_WAIT_L(0); PG8_BAR; PG8_MMA(0, 0, At, B0); PG8_MMA(0, 1, At, B1); PG8_BAR; PG8_SCHED;
            PG8_LDA(At, 0, 1); PG8_STAGE(PG8_SB(0, 0), b2, voffB); PG8_STAGE(PG8_SB(0, 1), b2 + hstep, voffB); PG8_STAGE(PG8_SA(0, 0), a2, voffA);
            PG8_WAIT_V(8); PG8_WAIT_L(0); PG8_BAR; PG8_MMA(1, 0, At, B0); PG8_MMA(1, 1, At, B1); PG8_BAR; PG8_SCHED;
            PG8_LDB(B0, 1, 0); PG8_LDB(B1, 1, 1); PG8_SCHED; PG8_LDA(At, 1, 0); PG8_STAGE(PG8_SA(0, 1), a2 + hstep, voffA);
            PG8_WAIT_V(8); PG8_WAIT_L(0); PG8_BAR; PG8_MMA(0, 0, At, B0); PG8_MMA(0, 1, At, B1); PG8_BAR; PG8_SCHED;
            PG8_LDA(At, 1, 1); PG8_STAGE(PG8_SB(1, 0), b3, voffB); PG8_STAGE(PG8_SB(1, 1), b3 + hstep, voffB); PG8_STAGE(PG8_SA(1, 0), a3, voffA);
            PG8_WAIT_V(8); PG8_WAIT_L(0); PG8_BAR; PG8_MMA(1, 0, At, B0); PG8_MMA(1, 1, At, B1); PG8_BAR; PG8_SCHED;
            } else {
            PG8_LDB(B0, 0, 0); PG8_SCHED; PG8_LDA(At, 0, 0); PG8_STAGE(PG8_SA(1, 1), a1 + hstep, voffA);
            PG8_WAIT_L(8); PG8_BAR; PG8_WAIT_L(0); PG8_MMA(0, 0, At, B0); PG8_BAR; PG8_SCHED;
            PG8_LDB(B1, 0, 1); PG8_STAGE(PG8_SB(0, 0), b2, voffB);
            PG8_BAR; PG8_WAIT_L(0); PG8_MMA(0, 1, At, B1); PG8_BAR;
            PG8_LDA(At, 0, 1); PG8_STAGE(PG8_SA(0, 0), a2, voffA);
            PG8_BAR; PG8_WAIT_L(0); PG8_MMA(1, 0, At, B0); PG8_BAR; PG8_SCHED;
            PG8_STAGE(PG8_SB(0, 1), b2 + hstep, voffB);
            PG8_WAIT_V(6); PG8_BAR; PG8_MMA(1, 1, At, B1); PG8_BAR;
            PG8_LDB(B0, 1, 0); PG8_SCHED; PG8_LDA(At, 1, 0); PG8_STAGE(PG8_SA(0, 1), a2 + hstep, voffA);
            PG8_WAIT_L(8); PG8_BAR; PG8_WAIT_L(0); PG8_MMA(0, 0, At, B0); PG8_BAR; PG8_SCHED;
            PG8_LDB(B1, 1, 1); PG8_STAGE(PG8_SB(1, 0), b3, voffB);
            PG8_BAR; PG8_WAIT_L(0); PG8_MMA(0, 1, At, B1); PG8_BAR;
            PG8_LDA(At, 1, 1); PG8_STAGE(PG8_SA(1, 0), a3, voffA);
            PG8_BAR; PG8_WAIT_L(0); PG8_MMA(1, 0, At, B0); PG8_BAR; PG8_SCHED;
            PG8_STAGE(PG8_SB(1, 1), b3 + hstep, voffB);
            PG8_WAIT_V(6); PG8_BAR; PG8_MMA(1, 1, At, B1); PG8_BAR;
            }
        }
        if constexpr (ALIGN_EPI) { if (wr == 0) PG8_BAR; }
        if constexpr (!Epi::AFTER_DRAIN) { E(acc, cur, wr, wc, fr, fq); S.done(cur); }
        if (!has_next) break;
#pragma unroll
        for (int a = 0; a < 2; ++a)
#pragma unroll
            for (int b = 0; b < 2; ++b)
#pragma unroll
                for (int m = 0; m < 4; ++m)
#pragma unroll
                    for (int n = 0; n < 2; ++n) acc[a][b][m][n] = (f32x4){0.f, 0.f, 0.f, 0.f};
        cur = nxt; cA = nA; cB = nB; ++ui;
        if constexpr (ALIGN_EPI) { if (wr == 1) PG8_BAR; }
    }
    PG8_WAIT_V(0);
    if constexpr (!ALIGN_EPI) { if (wr == 0) PG8_BAR; }
    PG8_BAR;
    if constexpr (Epi::AFTER_DRAIN) { E.fused(acc, cur, wr, wc, fr, fq, lds, wid, lane); S.done(cur); }
#undef PG8_SA
#undef PG8_SB
#undef PG8_STAGE
#undef PG8_LDA
#undef PG8_LDB
#undef PG8_MMA
#undef PG8_WAIT_V
#undef PG8_WAIT_L
#undef PG8_BAR
#undef PG8_SCHED
}
}
typedef short bf16x8 __attribute__((ext_vector_type(8)));
constexpr int FR_NWK = 0, FR_QD = 16, FR_KTT = 32, FR_QK = 48, FR_N = 56;
__device__ __forceinline__ int kperm(int g, int j) { return j < 4 ? 4 * g + j : 16 + 4 * g + (j - 4); }

typedef float f32x2_t __attribute__((ext_vector_type(2))); typedef __bf16 bf16x2_t __attribute__((ext_vector_type(2)));
__device__ __forceinline__ unsigned cvtpk_c(float lo, float hi) { const f32x2_t v = {lo, hi}; const bf16x2_t b = __builtin_convertvector(v, bf16x2_t); return __builtin_bit_cast(unsigned, b); }
__device__ __forceinline__ bf16x8 pack8(const f32x4 a, const f32x4 b) {
    return __builtin_bit_cast(bf16x8, (u32x4){cvtpk_c(a[0], a[1]), cvtpk_c(a[2], a[3]), cvtpk_c(b[0], b[1]), cvtpk_c(b[2], b[3])});
}
constexpr int DP_KP = 136;
constexpr int DP_RP = 72;
constexpr int DP_QS = 0, DP_KS = DP_QS + 64 * DP_KP * 2, DP_RHST = DP_KS + 64 * DP_KP * 2, DP_AM = DP_RHST + 256 * DP_RP * 2, DP_AMP = 68,
              DP_QKM = DP_AM + 64 * DP_AMP * 4, DP_QKP = 72, DP_GS = DP_QKM + 64 * DP_QKP * 2, DP_DM = DP_GS + 4 * 64 * 4, DP_DMP = 20,
              DP_TB = DP_DM + 64 * DP_DMP * 4, DP_END = DP_TB + 64 * DP_RP * 2;
static_assert(DP_END <= 131072 && DP_AM % 16 == 0 && DP_DM % 16 == 0 && DP_TB % 16 == 0 && DP_RHST % 16 == 0, "dnprep LDS");
#ifndef DPS
#define DPS(k)
#endif
__device__ __forceinline__ void phase_dnprep(const P& p, LAS unsigned char* lds, unsigned long long& pr_prev, unsigned long long& pr_acc) {
    const int tid_ = otid();
    LAS bf16_t* QS = (LAS bf16_t*)(lds + DP_QS); LAS bf16_t* KS = (LAS bf16_t*)(lds + DP_KS); LAS bf16_t* RHST = (LAS bf16_t*)(lds + DP_RHST);
    LAS float* AM = (LAS float*)(lds + DP_AM); LAS bf16_t* QKM = (LAS bf16_t*)(lds + DP_QKM); LAS float* GS = (LAS float*)(lds + DP_GS);
    LAS float* DM = (LAS float*)(lds + DP_DM); LAS bf16_t* TB = (LAS bf16_t*)(lds + DP_TB);
    const bf16_t* PR = ws_h(p, WS_PROJ); const float* BG = ws_f(p, WS_BG);
    for (int i = tid_; i < 64 * DP_RP / 2; i += NTHR) ((LAS unsigned*)TB)[i] = 0u;
    float pgx = 0.f, pbx = 0.f, cw[3][4][2]; unsigned xr[3][11];
#define DP_FETCH(uid_, ln_, wv_) do { const int n_ = (uid_) % NCHUNK, bh_ = (uid_) / NCHUNK, h_ = bh_ & 3, m0_ = (bh_ >> 2) * SEQ + n_ * 64; \
        if ((wv_) == 0) { pgx = BG[(size_t)(m0_ + (ln_)) * 8 + 4 + h_]; pbx = BG[(size_t)(m0_ + (ln_)) * 8 + h_]; } \
        _Pragma("unroll") for (int part = 0; part < 3; ++part) _Pragma("unroll") for (int j = 0; j < 4; ++j) { const float* w = p.dn_conv_w + j * 1536 + part * 512 + h_ * 128 + 2 * (ln_); cw[part][j][0] = w[0]; cw[part][j][1] = w[1]; } \
        _Pragma("unroll") for (int rr = 0; rr < 11; ++rr) { const int t_ = n_ * 64 + (wv_) * 8 + rr - 3; \
            _Pragma("unroll") for (int part = 0; part < 3; ++part) { unsigned v_ = 0u; if (t_ >= 0) v_ = *(const unsigned*)(PR + (size_t)(m0_ + (wv_) * 8 + rr - 3) * PLD + part * 512 + h_ * 128 + 2 * (ln_)); xr[part][rr] = v_; } } } while (0)
    if ((int)blockIdx.x < NUNIT) { int t0 = tid_; asm volatile("" : "+v"(t0)); DP_FETCH((int)blockIdx.x, t0 & 63, t0 >> 6); }
    for (int uid = blockIdx.x; uid < NUNIT; uid += gridDim.x) {
        const int n = uid % NCHUNK;
        int tid = tid_; asm volatile("" : "+v"(tid));
        const int lane = tid & 63, wave = tid >> 6, r16 = lane & 15, g4 = lane >> 4;
        unsigned char* abu = p.ws + WS_DNF_AB + (size_t)uid * DNF_AB_UNIT;
        if (wave == 0) {
            float x = pgx;
#pragma unroll
            for (int o = 1; o < 64; o <<= 1) { const float t = __shfl_up(x, o); if (lane >= o) x += t; }
            const float gl = __shfl(x, 63);
            GS[lane] = x; GS[64 + lane] = pbx; GS[128 + lane] = __expf(x); GS[192 + lane] = __expf(gl - x);
            if (lane == 0) ws_f(p, WS_DNF_CD)[uid] = __expf(gl);
        }
        __syncthreads();
        {
            float c[8][3][2], ssum[16];
#pragma unroll
            for (int i = 0; i < 8; ++i) {
#pragma unroll
                for (int part = 0; part < 3; ++part)
#pragma unroll
                    for (int e = 0; e < 2; ++e) { float a = 0.f;
#pragma unroll
                        for (int j = 0; j < 4; ++j) a += cw[part][j][e] * (e == 0 ? __builtin_bit_cast(float, xr[part][i + j] << 16) : __builtin_bit_cast(float, xr[part][i + j] & 0xffff0000u));
                        c[i][part][e] = a * __builtin_amdgcn_rcpf(1.0f + __expf(-a)); }
                ssum[2 * i] = c[i][0][0] * c[i][0][0] + c[i][0][1] * c[i][0][1]; ssum[2 * i + 1] = c[i][1][0] * c[i][1][0] + c[i][1][1] * c[i][1][1]; }
#pragma unroll
            for (int o = 1; o < 64; o <<= 1) {
#pragma unroll
                for (int q = 0; q < 16; ++q) ssum[q] += __shfl_xor(ssum[q], o); }
#pragma unroll
            for (int i = 0; i < 8; ++i) { const int row = wave * 8 + i;
                const float rq = 0.08838834764831845f * __builtin_amdgcn_rsqf(ssum[2 * i] + EPS), rk = __builtin_amdgcn_rsqf(ssum[2 * i + 1] + EPS);
                const float beta = GS[64 + row], eg = GS[128 + row];
                const float q0 = c[i][0][0] * rq, q1 = c[i][0][1] * rq, k0 = c[i][1][0] * rk, k1 = c[i][1][1] * rk;
                *(LAS unsigned*)(QS + row * DP_KP + 2 * lane) = pk2(q0, q1);
                *(LAS unsigned*)(KS + row * DP_KP + 2 * lane) = pk2(k0, k1);
                RHST[(2 * lane) * DP_RP + row] = f2bf(beta * c[i][2][0]); RHST[(2 * lane + 1) * DP_RP + row] = f2bf(beta * c[i][2][1]);
                RHST[(128 + 2 * lane) * DP_RP + row] = f2bf(beta * eg * k0); RHST[(128 + 2 * lane + 1) * DP_RP + row] = f2bf(beta * eg * k1); }
        }
        if (uid + (int)gridDim.x < NUNIT) DP_FETCH(uid + (int)gridDim.x, lane, wave);
        __syncthreads(); DPS(16);
        {
            const int ti = wave >> 1;
            f32x4 akk[2], aqk[2];
#pragma unroll
            for (int c = 0; c < 2; ++c) { akk[c] = (f32x4){0.f, 0.f, 0.f, 0.f}; aqk[c] = (f32x4){0.f, 0.f, 0.f, 0.f}; }
#pragma unroll
            for (int kb = 0; kb < 4; ++kb) {
                const bf16x8 ak = *(const LAS bf16x8*)(KS + (16 * ti + r16) * DP_KP + 32 * kb + 8 * g4), aq = *(const LAS bf16x8*)(QS + (16 * ti + r16) * DP_KP + 32 * kb + 8 * g4);
#pragma unroll
                for (int c = 0; c < 2; ++c) { const int tj = 2 * (wave & 1) + c; const bf16x8 bk = *(const LAS bf16x8*)(KS + (16 * tj + r16) * DP_KP + 32 * kb + 8 * g4);
                    akk[c] = __builtin_amdgcn_mfma_f32_16x16x32_bf16(ak, bk, akk[c], 0, 0, 0); aqk[c] = __builtin_amdgcn_mfma_f32_16x16x32_bf16(aq, bk, aqk[c], 0, 0, 0); }
            }
#pragma unroll
            for (int c = 0; c < 2; ++c) { const int tj = 2 * (wave & 1) + c, J = 16 * tj + r16; const float gj = GS[J];
#pragma unroll
                for (int i = 0; i < 4; ++i) { const int I = 16 * ti + 4 * g4 + i; const float dec = I >= J ? __expf(GS[I] - gj) : 0.f;
                    AM[I * DP_AMP + J] = I > J ? GS[64 + I] * akk[c][i] * dec : 0.f; QKM[I * DP_QKP + J] = f2bf(aqk[c][i] * dec); } }
        }
        __syncthreads(); DPS(17);
        if (wave == 0) {
            const int bb = g4, cc = r16; float t[16];
            f32x4 tr[16][4];
#pragma unroll
            for (int i = 1; i < 16; ++i)
#pragma unroll
                for (int j4 = 0; j4 < (i + 3) / 4; ++j4) tr[i][j4] = *(const LAS f32x4*)(AM + (16 * bb + i) * DP_AMP + 16 * bb + 4 * j4);
            __builtin_amdgcn_sched_barrier(0);
#pragma unroll
            for (int i = 0; i < 16; ++i) { float acc = (i == cc) ? 1.f : 0.f;
#pragma unroll
                for (int j = 0; j < i; ++j) acc -= tr[i][j >> 2][j & 3] * t[j];
                t[i] = acc; }
#pragma unroll
            for (int i = 0; i < 16; ++i) { DM[(16 * bb + i) * DP_DMP + cc] = t[i]; TB[(16 * bb + i) * DP_RP + 16 * bb + cc] = f2bf(t[i]); }
        } else if (wave >= 4) {
            for (int f = FR_QD + (wave - 4); f < FR_N; f += 4) {
                u32x4 o;
                if (f < FR_KTT) { const int mt = (f - FR_QD) >> 2, kb = (f - FR_QD) & 3, row = 16 * mt + r16; const float sc = GS[128 + row];
                    const u32x2 lo = *(const LAS u32x2*)(QS + row * DP_KP + 32 * kb + 4 * g4), hi = *(const LAS u32x2*)(QS + row * DP_KP + 32 * kb + 16 + 4 * g4);
                    const unsigned w[4] = {lo.x, lo.y, hi.x, hi.y}; unsigned r[4];
#pragma unroll
                    for (int e = 0; e < 4; ++e) r[e] = cvtpk_c(__builtin_bit_cast(float, w[e] << 16) * sc, __builtin_bit_cast(float, w[e] & 0xffff0000u) * sc);
                    o = (u32x4){r[0], r[1], r[2], r[3]};
                } else if (f < FR_QK) { const int kt = (f - FR_KTT) >> 1, tb = (f - FR_KTT) & 1; float v[8];
#pragma unroll
                    for (int j = 0; j < 8; ++j) { const int tok = 32 * tb + kperm(g4, j); v[j] = bf2f(KS[tok * DP_KP + 16 * kt + r16]) * GS[192 + tok]; }
                    o = (u32x4){cvtpk_c(v[0], v[1]), cvtpk_c(v[2], v[3]), cvtpk_c(v[4], v[5]), cvtpk_c(v[6], v[7])};
                } else { const int mt = (f - FR_QK) >> 1, tb = (f - FR_QK) & 1, row = 16 * mt + r16;
                    const u32x2 lo = *(const LAS u32x2*)(QKM + row * DP_QKP + 32 * tb + 4 * g4), hi = *(const LAS u32x2*)(QKM + row * DP_QKP + 32 * tb + 16 + 4 * g4);
                    o = (u32x4){lo.x, lo.y, hi.x, hi.y}; }
                *(u32x4*)(abu + (size_t)f * 1024 + lane * 16) = o;
            }
        }
        __syncthreads(); DPS(18);
        if (wave < 3) {
            const int j = wave; f32x4 Tk[4];
#pragma unroll
            for (int kk = 0; kk < 4; ++kk) Tk[j][kk] = DM[(16 * j + 4 * g4 + kk) * DP_DMP + r16];
#pragma unroll
            for (int i = 1; i < 4; ++i) if (i > j) {
                f32x4 acc = (f32x4){0.f, 0.f, 0.f, 0.f};
#pragma unroll
                for (int k = 0; k < 3; ++k) if (k >= j && k < i) { const f32x4 a = *(const LAS f32x4*)(AM + (16 * i + r16) * DP_AMP + 16 * k + 4 * g4);
#pragma unroll
                    for (int kk = 0; kk < 4; ++kk) acc = __builtin_amdgcn_mfma_f32_16x16x4f32(a[kk], Tk[k][kk], acc, 0, 0, 0); }
                const f32x4 dd = *(const LAS f32x4*)(DM + (16 * i + r16) * DP_DMP + 4 * g4);
                f32x4 res = (f32x4){0.f, 0.f, 0.f, 0.f};
#pragma unroll
                for (int kk = 0; kk < 4; ++kk) res = __builtin_amdgcn_mfma_f32_16x16x4f32(dd[kk], acc[kk], res, 0, 0, 0);
                Tk[i] = -res;
#pragma unroll
                for (int e = 0; e < 4; ++e) TB[(16 * i + 4 * g4 + e) * DP_RP + 16 * j + r16] = f2bf(Tk[i][e]); }
        }
        __syncthreads(); DPS(19);
        {
            const int mt = wave & 3, half = wave >> 2;
            bf16x8 tf[2];
#pragma unroll
            for (int kb = 0; kb < 2; ++kb) tf[kb] = *(const LAS bf16x8*)(TB + (16 * mt + r16) * DP_RP + 32 * kb + 8 * g4);
            if (half == 0) {
                float* wv = (float*)(p.ws + WS_DNF_WV + (size_t)uid * DNF_WV_UNIT) + (size_t)mt * 256 + lane * 4;
#pragma unroll
                for (int vt = 0; vt < 8; ++vt) { f32x4 acc = (f32x4){0.f, 0.f, 0.f, 0.f};
#pragma unroll
                    for (int kb = 0; kb < 2; ++kb) acc = __builtin_amdgcn_mfma_f32_16x16x32_bf16(tf[kb], *(const LAS bf16x8*)(RHST + (16 * vt + r16) * DP_RP + 32 * kb + 8 * g4), acc, 0, 0, 0);
                    *(f32x4*)(wv + (size_t)vt * 1024) = acc; }
            } else {
#pragma unroll
                for (int kbp = 0; kbp < 4; ++kbp) { f32x4 xt[2];
#pragma unroll
                    for (int c2 = 0; c2 < 2; ++c2) { xt[c2] = (f32x4){0.f, 0.f, 0.f, 0.f};
#pragma unroll
                        for (int kb = 0; kb < 2; ++kb) xt[c2] = __builtin_amdgcn_mfma_f32_16x16x32_bf16(*(const LAS bf16x8*)(RHST + (128 + 16 * (2 * kbp + c2) + r16) * DP_RP + 32 * kb + 8 * g4), tf[kb], xt[c2], 0, 0, 0); }
                    *(u32x4*)(abu + (size_t)(FR_NWK + mt * 4 + kbp) * 1024 + lane * 16) = __builtin_bit_cast(u32x4, pack8(-xt[0], -xt[1])); }
            }
        }
        __syncthreads(); DPS(20);
    }
#undef DP_FETCH
}

constexpr size_t O_ODN = O_Y;
#define DN_SB() __builtin_amdgcn_sched_barrier(0)
__device__ __forceinline__ void dn_consume(const LAS unsigned char* fb, int wl, f32x4 (&S)[8], float cd, float* op) {
    f32x4 u[4], o[4];
    bf16x8 fa[16], fq[16], Sb[4], Ub[2];
#pragma unroll
    for (int mt = 0; mt < 4; ++mt) u[mt] = *(const LAS f32x4*)(fb + (FR_N + wl * 4 + mt) * 1024);
#pragma unroll
    for (int f = 0; f < 16; ++f) fa[f] = *(const LAS bf16x8*)(fb + (FR_NWK + f) * 1024);
#pragma unroll
    for (int f = 0; f < 8; ++f) fq[f] = *(const LAS bf16x8*)(fb + (FR_QD + f) * 1024);
    DN_SB();
#pragma unroll
    for (int kb = 0; kb < 4; ++kb) Sb[kb] = pack8(S[2 * kb], S[2 * kb + 1]);
#pragma unroll
    for (int mt = 0; mt < 4; ++mt)
#pragma unroll
        for (int kb = 0; kb < 4; ++kb) u[mt] = __builtin_amdgcn_mfma_f32_16x16x32_bf16(fa[mt * 4 + kb], Sb[kb], u[mt], 0, 0, 0);
    DN_SB();
#pragma unroll
    for (int f = 8; f < 16; ++f) fq[f] = *(const LAS bf16x8*)(fb + (FR_QD + f) * 1024);
#pragma unroll
    for (int f = 0; f < 8; ++f) fa[f] = *(const LAS bf16x8*)(fb + (FR_KTT + f) * 1024);
    DN_SB();
#pragma unroll
    for (int mt = 0; mt < 4; ++mt) { o[mt] = (f32x4){0.f, 0.f, 0.f, 0.f};
#pragma unroll
        for (int kb = 0; kb < 4; ++kb) o[mt] = __builtin_amdgcn_mfma_f32_16x16x32_bf16(fq[mt * 4 + kb], Sb[kb], o[mt], 0, 0, 0); }
    DN_SB();
#pragma unroll
    for (int f = 8; f < 16; ++f) fa[f] = *(const LAS bf16x8*)(fb + (FR_KTT + f) * 1024);
#pragma unroll
    for (int f = 0; f < 8; ++f) fq[f] = *(const LAS bf16x8*)(fb + (FR_QK + f) * 1024);
#pragma unroll
    for (int tb = 0; tb < 2; ++tb) Ub[tb] = pack8(u[2 * tb], u[2 * tb + 1]);
#pragma unroll
    for (int kt = 0; kt < 8; ++kt) S[kt] = S[kt] * cd;
    DN_SB();
#pragma unroll
    for (int kt = 0; kt < 8; ++kt)
#pragma unroll
        for (int tb = 0; tb < 2; ++tb) S[kt] = __builtin_amdgcn_mfma_f32_16x16x32_bf16(fa[kt * 2 + tb], Ub[tb], S[kt], 0, 0, 0);
#pragma unroll
    for (int mt = 0; mt < 4; ++mt) {
#pragma unroll
        for (int tb = 0; tb < 2; ++tb) o[mt] = __builtin_amdgcn_mfma_f32_16x16x32_bf16(fq[mt * 2 + tb], Ub[tb], o[mt], 0, 0, 0);
#pragma unroll
        for (int i = 0; i < 4; ++i) op[(size_t)(16 * mt + i) * 512] = o[mt][i]; }
}
constexpr int DN_SBUF = 73728;
__device__ __forceinline__ void phase_dnscan(const P& p, LAS unsigned char* lds) {
    if (blockIdx.x >= BATCH * 4 * 2) return;
    const int tid = otid(), lane = tid & 63, wave = __builtin_amdgcn_readfirstlane(tid >> 6), r16 = lane & 15, g4 = lane >> 4;
    const int bh = blockIdx.x >> 1, vh = blockIdx.x & 1, h = bh & 3, b = bh >> 2, wl = wave & 3, vs = vh * 4 + wl, v0 = vs * 16;
    const float* cdp = ws_f(p, WS_DNF_CD) + (size_t)bh * NCHUNK;
    float* odn = p.out + O_ODN;
#define DN_BAR() do { asm volatile("s_waitcnt lgkmcnt(0)" ::: "memory"); __builtin_amdgcn_s_barrier(); asm volatile("" ::: "memory"); } while (0)
    if (wave >= 4) {
        const unsigned char* ab = p.ws + WS_DNF_AB + (size_t)bh * NCHUNK * DNF_AB_UNIT + lane * 16;
        const unsigned char* wvb = p.ws + WS_DNF_WV + (size_t)bh * NCHUNK * DNF_WV_UNIT + (size_t)vh * 16 * 1024 + lane * 16;
        u32x4 R[3][18];
#define DN_SRC(n_, q_) ((q_) < FR_N ? ab + (size_t)(n_) * DNF_AB_UNIT + (q_) * 1024 : wvb + (size_t)(n_) * DNF_WV_UNIT + ((q_) - FR_N) * 1024)
#define DN_LD(n_, s_) do { if ((n_) < NCHUNK) { _Pragma("unroll") for (int i_ = 0; i_ < 18; ++i_) R[s_][i_] = *(const u32x4*)DN_SRC(n_, wl * 18 + i_); } } while (0)
#define DN_ST(n_, s_) do { if ((n_) < NCHUNK) { LAS unsigned char* d_ = lds + ((n_) & 1) * DN_SBUF + wl * 18 * 1024 + lane * 16; _Pragma("unroll") for (int i_ = 0; i_ < 18; ++i_) *(LAS u32x4*)(d_ + i_ * 1024) = R[s_][i_]; } } while (0)
        DN_LD(0, 0); DN_LD(1, 1); DN_LD(2, 2); DN_ST(0, 0);
        DN_BAR();
#define DN_LSTEP(n_, s_) do { const int n = (n_); if (n < NCHUNK) { DN_LD(n + 3, s_); DN_ST(n + 1, ((s_) + 1) % 3); DN_BAR(); } } while (0)
        for (int n3 = 0; n3 < NCHUNK; n3 += 3) { DN_LSTEP(n3, 0); DN_LSTEP(n3 + 1, 1); DN_LSTEP(n3 + 2, 2); }
#undef DN_LSTEP
#undef DN_LD
#undef DN_ST
#undef DN_SRC
        return;
    }
    f32x4 S[8];
#pragma unroll
    for (int t = 0; t < 8; ++t) S[t] = (f32x4){0.f, 0.f, 0.f, 0.f};
    float cd = cdp[0];
    DN_BAR();
    for (int n = 0; n < NCHUNK; ++n) {
        const float cdn = cdp[n + 1 < NCHUNK ? n + 1 : n];
        dn_consume(lds + (n & 1) * DN_SBUF + lane * 16, wl, S, cd, odn + (size_t)(b * SEQ + n * 64 + 4 * g4) * 512 + h * 128 + v0 + r16);
        cd = cdn;
        DN_BAR();
    }
#undef DN_BAR
    {
        float* so = p.out + O_PSSM + (size_t)bh * 128 * 128 + v0 + r16;
#pragma unroll
        for (int kt = 0; kt < 8; ++kt)
#pragma unroll
            for (int i = 0; i < 4; ++i) so[(size_t)(16 * kt + 4 * g4 + i) * 128] = S[kt][i];
    }
}
__device__ __forceinline__ void phase_dngate(const P& p) {
    const int tid_ = otid(), lane = tid_ & 63, wave = tid_ >> 6;
    const int gw = blockIdx.x * NWAVES + wave, NGW = gridDim.x * NWAVES;
    const f32x4 nw0 = *(const f32x4*)(p.dn_norm_w + (lane & 15) * 8), nw1 = *(const f32x4*)(p.dn_norm_w + (lane & 15) * 8 + 4);
    f32x4 a, c; u32x4 z;
#define DG_LOAD(m_) do { const float* o_ = p.out + O_ODN + (size_t)(m_) * 512 + lane * 8; a = *(const f32x4*)o_; c = *(const f32x4*)(o_ + 4); z = *(const u32x4*)(ws_h(p, WS_PROJ) + (size_t)(m_) * PLD + PC_Z + lane * 8); } while (0)
    if (gw < TP) DG_LOAD(gw);
    for (int m = gw; m < TP; m += NGW) {
        const f32x4 a0 = a, c0 = c; const u32x4 z0 = z;
        if (m + NGW < TP) DG_LOAD(m + NGW);
        float ss = (a0[0] * a0[0] + a0[1] * a0[1]) + (a0[2] * a0[2] + a0[3] * a0[3]) + (c0[0] * c0[0] + c0[1] * c0[1]) + (c0[2] * c0[2] + c0[3] * c0[3]);
#pragma unroll
        for (int off = 1; off < 16; off <<= 1) ss += __shfl_xor(ss, off);
        const float rstd = 1.0f / sqrtf(ss * (1.0f / 128.0f) + EPS);
        const unsigned zw[4] = {z0.x, z0.y, z0.z, z0.w}; const float ov[8] = {a0[0], a0[1], a0[2], a0[3], c0[0], c0[1], c0[2], c0[3]}; const float nwv[8] = {nw0[0], nw0[1], nw0[2], nw0[3], nw1[0], nw1[1], nw1[2], nw1[3]};
        unsigned r[4];
#pragma unroll
        for (int e = 0; e < 4; ++e) { const float z0f = __builtin_bit_cast(float, zw[e] << 16), z1f = __builtin_bit_cast(float, zw[e] & 0xffff0000u);
            r[e] = pk2(ov[2 * e] * rstd * nwv[2 * e] * silu_f(z0f), ov[2 * e + 1] * rstd * nwv[2 * e + 1] * silu_f(z1f)); }
        *(u32x4*)(ws_h(p, WS_MIX) + (size_t)m * 1024 + lane * 8) = (u32x4){r[0], r[1], r[2], r[3]};
    }
#undef DG_LOAD
}
__device__ __forceinline__ void phase_dnsample(const P& p, LAS unsigned char* lds) {
    const int tid = otid(), lane = tid & 63, us = tid >> 8, w4 = (tid >> 6) & 3, kh = lane >> 5, col_ = w4 * 32 + (lane & 31);
    LAS float* QH = (LAS float*)lds + us * 4352;
    LAS float* KH = QH + 1024; LAS float* VH = QH + 2048; LAS float* OH = QH + 3072; LAS float* RED = QH + 4096;
    const bf16_t* PR = ws_h(p, WS_PROJ); const float* BG = ws_f(p, WS_BG);
    for (int ub = blockIdx.x; ub < DEC_BATCH * 2; ub += gridDim.x) {
        const int uidx = ub * 2 + us, b = uidx >> 2, h = uidx & 3, m0 = TP + b * DEC_SEQ;
        int col = col_; asm volatile("" : "+v"(col));
        {
            float x0[11], x1[11];
            const int ch0 = kh * 512 + h * 128 + col;
#pragma unroll
            for (int rr = 0; rr < 11; ++rr) {
                if (rr < 3) { const float* st = p.state_dn_conv + ((size_t)b * 3 + rr) * 1536; x0[rr] = st[ch0]; x1[rr] = st[1024 + h * 128 + col]; }
                else { const bf16_t* pr = PR + (size_t)(m0 + rr - 3) * PLD; x0[rr] = bf2f(pr[ch0]); x1[rr] = bf2f(pr[1024 + h * 128 + col]); } }
            float w0[4], w1[4];
#pragma unroll
            for (int j = 0; j < 4; ++j) { w0[j] = p.dn_conv_w[j * 1536 + ch0]; w1[j] = p.dn_conv_w[j * 1536 + 1024 + h * 128 + col]; }
#pragma unroll
            for (int t = 0; t < 8; ++t) { float a = 0.f, d = 0.f;
#pragma unroll
                for (int j = 0; j < 4; ++j) { a += w0[j] * x0[t + j]; d += w1[j] * x1[t + j]; }
                a = silu_f(a); d = silu_f(d);
                if (kh == 0) { QH[t * 128 + col] = a; VH[t * 128 + col] = d; } else KH[t * 128 + col] = a;
                const float sq = wave_sum(kh == 0 ? a * a : 0.f), sk = wave_sum(kh == 1 ? a * a : 0.f);
                if (lane == 0) { RED[w4 * 16 + t] = sq; RED[w4 * 16 + 8 + t] = sk; } }
        }
        __syncthreads();
#pragma unroll
        for (int t = 0; t < 8; ++t) {
            if (kh == 0) { const float sq = (RED[t] + RED[16 + t]) + (RED[32 + t] + RED[48 + t]); QH[t * 128 + col] *= 0.08838834764831845f / sqrtf(sq + EPS); }
            else { const float sk = (RED[8 + t] + RED[24 + t]) + (RED[40 + t] + RED[56 + t]); KH[t * 128 + col] *= 1.0f / sqrtf(sk + EPS); } }
        __syncthreads();
        float S[64];
        const float* S0 = p.state_dn_ssm + ((size_t)b * 4 + h) * 128 * 128 + (size_t)kh * 64 * 128 + col;
#pragma unroll
        for (int k = 0; k < 64; ++k) { S[k] = *S0; S0 += 128; if ((k & 7) == 7) asm volatile("" : "+v"(S0)); }
#pragma unroll 1
        for (int t = 0; t < 8; ++t) {
            const float beta = BG[(size_t)(m0 + t) * 8 + h], eg = expf(BG[(size_t)(m0 + t) * 8 + 4 + h]);
            const LAS float* kp = KH + t * 128 + kh * 64; const LAS float* qp = QH + t * 128 + kh * 64;
            float kS = 0.f;
#pragma unroll
            for (int k4 = 0; k4 < 16; ++k4) { const f32x4 kk = *(const LAS f32x4*)(kp + 4 * k4);
#pragma unroll
                for (int e = 0; e < 4; ++e) { S[4 * k4 + e] *= eg; kS += kk[e] * S[4 * k4 + e]; } }
            kS += __shfl_xor(kS, 32);
            const float u = beta * (VH[t * 128 + col] - kS);
            float o = 0.f;
#pragma unroll
            for (int k4 = 0; k4 < 16; ++k4) { const f32x4 kk = *(const LAS f32x4*)(kp + 4 * k4), qq = *(const LAS f32x4*)(qp + 4 * k4);
#pragma unroll
                for (int e = 0; e < 4; ++e) { S[4 * k4 + e] += kk[e] * u; o += qq[e] * S[4 * k4 + e]; } }
            o += __shfl_xor(o, 32);
            if (kh == 0) OH[t * 128 + col] = o;
        }
        float* So = p.out + O_SSSM + ((size_t)b * 4 + h) * 128 * 128 + (size_t)kh * 64 * 128 + col;
#pragma unroll
        for (int k = 0; k < 64; ++k) { *So = S[k]; So += 128; if ((k & 7) == 7) asm volatile("" : "+v"(So)); }
        __syncthreads();
#pragma unroll
        for (int t = 0; t < 8; ++t) { const float o = kh == 0 ? OH[t * 128 + col] : 0.f; const float s = wave_sum(o * o); if (lane == 0) RED[w4 * 16 + t] = s; }
        __syncthreads();
        if (kh == 0) {
            const float nw = p.dn_norm_w[col];
#pragma unroll
            for (int t = 0; t < 8; ++t) { const float rstd = 1.0f / sqrtf(((RED[t] + RED[16 + t]) + (RED[32 + t] + RED[48 + t])) * (1.0f / 128.0f) + EPS);
                const float z = bf2f(PR[(size_t)(m0 + t) * PLD + PC_Z + h * 128 + col]);
                ws_h(p, WS_MIX)[(size_t)(m0 + t) * 1024 + h * 128 + col] = f2bf(OH[t * 128 + col] * rstd * nw * silu_f(z)); }
        }
        __syncthreads();
    }
}
constexpr int NSEG = 16, CSEG = NCHUNK / NSEG, NBH = BATCH * 4;
static_assert(NCHUNK % NSEG == 0, "segments");
constexpr size_t O_RFRAG = O_ODN + (size_t)TP * 512;
constexpr size_t O_BSEG = O_RFRAG + (size_t)NBH * NSEG * 8192;
constexpr size_t O_SSEG = O_BSEG + (size_t)NBH * NSEG * 16384;
constexpr size_t O_CPROD = O_SSEG + (size_t)NBH * NSEG * 16384;
static_assert(O_CPROD + NBH * NSEG <= (size_t)T * D, "segment scratch fits in the y region of d_out");

template <bool HASWV> __device__ __forceinline__ void dn_consume_map(const LAS unsigned char* fb, int wl, f32x4 (&X)[8], float cd) {
    f32x4 u[4]; bf16x8 fa[16], fk[16], Xb[4], Ub[2];
#pragma unroll
    for (int mt = 0; mt < 4; ++mt) u[mt] = HASWV ? *(const LAS f32x4*)(fb + (FR_N + wl * 4 + mt) * 1024) : (f32x4){0.f, 0.f, 0.f, 0.f};
#pragma unroll
    for (int f = 0; f < 16; ++f) fa[f] = *(const LAS bf16x8*)(fb + (FR_NWK + f) * 1024);
#pragma unroll
    for (int f = 0; f < 8; ++f) fk[f] = *(const LAS bf16x8*)(fb + (FR_KTT + f) * 1024);
    DN_SB();
#pragma unroll
    for (int kb = 0; kb < 4; ++kb) Xb[kb] = pack8(X[2 * kb], X[2 * kb + 1]);
#pragma unroll
    for (int mt = 0; mt < 4; ++mt)
#pragma unroll
        for (int kb = 0; kb < 4; ++kb) u[mt] = __builtin_amdgcn_mfma_f32_16x16x32_bf16(fa[mt * 4 + kb], Xb[kb], u[mt], 0, 0, 0);
    DN_SB();
#pragma unroll
    for (int f = 8; f < 16; ++f) fk[f] = *(const LAS bf16x8*)(fb + (FR_KTT + f) * 1024);
#pragma unroll
    for (int tb = 0; tb < 2; ++tb) Ub[tb] = pack8(u[2 * tb], u[2 * tb + 1]);
#pragma unroll
    for (int kt = 0; kt < 8; ++kt) X[kt] = X[kt] * cd;
    DN_SB();
#pragma unroll
    for (int kt = 0; kt < 8; ++kt)
#pragma unroll
        for (int tb = 0; tb < 2; ++tb) X[kt] = __builtin_amdgcn_mfma_f32_16x16x32_bf16(fk[kt * 2 + tb], Ub[tb], X[kt], 0, 0, 0);
}
#define DNS_BAR() do { asm volatile("s_waitcnt lgkmcnt(0)" ::: "memory"); __builtin_amdgcn_s_barrier(); asm volatile("" ::: "memory"); } while (0)
template <int MODE> __device__ __forceinline__ void dns_loader(const P& p, LAS unsigned char* lds, int bh, int n0, int nsteps, int vh, int wl, int lane) {
    constexpr int NPW = MODE == 2 ? 18 : (MODE == 1 ? 12 : 8);
    const unsigned char* ab = p.ws + WS_DNF_AB + ((size_t)bh * NCHUNK + n0) * DNF_AB_UNIT + lane * 16;
    const unsigned char* wvb = p.ws + WS_DNF_WV + ((size_t)bh * NCHUNK + n0) * DNF_WV_UNIT + (size_t)vh * 16 * 1024 + lane * 16;
    u32x4 R[3][NPW];
#define DNS_FRAG(q_) (MODE == 2 ? (q_) : ((q_) < 16 ? (q_) : ((q_) < 32 ? FR_KTT + (q_) - 16 : FR_N + (q_) - 32)))
#define DNS_SRC(n_, q_) (DNS_FRAG(q_) < FR_N ? ab + (size_t)(n_) * DNF_AB_UNIT + DNS_FRAG(q_) * 1024 : wvb + (size_t)(n_) * DNF_WV_UNIT + (DNS_FRAG(q_) - FR_N) * 1024)
#define DNS_LD(n_, s_) do { if ((n_) < nsteps) { _Pragma("unroll") for (int i_ = 0; i_ < NPW; ++i_) R[s_][i_] = *(const u32x4*)DNS_SRC(n_, wl * NPW + i_); } } while (0)
#define DNS_ST(n_, s_) do { if ((n_) < nsteps) { LAS unsigned char* d_ = lds + ((n_) & 1) * DN_SBUF + lane * 16; _Pragma("unroll") for (int i_ = 0; i_ < NPW; ++i_) *(LAS u32x4*)(d_ + DNS_FRAG(wl * NPW + i_) * 1024) = R[s_][i_]; } } while (0)
    DNS_LD(0, 0); DNS_LD(1, 1); DNS_LD(2, 2); DNS_ST(0, 0);
    DNS_BAR();
#define DNS_LSTEP(n_, s_) do { const int n = (n_); if (n < nsteps) { DNS_LD(n + 3, s_); DNS_ST(n + 1, ((s_) + 1) % 3); DNS_BAR(); } } while (0)
    for (int n3 = 0; n3 < nsteps; n3 += 3) { DNS_LSTEP(n3, 0); DNS_LSTEP(n3 + 1, 1); DNS_LSTEP(n3 + 2, 2); }
#undef DNS_LSTEP
#undef DNS_LD
#undef DNS_ST
#undef DNS_SRC
#undef DNS_FRAG
}
constexpr int PA_RTP = 72;
template <int MODE> __device__ __forceinline__ void dns_passA_task(const P& p, LAS unsigned char* lds, int bh, int seg, int q, int wave, int lane) {
    const int r16 = lane & 15, g4 = lane >> 4, wl = wave & 3, n0 = seg * CSEG;
    const float* cdp = ws_f(p, WS_DNF_CD) + (size_t)bh * NCHUNK + n0;
    LAS bf16_t* RT = (LAS bf16_t*)lds;
    if (wave >= 4) { dns_loader<MODE>(p, lds, bh, n0, CSEG, q & 1, wl, lane); }
    else {
        f32x4 X[8];
#pragma unroll
        for (int kt = 0; kt < 8; ++kt)
#pragma unroll
            for (int i = 0; i < 4; ++i) X[kt][i] = (MODE == 0 && 16 * kt + 4 * g4 + i == 64 * q + 16 * wl + r16) ? 1.f : 0.f;
        float cd = cdp[0], cprod = 1.f;
        DNS_BAR();
        for (int n = 0; n < CSEG; ++n) {
            const float cdn = cdp[n + 1 < CSEG ? n + 1 : n];
            dn_consume_map<MODE == 1>(lds + (n & 1) * DN_SBUF + lane * 16, wl, X, cd);
            cprod *= cd; cd = cdn;
            DNS_BAR();
        }
        if (MODE == 0) {
#pragma unroll
            for (int kt = 0; kt < 8; ++kt)
#pragma unroll
                for (int i = 0; i < 4; ++i) { const int row = 16 * kt + 4 * g4 + i, col = 16 * wl + r16; const float v = X[kt][i] - ((row == 64 * q + col) ? cprod : 0.f);
                    RT[row * PA_RTP + col] = f2bf(v); }
            if (q == 0 && wave == 0 && lane == 0) p.out[O_CPROD + bh * NSEG + seg] = cprod;
        } else {
            float* bo = p.out + O_BSEG + ((size_t)(bh * NSEG + seg) * 8 + (4 * (q & 1) + wl)) * 2048 + lane * 4;
#pragma unroll
            for (int kt = 0; kt < 8; ++kt) *(f32x4*)(bo + kt * 256) = X[kt];
        }
    }
    DNS_BAR();
    if (MODE == 0) {
#pragma unroll
        for (int j = 0; j < 2; ++j) { const int f = wave * 2 + j, mt = f >> 1, kbl = f & 1, row = 16 * mt + r16;
            const u32x2 lo = *(const LAS u32x2*)(RT + row * PA_RTP + 32 * kbl + 4 * g4), hi = *(const LAS u32x2*)(RT + row * PA_RTP + 32 * kbl + 16 + 4 * g4);
            *(u32x4*)((unsigned char*)(p.out + O_RFRAG) + ((size_t)(bh * NSEG + seg) * 32 + mt * 4 + 2 * q + kbl) * 1024 + lane * 16) = (u32x4){lo.x, lo.y, hi.x, hi.y}; }
        DNS_BAR();
    }
}
__device__ __forceinline__ void phase_dns_passA(const P& p, LAS unsigned char* lds) {
    const int tid = otid(), lane = tid & 63, wave = __builtin_amdgcn_readfirstlane(tid >> 6);
    for (int t = blockIdx.x; t < NBH * NSEG * 4; t += gridDim.x) {
        const int q = t & 3, seg = (t >> 2) % NSEG, bh = t / (4 * NSEG);
        if (q < 2) dns_passA_task<0>(p, lds, bh, seg, q, wave, lane); else dns_passA_task<1>(p, lds, bh, seg, q, wave, lane);
    }
}
__device__ __forceinline__ void phase_dns_passB(const P& p, LAS unsigned char* lds) {
    if ((int)blockIdx.x >= NBH * 8) return;
    const int tid = otid(), lane = tid & 63, w = __builtin_amdgcn_readfirstlane(tid >> 6), r16 = lane & 15, g4 = lane >> 4;
    const int bh = blockIdx.x >> 3, vs = blockIdx.x & 7;
    LAS u32x2* XB = (LAS u32x2*)lds;
    const unsigned char* rf0 = (const unsigned char*)(p.out + O_RFRAG) + ((size_t)bh * NSEG * 32 + w * 4) * 1024 + lane * 16;
    const float* bt0 = p.out + O_BSEG + ((size_t)bh * NSEG * 8 + vs) * 2048 + w * 256 + lane * 4;
    float* ss0 = p.out + O_SSEG + ((size_t)bh * NSEG * 8 + vs) * 2048 + w * 256 + lane * 4;
    const float* cp0 = p.out + O_CPROD + bh * NSEG;
    u32x4 rf[4][4]; f32x4 bt[4]; float cp[4];
#define PB_LD(s_, r_) do { if ((s_) < NSEG) { _Pragma("unroll") for (int kb = 0; kb < 4; ++kb) rf[r_][kb] = *(const u32x4*)(rf0 + (size_t)(s_) * 32768 + kb * 1024); bt[r_] = *(const f32x4*)(bt0 + (size_t)(s_) * 16384); cp[r_] = cp0[(s_)]; } } while (0)
    PB_LD(0, 0); PB_LD(1, 1); PB_LD(2, 2);
    f32x4 S = (f32x4){0.f, 0.f, 0.f, 0.f};
#pragma unroll
    for (int s = 0; s < NSEG; ++s) {
        PB_LD(s + 3, (s + 3) & 3);
        *(f32x4*)(ss0 + (size_t)s * 16384) = S;
        XB[((s & 1) * 8 + w) * 64 + lane] = (u32x2){cvtpk_c(S[0], S[1]), cvtpk_c(S[2], S[3])};
        DNS_BAR();
        f32x4 acc = S * cp[s & 3] + bt[s & 3];
#pragma unroll
        for (int kb = 0; kb < 4; ++kb) { const u32x2 lo = XB[((s & 1) * 8 + 2 * kb) * 64 + lane], hi = XB[((s & 1) * 8 + 2 * kb + 1) * 64 + lane];
            acc = __builtin_amdgcn_mfma_f32_16x16x32_bf16(__builtin_bit_cast(bf16x8, rf[s & 3][kb]), __builtin_bit_cast(bf16x8, (u32x4){lo.x, lo.y, hi.x, hi.y}), acc, 0, 0, 0); }
        S = acc;
    }
#undef PB_LD
    float* so = p.out + O_PSSM + (size_t)bh * 128 * 128 + vs * 16 + r16;
#pragma unroll
    for (int i = 0; i < 4; ++i) so[(size_t)(16 * w + 4 * g4 + i) * 128] = S[i];
    DNS_BAR();
}
__device__ __forceinline__ void phase_dns_passC(const P& p, LAS unsigned char* lds) {
    const int tid = otid(), lane = tid & 63, wave = __builtin_amdgcn_readfirstlane(tid >> 6), r16 = lane & 15, g4 = lane >> 4, wl = wave & 3;
    for (int t = blockIdx.x; t < NBH * NSEG * 2; t += gridDim.x) {
        const int vh = t & 1, seg = (t >> 1) % NSEG, bh = t / (2 * NSEG), h = bh & 3, b = bh >> 2, vs = vh * 4 + wl, n0 = seg * CSEG;
        if (wave >= 4) dns_loader<2>(p, lds, bh, n0, CSEG, vh, wl, lane);
        else {
            const float* cdp = ws_f(p, WS_DNF_CD) + (size_t)bh * NCHUNK + n0;
            const float* ss = p.out + O_SSEG + ((size_t)(bh * NSEG + seg) * 8 + vs) * 2048 + lane * 4;
            f32x4 S[8];
#pragma unroll
            for (int kt = 0; kt < 8; ++kt) S[kt] = *(const f32x4*)(ss + kt * 256);
            float cd = cdp[0];
            DNS_BAR();
            for (int n = 0; n < CSEG; ++n) {
                const float cdn = cdp[n + 1 < CSEG ? n + 1 : n];
                dn_consume(lds + (n & 1) * DN_SBUF + lane * 16, wl, S, cd, p.out + O_ODN + (size_t)(b * SEQ + (n0 + n) * 64 + 4 * g4) * 512 + h * 128 + vs * 16 + r16);
                cd = cdn;
                DNS_BAR();
            }
        }
        DNS_BAR();
    }
}
#undef DNS_BAR
constexpr size_t WS_EDGE = WS_FREE;
constexpr size_t WS_HEAD = al256(WS_EDGE + (size_t)(T / 256) * 2 * 2 * DFF * 4);
constexpr size_t WS_END = al256(WS_HEAD + (size_t)(T / 256) * 2 * 2 * DFF * 4);
constexpr int EX_OFF = 131072;
namespace pg8 {
typedef unsigned u32x2v __attribute__((ext_vector_type(2)));
__device__ __forceinline__ float dpp_shr1(float old, float src) { return __builtin_bit_cast(float, __builtin_amdgcn_update_dpp(__builtin_bit_cast(int, old), __builtin_bit_cast(int, src), 0x111, 0xf, 0xf, false)); }
__device__ __forceinline__ float dpp_shr2(float old, float src) { return __builtin_bit_cast(float, __builtin_amdgcn_update_dpp(__builtin_bit_cast(int, old), __builtin_bit_cast(int, src), 0x112, 0xf, 0xf, false)); }
__device__ __forceinline__ float dpp_ror1(float src) { return __builtin_bit_cast(float, __builtin_amdgcn_update_dpp(0, __builtin_bit_cast(int, src), 0x121, 0xf, 0xf, false)); }
__device__ __forceinline__ float dpp_ror2(float src) { return __builtin_bit_cast(float, __builtin_amdgcn_update_dpp(0, __builtin_bit_cast(int, src), 0x122, 0xf, 0xf, false)); }
struct EpiFfnUp {
    static constexpr bool PERM = false, AFTER_DRAIN = false;
    bf16_t* ACT; float* edge; float* head; const float* cw; const float* cb; const float* state; float* out_pfc; float* out_sfc; PG8_LAS unsigned char* lds;
    __device__ __forceinline__ void operator()(const f32x4 (&acc)[2][2][4][2], const Unit& u, int wr, int wc, int fr, int fq) const {
        PG8_LAS float* EX = (PG8_LAS float*)(lds + EX_OFF);
        const bool smp = u.pm >= TP / BM;
        const int cl = wc * 32 + 4 * fq;
        if (fr >= 14) {
#pragma unroll
            for (int ai = 0; ai < 2; ++ai)
#pragma unroll
                for (int bj = 0; bj < 2; ++bj)
#pragma unroll
                    for (int n = 0; n < 2; ++n) *(PG8_LAS f32x4*)(EX + ((2 * ai + wr) * 2 + (fr - 14)) * 256 + bj * HALF + cl + 16 * n) = acc[ai][bj][3][n];
            if (wr == 1) {
#pragma unroll
                for (int bj = 0; bj < 2; ++bj)
#pragma unroll
                    for (int n = 0; n < 2; ++n) { const int oc = bj * DFF + u.pn * HALF + cl + 16 * n;
                        *(f32x4*)(edge + ((size_t)u.pm * 2 + (fr - 14)) * 2 * DFF + oc) = acc[1][bj][3][n];
                        if (!smp && (u.pm & (SEQ / BM - 1)) == SEQ / BM - 1) *(f32x4*)(out_pfc + ((size_t)(u.pm / (SEQ / BM)) * 2 + (fr - 14)) * 2 * DFF + oc) = acc[1][bj][3][n]; }
            }
        }
        if (fr < 2 && wr == 0) {
#pragma unroll
            for (int bj = 0; bj < 2; ++bj)
#pragma unroll
                for (int n = 0; n < 2; ++n) *(f32x4*)(head + ((size_t)u.pm * 2 + fr) * 2 * DFF + bj * DFF + u.pn * HALF + cl + 16 * n) = acc[0][bj][0][n];
        }
        asm volatile("s_waitcnt lgkmcnt(0)" ::: "memory"); __builtin_amdgcn_s_barrier(); asm volatile("" ::: "memory");
#pragma unroll
        for (int n = 0; n < 2; ++n) {
            const int f0 = u.pn * HALF + cl + 16 * n;
            f32x4 wg[3], wu[3], bg, bu;
#pragma unroll
            for (int j = 0; j < 3; ++j) { wg[j] = *(const f32x4*)(cw + (size_t)j * 2 * DFF + f0); wu[j] = *(const f32x4*)(cw + (size_t)j * 2 * DFF + DFF + f0); }
            bg = *(const f32x4*)(cb + f0); bu = *(const f32x4*)(cb + DFF + f0);
#pragma unroll
            for (int ai = 0; ai < 2; ++ai) {
                const int s = 2 * ai + wr;
                f32x4 pg = (f32x4){0.f, 0.f, 0.f, 0.f}, pu = pg;
                if (!smp && s > 0 && fr >= 14) { pg = *(const PG8_LAS f32x4*)(EX + ((s - 1) * 2 + (fr - 14)) * 256 + cl + 16 * n); pu = *(const PG8_LAS f32x4*)(EX + ((s - 1) * 2 + (fr - 14)) * 256 + HALF + cl + 16 * n); }
#pragma unroll
                for (int m = 0; m < 4; ++m) {
                    const f32x4 cg = acc[ai][0][m][n], cu = acc[ai][1][m][n];
                    const int row = u.pm * BM + ai * HALF + wr * 64 + m * 16 + fr;
                    f32x4 g1, g2, u1, u2;
#pragma unroll
                    for (int e = 0; e < 4; ++e) { g1[e] = dpp_shr1(dpp_ror1(pg[e]), cg[e]); g2[e] = dpp_shr2(dpp_ror2(pg[e]), cg[e]); u1[e] = dpp_shr1(dpp_ror1(pu[e]), cu[e]); u2[e] = dpp_shr2(dpp_ror2(pu[e]), cu[e]); }
                    if (smp) {
                        const int t = fr & 7, b = (row - TP) >> 3;
                        if (t < 2) { const float* st = state + (size_t)b * 2 * 2 * DFF + f0; const f32x4 s1g = *(const f32x4*)(st + 2 * DFF), s1u = *(const f32x4*)(st + 2 * DFF + DFF);
                            if (t == 0) { g1 = s1g; u1 = s1u; g2 = *(const f32x4*)st; u2 = *(const f32x4*)(st + DFF); } else { g2 = s1g; u2 = s1u; } }
                        if (t >= 6) { float* o = out_sfc + ((size_t)b * 2 + (t - 6)) * 2 * DFF + f0; *(f32x4*)o = cg; *(f32x4*)(o + DFF) = cu; }
                    }
                    const f32x4 gc = wg[0] * g2 + wg[1] * g1 + wg[2] * cg + bg, uc = wu[0] * u2 + wu[1] * u1 + wu[2] * cu + bu;
                    u32x2v w;
                    { const float a0 = gc[0] / (1.0f + __expf(-gc[0])) * uc[0], a1 = gc[1] / (1.0f + __expf(-gc[1])) * uc[1], a2 = gc[2] / (1.0f + __expf(-gc[2])) * uc[2], a3 = gc[3] / (1.0f + __expf(-gc[3])) * uc[3];
                      w.x = cvt_pk_bf16(a0, a1); w.y = cvt_pk_bf16(a2, a3); }
                    *(u32x2v*)(ACT + (size_t)row * DFF + f0) = w;
                    pg = cg; pu = cu;
                }
            }
        }
    }
};
}
__device__ __forceinline__ void phase_ffn_fix(const P& p) {
    constexpr int TPS = SEQ / 256;
    const long n = (long)(BATCH * TPS) * DFF;
    const float* edge = ws_f(p, WS_EDGE); const float* head = ws_f(p, WS_HEAD);
    for (long i = blockIdx.x * (long)NTHR + otid(); i < n; i += (long)gridDim.x * NTHR) {
        const int pm = (int)(i / DFF), f = (int)(i % DFF);
        if (pm % TPS == 0) continue;
        float r0[2], r1[2];
#pragma unroll
        for (int gu = 0; gu < 2; ++gu) { const int c = gu * DFF + f;
            const float um2 = edge[((size_t)(pm - 1) * 2 + 0) * 2 * DFF + c], um1 = edge[((size_t)(pm - 1) * 2 + 1) * 2 * DFF + c], u0 = head[((size_t)pm * 2 + 0) * 2 * DFF + c], u1 = head[((size_t)pm * 2 + 1) * 2 * DFF + c];
            const float w0 = p.ffn_conv_w[c], w1 = p.ffn_conv_w[2 * DFF + c], w2 = p.ffn_conv_w[4 * DFF + c], bb = p.ffn_conv_b[c];
            r0[gu] = w0 * um2 + w1 * um1 + w2 * u0 + bb; r1[gu] = w0 * um1 + w1 * u0 + w2 * u1 + bb; }
        bf16_t* ACT = ws_h(p, WS_ACT) + (size_t)pm * 256 * DFF + f;
        ACT[0] = f2bf(silu_f(r0[0]) * r0[1]); ACT[DFF] = f2bf(silu_f(r1[0]) * r1[1]);
    }
}
constexpr int SW_KP = 72;
__device__ __forceinline__ void swa_qtile(const LAS bf16_t* KS, const LAS bf16_t* VT, int vtp, int qt, const bf16_t* qptr, int qrow_mask, const LAS float* BT, float sink, bool first, bf16_t* optr, int nvalid_q, int lane) {
    const int r16 = lane & 15, g4 = lane >> 4, kt0 = qt;
    bf16x8 bq[2];
#pragma unroll
    for (int ks = 0; ks < 2; ++ks) bq[ks] = *(const bf16x8*)(qptr + (size_t)(r16 & qrow_mask) * PLD + 32 * ks + 8 * g4);
    f32x4 s[10];
#pragma unroll
    for (int t = 0; t < 9; ++t) { f32x4 a = (f32x4){0.f, 0.f, 0.f, 0.f};
#pragma unroll
        for (int ks = 0; ks < 2; ++ks) a = __builtin_amdgcn_mfma_f32_16x16x32_bf16(*(const LAS bf16x8*)(KS + (16 * (kt0 + t) + r16) * SW_KP + 32 * ks + 8 * g4), bq[ks], a, 0, 0, 0);
        s[t] = a; }
    float mx = sink;
#pragma unroll
    for (int t = 0; t < 9; ++t)
#pragma unroll
        for (int e = 0; e < 4; ++e) { const int jj = 16 * (kt0 + t) + 4 * g4 + e, d = 128 + 16 * qt + r16 - jj; const bool ok = d >= 0 && d <= 127 && !(first && jj < 128);
            const float v = ok ? s[t][e] * 0.125f + BT[ok ? d : 0] : -1e30f; s[t][e] = v; mx = fmaxf(mx, v); }
    mx = fmaxf(mx, __shfl_xor(mx, 16)); mx = fmaxf(mx, __shfl_xor(mx, 32));
    float l = 0.f;
#pragma unroll
    for (int t = 0; t < 9; ++t)
#pragma unroll
        for (int e = 0; e < 4; ++e) { const float pv = __expf(s[t][e] - mx); s[t][e] = pv; l += pv; }
    s[9] = (f32x4){0.f, 0.f, 0.f, 0.f};
    l += __shfl_xor(l, 16); l += __shfl_xor(l, 32);
    l += __expf(sink - mx);
    const float rl = 1.0f / l;
    bf16x8 pb[5];
#pragma unroll
    for (int q = 0; q < 5; ++q) pb[q] = pack8(s[2 * q], s[2 * q + 1]);
#pragma unroll
    for (int dt = 0; dt < 4; ++dt) { f32x4 o = (f32x4){0.f, 0.f, 0.f, 0.f};
#pragma unroll
        for (int q = 0; q < 5; ++q) { const LAS bf16_t* vp = VT + (16 * dt + r16) * vtp + 16 * (kt0 + 2 * q) + 4 * g4;
            const u32x2 lo = *(const LAS u32x2*)vp, hi = *(const LAS u32x2*)(vp + 16);
            o = __builtin_amdgcn_mfma_f32_16x16x32_bf16(__builtin_bit_cast(bf16x8, (u32x4){lo.x, lo.y, hi.x, hi.y}), pb[q], o, 0, 0, 0); }
        if (r16 < nvalid_q) *(u32x2*)(optr + (size_t)r16 * 1024 + 16 * dt + 4 * g4) = (u32x2){cvtpk_c(o[0] * rl, o[1] * rl), cvtpk_c(o[2] * rl, o[3] * rl)}; }
}
constexpr int SWP_VTP = 272, SWS_NK = 144, SWS_VTP = 168;
constexpr int SW_KS = 0, SW_VT = 43008, SW_BT = 86016, SW_END = SW_BT + 8 * 128 * 4;
static_assert(256 * SW_KP * 2 <= SW_VT && SW_VT + 64 * SWP_VTP * 2 <= SW_BT && 2 * SWS_NK * SW_KP * 2 <= SW_VT && SW_VT + 2 * 64 * SWS_VTP * 2 <= SW_BT, "swa LDS map");
__device__ __forceinline__ void phase_swa(const P& p, LAS unsigned char* lds) {
    const int tid = otid(), lane = tid & 63, wave = tid >> 6;
    LAS bf16_t* KS = (LAS bf16_t*)(lds + SW_KS); LAS bf16_t* VT = (LAS bf16_t*)(lds + SW_VT); LAS float* BT = (LAS float*)(lds + SW_BT);
    const bf16_t* PR = ws_h(p, WS_PROJ); bf16_t* MX = ws_h(p, WS_MIX);
    constexpr int NQB = SEQ / 128, NPU = BATCH * NQB * 2, NU = NPU + DEC_BATCH;
    for (int i = tid; i < 8 * 128; i += NTHR) BT[i] = p.rel_bias[t5_bucket(i & 127) * 8 + (i >> 7)];
    for (int u = blockIdx.x; u < NU; u += gridDim.x) {
        __syncthreads();
        if (u < NPU) {
            const int kvh = u & 1, qb = (u >> 1) % NQB, b = (u >> 1) / NQB, m0 = b * SEQ + qb * 128; const bool first = qb == 0;
            for (int it = tid; it < 256 * 8; it += NTHR) { const int jj = it >> 3, c = it & 7; u32x4 v = (u32x4){0u, 0u, 0u, 0u};
                if (!(first && jj < 128)) v = *(const u32x4*)(PR + (size_t)(m0 - 128 + jj) * PLD + PC_SK + kvh * 64 + 8 * c);
                *(LAS u32x4*)(KS + jj * SW_KP + 8 * c) = v; }
            for (int it = tid; it < 272 * 8; it += NTHR) { const int jj = it % 272, c = it / 272; u32x4 v = (u32x4){0u, 0u, 0u, 0u};
                if (jj < 256 && !(first && jj < 128)) v = *(const u32x4*)(PR + (size_t)(m0 - 128 + jj) * PLD + PC_SV + kvh * 64 + 8 * c);
                const unsigned w[4] = {v.x, v.y, v.z, v.w};
#pragma unroll
                for (int e = 0; e < 4; ++e) { VT[(8 * c + 2 * e) * SWP_VTP + jj] = (bf16_t)(w[e] & 0xffffu); VT[(8 * c + 2 * e + 1) * SWP_VTP + jj] = (bf16_t)(w[e] >> 16); } }
            __syncthreads();
            const int hq = kvh * 4 + (wave >> 1), qh = wave & 1;
#pragma unroll 1
            for (int q4 = 0; q4 < 4; ++q4) { const int qt = 4 * qh + q4;
                swa_qtile(KS, VT, SWP_VTP, qt, PR + (size_t)(m0 + 16 * qt) * PLD + PC_SQ + hq * 64, 15, BT + hq * 128, p.swa_sinks[hq], first, MX + (size_t)(m0 + 16 * qt) * 1024 + 512 + hq * 64, 16, lane); }
        } else {
            const int b = u - NPU, m0 = TP + b * DEC_SEQ;
            for (int it = tid; it < 2 * SWS_NK * 8; it += NTHR) { const int kvh = it / (SWS_NK * 8), r = it % (SWS_NK * 8), jj = r >> 3, c = r & 7; u32x4 v = (u32x4){0u, 0u, 0u, 0u};
                if (jj < 128) { const float* src = p.cache_k + ((size_t)b * 128 + jj) * 128 + kvh * 64 + 8 * c; const f32x4 a = *(const f32x4*)src, d = *(const f32x4*)(src + 4);
                    v = (u32x4){pk2(a[0], a[1]), pk2(a[2], a[3]), pk2(d[0], d[1]), pk2(d[2], d[3])}; }
                else if (jj < 128 + DEC_SEQ) v = *(const u32x4*)(PR + (size_t)(m0 + jj - 128) * PLD + PC_SK + kvh * 64 + 8 * c);
                *(LAS u32x4*)(KS + (kvh * SWS_NK + jj) * SW_KP + 8 * c) = v; }
            for (int it = tid; it < 2 * SWS_VTP * 8; it += NTHR) { const int kvh = it / (SWS_VTP * 8), r = it % (SWS_VTP * 8), jj = r % SWS_VTP, c = r / SWS_VTP; float f[8];
#pragma unroll
                for (int e = 0; e < 8; ++e) f[e] = 0.f;
                if (jj < 128) { const float* src = p.cache_v + ((size_t)b * 128 + jj) * 128 + kvh * 64 + 8 * c; const f32x4 a = *(const f32x4*)src, d = *(const f32x4*)(src + 4);
                    f[0] = a[0]; f[1] = a[1]; f[2] = a[2]; f[3] = a[3]; f[4] = d[0]; f[5] = d[1]; f[6] = d[2]; f[7] = d[3]; }
                else if (jj < 128 + DEC_SEQ) { const bf16_t* src = PR + (size_t)(m0 + jj - 128) * PLD + PC_SV + kvh * 64 + 8 * c;
#pragma unroll
                    for (int e = 0; e < 8; ++e) f[e] = bf2f(src[e]); }
#pragma unroll
                for (int e = 0; e < 8; ++e) VT[(kvh * 64 + 8 * c + e) * SWS_VTP + jj] = f2bf(f[e]); }
            __syncthreads();
            const int kvh = wave >> 2, hq = kvh * 4 + (wave & 3);
            swa_qtile(KS + kvh * SWS_NK * SW_KP, VT + kvh * 64 * SWS_VTP, SWS_VTP, 0, PR + (size_t)m0 * PLD + PC_SQ + hq * 64, 7, BT + hq * 128, p.swa_sinks[hq], false, MX + (size_t)m0 * 1024 + 512 + hq * 64, 8, lane);
        }
    }
    __syncthreads();
}
static void fill_params(P& p, void* const* d_in, void* d_out, void* d_ws) {
    const float** pp = (const float**)&p;
    for (int i = 0; i < 26; ++i) pp[i] = (const float*)d_in[i];
    p.out = (float*)d_out; p.ws = (unsigned char*)d_ws;
}
namespace cg = cooperative_groups;
constexpr int CW_BAR = 1024;
constexpr size_t CTL_ZERO_BYTES = 65536;

#ifndef PROBE_MASK
#define PROBE_MASK 0
#endif
#ifndef PROBE_K
#define PROBE_K 4
#endif
#ifndef PROBE_XSYNC
#define PROBE_XSYNC 0
#endif
#if PROBE_MASK
#define PROBE_SUB(k) do { xcd_barrier(bar); PROBE_STAMP(k); } while (0)
#define PROBE_DECL unsigned long long pr_prev = __builtin_amdgcn_s_memrealtime(), pr_acc = 0ull
#define PROBE_STAMP(k) do { const unsigned long long now_ = __builtin_amdgcn_s_memrealtime(); if ((PROBE_MASK >> (k)) & 1) pr_acc += now_ - pr_prev; pr_prev = now_; } while (0)
#define PROBE_END() do { xcd_barrier(bar); PROBE_STAMP(11); if (blockIdx.x == 0 && threadIdx.x == 0) { const unsigned long long t0_ = __builtin_amdgcn_s_memrealtime(); while (__builtin_amdgcn_s_memrealtime() - t0_ < (unsigned long long)PROBE_K * pr_acc) __builtin_amdgcn_s_sleep(8); } } while (0)
#else
#define PROBE_DECL unsigned long long pr_prev = 0ull, pr_acc = 0ull
#define PROBE_SUB(k)
#define PROBE_STAMP(k)
#define PROBE_END() do { for (int i_ = 0; i_ < PROBE_XSYNC; ++i_) xcd_barrier(bar); } while (0)
#endif
__global__ void __launch_bounds__(512, 2) fwd_megakernel(P p) {
    extern __shared__ __attribute__((aligned(16))) unsigned char lds_raw[];
    LAS unsigned char* lds = (LAS unsigned char*)lds_raw;
    cg::grid_group grid = cg::this_grid();
    PROBE_DECL;
    volatile LAS unsigned* MISC = (volatile LAS unsigned*)(lds + LDS_BYTES - 64);
    if (threadIdx.x < 16) MISC[threadIdx.x] = 0u;
    __syncthreads();
    const XcdBarrier bar = xcd_barrier_post((unsigned*)(p.ws + WS_CTL) + CW_BAR, MISC);
    phase_mod(p, lds); phase_transposes(p, lds);
    grid.sync(); PROBE_STAMP(0);
    phase_norm<0>(p);
    xcd_barrier(bar); PROBE_STAMP(1);
    { pg8::StaticOrder S; pg8::Gemm g{ws_h(p, WS_H), ws_h(p, WS_WT_IN), T, PLD, D}; S.init(T, PLD, gridDim.x, blockIdx.x); pg8::EpiStoreBf16 E{ws_h(p, WS_PROJ), PLD};
      pg8::gemm_phase<pg8::EpiStoreBf16, pg8::StaticOrder, true, true>(lds, g, S, E); }
    xcd_barrier(bar); PROBE_STAMP(2);
    phase_state_out(p);
    PROBE_STAMP(21);
    phase_dnprep(p, lds, pr_prev, pr_acc);
    PROBE_SUB(12);
    phase_dnsample(p, lds);
    PROBE_SUB(13);
    phase_swa(p, lds);
    xcd_barrier(bar); PROBE_STAMP(3);
    phase_dns_passA(p, lds);
    xcd_barrier(bar); PROBE_STAMP(14);
    phase_dns_passB(p, lds);
    xcd_barrier(bar); PROBE_STAMP(15);
    phase_dns_passC(p, lds);
    xcd_barrier(bar); PROBE_STAMP(4);
    phase_dngate(p);
    xcd_barrier(bar); PROBE_STAMP(5);
    { pg8::StaticOrder S; pg8::Gemm g{ws_h(p, WS_MIX), ws_h(p, WS_WT_OUT), T, D, 1024}; S.init(T, D, gridDim.x, blockIdx.x); pg8::EpiGateRes E{p.x_prompt, p.x_sample, p.out + O_Y, ws_f(p, WS_MOD) + 2 * D};
      pg8::gemm_phase<pg8::EpiGateRes, pg8::StaticOrder, true, true>(lds, g, S, E); }
    xcd_barrier(bar); PROBE_STAMP(6);
    phase_norm<1>(p);
    xcd_barrier(bar); PROBE_STAMP(7);
    { pg8::StaticOrder S; pg8::Gemm g{ws_h(p, WS_H), ws_h(p, WS_WT_UP), T, 2 * DFF, D}; S.init(T, 2 * DFF, gridDim.x, blockIdx.x);
      pg8::EpiFfnUp E{ws_h(p, WS_ACT), ws_f(p, WS_EDGE), ws_f(p, WS_HEAD), p.ffn_conv_w, p.ffn_conv_b, p.state_ffn, p.out + O_PFC, p.out + O_SFC, lds};
      pg8::gemm_phase<pg8::EpiFfnUp, pg8::StaticOrder, true, true>(lds, g, S, E); }
    xcd_barrier(bar); PROBE_STAMP(8);
    phase_ffn_fix(p);
    xcd_barrier(bar); PROBE_STAMP(9);
    { pg8::StaticOrder S; pg8::Gemm g{ws_h(p, WS_ACT), ws_h(p, WS_WT_DN), T, D, DFF}; S.init(T, D, gridDim.x, blockIdx.x); pg8::EpiGateRes E{p.out + O_Y, p.out + O_Y + (size_t)TP * D, p.out + O_Y, ws_f(p, WS_MOD) + 5 * D};
      pg8::gemm_phase<pg8::EpiGateRes, pg8::StaticOrder, true, true>(lds, g, S, E); }
    xcd_barrier(bar); PROBE_STAMP(10);
    phase_norm<2>(p);
    PROBE_END();
}
extern "C" void kernel_launch(void* const* d_in, const int* in_sizes, int n_in, void* d_out, int out_size, void* d_ws, size_t ws_size, hipStream_t stream) {
    static int grid_blocks = 0;
    if (grid_blocks == 0) {
        if (n_in != 26 || (long)out_size != O_END || ws_size < WS_END) { fprintf(stderr, "kernel_launch: unexpected shapes n_in=%d out=%d ws=%zu (need %zu)\n", n_in, out_size, ws_size, (size_t)WS_END); grid_blocks = -1; return; }
        int dev = 0, cus = 0, per_cu = 0;
        if (hipGetDevice(&dev) != hipSuccess || hipDeviceGetAttribute(&cus, hipDeviceAttributeMultiprocessorCount, dev) != hipSuccess) { grid_blocks = -1; return; }
        if (hipFuncSetAttribute((const void*)fwd_megakernel, hipFuncAttributeMaxDynamicSharedMemorySize, LDS_BYTES) != hipSuccess) { fprintf(stderr, "kernel_launch: hipFuncSetAttribute failed\n"); grid_blocks = -1; return; }
        if (hipOccupancyMaxActiveBlocksPerMultiprocessor(&per_cu, (const void*)fwd_megakernel, NTHR, LDS_BYTES) != hipSuccess || per_cu < 1) { fprintf(stderr, "kernel_launch: occupancy query says %d\n", per_cu); grid_blocks = -1; return; }
        grid_blocks = cus;
        fprintf(stderr, "kernel_launch: grid %d (cus %d, per_cu %d)\n", grid_blocks, cus, per_cu);
    }
    if (grid_blocks < 0) return;
    P p{}; fill_params(p, d_in, d_out, d_ws);
    if (hipMemsetAsync((char*)d_ws + WS_CTL, 0, CTL_ZERO_BYTES, stream) != hipSuccess) { fprintf(stderr, "kernel_launch: memset of the control words failed\n"); return; }
    void* args[] = {&p};
    const hipError_t e = hipLaunchCooperativeKernel((const void*)fwd_megakernel, dim3(grid_blocks), dim3(NTHR), args, LDS_BYTES, stream);
    if (e != hipSuccess) fprintf(stderr, "cooperative launch failed: %s (grid %d)\n", hipGetErrorString(e), grid_blocks);
}
```

```cpp
#define PROBE_MASK 0
#define PROBE_XSYNC 0
#include <hip/hip_runtime.h>
#include <hip/hip_cooperative_groups.h>
#include <cstdio>
#include <cstdint>
#define HD __device__ __forceinline__
#if defined(PROBE_MASK) && PROBE_MASK
#define DPS(k) do { const unsigned long long now_ = __builtin_amdgcn_s_memrealtime(); if ((PROBE_MASK >> (k)) & 1) pr_acc += now_ - pr_prev; pr_prev = now_; } while (0)
#endif
#ifndef CFG_D_MODEL
#define CFG_D_MODEL 1024
#endif
#ifndef CFG_SEQ
#define CFG_SEQ 8192
#endif
#ifndef CFG_DEC_BATCH
#define CFG_DEC_BATCH 128
#endif
#ifndef CFG_D_FF
#define CFG_D_FF 2816
#endif

constexpr int D = CFG_D_MODEL, BATCH = 2, SEQ = CFG_SEQ, DEC_BATCH = CFG_DEC_BATCH, DEC_SEQ = 8, DFF = CFG_D_FF;
constexpr int TP = BATCH * SEQ, TS = DEC_BATCH * DEC_SEQ, T = TP + TS, NCB = BATCH + DEC_BATCH;
constexpr int IN_COLS = 2824, PLD = 2816;
constexpr int PC_QKV = 0, PC_Z = 1536, PC_SQ = 2048, PC_SK = 2560, PC_SV = 2688;
constexpr int WC_BA = 2048;
constexpr float EPS = 1e-6f;

constexpr long O_Y = 0;
constexpr long O_PDC = (long)T * D;
constexpr long O_SDC = O_PDC + (long)BATCH * 3 * 1536;
constexpr long O_PSSM = O_SDC + (long)DEC_BATCH * 3 * 1536;
constexpr long O_SSSM = O_PSSM + (long)BATCH * 4 * 128 * 128;
constexpr long O_PK = O_SSSM + (long)DEC_BATCH * 4 * 128 * 128;
constexpr long O_SK = O_PK + (long)BATCH * 128 * 128;
constexpr long O_PV = O_SK + (long)DEC_BATCH * 128 * 128;
constexpr long O_SV = O_PV + (long)BATCH * 128 * 128;
constexpr long O_PFC = O_SV + (long)DEC_BATCH * 128 * 128;
constexpr long O_SFC = O_PFC + (long)BATCH * 2 * 2 * DFF;
constexpr long O_END = O_SFC + (long)DEC_BATCH * 2 * 2 * DFF;

constexpr size_t al256(size_t x) { return (x + 255) & ~(size_t)255; }
constexpr size_t WS_CTL = 0;
constexpr size_t WS_MOD = 1u << 20;
constexpr size_t WS_BG = al256(WS_MOD + (size_t)NCB * 6 * D * 4);
constexpr size_t WS_WBAT = al256(WS_BG + (size_t)T * 8 * 4);
constexpr size_t WS_WT_IN = al256(WS_WBAT + (size_t)8 * D * 4);
constexpr size_t WS_WT_OUT = al256(WS_WT_IN + (size_t)PLD * D * 2);
constexpr size_t WS_WT_UP = al256(WS_WT_OUT + (size_t)D * 1024 * 2);
constexpr size_t WS_WT_DN = al256(WS_WT_UP + (size_t)2 * DFF * D * 2);
constexpr size_t WS_H = al256(WS_WT_DN + (size_t)D * DFF * 2);
constexpr int NCHUNK = SEQ / 64, NUNIT = BATCH * 4 * NCHUNK;
constexpr int DNF_AB_UNIT = 57344, DNF_WV_UNIT = 32768;
constexpr size_t WS_DNF_WV = WS_H;
constexpr size_t WS_DNF_AB = al256(WS_H + (size_t)T * (D > 1024 ? D : 1024) * 2);
constexpr size_t WS_DNF_CD = al256(WS_DNF_AB + (size_t)NUNIT * DNF_AB_UNIT);
constexpr size_t WS_QKVC = WS_DNF_AB;
constexpr size_t WS_PROJ = al256((WS_DNF_CD + (size_t)NUNIT * 4) > (WS_QKVC + (size_t)T * 1536 * 2) ? (WS_DNF_CD + (size_t)NUNIT * 4) : (WS_QKVC + (size_t)T * 1536 * 2));
constexpr size_t WS_MIX = al256(WS_PROJ + (size_t)T * PLD * 2);
constexpr size_t WS_FREE = al256(WS_MIX + (size_t)T * 1024 * 2);
constexpr size_t WS_ODN = WS_H, WS_ACT = WS_PROJ;
static_assert((size_t)NUNIT * DNF_WV_UNIT <= (size_t)T * 1024 * 2, "Wv tiles overlay H");

typedef unsigned short bf16_t;
HD unsigned f2bf_bits(float f) { unsigned u = __builtin_bit_cast(unsigned, f); return (u + 0x7fffu + ((u >> 16) & 1u)) >> 16; }
HD bf16_t f2bf(float f) { return (bf16_t)f2bf_bits(f); }
HD float bf2f(bf16_t b) { return __builtin_bit_cast(float, (unsigned)b << 16); }
HD float silu_f(float x) { return x / (1.0f + expf(-x)); }
HD float sigmoid_f(float x) { return 1.0f / (1.0f + expf(-x)); }
HD float softplus_f(float x) { return x > 20.f ? x : log1pf(expf(x)); }

struct P {
    const float *x_prompt, *x_sample, *state_dn_conv, *state_dn_ssm, *cache_k, *cache_v, *state_ffn, *c_prompt, *c_sample, *rel_bias,
        *final_norm_w, *w_ada, *b_ada, *norm_mix_w, *w_in, *dn_conv_w, *dn_A_log, *dn_dt_bias, *dn_norm_w, *swa_sinks, *w_out, *norm_ffn_w,
        *w_up, *ffn_conv_w, *ffn_conv_b, *w_down;
    float* out; unsigned char* ws;
};

HD const float* xrow(const P& p, int m) { return m < TP ? p.x_prompt + (size_t)m * D : p.x_sample + (size_t)(m - TP) * D; }
HD int cb_of(int m) { return m < TP ? m / SEQ : BATCH + (m - TP) / DEC_SEQ; }
HD int t_of(int m) { return m < TP ? m % SEQ : (m - TP) % DEC_SEQ; }
HD float* ws_f(const P& p, size_t off) { return (float*)(p.ws + off); }
HD bf16_t* ws_h(const P& p, size_t off) { return (bf16_t*)(p.ws + off); }

HD int t5_bucket(int d) {
    if (d < 16) return d;
    const float logv = logf((float)d / 16.0f) / 2.0794415416798357f;
    int b = 16 + (int)(logv * 16.0f);
    return b < 31 ? b : 31;
}

constexpr long N_R0A = (long)NCB * 6 * D;
HD void r0a_body(long idx, const P& p) {
    const int cb = (int)(idx / (6 * D)), e = (int)(idx % (6 * D));
    const float* c = cb < BATCH ? p.c_prompt + (size_t)cb * D : p.c_sample + (size_t)(cb - BATCH) * D;
    float acc = 0.f;
    for (int d = 0; d < D; ++d) acc += silu_f(c[d]) * p.w_ada[(size_t)d * 6 * D + e];
    ws_f(p, WS_MOD)[idx] = acc + p.b_ada[e];
}
constexpr long N_R1 = T;
template <int WHICH> HD void r1_body(long idx, const P& p) {
    const int m = (int)idx, cb = cb_of(m);
    const float* xr = WHICH == 0 ? xrow(p, m) : p.out + O_Y + (size_t)m * D;
    const float* nw = WHICH == 0 ? p.norm_mix_w : p.norm_ffn_w;
    const float* mod = ws_f(p, WS_MOD) + (size_t)cb * 6 * D;
    const float* sh = mod + (WHICH == 0 ? 0 : 3 * D); const float* sc = mod + (WHICH == 0 ? D : 4 * D);
    float ss = 0.f;
    for (int k = 0; k < D; ++k) ss += xr[k] * xr[k];
    const float rstd = 1.0f / sqrtf(ss / (float)D + EPS);
    float ba[8];
#pragma unroll
    for (int j = 0; j < 8; ++j) ba[j] = 0.f;
    bf16_t* H = ws_h(p, WS_H) + (size_t)m * D;
    for (int k = 0; k < D; ++k) {
        const float h = xr[k] * rstd * nw[k] * (1.0f + sc[k]) + sh[k];
        H[k] = f2bf(h);
        if (WHICH == 0) {
#pragma unroll
            for (int j = 0; j < 8; ++j) ba[j] += h * p.w_in[(size_t)k * IN_COLS + WC_BA + j];
        }
    }
    if (WHICH == 0) {
        float* bg = ws_f(p, WS_BG) + (size_t)m * 8;
#pragma unroll
        for (int j = 0; j < 4; ++j) {
            bg[j] = sigmoid_f(ba[j]);
            bg[4 + j] = -expf(p.dn_A_log[j]) * softplus_f(ba[4 + j] + p.dn_dt_bias[j]);
        }
    }
}
constexpr long N_R2 = (long)(T / 8) * PLD;
HD void r2_body(long idx, const P& p) {
    const int mg = (int)(idx / PLD), n = (int)(idx % PLD), oc = n < WC_BA ? n : n + 8;
    const bf16_t* H = ws_h(p, WS_H) + (size_t)mg * 8 * D;
    float acc[8];
#pragma unroll
    for (int i = 0; i < 8; ++i) acc[i] = 0.f;
    for (int k = 0; k < D; ++k) {
        const float w = bf2f(f2bf(p.w_in[(size_t)k * IN_COLS + oc]));
#pragma unroll
        for (int i = 0; i < 8; ++i) acc[i] += bf2f(H[(size_t)i * D + k]) * w;
    }
    bf16_t* PR = ws_h(p, WS_PROJ);
#pragma unroll
    for (int i = 0; i < 8; ++i) PR[(size_t)(mg * 8 + i) * PLD + n] = f2bf(acc[i]);
}
constexpr long N_R2B_1 = (long)BATCH * 3 * 1536, N_R2B_2 = (long)DEC_BATCH * 3 * 1536, N_R2B_3 = (long)BATCH * 128 * 128, N_R2B_4 = (long)DEC_BATCH * 128 * 128;
constexpr long N_R2B = N_R2B_1 + N_R2B_2 + 2 * (N_R2B_3 + N_R2B_4);
HD void r2b_body(long idx, const P& p) {
    const bf16_t* PR = ws_h(p, WS_PROJ);
    long r = idx;
    if (r < N_R2B_1) { const int b = (int)(r / (3 * 1536)), j = (int)(r / 1536 % 3), c = (int)(r % 1536);
        p.out[O_PDC + r] = bf2f(PR[(size_t)(b * SEQ + SEQ - 3 + j) * PLD + PC_QKV + c]); return; }
    r -= N_R2B_1;
    if (r < N_R2B_2) { const int b = (int)(r / (3 * 1536)), j = (int)(r / 1536 % 3), c = (int)(r % 1536);
        p.out[O_SDC + r] = bf2f(PR[(size_t)(TP + b * DEC_SEQ + DEC_SEQ - 3 + j) * PLD + PC_QKV + c]); return; }
    r -= N_R2B_2;
    for (int kv = 0; kv < 2; ++kv) {
        const int pc = kv == 0 ? PC_SK : PC_SV; const float* cache = kv == 0 ? p.cache_k : p.cache_v;
        if (r < N_R2B_3) { const int b = (int)(r / (128 * 128)), j = (int)(r / 128 % 128), c = (int)(r % 128);
            p.out[(kv == 0 ? O_PK : O_PV) + r] = bf2f(PR[(size_t)(b * SEQ + SEQ - 128 + j) * PLD + pc + c]); return; }
        r -= N_R2B_3;
        if (r < N_R2B_4) { const int b = (int)(r / (128 * 128)), j = (int)(r / 128 % 128), c = (int)(r % 128);
            float v;
            if (j < 128 - DEC_SEQ) v = cache[((size_t)b * 128 + j + DEC_SEQ) * 128 + c];
            else v = bf2f(PR[(size_t)(TP + b * DEC_SEQ + (j - (128 - DEC_SEQ))) * PLD + pc + c]);
            p.out[(kv == 0 ? O_SK : O_SV) + r] = v; return; }
        r -= N_R2B_4;
    }
}
constexpr long N_R3 = (long)T * 12;
HD float r3_conv(const P& p, int m, int t, int ch) {
    const bf16_t* PR = ws_h(p, WS_PROJ);
    float acc = 0.f;
#pragma unroll
    for (int j = 0; j < 4; ++j) {
        const int tt = t - 3 + j; float xv;
        if (tt >= 0) xv = bf2f(PR[(size_t)(m - (t - tt)) * PLD + PC_QKV + ch]);
        else xv = m < TP ? 0.f : p.state_dn_conv[((size_t)((m - TP) / DEC_SEQ) * 3 + (3 + tt)) * 1536 + ch];
        acc += p.dn_conv_w[j * 1536 + ch] * xv;
    }
    return silu_f(acc);
}
HD void r3_body(long idx, const P& p) {
    const int m = (int)(idx / 12), grp = (int)(idx % 12), part = grp / 4, cbase = grp * 128, t = t_of(m);
    float scale = 1.f;
    if (part < 2) {
        float ss = 0.f;
        for (int c = 0; c < 128; ++c) { const float v = r3_conv(p, m, t, cbase + c); ss += v * v; }
        scale = 1.0f / sqrtf(ss + EPS);
        if (part == 0) scale *= 0.08838834764831845f;
    }
    bf16_t* Q = ws_h(p, WS_QKVC) + (size_t)m * 1536 + cbase;
    for (int c = 0; c < 128; ++c) Q[c] = f2bf(r3_conv(p, m, t, cbase + c) * scale);
}
constexpr long N_R4 = (long)NCB * 4 * 128;
HD void r4_body(long idx, const P& p) {
    const int seq = (int)(idx / 512), h = (int)(idx / 128 % 4), v = (int)(idx % 128);
    const bool smp = seq >= BATCH; const int b = smp ? seq - BATCH : seq;
    float* S = p.out + (smp ? O_SSSM : O_PSSM) + ((size_t)b * 4 + h) * 128 * 128 + v;
    const float* S0 = smp ? p.state_dn_ssm + ((size_t)b * 4 + h) * 128 * 128 + v : nullptr;
    for (int k = 0; k < 128; ++k) S[(size_t)k * 128] = smp ? S0[(size_t)k * 128] : 0.f;
    const int L = smp ? DEC_SEQ : SEQ, m0 = smp ? TP + b * DEC_SEQ : b * SEQ;
    const bf16_t* QK = ws_h(p, WS_QKVC); const float* BG = ws_f(p, WS_BG); float* ODN = ws_f(p, WS_ODN);
    for (int t = 0; t < L; ++t) {
        const int m = m0 + t;
        const bf16_t* q = QK + (size_t)m * 1536 + h * 128; const bf16_t* kk = q + 512; const float vv = bf2f(q[1024 + v]);
        const float beta = BG[(size_t)m * 8 + h], eg = expf(BG[(size_t)m * 8 + 4 + h]);
        float kS = 0.f;
        for (int k = 0; k < 128; ++k) kS += bf2f(kk[k]) * (S[(size_t)k * 128] * eg);
        const float u = beta * (vv - kS);
        float o = 0.f;
        for (int k = 0; k < 128; ++k) { const float s = S[(size_t)k * 128] * eg + bf2f(kk[k]) * u; S[(size_t)k * 128] = s; o += bf2f(q[k]) * s; }
        ODN[(size_t)m * 512 + h * 128 + v] = o;
    }
}
constexpr long N_R5 = (long)T * 4;
HD void r5_body(long idx, const P& p) {
    const int m = (int)(idx / 4), h = (int)(idx % 4);
    const float* o = ws_f(p, WS_ODN) + (size_t)m * 512 + h * 128;
    float ss = 0.f;
    for (int v = 0; v < 128; ++v) ss += o[v] * o[v];
    const float rstd = 1.0f / sqrtf(ss / 128.0f + EPS);
    const bf16_t* z = ws_h(p, WS_PROJ) + (size_t)m * PLD + PC_Z + h * 128;
    bf16_t* mix = ws_h(p, WS_MIX) + (size_t)m * 1024 + h * 128;
    for (int v = 0; v < 128; ++v) mix[v] = f2bf(o[v] * rstd * p.dn_norm_w[v] * silu_f(bf2f(z[v])));
}
constexpr long N_R6 = (long)T * 8 * 8;
HD void r6_body(long idx, const P& p) {
    const int m = (int)(idx / 64), hq = (int)(idx / 8 % 8), dg = (int)(idx % 8), kvh = hq / 4, t = t_of(m);
    const bool smp = m >= TP; const int b = smp ? (m - TP) / DEC_SEQ : 0;
    const bf16_t* PR = ws_h(p, WS_PROJ);
    const bf16_t* q = PR + (size_t)m * PLD + PC_SQ + hq * 64;
    const float sink = p.swa_sinks[hq];
    const int nk = smp ? 128 : (t < 127 ? t + 1 : 128);
    float mx = sink;
    for (int pass = 0; pass < 2; ++pass) {
        float den = 0.f, acc[8];
#pragma unroll
        for (int i = 0; i < 8; ++i) acc[i] = 0.f;
        for (int jj = 0; jj < nk; ++jj) {
            int dist; const float* kf = nullptr; const float* vf = nullptr; const bf16_t* kb = nullptr; const bf16_t* vb = nullptr;
            if (smp) { const int j = t + 1 + jj; dist = 128 + t - j;
                if (j < 128) { kf = p.cache_k + ((size_t)b * 128 + j) * 128 + kvh * 64; vf = p.cache_v + ((size_t)b * 128 + j) * 128 + kvh * 64; }
                else { const size_t mm = (size_t)(TP + b * DEC_SEQ + (j - 128)); kb = PR + mm * PLD + PC_SK + kvh * 64; vb = PR + mm * PLD + PC_SV + kvh * 64; } }
            else { dist = nk - 1 - jj; const size_t mm = (size_t)(m - dist); kb = PR + mm * PLD + PC_SK + kvh * 64; vb = PR + mm * PLD + PC_SV + kvh * 64; }
            float s = 0.f;
            for (int d = 0; d < 64; ++d) s += bf2f(q[d]) * (kf ? kf[d] : bf2f(kb[d]));
            s = s * 0.125f + p.rel_bias[t5_bucket(dist) * 8 + hq];
            if (pass == 0) { mx = s > mx ? s : mx; }
            else { const float pr = expf(s - mx); den += pr;
#pragma unroll
                for (int i = 0; i < 8; ++i) acc[i] += pr * (vf ? vf[dg * 8 + i] : bf2f(vb[dg * 8 + i])); }
        }
        if (pass == 1) { den += expf(sink - mx); bf16_t* mix = ws_h(p, WS_MIX) + (size_t)m * 1024 + 512 + hq * 64 + dg * 8;
#pragma unroll
            for (int i = 0; i < 8; ++i) mix[i] = f2bf(acc[i] / den); }
    }
}
constexpr long N_R7 = (long)(T / 8) * D;
HD void r7_body(long idx, const P& p) {
    const int mg = (int)(idx / D), d = (int)(idx % D);
    const bf16_t* MX = ws_h(p, WS_MIX) + (size_t)mg * 8 * 1024;
    float acc[8];
#pragma unroll
    for (int i = 0; i < 8; ++i) acc[i] = 0.f;
    for (int e = 0; e < 1024; ++e) { const float w = bf2f(f2bf(p.w_out[(size_t)e * D + d]));
#pragma unroll
        for (int i = 0; i < 8; ++i) acc[i] += bf2f(MX[(size_t)i * 1024 + e]) * w; }
#pragma unroll
    for (int i = 0; i < 8; ++i) { const int m = mg * 8 + i; const float g1 = ws_f(p, WS_MOD)[(size_t)cb_of(m) * 6 * D + 2 * D + d];
        p.out[O_Y + (size_t)m * D + d] = xrow(p, m)[d] + g1 * acc[i]; }
}
constexpr long N_R9 = (long)(T / 8) * DFF;
HD void r9_body(long idx, const P& p) {
    const int mg = (int)(idx / DFF), f = (int)(idx % DFF), m0 = mg * 8, t0 = t_of(m0);
    const bool smp = m0 >= TP; const int b = smp ? (m0 - TP) / DEC_SEQ : m0 / SEQ;
    const bf16_t* H = ws_h(p, WS_H);
    float ug[10], uu[10];
#pragma unroll
    for (int i = 0; i < 10; ++i) { ug[i] = 0.f; uu[i] = 0.f; }
    const bool halo = (!smp && t0 > 0);
    for (int k = 0; k < D; ++k) {
        const float wg = bf2f(f2bf(p.w_up[(size_t)k * 2 * DFF + f])), wu = bf2f(f2bf(p.w_up[(size_t)k * 2 * DFF + DFF + f]));
#pragma unroll
        for (int i = 0; i < 10; ++i) { if (i < 2 && !halo) continue; const float h = bf2f(H[(size_t)(m0 - 2 + i) * D + k]); ug[i] += h * wg; uu[i] += h * wu; }
    }
    if (smp) {
#pragma unroll
        for (int i = 0; i < 2; ++i) { ug[i] = p.state_ffn[((size_t)b * 2 + i) * 2 * DFF + f]; uu[i] = p.state_ffn[((size_t)b * 2 + i) * 2 * DFF + DFF + f]; }
    }
    const float w0g = p.ffn_conv_w[f], w1g = p.ffn_conv_w[2 * DFF + f], w2g = p.ffn_conv_w[4 * DFF + f], bgt = p.ffn_conv_b[f];
    const float w0u = p.ffn_conv_w[DFF + f], w1u = p.ffn_conv_w[3 * DFF + f], w2u = p.ffn_conv_w[5 * DFF + f], bup = p.ffn_conv_b[DFF + f];
    bf16_t* ACT = ws_h(p, WS_ACT);
#pragma unroll
    for (int i = 0; i < 8; ++i) {
        const float gc = w0g * ug[i] + w1g * ug[i + 1] + w2g * ug[i + 2] + bgt, uc = w0u * uu[i] + w1u * uu[i + 1] + w2u * uu[i + 2] + bup;
        ACT[(size_t)(m0 + i) * DFF + f] = f2bf(silu_f(gc) * uc);
    }
    if (smp) {
#pragma unroll
        for (int j = 0; j < 2; ++j) { float* o = p.out + O_SFC + ((size_t)b * 2 + j) * 2 * DFF; o[f] = ug[8 + j]; o[DFF + f] = uu[8 + j]; }
    } else if (t0 == SEQ - 8) {
#pragma unroll
        for (int j = 0; j < 2; ++j) { float* o = p.out + O_PFC + ((size_t)b * 2 + j) * 2 * DFF; o[f] = ug[8 + j]; o[DFF + f] = uu[8 + j]; }
    }
}
constexpr long N_R10 = (long)(T / 8) * D;
HD void r10_body(long idx, const P& p) {
    const int mg = (int)(idx / D), d = (int)(idx % D);
    const bf16_t* A = ws_h(p, WS_ACT) + (size_t)mg * 8 * DFF;
    float acc[8];
#pragma unroll
    for (int i = 0; i < 8; ++i) acc[i] = 0.f;
    for (int f = 0; f < DFF; ++f) { const float w = bf2f(f2bf(p.w_down[(size_t)f * D + d]));
#pragma unroll
        for (int i = 0; i < 8; ++i) acc[i] += bf2f(A[(size_t)i * DFF + f]) * w; }
#pragma unroll
    for (int i = 0; i < 8; ++i) { const int m = mg * 8 + i; const float g2 = ws_f(p, WS_MOD)[(size_t)cb_of(m) * 6 * D + 5 * D + d];
        float* o = p.out + O_Y + (size_t)m * D + d; *o = *o + g2 * acc[i]; }
}
constexpr long N_R11 = T, N_R8 = T;
HD void r11_body(long idx, const P& p) {
    float* xr = p.out + O_Y + (size_t)idx * D;
    float ss = 0.f;
    for (int k = 0; k < D; ++k) ss += xr[k] * xr[k];
    const float rstd = 1.0f / sqrtf(ss / (float)D + EPS);
    for (int k = 0; k < D; ++k) xr[k] = xr[k] * rstd * p.final_norm_w[k];
}
#define LAS __attribute__((address_space(3)))
typedef float f32x4 __attribute__((ext_vector_type(4)));
typedef unsigned u32x4 __attribute__((ext_vector_type(4)));
typedef unsigned u32x2 __attribute__((ext_vector_type(2)));
constexpr int NWAVES = 8, NTHR = 512;
constexpr int LDS_BYTES = 163840;
__device__ __forceinline__ int otid() { int t = threadIdx.x; asm volatile("" : "+v"(t)); return t; }
__device__ __forceinline__ float wave_sum(float v) {
#pragma unroll
    for (int o = 1; o < 64; o <<= 1) v += __shfl_xor(v, o);
    return v;
}
__device__ __forceinline__ unsigned pk2(float lo, float hi) { return f2bf_bits(lo) | (f2bf_bits(hi) << 16); }

__device__ __forceinline__ void transpose_item(const float* W, int ldw, int K, bf16_t* WT, int dst_n0, int src_n0, int k0, LAS float* scr, int lane) {
#pragma unroll
    for (int i = 0; i < 32; ++i) { const int kk = 2 * i + (lane >> 5); scr[kk * 33 + (lane & 31)] = W[(size_t)(k0 + kk) * ldw + src_n0 + (lane & 31)]; }
    asm volatile("s_waitcnt lgkmcnt(0)" ::: "memory");
    const int c = lane & 7;
#pragma unroll
    for (int j = 0; j < 4; ++j) { const int n = (lane >> 3) + 8 * j; const LAS float* s = scr + (8 * c) * 33 + n;
        u32x4 o; o.x = pk2(s[0 * 33], s[1 * 33]); o.y = pk2(s[2 * 33], s[3 * 33]); o.z = pk2(s[4 * 33], s[5 * 33]); o.w = pk2(s[6 * 33], s[7 * 33]);
        *(u32x4*)(WT + (size_t)(dst_n0 + n) * K + k0 + 8 * c) = o; }
    asm volatile("s_waitcnt lgkmcnt(0)" ::: "memory");
}
constexpr int TI_IN = (PLD / 32) * (D / 64), TI_OUT = (D / 32) * (1024 / 64), TI_UP = (2 * DFF / 32) * (D / 64), TI_DN = (D / 32) * (DFF / 64), TI_ALL = TI_IN + TI_OUT + TI_UP + TI_DN;
__device__ __forceinline__ void phase_transposes(const P& p, LAS unsigned char* lds) {
    const int tid_ = otid(), lane = tid_ & 63, wave = tid_ >> 6;
    if (blockIdx.x == gridDim.x - 1) { for (int i = tid_; i < 8 * D; i += NTHR) ws_f(p, WS_WBAT)[i] = p.w_in[(size_t)(i % D) * IN_COLS + WC_BA + i / D]; }
    LAS float* scr = (LAS float*)(lds + wave * 16384);
    const int gw = blockIdx.x * NWAVES + wave, NGW = gridDim.x * NWAVES;
    for (int it = gw; it < TI_ALL; it += NGW) {
        int r = it;
        if (r < TI_IN) { const int nb = r % (PLD / 32), kb = r / (PLD / 32), n0 = nb * 32; transpose_item(p.w_in, IN_COLS, D, ws_h(p, WS_WT_IN), n0, n0 < WC_BA ? n0 : n0 + 8, kb * 64, scr, lane); continue; } r -= TI_IN;
        if (r < TI_OUT) { const int nb = r % (D / 32), kb = r / (D / 32), n0 = nb * 32; transpose_item(p.w_out, D, 1024, ws_h(p, WS_WT_OUT), n0, n0, kb * 64, scr, lane); continue; } r -= TI_OUT;
        if (r < TI_UP) { const int nb = r % (2 * DFF / 32), kb = r / (2 * DFF / 32), n0 = nb * 32;
            const int pn = n0 >> 8, bj = (n0 >> 7) & 1, c = n0 & 127; transpose_item(p.w_up, 2 * DFF, D, ws_h(p, WS_WT_UP), n0, bj * DFF + 128 * pn + c, kb * 64, scr, lane); continue; } r -= TI_UP;
        { const int nb = r % (D / 32), kb = r / (D / 32), n0 = nb * 32; transpose_item(p.w_down, D, DFF, ws_h(p, WS_WT_DN), n0, n0, kb * 64, scr, lane); }
    }
}
typedef short bf16x8m __attribute__((ext_vector_type(8)));
typedef float f32x2m __attribute__((ext_vector_type(2))); typedef __bf16 bf16x2m __attribute__((ext_vector_type(2)));
__device__ __forceinline__ unsigned cvtpk_m(float lo, float hi) { const f32x2m v = {lo, hi}; return __builtin_bit_cast(unsigned, __builtin_convertvector(v, bf16x2m)); }
__device__ __forceinline__ void split8(const float (&x)[8], bf16x8m& hi, bf16x8m& lo) {
    unsigned h[4], l[4];
#pragma unroll
    for (int e = 0; e < 4; ++e) { h[e] = cvtpk_m(x[2 * e], x[2 * e + 1]);
        l[e] = cvtpk_m(x[2 * e] - __builtin_bit_cast(float, h[e] << 16), x[2 * e + 1] - __builtin_bit_cast(float, h[e] & 0xffff0000u)); }
    hi = __builtin_bit_cast(bf16x8m, (u32x4){h[0], h[1], h[2], h[3]}); lo = __builtin_bit_cast(bf16x8m, (u32x4){l[0], l[1], l[2], l[3]});
}
__device__ __forceinline__ float silu_fast(float x) { return x * __builtin_amdgcn_rcpf(1.0f + __expf(-x)); }
__device__ __forceinline__ void phase_mod(const P& p, LAS unsigned char* lds) {
    constexpr int KC = 256, NCG = 6 * D / 32, NCH = D / KC, NMT = (NCB + 15) / 16;
    static_assert(NMT <= 16, "two m-tiles per wave at most");
    LAS float* WB = (LAS float*)lds;
    const int tid = otid(), lane = tid & 63, wave = tid >> 6, r16 = lane & 15, g4 = lane >> 4;
    for (int cg = blockIdx.x; cg < NCG; cg += gridDim.x) {
        f32x4 acc[2][2];
#pragma unroll
        for (int s = 0; s < 2; ++s)
#pragma unroll
            for (int nt = 0; nt < 2; ++nt) acc[s][nt] = (f32x4){0.f, 0.f, 0.f, 0.f};
        f32x4 wreg[4];
#pragma unroll
        for (int j = 0; j < 4; ++j) { const int idx = tid + NTHR * j; wreg[j] = *(const f32x4*)(p.w_ada + (size_t)(idx >> 3) * 6 * D + cg * 32 + 4 * (idx & 7)); }
        __syncthreads();
        for (int ch = 0; ch < NCH; ++ch) {
            LAS float* wb = WB + (ch & 1) * KC * 32;
#pragma unroll
            for (int j = 0; j < 4; ++j) { const int idx = tid + NTHR * j; *(LAS f32x4*)(wb + (idx >> 3) * 32 + 4 * (idx & 7)) = wreg[j]; }
            if (ch + 1 < NCH) {
#pragma unroll
                for (int j = 0; j < 4; ++j) { const int idx = tid + NTHR * j; wreg[j] = *(const f32x4*)(p.w_ada + (size_t)((ch + 1) * KC + (idx >> 3)) * 6 * D + cg * 32 + 4 * (idx & 7)); }
            }
            __syncthreads();
#pragma unroll 2
            for (int ks = 0; ks < KC / 32; ++ks) {
                bf16x8m bh[2], bl[2];
#pragma unroll
                for (int nt = 0; nt < 2; ++nt) { float x[8];
#pragma unroll
                    for (int j = 0; j < 8; ++j) x[j] = wb[(32 * ks + 8 * g4 + j) * 32 + 16 * nt + r16];
                    split8(x, bh[nt], bl[nt]); }
#pragma unroll
                for (int s = 0; s < 2; ++s) { const int mt = wave + 8 * s; if (mt >= NMT) continue;
                    const int row = 16 * mt + r16; float x[8];
                    if (row < NCB) { const float* c = (row < BATCH ? p.c_prompt + (size_t)row * D : p.c_sample + (size_t)(row - BATCH) * D) + ch * KC + 32 * ks + 8 * g4;
                        const f32x4 a = *(const f32x4*)c, d = *(const f32x4*)(c + 4);
                        x[0] = silu_fast(a[0]); x[1] = silu_fast(a[1]); x[2] = silu_fast(a[2]); x[3] = silu_fast(a[3]); x[4] = silu_fast(d[0]); x[5] = silu_fast(d[1]); x[6] = silu_fast(d[2]); x[7] = silu_fast(d[3]); }
                    else {
#pragma unroll
                        for (int j = 0; j < 8; ++j) x[j] = 0.f; }
                    bf16x8m ah, al; split8(x, ah, al);
#pragma unroll
                    for (int nt = 0; nt < 2; ++nt) {
                        acc[s][nt] = __builtin_amdgcn_mfma_f32_16x16x32_bf16(ah, bh[nt], acc[s][nt], 0, 0, 0);
                        acc[s][nt] = __builtin_amdgcn_mfma_f32_16x16x32_bf16(ah, bl[nt], acc[s][nt], 0, 0, 0);
                        acc[s][nt] = __builtin_amdgcn_mfma_f32_16x16x32_bf16(al, bh[nt], acc[s][nt], 0, 0, 0); } }
            }
        }
#pragma unroll
        for (int s = 0; s < 2; ++s) { const int mt = wave + 8 * s; if (mt >= NMT) continue;
#pragma unroll
            for (int nt = 0; nt < 2; ++nt) { const int e = cg * 32 + 16 * nt + r16; const float bb = p.b_ada[e];
#pragma unroll
                for (int i = 0; i < 4; ++i) { const int row = 16 * mt + 4 * g4 + i; if (row < NCB) ws_f(p, WS_MOD)[(size_t)row * 6 * D + e] = acc[s][nt][i] + bb; } } }
    }
    __syncthreads();
}
template <int WHICH> __device__ __forceinline__ void phase_norm(const P& p) {
    static_assert(D == 1024, "one wave per 1024-float row");
    const int tid_ = otid(), lane = tid_ & 63, wave = tid_ >> 6;
    const int gw = blockIdx.x * NWAVES + wave, NGW = gridDim.x * NWAVES;
    const float* nwp = WHICH == 0 ? p.norm_mix_w : (WHICH == 1 ? p.norm_ffn_w : p.final_norm_w);
    f32x4 nwv[4];
#pragma unroll
    for (int j = 0; j < 4; ++j) nwv[j] = ((const f32x4*)nwp)[lane + 64 * j];
    f32x4 wbt[WHICH == 0 ? 8 : 1][4];
    if (WHICH == 0) {
#pragma unroll
        for (int c = 0; c < 8; ++c)
#pragma unroll
            for (int j = 0; j < 4; ++j) wbt[c][j] = ((const f32x4*)(ws_f(p, WS_WBAT) + c * D))[lane + 64 * j];
    }
    f32x4 v[4];
    if (gw < T) { const float* xr = WHICH == 0 ? xrow(p, gw) : p.out + O_Y + (size_t)gw * D;
#pragma unroll
        for (int j = 0; j < 4; ++j) v[j] = ((const f32x4*)xr)[lane + 64 * j]; }
    for (int m = gw; m < T; m += NGW) {
        f32x4 vn[4]; const int mn = m + NGW;
        if (mn < T) { const float* xr = WHICH == 0 ? xrow(p, mn) : p.out + O_Y + (size_t)mn * D;
#pragma unroll
            for (int j = 0; j < 4; ++j) vn[j] = ((const f32x4*)xr)[lane + 64 * j]; }
        float ss = 0.f;
#pragma unroll
        for (int j = 0; j < 4; ++j) ss += (v[j][0] * v[j][0] + v[j][1] * v[j][1]) + (v[j][2] * v[j][2] + v[j][3] * v[j][3]);
        const float rstd = 1.0f / sqrtf(wave_sum(ss) * (1.0f / D) + EPS);
        if (WHICH == 2) {
#pragma unroll
            for (int j = 0; j < 4; ++j) ((f32x4*)(p.out + O_Y + (size_t)m * D))[lane + 64 * j] = v[j] * rstd * nwv[j];
        } else {
            const int cb = cb_of(m);
            const float* mod = ws_f(p, WS_MOD) + (size_t)cb * 6 * D;
            const float* sh = mod + (WHICH == 0 ? 0 : 3 * D); const float* sc = mod + (WHICH == 0 ? D : 4 * D);
            float ba[8];
#pragma unroll
            for (int j = 0; j < 8; ++j) ba[j] = 0.f;
            unsigned long long* o8 = (unsigned long long*)(ws_h(p, WS_H) + (size_t)m * D);
#pragma unroll
            for (int j = 0; j < 4; ++j) {
                const f32x4 s1 = ((const f32x4*)sc)[lane + 64 * j], s0 = ((const f32x4*)sh)[lane + 64 * j];
                const f32x4 h = v[j] * rstd * nwv[j] * (s1 + 1.0f) + s0;
                o8[lane + 64 * j] = (unsigned long long)pk2(h[0], h[1]) | ((unsigned long long)pk2(h[2], h[3]) << 32);
                if (WHICH == 0) {
#pragma unroll
                    for (int c = 0; c < 8; ++c) ba[c] += (h[0] * wbt[c][j][0] + h[1] * wbt[c][j][1]) + (h[2] * wbt[c][j][2] + h[3] * wbt[c][j][3]);
                }
            }
            if (WHICH == 0) {
#pragma unroll
                for (int j = 0; j < 8; ++j) ba[j] = wave_sum(ba[j]);
                float mine = 0.f;
#pragma unroll
                for (int j = 0; j < 8; ++j) mine = (lane == j) ? ba[j] : mine;
                if (lane < 8) { float* bg = ws_f(p, WS_BG) + (size_t)m * 8; const int j = lane & 3;
                    bg[lane] = lane < 4 ? sigmoid_f(mine) : -expf(p.dn_A_log[j]) * softplus_f(mine + p.dn_dt_bias[j]); }
            }
        }
#pragma unroll
        for (int j = 0; j < 4; ++j) v[j] = vn[j];
    }
}

constexpr long SO_1 = (long)BATCH * 3 * 1536 / 4, SO_2 = (long)DEC_BATCH * 3 * 1536 / 4, SO_3 = (long)BATCH * 128 * 128 / 4, SO_4 = (long)DEC_BATCH * 128 * 128 / 4, SO_N = SO_1 + SO_2 + 2 * (SO_3 + SO_4);
__device__ __forceinline__ void so_item(const P& p, long it, f32x4& val, float*& dst) {
    const bf16_t* PR = ws_h(p, WS_PROJ); const bf16_t* src = nullptr; const float* fsrc = nullptr;
    long r = it;
    if (r < SO_1) { const int b = (int)(r / (3 * 384)), j = (int)(r / 384 % 3), c = (int)(r % 384) * 4; src = PR + (size_t)(b * SEQ + SEQ - 3 + j) * PLD + PC_QKV + c; dst = p.out + O_PDC + r * 4; }
    else if ((r -= SO_1) < SO_2) { const int b = (int)(r / (3 * 384)), j = (int)(r / 384 % 3), c = (int)(r % 384) * 4; src = PR + (size_t)(TP + b * DEC_SEQ + DEC_SEQ - 3 + j) * PLD + PC_QKV + c; dst = p.out + O_SDC + r * 4; }
    else { r -= SO_2; const int kv = r >= SO_3 + SO_4; if (kv) r -= SO_3 + SO_4; const int pc = kv ? PC_SV : PC_SK; const float* cache = kv ? p.cache_v : p.cache_k;
        if (r < SO_3) { const int b = (int)(r / (128 * 32)), j = (int)(r / 32 % 128), c = (int)(r % 32) * 4; src = PR + (size_t)(b * SEQ + SEQ - 128 + j) * PLD + pc + c; dst = p.out + (kv ? O_PV : O_PK) + r * 4; }
        else { r -= SO_3; const int b = (int)(r / (128 * 32)), j = (int)(r / 32 % 128), c = (int)(r % 32) * 4; dst = p.out + (kv ? O_SV : O_SK) + r * 4;
            if (j < 128 - DEC_SEQ) fsrc = cache + ((size_t)b * 128 + j + DEC_SEQ) * 128 + c; else src = PR + (size_t)(TP + b * DEC_SEQ + (j - (128 - DEC_SEQ))) * PLD + pc + c; } }
    if (fsrc) val = *(const f32x4*)fsrc;
    else { const u32x2 w = *(const u32x2*)src; val = (f32x4){__builtin_bit_cast(float, w.x << 16), __builtin_bit_cast(float, w.x & 0xffff0000u), __builtin_bit_cast(float, w.y << 16), __builtin_bit_cast(float, w.y & 0xffff0000u)}; }
}
__device__ __forceinline__ void phase_state_out(const P& p) {
    const long gt = blockIdx.x * (long)NTHR + otid(), gs = (long)gridDim.x * NTHR;
    for (long it = gt; it < SO_N; it += 4 * gs) {
        f32x4 v[4]; float* d[4];
#pragma unroll
        for (int u = 0; u < 4; ++u) if (it + u * gs < SO_N) so_item(p, it + u * gs, v[u], d[u]);
#pragma unroll
        for (int u = 0; u < 4; ++u) if (it + u * gs < SO_N) *(f32x4*)d[u] = v[u];
    }
}
#define XB_TMO      128
#define XB_XCNT(j)  (256  + 64 * (j))
#define XB_XSUB(j)  (1280 + 64 * (j))
#define XB_XGEN(j)  (2304 + 64 * (j))
#define XB_TOP      3328
#define XB_TOPGEN   3392
#define XCD_BAR_WORDS 3456
#define XB_SPIN_CAP (1u << 18)

__device__ __forceinline__ unsigned xb_ld(unsigned* p)              { return __hip_atomic_load(p, __ATOMIC_RELAXED, __HIP_MEMORY_SCOPE_AGENT); }
__device__ __forceinline__ unsigned xb_add(unsigned* p, unsigned v) { return __hip_atomic_fetch_add(p, v, __ATOMIC_RELAXED, __HIP_MEMORY_SCOPE_AGENT); }
__device__ __forceinline__ unsigned xb_xcc_id() { return (unsigned)__builtin_amdgcn_s_getreg((3 << 11) | 20) & 0xFu; }
#define XB_SPIN(cond, bar) do { unsigned _sp = 0; while (cond) { __builtin_amdgcn_s_sleep(1); \
    if ((++_sp & 255u) == 0u) { if (xb_ld(&(bar)[XB_TMO])) break; if (_sp > XB_SPIN_CAP) { atomicAdd(&(bar)[XB_TMO], 1u); break; } } } } while (0)

struct XcdBarrier {
    unsigned* bar; unsigned x;
    volatile LAS unsigned* st;
};

__device__ __forceinline__ XcdBarrier xcd_barrier_post(unsigned* bar, volatile LAS unsigned* st) {
    XcdBarrier b; b.bar = bar; b.x = xb_xcc_id(); b.st = st;
    if (threadIdx.x == 0) (void)xb_add(&bar[XB_XCNT(b.x)], 1u);
    return b;
}
__device__ __forceinline__ void xcd_barrier_complete(unsigned* bar, unsigned x, unsigned& nloc, unsigned& nx) {
    const unsigned G = gridDim.x * gridDim.y * gridDim.z;
    unsigned sum, cnt, mine, sp = 0u;
    for (;;) {
        sum = 0u; cnt = 0u; mine = 0u;
#pragma unroll
        for (unsigned j = 0; j < 16; ++j) { const unsigned c = xb_ld(&bar[XB_XCNT(j)]); sum += c; cnt += (c > 0u) ? 1u : 0u; mine = (j == x) ? c : mine; }
        if (sum == G) break;
        __builtin_amdgcn_s_sleep(1);
        if ((++sp & 255u) == 0u) { if (xb_ld(&bar[XB_TMO])) break; if (sp > XB_SPIN_CAP) { atomicAdd(&bar[XB_TMO], 1u); break; } }
    }
    nloc = mine > 0u ? mine : 1u; nx = cnt > 0u ? cnt : 1u;
}

__device__ __forceinline__ void xcd_barrier(const XcdBarrier& b) {
    asm volatile("s_waitcnt vmcnt(0)" ::: "memory");
    __syncthreads();
    if (threadIdx.x == 0) {
        unsigned* bar = b.bar;
        __builtin_amdgcn_s_waitcnt(0);
        unsigned nloc = b.st[0], nx = b.st[1];
        if (nloc == 0u) { xcd_barrier_complete(bar, b.x, nloc, nx); b.st[0] = nloc; b.st[1] = nx; }
        const unsigned old = xb_add(&bar[XB_XSUB(b.x)], 1u);
        const unsigned gen = old / nloc;
        if (old + 1u == (gen + 1u) * nloc) {
            __builtin_amdgcn_fence(__ATOMIC_RELEASE, "agent");
            asm volatile("s_waitcnt vmcnt(0)" ::: "memory");
            const unsigned og = xb_add(&bar[XB_TOP], 1u);
            const unsigned tg = og / nx;
            if (og + 1u == (tg + 1u) * nx) xb_add(&bar[XB_TOPGEN], 1u);
            else XB_SPIN(xb_ld(&bar[XB_TOPGEN]) == tg, bar);
            __builtin_amdgcn_fence(__ATOMIC_ACQUIRE, "agent");
            xb_add(&bar[XB_XGEN(b.x)], 1u);
            asm volatile("s_waitcnt vmcnt(0)" ::: "memory");
        } else {
            XB_SPIN(xb_ld(&bar[XB_XGEN(b.x)]) == gen, bar);
            __builtin_amdgcn_fence(__ATOMIC_ACQUIRE, "agent");
            asm volatile("s_waitcnt vmcnt(0)" ::: "memory");
        }
    }
    __syncthreads();
}
namespace pg8 {
#define PG8_LAS __attribute__((address_space(3)))
typedef unsigned short bf16_t;
typedef short bf16x8 __attribute__((ext_vector_type(8)));
typedef float f32x4 __attribute__((ext_vector_type(4)));
typedef unsigned u32x4 __attribute__((ext_vector_type(4)));
constexpr int BM = 256, BK = 64, HALF = 128, HTB = HALF * BK * 2  , STAGE_BYTES = 8 * HTB, NXCD = 8, WGM = 8;

__host__ __device__ __forceinline__ int lds_byte(int r, int c) { const int st = (r >> 4) * 2 + (c >> 5), rr = r & 15, cc = c & 31, ob = rr * 64 + cc * 2; return st * 1024 + (ob ^ (((ob >> 9) & 1) << 5)); }
__host__ __device__ __forceinline__ void stage_rc(int b, int& R, int& C) { const int st = b / 1024, sb = b % 1024, swz = sb ^ (((sb >> 9) & 1) << 5); R = (st >> 1) * 16 + swz / 64; C = (st & 1) * 32 + (swz % 64) / 2; }
__host__ __device__ __forceinline__ int perm32(int rho) { const int n = rho >> 4, i = rho & 15; return 8 * (i >> 2) + 4 * n + (i & 3); }

struct Unit { int pm, pn; };
struct Gemm { const bf16_t* A; const bf16_t* Bt; int M, N, K; };

struct StaticOrder {
    int nM, nN, nwg, G, c;
    __host__ __device__ void init(int M, int N, int G_, int c_) { nM = M / BM; nN = N / BM; nwg = nM * nN; G = G_; c = c_; }
    __host__ __device__ bool next(int i, Unit& u) const {
        const long L = (long)i * G + c; if (L >= nwg) return false;
        int wgid = (int)L; { const int q = nwg / NXCD, r = nwg % NXCD, xcd = wgid % NXCD, off = wgid / NXCD; wgid = (xcd < r ? xcd * (q + 1) : r * (q + 1) + (xcd - r) * q) + off; }
        const int nig = WGM * nN, gid = wgid / nig, fm = gid * WGM, gsz = (nM - fm) < WGM ? (nM - fm) : WGM;
        u.pm = fm + ((wgid % nig) % gsz); u.pn = (wgid % nig) / gsz; return true;
    }
    __device__ __forceinline__ void a_ready(const Unit&) const {}
    __device__ __forceinline__ void done(const Unit&) const {}
};

__device__ __forceinline__ unsigned cvt_pk_bf16(float lo, float hi) { unsigned r; asm volatile("v_cvt_pk_bf16_f32 %0, %1, %2" : "=v"(r) : "v"(lo), "v"(hi)); return r; }
struct EpiStoreBf16 {
    static constexpr bool PERM = true, AFTER_DRAIN = false;
    bf16_t* O; int ldc;
    __device__ __forceinline__ void operator()(const f32x4 (&acc)[2][2][4][2], const Unit& u, int wr, int wc, int fr, int fq) const {
        const int row0 = u.pm * BM + wr * 64 + fr, col0 = u.pn * BM + wc * 32 + 8 * fq;
#pragma unroll
        for (int ai = 0; ai < 2; ++ai)
#pragma unroll
            for (int m = 0; m < 4; ++m) { bf16_t* rowp = O + (size_t)(row0 + ai * HALF + m * 16) * ldc + col0;
#pragma unroll
                for (int bj = 0; bj < 2; ++bj) { const f32x4 v0 = acc[ai][bj][m][0], v1 = acc[ai][bj][m][1];
                    u32x4 w; w.x = cvt_pk_bf16(v0[0], v0[1]); w.y = cvt_pk_bf16(v0[2], v0[3]); w.z = cvt_pk_bf16(v1[0], v1[1]); w.w = cvt_pk_bf16(v1[2], v1[3]);
                    *(u32x4*)(rowp + bj * HALF) = w; } }
    }
};
struct EpiGateRes {
    static constexpr bool PERM = false, AFTER_DRAIN = false;
    const float* base_p; const float* base_s; float* out; const float* gate;
    __device__ __forceinline__ void operator()(const f32x4 (&acc)[2][2][4][2], const Unit& u, int wr, int wc, int fr, int fq) const {
        const int row0 = u.pm * BM + wr * 64 + fr, col0 = u.pn * BM + wc * 32 + 4 * fq;
        const bool smp = row0 >= TP; const float* base = smp ? base_s - (size_t)TP * D : base_p;
#pragma unroll
        for (int ai = 0; ai < 2; ++ai)
#pragma unroll
            for (int m = 0; m < 4; ++m) { const int r = row0 + ai * HALF + m * 16; const int cb = smp ? BATCH + ((r - TP) >> 3) : r / SEQ;
                const float* gp = gate + (size_t)cb * 6 * D + col0; const size_t off = (size_t)r * D + col0;
#pragma unroll
                for (int bj = 0; bj < 2; ++bj)
#pragma unroll
                    for (int n = 0; n < 2; ++n) { const f32x4 gv = *(const f32x4*)(gp + bj * HALF + n * 16), bs = *(const f32x4*)(base + off + bj * HALF + n * 16);
                        *(f32x4*)(out + off + bj * HALF + n * 16) = bs + gv * acc[ai][bj][m][n]; } }
    }
};
template <class Epi, class Sched, bool ALIGN_EPI = false, bool SP2 = false>
__device__ __forceinline__ void gemm_phase(PG8_LAS unsigned char* lds, const Gemm g, const Sched& S, const Epi& E) {
    const int tid = otid(), wid = __builtin_amdgcn_readfirstlane(tid >> 6), lane = tid & 63, wr = wid >> 2, wc = wid & 3, fr = lane & 15, fq = lane >> 4;
    const int K = g.K, nt = K / BK;
    unsigned voffA[2], voffB[2];
#pragma unroll
    for (int i = 0; i < 2; ++i) { int R, C; stage_rc(tid * 16 + i * 8192, R, C); const int Rb = Epi::PERM ? ((R & ~31) + perm32(R & 31)) : R;
        voffA[i] = (unsigned)(R * K + C) * 2u; voffB[i] = (unsigned)(Rb * K + C) * 2u; }
    const size_t kstep = (size_t)(BK * 2);
    const size_t hstep = (size_t)HALF * K * 2;
    const size_t tstep = 2 * hstep;
    const unsigned ldsw = (unsigned)wid * 1024u;
    const int aoff = lds_byte(wr * 64 + fr, fq * 8), boff = lds_byte(wc * 32 + fr, fq * 8);
#define PG8_SA(b, h) (((b) * 2 + (h)) * HTB)
#define PG8_SB(b, h) ((4 + (b) * 2 + (h)) * HTB)
#define PG8_STAGE(bufoff, gbase, voff) do { _Pragma("unroll") for (int _i = 0; _i < 2; ++_i) \
        __builtin_amdgcn_global_load_lds((const unsigned*)((const char*)(gbase) + (voff)[_i]), (PG8_LAS unsigned*)(lds + (bufoff) + ldsw + _i * 8192), 16, 0, 0); } while (0)
#define PG8_LDA(dst, b, h) do { _Pragma("unroll") for (int m = 0; m < 4; ++m) _Pragma("unroll") for (int k = 0; k < 2; ++k) dst[m][k] = *(const PG8_LAS bf16x8*)(lds + PG8_SA(b, h) + aoff + m * 2048 + k * 1024); } while (0)
#define PG8_LDB(dst, b, h) do { _Pragma("unroll") for (int n = 0; n < 2; ++n) _Pragma("unroll") for (int k = 0; k < 2; ++k) dst[n][k] = *(const PG8_LAS bf16x8*)(lds + PG8_SB(b, h) + boff + n * 2048 + k * 1024); } while (0)
#define PG8_MMA(ai, bj, At, Bt) do { __builtin_amdgcn_s_setprio(1); _Pragma("unroll") for (int m = 0; m < 4; ++m) _Pragma("unroll") for (int n = 0; n < 2; ++n) _Pragma("unroll") for (int k = 0; k < 2; ++k) \
        acc[ai][bj][m][n] = __builtin_amdgcn_mfma_f32_16x16x32_bf16(Bt[n][k], At[m][k], acc[ai][bj][m][n], 0, 0, 0); __builtin_amdgcn_s_setprio(0); } while (0)
#define PG8_WAIT_V(n) asm volatile("s_waitcnt vmcnt(" #n ")" ::: "memory")
#define PG8_WAIT_L(n) asm volatile("s_waitcnt lgkmcnt(" #n ")" ::: "memory")
#define PG8_BAR __builtin_amdgcn_s_barrier()
#define PG8_SCHED __builtin_amdgcn_sched_barrier(0)
    Unit cur, nxt; int ui = 0;
    if (!S.next(0, cur)) return;
    f32x4 acc[2][2][4][2];
#pragma unroll
    for (int a = 0; a < 2; ++a)
#pragma unroll
        for (int b = 0; b < 2; ++b)
#pragma unroll
            for (int m = 0; m < 4; ++m)
#pragma unroll
                for (int n = 0; n < 2; ++n) acc[a][b][m][n] = (f32x4){0.f, 0.f, 0.f, 0.f};
    bf16x8 At[4][2], B0[2][2], B1[2][2];
    const char* cA = (const char*)g.A + (size_t)cur.pm * tstep; const char* cB = (const char*)g.Bt + (size_t)cur.pn * tstep;
    S.a_ready(cur);
    if constexpr (SP2) {
        PG8_STAGE(PG8_SB(0, 0), cB, voffB); PG8_STAGE(PG8_SB(0, 1), cB + hstep, voffB); PG8_STAGE(PG8_SA(0, 0), cA, voffA); PG8_STAGE(PG8_SA(0, 1), cA + hstep, voffA);
        if (wr == 1) PG8_BAR;
        PG8_WAIT_V(2); PG8_BAR;
        PG8_STAGE(PG8_SB(1, 0), cB + kstep, voffB); PG8_STAGE(PG8_SA(1, 0), cA + kstep, voffA); PG8_STAGE(PG8_SB(1, 1), cB + hstep + kstep, voffB);
        PG8_WAIT_V(6); PG8_BAR;
    } else {
        PG8_STAGE(PG8_SB(0, 0), cB, voffB); PG8_STAGE(PG8_SA(0, 0), cA, voffA); PG8_STAGE(PG8_SB(0, 1), cB + hstep, voffB); PG8_STAGE(PG8_SA(0, 1), cA + hstep, voffA);
        if (wr == 1) PG8_BAR;
        PG8_WAIT_V(4); PG8_BAR;
        PG8_STAGE(PG8_SB(1, 0), cB + kstep, voffB); PG8_STAGE(PG8_SA(1, 0), cA + kstep, voffA); PG8_STAGE(PG8_SB(1, 1), cB + hstep + kstep, voffB);
        PG8_WAIT_V(6); PG8_BAR;
    }
    for (;;) {
        const bool has_next = S.next(ui + 1, nxt);
        const char* nA = has_next ? (const char*)g.A + (size_t)nxt.pm * tstep : cA; const char* nB = has_next ? (const char*)g.Bt + (size_t)nxt.pn * tstep : cB;
        for (int t = 0; t < nt; t += 2) {
            const bool last = (t == nt - 2);
            const char* a1 = cA + (size_t)(t + 1) * kstep;
            const char* a2 = last ? nA : cA + (size_t)(t + 2) * kstep; const char* b2 = last ? nB : cB + (size_t)(t + 2) * kstep;
            const char* a3 = a2 + kstep; const char* b3 = b2 + kstep;
            if (last && has_next) S.a_ready(nxt);
            if constexpr (SP2) {
            PG8_LDB(B0, 0, 0); PG8_LDB(B1, 0, 1); PG8_SCHED; PG8_LDA(At, 0, 0); PG8_STAGE(PG8_SA(1, 1), a1 + hstep, voffA);
            PG8_WAIT_V(8); PG8_WAIT_L(0); PG8_BAR; PG8_MMA(0, 0, At, B0); PG8_MMA(0, 1, At, B1); PG8_BAR; PG8_SCHED;
            PG8_LDA(At, 0, 1); PG8_STAGE(PG8_SB(0, 0), b2, voffB); PG8_STAGE(PG8_SB(0, 1), b2 + hstep, voffB); PG8_STAGE(PG8_SA(0, 0), a2, voffA);
            PG8_WAIT_V(8); PG8_WAIT_L(0); PG8_BAR; PG8_MMA(1, 0, At, B0); PG8_MMA(1, 1, At, B1); PG8_BAR; PG8_SCHED;
            PG8_LDB(B0, 1, 0); PG8_LDB(B1, 1, 1); PG8_SCHED; PG8_LDA(At, 1, 0); PG8_STAGE(PG8_SA(0, 1), a2 + hstep, voffA);
            PG8_WAIT_V(8); PG8_WAIT_L(0); PG8_BAR; PG8_MMA(0, 0, At, B0); PG8_MMA(0, 1, At, B1); PG8_BAR; PG8_SCHED;
            PG8_LDA(At, 1, 1); PG8_STAGE(PG8_SB(1, 0), b3, voffB); PG8_STAGE(PG8_SB(1, 1), b3 + hstep, voffB); PG8_STAGE(PG8_SA(1, 0), a3, voffA);
            PG8_WAIT_V(8); PG8_WAIT_L(0); PG8_BAR; PG8_MMA(1, 0, At, B0); PG8_MMA(1, 1, At, B1); PG8_BAR; PG8_SCHED;
            } else {
            PG8_LDB(B0, 0, 0); PG8_SCHED; PG8_LDA(At, 0, 0); PG8_STAGE(PG8_SA(1, 1), a1 + hstep, voffA);
            PG8_WAIT_L(8); PG8_BAR; PG8_WAIT_L(0); PG8_MMA(0, 0, At, B0); PG8_BAR; PG8_SCHED;
            PG8_LDB(B1, 0, 1); PG8_STAGE(PG8_SB(0, 0), b2, voffB);
            PG8_BAR; PG8_WAIT_L(0); PG8_MMA(0, 1, At, B1); PG8_BAR;
            PG8_LDA(At, 0, 1); PG8_STAGE(PG8_SA(0, 0), a2, voffA);
            PG8_BAR; PG8_WAIT_L(0); PG8_MMA(1, 0, At, B0); PG8_BAR; PG8_SCHED;
            PG8_STAGE(PG8_SB(0, 1), b2 + hstep, voffB);
            PG8_WAIT_V(6); PG8_BAR; PG8_MMA(1, 1, At, B1); PG8_BAR;
            PG8_LDB(B0, 1, 0); PG8_SCHED; PG8_LDA(At, 1, 0); PG8_STAGE(PG8_SA(0, 1), a2 + hstep, voffA);
            PG8_WAIT_L(8); PG8_BAR; PG8_WAIT_L(0); PG8_MMA(0, 0, At, B0); PG8_BAR; PG8_SCHED;
            PG8_LDB(B1, 1, 1); PG8_STAGE(PG8_SB(1, 0), b3, voffB);
            PG8_BAR; PG8_WAIT_L(0); PG8_MMA(0, 1, At, B1); PG8_BAR;
            PG8_LDA(At, 1, 1); PG8_STAGE(PG8_SA(1, 0), a3, voffA);
            PG8_BAR; PG8_WAIT_L(0); PG8_MMA(1, 0, At, B0); PG8_BAR; PG8_SCHED;
            PG8_STAGE(PG8_SB(1, 1), b3 + hstep, voffB);
            PG8_WAIT_V(6); PG8_BAR; PG8_MMA(1, 1, At, B1); PG8_BAR;
            }
        }
        if constexpr (ALIGN_EPI) { if (wr == 0) PG8_BAR; }
        if constexpr (!Epi::AFTER_DRAIN) { E(acc, cur, wr, wc, fr, fq); S.done(cur); }
        if (!has_next) break;
#pragma unroll
        for (int a = 0; a < 2; ++a)
#pragma unroll
            for (int b = 0; b < 2; ++b)
#pragma unroll
                for (int m = 0; m < 4; ++m)
#pragma unroll
                    for (int n = 0; n < 2; ++n) acc[a][b][m][n] = (f32x4){0.f, 0.f, 0.f, 0.f};
        cur = nxt; cA = nA; cB = nB; ++ui;
        if constexpr (ALIGN_EPI) { if (wr == 1) PG8_BAR; }
    }
    PG8_WAIT_V(0);
    if constexpr (!ALIGN_EPI) { if (wr == 0) PG8_BAR; }
    PG8_BAR;
    if constexpr (Epi::AFTER_DRAIN) { E.fused(acc, cur, wr, wc, fr, fq, lds, wid, lane); S.done(cur); }
#undef PG8_SA
#undef PG8_SB
#undef PG8_STAGE
#undef PG8_LDA
#undef PG8_LDB
#undef PG8_MMA
#undef PG8_WAIT_V
#undef PG8_WAIT_L
#undef PG8_BAR
#undef PG8_SCHED
}
}
typedef short bf16x8 __attribute__((ext_vector_type(8)));
constexpr int FR_NWK = 0, FR_QD = 16, FR_KTT = 32, FR_QK = 48, FR_N = 56;
__device__ __forceinline__ int kperm(int g, int j) { return j < 4 ? 4 * g + j : 16 + 4 * g + (j - 4); }

typedef float f32x2_t __attribute__((ext_vector_type(2))); typedef __bf16 bf16x2_t __attribute__((ext_vector_type(2)));
__device__ __forceinline__ unsigned cvtpk_c(float lo, float hi) { const f32x2_t v = {lo, hi}; const bf16x2_t b = __builtin_convertvector(v, bf16x2_t); return __builtin_bit_cast(unsigned, b); }
__device__ __forceinline__ bf16x8 pack8(const f32x4 a, const f32x4 b) {
    return __builtin_bit_cast(bf16x8, (u32x4){cvtpk_c(a[0], a[1]), cvtpk_c(a[2], a[3]), cvtpk_c(b[0], b[1]), cvtpk_c(b[2], b[3])});
}
constexpr int DP_KP = 136;
constexpr int DP_RP = 72;
constexpr int DP_QS = 0, DP_KS = DP_QS + 64 * DP_KP * 2, DP_RHST = DP_KS + 64 * DP_KP * 2, DP_AM = DP_RHST + 256 * DP_RP * 2, DP_AMP = 68,
              DP_QKM = DP_AM + 64 * DP_AMP * 4, DP_QKP = 72, DP_GS = DP_QKM + 64 * DP_QKP * 2, DP_DM = DP_GS + 4 * 64 * 4, DP_DMP = 20,
              DP_TB = DP_DM + 64 * DP_DMP * 4, DP_END = DP_TB + 64 * DP_RP * 2;
static_assert(DP_END <= 131072 && DP_AM % 16 == 0 && DP_DM % 16 == 0 && DP_TB % 16 == 0 && DP_RHST % 16 == 0, "dnprep LDS");
#ifndef DPS
#define DPS(k)
#endif
__device__ __forceinline__ void phase_dnprep(const P& p, LAS unsigned char* lds, unsigned long long& pr_prev, unsigned long long& pr_acc) {
    const int tid_ = otid();
    LAS bf16_t* QS = (LAS bf16_t*)(lds + DP_QS); LAS bf16_t* KS = (LAS bf16_t*)(lds + DP_KS); LAS bf16_t* RHST = (LAS bf16_t*)(lds + DP_RHST);
    LAS float* AM = (LAS float*)(lds + DP_AM); LAS bf16_t* QKM = (LAS bf16_t*)(lds + DP_QKM); LAS float* GS = (LAS float*)(lds + DP_GS);
    LAS float* DM = (LAS float*)(lds + DP_DM); LAS bf16_t* TB = (LAS bf16_t*)(lds + DP_TB);
    const bf16_t* PR = ws_h(p, WS_PROJ); const float* BG = ws_f(p, WS_BG);
    for (int i = tid_; i < 64 * DP_RP / 2; i += NTHR) ((LAS unsigned*)TB)[i] = 0u;
    float pgx = 0.f, pbx = 0.f, cw[3][4][2]; unsigned xr[3][11];
#define DP_FETCH(uid_, ln_, wv_) do { const int n_ = (uid_) % NCHUNK, bh_ = (uid_) / NCHUNK, h_ = bh_ & 3, m0_ = (bh_ >> 2) * SEQ + n_ * 64; \
        if ((wv_) == 0) { pgx = BG[(size_t)(m0_ + (ln_)) * 8 + 4 + h_]; pbx = BG[(size_t)(m0_ + (ln_)) * 8 + h_]; } \
        _Pragma("unroll") for (int part = 0; part < 3; ++part) _Pragma("unroll") for (int j = 0; j < 4; ++j) { const float* w = p.dn_conv_w + j * 1536 + part * 512 + h_ * 128 + 2 * (ln_); cw[part][j][0] = w[0]; cw[part][j][1] = w[1]; } \
        _Pragma("unroll") for (int rr = 0; rr < 11; ++rr) { const int t_ = n_ * 64 + (wv_) * 8 + rr - 3; \
            _Pragma("unroll") for (int part = 0; part < 3; ++part) { unsigned v_ = 0u; if (t_ >= 0) v_ = *(const unsigned*)(PR + (size_t)(m0_ + (wv_) * 8 + rr - 3) * PLD + part * 512 + h_ * 128 + 2 * (ln_)); xr[part][rr] = v_; } } } while (0)
    if ((int)blockIdx.x < NUNIT) { int t0 = tid_; asm volatile("" : "+v"(t0)); DP_FETCH((int)blockIdx.x, t0 & 63, t0 >> 6); }
    for (int uid = blockIdx.x; uid < NUNIT; uid += gridDim.x) {
        const int n = uid % NCHUNK;
        int tid = tid_; asm volatile("" : "+v"(tid));
        const int lane = tid & 63, wave = tid >> 6, r16 = lane & 15, g4 = lane >> 4;
        unsigned char* abu = p.ws + WS_DNF_AB + (size_t)uid * DNF_AB_UNIT;
        if (wave == 0) {
            float x = pgx;
#pragma unroll
            for (int o = 1; o < 64; o <<= 1) { const float t = __shfl_up(x, o); if (lane >= o) x += t; }
            const float gl = __shfl(x, 63);
            GS[lane] = x; GS[64 + lane] = pbx; GS[128 + lane] = __expf(x); GS[192 + lane] = __expf(gl - x);
            if (lane == 0) ws_f(p, WS_DNF_CD)[uid] = __expf(gl);
        }
        __syncthreads();
        {
            float c[8][3][2], ssum[16];
#pragma unroll
            for (int i = 0; i < 8; ++i) {
#pragma unroll
                for (int part = 0; part < 3; ++part)
#pragma unroll
                    for (int e = 0; e < 2; ++e) { float a = 0.f;
#pragma unroll
                        for (int j = 0; j < 4; ++j) a += cw[part][j][e] * (e == 0 ? __builtin_bit_cast(float, xr[part][i + j] << 16) : __builtin_bit_cast(float, xr[part][i + j] & 0xffff0000u));
                        c[i][part][e] = a * __builtin_amdgcn_rcpf(1.0f + __expf(-a)); }
                ssum[2 * i] = c[i][0][0] * c[i][0][0] + c[i][0][1] * c[i][0][1]; ssum[2 * i + 1] = c[i][1][0] * c[i][1][0] + c[i][1][1] * c[i][1][1]; }
#pragma unroll
            for (int o = 1; o < 64; o <<= 1) {
#pragma unroll
                for (int q = 0; q < 16; ++q) ssum[q] += __shfl_xor(ssum[q], o); }
#pragma unroll
            for (int i = 0; i < 8; ++i) { const int row = wave * 8 + i;
                const float rq = 0.08838834764831845f * __builtin_amdgcn_rsqf(ssum[2 * i] + EPS), rk = __builtin_amdgcn_rsqf(ssum[2 * i + 1] + EPS);
                const float beta = GS[64 + row], eg = GS[128 + row];
                const float q0 = c[i][0][0] * rq, q1 = c[i][0][1] * rq, k0 = c[i][1][0] * rk, k1 = c[i][1][1] * rk;
                *(LAS unsigned*)(QS + row * DP_KP + 2 * lane) = pk2(q0, q1);
                *(LAS unsigned*)(KS + row * DP_KP + 2 * lane) = pk2(k0, k1);
                RHST[(2 * lane) * DP_RP + row] = f2bf(beta * c[i][2][0]); RHST[(2 * lane + 1) * DP_RP + row] = f2bf(beta * c[i][2][1]);
                RHST[(128 + 2 * lane) * DP_RP + row] = f2bf(beta * eg * k0); RHST[(128 + 2 * lane + 1) * DP_RP + row] = f2bf(beta * eg * k1); }
        }
        if (uid + (int)gridDim.x < NUNIT) DP_FETCH(uid + (int)gridDim.x, lane, wave);
        __syncthreads(); DPS(16);
        {
            const int ti = wave >> 1;
            f32x4 akk[2], aqk[2];
#pragma unroll
            for (int c = 0; c < 2; ++c) { akk[c] = (f32x4){0.f, 0.f, 0.f, 0.f}; aqk[c] = (f32x4){0.f, 0.f, 0.f, 0.f}; }
#pragma unroll
            for (int kb = 0; kb < 4; ++kb) {
                const bf16x8 ak = *(const LAS bf16x8*)(KS + (16 * ti + r16) * DP_KP + 32 * kb + 8 * g4), aq = *(const LAS bf16x8*)(QS + (16 * ti + r16) * DP_KP + 32 * kb + 8 * g4);
#pragma unroll
                for (int c = 0; c < 2; ++c) { const int tj = 2 * (wave & 1) + c; const bf16x8 bk = *(const LAS bf16x8*)(KS + (16 * tj + r16) * DP_KP + 32 * kb + 8 * g4);
                    akk[c] = __builtin_amdgcn_mfma_f32_16x16x32_bf16(ak, bk, akk[c], 0, 0, 0); aqk[c] = __builtin_amdgcn_mfma_f32_16x16x32_bf16(aq, bk, aqk[c], 0, 0, 0); }
            }
#pragma unroll
            for (int c = 0; c < 2; ++c) { const int tj = 2 * (wave & 1) + c, J = 16 * tj + r16; const float gj = GS[J];
#pragma unroll
                for (int i = 0; i < 4; ++i) { const int I = 16 * ti + 4 * g4 + i; const float dec = I >= J ? __expf(GS[I] - gj) : 0.f;
                    AM[I * DP_AMP + J] = I > J ? GS[64 + I] * akk[c][i] * dec : 0.f; QKM[I * DP_QKP + J] = f2bf(aqk[c][i] * dec); } }
        }
        __syncthreads(); DPS(17);
        if (wave == 0) {
            const int bb = g4, cc = r16; float t[16];
            f32x4 tr[16][4];
#pragma unroll
            for (int i = 1; i < 16; ++i)
#pragma unroll
                for (int j4 = 0; j4 < (i + 3) / 4; ++j4) tr[i][j4] = *(const LAS f32x4*)(AM + (16 * bb + i) * DP_AMP + 16 * bb + 4 * j4);
            __builtin_amdgcn_sched_barrier(0);
#pragma unroll
            for (int i = 0; i < 16; ++i) { float acc = (i == cc) ? 1.f : 0.f;
#pragma unroll
                for (int j = 0; j < i; ++j) acc -= tr[i][j >> 2][j & 3] * t[j];
                t[i] = acc; }
#pragma unroll
            for (int i = 0; i < 16; ++i) { DM[(16 * bb + i) * DP_DMP + cc] = t[i]; TB[(16 * bb + i) * DP_RP + 16 * bb + cc] = f2bf(t[i]); }
        } else if (wave >= 4) {
            for (int f = FR_QD + (wave - 4); f < FR_N; f += 4) {
                u32x4 o;
                if (f < FR_KTT) { const int mt = (f - FR_QD) >> 2, kb = (f - FR_QD) & 3, row = 16 * mt + r16; const float sc = GS[128 + row];
                    const u32x2 lo = *(const LAS u32x2*)(QS + row * DP_KP + 32 * kb + 4 * g4), hi = *(const LAS u32x2*)(QS + row * DP_KP + 32 * kb + 16 + 4 * g4);
                    const unsigned w[4] = {lo.x, lo.y, hi.x, hi.y}; unsigned r[4];
#pragma unroll
                    for (int e = 0; e < 4; ++e) r[e] = cvtpk_c(__builtin_bit_cast(float, w[e] << 16) * sc, __builtin_bit_cast(float, w[e] & 0xffff0000u) * sc);
                    o = (u32x4){r[0], r[1], r[2], r[3]};
                } else if (f < FR_QK) { const int kt = (f - FR_KTT) >> 1, tb = (f - FR_KTT) & 1; float v[8];
#pragma unroll
                    for (int j = 0; j < 8; ++j) { const int tok = 32 * tb + kperm(g4, j); v[j] = bf2f(KS[tok * DP_KP + 16 * kt + r16]) * GS[192 + tok]; }
                    o = (u32x4){cvtpk_c(v[0], v[1]), cvtpk_c(v[2], v[3]), cvtpk_c(v[4], v[5]), cvtpk_c(v[6], v[7])};
                } else { const int mt = (f - FR_QK) >> 1, tb = (f - FR_QK) & 1, row = 16 * mt + r16;
                    const u32x2 lo = *(const LAS u32x2*)(QKM + row * DP_QKP + 32 * tb + 4 * g4), hi = *(const LAS u32x2*)(QKM + row * DP_QKP + 32 * tb + 16 + 4 * g4);
                    o = (u32x4){lo.x, lo.y, hi.x, hi.y}; }
                *(u32x4*)(abu + (size_t)f * 1024 + lane * 16) = o;
            }
        }
        __syncthreads(); DPS(18);
        if (wave < 3) {
            const int j = wave; f32x4 Tk[4];
#pragma unroll
            for (int kk = 0; kk < 4; ++kk) Tk[j][kk] = DM[(16 * j + 4 * g4 + kk) * DP_DMP + r16];
#pragma unroll
            for (int i = 1; i < 4; ++i) if (i > j) {
                f32x4 acc = (f32x4){0.f, 0.f, 0.f, 0.f};
#pragma unroll
                for (int k = 0; k < 3; ++k) if (k >= j && k < i) { const f32x4 a = *(const LAS f32x4*)(AM + (16 * i + r16) * DP_AMP + 16 * k + 4 * g4);
#pragma unroll
                    for (int kk = 0; kk < 4; ++kk) acc = __builtin_amdgcn_mfma_f32_16x16x4f32(a[kk], Tk[k][kk], acc, 0, 0, 0); }
                const f32x4 dd = *(const LAS f32x4*)(DM + (16 * i + r16) * DP_DMP + 4 * g4);
                f32x4 res = (f32x4){0.f, 0.f, 0.f, 0.f};
#pragma unroll
                for (int kk = 0; kk < 4; ++kk) res = __builtin_amdgcn_mfma_f32_16x16x4f32(dd[kk], acc[kk], res, 0, 0, 0);
                Tk[i] = -res;
#pragma unroll
                for (int e = 0; e < 4; ++e) TB[(16 * i + 4 * g4 + e) * DP_RP + 16 * j + r16] = f2bf(Tk[i][e]); }
        }
        __syncthreads(); DPS(19);
        {
            const int mt = wave & 3, half = wave >> 2;
            bf16x8 tf[2];
#pragma unroll
            for (int kb = 0; kb < 2; ++kb) tf[kb] = *(const LAS bf16x8*)(TB + (16 * mt + r16) * DP_RP + 32 * kb + 8 * g4);
            if (half == 0) {
                float* wv = (float*)(p.ws + WS_DNF_WV + (size_t)uid * DNF_WV_UNIT) + (size_t)mt * 256 + lane * 4;
#pragma unroll
                for (int vt = 0; vt < 8; ++vt) { f32x4 acc = (f32x4){0.f, 0.f, 0.f, 0.f};
#pragma unroll
                    for (int kb = 0; kb < 2; ++kb) acc = __builtin_amdgcn_mfma_f32_16x16x32_bf16(tf[kb], *(const LAS bf16x8*)(RHST + (16 * vt + r16) * DP_RP + 32 * kb + 8 * g4), acc, 0, 0, 0);
                    *(f32x4*)(wv + (size_t)vt * 1024) = acc; }
            } else {
#pragma unroll
                for (int kbp = 0; kbp < 4; ++kbp) { f32x4 xt[2];
#pragma unroll
                    for (int c2 = 0; c2 < 2; ++c2) { xt[c2] = (f32x4){0.f, 0.f, 0.f, 0.f};
#pragma unroll
                        for (int kb = 0; kb < 2; ++kb) xt[c2] = __builtin_amdgcn_mfma_f32_16x16x32_bf16(*(const LAS bf16x8*)(RHST + (128 + 16 * (2 * kbp + c2) + r16) * DP_RP + 32 * kb + 8 * g4), tf[kb], xt[c2], 0, 0, 0); }
                    *(u32x4*)(abu + (size_t)(FR_NWK + mt * 4 + kbp) * 1024 + lane * 16) = __builtin_bit_cast(u32x4, pack8(-xt[0], -xt[1])); }
            }
        }
        __syncthreads(); DPS(20);
    }
#undef DP_FETCH
}

constexpr size_t O_ODN = O_Y;
#define DN_SB() __builtin_amdgcn_sched_barrier(0)
__device__ __forceinline__ void dn_consume(const LAS unsigned char* fb, int wl, f32x4 (&S)[8], float cd, float* op) {
    f32x4 u[4], o[4];
    bf16x8 fa[16], fq[16], Sb[4], Ub[2];
#pragma unroll
    for (int mt = 0; mt < 4; ++mt) u[mt] = *(const LAS f32x4*)(fb + (FR_N + wl * 4 + mt) * 1024);
#pragma unroll
    for (int f = 0; f < 16; ++f) fa[f] = *(const LAS bf16x8*)(fb + (FR_NWK + f) * 1024);
#pragma unroll
    for (int f = 0; f < 8; ++f) fq[f] = *(const LAS bf16x8*)(fb + (FR_QD + f) * 1024);
    DN_SB();
#pragma unroll
    for (int kb = 0; kb < 4; ++kb) Sb[kb] = pack8(S[2 * kb], S[2 * kb + 1]);
#pragma unroll
    for (int mt = 0; mt < 4; ++mt)
#pragma unroll
        for (int kb = 0; kb < 4; ++kb) u[mt] = __builtin_amdgcn_mfma_f32_16x16x32_bf16(fa[mt * 4 + kb], Sb[kb], u[mt], 0, 0, 0);
    DN_SB();
#pragma unroll
    for (int f = 8; f < 16; ++f) fq[f] = *(const LAS bf16x8*)(fb + (FR_QD + f) * 1024);
#pragma unroll
    for (int f = 0; f < 8; ++f) fa[f] = *(const LAS bf16x8*)(fb + (FR_KTT + f) * 1024);
    DN_SB();
#pragma unroll
    for (int mt = 0; mt < 4; ++mt) { o[mt] = (f32x4){0.f, 0.f, 0.f, 0.f};
#pragma unroll
        for (int kb = 0; kb < 4; ++kb) o[mt] = __builtin_amdgcn_mfma_f32_16x16x32_bf16(fq[mt * 4 + kb], Sb[kb], o[mt], 0, 0, 0); }
    DN_SB();
#pragma unroll
    for (int f = 8; f < 16; ++f) fa[f] = *(const LAS bf16x8*)(fb + (FR_KTT + f) * 1024);
#pragma unroll
    for (int f = 0; f < 8; ++f) fq[f] = *(const LAS bf16x8*)(fb + (FR_QK + f) * 1024);
#pragma unroll
    for (int tb = 0; tb < 2; ++tb) Ub[tb] = pack8(u[2 * tb], u[2 * tb + 1]);
#pragma unroll
    for (int kt = 0; kt < 8; ++kt) S[kt] = S[kt] * cd;
    DN_SB();
#pragma unroll
    for (int kt = 0; kt < 8; ++kt)
#pragma unroll
        for (int tb = 0; tb < 2; ++tb) S[kt] = __builtin_amdgcn_mfma_f32_16x16x32_bf16(fa[kt * 2 + tb], Ub[tb], S[kt], 0, 0, 0);
#pragma unroll
    for (int mt = 0; mt < 4; ++mt) {
#pragma unroll
        for (int tb = 0; tb < 2; ++tb) o[mt] = __builtin_amdgcn_mfma_f32_16x16x32_bf16(fq[mt * 2 + tb], Ub[tb], o[mt], 0, 0, 0);
#pragma unroll
        for (int i = 0; i < 4; ++i) op[(size_t)(16 * mt + i) * 512] = o[mt][i]; }
}
constexpr int DN_SBUF = 73728;
__device__ __forceinline__ void phase_dnscan(const P& p, LAS unsigned char* lds) {
    if (blockIdx.x >= BATCH * 4 * 2) return;
    const int tid = otid(), lane = tid & 63, wave = __builtin_amdgcn_readfirstlane(tid >> 6), r16 = lane & 15, g4 = lane >> 4;
    const int bh = blockIdx.x >> 1, vh = blockIdx.x & 1, h = bh & 3, b = bh >> 2, wl = wave & 3, vs = vh * 4 + wl, v0 = vs * 16;
    const float* cdp = ws_f(p, WS_DNF_CD) + (size_t)bh * NCHUNK;
    float* odn = p.out + O_ODN;
#define DN_BAR() do { asm volatile("s_waitcnt lgkmcnt(0)" ::: "memory"); __builtin_amdgcn_s_barrier(); asm volatile("" ::: "memory"); } while (0)
    if (wave >= 4) {
        const unsigned char* ab = p.ws + WS_DNF_AB + (size_t)bh * NCHUNK * DNF_AB_UNIT + lane * 16;
        const unsigned char* wvb = p.ws + WS_DNF_WV + (size_t)bh * NCHUNK * DNF_WV_UNIT + (size_t)vh * 16 * 1024 + lane * 16;
        u32x4 R[3][18];
#define DN_SRC(n_, q_) ((q_) < FR_N ? ab + (size_t)(n_) * DNF_AB_UNIT + (q_) * 1024 : wvb + (size_t)(n_) * DNF_WV_UNIT + ((q_) - FR_N) * 1024)
#define DN_LD(n_, s_) do { if ((n_) < NCHUNK) { _Pragma("unroll") for (int i_ = 0; i_ < 18; ++i_) R[s_][i_] = *(const u32x4*)DN_SRC(n_, wl * 18 + i_); } } while (0)
#define DN_ST(n_, s_) do { if ((n_) < NCHUNK) { LAS unsigned char* d_ = lds + ((n_) & 1) * DN_SBUF + wl * 18 * 1024 + lane * 16; _Pragma("unroll") for (int i_ = 0; i_ < 18; ++i_) *(LAS u32x4*)(d_ + i_ * 1024) = R[s_][i_]; } } while (0)
        DN_LD(0, 0); DN_LD(1, 1); DN_LD(2, 2); DN_ST(0, 0);
        DN_BAR();
#define DN_LSTEP(n_, s_) do { const int n = (n_); if (n < NCHUNK) { DN_LD(n + 3, s_); DN_ST(n + 1, ((s_) + 1) % 3); DN_BAR(); } } while (0)
        for (int n3 = 0; n3 < NCHUNK; n3 += 3) { DN_LSTEP(n3, 0); DN_LSTEP(n3 + 1, 1); DN_LSTEP(n3 + 2, 2); }
#undef DN_LSTEP
#undef DN_LD
#undef DN_ST
#undef DN_SRC
        return;
    }
    f32x4 S[8];
#pragma unroll
    for (int t = 0; t < 8; ++t) S[t] = (f32x4){0.f, 0.f, 0.f, 0.f};
    float cd = cdp[0];
    DN_BAR();
    for (int n = 0; n < NCHUNK; ++n) {
        const float cdn = cdp[n + 1 < NCHUNK ? n + 1 : n];
        dn_consume(lds + (n & 1) * DN_SBUF + lane * 16, wl, S, cd, odn + (size_t)(b * SEQ + n * 64 + 4 * g4) * 512 + h * 128 + v0 + r16);
        cd = cdn;
        DN_BAR();
    }
#undef DN_BAR
    {
        float* so = p.out + O_PSSM + (size_t)bh * 128 * 128 + v0 + r16;
#pragma unroll
        for (int kt = 0; kt < 8; ++kt)
#pragma unroll
            for (int i = 0; i < 4; ++i) so[(size_t)(16 * kt + 4 * g4 + i) * 128] = S[kt][i];
    }
}
__device__ __forceinline__ void phase_dngate(const P& p) {
    const int tid_ = otid(), lane = tid_ & 63, wave = tid_ >> 6;
    const int gw = blockIdx.x * NWAVES + wave, NGW = gridDim.x * NWAVES;
    const f32x4 nw0 = *(const f32x4*)(p.dn_norm_w + (lane & 15) * 8), nw1 = *(const f32x4*)(p.dn_norm_w + (lane & 15) * 8 + 4);
    f32x4 a, c; u32x4 z;
#define DG_LOAD(m_) do { const float* o_ = p.out + O_ODN + (size_t)(m_) * 512 + lane * 8; a = *(const f32x4*)o_; c = *(const f32x4*)(o_ + 4); z = *(const u32x4*)(ws_h(p, WS_PROJ) + (size_t)(m_) * PLD + PC_Z + lane * 8); } while (0)
    if (gw < TP) DG_LOAD(gw);
    for (int m = gw; m < TP; m += NGW) {
        const f32x4 a0 = a, c0 = c; const u32x4 z0 = z;
        if (m + NGW < TP) DG_LOAD(m + NGW);
        float ss = (a0[0] * a0[0] + a0[1] * a0[1]) + (a0[2] * a0[2] + a0[3] * a0[3]) + (c0[0] * c0[0] + c0[1] * c0[1]) + (c0[2] * c0[2] + c0[3] * c0[3]);
#pragma unroll
        for (int off = 1; off < 16; off <<= 1) ss += __shfl_xor(ss, off);
        const float rstd = 1.0f / sqrtf(ss * (1.0f / 128.0f) + EPS);
        const unsigned zw[4] = {z0.x, z0.y, z0.z, z0.w}; const float ov[8] = {a0[0], a0[1], a0[2], a0[3], c0[0], c0[1], c0[2], c0[3]}; const float nwv[8] = {nw0[0], nw0[1], nw0[2], nw0[3], nw1[0], nw1[1], nw1[2], nw1[3]};
        unsigned r[4];
#pragma unroll
        for (int e = 0; e < 4; ++e) { const float z0f = __builtin_bit_cast(float, zw[e] << 16), z1f = __builtin_bit_cast(float, zw[e] & 0xffff0000u);
            r[e] = pk2(ov[2 * e] * rstd * nwv[2 * e] * silu_f(z0f), ov[2 * e + 1] * rstd * nwv[2 * e + 1] * silu_f(z1f)); }
        *(u32x4*)(ws_h(p, WS_MIX) + (size_t)m * 1024 + lane * 8) = (u32x4){r[0], r[1], r[2], r[3]};
    }
#undef DG_LOAD
}
__device__ __forceinline__ void phase_dnsample(const P& p, LAS unsigned char* lds) {
    const int tid = otid(), lane = tid & 63, us = tid >> 8, w4 = (tid >> 6) & 3, kh = lane >> 5, col_ = w4 * 32 + (lane & 31);
    LAS float* QH = (LAS float*)lds + us * 4352;
    LAS float* KH = QH + 1024; LAS float* VH = QH + 2048; LAS float* OH = QH + 3072; LAS float* RED = QH + 4096;
    const bf16_t* PR = ws_h(p, WS_PROJ); const float* BG = ws_f(p, WS_BG);
    for (int ub = blockIdx.x; ub < DEC_BATCH * 2; ub += gridDim.x) {
        const int uidx = ub * 2 + us, b = uidx >> 2, h = uidx & 3, m0 = TP + b * DEC_SEQ;
        int col = col_; asm volatile("" : "+v"(col));
        {
            float x0[11], x1[11];
            const int ch0 = kh * 512 + h * 128 + col;
#pragma unroll
            for (int rr = 0; rr < 11; ++rr) {
                if (rr < 3) { const float* st = p.state_dn_conv + ((size_t)b * 3 + rr) * 1536; x0[rr] = st[ch0]; x1[rr] = st[1024 + h * 128 + col]; }
                else { const bf16_t* pr = PR + (size_t)(m0 + rr - 3) * PLD; x0[rr] = bf2f(pr[ch0]); x1[rr] = bf2f(pr[1024 + h * 128 + col]); } }
            float w0[4], w1[4];
#pragma unroll
            for (int j = 0; j < 4; ++j) { w0[j] = p.dn_conv_w[j * 1536 + ch0]; w1[j] = p.dn_conv_w[j * 1536 + 1024 + h * 128 + col]; }
#pragma unroll
            for (int t = 0; t < 8; ++t) { float a = 0.f, d = 0.f;
#pragma unroll
                for (int j = 0; j < 4; ++j) { a += w0[j] * x0[t + j]; d += w1[j] * x1[t + j]; }
                a = silu_f(a); d = silu_f(d);
                if (kh == 0) { QH[t * 128 + col] = a; VH[t * 128 + col] = d; } else KH[t * 128 + col] = a;
                const float sq = wave_sum(kh == 0 ? a * a : 0.f), sk = wave_sum(kh == 1 ? a * a : 0.f);
                if (lane == 0) { RED[w4 * 16 + t] = sq; RED[w4 * 16 + 8 + t] = sk; } }
        }
        __syncthreads();
#pragma unroll
        for (int t = 0; t < 8; ++t) {
            if (kh == 0) { const float sq = (RED[t] + RED[16 + t]) + (RED[32 + t] + RED[48 + t]); QH[t * 128 + col] *= 0.08838834764831845f / sqrtf(sq + EPS); }
            else { const float sk = (RED[8 + t] + RED[24 + t]) + (RED[40 + t] + RED[56 + t]); KH[t * 128 + col] *= 1.0f / sqrtf(sk + EPS); } }
        __syncthreads();
        float S[64];
        const float* S0 = p.state_dn_ssm + ((size_t)b * 4 + h) * 128 * 128 + (size_t)kh * 64 * 128 + col;
#pragma unroll
        for (int k = 0; k < 64; ++k) { S[k] = *S0; S0 += 128; if ((k & 7) == 7) asm volatile("" : "+v"(S0)); }
#pragma unroll 1
        for (int t = 0; t < 8; ++t) {
            const float beta = BG[(size_t)(m0 + t) * 8 + h], eg = expf(BG[(size_t)(m0 + t) * 8 + 4 + h]);
            const LAS float* kp = KH + t * 128 + kh * 64; const LAS float* qp = QH + t * 128 + kh * 64;
            float kS = 0.f;
#pragma unroll
            for (int k4 = 0; k4 < 16; ++k4) { const f32x4 kk = *(const LAS f32x4*)(kp + 4 * k4);
#pragma unroll
                for (int e = 0; e < 4; ++e) { S[4 * k4 + e] *= eg; kS += kk[e] * S[4 * k4 + e]; } }
            kS += __shfl_xor(kS, 32);
            const float u = beta * (VH[t * 128 + col] - kS);
            float o = 0.f;
#pragma unroll
            for (int k4 = 0; k4 < 16; ++k4) { const f32x4 kk = *(const LAS f32x4*)(kp + 4 * k4), qq = *(const LAS f32x4*)(qp + 4 * k4);
#pragma unroll
                for (int e = 0; e < 4; ++e) { S[4 * k4 + e] += kk[e] * u; o += qq[e] * S[4 * k4 + e]; } }
            o += __shfl_xor(o, 32);
            if (kh == 0) OH[t * 128 + col] = o;
        }
        float* So = p.out + O_SSSM + ((size_t)b * 4 + h) * 128 * 128 + (size_t)kh * 64 * 128 + col;
#pragma unroll
        for (int k = 0; k < 64; ++k) { *So = S[k]; So += 128; if ((k & 7) == 7) asm volatile("" : "+v"(So)); }
        __syncthreads();
#pragma unroll
        for (int t = 0; t < 8; ++t) { const float o = kh == 0 ? OH[t * 128 + col] : 0.f; const float s = wave_sum(o * o); if (lane == 0) RED[w4 * 16 + t] = s; }
        __syncthreads();
        if (kh == 0) {
            const float nw = p.dn_norm_w[col];
#pragma unroll
            for (int t = 0; t < 8; ++t) { const float rstd = 1.0f / sqrtf(((RED[t] + RED[16 + t]) + (RED[32 + t] + RED[48 + t])) * (1.0f / 128.0f) + EPS);
                const float z = bf2f(PR[(size_t)(m0 + t) * PLD + PC_Z + h * 128 + col]);
                ws_h(p, WS_MIX)[(size_t)(m0 + t) * 1024 + h * 128 + col] = f2bf(OH[t * 128 + col] * rstd * nw * silu_f(z)); }
        }
        __syncthreads();
    }
}
constexpr int NSEG = 16, CSEG = NCHUNK / NSEG, NBH = BATCH * 4;
static_assert(NCHUNK % NSEG == 0, "segments");
constexpr size_t O_RFRAG = O_ODN + (size_t)TP * 512;
constexpr size_t O_BSEG = O_RFRAG + (size_t)NBH * NSEG * 8192;
constexpr size_t O_SSEG = O_BSEG + (size_t)NBH * NSEG * 16384;
constexpr size_t O_CPROD = O_SSEG + (size_t)NBH * NSEG * 16384;
static_assert(O_CPROD + NBH * NSEG <= (size_t)T * D, "segment scratch fits in the y region of d_out");

template <bool HASWV> __device__ __forceinline__ void dn_consume_map(const LAS unsigned char* fb, int wl, f32x4 (&X)[8], float cd) {
    f32x4 u[4]; bf16x8 fa[16], fk[16], Xb[4], Ub[2];
#pragma unroll
    for (int mt = 0; mt < 4; ++mt) u[mt] = HASWV ? *(const LAS f32x4*)(fb + (FR_N + wl * 4 + mt) * 1024) : (f32x4){0.f, 0.f, 0.f, 0.f};
#pragma unroll
    for (int f = 0; f < 16; ++f) fa[f] = *(const LAS bf16x8*)(fb + (FR_NWK + f) * 1024);
#pragma unroll
    for (int f = 0; f < 8; ++f) fk[f] = *(const LAS bf16x8*)(fb + (FR_KTT + f) * 1024);
    DN_SB();
#pragma unroll
    for (int kb = 0; kb < 4; ++kb) Xb[kb] = pack8(X[2 * kb], X[2 * kb + 1]);
#pragma unroll
    for (int mt = 0; mt < 4; ++mt)
#pragma unroll
        for (int kb = 0; kb < 4; ++kb) u[mt] = __builtin_amdgcn_mfma_f32_16x16x32_bf16(fa[mt * 4 + kb], Xb[kb], u[mt], 0, 0, 0);
    DN_SB();
#pragma unroll
    for (int f = 8; f < 16; ++f) fk[f] = *(const LAS bf16x8*)(fb + (FR_KTT + f) * 1024);
#pragma unroll
    for (int tb = 0; tb < 2; ++tb) Ub[tb] = pack8(u[2 * tb], u[2 * tb + 1]);
#pragma unroll
    for (int kt = 0; kt < 8; ++kt) X[kt] = X[kt] * cd;
    DN_SB();
#pragma unroll
    for (int kt = 0; kt < 8; ++kt)
#pragma unroll
        for (int tb = 0; tb < 2; ++tb) X[kt] = __builtin_amdgcn_mfma_f32_16x16x32_bf16(fk[kt * 2 + tb], Ub[tb], X[kt], 0, 0, 0);
}
#define DNS_BAR() do { asm volatile("s_waitcnt lgkmcnt(0)" ::: "memory"); __builtin_amdgcn_s_barrier(); asm volatile("" ::: "memory"); } while (0)
template <int MODE> __device__ __forceinline__ void dns_loader(const P& p, LAS unsigned char* lds, int bh, int n0, int nsteps, int vh, int wl, int lane) {
    constexpr int NPW = MODE == 2 ? 18 : (MODE == 1 ? 12 : 8);
    const unsigned char* ab = p.ws + WS_DNF_AB + ((size_t)bh * NCHUNK + n0) * DNF_AB_UNIT + lane * 16;
    const unsigned char* wvb = p.ws + WS_DNF_WV + ((size_t)bh * NCHUNK + n0) * DNF_WV_UNIT + (size_t)vh * 16 * 1024 + lane * 16;
    u32x4 R[3][NPW];
#define DNS_FRAG(q_) (MODE == 2 ? (q_) : ((q_) < 16 ? (q_) : ((q_) < 32 ? FR_KTT + (q_) - 16 : FR_N + (q_) - 32)))
#define DNS_SRC(n_, q_) (DNS_FRAG(q_) < FR_N ? ab + (size_t)(n_) * DNF_AB_UNIT + DNS_FRAG(q_) * 1024 : wvb + (size_t)(n_) * DNF_WV_UNIT + (DNS_FRAG(q_) - FR_N) * 1024)
#define DNS_LD(n_, s_) do { if ((n_) < nsteps) { _Pragma("unroll") for (int i_ = 0; i_ < NPW; ++i_) R[s_][i_] = *(const u32x4*)DNS_SRC(n_, wl * NPW + i_); } } while (0)
#define DNS_ST(n_, s_) do { if ((n_) < nsteps) { LAS unsigned char* d_ = lds + ((n_) & 1) * DN_SBUF + lane * 16; _Pragma("unroll") for (int i_ = 0; i_ < NPW; ++i_) *(LAS u32x4*)(d_ + DNS_FRAG(wl * NPW + i_) * 1024) = R[s_][i_]; } } while (0)
    DNS_LD(0, 0); DNS_LD(1, 1); DNS_LD(2, 2); DNS_ST(0, 0);
    DNS_BAR();
#define DNS_LSTEP(n_, s_) do { const int n = (n_); if (n < nsteps) { DNS_LD(n + 3, s_); DNS_ST(n + 1, ((s_) + 1) % 3); DNS_BAR(); } } while (0)
    for (int n3 = 0; n3 < nsteps; n3 += 3) { DNS_LSTEP(n3, 0); DNS_LSTEP(n3 + 1, 1); DNS_LSTEP(n3 + 2, 2); }
#undef DNS_LSTEP
#undef DNS_LD
#undef DNS_ST
#undef DNS_SRC
#undef DNS_FRAG
}
constexpr int PA_RTP = 72;
template <int MODE> __device__ __forceinline__ void dns_passA_task(const P& p, LAS unsigned char* lds, int bh, int seg, int q, int wave, int lane) {
    const int r16 = lane & 15, g4 = lane >> 4, wl = wave & 3, n0 = seg * CSEG;
    const float* cdp = ws_f(p, WS_DNF_CD) + (size_t)bh * NCHUNK + n0;
    LAS bf16_t* RT = (LAS bf16_t*)lds;
    if (wave >= 4) { dns_loader<MODE>(p, lds, bh, n0, CSEG, q & 1, wl, lane); }
    else {
        f32x4 X[8];
#pragma unroll
        for (int kt = 0; kt < 8; ++kt)
#pragma unroll
            for (int i = 0; i < 4; ++i) X[kt][i] = (MODE == 0 && 16 * kt + 4 * g4 + i == 64 * q + 16 * wl + r16) ? 1.f : 0.f;
        float cd = cdp[0], cprod = 1.f;
        DNS_BAR();
        for (int n = 0; n < CSEG; ++n) {
            const float cdn = cdp[n + 1 < CSEG ? n + 1 : n];
            dn_consume_map<MODE == 1>(lds + (n & 1) * DN_SBUF + lane * 16, wl, X, cd);
            cprod *= cd; cd = cdn;
            DNS_BAR();
        }
        if (MODE == 0) {
#pragma unroll
            for (int kt = 0; kt < 8; ++kt)
#pragma unroll
                for (int i = 0; i < 4; ++i) { const int row = 16 * kt + 4 * g4 + i, col = 16 * wl + r16; const float v = X[kt][i] - ((row == 64 * q + col) ? cprod : 0.f);
                    RT[row * PA_RTP + col] = f2bf(v); }
            if (q == 0 && wave == 0 && lane == 0) p.out[O_CPROD + bh * NSEG + seg] = cprod;
        } else {
            float* bo = p.out + O_BSEG + ((size_t)(bh * NSEG + seg) * 8 + (4 * (q & 1) + wl)) * 2048 + lane * 4;
#pragma unroll
            for (int kt = 0; kt < 8; ++kt) *(f32x4*)(bo + kt * 256) = X[kt];
        }
    }
    DNS_BAR();
    if (MODE == 0) {
#pragma unroll
        for (int j = 0; j < 2; ++j) { const int f = wave * 2 + j, mt = f >> 1, kbl = f & 1, row = 16 * mt + r16;
            const u32x2 lo = *(const LAS u32x2*)(RT + row * PA_RTP + 32 * kbl + 4 * g4), hi = *(const LAS u32x2*)(RT + row * PA_RTP + 32 * kbl + 16 + 4 * g4);
            *(u32x4*)((unsigned char*)(p.out + O_RFRAG) + ((size_t)(bh * NSEG + seg) * 32 + mt * 4 + 2 * q + kbl) * 1024 + lane * 16) = (u32x4){lo.x, lo.y, hi.x, hi.y}; }
        DNS_BAR();
    }
}
__device__ __forceinline__ void phase_dns_passA(const P& p, LAS unsigned char* lds) {
    const int tid = otid(), lane = tid & 63, wave = __builtin_amdgcn_readfirstlane(tid >> 6);
    for (int t = blockIdx.x; t < NBH * NSEG * 4; t += gridDim.x) {
        const int q = t & 3, seg = (t >> 2) % NSEG, bh = t / (4 * NSEG);
        if (q < 2) dns_passA_task<0>(p, lds, bh, seg, q, wave, lane); else dns_passA_task<1>(p, lds, bh, seg, q, wave, lane);
    }
}
__device__ __forceinline__ void phase_dns_passB(const P& p, LAS unsigned char* lds) {
    if ((int)blockIdx.x >= NBH * 8) return;
    const int tid = otid(), lane = tid & 63, w = __builtin_amdgcn_readfirstlane(tid >> 6), r16 = lane & 15, g4 = lane >> 4;
    const int bh = blockIdx.x >> 3, vs = blockIdx.x & 7;
    LAS u32x2* XB = (LAS u32x2*)lds;
    const unsigned char* rf0 = (const unsigned char*)(p.out + O_RFRAG) + ((size_t)bh * NSEG * 32 + w * 4) * 1024 + lane * 16;
    const float* bt0 = p.out + O_BSEG + ((size_t)bh * NSEG * 8 + vs) * 2048 + w * 256 + lane * 4;
    float* ss0 = p.out + O_SSEG + ((size_t)bh * NSEG * 8 + vs) * 2048 + w * 256 + lane * 4;
    const float* cp0 = p.out + O_CPROD + bh * NSEG;
    u32x4 rf[4][4]; f32x4 bt[4]; float cp[4];
#define PB_LD(s_, r_) do { if ((s_) < NSEG) { _Pragma("unroll") for (int kb = 0; kb < 4; ++kb) rf[r_][kb] = *(const u32x4*)(rf0 + (size_t)(s_) * 32768 + kb * 1024); bt[r_] = *(const f32x4*)(bt0 + (size_t)(s_) * 16384); cp[r_] = cp0[(s_)]; } } while (0)
    PB_LD(0, 0); PB_LD(1, 1); PB_LD(2, 2);
    f32x4 S = (f32x4){0.f, 0.f, 0.f, 0.f};
#pragma unroll
    for (int s = 0; s < NSEG; ++s) {
        PB_LD(s + 3, (s + 3) & 3);
        *(f32x4*)(ss0 + (size_t)s * 16384) = S;
        XB[((s & 1) * 8 + w) * 64 + lane] = (u32x2){cvtpk_c(S[0], S[1]), cvtpk_c(S[2], S[3])};
        DNS_BAR();
        f32x4 acc = S * cp[s & 3] + bt[s & 3];
#pragma unroll
        for (int kb = 0; kb < 4; ++kb) { const u32x2 lo = XB[((s & 1) * 8 + 2 * kb) * 64 + lane], hi = XB[((s & 1) * 8 + 2 * kb + 1) * 64 + lane];
            acc = __builtin_amdgcn_mfma_f32_16x16x32_bf16(__builtin_bit_cast(bf16x8, rf[s & 3][kb]), __builtin_bit_cast(bf16x8, (u32x4){lo.x, lo.y, hi.x, hi.y}), acc, 0, 0, 0); }
        S = acc;
    }
#undef PB_LD
    float* so = p.out + O_PSSM + (size_t)bh * 128 * 128 + vs * 16 + r16;
#pragma unroll
    for (int i = 0; i < 4; ++i) so[(size_t)(16 * w + 4 * g4 + i) * 128] = S[i];
    DNS_BAR();
}
__device__ __forceinline__ void phase_dns_passC(const P& p, LAS unsigned char* lds) {
    const int tid = otid(), lane = tid & 63, wave = __builtin_amdgcn_readfirstlane(tid >> 6), r16 = lane & 15, g4 = lane >> 4, wl = wave & 3;
    for (int t = blockIdx.x; t < NBH * NSEG * 2; t += gridDim.x) {
        const int vh = t & 1, seg = (t >> 1) % NSEG, bh = t / (2 * NSEG), h = bh & 3, b = bh >> 2, vs = vh * 4 + wl, n0 = seg * CSEG;
        if (wave >= 4) dns_loader<2>(p, lds, bh, n0, CSEG, vh, wl, lane);
        else {
            const float* cdp = ws_f(p, WS_DNF_CD) + (size_t)bh * NCHUNK + n0;
            const float* ss = p.out + O_SSEG + ((size_t)(bh * NSEG + seg) * 8 + vs) * 2048 + lane * 4;
            f32x4 S[8];
#pragma unroll
            for (int kt = 0; kt < 8; ++kt) S[kt] = *(const f32x4*)(ss + kt * 256);
            float cd = cdp[0];
            DNS_BAR();
            for (int n = 0; n < CSEG; ++n) {
                const float cdn = cdp[n + 1 < CSEG ? n + 1 : n];
                dn_consume(lds + (n & 1) * DN_SBUF + lane * 16, wl, S, cd, p.out + O_ODN + (size_t)(b * SEQ + (n0 + n) * 64 + 4 * g4) * 512 + h * 128 + vs * 16 + r16);
                cd = cdn;
                DNS_BAR();
            }
        }
        DNS_BAR();
    }
}
#undef DNS_BAR
constexpr size_t WS_EDGE = WS_FREE;
constexpr size_t WS_HEAD = al256(WS_EDGE + (size_t)(T / 256) * 2 * 2 * DFF * 4);
constexpr size_t WS_END = al256(WS_HEAD + (size_t)(T / 256) * 2 * 2 * DFF * 4);
constexpr int EX_OFF = 131072;
namespace pg8 {
typedef unsigned u32x2v __attribute__((ext_vector_type(2)));
__device__ __forceinline__ float dpp_shr1(float old, float src) { return __builtin_bit_cast(float, __builtin_amdgcn_update_dpp(__builtin_bit_cast(int, old), __builtin_bit_cast(int, src), 0x111, 0xf, 0xf, false)); }
__device__ __forceinline__ float dpp_shr2(float old, float src) { return __builtin_bit_cast(float, __builtin_amdgcn_update_dpp(__builtin_bit_cast(int, old), __builtin_bit_cast(int, src), 0x112, 0xf, 0xf, false)); }
__device__ __forceinline__ float dpp_ror1(float src) { return __builtin_bit_cast(float, __builtin_amdgcn_update_dpp(0, __builtin_bit_cast(int, src), 0x121, 0xf, 0xf, false)); }
__device__ __forceinline__ float dpp_ror2(float src) { return __builtin_bit_cast(float, __builtin_amdgcn_update_dpp(0, __builtin_bit_cast(int, src), 0x122, 0xf, 0xf, false)); }
struct EpiFfnUp {
    static constexpr bool PERM = false, AFTER_DRAIN = false;
    bf16_t* ACT; float* edge; float* head; const float* cw; const float* cb; const float* state; float* out_pfc; float* out_sfc; PG8_LAS unsigned char* lds;
    __device__ __forceinline__ void operator()(const f32x4 (&acc)[2][2][4][2], const Unit& u, int wr, int wc, int fr, int fq) const {
        PG8_LAS float* EX = (PG8_LAS float*)(lds + EX_OFF);
        const bool smp = u.pm >= TP / BM;
        const int cl = wc * 32 + 4 * fq;
        if (fr >= 14) {
#pragma unroll
            for (int ai = 0; ai < 2; ++ai)
#pragma unroll
                for (int bj = 0; bj < 2; ++bj)
#pragma unroll
                    for (int n = 0; n < 2; ++n) *(PG8_LAS f32x4*)(EX + ((2 * ai + wr) * 2 + (fr - 14)) * 256 + bj * HALF + cl + 16 * n) = acc[ai][bj][3][n];
            if (wr == 1) {
#pragma unroll
                for (int bj = 0; bj < 2; ++bj)
#pragma unroll
                    for (int n = 0; n < 2; ++n) { const int oc = bj * DFF + u.pn * HALF + cl + 16 * n;
                        *(f32x4*)(edge + ((size_t)u.pm * 2 + (fr - 14)) * 2 * DFF + oc) = acc[1][bj][3][n];
                        if (!smp && (u.pm & (SEQ / BM - 1)) == SEQ / BM - 1) *(f32x4*)(out_pfc + ((size_t)(u.pm / (SEQ / BM)) * 2 + (fr - 14)) * 2 * DFF + oc) = acc[1][bj][3][n]; }
            }
        }
        if (fr < 2 && wr == 0) {
#pragma unroll
            for (int bj = 0; bj < 2; ++bj)
#pragma unroll
                for (int n = 0; n < 2; ++n) *(f32x4*)(head + ((size_t)u.pm * 2 + fr) * 2 * DFF + bj * DFF + u.pn * HALF + cl + 16 * n) = acc[0][bj][0][n];
        }
        asm volatile("s_waitcnt lgkmcnt(0)" ::: "memory"); __builtin_amdgcn_s_barrier(); asm volatile("" ::: "memory");
#pragma unroll
        for (int n = 0; n < 2; ++n) {
            const int f0 = u.pn * HALF + cl + 16 * n;
            f32x4 wg[3], wu[3], bg, bu;
#pragma unroll
            for (int j = 0; j < 3; ++j) { wg[j] = *(const f32x4*)(cw + (size_t)j * 2 * DFF + f0); wu[j] = *(const f32x4*)(cw + (size_t)j * 2 * DFF + DFF + f0); }
            bg = *(const f32x4*)(cb + f0); bu = *(const f32x4*)(cb + DFF + f0);
#pragma unroll
            for (int ai = 0; ai < 2; ++ai) {
                const int s = 2 * ai + wr;
                f32x4 pg = (f32x4){0.f, 0.f, 0.f, 0.f}, pu = pg;
                if (!smp && s > 0 && fr >= 14) { pg = *(const PG8_LAS f32x4*)(EX + ((s - 1) * 2 + (fr - 14)) * 256 + cl + 16 * n); pu = *(const PG8_LAS f32x4*)(EX + ((s - 1) * 2 + (fr - 14)) * 256 + HALF + cl + 16 * n); }
#pragma unroll
                for (int m = 0; m < 4; ++m) {
                    const f32x4 cg = acc[ai][0][m][n], cu = acc[ai][1][m][n];
                    const int row = u.pm * BM + ai * HALF + wr * 64 + m * 16 + fr;
                    f32x4 g1, g2, u1, u2;
#pragma unroll
                    for (int e = 0; e < 4; ++e) { g1[e] = dpp_shr1(dpp_ror1(pg[e]), cg[e]); g2[e] = dpp_shr2(dpp_ror2(pg[e]), cg[e]); u1[e] = dpp_shr1(dpp_ror1(pu[e]), cu[e]); u2[e] = dpp_shr2(dpp_ror2(pu[e]), cu[e]); }
                    if (smp) {
                        const int t = fr & 7, b = (row - TP) >> 3;
                        if (t < 2) { const float* st = state + (size_t)b * 2 * 2 * DFF + f0; const f32x4 s1g = *(const f32x4*)(st + 2 * DFF), s1u = *(const f32x4*)(st + 2 * DFF + DFF);
                            if (t == 0) { g1 = s1g; u1 = s1u; g2 = *(const f32x4*)st; u2 = *(const f32x4*)(st + DFF); } else { g2 = s1g; u2 = s1u; } }
                        if (t >= 6) { float* o = out_sfc + ((size_t)b * 2 + (t - 6)) * 2 * DFF + f0; *(f32x4*)o = cg; *(f32x4*)(o + DFF) = cu; }
                    }
                    const f32x4 gc = wg[0] * g2 + wg[1] * g1 + wg[2] * cg + bg, uc = wu[0] * u2 + wu[1] * u1 + wu[2] * cu + bu;
                    u32x2v w;
                    { const float a0 = gc[0] / (1.0f + __expf(-gc[0])) * uc[0], a1 = gc[1] / (1.0f + __expf(-gc[1])) * uc[1], a2 = gc[2] / (1.0f + __expf(-gc[2])) * uc[2], a3 = gc[3] / (1.0f + __expf(-gc[3])) * uc[3];
                      w.x = cvt_pk_bf16(a0, a1); w.y = cvt_pk_bf16(a2, a3); }
                    *(u32x2v*)(ACT + (size_t)row * DFF + f0) = w;
                    pg = cg; pu = cu;
                }
            }
        }
    }
};
}
__device__ __forceinline__ void phase_ffn_fix(const P& p) {
    constexpr int TPS = SEQ / 256;
    const long n = (long)(BATCH * TPS) * DFF;
    const float* edge = ws_f(p, WS_EDGE); const float* head = ws_f(p, WS_HEAD);
    for (long i = blockIdx.x * (long)NTHR + otid(); i < n; i += (long)gridDim.x * NTHR) {
        const int pm = (int)(i / DFF), f = (int)(i % DFF);
        if (pm % TPS == 0) continue;
        float r0[2], r1[2];
#pragma unroll
        for (int gu = 0; gu < 2; ++gu) { const int c = gu * DFF + f;
            const float um2 = edge[((size_t)(pm - 1) * 2 + 0) * 2 * DFF + c], um1 = edge[((size_t)(pm - 1) * 2 + 1) * 2 * DFF + c], u0 = head[((size_t)pm * 2 + 0) * 2 * DFF + c], u1 = head[((size_t)pm * 2 + 1) * 2 * DFF + c];
            const float w0 = p.ffn_conv_w[c], w1 = p.ffn_conv_w[2 * DFF + c], w2 = p.ffn_conv_w[4 * DFF + c], bb = p.ffn_conv_b[c];
            r0[gu] = w0 * um2 + w1 * um1 + w2 * u0 + bb; r1[gu] = w0 * um1 + w1 * u0 + w2 * u1 + bb; }
        bf16_t* ACT = ws_h(p, WS_ACT) + (size_t)pm * 256 * DFF + f;
        ACT[0] = f2bf(silu_f(r0[0]) * r0[1]); ACT[DFF] = f2bf(silu_f(r1[0]) * r1[1]);
    }
}
constexpr int SW_KP = 72;
__device__ __forceinline__ void swa_qtile(const LAS bf16_t* KS, const LAS bf16_t* VT, int vtp, int qt, const bf16_t* qptr, int qrow_mask, const LAS float* BT, float sink, bool first, bf16_t* optr, int nvalid_q, int lane) {
    const int r16 = lane & 15, g4 = lane >> 4, kt0 = qt;
    bf16x8 bq[2];
#pragma unroll
    for (int ks = 0; ks < 2; ++ks) bq[ks] = *(const bf16x8*)(qptr + (size_t)(r16 & qrow_mask) * PLD + 32 * ks + 8 * g4);
    f32x4 s[10];
#pragma unroll
    for (int t = 0; t < 9; ++t) { f32x4 a = (f32x4){0.f, 0.f, 0.f, 0.f};
#pragma unroll
        for (int ks = 0; ks < 2; ++ks) a = __builtin_amdgcn_mfma_f32_16x16x32_bf16(*(const LAS bf16x8*)(KS + (16 * (kt0 + t) + r16) * SW_KP + 32 * ks + 8 * g4), bq[ks], a, 0, 0, 0);
        s[t] = a; }
    float mx = sink;
#pragma unroll
    for (int t = 0; t < 9; ++t)
#pragma unroll
        for (int e = 0; e < 4; ++e) { const int jj = 16 * (kt0 + t) + 4 * g4 + e, d = 128 + 16 * qt + r16 - jj; const bool ok = d >= 0 && d <= 127 && !(first && jj < 128);
            const float v = ok ? s[t][e] * 0.125f + BT[ok ? d : 0] : -1e30f; s[t][e] = v; mx = fmaxf(mx, v); }
    mx = fmaxf(mx, __shfl_xor(mx, 16)); mx = fmaxf(mx, __shfl_xor(mx, 32));
    float l = 0.f;
#pragma unroll
    for (int t = 0; t < 9; ++t)
#pragma unroll
        for (int e = 0; e < 4; ++e) { const float pv = __expf(s[t][e] - mx); s[t][e] = pv; l += pv; }
    s[9] = (f32x4){0.f, 0.f, 0.f, 0.f};
    l += __shfl_xor(l, 16); l += __shfl_xor(l, 32);
    l += __expf(sink - mx);
    const float rl = 1.0f / l;
    bf16x8 pb[5];
#pragma unroll
    for (int q = 0; q < 5; ++q) pb[q] = pack8(s[2 * q], s[2 * q + 1]);
#pragma unroll
    for (int dt = 0; dt < 4; ++dt) { f32x4 o = (f32x4){0.f, 0.f, 0.f, 0.f};
#pragma unroll
        for (int q = 0; q < 5; ++q) { const LAS bf16_t* vp = VT + (16 * dt + r16) * vtp + 16 * (kt0 + 2 * q) + 4 * g4;
            const u32x2 lo = *(const LAS u32x2*)vp, hi = *(const LAS u32x2*)(vp + 16);
            o = __builtin_amdgcn_mfma_f32_16x16x32_bf16(__builtin_bit_cast(bf16x8, (u32x4){lo.x, lo.y, hi.x, hi.y}), pb[q], o, 0, 0, 0); }
        if (r16 < nvalid_q) *(u32x2*)(optr + (size_t)r16 * 1024 + 16 * dt + 4 * g4) = (u32x2){cvtpk_c(o[0] * rl, o[1] * rl), cvtpk_c(o[2] * rl, o[3] * rl)}; }
}
constexpr int SWP_VTP = 272, SWS_NK = 144, SWS_VTP = 168;
constexpr int SW_KS = 0, SW_VT = 43008, SW_BT = 86016, SW_END = SW_BT + 8 * 128 * 4;
static_assert(256 * SW_KP * 2 <= SW_VT && SW_VT + 64 * SWP_VTP * 2 <= SW_BT && 2 * SWS_NK * SW_KP * 2 <= SW_VT && SW_VT + 2 * 64 * SWS_VTP * 2 <= SW_BT, "swa LDS map");
__device__ __forceinline__ void phase_swa(const P& p, LAS unsigned char* lds) {
    const int tid = otid(), lane = tid & 63, wave = tid >> 6;
    LAS bf16_t* KS = (LAS bf16_t*)(lds + SW_KS); LAS bf16_t* VT = (LAS bf16_t*)(lds + SW_VT); LAS float* BT = (LAS float*)(lds + SW_BT);
    const bf16_t* PR = ws_h(p, WS_PROJ); bf16_t* MX = ws_h(p, WS_MIX);
    constexpr int NQB = SEQ / 128, NPU = BATCH * NQB * 2, NU = NPU + DEC_BATCH;
    for (int i = tid; i < 8 * 128; i += NTHR) BT[i] = p.rel_bias[t5_bucket(i & 127) * 8 + (i >> 7)];
    for (int u = blockIdx.x; u < NU; u += gridDim.x) {
        __syncthreads();
        if (u < NPU) {
            const int kvh = u & 1, qb = (u >> 1) % NQB, b = (u >> 1) / NQB, m0 = b * SEQ + qb * 128; const bool first = qb == 0;
            for (int it = tid; it < 256 * 8; it += NTHR) { const int jj = it >> 3, c = it & 7; u32x4 v = (u32x4){0u, 0u, 0u, 0u};
                if (!(first && jj < 128)) v = *(const u32x4*)(PR + (size_t)(m0 - 128 + jj) * PLD + PC_SK + kvh * 64 + 8 * c);
                *(LAS u32x4*)(KS + jj * SW_KP + 8 * c) = v; }
            for (int it = tid; it < 272 * 8; it += NTHR) { const int jj = it % 272, c = it / 272; u32x4 v = (u32x4){0u, 0u, 0u, 0u};
                if (jj < 256 && !(first && jj < 128)) v = *(const u32x4*)(PR + (size_t)(m0 - 128 + jj) * PLD + PC_SV + kvh * 64 + 8 * c);
                const unsigned w[4] = {v.x, v.y, v.z, v.w};
#pragma unroll
                for (int e = 0; e < 4; ++e) { VT[(8 * c + 2 * e) * SWP_VTP + jj] = (bf16_t)(w[e] & 0xffffu); VT[(8 * c + 2 * e + 1) * SWP_VTP + jj] = (bf16_t)(w[e] >> 16); } }
            __syncthreads();
            const int hq = kvh * 4 + (wave >> 1), qh = wave & 1;
#pragma unroll 1
            for (int q4 = 0; q4 < 4; ++q4) { const int qt = 4 * qh + q4;
                swa_qtile(KS, VT, SWP_VTP, qt, PR + (size_t)(m0 + 16 * qt) * PLD + PC_SQ + hq * 64, 15, BT + hq * 128, p.swa_sinks[hq], first, MX + (size_t)(m0 + 16 * qt) * 1024 + 512 + hq * 64, 16, lane); }
        } else {
            const int b = u - NPU, m0 = TP + b * DEC_SEQ;
            for (int it = tid; it < 2 * SWS_NK * 8; it += NTHR) { const int kvh = it / (SWS_NK * 8), r = it % (SWS_NK * 8), jj = r >> 3, c = r & 7; u32x4 v = (u32x4){0u, 0u, 0u, 0u};
                if (jj < 128) { const float* src = p.cache_k + ((size_t)b * 128 + jj) * 128 + kvh * 64 + 8 * c; const f32x4 a = *(const f32x4*)src, d = *(const f32x4*)(src + 4);
                    v = (u32x4){pk2(a[0], a[1]), pk2(a[2], a[3]), pk2(d[0], d[1]), pk2(d[2], d[3])}; }
                else if (jj < 128 + DEC_SEQ) v = *(const u32x4*)(PR + (size_t)(m0 + jj - 128) * PLD + PC_SK + kvh * 64 + 8 * c);
                *(LAS u32x4*)(KS + (kvh * SWS_NK + jj) * SW_KP + 8 * c) = v; }
            for (int it = tid; it < 2 * SWS_VTP * 8; it += NTHR) { const int kvh = it / (SWS_VTP * 8), r = it % (SWS_VTP * 8), jj = r % SWS_VTP, c = r / SWS_VTP; float f[8];
#pragma unroll
                for (int e = 0; e < 8; ++e) f[e] = 0.f;
                if (jj < 128) { const float* src = p.cache_v + ((size_t)b * 128 + jj) * 128 + kvh * 64 + 8 * c; const f32x4 a = *(const f32x4*)src, d = *(const f32x4*)(src + 4);
                    f[0] = a[0]; f[1] = a[1]; f[2] = a[2]; f[3] = a[3]; f[4] = d[0]; f[5] = d[1]; f[6] = d[2]; f[7] = d[3]; }
                else if (jj < 128 + DEC_SEQ) { const bf16_t* src = PR + (size_t)(m0 + jj - 128) * PLD + PC_SV + kvh * 64 + 8 * c;
#pragma unroll
                    for (int e = 0; e < 8; ++e) f[e] = bf2f(src[e]); }
#pragma unroll
                for (int e = 0; e < 8; ++e) VT[(kvh * 64 + 8 * c + e) * SWS_VTP + jj] = f2bf(f[e]); }
            __syncthreads();
            const int kvh = wave >> 2, hq = kvh * 4 + (wave & 3);
            swa_qtile(KS + kvh * SWS_NK * SW_KP, VT + kvh * 64 * SWS_VTP, SWS_VTP, 0, PR + (size_t)m0 * PLD + PC_SQ + hq * 64, 7, BT + hq * 128, p.swa_sinks[hq], false, MX + (size_t)m0 * 1024 + 512 + hq * 64, 8, lane);
        }
    }
    __syncthreads();
}
static void fill_params(P& p, void* const* d_in, void* d_out, void* d_ws) {
    const float** pp = (const float**)&p;
    for (int i = 0; i < 26; ++i) pp[i] = (const float*)d_in[i];
    p.out = (float*)d_out; p.ws = (unsigned char*)d_ws;
}
namespace cg = cooperative_groups;
constexpr int CW_BAR = 1024;
constexpr size_t CTL_ZERO_BYTES = 65536;

#ifndef PROBE_MASK
#define PROBE_MASK 0
#endif
#ifndef PROBE_K
#define PROBE_K 4
#endif
#ifndef PROBE_XSYNC
#define PROBE_XSYNC 0
#endif
#if PROBE_MASK
#define PROBE_SUB(k) do { xcd_barrier(bar); PROBE_STAMP(k); } while (0)
#define PROBE_DECL unsigned long long pr_prev = __builtin_amdgcn_s_memrealtime(), pr_acc = 0ull
#define PROBE_STAMP(k) do { const unsigned long long now_ = __builtin_amdgcn_s_memrealtime(); if ((PROBE_MASK >> (k)) & 1) pr_acc += now_ - pr_prev; pr_prev = now_; } while (0)
#define PROBE_END() do { xcd_barrier(bar); PROBE_STAMP(11); if (blockIdx.x == 0 && threadIdx.x == 0) { const unsigned long long t0_ = __builtin_amdgcn_s_memrealtime(); while (__builtin_amdgcn_s_memrealtime() - t0_ < (unsigned long long)PROBE_K * pr_acc) __builtin_amdgcn_s_sleep(8); } } while (0)
#else
#define PROBE_DECL unsigned long long pr_prev = 0ull, pr_acc = 0ull
#define PROBE_SUB(k)
#define PROBE_STAMP(k)
#define PROBE_END() do { for (int i_ = 0; i_ < PROBE_XSYNC; ++i_) xcd_barrier(bar); } while (0)
#endif
__global__ void __launch_bounds__(512, 2) fwd_megakernel(P p) {
    extern __shared__ __attribute__((aligned(16))) unsigned char lds_raw[];
    LAS unsigned char* lds = (LAS unsigned char*)lds_raw;
    cg::grid_group grid = cg::this_grid();
    PROBE_DECL;
    volatile LAS unsigned* MISC = (volatile LAS unsigned*)(lds + LDS_BYTES - 64);
    if (threadIdx.x < 16) MISC[threadIdx.x] = 0u;
    __syncthreads();
    const XcdBarrier bar = xcd_barrier_post((unsigned*)(p.ws + WS_CTL) + CW_BAR, MISC);
    phase_mod(p, lds); phase_transposes(p, lds);
    if (p.ws == nullptr) grid.sync();
    xcd_barrier(bar); PROBE_STAMP(0);
    phase_norm<0>(p);
    xcd_barrier(bar); PROBE_STAMP(1);
    { pg8::StaticOrder S; pg8::Gemm g{ws_h(p, WS_H), ws_h(p, WS_WT_IN), T, PLD, D}; S.init(T, PLD, gridDim.x, blockIdx.x); pg8::EpiStoreBf16 E{ws_h(p, WS_PROJ), PLD};
      pg8::gemm_phase<pg8::EpiStoreBf16, pg8::StaticOrder, true, true>(lds, g, S, E); }
    xcd_barrier(bar); PROBE_STAMP(2);
    phase_state_out(p);
    PROBE_STAMP(21);
    phase_dnprep(p, lds, pr_prev, pr_acc);
    PROBE_SUB(12);
    phase_dnsample(p, lds);
    PROBE_SUB(13);
    phase_swa(p, lds);
    xcd_barrier(bar); PROBE_STAMP(3);
    phase_dns_passA(p, lds);
    xcd_barrier(bar); PROBE_STAMP(14);
    phase_dns_passB(p, lds);
    xcd_barrier(bar); PROBE_STAMP(15);
    phase_dns_passC(p, lds);
    xcd_barrier(bar); PROBE_STAMP(4);
    phase_dngate(p);
    xcd_barrier(bar); PROBE_STAMP(5);
    { pg8::StaticOrder S; pg8::Gemm g{ws_h(p, WS_MIX), ws_h(p, WS_WT_OUT), T, D, 1024}; S.init(T, D, gridDim.x, blockIdx.x); pg8::EpiGateRes E{p.x_prompt, p.x_sample, p.out + O_Y, ws_f(p, WS_MOD) + 2 * D};
      pg8::gemm_phase<pg8::EpiGateRes, pg8::StaticOrder, true, true>(lds, g, S, E); }
    xcd_barrier(bar); PROBE_STAMP(6);
    phase_norm<1>(p);
    xcd_barrier(bar); PROBE_STAMP(7);
    { pg8::StaticOrder S; pg8::Gemm g{ws_h(p, WS_H), ws_h(p, WS_WT_UP), T, 2 * DFF, D}; S.init(T, 2 * DFF, gridDim.x, blockIdx.x);
      pg8::EpiFfnUp E{ws_h(p, WS_ACT), ws_f(p, WS_EDGE), ws_f(p, WS_HEAD), p.ffn_conv_w, p.ffn_conv_b, p.state_ffn, p.out + O_PFC, p.out + O_SFC, lds};
      pg8::gemm_phase<pg8::EpiFfnUp, pg8::StaticOrder, true, true>(lds, g, S, E); }
    xcd_barrier(bar); PROBE_STAMP(8);
    phase_ffn_fix(p);
    xcd_barrier(bar); PROBE_STAMP(9);
    { pg8::StaticOrder S; pg8::Gemm g{ws_h(p, WS_ACT), ws_h(p, WS_WT_DN), T, D, DFF}; S.init(T, D, gridDim.x, blockIdx.x); pg8::EpiGateRes E{p.out + O_Y, p.out + O_Y + (size_t)TP * D, p.out + O_Y, ws_f(p, WS_MOD) + 5 * D};
      pg8::gemm_phase<pg8::EpiGateRes, pg8::StaticOrder, true, true>(lds, g, S, E); }
    xcd_barrier(bar); PROBE_STAMP(10);
    phase_norm<2>(p);
    PROBE_END();
}
extern "C" void kernel_launch(void* const* d_in, const int* in_sizes, int n_in, void* d_out, int out_size, void* d_ws, size_t ws_size, hipStream_t stream) {
    static int grid_blocks = 0;
    if (grid_blocks == 0) {
        if (n_in != 26 || (long)out_size != O_END || ws_size < WS_END) { fprintf(stderr, "kernel_launch: unexpected shapes n_in=%d out=%d ws=%zu (need %zu)\n", n_in, out_size, ws_size, (size_t)WS_END); grid_blocks = -1; return; }
        int dev = 0, cus = 0, per_cu = 0;
        if (hipGetDevice(&dev) != hipSuccess || hipDeviceGetAttribute(&cus, hipDeviceAttributeMultiprocessorCount, dev) != hipSuccess) { grid_blocks = -1; return; }
        if (hipFuncSetAttribute((const void*)fwd_megakernel, hipFuncAttributeMaxDynamicSharedMemorySize, LDS_BYTES) != hipSuccess) { fprintf(stderr, "kernel_launch: hipFuncSetAttribute failed\n"); grid_blocks = -1; return; }
        if (hipOccupancyMaxActiveBlocksPerMultiprocessor(&per_cu, (const void*)fwd_megakernel, NTHR, LDS_BYTES) != hipSuccess || per_cu < 1) { fprintf(stderr, "kernel_launch: occupancy query says %d\n", per_cu); grid_blocks = -1; return; }
        grid_blocks = cus;
        fprintf(stderr, "kernel_launch: grid %d (cus %d, per_cu %d)\n", grid_blocks, cus, per_cu);
    }
    if (grid_blocks < 0) return;
    P p{}; fill_params(p, d_in, d_out, d_ws);
    if (hipMemsetAsync((char*)d_ws + WS_CTL, 0, CTL_ZERO_BYTES, stream) != hipSuccess) { fprintf(stderr, "kernel_launch: memset of the control words failed\n"); return; }
    void* args[] = {&p};
    const hipError_t e = hipLaunchCooperativeKernel((const void*)fwd_megakernel, dim3(grid_blocks), dim3(NTHR), args, LDS_BYTES, stream);
    if (e != hipSuccess) fprintf(stderr, "cooperative launch failed: %s (grid %d)\n", hipGetErrorString(e), grid_blocks);
}
```

```cpp
#define PROBE_MASK 0
#define PROBE_XSYNC 0
#include <hip/hip_runtime.h>
#include <hip/hip_cooperative_groups.h>
#include <cstdio>
#include <cstdint>
#define HD __device__ __forceinline__
#if defined(PROBE_MASK) && PROBE_MASK
#define DPS(k) do { const unsigned long long now_ = __builtin_amdgcn_s_memrealtime(); if ((PROBE_MASK >> (k)) & 1) pr_acc += now_ - pr_prev; pr_prev = now_; } while (0)
#endif
#ifndef CFG_D_MODEL
#define CFG_D_MODEL 1024
#endif
#ifndef CFG_SEQ
#define CFG_SEQ 8192
#endif
#ifndef CFG_DEC_BATCH
#define CFG_DEC_BATCH 128
#endif
#ifndef CFG_D_FF
#define CFG_D_FF 2816
#endif

constexpr int D = CFG_D_MODEL, BATCH = 2, SEQ = CFG_SEQ, DEC_BATCH = CFG_DEC_BATCH, DEC_SEQ = 8, DFF = CFG_D_FF;
constexpr int TP = BATCH * SEQ, TS = DEC_BATCH * DEC_SEQ, T = TP + TS, NCB = BATCH + DEC_BATCH;
constexpr int IN_COLS = 2824, PLD = 2816;
constexpr int PC_QKV = 0, PC_Z = 1536, PC_SQ = 2048, PC_SK = 2560, PC_SV = 2688;
constexpr int WC_BA = 2048;
constexpr float EPS = 1e-6f;

constexpr long O_Y = 0;
constexpr long O_PDC = (long)T * D;
constexpr long O_SDC = O_PDC + (long)BATCH * 3 * 1536;
constexpr long O_PSSM = O_SDC + (long)DEC_BATCH * 3 * 1536;
constexpr long O_SSSM = O_PSSM + (long)BATCH * 4 * 128 * 128;
constexpr long O_PK = O_SSSM + (long)DEC_BATCH * 4 * 128 * 128;
constexpr long O_SK = O_PK + (long)BATCH * 128 * 128;
constexpr long O_PV = O_SK + (long)DEC_BATCH * 128 * 128;
constexpr long O_SV = O_PV + (long)BATCH * 128 * 128;
constexpr long O_PFC = O_SV + (long)DEC_BATCH * 128 * 128;
constexpr long O_SFC = O_PFC + (long)BATCH * 2 * 2 * DFF;
constexpr long O_END = O_SFC + (long)DEC_BATCH * 2 * 2 * DFF;

constexpr size_t al256(size_t x) { return (x + 255) & ~(size_t)255; }
constexpr size_t WS_CTL = 0;
constexpr size_t WS_MOD = 1u << 20;
constexpr size_t WS_BG = al256(WS_MOD + (size_t)NCB * 6 * D * 4);
constexpr size_t WS_WBAT = al256(WS_BG + (size_t)T * 8 * 4);
constexpr size_t WS_WT_IN = al256(WS_WBAT + (size_t)8 * D * 4);
constexpr size_t WS_WT_OUT = al256(WS_WT_IN + (size_t)PLD * D * 2);
constexpr size_t WS_WT_UP = al256(WS_WT_OUT + (size_t)D * 1024 * 2);
constexpr size_t WS_WT_DN = al256(WS_WT_UP + (size_t)2 * DFF * D * 2);
constexpr size_t WS_H = al256(WS_WT_DN + (size_t)D * DFF * 2);
constexpr int NCHUNK = SEQ / 64, NUNIT = BATCH * 4 * NCHUNK;
constexpr int DNF_AB_UNIT = 57344, DNF_WV_UNIT = 32768;
constexpr size_t WS_DNF_WV = WS_H;
constexpr size_t WS_DNF_AB = al256(WS_H + (size_t)T * (D > 1024 ? D : 1024) * 2);
constexpr size_t WS_DNF_CD = al256(WS_DNF_AB + (size_t)NUNIT * DNF_AB_UNIT);
constexpr size_t WS_QKVC = WS_DNF_AB;
constexpr size_t WS_PROJ = al256((WS_DNF_CD + (size_t)NUNIT * 4) > (WS_QKVC + (size_t)T * 1536 * 2) ? (WS_DNF_CD + (size_t)NUNIT * 4) : (WS_QKVC + (size_t)T * 1536 * 2));
constexpr size_t WS_MIX = al256(WS_PROJ + (size_t)T * PLD * 2);
constexpr size_t WS_FREE = al256(WS_MIX + (size_t)T * 1024 * 2);
constexpr size_t WS_ODN = WS_H, WS_ACT = WS_PROJ;
static_assert((size_t)NUNIT * DNF_WV_UNIT <= (size_t)T * 1024 * 2, "Wv tiles overlay H");

typedef unsigned short bf16_t;
HD unsigned f2bf_bits(float f) { unsigned u = __builtin_bit_cast(unsigned, f); return (u + 0x7fffu + ((u >> 16) & 1u)) >> 16; }
HD bf16_t f2bf(float f) { return (bf16_t)f2bf_bits(f); }
HD float bf2f(bf16_t b) { return __builtin_bit_cast(float, (unsigned)b << 16); }
HD float silu_f(float x) { return x / (1.0f + expf(-x)); }
HD float sigmoid_f(float x) { return 1.0f / (1.0f + expf(-x)); }
HD float softplus_f(float x) { return x > 20.f ? x : log1pf(expf(x)); }

struct P {
    const float *x_prompt, *x_sample, *state_dn_conv, *state_dn_ssm, *cache_k, *cache_v, *state_ffn, *c_prompt, *c_sample, *rel_bias,
        *final_norm_w, *w_ada, *b_ada, *norm_mix_w, *w_in, *dn_conv_w, *dn_A_log, *dn_dt_bias, *dn_norm_w, *swa_sinks, *w_out, *norm_ffn_w,
        *w_up, *ffn_conv_w, *ffn_conv_b, *w_down;
    float* out; unsigned char* ws;
};

HD const float* xrow(const P& p, int m) { return m < TP ? p.x_prompt + (size_t)m * D : p.x_sample + (size_t)(m - TP) * D; }
HD int cb_of(int m) { return m < TP ? m / SEQ : BATCH + (m - TP) / DEC_SEQ; }
HD int t_of(int m) { return m < TP ? m % SEQ : (m - TP) % DEC_SEQ; }
HD float* ws_f(const P& p, size_t off) { return (float*)(p.ws + off); }
HD bf16_t* ws_h(const P& p, size_t off) { return (bf16_t*)(p.ws + off); }

HD int t5_bucket(int d) {
    if (d < 16) return d;
    const float logv = logf((float)d / 16.0f) / 2.0794415416798357f;
    int b = 16 + (int)(logv * 16.0f);
    return b < 31 ? b : 31;
}

constexpr long N_R0A = (long)NCB * 6 * D;
HD void r0a_body(long idx, const P& p) {
    const int cb = (int)(idx / (6 * D)), e = (int)(idx % (6 * D));
    const float* c = cb < BATCH ? p.c_prompt + (size_t)cb * D : p.c_sample + (size_t)(cb - BATCH) * D;
    float acc = 0.f;
    for (int d = 0; d < D; ++d) acc += silu_f(c[d]) * p.w_ada[(size_t)d * 6 * D + e];
    ws_f(p, WS_MOD)[idx] = acc + p.b_ada[e];
}
constexpr long N_R1 = T;
template <int WHICH> HD void r1_body(long idx, const P& p) {
    const int m = (int)idx, cb = cb_of(m);
    const float* xr = WHICH == 0 ? xrow(p, m) : p.out + O_Y + (size_t)m * D;
    const float* nw = WHICH == 0 ? p.norm_mix_w : p.norm_ffn_w;
    const float* mod = ws_f(p, WS_MOD) + (size_t)cb * 6 * D;
    const float* sh = mod + (WHICH == 0 ? 0 : 3 * D); const float* sc = mod + (WHICH == 0 ? D : 4 * D);
    float ss = 0.f;
    for (int k = 0; k < D; ++k) ss += xr[k] * xr[k];
    const float rstd = 1.0f / sqrtf(ss / (float)D + EPS);
    float ba[8];
#pragma unroll
    for (int j = 0; j < 8; ++j) ba[j] = 0.f;
    bf16_t* H = ws_h(p, WS_H) + (size_t)m * D;
    for (int k = 0; k < D; ++k) {
        const float h = xr[k] * rstd * nw[k] * (1.0f + sc[k]) + sh[k];
        H[k] = f2bf(h);
        if (WHICH == 0) {
#pragma unroll
            for (int j = 0; j < 8; ++j) ba[j] += h * p.w_in[(size_t)k * IN_COLS + WC_BA + j];
        }
    }
    if (WHICH == 0) {
        float* bg = ws_f(p, WS_BG) + (size_t)m * 8;
#pragma unroll
        for (int j = 0; j < 4; ++j) {
            bg[j] = sigmoid_f(ba[j]);
            bg[4 + j] = -expf(p.dn_A_log[j]) * softplus_f(ba[4 + j] + p.dn_dt_bias[j]);
        }
    }
}
constexpr long N_R2 = (long)(T / 8) * PLD;
HD void r2_body(long idx, const P& p) {
    const int mg = (int)(idx / PLD), n = (int)(idx % PLD), oc = n < WC_BA ? n : n + 8;
    const bf16_t* H = ws_h(p, WS_H) + (size_t)mg * 8 * D;
    float acc[8];
#pragma unroll
    for (int i = 0; i < 8; ++i) acc[i] = 0.f;
    for (int k = 0; k < D; ++k) {
        const float w = bf2f(f2bf(p.w_in[(size_t)k * IN_COLS + oc]));
#pragma unroll
        for (int i = 0; i < 8; ++i) acc[i] += bf2f(H[(size_t)i * D + k]) * w;
    }
    bf16_t* PR = ws_h(p, WS_PROJ);
#pragma unroll
    for (int i = 0; i < 8; ++i) PR[(size_t)(mg * 8 + i) * PLD + n] = f2bf(acc[i]);
}
constexpr long N_R2B_1 = (long)BATCH * 3 * 1536, N_R2B_2 = (long)DEC_BATCH * 3 * 1536, N_R2B_3 = (long)BATCH * 128 * 128, N_R2B_4 = (long)DEC_BATCH * 128 * 128;
constexpr long N_R2B = N_R2B_1 + N_R2B_2 + 2 * (N_R2B_3 + N_R2B_4);
HD void r2b_body(long idx, const P& p) {
    const bf16_t* PR = ws_h(p, WS_PROJ);
    long r = idx;
    if (r < N_R2B_1) { const int b = (int)(r / (3 * 1536)), j = (int)(r / 1536 % 3), c = (int)(r % 1536);
        p.out[O_PDC + r] = bf2f(PR[(size_t)(b * SEQ + SEQ - 3 + j) * PLD + PC_QKV + c]); return; }
    r -= N_R2B_1;
    if (r < N_R2B_2) { const int b = (int)(r / (3 * 1536)), j = (int)(r / 1536 % 3), c = (int)(r % 1536);
        p.out[O_SDC + r] = bf2f(PR[(size_t)(TP + b * DEC_SEQ + DEC_SEQ - 3 + j) * PLD + PC_QKV + c]); return; }
    r -= N_R2B_2;
    for (int kv = 0; kv < 2; ++kv) {
        const int pc = kv == 0 ? PC_SK : PC_SV; const float* cache = kv == 0 ? p.cache_k : p.cache_v;
        if (r < N_R2B_3) { const int b = (int)(r / (128 * 128)), j = (int)(r / 128 % 128), c = (int)(r % 128);
            p.out[(kv == 0 ? O_PK : O_PV) + r] = bf2f(PR[(size_t)(b * SEQ + SEQ - 128 + j) * PLD + pc + c]); return; }
        r -= N_R2B_3;
        if (r < N_R2B_4) { const int b = (int)(r / (128 * 128)), j = (int)(r / 128 % 128), c = (int)(r % 128);
            float v;
            if (j < 128 - DEC_SEQ) v = cache[((size_t)b * 128 + j + DEC_SEQ) * 128 + c];
            else v = bf2f(PR[(size_t)(TP + b * DEC_SEQ + (j - (128 - DEC_SEQ))) * PLD + pc + c]);
            p.out[(kv == 0 ? O_SK : O_SV) + r] = v; return; }
        r -= N_R2B_4;
    }
}
constexpr long N_R3 = (long)T * 12;
HD float r3_conv(const P& p, int m, int t, int ch) {
    const bf16_t* PR = ws_h(p, WS_PROJ);
    float acc = 0.f;
#pragma unroll
    for (int j = 0; j < 4; ++j) {
        const int tt = t - 3 + j; float xv;
        if (tt >= 0) xv = bf2f(PR[(size_t)(m - (t - tt)) * PLD + PC_QKV + ch]);
        else xv = m < TP ? 0.f : p.state_dn_conv[((size_t)((m - TP) / DEC_SEQ) * 3 + (3 + tt)) * 1536 + ch];
        acc += p.dn_conv_w[j * 1536 + ch] * xv;
    }
    return silu_f(acc);
}
HD void r3_body(long idx, const P& p) {
    const int m = (int)(idx / 12), grp = (int)(idx % 12), part = grp / 4, cbase = grp * 128, t = t_of(m);
    float scale = 1.f;
    if (part < 2) {
        float ss = 0.f;
        for (int c = 0; c < 128; ++c) { const float v = r3_conv(p, m, t, cbase + c); ss += v * v; }
        scale = 1.0f / sqrtf(ss + EPS);
        if (part == 0) scale *= 0.08838834764831845f;
    }
    bf16_t* Q = ws_h(p, WS_QKVC) + (size_t)m * 1536 + cbase;
    for (int c = 0; c < 128; ++c) Q[c] = f2bf(r3_conv(p, m, t, cbase + c) * scale);
}
constexpr long N_R4 = (long)NCB * 4 * 128;
HD void r4_body(long idx, const P& p) {
    const int seq = (int)(idx / 512), h = (int)(idx / 128 % 4), v = (int)(idx % 128);
    const bool smp = seq >= BATCH; const int b = smp ? seq - BATCH : seq;
    float* S = p.out + (smp ? O_SSSM : O_PSSM) + ((size_t)b * 4 + h) * 128 * 128 + v;
    const float* S0 = smp ? p.state_dn_ssm + ((size_t)b * 4 + h) * 128 * 128 + v : nullptr;
    for (int k = 0; k < 128; ++k) S[(size_t)k * 128] = smp ? S0[(size_t)k * 128] : 0.f;
    const int L = smp ? DEC_SEQ : SEQ, m0 = smp ? TP + b * DEC_SEQ : b * SEQ;
    const bf16_t* QK = ws_h(p, WS_QKVC); const float* BG = ws_f(p, WS_BG); float* ODN = ws_f(p, WS_ODN);
    for (int t = 0; t < L; ++t) {
        const int m = m0 + t;
        const bf16_t* q = QK + (size_t)m * 1536 + h * 128; const bf16_t* kk = q + 512; const float vv = bf2f(q[1024 + v]);
        const float beta = BG[(size_t)m * 8 + h], eg = expf(BG[(size_t)m * 8 + 4 + h]);
        float kS = 0.f;
        for (int k = 0; k < 128; ++k) kS += bf2f(kk[k]) * (S[(size_t)k * 128] * eg);
        const float u = beta * (vv - kS);
        float o = 0.f;
        for (int k = 0; k < 128; ++k) { const float s = S[(size_t)k * 128] * eg + bf2f(kk[k]) * u; S[(size_t)k * 128] = s; o += bf2f(q[k]) * s; }
        ODN[(size_t)m * 512 + h * 128 + v] = o;
    }
}
constexpr long N_R5 = (long)T * 4;
HD void r5_body(long idx, const P& p) {
    const int m = (int)(idx / 4), h = (int)(idx % 4);
    const float* o = ws_f(p, WS_ODN) + (size_t)m * 512 + h * 128;
    float ss = 0.f;
    for (int v = 0; v < 128; ++v) ss += o[v] * o[v];
    const float rstd = 1.0f / sqrtf(ss / 128.0f + EPS);
    const bf16_t* z = ws_h(p, WS_PROJ) + (size_t)m * PLD + PC_Z + h * 128;
    bf16_t* mix = ws_h(p, WS_MIX) + (size_t)m * 1024 + h * 128;
    for (int v = 0; v < 128; ++v) mix[v] = f2bf(o[v] * rstd * p.dn_norm_w[v] * silu_f(bf2f(z[v])));
}
constexpr long N_R6 = (long)T * 8 * 8;
HD void r6_body(long idx, const P& p) {
    const int m = (int)(idx / 64), hq = (int)(idx / 8 % 8), dg = (int)(idx % 8), kvh = hq / 4, t = t_of(m);
    const bool smp = m >= TP; const int b = smp ? (m - TP) / DEC_SEQ : 0;
    const bf16_t* PR = ws_h(p, WS_PROJ);
    const bf16_t* q = PR + (size_t)m * PLD + PC_SQ + hq * 64;
    const float sink = p.swa_sinks[hq];
    const int nk = smp ? 128 : (t < 127 ? t + 1 : 128);
    float mx = sink;
    for (int pass = 0; pass < 2; ++pass) {
        float den = 0.f, acc[8];
#pragma unroll
        for (int i = 0; i < 8; ++i) acc[i] = 0.f;
        for (int jj = 0; jj < nk; ++jj) {
            int dist; const float* kf = nullptr; const float* vf = nullptr; const bf16_t* kb = nullptr; const bf16_t* vb = nullptr;
            if (smp) { const int j = t + 1 + jj; dist = 128 + t - j;
                if (j < 128) { kf = p.cache_k + ((size_t)b * 128 + j) * 128 + kvh * 64; vf = p.cache_v + ((size_t)b * 128 + j) * 128 + kvh * 64; }
                else { const size_t mm = (size_t)(TP + b * DEC_SEQ + (j - 128)); kb = PR + mm * PLD + PC_SK + kvh * 64; vb = PR + mm * PLD + PC_SV + kvh * 64; } }
            else { dist = nk - 1 - jj; const size_t mm = (size_t)(m - dist); kb = PR + mm * PLD + PC_SK + kvh * 64; vb = PR + mm * PLD + PC_SV + kvh * 64; }
            float s = 0.f;
            for (int d = 0; d < 64; ++d) s += bf2f(q[d]) * (kf ? kf[d] : bf2f(kb[d]));
            s = s * 0.125f + p.rel_bias[t5_bucket(dist) * 8 + hq];
            if (pass == 0) { mx = s > mx ? s : mx; }
            else { const float pr = expf(s - mx); den += pr;
#pragma unroll
                for (int i = 0; i < 8; ++i) acc[i] += pr * (vf ? vf[dg * 8 + i] : bf2f(vb[dg * 8 + i])); }
        }
        if (pass == 1) { den += expf(sink - mx); bf16_t* mix = ws_h(p, WS_MIX) + (size_t)m * 1024 + 512 + hq * 64 + dg * 8;
#pragma unroll
            for (int i = 0; i < 8; ++i) mix[i] = f2bf(acc[i] / den); }
    }
}
constexpr long N_R7 = (long)(T / 8) * D;
HD void r7_body(long idx, const P& p) {
    const int mg = (int)(idx / D), d = (int)(idx % D);
    const bf16_t* MX = ws_h(p, WS_MIX) + (size_t)mg * 8 * 1024;
    float acc[8];
#pragma unroll
    for (int i = 0; i < 8; ++i) acc[i] = 0.f;
    for (int e = 0; e < 1024; ++e) { const float w = bf2f(f2bf(p.w_out[(size_t)e * D + d]));
#pragma unroll
        for (int i = 0; i < 8; ++i) acc[i] += bf2f(MX[(size_t)i * 1024 + e]) * w; }
#pragma unroll
    for (int i = 0; i < 8; ++i) { const int m = mg * 8 + i; const float g1 = ws_f(p, WS_MOD)[(size_t)cb_of(m) * 6 * D + 2 * D + d];
        p.out[O_Y + (size_t)m * D + d] = xrow(p, m)[d] + g1 * acc[i]; }
}
constexpr long N_R9 = (long)(T / 8) * DFF;
HD void r9_body(long idx, const P& p) {
    const int mg = (int)(idx / DFF), f = (int)(idx % DFF), m0 = mg * 8, t0 = t_of(m0);
    const bool smp = m0 >= TP; const int b = smp ? (m0 - TP) / DEC_SEQ : m0 / SEQ;
    const bf16_t* H = ws_h(p, WS_H);
    float ug[10], uu[10];
#pragma unroll
    for (int i = 0; i < 10; ++i) { ug[i] = 0.f; uu[i] = 0.f; }
    const bool halo = (!smp && t0 > 0);
    for (int k = 0; k < D; ++k) {
        const float wg = bf2f(f2bf(p.w_up[(size_t)k * 2 * DFF + f])), wu = bf2f(f2bf(p.w_up[(size_t)k * 2 * DFF + DFF + f]));
#pragma unroll
        for (int i = 0; i < 10; ++i) { if (i < 2 && !halo) continue; const float h = bf2f(H[(size_t)(m0 - 2 + i) * D + k]); ug[i] += h * wg; uu[i] += h * wu; }
    }
    if (smp) {
#pragma unroll
        for (int i = 0; i < 2; ++i) { ug[i] = p.state_ffn[((size_t)b * 2 + i) * 2 * DFF + f]; uu[i] = p.state_ffn[((size_t)b * 2 + i) * 2 * DFF + DFF + f]; }
    }
    const float w0g = p.ffn_conv_w[f], w1g = p.ffn_conv_w[2 * DFF + f], w2g = p.ffn_conv_w[4 * DFF + f], bgt = p.ffn_conv_b[f];
    const float w0u = p.ffn_conv_w[DFF + f], w1u = p.ffn_conv_w[3 * DFF + f], w2u = p.ffn_conv_w[5 * DFF + f], bup = p.ffn_conv_b[DFF + f];
    bf16_t* ACT = ws_h(p, WS_ACT);
#pragma unroll
    for (int i = 0; i < 8; ++i) {
        const float gc = w0g * ug[i] + w1g * ug[i + 1] + w2g * ug[i + 2] + bgt, uc = w0u * uu[i] + w1u * uu[i + 1] + w2u * uu[i + 2] + bup;
        ACT[(size_t)(m0 + i) * DFF + f] = f2bf(silu_f(gc) * uc);
    }
    if (smp) {
#pragma unroll
        for (int j = 0; j < 2; ++j) { float* o = p.out + O_SFC + ((size_t)b * 2 + j) * 2 * DFF; o[f] = ug[8 + j]; o[DFF + f] = uu[8 + j]; }
    } else if (t0 == SEQ - 8) {
#pragma unroll
        for (int j = 0; j < 2; ++j) { float* o = p.out + O_PFC + ((size_t)b * 2 + j) * 2 * DFF; o[f] = ug[8 + j]; o[DFF + f] = uu[8 + j]; }
    }
}
constexpr long N_R10 = (long)(T / 8) * D;
HD void r10_body(long idx, const P& p) {
    const int mg = (int)(idx / D), d = (int)(idx % D);
    const bf16_t* A = ws_h(p, WS_ACT) + (size_t)mg * 8 * DFF;
    float acc[8];
#pragma unroll
    for (int i = 0; i < 8; ++i) acc[i] = 0.f;
    for (int f = 0; f < DFF; ++f) { const float w = bf2f(f2bf(p.w_down[(size_t)f * D + d]));
#pragma unroll
        for (int i = 0; i < 8; ++i) acc[i] += bf2f(A[(size_t)i * DFF + f]) * w; }
#pragma unroll
    for (int i = 0; i < 8; ++i) { const int m = mg * 8 + i; const float g2 = ws_f(p, WS_MOD)[(size_t)cb_of(m) * 6 * D + 5 * D + d];
        float* o = p.out + O_Y + (size_t)m * D + d; *o = *o + g2 * acc[i]; }
}
constexpr long N_R11 = T, N_R8 = T;
HD void r11_body(long idx, const P& p) {
    float* xr = p.out + O_Y + (size_t)idx * D;
    float ss = 0.f;
    for (int k = 0; k < D; ++k) ss += xr[k] * xr[k];
    const float rstd = 1.0f / sqrtf(ss / (float)D + EPS);
    for (int k = 0; k < D; ++k) xr[k] = xr[k] * rstd * p.final_norm_w[k];
}
#define LAS __attribute__((address_space(3)))
typedef float f32x4 __attribute__((ext_vector_type(4)));
typedef unsigned u32x4 __attribute__((ext_vector_type(4)));
typedef unsigned u32x2 __attribute__((ext_vector_type(2)));
constexpr int NWAVES = 8, NTHR = 512;
constexpr int LDS_BYTES = 163840;
__device__ __forceinline__ int otid() { int t = threadIdx.x; asm volatile("" : "+v"(t)); return t; }
__device__ __forceinline__ float wave_sum(float v) {
#pragma unroll
    for (int o = 1; o < 64; o <<= 1) v += __shfl_xor(v, o);
    return v;
}
__device__ __forceinline__ unsigned pk2(float lo, float hi) { return f2bf_bits(lo) | (f2bf_bits(hi) << 16); }

__device__ __forceinline__ void transpose_item(const float* W, int ldw, int K, bf16_t* WT, int dst_n0, int src_n0, int k0, LAS float* scr, int lane) {
#pragma unroll
    for (int i = 0; i < 32; ++i) { const int kk = 2 * i + (lane >> 5); scr[kk * 33 + (lane & 31)] = W[(size_t)(k0 + kk) * ldw + src_n0 + (lane & 31)]; }
    asm volatile("s_waitcnt lgkmcnt(0)" ::: "memory");
    const int c = lane & 7;
#pragma unroll
    for (int j = 0; j < 4; ++j) { const int n = (lane >> 3) + 8 * j; const LAS float* s = scr + (8 * c) * 33 + n;
        u32x4 o; o.x = pk2(s[0 * 33], s[1 * 33]); o.y = pk2(s[2 * 33], s[3 * 33]); o.z = pk2(s[4 * 33], s[5 * 33]); o.w = pk2(s[6 * 33], s[7 * 33]);
        *(u32x4*)(WT + (size_t)(dst_n0 + n) * K + k0 + 8 * c) = o; }
    asm volatile("s_waitcnt lgkmcnt(0)" ::: "memory");
}
constexpr int TI_IN = (PLD / 32) * (D / 64), TI_OUT = (D / 32) * (1024 / 64), TI_UP = (2 * DFF / 32) * (D / 64), TI_DN = (D / 32) * (DFF / 64), TI_ALL = TI_IN + TI_OUT + TI_UP + TI_DN;
__device__ __forceinline__ void phase_transposes(const P& p, LAS unsigned char* lds) {
    const int tid_ = otid(), lane = tid_ & 63, wave = tid_ >> 6;
    if (blockIdx.x == gridDim.x - 1) { for (int i = tid_; i < 8 * D; i += NTHR) ws_f(p, WS_WBAT)[i] = p.w_in[(size_t)(i % D) * IN_COLS + WC_BA + i / D]; }
    LAS float* scr = (LAS float*)(lds + wave * 16384);
    const int gw = blockIdx.x * NWAVES + wave, NGW = gridDim.x * NWAVES;
    for (int it = gw; it < TI_ALL; it += NGW) {
        int r = it;
        if (r < TI_IN) { const int nb = r % (PLD / 32), kb = r / (PLD / 32), n0 = nb * 32; transpose_item(p.w_in, IN_COLS, D, ws_h(p, WS_WT_IN), n0, n0 < WC_BA ? n0 : n0 + 8, kb * 64, scr, lane); continue; } r -= TI_IN;
        if (r < TI_OUT) { const int nb = r % (D / 32), kb = r / (D / 32), n0 = nb * 32; transpose_item(p.w_out, D, 1024, ws_h(p, WS_WT_OUT), n0, n0, kb * 64, scr, lane); continue; } r -= TI_OUT;
        if (r < TI_UP) { const int nb = r % (2 * DFF / 32), kb = r / (2 * DFF / 32), n0 = nb * 32;
            const int pn = n0 >> 8, bj = (n0 >> 7) & 1, c = n0 & 127; transpose_item(p.w_up, 2 * DFF, D, ws_h(p, WS_WT_UP), n0, bj * DFF + 128 * pn + c, kb * 64, scr, lane); continue; } r -= TI_UP;
        { const int nb = r % (D / 32), kb = r / (D / 32), n0 = nb * 32; transpose_item(p.w_down, D, DFF, ws_h(p, WS_WT_DN), n0, n0, kb * 64, scr, lane); }
    }
}
typedef short bf16x8m __attribute__((ext_vector_type(8)));
typedef float f32x2m __attribute__((ext_vector_type(2))); typedef __bf16 bf16x2m __attribute__((ext_vector_type(2)));
__device__ __forceinline__ unsigned cvtpk_m(float lo, float hi) { const f32x2m v = {lo, hi}; return __builtin_bit_cast(unsigned, __builtin_convertvector(v, bf16x2m)); }
__device__ __forceinline__ void split8(const float (&x)[8], bf16x8m& hi, bf16x8m& lo) {
    unsigned h[4], l[4];
#pragma unroll
    for (int e = 0; e < 4; ++e) { h[e] = cvtpk_m(x[2 * e], x[2 * e + 1]);
        l[e] = cvtpk_m(x[2 * e] - __builtin_bit_cast(float, h[e] << 16), x[2 * e + 1] - __builtin_bit_cast(float, h[e] & 0xffff0000u)); }
    hi = __builtin_bit_cast(bf16x8m, (u32x4){h[0], h[1], h[2], h[3]}); lo = __builtin_bit_cast(bf16x8m, (u32x4){l[0], l[1], l[2], l[3]});
}
__device__ __forceinline__ float silu_fast(float x) { return x * __builtin_amdgcn_rcpf(1.0f + __expf(-x)); }
__device__ __forceinline__ void phase_mod(const P& p, LAS unsigned char* lds) {
    constexpr int KC = 256, NCG = 6 * D / 32, NCH = D / KC, NMT = (NCB + 15) / 16;
    static_assert(NMT <= 16, "two m-tiles per wave at most");
    LAS float* WB = (LAS float*)lds;
    const int tid = otid(), lane = tid & 63, wave = tid >> 6, r16 = lane & 15, g4 = lane >> 4;
    for (int cg = blockIdx.x; cg < NCG; cg += gridDim.x) {
        f32x4 acc[2][2];
#pragma unroll
        for (int s = 0; s < 2; ++s)
#pragma unroll
            for (int nt = 0; nt < 2; ++nt) acc[s][nt] = (f32x4){0.f, 0.f, 0.f, 0.f};
        f32x4 wreg[4];
#pragma unroll
        for (int j = 0; j < 4; ++j) { const int idx = tid + NTHR * j; wreg[j] = *(const f32x4*)(p.w_ada + (size_t)(idx >> 3) * 6 * D + cg * 32 + 4 * (idx & 7)); }
        __syncthreads();
        for (int ch = 0; ch < NCH; ++ch) {
            LAS float* wb = WB + (ch & 1) * KC * 32;
#pragma unroll
            for (int j = 0; j < 4; ++j) { const int idx = tid + NTHR * j; *(LAS f32x4*)(wb + (idx >> 3) * 32 + 4 * (idx & 7)) = wreg[j]; }
            if (ch + 1 < NCH) {
#pragma unroll
                for (int j = 0; j < 4; ++j) { const int idx = tid + NTHR * j; wreg[j] = *(const f32x4*)(p.w_ada + (size_t)((ch + 1) * KC + (idx >> 3)) * 6 * D + cg * 32 + 4 * (idx & 7)); }
            }
            __syncthreads();
#pragma unroll 2
            for (int ks = 0; ks < KC / 32; ++ks) {
                bf16x8m bh[2], bl[2];
#pragma unroll
                for (int nt = 0; nt < 2; ++nt) { float x[8];
#pragma unroll
                    for (int j = 0; j < 8; ++j) x[j] = wb[(32 * ks + 8 * g4 + j) * 32 + 16 * nt + r16];
                    split8(x, bh[nt], bl[nt]); }
#pragma unroll
                for (int s = 0; s < 2; ++s) { const int mt = wave + 8 * s; if (mt >= NMT) continue;
                    const int row = 16 * mt + r16; float x[8];
                    if (row < NCB) { const float* c = (row < BATCH ? p.c_prompt + (size_t)row * D : p.c_sample + (size_t)(row - BATCH) * D) + ch * KC + 32 * ks + 8 * g4;
                        const f32x4 a = *(const f32x4*)c, d = *(const f32x4*)(c + 4);
                        x[0] = silu_fast(a[0]); x[1] = silu_fast(a[1]); x[2] = silu_fast(a[2]); x[3] = silu_fast(a[3]); x[4] = silu_fast(d[0]); x[5] = silu_fast(d[1]); x[6] = silu_fast(d[2]); x[7] = silu_fast(d[3]); }
                    else {
#pragma unroll
                        for (int j = 0; j < 8; ++j) x[j] = 0.f; }
                    bf16x8m ah, al; split8(x, ah, al);
#pragma unroll
                    for (int nt = 0; nt < 2; ++nt) {
                        acc[s][nt] = __builtin_amdgcn_mfma_f32_16x16x32_bf16(ah, bh[nt], acc[s][nt], 0, 0, 0);
                        acc[s][nt] = __builtin_amdgcn_mfma_f32_16x16x32_bf16(ah, bl[nt], acc[s][nt], 0, 0, 0);
                        acc[s][nt] = __builtin_amdgcn_mfma_f32_16x16x32_bf16(al, bh[nt], acc[s][nt], 0, 0, 0); } }
            }
        }
#pragma unroll
        for (int s = 0; s < 2; ++s) { const int mt = wave + 8 * s; if (mt >= NMT) continue;
#pragma unroll
            for (int nt = 0; nt < 2; ++nt) { const int e = cg * 32 + 16 * nt + r16; const float bb = p.b_ada[e];
#pragma unroll
                for (int i = 0; i < 4; ++i) { const int row = 16 * mt + 4 * g4 + i; if (row < NCB) ws_f(p, WS_MOD)[(size_t)row * 6 * D + e] = acc[s][nt][i] + bb; } } }
    }
    __syncthreads();
}
constexpr int NS_OUT = 4, NS_DN = 11;
constexpr size_t WS_SLAB = WS_DNF_AB;
static_assert((size_t)(TS / 256) * (D / 256) * NS_DN * 65536 * 4 <= (size_t)NUNIT * DNF_AB_UNIT, "slabs fit");
template <int WHICH> __device__ __forceinline__ void norm_row_tail(const P& p, int m, int lane, const f32x4 (&v)[4], const f32x4 (&nwv)[4], const f32x4 (&wbt)[WHICH == 0 ? 8 : 1][4]) {
    float ss = 0.f;
#pragma unroll
    for (int j = 0; j < 4; ++j) ss += (v[j][0] * v[j][0] + v[j][1] * v[j][1]) + (v[j][2] * v[j][2] + v[j][3] * v[j][3]);
    const float rstd = 1.0f / sqrtf(wave_sum(ss) * (1.0f / D) + EPS);
    if (WHICH == 2) {
#pragma unroll
        for (int j = 0; j < 4; ++j) ((f32x4*)(p.out + O_Y + (size_t)m * D))[lane + 64 * j] = v[j] * rstd * nwv[j];
        return;
    }
    const int cb = cb_of(m);
    const float* mod = ws_f(p, WS_MOD) + (size_t)cb * 6 * D;
    const float* sh = mod + (WHICH == 0 ? 0 : 3 * D); const float* sc = mod + (WHICH == 0 ? D : 4 * D);
    float ba[8];
#pragma unroll
    for (int j = 0; j < 8; ++j) ba[j] = 0.f;
    unsigned long long* o8 = (unsigned long long*)(ws_h(p, WS_H) + (size_t)m * D);
#pragma unroll
    for (int j = 0; j < 4; ++j) {
        const f32x4 s1 = ((const f32x4*)sc)[lane + 64 * j], s0 = ((const f32x4*)sh)[lane + 64 * j];
        const f32x4 h = v[j] * rstd * nwv[j] * (s1 + 1.0f) + s0;
        o8[lane + 64 * j] = (unsigned long long)pk2(h[0], h[1]) | ((unsigned long long)pk2(h[2], h[3]) << 32);
        if (WHICH == 0) {
#pragma unroll
            for (int c = 0; c < 8; ++c) ba[c] += (h[0] * wbt[c][j][0] + h[1] * wbt[c][j][1]) + (h[2] * wbt[c][j][2] + h[3] * wbt[c][j][3]);
        }
    }
    if (WHICH == 0) {
#pragma unroll
        for (int j = 0; j < 8; ++j) ba[j] = wave_sum(ba[j]);
        float mine = 0.f;
#pragma unroll
        for (int j = 0; j < 8; ++j) mine = (lane == j) ? ba[j] : mine;
        if (lane < 8) { float* bg = ws_f(p, WS_BG) + (size_t)m * 8; const int j = lane & 3;
            bg[lane] = lane < 4 ? sigmoid_f(mine) : -expf(p.dn_A_log[j]) * softplus_f(mine + p.dn_dt_bias[j]); }
    }
}
template <int WHICH> __device__ __forceinline__ void phase_norm(const P& p) {
    static_assert(D == 1024, "one wave per 1024-float row");
    const int tid_ = otid(), lane = tid_ & 63, wave = tid_ >> 6;
    const int gw = blockIdx.x * NWAVES + wave, NGW = gridDim.x * NWAVES;
    const float* nwp = WHICH == 0 ? p.norm_mix_w : (WHICH == 1 ? p.norm_ffn_w : p.final_norm_w);
    f32x4 nwv[4];
#pragma unroll
    for (int j = 0; j < 4; ++j) nwv[j] = ((const f32x4*)nwp)[lane + 64 * j];
    f32x4 wbt[WHICH == 0 ? 8 : 1][4];
    if (WHICH == 0) {
#pragma unroll
        for (int c = 0; c < 8; ++c)
#pragma unroll
            for (int j = 0; j < 4; ++j) wbt[c][j] = ((const f32x4*)(ws_f(p, WS_WBAT) + c * D))[lane + 64 * j];
    }
    constexpr int MEND = WHICH == 0 ? T : TP;
    f32x4 v[4];
    if (gw < MEND) { const float* xr = WHICH == 0 ? xrow(p, gw) : p.out + O_Y + (size_t)gw * D;
#pragma unroll
        for (int j = 0; j < 4; ++j) v[j] = ((const f32x4*)xr)[lane + 64 * j]; }
    for (int m = gw; m < MEND; m += NGW) {
        f32x4 vn[4]; const int mn = m + NGW;
        if (mn < MEND) { const float* xr = WHICH == 0 ? xrow(p, mn) : p.out + O_Y + (size_t)mn * D;
#pragma unroll
            for (int j = 0; j < 4; ++j) vn[j] = ((const f32x4*)xr)[lane + 64 * j]; }
        norm_row_tail<WHICH>(p, m, lane, v, nwv, wbt);
#pragma unroll
        for (int j = 0; j < 4; ++j) v[j] = vn[j];
    }
    if (WHICH != 0) {
        constexpr int NS = WHICH == 1 ? NS_OUT : NS_DN;
        for (int rs = gw; rs < TS; rs += NGW) { const int m = TP + rs, cbs = BATCH + (rs >> 3);
            const float* gt = ws_f(p, WS_MOD) + (size_t)cbs * 6 * D + (WHICH == 1 ? 2 * D : 5 * D);
            f32x4 vs[4];
#pragma unroll
            for (int j = 0; j < 4; ++j) { const float* sl = ws_f(p, WS_SLAB) + ((size_t)((rs >> 8) * 4 + j) * NS) * 65536 + (size_t)(rs & 255) * 256 + 4 * lane;
                f32x4 acc = (f32x4){0.f, 0.f, 0.f, 0.f};
#pragma unroll
                for (int ks = 0; ks < NS; ++ks) { acc += *(const f32x4*)sl; sl += 65536; asm volatile("" : "+v"(sl)); }
                const f32x4 base = WHICH == 1 ? ((const f32x4*)(p.x_sample + (size_t)rs * D))[lane + 64 * j] : ((const f32x4*)(p.out + O_Y + (size_t)m * D))[lane + 64 * j];
                vs[j] = base + ((const f32x4*)gt)[lane + 64 * j] * acc;
                if (WHICH == 1) ((f32x4*)(p.out + O_Y + (size_t)m * D))[lane + 64 * j] = vs[j];
                asm volatile("" ::: "memory"); }
            norm_row_tail<WHICH>(p, m, lane, vs, nwv, wbt);
        }
    }
}

constexpr long SO_1 = (long)BATCH * 3 * 1536 / 4, SO_2 = (long)DEC_BATCH * 3 * 1536 / 4, SO_3 = (long)BATCH * 128 * 128 / 4, SO_4 = (long)DEC_BATCH * 128 * 128 / 4, SO_N = SO_1 + SO_2 + 2 * (SO_3 + SO_4);
__device__ __forceinline__ void so_item(const P& p, long it, f32x4& val, float*& dst) {
    const bf16_t* PR = ws_h(p, WS_PROJ); const bf16_t* src = nullptr; const float* fsrc = nullptr;
    long r = it;
    if (r < SO_1) { const int b = (int)(r / (3 * 384)), j = (int)(r / 384 % 3), c = (int)(r % 384) * 4; src = PR + (size_t)(b * SEQ + SEQ - 3 + j) * PLD + PC_QKV + c; dst = p.out + O_PDC + r * 4; }
    else if ((r -= SO_1) < SO_2) { const int b = (int)(r / (3 * 384)), j = (int)(r / 384 % 3), c = (int)(r % 384) * 4; src = PR + (size_t)(TP + b * DEC_SEQ + DEC_SEQ - 3 + j) * PLD + PC_QKV + c; dst = p.out + O_SDC + r * 4; }
    else { r -= SO_2; const int kv = r >= SO_3 + SO_4; if (kv) r -= SO_3 + SO_4; const int pc = kv ? PC_SV : PC_SK; const float* cache = kv ? p.cache_v : p.cache_k;
        if (r < SO_3) { const int b = (int)(r / (128 * 32)), j = (int)(r / 32 % 128), c = (int)(r % 32) * 4; src = PR + (size_t)(b * SEQ + SEQ - 128 + j) * PLD + pc + c; dst = p.out + (kv ? O_PV : O_PK) + r * 4; }
        else { r -= SO_3; const int b = (int)(r / (128 * 32)), j = (int)(r / 32 % 128), c = (int)(r % 32) * 4; dst = p.out + (kv ? O_SV : O_SK) + r * 4;
            if (j < 128 - DEC_SEQ) fsrc = cache + ((size_t)b * 128 + j + DEC_SEQ) * 128 + c; else src = PR + (size_t)(TP + b * DEC_SEQ + (j - (128 - DEC_SEQ))) * PLD + pc + c; } }
    if (fsrc) val = *(const f32x4*)fsrc;
    else { const u32x2 w = *(const u32x2*)src; val = (f32x4){__builtin_bit_cast(float, w.x << 16), __builtin_bit_cast(float, w.x & 0xffff0000u), __builtin_bit_cast(float, w.y << 16), __builtin_bit_cast(float, w.y & 0xffff0000u)}; }
}
__device__ __forceinline__ void phase_state_out(const P& p) {
    const long gt = blockIdx.x * (long)NTHR + otid(), gs = (long)gridDim.x * NTHR;
    for (long it = gt; it < SO_N; it += 4 * gs) {
        f32x4 v[4]; float* d[4];
#pragma unroll
        for (int u = 0; u < 4; ++u) if (it + u * gs < SO_N) so_item(p, it + u * gs, v[u], d[u]);
#pragma unroll
        for (int u = 0; u < 4; ++u) if (it + u * gs < SO_N) *(f32x4*)d[u] = v[u];
    }
}
#define XB_TMO      128
#define XB_XCNT(j)  (256  + 64 * (j))
#define XB_XSUB(j)  (1280 + 64 * (j))
#define XB_XGEN(j)  (2304 + 64 * (j))
#define XB_TOP      3328
#define XB_TOPGEN   3392
#define XCD_BAR_WORDS 3456
#define XB_SPIN_CAP (1u << 18)

__device__ __forceinline__ unsigned xb_ld(unsigned* p)              { return __hip_atomic_load(p, __ATOMIC_RELAXED, __HIP_MEMORY_SCOPE_AGENT); }
__device__ __forceinline__ unsigned xb_add(unsigned* p, unsigned v) { return __hip_atomic_fetch_add(p, v, __ATOMIC_RELAXED, __HIP_MEMORY_SCOPE_AGENT); }
__device__ __forceinline__ unsigned xb_xcc_id() { return (unsigned)__builtin_amdgcn_s_getreg((3 << 11) | 20) & 0xFu; }
#define XB_SPIN(cond, bar) do { unsigned _sp = 0; while (cond) { __builtin_amdgcn_s_sleep(1); \
    if ((++_sp & 255u) == 0u) { if (xb_ld(&(bar)[XB_TMO])) break; if (_sp > XB_SPIN_CAP) { atomicAdd(&(bar)[XB_TMO], 1u); break; } } } } while (0)

struct XcdBarrier {
    unsigned* bar; unsigned x;
    volatile LAS unsigned* st;
};

__device__ __forceinline__ XcdBarrier xcd_barrier_post(unsigned* bar, volatile LAS unsigned* st) {
    XcdBarrier b; b.bar = bar; b.x = xb_xcc_id(); b.st = st;
    if (threadIdx.x == 0) (void)xb_add(&bar[XB_XCNT(b.x)], 1u);
    return b;
}
__device__ __forceinline__ void xcd_barrier_complete(unsigned* bar, unsigned x, unsigned& nloc, unsigned& nx) {
    const unsigned G = gridDim.x * gridDim.y * gridDim.z;
    unsigned sum, cnt, mine, sp = 0u;
    for (;;) {
        sum = 0u; cnt = 0u; mine = 0u;
#pragma unroll
        for (unsigned j = 0; j < 16; ++j) { const unsigned c = xb_ld(&bar[XB_XCNT(j)]); sum += c; cnt += (c > 0u) ? 1u : 0u; mine = (j == x) ? c : mine; }
        if (sum == G) break;
        __builtin_amdgcn_s_sleep(1);
        if ((++sp & 255u) == 0u) { if (xb_ld(&bar[XB_TMO])) break; if (sp > XB_SPIN_CAP) { atomicAdd(&bar[XB_TMO], 1u); break; } }
    }
    nloc = mine > 0u ? mine : 1u; nx = cnt > 0u ? cnt : 1u;
}

__device__ __forceinline__ void xcd_barrier(const XcdBarrier& b) {
    asm volatile("s_waitcnt vmcnt(0)" ::: "memory");
    __syncthreads();
    if (threadIdx.x == 0) {
        unsigned* bar = b.bar;
        __builtin_amdgcn_s_waitcnt(0);
        unsigned nloc = b.st[0], nx = b.st[1];
        if (nloc == 0u) { xcd_barrier_complete(bar, b.x, nloc, nx); b.st[0] = nloc; b.st[1] = nx; }
        const unsigned old = xb_add(&bar[XB_XSUB(b.x)], 1u);
        const unsigned gen = old / nloc;
        if (old + 1u == (gen + 1u) * nloc) {
            __builtin_amdgcn_fence(__ATOMIC_RELEASE, "agent");
            asm volatile("s_waitcnt vmcnt(0)" ::: "memory");
            const unsigned og = xb_add(&bar[XB_TOP], 1u);
            const unsigned tg = og / nx;
            if (og + 1u == (tg + 1u) * nx) xb_add(&bar[XB_TOPGEN], 1u);
            else XB_SPIN(xb_ld(&bar[XB_TOPGEN]) == tg, bar);
            __builtin_amdgcn_fence(__ATOMIC_ACQUIRE, "agent");
            xb_add(&bar[XB_XGEN(b.x)], 1u);
            asm volatile("s_waitcnt vmcnt(0)" ::: "memory");
        } else {
            XB_SPIN(xb_ld(&bar[XB_XGEN(b.x)]) == gen, bar);
            __builtin_amdgcn_fence(__ATOMIC_ACQUIRE, "agent");
            asm volatile("s_waitcnt vmcnt(0)" ::: "memory");
        }
    }
    __syncthreads();
}
namespace pg8 {
#define PG8_LAS __attribute__((address_space(3)))
typedef unsigned short bf16_t;
typedef short bf16x8 __attribute__((ext_vector_type(8)));
typedef float f32x4 __attribute__((ext_vector_type(4)));
typedef unsigned u32x4 __attribute__((ext_vector_type(4)));
constexpr int BM = 256, BK = 64, HALF = 128, HTB = HALF * BK * 2  , STAGE_BYTES = 8 * HTB, NXCD = 8, WGM = 8;

__host__ __device__ __forceinline__ int lds_byte(int r, int c) { const int st = (r >> 4) * 2 + (c >> 5), rr = r & 15, cc = c & 31, ob = rr * 64 + cc * 2; return st * 1024 + (ob ^ (((ob >> 9) & 1) << 5)); }
__host__ __device__ __forceinline__ void stage_rc(int b, int& R, int& C) { const int st = b / 1024, sb = b % 1024, swz = sb ^ (((sb >> 9) & 1) << 5); R = (st >> 1) * 16 + swz / 64; C = (st & 1) * 32 + (swz % 64) / 2; }
__host__ __device__ __forceinline__ int perm32(int rho) { const int n = rho >> 4, i = rho & 15; return 8 * (i >> 2) + 4 * n + (i & 3); }

struct Unit { int pm, pn, k0, nt, atomic; };
struct Gemm { const bf16_t* A; const bf16_t* Bt; int M, N, K; };

struct StaticOrder {
    int nM, nN, nwg, G, c, ntk;
    __host__ __device__ void init(int M, int N, int G_, int c_, int K_) { nM = M / BM; nN = N / BM; nwg = nM * nN; G = G_; c = c_; ntk = K_ / BK; }
    __host__ __device__ bool next(int i, Unit& u) const {
        const long L = (long)i * G + c; if (L >= nwg) return false;
        int wgid = (int)L; { const int q = nwg / NXCD, r = nwg % NXCD, xcd = wgid % NXCD, off = wgid / NXCD; wgid = (xcd < r ? xcd * (q + 1) : r * (q + 1) + (xcd - r) * q) + off; }
        const int nig = WGM * nN, gid = wgid / nig, fm = gid * WGM, gsz = (nM - fm) < WGM ? (nM - fm) : WGM;
        u.pm = fm + ((wgid % nig) % gsz); u.pn = (wgid % nig) / gsz; u.k0 = 0; u.nt = ntk; u.atomic = 0; return true;
    }
    __device__ __forceinline__ void a_ready(const Unit&) const {}
    __device__ __forceinline__ void done(const Unit&) const {}
};

struct SplitOrder {
    StaticOrder so; int nu1, ns, ntk_sub, npn, nsub, G, c;
    __device__ void init(int N, int K, int NS, int G_, int c_) { so.init(TP, N, G_, c_, K); nu1 = so.nwg; ns = NS; ntk_sub = K / BK / NS; npn = N / BM; nsub = (TS / BM) * npn * NS; G = G_; c = c_; }
    __device__ bool next(int i, Unit& u) const {
        const long L = (long)i * G + c; if (L < nu1) return so.next(i, u);
        const int s = (int)(L - nu1); if (s >= nsub) return false;
        const int ks = s % ns, t = s / ns; u.pm = TP / BM + t / npn; u.pn = t % npn; u.k0 = ks * ntk_sub * BK; u.nt = ntk_sub; u.atomic = 1; return true; }
    __device__ __forceinline__ void a_ready(const Unit&) const {}
    __device__ __forceinline__ void done(const Unit&) const {}
};
__device__ __forceinline__ unsigned cvt_pk_bf16(float lo, float hi) { unsigned r; asm volatile("v_cvt_pk_bf16_f32 %0, %1, %2" : "=v"(r) : "v"(lo), "v"(hi)); return r; }
struct EpiStoreBf16 {
    static constexpr bool PERM = true, AFTER_DRAIN = false;
    bf16_t* O; int ldc;
    __device__ __forceinline__ void operator()(const f32x4 (&acc)[2][2][4][2], const Unit& u, int wr, int wc, int fr, int fq) const {
        const int row0 = u.pm * BM + wr * 64 + fr, col0 = u.pn * BM + wc * 32 + 8 * fq;
#pragma unroll
        for (int ai = 0; ai < 2; ++ai)
#pragma unroll
            for (int m = 0; m < 4; ++m) { bf16_t* rowp = O + (size_t)(row0 + ai * HALF + m * 16) * ldc + col0;
#pragma unroll
                for (int bj = 0; bj < 2; ++bj) { const f32x4 v0 = acc[ai][bj][m][0], v1 = acc[ai][bj][m][1];
                    u32x4 w; w.x = cvt_pk_bf16(v0[0], v0[1]); w.y = cvt_pk_bf16(v0[2], v0[3]); w.z = cvt_pk_bf16(v1[0], v1[1]); w.w = cvt_pk_bf16(v1[2], v1[3]);
                    *(u32x4*)(rowp + bj * HALF) = w; } }
    }
};
struct EpiGateRes {
    static constexpr bool PERM = false, AFTER_DRAIN = false;
    const float* base_p; const float* base_s; float* out; const float* gate; float* slab; int ns;
    __device__ __forceinline__ void operator()(const f32x4 (&acc)[2][2][4][2], const Unit& u, int wr, int wc, int fr, int fq) const {
        const int row0 = u.pm * BM + wr * 64 + fr, col0 = u.pn * BM + wc * 32 + 4 * fq;
        const bool smp = row0 >= TP; const float* base = smp ? base_s - (size_t)TP * D : base_p;
#pragma unroll
        for (int ai = 0; ai < 2; ++ai)
#pragma unroll
            for (int m = 0; m < 4; ++m) { const int r = row0 + ai * HALF + m * 16; const int cb = smp ? BATCH + ((r - TP) >> 3) : r / SEQ;
                const float* gp = gate + (size_t)cb * 6 * D + col0; const size_t off = (size_t)r * D + col0;
#pragma unroll
                for (int bj = 0; bj < 2; ++bj)
#pragma unroll
                    for (int n = 0; n < 2; ++n) { const f32x4 gv = *(const f32x4*)(gp + bj * HALF + n * 16);
                        if (u.atomic) { const int sidx = ((u.pm - TP / BM) * (D / BM) + u.pn) * ns + u.k0 / (u.nt * BK);
                            *(f32x4*)(slab + (size_t)sidx * 65536 + (size_t)(r - u.pm * BM) * 256 + (col0 - u.pn * BM) + bj * HALF + n * 16) = acc[ai][bj][m][n]; }
                        else { const f32x4 bs = *(const f32x4*)(base + off + bj * HALF + n * 16); *(f32x4*)(out + off + bj * HALF + n * 16) = bs + gv * acc[ai][bj][m][n]; } } }
    }
};
template <class Epi, class Sched, bool ALIGN_EPI = false, bool SP2 = false>
__device__ __forceinline__ void gemm_phase(PG8_LAS unsigned char* lds, const Gemm g, const Sched& S, const Epi& E) {
    const int tid = otid(), wid = __builtin_amdgcn_readfirstlane(tid >> 6), lane = tid & 63, wr = wid >> 2, wc = wid & 3, fr = lane & 15, fq = lane >> 4;
    const int K = g.K;
    unsigned voffA[2], voffB[2];
#pragma unroll
    for (int i = 0; i < 2; ++i) { int R, C; stage_rc(tid * 16 + i * 8192, R, C); const int Rb = Epi::PERM ? ((R & ~31) + perm32(R & 31)) : R;
        voffA[i] = (unsigned)(R * K + C) * 2u; voffB[i] = (unsigned)(Rb * K + C) * 2u; }
    const size_t kstep = (size_t)(BK * 2);
    const size_t hstep = (size_t)HALF * K * 2;
    const size_t tstep = 2 * hstep;
    const unsigned ldsw = (unsigned)wid * 1024u;
    const int aoff = lds_byte(wr * 64 + fr, fq * 8), boff = lds_byte(wc * 32 + fr, fq * 8);
#define PG8_SA(b, h) (((b) * 2 + (h)) * HTB)
#define PG8_SB(b, h) ((4 + (b) * 2 + (h)) * HTB)
#define PG8_STAGE(bufoff, gbase, voff) do { _Pragma("unroll") for (int _i = 0; _i < 2; ++_i) \
        __builtin_amdgcn_global_load_lds((const unsigned*)((const char*)(gbase) + (voff)[_i]), (PG8_LAS unsigned*)(lds + (bufoff) + ldsw + _i * 8192), 16, 0, 0); } while (0)
#define PG8_LDA(dst, b, h) do { _Pragma("unroll") for (int m = 0; m < 4; ++m) _Pragma("unroll") for (int k = 0; k < 2; ++k) dst[m][k] = *(const PG8_LAS bf16x8*)(lds + PG8_SA(b, h) + aoff + m * 2048 + k * 1024); } while (0)
#define PG8_LDB(dst, b, h) do { _Pragma("unroll") for (int n = 0; n < 2; ++n) _Pragma("unroll") for (int k = 0; k < 2; ++k) dst[n][k] = *(const PG8_LAS bf16x8*)(lds + PG8_SB(b, h) + boff + n * 2048 + k * 1024); } while (0)
#define PG8_MMA(ai, bj, At, Bt) do { __builtin_amdgcn_s_setprio(1); _Pragma("unroll") for (int m = 0; m < 4; ++m) _Pragma("unroll") for (int n = 0; n < 2; ++n) _Pragma("unroll") for (int k = 0; k < 2; ++k) \
        acc[ai][bj][m][n] = __builtin_amdgcn_mfma_f32_16x16x32_bf16(Bt[n][k], At[m][k], acc[ai][bj][m][n], 0, 0, 0); __builtin_amdgcn_s_setprio(0); } while (0)
#define PG8_WAIT_V(n) asm volatile("s_waitcnt vmcnt(" #n ")" ::: "memory")
#define PG8_WAIT_L(n) asm volatile("s_waitcnt lgkmcnt(" #n ")" ::: "memory")
#define PG8_BAR __builtin_amdgcn_s_barrier()
#define PG8_SCHED __builtin_amdgcn_sched_barrier(0)
    Unit cur, nxt; int ui = 0;
    if (!S.next(0, cur)) return;
    f32x4 acc[2][2][4][2];
#pragma unroll
    for (int a = 0; a < 2; ++a)
#pragma unroll
        for (int b = 0; b < 2; ++b)
#pragma unroll
            for (int m = 0; m < 4; ++m)
#pragma unroll
                for (int n = 0; n < 2; ++n) acc[a][b][m][n] = (f32x4){0.f, 0.f, 0.f, 0.f};
    bf16x8 At[4][2], B0[2][2], B1[2][2];
    const char* cA = (const char*)g.A + (size_t)cur.pm * tstep + (size_t)cur.k0 * 2; const char* cB = (const char*)g.Bt + (size_t)cur.pn * tstep + (size_t)cur.k0 * 2;
    S.a_ready(cur);
    if constexpr (SP2) {
        PG8_STAGE(PG8_SB(0, 0), cB, voffB); PG8_STAGE(PG8_SB(0, 1), cB + hstep, voffB); PG8_STAGE(PG8_SA(0, 0), cA, voffA); PG8_STAGE(PG8_SA(0, 1), cA + hstep, voffA);
        if (wr == 1) PG8_BAR;
        PG8_WAIT_V(2); PG8_BAR;
        PG8_STAGE(PG8_SB(1, 0), cB + kstep, voffB); PG8_STAGE(PG8_SA(1, 0), cA + kstep, voffA); PG8_STAGE(PG8_SB(1, 1), cB + hstep + kstep, voffB);
        PG8_WAIT_V(6); PG8_BAR;
    } else {
        PG8_STAGE(PG8_SB(0, 0), cB, voffB); PG8_STAGE(PG8_SA(0, 0), cA, voffA); PG8_STAGE(PG8_SB(0, 1), cB + hstep, voffB); PG8_STAGE(PG8_SA(0, 1), cA + hstep, voffA);
        if (wr == 1) PG8_BAR;
        PG8_WAIT_V(4); PG8_BAR;
        PG8_STAGE(PG8_SB(1, 0), cB + kstep, voffB); PG8_STAGE(PG8_SA(1, 0), cA + kstep, voffA); PG8_STAGE(PG8_SB(1, 1), cB + hstep + kstep, voffB);
        PG8_WAIT_V(6); PG8_BAR;
    }
    for (;;) {
        const bool has_next = S.next(ui + 1, nxt);
        const char* nA = has_next ? (const char*)g.A + (size_t)nxt.pm * tstep + (size_t)nxt.k0 * 2 : cA; const char* nB = has_next ? (const char*)g.Bt + (size_t)nxt.pn * tstep + (size_t)nxt.k0 * 2 : cB;
        const int nt = cur.nt;
        for (int t = 0; t < nt; t += 2) {
            const bool last = (t == nt - 2);
            const char* a1 = cA + (size_t)(t + 1) * kstep;
            const char* a2 = last ? nA : cA + (size_t)(t + 2) * kstep; const char* b2 = last ? nB : cB + (size_t)(t + 2) * kstep;
            const char* a3 = a2 + kstep; const char* b3 = b2 + kstep;
            if (last && has_next) S.a_ready(nxt);
            if constexpr (SP2) {
            PG8_LDB(B0, 0, 0); PG8_LDB(B1, 0, 1); PG8_SCHED; PG8_LDA(At, 0, 0); PG8_STAGE(PG8_SA(1, 1), a1 + hstep, voffA);
            PG8_WAIT_V(8); PG8_WAIT_L(0); PG8_BAR; PG8_MMA(0, 0, At, B0); PG8_MMA(0, 1, At, B1); PG8_BAR; PG8_SCHED;
            PG8_LDA(At, 0, 1); PG8_STAGE(PG8_SB(0, 0), b2, voffB); PG8_STAGE(PG8_SB(0, 1), b2 + hstep, voffB); PG8_STAGE(PG8_SA(0, 0), a2, voffA);
            PG8_WAIT_V(8); PG8_WAIT_L(0); PG8_BAR; PG8_MMA(1, 0, At, B0); PG8_MMA(1, 1, At, B1); PG8_BAR; PG8_SCHED;
            PG8_LDB(B0, 1, 0); PG8_LDB(B1, 1, 1); PG8_SCHED; PG8_LDA(At, 1, 0); PG8_STAGE(PG8_SA(0, 1), a2 + hstep, voffA);
            PG8_WAIT_V(8); PG8_WAIT_L(0); PG8_BAR; PG8_MMA(0, 0, At, B0); PG8_MMA(0, 1, At, B1); PG8_BAR; PG8_SCHED;
            PG8_LDA(At, 1, 1); PG8_STAGE(PG8_SB(1, 0), b3, voffB); PG8_STAGE(PG8_SB(1, 1), b3 + hstep, voffB); PG8_STAGE(PG8_SA(1, 0), a3, voffA);
            PG8_WAIT_V(8); PG8_WAIT_L(0); PG8_BAR; PG8_MMA(1, 0, At, B0); PG8_MMA(1, 1, At, B1); PG8_BAR; PG8_SCHED;
            } else {
            PG8_LDB(B0, 0, 0); PG8_SCHED; PG8_LDA(At, 0, 0); PG8_STAGE(PG8_SA(1, 1), a1 + hstep, voffA);
            PG8_WAIT_L(8); PG8_BAR; PG8_WAIT_L(0); PG8_MMA(0, 0, At, B0); PG8_BAR; PG8_SCHED;
            PG8_LDB(B1, 0, 1); PG8_STAGE(PG8_SB(0, 0), b2, voffB);
            PG8_BAR; PG8_WAIT_L(0); PG8_MMA(0, 1, At, B1); PG8_BAR;
            PG8_LDA(At, 0, 1); PG8_STAGE(PG8_SA(0, 0), a2, voffA);
            PG8_BAR; PG8_WAIT_L(0); PG8_MMA(1, 0, At, B0); PG8_BAR; PG8_SCHED;
            PG8_STAGE(PG8_SB(0, 1), b2 + hstep, voffB);
            PG8_WAIT_V(6); PG8_BAR; PG8_MMA(1, 1, At, B1); PG8_BAR;
            PG8_LDB(B0, 1, 0); PG8_SCHED; PG8_LDA(At, 1, 0); PG8_STAGE(PG8_SA(0, 1), a2 + hstep, voffA);
            PG8_WAIT_L(8); PG8_BAR; PG8_WAIT_L(0); PG8_MMA(0, 0, At, B0); PG8_BAR; PG8_SCHED;
            PG8_LDB(B1, 1, 1); PG8_STAGE(PG8_SB(1, 0), b3, voffB);
            PG8_BAR; PG8_WAIT_L(0); PG8_MMA(0, 1, At, B1); PG8_BAR;
            PG8_LDA(At, 1, 1); PG8_STAGE(PG8_SA(1, 0), a3, voffA);
            PG8_BAR; PG8_WAIT_L(0); PG8_MMA(1, 0, At, B0); PG8_BAR; PG8_SCHED;
            PG8_STAGE(PG8_SB(1, 1), b3 + hstep, voffB);
            PG8_WAIT_V(6); PG8_BAR; PG8_MMA(1, 1, At, B1); PG8_BAR;
            }
        }
        if constexpr (ALIGN_EPI) { if (wr == 0) PG8_BAR; }
        if constexpr (!Epi::AFTER_DRAIN) { E(acc, cur, wr, wc, fr, fq); S.done(cur); }
        if (!has_next) break;
#pragma unroll
        for (int a = 0; a < 2; ++a)
#pragma unroll
            for (int b = 0; b < 2; ++b)
#pragma unroll
                for (int m = 0; m < 4; ++m)
#pragma unroll
                    for (int n = 0; n < 2; ++n) acc[a][b][m][n] = (f32x4){0.f, 0.f, 0.f, 0.f};
        cur = nxt; cA = nA; cB = nB; ++ui;
        if constexpr (ALIGN_EPI) { if (wr == 1) PG8_BAR; }
    }
    PG8_WAIT_V(0);
    if constexpr (!ALIGN_EPI) { if (wr == 0) PG8_BAR; }
    PG8_BAR;
    if constexpr (Epi::AFTER_DRAIN) { E.fused(acc, cur, wr, wc, fr, fq, lds, wid, lane); S.done(cur); }
#undef PG8_SA
#undef PG8_SB
#undef PG8_STAGE
#undef PG8_LDA
#undef PG8_LDB
#undef PG8_MMA
#undef PG8_WAIT_V
#undef PG8_WAIT_L
#undef PG8_BAR
#undef PG8_SCHED
}
}
typedef short bf16x8 __attribute__((ext_vector_type(8)));
constexpr int FR_NWK = 0, FR_QD = 16, FR_KTT = 32, FR_QK = 48, FR_N = 56;
__device__ __forceinline__ int kperm(int g, int j) { return j < 4 ? 4 * g + j : 16 + 4 * g + (j - 4); }

typedef float f32x2_t __attribute__((ext_vector_type(2))); typedef __bf16 bf16x2_t __attribute__((ext_vector_type(2)));
__device__ __forceinline__ unsigned cvtpk_c(float lo, float hi) { const f32x2_t v = {lo, hi}; const bf16x2_t b = __builtin_convertvector(v, bf16x2_t); return __builtin_bit_cast(unsigned, b); }
__device__ __forceinline__ bf16x8 pack8(const f32x4 a, const f32x4 b) {
    return __builtin_bit_cast(bf16x8, (u32x4){cvtpk_c(a[0], a[1]), cvtpk_c(a[2], a[3]), cvtpk_c(b[0], b[1]), cvtpk_c(b[2], b[3])});
}
constexpr int DP_KP = 136;
constexpr int DP_RP = 72;
constexpr int DP_QS = 0, DP_KS = DP_QS + 64 * DP_KP * 2, DP_RHST = DP_KS + 64 * DP_KP * 2, DP_AM = DP_RHST + 256 * DP_RP * 2, DP_AMP = 68,
              DP_QKM = DP_AM + 64 * DP_AMP * 4, DP_QKP = 72, DP_GS = DP_QKM + 64 * DP_QKP * 2, DP_DM = DP_GS + 4 * 64 * 4, DP_DMP = 20,
              DP_TB = DP_DM + 64 * DP_DMP * 4, DP_END = DP_TB + 64 * DP_RP * 2;
static_assert(DP_END <= 131072 && DP_AM % 16 == 0 && DP_DM % 16 == 0 && DP_TB % 16 == 0 && DP_RHST % 16 == 0, "dnprep LDS");
#ifndef DPS
#define DPS(k)
#endif
__device__ __forceinline__ void phase_dnprep(const P& p, LAS unsigned char* lds, unsigned long long& pr_prev, unsigned long long& pr_acc) {
    const int tid_ = otid();
    LAS bf16_t* QS = (LAS bf16_t*)(lds + DP_QS); LAS bf16_t* KS = (LAS bf16_t*)(lds + DP_KS); LAS bf16_t* RHST = (LAS bf16_t*)(lds + DP_RHST);
    LAS float* AM = (LAS float*)(lds + DP_AM); LAS bf16_t* QKM = (LAS bf16_t*)(lds + DP_QKM); LAS float* GS = (LAS float*)(lds + DP_GS);
    LAS float* DM = (LAS float*)(lds + DP_DM); LAS bf16_t* TB = (LAS bf16_t*)(lds + DP_TB);
    const bf16_t* PR = ws_h(p, WS_PROJ); const float* BG = ws_f(p, WS_BG);
    for (int i = tid_; i < 64 * DP_RP / 2; i += NTHR) ((LAS unsigned*)TB)[i] = 0u;
    float pgx = 0.f, pbx = 0.f, cw[3][4][2]; unsigned xr[3][11];
#define DP_FETCH(uid_, ln_, wv_) do { const int n_ = (uid_) % NCHUNK, bh_ = (uid_) / NCHUNK, h_ = bh_ & 3, m0_ = (bh_ >> 2) * SEQ + n_ * 64; \
        if ((wv_) == 0) { pgx = BG[(size_t)(m0_ + (ln_)) * 8 + 4 + h_]; pbx = BG[(size_t)(m0_ + (ln_)) * 8 + h_]; } \
        _Pragma("unroll") for (int part = 0; part < 3; ++part) _Pragma("unroll") for (int j = 0; j < 4; ++j) { const float* w = p.dn_conv_w + j * 1536 + part * 512 + h_ * 128 + 2 * (ln_); cw[part][j][0] = w[0]; cw[part][j][1] = w[1]; } \
        _Pragma("unroll") for (int rr = 0; rr < 11; ++rr) { const int t_ = n_ * 64 + (wv_) * 8 + rr - 3; \
            _Pragma("unroll") for (int part = 0; part < 3; ++part) { unsigned v_ = 0u; if (t_ >= 0) v_ = *(const unsigned*)(PR + (size_t)(m0_ + (wv_) * 8 + rr - 3) * PLD + part * 512 + h_ * 128 + 2 * (ln_)); xr[part][rr] = v_; } } } while (0)
    if ((int)blockIdx.x < NUNIT) { int t0 = tid_; asm volatile("" : "+v"(t0)); DP_FETCH((int)blockIdx.x, t0 & 63, t0 >> 6); }
    for (int uid = blockIdx.x; uid < NUNIT; uid += gridDim.x) {
        const int n = uid % NCHUNK;
        int tid = tid_; asm volatile("" : "+v"(tid));
        const int lane = tid & 63, wave = tid >> 6, r16 = lane & 15, g4 = lane >> 4;
        unsigned char* abu = p.ws + WS_DNF_AB + (size_t)uid * DNF_AB_UNIT;
        if (wave == 0) {
            float x = pgx;
#pragma unroll
            for (int o = 1; o < 64; o <<= 1) { const float t = __shfl_up(x, o); if (lane >= o) x += t; }
            const float gl = __shfl(x, 63);
            GS[lane] = x; GS[64 + lane] = pbx; GS[128 + lane] = __expf(x); GS[192 + lane] = __expf(gl - x);
            if (lane == 0) ws_f(p, WS_DNF_CD)[uid] = __expf(gl);
        }
        __syncthreads();
        {
            float c[8][3][2], ssum[16];
#pragma unroll
            for (int i = 0; i < 8; ++i) {
#pragma unroll
                for (int part = 0; part < 3; ++part)
#pragma unroll
                    for (int e = 0; e < 2; ++e) { float a = 0.f;
#pragma unroll
                        for (int j = 0; j < 4; ++j) a += cw[part][j][e] * (e == 0 ? __builtin_bit_cast(float, xr[part][i + j] << 16) : __builtin_bit_cast(float, xr[part][i + j] & 0xffff0000u));
                        c[i][part][e] = a * __builtin_amdgcn_rcpf(1.0f + __expf(-a)); }
                ssum[2 * i] = c[i][0][0] * c[i][0][0] + c[i][0][1] * c[i][0][1]; ssum[2 * i + 1] = c[i][1][0] * c[i][1][0] + c[i][1][1] * c[i][1][1]; }
#pragma unroll
            for (int o = 1; o < 64; o <<= 1) {
#pragma unroll
                for (int q = 0; q < 16; ++q) ssum[q] += __shfl_xor(ssum[q], o); }
#pragma unroll
            for (int i = 0; i < 8; ++i) { const int row = wave * 8 + i;
                const float rq = 0.08838834764831845f * __builtin_amdgcn_rsqf(ssum[2 * i] + EPS), rk = __builtin_amdgcn_rsqf(ssum[2 * i + 1] + EPS);
                const float beta = GS[64 + row], eg = GS[128 + row];
                const float q0 = c[i][0][0] * rq, q1 = c[i][0][1] * rq, k0 = c[i][1][0] * rk, k1 = c[i][1][1] * rk;
                *(LAS unsigned*)(QS + row * DP_KP + 2 * lane) = pk2(q0, q1);
                *(LAS unsigned*)(KS + row * DP_KP + 2 * lane) = pk2(k0, k1);
                RHST[(2 * lane) * DP_RP + row] = f2bf(beta * c[i][2][0]); RHST[(2 * lane + 1) * DP_RP + row] = f2bf(beta * c[i][2][1]);
                RHST[(128 + 2 * lane) * DP_RP + row] = f2bf(beta * eg * k0); RHST[(128 + 2 * lane + 1) * DP_RP + row] = f2bf(beta * eg * k1); }
        }
        if (uid + (int)gridDim.x < NUNIT) DP_FETCH(uid + (int)gridDim.x, lane, wave);
        __syncthreads(); DPS(16);
        {
            const int ti = wave >> 1;
            f32x4 akk[2], aqk[2];
#pragma unroll
            for (int c = 0; c < 2; ++c) { akk[c] = (f32x4){0.f, 0.f, 0.f, 0.f}; aqk[c] = (f32x4){0.f, 0.f, 0.f, 0.f}; }
#pragma unroll
            for (int kb = 0; kb < 4; ++kb) {
                const bf16x8 ak = *(const LAS bf16x8*)(KS + (16 * ti + r16) * DP_KP + 32 * kb + 8 * g4), aq = *(const LAS bf16x8*)(QS + (16 * ti + r16) * DP_KP + 32 * kb + 8 * g4);
#pragma unroll
                for (int c = 0; c < 2; ++c) { const int tj = 2 * (wave & 1) + c; const bf16x8 bk = *(const LAS bf16x8*)(KS + (16 * tj + r16) * DP_KP + 32 * kb + 8 * g4);
                    akk[c] = __builtin_amdgcn_mfma_f32_16x16x32_bf16(ak, bk, akk[c], 0, 0, 0); aqk[c] = __builtin_amdgcn_mfma_f32_16x16x32_bf16(aq, bk, aqk[c], 0, 0, 0); }
            }
#pragma unroll
            for (int c = 0; c < 2; ++c) { const int tj = 2 * (wave & 1) + c, J = 16 * tj + r16; const float gj = GS[J];
#pragma unroll
                for (int i = 0; i < 4; ++i) { const int I = 16 * ti + 4 * g4 + i; const float dec = I >= J ? __expf(GS[I] - gj) : 0.f;
                    AM[I * DP_AMP + J] = I > J ? GS[64 + I] * akk[c][i] * dec : 0.f; QKM[I * DP_QKP + J] = f2bf(aqk[c][i] * dec); } }
        }
        __syncthreads(); DPS(17);
        if (wave == 0) {
            const int bb = g4, cc = r16; float t[16];
            f32x4 tr[16][4];
#pragma unroll
            for (int i = 1; i < 16; ++i)
#pragma unroll
                for (int j4 = 0; j4 < (i + 3) / 4; ++j4) tr[i][j4] = *(const LAS f32x4*)(AM + (16 * bb + i) * DP_AMP + 16 * bb + 4 * j4);
            __builtin_amdgcn_sched_barrier(0);
#pragma unroll
            for (int i = 0; i < 16; ++i) { float acc = (i == cc) ? 1.f : 0.f;
#pragma unroll
                for (int j = 0; j < i; ++j) acc -= tr[i][j >> 2][j & 3] * t[j];
                t[i] = acc; }
#pragma unroll
            for (int i = 0; i < 16; ++i) { DM[(16 * bb + i) * DP_DMP + cc] = t[i]; TB[(16 * bb + i) * DP_RP + 16 * bb + cc] = f2bf(t[i]); }
        } else if (wave >= 4) {
            for (int f = FR_QD + (wave - 4); f < FR_N; f += 4) {
                u32x4 o;
                if (f < FR_KTT) { const int mt = (f - FR_QD) >> 2, kb = (f - FR_QD) & 3, row = 16 * mt + r16; const float sc = GS[128 + row];
                    const u32x2 lo = *(const LAS u32x2*)(QS + row * DP_KP + 32 * kb + 4 * g4), hi = *(const LAS u32x2*)(QS + row * DP_KP + 32 * kb + 16 + 4 * g4);
                    const unsigned w[4] = {lo.x, lo.y, hi.x, hi.y}; unsigned r[4];
#pragma unroll
                    for (int e = 0; e < 4; ++e) r[e] = cvtpk_c(__builtin_bit_cast(float, w[e] << 16) * sc, __builtin_bit_cast(float, w[e] & 0xffff0000u) * sc);
                    o = (u32x4){r[0], r[1], r[2], r[3]};
                } else if (f < FR_QK) { const int kt = (f - FR_KTT) >> 1, tb = (f - FR_KTT) & 1; float v[8];
#pragma unroll
                    for (int j = 0; j < 8; ++j) { const int tok = 32 * tb + kperm(g4, j); v[j] = bf2f(KS[tok * DP_KP + 16 * kt + r16]) * GS[192 + tok]; }
                    o = (u32x4){cvtpk_c(v[0], v[1]), cvtpk_c(v[2], v[3]), cvtpk_c(v[4], v[5]), cvtpk_c(v[6], v[7])};
                } else { const int mt = (f - FR_QK) >> 1, tb = (f - FR_QK) & 1, row = 16 * mt + r16;
                    const u32x2 lo = *(const LAS u32x2*)(QKM + row * DP_QKP + 32 * tb + 4 * g4), hi = *(const LAS u32x2*)(QKM + row * DP_QKP + 32 * tb + 16 + 4 * g4);
                    o = (u32x4){lo.x, lo.y, hi.x, hi.y}; }
                *(u32x4*)(abu + (size_t)f * 1024 + lane * 16) = o;
            }
        }
        __syncthreads(); DPS(18);
        if (wave < 3) {
            const int j = wave; f32x4 Tk[4];
#pragma unroll
            for (int kk = 0; kk < 4; ++kk) Tk[j][kk] = DM[(16 * j + 4 * g4 + kk) * DP_DMP + r16];
#pragma unroll
            for (int i = 1; i < 4; ++i) if (i > j) {
                f32x4 acc = (f32x4){0.f, 0.f, 0.f, 0.f};
#pragma unroll
                for (int k = 0; k < 3; ++k) if (k >= j && k < i) { const f32x4 a = *(const LAS f32x4*)(AM + (16 * i + r16) * DP_AMP + 16 * k + 4 * g4);
#pragma unroll
                    for (int kk = 0; kk < 4; ++kk) acc = __builtin_amdgcn_mfma_f32_16x16x4f32(a[kk], Tk[k][kk], acc, 0, 0, 0); }
                const f32x4 dd = *(const LAS f32x4*)(DM + (16 * i + r16) * DP_DMP + 4 * g4);
                f32x4 res = (f32x4){0.f, 0.f, 0.f, 0.f};
#pragma unroll
                for (int kk = 0; kk < 4; ++kk) res = __builtin_amdgcn_mfma_f32_16x16x4f32(dd[kk], acc[kk], res, 0, 0, 0);
                Tk[i] = -res;
#pragma unroll
                for (int e = 0; e < 4; ++e) TB[(16 * i + 4 * g4 + e) * DP_RP + 16 * j + r16] = f2bf(Tk[i][e]); }
        }
        __syncthreads(); DPS(19);
        {
            const int mt = wave & 3, half = wave >> 2;
            bf16x8 tf[2];
#pragma unroll
            for (int kb = 0; kb < 2; ++kb) tf[kb] = *(const LAS bf16x8*)(TB + (16 * mt + r16) * DP_RP + 32 * kb + 8 * g4);
            if (half == 0) {
                float* wv = (float*)(p.ws + WS_DNF_WV + (size_t)uid * DNF_WV_UNIT) + (size_t)mt * 256 + lane * 4;
#pragma unroll
                for (int vt = 0; vt < 8; ++vt) { f32x4 acc = (f32x4){0.f, 0.f, 0.f, 0.f};
#pragma unroll
                    for (int kb = 0; kb < 2; ++kb) acc = __builtin_amdgcn_mfma_f32_16x16x32_bf16(tf[kb], *(const LAS bf16x8*)(RHST + (16 * vt + r16) * DP_RP + 32 * kb + 8 * g4), acc, 0, 0, 0);
                    *(f32x4*)(wv + (size_t)vt * 1024) = acc; }
            } else {
#pragma unroll
                for (int kbp = 0; kbp < 4; ++kbp) { f32x4 xt[2];
#pragma unroll
                    for (int c2 = 0; c2 < 2; ++c2) { xt[c2] = (f32x4){0.f, 0.f, 0.f, 0.f};
#pragma unroll
                        for (int kb = 0; kb < 2; ++kb) xt[c2] = __builtin_amdgcn_mfma_f32_16x16x32_bf16(*(const LAS bf16x8*)(RHST + (128 + 16 * (2 * kbp + c2) + r16) * DP_RP + 32 * kb + 8 * g4), tf[kb], xt[c2], 0, 0, 0); }
                    *(u32x4*)(abu + (size_t)(FR_NWK + mt * 4 + kbp) * 1024 + lane * 16) = __builtin_bit_cast(u32x4, pack8(-xt[0], -xt[1])); }
            }
        }
        __syncthreads(); DPS(20);
    }
#undef DP_FETCH
}

constexpr size_t O_ODN = O_Y;
#define DN_SB() __builtin_amdgcn_sched_barrier(0)
__device__ __forceinline__ void dn_consume(const LAS unsigned char* fb, int wl, f32x4 (&S)[8], float cd, float* op) {
    f32x4 u[4], o[4];
    bf16x8 fa[16], fq[16], Sb[4], Ub[2];
#pragma unroll
    for (int mt = 0; mt < 4; ++mt) u[mt] = *(const LAS f32x4*)(fb + (FR_N + wl * 4 + mt) * 1024);
#pragma unroll
    for (int f = 0; f < 16; ++f) fa[f] = *(const LAS bf16x8*)(fb + (FR_NWK + f) * 1024);
#pragma unroll
    for (int f = 0; f < 8; ++f) fq[f] = *(const LAS bf16x8*)(fb + (FR_QD + f) * 1024);
    DN_SB();
#pragma unroll
    for (int kb = 0; kb < 4; ++kb) Sb[kb] = pack8(S[2 * kb], S[2 * kb + 1]);
#pragma unroll
    for (int mt = 0; mt < 4; ++mt)
#pragma unroll
        for (int kb = 0; kb < 4; ++kb) u[mt] = __builtin_amdgcn_mfma_f32_16x16x32_bf16(fa[mt * 4 + kb], Sb[kb], u[mt], 0, 0, 0);
    DN_SB();
#pragma unroll
    for (int f = 8; f < 16; ++f) fq[f] = *(const LAS bf16x8*)(fb + (FR_QD + f) * 1024);
#pragma unroll
    for (int f = 0; f < 8; ++f) fa[f] = *(const LAS bf16x8*)(fb + (FR_KTT + f) * 1024);
    DN_SB();
#pragma unroll
    for (int mt = 0; mt < 4; ++mt) { o[mt] = (f32x4){0.f, 0.f, 0.f, 0.f};
#pragma unroll
        for (int kb = 0; kb < 4; ++kb) o[mt] = __builtin_amdgcn_mfma_f32_16x16x32_bf16(fq[mt * 4 + kb], Sb[kb], o[mt], 0, 0, 0); }
    DN_SB();
#pragma unroll
    for (int f = 8; f < 16; ++f) fa[f] = *(const LAS bf16x8*)(fb + (FR_KTT + f) * 1024);
#pragma unroll
    for (int f = 0; f < 8; ++f) fq[f] = *(const LAS bf16x8*)(fb + (FR_QK + f) * 1024);
#pragma unroll
    for (int tb = 0; tb < 2; ++tb) Ub[tb] = pack8(u[2 * tb], u[2 * tb + 1]);
#pragma unroll
    for (int kt = 0; kt < 8; ++kt) S[kt] = S[kt] * cd;
    DN_SB();
#pragma unroll
    for (int kt = 0; kt < 8; ++kt)
#pragma unroll
        for (int tb = 0; tb < 2; ++tb) S[kt] = __builtin_amdgcn_mfma_f32_16x16x32_bf16(fa[kt * 2 + tb], Ub[tb], S[kt], 0, 0, 0);
#pragma unroll
    for (int mt = 0; mt < 4; ++mt) {
#pragma unroll
        for (int tb = 0; tb < 2; ++tb) o[mt] = __builtin_amdgcn_mfma_f32_16x16x32_bf16(fq[mt * 2 + tb], Ub[tb], o[mt], 0, 0, 0);
#pragma unroll
        for (int i = 0; i < 4; ++i) op[(size_t)(16 * mt + i) * 512] = o[mt][i]; }
}
constexpr int DN_SBUF = 73728;
__device__ __forceinline__ void phase_dnscan(const P& p, LAS unsigned char* lds) {
    if (blockIdx.x >= BATCH * 4 * 2) return;
    const int tid = otid(), lane = tid & 63, wave = __builtin_amdgcn_readfirstlane(tid >> 6), r16 = lane & 15, g4 = lane >> 4;
    const int bh = blockIdx.x >> 1, vh = blockIdx.x & 1, h = bh & 3, b = bh >> 2, wl = wave & 3, vs = vh * 4 + wl, v0 = vs * 16;
    const float* cdp = ws_f(p, WS_DNF_CD) + (size_t)bh * NCHUNK;
    float* odn = p.out + O_ODN;
#define DN_BAR() do { asm volatile("s_waitcnt lgkmcnt(0)" ::: "memory"); __builtin_amdgcn_s_barrier(); asm volatile("" ::: "memory"); } while (0)
    if (wave >= 4) {
        const unsigned char* ab = p.ws + WS_DNF_AB + (size_t)bh * NCHUNK * DNF_AB_UNIT + lane * 16;
        const unsigned char* wvb = p.ws + WS_DNF_WV + (size_t)bh * NCHUNK * DNF_WV_UNIT + (size_t)vh * 16 * 1024 + lane * 16;
        u32x4 R[3][18];
#define DN_SRC(n_, q_) ((q_) < FR_N ? ab + (size_t)(n_) * DNF_AB_UNIT + (q_) * 1024 : wvb + (size_t)(n_) * DNF_WV_UNIT + ((q_) - FR_N) * 1024)
#define DN_LD(n_, s_) do { if ((n_) < NCHUNK) { _Pragma("unroll") for (int i_ = 0; i_ < 18; ++i_) R[s_][i_] = *(const u32x4*)DN_SRC(n_, wl * 18 + i_); } } while (0)
#define DN_ST(n_, s_) do { if ((n_) < NCHUNK) { LAS unsigned char* d_ = lds + ((n_) & 1) * DN_SBUF + wl * 18 * 1024 + lane * 16; _Pragma("unroll") for (int i_ = 0; i_ < 18; ++i_) *(LAS u32x4*)(d_ + i_ * 1024) = R[s_][i_]; } } while (0)
        DN_LD(0, 0); DN_LD(1, 1); DN_LD(2, 2); DN_ST(0, 0);
        DN_BAR();
#define DN_LSTEP(n_, s_) do { const int n = (n_); if (n < NCHUNK) { DN_LD(n + 3, s_); DN_ST(n + 1, ((s_) + 1) % 3); DN_BAR(); } } while (0)
        for (int n3 = 0; n3 < NCHUNK; n3 += 3) { DN_LSTEP(n3, 0); DN_LSTEP(n3 + 1, 1); DN_LSTEP(n3 + 2, 2); }
#undef DN_LSTEP
#undef DN_LD
#undef DN_ST
#undef DN_SRC
        return;
    }
    f32x4 S[8];
#pragma unroll
    for (int t = 0; t < 8; ++t) S[t] = (f32x4){0.f, 0.f, 0.f, 0.f};
    float cd = cdp[0];
    DN_BAR();
    for (int n = 0; n < NCHUNK; ++n) {
        const float cdn = cdp[n + 1 < NCHUNK ? n + 1 : n];
        dn_consume(lds + (n & 1) * DN_SBUF + lane * 16, wl, S, cd, odn + (size_t)(b * SEQ + n * 64 + 4 * g4) * 512 + h * 128 + v0 + r16);
        cd = cdn;
        DN_BAR();
    }
#undef DN_BAR
    {
        float* so = p.out + O_PSSM + (size_t)bh * 128 * 128 + v0 + r16;
#pragma unroll
        for (int kt = 0; kt < 8; ++kt)
#pragma unroll
            for (int i = 0; i < 4; ++i) so[(size_t)(16 * kt + 4 * g4 + i) * 128] = S[kt][i];
    }
}
__device__ __forceinline__ void phase_dngate(const P& p) {
    const int tid_ = otid(), lane = tid_ & 63, wave = tid_ >> 6;
    const int gw = blockIdx.x * NWAVES + wave, NGW = gridDim.x * NWAVES;
    const f32x4 nw0 = *(const f32x4*)(p.dn_norm_w + (lane & 15) * 8), nw1 = *(const f32x4*)(p.dn_norm_w + (lane & 15) * 8 + 4);
    f32x4 a, c; u32x4 z;
#define DG_LOAD(m_) do { const float* o_ = p.out + O_ODN + (size_t)(m_) * 512 + lane * 8; a = *(const f32x4*)o_; c = *(const f32x4*)(o_ + 4); z = *(const u32x4*)(ws_h(p, WS_PROJ) + (size_t)(m_) * PLD + PC_Z + lane * 8); } while (0)
    if (gw < TP) DG_LOAD(gw);
    for (int m = gw; m < TP; m += NGW) {
        const f32x4 a0 = a, c0 = c; const u32x4 z0 = z;
        if (m + NGW < TP) DG_LOAD(m + NGW);
        float ss = (a0[0] * a0[0] + a0[1] * a0[1]) + (a0[2] * a0[2] + a0[3] * a0[3]) + (c0[0] * c0[0] + c0[1] * c0[1]) + (c0[2] * c0[2] + c0[3] * c0[3]);
#pragma unroll
        for (int off = 1; off < 16; off <<= 1) ss += __shfl_xor(ss, off);
        const float rstd = 1.0f / sqrtf(ss * (1.0f / 128.0f) + EPS);
        const unsigned zw[4] = {z0.x, z0.y, z0.z, z0.w}; const float ov[8] = {a0[0], a0[1], a0[2], a0[3], c0[0], c0[1], c0[2], c0[3]}; const float nwv[8] = {nw0[0], nw0[1], nw0[2], nw0[3], nw1[0], nw1[1], nw1[2], nw1[3]};
        unsigned r[4];
#pragma unroll
        for (int e = 0; e < 4; ++e) { const float z0f = __builtin_bit_cast(float, zw[e] << 16), z1f = __builtin_bit_cast(float, zw[e] & 0xffff0000u);
            r[e] = pk2(ov[2 * e] * rstd * nwv[2 * e] * silu_f(z0f), ov[2 * e + 1] * rstd * nwv[2 * e + 1] * silu_f(z1f)); }
        *(u32x4*)(ws_h(p, WS_MIX) + (size_t)m * 1024 + lane * 8) = (u32x4){r[0], r[1], r[2], r[3]};
    }
#undef DG_LOAD
}
__device__ __forceinline__ void phase_dnsample(const P& p, LAS unsigned char* lds) {
    const int tid = otid(), lane = tid & 63, us = tid >> 8, w4 = (tid >> 6) & 3, kh = lane >> 5, col_ = w4 * 32 + (lane & 31);
    LAS float* QH = (LAS float*)lds + us * 4352;
    LAS float* KH = QH + 1024; LAS float* VH = QH + 2048; LAS float* OH = QH + 3072; LAS float* RED = QH + 4096;
    const bf16_t* PR = ws_h(p, WS_PROJ); const float* BG = ws_f(p, WS_BG);
    for (int ub = blockIdx.x; ub < DEC_BATCH * 2; ub += gridDim.x) {
        const int uidx = ub * 2 + us, b = uidx >> 2, h = uidx & 3, m0 = TP + b * DEC_SEQ;
        int col = col_; asm volatile("" : "+v"(col));
        {
            float x0[11], x1[11];
            const int ch0 = kh * 512 + h * 128 + col;
#pragma unroll
            for (int rr = 0; rr < 11; ++rr) {
                if (rr < 3) { const float* st = p.state_dn_conv + ((size_t)b * 3 + rr) * 1536; x0[rr] = st[ch0]; x1[rr] = st[1024 + h * 128 + col]; }
                else { const bf16_t* pr = PR + (size_t)(m0 + rr - 3) * PLD; x0[rr] = bf2f(pr[ch0]); x1[rr] = bf2f(pr[1024 + h * 128 + col]); } }
            float w0[4], w1[4];
#pragma unroll
            for (int j = 0; j < 4; ++j) { w0[j] = p.dn_conv_w[j * 1536 + ch0]; w1[j] = p.dn_conv_w[j * 1536 + 1024 + h * 128 + col]; }
#pragma unroll
            for (int t = 0; t < 8; ++t) { float a = 0.f, d = 0.f;
#pragma unroll
                for (int j = 0; j < 4; ++j) { a += w0[j] * x0[t + j]; d += w1[j] * x1[t + j]; }
                a = silu_f(a); d = silu_f(d);
                if (kh == 0) { QH[t * 128 + col] = a; VH[t * 128 + col] = d; } else KH[t * 128 + col] = a;
                const float sq = wave_sum(kh == 0 ? a * a : 0.f), sk = wave_sum(kh == 1 ? a * a : 0.f);
                if (lane == 0) { RED[w4 * 16 + t] = sq; RED[w4 * 16 + 8 + t] = sk; } }
        }
        __syncthreads();
#pragma unroll
        for (int t = 0; t < 8; ++t) {
            if (kh == 0) { const float sq = (RED[t] + RED[16 + t]) + (RED[32 + t] + RED[48 + t]); QH[t * 128 + col] *= 0.08838834764831845f / sqrtf(sq + EPS); }
            else { const float sk = (RED[8 + t] + RED[24 + t]) + (RED[40 + t] + RED[56 + t]); KH[t * 128 + col] *= 1.0f / sqrtf(sk + EPS); } }
        __syncthreads();
        float S[64];
        const float* S0 = p.state_dn_ssm + ((size_t)b * 4 + h) * 128 * 128 + (size_t)kh * 64 * 128 + col;
#pragma unroll
        for (int k = 0; k < 64; ++k) { S[k] = *S0; S0 += 128; if ((k & 7) == 7) asm volatile("" : "+v"(S0)); }
#pragma unroll 1
        for (int t = 0; t < 8; ++t) {
            const float beta = BG[(size_t)(m0 + t) * 8 + h], eg = expf(BG[(size_t)(m0 + t) * 8 + 4 + h]);
            const LAS float* kp = KH + t * 128 + kh * 64; const LAS float* qp = QH + t * 128 + kh * 64;
            float kS = 0.f;
#pragma unroll
            for (int k4 = 0; k4 < 16; ++k4) { const f32x4 kk = *(const LAS f32x4*)(kp + 4 * k4);
#pragma unroll
                for (int e = 0; e < 4; ++e) { S[4 * k4 + e] *= eg; kS += kk[e] * S[4 * k4 + e]; } }
            kS += __shfl_xor(kS, 32);
            const float u = beta * (VH[t * 128 + col] - kS);
            float o = 0.f;
#pragma unroll
            for (int k4 = 0; k4 < 16; ++k4) { const f32x4 kk = *(const LAS f32x4*)(kp + 4 * k4), qq = *(const LAS f32x4*)(qp + 4 * k4);
#pragma unroll
                for (int e = 0; e < 4; ++e) { S[4 * k4 + e] += kk[e] * u; o += qq[e] * S[4 * k4 + e]; } }
            o += __shfl_xor(o, 32);
            if (kh == 0) OH[t * 128 + col] = o;
        }
        float* So = p.out + O_SSSM + ((size_t)b * 4 + h) * 128 * 128 + (size_t)kh * 64 * 128 + col;
#pragma unroll
        for (int k = 0; k < 64; ++k) { *So = S[k]; So += 128; if ((k & 7) == 7) asm volatile("" : "+v"(So)); }
        __syncthreads();
#pragma unroll
        for (int t = 0; t < 8; ++t) { const float o = kh == 0 ? OH[t * 128 + col] : 0.f; const float s = wave_sum(o * o); if (lane == 0) RED[w4 * 16 + t] = s; }
        __syncthreads();
        if (kh == 0) {
            const float nw = p.dn_norm_w[col];
#pragma unroll
            for (int t = 0; t < 8; ++t) { const float rstd = 1.0f / sqrtf(((RED[t] + RED[16 + t]) + (RED[32 + t] + RED[48 + t])) * (1.0f / 128.0f) + EPS);
                const float z = bf2f(PR[(size_t)(m0 + t) * PLD + PC_Z + h * 128 + col]);
                ws_h(p, WS_MIX)[(size_t)(m0 + t) * 1024 + h * 128 + col] = f2bf(OH[t * 128 + col] * rstd * nw * silu_f(z)); }
        }
        __syncthreads();
    }
}
constexpr int NSEG = 16, CSEG = NCHUNK / NSEG, NBH = BATCH * 4;
static_assert(NCHUNK % NSEG == 0, "segments");
constexpr size_t O_RFRAG = O_ODN + (size_t)TP * 512;
constexpr size_t O_BSEG = O_RFRAG + (size_t)NBH * NSEG * 8192;
constexpr size_t O_SSEG = O_BSEG + (size_t)NBH * NSEG * 16384;
constexpr size_t O_CPROD = O_SSEG + (size_t)NBH * NSEG * 16384;
static_assert(O_CPROD + NBH * NSEG <= (size_t)T * D, "segment scratch fits in the y region of d_out");

template <bool HASWV> __device__ __forceinline__ void dn_consume_map(const LAS unsigned char* fb, int wl, f32x4 (&X)[8], float cd) {
    f32x4 u[4]; bf16x8 fa[16], fk[16], Xb[4], Ub[2];
#pragma unroll
    for (int mt = 0; mt < 4; ++mt) u[mt] = HASWV ? *(const LAS f32x4*)(fb + (FR_N + wl * 4 + mt) * 1024) : (f32x4){0.f, 0.f, 0.f, 0.f};
#pragma unroll
    for (int f = 0; f < 16; ++f) fa[f] = *(const LAS bf16x8*)(fb + (FR_NWK + f) * 1024);
#pragma unroll
    for (int f = 0; f < 8; ++f) fk[f] = *(const LAS bf16x8*)(fb + (FR_KTT + f) * 1024);
    DN_SB();
#pragma unroll
    for (int kb = 0; kb < 4; ++kb) Xb[kb] = pack8(X[2 * kb], X[2 * kb + 1]);
#pragma unroll
    for (int mt = 0; mt < 4; ++mt)
#pragma unroll
        for (int kb = 0; kb < 4; ++kb) u[mt] = __builtin_amdgcn_mfma_f32_16x16x32_bf16(fa[mt * 4 + kb], Xb[kb], u[mt], 0, 0, 0);
    DN_SB();
#pragma unroll
    for (int f = 8; f < 16; ++f) fk[f] = *(const LAS bf16x8*)(fb + (FR_KTT + f) * 1024);
#pragma unroll
    for (int tb = 0; tb < 2; ++tb) Ub[tb] = pack8(u[2 * tb], u[2 * tb + 1]);
#pragma unroll
    for (int kt = 0; kt < 8; ++kt) X[kt] = X[kt] * cd;
    DN_SB();
#pragma unroll
    for (int kt = 0; kt < 8; ++kt)
#pragma unroll
        for (int tb = 0; tb < 2; ++tb) X[kt] = __builtin_amdgcn_mfma_f32_16x16x32_bf16(fk[kt * 2 + tb], Ub[tb], X[kt], 0, 0, 0);
}
#define DNS_BAR() do { asm volatile("s_waitcnt lgkmcnt(0)" ::: "memory"); __builtin_amdgcn_s_barrier(); asm volatile("" ::: "memory"); } while (0)
template <int MODE> __device__ __forceinline__ void dns_loader(const P& p, LAS unsigned char* lds, int bh, int n0, int nsteps, int vh, int wl, int lane) {
    constexpr int NPW = MODE == 2 ? 18 : (MODE == 1 ? 12 : 8);
    const unsigned char* ab = p.ws + WS_DNF_AB + ((size_t)bh * NCHUNK + n0) * DNF_AB_UNIT + lane * 16;
    const unsigned char* wvb = p.ws + WS_DNF_WV + ((size_t)bh * NCHUNK + n0) * DNF_WV_UNIT + (size_t)vh * 16 * 1024 + lane * 16;
    u32x4 R[3][NPW];
#define DNS_FRAG(q_) (MODE == 2 ? (q_) : ((q_) < 16 ? (q_) : ((q_) < 32 ? FR_KTT + (q_) - 16 : FR_N + (q_) - 32)))
#define DNS_SRC(n_, q_) (DNS_FRAG(q_) < FR_N ? ab + (size_t)(n_) * DNF_AB_UNIT + DNS_FRAG(q_) * 1024 : wvb + (size_t)(n_) * DNF_WV_UNIT + (DNS_FRAG(q_) - FR_N) * 1024)
#define DNS_LD(n_, s_) do { if ((n_) < nsteps) { _Pragma("unroll") for (int i_ = 0; i_ < NPW; ++i_) R[s_][i_] = *(const u32x4*)DNS_SRC(n_, wl * NPW + i_); } } while (0)
#define DNS_ST(n_, s_) do { if ((n_) < nsteps) { LAS unsigned char* d_ = lds + ((n_) & 1) * DN_SBUF + lane * 16; _Pragma("unroll") for (int i_ = 0; i_ < NPW; ++i_) *(LAS u32x4*)(d_ + DNS_FRAG(wl * NPW + i_) * 1024) = R[s_][i_]; } } while (0)
    DNS_LD(0, 0); DNS_LD(1, 1); DNS_LD(2, 2); DNS_ST(0, 0);
    DNS_BAR();
#define DNS_LSTEP(n_, s_) do { const int n = (n_); if (n < nsteps) { DNS_LD(n + 3, s_); DNS_ST(n + 1, ((s_) + 1) % 3); DNS_BAR(); } } while (0)
    for (int n3 = 0; n3 < nsteps; n3 += 3) { DNS_LSTEP(n3, 0); DNS_LSTEP(n3 + 1, 1); DNS_LSTEP(n3 + 2, 2); }
#undef DNS_LSTEP
#undef DNS_LD
#undef DNS_ST
#undef DNS_SRC
#undef DNS_FRAG
}
constexpr int PA_RTP = 72;
template <int MODE> __device__ __forceinline__ void dns_passA_task(const P& p, LAS unsigned char* lds, int bh, int seg, int q, int wave, int lane) {
    const int r16 = lane & 15, g4 = lane >> 4, wl = wave & 3, n0 = seg * CSEG;
    const float* cdp = ws_f(p, WS_DNF_CD) + (size_t)bh * NCHUNK + n0;
    LAS bf16_t* RT = (LAS bf16_t*)lds;
    if (wave >= 4) { dns_loader<MODE>(p, lds, bh, n0, CSEG, q & 1, wl, lane); }
    else {
        f32x4 X[8];
#pragma unroll
        for (int kt = 0; kt < 8; ++kt)
#pragma unroll
            for (int i = 0; i < 4; ++i) X[kt][i] = (MODE == 0 && 16 * kt + 4 * g4 + i == 64 * q + 16 * wl + r16) ? 1.f : 0.f;
        float cd = cdp[0], cprod = 1.f;
        DNS_BAR();
        for (int n = 0; n < CSEG; ++n) {
            const float cdn = cdp[n + 1 < CSEG ? n + 1 : n];
            dn_consume_map<MODE == 1>(lds + (n & 1) * DN_SBUF + lane * 16, wl, X, cd);
            cprod *= cd; cd = cdn;
            DNS_BAR();
        }
        if (MODE == 0) {
#pragma unroll
            for (int kt = 0; kt < 8; ++kt)
#pragma unroll
                for (int i = 0; i < 4; ++i) { const int row = 16 * kt + 4 * g4 + i, col = 16 * wl + r16; const float v = X[kt][i] - ((row == 64 * q + col) ? cprod : 0.f);
                    RT[row * PA_RTP + col] = f2bf(v); }
            if (q == 0 && wave == 0 && lane == 0) p.out[O_CPROD + bh * NSEG + seg] = cprod;
        } else {
            float* bo = p.out + O_BSEG + ((size_t)(bh * NSEG + seg) * 8 + (4 * (q & 1) + wl)) * 2048 + lane * 4;
#pragma unroll
            for (int kt = 0; kt < 8; ++kt) *(f32x4*)(bo + kt * 256) = X[kt];
        }
    }
    DNS_BAR();
    if (MODE == 0) {
#pragma unroll
        for (int j = 0; j < 2; ++j) { const int f = wave * 2 + j, mt = f >> 1, kbl = f & 1, row = 16 * mt + r16;
            const u32x2 lo = *(const LAS u32x2*)(RT + row * PA_RTP + 32 * kbl + 4 * g4), hi = *(const LAS u32x2*)(RT + row * PA_RTP + 32 * kbl + 16 + 4 * g4);
            *(u32x4*)((unsigned char*)(p.out + O_RFRAG) + ((size_t)(bh * NSEG + seg) * 32 + mt * 4 + 2 * q + kbl) * 1024 + lane * 16) = (u32x4){lo.x, lo.y, hi.x, hi.y}; }
        DNS_BAR();
    }
}
__device__ __forceinline__ void phase_dns_passA(const P& p, LAS unsigned char* lds) {
    const int tid = otid(), lane = tid & 63, wave = __builtin_amdgcn_readfirstlane(tid >> 6);
    for (int t = blockIdx.x; t < NBH * NSEG * 4; t += gridDim.x) {
        const int q = t & 3, seg = (t >> 2) % NSEG, bh = t / (4 * NSEG);
        if (q < 2) dns_passA_task<0>(p, lds, bh, seg, q, wave, lane); else dns_passA_task<1>(p, lds, bh, seg, q, wave, lane);
    }
}
__device__ __forceinline__ void phase_dns_passB(const P& p, LAS unsigned char* lds) {
    if ((int)blockIdx.x >= NBH * 8) return;
    const int tid = otid(), lane = tid & 63, w = __builtin_amdgcn_readfirstlane(tid >> 6), r16 = lane & 15, g4 = lane >> 4;
    const int bh = blockIdx.x >> 3, vs = blockIdx.x & 7;
    LAS u32x2* XB = (LAS u32x2*)lds;
    const unsigned char* rf0 = (const unsigned char*)(p.out + O_RFRAG) + ((size_t)bh * NSEG * 32 + w * 4) * 1024 + lane * 16;
    const float* bt0 = p.out + O_BSEG + ((size_t)bh * NSEG * 8 + vs) * 2048 + w * 256 + lane * 4;
    float* ss0 = p.out + O_SSEG + ((size_t)bh * NSEG * 8 + vs) * 2048 + w * 256 + lane * 4;
    const float* cp0 = p.out + O_CPROD + bh * NSEG;
    u32x4 rf[4][4]; f32x4 bt[4]; float cp[4];
#define PB_LD(s_, r_) do { if ((s_) < NSEG) { _Pragma("unroll") for (int kb = 0; kb < 4; ++kb) rf[r_][kb] = *(const u32x4*)(rf0 + (size_t)(s_) * 32768 + kb * 1024); bt[r_] = *(const f32x4*)(bt0 + (size_t)(s_) * 16384); cp[r_] = cp0[(s_)]; } } while (0)
    PB_LD(0, 0); PB_LD(1, 1); PB_LD(2, 2);
    f32x4 S = (f32x4){0.f, 0.f, 0.f, 0.f};
#pragma unroll
    for (int s = 0; s < NSEG; ++s) {
        PB_LD(s + 3, (s + 3) & 3);
        *(f32x4*)(ss0 + (size_t)s * 16384) = S;
        XB[((s & 1) * 8 + w) * 64 + lane] = (u32x2){cvtpk_c(S[0], S[1]), cvtpk_c(S[2], S[3])};
        DNS_BAR();
        f32x4 acc = S * cp[s & 3] + bt[s & 3];
#pragma unroll
        for (int kb = 0; kb < 4; ++kb) { const u32x2 lo = XB[((s & 1) * 8 + 2 * kb) * 64 + lane], hi = XB[((s & 1) * 8 + 2 * kb + 1) * 64 + lane];
            acc = __builtin_amdgcn_mfma_f32_16x16x32_bf16(__builtin_bit_cast(bf16x8, rf[s & 3][kb]), __builtin_bit_cast(bf16x8, (u32x4){lo.x, lo.y, hi.x, hi.y}), acc, 0, 0, 0); }
        S = acc;
    }
#undef PB_LD
    float* so = p.out + O_PSSM + (size_t)bh * 128 * 128 + vs * 16 + r16;
#pragma unroll
    for (int i = 0; i < 4; ++i) so[(size_t)(16 * w + 4 * g4 + i) * 128] = S[i];
    DNS_BAR();
}
__device__ __forceinline__ void phase_dns_passC(const P& p, LAS unsigned char* lds) {
    const int tid = otid(), lane = tid & 63, wave = __builtin_amdgcn_readfirstlane(tid >> 6), r16 = lane & 15, g4 = lane >> 4, wl = wave & 3;
    for (int t = blockIdx.x; t < NBH * NSEG * 2; t += gridDim.x) {
        const int vh = t & 1, seg = (t >> 1) % NSEG, bh = t / (2 * NSEG), h = bh & 3, b = bh >> 2, vs = vh * 4 + wl, n0 = seg * CSEG;
        if (wave >= 4) dns_loader<2>(p, lds, bh, n0, CSEG, vh, wl, lane);
        else {
            const float* cdp = ws_f(p, WS_DNF_CD) + (size_t)bh * NCHUNK + n0;
            const float* ss = p.out + O_SSEG + ((size_t)(bh * NSEG + seg) * 8 + vs) * 2048 + lane * 4;
            f32x4 S[8];
#pragma unroll
            for (int kt = 0; kt < 8; ++kt) S[kt] = *(const f32x4*)(ss + kt * 256);
            float cd = cdp[0];
            DNS_BAR();
            for (int n = 0; n < CSEG; ++n) {
                const float cdn = cdp[n + 1 < CSEG ? n + 1 : n];
                dn_consume(lds + (n & 1) * DN_SBUF + lane * 16, wl, S, cd, p.out + O_ODN + (size_t)(b * SEQ + (n0 + n) * 64 + 4 * g4) * 512 + h * 128 + vs * 16 + r16);
                cd = cdn;
                DNS_BAR();
            }
        }
        DNS_BAR();
    }
}
#undef DNS_BAR
constexpr size_t WS_EDGE = WS_FREE;
constexpr size_t WS_HEAD = al256(WS_EDGE + (size_t)(T / 256) * 2 * 2 * DFF * 4);
constexpr size_t WS_END = al256(WS_HEAD + (size_t)(T / 256) * 2 * 2 * DFF * 4);
constexpr int EX_OFF = 131072;
namespace pg8 {
typedef unsigned u32x2v __attribute__((ext_vector_type(2)));
__device__ __forceinline__ float dpp_shr1(float old, float src) { return __builtin_bit_cast(float, __builtin_amdgcn_update_dpp(__builtin_bit_cast(int, old), __builtin_bit_cast(int, src), 0x111, 0xf, 0xf, false)); }
__device__ __forceinline__ float dpp_shr2(float old, float src) { return __builtin_bit_cast(float, __builtin_amdgcn_update_dpp(__builtin_bit_cast(int, old), __builtin_bit_cast(int, src), 0x112, 0xf, 0xf, false)); }
__device__ __forceinline__ float dpp_ror1(float src) { return __builtin_bit_cast(float, __builtin_amdgcn_update_dpp(0, __builtin_bit_cast(int, src), 0x121, 0xf, 0xf, false)); }
__device__ __forceinline__ float dpp_ror2(float src) { return __builtin_bit_cast(float, __builtin_amdgcn_update_dpp(0, __builtin_bit_cast(int, src), 0x122, 0xf, 0xf, false)); }
struct EpiFfnUp {
    static constexpr bool PERM = false, AFTER_DRAIN = false;
    bf16_t* ACT; float* edge; float* head; const float* cw; const float* cb; const float* state; float* out_pfc; float* out_sfc; PG8_LAS unsigned char* lds;
    __device__ __forceinline__ void operator()(const f32x4 (&acc)[2][2][4][2], const Unit& u, int wr, int wc, int fr, int fq) const {
        PG8_LAS float* EX = (PG8_LAS float*)(lds + EX_OFF);
        const bool smp = u.pm >= TP / BM;
        const int cl = wc * 32 + 4 * fq;
        if (fr >= 14) {
#pragma unroll
            for (int ai = 0; ai < 2; ++ai)
#pragma unroll
                for (int bj = 0; bj < 2; ++bj)
#pragma unroll
                    for (int n = 0; n < 2; ++n) *(PG8_LAS f32x4*)(EX + ((2 * ai + wr) * 2 + (fr - 14)) * 256 + bj * HALF + cl + 16 * n) = acc[ai][bj][3][n];
            if (wr == 1) {
#pragma unroll
                for (int bj = 0; bj < 2; ++bj)
#pragma unroll
                    for (int n = 0; n < 2; ++n) { const int oc = bj * DFF + u.pn * HALF + cl + 16 * n;
                        *(f32x4*)(edge + ((size_t)u.pm * 2 + (fr - 14)) * 2 * DFF + oc) = acc[1][bj][3][n];
                        if (!smp && (u.pm & (SEQ / BM - 1)) == SEQ / BM - 1) *(f32x4*)(out_pfc + ((size_t)(u.pm / (SEQ / BM)) * 2 + (fr - 14)) * 2 * DFF + oc) = acc[1][bj][3][n]; }
            }
        }
        if (fr < 2 && wr == 0) {
#pragma unroll
            for (int bj = 0; bj < 2; ++bj)
#pragma unroll
                for (int n = 0; n < 2; ++n) *(f32x4*)(head + ((size_t)u.pm * 2 + fr) * 2 * DFF + bj * DFF + u.pn * HALF + cl + 16 * n) = acc[0][bj][0][n];
        }
        asm volatile("s_waitcnt lgkmcnt(0)" ::: "memory"); __builtin_amdgcn_s_barrier(); asm volatile("" ::: "memory");
#pragma unroll
        for (int n = 0; n < 2; ++n) {
            const int f0 = u.pn * HALF + cl + 16 * n;
            f32x4 wg[3], wu[3], bg, bu;
#pragma unroll
            for (int j = 0; j < 3; ++j) { wg[j] = *(const f32x4*)(cw + (size_t)j * 2 * DFF + f0); wu[j] = *(const f32x4*)(cw + (size_t)j * 2 * DFF + DFF + f0); }
            bg = *(const f32x4*)(cb + f0); bu = *(const f32x4*)(cb + DFF + f0);
#pragma unroll
            for (int ai = 0; ai < 2; ++ai) {
                const int s = 2 * ai + wr;
                f32x4 pg = (f32x4){0.f, 0.f, 0.f, 0.f}, pu = pg;
                if (!smp && s > 0 && fr >= 14) { pg = *(const PG8_LAS f32x4*)(EX + ((s - 1) * 2 + (fr - 14)) * 256 + cl + 16 * n); pu = *(const PG8_LAS f32x4*)(EX + ((s - 1) * 2 + (fr - 14)) * 256 + HALF + cl + 16 * n); }
#pragma unroll
                for (int m = 0; m < 4; ++m) {
                    const f32x4 cg = acc[ai][0][m][n], cu = acc[ai][1][m][n];
                    const int row = u.pm * BM + ai * HALF + wr * 64 + m * 16 + fr;
                    f32x4 g1, g2, u1, u2;
#pragma unroll
                    for (int e = 0; e < 4; ++e) { g1[e] = dpp_shr1(dpp_ror1(pg[e]), cg[e]); g2[e] = dpp_shr2(dpp_ror2(pg[e]), cg[e]); u1[e] = dpp_shr1(dpp_ror1(pu[e]), cu[e]); u2[e] = dpp_shr2(dpp_ror2(pu[e]), cu[e]); }
                    if (smp) {
                        const int t = fr & 7, b = (row - TP) >> 3;
                        if (t < 2) { const float* st = state + (size_t)b * 2 * 2 * DFF + f0; const f32x4 s1g = *(const f32x4*)(st + 2 * DFF), s1u = *(const f32x4*)(st + 2 * DFF + DFF);
                            if (t == 0) { g1 = s1g; u1 = s1u; g2 = *(const f32x4*)st; u2 = *(const f32x4*)(st + DFF); } else { g2 = s1g; u2 = s1u; } }
                        if (t >= 6) { float* o = out_sfc + ((size_t)b * 2 + (t - 6)) * 2 * DFF + f0; *(f32x4*)o = cg; *(f32x4*)(o + DFF) = cu; }
                    }
                    const f32x4 gc = wg[0] * g2 + wg[1] * g1 + wg[2] * cg + bg, uc = wu[0] * u2 + wu[1] * u1 + wu[2] * cu + bu;
                    u32x2v w;
                    { const float a0 = gc[0] / (1.0f + __expf(-gc[0])) * uc[0], a1 = gc[1] / (1.0f + __expf(-gc[1])) * uc[1], a2 = gc[2] / (1.0f + __expf(-gc[2])) * uc[2], a3 = gc[3] / (1.0f + __expf(-gc[3])) * uc[3];
                      w.x = cvt_pk_bf16(a0, a1); w.y = cvt_pk_bf16(a2, a3); }
                    *(u32x2v*)(ACT + (size_t)row * DFF + f0) = w;
                    pg = cg; pu = cu;
                }
            }
        }
    }
};
}
__device__ __forceinline__ void phase_ffn_fix(const P& p) {
    constexpr int TPS = SEQ / 256;
    const long n = (long)(BATCH * TPS) * DFF;
    const float* edge = ws_f(p, WS_EDGE); const float* head = ws_f(p, WS_HEAD);
    for (long i = blockIdx.x * (long)NTHR + otid(); i < n; i += (long)gridDim.x * NTHR) {
        const int pm = (int)(i / DFF), f = (int)(i % DFF);
        if (pm % TPS == 0) continue;
        float r0[2], r1[2];
#pragma unroll
        for (int gu = 0; gu < 2; ++gu) { const int c = gu * DFF + f;
            const float um2 = edge[((size_t)(pm - 1) * 2 + 0) * 2 * DFF + c], um1 = edge[((size_t)(pm - 1) * 2 + 1) * 2 * DFF + c], u0 = head[((size_t)pm * 2 + 0) * 2 * DFF + c], u1 = head[((size_t)pm * 2 + 1) * 2 * DFF + c];
            const float w0 = p.ffn_conv_w[c], w1 = p.ffn_conv_w[2 * DFF + c], w2 = p.ffn_conv_w[4 * DFF + c], bb = p.ffn_conv_b[c];
            r0[gu] = w0 * um2 + w1 * um1 + w2 * u0 + bb; r1[gu] = w0 * um1 + w1 * u0 + w2 * u1 + bb; }
        bf16_t* ACT = ws_h(p, WS_ACT) + (size_t)pm * 256 * DFF + f;
        ACT[0] = f2bf(silu_f(r0[0]) * r0[1]); ACT[DFF] = f2bf(silu_f(r1[0]) * r1[1]);
    }
}
constexpr int SW_KP = 72;
__device__ __forceinline__ void swa_qtile(const LAS bf16_t* KS, const LAS bf16_t* VT, int vtp, int qt, const bf16_t* qptr, int qrow_mask, const LAS float* BT, float sink, bool first, bf16_t* optr, int nvalid_q, int lane) {
    const int r16 = lane & 15, g4 = lane >> 4, kt0 = qt;
    bf16x8 bq[2];
#pragma unroll
    for (int ks = 0; ks < 2; ++ks) bq[ks] = *(const bf16x8*)(qptr + (size_t)(r16 & qrow_mask) * PLD + 32 * ks + 8 * g4);
    f32x4 s[10];
#pragma unroll
    for (int t = 0; t < 9; ++t) { f32x4 a = (f32x4){0.f, 0.f, 0.f, 0.f};
#pragma unroll
        for (int ks = 0; ks < 2; ++ks) a = __builtin_amdgcn_mfma_f32_16x16x32_bf16(*(const LAS bf16x8*)(KS + (16 * (kt0 + t) + r16) * SW_KP + 32 * ks + 8 * g4), bq[ks], a, 0, 0, 0);
        s[t] = a; }
    float mx = sink;
#pragma unroll
    for (int t = 0; t < 9; ++t)
#pragma unroll
        for (int e = 0; e < 4; ++e) { const int jj = 16 * (kt0 + t) + 4 * g4 + e, d = 128 + 16 * qt + r16 - jj; const bool ok = d >= 0 && d <= 127 && !(first && jj < 128);
            const float v = ok ? s[t][e] * 0.125f + BT[ok ? d : 0] : -1e30f; s[t][e] = v; mx = fmaxf(mx, v); }
    mx = fmaxf(mx, __shfl_xor(mx, 16)); mx = fmaxf(mx, __shfl_xor(mx, 32));
    float l = 0.f;
#pragma unroll
    for (int t = 0; t < 9; ++t)
#pragma unroll
        for (int e = 0; e < 4; ++e) { const float pv = __expf(s[t][e] - mx); s[t][e] = pv; l += pv; }
    s[9] = (f32x4){0.f, 0.f, 0.f, 0.f};
    l += __shfl_xor(l, 16); l += __shfl_xor(l, 32);
    l += __expf(sink - mx);
    const float rl = 1.0f / l;
    bf16x8 pb[5];
#pragma unroll
    for (int q = 0; q < 5; ++q) pb[q] = pack8(s[2 * q], s[2 * q + 1]);
#pragma unroll
    for (int dt = 0; dt < 4; ++dt) { f32x4 o = (f32x4){0.f, 0.f, 0.f, 0.f};
#pragma unroll
        for (int q = 0; q < 5; ++q) { const LAS bf16_t* vp = VT + (16 * dt + r16) * vtp + 16 * (kt0 + 2 * q) + 4 * g4;
            const u32x2 lo = *(const LAS u32x2*)vp, hi = *(const LAS u32x2*)(vp + 16);
            o = __builtin_amdgcn_mfma_f32_16x16x32_bf16(__builtin_bit_cast(bf16x8, (u32x4){lo.x, lo.y, hi.x, hi.y}), pb[q], o, 0, 0, 0); }
        if (r16 < nvalid_q) *(u32x2*)(optr + (size_t)r16 * 1024 + 16 * dt + 4 * g4) = (u32x2){cvtpk_c(o[0] * rl, o[1] * rl), cvtpk_c(o[2] * rl, o[3] * rl)}; }
}
constexpr int SWP_VTP = 272, SWS_NK = 144, SWS_VTP = 168;
constexpr int SW_KS = 0, SW_VT = 43008, SW_BT = 86016, SW_END = SW_BT + 8 * 128 * 4;
static_assert(256 * SW_KP * 2 <= SW_VT && SW_VT + 64 * SWP_VTP * 2 <= SW_BT && 2 * SWS_NK * SW_KP * 2 <= SW_VT && SW_VT + 2 * 64 * SWS_VTP * 2 <= SW_BT, "swa LDS map");
__device__ __forceinline__ void phase_swa(const P& p, LAS unsigned char* lds) {
    const int tid = otid(), lane = tid & 63, wave = tid >> 6;
    LAS bf16_t* KS = (LAS bf16_t*)(lds + SW_KS); LAS bf16_t* VT = (LAS bf16_t*)(lds + SW_VT); LAS float* BT = (LAS float*)(lds + SW_BT);
    const bf16_t* PR = ws_h(p, WS_PROJ); bf16_t* MX = ws_h(p, WS_MIX);
    constexpr int NQB = SEQ / 128, NPU = BATCH * NQB * 2, NU = NPU + DEC_BATCH;
    for (int i = tid; i < 8 * 128; i += NTHR) BT[i] = p.rel_bias[t5_bucket(i & 127) * 8 + (i >> 7)];
    for (int u = blockIdx.x; u < NU; u += gridDim.x) {
        __syncthreads();
        if (u < NPU) {
            const int kvh = u & 1, qb = (u >> 1) % NQB, b = (u >> 1) / NQB, m0 = b * SEQ + qb * 128; const bool first = qb == 0;
            for (int it = tid; it < 256 * 8; it += NTHR) { const int jj = it >> 3, c = it & 7; u32x4 v = (u32x4){0u, 0u, 0u, 0u};
                if (!(first && jj < 128)) v = *(const u32x4*)(PR + (size_t)(m0 - 128 + jj) * PLD + PC_SK + kvh * 64 + 8 * c);
                *(LAS u32x4*)(KS + jj * SW_KP + 8 * c) = v; }
            for (int it = tid; it < 272 * 8; it += NTHR) { const int jj = it % 272, c = it / 272; u32x4 v = (u32x4){0u, 0u, 0u, 0u};
                if (jj < 256 && !(first && jj < 128)) v = *(const u32x4*)(PR + (size_t)(m0 - 128 + jj) * PLD + PC_SV + kvh * 64 + 8 * c);
                const unsigned w[4] = {v.x, v.y, v.z, v.w};
#pragma unroll
                for (int e = 0; e < 4; ++e) { VT[(8 * c + 2 * e) * SWP_VTP + jj] = (bf16_t)(w[e] & 0xffffu); VT[(8 * c + 2 * e + 1) * SWP_VTP + jj] = (bf16_t)(w[e] >> 16); } }
            __syncthreads();
            const int hq = kvh * 4 + (wave >> 1), qh = wave & 1;
#pragma unroll 1
            for (int q4 = 0; q4 < 4; ++q4) { const int qt = 4 * qh + q4;
                swa_qtile(KS, VT, SWP_VTP, qt, PR + (size_t)(m0 + 16 * qt) * PLD + PC_SQ + hq * 64, 15, BT + hq * 128, p.swa_sinks[hq], first, MX + (size_t)(m0 + 16 * qt) * 1024 + 512 + hq * 64, 16, lane); }
        } else {
            const int b = u - NPU, m0 = TP + b * DEC_SEQ;
            for (int it = tid; it < 2 * SWS_NK * 8; it += NTHR) { const int kvh = it / (SWS_NK * 8), r = it % (SWS_NK * 8), jj = r >> 3, c = r & 7; u32x4 v = (u32x4){0u, 0u, 0u, 0u};
                if (jj < 128) { const float* src = p.cache_k + ((size_t)b * 128 + jj) * 128 + kvh * 64 + 8 * c; const f32x4 a = *(const f32x4*)src, d = *(const f32x4*)(src + 4);
                    v = (u32x4){pk2(a[0], a[1]), pk2(a[2], a[3]), pk2(d[0], d[1]), pk2(d[2], d[3])}; }
                else if (jj < 128 + DEC_SEQ) v = *(const u32x4*)(PR + (size_t)(m0 + jj - 128) * PLD + PC_SK + kvh * 64 + 8 * c);
                *(LAS u32x4*)(KS + (kvh * SWS_NK + jj) * SW_KP + 8 * c) = v; }
            for (int it = tid; it < 2 * SWS_VTP * 8; it += NTHR) { const int kvh = it / (SWS_VTP * 8), r = it % (SWS_VTP * 8), jj = r % SWS_VTP, c = r / SWS_VTP; float f[8];
#pragma unroll
                for (int e = 0; e < 8; ++e) f[e] = 0.f;
                if (jj < 128) { const float* src = p.cache_v + ((size_t)b * 128 + jj) * 128 + kvh * 64 + 8 * c; const f32x4 a = *(const f32x4*)src, d = *(const f32x4*)(src + 4);
                    f[0] = a[0]; f[1] = a[1]; f[2] = a[2]; f[3] = a[3]; f[4] = d[0]; f[5] = d[1]; f[6] = d[2]; f[7] = d[3]; }
                else if (jj < 128 + DEC_SEQ) { const bf16_t* src = PR + (size_t)(m0 + jj - 128) * PLD + PC_SV + kvh * 64 + 8 * c;
#pragma unroll
                    for (int e = 0; e < 8; ++e) f[e] = bf2f(src[e]); }
#pragma unroll
                for (int e = 0; e < 8; ++e) VT[(kvh * 64 + 8 * c + e) * SWS_VTP + jj] = f2bf(f[e]); }
            __syncthreads();
            const int kvh = wave >> 2, hq = kvh * 4 + (wave & 3);
            swa_qtile(KS + kvh * SWS_NK * SW_KP, VT + kvh * 64 * SWS_VTP, SWS_VTP, 0, PR + (size_t)m0 * PLD + PC_SQ + hq * 64, 7, BT + hq * 128, p.swa_sinks[hq], false, MX + (size_t)m0 * 1024 + 512 + hq * 64, 8, lane);
        }
    }
    __syncthreads();
}
static void fill_params(P& p, void* const* d_in, void* d_out, void* d_ws) {
    const float** pp = (const float**)&p;
    for (int i = 0; i < 26; ++i) pp[i] = (const float*)d_in[i];
    p.out = (float*)d_out; p.ws = (unsigned char*)d_ws;
}
namespace cg = cooperative_groups;
constexpr int CW_BAR = 1024;
constexpr size_t CTL_ZERO_BYTES = 65536;

#ifndef PROBE_MASK
#define PROBE_MASK 0
#endif
#ifndef PROBE_K
#define PROBE_K 4
#endif
#ifndef PROBE_XSYNC
#define PROBE_XSYNC 0
#endif
#if PROBE_MASK
#define PROBE_SUB(k) do { xcd_barrier(bar); PROBE_STAMP(k); } while (0)
#define PROBE_DECL unsigned long long pr_prev = __builtin_amdgcn_s_memrealtime(), pr_acc = 0ull
#define PROBE_STAMP(k) do { const unsigned long long now_ = __builtin_amdgcn_s_memrealtime(); if ((PROBE_MASK >> (k)) & 1) pr_acc += now_ - pr_prev; pr_prev = now_; } while (0)
#define PROBE_END() do { xcd_barrier(bar); PROBE_STAMP(11); if (blockIdx.x == 0 && threadIdx.x == 0) { const unsigned long long t0_ = __builtin_amdgcn_s_memrealtime(); while (__builtin_amdgcn_s_memrealtime() - t0_ < (unsigned long long)PROBE_K * pr_acc) __builtin_amdgcn_s_sleep(8); } } while (0)
#else
#define PROBE_DECL unsigned long long pr_prev = 0ull, pr_acc = 0ull
#define PROBE_SUB(k)
#define PROBE_STAMP(k)
#define PROBE_END() do { for (int i_ = 0; i_ < PROBE_XSYNC; ++i_) xcd_barrier(bar); } while (0)
#endif
__global__ void __launch_bounds__(512, 2) fwd_megakernel(P p) {
    extern __shared__ __attribute__((aligned(16))) unsigned char lds_raw[];
    LAS unsigned char* lds = (LAS unsigned char*)lds_raw;
    cg::grid_group grid = cg::this_grid();
    PROBE_DECL;
    volatile LAS unsigned* MISC = (volatile LAS unsigned*)(lds + LDS_BYTES - 64);
    if (threadIdx.x < 16) MISC[threadIdx.x] = 0u;
    __syncthreads();
    const XcdBarrier bar = xcd_barrier_post((unsigned*)(p.ws + WS_CTL) + CW_BAR, MISC);
    phase_mod(p, lds); phase_transposes(p, lds);
    if (p.ws == nullptr) grid.sync();
    xcd_barrier(bar); PROBE_STAMP(0);
    phase_norm<0>(p);
    xcd_barrier(bar); PROBE_STAMP(1);
    { pg8::StaticOrder S; pg8::Gemm g{ws_h(p, WS_H), ws_h(p, WS_WT_IN), T, PLD, D}; S.init(T, PLD, gridDim.x, blockIdx.x, D); pg8::EpiStoreBf16 E{ws_h(p, WS_PROJ), PLD};
      pg8::gemm_phase<pg8::EpiStoreBf16, pg8::StaticOrder, true, true>(lds, g, S, E); }
    xcd_barrier(bar); PROBE_STAMP(2);
    phase_state_out(p);
    PROBE_STAMP(21);
    phase_dnprep(p, lds, pr_prev, pr_acc);
    PROBE_SUB(12);
    phase_dnsample(p, lds);
    PROBE_SUB(13);
    phase_swa(p, lds);
    xcd_barrier(bar); PROBE_STAMP(3);
    phase_dns_passA(p, lds);
    xcd_barrier(bar); PROBE_STAMP(14);
    phase_dns_passB(p, lds);
    xcd_barrier(bar); PROBE_STAMP(15);
    phase_dns_passC(p, lds);
    xcd_barrier(bar); PROBE_STAMP(4);
    phase_dngate(p);
    xcd_barrier(bar); PROBE_STAMP(5);
    { pg8::SplitOrder S; pg8::Gemm g{ws_h(p, WS_MIX), ws_h(p, WS_WT_OUT), T, D, 1024}; S.init(D, 1024, NS_OUT, gridDim.x, blockIdx.x); pg8::EpiGateRes E{p.x_prompt, p.x_sample, p.out + O_Y, ws_f(p, WS_MOD) + 2 * D, ws_f(p, WS_SLAB), NS_OUT};
      pg8::gemm_phase<pg8::EpiGateRes, pg8::SplitOrder, true, true>(lds, g, S, E); }
    xcd_barrier(bar); PROBE_STAMP(6);
    phase_norm<1>(p);
    xcd_barrier(bar); PROBE_STAMP(7);
    { pg8::StaticOrder S; pg8::Gemm g{ws_h(p, WS_H), ws_h(p, WS_WT_UP), T, 2 * DFF, D}; S.init(T, 2 * DFF, gridDim.x, blockIdx.x, D);
      pg8::EpiFfnUp E{ws_h(p, WS_ACT), ws_f(p, WS_EDGE), ws_f(p, WS_HEAD), p.ffn_conv_w, p.ffn_conv_b, p.state_ffn, p.out + O_PFC, p.out + O_SFC, lds};
      pg8::gemm_phase<pg8::EpiFfnUp, pg8::StaticOrder, true, true>(lds, g, S, E); }
    xcd_barrier(bar); PROBE_STAMP(8);
    phase_ffn_fix(p);
    xcd_barrier(bar); PROBE_STAMP(9);
    { pg8::SplitOrder S; pg8::Gemm g{ws_h(p, WS_ACT), ws_h(p, WS_WT_DN), T, D, DFF}; S.init(D, DFF, NS_DN, gridDim.x, blockIdx.x); pg8::EpiGateRes E{p.out + O_Y, p.out + O_Y + (size_t)TP * D, p.out + O_Y, ws_f(p, WS_MOD) + 5 * D, ws_f(p, WS_SLAB), NS_DN};
      pg8::gemm_phase<pg8::EpiGateRes, pg8::SplitOrder, true, true>(lds, g, S, E); }
    xcd_barrier(bar); PROBE_STAMP(10);
    phase_norm<2>(p);
    PROBE_END();
}
extern "C" void kernel_launch(void* const* d_in, const int* in_sizes, int n_in, void* d_out, int out_size, void* d_ws, size_t ws_size, hipStream_t stream) {
    static int grid_blocks = 0;
    if (grid_blocks == 0) {
        if (n_in != 26 || (long)out_size != O_END || ws_size < WS_END) { fprintf(stderr, "kernel_launch: unexpected shapes n_in=%d out=%d ws=%zu (need %zu)\n", n_in, out_size, ws_size, (size_t)WS_END); grid_blocks = -1; return; }
        int dev = 0, cus = 0, per_cu = 0;
        if (hipGetDevice(&dev) != hipSuccess || hipDeviceGetAttribute(&cus, hipDeviceAttributeMultiprocessorCount, dev) != hipSuccess) { grid_blocks = -1; return; }
        if (hipFuncSetAttribute((const void*)fwd_megakernel, hipFuncAttributeMaxDynamicSharedMemorySize, LDS_BYTES) != hipSuccess) { fprintf(stderr, "kernel_launch: hipFuncSetAttribute failed\n"); grid_blocks = -1; return; }
        if (hipOccupancyMaxActiveBlocksPerMultiprocessor(&per_cu, (const void*)fwd_megakernel, NTHR, LDS_BYTES) != hipSuccess || per_cu < 1) { fprintf(stderr, "kernel_launch: occupancy query says %d\n", per_cu); grid_blocks = -1; return; }
        grid_blocks = cus;
        fprintf(stderr, "kernel_launch: grid %d (cus %d, per_cu %d)\n", grid_blocks, cus, per_cu);
    }
    if (grid_blocks < 0) return;
    P p{}; fill_params(p, d_in, d_out, d_ws);
    if (hipMemsetAsync((char*)d_ws + WS_CTL, 0, CTL_ZERO_BYTES, stream) != hipSuccess) { fprintf(stderr, "kernel_launch: memset of the control words failed\n"); return; }
    void* args[] = {&p};
    const hipError_t e = hipLaunchCooperativeKernel((const void*)fwd_megakernel, dim3(grid_blocks), dim3(NTHR), args, LDS_BYTES, stream);
    if (e != hipSuccess) fprintf(stderr, "cooperative launch failed: %s (grid %d)\n", hipGetErrorString(e), grid_blocks);
}
```

```cpp
#define PROBE_MASK 0
#define PROBE_XSYNC 0
#include <hip/hip_runtime.h>
#include <hip/hip_cooperative_groups.h>
#include <cstdio>
#include <cstdint>
#define HD __device__ __forceinline__
#if defined(PROBE_MASK) && PROBE_MASK
#define DPS(k) do { const unsigned long long now_ = __builtin_amdgcn_s_memrealtime(); if ((PROBE_MASK >> (k)) & 1) pr_acc += now_ - pr_prev; pr_prev = now_; } while (0)
#endif
#ifndef CFG_D_MODEL
#define CFG_D_MODEL 1024
#endif
#ifndef CFG_SEQ
#define CFG_SEQ 8192
#endif
#ifndef CFG_DEC_BATCH
#define CFG_DEC_BATCH 128
#endif
#ifndef CFG_D_FF
#define CFG_D_FF 2816
#endif

constexpr int D = CFG_D_MODEL, BATCH = 2, SEQ = CFG_SEQ, DEC_BATCH = CFG_DEC_BATCH, DEC_SEQ = 8, DFF = CFG_D_FF;
constexpr int TP = BATCH * SEQ, TS = DEC_BATCH * DEC_SEQ, T = TP + TS, NCB = BATCH + DEC_BATCH;
constexpr int IN_COLS = 2824, PLD = 2816;
constexpr int PC_QKV = 0, PC_Z = 1536, PC_SQ = 2048, PC_SK = 2560, PC_SV = 2688;
constexpr int WC_BA = 2048;
constexpr float EPS = 1e-6f;

constexpr long O_Y = 0;
constexpr long O_PDC = (long)T * D;
constexpr long O_SDC = O_PDC + (long)BATCH * 3 * 1536;
constexpr long O_PSSM = O_SDC + (long)DEC_BATCH * 3 * 1536;
constexpr long O_SSSM = O_PSSM + (long)BATCH * 4 * 128 * 128;
constexpr long O_PK = O_SSSM + (long)DEC_BATCH * 4 * 128 * 128;
constexpr long O_SK = O_PK + (long)BATCH * 128 * 128;
constexpr long O_PV = O_SK + (long)DEC_BATCH * 128 * 128;
constexpr long O_SV = O_PV + (long)BATCH * 128 * 128;
constexpr long O_PFC = O_SV + (long)DEC_BATCH * 128 * 128;
constexpr long O_SFC = O_PFC + (long)BATCH * 2 * 2 * DFF;
constexpr long O_END = O_SFC + (long)DEC_BATCH * 2 * 2 * DFF;

constexpr size_t al256(size_t x) { return (x + 255) & ~(size_t)255; }
constexpr size_t WS_CTL = 0;
constexpr size_t WS_MOD = 1u << 20;
constexpr size_t WS_BG = al256(WS_MOD + (size_t)NCB * 6 * D * 4);
constexpr size_t WS_WBAT = al256(WS_BG + (size_t)T * 8 * 4);
constexpr size_t WS_WT_IN = al256(WS_WBAT + (size_t)8 * D * 4);
constexpr size_t WS_WT_OUT = al256(WS_WT_IN + (size_t)PLD * D * 2);
constexpr size_t WS_WT_UP = al256(WS_WT_OUT + (size_t)D * 1024 * 2);
constexpr size_t WS_WT_DN = al256(WS_WT_UP + (size_t)2 * DFF * D * 2);
constexpr size_t WS_H = al256(WS_WT_DN + (size_t)D * DFF * 2);
constexpr int NCHUNK = SEQ / 64, NUNIT = BATCH * 4 * NCHUNK;
constexpr int DNF_AB_UNIT = 57344, DNF_WV_UNIT = 32768;
constexpr size_t WS_DNF_WV = WS_H;
constexpr size_t WS_DNF_AB = al256(WS_H + (size_t)T * (D > 1024 ? D : 1024) * 2);
constexpr size_t WS_DNF_CD = al256(WS_DNF_AB + (size_t)NUNIT * DNF_AB_UNIT);
constexpr size_t WS_QKVC = WS_DNF_AB;
constexpr size_t WS_PROJ = al256((WS_DNF_CD + (size_t)NUNIT * 4) > (WS_QKVC + (size_t)T * 1536 * 2) ? (WS_DNF_CD + (size_t)NUNIT * 4) : (WS_QKVC + (size_t)T * 1536 * 2));
constexpr size_t WS_MIX = al256(WS_PROJ + (size_t)T * PLD * 2);
constexpr size_t WS_FREE = al256(WS_MIX + (size_t)T * 1024 * 2);
constexpr size_t WS_ODN = WS_H, WS_ACT = WS_PROJ;
static_assert((size_t)NUNIT * DNF_WV_UNIT <= (size_t)T * 1024 * 2, "Wv tiles overlay H");

typedef unsigned short bf16_t;
HD unsigned f2bf_bits(float f) { unsigned u = __builtin_bit_cast(unsigned, f); return (u + 0x7fffu + ((u >> 16) & 1u)) >> 16; }
HD bf16_t f2bf(float f) { return (bf16_t)f2bf_bits(f); }
HD float bf2f(bf16_t b) { return __builtin_bit_cast(float, (unsigned)b << 16); }
HD float silu_f(float x) { return x / (1.0f + expf(-x)); }
HD float sigmoid_f(float x) { return 1.0f / (1.0f + expf(-x)); }
HD float softplus_f(float x) { return x > 20.f ? x : log1pf(expf(x)); }

struct P {
    const float *x_prompt, *x_sample, *state_dn_conv, *state_dn_ssm, *cache_k, *cache_v, *state_ffn, *c_prompt, *c_sample, *rel_bias,
        *final_norm_w, *w_ada, *b_ada, *norm_mix_w, *w_in, *dn_conv_w, *dn_A_log, *dn_dt_bias, *dn_norm_w, *swa_sinks, *w_out, *norm_ffn_w,
        *w_up, *ffn_conv_w, *ffn_conv_b, *w_down;
    float* out; unsigned char* ws;
};

HD const float* xrow(const P& p, int m) { return m < TP ? p.x_prompt + (size_t)m * D : p.x_sample + (size_t)(m - TP) * D; }
HD int cb_of(int m) { return m < TP ? m / SEQ : BATCH + (m - TP) / DEC_SEQ; }
HD int t_of(int m) { return m < TP ? m % SEQ : (m - TP) % DEC_SEQ; }
HD float* ws_f(const P& p, size_t off) { return (float*)(p.ws + off); }
HD bf16_t* ws_h(const P& p, size_t off) { return (bf16_t*)(p.ws + off); }

HD int t5_bucket(int d) {
    if (d < 16) return d;
    const float logv = logf((float)d / 16.0f) / 2.0794415416798357f;
    int b = 16 + (int)(logv * 16.0f);
    return b < 31 ? b : 31;
}

constexpr long N_R0A = (long)NCB * 6 * D;
HD void r0a_body(long idx, const P& p) {
    const int cb = (int)(idx / (6 * D)), e = (int)(idx % (6 * D));
    const float* c = cb < BATCH ? p.c_prompt + (size_t)cb * D : p.c_sample + (size_t)(cb - BATCH) * D;
    float acc = 0.f;
    for (int d = 0; d < D; ++d) acc += silu_f(c[d]) * p.w_ada[(size_t)d * 6 * D + e];
    ws_f(p, WS_MOD)[idx] = acc + p.b_ada[e];
}
constexpr long N_R1 = T;
template <int WHICH> HD void r1_body(long idx, const P& p) {
    const int m = (int)idx, cb = cb_of(m);
    const float* xr = WHICH == 0 ? xrow(p, m) : p.out + O_Y + (size_t)m * D;
    const float* nw = WHICH == 0 ? p.norm_mix_w : p.norm_ffn_w;
    const float* mod = ws_f(p, WS_MOD) + (size_t)cb * 6 * D;
    const float* sh = mod + (WHICH == 0 ? 0 : 3 * D); const float* sc = mod + (WHICH == 0 ? D : 4 * D);
    float ss = 0.f;
    for (int k = 0; k < D; ++k) ss += xr[k] * xr[k];
    const float rstd = 1.0f / sqrtf(ss / (float)D + EPS);
    float ba[8];
#pragma unroll
    for (int j = 0; j < 8; ++j) ba[j] = 0.f;
    bf16_t* H = ws_h(p, WS_H) + (size_t)m * D;
    for (int k = 0; k < D; ++k) {
        const float h = xr[k] * rstd * nw[k] * (1.0f + sc[k]) + sh[k];
        H[k] = f2bf(h);
        if (WHICH == 0) {
#pragma unroll
            for (int j = 0; j < 8; ++j) ba[j] += h * p.w_in[(size_t)k * IN_COLS + WC_BA + j];
        }
    }
    if (WHICH == 0) {
        float* bg = ws_f(p, WS_BG) + (size_t)m * 8;
#pragma unroll
        for (int j = 0; j < 4; ++j) {
            bg[j] = sigmoid_f(ba[j]);
            bg[4 + j] = -expf(p.dn_A_log[j]) * softplus_f(ba[4 + j] + p.dn_dt_bias[j]);
        }
    }
}
constexpr long N_R2 = (long)(T / 8) * PLD;
HD void r2_body(long idx, const P& p) {
    const int mg = (int)(idx / PLD), n = (int)(idx % PLD), oc = n < WC_BA ? n : n + 8;
    const bf16_t* H = ws_h(p, WS_H) + (size_t)mg * 8 * D;
    float acc[8];
#pragma unroll
    for (int i = 0; i < 8; ++i) acc[i] = 0.f;
    for (int k = 0; k < D; ++k) {
        const float w = bf2f(f2bf(p.w_in[(size_t)k * IN_COLS + oc]));
#pragma unroll
        for (int i = 0; i < 8; ++i) acc[i] += bf2f(H[(size_t)i * D + k]) * w;
    }
    bf16_t* PR = ws_h(p, WS_PROJ);
#pragma unroll
    for (int i = 0; i < 8; ++i) PR[(size_t)(mg * 8 + i) * PLD + n] = f2bf(acc[i]);
}
constexpr long N_R2B_1 = (long)BATCH * 3 * 1536, N_R2B_2 = (long)DEC_BATCH * 3 * 1536, N_R2B_3 = (long)BATCH * 128 * 128, N_R2B_4 = (long)DEC_BATCH * 128 * 128;
constexpr long N_R2B = N_R2B_1 + N_R2B_2 + 2 * (N_R2B_3 + N_R2B_4);
HD void r2b_body(long idx, const P& p) {
    const bf16_t* PR = ws_h(p, WS_PROJ);
    long r = idx;
    if (r < N_R2B_1) { const int b = (int)(r / (3 * 1536)), j = (int)(r / 1536 % 3), c = (int)(r % 1536);
        p.out[O_PDC + r] = bf2f(PR[(size_t)(b * SEQ + SEQ - 3 + j) * PLD + PC_QKV + c]); return; }
    r -= N_R2B_1;
    if (r < N_R2B_2) { const int b = (int)(r / (3 * 1536)), j = (int)(r / 1536 % 3), c = (int)(r % 1536);
        p.out[O_SDC + r] = bf2f(PR[(size_t)(TP + b * DEC_SEQ + DEC_SEQ - 3 + j) * PLD + PC_QKV + c]); return; }
    r -= N_R2B_2;
    for (int kv = 0; kv < 2; ++kv) {
        const int pc = kv == 0 ? PC_SK : PC_SV; const float* cache = kv == 0 ? p.cache_k : p.cache_v;
        if (r < N_R2B_3) { const int b = (int)(r / (128 * 128)), j = (int)(r / 128 % 128), c = (int)(r % 128);
            p.out[(kv == 0 ? O_PK : O_PV) + r] = bf2f(PR[(size_t)(b * SEQ + SEQ - 128 + j) * PLD + pc + c]); return; }
        r -= N_R2B_3;
        if (r < N_R2B_4) { const int b = (int)(r / (128 * 128)), j = (int)(r / 128 % 128), c = (int)(r % 128);
            float v;
            if (j < 128 - DEC_SEQ) v = cache[((size_t)b * 128 + j + DEC_SEQ) * 128 + c];
            else v = bf2f(PR[(size_t)(TP + b * DEC_SEQ + (j - (128 - DEC_SEQ))) * PLD + pc + c]);
            p.out[(kv == 0 ? O_SK : O_SV) + r] = v; return; }
        r -= N_R2B_4;
    }
}
constexpr long N_R3 = (long)T * 12;
HD float r3_conv(const P& p, int m, int t, int ch) {
    const bf16_t* PR = ws_h(p, WS_PROJ);
    float acc = 0.f;
#pragma unroll
    for (int j = 0; j < 4; ++j) {
        const int tt = t - 3 + j; float xv;
        if (tt >= 0) xv = bf2f(PR[(size_t)(m - (t - tt)) * PLD + PC_QKV + ch]);
        else xv = m < TP ? 0.f : p.state_dn_conv[((size_t)((m - TP) / DEC_SEQ) * 3 + (3 + tt)) * 1536 + ch];
        acc += p.dn_conv_w[j * 1536 + ch] * xv;
    }
    return silu_f(acc);
}
HD void r3_body(long idx, const P& p) {
    const int m = (int)(idx / 12), grp = (int)(idx % 12), part = grp / 4, cbase = grp * 128, t = t_of(m);
    float scale = 1.f;
    if (part < 2) {
        float ss = 0.f;
        for (int c = 0; c < 128; ++c) { const float v = r3_conv(p, m, t, cbase + c); ss += v * v; }
        scale = 1.0f / sqrtf(ss + EPS);
        if (part == 0) scale *= 0.08838834764831845f;
    }
    bf16_t* Q = ws_h(p, WS_QKVC) + (size_t)m * 1536 + cbase;
    for (int c = 0; c < 128; ++c) Q[c] = f2bf(r3_conv(p, m, t, cbase + c) * scale);
}
constexpr long N_R4 = (long)NCB * 4 * 128;
HD void r4_body(long idx, const P& p) {
    const int seq = (int)(idx / 512), h = (int)(idx / 128 % 4), v = (int)(idx % 128);
    const bool smp = seq >= BATCH; const int b = smp ? seq - BATCH : seq;
    float* S = p.out + (smp ? O_SSSM : O_PSSM) + ((size_t)b * 4 + h) * 128 * 128 + v;
    const float* S0 = smp ? p.state_dn_ssm + ((size_t)b * 4 + h) * 128 * 128 + v : nullptr;
    for (int k = 0; k < 128; ++k) S[(size_t)k * 128] = smp ? S0[(size_t)k * 128] : 0.f;
    const int L = smp ? DEC_SEQ : SEQ, m0 = smp ? TP + b * DEC_SEQ : b * SEQ;
    const bf16_t* QK = ws_h(p, WS_QKVC); const float* BG = ws_f(p, WS_BG); float* ODN = ws_f(p, WS_ODN);
    for (int t = 0; t < L; ++t) {
        const int m = m0 + t;
        const bf16_t* q = QK + (size_t)m * 1536 + h * 128; const bf16_t* kk = q + 512; const float vv = bf2f(q[1024 + v]);
        const float beta = BG[(size_t)m * 8 + h], eg = expf(BG[(size_t)m * 8 + 4 + h]);
        float kS = 0.f;
        for (int k = 0; k < 128; ++k) kS += bf2f(kk[k]) * (S[(size_t)k * 128] * eg);
        const float u = beta * (vv - kS);
        float o = 0.f;
        for (int k = 0; k < 128; ++k) { const float s = S[(size_t)k * 128] * eg + bf2f(kk[k]) * u; S[(size_t)k * 128] = s; o += bf2f(q[k]) * s; }
        ODN[(size_t)m * 512 + h * 128 + v] = o;
    }
}
constexpr long N_R5 = (long)T * 4;
HD void r5_body(long idx, const P& p) {
    const int m = (int)(idx / 4), h = (int)(idx % 4);
    const float* o = ws_f(p, WS_ODN) + (size_t)m * 512 + h * 128;
    float ss = 0.f;
    for (int v = 0; v < 128; ++v) ss += o[v] * o[v];
    const float rstd = 1.0f / sqrtf(ss / 128.0f + EPS);
    const bf16_t* z = ws_h(p, WS_PROJ) + (size_t)m * PLD + PC_Z + h * 128;
    bf16_t* mix = ws_h(p, WS_MIX) + (size_t)m * 1024 + h * 128;
    for (int v = 0; v < 128; ++v) mix[v] = f2bf(o[v] * rstd * p.dn_norm_w[v] * silu_f(bf2f(z[v])));
}
constexpr long N_R6 = (long)T * 8 * 8;
HD void r6_body(long idx, const P& p) {
    const int m = (int)(idx / 64), hq = (int)(idx / 8 % 8), dg = (int)(idx % 8), kvh = hq / 4, t = t_of(m);
    const bool smp = m >= TP; const int b = smp ? (m - TP) / DEC_SEQ : 0;
    const bf16_t* PR = ws_h(p, WS_PROJ);
    const bf16_t* q = PR + (size_t)m * PLD + PC_SQ + hq * 64;
    const float sink = p.swa_sinks[hq];
    const int nk = smp ? 128 : (t < 127 ? t + 1 : 128);
    float mx = sink;
    for (int pass = 0; pass < 2; ++pass) {
        float den = 0.f, acc[8];
#pragma unroll
        for (int i = 0; i < 8; ++i) acc[i] = 0.f;
        for (int jj = 0; jj < nk; ++jj) {
            int dist; const float* kf = nullptr; const float* vf = nullptr; const bf16_t* kb = nullptr; const bf16_t* vb = nullptr;
            if (smp) { const int j = t + 1 + jj; dist = 128 + t - j;
                if (j < 128) { kf = p.cache_k + ((size_t)b * 128 + j) * 128 + kvh * 64; vf = p.cache_v + ((size_t)b * 128 + j) * 128 + kvh * 64; }
                else { const size_t mm = (size_t)(TP + b * DEC_SEQ + (j - 128)); kb = PR + mm * PLD + PC_SK + kvh * 64; vb = PR + mm * PLD + PC_SV + kvh * 64; } }
            else { dist = nk - 1 - jj; const size_t mm = (size_t)(m - dist); kb = PR + mm * PLD + PC_SK + kvh * 64; vb = PR + mm * PLD + PC_SV + kvh * 64; }
            float s = 0.f;
            for (int d = 0; d < 64; ++d) s += bf2f(q[d]) * (kf ? kf[d] : bf2f(kb[d]));
            s = s * 0.125f + p.rel_bias[t5_bucket(dist) * 8 + hq];
            if (pass == 0) { mx = s > mx ? s : mx; }
            else { const float pr = expf(s - mx); den += pr;
#pragma unroll
                for (int i = 0; i < 8; ++i) acc[i] += pr * (vf ? vf[dg * 8 + i] : bf2f(vb[dg * 8 + i])); }
        }
        if (pass == 1) { den += expf(sink - mx); bf16_t* mix = ws_h(p, WS_MIX) + (size_t)m * 1024 + 512 + hq * 64 + dg * 8;
#pragma unroll
            for (int i = 0; i < 8; ++i) mix[i] = f2bf(acc[i] / den); }
    }
}
constexpr long N_R7 = (long)(T / 8) * D;
HD void r7_body(long idx, const P& p) {
    const int mg = (int)(idx / D), d = (int)(idx % D);
    const bf16_t* MX = ws_h(p, WS_MIX) + (size_t)mg * 8 * 1024;
    float acc[8];
#pragma unroll
    for (int i = 0; i < 8; ++i) acc[i] = 0.f;
    for (int e = 0; e < 1024; ++e) { const float w = bf2f(f2bf(p.w_out[(size_t)e * D + d]));
#pragma unroll
        for (int i = 0; i < 8; ++i) acc[i] += bf2f(MX[(size_t)i * 1024 + e]) * w; }
#pragma unroll
    for (int i = 0; i < 8; ++i) { const int m = mg * 8 + i; const float g1 = ws_f(p, WS_MOD)[(size_t)cb_of(m) * 6 * D + 2 * D + d];
        p.out[O_Y + (size_t)m * D + d] = xrow(p, m)[d] + g1 * acc[i]; }
}
constexpr long N_R9 = (long)(T / 8) * DFF;
HD void r9_body(long idx, const P& p) {
    const int mg = (int)(idx / DFF), f = (int)(idx % DFF), m0 = mg * 8, t0 = t_of(m0);
    const bool smp = m0 >= TP; const int b = smp ? (m0 - TP) / DEC_SEQ : m0 / SEQ;
    const bf16_t* H = ws_h(p, WS_H);
    float ug[10], uu[10];
#pragma unroll
    for (int i = 0; i < 10; ++i) { ug[i] = 0.f; uu[i] = 0.f; }
    const bool halo = (!smp && t0 > 0);
    for (int k = 0; k < D; ++k) {
        const float wg = bf2f(f2bf(p.w_up[(size_t)k * 2 * DFF + f])), wu = bf2f(f2bf(p.w_up[(size_t)k * 2 * DFF + DFF + f]));
#pragma unroll
        for (int i = 0; i < 10; ++i) { if (i < 2 && !halo) continue; const float h = bf2f(H[(size_t)(m0 - 2 + i) * D + k]); ug[i] += h * wg; uu[i] += h * wu; }
    }
    if (smp) {
#pragma unroll
        for (int i = 0; i < 2; ++i) { ug[i] = p.state_ffn[((size_t)b * 2 + i) * 2 * DFF + f]; uu[i] = p.state_ffn[((size_t)b * 2 + i) * 2 * DFF + DFF + f]; }
    }
    const float w0g = p.ffn_conv_w[f], w1g = p.ffn_conv_w[2 * DFF + f], w2g = p.ffn_conv_w[4 * DFF + f], bgt = p.ffn_conv_b[f];
    const float w0u = p.ffn_conv_w[DFF + f], w1u = p.ffn_conv_w[3 * DFF + f], w2u = p.ffn_conv_w[5 * DFF + f], bup = p.ffn_conv_b[DFF + f];
    bf16_t* ACT = ws_h(p, WS_ACT);
#pragma unroll
    for (int i = 0; i < 8; ++i) {
        const float gc = w0g * ug[i] + w1g * ug[i + 1] + w2g * ug[i + 2] + bgt, uc = w0u * uu[i] + w1u * uu[i + 1] + w2u * uu[i + 2] + bup;
        ACT[(size_t)(m0 + i) * DFF + f] = f2bf(silu_f(gc) * uc);
    }
    if (smp) {
#pragma unroll
        for (int j = 0; j < 2; ++j) { float* o = p.out + O_SFC + ((size_t)b * 2 + j) * 2 * DFF; o[f] = ug[8 + j]; o[DFF + f] = uu[8 + j]; }
    } else if (t0 == SEQ - 8) {
#pragma unroll
        for (int j = 0; j < 2; ++j) { float* o = p.out + O_PFC + ((size_t)b * 2 + j) * 2 * DFF; o[f] = ug[8 + j]; o[DFF + f] = uu[8 + j]; }
    }
}
constexpr long N_R10 = (long)(T / 8) * D;
HD void r10_body(long idx, const P& p) {
    const int mg = (int)(idx / D), d = (int)(idx % D);
    const bf16_t* A = ws_h(p, WS_ACT) + (size_t)mg * 8 * DFF;
    float acc[8];
#pragma unroll
    for (int i = 0; i < 8; ++i) acc[i] = 0.f;
    for (int f = 0; f < DFF; ++f) { const float w = bf2f(f2bf(p.w_down[(size_t)f * D + d]));
#pragma unroll
        for (int i = 0; i < 8; ++i) acc[i] += bf2f(A[(size_t)i * DFF + f]) * w; }
#pragma unroll
    for (int i = 0; i < 8; ++i) { const int m = mg * 8 + i; const float g2 = ws_f(p, WS_MOD)[(size_t)cb_of(m) * 6 * D + 5 * D + d];
        float* o = p.out + O_Y + (size_t)m * D + d; *o = *o + g2 * acc[i]; }
}
constexpr long N_R11 = T, N_R8 = T;
HD void r11_body(long idx, const P& p) {
    float* xr = p.out + O_Y + (size_t)idx * D;
    float ss = 0.f;
    for (int k = 0; k < D; ++k) ss += xr[k] * xr[k];
    const float rstd = 1.0f / sqrtf(ss / (float)D + EPS);
    for (int k = 0; k < D; ++k) xr[k] = xr[k] * rstd * p.final_norm_w[k];
}
#define LAS __attribute__((address_space(3)))
typedef float f32x4 __attribute__((ext_vector_type(4)));
typedef unsigned u32x4 __attribute__((ext_vector_type(4)));
typedef unsigned u32x2 __attribute__((ext_vector_type(2)));
constexpr int NWAVES = 8, NTHR = 512;
constexpr int LDS_BYTES = 163840;
__device__ __forceinline__ int otid() { int t = threadIdx.x; asm volatile("" : "+v"(t)); return t; }
__device__ __forceinline__ float wave_sum(float v) {
#pragma unroll
    for (int o = 1; o < 64; o <<= 1) v += __shfl_xor(v, o);
    return v;
}
__device__ __forceinline__ unsigned pk2(float lo, float hi) { return f2bf_bits(lo) | (f2bf_bits(hi) << 16); }

__device__ __forceinline__ void transpose_item(const float* W, int ldw, int K, bf16_t* WT, int dst_n0, int src_n0, int k0, LAS float* scr, int lane) {
#pragma unroll
    for (int i = 0; i < 32; ++i) { const int kk = 2 * i + (lane >> 5); scr[kk * 33 + (lane & 31)] = W[(size_t)(k0 + kk) * ldw + src_n0 + (lane & 31)]; }
    asm volatile("s_waitcnt lgkmcnt(0)" ::: "memory");
    const int c = lane & 7;
#pragma unroll
    for (int j = 0; j < 4; ++j) { const int n = (lane >> 3) + 8 * j; const LAS float* s = scr + (8 * c) * 33 + n;
        u32x4 o; o.x = pk2(s[0 * 33], s[1 * 33]); o.y = pk2(s[2 * 33], s[3 * 33]); o.z = pk2(s[4 * 33], s[5 * 33]); o.w = pk2(s[6 * 33], s[7 * 33]);
        *(u32x4*)(WT + (size_t)(dst_n0 + n) * K + k0 + 8 * c) = o; }
    asm volatile("s_waitcnt lgkmcnt(0)" ::: "memory");
}
constexpr int TI_IN = (PLD / 32) * (D / 64), TI_OUT = (D / 32) * (1024 / 64), TI_UP = (2 * DFF / 32) * (D / 64), TI_DN = (D / 32) * (DFF / 64), TI_ALL = TI_IN + TI_OUT + TI_UP + TI_DN;
__device__ __forceinline__ void phase_transposes(const P& p, LAS unsigned char* lds) {
    const int tid_ = otid(), lane = tid_ & 63, wave = tid_ >> 6;
    LAS float* scr = (LAS float*)(lds + wave * 16384);
    if (blockIdx.x == gridDim.x - 1) { for (int i = tid_; i < 8 * D; i += NTHR) ws_f(p, WS_WBAT)[i] = p.w_in[(size_t)(i % D) * IN_COLS + WC_BA + i / D]; }
    constexpr int NCG_MOD = 6 * D / 32;
    const bool split = (int)gridDim.x >= NCG_MOD + 32;
    if (split && (int)blockIdx.x < NCG_MOD) return;
    const int gw = (split ? (int)blockIdx.x - NCG_MOD : (int)blockIdx.x) * NWAVES + wave, NGW = (split ? (int)gridDim.x - NCG_MOD : (int)gridDim.x) * NWAVES;
    for (int it = gw; it < TI_ALL; it += NGW) {
        int r = it;
        if (r < TI_IN) { const int nb = r % (PLD / 32), kb = r / (PLD / 32), n0 = nb * 32; transpose_item(p.w_in, IN_COLS, D, ws_h(p, WS_WT_IN), n0, n0 < WC_BA ? n0 : n0 + 8, kb * 64, scr, lane); continue; } r -= TI_IN;
        if (r < TI_OUT) { const int nb = r % (D / 32), kb = r / (D / 32), n0 = nb * 32; transpose_item(p.w_out, D, 1024, ws_h(p, WS_WT_OUT), n0, n0, kb * 64, scr, lane); continue; } r -= TI_OUT;
        if (r < TI_UP) { const int nb = r % (2 * DFF / 32), kb = r / (2 * DFF / 32), n0 = nb * 32;
            const int pn = n0 >> 8, bj = (n0 >> 7) & 1, c = n0 & 127; transpose_item(p.w_up, 2 * DFF, D, ws_h(p, WS_WT_UP), n0, bj * DFF + 128 * pn + c, kb * 64, scr, lane); continue; } r -= TI_UP;
        { const int nb = r % (D / 32), kb = r / (D / 32), n0 = nb * 32; transpose_item(p.w_down, D, DFF, ws_h(p, WS_WT_DN), n0, n0, kb * 64, scr, lane); }
    }
}
typedef short bf16x8m __attribute__((ext_vector_type(8)));
typedef float f32x2m __attribute__((ext_vector_type(2))); typedef __bf16 bf16x2m __attribute__((ext_vector_type(2)));
__device__ __forceinline__ unsigned cvtpk_m(float lo, float hi) { const f32x2m v = {lo, hi}; return __builtin_bit_cast(unsigned, __builtin_convertvector(v, bf16x2m)); }
__device__ __forceinline__ void split8(const float (&x)[8], bf16x8m& hi, bf16x8m& lo) {
    unsigned h[4], l[4];
#pragma unroll
    for (int e = 0; e < 4; ++e) { h[e] = cvtpk_m(x[2 * e], x[2 * e + 1]);
        l[e] = cvtpk_m(x[2 * e] - __builtin_bit_cast(float, h[e] << 16), x[2 * e + 1] - __builtin_bit_cast(float, h[e] & 0xffff0000u)); }
    hi = __builtin_bit_cast(bf16x8m, (u32x4){h[0], h[1], h[2], h[3]}); lo = __builtin_bit_cast(bf16x8m, (u32x4){l[0], l[1], l[2], l[3]});
}
__device__ __forceinline__ float silu_fast(float x) { return x * __builtin_amdgcn_rcpf(1.0f + __expf(-x)); }
__device__ __forceinline__ void phase_mod(const P& p, LAS unsigned char* lds) {
    constexpr int KC = 256, NCG = 6 * D / 32, NCH = D / KC, NMT = (NCB + 15) / 16;
    static_assert(NMT <= 16, "two m-tiles per wave at most");
    LAS float* WB = (LAS float*)lds;
    const int tid = otid(), lane = tid & 63, wave = tid >> 6, r16 = lane & 15, g4 = lane >> 4;
    for (int cg = blockIdx.x; cg < NCG; cg += gridDim.x) {
        f32x4 acc[2][2];
#pragma unroll
        for (int s = 0; s < 2; ++s)
#pragma unroll
            for (int nt = 0; nt < 2; ++nt) acc[s][nt] = (f32x4){0.f, 0.f, 0.f, 0.f};
        f32x4 wreg[4];
#pragma unroll
        for (int j = 0; j < 4; ++j) { const int idx = tid + NTHR * j; wreg[j] = *(const f32x4*)(p.w_ada + (size_t)(idx >> 3) * 6 * D + cg * 32 + 4 * (idx & 7)); }
        __syncthreads();
        for (int ch = 0; ch < NCH; ++ch) {
            LAS float* wb = WB + (ch & 1) * KC * 32;
#pragma unroll
            for (int j = 0; j < 4; ++j) { const int idx = tid + NTHR * j; *(LAS f32x4*)(wb + (idx >> 3) * 32 + 4 * (idx & 7)) = wreg[j]; }
            if (ch + 1 < NCH) {
#pragma unroll
                for (int j = 0; j < 4; ++j) { const int idx = tid + NTHR * j; wreg[j] = *(const f32x4*)(p.w_ada + (size_t)((ch + 1) * KC + (idx >> 3)) * 6 * D + cg * 32 + 4 * (idx & 7)); }
            }
            __syncthreads();
#pragma unroll 2
            for (int ks = 0; ks < KC / 32; ++ks) {
                bf16x8m bh[2], bl[2];
#pragma unroll
                for (int nt = 0; nt < 2; ++nt) { float x[8];
#pragma unroll
                    for (int j = 0; j < 8; ++j) x[j] = wb[(32 * ks + 8 * g4 + j) * 32 + 16 * nt + r16];
                    split8(x, bh[nt], bl[nt]); }
#pragma unroll
                for (int s = 0; s < 2; ++s) { const int mt = wave + 8 * s; if (mt >= NMT) continue;
                    const int row = 16 * mt + r16; float x[8];
                    if (row < NCB) { const float* c = (row < BATCH ? p.c_prompt + (size_t)row * D : p.c_sample + (size_t)(row - BATCH) * D) + ch * KC + 32 * ks + 8 * g4;
                        const f32x4 a = *(const f32x4*)c, d = *(const f32x4*)(c + 4);
                        x[0] = silu_fast(a[0]); x[1] = silu_fast(a[1]); x[2] = silu_fast(a[2]); x[3] = silu_fast(a[3]); x[4] = silu_fast(d[0]); x[5] = silu_fast(d[1]); x[6] = silu_fast(d[2]); x[7] = silu_fast(d[3]); }
                    else {
#pragma unroll
                        for (int j = 0; j < 8; ++j) x[j] = 0.f; }
                    bf16x8m ah, al; split8(x, ah, al);
#pragma unroll
                    for (int nt = 0; nt < 2; ++nt) {
                        acc[s][nt] = __builtin_amdgcn_mfma_f32_16x16x32_bf16(ah, bh[nt], acc[s][nt], 0, 0, 0);
                        acc[s][nt] = __builtin_amdgcn_mfma_f32_16x16x32_bf16(ah, bl[nt], acc[s][nt], 0, 0, 0);
                        acc[s][nt] = __builtin_amdgcn_mfma_f32_16x16x32_bf16(al, bh[nt], acc[s][nt], 0, 0, 0); } }
            }
        }
#pragma unroll
        for (int s = 0; s < 2; ++s) { const int mt = wave + 8 * s; if (mt >= NMT) continue;
#pragma unroll
            for (int nt = 0; nt < 2; ++nt) { const int e = cg * 32 + 16 * nt + r16; const float bb = p.b_ada[e];
#pragma unroll
                for (int i = 0; i < 4; ++i) { const int row = 16 * mt + 4 * g4 + i; if (row < NCB) ws_f(p, WS_MOD)[(size_t)row * 6 * D + e] = acc[s][nt][i] + bb; } } }
    }
    __syncthreads();
}
constexpr int NS_OUT = 4, NS_DN = 11;
constexpr size_t WS_SLAB = WS_DNF_AB;
static_assert((size_t)(TS / 256) * (D / 256) * NS_DN * 65536 * 4 <= (size_t)NUNIT * DNF_AB_UNIT, "slabs fit");
template <int WHICH> __device__ __forceinline__ void norm_row_tail(const P& p, int m, int lane, const f32x4 (&v)[4], const f32x4 (&nwv)[4], const LAS float* wbt) {
    float ss = 0.f;
#pragma unroll
    for (int j = 0; j < 4; ++j) ss += (v[j][0] * v[j][0] + v[j][1] * v[j][1]) + (v[j][2] * v[j][2] + v[j][3] * v[j][3]);
    const float rstd = 1.0f / sqrtf(wave_sum(ss) * (1.0f / D) + EPS);
    if (WHICH == 2) {
#pragma unroll
        for (int j = 0; j < 4; ++j) ((f32x4*)(p.out + O_Y + (size_t)m * D))[lane + 64 * j] = v[j] * rstd * nwv[j];
        return;
    }
    const int cb = cb_of(m);
    const float* mod = ws_f(p, WS_MOD) + (size_t)cb * 6 * D;
    const float* sh = mod + (WHICH == 0 ? 0 : 3 * D); const float* sc = mod + (WHICH == 0 ? D : 4 * D);
    float ba[8];
#pragma unroll
    for (int j = 0; j < 8; ++j) ba[j] = 0.f;
    unsigned long long* o8 = (unsigned long long*)(ws_h(p, WS_H) + (size_t)m * D);
#pragma unroll
    for (int j = 0; j < 4; ++j) {
        const f32x4 s1 = ((const f32x4*)sc)[lane + 64 * j], s0 = ((const f32x4*)sh)[lane + 64 * j];
        const f32x4 h = v[j] * rstd * nwv[j] * (s1 + 1.0f) + s0;
        o8[lane + 64 * j] = (unsigned long long)cvtpk_m(h[0], h[1]) | ((unsigned long long)cvtpk_m(h[2], h[3]) << 32);
        if (WHICH == 0) {
#pragma unroll
            for (int c = 0; c < 8; ++c) { const f32x4 w = *(const LAS f32x4*)(wbt + c * D + 4 * (lane + 64 * j)); ba[c] += (h[0] * w[0] + h[1] * w[1]) + (h[2] * w[2] + h[3] * w[3]); }
        }
    }
    if (WHICH == 0) {
#pragma unroll
        for (int j = 0; j < 8; ++j) ba[j] = wave_sum(ba[j]);
        float mine = 0.f;
#pragma unroll
        for (int j = 0; j < 8; ++j) mine = (lane == j) ? ba[j] : mine;
        if (lane < 8) { float* bg = ws_f(p, WS_BG) + (size_t)m * 8; const int j = lane & 3;
            bg[lane] = lane < 4 ? sigmoid_f(mine) : -expf(p.dn_A_log[j]) * softplus_f(mine + p.dn_dt_bias[j]); }
    }
}
template <int WHICH> __device__ __forceinline__ void phase_norm(const P& p, LAS unsigned char* lds) {
    static_assert(D == 1024, "one wave per 1024-float row");
    const int tid_ = otid(), lane = tid_ & 63, wave = tid_ >> 6;
    const int gw = blockIdx.x * NWAVES + wave, NGW = gridDim.x * NWAVES;
    const float* nwp = WHICH == 0 ? p.norm_mix_w : (WHICH == 1 ? p.norm_ffn_w : p.final_norm_w);
    f32x4 nwv[4];
#pragma unroll
    for (int j = 0; j < 4; ++j) nwv[j] = ((const f32x4*)nwp)[lane + 64 * j];
    const LAS float* wbt = (const LAS float*)lds;
    if (WHICH == 0) { for (int i = tid_; i < 8 * D / 4; i += NTHR) ((LAS f32x4*)lds)[i] = ((const f32x4*)ws_f(p, WS_WBAT))[i]; __syncthreads(); }
    constexpr int MEND = WHICH == 0 ? T : TP;
    f32x4 va[4], vb[4], vc[4];
#define NR_LOAD(buf_, mm_) do { if ((mm_) < MEND) { const float* xr_ = WHICH == 0 ? xrow(p, (mm_)) : p.out + O_Y + (size_t)(mm_) * D; _Pragma("unroll") for (int j = 0; j < 4; ++j) buf_[j] = ((const f32x4*)xr_)[lane + 64 * j]; } } while (0)
#define NR_PROC(buf_, mm_) do { if ((mm_) < MEND) norm_row_tail<WHICH>(p, (mm_), lane, buf_, nwv, wbt); } while (0)
    NR_LOAD(va, gw); NR_LOAD(vb, gw + NGW);
    for (int m = gw; m < MEND; m += 3 * NGW) {
        NR_LOAD(vc, m + 2 * NGW); NR_PROC(va, m);
        NR_LOAD(va, m + 3 * NGW); NR_PROC(vb, m + NGW);
        NR_LOAD(vb, m + 4 * NGW); NR_PROC(vc, m + 2 * NGW);
    }
#undef NR_LOAD
#undef NR_PROC
    if (WHICH != 0) {
        constexpr int NS = WHICH == 1 ? NS_OUT : NS_DN;
        for (int rs = gw; rs < TS; rs += NGW) { const int m = TP + rs, cbs = BATCH + (rs >> 3);
            const float* gt = ws_f(p, WS_MOD) + (size_t)cbs * 6 * D + (WHICH == 1 ? 2 * D : 5 * D);
            f32x4 vs[4];
#pragma unroll
            for (int j = 0; j < 4; ++j) { const float* sl = ws_f(p, WS_SLAB) + ((size_t)((rs >> 8) * 4 + j) * NS) * 65536 + (size_t)(rs & 255) * 256 + 4 * lane;
                f32x4 acc = (f32x4){0.f, 0.f, 0.f, 0.f};
#pragma unroll
                for (int ks = 0; ks < NS; ++ks) { acc += *(const f32x4*)sl; sl += 65536; asm volatile("" : "+v"(sl)); }
                const f32x4 base = WHICH == 1 ? ((const f32x4*)(p.x_sample + (size_t)rs * D))[lane + 64 * j] : ((const f32x4*)(p.out + O_Y + (size_t)m * D))[lane + 64 * j];
                vs[j] = base + ((const f32x4*)gt)[lane + 64 * j] * acc;
                if (WHICH == 1) ((f32x4*)(p.out + O_Y + (size_t)m * D))[lane + 64 * j] = vs[j];
                asm volatile("" ::: "memory"); }
            norm_row_tail<WHICH>(p, m, lane, vs, nwv, wbt);
        }
    }
}

constexpr long SO_1 = (long)BATCH * 3 * 1536 / 4, SO_2 = (long)DEC_BATCH * 3 * 1536 / 4, SO_3 = (long)BATCH * 128 * 128 / 4, SO_4 = (long)DEC_BATCH * 128 * 128 / 4, SO_N = SO_1 + SO_2 + 2 * (SO_3 + SO_4);
__device__ __forceinline__ void so_item(const P& p, long it, f32x4& val, float*& dst) {
    const bf16_t* PR = ws_h(p, WS_PROJ); const bf16_t* src = nullptr; const float* fsrc = nullptr;
    long r = it;
    if (r < SO_1) { const int b = (int)(r / (3 * 384)), j = (int)(r / 384 % 3), c = (int)(r % 384) * 4; src = PR + (size_t)(b * SEQ + SEQ - 3 + j) * PLD + PC_QKV + c; dst = p.out + O_PDC + r * 4; }
    else if ((r -= SO_1) < SO_2) { const int b = (int)(r / (3 * 384)), j = (int)(r / 384 % 3), c = (int)(r % 384) * 4; src = PR + (size_t)(TP + b * DEC_SEQ + DEC_SEQ - 3 + j) * PLD + PC_QKV + c; dst = p.out + O_SDC + r * 4; }
    else { r -= SO_2; const int kv = r >= SO_3 + SO_4; if (kv) r -= SO_3 + SO_4; const int pc = kv ? PC_SV : PC_SK; const float* cache = kv ? p.cache_v : p.cache_k;
        if (r < SO_3) { const int b = (int)(r / (128 * 32)), j = (int)(r / 32 % 128), c = (int)(r % 32) * 4; src = PR + (size_t)(b * SEQ + SEQ - 128 + j) * PLD + pc + c; dst = p.out + (kv ? O_PV : O_PK) + r * 4; }
        else { r -= SO_3; const int b = (int)(r / (128 * 32)), j = (int)(r / 32 % 128), c = (int)(r % 32) * 4; dst = p.out + (kv ? O_SV : O_SK) + r * 4;
            if (j < 128 - DEC_SEQ) fsrc = cache + ((size_t)b * 128 + j + DEC_SEQ) * 128 + c; else src = PR + (size_t)(TP + b * DEC_SEQ + (j - (128 - DEC_SEQ))) * PLD + pc + c; } }
    if (fsrc) val = *(const f32x4*)fsrc;
    else { const u32x2 w = *(const u32x2*)src; val = (f32x4){__builtin_bit_cast(float, w.x << 16), __builtin_bit_cast(float, w.x & 0xffff0000u), __builtin_bit_cast(float, w.y << 16), __builtin_bit_cast(float, w.y & 0xffff0000u)}; }
}
__device__ __forceinline__ void phase_state_out(const P& p) {
    const long gt = blockIdx.x * (long)NTHR + otid(), gs = (long)gridDim.x * NTHR;
    for (long it = gt; it < SO_N; it += 4 * gs) {
        f32x4 v[4]; float* d[4];
#pragma unroll
        for (int u = 0; u < 4; ++u) if (it + u * gs < SO_N) so_item(p, it + u * gs, v[u], d[u]);
#pragma unroll
        for (int u = 0; u < 4; ++u) if (it + u * gs < SO_N) *(f32x4*)d[u] = v[u];
    }
}
#define XB_TMO      128
#define XB_XCNT(j)  (256  + 64 * (j))
#define XB_XSUB(j)  (1280 + 64 * (j))
#define XB_XGEN(j)  (2304 + 64 * (j))
#define XB_TOP      3328
#define XB_TOPGEN   3392
#define XCD_BAR_WORDS 3456
#define XB_SPIN_CAP (1u << 18)

__device__ __forceinline__ unsigned xb_ld(unsigned* p)              { return __hip_atomic_load(p, __ATOMIC_RELAXED, __HIP_MEMORY_SCOPE_AGENT); }
__device__ __forceinline__ unsigned xb_add(unsigned* p, unsigned v) { return __hip_atomic_fetch_add(p, v, __ATOMIC_RELAXED, __HIP_MEMORY_SCOPE_AGENT); }
__device__ __forceinline__ unsigned xb_xcc_id() { return (unsigned)__builtin_amdgcn_s_getreg((3 << 11) | 20) & 0xFu; }
#define XB_SPIN(cond, bar) do { unsigned _sp = 0; while (cond) { __builtin_amdgcn_s_sleep(1); \
    if ((++_sp & 255u) == 0u) { if (xb_ld(&(bar)[XB_TMO])) break; if (_sp > XB_SPIN_CAP) { atomicAdd(&(bar)[XB_TMO], 1u); break; } } } } while (0)

struct XcdBarrier {
    unsigned* bar; unsigned x;
    volatile LAS unsigned* st;
};

__device__ __forceinline__ XcdBarrier xcd_barrier_post(unsigned* bar, volatile LAS unsigned* st) {
    XcdBarrier b; b.bar = bar; b.x = xb_xcc_id(); b.st = st;
    if (threadIdx.x == 0) (void)xb_add(&bar[XB_XCNT(b.x)], 1u);
    return b;
}
__device__ __forceinline__ void xcd_barrier_complete(unsigned* bar, unsigned x, unsigned& nloc, unsigned& nx) {
    const unsigned G = gridDim.x * gridDim.y * gridDim.z;
    unsigned sum, cnt, mine, sp = 0u;
    for (;;) {
        sum = 0u; cnt = 0u; mine = 0u;
#pragma unroll
        for (unsigned j = 0; j < 16; ++j) { const unsigned c = xb_ld(&bar[XB_XCNT(j)]); sum += c; cnt += (c > 0u) ? 1u : 0u; mine = (j == x) ? c : mine; }
        if (sum == G) break;
        __builtin_amdgcn_s_sleep(1);
        if ((++sp & 255u) == 0u) { if (xb_ld(&bar[XB_TMO])) break; if (sp > XB_SPIN_CAP) { atomicAdd(&bar[XB_TMO], 1u); break; } }
    }
    nloc = mine > 0u ? mine : 1u; nx = cnt > 0u ? cnt : 1u;
}

__device__ __forceinline__ void xcd_barrier(const XcdBarrier& b) {
    asm volatile("s_waitcnt vmcnt(0)" ::: "memory");
    __syncthreads();
    if (threadIdx.x == 0) {
        unsigned* bar = b.bar;
        __builtin_amdgcn_s_waitcnt(0);
        unsigned nloc = b.st[0], nx = b.st[1];
        if (nloc == 0u) { xcd_barrier_complete(bar, b.x, nloc, nx); b.st[0] = nloc; b.st[1] = nx; }
        const unsigned old = xb_add(&bar[XB_XSUB(b.x)], 1u);
        const unsigned gen = old / nloc;
        if (old + 1u == (gen + 1u) * nloc) {
            __builtin_amdgcn_fence(__ATOMIC_RELEASE, "agent");
            asm volatile("s_waitcnt vmcnt(0)" ::: "memory");
            const unsigned og = xb_add(&bar[XB_TOP], 1u);
            const unsigned tg = og / nx;
            if (og + 1u == (tg + 1u) * nx) xb_add(&bar[XB_TOPGEN], 1u);
            else XB_SPIN(xb_ld(&bar[XB_TOPGEN]) == tg, bar);
            __builtin_amdgcn_fence(__ATOMIC_ACQUIRE, "agent");
            xb_add(&bar[XB_XGEN(b.x)], 1u);
            asm volatile("s_waitcnt vmcnt(0)" ::: "memory");
        } else {
            XB_SPIN(xb_ld(&bar[XB_XGEN(b.x)]) == gen, bar);
            __builtin_amdgcn_fence(__ATOMIC_ACQUIRE, "agent");
            asm volatile("s_waitcnt vmcnt(0)" ::: "memory");
        }
    }
    __syncthreads();
}
namespace pg8 {
#define PG8_LAS __attribute__((address_space(3)))
typedef unsigned short bf16_t;
typedef short bf16x8 __attribute__((ext_vector_type(8)));
typedef float f32x4 __attribute__((ext_vector_type(4)));
typedef unsigned u32x4 __attribute__((ext_vector_type(4)));
constexpr int BM = 256, BK = 64, HALF = 128, HTB = HALF * BK * 2  , STAGE_BYTES = 8 * HTB, NXCD = 8, WGM = 8;

__host__ __device__ __forceinline__ int lds_byte(int r, int c) { const int st = (r >> 4) * 2 + (c >> 5), rr = r & 15, cc = c & 31, ob = rr * 64 + cc * 2; return st * 1024 + (ob ^ (((ob >> 9) & 1) << 5)); }
__host__ __device__ __forceinline__ void stage_rc(int b, int& R, int& C) { const int st = b / 1024, sb = b % 1024, swz = sb ^ (((sb >> 9) & 1) << 5); R = (st >> 1) * 16 + swz / 64; C = (st & 1) * 32 + (swz % 64) / 2; }
__host__ __device__ __forceinline__ int perm32(int rho) { const int n = rho >> 4, i = rho & 15; return 8 * (i >> 2) + 4 * n + (i & 3); }

struct Unit { int pm, pn, k0, nt, atomic; };
struct Gemm { const bf16_t* A; const bf16_t* Bt; int M, N, K; };

struct StaticOrder {
    int nM, nN, nwg, G, c, ntk;
    __host__ __device__ void init(int M, int N, int G_, int c_, int K_) { nM = M / BM; nN = N / BM; nwg = nM * nN; G = G_; c = c_; ntk = K_ / BK; }
    __host__ __device__ bool next(int i, Unit& u) const {
        const long L = (long)i * G + c; if (L >= nwg) return false;
        int wgid = (int)L; { const int q = nwg / NXCD, r = nwg % NXCD, xcd = wgid % NXCD, off = wgid / NXCD; wgid = (xcd < r ? xcd * (q + 1) : r * (q + 1) + (xcd - r) * q) + off; }
        const int nig = WGM * nN, gid = wgid / nig, fm = gid * WGM, gsz = (nM - fm) < WGM ? (nM - fm) : WGM;
        u.pm = fm + ((wgid % nig) % gsz); u.pn = (wgid % nig) / gsz; u.k0 = 0; u.nt = ntk; u.atomic = 0; return true;
    }
    __device__ __forceinline__ void a_ready(const Unit&) const {}
    __device__ __forceinline__ void done(const Unit&) const {}
};

struct SplitOrder {
    StaticOrder so; int nu1, ns, ntk_sub, npn, nsub, G, c;
    __device__ void init(int N, int K, int NS, int G_, int c_) { so.init(TP, N, G_, c_, K); nu1 = so.nwg; ns = NS; ntk_sub = K / BK / NS; npn = N / BM; nsub = (TS / BM) * npn * NS; G = G_; c = c_; }
    __device__ bool next(int i, Unit& u) const {
        const long L = (long)i * G + c; if (L < nu1) return so.next(i, u);
        const int s = (int)(L - nu1); if (s >= nsub) return false;
        const int ks = s % ns, t = s / ns; u.pm = TP / BM + t / npn; u.pn = t % npn; u.k0 = ks * ntk_sub * BK; u.nt = ntk_sub; u.atomic = 1; return true; }
    __device__ __forceinline__ void a_ready(const Unit&) const {}
    __device__ __forceinline__ void done(const Unit&) const {}
};
__device__ __forceinline__ unsigned cvt_pk_bf16(float lo, float hi) { unsigned r; asm volatile("v_cvt_pk_bf16_f32 %0, %1, %2" : "=v"(r) : "v"(lo), "v"(hi)); return r; }
struct EpiStoreBf16 {
    static constexpr bool PERM = true, AFTER_DRAIN = false;
    bf16_t* O; int ldc;
    __device__ __forceinline__ void operator()(const f32x4 (&acc)[2][2][4][2], const Unit& u, int wr, int wc, int fr, int fq) const {
        const int row0 = u.pm * BM + wr * 64 + fr, col0 = u.pn * BM + wc * 32 + 8 * fq;
#pragma unroll
        for (int ai = 0; ai < 2; ++ai)
#pragma unroll
            for (int m = 0; m < 4; ++m) { bf16_t* rowp = O + (size_t)(row0 + ai * HALF + m * 16) * ldc + col0;
#pragma unroll
                for (int bj = 0; bj < 2; ++bj) { const f32x4 v0 = acc[ai][bj][m][0], v1 = acc[ai][bj][m][1];
                    u32x4 w; w.x = cvt_pk_bf16(v0[0], v0[1]); w.y = cvt_pk_bf16(v0[2], v0[3]); w.z = cvt_pk_bf16(v1[0], v1[1]); w.w = cvt_pk_bf16(v1[2], v1[3]);
                    *(u32x4*)(rowp + bj * HALF) = w; } }
    }
};
struct EpiGateRes {
    static constexpr bool PERM = false, AFTER_DRAIN = false;
    const float* base_p; const float* base_s; float* out; const float* gate; float* slab; int ns;
    __device__ __forceinline__ void operator()(const f32x4 (&acc)[2][2][4][2], const Unit& u, int wr, int wc, int fr, int fq) const {
        const int row0 = u.pm * BM + wr * 64 + fr, col0 = u.pn * BM + wc * 32 + 4 * fq;
        const bool smp = row0 >= TP; const float* base = smp ? base_s - (size_t)TP * D : base_p;
#pragma unroll
        for (int ai = 0; ai < 2; ++ai)
#pragma unroll
            for (int m = 0; m < 4; ++m) { const int r = row0 + ai * HALF + m * 16; const int cb = smp ? BATCH + ((r - TP) >> 3) : r / SEQ;
                const float* gp = gate + (size_t)cb * 6 * D + col0; const size_t off = (size_t)r * D + col0;
#pragma unroll
                for (int bj = 0; bj < 2; ++bj)
#pragma unroll
                    for (int n = 0; n < 2; ++n) { const f32x4 gv = *(const f32x4*)(gp + bj * HALF + n * 16);
                        if (u.atomic) { const int sidx = ((u.pm - TP / BM) * (D / BM) + u.pn) * ns + u.k0 / (u.nt * BK);
                            *(f32x4*)(slab + (size_t)sidx * 65536 + (size_t)(r - u.pm * BM) * 256 + (col0 - u.pn * BM) + bj * HALF + n * 16) = acc[ai][bj][m][n]; }
                        else { const f32x4 bs = *(const f32x4*)(base + off + bj * HALF + n * 16); *(f32x4*)(out + off + bj * HALF + n * 16) = bs + gv * acc[ai][bj][m][n]; } } }
    }
};
template <class Epi, class Sched, bool ALIGN_EPI = false, bool SP2 = false>
__device__ __forceinline__ void gemm_phase(PG8_LAS unsigned char* lds, const Gemm g, const Sched& S, const Epi& E) {
    const int tid = otid(), wid = __builtin_amdgcn_readfirstlane(tid >> 6), lane = tid & 63, wr = wid >> 2, wc = wid & 3, fr = lane & 15, fq = lane >> 4;
    const int K = g.K;
    unsigned voffA[2], voffB[2];
#pragma unroll
    for (int i = 0; i < 2; ++i) { int R, C; stage_rc(tid * 16 + i * 8192, R, C); const int Rb = Epi::PERM ? ((R & ~31) + perm32(R & 31)) : R;
        voffA[i] = (unsigned)(R * K + C) * 2u; voffB[i] = (unsigned)(Rb * K + C) * 2u; }
    const size_t kstep = (size_t)(BK * 2);
    const size_t hstep = (size_t)HALF * K * 2;
    const size_t tstep = 2 * hstep;
    const unsigned ldsw = (unsigned)wid * 1024u;
    const int aoff = lds_byte(wr * 64 + fr, fq * 8), boff = lds_byte(wc * 32 + fr, fq * 8);
#define PG8_SA(b, h) (((b) * 2 + (h)) * HTB)
#define PG8_SB(b, h) ((4 + (b) * 2 + (h)) * HTB)
#define PG8_STAGE(bufoff, gbase, voff) do { _Pragma("unroll") for (int _i = 0; _i < 2; ++_i) \
        __builtin_amdgcn_global_load_lds((const unsigned*)((const char*)(gbase) + (voff)[_i]), (PG8_LAS unsigned*)(lds + (bufoff) + ldsw + _i * 8192), 16, 0, 0); } while (0)
#define PG8_LDA(dst, b, h) do { _Pragma("unroll") for (int m = 0; m < 4; ++m) _Pragma("unroll") for (int k = 0; k < 2; ++k) dst[m][k] = *(const PG8_LAS bf16x8*)(lds + PG8_SA(b, h) + aoff + m * 2048 + k * 1024); } while (0)
#define PG8_LDB(dst, b, h) do { _Pragma("unroll") for (int n = 0; n < 2; ++n) _Pragma("unroll") for (int k = 0; k < 2; ++k) dst[n][k] = *(const PG8_LAS bf16x8*)(lds + PG8_SB(b, h) + boff + n * 2048 + k * 1024); } while (0)
#define PG8_MMA(ai, bj, At, Bt) do { __builtin_amdgcn_s_setprio(1); _Pragma("unroll") for (int m = 0; m < 4; ++m) _Pragma("unroll") for (int n = 0; n < 2; ++n) _Pragma("unroll") for (int k = 0; k < 2; ++k) \
        acc[ai][bj][m][n] = __builtin_amdgcn_mfma_f32_16x16x32_bf16(Bt[n][k], At[m][k], acc[ai][bj][m][n], 0, 0, 0); __builtin_amdgcn_s_setprio(0); } while (0)
#define PG8_WAIT_V(n) asm volatile("s_waitcnt vmcnt(" #n ")" ::: "memory")
#define PG8_WAIT_L(n) asm volatile("s_waitcnt lgkmcnt(" #n ")" ::: "memory")
#define PG8_BAR __builtin_amdgcn_s_barrier()
#define PG8_SCHED __builtin_amdgcn_sched_barrier(0)
    Unit cur, nxt; int ui = 0;
    if (!S.next(0, cur)) return;
    f32x4 acc[2][2][4][2];
#pragma unroll
    for (int a = 0; a < 2; ++a)
#pragma unroll
        for (int b = 0; b < 2; ++b)
#pragma unroll
            for (int m = 0; m < 4; ++m)
#pragma unroll
                for (int n = 0; n < 2; ++n) acc[a][b][m][n] = (f32x4){0.f, 0.f, 0.f, 0.f};
    bf16x8 At[4][2], B0[2][2], B1[2][2];
    const char* cA = (const char*)g.A + (size_t)cur.pm * tstep + (size_t)cur.k0 * 2; const char* cB = (const char*)g.Bt + (size_t)cur.pn * tstep + (size_t)cur.k0 * 2;
    S.a_ready(cur);
    if constexpr (SP2) {
        PG8_STAGE(PG8_SB(0, 0), cB, voffB); PG8_STAGE(PG8_SB(0, 1), cB + hstep, voffB); PG8_STAGE(PG8_SA(0, 0), cA, voffA); PG8_STAGE(PG8_SA(0, 1), cA + hstep, voffA);
        if (wr == 1) PG8_BAR;
        PG8_WAIT_V(2); PG8_BAR;
        PG8_STAGE(PG8_SB(1, 0), cB + kstep, voffB); PG8_STAGE(PG8_SA(1, 0), cA + kstep, voffA); PG8_STAGE(PG8_SB(1, 1), cB + hstep + kstep, voffB);
        PG8_WAIT_V(6); PG8_BAR;
    } else {
        PG8_STAGE(PG8_SB(0, 0), cB, voffB); PG8_STAGE(PG8_SA(0, 0), cA, voffA); PG8_STAGE(PG8_SB(0, 1), cB + hstep, voffB); PG8_STAGE(PG8_SA(0, 1), cA + hstep, voffA);
        if (wr == 1) PG8_BAR;
        PG8_WAIT_V(4); PG8_BAR;
        PG8_STAGE(PG8_SB(1, 0), cB + kstep, voffB); PG8_STAGE(PG8_SA(1, 0), cA + kstep, voffA); PG8_STAGE(PG8_SB(1, 1), cB + hstep + kstep, voffB);
        PG8_WAIT_V(6); PG8_BAR;
    }
    for (;;) {
        const bool has_next = S.next(ui + 1, nxt);
        const char* nA = has_next ? (const char*)g.A + (size_t)nxt.pm * tstep + (size_t)nxt.k0 * 2 : cA; const char* nB = has_next ? (const char*)g.Bt + (size_t)nxt.pn * tstep + (size_t)nxt.k0 * 2 : cB;
        const int nt = cur.nt;
        for (int t = 0; t < nt; t += 2) {
            const bool last = (t == nt - 2);
            const char* a1 = cA + (size_t)(t + 1) * kstep;
            const char* a2 = last ? nA : cA + (size_t)(t + 2) * kstep; const char* b2 = last ? nB : cB + (size_t)(t + 2) * kstep;
            const char* a3 = a2 + kstep; const char* b3 = b2 + kstep;
            if (last && has_next) S.a_ready(nxt);
            if constexpr (SP2) {
            PG8_LDB(B0, 0, 0); PG8_LDB(B1, 0, 1); PG8_SCHED; PG8_LDA(At, 0, 0); PG8_STAGE(PG8_SA(1, 1), a1 + hstep, voffA);
            PG8_WAIT_V(8); PG8_WAIT_L(0); PG8_BAR; PG8_MMA(0, 0, At, B0); PG8_MMA(0, 1, At, B1); PG8_BAR; PG8_SCHED;
            PG8_LDA(At, 0, 1); PG8_STAGE(PG8_SB(0, 0), b2, voffB); PG8_STAGE(PG8_SB(0, 1), b2 + hstep, voffB); PG8_STAGE(PG8_SA(0, 0), a2, voffA);
            PG8_WAIT_V(8); PG8_WAIT_L(0); PG8_BAR; PG8_MMA(1, 0, At, B0); PG8_MMA(1, 1, At, B1); PG8_BAR; PG8_SCHED;
            PG8_LDB(B0, 1, 0); PG8_LDB(B1, 1, 1); PG8_SCHED; PG8_LDA(At, 1, 0); PG8_STAGE(PG8_SA(0, 1), a2 + hstep, voffA);
            PG8_WAIT_V(8); PG8_WAIT_L(0); PG8_BAR; PG8_MMA(0, 0, At, B0); PG8_MMA(0, 1, At, B1); PG8_BAR; PG8_SCHED;
            PG8_LDA(At, 1, 1); PG8_STAGE(PG8_SB(1, 0), b3, voffB); PG8_STAGE(PG8_SB(1, 1), b3 + hstep, voffB); PG8_STAGE(PG8_SA(1, 0), a3, voffA);
            PG8_WAIT_V(8); PG8_WAIT_L(0); PG8_BAR; PG8_MMA(1, 0, At, B0); PG8_MMA(1, 1, At, B1); PG8_BAR; PG8_SCHED;
            } else {
            PG8_LDB(B0, 0, 0); PG8_SCHED; PG8_LDA(At, 0, 0); PG8_STAGE(PG8_SA(1, 1), a1 + hstep, voffA);
            PG8_WAIT_L(8); PG8_BAR; PG8_WAIT_L(0); PG8_MMA(0, 0, At, B0); PG8_BAR; PG8_SCHED;
            PG8_LDB(B1, 0, 1); PG8_STAGE(PG8_SB(0, 0), b2, voffB);
            PG8_BAR; PG8_WAIT_L(0); PG8_MMA(0, 1, At, B1); PG8_BAR;
            PG8_LDA(At, 0, 1); PG8_STAGE(PG8_SA(0, 0), a2, voffA);
            PG8_BAR; PG8_WAIT_L(0); PG8_MMA(1, 0, At, B0); PG8_BAR; PG8_SCHED;
            PG8_STAGE(PG8_SB(0, 1), b2 + hstep, voffB);
            PG8_WAIT_V(6); PG8_BAR; PG8_MMA(1, 1, At, B1); PG8_BAR;
            PG8_LDB(B0, 1, 0); PG8_SCHED; PG8_LDA(At, 1, 0); PG8_STAGE(PG8_SA(0, 1), a2 + hstep, voffA);
            PG8_WAIT_L(8); PG8_BAR; PG8_WAIT_L(0); PG8_MMA(0, 0, At, B0); PG8_BAR; PG8_SCHED;
            PG8_LDB(B1, 1, 1); PG8_STAGE(PG8_SB(1, 0), b3, voffB);
            PG8_BAR; PG8_WAIT_L(0); PG8_MMA(0, 1, At, B1); PG8_BAR;
            PG8_LDA(At, 1, 1); PG8_STAGE(PG8_SA(1, 0), a3, voffA);
            PG8_BAR; PG8_WAIT_L(0); PG8_MMA(1, 0, At, B0); PG8_BAR; PG8_SCHED;
            PG8_STAGE(PG8_SB(1, 1), b3 + hstep, voffB);
            PG8_WAIT_V(6); PG8_BAR; PG8_MMA(1, 1, At, B1); PG8_BAR;
            }
        }
        if constexpr (ALIGN_EPI) { if (wr == 0) PG8_BAR; }
        if constexpr (!Epi::AFTER_DRAIN) { E(acc, cur, wr, wc, fr, fq); S.done(cur); }
        if (!has_next) break;
#pragma unroll
        for (int a = 0; a < 2; ++a)
#pragma unroll
            for (int b = 0; b < 2; ++b)
#pragma unroll
                for (int m = 0; m < 4; ++m)
#pragma unroll
                    for (int n = 0; n < 2; ++n) acc[a][b][m][n] = (f32x4){0.f, 0.f, 0.f, 0.f};
        cur = nxt; cA = nA; cB = nB; ++ui;
        if constexpr (ALIGN_EPI) { if (wr == 1) PG8_BAR; }
    }
    PG8_WAIT_V(0);
    if constexpr (!ALIGN_EPI) { if (wr == 0) PG8_BAR; }
    PG8_BAR;
    if constexpr (Epi::AFTER_DRAIN) { E.fused(acc, cur, wr, wc, fr, fq, lds, wid, lane); S.done(cur); }
#undef PG8_SA
#undef PG8_SB
#undef PG8_STAGE
#undef PG8_LDA
#undef PG8_LDB
#undef PG8_MMA
#undef PG8_WAIT_V
#undef PG8_WAIT_L
#undef PG8_BAR
#undef PG8_SCHED
}
}
typedef short bf16x8 __attribute__((ext_vector_type(8)));
constexpr int FR_NWK = 0, FR_QD = 16, FR_KTT = 32, FR_QK = 48, FR_N = 56;
__device__ __forceinline__ int kperm(int g, int j) { return j < 4 ? 4 * g + j : 16 + 4 * g + (j - 4); }

typedef float f32x2_t __attribute__((ext_vector_type(2))); typedef __bf16 bf16x2_t __attribute__((ext_vector_type(2)));
__device__ __forceinline__ unsigned cvtpk_c(float lo, float hi) { const f32x2_t v = {lo, hi}; const bf16x2_t b = __builtin_convertvector(v, bf16x2_t); return __builtin_bit_cast(unsigned, b); }
__device__ __forceinline__ bf16x8 pack8(const f32x4 a, const f32x4 b) {
    return __builtin_bit_cast(bf16x8, (u32x4){cvtpk_c(a[0], a[1]), cvtpk_c(a[2], a[3]), cvtpk_c(b[0], b[1]), cvtpk_c(b[2], b[3])});
}
constexpr int DP_KP = 136;
constexpr int DP_RP = 72;
constexpr int DP_QS = 0, DP_KS = DP_QS + 64 * DP_KP * 2, DP_RHST = DP_KS + 64 * DP_KP * 2, DP_AM = DP_RHST + 256 * DP_RP * 2, DP_AMP = 68,
              DP_QKM = DP_AM + 64 * DP_AMP * 4, DP_QKP = 72, DP_GS = DP_QKM + 64 * DP_QKP * 2, DP_DM = DP_GS + 4 * 64 * 4, DP_DMP = 20,
              DP_TB = DP_DM + 64 * DP_DMP * 4, DP_END = DP_TB + 64 * DP_RP * 2;
static_assert(DP_END <= 131072 && DP_AM % 16 == 0 && DP_DM % 16 == 0 && DP_TB % 16 == 0 && DP_RHST % 16 == 0, "dnprep LDS");
#ifndef DPS
#define DPS(k)
#endif
__device__ __forceinline__ void phase_dnprep(const P& p, LAS unsigned char* lds, unsigned long long& pr_prev, unsigned long long& pr_acc) {
    const int tid_ = otid();
    LAS bf16_t* QS = (LAS bf16_t*)(lds + DP_QS); LAS bf16_t* KS = (LAS bf16_t*)(lds + DP_KS); LAS bf16_t* RHST = (LAS bf16_t*)(lds + DP_RHST);
    LAS float* AM = (LAS float*)(lds + DP_AM); LAS bf16_t* QKM = (LAS bf16_t*)(lds + DP_QKM); LAS float* GS = (LAS float*)(lds + DP_GS);
    LAS float* DM = (LAS float*)(lds + DP_DM); LAS bf16_t* TB = (LAS bf16_t*)(lds + DP_TB);
    const bf16_t* PR = ws_h(p, WS_PROJ); const float* BG = ws_f(p, WS_BG);
    for (int i = tid_; i < 64 * DP_RP / 2; i += NTHR) ((LAS unsigned*)TB)[i] = 0u;
    float pgx = 0.f, pbx = 0.f, cw[3][4][2]; unsigned xr[3][11];
#define DP_FETCH(uid_, ln_, wv_) do { const int n_ = (uid_) % NCHUNK, bh_ = (uid_) / NCHUNK, h_ = bh_ & 3, m0_ = (bh_ >> 2) * SEQ + n_ * 64; \
        if ((wv_) == 0) { pgx = BG[(size_t)(m0_ + (ln_)) * 8 + 4 + h_]; pbx = BG[(size_t)(m0_ + (ln_)) * 8 + h_]; } \
        _Pragma("unroll") for (int part = 0; part < 3; ++part) _Pragma("unroll") for (int j = 0; j < 4; ++j) { const float* w = p.dn_conv_w + j * 1536 + part * 512 + h_ * 128 + 2 * (ln_); cw[part][j][0] = w[0]; cw[part][j][1] = w[1]; } \
        _Pragma("unroll") for (int rr = 0; rr < 11; ++rr) { const int t_ = n_ * 64 + (wv_) * 8 + rr - 3; \
            _Pragma("unroll") for (int part = 0; part < 3; ++part) { unsigned v_ = 0u; if (t_ >= 0) v_ = *(const unsigned*)(PR + (size_t)(m0_ + (wv_) * 8 + rr - 3) * PLD + part * 512 + h_ * 128 + 2 * (ln_)); xr[part][rr] = v_; } } } while (0)
    if ((int)blockIdx.x < NUNIT) { int t0 = tid_; asm volatile("" : "+v"(t0)); DP_FETCH((int)blockIdx.x, t0 & 63, t0 >> 6); }
    for (int uid = blockIdx.x; uid < NUNIT; uid += gridDim.x) {
        const int n = uid % NCHUNK;
        int tid = tid_; asm volatile("" : "+v"(tid));
        const int lane = tid & 63, wave = tid >> 6, r16 = lane & 15, g4 = lane >> 4;
        unsigned char* abu = p.ws + WS_DNF_AB + (size_t)uid * DNF_AB_UNIT;
        if (wave == 0) {
            float x = pgx;
#pragma unroll
            for (int o = 1; o < 64; o <<= 1) { const float t = __shfl_up(x, o); if (lane >= o) x += t; }
            const float gl = __shfl(x, 63);
            GS[lane] = x; GS[64 + lane] = pbx; GS[128 + lane] = __expf(x); GS[192 + lane] = __expf(gl - x);
            if (lane == 0) ws_f(p, WS_DNF_CD)[uid] = __expf(gl);
        }
        __syncthreads();
        {
            float c[8][3][2], ssum[16];
#pragma unroll
            for (int i = 0; i < 8; ++i) {
#pragma unroll
                for (int part = 0; part < 3; ++part)
#pragma unroll
                    for (int e = 0; e < 2; ++e) { float a = 0.f;
#pragma unroll
                        for (int j = 0; j < 4; ++j) a += cw[part][j][e] * (e == 0 ? __builtin_bit_cast(float, xr[part][i + j] << 16) : __builtin_bit_cast(float, xr[part][i + j] & 0xffff0000u));
                        c[i][part][e] = a * __builtin_amdgcn_rcpf(1.0f + __expf(-a)); }
                ssum[2 * i] = c[i][0][0] * c[i][0][0] + c[i][0][1] * c[i][0][1]; ssum[2 * i + 1] = c[i][1][0] * c[i][1][0] + c[i][1][1] * c[i][1][1]; }
#pragma unroll
            for (int o = 1; o < 64; o <<= 1) {
#pragma unroll
                for (int q = 0; q < 16; ++q) ssum[q] += __shfl_xor(ssum[q], o); }
#pragma unroll
            for (int i = 0; i < 8; ++i) { const int row = wave * 8 + i;
                const float rq = 0.08838834764831845f * __builtin_amdgcn_rsqf(ssum[2 * i] + EPS), rk = __builtin_amdgcn_rsqf(ssum[2 * i + 1] + EPS);
                const float beta = GS[64 + row], eg = GS[128 + row];
                const float q0 = c[i][0][0] * rq, q1 = c[i][0][1] * rq, k0 = c[i][1][0] * rk, k1 = c[i][1][1] * rk;
                *(LAS unsigned*)(QS + row * DP_KP + 2 * lane) = pk2(q0, q1);
                *(LAS unsigned*)(KS + row * DP_KP + 2 * lane) = pk2(k0, k1);
                RHST[(2 * lane) * DP_RP + row] = f2bf(beta * c[i][2][0]); RHST[(2 * lane + 1) * DP_RP + row] = f2bf(beta * c[i][2][1]);
                RHST[(128 + 2 * lane) * DP_RP + row] = f2bf(beta * eg * k0); RHST[(128 + 2 * lane + 1) * DP_RP + row] = f2bf(beta * eg * k1); }
        }
        if (uid + (int)gridDim.x < NUNIT) DP_FETCH(uid + (int)gridDim.x, lane, wave);
        __syncthreads(); DPS(16);
        {
            const int ti = wave >> 1;
            f32x4 akk[2], aqk[2];
#pragma unroll
            for (int c = 0; c < 2; ++c) { akk[c] = (f32x4){0.f, 0.f, 0.f, 0.f}; aqk[c] = (f32x4){0.f, 0.f, 0.f, 0.f}; }
#pragma unroll
            for (int kb = 0; kb < 4; ++kb) {
                const bf16x8 ak = *(const LAS bf16x8*)(KS + (16 * ti + r16) * DP_KP + 32 * kb + 8 * g4), aq = *(const LAS bf16x8*)(QS + (16 * ti + r16) * DP_KP + 32 * kb + 8 * g4);
#pragma unroll
                for (int c = 0; c < 2; ++c) { const int tj = 2 * (wave & 1) + c; const bf16x8 bk = *(const LAS bf16x8*)(KS + (16 * tj + r16) * DP_KP + 32 * kb + 8 * g4);
                    akk[c] = __builtin_amdgcn_mfma_f32_16x16x32_bf16(ak, bk, akk[c], 0, 0, 0); aqk[c] = __builtin_amdgcn_mfma_f32_16x16x32_bf16(aq, bk, aqk[c], 0, 0, 0); }
            }
#pragma unroll
            for (int c = 0; c < 2; ++c) { const int tj = 2 * (wave & 1) + c, J = 16 * tj + r16; const float gj = GS[J];
#pragma unroll
                for (int i = 0; i < 4; ++i) { const int I = 16 * ti + 4 * g4 + i; const float dec = I >= J ? __expf(GS[I] - gj) : 0.f;
                    AM[I * DP_AMP + J] = I > J ? GS[64 + I] * akk[c][i] * dec : 0.f; QKM[I * DP_QKP + J] = f2bf(aqk[c][i] * dec); } }
        }
        __syncthreads(); DPS(17);
        if (wave == 0) {
            const int bb = g4, cc = r16; float t[16];
            f32x4 tr[16][4];
#pragma unroll
            for (int i = 1; i < 16; ++i)
#pragma unroll
                for (int j4 = 0; j4 < (i + 3) / 4; ++j4) tr[i][j4] = *(const LAS f32x4*)(AM + (16 * bb + i) * DP_AMP + 16 * bb + 4 * j4);
            __builtin_amdgcn_sched_barrier(0);
#pragma unroll
            for (int i = 0; i < 16; ++i) { float acc = (i == cc) ? 1.f : 0.f;
#pragma unroll
                for (int j = 0; j < i; ++j) acc -= tr[i][j >> 2][j & 3] * t[j];
                t[i] = acc; }
#pragma unroll
            for (int i = 0; i < 16; ++i) { DM[(16 * bb + i) * DP_DMP + cc] = t[i]; TB[(16 * bb + i) * DP_RP + 16 * bb + cc] = f2bf(t[i]); }
        } else if (wave >= 4) {
            for (int f = FR_QD + (wave - 4); f < FR_N; f += 4) {
                u32x4 o;
                if (f < FR_KTT) { const int mt = (f - FR_QD) >> 2, kb = (f - FR_QD) & 3, row = 16 * mt + r16; const float sc = GS[128 + row];
                    const u32x2 lo = *(const LAS u32x2*)(QS + row * DP_KP + 32 * kb + 4 * g4), hi = *(const LAS u32x2*)(QS + row * DP_KP + 32 * kb + 16 + 4 * g4);
                    const unsigned w[4] = {lo.x, lo.y, hi.x, hi.y}; unsigned r[4];
#pragma unroll
                    for (int e = 0; e < 4; ++e) r[e] = cvtpk_c(__builtin_bit_cast(float, w[e] << 16) * sc, __builtin_bit_cast(float, w[e] & 0xffff0000u) * sc);
                    o = (u32x4){r[0], r[1], r[2], r[3]};
                } else if (f < FR_QK) { const int kt = (f - FR_KTT) >> 1, tb = (f - FR_KTT) & 1; float v[8];
#pragma unroll
                    for (int j = 0; j < 8; ++j) { const int tok = 32 * tb + kperm(g4, j); v[j] = bf2f(KS[tok * DP_KP + 16 * kt + r16]) * GS[192 + tok]; }
                    o = (u32x4){cvtpk_c(v[0], v[1]), cvtpk_c(v[2], v[3]), cvtpk_c(v[4], v[5]), cvtpk_c(v[6], v[7])};
                } else { const int mt = (f - FR_QK) >> 1, tb = (f - FR_QK) & 1, row = 16 * mt + r16;
                    const u32x2 lo = *(const LAS u32x2*)(QKM + row * DP_QKP + 32 * tb + 4 * g4), hi = *(const LAS u32x2*)(QKM + row * DP_QKP + 32 * tb + 16 + 4 * g4);
                    o = (u32x4){lo.x, lo.y, hi.x, hi.y}; }
                *(u32x4*)(abu + (size_t)f * 1024 + lane * 16) = o;
            }
        }
        __syncthreads(); DPS(18);
        if (wave < 3) {
            const int j = wave; f32x4 Tk[4];
#pragma unroll
            for (int kk = 0; kk < 4; ++kk) Tk[j][kk] = DM[(16 * j + 4 * g4 + kk) * DP_DMP + r16];
#pragma unroll
            for (int i = 1; i < 4; ++i) if (i > j) {
                f32x4 acc = (f32x4){0.f, 0.f, 0.f, 0.f};
#pragma unroll
                for (int k = 0; k < 3; ++k) if (k >= j && k < i) { const f32x4 a = *(const LAS f32x4*)(AM + (16 * i + r16) * DP_AMP + 16 * k + 4 * g4);
#pragma unroll
                    for (int kk = 0; kk < 4; ++kk) acc = __builtin_amdgcn_mfma_f32_16x16x4f32(a[kk], Tk[k][kk], acc, 0, 0, 0); }
                const f32x4 dd = *(const LAS f32x4*)(DM + (16 * i + r16) * DP_DMP + 4 * g4);
                f32x4 res = (f32x4){0.f, 0.f, 0.f, 0.f};
#pragma unroll
                for (int kk = 0; kk < 4; ++kk) res = __builtin_amdgcn_mfma_f32_16x16x4f32(dd[kk], acc[kk], res, 0, 0, 0);
                Tk[i] = -res;
#pragma unroll
                for (int e = 0; e < 4; ++e) TB[(16 * i + 4 * g4 + e) * DP_RP + 16 * j + r16] = f2bf(Tk[i][e]); }
        }
        __syncthreads(); DPS(19);
        {
            const int mt = wave & 3, half = wave >> 2;
            bf16x8 tf[2];
#pragma unroll
            for (int kb = 0; kb < 2; ++kb) tf[kb] = *(const LAS bf16x8*)(TB + (16 * mt + r16) * DP_RP + 32 * kb + 8 * g4);
            if (half == 0) {
                float* wv = (float*)(p.ws + WS_DNF_WV + (size_t)uid * DNF_WV_UNIT) + (size_t)mt * 256 + lane * 4;
#pragma unroll
                for (int vt = 0; vt < 8; ++vt) { f32x4 acc = (f32x4){0.f, 0.f, 0.f, 0.f};
#pragma unroll
                    for (int kb = 0; kb < 2; ++kb) acc = __builtin_amdgcn_mfma_f32_16x16x32_bf16(tf[kb], *(const LAS bf16x8*)(RHST + (16 * vt + r16) * DP_RP + 32 * kb + 8 * g4), acc, 0, 0, 0);
                    *(f32x4*)(wv + (size_t)vt * 1024) = acc; }
            } else {
#pragma unroll
                for (int kbp = 0; kbp < 4; ++kbp) { f32x4 xt[2];
#pragma unroll
                    for (int c2 = 0; c2 < 2; ++c2) { xt[c2] = (f32x4){0.f, 0.f, 0.f, 0.f};
#pragma unroll
                        for (int kb = 0; kb < 2; ++kb) xt[c2] = __builtin_amdgcn_mfma_f32_16x16x32_bf16(*(const LAS bf16x8*)(RHST + (128 + 16 * (2 * kbp + c2) + r16) * DP_RP + 32 * kb + 8 * g4), tf[kb], xt[c2], 0, 0, 0); }
                    *(u32x4*)(abu + (size_t)(FR_NWK + mt * 4 + kbp) * 1024 + lane * 16) = __builtin_bit_cast(u32x4, pack8(-xt[0], -xt[1])); }
            }
        }
        __syncthreads(); DPS(20);
    }
#undef DP_FETCH
}

constexpr size_t O_ODN = O_Y;
#define DN_SB() __builtin_amdgcn_sched_barrier(0)
__device__ __forceinline__ void dn_consume(const LAS unsigned char* fb, int wl, f32x4 (&S)[8], float cd, float* op) {
    f32x4 u[4], o[4];
    bf16x8 fa[16], fq[16], Sb[4], Ub[2];
#pragma unroll
    for (int mt = 0; mt < 4; ++mt) u[mt] = *(const LAS f32x4*)(fb + (FR_N + wl * 4 + mt) * 1024);
#pragma unroll
    for (int f = 0; f < 16; ++f) fa[f] = *(const LAS bf16x8*)(fb + (FR_NWK + f) * 1024);
#pragma unroll
    for (int f = 0; f < 8; ++f) fq[f] = *(const LAS bf16x8*)(fb + (FR_QD + f) * 1024);
    DN_SB();
#pragma unroll
    for (int kb = 0; kb < 4; ++kb) Sb[kb] = pack8(S[2 * kb], S[2 * kb + 1]);
#pragma unroll
    for (int mt = 0; mt < 4; ++mt)
#pragma unroll
        for (int kb = 0; kb < 4; ++kb) u[mt] = __builtin_amdgcn_mfma_f32_16x16x32_bf16(fa[mt * 4 + kb], Sb[kb], u[mt], 0, 0, 0);
    DN_SB();
#pragma unroll
    for (int f = 8; f < 16; ++f) fq[f] = *(const LAS bf16x8*)(fb + (FR_QD + f) * 1024);
#pragma unroll
    for (int f = 0; f < 8; ++f) fa[f] = *(const LAS bf16x8*)(fb + (FR_KTT + f) * 1024);
    DN_SB();
#pragma unroll
    for (int mt = 0; mt < 4; ++mt) { o[mt] = (f32x4){0.f, 0.f, 0.f, 0.f};
#pragma unroll
        for (int kb = 0; kb < 4; ++kb) o[mt] = __builtin_amdgcn_mfma_f32_16x16x32_bf16(fq[mt * 4 + kb], Sb[kb], o[mt], 0, 0, 0); }
    DN_SB();
#pragma unroll
    for (int f = 8; f < 16; ++f) fa[f] = *(const LAS bf16x8*)(fb + (FR_KTT + f) * 1024);
#pragma unroll
    for (int f = 0; f < 8; ++f) fq[f] = *(const LAS bf16x8*)(fb + (FR_QK + f) * 1024);
#pragma unroll
    for (int tb = 0; tb < 2; ++tb) Ub[tb] = pack8(u[2 * tb], u[2 * tb + 1]);
#pragma unroll
    for (int kt = 0; kt < 8; ++kt) S[kt] = S[kt] * cd;
    DN_SB();
#pragma unroll
    for (int kt = 0; kt < 8; ++kt)
#pragma unroll
        for (int tb = 0; tb < 2; ++tb) S[kt] = __builtin_amdgcn_mfma_f32_16x16x32_bf16(fa[kt * 2 + tb], Ub[tb], S[kt], 0, 0, 0);
#pragma unroll
    for (int mt = 0; mt < 4; ++mt) {
#pragma unroll
        for (int tb = 0; tb < 2; ++tb) o[mt] = __builtin_amdgcn_mfma_f32_16x16x32_bf16(fq[mt * 2 + tb], Ub[tb], o[mt], 0, 0, 0);
#pragma unroll
        for (int i = 0; i < 4; ++i) op[(size_t)(16 * mt + i) * 512] = o[mt][i]; }
}
constexpr int DN_SBUF = 73728;
__device__ __forceinline__ void phase_dnscan(const P& p, LAS unsigned char* lds) {
    if (blockIdx.x >= BATCH * 4 * 2) return;
    const int tid = otid(), lane = tid & 63, wave = __builtin_amdgcn_readfirstlane(tid >> 6), r16 = lane & 15, g4 = lane >> 4;
    const int bh = blockIdx.x >> 1, vh = blockIdx.x & 1, h = bh & 3, b = bh >> 2, wl = wave & 3, vs = vh * 4 + wl, v0 = vs * 16;
    const float* cdp = ws_f(p, WS_DNF_CD) + (size_t)bh * NCHUNK;
    float* odn = p.out + O_ODN;
#define DN_BAR() do { asm volatile("s_waitcnt lgkmcnt(0)" ::: "memory"); __builtin_amdgcn_s_barrier(); asm volatile("" ::: "memory"); } while (0)
    if (wave >= 4) {
        const unsigned char* ab = p.ws + WS_DNF_AB + (size_t)bh * NCHUNK * DNF_AB_UNIT + lane * 16;
        const unsigned char* wvb = p.ws + WS_DNF_WV + (size_t)bh * NCHUNK * DNF_WV_UNIT + (size_t)vh * 16 * 1024 + lane * 16;
        u32x4 R[3][18];
#define DN_SRC(n_, q_) ((q_) < FR_N ? ab + (size_t)(n_) * DNF_AB_UNIT + (q_) * 1024 : wvb + (size_t)(n_) * DNF_WV_UNIT + ((q_) - FR_N) * 1024)
#define DN_LD(n_, s_) do { if ((n_) < NCHUNK) { _Pragma("unroll") for (int i_ = 0; i_ < 18; ++i_) R[s_][i_] = *(const u32x4*)DN_SRC(n_, wl * 18 + i_); } } while (0)
#define DN_ST(n_, s_) do { if ((n_) < NCHUNK) { LAS unsigned char* d_ = lds + ((n_) & 1) * DN_SBUF + wl * 18 * 1024 + lane * 16; _Pragma("unroll") for (int i_ = 0; i_ < 18; ++i_) *(LAS u32x4*)(d_ + i_ * 1024) = R[s_][i_]; } } while (0)
        DN_LD(0, 0); DN_LD(1, 1); DN_LD(2, 2); DN_ST(0, 0);
        DN_BAR();
#define DN_LSTEP(n_, s_) do { const int n = (n_); if (n < NCHUNK) { DN_LD(n + 3, s_); DN_ST(n + 1, ((s_) + 1) % 3); DN_BAR(); } } while (0)
        for (int n3 = 0; n3 < NCHUNK; n3 += 3) { DN_LSTEP(n3, 0); DN_LSTEP(n3 + 1, 1); DN_LSTEP(n3 + 2, 2); }
#undef DN_LSTEP
#undef DN_LD
#undef DN_ST
#undef DN_SRC
        return;
    }
    f32x4 S[8];
#pragma unroll
    for (int t = 0; t < 8; ++t) S[t] = (f32x4){0.f, 0.f, 0.f, 0.f};
    float cd = cdp[0];
    DN_BAR();
    for (int n = 0; n < NCHUNK; ++n) {
        const float cdn = cdp[n + 1 < NCHUNK ? n + 1 : n];
        dn_consume(lds + (n & 1) * DN_SBUF + lane * 16, wl, S, cd, odn + (size_t)(b * SEQ + n * 64 + 4 * g4) * 512 + h * 128 + v0 + r16);
        cd = cdn;
        DN_BAR();
    }
#undef DN_BAR
    {
        float* so = p.out + O_PSSM + (size_t)bh * 128 * 128 + v0 + r16;
#pragma unroll
        for (int kt = 0; kt < 8; ++kt)
#pragma unroll
            for (int i = 0; i < 4; ++i) so[(size_t)(16 * kt + 4 * g4 + i) * 128] = S[kt][i];
    }
}
__device__ __forceinline__ void phase_dngate(const P& p) {
    const int tid_ = otid(), lane = tid_ & 63, wave = tid_ >> 6;
    const int gw = blockIdx.x * NWAVES + wave, NGW = gridDim.x * NWAVES;
    const f32x4 nw0 = *(const f32x4*)(p.dn_norm_w + (lane & 15) * 8), nw1 = *(const f32x4*)(p.dn_norm_w + (lane & 15) * 8 + 4);
    f32x4 a, c; u32x4 z;
#define DG_LOAD(m_) do { const float* o_ = p.out + O_ODN + (size_t)(m_) * 512 + lane * 8; a = *(const f32x4*)o_; c = *(const f32x4*)(o_ + 4); z = *(const u32x4*)(ws_h(p, WS_PROJ) + (size_t)(m_) * PLD + PC_Z + lane * 8); } while (0)
    if (gw < TP) DG_LOAD(gw);
    for (int m = gw; m < TP; m += NGW) {
        const f32x4 a0 = a, c0 = c; const u32x4 z0 = z;
        if (m + NGW < TP) DG_LOAD(m + NGW);
        float ss = (a0[0] * a0[0] + a0[1] * a0[1]) + (a0[2] * a0[2] + a0[3] * a0[3]) + (c0[0] * c0[0] + c0[1] * c0[1]) + (c0[2] * c0[2] + c0[3] * c0[3]);
#pragma unroll
        for (int off = 1; off < 16; off <<= 1) ss += __shfl_xor(ss, off);
        const float rstd = 1.0f / sqrtf(ss * (1.0f / 128.0f) + EPS);
        const unsigned zw[4] = {z0.x, z0.y, z0.z, z0.w}; const float ov[8] = {a0[0], a0[1], a0[2], a0[3], c0[0], c0[1], c0[2], c0[3]}; const float nwv[8] = {nw0[0], nw0[1], nw0[2], nw0[3], nw1[0], nw1[1], nw1[2], nw1[3]};
        unsigned r[4];
#pragma unroll
        for (int e = 0; e < 4; ++e) { const float z0f = __builtin_bit_cast(float, zw[e] << 16), z1f = __builtin_bit_cast(float, zw[e] & 0xffff0000u);
            r[e] = pk2(ov[2 * e] * rstd * nwv[2 * e] * silu_f(z0f), ov[2 * e + 1] * rstd * nwv[2 * e + 1] * silu_f(z1f)); }
        *(u32x4*)(ws_h(p, WS_MIX) + (size_t)m * 1024 + lane * 8) = (u32x4){r[0], r[1], r[2], r[3]};
    }
#undef DG_LOAD
}
__device__ __forceinline__ void phase_dnsample(const P& p, LAS unsigned char* lds, unsigned long long& pr_prev, unsigned long long& pr_acc) {
    const int tid = otid(), lane = tid & 63, us = tid >> 8, w4 = (tid >> 6) & 3, kh = lane >> 5, col_ = w4 * 32 + (lane & 31);
    LAS float* QH = (LAS float*)lds + us * 4352;
    LAS float* KH = QH + 1024; LAS float* VH = QH + 2048; LAS float* OH = QH + 3072; LAS float* RED = QH + 4096;
    const bf16_t* PR = ws_h(p, WS_PROJ); const float* BG = ws_f(p, WS_BG);
    for (int ub = blockIdx.x; ub < DEC_BATCH * 2; ub += gridDim.x) {
        const int uidx = ub * 2 + us, b = uidx >> 2, h = uidx & 3, m0 = TP + b * DEC_SEQ;
        int col = col_; asm volatile("" : "+v"(col));
        {
            float x0[11], x1[11];
            const int ch0 = kh * 512 + h * 128 + col;
#pragma unroll
            for (int rr = 0; rr < 11; ++rr) {
                if (rr < 3) { const float* st = p.state_dn_conv + ((size_t)b * 3 + rr) * 1536; x0[rr] = st[ch0]; x1[rr] = st[1024 + h * 128 + col]; }
                else { const bf16_t* pr = PR + (size_t)(m0 + rr - 3) * PLD; x0[rr] = bf2f(pr[ch0]); x1[rr] = bf2f(pr[1024 + h * 128 + col]); } }
            float w0[4], w1[4];
#pragma unroll
            for (int j = 0; j < 4; ++j) { w0[j] = p.dn_conv_w[j * 1536 + ch0]; w1[j] = p.dn_conv_w[j * 1536 + 1024 + h * 128 + col]; }
            float ssq[8], ssk[8];
#pragma unroll
            for (int t = 0; t < 8; ++t) { float a = 0.f, d = 0.f;
#pragma unroll
                for (int j = 0; j < 4; ++j) { a += w0[j] * x0[t + j]; d += w1[j] * x1[t + j]; }
                a = a * __builtin_amdgcn_rcpf(1.0f + __expf(-a)); d = d * __builtin_amdgcn_rcpf(1.0f + __expf(-d));
                if (kh == 0) { QH[t * 128 + col] = a; VH[t * 128 + col] = d; } else KH[t * 128 + col] = a;
                ssq[t] = kh == 0 ? a * a : 0.f; ssk[t] = kh == 1 ? a * a : 0.f; }
#pragma unroll
            for (int o = 1; o < 64; o <<= 1) {
#pragma unroll
                for (int t = 0; t < 8; ++t) { ssq[t] += __shfl_xor(ssq[t], o); ssk[t] += __shfl_xor(ssk[t], o); } }
            if (lane == 0) {
#pragma unroll
                for (int t = 0; t < 8; ++t) { RED[w4 * 16 + t] = ssq[t]; RED[w4 * 16 + 8 + t] = ssk[t]; } }
        }
        __syncthreads(); DPS(27);
#pragma unroll
        for (int t = 0; t < 8; ++t) {
            if (kh == 0) { const float sq = (RED[t] + RED[16 + t]) + (RED[32 + t] + RED[48 + t]); QH[t * 128 + col] *= 0.08838834764831845f / sqrtf(sq + EPS); }
            else { const float sk = (RED[8 + t] + RED[24 + t]) + (RED[40 + t] + RED[56 + t]); KH[t * 128 + col] *= 1.0f / sqrtf(sk + EPS); } }
        __syncthreads(); DPS(28);
        float S[64];
        const float* S0 = p.state_dn_ssm + ((size_t)b * 4 + h) * 128 * 128 + (size_t)kh * 64 * 128 + col;
#pragma unroll
        for (int k = 0; k < 64; ++k) { S[k] = *S0; S0 += 128; if ((k & 7) == 7) asm volatile("" : "+v"(S0)); }
#pragma unroll 1
        for (int t = 0; t < 8; ++t) {
            const float beta = BG[(size_t)(m0 + t) * 8 + h], eg = __expf(BG[(size_t)(m0 + t) * 8 + 4 + h]);
            const LAS float* kp = KH + t * 128 + kh * 64; const LAS float* qp = QH + t * 128 + kh * 64;
            f32x4 kk[16], qq[16];
#pragma unroll
            for (int k4 = 0; k4 < 16; ++k4) kk[k4] = *(const LAS f32x4*)(kp + 4 * k4);
#pragma unroll
            for (int k4 = 0; k4 < 16; ++k4) qq[k4] = *(const LAS f32x4*)(qp + 4 * k4);
            const float vt = VH[t * 128 + col];
            __builtin_amdgcn_sched_barrier(0);
            float kS = 0.f;
#pragma unroll
            for (int k4 = 0; k4 < 16; ++k4)
#pragma unroll
                for (int e = 0; e < 4; ++e) { S[4 * k4 + e] *= eg; kS += kk[k4][e] * S[4 * k4 + e]; }
            kS += __shfl_xor(kS, 32);
            const float u = beta * (vt - kS);
            float o = 0.f;
#pragma unroll
            for (int k4 = 0; k4 < 16; ++k4)
#pragma unroll
                for (int e = 0; e < 4; ++e) { S[4 * k4 + e] += kk[k4][e] * u; o += qq[k4][e] * S[4 * k4 + e]; }
            o += __shfl_xor(o, 32);
            if (kh == 0) OH[t * 128 + col] = o;
            __builtin_amdgcn_sched_barrier(0);
        }
        float* So = p.out + O_SSSM + ((size_t)b * 4 + h) * 128 * 128 + (size_t)kh * 64 * 128 + col;
#pragma unroll
        for (int k = 0; k < 64; ++k) { *So = S[k]; So += 128; if ((k & 7) == 7) asm volatile("" : "+v"(So)); }
        __syncthreads(); DPS(29);
#pragma unroll
        for (int t = 0; t < 8; ++t) { const float o = kh == 0 ? OH[t * 128 + col] : 0.f; const float s = wave_sum(o * o); if (lane == 0) RED[w4 * 16 + t] = s; }
        __syncthreads();
        if (kh == 0) {
            const float nw = p.dn_norm_w[col];
#pragma unroll
            for (int t = 0; t < 8; ++t) { const float rstd = 1.0f / sqrtf(((RED[t] + RED[16 + t]) + (RED[32 + t] + RED[48 + t])) * (1.0f / 128.0f) + EPS);
                const float z = bf2f(PR[(size_t)(m0 + t) * PLD + PC_Z + h * 128 + col]);
                ws_h(p, WS_MIX)[(size_t)(m0 + t) * 1024 + h * 128 + col] = f2bf(OH[t * 128 + col] * rstd * nw * silu_f(z)); }
        }
        __syncthreads(); DPS(30);
    }
}
constexpr int NSEG = 16, CSEG = NCHUNK / NSEG, NBH = BATCH * 4;
static_assert(NCHUNK % NSEG == 0, "segments");
constexpr size_t O_RFRAG = O_ODN + (size_t)TP * 512;
constexpr size_t O_BSEG = O_RFRAG + (size_t)NBH * NSEG * 8192;
constexpr size_t O_SSEG = O_BSEG + (size_t)NBH * NSEG * 16384;
constexpr size_t O_CPROD = O_SSEG + (size_t)NBH * NSEG * 16384;
static_assert(O_CPROD + NBH * NSEG <= (size_t)T * D, "segment scratch fits in the y region of d_out");

template <bool HASWV> __device__ __forceinline__ void dn_consume_map(const LAS unsigned char* fb, int wl, f32x4 (&X)[8], float cd) {
    f32x4 u[4]; bf16x8 f0[8], f1[8], Xb[4], Ub[2];
#pragma unroll
    for (int mt = 0; mt < 4; ++mt) u[mt] = HASWV ? *(const LAS f32x4*)(fb + (FR_N + wl * 4 + mt) * 1024) : (f32x4){0.f, 0.f, 0.f, 0.f};
#pragma unroll
    for (int f = 0; f < 8; ++f) f0[f] = *(const LAS bf16x8*)(fb + (FR_NWK + f) * 1024);
#pragma unroll
    for (int f = 0; f < 8; ++f) f1[f] = *(const LAS bf16x8*)(fb + (FR_NWK + 8 + f) * 1024);
    DN_SB();
#pragma unroll
    for (int kb = 0; kb < 4; ++kb) Xb[kb] = pack8(X[2 * kb], X[2 * kb + 1]);
#pragma unroll
    for (int mt = 0; mt < 2; ++mt)
#pragma unroll
        for (int kb = 0; kb < 4; ++kb) u[mt] = __builtin_amdgcn_mfma_f32_16x16x32_bf16(f0[mt * 4 + kb], Xb[kb], u[mt], 0, 0, 0);
    DN_SB();
#pragma unroll
    for (int f = 0; f < 8; ++f) f0[f] = *(const LAS bf16x8*)(fb + (FR_KTT + f) * 1024);
    DN_SB();
#pragma unroll
    for (int mt = 2; mt < 4; ++mt)
#pragma unroll
        for (int kb = 0; kb < 4; ++kb) u[mt] = __builtin_amdgcn_mfma_f32_16x16x32_bf16(f1[(mt - 2) * 4 + kb], Xb[kb], u[mt], 0, 0, 0);
    DN_SB();
#pragma unroll
    for (int f = 0; f < 8; ++f) f1[f] = *(const LAS bf16x8*)(fb + (FR_KTT + 8 + f) * 1024);
#pragma unroll
    for (int tb = 0; tb < 2; ++tb) Ub[tb] = pack8(u[2 * tb], u[2 * tb + 1]);
#pragma unroll
    for (int kt = 0; kt < 8; ++kt) X[kt] = X[kt] * cd;
    DN_SB();
#pragma unroll
    for (int kt = 0; kt < 4; ++kt)
#pragma unroll
        for (int tb = 0; tb < 2; ++tb) X[kt] = __builtin_amdgcn_mfma_f32_16x16x32_bf16(f0[kt * 2 + tb], Ub[tb], X[kt], 0, 0, 0);
#pragma unroll
    for (int kt = 4; kt < 8; ++kt)
#pragma unroll
        for (int tb = 0; tb < 2; ++tb) X[kt] = __builtin_amdgcn_mfma_f32_16x16x32_bf16(f1[(kt - 4) * 2 + tb], Ub[tb], X[kt], 0, 0, 0);
}
#define DNS_BAR() do { asm volatile("s_waitcnt lgkmcnt(0)" ::: "memory"); __builtin_amdgcn_s_barrier(); asm volatile("" ::: "memory"); } while (0)
template <int MODE> __device__ __forceinline__ void dns_loader(const P& p, LAS unsigned char* lds, int bh, int n0, int nsteps, int vh, int wl, int lane) {
    constexpr int NPW = MODE == 2 ? 18 : (MODE == 1 ? 12 : 8);
    const unsigned char* ab = p.ws + WS_DNF_AB + ((size_t)bh * NCHUNK + n0) * DNF_AB_UNIT + lane * 16;
    const unsigned char* wvb = p.ws + WS_DNF_WV + ((size_t)bh * NCHUNK + n0) * DNF_WV_UNIT + (size_t)vh * 16 * 1024 + lane * 16;
    u32x4 R[2][NPW];
#define DNS_FRAG(q_) (MODE == 2 ? (q_) : ((q_) < 16 ? (q_) : ((q_) < 32 ? FR_KTT + (q_) - 16 : FR_N + (q_) - 32)))
#define DNS_SRC(n_, q_) (DNS_FRAG(q_) < FR_N ? ab + (size_t)(n_) * DNF_AB_UNIT + DNS_FRAG(q_) * 1024 : wvb + (size_t)(n_) * DNF_WV_UNIT + (DNS_FRAG(q_) - FR_N) * 1024)
#define DNS_LD(n_, s_) do { if ((n_) < nsteps) { _Pragma("unroll") for (int i_ = 0; i_ < NPW; ++i_) R[s_][i_] = *(const u32x4*)DNS_SRC(n_, wl * NPW + i_); } } while (0)
#define DNS_ST(n_, s_) do { if ((n_) < nsteps) { LAS unsigned char* d_ = lds + ((n_) & 1) * DN_SBUF + lane * 16; _Pragma("unroll") for (int i_ = 0; i_ < NPW; ++i_) *(LAS u32x4*)(d_ + DNS_FRAG(wl * NPW + i_) * 1024) = R[s_][i_]; } } while (0)
    DNS_LD(0, 0); DNS_LD(1, 1); DNS_ST(0, 0);
    DNS_BAR();
#define DNS_LSTEP(n_, s_) do { const int n = (n_); if (n < nsteps) { DNS_LD(n + 2, s_); DNS_ST(n + 1, (s_) ^ 1); DNS_BAR(); } } while (0)
    for (int n2 = 0; n2 < nsteps; n2 += 2) { DNS_LSTEP(n2, 0); DNS_LSTEP(n2 + 1, 1); }
#undef DNS_LSTEP
#undef DNS_LD
#undef DNS_ST
#undef DNS_SRC
#undef DNS_FRAG
}
constexpr int PA_RTP = 72;
template <int MODE> __device__ __forceinline__ void dns_passA_task(const P& p, LAS unsigned char* lds, int bh, int seg, int q, int wave, int lane) {
    const int r16 = lane & 15, g4 = lane >> 4, wl = wave & 3, n0 = seg * CSEG;
    const float* cdp = ws_f(p, WS_DNF_CD) + (size_t)bh * NCHUNK + n0;
    LAS bf16_t* RT = (LAS bf16_t*)lds;
    if (wave >= 4) { dns_loader<MODE>(p, lds, bh, n0, CSEG, q & 1, wl, lane); }
    else {
        f32x4 X[8];
#pragma unroll
        for (int kt = 0; kt < 8; ++kt)
#pragma unroll
            for (int i = 0; i < 4; ++i) X[kt][i] = (MODE == 0 && 16 * kt + 4 * g4 + i == 64 * q + 16 * wl + r16) ? 1.f : 0.f;
        float cd = cdp[0], cprod = 1.f;
        DNS_BAR();
        for (int n = 0; n < CSEG; ++n) {
            const float cdn = cdp[n + 1 < CSEG ? n + 1 : n];
            dn_consume_map<MODE == 1>(lds + (n & 1) * DN_SBUF + lane * 16, wl, X, cd);
            cprod *= cd; cd = cdn;
            DNS_BAR();
        }
        if (MODE == 0) {
#pragma unroll
            for (int kt = 0; kt < 8; ++kt)
#pragma unroll
                for (int i = 0; i < 4; ++i) { const int row = 16 * kt + 4 * g4 + i, col = 16 * wl + r16; const float v = X[kt][i] - ((row == 64 * q + col) ? cprod : 0.f);
                    RT[row * PA_RTP + col] = f2bf(v); }
            if (q == 0 && wave == 0 && lane == 0) p.out[O_CPROD + bh * NSEG + seg] = cprod;
        } else {
            float* bo = p.out + O_BSEG + ((size_t)(bh * NSEG + seg) * 8 + (4 * (q & 1) + wl)) * 2048 + lane * 4;
#pragma unroll
            for (int kt = 0; kt < 8; ++kt) *(f32x4*)(bo + kt * 256) = X[kt];
        }
    }
    DNS_BAR();
    if (MODE == 0) {
#pragma unroll
        for (int j = 0; j < 2; ++j) { const int f = wave * 2 + j, mt = f >> 1, kbl = f & 1, row = 16 * mt + r16;
            const u32x2 lo = *(const LAS u32x2*)(RT + row * PA_RTP + 32 * kbl + 4 * g4), hi = *(const LAS u32x2*)(RT + row * PA_RTP + 32 * kbl + 16 + 4 * g4);
            *(u32x4*)((unsigned char*)(p.out + O_RFRAG) + ((size_t)(bh * NSEG + seg) * 32 + mt * 4 + 2 * q + kbl) * 1024 + lane * 16) = (u32x4){lo.x, lo.y, hi.x, hi.y}; }
        DNS_BAR();
    }
}
__device__ __forceinline__ void phase_dns_passA(const P& p, LAS unsigned char* lds) {
    const int tid = otid(), lane = tid & 63, wave = __builtin_amdgcn_readfirstlane(tid >> 6);
    for (int t = blockIdx.x; t < NBH * NSEG * 4; t += gridDim.x) {
        const int q = t & 3, seg = (t >> 2) % NSEG, bh = t / (4 * NSEG);
        if (q < 2) dns_passA_task<0>(p, lds, bh, seg, q, wave, lane); else dns_passA_task<1>(p, lds, bh, seg, q, wave, lane);
    }
}
__device__ __forceinline__ void phase_dns_passB(const P& p, LAS unsigned char* lds) {
    if ((int)blockIdx.x >= NBH * 8) return;
    const int tid = otid(), lane = tid & 63, w = __builtin_amdgcn_readfirstlane(tid >> 6), r16 = lane & 15, g4 = lane >> 4;
    const int bh = blockIdx.x >> 3, vs = blockIdx.x & 7;
    LAS u32x2* XB = (LAS u32x2*)lds;
    const unsigned char* rf0 = (const unsigned char*)(p.out + O_RFRAG) + ((size_t)bh * NSEG * 32 + w * 4) * 1024 + lane * 16;
    const float* bt0 = p.out + O_BSEG + ((size_t)bh * NSEG * 8 + vs) * 2048 + w * 256 + lane * 4;
    float* ss0 = p.out + O_SSEG + ((size_t)bh * NSEG * 8 + vs) * 2048 + w * 256 + lane * 4;
    const float* cp0 = p.out + O_CPROD + bh * NSEG;
    u32x4 rf[4][4]; f32x4 bt[4]; float cp[4];
#define PB_LD(s_, r_) do { if ((s_) < NSEG) { _Pragma("unroll") for (int kb = 0; kb < 4; ++kb) rf[r_][kb] = *(const u32x4*)(rf0 + (size_t)(s_) * 32768 + kb * 1024); bt[r_] = *(const f32x4*)(bt0 + (size_t)(s_) * 16384); cp[r_] = cp0[(s_)]; } } while (0)
    PB_LD(0, 0); PB_LD(1, 1); PB_LD(2, 2);
    f32x4 S = (f32x4){0.f, 0.f, 0.f, 0.f};
#pragma unroll
    for (int s = 0; s < NSEG; ++s) {
        PB_LD(s + 3, (s + 3) & 3);
        *(f32x4*)(ss0 + (size_t)s * 16384) = S;
        XB[((s & 1) * 8 + w) * 64 + lane] = (u32x2){cvtpk_c(S[0], S[1]), cvtpk_c(S[2], S[3])};
        DNS_BAR();
        f32x4 acc = S * cp[s & 3] + bt[s & 3];
#pragma unroll
        for (int kb = 0; kb < 4; ++kb) { const u32x2 lo = XB[((s & 1) * 8 + 2 * kb) * 64 + lane], hi = XB[((s & 1) * 8 + 2 * kb + 1) * 64 + lane];
            acc = __builtin_amdgcn_mfma_f32_16x16x32_bf16(__builtin_bit_cast(bf16x8, rf[s & 3][kb]), __builtin_bit_cast(bf16x8, (u32x4){lo.x, lo.y, hi.x, hi.y}), acc, 0, 0, 0); }
        S = acc;
    }
#undef PB_LD
    float* so = p.out + O_PSSM + (size_t)bh * 128 * 128 + vs * 16 + r16;
#pragma unroll
    for (int i = 0; i < 4; ++i) so[(size_t)(16 * w + 4 * g4 + i) * 128] = S[i];
    DNS_BAR();
}
__device__ __forceinline__ void phase_dns_passC(const P& p, LAS unsigned char* lds) {
    const int tid = otid(), lane = tid & 63, wave = __builtin_amdgcn_readfirstlane(tid >> 6), r16 = lane & 15, g4 = lane >> 4, wl = wave & 3;
    for (int t = blockIdx.x; t < NBH * NSEG * 2; t += gridDim.x) {
        const int vh = t & 1, seg = (t >> 1) % NSEG, bh = t / (2 * NSEG), h = bh & 3, b = bh >> 2, vs = vh * 4 + wl, n0 = seg * CSEG;
        if (wave >= 4) dns_loader<2>(p, lds, bh, n0, CSEG, vh, wl, lane);
        else {
            const float* cdp = ws_f(p, WS_DNF_CD) + (size_t)bh * NCHUNK + n0;
            const float* ss = p.out + O_SSEG + ((size_t)(bh * NSEG + seg) * 8 + vs) * 2048 + lane * 4;
            f32x4 S[8];
#pragma unroll
            for (int kt = 0; kt < 8; ++kt) S[kt] = *(const f32x4*)(ss + kt * 256);
            float cd = cdp[0];
            DNS_BAR();
            for (int n = 0; n < CSEG; ++n) {
                const float cdn = cdp[n + 1 < CSEG ? n + 1 : n];
                dn_consume(lds + (n & 1) * DN_SBUF + lane * 16, wl, S, cd, p.out + O_ODN + (size_t)(b * SEQ + (n0 + n) * 64 + 4 * g4) * 512 + h * 128 + vs * 16 + r16);
                cd = cdn;
                DNS_BAR();
            }
        }
        DNS_BAR();
    }
}
#undef DNS_BAR
constexpr size_t WS_EDGE = WS_FREE;
constexpr size_t WS_HEAD = al256(WS_EDGE + (size_t)(T / 256) * 2 * 2 * DFF * 4);
constexpr size_t WS_END = al256(WS_HEAD + (size_t)(T / 256) * 2 * 2 * DFF * 4);
constexpr int EX_OFF = 131072;
namespace pg8 {
typedef unsigned u32x2v __attribute__((ext_vector_type(2)));
__device__ __forceinline__ float dpp_shr1(float old, float src) { return __builtin_bit_cast(float, __builtin_amdgcn_update_dpp(__builtin_bit_cast(int, old), __builtin_bit_cast(int, src), 0x111, 0xf, 0xf, false)); }
__device__ __forceinline__ float dpp_shr2(float old, float src) { return __builtin_bit_cast(float, __builtin_amdgcn_update_dpp(__builtin_bit_cast(int, old), __builtin_bit_cast(int, src), 0x112, 0xf, 0xf, false)); }
__device__ __forceinline__ float dpp_ror1(float src) { return __builtin_bit_cast(float, __builtin_amdgcn_update_dpp(0, __builtin_bit_cast(int, src), 0x121, 0xf, 0xf, false)); }
__device__ __forceinline__ float dpp_ror2(float src) { return __builtin_bit_cast(float, __builtin_amdgcn_update_dpp(0, __builtin_bit_cast(int, src), 0x122, 0xf, 0xf, false)); }
struct EpiFfnUp {
    static constexpr bool PERM = false, AFTER_DRAIN = false;
    bf16_t* ACT; float* edge; float* head; const float* cw; const float* cb; const float* state; float* out_pfc; float* out_sfc; PG8_LAS unsigned char* lds;
    __device__ __forceinline__ void operator()(const f32x4 (&acc)[2][2][4][2], const Unit& u, int wr, int wc, int fr, int fq) const {
        PG8_LAS float* EX = (PG8_LAS float*)(lds + EX_OFF);
        const bool smp = u.pm >= TP / BM;
        const int cl = wc * 32 + 4 * fq;
        if (fr >= 14) {
#pragma unroll
            for (int ai = 0; ai < 2; ++ai)
#pragma unroll
                for (int bj = 0; bj < 2; ++bj)
#pragma unroll
                    for (int n = 0; n < 2; ++n) *(PG8_LAS f32x4*)(EX + ((2 * ai + wr) * 2 + (fr - 14)) * 256 + bj * HALF + cl + 16 * n) = acc[ai][bj][3][n];
            if (wr == 1) {
#pragma unroll
                for (int bj = 0; bj < 2; ++bj)
#pragma unroll
                    for (int n = 0; n < 2; ++n) { const int oc = bj * DFF + u.pn * HALF + cl + 16 * n;
                        *(f32x4*)(edge + ((size_t)u.pm * 2 + (fr - 14)) * 2 * DFF + oc) = acc[1][bj][3][n];
                        if (!smp && (u.pm & (SEQ / BM - 1)) == SEQ / BM - 1) *(f32x4*)(out_pfc + ((size_t)(u.pm / (SEQ / BM)) * 2 + (fr - 14)) * 2 * DFF + oc) = acc[1][bj][3][n]; }
            }
        }
        if (fr < 2 && wr == 0) {
#pragma unroll
            for (int bj = 0; bj < 2; ++bj)
#pragma unroll
                for (int n = 0; n < 2; ++n) *(f32x4*)(head + ((size_t)u.pm * 2 + fr) * 2 * DFF + bj * DFF + u.pn * HALF + cl + 16 * n) = acc[0][bj][0][n];
        }
        asm volatile("s_waitcnt lgkmcnt(0)" ::: "memory"); __builtin_amdgcn_s_barrier(); asm volatile("" ::: "memory");
#pragma unroll
        for (int n = 0; n < 2; ++n) {
            const int f0 = u.pn * HALF + cl + 16 * n;
            f32x4 wg[3], wu[3], bg, bu;
#pragma unroll
            for (int j = 0; j < 3; ++j) { wg[j] = *(const f32x4*)(cw + (size_t)j * 2 * DFF + f0); wu[j] = *(const f32x4*)(cw + (size_t)j * 2 * DFF + DFF + f0); }
            bg = *(const f32x4*)(cb + f0); bu = *(const f32x4*)(cb + DFF + f0);
#pragma unroll
            for (int ai = 0; ai < 2; ++ai) {
                const int s = 2 * ai + wr;
                f32x4 pg = (f32x4){0.f, 0.f, 0.f, 0.f}, pu = pg;
                if (!smp && s > 0 && fr >= 14) { pg = *(const PG8_LAS f32x4*)(EX + ((s - 1) * 2 + (fr - 14)) * 256 + cl + 16 * n); pu = *(const PG8_LAS f32x4*)(EX + ((s - 1) * 2 + (fr - 14)) * 256 + HALF + cl + 16 * n); }
#pragma unroll
                for (int m = 0; m < 4; ++m) {
                    const f32x4 cg = acc[ai][0][m][n], cu = acc[ai][1][m][n];
                    const int row = u.pm * BM + ai * HALF + wr * 64 + m * 16 + fr;
                    f32x4 g1, g2, u1, u2;
#pragma unroll
                    for (int e = 0; e < 4; ++e) { g1[e] = dpp_shr1(dpp_ror1(pg[e]), cg[e]); g2[e] = dpp_shr2(dpp_ror2(pg[e]), cg[e]); u1[e] = dpp_shr1(dpp_ror1(pu[e]), cu[e]); u2[e] = dpp_shr2(dpp_ror2(pu[e]), cu[e]); }
                    if (smp) {
                        const int t = fr & 7, b = (row - TP) >> 3;
                        if (t < 2) { const float* st = state + (size_t)b * 2 * 2 * DFF + f0; const f32x4 s1g = *(const f32x4*)(st + 2 * DFF), s1u = *(const f32x4*)(st + 2 * DFF + DFF);
                            if (t == 0) { g1 = s1g; u1 = s1u; g2 = *(const f32x4*)st; u2 = *(const f32x4*)(st + DFF); } else { g2 = s1g; u2 = s1u; } }
                        if (t >= 6) { float* o = out_sfc + ((size_t)b * 2 + (t - 6)) * 2 * DFF + f0; *(f32x4*)o = cg; *(f32x4*)(o + DFF) = cu; }
                    }
                    const f32x4 gc = wg[0] * g2 + wg[1] * g1 + wg[2] * cg + bg, uc = wu[0] * u2 + wu[1] * u1 + wu[2] * cu + bu;
                    u32x2v w;
                    { const float a0 = gc[0] * uc[0] * __builtin_amdgcn_rcpf(1.0f + __expf(-gc[0])), a1 = gc[1] * uc[1] * __builtin_amdgcn_rcpf(1.0f + __expf(-gc[1])), a2 = gc[2] * uc[2] * __builtin_amdgcn_rcpf(1.0f + __expf(-gc[2])), a3 = gc[3] * uc[3] * __builtin_amdgcn_rcpf(1.0f + __expf(-gc[3]));
                      w.x = cvt_pk_bf16(a0, a1); w.y = cvt_pk_bf16(a2, a3); }
                    *(u32x2v*)(ACT + (size_t)row * DFF + f0) = w;
                    pg = cg; pu = cu;
                }
            }
        }
    }
};
}
__device__ __forceinline__ void phase_ffn_fix(const P& p) {
    constexpr int TPS = SEQ / 256;
    const long n = (long)(BATCH * TPS) * DFF;
    const float* edge = ws_f(p, WS_EDGE); const float* head = ws_f(p, WS_HEAD);
    for (long i = blockIdx.x * (long)NTHR + otid(); i < n; i += (long)gridDim.x * NTHR) {
        const int pm = (int)(i / DFF), f = (int)(i % DFF);
        if (pm % TPS == 0) continue;
        float r0[2], r1[2];
#pragma unroll
        for (int gu = 0; gu < 2; ++gu) { const int c = gu * DFF + f;
            const float um2 = edge[((size_t)(pm - 1) * 2 + 0) * 2 * DFF + c], um1 = edge[((size_t)(pm - 1) * 2 + 1) * 2 * DFF + c], u0 = head[((size_t)pm * 2 + 0) * 2 * DFF + c], u1 = head[((size_t)pm * 2 + 1) * 2 * DFF + c];
            const float w0 = p.ffn_conv_w[c], w1 = p.ffn_conv_w[2 * DFF + c], w2 = p.ffn_conv_w[4 * DFF + c], bb = p.ffn_conv_b[c];
            r0[gu] = w0 * um2 + w1 * um1 + w2 * u0 + bb; r1[gu] = w0 * um1 + w1 * u0 + w2 * u1 + bb; }
        bf16_t* ACT = ws_h(p, WS_ACT) + (size_t)pm * 256 * DFF + f;
        ACT[0] = f2bf(silu_f(r0[0]) * r0[1]); ACT[DFF] = f2bf(silu_f(r1[0]) * r1[1]);
    }
}
constexpr int SW_KP = 72;
__device__ __forceinline__ void swa_bias(const LAS float* BT, int lane, float (&bv)[9][4]) {
    const int r16 = lane & 15, g4 = lane >> 4;
#pragma unroll
    for (int t = 0; t < 9; ++t)
#pragma unroll
        for (int e = 0; e < 4; ++e) { const int d = 128 + r16 - 16 * t - 4 * g4 - e; bv[t][e] = (d >= 0 && d <= 127) ? BT[d] * 1.4426950408889634f : -1e30f; }
}
__device__ __forceinline__ void swa_qtile(const LAS bf16_t* KS, const LAS bf16_t* VT, int vtp, int qt, const bf16x8 (&bq)[2], const float (&bv)[9][4], float sink2, bool first, bf16_t* optr, int nvalid_q, int lane) {
    const int r16 = lane & 15, g4 = lane >> 4, kt0 = qt;
    f32x4 s[10];
#pragma unroll
    for (int tb = 0; tb < 2; ++tb) {
        bf16x8 ka[5][2];
#pragma unroll
        for (int t = 0; t < 5; ++t)
#pragma unroll
            for (int ks = 0; ks < 2; ++ks) if (5 * tb + t < 9) ka[t][ks] = *(const LAS bf16x8*)(KS + (16 * (kt0 + 5 * tb + t) + r16) * SW_KP + 32 * ks + 8 * g4);
        __builtin_amdgcn_sched_barrier(0);
#pragma unroll
        for (int t = 0; t < 5; ++t) if (5 * tb + t < 9) { f32x4 a = (f32x4){0.f, 0.f, 0.f, 0.f};
#pragma unroll
            for (int ks = 0; ks < 2; ++ks) a = __builtin_amdgcn_mfma_f32_16x16x32_bf16(ka[t][ks], bq[ks], a, 0, 0, 0);
            s[5 * tb + t] = a; }
        __builtin_amdgcn_sched_barrier(0);
    }
    float mx = sink2;
#pragma unroll
    for (int t = 0; t < 9; ++t)
#pragma unroll
        for (int e = 0; e < 4; ++e) { float v = s[t][e] * 0.18033688011112042f + bv[t][e]; if (first && 16 * (kt0 + t) + 4 * g4 + e < 128) v = -1e30f; s[t][e] = v; mx = fmaxf(mx, v); }
    mx = fmaxf(mx, __shfl_xor(mx, 16)); mx = fmaxf(mx, __shfl_xor(mx, 32));
    float l = 0.f;
#pragma unroll
    for (int t = 0; t < 9; ++t)
#pragma unroll
        for (int e = 0; e < 4; ++e) { const float pv = __builtin_amdgcn_exp2f(s[t][e] - mx); s[t][e] = pv; l += pv; }
    s[9] = (f32x4){0.f, 0.f, 0.f, 0.f};
    l += __shfl_xor(l, 16); l += __shfl_xor(l, 32);
    l += __builtin_amdgcn_exp2f(sink2 - mx);
    const float rl = __builtin_amdgcn_rcpf(l);
    bf16x8 pb[5];
#pragma unroll
    for (int q = 0; q < 5; ++q) pb[q] = pack8(s[2 * q], s[2 * q + 1]);
#pragma unroll
    for (int dp = 0; dp < 2; ++dp) {
        u32x2 vl[2][5], vh[2][5];
#pragma unroll
        for (int d2 = 0; d2 < 2; ++d2)
#pragma unroll
            for (int q = 0; q < 5; ++q) { const LAS bf16_t* vp = VT + (16 * (2 * dp + d2) + r16) * vtp + 16 * (kt0 + 2 * q) + 4 * g4; vl[d2][q] = *(const LAS u32x2*)vp; vh[d2][q] = *(const LAS u32x2*)(vp + 16); }
        __builtin_amdgcn_sched_barrier(0);
#pragma unroll
        for (int d2 = 0; d2 < 2; ++d2) { const int dt = 2 * dp + d2; f32x4 o = (f32x4){0.f, 0.f, 0.f, 0.f};
#pragma unroll
            for (int q = 0; q < 5; ++q) o = __builtin_amdgcn_mfma_f32_16x16x32_bf16(__builtin_bit_cast(bf16x8, (u32x4){vl[d2][q].x, vl[d2][q].y, vh[d2][q].x, vh[d2][q].y}), pb[q], o, 0, 0, 0);
            if (r16 < nvalid_q) *(u32x2*)(optr + (size_t)r16 * 1024 + 16 * dt + 4 * g4) = (u32x2){cvtpk_c(o[0] * rl, o[1] * rl), cvtpk_c(o[2] * rl, o[3] * rl)}; }
        __builtin_amdgcn_sched_barrier(0);
    }
}
constexpr int SWP_VTP = 272, SWS_NK = 144, SWS_VTP = 168;
constexpr int SW_KS = 0, SW_VT = 43008, SW_BT = 86016, SW_END = SW_BT + 8 * 128 * 4;
static_assert(256 * SW_KP * 2 <= SW_VT && SW_VT + 64 * SWP_VTP * 2 <= SW_BT && SWS_NK * SW_KP * 2 <= SW_VT && SW_VT + 64 * SWS_VTP * 2 <= SW_BT, "swa LDS map");
__device__ __forceinline__ void phase_swa(const P& p, LAS unsigned char* lds, unsigned long long& pr_prev, unsigned long long& pr_acc) {
    const int tid = otid(), lane = tid & 63, wave = tid >> 6;
    LAS bf16_t* KS = (LAS bf16_t*)(lds + SW_KS); LAS bf16_t* VT = (LAS bf16_t*)(lds + SW_VT); LAS float* BT = (LAS float*)(lds + SW_BT);
    const bf16_t* PR = ws_h(p, WS_PROJ); bf16_t* MX = ws_h(p, WS_MIX);
    constexpr int NQB = SEQ / 128, NPU = BATCH * NQB * 2, NU = NPU + DEC_BATCH * 2;
    for (int i = tid; i < 8 * 128; i += NTHR) BT[i] = p.rel_bias[t5_bucket(i & 127) * 8 + (i >> 7)];
    for (int u = blockIdx.x; u < NU; u += gridDim.x) {
        __syncthreads(); DPS(22);
        if (u < NPU) {
            const int kvh = u & 1, qb = (u >> 1) % NQB, b = (u >> 1) / NQB, m0 = b * SEQ + qb * 128; const bool first = qb == 0;
            const bf16_t* qbase = PR + (size_t)(m0 + 64 * (wave & 1) + (lane & 15)) * PLD + PC_SQ + (kvh * 4 + (wave >> 1)) * 64 + 8 * (lane >> 4);
            bf16x8 bq[2], bqn[2];
#pragma unroll
            for (int ks = 0; ks < 2; ++ks) bq[ks] = *(const bf16x8*)(qbase + 32 * ks);
            {
                u32x4 kr[4], vr[5];
#pragma unroll
                for (int i = 0; i < 4; ++i) { const int it = tid + i * NTHR, jj = it >> 3, c = it & 7; kr[i] = (u32x4){0u, 0u, 0u, 0u};
                    if (!(first && jj < 128)) kr[i] = *(const u32x4*)(PR + (size_t)(m0 - 128 + jj) * PLD + PC_SK + kvh * 64 + 8 * c); }
#pragma unroll
                for (int i = 0; i < 5; ++i) { const int it = tid + i * NTHR, jj = it % 272, c = it / 272; vr[i] = (u32x4){0u, 0u, 0u, 0u};
                    if (it < 272 * 8 && jj < 256 && !(first && jj < 128)) vr[i] = *(const u32x4*)(PR + (size_t)(m0 - 128 + jj) * PLD + PC_SV + kvh * 64 + 8 * c); }
#pragma unroll
                for (int i = 0; i < 4; ++i) { const int it = tid + i * NTHR, jj = it >> 3, c = it & 7; *(LAS u32x4*)(KS + jj * SW_KP + 8 * c) = kr[i]; }
#pragma unroll
                for (int i = 0; i < 5; ++i) { const int it = tid + i * NTHR, jj = it % 272, c = it / 272;
                    if (it < 272 * 8) { const unsigned w[4] = {vr[i].x, vr[i].y, vr[i].z, vr[i].w};
#pragma unroll
                        for (int e = 0; e < 4; ++e) { VT[(8 * c + 2 * e) * SWP_VTP + jj] = (bf16_t)(w[e] & 0xffffu); VT[(8 * c + 2 * e + 1) * SWP_VTP + jj] = (bf16_t)(w[e] >> 16); } } }
            }
            __syncthreads(); DPS(23);
            const int hq = kvh * 4 + (wave >> 1), qh = wave & 1, r16 = lane & 15, g4 = lane >> 4;
            float bv[9][4]; swa_bias(BT + hq * 128, lane, bv);
            const float sink2 = p.swa_sinks[hq] * 1.4426950408889634f;
#pragma unroll 1
            for (int q4 = 0; q4 < 4; ++q4) { const int qt = 4 * qh + q4;
                if (q4 < 3) {
#pragma unroll
                    for (int ks = 0; ks < 2; ++ks) bqn[ks] = *(const bf16x8*)(qbase + (size_t)(16 * (q4 + 1)) * PLD + 32 * ks); }
                swa_qtile(KS, VT, SWP_VTP, qt, bq, bv, sink2, first, MX + (size_t)(m0 + 16 * qt) * 1024 + 512 + hq * 64, 16, lane);
                bq[0] = bqn[0]; bq[1] = bqn[1]; }
            DPS(24);
        } else {
            const int su = u - NPU, b = su >> 1, kvh = su & 1, m0 = TP + b * DEC_SEQ;
            bf16x8 bqs[2];
#pragma unroll
            for (int ks = 0; ks < 2; ++ks) bqs[ks] = *(const bf16x8*)(PR + (size_t)(m0 + (lane & 7)) * PLD + PC_SQ + (kvh * 4 + (wave & 3)) * 64 + 32 * ks + 8 * (lane >> 4));
            {
                f32x4 ka[3][2], va[3][2]; u32x4 kn[3], vn[3];
#pragma unroll
                for (int i = 0; i < 3; ++i) { const int it = tid + i * NTHR, jj = it >> 3, c = it & 7;
                    ka[i][0] = ka[i][1] = (f32x4){0.f, 0.f, 0.f, 0.f}; kn[i] = (u32x4){0u, 0u, 0u, 0u};
                    if (it < SWS_NK * 8) { if (jj < 128) { const float* src = p.cache_k + ((size_t)b * 128 + jj) * 128 + kvh * 64 + 8 * c; ka[i][0] = *(const f32x4*)src; ka[i][1] = *(const f32x4*)(src + 4); }
                        else if (jj < 128 + DEC_SEQ) kn[i] = *(const u32x4*)(PR + (size_t)(m0 + jj - 128) * PLD + PC_SK + kvh * 64 + 8 * c); } }
#pragma unroll
                for (int i = 0; i < 3; ++i) { const int it = tid + i * NTHR, jj = it % SWS_VTP, c = it / SWS_VTP;
                    va[i][0] = va[i][1] = (f32x4){0.f, 0.f, 0.f, 0.f}; vn[i] = (u32x4){0u, 0u, 0u, 0u};
                    if (it < SWS_VTP * 8) { if (jj < 128) { const float* src = p.cache_v + ((size_t)b * 128 + jj) * 128 + kvh * 64 + 8 * c; va[i][0] = *(const f32x4*)src; va[i][1] = *(const f32x4*)(src + 4); }
                        else if (jj < 128 + DEC_SEQ) vn[i] = *(const u32x4*)(PR + (size_t)(m0 + jj - 128) * PLD + PC_SV + kvh * 64 + 8 * c); } }
#pragma unroll
                for (int i = 0; i < 3; ++i) { const int it = tid + i * NTHR, jj = it >> 3, c = it & 7;
                    if (it < SWS_NK * 8) { u32x4 v = kn[i]; if (jj < 128) v = (u32x4){cvtpk_c(ka[i][0][0], ka[i][0][1]), cvtpk_c(ka[i][0][2], ka[i][0][3]), cvtpk_c(ka[i][1][0], ka[i][1][1]), cvtpk_c(ka[i][1][2], ka[i][1][3])};
                        *(LAS u32x4*)(KS + jj * SW_KP + 8 * c) = v; } }
#pragma unroll
                for (int i = 0; i < 3; ++i) { const int it = tid + i * NTHR, jj = it % SWS_VTP, c = it / SWS_VTP;
                    if (it < SWS_VTP * 8) { u32x4 v = vn[i]; if (jj < 128) v = (u32x4){cvtpk_c(va[i][0][0], va[i][0][1]), cvtpk_c(va[i][0][2], va[i][0][3]), cvtpk_c(va[i][1][0], va[i][1][1]), cvtpk_c(va[i][1][2], va[i][1][3])};
                        const unsigned w[4] = {v.x, v.y, v.z, v.w};
#pragma unroll
                        for (int e = 0; e < 4; ++e) { VT[(8 * c + 2 * e) * SWS_VTP + jj] = (bf16_t)(w[e] & 0xffffu); VT[(8 * c + 2 * e + 1) * SWS_VTP + jj] = (bf16_t)(w[e] >> 16); } } }
            }
            __syncthreads(); DPS(25);
            if (wave < 4) { const int hq = kvh * 4 + wave;
                float bv[9][4]; swa_bias(BT + hq * 128, lane, bv);
                swa_qtile(KS, VT, SWS_VTP, 0, bqs, bv, p.swa_sinks[hq] * 1.4426950408889634f, false, MX + (size_t)m0 * 1024 + 512 + hq * 64, 8, lane); }
        }
    }
    __syncthreads();
}
static void fill_params(P& p, void* const* d_in, void* d_out, void* d_ws) {
    const float** pp = (const float**)&p;
    for (int i = 0; i < 26; ++i) pp[i] = (const float*)d_in[i];
    p.out = (float*)d_out; p.ws = (unsigned char*)d_ws;
}
namespace cg = cooperative_groups;
constexpr int CW_BAR = 1024;
constexpr size_t CTL_ZERO_BYTES = 65536;

#ifndef PROBE_MASK
#define PROBE_MASK 0
#endif
#ifndef PROBE_K
#define PROBE_K 4
#endif
#ifndef PROBE_XSYNC
#define PROBE_XSYNC 0
#endif
#if PROBE_MASK
#define PROBE_SUB(k) do { xcd_barrier(bar); PROBE_STAMP(k); } while (0)
#define PROBE_DECL unsigned long long pr_prev = __builtin_amdgcn_s_memrealtime(), pr_acc = 0ull
#define PROBE_STAMP(k) do { const unsigned long long now_ = __builtin_amdgcn_s_memrealtime(); if ((PROBE_MASK >> (k)) & 1) pr_acc += now_ - pr_prev; pr_prev = now_; } while (0)
#define PROBE_END() do { xcd_barrier(bar); PROBE_STAMP(11); if (blockIdx.x == 0 && __builtin_amdgcn_mbcnt_hi(~0u, __builtin_amdgcn_mbcnt_lo(~0u, 0u)) == 0u) { const unsigned long long t0_ = __builtin_amdgcn_s_memrealtime(); while (__builtin_amdgcn_s_memrealtime() - t0_ < (unsigned long long)PROBE_K * pr_acc) __builtin_amdgcn_s_sleep(8); } } while (0)
#else
#define PROBE_DECL unsigned long long pr_prev = 0ull, pr_acc = 0ull
#define PROBE_SUB(k)
#define PROBE_STAMP(k)
#define PROBE_END() do { for (int i_ = 0; i_ < PROBE_XSYNC; ++i_) xcd_barrier(bar); } while (0)
#endif
__global__ void __launch_bounds__(512, 2) fwd_megakernel(P p) {
    extern __shared__ __attribute__((aligned(16))) unsigned char lds_raw[];
    LAS unsigned char* lds = (LAS unsigned char*)lds_raw;
    cg::grid_group grid = cg::this_grid();
    PROBE_DECL;
    volatile LAS unsigned* MISC = (volatile LAS unsigned*)(lds + LDS_BYTES - 64);
    if (threadIdx.x < 16) MISC[threadIdx.x] = 0u;
    __syncthreads();
    const XcdBarrier bar = xcd_barrier_post((unsigned*)(p.ws + WS_CTL) + CW_BAR, MISC);
    phase_mod(p, lds); phase_transposes(p, lds);
    if (p.ws == nullptr) grid.sync();
    xcd_barrier(bar); PROBE_STAMP(0);
    phase_norm<0>(p, lds);
    xcd_barrier(bar); PROBE_STAMP(1);
    { pg8::StaticOrder S; pg8::Gemm g{ws_h(p, WS_H), ws_h(p, WS_WT_IN), T, PLD, D}; S.init(T, PLD, gridDim.x, blockIdx.x, D); pg8::EpiStoreBf16 E{ws_h(p, WS_PROJ), PLD};
      pg8::gemm_phase<pg8::EpiStoreBf16, pg8::StaticOrder, true, true>(lds, g, S, E); }
    xcd_barrier(bar); PROBE_STAMP(2);
    phase_state_out(p);
    PROBE_STAMP(21);
    phase_dnprep(p, lds, pr_prev, pr_acc);
    PROBE_SUB(12);
    phase_dnsample(p, lds, pr_prev, pr_acc);
    PROBE_SUB(13);
    phase_swa(p, lds, pr_prev, pr_acc);
    xcd_barrier(bar); PROBE_STAMP(3);
    phase_dns_passA(p, lds);
    xcd_barrier(bar); PROBE_STAMP(14);
    phase_dns_passB(p, lds);
    xcd_barrier(bar); PROBE_STAMP(15);
    phase_dns_passC(p, lds);
    xcd_barrier(bar); PROBE_STAMP(4);
    phase_dngate(p);
    xcd_barrier(bar); PROBE_STAMP(5);
    { pg8::SplitOrder S; pg8::Gemm g{ws_h(p, WS_MIX), ws_h(p, WS_WT_OUT), T, D, 1024}; S.init(D, 1024, NS_OUT, gridDim.x, blockIdx.x); pg8::EpiGateRes E{p.x_prompt, p.x_sample, p.out + O_Y, ws_f(p, WS_MOD) + 2 * D, ws_f(p, WS_SLAB), NS_OUT};
      pg8::gemm_phase<pg8::EpiGateRes, pg8::SplitOrder, true, true>(lds, g, S, E); }
    xcd_barrier(bar); PROBE_STAMP(6);
    phase_norm<1>(p, lds);
    xcd_barrier(bar); PROBE_STAMP(7);
    { pg8::StaticOrder S; pg8::Gemm g{ws_h(p, WS_H), ws_h(p, WS_WT_UP), T, 2 * DFF, D}; S.init(T, 2 * DFF, gridDim.x, blockIdx.x, D);
      pg8::EpiFfnUp E{ws_h(p, WS_ACT), ws_f(p, WS_EDGE), ws_f(p, WS_HEAD), p.ffn_conv_w, p.ffn_conv_b, p.state_ffn, p.out + O_PFC, p.out + O_SFC, lds};
      pg8::gemm_phase<pg8::EpiFfnUp, pg8::StaticOrder, true, true>(lds, g, S, E); }
    xcd_barrier(bar); PROBE_STAMP(8);
    phase_ffn_fix(p);
    xcd_barrier(bar); PROBE_STAMP(9);
    { pg8::SplitOrder S; pg8::Gemm g{ws_h(p, WS_ACT), ws_h(p, WS_WT_DN), T, D, DFF}; S.init(D, DFF, NS_DN, gridDim.x, blockIdx.x); pg8::EpiGateRes E{p.out + O_Y, p.out + O_Y + (size_t)TP * D, p.out + O_Y, ws_f(p, WS_MOD) + 5 * D, ws_f(p, WS_SLAB), NS_DN};
      pg8::gemm_phase<pg8::EpiGateRes, pg8::SplitOrder, true, true>(lds, g, S, E); }
    xcd_barrier(bar); PROBE_STAMP(10);
    phase_norm<2>(p, lds);
    PROBE_END();
}
extern "C" void kernel_launch(void* const* d_in, const int* in_sizes, int n_in, void* d_out, int out_size, void* d_ws, size_t ws_size, hipStream_t stream) {
    static int grid_blocks = 0;
    if (grid_blocks == 0) {
        if (n_in != 26 || (long)out_size != O_END || ws_size < WS_END) { fprintf(stderr, "kernel_launch: unexpected shapes n_in=%d out=%d ws=%zu (need %zu)\n", n_in, out_size, ws_size, (size_t)WS_END); grid_blocks = -1; return; }
        int dev = 0, cus = 0, per_cu = 0;
        if (hipGetDevice(&dev) != hipSuccess || hipDeviceGetAttribute(&cus, hipDeviceAttributeMultiprocessorCount, dev) != hipSuccess) { grid_blocks = -1; return; }
        if (hipFuncSetAttribute((const void*)fwd_megakernel, hipFuncAttributeMaxDynamicSharedMemorySize, LDS_BYTES) != hipSuccess) { fprintf(stderr, "kernel_launch: hipFuncSetAttribute failed\n"); grid_blocks = -1; return; }
        if (hipOccupancyMaxActiveBlocksPerMultiprocessor(&per_cu, (const void*)fwd_megakernel, NTHR, LDS_BYTES) != hipSuccess || per_cu < 1) { fprintf(stderr, "kernel_launch: occupancy query says %d\n", per_cu); grid_blocks = -1; return; }
        grid_blocks = cus;
        fprintf(stderr, "kernel_launch: grid %d (cus %d, per_cu %d)\n", grid_blocks, cus, per_cu);
    }
    if (grid_blocks < 0) return;
    P p{}; fill_params(p, d_in, d_out, d_ws);
    if (hipMemsetAsync((char*)d_ws + WS_CTL, 0, CTL_ZERO_BYTES, stream) != hipSuccess) { fprintf(stderr, "kernel_launch: memset of the control words failed\n"); return; }
    void* args[] = {&p};
    const hipError_t e = hipLaunchCooperativeKernel((const void*)fwd_megakernel, dim3(grid_blocks), dim3(NTHR), args, LDS_BYTES, stream);
    if (e != hipSuccess) fprintf(stderr, "cooperative launch failed: %s (grid %d)\n", hipGetErrorString(e), grid_blocks);
}
```

```cpp
#define PROBE_MASK 0
#define PROBE_XSYNC 0
#include <hip/hip_runtime.h>
#include <hip/hip_cooperative_groups.h>
#include <cstdio>
#include <cstdint>
#define HD __device__ __forceinline__
#if defined(PROBE_MASK) && PROBE_MASK
#define DPS(k) do { const unsigned long long now_ = __builtin_amdgcn_s_memrealtime(); if ((PROBE_MASK >> (k)) & 1) pr_acc += now_ - pr_prev; pr_prev = now_; } while (0)
#endif
#ifndef CFG_D_MODEL
#define CFG_D_MODEL 1024
#endif
#ifndef CFG_SEQ
#define CFG_SEQ 8192
#endif
#ifndef CFG_DEC_BATCH
#define CFG_DEC_BATCH 128
#endif
#ifndef CFG_D_FF
#define CFG_D_FF 2816
#endif

constexpr int D = CFG_D_MODEL, BATCH = 2, SEQ = CFG_SEQ, DEC_BATCH = CFG_DEC_BATCH, DEC_SEQ = 8, DFF = CFG_D_FF;
constexpr int TP = BATCH * SEQ, TS = DEC_BATCH * DEC_SEQ, T = TP + TS, NCB = BATCH + DEC_BATCH;
constexpr int IN_COLS = 2824, PLD = 2816;
constexpr int PC_QKV = 0, PC_Z = 1536, PC_SQ = 2048, PC_SK = 2560, PC_SV = 2688;
constexpr int WC_BA = 2048;
constexpr float EPS = 1e-6f;

constexpr long O_Y = 0;
constexpr long O_PDC = (long)T * D;
constexpr long O_SDC = O_PDC + (long)BATCH * 3 * 1536;
constexpr long O_PSSM = O_SDC + (long)DEC_BATCH * 3 * 1536;
constexpr long O_SSSM = O_PSSM + (long)BATCH * 4 * 128 * 128;
constexpr long O_PK = O_SSSM + (long)DEC_BATCH * 4 * 128 * 128;
constexpr long O_SK = O_PK + (long)BATCH * 128 * 128;
constexpr long O_PV = O_SK + (long)DEC_BATCH * 128 * 128;
constexpr long O_SV = O_PV + (long)BATCH * 128 * 128;
constexpr long O_PFC = O_SV + (long)DEC_BATCH * 128 * 128;
constexpr long O_SFC = O_PFC + (long)BATCH * 2 * 2 * DFF;
constexpr long O_END = O_SFC + (long)DEC_BATCH * 2 * 2 * DFF;

constexpr size_t al256(size_t x) { return (x + 255) & ~(size_t)255; }
constexpr size_t WS_CTL = 0;
constexpr size_t WS_MOD = 1u << 20;
constexpr size_t WS_BG = al256(WS_MOD + (size_t)NCB * 6 * D * 4);
constexpr size_t WS_WBAT = al256(WS_BG + (size_t)T * 8 * 4);
constexpr size_t WS_WT_IN = al256(WS_WBAT + (size_t)8 * D * 4);
constexpr size_t WS_WT_OUT = al256(WS_WT_IN + (size_t)PLD * D * 2);
constexpr size_t WS_WT_UP = al256(WS_WT_OUT + (size_t)D * 1024 * 2);
constexpr size_t WS_WT_DN = al256(WS_WT_UP + (size_t)2 * DFF * D * 2);
constexpr size_t WS_H = al256(WS_WT_DN + (size_t)D * DFF * 2);
constexpr int NCHUNK = SEQ / 64, NUNIT = BATCH * 4 * NCHUNK;
constexpr int DNF_AB_UNIT = 57344, DNF_WV_UNIT = 32768;
constexpr size_t WS_DNF_WV = WS_H;
constexpr size_t WS_DNF_AB = al256(WS_H + (size_t)T * (D > 1024 ? D : 1024) * 2);
constexpr size_t WS_DNF_CD = al256(WS_DNF_AB + (size_t)NUNIT * DNF_AB_UNIT);
constexpr size_t WS_QKVC = WS_DNF_AB;
constexpr size_t WS_PROJ = al256((WS_DNF_CD + (size_t)NUNIT * 4) > (WS_QKVC + (size_t)T * 1536 * 2) ? (WS_DNF_CD + (size_t)NUNIT * 4) : (WS_QKVC + (size_t)T * 1536 * 2));
constexpr size_t WS_MIX = al256(WS_PROJ + (size_t)T * PLD * 2);
constexpr size_t WS_FREE = al256(WS_MIX + (size_t)T * 1024 * 2);
constexpr size_t WS_ODN = WS_H, WS_ACT = WS_PROJ;
static_assert((size_t)NUNIT * DNF_WV_UNIT <= (size_t)T * 1024 * 2, "Wv tiles overlay H");

typedef unsigned short bf16_t;
HD unsigned f2bf_bits(float f) { unsigned u = __builtin_bit_cast(unsigned, f); return (u + 0x7fffu + ((u >> 16) & 1u)) >> 16; }
HD bf16_t f2bf(float f) { return (bf16_t)f2bf_bits(f); }
HD float bf2f(bf16_t b) { return __builtin_bit_cast(float, (unsigned)b << 16); }
HD float silu_f(float x) { return x / (1.0f + expf(-x)); }
HD float sigmoid_f(float x) { return 1.0f / (1.0f + expf(-x)); }
HD float softplus_f(float x) { return x > 20.f ? x : log1pf(expf(x)); }

struct P {
    const float *x_prompt, *x_sample, *state_dn_conv, *state_dn_ssm, *cache_k, *cache_v, *state_ffn, *c_prompt, *c_sample, *rel_bias,
        *final_norm_w, *w_ada, *b_ada, *norm_mix_w, *w_in, *dn_conv_w, *dn_A_log, *dn_dt_bias, *dn_norm_w, *swa_sinks, *w_out, *norm_ffn_w,
        *w_up, *ffn_conv_w, *ffn_conv_b, *w_down;
    float* out; unsigned char* ws;
};

HD const float* xrow(const P& p, int m) { return m < TP ? p.x_prompt + (size_t)m * D : p.x_sample + (size_t)(m - TP) * D; }
HD int cb_of(int m) { return m < TP ? m / SEQ : BATCH + (m - TP) / DEC_SEQ; }
HD int t_of(int m) { return m < TP ? m % SEQ : (m - TP) % DEC_SEQ; }
HD float* ws_f(const P& p, size_t off) { return (float*)(p.ws + off); }
HD bf16_t* ws_h(const P& p, size_t off) { return (bf16_t*)(p.ws + off); }

HD int t5_bucket(int d) {
    if (d < 16) return d;
    const float logv = logf((float)d / 16.0f) / 2.0794415416798357f;
    int b = 16 + (int)(logv * 16.0f);
    return b < 31 ? b : 31;
}

constexpr long N_R0A = (long)NCB * 6 * D;
HD void r0a_body(long idx, const P& p) {
    const int cb = (int)(idx / (6 * D)), e = (int)(idx % (6 * D));
    const float* c = cb < BATCH ? p.c_prompt + (size_t)cb * D : p.c_sample + (size_t)(cb - BATCH) * D;
    float acc = 0.f;
    for (int d = 0; d < D; ++d) acc += silu_f(c[d]) * p.w_ada[(size_t)d * 6 * D + e];
    ws_f(p, WS_MOD)[idx] = acc + p.b_ada[e];
}
constexpr long N_R1 = T;
template <int WHICH> HD void r1_body(long idx, const P& p) {
    const int m = (int)idx, cb = cb_of(m);
    const float* xr = WHICH == 0 ? xrow(p, m) : p.out + O_Y + (size_t)m * D;
    const float* nw = WHICH == 0 ? p.norm_mix_w : p.norm_ffn_w;
    const float* mod = ws_f(p, WS_MOD) + (size_t)cb * 6 * D;
    const float* sh = mod + (WHICH == 0 ? 0 : 3 * D); const float* sc = mod + (WHICH == 0 ? D : 4 * D);
    float ss = 0.f;
    for (int k = 0; k < D; ++k) ss += xr[k] * xr[k];
    const float rstd = 1.0f / sqrtf(ss / (float)D + EPS);
    float ba[8];
#pragma unroll
    for (int j = 0; j < 8; ++j) ba[j] = 0.f;
    bf16_t* H = ws_h(p, WS_H) + (size_t)m * D;
    for (int k = 0; k < D; ++k) {
        const float h = xr[k] * rstd * nw[k] * (1.0f + sc[k]) + sh[k];
        H[k] = f2bf(h);
        if (WHICH == 0) {
#pragma unroll
            for (int j = 0; j < 8; ++j) ba[j] += h * p.w_in[(size_t)k * IN_COLS + WC_BA + j];
        }
    }
    if (WHICH == 0) {
        float* bg = ws_f(p, WS_BG) + (size_t)m * 8;
#pragma unroll
        for (int j = 0; j < 4; ++j) {
            bg[j] = sigmoid_f(ba[j]);
            bg[4 + j] = -expf(p.dn_A_log[j]) * softplus_f(ba[4 + j] + p.dn_dt_bias[j]);
        }
    }
}
constexpr long N_R2 = (long)(T / 8) * PLD;
HD void r2_body(long idx, const P& p) {
    const int mg = (int)(idx / PLD), n = (int)(idx % PLD), oc = n < WC_BA ? n : n + 8;
    const bf16_t* H = ws_h(p, WS_H) + (size_t)mg * 8 * D;
    float acc[8];
#pragma unroll
    for (int i = 0; i < 8; ++i) acc[i] = 0.f;
    for (int k = 0; k < D; ++k) {
        const float w = bf2f(f2bf(p.w_in[(size_t)k * IN_COLS + oc]));
#pragma unroll
        for (int i = 0; i < 8; ++i) acc[i] += bf2f(H[(size_t)i * D + k]) * w;
    }
    bf16_t* PR = ws_h(p, WS_PROJ);
#pragma unroll
    for (int i = 0; i < 8; ++i) PR[(size_t)(mg * 8 + i) * PLD + n] = f2bf(acc[i]);
}
constexpr long N_R2B_1 = (long)BATCH * 3 * 1536, N_R2B_2 = (long)DEC_BATCH * 3 * 1536, N_R2B_3 = (long)BATCH * 128 * 128, N_R2B_4 = (long)DEC_BATCH * 128 * 128;
constexpr long N_R2B = N_R2B_1 + N_R2B_2 + 2 * (N_R2B_3 + N_R2B_4);
HD void r2b_body(long idx, const P& p) {
    const bf16_t* PR = ws_h(p, WS_PROJ);
    long r = idx;
    if (r < N_R2B_1) { const int b = (int)(r / (3 * 1536)), j = (int)(r / 1536 % 3), c = (int)(r % 1536);
        p.out[O_PDC + r] = bf2f(PR[(size_t)(b * SEQ + SEQ - 3 + j) * PLD + PC_QKV + c]); return; }
    r -= N_R2B_1;
    if (r < N_R2B_2) { const int b = (int)(r / (3 * 1536)), j = (int)(r / 1536 % 3), c = (int)(r % 1536);
        p.out[O_SDC + r] = bf2f(PR[(size_t)(TP + b * DEC_SEQ + DEC_SEQ - 3 + j) * PLD + PC_QKV + c]); return; }
    r -= N_R2B_2;
    for (int kv = 0; kv < 2; ++kv) {
        const int pc = kv == 0 ? PC_SK : PC_SV; const float* cache = kv == 0 ? p.cache_k : p.cache_v;
        if (r < N_R2B_3) { const int b = (int)(r / (128 * 128)), j = (int)(r / 128 % 128), c = (int)(r % 128);
            p.out[(kv == 0 ? O_PK : O_PV) + r] = bf2f(PR[(size_t)(b * SEQ + SEQ - 128 + j) * PLD + pc + c]); return; }
        r -= N_R2B_3;
        if (r < N_R2B_4) { const int b = (int)(r / (128 * 128)), j = (int)(r / 128 % 128), c = (int)(r % 128);
            float v;
            if (j < 128 - DEC_SEQ) v = cache[((size_t)b * 128 + j + DEC_SEQ) * 128 + c];
            else v = bf2f(PR[(size_t)(TP + b * DEC_SEQ + (j - (128 - DEC_SEQ))) * PLD + pc + c]);
            p.out[(kv == 0 ? O_SK : O_SV) + r] = v; return; }
        r -= N_R2B_4;
    }
}
constexpr long N_R3 = (long)T * 12;
HD float r3_conv(const P& p, int m, int t, int ch) {
    const bf16_t* PR = ws_h(p, WS_PROJ);
    float acc = 0.f;
#pragma unroll
    for (int j = 0; j < 4; ++j) {
        const int tt = t - 3 + j; float xv;
        if (tt >= 0) xv = bf2f(PR[(size_t)(m - (t - tt)) * PLD + PC_QKV + ch]);
        else xv = m < TP ? 0.f : p.state_dn_conv[((size_t)((m - TP) / DEC_SEQ) * 3 + (3 + tt)) * 1536 + ch];
        acc += p.dn_conv_w[j * 1536 + ch] * xv;
    }
    return silu_f(acc);
}
HD void r3_body(long idx, const P& p) {
    const int m = (int)(idx / 12), grp = (int)(idx % 12), part = grp / 4, cbase = grp * 128, t = t_of(m);
    float scale = 1.f;
    if (part < 2) {
        float ss = 0.f;
        for (int c = 0; c < 128; ++c) { const float v = r3_conv(p, m, t, cbase + c); ss += v * v; }
        scale = 1.0f / sqrtf(ss + EPS);
        if (part == 0) scale *= 0.08838834764831845f;
    }
    bf16_t* Q = ws_h(p, WS_QKVC) + (size_t)m * 1536 + cbase;
    for (int c = 0; c < 128; ++c) Q[c] = f2bf(r3_conv(p, m, t, cbase + c) * scale);
}
constexpr long N_R4 = (long)NCB * 4 * 128;
HD void r4_body(long idx, const P& p) {
    const int seq = (int)(idx / 512), h = (int)(idx / 128 % 4), v = (int)(idx % 128);
    const bool smp = seq >= BATCH; const int b = smp ? seq - BATCH : seq;
    float* S = p.out + (smp ? O_SSSM : O_PSSM) + ((size_t)b * 4 + h) * 128 * 128 + v;
    const float* S0 = smp ? p.state_dn_ssm + ((size_t)b * 4 + h) * 128 * 128 + v : nullptr;
    for (int k = 0; k < 128; ++k) S[(size_t)k * 128] = smp ? S0[(size_t)k * 128] : 0.f;
    const int L = smp ? DEC_SEQ : SEQ, m0 = smp ? TP + b * DEC_SEQ : b * SEQ;
    const bf16_t* QK = ws_h(p, WS_QKVC); const float* BG = ws_f(p, WS_BG); float* ODN = ws_f(p, WS_ODN);
    for (int t = 0; t < L; ++t) {
        const int m = m0 + t;
        const bf16_t* q = QK + (size_t)m * 1536 + h * 128; const bf16_t* kk = q + 512; const float vv = bf2f(q[1024 + v]);
        const float beta = BG[(size_t)m * 8 + h], eg = expf(BG[(size_t)m * 8 + 4 + h]);
        float kS = 0.f;
        for (int k = 0; k < 128; ++k) kS += bf2f(kk[k]) * (S[(size_t)k * 128] * eg);
        const float u = beta * (vv - kS);
        float o = 0.f;
        for (int k = 0; k < 128; ++k) { const float s = S[(size_t)k * 128] * eg + bf2f(kk[k]) * u; S[(size_t)k * 128] = s; o += bf2f(q[k]) * s; }
        ODN[(size_t)m * 512 + h * 128 + v] = o;
    }
}
constexpr long N_R5 = (long)T * 4;
HD void r5_body(long idx, const P& p) {
    const int m = (int)(idx / 4), h = (int)(idx % 4);
    const float* o = ws_f(p, WS_ODN) + (size_t)m * 512 + h * 128;
    float ss = 0.f;
    for (int v = 0; v < 128; ++v) ss += o[v] * o[v];
    const float rstd = 1.0f / sqrtf(ss / 128.0f + EPS);
    const bf16_t* z = ws_h(p, WS_PROJ) + (size_t)m * PLD + PC_Z + h * 128;
    bf16_t* mix = ws_h(p, WS_MIX) + (size_t)m * 1024 + h * 128;
    for (int v = 0; v < 128; ++v) mix[v] = f2bf(o[v] * rstd * p.dn_norm_w[v] * silu_f(bf2f(z[v])));
}
constexpr long N_R6 = (long)T * 8 * 8;
HD void r6_body(long idx, const P& p) {
    const int m = (int)(idx / 64), hq = (int)(idx / 8 % 8), dg = (int)(idx % 8), kvh = hq / 4, t = t_of(m);
    const bool smp = m >= TP; const int b = smp ? (m - TP) / DEC_SEQ : 0;
    const bf16_t* PR = ws_h(p, WS_PROJ);
    const bf16_t* q = PR + (size_t)m * PLD + PC_SQ + hq * 64;
    const float sink = p.swa_sinks[hq];
    const int nk = smp ? 128 : (t < 127 ? t + 1 : 128);
    float mx = sink;
    for (int pass = 0; pass < 2; ++pass) {
        float den = 0.f, acc[8];
#pragma unroll
        for (int i = 0; i < 8; ++i) acc[i] = 0.f;
        for (int jj = 0; jj < nk; ++jj) {
            int dist; const float* kf = nullptr; const float* vf = nullptr; const bf16_t* kb = nullptr; const bf16_t* vb = nullptr;
            if (smp) { const int j = t + 1 + jj; dist = 128 + t - j;
                if (j < 128) { kf = p.cache_k + ((size_t)b * 128 + j) * 128 + kvh * 64; vf = p.cache_v + ((size_t)b * 128 + j) * 128 + kvh * 64; }
                else { const size_t mm = (size_t)(TP + b * DEC_SEQ + (j - 128)); kb = PR + mm * PLD + PC_SK + kvh * 64; vb = PR + mm * PLD + PC_SV + kvh * 64; } }
            else { dist = nk - 1 - jj; const size_t mm = (size_t)(m - dist); kb = PR + mm * PLD + PC_SK + kvh * 64; vb = PR + mm * PLD + PC_SV + kvh * 64; }
            float s = 0.f;
            for (int d = 0; d < 64; ++d) s += bf2f(q[d]) * (kf ? kf[d] : bf2f(kb[d]));
            s = s * 0.125f + p.rel_bias[t5_bucket(dist) * 8 + hq];
            if (pass == 0) { mx = s > mx ? s : mx; }
            else { const float pr = expf(s - mx); den += pr;
#pragma unroll
                for (int i = 0; i < 8; ++i) acc[i] += pr * (vf ? vf[dg * 8 + i] : bf2f(vb[dg * 8 + i])); }
        }
        if (pass == 1) { den += expf(sink - mx); bf16_t* mix = ws_h(p, WS_MIX) + (size_t)m * 1024 + 512 + hq * 64 + dg * 8;
#pragma unroll
            for (int i = 0; i < 8; ++i) mix[i] = f2bf(acc[i] / den); }
    }
}
constexpr long N_R7 = (long)(T / 8) * D;
HD void r7_body(long idx, const P& p) {
    const int mg = (int)(idx / D), d = (int)(idx % D);
    const bf16_t* MX = ws_h(p, WS_MIX) + (size_t)mg * 8 * 1024;
    float acc[8];
#pragma unroll
    for (int i = 0; i < 8; ++i) acc[i] = 0.f;
    for (int e = 0; e < 1024; ++e) { const float w = bf2f(f2bf(p.w_out[(size_t)e * D + d]));
#pragma unroll
        for (int i = 0; i < 8; ++i) acc[i] += bf2f(MX[(size_t)i * 1024 + e]) * w; }
#pragma unroll
    for (int i = 0; i < 8; ++i) { const int m = mg * 8 + i; const float g1 = ws_f(p, WS_MOD)[(size_t)cb_of(m) * 6 * D + 2 * D + d];
        p.out[O_Y + (size_t)m * D + d] = xrow(p, m)[d] + g1 * acc[i]; }
}
constexpr long N_R9 = (long)(T / 8) * DFF;
HD void r9_body(long idx, const P& p) {
    const int mg = (int)(idx / DFF), f = (int)(idx % DFF), m0 = mg * 8, t0 = t_of(m0);
    const bool smp = m0 >= TP; const int b = smp ? (m0 - TP) / DEC_SEQ : m0 / SEQ;
    const bf16_t* H = ws_h(p, WS_H);
    float ug[10], uu[10];
#pragma unroll
    for (int i = 0; i < 10; ++i) { ug[i] = 0.f; uu[i] = 0.f; }
    const bool halo = (!smp && t0 > 0);
    for (int k = 0; k < D; ++k) {
        const float wg = bf2f(f2bf(p.w_up[(size_t)k * 2 * DFF + f])), wu = bf2f(f2bf(p.w_up[(size_t)k * 2 * DFF + DFF + f]));
#pragma unroll
        for (int i = 0; i < 10; ++i) { if (i < 2 && !halo) continue; const float h = bf2f(H[(size_t)(m0 - 2 + i) * D + k]); ug[i] += h * wg; uu[i] += h * wu; }
    }
    if (smp) {
#pragma unroll
        for (int i = 0; i < 2; ++i) { ug[i] = p.state_ffn[((size_t)b * 2 + i) * 2 * DFF + f]; uu[i] = p.state_ffn[((size_t)b * 2 + i) * 2 * DFF + DFF + f]; }
    }
    const float w0g = p.ffn_conv_w[f], w1g = p.ffn_conv_w[2 * DFF + f], w2g = p.ffn_conv_w[4 * DFF + f], bgt = p.ffn_conv_b[f];
    const float w0u = p.ffn_conv_w[DFF + f], w1u = p.ffn_conv_w[3 * DFF + f], w2u = p.ffn_conv_w[5 * DFF + f], bup = p.ffn_conv_b[DFF + f];
    bf16_t* ACT = ws_h(p, WS_ACT);
#pragma unroll
    for (int i = 0; i < 8; ++i) {
        const float gc = w0g * ug[i] + w1g * ug[i + 1] + w2g * ug[i + 2] + bgt, uc = w0u * uu[i] + w1u * uu[i + 1] + w2u * uu[i + 2] + bup;
        ACT[(size_t)(m0 + i) * DFF + f] = f2bf(silu_f(gc) * uc);
    }
    if (smp) {
#pragma unroll
        for (int j = 0; j < 2; ++j) { float* o = p.out + O_SFC + ((size_t)b * 2 + j) * 2 * DFF; o[f] = ug[8 + j]; o[DFF + f] = uu[8 + j]; }
    } else if (t0 == SEQ - 8) {
#pragma unroll
        for (int j = 0; j < 2; ++j) { float* o = p.out + O_PFC + ((size_t)b * 2 + j) * 2 * DFF; o[f] = ug[8 + j]; o[DFF + f] = uu[8 + j]; }
    }
}
constexpr long N_R10 = (long)(T / 8) * D;
HD void r10_body(long idx, const P& p) {
    const int mg = (int)(idx / D), d = (int)(idx % D);
    const bf16_t* A = ws_h(p, WS_ACT) + (size_t)mg * 8 * DFF;
    float acc[8];
#pragma unroll
    for (int i = 0; i < 8; ++i) acc[i] = 0.f;
    for (int f = 0; f < DFF; ++f) { const float w = bf2f(f2bf(p.w_down[(size_t)f * D + d]));
#pragma unroll
        for (int i = 0; i < 8; ++i) acc[i] += bf2f(A[(size_t)i * DFF + f]) * w; }
#pragma unroll
    for (int i = 0; i < 8; ++i) { const int m = mg * 8 + i; const float g2 = ws_f(p, WS_MOD)[(size_t)cb_of(m) * 6 * D + 5 * D + d];
        float* o = p.out + O_Y + (size_t)m * D + d; *o = *o + g2 * acc[i]; }
}
constexpr long N_R11 = T, N_R8 = T;
HD void r11_body(long idx, const P& p) {
    float* xr = p.out + O_Y + (size_t)idx * D;
    float ss = 0.f;
    for (int k = 0; k < D; ++k) ss += xr[k] * xr[k];
    const float rstd = 1.0f / sqrtf(ss / (float)D + EPS);
    for (int k = 0; k < D; ++k) xr[k] = xr[k] * rstd * p.final_norm_w[k];
}
#define LAS __attribute__((address_space(3)))
typedef float f32x4 __attribute__((ext_vector_type(4)));
typedef unsigned u32x4 __attribute__((ext_vector_type(4)));
typedef unsigned u32x2 __attribute__((ext_vector_type(2)));
constexpr int NWAVES = 8, NTHR = 512;
constexpr int LDS_BYTES = 163840;
__device__ __forceinline__ int otid() { int t = threadIdx.x; asm volatile("" : "+v"(t)); return t; }
__device__ __forceinline__ float wave_sum(float v) {
#pragma unroll
    for (int o = 1; o < 64; o <<= 1) v += __shfl_xor(v, o);
    return v;
}
__device__ __forceinline__ unsigned pk2(float lo, float hi) { return f2bf_bits(lo) | (f2bf_bits(hi) << 16); }

__device__ __forceinline__ void transpose_item(const float* W, int ldw, int K, bf16_t* WT, int dst_n0, int src_n0, int k0, LAS float* scr, int lane) {
#pragma unroll
    for (int i = 0; i < 32; ++i) { const int kk = 2 * i + (lane >> 5); scr[kk * 33 + (lane & 31)] = W[(size_t)(k0 + kk) * ldw + src_n0 + (lane & 31)]; }
    asm volatile("s_waitcnt lgkmcnt(0)" ::: "memory");
    const int c = lane & 7;
#pragma unroll
    for (int j = 0; j < 4; ++j) { const int n = (lane >> 3) + 8 * j; const LAS float* s = scr + (8 * c) * 33 + n;
        u32x4 o; o.x = pk2(s[0 * 33], s[1 * 33]); o.y = pk2(s[2 * 33], s[3 * 33]); o.z = pk2(s[4 * 33], s[5 * 33]); o.w = pk2(s[6 * 33], s[7 * 33]);
        *(u32x4*)(WT + (size_t)(dst_n0 + n) * K + k0 + 8 * c) = o; }
    asm volatile("s_waitcnt lgkmcnt(0)" ::: "memory");
}
constexpr int TI_IN = (PLD / 32) * (D / 64), TI_OUT = (D / 32) * (1024 / 64), TI_UP = (2 * DFF / 32) * (D / 64), TI_DN = (D / 32) * (DFF / 64), TI_ALL = TI_IN + TI_OUT + TI_UP + TI_DN;
__device__ __forceinline__ void phase_transposes(const P& p, LAS unsigned char* lds) {
    const int tid_ = otid(), lane = tid_ & 63, wave = tid_ >> 6;
    LAS float* scr = (LAS float*)(lds + wave * 16384);
    if (blockIdx.x == gridDim.x - 1) { for (int i = tid_; i < 8 * D; i += NTHR) ws_f(p, WS_WBAT)[i] = p.w_in[(size_t)(i % D) * IN_COLS + WC_BA + i / D]; }
    constexpr int NCG_MOD = 6 * D / 32;
    const bool split = (int)gridDim.x >= NCG_MOD + 32;
    if (split && (int)blockIdx.x < NCG_MOD) return;
    const int gw = (split ? (int)blockIdx.x - NCG_MOD : (int)blockIdx.x) * NWAVES + wave, NGW = (split ? (int)gridDim.x - NCG_MOD : (int)gridDim.x) * NWAVES;
    for (int it = gw; it < TI_ALL; it += NGW) {
        int r = it;
        if (r < TI_IN) { const int nb = r % (PLD / 32), kb = r / (PLD / 32), n0 = nb * 32; transpose_item(p.w_in, IN_COLS, D, ws_h(p, WS_WT_IN), n0, n0 < WC_BA ? n0 : n0 + 8, kb * 64, scr, lane); continue; } r -= TI_IN;
        if (r < TI_OUT) { const int nb = r % (D / 32), kb = r / (D / 32), n0 = nb * 32; transpose_item(p.w_out, D, 1024, ws_h(p, WS_WT_OUT), n0, n0, kb * 64, scr, lane); continue; } r -= TI_OUT;
        if (r < TI_UP) { const int nb = r % (2 * DFF / 32), kb = r / (2 * DFF / 32), n0 = nb * 32;
            const int pn = n0 >> 8, bj = (n0 >> 7) & 1, c = n0 & 127; transpose_item(p.w_up, 2 * DFF, D, ws_h(p, WS_WT_UP), n0, bj * DFF + 128 * pn + c, kb * 64, scr, lane); continue; } r -= TI_UP;
        { const int nb = r % (D / 32), kb = r / (D / 32), n0 = nb * 32; transpose_item(p.w_down, D, DFF, ws_h(p, WS_WT_DN), n0, n0, kb * 64, scr, lane); }
    }
}
typedef short bf16x8m __attribute__((ext_vector_type(8)));
typedef float f32x2m __attribute__((ext_vector_type(2))); typedef __bf16 bf16x2m __attribute__((ext_vector_type(2)));
__device__ __forceinline__ unsigned cvtpk_m(float lo, float hi) { const f32x2m v = {lo, hi}; return __builtin_bit_cast(unsigned, __builtin_convertvector(v, bf16x2m)); }
__device__ __forceinline__ void split8(const float (&x)[8], bf16x8m& hi, bf16x8m& lo) {
    unsigned h[4], l[4];
#pragma unroll
    for (int e = 0; e < 4; ++e) { h[e] = cvtpk_m(x[2 * e], x[2 * e + 1]);
        l[e] = cvtpk_m(x[2 * e] - __builtin_bit_cast(float, h[e] << 16), x[2 * e + 1] - __builtin_bit_cast(float, h[e] & 0xffff0000u)); }
    hi = __builtin_bit_cast(bf16x8m, (u32x4){h[0], h[1], h[2], h[3]}); lo = __builtin_bit_cast(bf16x8m, (u32x4){l[0], l[1], l[2], l[3]});
}
__device__ __forceinline__ float silu_fast(float x) { return x * __builtin_amdgcn_rcpf(1.0f + __expf(-x)); }
__device__ __forceinline__ void phase_mod(const P& p, LAS unsigned char* lds) {
    constexpr int KC = 256, NCG = 6 * D / 32, NCH = D / KC, NMT = (NCB + 15) / 16;
    static_assert(NMT <= 16, "two m-tiles per wave at most");
    LAS float* WB = (LAS float*)lds;
    const int tid = otid(), lane = tid & 63, wave = tid >> 6, r16 = lane & 15, g4 = lane >> 4;
    for (int cg = blockIdx.x; cg < NCG; cg += gridDim.x) {
        f32x4 acc[2][2];
#pragma unroll
        for (int s = 0; s < 2; ++s)
#pragma unroll
            for (int nt = 0; nt < 2; ++nt) acc[s][nt] = (f32x4){0.f, 0.f, 0.f, 0.f};
        f32x4 wreg[4];
#pragma unroll
        for (int j = 0; j < 4; ++j) { const int idx = tid + NTHR * j; wreg[j] = *(const f32x4*)(p.w_ada + (size_t)(idx >> 3) * 6 * D + cg * 32 + 4 * (idx & 7)); }
        __syncthreads();
        for (int ch = 0; ch < NCH; ++ch) {
            LAS float* wb = WB + (ch & 1) * KC * 32;
#pragma unroll
            for (int j = 0; j < 4; ++j) { const int idx = tid + NTHR * j; *(LAS f32x4*)(wb + (idx >> 3) * 32 + 4 * (idx & 7)) = wreg[j]; }
            if (ch + 1 < NCH) {
#pragma unroll
                for (int j = 0; j < 4; ++j) { const int idx = tid + NTHR * j; wreg[j] = *(const f32x4*)(p.w_ada + (size_t)((ch + 1) * KC + (idx >> 3)) * 6 * D + cg * 32 + 4 * (idx & 7)); }
            }
            __syncthreads();
#pragma unroll 2
            for (int ks = 0; ks < KC / 32; ++ks) {
                bf16x8m bh[2], bl[2];
#pragma unroll
                for (int nt = 0; nt < 2; ++nt) { float x[8];
#pragma unroll
                    for (int j = 0; j < 8; ++j) x[j] = wb[(32 * ks + 8 * g4 + j) * 32 + 16 * nt + r16];
                    split8(x, bh[nt], bl[nt]); }
#pragma unroll
                for (int s = 0; s < 2; ++s) { const int mt = wave + 8 * s; if (mt >= NMT) continue;
                    const int row = 16 * mt + r16; float x[8];
                    if (row < NCB) { const float* c = (row < BATCH ? p.c_prompt + (size_t)row * D : p.c_sample + (size_t)(row - BATCH) * D) + ch * KC + 32 * ks + 8 * g4;
                        const f32x4 a = *(const f32x4*)c, d = *(const f32x4*)(c + 4);
                        x[0] = silu_fast(a[0]); x[1] = silu_fast(a[1]); x[2] = silu_fast(a[2]); x[3] = silu_fast(a[3]); x[4] = silu_fast(d[0]); x[5] = silu_fast(d[1]); x[6] = silu_fast(d[2]); x[7] = silu_fast(d[3]); }
                    else {
#pragma unroll
                        for (int j = 0; j < 8; ++j) x[j] = 0.f; }
                    bf16x8m ah, al; split8(x, ah, al);
#pragma unroll
                    for (int nt = 0; nt < 2; ++nt) {
                        acc[s][nt] = __builtin_amdgcn_mfma_f32_16x16x32_bf16(ah, bh[nt], acc[s][nt], 0, 0, 0);
                        acc[s][nt] = __builtin_amdgcn_mfma_f32_16x16x32_bf16(ah, bl[nt], acc[s][nt], 0, 0, 0);
                        acc[s][nt] = __builtin_amdgcn_mfma_f32_16x16x32_bf16(al, bh[nt], acc[s][nt], 0, 0, 0); } }
            }
        }
#pragma unroll
        for (int s = 0; s < 2; ++s) { const int mt = wave + 8 * s; if (mt >= NMT) continue;
#pragma unroll
            for (int nt = 0; nt < 2; ++nt) { const int e = cg * 32 + 16 * nt + r16; const float bb = p.b_ada[e];
#pragma unroll
                for (int i = 0; i < 4; ++i) { const int row = 16 * mt + 4 * g4 + i; if (row < NCB) ws_f(p, WS_MOD)[(size_t)row * 6 * D + e] = acc[s][nt][i] + bb; } } }
    }
    __syncthreads();
}
constexpr int NS_OUT = 4, NS_DN = 11;
constexpr size_t SLAB_DN_BYTES = (size_t)(TS / 256) * (D / 256) * NS_DN * 65536 * 4, WS_SLAB_DN = WS_H;
constexpr size_t WS_XB = al256(WS_SLAB_DN + SLAB_DN_BYTES);
static_assert(WS_XB >= WS_DNF_AB && WS_XB + (size_t)T * D * 2 <= WS_DNF_CD && (size_t)(TS / 256) * (D / 256) * NS_OUT * 65536 <= (size_t)T * D, "residual stream / slabs fit");
template <int WHICH> __device__ __forceinline__ void norm_row_tail(const P& p, int m, int lane, const f32x4 (&v)[4], const f32x4 (&nwv)[4], const LAS float* wbt) {
    float ss = 0.f;
#pragma unroll
    for (int j = 0; j < 4; ++j) ss += (v[j][0] * v[j][0] + v[j][1] * v[j][1]) + (v[j][2] * v[j][2] + v[j][3] * v[j][3]);
    const float rstd = 1.0f / sqrtf(wave_sum(ss) * (1.0f / D) + EPS);
    if (WHICH == 2) {
#pragma unroll
        for (int j = 0; j < 4; ++j) ((f32x4*)(p.out + O_Y + (size_t)m * D))[lane + 64 * j] = v[j] * rstd * nwv[j];
        return;
    }
    const int cb = cb_of(m);
    const float* mod = ws_f(p, WS_MOD) + (size_t)cb * 6 * D;
    const float* sh = mod + (WHICH == 0 ? 0 : 3 * D); const float* sc = mod + (WHICH == 0 ? D : 4 * D);
    float ba[8];
#pragma unroll
    for (int j = 0; j < 8; ++j) ba[j] = 0.f;
    unsigned long long* o8 = (unsigned long long*)(ws_h(p, WS_H) + (size_t)m * D);
#pragma unroll
    for (int j = 0; j < 4; ++j) {
        const f32x4 s1 = ((const f32x4*)sc)[lane + 64 * j], s0 = ((const f32x4*)sh)[lane + 64 * j];
        const f32x4 h = v[j] * rstd * nwv[j] * (s1 + 1.0f) + s0;
        o8[lane + 64 * j] = (unsigned long long)cvtpk_m(h[0], h[1]) | ((unsigned long long)cvtpk_m(h[2], h[3]) << 32);
        if (WHICH == 0) {
#pragma unroll
            for (int c = 0; c < 8; ++c) { const f32x4 w = *(const LAS f32x4*)(wbt + c * D + 4 * (lane + 64 * j)); ba[c] += (h[0] * w[0] + h[1] * w[1]) + (h[2] * w[2] + h[3] * w[3]); }
        }
    }
    if (WHICH == 0) {
#pragma unroll
        for (int j = 0; j < 8; ++j) ba[j] = wave_sum(ba[j]);
        float mine = 0.f;
#pragma unroll
        for (int j = 0; j < 8; ++j) mine = (lane == j) ? ba[j] : mine;
        if (lane < 8) { float* bg = ws_f(p, WS_BG) + (size_t)m * 8; const int j = lane & 3;
            bg[lane] = lane < 4 ? sigmoid_f(mine) : -expf(p.dn_A_log[j]) * softplus_f(mine + p.dn_dt_bias[j]); }
    }
}
template <int WHICH> __device__ __forceinline__ void phase_norm(const P& p, LAS unsigned char* lds) {
    static_assert(D == 1024, "one wave per 1024-element row");
    const int tid_ = otid(), lane = tid_ & 63, wave = tid_ >> 6;
    const int gw = blockIdx.x * NWAVES + wave, NGW = gridDim.x * NWAVES;
    const float* nwp = WHICH == 0 ? p.norm_mix_w : (WHICH == 1 ? p.norm_ffn_w : p.final_norm_w);
    f32x4 nwv[4];
#pragma unroll
    for (int j = 0; j < 4; ++j) nwv[j] = ((const f32x4*)nwp)[lane + 64 * j];
    const LAS float* wbt = (const LAS float*)lds;
    if (WHICH == 0) { for (int i = tid_; i < 8 * D / 4; i += NTHR) ((LAS f32x4*)lds)[i] = ((const f32x4*)ws_f(p, WS_WBAT))[i]; __syncthreads(); }
    const bf16_t* XB = ws_h(p, WS_XB);
    constexpr int MEND = WHICH == 0 ? T : TP;
    typedef f32x4 rowbuf_t[4];
    rowbuf_t ra, rb, rc;
#define NR_LOAD(buf_, mm_) do { if ((mm_) < MEND) { if (WHICH == 0) { const float* xr_ = xrow(p, (mm_)); _Pragma("unroll") for (int j = 0; j < 4; ++j) buf_[j] = ((const f32x4*)xr_)[lane + 64 * j]; } \
        else { const u32x2* xr_ = (const u32x2*)(XB + (size_t)(mm_) * D); u32x2 w_[4]; _Pragma("unroll") for (int j = 0; j < 4; ++j) w_[j] = xr_[lane + 64 * j]; \
            buf_[0] = __builtin_bit_cast(f32x4, (u32x4){w_[0].x, w_[0].y, w_[1].x, w_[1].y}); buf_[1] = __builtin_bit_cast(f32x4, (u32x4){w_[2].x, w_[2].y, w_[3].x, w_[3].y}); } } } while (0)
#define NR_PROC(buf_, mm_) do { if ((mm_) < MEND) { f32x4 v_[4]; if (WHICH == 0) { _Pragma("unroll") for (int j = 0; j < 4; ++j) v_[j] = buf_[j]; } \
        else { const u32x4 a_ = __builtin_bit_cast(u32x4, buf_[0]), b_ = __builtin_bit_cast(u32x4, buf_[1]); const unsigned w_[8] = {a_.x, a_.y, a_.z, a_.w, b_.x, b_.y, b_.z, b_.w}; \
            _Pragma("unroll") for (int j = 0; j < 4; ++j) v_[j] = (f32x4){__builtin_bit_cast(float, w_[2 * j] << 16), __builtin_bit_cast(float, w_[2 * j] & 0xffff0000u), __builtin_bit_cast(float, w_[2 * j + 1] << 16), __builtin_bit_cast(float, w_[2 * j + 1] & 0xffff0000u)}; } \
        norm_row_tail<WHICH>(p, (mm_), lane, v_, nwv, wbt); } } while (0)
    NR_LOAD(ra, gw); NR_LOAD(rb, gw + NGW);
    for (int m = gw; m < MEND; m += 3 * NGW) {
        NR_LOAD(rc, m + 2 * NGW); NR_PROC(ra, m);
        NR_LOAD(ra, m + 3 * NGW); NR_PROC(rb, m + NGW);
        NR_LOAD(rb, m + 4 * NGW); NR_PROC(rc, m + 2 * NGW);
    }
#undef NR_LOAD
#undef NR_PROC
    if (WHICH != 0) {
        constexpr int NS = WHICH == 1 ? NS_OUT : NS_DN;
        const float* slabs = WHICH == 1 ? p.out + O_Y : ws_f(p, WS_SLAB_DN);
        for (int rs = gw; rs < TS; rs += NGW) { const int m = TP + rs, cbs = BATCH + (rs >> 3);
            const float* gt = ws_f(p, WS_MOD) + (size_t)cbs * 6 * D + (WHICH == 1 ? 2 * D : 5 * D);
            f32x4 vs[4];
#pragma unroll
            for (int j = 0; j < 4; ++j) { const float* sl = slabs + ((size_t)((rs >> 8) * 4 + j) * NS) * 65536 + (size_t)(rs & 255) * 256 + 4 * lane;
                f32x4 acc = (f32x4){0.f, 0.f, 0.f, 0.f};
#pragma unroll
                for (int ks = 0; ks < NS; ++ks) { acc += *(const f32x4*)sl; sl += 65536; asm volatile("" : "+v"(sl)); }
                f32x4 base;
                if (WHICH == 1) base = ((const f32x4*)(p.x_sample + (size_t)rs * D))[lane + 64 * j];
                else { const u32x2 w = ((const u32x2*)(XB + (size_t)m * D))[lane + 64 * j]; base = (f32x4){__builtin_bit_cast(float, w.x << 16), __builtin_bit_cast(float, w.x & 0xffff0000u), __builtin_bit_cast(float, w.y << 16), __builtin_bit_cast(float, w.y & 0xffff0000u)}; }
                vs[j] = base + ((const f32x4*)gt)[lane + 64 * j] * acc;
                if (WHICH == 1) ((u32x2*)(ws_h(p, WS_XB) + (size_t)m * D))[lane + 64 * j] = (u32x2){cvtpk_m(vs[j][0], vs[j][1]), cvtpk_m(vs[j][2], vs[j][3])};
                asm volatile("" ::: "memory"); }
            norm_row_tail<WHICH>(p, m, lane, vs, nwv, wbt);
        }
    }
}

constexpr long SO_1 = (long)BATCH * 3 * 1536 / 4, SO_2 = (long)DEC_BATCH * 3 * 1536 / 4, SO_3 = (long)BATCH * 128 * 128 / 4, SO_4 = (long)DEC_BATCH * 128 * 128 / 4, SO_N = SO_1 + SO_2 + 2 * (SO_3 + SO_4);
__device__ __forceinline__ void so_item(const P& p, long it, f32x4& val, float*& dst) {
    const bf16_t* PR = ws_h(p, WS_PROJ); const bf16_t* src = nullptr; const float* fsrc = nullptr;
    long r = it;
    if (r < SO_1) { const int b = (int)(r / (3 * 384)), j = (int)(r / 384 % 3), c = (int)(r % 384) * 4; src = PR + (size_t)(b * SEQ + SEQ - 3 + j) * PLD + PC_QKV + c; dst = p.out + O_PDC + r * 4; }
    else if ((r -= SO_1) < SO_2) { const int b = (int)(r / (3 * 384)), j = (int)(r / 384 % 3), c = (int)(r % 384) * 4; src = PR + (size_t)(TP + b * DEC_SEQ + DEC_SEQ - 3 + j) * PLD + PC_QKV + c; dst = p.out + O_SDC + r * 4; }
    else { r -= SO_2; const int kv = r >= SO_3 + SO_4; if (kv) r -= SO_3 + SO_4; const int pc = kv ? PC_SV : PC_SK; const float* cache = kv ? p.cache_v : p.cache_k;
        if (r < SO_3) { const int b = (int)(r / (128 * 32)), j = (int)(r / 32 % 128), c = (int)(r % 32) * 4; src = PR + (size_t)(b * SEQ + SEQ - 128 + j) * PLD + pc + c; dst = p.out + (kv ? O_PV : O_PK) + r * 4; }
        else { r -= SO_3; const int b = (int)(r / (128 * 32)), j = (int)(r / 32 % 128), c = (int)(r % 32) * 4; dst = p.out + (kv ? O_SV : O_SK) + r * 4;
            if (j < 128 - DEC_SEQ) fsrc = cache + ((size_t)b * 128 + j + DEC_SEQ) * 128 + c; else src = PR + (size_t)(TP + b * DEC_SEQ + (j - (128 - DEC_SEQ))) * PLD + pc + c; } }
    if (fsrc) val = *(const f32x4*)fsrc;
    else { const u32x2 w = *(const u32x2*)src; val = (f32x4){__builtin_bit_cast(float, w.x << 16), __builtin_bit_cast(float, w.x & 0xffff0000u), __builtin_bit_cast(float, w.y << 16), __builtin_bit_cast(float, w.y & 0xffff0000u)}; }
}
__device__ __forceinline__ void phase_state_out(const P& p) {
    const long gt = blockIdx.x * (long)NTHR + otid(), gs = (long)gridDim.x * NTHR;
    for (long it = gt; it < SO_N; it += 4 * gs) {
        f32x4 v[4]; float* d[4];
#pragma unroll
        for (int u = 0; u < 4; ++u) if (it + u * gs < SO_N) so_item(p, it + u * gs, v[u], d[u]);
#pragma unroll
        for (int u = 0; u < 4; ++u) if (it + u * gs < SO_N) *(f32x4*)d[u] = v[u];
    }
}
#define XB_TMO      128
#define XB_XCNT(j)  (256  + 64 * (j))
#define XB_XSUB(j)  (1280 + 64 * (j))
#define XB_XGEN(j)  (2304 + 64 * (j))
#define XB_TOP      3328
#define XB_TOPGEN   3392
#define XCD_BAR_WORDS 3456
#define XB_SPIN_CAP (1u << 18)

__device__ __forceinline__ unsigned xb_ld(unsigned* p)              { return __hip_atomic_load(p, __ATOMIC_RELAXED, __HIP_MEMORY_SCOPE_AGENT); }
__device__ __forceinline__ unsigned xb_add(unsigned* p, unsigned v) { return __hip_atomic_fetch_add(p, v, __ATOMIC_RELAXED, __HIP_MEMORY_SCOPE_AGENT); }
__device__ __forceinline__ unsigned xb_xcc_id() { return (unsigned)__builtin_amdgcn_s_getreg((3 << 11) | 20) & 0xFu; }
#define XB_SPIN(cond, bar) do { unsigned _sp = 0; while (cond) { __builtin_amdgcn_s_sleep(1); \
    if ((++_sp & 255u) == 0u) { if (xb_ld(&(bar)[XB_TMO])) break; if (_sp > XB_SPIN_CAP) { atomicAdd(&(bar)[XB_TMO], 1u); break; } } } } while (0)

struct XcdBarrier {
    unsigned* bar; unsigned x;
    volatile LAS unsigned* st;
};

__device__ __forceinline__ XcdBarrier xcd_barrier_post(unsigned* bar, volatile LAS unsigned* st) {
    XcdBarrier b; b.bar = bar; b.x = xb_xcc_id(); b.st = st;
    if (threadIdx.x == 0) (void)xb_add(&bar[XB_XCNT(b.x)], 1u);
    return b;
}
__device__ __forceinline__ void xcd_barrier_complete(unsigned* bar, unsigned x, unsigned& nloc, unsigned& nx) {
    const unsigned G = gridDim.x * gridDim.y * gridDim.z;
    unsigned sum, cnt, mine, sp = 0u;
    for (;;) {
        sum = 0u; cnt = 0u; mine = 0u;
#pragma unroll
        for (unsigned j = 0; j < 16; ++j) { const unsigned c = xb_ld(&bar[XB_XCNT(j)]); sum += c; cnt += (c > 0u) ? 1u : 0u; mine = (j == x) ? c : mine; }
        if (sum == G) break;
        __builtin_amdgcn_s_sleep(1);
        if ((++sp & 255u) == 0u) { if (xb_ld(&bar[XB_TMO])) break; if (sp > XB_SPIN_CAP) { atomicAdd(&bar[XB_TMO], 1u); break; } }
    }
    nloc = mine > 0u ? mine : 1u; nx = cnt > 0u ? cnt : 1u;
}

__device__ __forceinline__ void xcd_barrier(const XcdBarrier& b) {
    asm volatile("s_waitcnt vmcnt(0)" ::: "memory");
    __syncthreads();
    if (threadIdx.x == 0) {
        unsigned* bar = b.bar;
        __builtin_amdgcn_s_waitcnt(0);
        unsigned nloc = b.st[0], nx = b.st[1];
        if (nloc == 0u) { xcd_barrier_complete(bar, b.x, nloc, nx); b.st[0] = nloc; b.st[1] = nx; }
        const unsigned old = xb_add(&bar[XB_XSUB(b.x)], 1u);
        const unsigned gen = old / nloc;
        if (old + 1u == (gen + 1u) * nloc) {
            __builtin_amdgcn_fence(__ATOMIC_RELEASE, "agent");
            asm volatile("s_waitcnt vmcnt(0)" ::: "memory");
            const unsigned og = xb_add(&bar[XB_TOP], 1u);
            const unsigned tg = og / nx;
            if (og + 1u == (tg + 1u) * nx) xb_add(&bar[XB_TOPGEN], 1u);
            else XB_SPIN(xb_ld(&bar[XB_TOPGEN]) == tg, bar);
            __builtin_amdgcn_fence(__ATOMIC_ACQUIRE, "agent");
            xb_add(&bar[XB_XGEN(b.x)], 1u);
            asm volatile("s_waitcnt vmcnt(0)" ::: "memory");
        } else {
            XB_SPIN(xb_ld(&bar[XB_XGEN(b.x)]) == gen, bar);
            __builtin_amdgcn_fence(__ATOMIC_ACQUIRE, "agent");
            asm volatile("s_waitcnt vmcnt(0)" ::: "memory");
        }
    }
    __syncthreads();
}
namespace pg8 {
#define PG8_LAS __attribute__((address_space(3)))
typedef unsigned short bf16_t;
typedef short bf16x8 __attribute__((ext_vector_type(8)));
typedef float f32x4 __attribute__((ext_vector_type(4)));
typedef unsigned u32x4 __attribute__((ext_vector_type(4)));
constexpr int BM = 256, BK = 64, HALF = 128, HTB = HALF * BK * 2  , STAGE_BYTES = 8 * HTB, NXCD = 8, WGM = 8;

__host__ __device__ __forceinline__ int lds_byte(int r, int c) { const int st = (r >> 4) * 2 + (c >> 5), rr = r & 15, cc = c & 31, ob = rr * 64 + cc * 2; return st * 1024 + (ob ^ (((ob >> 9) & 1) << 5)); }
__host__ __device__ __forceinline__ void stage_rc(int b, int& R, int& C) { const int st = b / 1024, sb = b % 1024, swz = sb ^ (((sb >> 9) & 1) << 5); R = (st >> 1) * 16 + swz / 64; C = (st & 1) * 32 + (swz % 64) / 2; }
__host__ __device__ __forceinline__ int perm32(int rho) { const int n = rho >> 4, i = rho & 15; return 8 * (i >> 2) + 4 * n + (i & 3); }

struct Unit { int pm, pn, k0, nt, atomic; };
struct Gemm { const bf16_t* A; const bf16_t* Bt; int M, N, K; };

struct StaticOrder {
    int nM, nN, nwg, G, c, ntk;
    __host__ __device__ void init(int M, int N, int G_, int c_, int K_) { nM = M / BM; nN = N / BM; nwg = nM * nN; G = G_; c = c_; ntk = K_ / BK; }
    __host__ __device__ bool next(int i, Unit& u) const {
        const long L = (long)i * G + c; if (L >= nwg) return false;
        int wgid = (int)L; { const int q = nwg / NXCD, r = nwg % NXCD, xcd = wgid % NXCD, off = wgid / NXCD; wgid = (xcd < r ? xcd * (q + 1) : r * (q + 1) + (xcd - r) * q) + off; }
        const int nig = WGM * nN, gid = wgid / nig, fm = gid * WGM, gsz = (nM - fm) < WGM ? (nM - fm) : WGM;
        u.pm = fm + ((wgid % nig) % gsz); u.pn = (wgid % nig) / gsz; u.k0 = 0; u.nt = ntk; u.atomic = 0; return true;
    }
    __device__ __forceinline__ void a_ready(const Unit&) const {}
    __device__ __forceinline__ void done(const Unit&) const {}
};

struct SplitOrder {
    StaticOrder so; int nu1, ns, ntk_sub, npn, nsub, G, c;
    __device__ void init(int N, int K, int NS, int G_, int c_) { so.init(TP, N, G_, c_, K); nu1 = so.nwg; ns = NS; ntk_sub = K / BK / NS; npn = N / BM; nsub = (TS / BM) * npn * NS; G = G_; c = c_; }
    __device__ bool next(int i, Unit& u) const {
        const long L = (long)i * G + c; if (L < nu1) return so.next(i, u);
        const int s = (int)(L - nu1); if (s >= nsub) return false;
        const int ks = s % ns, t = s / ns; u.pm = TP / BM + t / npn; u.pn = t % npn; u.k0 = ks * ntk_sub * BK; u.nt = ntk_sub; u.atomic = 1; return true; }
    __device__ __forceinline__ void a_ready(const Unit&) const {}
    __device__ __forceinline__ void done(const Unit&) const {}
};
__device__ __forceinline__ unsigned cvt_pk_bf16(float lo, float hi) { unsigned r; asm volatile("v_cvt_pk_bf16_f32 %0, %1, %2" : "=v"(r) : "v"(lo), "v"(hi)); return r; }
struct EpiStoreBf16 {
    static constexpr bool PERM = true, AFTER_DRAIN = false;
    bf16_t* O; int ldc;
    __device__ __forceinline__ void operator()(const f32x4 (&acc)[2][2][4][2], const Unit& u, int wr, int wc, int fr, int fq) const {
        const int row0 = u.pm * BM + wr * 64 + fr, col0 = u.pn * BM + wc * 32 + 8 * fq;
#pragma unroll
        for (int ai = 0; ai < 2; ++ai)
#pragma unroll
            for (int m = 0; m < 4; ++m) { bf16_t* rowp = O + (size_t)(row0 + ai * HALF + m * 16) * ldc + col0;
#pragma unroll
                for (int bj = 0; bj < 2; ++bj) { const f32x4 v0 = acc[ai][bj][m][0], v1 = acc[ai][bj][m][1];
                    u32x4 w; w.x = cvt_pk_bf16(v0[0], v0[1]); w.y = cvt_pk_bf16(v0[2], v0[3]); w.z = cvt_pk_bf16(v1[0], v1[1]); w.w = cvt_pk_bf16(v1[2], v1[3]);
                    *(u32x4*)(rowp + bj * HALF) = w; } }
    }
};
template <int MODE> struct EpiGateRes {
    static constexpr bool PERM = false, AFTER_DRAIN = false;
    const float* base_p; const float* base_s; bf16_t* xb; const float* gate; float* slab; int ns;
    __device__ __forceinline__ void operator()(const f32x4 (&acc)[2][2][4][2], const Unit& u, int wr, int wc, int fr, int fq) const {
        typedef unsigned u32x2e __attribute__((ext_vector_type(2)));
        const int row0 = u.pm * BM + wr * 64 + fr, col0 = u.pn * BM + wc * 32 + 4 * fq;
        const bool smp = row0 >= TP; const float* base = smp ? base_s - (size_t)TP * D : base_p;
#pragma unroll
        for (int ai = 0; ai < 2; ++ai)
#pragma unroll
            for (int m = 0; m < 4; ++m) { const int r = row0 + ai * HALF + m * 16; const int cb = smp ? BATCH + ((r - TP) >> 3) : r / SEQ;
                const float* gp = gate + (size_t)cb * 6 * D + col0; const size_t off = (size_t)r * D + col0;
#pragma unroll
                for (int bj = 0; bj < 2; ++bj)
#pragma unroll
                    for (int n = 0; n < 2; ++n) {
                        if (u.atomic) { const int sidx = ((u.pm - TP / BM) * (D / BM) + u.pn) * ns + u.k0 / (u.nt * BK);
                            *(f32x4*)(slab + (size_t)sidx * 65536 + (size_t)(r - u.pm * BM) * 256 + (col0 - u.pn * BM) + bj * HALF + n * 16) = acc[ai][bj][m][n]; }
                        else { const f32x4 gv = *(const f32x4*)(gp + bj * HALF + n * 16); f32x4 bs;
                            if (MODE == 0) bs = *(const f32x4*)(base + off + bj * HALF + n * 16);
                            else { const u32x2e w = *(const u32x2e*)(xb + off + bj * HALF + n * 16); bs = (f32x4){__builtin_bit_cast(float, w.x << 16), __builtin_bit_cast(float, w.x & 0xffff0000u), __builtin_bit_cast(float, w.y << 16), __builtin_bit_cast(float, w.y & 0xffff0000u)}; }
                            const f32x4 v = bs + gv * acc[ai][bj][m][n];
                            *(u32x2e*)(xb + off + bj * HALF + n * 16) = (u32x2e){cvt_pk_bf16(v[0], v[1]), cvt_pk_bf16(v[2], v[3])}; } } }
    }
};
template <class Epi, class Sched, bool ALIGN_EPI = false, bool SP2 = false>
__device__ __forceinline__ void gemm_phase(PG8_LAS unsigned char* lds, const Gemm g, const Sched& S, const Epi& E) {
    const int tid = otid(), wid = __builtin_amdgcn_readfirstlane(tid >> 6), lane = tid & 63, wr = wid >> 2, wc = wid & 3, fr = lane & 15, fq = lane >> 4;
    const int K = g.K;
    unsigned voffA[2], voffB[2];
#pragma unroll
    for (int i = 0; i < 2; ++i) { int R, C; stage_rc(tid * 16 + i * 8192, R, C); const int Rb = Epi::PERM ? ((R & ~31) + perm32(R & 31)) : R;
        voffA[i] = (unsigned)(R * K + C) * 2u; voffB[i] = (unsigned)(Rb * K + C) * 2u; }
    const size_t kstep = (size_t)(BK * 2);
    const size_t hstep = (size_t)HALF * K * 2;
    const size_t tstep = 2 * hstep;
    const unsigned ldsw = (unsigned)wid * 1024u;
    const int aoff = lds_byte(wr * 64 + fr, fq * 8), boff = lds_byte(wc * 32 + fr, fq * 8);
#define PG8_SA(b, h) (((b) * 2 + (h)) * HTB)
#define PG8_SB(b, h) ((4 + (b) * 2 + (h)) * HTB)
#define PG8_STAGE(bufoff, gbase, voff) do { _Pragma("unroll") for (int _i = 0; _i < 2; ++_i) \
        __builtin_amdgcn_global_load_lds((const unsigned*)((const char*)(gbase) + (voff)[_i]), (PG8_LAS unsigned*)(lds + (bufoff) + ldsw + _i * 8192), 16, 0, 0); } while (0)
#define PG8_LDA(dst, b, h) do { _Pragma("unroll") for (int m = 0; m < 4; ++m) _Pragma("unroll") for (int k = 0; k < 2; ++k) dst[m][k] = *(const PG8_LAS bf16x8*)(lds + PG8_SA(b, h) + aoff + m * 2048 + k * 1024); } while (0)
#define PG8_LDB(dst, b, h) do { _Pragma("unroll") for (int n = 0; n < 2; ++n) _Pragma("unroll") for (int k = 0; k < 2; ++k) dst[n][k] = *(const PG8_LAS bf16x8*)(lds + PG8_SB(b, h) + boff + n * 2048 + k * 1024); } while (0)
#define PG8_MMA(ai, bj, At, Bt) do { __builtin_amdgcn_s_setprio(1); _Pragma("unroll") for (int m = 0; m < 4; ++m) _Pragma("unroll") for (int n = 0; n < 2; ++n) _Pragma("unroll") for (int k = 0; k < 2; ++k) \
        acc[ai][bj][m][n] = __builtin_amdgcn_mfma_f32_16x16x32_bf16(Bt[n][k], At[m][k], acc[ai][bj][m][n], 0, 0, 0); __builtin_amdgcn_s_setprio(0); } while (0)
#define PG8_WAIT_V(n) asm volatile("s_waitcnt vmcnt(" #n ")" ::: "memory")
#define PG8_WAIT_L(n) asm volatile("s_waitcnt lgkmcnt(" #n ")" ::: "memory")
#define PG8_BAR __builtin_amdgcn_s_barrier()
#define PG8_SCHED __builtin_amdgcn_sched_barrier(0)
    Unit cur, nxt; int ui = 0;
    if (!S.next(0, cur)) return;
    f32x4 acc[2][2][4][2];
#pragma unroll
    for (int a = 0; a < 2; ++a)
#pragma unroll
        for (int b = 0; b < 2; ++b)
#pragma unroll
            for (int m = 0; m < 4; ++m)
#pragma unroll
                for (int n = 0; n < 2; ++n) acc[a][b][m][n] = (f32x4){0.f, 0.f, 0.f, 0.f};
    bf16x8 At[4][2], B0[2][2], B1[2][2];
    const char* cA = (const char*)g.A + (size_t)cur.pm * tstep + (size_t)cur.k0 * 2; const char* cB = (const char*)g.Bt + (size_t)cur.pn * tstep + (size_t)cur.k0 * 2;
    S.a_ready(cur);
    if constexpr (SP2) {
        PG8_STAGE(PG8_SB(0, 0), cB, voffB); PG8_STAGE(PG8_SB(0, 1), cB + hstep, voffB); PG8_STAGE(PG8_SA(0, 0), cA, voffA); PG8_STAGE(PG8_SA(0, 1), cA + hstep, voffA);
        if (wr == 1) PG8_BAR;
        PG8_WAIT_V(2); PG8_BAR;
        PG8_STAGE(PG8_SB(1, 0), cB + kstep, voffB); PG8_STAGE(PG8_SA(1, 0), cA + kstep, voffA); PG8_STAGE(PG8_SB(1, 1), cB + hstep + kstep, voffB);
        PG8_WAIT_V(6); PG8_BAR;
    } else {
        PG8_STAGE(PG8_SB(0, 0), cB, voffB); PG8_STAGE(PG8_SA(0, 0), cA, voffA); PG8_STAGE(PG8_SB(0, 1), cB + hstep, voffB); PG8_STAGE(PG8_SA(0, 1), cA + hstep, voffA);
        if (wr == 1) PG8_BAR;
        PG8_WAIT_V(4); PG8_BAR;
        PG8_STAGE(PG8_SB(1, 0), cB + kstep, voffB); PG8_STAGE(PG8_SA(1, 0), cA + kstep, voffA); PG8_STAGE(PG8_SB(1, 1), cB + hstep + kstep, voffB);
        PG8_WAIT_V(6); PG8_BAR;
    }
    for (;;) {
        const bool has_next = S.next(ui + 1, nxt);
        const char* nA = has_next ? (const char*)g.A + (size_t)nxt.pm * tstep + (size_t)nxt.k0 * 2 : cA; const char* nB = has_next ? (const char*)g.Bt + (size_t)nxt.pn * tstep + (size_t)nxt.k0 * 2 : cB;
        const int nt = cur.nt;
        for (int t = 0; t < nt; t += 2) {
            const bool last = (t == nt - 2);
            const char* a1 = cA + (size_t)(t + 1) * kstep;
            const char* a2 = last ? nA : cA + (size_t)(t + 2) * kstep; const char* b2 = last ? nB : cB + (size_t)(t + 2) * kstep;
            const char* a3 = a2 + kstep; const char* b3 = b2 + kstep;
            if (last && has_next) S.a_ready(nxt);
            if constexpr (SP2) {
            PG8_LDB(B0, 0, 0); PG8_LDB(B1, 0, 1); PG8_SCHED; PG8_LDA(At, 0, 0); PG8_STAGE(PG8_SA(1, 1), a1 + hstep, voffA);
            PG8_WAIT_V(8); PG8_WAIT_L(0); PG8_BAR; PG8_MMA(0, 0, At, B0); PG8_MMA(0, 1, At, B1); PG8_BAR; PG8_SCHED;
            PG8_LDA(At, 0, 1); PG8_STAGE(PG8_SB(0, 0), b2, voffB); PG8_STAGE(PG8_SB(0, 1), b2 + hstep, voffB); PG8_STAGE(PG8_SA(0, 0), a2, voffA);
            PG8_WAIT_V(8); PG8_WAIT_L(0); PG8_BAR; PG8_MMA(1, 0, At, B0); PG8_MMA(1, 1, At, B1); PG8_BAR; PG8_SCHED;
            PG8_LDB(B0, 1, 0); PG8_LDB(B1, 1, 1); PG8_SCHED; PG8_LDA(At, 1, 0); PG8_STAGE(PG8_SA(0, 1), a2 + hstep, voffA);
            PG8_WAIT_V(8); PG8_WAIT_L(0); PG8_BAR; PG8_MMA(0, 0, At, B0); PG8_MMA(0, 1, At, B1); PG8_BAR; PG8_SCHED;
            PG8_LDA(At, 1, 1); PG8_STAGE(PG8_SB(1, 0), b3, voffB); PG8_STAGE(PG8_SB(1, 1), b3 + hstep, voffB); PG8_STAGE(PG8_SA(1, 0), a3, voffA);
            PG8_WAIT_V(8); PG8_WAIT_L(0); PG8_BAR; PG8_MMA(1, 0, At, B0); PG8_MMA(1, 1, At, B1); PG8_BAR; PG8_SCHED;
            } else {
            PG8_LDB(B0, 0, 0); PG8_SCHED; PG8_LDA(At, 0, 0); PG8_STAGE(PG8_SA(1, 1), a1 + hstep, voffA);
            PG8_WAIT_L(8); PG8_BAR; PG8_WAIT_L(0); PG8_MMA(0, 0, At, B0); PG8_BAR; PG8_SCHED;
            PG8_LDB(B1, 0, 1); PG8_STAGE(PG8_SB(0, 0), b2, voffB);
            PG8_BAR; PG8_WAIT_L(0); PG8_MMA(0, 1, At, B1); PG8_BAR;
            PG8_LDA(At, 0, 1); PG8_STAGE(PG8_SA(0, 0), a2, voffA);
            PG8_BAR; PG8_WAIT_L(0); PG8_MMA(1, 0, At, B0); PG8_BAR; PG8_SCHED;
            PG8_STAGE(PG8_SB(0, 1), b2 + hstep, voffB);
            PG8_WAIT_V(6); PG8_BAR; PG8_MMA(1, 1, At, B1); PG8_BAR;
            PG8_LDB(B0, 1, 0); PG8_SCHED; PG8_LDA(At, 1, 0); PG8_STAGE(PG8_SA(0, 1), a2 + hstep, voffA);
            PG8_WAIT_L(8); PG8_BAR; PG8_WAIT_L(0); PG8_MMA(0, 0, At, B0); PG8_BAR; PG8_SCHED;
            PG8_LDB(B1, 1, 1); PG8_STAGE(PG8_SB(1, 0), b3, voffB);
            PG8_BAR; PG8_WAIT_L(0); PG8_MMA(0, 1, At, B1); PG8_BAR;
            PG8_LDA(At, 1, 1); PG8_STAGE(PG8_SA(1, 0), a3, voffA);
            PG8_BAR; PG8_WAIT_L(0); PG8_MMA(1, 0, At, B0); PG8_BAR; PG8_SCHED;
            PG8_STAGE(PG8_SB(1, 1), b3 + hstep, voffB);
            PG8_WAIT_V(6); PG8_BAR; PG8_MMA(1, 1, At, B1); PG8_BAR;
            }
        }
        if constexpr (ALIGN_EPI) { if (wr == 0) PG8_BAR; }
        if constexpr (!Epi::AFTER_DRAIN) { E(acc, cur, wr, wc, fr, fq); S.done(cur); }
        if (!has_next) break;
#pragma unroll
        for (int a = 0; a < 2; ++a)
#pragma unroll
            for (int b = 0; b < 2; ++b)
#pragma unroll
                for (int m = 0; m < 4; ++m)
#pragma unroll
                    for (int n = 0; n < 2; ++n) acc[a][b][m][n] = (f32x4){0.f, 0.f, 0.f, 0.f};
        cur = nxt; cA = nA; cB = nB; ++ui;
        if constexpr (ALIGN_EPI) { if (wr == 1) PG8_BAR; }
    }
    PG8_WAIT_V(0);
    if constexpr (!ALIGN_EPI) { if (wr == 0) PG8_BAR; }
    PG8_BAR;
    if constexpr (Epi::AFTER_DRAIN) { E.fused(acc, cur, wr, wc, fr, fq, lds, wid, lane); S.done(cur); }
#undef PG8_SA
#undef PG8_SB
#undef PG8_STAGE
#undef PG8_LDA
#undef PG8_LDB
#undef PG8_MMA
#undef PG8_WAIT_V
#undef PG8_WAIT_L
#undef PG8_BAR
#undef PG8_SCHED
}
}
typedef short bf16x8 __attribute__((ext_vector_type(8)));
constexpr int FR_NWK = 0, FR_QD = 16, FR_KTT = 32, FR_QK = 48, FR_N = 56;
__device__ __forceinline__ int kperm(int g, int j) { return j < 4 ? 4 * g + j : 16 + 4 * g + (j - 4); }

typedef float f32x2_t __attribute__((ext_vector_type(2))); typedef __bf16 bf16x2_t __attribute__((ext_vector_type(2)));
__device__ __forceinline__ unsigned cvtpk_c(float lo, float hi) { const f32x2_t v = {lo, hi}; const bf16x2_t b = __builtin_convertvector(v, bf16x2_t); return __builtin_bit_cast(unsigned, b); }
__device__ __forceinline__ bf16x8 pack8(const f32x4 a, const f32x4 b) {
    return __builtin_bit_cast(bf16x8, (u32x4){cvtpk_c(a[0], a[1]), cvtpk_c(a[2], a[3]), cvtpk_c(b[0], b[1]), cvtpk_c(b[2], b[3])});
}
constexpr int DP_KP = 136;
constexpr int DP_RP = 72;
constexpr int DP_QS = 0, DP_KS = DP_QS + 64 * DP_KP * 2, DP_RHST = DP_KS + 64 * DP_KP * 2, DP_AM = DP_RHST + 256 * DP_RP * 2, DP_AMP = 68,
              DP_QKM = DP_AM + 64 * DP_AMP * 4, DP_QKP = 72, DP_GS = DP_QKM + 64 * DP_QKP * 2, DP_DM = DP_GS + 4 * 64 * 4, DP_DMP = 20,
              DP_TB = DP_DM + 64 * DP_DMP * 4, DP_END = DP_TB + 64 * DP_RP * 2;
static_assert(DP_END <= 131072 && DP_AM % 16 == 0 && DP_DM % 16 == 0 && DP_TB % 16 == 0 && DP_RHST % 16 == 0, "dnprep LDS");
#ifndef DPS
#define DPS(k)
#endif
__device__ __forceinline__ void phase_dnprep(const P& p, LAS unsigned char* lds, unsigned long long& pr_prev, unsigned long long& pr_acc) {
    const int tid_ = otid();
    LAS bf16_t* QS = (LAS bf16_t*)(lds + DP_QS); LAS bf16_t* KS = (LAS bf16_t*)(lds + DP_KS); LAS bf16_t* RHST = (LAS bf16_t*)(lds + DP_RHST);
    LAS float* AM = (LAS float*)(lds + DP_AM); LAS bf16_t* QKM = (LAS bf16_t*)(lds + DP_QKM); LAS float* GS = (LAS float*)(lds + DP_GS);
    LAS float* DM = (LAS float*)(lds + DP_DM); LAS bf16_t* TB = (LAS bf16_t*)(lds + DP_TB);
    const bf16_t* PR = ws_h(p, WS_PROJ); const float* BG = ws_f(p, WS_BG);
    for (int i = tid_; i < 64 * DP_RP / 2; i += NTHR) ((LAS unsigned*)TB)[i] = 0u;
    float pgx = 0.f, pbx = 0.f, cw[3][4][2]; unsigned xr[3][11];
#define DP_FETCH(uid_, ln_, wv_) do { const int n_ = (uid_) % NCHUNK, bh_ = (uid_) / NCHUNK, h_ = bh_ & 3, m0_ = (bh_ >> 2) * SEQ + n_ * 64; \
        if ((wv_) == 0) { pgx = BG[(size_t)(m0_ + (ln_)) * 8 + 4 + h_]; pbx = BG[(size_t)(m0_ + (ln_)) * 8 + h_]; } \
        _Pragma("unroll") for (int part = 0; part < 3; ++part) _Pragma("unroll") for (int j = 0; j < 4; ++j) { const float* w = p.dn_conv_w + j * 1536 + part * 512 + h_ * 128 + 2 * (ln_); cw[part][j][0] = w[0]; cw[part][j][1] = w[1]; } \
        _Pragma("unroll") for (int rr = 0; rr < 11; ++rr) { const int t_ = n_ * 64 + (wv_) * 8 + rr - 3; \
            _Pragma("unroll") for (int part = 0; part < 3; ++part) { unsigned v_ = 0u; if (t_ >= 0) v_ = *(const unsigned*)(PR + (size_t)(m0_ + (wv_) * 8 + rr - 3) * PLD + part * 512 + h_ * 128 + 2 * (ln_)); xr[part][rr] = v_; } } } while (0)
    if ((int)blockIdx.x < NUNIT) { int t0 = tid_; asm volatile("" : "+v"(t0)); DP_FETCH((int)blockIdx.x, t0 & 63, t0 >> 6); }
    for (int uid = blockIdx.x; uid < NUNIT; uid += gridDim.x) {
        const int n = uid % NCHUNK;
        int tid = tid_; asm volatile("" : "+v"(tid));
        const int lane = tid & 63, wave = tid >> 6, r16 = lane & 15, g4 = lane >> 4;
        unsigned char* abu = p.ws + WS_DNF_AB + (size_t)uid * DNF_AB_UNIT;
        if (wave == 0) {
            float x = pgx;
#pragma unroll
            for (int o = 1; o < 64; o <<= 1) { const float t = __shfl_up(x, o); if (lane >= o) x += t; }
            const float gl = __shfl(x, 63);
            GS[lane] = x; GS[64 + lane] = pbx; GS[128 + lane] = __expf(x); GS[192 + lane] = __expf(gl - x);
            if (lane == 0) ws_f(p, WS_DNF_CD)[uid] = __expf(gl);
        }
        __syncthreads();
        {
            float c[8][3][2], ssum[16];
#pragma unroll
            for (int i = 0; i < 8; ++i) {
#pragma unroll
                for (int part = 0; part < 3; ++part)
#pragma unroll
                    for (int e = 0; e < 2; ++e) { float a = 0.f;
#pragma unroll
                        for (int j = 0; j < 4; ++j) a += cw[part][j][e] * (e == 0 ? __builtin_bit_cast(float, xr[part][i + j] << 16) : __builtin_bit_cast(float, xr[part][i + j] & 0xffff0000u));
                        c[i][part][e] = a * __builtin_amdgcn_rcpf(1.0f + __expf(-a)); }
                ssum[2 * i] = c[i][0][0] * c[i][0][0] + c[i][0][1] * c[i][0][1]; ssum[2 * i + 1] = c[i][1][0] * c[i][1][0] + c[i][1][1] * c[i][1][1]; }
#pragma unroll
            for (int o = 1; o < 64; o <<= 1) {
#pragma unroll
                for (int q = 0; q < 16; ++q) ssum[q] += __shfl_xor(ssum[q], o); }
#pragma unroll
            for (int i = 0; i < 8; ++i) { const int row = wave * 8 + i;
                const float rq = 0.08838834764831845f * __builtin_amdgcn_rsqf(ssum[2 * i] + EPS), rk = __builtin_amdgcn_rsqf(ssum[2 * i + 1] + EPS);
                const float beta = GS[64 + row], eg = GS[128 + row];
                const float q0 = c[i][0][0] * rq, q1 = c[i][0][1] * rq, k0 = c[i][1][0] * rk, k1 = c[i][1][1] * rk;
                *(LAS unsigned*)(QS + row * DP_KP + 2 * lane) = pk2(q0, q1);
                *(LAS unsigned*)(KS + row * DP_KP + 2 * lane) = pk2(k0, k1);
                RHST[(2 * lane) * DP_RP + row] = f2bf(beta * c[i][2][0]); RHST[(2 * lane + 1) * DP_RP + row] = f2bf(beta * c[i][2][1]);
                RHST[(128 + 2 * lane) * DP_RP + row] = f2bf(beta * eg * k0); RHST[(128 + 2 * lane + 1) * DP_RP + row] = f2bf(beta * eg * k1); }
        }
        if (uid + (int)gridDim.x < NUNIT) DP_FETCH(uid + (int)gridDim.x, lane, wave);
        __syncthreads(); DPS(16);
        {
            const int ti = wave >> 1;
            f32x4 akk[2], aqk[2];
#pragma unroll
            for (int c = 0; c < 2; ++c) { akk[c] = (f32x4){0.f, 0.f, 0.f, 0.f}; aqk[c] = (f32x4){0.f, 0.f, 0.f, 0.f}; }
#pragma unroll
            for (int kb = 0; kb < 4; ++kb) {
                const bf16x8 ak = *(const LAS bf16x8*)(KS + (16 * ti + r16) * DP_KP + 32 * kb + 8 * g4), aq = *(const LAS bf16x8*)(QS + (16 * ti + r16) * DP_KP + 32 * kb + 8 * g4);
#pragma unroll
                for (int c = 0; c < 2; ++c) { const int tj = 2 * (wave & 1) + c; const bf16x8 bk = *(const LAS bf16x8*)(KS + (16 * tj + r16) * DP_KP + 32 * kb + 8 * g4);
                    akk[c] = __builtin_amdgcn_mfma_f32_16x16x32_bf16(ak, bk, akk[c], 0, 0, 0); aqk[c] = __builtin_amdgcn_mfma_f32_16x16x32_bf16(aq, bk, aqk[c], 0, 0, 0); }
            }
#pragma unroll
            for (int c = 0; c < 2; ++c) { const int tj = 2 * (wave & 1) + c, J = 16 * tj + r16; const float gj = GS[J];
#pragma unroll
                for (int i = 0; i < 4; ++i) { const int I = 16 * ti + 4 * g4 + i; const float dec = I >= J ? __expf(GS[I] - gj) : 0.f;
                    AM[I * DP_AMP + J] = I > J ? GS[64 + I] * akk[c][i] * dec : 0.f; QKM[I * DP_QKP + J] = f2bf(aqk[c][i] * dec); } }
        }
        __syncthreads(); DPS(17);
        if (wave == 0) {
            const int bb = g4, cc = r16; float t[16];
            f32x4 tr[16][4];
#pragma unroll
            for (int i = 1; i < 16; ++i)
#pragma unroll
                for (int j4 = 0; j4 < (i + 3) / 4; ++j4) tr[i][j4] = *(const LAS f32x4*)(AM + (16 * bb + i) * DP_AMP + 16 * bb + 4 * j4);
            __builtin_amdgcn_sched_barrier(0);
#pragma unroll
            for (int i = 0; i < 16; ++i) { float acc = (i == cc) ? 1.f : 0.f;
#pragma unroll
                for (int j = 0; j < i; ++j) acc -= tr[i][j >> 2][j & 3] * t[j];
                t[i] = acc; }
#pragma unroll
            for (int i = 0; i < 16; ++i) { DM[(16 * bb + i) * DP_DMP + cc] = t[i]; TB[(16 * bb + i) * DP_RP + 16 * bb + cc] = f2bf(t[i]); }
        } else if (wave >= 4) {
            for (int f = FR_QD + (wave - 4); f < FR_N; f += 4) {
                u32x4 o;
                if (f < FR_KTT) { const int mt = (f - FR_QD) >> 2, kb = (f - FR_QD) & 3, row = 16 * mt + r16; const float sc = GS[128 + row];
                    const u32x2 lo = *(const LAS u32x2*)(QS + row * DP_KP + 32 * kb + 4 * g4), hi = *(const LAS u32x2*)(QS + row * DP_KP + 32 * kb + 16 + 4 * g4);
                    const unsigned w[4] = {lo.x, lo.y, hi.x, hi.y}; unsigned r[4];
#pragma unroll
                    for (int e = 0; e < 4; ++e) r[e] = cvtpk_c(__builtin_bit_cast(float, w[e] << 16) * sc, __builtin_bit_cast(float, w[e] & 0xffff0000u) * sc);
                    o = (u32x4){r[0], r[1], r[2], r[3]};
                } else if (f < FR_QK) { const int kt = (f - FR_KTT) >> 1, tb = (f - FR_KTT) & 1; float v[8];
#pragma unroll
                    for (int j = 0; j < 8; ++j) { const int tok = 32 * tb + kperm(g4, j); v[j] = bf2f(KS[tok * DP_KP + 16 * kt + r16]) * GS[192 + tok]; }
                    o = (u32x4){cvtpk_c(v[0], v[1]), cvtpk_c(v[2], v[3]), cvtpk_c(v[4], v[5]), cvtpk_c(v[6], v[7])};
                } else { const int mt = (f - FR_QK) >> 1, tb = (f - FR_QK) & 1, row = 16 * mt + r16;
                    const u32x2 lo = *(const LAS u32x2*)(QKM + row * DP_QKP + 32 * tb + 4 * g4), hi = *(const LAS u32x2*)(QKM + row * DP_QKP + 32 * tb + 16 + 4 * g4);
                    o = (u32x4){lo.x, lo.y, hi.x, hi.y}; }
                *(u32x4*)(abu + (size_t)f * 1024 + lane * 16) = o;
            }
        }
        __syncthreads(); DPS(18);
        if (wave < 3) {
            const int j = wave; f32x4 Tk[4];
#pragma unroll
            for (int kk = 0; kk < 4; ++kk) Tk[j][kk] = DM[(16 * j + 4 * g4 + kk) * DP_DMP + r16];
#pragma unroll
            for (int i = 1; i < 4; ++i) if (i > j) {
                f32x4 acc = (f32x4){0.f, 0.f, 0.f, 0.f};
#pragma unroll
                for (int k = 0; k < 3; ++k) if (k >= j && k < i) { const f32x4 a = *(const LAS f32x4*)(AM + (16 * i + r16) * DP_AMP + 16 * k + 4 * g4);
#pragma unroll
                    for (int kk = 0; kk < 4; ++kk) acc = __builtin_amdgcn_mfma_f32_16x16x4f32(a[kk], Tk[k][kk], acc, 0, 0, 0); }
                const f32x4 dd = *(const LAS f32x4*)(DM + (16 * i + r16) * DP_DMP + 4 * g4);
                f32x4 res = (f32x4){0.f, 0.f, 0.f, 0.f};
#pragma unroll
                for (int kk = 0; kk < 4; ++kk) res = __builtin_amdgcn_mfma_f32_16x16x4f32(dd[kk], acc[kk], res, 0, 0, 0);
                Tk[i] = -res;
#pragma unroll
                for (int e = 0; e < 4; ++e) TB[(16 * i + 4 * g4 + e) * DP_RP + 16 * j + r16] = f2bf(Tk[i][e]); }
        }
        __syncthreads(); DPS(19);
        {
            const int mt = wave & 3, half = wave >> 2;
            bf16x8 tf[2];
#pragma unroll
            for (int kb = 0; kb < 2; ++kb) tf[kb] = *(const LAS bf16x8*)(TB + (16 * mt + r16) * DP_RP + 32 * kb + 8 * g4);
            if (half == 0) {
                float* wv = (float*)(p.ws + WS_DNF_WV + (size_t)uid * DNF_WV_UNIT) + (size_t)mt * 256 + lane * 4;
#pragma unroll
                for (int vt = 0; vt < 8; ++vt) { f32x4 acc = (f32x4){0.f, 0.f, 0.f, 0.f};
#pragma unroll
                    for (int kb = 0; kb < 2; ++kb) acc = __builtin_amdgcn_mfma_f32_16x16x32_bf16(tf[kb], *(const LAS bf16x8*)(RHST + (16 * vt + r16) * DP_RP + 32 * kb + 8 * g4), acc, 0, 0, 0);
                    *(f32x4*)(wv + (size_t)vt * 1024) = acc; }
            } else {
#pragma unroll
                for (int kbp = 0; kbp < 4; ++kbp) { f32x4 xt[2];
#pragma unroll
                    for (int c2 = 0; c2 < 2; ++c2) { xt[c2] = (f32x4){0.f, 0.f, 0.f, 0.f};
#pragma unroll
                        for (int kb = 0; kb < 2; ++kb) xt[c2] = __builtin_amdgcn_mfma_f32_16x16x32_bf16(*(const LAS bf16x8*)(RHST + (128 + 16 * (2 * kbp + c2) + r16) * DP_RP + 32 * kb + 8 * g4), tf[kb], xt[c2], 0, 0, 0); }
                    *(u32x4*)(abu + (size_t)(FR_NWK + mt * 4 + kbp) * 1024 + lane * 16) = __builtin_bit_cast(u32x4, pack8(-xt[0], -xt[1])); }
            }
        }
        __syncthreads(); DPS(20);
    }
#undef DP_FETCH
}

constexpr size_t O_ODN = O_Y;
#define DN_SB() __builtin_amdgcn_sched_barrier(0)
__device__ __forceinline__ void dn_consume(const LAS unsigned char* fb, int wl, f32x4 (&S)[8], float cd, float* op) {
    f32x4 u[4], o[4];
    bf16x8 fa[16], fq[16], Sb[4], Ub[2];
#pragma unroll
    for (int mt = 0; mt < 4; ++mt) u[mt] = *(const LAS f32x4*)(fb + (FR_N + wl * 4 + mt) * 1024);
#pragma unroll
    for (int f = 0; f < 16; ++f) fa[f] = *(const LAS bf16x8*)(fb + (FR_NWK + f) * 1024);
#pragma unroll
    for (int f = 0; f < 8; ++f) fq[f] = *(const LAS bf16x8*)(fb + (FR_QD + f) * 1024);
    DN_SB();
#pragma unroll
    for (int kb = 0; kb < 4; ++kb) Sb[kb] = pack8(S[2 * kb], S[2 * kb + 1]);
#pragma unroll
    for (int mt = 0; mt < 4; ++mt)
#pragma unroll
        for (int kb = 0; kb < 4; ++kb) u[mt] = __builtin_amdgcn_mfma_f32_16x16x32_bf16(fa[mt * 4 + kb], Sb[kb], u[mt], 0, 0, 0);
    DN_SB();
#pragma unroll
    for (int f = 8; f < 16; ++f) fq[f] = *(const LAS bf16x8*)(fb + (FR_QD + f) * 1024);
#pragma unroll
    for (int f = 0; f < 8; ++f) fa[f] = *(const LAS bf16x8*)(fb + (FR_KTT + f) * 1024);
    DN_SB();
#pragma unroll
    for (int mt = 0; mt < 4; ++mt) { o[mt] = (f32x4){0.f, 0.f, 0.f, 0.f};
#pragma unroll
        for (int kb = 0; kb < 4; ++kb) o[mt] = __builtin_amdgcn_mfma_f32_16x16x32_bf16(fq[mt * 4 + kb], Sb[kb], o[mt], 0, 0, 0); }
    DN_SB();
#pragma unroll
    for (int f = 8; f < 16; ++f) fa[f] = *(const LAS bf16x8*)(fb + (FR_KTT + f) * 1024);
#pragma unroll
    for (int f = 0; f < 8; ++f) fq[f] = *(const LAS bf16x8*)(fb + (FR_QK + f) * 1024);
#pragma unroll
    for (int tb = 0; tb < 2; ++tb) Ub[tb] = pack8(u[2 * tb], u[2 * tb + 1]);
#pragma unroll
    for (int kt = 0; kt < 8; ++kt) S[kt] = S[kt] * cd;
    DN_SB();
#pragma unroll
    for (int kt = 0; kt < 8; ++kt)
#pragma unroll
        for (int tb = 0; tb < 2; ++tb) S[kt] = __builtin_amdgcn_mfma_f32_16x16x32_bf16(fa[kt * 2 + tb], Ub[tb], S[kt], 0, 0, 0);
#pragma unroll
    for (int mt = 0; mt < 4; ++mt) {
#pragma unroll
        for (int tb = 0; tb < 2; ++tb) o[mt] = __builtin_amdgcn_mfma_f32_16x16x32_bf16(fq[mt * 2 + tb], Ub[tb], o[mt], 0, 0, 0);
#pragma unroll
        for (int i = 0; i < 4; ++i) op[(size_t)(16 * mt + i) * 512] = o[mt][i]; }
}
constexpr int DN_SBUF = 73728;
__device__ __forceinline__ void phase_dnscan(const P& p, LAS unsigned char* lds) {
    if (blockIdx.x >= BATCH * 4 * 2) return;
    const int tid = otid(), lane = tid & 63, wave = __builtin_amdgcn_readfirstlane(tid >> 6), r16 = lane & 15, g4 = lane >> 4;
    const int bh = blockIdx.x >> 1, vh = blockIdx.x & 1, h = bh & 3, b = bh >> 2, wl = wave & 3, vs = vh * 4 + wl, v0 = vs * 16;
    const float* cdp = ws_f(p, WS_DNF_CD) + (size_t)bh * NCHUNK;
    float* odn = p.out + O_ODN;
#define DN_BAR() do { asm volatile("s_waitcnt lgkmcnt(0)" ::: "memory"); __builtin_amdgcn_s_barrier(); asm volatile("" ::: "memory"); } while (0)
    if (wave >= 4) {
        const unsigned char* ab = p.ws + WS_DNF_AB + (size_t)bh * NCHUNK * DNF_AB_UNIT + lane * 16;
        const unsigned char* wvb = p.ws + WS_DNF_WV + (size_t)bh * NCHUNK * DNF_WV_UNIT + (size_t)vh * 16 * 1024 + lane * 16;
        u32x4 R[3][18];
#define DN_SRC(n_, q_) ((q_) < FR_N ? ab + (size_t)(n_) * DNF_AB_UNIT + (q_) * 1024 : wvb + (size_t)(n_) * DNF_WV_UNIT + ((q_) - FR_N) * 1024)
#define DN_LD(n_, s_) do { if ((n_) < NCHUNK) { _Pragma("unroll") for (int i_ = 0; i_ < 18; ++i_) R[s_][i_] = *(const u32x4*)DN_SRC(n_, wl * 18 + i_); } } while (0)
#define DN_ST(n_, s_) do { if ((n_) < NCHUNK) { LAS unsigned char* d_ = lds + ((n_) & 1) * DN_SBUF + wl * 18 * 1024 + lane * 16; _Pragma("unroll") for (int i_ = 0; i_ < 18; ++i_) *(LAS u32x4*)(d_ + i_ * 1024) = R[s_][i_]; } } while (0)
        DN_LD(0, 0); DN_LD(1, 1); DN_LD(2, 2); DN_ST(0, 0);
        DN_BAR();
#define DN_LSTEP(n_, s_) do { const int n = (n_); if (n < NCHUNK) { DN_LD(n + 3, s_); DN_ST(n + 1, ((s_) + 1) % 3); DN_BAR(); } } while (0)
        for (int n3 = 0; n3 < NCHUNK; n3 += 3) { DN_LSTEP(n3, 0); DN_LSTEP(n3 + 1, 1); DN_LSTEP(n3 + 2, 2); }
#undef DN_LSTEP
#undef DN_LD
#undef DN_ST
#undef DN_SRC
        return;
    }
    f32x4 S[8];
#pragma unroll
    for (int t = 0; t < 8; ++t) S[t] = (f32x4){0.f, 0.f, 0.f, 0.f};
    float cd = cdp[0];
    DN_BAR();
    for (int n = 0; n < NCHUNK; ++n) {
        const float cdn = cdp[n + 1 < NCHUNK ? n + 1 : n];
        dn_consume(lds + (n & 1) * DN_SBUF + lane * 16, wl, S, cd, odn + (size_t)(b * SEQ + n * 64 + 4 * g4) * 512 + h * 128 + v0 + r16);
        cd = cdn;
        DN_BAR();
    }
#undef DN_BAR
    {
        float* so = p.out + O_PSSM + (size_t)bh * 128 * 128 + v0 + r16;
#pragma unroll
        for (int kt = 0; kt < 8; ++kt)
#pragma unroll
            for (int i = 0; i < 4; ++i) so[(size_t)(16 * kt + 4 * g4 + i) * 128] = S[kt][i];
    }
}
__device__ __forceinline__ void phase_dngate(const P& p) {
    const int tid_ = otid(), lane = tid_ & 63, wave = tid_ >> 6;
    const int gw = blockIdx.x * NWAVES + wave, NGW = gridDim.x * NWAVES;
    const f32x4 nw0 = *(const f32x4*)(p.dn_norm_w + (lane & 15) * 8), nw1 = *(const f32x4*)(p.dn_norm_w + (lane & 15) * 8 + 4);
    f32x4 a, c; u32x4 z;
#define DG_LOAD(m_) do { const float* o_ = p.out + O_ODN + (size_t)(m_) * 512 + lane * 8; a = *(const f32x4*)o_; c = *(const f32x4*)(o_ + 4); z = *(const u32x4*)(ws_h(p, WS_PROJ) + (size_t)(m_) * PLD + PC_Z + lane * 8); } while (0)
    if (gw < TP) DG_LOAD(gw);
    for (int m = gw; m < TP; m += NGW) {
        const f32x4 a0 = a, c0 = c; const u32x4 z0 = z;
        if (m + NGW < TP) DG_LOAD(m + NGW);
        float ss = (a0[0] * a0[0] + a0[1] * a0[1]) + (a0[2] * a0[2] + a0[3] * a0[3]) + (c0[0] * c0[0] + c0[1] * c0[1]) + (c0[2] * c0[2] + c0[3] * c0[3]);
#pragma unroll
        for (int off = 1; off < 16; off <<= 1) ss += __shfl_xor(ss, off);
        const float rstd = 1.0f / sqrtf(ss * (1.0f / 128.0f) + EPS);
        const unsigned zw[4] = {z0.x, z0.y, z0.z, z0.w}; const float ov[8] = {a0[0], a0[1], a0[2], a0[3], c0[0], c0[1], c0[2], c0[3]}; const float nwv[8] = {nw0[0], nw0[1], nw0[2], nw0[3], nw1[0], nw1[1], nw1[2], nw1[3]};
        unsigned r[4];
#pragma unroll
        for (int e = 0; e < 4; ++e) { const float z0f = __builtin_bit_cast(float, zw[e] << 16), z1f = __builtin_bit_cast(float, zw[e] & 0xffff0000u);
            r[e] = pk2(ov[2 * e] * rstd * nwv[2 * e] * silu_f(z0f), ov[2 * e + 1] * rstd * nwv[2 * e + 1] * silu_f(z1f)); }
        *(u32x4*)(ws_h(p, WS_MIX) + (size_t)m * 1024 + lane * 8) = (u32x4){r[0], r[1], r[2], r[3]};
    }
#undef DG_LOAD
}
__device__ __forceinline__ void phase_dnsample(const P& p, LAS unsigned char* lds, unsigned long long& pr_prev, unsigned long long& pr_acc) {
    const int tid = otid(), lane = tid & 63, us = tid >> 8, w4 = (tid >> 6) & 3, kh = lane >> 5, col_ = w4 * 32 + (lane & 31);
    LAS float* QH = (LAS float*)lds + us * 4352;
    LAS float* KH = QH + 1024; LAS float* VH = QH + 2048; LAS float* OH = QH + 3072; LAS float* RED = QH + 4096;
    const bf16_t* PR = ws_h(p, WS_PROJ); const float* BG = ws_f(p, WS_BG);
    for (int ub = blockIdx.x; ub < DEC_BATCH * 2; ub += gridDim.x) {
        const int uidx = ub * 2 + us, b = uidx >> 2, h = uidx & 3, m0 = TP + b * DEC_SEQ;
        int col = col_; asm volatile("" : "+v"(col));
        {
            float x0[11], x1[11];
            const int ch0 = kh * 512 + h * 128 + col;
#pragma unroll
            for (int rr = 0; rr < 11; ++rr) {
                if (rr < 3) { const float* st = p.state_dn_conv + ((size_t)b * 3 + rr) * 1536; x0[rr] = st[ch0]; x1[rr] = st[1024 + h * 128 + col]; }
                else { const bf16_t* pr = PR + (size_t)(m0 + rr - 3) * PLD; x0[rr] = bf2f(pr[ch0]); x1[rr] = bf2f(pr[1024 + h * 128 + col]); } }
            float w0[4], w1[4];
#pragma unroll
            for (int j = 0; j < 4; ++j) { w0[j] = p.dn_conv_w[j * 1536 + ch0]; w1[j] = p.dn_conv_w[j * 1536 + 1024 + h * 128 + col]; }
            float ssq[8], ssk[8];
#pragma unroll
            for (int t = 0; t < 8; ++t) { float a = 0.f, d = 0.f;
#pragma unroll
                for (int j = 0; j < 4; ++j) { a += w0[j] * x0[t + j]; d += w1[j] * x1[t + j]; }
                a = a * __builtin_amdgcn_rcpf(1.0f + __expf(-a)); d = d * __builtin_amdgcn_rcpf(1.0f + __expf(-d));
                if (kh == 0) { QH[t * 128 + col] = a; VH[t * 128 + col] = d; } else KH[t * 128 + col] = a;
                ssq[t] = kh == 0 ? a * a : 0.f; ssk[t] = kh == 1 ? a * a : 0.f; }
#pragma unroll
            for (int o = 1; o < 64; o <<= 1) {
#pragma unroll
                for (int t = 0; t < 8; ++t) { ssq[t] += __shfl_xor(ssq[t], o); ssk[t] += __shfl_xor(ssk[t], o); } }
            if (lane == 0) {
#pragma unroll
                for (int t = 0; t < 8; ++t) { RED[w4 * 16 + t] = ssq[t]; RED[w4 * 16 + 8 + t] = ssk[t]; } }
        }
        __syncthreads(); DPS(27);
#pragma unroll
        for (int t = 0; t < 8; ++t) {
            if (kh == 0) { const float sq = (RED[t] + RED[16 + t]) + (RED[32 + t] + RED[48 + t]); QH[t * 128 + col] *= 0.08838834764831845f / sqrtf(sq + EPS); }
            else { const float sk = (RED[8 + t] + RED[24 + t]) + (RED[40 + t] + RED[56 + t]); KH[t * 128 + col] *= 1.0f / sqrtf(sk + EPS); } }
        __syncthreads(); DPS(28);
        float S[64];
        const float* S0 = p.state_dn_ssm + ((size_t)b * 4 + h) * 128 * 128 + (size_t)kh * 64 * 128 + col;
#pragma unroll
        for (int k = 0; k < 64; ++k) { S[k] = *S0; S0 += 128; if ((k & 7) == 7) asm volatile("" : "+v"(S0)); }
#pragma unroll 1
        for (int t = 0; t < 8; ++t) {
            const float beta = BG[(size_t)(m0 + t) * 8 + h], eg = __expf(BG[(size_t)(m0 + t) * 8 + 4 + h]);
            const LAS float* kp = KH + t * 128 + kh * 64; const LAS float* qp = QH + t * 128 + kh * 64;
            f32x4 kk[16], qq[16];
#pragma unroll
            for (int k4 = 0; k4 < 16; ++k4) kk[k4] = *(const LAS f32x4*)(kp + 4 * k4);
#pragma unroll
            for (int k4 = 0; k4 < 16; ++k4) qq[k4] = *(const LAS f32x4*)(qp + 4 * k4);
            const float vt = VH[t * 128 + col];
            __builtin_amdgcn_sched_barrier(0);
            float kS = 0.f;
#pragma unroll
            for (int k4 = 0; k4 < 16; ++k4)
#pragma unroll
                for (int e = 0; e < 4; ++e) { S[4 * k4 + e] *= eg; kS += kk[k4][e] * S[4 * k4 + e]; }
            kS += __shfl_xor(kS, 32);
            const float u = beta * (vt - kS);
            float o = 0.f;
#pragma unroll
            for (int k4 = 0; k4 < 16; ++k4)
#pragma unroll
                for (int e = 0; e < 4; ++e) { S[4 * k4 + e] += kk[k4][e] * u; o += qq[k4][e] * S[4 * k4 + e]; }
            o += __shfl_xor(o, 32);
            if (kh == 0) OH[t * 128 + col] = o;
            __builtin_amdgcn_sched_barrier(0);
        }
        float* So = p.out + O_SSSM + ((size_t)b * 4 + h) * 128 * 128 + (size_t)kh * 64 * 128 + col;
#pragma unroll
        for (int k = 0; k < 64; ++k) { *So = S[k]; So += 128; if ((k & 7) == 7) asm volatile("" : "+v"(So)); }
        __syncthreads(); DPS(29);
#pragma unroll
        for (int t = 0; t < 8; ++t) { const float o = kh == 0 ? OH[t * 128 + col] : 0.f; const float s = wave_sum(o * o); if (lane == 0) RED[w4 * 16 + t] = s; }
        __syncthreads();
        if (kh == 0) {
            const float nw = p.dn_norm_w[col];
#pragma unroll
            for (int t = 0; t < 8; ++t) { const float rstd = 1.0f / sqrtf(((RED[t] + RED[16 + t]) + (RED[32 + t] + RED[48 + t])) * (1.0f / 128.0f) + EPS);
                const float z = bf2f(PR[(size_t)(m0 + t) * PLD + PC_Z + h * 128 + col]);
                ws_h(p, WS_MIX)[(size_t)(m0 + t) * 1024 + h * 128 + col] = f2bf(OH[t * 128 + col] * rstd * nw * silu_f(z)); }
        }
        __syncthreads(); DPS(30);
    }
}
constexpr int NSEG = 16, CSEG = NCHUNK / NSEG, NBH = BATCH * 4;
static_assert(NCHUNK % NSEG == 0, "segments");
constexpr size_t O_RFRAG = O_ODN + (size_t)TP * 512;
constexpr size_t O_BSEG = O_RFRAG + (size_t)NBH * NSEG * 8192;
constexpr size_t O_SSEG = O_BSEG + (size_t)NBH * NSEG * 16384;
constexpr size_t O_CPROD = O_SSEG + (size_t)NBH * NSEG * 16384;
static_assert(O_CPROD + NBH * NSEG <= (size_t)T * D, "segment scratch fits in the y region of d_out");

template <bool HASWV> __device__ __forceinline__ void dn_consume_map(const LAS unsigned char* fb, int wl, f32x4 (&X)[8], float cd) {
    f32x4 u[4]; bf16x8 f0[8], f1[8], Xb[4], Ub[2];
#pragma unroll
    for (int mt = 0; mt < 4; ++mt) u[mt] = HASWV ? *(const LAS f32x4*)(fb + (FR_N + wl * 4 + mt) * 1024) : (f32x4){0.f, 0.f, 0.f, 0.f};
#pragma unroll
    for (int f = 0; f < 8; ++f) f0[f] = *(const LAS bf16x8*)(fb + (FR_NWK + f) * 1024);
#pragma unroll
    for (int f = 0; f < 8; ++f) f1[f] = *(const LAS bf16x8*)(fb + (FR_NWK + 8 + f) * 1024);
    DN_SB();
#pragma unroll
    for (int kb = 0; kb < 4; ++kb) Xb[kb] = pack8(X[2 * kb], X[2 * kb + 1]);
#pragma unroll
    for (int mt = 0; mt < 2; ++mt)
#pragma unroll
        for (int kb = 0; kb < 4; ++kb) u[mt] = __builtin_amdgcn_mfma_f32_16x16x32_bf16(f0[mt * 4 + kb], Xb[kb], u[mt], 0, 0, 0);
    DN_SB();
#pragma unroll
    for (int f = 0; f < 8; ++f) f0[f] = *(const LAS bf16x8*)(fb + (FR_KTT + f) * 1024);
    DN_SB();
#pragma unroll
    for (int mt = 2; mt < 4; ++mt)
#pragma unroll
        for (int kb = 0; kb < 4; ++kb) u[mt] = __builtin_amdgcn_mfma_f32_16x16x32_bf16(f1[(mt - 2) * 4 + kb], Xb[kb], u[mt], 0, 0, 0);
    DN_SB();
#pragma unroll
    for (int f = 0; f < 8; ++f) f1[f] = *(const LAS bf16x8*)(fb + (FR_KTT + 8 + f) * 1024);
#pragma unroll
    for (int tb = 0; tb < 2; ++tb) Ub[tb] = pack8(u[2 * tb], u[2 * tb + 1]);
#pragma unroll
    for (int kt = 0; kt < 8; ++kt) X[kt] = X[kt] * cd;
    DN_SB();
#pragma unroll
    for (int kt = 0; kt < 4; ++kt)
#pragma unroll
        for (int tb = 0; tb < 2; ++tb) X[kt] = __builtin_amdgcn_mfma_f32_16x16x32_bf16(f0[kt * 2 + tb], Ub[tb], X[kt], 0, 0, 0);
#pragma unroll
    for (int kt = 4; kt < 8; ++kt)
#pragma unroll
        for (int tb = 0; tb < 2; ++tb) X[kt] = __builtin_amdgcn_mfma_f32_16x16x32_bf16(f1[(kt - 4) * 2 + tb], Ub[tb], X[kt], 0, 0, 0);
}
#define DNS_BAR() do { asm volatile("s_waitcnt lgkmcnt(0)" ::: "memory"); __builtin_amdgcn_s_barrier(); asm volatile("" ::: "memory"); } while (0)
template <int MODE> __device__ __forceinline__ void dns_loader(const P& p, LAS unsigned char* lds, int bh, int n0, int nsteps, int vh, int wl, int lane) {
    constexpr int NPW = MODE == 2 ? 18 : (MODE == 1 ? 12 : 8);
    const unsigned char* ab = p.ws + WS_DNF_AB + ((size_t)bh * NCHUNK + n0) * DNF_AB_UNIT + lane * 16;
    const unsigned char* wvb = p.ws + WS_DNF_WV + ((size_t)bh * NCHUNK + n0) * DNF_WV_UNIT + (size_t)vh * 16 * 1024 + lane * 16;
    u32x4 R[2][NPW];
#define DNS_FRAG(q_) (MODE == 2 ? (q_) : ((q_) < 16 ? (q_) : ((q_) < 32 ? FR_KTT + (q_) - 16 : FR_N + (q_) - 32)))
#define DNS_SRC(n_, q_) (DNS_FRAG(q_) < FR_N ? ab + (size_t)(n_) * DNF_AB_UNIT + DNS_FRAG(q_) * 1024 : wvb + (size_t)(n_) * DNF_WV_UNIT + (DNS_FRAG(q_) - FR_N) * 1024)
#define DNS_LD(n_, s_) do { if ((n_) < nsteps) { _Pragma("unroll") for (int i_ = 0; i_ < NPW; ++i_) R[s_][i_] = *(const u32x4*)DNS_SRC(n_, wl * NPW + i_); } } while (0)
#define DNS_ST(n_, s_) do { if ((n_) < nsteps) { LAS unsigned char* d_ = lds + ((n_) & 1) * DN_SBUF + lane * 16; _Pragma("unroll") for (int i_ = 0; i_ < NPW; ++i_) *(LAS u32x4*)(d_ + DNS_FRAG(wl * NPW + i_) * 1024) = R[s_][i_]; } } while (0)
    DNS_LD(0, 0); DNS_LD(1, 1); DNS_ST(0, 0);
    DNS_BAR();
#define DNS_LSTEP(n_, s_) do { const int n = (n_); if (n < nsteps) { DNS_LD(n + 2, s_); DNS_ST(n + 1, (s_) ^ 1); DNS_BAR(); } } while (0)
    for (int n2 = 0; n2 < nsteps; n2 += 2) { DNS_LSTEP(n2, 0); DNS_LSTEP(n2 + 1, 1); }
#undef DNS_LSTEP
#undef DNS_LD
#undef DNS_ST
#undef DNS_SRC
#undef DNS_FRAG
}
constexpr int PA_RTP = 72;
template <int MODE> __device__ __forceinline__ void dns_passA_task(const P& p, LAS unsigned char* lds, int bh, int seg, int q, int wave, int lane) {
    const int r16 = lane & 15, g4 = lane >> 4, wl = wave & 3, n0 = seg * CSEG;
    const float* cdp = ws_f(p, WS_DNF_CD) + (size_t)bh * NCHUNK + n0;
    LAS bf16_t* RT = (LAS bf16_t*)lds;
    if (wave >= 4) { dns_loader<MODE>(p, lds, bh, n0, CSEG, q & 1, wl, lane); }
    else {
        f32x4 X[8];
#pragma unroll
        for (int kt = 0; kt < 8; ++kt)
#pragma unroll
            for (int i = 0; i < 4; ++i) X[kt][i] = (MODE == 0 && 16 * kt + 4 * g4 + i == 64 * q + 16 * wl + r16) ? 1.f : 0.f;
        float cd = cdp[0], cprod = 1.f;
        DNS_BAR();
        for (int n = 0; n < CSEG; ++n) {
            const float cdn = cdp[n + 1 < CSEG ? n + 1 : n];
            dn_consume_map<MODE == 1>(lds + (n & 1) * DN_SBUF + lane * 16, wl, X, cd);
            cprod *= cd; cd = cdn;
            DNS_BAR();
        }
        if (MODE == 0) {
#pragma unroll
            for (int kt = 0; kt < 8; ++kt)
#pragma unroll
                for (int i = 0; i < 4; ++i) { const int row = 16 * kt + 4 * g4 + i, col = 16 * wl + r16; const float v = X[kt][i] - ((row == 64 * q + col) ? cprod : 0.f);
                    RT[row * PA_RTP + col] = f2bf(v); }
            if (q == 0 && wave == 0 && lane == 0) p.out[O_CPROD + bh * NSEG + seg] = cprod;
        } else {
            float* bo = p.out + O_BSEG + ((size_t)(bh * NSEG + seg) * 8 + (4 * (q & 1) + wl)) * 2048 + lane * 4;
#pragma unroll
            for (int kt = 0; kt < 8; ++kt) *(f32x4*)(bo + kt * 256) = X[kt];
        }
    }
    DNS_BAR();
    if (MODE == 0) {
#pragma unroll
        for (int j = 0; j < 2; ++j) { const int f = wave * 2 + j, mt = f >> 1, kbl = f & 1, row = 16 * mt + r16;
            const u32x2 lo = *(const LAS u32x2*)(RT + row * PA_RTP + 32 * kbl + 4 * g4), hi = *(const LAS u32x2*)(RT + row * PA_RTP + 32 * kbl + 16 + 4 * g4);
            *(u32x4*)((unsigned char*)(p.out + O_RFRAG) + ((size_t)(bh * NSEG + seg) * 32 + mt * 4 + 2 * q + kbl) * 1024 + lane * 16) = (u32x4){lo.x, lo.y, hi.x, hi.y}; }
        DNS_BAR();
    }
}
__device__ __forceinline__ void phase_dns_passA(const P& p, LAS unsigned char* lds) {
    const int tid = otid(), lane = tid & 63, wave = __builtin_amdgcn_readfirstlane(tid >> 6);
    for (int t = blockIdx.x; t < NBH * NSEG * 4; t += gridDim.x) {
        const int q = t & 3, seg = (t >> 2) % NSEG, bh = t / (4 * NSEG);
        if (q < 2) dns_passA_task<0>(p, lds, bh, seg, q, wave, lane); else dns_passA_task<1>(p, lds, bh, seg, q, wave, lane);
    }
}
__device__ __forceinline__ void phase_dns_passB(const P& p, LAS unsigned char* lds) {
    if ((int)blockIdx.x >= NBH * 8) return;
    const int tid = otid(), lane = tid & 63, w = __builtin_amdgcn_readfirstlane(tid >> 6), r16 = lane & 15, g4 = lane >> 4;
    const int bh = blockIdx.x >> 3, vs = blockIdx.x & 7;
    LAS u32x2* XB = (LAS u32x2*)lds;
    const unsigned char* rf0 = (const unsigned char*)(p.out + O_RFRAG) + ((size_t)bh * NSEG * 32 + w * 4) * 1024 + lane * 16;
    const float* bt0 = p.out + O_BSEG + ((size_t)bh * NSEG * 8 + vs) * 2048 + w * 256 + lane * 4;
    float* ss0 = p.out + O_SSEG + ((size_t)bh * NSEG * 8 + vs) * 2048 + w * 256 + lane * 4;
    const float* cp0 = p.out + O_CPROD + bh * NSEG;
    u32x4 rf[4][4]; f32x4 bt[4]; float cp[4];
#define PB_LD(s_, r_) do { if ((s_) < NSEG) { _Pragma("unroll") for (int kb = 0; kb < 4; ++kb) rf[r_][kb] = *(const u32x4*)(rf0 + (size_t)(s_) * 32768 + kb * 1024); bt[r_] = *(const f32x4*)(bt0 + (size_t)(s_) * 16384); cp[r_] = cp0[(s_)]; } } while (0)
    PB_LD(0, 0); PB_LD(1, 1); PB_LD(2, 2);
    f32x4 S = (f32x4){0.f, 0.f, 0.f, 0.f};
#pragma unroll
    for (int s = 0; s < NSEG; ++s) {
        PB_LD(s + 3, (s + 3) & 3);
        *(f32x4*)(ss0 + (size_t)s * 16384) = S;
        XB[((s & 1) * 8 + w) * 64 + lane] = (u32x2){cvtpk_c(S[0], S[1]), cvtpk_c(S[2], S[3])};
        DNS_BAR();
        f32x4 acc = S * cp[s & 3] + bt[s & 3];
#pragma unroll
        for (int kb = 0; kb < 4; ++kb) { const u32x2 lo = XB[((s & 1) * 8 + 2 * kb) * 64 + lane], hi = XB[((s & 1) * 8 + 2 * kb + 1) * 64 + lane];
            acc = __builtin_amdgcn_mfma_f32_16x16x32_bf16(__builtin_bit_cast(bf16x8, rf[s & 3][kb]), __builtin_bit_cast(bf16x8, (u32x4){lo.x, lo.y, hi.x, hi.y}), acc, 0, 0, 0); }
        S = acc;
    }
#undef PB_LD
    float* so = p.out + O_PSSM + (size_t)bh * 128 * 128 + vs * 16 + r16;
#pragma unroll
    for (int i = 0; i < 4; ++i) so[(size_t)(16 * w + 4 * g4 + i) * 128] = S[i];
    DNS_BAR();
}
__device__ __forceinline__ void phase_dns_passC(const P& p, LAS unsigned char* lds) {
    const int tid = otid(), lane = tid & 63, wave = __builtin_amdgcn_readfirstlane(tid >> 6), r16 = lane & 15, g4 = lane >> 4, wl = wave & 3;
    for (int t = blockIdx.x; t < NBH * NSEG * 2; t += gridDim.x) {
        const int vh = t & 1, seg = (t >> 1) % NSEG, bh = t / (2 * NSEG), h = bh & 3, b = bh >> 2, vs = vh * 4 + wl, n0 = seg * CSEG;
        if (wave >= 4) dns_loader<2>(p, lds, bh, n0, CSEG, vh, wl, lane);
        else {
            const float* cdp = ws_f(p, WS_DNF_CD) + (size_t)bh * NCHUNK + n0;
            const float* ss = p.out + O_SSEG + ((size_t)(bh * NSEG + seg) * 8 + vs) * 2048 + lane * 4;
            f32x4 S[8];
#pragma unroll
            for (int kt = 0; kt < 8; ++kt) S[kt] = *(const f32x4*)(ss + kt * 256);
            float cd = cdp[0];
            DNS_BAR();
            for (int n = 0; n < CSEG; ++n) {
                const float cdn = cdp[n + 1 < CSEG ? n + 1 : n];
                dn_consume(lds + (n & 1) * DN_SBUF + lane * 16, wl, S, cd, p.out + O_ODN + (size_t)(b * SEQ + (n0 + n) * 64 + 4 * g4) * 512 + h * 128 + vs * 16 + r16);
                cd = cdn;
                DNS_BAR();
            }
        }
        DNS_BAR();
    }
}
#undef DNS_BAR
constexpr size_t WS_EDGE = WS_FREE;
constexpr size_t WS_HEAD = al256(WS_EDGE + (size_t)(T / 256) * 2 * 2 * DFF * 4);
constexpr size_t WS_END = al256(WS_HEAD + (size_t)(T / 256) * 2 * 2 * DFF * 4);
constexpr int EX_OFF = 131072;
namespace pg8 {
typedef unsigned u32x2v __attribute__((ext_vector_type(2)));
__device__ __forceinline__ float dpp_shr1(float old, float src) { return __builtin_bit_cast(float, __builtin_amdgcn_update_dpp(__builtin_bit_cast(int, old), __builtin_bit_cast(int, src), 0x111, 0xf, 0xf, false)); }
__device__ __forceinline__ float dpp_shr2(float old, float src) { return __builtin_bit_cast(float, __builtin_amdgcn_update_dpp(__builtin_bit_cast(int, old), __builtin_bit_cast(int, src), 0x112, 0xf, 0xf, false)); }
__device__ __forceinline__ float dpp_ror1(float src) { return __builtin_bit_cast(float, __builtin_amdgcn_update_dpp(0, __builtin_bit_cast(int, src), 0x121, 0xf, 0xf, false)); }
__device__ __forceinline__ float dpp_ror2(float src) { return __builtin_bit_cast(float, __builtin_amdgcn_update_dpp(0, __builtin_bit_cast(int, src), 0x122, 0xf, 0xf, false)); }
struct EpiFfnUp {
    static constexpr bool PERM = false, AFTER_DRAIN = false;
    bf16_t* ACT; float* edge; float* head; const float* cw; const float* cb; const float* state; float* out_pfc; float* out_sfc; PG8_LAS unsigned char* lds;
    __device__ __forceinline__ void operator()(const f32x4 (&acc)[2][2][4][2], const Unit& u, int wr, int wc, int fr, int fq) const {
        PG8_LAS float* EX = (PG8_LAS float*)(lds + EX_OFF);
        const bool smp = u.pm >= TP / BM;
        const int cl = wc * 32 + 4 * fq;
        if (fr >= 14) {
#pragma unroll
            for (int ai = 0; ai < 2; ++ai)
#pragma unroll
                for (int bj = 0; bj < 2; ++bj)
#pragma unroll
                    for (int n = 0; n < 2; ++n) *(PG8_LAS f32x4*)(EX + ((2 * ai + wr) * 2 + (fr - 14)) * 256 + bj * HALF + cl + 16 * n) = acc[ai][bj][3][n];
            if (wr == 1) {
#pragma unroll
                for (int bj = 0; bj < 2; ++bj)
#pragma unroll
                    for (int n = 0; n < 2; ++n) { const int oc = bj * DFF + u.pn * HALF + cl + 16 * n;
                        *(f32x4*)(edge + ((size_t)u.pm * 2 + (fr - 14)) * 2 * DFF + oc) = acc[1][bj][3][n];
                        if (!smp && (u.pm & (SEQ / BM - 1)) == SEQ / BM - 1) *(f32x4*)(out_pfc + ((size_t)(u.pm / (SEQ / BM)) * 2 + (fr - 14)) * 2 * DFF + oc) = acc[1][bj][3][n]; }
            }
        }
        if (fr < 2 && wr == 0) {
#pragma unroll
            for (int bj = 0; bj < 2; ++bj)
#pragma unroll
                for (int n = 0; n < 2; ++n) *(f32x4*)(head + ((size_t)u.pm * 2 + fr) * 2 * DFF + bj * DFF + u.pn * HALF + cl + 16 * n) = acc[0][bj][0][n];
        }
        asm volatile("s_waitcnt lgkmcnt(0)" ::: "memory"); __builtin_amdgcn_s_barrier(); asm volatile("" ::: "memory");
#pragma unroll
        for (int n = 0; n < 2; ++n) {
            const int f0 = u.pn * HALF + cl + 16 * n;
            f32x4 wg[3], wu[3], bg, bu;
#pragma unroll
            for (int j = 0; j < 3; ++j) { wg[j] = *(const f32x4*)(cw + (size_t)j * 2 * DFF + f0); wu[j] = *(const f32x4*)(cw + (size_t)j * 2 * DFF + DFF + f0); }
            bg = *(const f32x4*)(cb + f0); bu = *(const f32x4*)(cb + DFF + f0);
#pragma unroll
            for (int ai = 0; ai < 2; ++ai) {
                const int s = 2 * ai + wr;
                f32x4 pg = (f32x4){0.f, 0.f, 0.f, 0.f}, pu = pg;
                if (!smp && s > 0 && fr >= 14) { pg = *(const PG8_LAS f32x4*)(EX + ((s - 1) * 2 + (fr - 14)) * 256 + cl + 16 * n); pu = *(const PG8_LAS f32x4*)(EX + ((s - 1) * 2 + (fr - 14)) * 256 + HALF + cl + 16 * n); }
#pragma unroll
                for (int m = 0; m < 4; ++m) {
                    const f32x4 cg = acc[ai][0][m][n], cu = acc[ai][1][m][n];
                    const int row = u.pm * BM + ai * HALF + wr * 64 + m * 16 + fr;
                    f32x4 g1, g2, u1, u2;
#pragma unroll
                    for (int e = 0; e < 4; ++e) { g1[e] = dpp_shr1(dpp_ror1(pg[e]), cg[e]); g2[e] = dpp_shr2(dpp_ror2(pg[e]), cg[e]); u1[e] = dpp_shr1(dpp_ror1(pu[e]), cu[e]); u2[e] = dpp_shr2(dpp_ror2(pu[e]), cu[e]); }
                    if (smp) {
                        const int t = fr & 7, b = (row - TP) >> 3;
                        if (t < 2) { const float* st = state + (size_t)b * 2 * 2 * DFF + f0; const f32x4 s1g = *(const f32x4*)(st + 2 * DFF), s1u = *(const f32x4*)(st + 2 * DFF + DFF);
                            if (t == 0) { g1 = s1g; u1 = s1u; g2 = *(const f32x4*)st; u2 = *(const f32x4*)(st + DFF); } else { g2 = s1g; u2 = s1u; } }
                        if (t >= 6) { float* o = out_sfc + ((size_t)b * 2 + (t - 6)) * 2 * DFF + f0; *(f32x4*)o = cg; *(f32x4*)(o + DFF) = cu; }
                    }
                    const f32x4 gc = wg[0] * g2 + wg[1] * g1 + wg[2] * cg + bg, uc = wu[0] * u2 + wu[1] * u1 + wu[2] * cu + bu;
                    u32x2v w;
                    { const float a0 = gc[0] * uc[0] * __builtin_amdgcn_rcpf(1.0f + __expf(-gc[0])), a1 = gc[1] * uc[1] * __builtin_amdgcn_rcpf(1.0f + __expf(-gc[1])), a2 = gc[2] * uc[2] * __builtin_amdgcn_rcpf(1.0f + __expf(-gc[2])), a3 = gc[3] * uc[3] * __builtin_amdgcn_rcpf(1.0f + __expf(-gc[3]));
                      w.x = cvt_pk_bf16(a0, a1); w.y = cvt_pk_bf16(a2, a3); }
                    *(u32x2v*)(ACT + (size_t)row * DFF + f0) = w;
                    pg = cg; pu = cu;
                }
            }
        }
    }
};
}
__device__ __forceinline__ void phase_ffn_fix(const P& p) {
    constexpr int TPS = SEQ / 256;
    const long n = (long)(BATCH * TPS) * DFF;
    const float* edge = ws_f(p, WS_EDGE); const float* head = ws_f(p, WS_HEAD);
    for (long i = blockIdx.x * (long)NTHR + otid(); i < n; i += (long)gridDim.x * NTHR) {
        const int pm = (int)(i / DFF), f = (int)(i % DFF);
        if (pm % TPS == 0) continue;
        float r0[2], r1[2];
#pragma unroll
        for (int gu = 0; gu < 2; ++gu) { const int c = gu * DFF + f;
            const float um2 = edge[((size_t)(pm - 1) * 2 + 0) * 2 * DFF + c], um1 = edge[((size_t)(pm - 1) * 2 + 1) * 2 * DFF + c], u0 = head[((size_t)pm * 2 + 0) * 2 * DFF + c], u1 = head[((size_t)pm * 2 + 1) * 2 * DFF + c];
            const float w0 = p.ffn_conv_w[c], w1 = p.ffn_conv_w[2 * DFF + c], w2 = p.ffn_conv_w[4 * DFF + c], bb = p.ffn_conv_b[c];
            r0[gu] = w0 * um2 + w1 * um1 + w2 * u0 + bb; r1[gu] = w0 * um1 + w1 * u0 + w2 * u1 + bb; }
        bf16_t* ACT = ws_h(p, WS_ACT) + (size_t)pm * 256 * DFF + f;
        ACT[0] = f2bf(silu_f(r0[0]) * r0[1]); ACT[DFF] = f2bf(silu_f(r1[0]) * r1[1]);
    }
}
constexpr int SW_KP = 72;
__device__ __forceinline__ void swa_bias(const LAS float* BT, int lane, float (&bv)[9][4]) {
    const int r16 = lane & 15, g4 = lane >> 4;
#pragma unroll
    for (int t = 0; t < 9; ++t)
#pragma unroll
        for (int e = 0; e < 4; ++e) { const int d = 128 + r16 - 16 * t - 4 * g4 - e; bv[t][e] = (d >= 0 && d <= 127) ? BT[d] * 1.4426950408889634f : -1e30f; }
}
__device__ __forceinline__ void swa_qtile(const LAS bf16_t* KS, const LAS bf16_t* VT, int vtp, int qt, const bf16x8 (&bq)[2], const float (&bv)[9][4], float sink2, bool first, bf16_t* optr, int nvalid_q, int lane) {
    const int r16 = lane & 15, g4 = lane >> 4, kt0 = qt;
    f32x4 s[10];
#pragma unroll
    for (int tb = 0; tb < 2; ++tb) {
        bf16x8 ka[5][2];
#pragma unroll
        for (int t = 0; t < 5; ++t)
#pragma unroll
            for (int ks = 0; ks < 2; ++ks) if (5 * tb + t < 9) ka[t][ks] = *(const LAS bf16x8*)(KS + (16 * (kt0 + 5 * tb + t) + r16) * SW_KP + 32 * ks + 8 * g4);
        __builtin_amdgcn_sched_barrier(0);
#pragma unroll
        for (int t = 0; t < 5; ++t) if (5 * tb + t < 9) { f32x4 a = (f32x4){0.f, 0.f, 0.f, 0.f};
#pragma unroll
            for (int ks = 0; ks < 2; ++ks) a = __builtin_amdgcn_mfma_f32_16x16x32_bf16(ka[t][ks], bq[ks], a, 0, 0, 0);
            s[5 * tb + t] = a; }
        __builtin_amdgcn_sched_barrier(0);
    }
    float mx = sink2;
#pragma unroll
    for (int t = 0; t < 9; ++t)
#pragma unroll
        for (int e = 0; e < 4; ++e) { float v = s[t][e] * 0.18033688011112042f + bv[t][e]; if (first && 16 * (kt0 + t) + 4 * g4 + e < 128) v = -1e30f; s[t][e] = v; mx = fmaxf(mx, v); }
    mx = fmaxf(mx, __shfl_xor(mx, 16)); mx = fmaxf(mx, __shfl_xor(mx, 32));
    float l = 0.f;
#pragma unroll
    for (int t = 0; t < 9; ++t)
#pragma unroll
        for (int e = 0; e < 4; ++e) { const float pv = __builtin_amdgcn_exp2f(s[t][e] - mx); s[t][e] = pv; l += pv; }
    s[9] = (f32x4){0.f, 0.f, 0.f, 0.f};
    l += __shfl_xor(l, 16); l += __shfl_xor(l, 32);
    l += __builtin_amdgcn_exp2f(sink2 - mx);
    const float rl = __builtin_amdgcn_rcpf(l);
    bf16x8 pb[5];
#pragma unroll
    for (int q = 0; q < 5; ++q) pb[q] = pack8(s[2 * q], s[2 * q + 1]);
#pragma unroll
    for (int dp = 0; dp < 2; ++dp) {
        u32x2 vl[2][5], vh[2][5];
#pragma unroll
        for (int d2 = 0; d2 < 2; ++d2)
#pragma unroll
            for (int q = 0; q < 5; ++q) { const LAS bf16_t* vp = VT + (16 * (2 * dp + d2) + r16) * vtp + 16 * (kt0 + 2 * q) + 4 * g4; vl[d2][q] = *(const LAS u32x2*)vp; vh[d2][q] = *(const LAS u32x2*)(vp + 16); }
        __builtin_amdgcn_sched_barrier(0);
#pragma unroll
        for (int d2 = 0; d2 < 2; ++d2) { const int dt = 2 * dp + d2; f32x4 o = (f32x4){0.f, 0.f, 0.f, 0.f};
#pragma unroll
            for (int q = 0; q < 5; ++q) o = __builtin_amdgcn_mfma_f32_16x16x32_bf16(__builtin_bit_cast(bf16x8, (u32x4){vl[d2][q].x, vl[d2][q].y, vh[d2][q].x, vh[d2][q].y}), pb[q], o, 0, 0, 0);
            if (r16 < nvalid_q) *(u32x2*)(optr + (size_t)r16 * 1024 + 16 * dt + 4 * g4) = (u32x2){cvtpk_c(o[0] * rl, o[1] * rl), cvtpk_c(o[2] * rl, o[3] * rl)}; }
        __builtin_amdgcn_sched_barrier(0);
    }
}
constexpr int SWP_VTP = 272, SWS_NK = 144, SWS_VTP = 168;
constexpr int SW_KS = 0, SW_VT = 43008, SW_BT = 86016, SW_END = SW_BT + 8 * 128 * 4;
static_assert(256 * SW_KP * 2 <= SW_VT && SW_VT + 64 * SWP_VTP * 2 <= SW_BT && SWS_NK * SW_KP * 2 <= SW_VT && SW_VT + 64 * SWS_VTP * 2 <= SW_BT, "swa LDS map");
__device__ __forceinline__ void phase_swa(const P& p, LAS unsigned char* lds, unsigned long long& pr_prev, unsigned long long& pr_acc) {
    const int tid = otid(), lane = tid & 63, wave = tid >> 6;
    LAS bf16_t* KS = (LAS bf16_t*)(lds + SW_KS); LAS bf16_t* VT = (LAS bf16_t*)(lds + SW_VT); LAS float* BT = (LAS float*)(lds + SW_BT);
    const bf16_t* PR = ws_h(p, WS_PROJ); bf16_t* MX = ws_h(p, WS_MIX);
    constexpr int NQB = SEQ / 128, NPU = BATCH * NQB * 2, NU = NPU + DEC_BATCH * 2;
    for (int i = tid; i < 8 * 128; i += NTHR) BT[i] = p.rel_bias[t5_bucket(i & 127) * 8 + (i >> 7)];
    for (int u = blockIdx.x; u < NU; u += gridDim.x) {
        __syncthreads(); DPS(22);
        if (u < NPU) {
            const int kvh = u & 1, qb = (u >> 1) % NQB, b = (u >> 1) / NQB, m0 = b * SEQ + qb * 128; const bool first = qb == 0;
            const bf16_t* qbase = PR + (size_t)(m0 + 64 * (wave & 1) + (lane & 15)) * PLD + PC_SQ + (kvh * 4 + (wave >> 1)) * 64 + 8 * (lane >> 4);
            bf16x8 bq[2], bqn[2];
#pragma unroll
            for (int ks = 0; ks < 2; ++ks) bq[ks] = *(const bf16x8*)(qbase + 32 * ks);
            {
                u32x4 kr[4], vr[5];
#pragma unroll
                for (int i = 0; i < 4; ++i) { const int it = tid + i * NTHR, jj = it >> 3, c = it & 7; kr[i] = (u32x4){0u, 0u, 0u, 0u};
                    if (!(first && jj < 128)) kr[i] = *(const u32x4*)(PR + (size_t)(m0 - 128 + jj) * PLD + PC_SK + kvh * 64 + 8 * c); }
#pragma unroll
                for (int i = 0; i < 5; ++i) { const int it = tid + i * NTHR, jj = it % 272, c = it / 272; vr[i] = (u32x4){0u, 0u, 0u, 0u};
                    if (it < 272 * 8 && jj < 256 && !(first && jj < 128)) vr[i] = *(const u32x4*)(PR + (size_t)(m0 - 128 + jj) * PLD + PC_SV + kvh * 64 + 8 * c); }
#pragma unroll
                for (int i = 0; i < 4; ++i) { const int it = tid + i * NTHR, jj = it >> 3, c = it & 7; *(LAS u32x4*)(KS + jj * SW_KP + 8 * c) = kr[i]; }
#pragma unroll
                for (int i = 0; i < 5; ++i) { const int it = tid + i * NTHR, jj = it % 272, c = it / 272;
                    if (it < 272 * 8) { const unsigned w[4] = {vr[i].x, vr[i].y, vr[i].z, vr[i].w};
#pragma unroll
                        for (int e = 0; e < 4; ++e) { VT[(8 * c + 2 * e) * SWP_VTP + jj] = (bf16_t)(w[e] & 0xffffu); VT[(8 * c + 2 * e + 1) * SWP_VTP + jj] = (bf16_t)(w[e] >> 16); } } }
            }
            __syncthreads(); DPS(23);
            const int hq = kvh * 4 + (wave >> 1), qh = wave & 1, r16 = lane & 15, g4 = lane >> 4;
            float bv[9][4]; swa_bias(BT + hq * 128, lane, bv);
            const float sink2 = p.swa_sinks[hq] * 1.4426950408889634f;
#pragma unroll 1
            for (int q4 = 0; q4 < 4; ++q4) { const int qt = 4 * qh + q4;
                if (q4 < 3) {
#pragma unroll
                    for (int ks = 0; ks < 2; ++ks) bqn[ks] = *(const bf16x8*)(qbase + (size_t)(16 * (q4 + 1)) * PLD + 32 * ks); }
                swa_qtile(KS, VT, SWP_VTP, qt, bq, bv, sink2, first, MX + (size_t)(m0 + 16 * qt) * 1024 + 512 + hq * 64, 16, lane);
                bq[0] = bqn[0]; bq[1] = bqn[1]; }
            DPS(24);
        } else {
            const int su = u - NPU, b = su >> 1, kvh = su & 1, m0 = TP + b * DEC_SEQ;
            bf16x8 bqs[2];
#pragma unroll
            for (int ks = 0; ks < 2; ++ks) bqs[ks] = *(const bf16x8*)(PR + (size_t)(m0 + (lane & 7)) * PLD + PC_SQ + (kvh * 4 + (wave & 3)) * 64 + 32 * ks + 8 * (lane >> 4));
            {
                f32x4 ka[3][2], va[3][2]; u32x4 kn[3], vn[3];
#pragma unroll
                for (int i = 0; i < 3; ++i) { const int it = tid + i * NTHR, jj = it >> 3, c = it & 7;
                    ka[i][0] = ka[i][1] = (f32x4){0.f, 0.f, 0.f, 0.f}; kn[i] = (u32x4){0u, 0u, 0u, 0u};
                    if (it < SWS_NK * 8) { if (jj < 128) { const float* src = p.cache_k + ((size_t)b * 128 + jj) * 128 + kvh * 64 + 8 * c; ka[i][0] = *(const f32x4*)src; ka[i][1] = *(const f32x4*)(src + 4); }
                        else if (jj < 128 + DEC_SEQ) kn[i] = *(const u32x4*)(PR + (size_t)(m0 + jj - 128) * PLD + PC_SK + kvh * 64 + 8 * c); } }
#pragma unroll
                for (int i = 0; i < 3; ++i) { const int it = tid + i * NTHR, jj = it % SWS_VTP, c = it / SWS_VTP;
                    va[i][0] = va[i][1] = (f32x4){0.f, 0.f, 0.f, 0.f}; vn[i] = (u32x4){0u, 0u, 0u, 0u};
                    if (it < SWS_VTP * 8) { if (jj < 128) { const float* src = p.cache_v + ((size_t)b * 128 + jj) * 128 + kvh * 64 + 8 * c; va[i][0] = *(const f32x4*)src; va[i][1] = *(const f32x4*)(src + 4); }
                        else if (jj < 128 + DEC_SEQ) vn[i] = *(const u32x4*)(PR + (size_t)(m0 + jj - 128) * PLD + PC_SV + kvh * 64 + 8 * c); } }
#pragma unroll
                for (int i = 0; i < 3; ++i) { const int it = tid + i * NTHR, jj = it >> 3, c = it & 7;
                    if (it < SWS_NK * 8) { u32x4 v = kn[i]; if (jj < 128) v = (u32x4){cvtpk_c(ka[i][0][0], ka[i][0][1]), cvtpk_c(ka[i][0][2], ka[i][0][3]), cvtpk_c(ka[i][1][0], ka[i][1][1]), cvtpk_c(ka[i][1][2], ka[i][1][3])};
                        *(LAS u32x4*)(KS + jj * SW_KP + 8 * c) = v; } }
#pragma unroll
                for (int i = 0; i < 3; ++i) { const int it = tid + i * NTHR, jj = it % SWS_VTP, c = it / SWS_VTP;
                    if (it < SWS_VTP * 8) { u32x4 v = vn[i]; if (jj < 128) v = (u32x4){cvtpk_c(va[i][0][0], va[i][0][1]), cvtpk_c(va[i][0][2], va[i][0][3]), cvtpk_c(va[i][1][0], va[i][1][1]), cvtpk_c(va[i][1][2], va[i][1][3])};
                        const unsigned w[4] = {v.x, v.y, v.z, v.w};
#pragma unroll
                        for (int e = 0; e < 4; ++e) { VT[(8 * c + 2 * e) * SWS_VTP + jj] = (bf16_t)(w[e] & 0xffffu); VT[(8 * c + 2 * e + 1) * SWS_VTP + jj] = (bf16_t)(w[e] >> 16); } } }
            }
            __syncthreads(); DPS(25);
            if (wave < 4) { const int hq = kvh * 4 + wave;
                float bv[9][4]; swa_bias(BT + hq * 128, lane, bv);
                swa_qtile(KS, VT, SWS_VTP, 0, bqs, bv, p.swa_sinks[hq] * 1.4426950408889634f, false, MX + (size_t)m0 * 1024 + 512 + hq * 64, 8, lane); }
        }
    }
    __syncthreads();
}
static void fill_params(P& p, void* const* d_in, void* d_out, void* d_ws) {
    const float** pp = (const float**)&p;
    for (int i = 0; i < 26; ++i) pp[i] = (const float*)d_in[i];
    p.out = (float*)d_out; p.ws = (unsigned char*)d_ws;
}
namespace cg = cooperative_groups;
constexpr int CW_BAR = 1024;
constexpr size_t CTL_ZERO_BYTES = 65536;

#ifndef PROBE_MASK
#define PROBE_MASK 0
#endif
#ifndef PROBE_K
#define PROBE_K 4
#endif
#ifndef PROBE_XSYNC
#define PROBE_XSYNC 0
#endif
#if PROBE_MASK
#define PROBE_SUB(k) do { xcd_barrier(bar); PROBE_STAMP(k); } while (0)
#define PROBE_DECL unsigned long long pr_prev = __builtin_amdgcn_s_memrealtime(), pr_acc = 0ull
#define PROBE_STAMP(k) do { const unsigned long long now_ = __builtin_amdgcn_s_memrealtime(); if ((PROBE_MASK >> (k)) & 1) pr_acc += now_ - pr_prev; pr_prev = now_; } while (0)
#define PROBE_END() do { xcd_barrier(bar); PROBE_STAMP(11); if (blockIdx.x == 0 && __builtin_amdgcn_mbcnt_hi(~0u, __builtin_amdgcn_mbcnt_lo(~0u, 0u)) == 0u) { const unsigned long long t0_ = __builtin_amdgcn_s_memrealtime(); while (__builtin_amdgcn_s_memrealtime() - t0_ < (unsigned long long)PROBE_K * pr_acc) __builtin_amdgcn_s_sleep(8); } } while (0)
#else
#define PROBE_DECL unsigned long long pr_prev = 0ull, pr_acc = 0ull
#define PROBE_SUB(k)
#define PROBE_STAMP(k)
#define PROBE_END() do { for (int i_ = 0; i_ < PROBE_XSYNC; ++i_) xcd_barrier(bar); } while (0)
#endif
__global__ void __launch_bounds__(512, 2) fwd_megakernel(P p) {
    extern __shared__ __attribute__((aligned(16))) unsigned char lds_raw[];
    LAS unsigned char* lds = (LAS unsigned char*)lds_raw;
    cg::grid_group grid = cg::this_grid();
    PROBE_DECL;
    volatile LAS unsigned* MISC = (volatile LAS unsigned*)(lds + LDS_BYTES - 64);
    if (threadIdx.x < 16) MISC[threadIdx.x] = 0u;
    __syncthreads();
    const XcdBarrier bar = xcd_barrier_post((unsigned*)(p.ws + WS_CTL) + CW_BAR, MISC);
    phase_mod(p, lds); phase_transposes(p, lds);
    if (p.ws == nullptr) grid.sync();
    xcd_barrier(bar); PROBE_STAMP(0);
    phase_norm<0>(p, lds);
    xcd_barrier(bar); PROBE_STAMP(1);
    { pg8::StaticOrder S; pg8::Gemm g{ws_h(p, WS_H), ws_h(p, WS_WT_IN), T, PLD, D}; S.init(T, PLD, gridDim.x, blockIdx.x, D); pg8::EpiStoreBf16 E{ws_h(p, WS_PROJ), PLD};
      pg8::gemm_phase<pg8::EpiStoreBf16, pg8::StaticOrder, true, true>(lds, g, S, E); }
    xcd_barrier(bar); PROBE_STAMP(2);
    phase_state_out(p);
    PROBE_STAMP(21);
    phase_dnprep(p, lds, pr_prev, pr_acc);
    PROBE_SUB(12);
    phase_dnsample(p, lds, pr_prev, pr_acc);
    PROBE_SUB(13);
    phase_swa(p, lds, pr_prev, pr_acc);
    xcd_barrier(bar); PROBE_STAMP(3);
    phase_dns_passA(p, lds);
    xcd_barrier(bar); PROBE_STAMP(14);
    phase_dns_passB(p, lds);
    xcd_barrier(bar); PROBE_STAMP(15);
    phase_dns_passC(p, lds);
    xcd_barrier(bar); PROBE_STAMP(4);
    phase_dngate(p);
    xcd_barrier(bar); PROBE_STAMP(5);
    { pg8::SplitOrder S; pg8::Gemm g{ws_h(p, WS_MIX), ws_h(p, WS_WT_OUT), T, D, 1024}; S.init(D, 1024, NS_OUT, gridDim.x, blockIdx.x); pg8::EpiGateRes<0> E{p.x_prompt, p.x_sample, ws_h(p, WS_XB), ws_f(p, WS_MOD) + 2 * D, p.out + O_Y, NS_OUT};
      pg8::gemm_phase<pg8::EpiGateRes<0>, pg8::SplitOrder, true, true>(lds, g, S, E); }
    xcd_barrier(bar); PROBE_STAMP(6);
    phase_norm<1>(p, lds);
    xcd_barrier(bar); PROBE_STAMP(7);
    { pg8::StaticOrder S; pg8::Gemm g{ws_h(p, WS_H), ws_h(p, WS_WT_UP), T, 2 * DFF, D}; S.init(T, 2 * DFF, gridDim.x, blockIdx.x, D);
      pg8::EpiFfnUp E{ws_h(p, WS_ACT), ws_f(p, WS_EDGE), ws_f(p, WS_HEAD), p.ffn_conv_w, p.ffn_conv_b, p.state_ffn, p.out + O_PFC, p.out + O_SFC, lds};
      pg8::gemm_phase<pg8::EpiFfnUp, pg8::StaticOrder, true, true>(lds, g, S, E); }
    xcd_barrier(bar); PROBE_STAMP(8);
    phase_ffn_fix(p);
    xcd_barrier(bar); PROBE_STAMP(9);
    { pg8::SplitOrder S; pg8::Gemm g{ws_h(p, WS_ACT), ws_h(p, WS_WT_DN), T, D, DFF}; S.init(D, DFF, NS_DN, gridDim.x, blockIdx.x); pg8::EpiGateRes<1> E{nullptr, nullptr, ws_h(p, WS_XB), ws_f(p, WS_MOD) + 5 * D, ws_f(p, WS_SLAB_DN), NS_DN};
      pg8::gemm_phase<pg8::EpiGateRes<1>, pg8::SplitOrder, true, true>(lds, g, S, E); }
    xcd_barrier(bar); PROBE_STAMP(10);
    phase_norm<2>(p, lds);
    PROBE_END();
}
extern "C" void kernel_launch(void* const* d_in, const int* in_sizes, int n_in, void* d_out, int out_size, void* d_ws, size_t ws_size, hipStream_t stream) {
    static int grid_blocks = 0;
    if (grid_blocks == 0) {
        if (n_in != 26 || (long)out_size != O_END || ws_size < WS_END) { fprintf(stderr, "kernel_launch: unexpected shapes n_in=%d out=%d ws=%zu (need %zu)\n", n_in, out_size, ws_size, (size_t)WS_END); grid_blocks = -1; return; }
        int dev = 0, cus = 0, per_cu = 0;
        if (hipGetDevice(&dev) != hipSuccess || hipDeviceGetAttribute(&cus, hipDeviceAttributeMultiprocessorCount, dev) != hipSuccess) { grid_blocks = -1; return; }
        if (hipFuncSetAttribute((const void*)fwd_megakernel, hipFuncAttributeMaxDynamicSharedMemorySize, LDS_BYTES) != hipSuccess) { fprintf(stderr, "kernel_launch: hipFuncSetAttribute failed\n"); grid_blocks = -1; return; }
        if (hipOccupancyMaxActiveBlocksPerMultiprocessor(&per_cu, (const void*)fwd_megakernel, NTHR, LDS_BYTES) != hipSuccess || per_cu < 1) { fprintf(stderr, "kernel_launch: occupancy query says %d\n", per_cu); grid_blocks = -1; return; }
        grid_blocks = cus;
        fprintf(stderr, "kernel_launch: grid %d (cus %d, per_cu %d)\n", grid_blocks, cus, per_cu);
    }
    if (grid_blocks < 0) return;
    P p{}; fill_params(p, d_in, d_out, d_ws);
    if (hipMemsetAsync((char*)d_ws + WS_CTL, 0, CTL_ZERO_BYTES, stream) != hipSuccess) { fprintf(stderr, "kernel_launch: memset of the control words failed\n"); return; }
    void* args[] = {&p};
    const hipError_t e = hipLaunchCooperativeKernel((const void*)fwd_megakernel, dim3(grid_blocks), dim3(NTHR), args, LDS_BYTES, stream);
    if (e != hipSuccess) fprintf(stderr, "cooperative launch failed: %s (grid %d)\n", hipGetErrorString(e), grid_blocks);
}
```

```cpp
#define PROBE_MASK 0
#define PROBE_XSYNC 0
#include <hip/hip_runtime.h>
#include <hip/hip_cooperative_groups.h>
#include <cstdio>
#include <cstdint>
#define HD __device__ __forceinline__
#if defined(PROBE_MASK) && PROBE_MASK
#define DPS(k) do { const unsigned long long now_ = __builtin_amdgcn_s_memrealtime(); if ((PROBE_MASK >> (k)) & 1) pr_acc += now_ - pr_prev; pr_prev = now_; } while (0)
#endif
#ifndef CFG_D_MODEL
#define CFG_D_MODEL 1024
#endif
#ifndef CFG_SEQ
#define CFG_SEQ 8192
#endif
#ifndef CFG_DEC_BATCH
#define CFG_DEC_BATCH 128
#endif
#ifndef CFG_D_FF
#define CFG_D_FF 2816
#endif

constexpr int D = CFG_D_MODEL, BATCH = 2, SEQ = CFG_SEQ, DEC_BATCH = CFG_DEC_BATCH, DEC_SEQ = 8, DFF = CFG_D_FF;
constexpr int TP = BATCH * SEQ, TS = DEC_BATCH * DEC_SEQ, T = TP + TS, NCB = BATCH + DEC_BATCH;
constexpr int IN_COLS = 2824, PLD = 2816;
constexpr int PC_QKV = 0, PC_Z = 1536, PC_SQ = 2048, PC_SK = 2560, PC_SV = 2688;
constexpr int WC_BA = 2048;
constexpr float EPS = 1e-6f;

constexpr long O_Y = 0;
constexpr long O_PDC = (long)T * D;
constexpr long O_SDC = O_PDC + (long)BATCH * 3 * 1536;
constexpr long O_PSSM = O_SDC + (long)DEC_BATCH * 3 * 1536;
constexpr long O_SSSM = O_PSSM + (long)BATCH * 4 * 128 * 128;
constexpr long O_PK = O_SSSM + (long)DEC_BATCH * 4 * 128 * 128;
constexpr long O_SK = O_PK + (long)BATCH * 128 * 128;
constexpr long O_PV = O_SK + (long)DEC_BATCH * 128 * 128;
constexpr long O_SV = O_PV + (long)BATCH * 128 * 128;
constexpr long O_PFC = O_SV + (long)DEC_BATCH * 128 * 128;
constexpr long O_SFC = O_PFC + (long)BATCH * 2 * 2 * DFF;
constexpr long O_END = O_SFC + (long)DEC_BATCH * 2 * 2 * DFF;

constexpr size_t al256(size_t x) { return (x + 255) & ~(size_t)255; }
constexpr size_t WS_CTL = 0;
constexpr size_t WS_MOD = 1u << 20;
constexpr size_t WS_BG = al256(WS_MOD + (size_t)NCB * 6 * D * 4);
constexpr size_t WS_WBAT = al256(WS_BG + (size_t)T * 8 * 4);
constexpr size_t WS_WT_IN = al256(WS_WBAT + (size_t)8 * D * 4);
constexpr size_t WS_WT_OUT = al256(WS_WT_IN + (size_t)PLD * D * 2);
constexpr size_t WS_WT_UP = al256(WS_WT_OUT + (size_t)D * 1024 * 2);
constexpr size_t WS_WT_DN = al256(WS_WT_UP + (size_t)2 * DFF * D * 2);
constexpr size_t WS_H = al256(WS_WT_DN + (size_t)D * DFF * 2);
constexpr int NCHUNK = SEQ / 64, NUNIT = BATCH * 4 * NCHUNK;
constexpr int DNF_AB_UNIT = 57344, DNF_WV_UNIT = 32768;
constexpr size_t WS_DNF_WV = WS_H;
constexpr size_t WS_DNF_AB = al256(WS_H + (size_t)T * (D > 1024 ? D : 1024) * 2);
constexpr size_t WS_DNF_CD = al256(WS_DNF_AB + (size_t)NUNIT * DNF_AB_UNIT);
constexpr size_t WS_QKVC = WS_DNF_AB;
constexpr size_t WS_PROJ = al256((WS_DNF_CD + (size_t)NUNIT * 4) > (WS_QKVC + (size_t)T * 1536 * 2) ? (WS_DNF_CD + (size_t)NUNIT * 4) : (WS_QKVC + (size_t)T * 1536 * 2));
constexpr size_t WS_MIX = al256(WS_PROJ + (size_t)T * PLD * 2);
constexpr size_t WS_FREE = al256(WS_MIX + (size_t)T * 1024 * 2);
constexpr size_t WS_ODN = WS_H, WS_ACT = WS_PROJ;
static_assert((size_t)NUNIT * DNF_WV_UNIT <= (size_t)T * 1024 * 2, "Wv tiles overlay H");

typedef unsigned short bf16_t;
HD unsigned f2bf_bits(float f) { unsigned u = __builtin_bit_cast(unsigned, f); return (u + 0x7fffu + ((u >> 16) & 1u)) >> 16; }
HD bf16_t f2bf(float f) { return (bf16_t)f2bf_bits(f); }
HD float bf2f(bf16_t b) { return __builtin_bit_cast(float, (unsigned)b << 16); }
HD float silu_f(float x) { return x / (1.0f + expf(-x)); }
HD float sigmoid_f(float x) { return 1.0f / (1.0f + expf(-x)); }
HD float softplus_f(float x) { return x > 20.f ? x : log1pf(expf(x)); }

struct P {
    const float *x_prompt, *x_sample, *state_dn_conv, *state_dn_ssm, *cache_k, *cache_v, *state_ffn, *c_prompt, *c_sample, *rel_bias,
        *final_norm_w, *w_ada, *b_ada, *norm_mix_w, *w_in, *dn_conv_w, *dn_A_log, *dn_dt_bias, *dn_norm_w, *swa_sinks, *w_out, *norm_ffn_w,
        *w_up, *ffn_conv_w, *ffn_conv_b, *w_down;
    float* out; unsigned char* ws;
};

HD const float* xrow(const P& p, int m) { return m < TP ? p.x_prompt + (size_t)m * D : p.x_sample + (size_t)(m - TP) * D; }
HD int cb_of(int m) { return m < TP ? m / SEQ : BATCH + (m - TP) / DEC_SEQ; }
HD int t_of(int m) { return m < TP ? m % SEQ : (m - TP) % DEC_SEQ; }
HD float* ws_f(const P& p, size_t off) { return (float*)(p.ws + off); }
HD bf16_t* ws_h(const P& p, size_t off) { return (bf16_t*)(p.ws + off); }

HD int t5_bucket(int d) {
    if (d < 16) return d;
    const float logv = logf((float)d / 16.0f) / 2.0794415416798357f;
    int b = 16 + (int)(logv * 16.0f);
    return b < 31 ? b : 31;
}

constexpr long N_R0A = (long)NCB * 6 * D;
HD void r0a_body(long idx, const P& p) {
    const int cb = (int)(idx / (6 * D)), e = (int)(idx % (6 * D));
    const float* c = cb < BATCH ? p.c_prompt + (size_t)cb * D : p.c_sample + (size_t)(cb - BATCH) * D;
    float acc = 0.f;
    for (int d = 0; d < D; ++d) acc += silu_f(c[d]) * p.w_ada[(size_t)d * 6 * D + e];
    ws_f(p, WS_MOD)[idx] = acc + p.b_ada[e];
}
constexpr long N_R1 = T;
template <int WHICH> HD void r1_body(long idx, const P& p) {
    const int m = (int)idx, cb = cb_of(m);
    const float* xr = WHICH == 0 ? xrow(p, m) : p.out + O_Y + (size_t)m * D;
    const float* nw = WHICH == 0 ? p.norm_mix_w : p.norm_ffn_w;
    const float* mod = ws_f(p, WS_MOD) + (size_t)cb * 6 * D;
    const float* sh = mod + (WHICH == 0 ? 0 : 3 * D); const float* sc = mod + (WHICH == 0 ? D : 4 * D);
    float ss = 0.f;
    for (int k = 0; k < D; ++k) ss += xr[k] * xr[k];
    const float rstd = 1.0f / sqrtf(ss / (float)D + EPS);
    float ba[8];
#pragma unroll
    for (int j = 0; j < 8; ++j) ba[j] = 0.f;
    bf16_t* H = ws_h(p, WS_H) + (size_t)m * D;
    for (int k = 0; k < D; ++k) {
        const float h = xr[k] * rstd * nw[k] * (1.0f + sc[k]) + sh[k];
        H[k] = f2bf(h);
        if (WHICH == 0) {
#pragma unroll
            for (int j = 0; j < 8; ++j) ba[j] += h * p.w_in[(size_t)k * IN_COLS + WC_BA + j];
        }
    }
    if (WHICH == 0) {
        float* bg = ws_f(p, WS_BG) + (size_t)m * 8;
#pragma unroll
        for (int j = 0; j < 4; ++j) {
            bg[j] = sigmoid_f(ba[j]);
            bg[4 + j] = -expf(p.dn_A_log[j]) * softplus_f(ba[4 + j] + p.dn_dt_bias[j]);
        }
    }
}
constexpr long N_R2 = (long)(T / 8) * PLD;
HD void r2_body(long idx, const P& p) {
    const int mg = (int)(idx / PLD), n = (int)(idx % PLD), oc = n < WC_BA ? n : n + 8;
    const bf16_t* H = ws_h(p, WS_H) + (size_t)mg * 8 * D;
    float acc[8];
#pragma unroll
    for (int i = 0; i < 8; ++i) acc[i] = 0.f;
    for (int k = 0; k < D; ++k) {
        const float w = bf2f(f2bf(p.w_in[(size_t)k * IN_COLS + oc]));
#pragma unroll
        for (int i = 0; i < 8; ++i) acc[i] += bf2f(H[(size_t)i * D + k]) * w;
    }
    bf16_t* PR = ws_h(p, WS_PROJ);
#pragma unroll
    for (int i = 0; i < 8; ++i) PR[(size_t)(mg * 8 + i) * PLD + n] = f2bf(acc[i]);
}
constexpr long N_R2B_1 = (long)BATCH * 3 * 1536, N_R2B_2 = (long)DEC_BATCH * 3 * 1536, N_R2B_3 = (long)BATCH * 128 * 128, N_R2B_4 = (long)DEC_BATCH * 128 * 128;
constexpr long N_R2B = N_R2B_1 + N_R2B_2 + 2 * (N_R2B_3 + N_R2B_4);
HD void r2b_body(long idx, const P& p) {
    const bf16_t* PR = ws_h(p, WS_PROJ);
    long r = idx;
    if (r < N_R2B_1) { const int b = (int)(r / (3 * 1536)), j = (int)(r / 1536 % 3), c = (int)(r % 1536);
        p.out[O_PDC + r] = bf2f(PR[(size_t)(b * SEQ + SEQ - 3 + j) * PLD + PC_QKV + c]); return; }
    r -= N_R2B_1;
    if (r < N_R2B_2) { const int b = (int)(r / (3 * 1536)), j = (int)(r / 1536 % 3), c = (int)(r % 1536);
        p.out[O_SDC + r] = bf2f(PR[(size_t)(TP + b * DEC_SEQ + DEC_SEQ - 3 + j) * PLD + PC_QKV + c]); return; }
    r -= N_R2B_2;
    for (int kv = 0; kv < 2; ++kv) {
        const int pc = kv == 0 ? PC_SK : PC_SV; const float* cache = kv == 0 ? p.cache_k : p.cache_v;
        if (r < N_R2B_3) { const int b = (int)(r / (128 * 128)), j = (int)(r / 128 % 128), c = (int)(r % 128);
            p.out[(kv == 0 ? O_PK : O_PV) + r] = bf2f(PR[(size_t)(b * SEQ + SEQ - 128 + j) * PLD + pc + c]); return; }
        r -= N_R2B_3;
        if (r < N_R2B_4) { const int b = (int)(r / (128 * 128)), j = (int)(r / 128 % 128), c = (int)(r % 128);
            float v;
            if (j < 128 - DEC_SEQ) v = cache[((size_t)b * 128 + j + DEC_SEQ) * 128 + c];
            else v = bf2f(PR[(size_t)(TP + b * DEC_SEQ + (j - (128 - DEC_SEQ))) * PLD + pc + c]);
            p.out[(kv == 0 ? O_SK : O_SV) + r] = v; return; }
        r -= N_R2B_4;
    }
}
constexpr long N_R3 = (long)T * 12;
HD float r3_conv(const P& p, int m, int t, int ch) {
    const bf16_t* PR = ws_h(p, WS_PROJ);
    float acc = 0.f;
#pragma unroll
    for (int j = 0; j < 4; ++j) {
        const int tt = t - 3 + j; float xv;
        if (tt >= 0) xv = bf2f(PR[(size_t)(m - (t - tt)) * PLD + PC_QKV + ch]);
        else xv = m < TP ? 0.f : p.state_dn_conv[((size_t)((m - TP) / DEC_SEQ) * 3 + (3 + tt)) * 1536 + ch];
        acc += p.dn_conv_w[j * 1536 + ch] * xv;
    }
    return silu_f(acc);
}
HD void r3_body(long idx, const P& p) {
    const int m = (int)(idx / 12), grp = (int)(idx % 12), part = grp / 4, cbase = grp * 128, t = t_of(m);
    float scale = 1.f;
    if (part < 2) {
        float ss = 0.f;
        for (int c = 0; c < 128; ++c) { const float v = r3_conv(p, m, t, cbase + c); ss += v * v; }
        scale = 1.0f / sqrtf(ss + EPS);
        if (part == 0) scale *= 0.08838834764831845f;
    }
    bf16_t* Q = ws_h(p, WS_QKVC) + (size_t)m * 1536 + cbase;
    for (int c = 0; c < 128; ++c) Q[c] = f2bf(r3_conv(p, m, t, cbase + c) * scale);
}
constexpr long N_R4 = (long)NCB * 4 * 128;
HD void r4_body(long idx, const P& p) {
    const int seq = (int)(idx / 512), h = (int)(idx / 128 % 4), v = (int)(idx % 128);
    const bool smp = seq >= BATCH; const int b = smp ? seq - BATCH : seq;
    float* S = p.out + (smp ? O_SSSM : O_PSSM) + ((size_t)b * 4 + h) * 128 * 128 + v;
    const float* S0 = smp ? p.state_dn_ssm + ((size_t)b * 4 + h) * 128 * 128 + v : nullptr;
    for (int k = 0; k < 128; ++k) S[(size_t)k * 128] = smp ? S0[(size_t)k * 128] : 0.f;
    const int L = smp ? DEC_SEQ : SEQ, m0 = smp ? TP + b * DEC_SEQ : b * SEQ;
    const bf16_t* QK = ws_h(p, WS_QKVC); const float* BG = ws_f(p, WS_BG); float* ODN = ws_f(p, WS_ODN);
    for (int t = 0; t < L; ++t) {
        const int m = m0 + t;
        const bf16_t* q = QK + (size_t)m * 1536 + h * 128; const bf16_t* kk = q + 512; const float vv = bf2f(q[1024 + v]);
        const float beta = BG[(size_t)m * 8 + h], eg = expf(BG[(size_t)m * 8 + 4 + h]);
        float kS = 0.f;
        for (int k = 0; k < 128; ++k) kS += bf2f(kk[k]) * (S[(size_t)k * 128] * eg);
        const float u = beta * (vv - kS);
        float o = 0.f;
        for (int k = 0; k < 128; ++k) { const float s = S[(size_t)k * 128] * eg + bf2f(kk[k]) * u; S[(size_t)k * 128] = s; o += bf2f(q[k]) * s; }
        ODN[(size_t)m * 512 + h * 128 + v] = o;
    }
}
constexpr long N_R5 = (long)T * 4;
HD void r5_body(long idx, const P& p) {
    const int m = (int)(idx / 4), h = (int)(idx % 4);
    const float* o = ws_f(p, WS_ODN) + (size_t)m * 512 + h * 128;
    float ss = 0.f;
    for (int v = 0; v < 128; ++v) ss += o[v] * o[v];
    const float rstd = 1.0f / sqrtf(ss / 128.0f + EPS);
    const bf16_t* z = ws_h(p, WS_PROJ) + (size_t)m * PLD + PC_Z + h * 128;
    bf16_t* mix = ws_h(p, WS_MIX) + (size_t)m * 1024 + h * 128;
    for (int v = 0; v < 128; ++v) mix[v] = f2bf(o[v] * rstd * p.dn_norm_w[v] * silu_f(bf2f(z[v])));
}
constexpr long N_R6 = (long)T * 8 * 8;
HD void r6_body(long idx, const P& p) {
    const int m = (int)(idx / 64), hq = (int)(idx / 8 % 8), dg = (int)(idx % 8), kvh = hq / 4, t = t_of(m);
    const bool smp = m >= TP; const int b = smp ? (m - TP) / DEC_SEQ : 0;
    const bf16_t* PR = ws_h(p, WS_PROJ);
    const bf16_t* q = PR + (size_t)m * PLD + PC_SQ + hq * 64;
    const float sink = p.swa_sinks[hq];
    const int nk = smp ? 128 : (t < 127 ? t + 1 : 128);
    float mx = sink;
    for (int pass = 0; pass < 2; ++pass) {
        float den = 0.f, acc[8];
#pragma unroll
        for (int i = 0; i < 8; ++i) acc[i] = 0.f;
        for (int jj = 0; jj < nk; ++jj) {
            int dist; const float* kf = nullptr; const float* vf = nullptr; const bf16_t* kb = nullptr; const bf16_t* vb = nullptr;
            if (smp) { const int j = t + 1 + jj; dist = 128 + t - j;
                if (j < 128) { kf = p.cache_k + ((size_t)b * 128 + j) * 128 + kvh * 64; vf = p.cache_v + ((size_t)b * 128 + j) * 128 + kvh * 64; }
                else { const size_t mm = (size_t)(TP + b * DEC_SEQ + (j - 128)); kb = PR + mm * PLD + PC_SK + kvh * 64; vb = PR + mm * PLD + PC_SV + kvh * 64; } }
            else { dist = nk - 1 - jj; const size_t mm = (size_t)(m - dist); kb = PR + mm * PLD + PC_SK + kvh * 64; vb = PR + mm * PLD + PC_SV + kvh * 64; }
            float s = 0.f;
            for (int d = 0; d < 64; ++d) s += bf2f(q[d]) * (kf ? kf[d] : bf2f(kb[d]));
            s = s * 0.125f + p.rel_bias[t5_bucket(dist) * 8 + hq];
            if (pass == 0) { mx = s > mx ? s : mx; }
            else { const float pr = expf(s - mx); den += pr;
#pragma unroll
                for (int i = 0; i < 8; ++i) acc[i] += pr * (vf ? vf[dg * 8 + i] : bf2f(vb[dg * 8 + i])); }
        }
        if (pass == 1) { den += expf(sink - mx); bf16_t* mix = ws_h(p, WS_MIX) + (size_t)m * 1024 + 512 + hq * 64 + dg * 8;
#pragma unroll
            for (int i = 0; i < 8; ++i) mix[i] = f2bf(acc[i] / den); }
    }
}
constexpr long N_R7 = (long)(T / 8) * D;
HD void r7_body(long idx, const P& p) {
    const int mg = (int)(idx / D), d = (int)(idx % D);
    const bf16_t* MX = ws_h(p, WS_MIX) + (size_t)mg * 8 * 1024;
    float acc[8];
#pragma unroll
    for (int i = 0; i < 8; ++i) acc[i] = 0.f;
    for (int e = 0; e < 1024; ++e) { const float w = bf2f(f2bf(p.w_out[(size_t)e * D + d]));
#pragma unroll
        for (int i = 0; i < 8; ++i) acc[i] += bf2f(MX[(size_t)i * 1024 + e]) * w; }
#pragma unroll
    for (int i = 0; i < 8; ++i) { const int m = mg * 8 + i; const float g1 = ws_f(p, WS_MOD)[(size_t)cb_of(m) * 6 * D + 2 * D + d];
        p.out[O_Y + (size_t)m * D + d] = xrow(p, m)[d] + g1 * acc[i]; }
}
constexpr long N_R9 = (long)(T / 8) * DFF;
HD void r9_body(long idx, const P& p) {
    const int mg = (int)(idx / DFF), f = (int)(idx % DFF), m0 = mg * 8, t0 = t_of(m0);
    const bool smp = m0 >= TP; const int b = smp ? (m0 - TP) / DEC_SEQ : m0 / SEQ;
    const bf16_t* H = ws_h(p, WS_H);
    float ug[10], uu[10];
#pragma unroll
    for (int i = 0; i < 10; ++i) { ug[i] = 0.f; uu[i] = 0.f; }
    const bool halo = (!smp && t0 > 0);
    for (int k = 0; k < D; ++k) {
        const float wg = bf2f(f2bf(p.w_up[(size_t)k * 2 * DFF + f])), wu = bf2f(f2bf(p.w_up[(size_t)k * 2 * DFF + DFF + f]));
#pragma unroll
        for (int i = 0; i < 10; ++i) { if (i < 2 && !halo) continue; const float h = bf2f(H[(size_t)(m0 - 2 + i) * D + k]); ug[i] += h * wg; uu[i] += h * wu; }
    }
    if (smp) {
#pragma unroll
        for (int i = 0; i < 2; ++i) { ug[i] = p.state_ffn[((size_t)b * 2 + i) * 2 * DFF + f]; uu[i] = p.state_ffn[((size_t)b * 2 + i) * 2 * DFF + DFF + f]; }
    }
    const float w0g = p.ffn_conv_w[f], w1g = p.ffn_conv_w[2 * DFF + f], w2g = p.ffn_conv_w[4 * DFF + f], bgt = p.ffn_conv_b[f];
    const float w0u = p.ffn_conv_w[DFF + f], w1u = p.ffn_conv_w[3 * DFF + f], w2u = p.ffn_conv_w[5 * DFF + f], bup = p.ffn_conv_b[DFF + f];
    bf16_t* ACT = ws_h(p, WS_ACT);
#pragma unroll
    for (int i = 0; i < 8; ++i) {
        const float gc = w0g * ug[i] + w1g * ug[i + 1] + w2g * ug[i + 2] + bgt, uc = w0u * uu[i] + w1u * uu[i + 1] + w2u * uu[i + 2] + bup;
        ACT[(size_t)(m0 + i) * DFF + f] = f2bf(silu_f(gc) * uc);
    }
    if (smp) {
#pragma unroll
        for (int j = 0; j < 2; ++j) { float* o = p.out + O_SFC + ((size_t)b * 2 + j) * 2 * DFF; o[f] = ug[8 + j]; o[DFF + f] = uu[8 + j]; }
    } else if (t0 == SEQ - 8) {
#pragma unroll
        for (int j = 0; j < 2; ++j) { float* o = p.out + O_PFC + ((size_t)b * 2 + j) * 2 * DFF; o[f] = ug[8 + j]; o[DFF + f] = uu[8 + j]; }
    }
}
constexpr long N_R10 = (long)(T / 8) * D;
HD void r10_body(long idx, const P& p) {
    const int mg = (int)(idx / D), d = (int)(idx % D);
    const bf16_t* A = ws_h(p, WS_ACT) + (size_t)mg * 8 * DFF;
    float acc[8];
#pragma unroll
    for (int i = 0; i < 8; ++i) acc[i] = 0.f;
    for (int f = 0; f < DFF; ++f) { const float w = bf2f(f2bf(p.w_down[(size_t)f * D + d]));
#pragma unroll
        for (int i = 0; i < 8; ++i) acc[i] += bf2f(A[(size_t)i * DFF + f]) * w; }
#pragma unroll
    for (int i = 0; i < 8; ++i) { const int m = mg * 8 + i; const float g2 = ws_f(p, WS_MOD)[(size_t)cb_of(m) * 6 * D + 5 * D + d];
        float* o = p.out + O_Y + (size_t)m * D + d; *o = *o + g2 * acc[i]; }
}
constexpr long N_R11 = T, N_R8 = T;
HD void r11_body(long idx, const P& p) {
    float* xr = p.out + O_Y + (size_t)idx * D;
    float ss = 0.f;
    for (int k = 0; k < D; ++k) ss += xr[k] * xr[k];
    const float rstd = 1.0f / sqrtf(ss / (float)D + EPS);
    for (int k = 0; k < D; ++k) xr[k] = xr[k] * rstd * p.final_norm_w[k];
}
#define LAS __attribute__((address_space(3)))
typedef float f32x4 __attribute__((ext_vector_type(4)));
typedef unsigned u32x4 __attribute__((ext_vector_type(4)));
typedef unsigned u32x2 __attribute__((ext_vector_type(2)));
constexpr int NWAVES = 8, NTHR = 512;
constexpr int LDS_BYTES = 163840;
__device__ __forceinline__ int otid() { int t = threadIdx.x; asm volatile("" : "+v"(t)); return t; }
__device__ __forceinline__ float wave_sum(float v) {
#pragma unroll
    for (int o = 1; o < 64; o <<= 1) v += __shfl_xor(v, o);
    return v;
}
__device__ __forceinline__ unsigned pk2(float lo, float hi) { return f2bf_bits(lo) | (f2bf_bits(hi) << 16); }

__device__ __forceinline__ void transpose_item(const float* W, int ldw, int K, bf16_t* WT, int dst_n0, int src_n0, int k0, LAS float* scr, int lane) {
#pragma unroll
    for (int i = 0; i < 32; ++i) { const int kk = 2 * i + (lane >> 5); scr[kk * 33 + (lane & 31)] = W[(size_t)(k0 + kk) * ldw + src_n0 + (lane & 31)]; }
    asm volatile("s_waitcnt lgkmcnt(0)" ::: "memory");
    const int c = lane & 7;
#pragma unroll
    for (int j = 0; j < 4; ++j) { const int n = (lane >> 3) + 8 * j; const LAS float* s = scr + (8 * c) * 33 + n;
        u32x4 o; o.x = pk2(s[0 * 33], s[1 * 33]); o.y = pk2(s[2 * 33], s[3 * 33]); o.z = pk2(s[4 * 33], s[5 * 33]); o.w = pk2(s[6 * 33], s[7 * 33]);
        *(u32x4*)(WT + (size_t)(dst_n0 + n) * K + k0 + 8 * c) = o; }
    asm volatile("s_waitcnt lgkmcnt(0)" ::: "memory");
}
constexpr int TI_IN = (PLD / 32) * (D / 64), TI_OUT = (D / 32) * (1024 / 64), TI_UP = (2 * DFF / 32) * (D / 64), TI_DN = (D / 32) * (DFF / 64), TI_ALL = TI_IN + TI_OUT + TI_UP + TI_DN;
__device__ __forceinline__ void phase_transposes(const P& p, LAS unsigned char* lds) {
    const int tid_ = otid(), lane = tid_ & 63, wave = tid_ >> 6;
    LAS float* scr = (LAS float*)(lds + wave * 16384);
    if (blockIdx.x == gridDim.x - 1) { for (int i = tid_; i < 8 * D; i += NTHR) ws_f(p, WS_WBAT)[i] = p.w_in[(size_t)(i % D) * IN_COLS + WC_BA + i / D]; }
    constexpr int NCG_MOD = 6 * D / 32;
    const bool split = (int)gridDim.x >= NCG_MOD + 32;
    if (split && (int)blockIdx.x < NCG_MOD) return;
    const int gw = (split ? (int)blockIdx.x - NCG_MOD : (int)blockIdx.x) * NWAVES + wave, NGW = (split ? (int)gridDim.x - NCG_MOD : (int)gridDim.x) * NWAVES;
    for (int it = gw; it < TI_ALL; it += NGW) {
        int r = it;
        if (r < TI_IN) { const int nb = r % (PLD / 32), kb = r / (PLD / 32), n0 = nb * 32; transpose_item(p.w_in, IN_COLS, D, ws_h(p, WS_WT_IN), n0, n0 < WC_BA ? n0 : n0 + 8, kb * 64, scr, lane); continue; } r -= TI_IN;
        if (r < TI_OUT) { const int nb = r % (D / 32), kb = r / (D / 32), n0 = nb * 32; transpose_item(p.w_out, D, 1024, ws_h(p, WS_WT_OUT), n0, n0, kb * 64, scr, lane); continue; } r -= TI_OUT;
        if (r < TI_UP) { const int nb = r % (2 * DFF / 32), kb = r / (2 * DFF / 32), n0 = nb * 32;
            const int pn = n0 >> 8, bj = (n0 >> 7) & 1, c = n0 & 127; transpose_item(p.w_up, 2 * DFF, D, ws_h(p, WS_WT_UP), n0, bj * DFF + 128 * pn + c, kb * 64, scr, lane); continue; } r -= TI_UP;
        { const int nb = r % (D / 32), kb = r / (D / 32), n0 = nb * 32; transpose_item(p.w_down, D, DFF, ws_h(p, WS_WT_DN), n0, n0, kb * 64, scr, lane); }
    }
}
typedef short bf16x8m __attribute__((ext_vector_type(8)));
typedef float f32x2m __attribute__((ext_vector_type(2))); typedef __bf16 bf16x2m __attribute__((ext_vector_type(2)));
__device__ __forceinline__ unsigned cvtpk_m(float lo, float hi) { const f32x2m v = {lo, hi}; return __builtin_bit_cast(unsigned, __builtin_convertvector(v, bf16x2m)); }
__device__ __forceinline__ void split8(const float (&x)[8], bf16x8m& hi, bf16x8m& lo) {
    unsigned h[4], l[4];
#pragma unroll
    for (int e = 0; e < 4; ++e) { h[e] = cvtpk_m(x[2 * e], x[2 * e + 1]);
        l[e] = cvtpk_m(x[2 * e] - __builtin_bit_cast(float, h[e] << 16), x[2 * e + 1] - __builtin_bit_cast(float, h[e] & 0xffff0000u)); }
    hi = __builtin_bit_cast(bf16x8m, (u32x4){h[0], h[1], h[2], h[3]}); lo = __builtin_bit_cast(bf16x8m, (u32x4){l[0], l[1], l[2], l[3]});
}
__device__ __forceinline__ float silu_fast(float x) { return x * __builtin_amdgcn_rcpf(1.0f + __expf(-x)); }
__device__ __forceinline__ void phase_mod(const P& p, LAS unsigned char* lds) {
    constexpr int KC = 256, NCG = 6 * D / 32, NCH = D / KC, NMT = (NCB + 15) / 16;
    static_assert(NMT <= 16, "two m-tiles per wave at most");
    LAS float* WB = (LAS float*)lds;
    const int tid = otid(), lane = tid & 63, wave = tid >> 6, r16 = lane & 15, g4 = lane >> 4;
    for (int cg = blockIdx.x; cg < NCG; cg += gridDim.x) {
        f32x4 acc[2][2];
#pragma unroll
        for (int s = 0; s < 2; ++s)
#pragma unroll
            for (int nt = 0; nt < 2; ++nt) acc[s][nt] = (f32x4){0.f, 0.f, 0.f, 0.f};
        f32x4 wreg[4];
#pragma unroll
        for (int j = 0; j < 4; ++j) { const int idx = tid + NTHR * j; wreg[j] = *(const f32x4*)(p.w_ada + (size_t)(idx >> 3) * 6 * D + cg * 32 + 4 * (idx & 7)); }
        __syncthreads();
        for (int ch = 0; ch < NCH; ++ch) {
            LAS float* wb = WB + (ch & 1) * KC * 32;
#pragma unroll
            for (int j = 0; j < 4; ++j) { const int idx = tid + NTHR * j; *(LAS f32x4*)(wb + (idx >> 3) * 32 + 4 * (idx & 7)) = wreg[j]; }
            if (ch + 1 < NCH) {
#pragma unroll
                for (int j = 0; j < 4; ++j) { const int idx = tid + NTHR * j; wreg[j] = *(const f32x4*)(p.w_ada + (size_t)((ch + 1) * KC + (idx >> 3)) * 6 * D + cg * 32 + 4 * (idx & 7)); }
            }
            f32x4 areg[KC / 32][2];
#define MOD_LDA(mt_) do { const int row_ = 16 * (mt_) + r16; if (row_ < NCB) { const float* c_ = (row_ < BATCH ? p.c_prompt + (size_t)row_ * D : p.c_sample + (size_t)(row_ - BATCH) * D) + ch * KC + 8 * g4; \
                _Pragma("unroll") for (int ks = 0; ks < KC / 32; ++ks) { areg[ks][0] = *(const f32x4*)(c_ + 32 * ks); areg[ks][1] = *(const f32x4*)(c_ + 32 * ks + 4); } } \
                else { _Pragma("unroll") for (int ks = 0; ks < KC / 32; ++ks) { areg[ks][0] = (f32x4){0.f, 0.f, 0.f, 0.f}; areg[ks][1] = (f32x4){0.f, 0.f, 0.f, 0.f}; } } } while (0)
            MOD_LDA(wave);
            __syncthreads();
#pragma unroll
            for (int s = 0; s < 2; ++s) { const int mt = wave + 8 * s; if (mt >= NMT) continue;
                if (s == 1) MOD_LDA(mt);
#pragma unroll
                for (int ks = 0; ks < KC / 32; ++ks) {
                    bf16x8m bh[2], bl[2];
#pragma unroll
                    for (int nt = 0; nt < 2; ++nt) { float x[8];
#pragma unroll
                        for (int j = 0; j < 8; ++j) x[j] = wb[(32 * ks + 8 * g4 + j) * 32 + 16 * nt + r16];
                        split8(x, bh[nt], bl[nt]); }
                    float x[8]; const f32x4 a = areg[ks][0], d = areg[ks][1];
                    x[0] = silu_fast(a[0]); x[1] = silu_fast(a[1]); x[2] = silu_fast(a[2]); x[3] = silu_fast(a[3]); x[4] = silu_fast(d[0]); x[5] = silu_fast(d[1]); x[6] = silu_fast(d[2]); x[7] = silu_fast(d[3]);
                    bf16x8m ah, al; split8(x, ah, al);
#pragma unroll
                    for (int nt = 0; nt < 2; ++nt) {
                        acc[s][nt] = __builtin_amdgcn_mfma_f32_16x16x32_bf16(ah, bh[nt], acc[s][nt], 0, 0, 0);
                        acc[s][nt] = __builtin_amdgcn_mfma_f32_16x16x32_bf16(ah, bl[nt], acc[s][nt], 0, 0, 0);
                        acc[s][nt] = __builtin_amdgcn_mfma_f32_16x16x32_bf16(al, bh[nt], acc[s][nt], 0, 0, 0); }
                }
            }
#undef MOD_LDA
        }
#pragma unroll
        for (int s = 0; s < 2; ++s) { const int mt = wave + 8 * s; if (mt >= NMT) continue;
#pragma unroll
            for (int nt = 0; nt < 2; ++nt) { const int e = cg * 32 + 16 * nt + r16; const float bb = p.b_ada[e];
#pragma unroll
                for (int i = 0; i < 4; ++i) { const int row = 16 * mt + 4 * g4 + i; if (row < NCB) ws_f(p, WS_MOD)[(size_t)row * 6 * D + e] = acc[s][nt][i] + bb; } } }
    }
    __syncthreads();
}
constexpr int NS_OUT = 4, NS_DN = 11;
constexpr size_t SLAB_DN_BYTES = (size_t)(TS / 256) * (D / 256) * NS_DN * 65536 * 4, WS_SLAB_DN = WS_H;
constexpr size_t WS_XB = al256(WS_SLAB_DN + SLAB_DN_BYTES);
static_assert(WS_XB >= WS_DNF_AB && WS_XB + (size_t)T * D * 2 <= WS_DNF_CD && (size_t)(TS / 256) * (D / 256) * NS_OUT * 65536 <= (size_t)T * D, "residual stream / slabs fit");
template <int WHICH> __device__ __forceinline__ void norm_row_tail(const P& p, int m, int lane, const f32x4 (&v)[4], const f32x4 (&nwv)[4], const LAS float* wbt) {
    float ss = 0.f;
#pragma unroll
    for (int j = 0; j < 4; ++j) ss += (v[j][0] * v[j][0] + v[j][1] * v[j][1]) + (v[j][2] * v[j][2] + v[j][3] * v[j][3]);
    const float rstd = 1.0f / sqrtf(wave_sum(ss) * (1.0f / D) + EPS);
    if (WHICH == 2) {
#pragma unroll
        for (int j = 0; j < 4; ++j) ((f32x4*)(p.out + O_Y + (size_t)m * D))[lane + 64 * j] = v[j] * rstd * nwv[j];
        return;
    }
    const int cb = cb_of(m);
    const float* mod = ws_f(p, WS_MOD) + (size_t)cb * 6 * D;
    const float* sh = mod + (WHICH == 0 ? 0 : 3 * D); const float* sc = mod + (WHICH == 0 ? D : 4 * D);
    float ba[8];
#pragma unroll
    for (int j = 0; j < 8; ++j) ba[j] = 0.f;
    unsigned long long* o8 = (unsigned long long*)(ws_h(p, WS_H) + (size_t)m * D);
#pragma unroll
    for (int j = 0; j < 4; ++j) {
        const f32x4 s1 = ((const f32x4*)sc)[lane + 64 * j], s0 = ((const f32x4*)sh)[lane + 64 * j];
        const f32x4 h = v[j] * rstd * nwv[j] * (s1 + 1.0f) + s0;
        o8[lane + 64 * j] = (unsigned long long)cvtpk_m(h[0], h[1]) | ((unsigned long long)cvtpk_m(h[2], h[3]) << 32);
        if (WHICH == 0) {
#pragma unroll
            for (int c = 0; c < 8; ++c) { const f32x4 w = *(const LAS f32x4*)(wbt + c * D + 4 * (lane + 64 * j)); ba[c] += (h[0] * w[0] + h[1] * w[1]) + (h[2] * w[2] + h[3] * w[3]); }
        }
    }
    if (WHICH == 0) {
#pragma unroll
        for (int j = 0; j < 8; ++j) ba[j] = wave_sum(ba[j]);
        float mine = 0.f;
#pragma unroll
        for (int j = 0; j < 8; ++j) mine = (lane == j) ? ba[j] : mine;
        if (lane < 8) { float* bg = ws_f(p, WS_BG) + (size_t)m * 8; const int j = lane & 3;
            bg[lane] = lane < 4 ? sigmoid_f(mine) : -expf(p.dn_A_log[j]) * softplus_f(mine + p.dn_dt_bias[j]); }
    }
}
template <int WHICH> __device__ __forceinline__ void phase_norm(const P& p, LAS unsigned char* lds) {
    static_assert(D == 1024, "one wave per 1024-element row");
    const int tid_ = otid(), lane = tid_ & 63, wave = tid_ >> 6;
    const int gw = blockIdx.x * NWAVES + wave, NGW = gridDim.x * NWAVES;
    const float* nwp = WHICH == 0 ? p.norm_mix_w : (WHICH == 1 ? p.norm_ffn_w : p.final_norm_w);
    f32x4 nwv[4];
#pragma unroll
    for (int j = 0; j < 4; ++j) nwv[j] = ((const f32x4*)nwp)[lane + 64 * j];
    const LAS float* wbt = (const LAS float*)lds;
    if (WHICH == 0) { for (int i = tid_; i < 8 * D / 4; i += NTHR) ((LAS f32x4*)lds)[i] = ((const f32x4*)ws_f(p, WS_WBAT))[i]; __syncthreads(); }
    const bf16_t* XB = ws_h(p, WS_XB);
    constexpr int MEND = WHICH == 0 ? T : TP;
    typedef f32x4 rowbuf_t[4];
    rowbuf_t ra, rb, rc;
#define NR_LOAD(buf_, mm_) do { if ((mm_) < MEND) { if (WHICH == 0) { const float* xr_ = xrow(p, (mm_)); _Pragma("unroll") for (int j = 0; j < 4; ++j) buf_[j] = ((const f32x4*)xr_)[lane + 64 * j]; } \
        else { const u32x2* xr_ = (const u32x2*)(XB + (size_t)(mm_) * D); u32x2 w_[4]; _Pragma("unroll") for (int j = 0; j < 4; ++j) w_[j] = xr_[lane + 64 * j]; \
            buf_[0] = __builtin_bit_cast(f32x4, (u32x4){w_[0].x, w_[0].y, w_[1].x, w_[1].y}); buf_[1] = __builtin_bit_cast(f32x4, (u32x4){w_[2].x, w_[2].y, w_[3].x, w_[3].y}); } } } while (0)
#define NR_PROC(buf_, mm_) do { if ((mm_) < MEND) { f32x4 v_[4]; if (WHICH == 0) { _Pragma("unroll") for (int j = 0; j < 4; ++j) v_[j] = buf_[j]; } \
        else { const u32x4 a_ = __builtin_bit_cast(u32x4, buf_[0]), b_ = __builtin_bit_cast(u32x4, buf_[1]); const unsigned w_[8] = {a_.x, a_.y, a_.z, a_.w, b_.x, b_.y, b_.z, b_.w}; \
            _Pragma("unroll") for (int j = 0; j < 4; ++j) v_[j] = (f32x4){__builtin_bit_cast(float, w_[2 * j] << 16), __builtin_bit_cast(float, w_[2 * j] & 0xffff0000u), __builtin_bit_cast(float, w_[2 * j + 1] << 16), __builtin_bit_cast(float, w_[2 * j + 1] & 0xffff0000u)}; } \
        norm_row_tail<WHICH>(p, (mm_), lane, v_, nwv, wbt); } } while (0)
    NR_LOAD(ra, gw); NR_LOAD(rb, gw + NGW);
    for (int m = gw; m < MEND; m += 3 * NGW) {
        NR_LOAD(rc, m + 2 * NGW); NR_PROC(ra, m);
        NR_LOAD(ra, m + 3 * NGW); NR_PROC(rb, m + NGW);
        NR_LOAD(rb, m + 4 * NGW); NR_PROC(rc, m + 2 * NGW);
    }
#undef NR_LOAD
#undef NR_PROC
    if (WHICH != 0) {
        constexpr int NS = WHICH == 1 ? NS_OUT : NS_DN;
        const float* slabs = WHICH == 1 ? p.out + O_Y : ws_f(p, WS_SLAB_DN);
        for (int rs = gw; rs < TS; rs += NGW) { const int m = TP + rs, cbs = BATCH + (rs >> 3);
            const float* gt = ws_f(p, WS_MOD) + (size_t)cbs * 6 * D + (WHICH == 1 ? 2 * D : 5 * D);
            f32x4 vs[4];
#pragma unroll
            for (int j = 0; j < 4; ++j) { const float* sl = slabs + ((size_t)((rs >> 8) * 4 + j) * NS) * 65536 + (size_t)(rs & 255) * 256 + 4 * lane;
                f32x4 acc = (f32x4){0.f, 0.f, 0.f, 0.f};
#pragma unroll
                for (int ks = 0; ks < NS; ++ks) { acc += *(const f32x4*)sl; sl += 65536; asm volatile("" : "+v"(sl)); }
                f32x4 base;
                if (WHICH == 1) base = ((const f32x4*)(p.x_sample + (size_t)rs * D))[lane + 64 * j];
                else { const u32x2 w = ((const u32x2*)(XB + (size_t)m * D))[lane + 64 * j]; base = (f32x4){__builtin_bit_cast(float, w.x << 16), __builtin_bit_cast(float, w.x & 0xffff0000u), __builtin_bit_cast(float, w.y << 16), __builtin_bit_cast(float, w.y & 0xffff0000u)}; }
                vs[j] = base + ((const f32x4*)gt)[lane + 64 * j] * acc;
                if (WHICH == 1) ((u32x2*)(ws_h(p, WS_XB) + (size_t)m * D))[lane + 64 * j] = (u32x2){cvtpk_m(vs[j][0], vs[j][1]), cvtpk_m(vs[j][2], vs[j][3])};
                asm volatile("" ::: "memory"); }
            norm_row_tail<WHICH>(p, m, lane, vs, nwv, wbt);
        }
    }
}

constexpr long SO_1 = (long)BATCH * 3 * 1536 / 4, SO_2 = (long)DEC_BATCH * 3 * 1536 / 4, SO_3 = (long)BATCH * 128 * 128 / 4, SO_4 = (long)DEC_BATCH * 128 * 128 / 4, SO_N = SO_1 + SO_2 + 2 * (SO_3 + SO_4);
__device__ __forceinline__ void so_item(const P& p, long it, f32x4& val, float*& dst) {
    const bf16_t* PR = ws_h(p, WS_PROJ); const bf16_t* src = nullptr; const float* fsrc = nullptr;
    long r = it;
    if (r < SO_1) { const int b = (int)(r / (3 * 384)), j = (int)(r / 384 % 3), c = (int)(r % 384) * 4; src = PR + (size_t)(b * SEQ + SEQ - 3 + j) * PLD + PC_QKV + c; dst = p.out + O_PDC + r * 4; }
    else if ((r -= SO_1) < SO_2) { const int b = (int)(r / (3 * 384)), j = (int)(r / 384 % 3), c = (int)(r % 384) * 4; src = PR + (size_t)(TP + b * DEC_SEQ + DEC_SEQ - 3 + j) * PLD + PC_QKV + c; dst = p.out + O_SDC + r * 4; }
    else { r -= SO_2; const int kv = r >= SO_3 + SO_4; if (kv) r -= SO_3 + SO_4; const int pc = kv ? PC_SV : PC_SK; const float* cache = kv ? p.cache_v : p.cache_k;
        if (r < SO_3) { const int b = (int)(r / (128 * 32)), j = (int)(r / 32 % 128), c = (int)(r % 32) * 4; src = PR + (size_t)(b * SEQ + SEQ - 128 + j) * PLD + pc + c; dst = p.out + (kv ? O_PV : O_PK) + r * 4; }
        else { r -= SO_3; const int b = (int)(r / (128 * 32)), j = (int)(r / 32 % 128), c = (int)(r % 32) * 4; dst = p.out + (kv ? O_SV : O_SK) + r * 4;
            if (j < 128 - DEC_SEQ) fsrc = cache + ((size_t)b * 128 + j + DEC_SEQ) * 128 + c; else src = PR + (size_t)(TP + b * DEC_SEQ + (j - (128 - DEC_SEQ))) * PLD + pc + c; } }
    if (fsrc) val = *(const f32x4*)fsrc;
    else { const u32x2 w = *(const u32x2*)src; val = (f32x4){__builtin_bit_cast(float, w.x << 16), __builtin_bit_cast(float, w.x & 0xffff0000u), __builtin_bit_cast(float, w.y << 16), __builtin_bit_cast(float, w.y & 0xffff0000u)}; }
}
__device__ __forceinline__ void phase_state_out(const P& p) {
    const long gt = blockIdx.x * (long)NTHR + otid(), gs = (long)gridDim.x * NTHR;
    for (long it = gt; it < SO_N; it += 4 * gs) {
        f32x4 v[4]; float* d[4];
#pragma unroll
        for (int u = 0; u < 4; ++u) if (it + u * gs < SO_N) so_item(p, it + u * gs, v[u], d[u]);
#pragma unroll
        for (int u = 0; u < 4; ++u) if (it + u * gs < SO_N) *(f32x4*)d[u] = v[u];
    }
}
#define XB_TMO      128
#define XB_XCNT(j)  (256  + 64 * (j))
#define XB_XSUB(j)  (1280 + 64 * (j))
#define XB_XGEN(j)  (2304 + 64 * (j))
#define XB_TOP      3328
#define XB_TOPGEN   3392
#define XCD_BAR_WORDS 3456
#define XB_SPIN_CAP (1u << 18)

__device__ __forceinline__ unsigned xb_ld(unsigned* p)              { return __hip_atomic_load(p, __ATOMIC_RELAXED, __HIP_MEMORY_SCOPE_AGENT); }
__device__ __forceinline__ unsigned xb_add(unsigned* p, unsigned v) { return __hip_atomic_fetch_add(p, v, __ATOMIC_RELAXED, __HIP_MEMORY_SCOPE_AGENT); }
__device__ __forceinline__ unsigned xb_xcc_id() { return (unsigned)__builtin_amdgcn_s_getreg((3 << 11) | 20) & 0xFu; }
#define XB_SPIN(cond, bar) do { unsigned _sp = 0; while (cond) { __builtin_amdgcn_s_sleep(1); \
    if ((++_sp & 255u) == 0u) { if (xb_ld(&(bar)[XB_TMO])) break; if (_sp > XB_SPIN_CAP) { atomicAdd(&(bar)[XB_TMO], 1u); break; } } } } while (0)

struct XcdBarrier {
    unsigned* bar; unsigned x;
    volatile LAS unsigned* st;
};

__device__ __forceinline__ XcdBarrier xcd_barrier_post(unsigned* bar, volatile LAS unsigned* st) {
    XcdBarrier b; b.bar = bar; b.x = xb_xcc_id(); b.st = st;
    if (threadIdx.x == 0) (void)xb_add(&bar[XB_XCNT(b.x)], 1u);
    return b;
}
__device__ __forceinline__ void xcd_barrier_complete(unsigned* bar, unsigned x, unsigned& nloc, unsigned& nx) {
    const unsigned G = gridDim.x * gridDim.y * gridDim.z;
    unsigned sum, cnt, mine, sp = 0u;
    for (;;) {
        sum = 0u; cnt = 0u; mine = 0u;
#pragma unroll
        for (unsigned j = 0; j < 16; ++j) { const unsigned c = xb_ld(&bar[XB_XCNT(j)]); sum += c; cnt += (c > 0u) ? 1u : 0u; mine = (j == x) ? c : mine; }
        if (sum == G) break;
        __builtin_amdgcn_s_sleep(1);
        if ((++sp & 255u) == 0u) { if (xb_ld(&bar[XB_TMO])) break; if (sp > XB_SPIN_CAP) { atomicAdd(&bar[XB_TMO], 1u); break; } }
    }
    nloc = mine > 0u ? mine : 1u; nx = cnt > 0u ? cnt : 1u;
}

__device__ __forceinline__ void xcd_barrier(const XcdBarrier& b) {
    asm volatile("s_waitcnt vmcnt(0)" ::: "memory");
    __syncthreads();
    if (threadIdx.x == 0) {
        unsigned* bar = b.bar;
        __builtin_amdgcn_s_waitcnt(0);
        unsigned nloc = b.st[0], nx = b.st[1];
        if (nloc == 0u) { xcd_barrier_complete(bar, b.x, nloc, nx); b.st[0] = nloc; b.st[1] = nx; }
        const unsigned old = xb_add(&bar[XB_XSUB(b.x)], 1u);
        const unsigned gen = old / nloc;
        if (old + 1u == (gen + 1u) * nloc) {
            __builtin_amdgcn_fence(__ATOMIC_RELEASE, "agent");
            asm volatile("s_waitcnt vmcnt(0)" ::: "memory");
            const unsigned og = xb_add(&bar[XB_TOP], 1u);
            const unsigned tg = og / nx;
            if (og + 1u == (tg + 1u) * nx) xb_add(&bar[XB_TOPGEN], 1u);
            else XB_SPIN(xb_ld(&bar[XB_TOPGEN]) == tg, bar);
            __builtin_amdgcn_fence(__ATOMIC_ACQUIRE, "agent");
            xb_add(&bar[XB_XGEN(b.x)], 1u);
            asm volatile("s_waitcnt vmcnt(0)" ::: "memory");
        } else {
            XB_SPIN(xb_ld(&bar[XB_XGEN(b.x)]) == gen, bar);
            __builtin_amdgcn_fence(__ATOMIC_ACQUIRE, "agent");
            asm volatile("s_waitcnt vmcnt(0)" ::: "memory");
        }
    }
    __syncthreads();
}
namespace pg8 {
#define PG8_LAS __attribute__((address_space(3)))
typedef unsigned short bf16_t;
typedef short bf16x8 __attribute__((ext_vector_type(8)));
typedef float f32x4 __attribute__((ext_vector_type(4)));
typedef unsigned u32x4 __attribute__((ext_vector_type(4)));
constexpr int BM = 256, BK = 64, HALF = 128, HTB = HALF * BK * 2  , STAGE_BYTES = 8 * HTB, NXCD = 8, WGM = 8;

__host__ __device__ __forceinline__ int lds_byte(int r, int c) { const int st = (r >> 4) * 2 + (c >> 5), rr = r & 15, cc = c & 31, ob = rr * 64 + cc * 2; return st * 1024 + (ob ^ (((ob >> 9) & 1) << 5)); }
__host__ __device__ __forceinline__ void stage_rc(int b, int& R, int& C) { const int st = b / 1024, sb = b % 1024, swz = sb ^ (((sb >> 9) & 1) << 5); R = (st >> 1) * 16 + swz / 64; C = (st & 1) * 32 + (swz % 64) / 2; }
__host__ __device__ __forceinline__ int perm32(int rho) { const int n = rho >> 4, i = rho & 15; return 8 * (i >> 2) + 4 * n + (i & 3); }

struct Unit { int pm, pn, k0, nt, atomic; };
struct Gemm { const bf16_t* A; const bf16_t* Bt; int M, N, K; };

struct StaticOrder {
    int nM, nN, nwg, G, c, ntk;
    __host__ __device__ void init(int M, int N, int G_, int c_, int K_) { nM = M / BM; nN = N / BM; nwg = nM * nN; G = G_; c = c_; ntk = K_ / BK; }
    __host__ __device__ bool next(int i, Unit& u) const {
        const long L = (long)i * G + c; if (L >= nwg) return false;
        int wgid = (int)L; { const int q = nwg / NXCD, r = nwg % NXCD, xcd = wgid % NXCD, off = wgid / NXCD; wgid = (xcd < r ? xcd * (q + 1) : r * (q + 1) + (xcd - r) * q) + off; }
        const int nig = WGM * nN, gid = wgid / nig, fm = gid * WGM, gsz = (nM - fm) < WGM ? (nM - fm) : WGM;
        u.pm = fm + ((wgid % nig) % gsz); u.pn = (wgid % nig) / gsz; u.k0 = 0; u.nt = ntk; u.atomic = 0; return true;
    }
    __device__ __forceinline__ void a_ready(const Unit&) const {}
    __device__ __forceinline__ void done(const Unit&) const {}
};

struct SplitOrder {
    StaticOrder so; int nu1, ns, ntk_sub, npn, nsub, G, c;
    __device__ void init(int N, int K, int NS, int G_, int c_) { so.init(TP, N, G_, c_, K); nu1 = so.nwg; ns = NS; ntk_sub = K / BK / NS; npn = N / BM; nsub = (TS / BM) * npn * NS; G = G_; c = c_; }
    __device__ bool next(int i, Unit& u) const {
        const long L = (long)i * G + c; if (L < nu1) return so.next(i, u);
        const int s = (int)(L - nu1); if (s >= nsub) return false;
        const int ks = s % ns, t = s / ns; u.pm = TP / BM + t / npn; u.pn = t % npn; u.k0 = ks * ntk_sub * BK; u.nt = ntk_sub; u.atomic = 1; return true; }
    __device__ __forceinline__ void a_ready(const Unit&) const {}
    __device__ __forceinline__ void done(const Unit&) const {}
};
__device__ __forceinline__ unsigned cvt_pk_bf16(float lo, float hi) { unsigned r; asm volatile("v_cvt_pk_bf16_f32 %0, %1, %2" : "=v"(r) : "v"(lo), "v"(hi)); return r; }
struct EpiStoreBf16 {
    static constexpr bool PERM = true, AFTER_DRAIN = false;
    bf16_t* O; int ldc;
    __device__ __forceinline__ void operator()(const f32x4 (&acc)[2][2][4][2], const Unit& u, int wr, int wc, int fr, int fq) const {
        const int row0 = u.pm * BM + wr * 64 + fr, col0 = u.pn * BM + wc * 32 + 8 * fq;
#pragma unroll
        for (int ai = 0; ai < 2; ++ai)
#pragma unroll
            for (int m = 0; m < 4; ++m) { bf16_t* rowp = O + (size_t)(row0 + ai * HALF + m * 16) * ldc + col0;
#pragma unroll
                for (int bj = 0; bj < 2; ++bj) { const f32x4 v0 = acc[ai][bj][m][0], v1 = acc[ai][bj][m][1];
                    u32x4 w; w.x = cvt_pk_bf16(v0[0], v0[1]); w.y = cvt_pk_bf16(v0[2], v0[3]); w.z = cvt_pk_bf16(v1[0], v1[1]); w.w = cvt_pk_bf16(v1[2], v1[3]);
                    *(u32x4*)(rowp + bj * HALF) = w; } }
    }
};
template <int MODE> struct EpiGateRes {
    static constexpr bool PERM = false, AFTER_DRAIN = false;
    const float* base_p; const float* base_s; bf16_t* xb; const float* gate; float* slab; int ns;
    __device__ __forceinline__ void operator()(const f32x4 (&acc)[2][2][4][2], const Unit& u, int wr, int wc, int fr, int fq) const {
        typedef unsigned u32x2e __attribute__((ext_vector_type(2)));
        const int row0 = u.pm * BM + wr * 64 + fr, col0 = u.pn * BM + wc * 32 + 4 * fq;
        const bool smp = row0 >= TP; const float* base = smp ? base_s - (size_t)TP * D : base_p;
#pragma unroll
        for (int ai = 0; ai < 2; ++ai)
#pragma unroll
            for (int m = 0; m < 4; ++m) { const int r = row0 + ai * HALF + m * 16; const int cb = smp ? BATCH + ((r - TP) >> 3) : r / SEQ;
                const float* gp = gate + (size_t)cb * 6 * D + col0; const size_t off = (size_t)r * D + col0;
#pragma unroll
                for (int bj = 0; bj < 2; ++bj)
#pragma unroll
                    for (int n = 0; n < 2; ++n) {
                        if (u.atomic) { const int sidx = ((u.pm - TP / BM) * (D / BM) + u.pn) * ns + u.k0 / (u.nt * BK);
                            *(f32x4*)(slab + (size_t)sidx * 65536 + (size_t)(r - u.pm * BM) * 256 + (col0 - u.pn * BM) + bj * HALF + n * 16) = acc[ai][bj][m][n]; }
                        else { const f32x4 gv = *(const f32x4*)(gp + bj * HALF + n * 16); f32x4 bs;
                            if (MODE == 0) bs = *(const f32x4*)(base + off + bj * HALF + n * 16);
                            else { const u32x2e w = *(const u32x2e*)(xb + off + bj * HALF + n * 16); bs = (f32x4){__builtin_bit_cast(float, w.x << 16), __builtin_bit_cast(float, w.x & 0xffff0000u), __builtin_bit_cast(float, w.y << 16), __builtin_bit_cast(float, w.y & 0xffff0000u)}; }
                            const f32x4 v = bs + gv * acc[ai][bj][m][n];
                            *(u32x2e*)(xb + off + bj * HALF + n * 16) = (u32x2e){cvt_pk_bf16(v[0], v[1]), cvt_pk_bf16(v[2], v[3])}; } } }
    }
};
template <class Epi, class Sched, bool ALIGN_EPI = false, bool SP2 = false>
__device__ __forceinline__ void gemm_phase(PG8_LAS unsigned char* lds, const Gemm g, const Sched& S, const Epi& E) {
    const int tid = otid(), wid = __builtin_amdgcn_readfirstlane(tid >> 6), lane = tid & 63, wr = wid >> 2, wc = wid & 3, fr = lane & 15, fq = lane >> 4;
    const int K = g.K;
    unsigned voffA[2], voffB[2];
#pragma unroll
    for (int i = 0; i < 2; ++i) { int R, C; stage_rc(tid * 16 + i * 8192, R, C); const int Rb = Epi::PERM ? ((R & ~31) + perm32(R & 31)) : R;
        voffA[i] = (unsigned)(R * K + C) * 2u; voffB[i] = (unsigned)(Rb * K + C) * 2u; }
    const size_t kstep = (size_t)(BK * 2);
    const size_t hstep = (size_t)HALF * K * 2;
    const size_t tstep = 2 * hstep;
    const unsigned ldsw = (unsigned)wid * 1024u;
    const int aoff = lds_byte(wr * 64 + fr, fq * 8), boff = lds_byte(wc * 32 + fr, fq * 8);
#define PG8_SA(b, h) (((b) * 2 + (h)) * HTB)
#define PG8_SB(b, h) ((4 + (b) * 2 + (h)) * HTB)
#define PG8_STAGE(bufoff, gbase, voff) do { _Pragma("unroll") for (int _i = 0; _i < 2; ++_i) \
        __builtin_amdgcn_global_load_lds((const unsigned*)((const char*)(gbase) + (voff)[_i]), (PG8_LAS unsigned*)(lds + (bufoff) + ldsw + _i * 8192), 16, 0, 0); } while (0)
#define PG8_LDA(dst, b, h) do { _Pragma("unroll") for (int m = 0; m < 4; ++m) _Pragma("unroll") for (int k = 0; k < 2; ++k) dst[m][k] = *(const PG8_LAS bf16x8*)(lds + PG8_SA(b, h) + aoff + m * 2048 + k * 1024); } while (0)
#define PG8_LDB(dst, b, h) do { _Pragma("unroll") for (int n = 0; n < 2; ++n) _Pragma("unroll") for (int k = 0; k < 2; ++k) dst[n][k] = *(const PG8_LAS bf16x8*)(lds + PG8_SB(b, h) + boff + n * 2048 + k * 1024); } while (0)
#define PG8_MMA(ai, bj, At, Bt) do { __builtin_amdgcn_s_setprio(1); _Pragma("unroll") for (int m = 0; m < 4; ++m) _Pragma("unroll") for (int n = 0; n < 2; ++n) _Pragma("unroll") for (int k = 0; k < 2; ++k) \
        acc[ai][bj][m][n] = __builtin_amdgcn_mfma_f32_16x16x32_bf16(Bt[n][k], At[m][k], acc[ai][bj][m][n], 0, 0, 0); __builtin_amdgcn_s_setprio(0); } while (0)
#define PG8_WAIT_V(n) asm volatile("s_waitcnt vmcnt(" #n ")" ::: "memory")
#define PG8_WAIT_L(n) asm volatile("s_waitcnt lgkmcnt(" #n ")" ::: "memory")
#define PG8_BAR __builtin_amdgcn_s_barrier()
#define PG8_SCHED __builtin_amdgcn_sched_barrier(0)
    Unit cur, nxt; int ui = 0;
    if (!S.next(0, cur)) return;
    f32x4 acc[2][2][4][2];
#pragma unroll
    for (int a = 0; a < 2; ++a)
#pragma unroll
        for (int b = 0; b < 2; ++b)
#pragma unroll
            for (int m = 0; m < 4; ++m)
#pragma unroll
                for (int n = 0; n < 2; ++n) acc[a][b][m][n] = (f32x4){0.f, 0.f, 0.f, 0.f};
    bf16x8 At[4][2], B0[2][2], B1[2][2];
    const char* cA = (const char*)g.A + (size_t)cur.pm * tstep + (size_t)cur.k0 * 2; const char* cB = (const char*)g.Bt + (size_t)cur.pn * tstep + (size_t)cur.k0 * 2;
    S.a_ready(cur);
    if constexpr (SP2) {
        PG8_STAGE(PG8_SB(0, 0), cB, voffB); PG8_STAGE(PG8_SB(0, 1), cB + hstep, voffB); PG8_STAGE(PG8_SA(0, 0), cA, voffA); PG8_STAGE(PG8_SA(0, 1), cA + hstep, voffA);
        if (wr == 1) PG8_BAR;
        PG8_WAIT_V(2); PG8_BAR;
        PG8_STAGE(PG8_SB(1, 0), cB + kstep, voffB); PG8_STAGE(PG8_SA(1, 0), cA + kstep, voffA); PG8_STAGE(PG8_SB(1, 1), cB + hstep + kstep, voffB);
        PG8_WAIT_V(6); PG8_BAR;
    } else {
        PG8_STAGE(PG8_SB(0, 0), cB, voffB); PG8_STAGE(PG8_SA(0, 0), cA, voffA); PG8_STAGE(PG8_SB(0, 1), cB + hstep, voffB); PG8_STAGE(PG8_SA(0, 1), cA + hstep, voffA);
        if (wr == 1) PG8_BAR;
        PG8_WAIT_V(4); PG8_BAR;
        PG8_STAGE(PG8_SB(1, 0), cB + kstep, voffB); PG8_STAGE(PG8_SA(1, 0), cA + kstep, voffA); PG8_STAGE(PG8_SB(1, 1), cB + hstep + kstep, voffB);
        PG8_WAIT_V(6); PG8_BAR;
    }
    for (;;) {
        const bool has_next = S.next(ui + 1, nxt);
        const char* nA = has_next ? (const char*)g.A + (size_t)nxt.pm * tstep + (size_t)nxt.k0 * 2 : cA; const char* nB = has_next ? (const char*)g.Bt + (size_t)nxt.pn * tstep + (size_t)nxt.k0 * 2 : cB;
        const int nt = cur.nt;
        for (int t = 0; t < nt; t += 2) {
            const bool last = (t == nt - 2);
            const char* a1 = cA + (size_t)(t + 1) * kstep;
            const char* a2 = last ? nA : cA + (size_t)(t + 2) * kstep; const char* b2 = last ? nB : cB + (size_t)(t + 2) * kstep;
            const char* a3 = a2 + kstep; const char* b3 = b2 + kstep;
            if (last && has_next) S.a_ready(nxt);
            if constexpr (SP2) {
            PG8_LDB(B0, 0, 0); PG8_LDB(B1, 0, 1); PG8_SCHED; PG8_LDA(At, 0, 0); PG8_STAGE(PG8_SA(1, 1), a1 + hstep, voffA);
            PG8_WAIT_V(8); PG8_WAIT_L(0); PG8_BAR; PG8_MMA(0, 0, At, B0); PG8_MMA(0, 1, At, B1); PG8_BAR; PG8_SCHED;
            PG8_LDA(At, 0, 1); PG8_STAGE(PG8_SB(0, 0), b2, voffB); PG8_STAGE(PG8_SB(0, 1), b2 + hstep, voffB); PG8_STAGE(PG8_SA(0, 0), a2, voffA);
            PG8_WAIT_V(8); PG8_WAIT_L(0); PG8_BAR; PG8_MMA(1, 0, At, B0); PG8_MMA(1, 1, At, B1); PG8_BAR; PG8_SCHED;
            PG8_LDB(B0, 1, 0); PG8_LDB(B1, 1, 1); PG8_SCHED; PG8_LDA(At, 1, 0); PG8_STAGE(PG8_SA(0, 1), a2 + hstep, voffA);
            PG8_WAIT_V(8); PG8_WAIT_L(0); PG8_BAR; PG8_MMA(0, 0, At, B0); PG8_MMA(0, 1, At, B1); PG8_BAR; PG8_SCHED;
            PG8_LDA(At, 1, 1); PG8_STAGE(PG8_SB(1, 0), b3, voffB); PG8_STAGE(PG8_SB(1, 1), b3 + hstep, voffB); PG8_STAGE(PG8_SA(1, 0), a3, voffA);
            PG8_WAIT_V(8); PG8_WAIT_L(0); PG8_BAR; PG8_MMA(1, 0, At, B0); PG8_MMA(1, 1, At, B1); PG8_BAR; PG8_SCHED;
            } else {
            PG8_LDB(B0, 0, 0); PG8_SCHED; PG8_LDA(At, 0, 0); PG8_STAGE(PG8_SA(1, 1), a1 + hstep, voffA);
            PG8_WAIT_L(8); PG8_BAR; PG8_WAIT_L(0); PG8_MMA(0, 0, At, B0); PG8_BAR; PG8_SCHED;
            PG8_LDB(B1, 0, 1); PG8_STAGE(PG8_SB(0, 0), b2, voffB);
            PG8_BAR; PG8_WAIT_L(0); PG8_MMA(0, 1, At, B1); PG8_BAR;
            PG8_LDA(At, 0, 1); PG8_STAGE(PG8_SA(0, 0), a2, voffA);
            PG8_BAR; PG8_WAIT_L(0); PG8_MMA(1, 0, At, B0); PG8_BAR; PG8_SCHED;
            PG8_STAGE(PG8_SB(0, 1), b2 + hstep, voffB);
            PG8_WAIT_V(6); PG8_BAR; PG8_MMA(1, 1, At, B1); PG8_BAR;
            PG8_LDB(B0, 1, 0); PG8_SCHED; PG8_LDA(At, 1, 0); PG8_STAGE(PG8_SA(0, 1), a2 + hstep, voffA);
            PG8_WAIT_L(8); PG8_BAR; PG8_WAIT_L(0); PG8_MMA(0, 0, At, B0); PG8_BAR; PG8_SCHED;
            PG8_LDB(B1, 1, 1); PG8_STAGE(PG8_SB(1, 0), b3, voffB);
            PG8_BAR; PG8_WAIT_L(0); PG8_MMA(0, 1, At, B1); PG8_BAR;
            PG8_LDA(At, 1, 1); PG8_STAGE(PG8_SA(1, 0), a3, voffA);
            PG8_BAR; PG8_WAIT_L(0); PG8_MMA(1, 0, At, B0); PG8_BAR; PG8_SCHED;
            PG8_STAGE(PG8_SB(1, 1), b3 + hstep, voffB);
            PG8_WAIT_V(6); PG8_BAR; PG8_MMA(1, 1, At, B1); PG8_BAR;
            }
        }
        if constexpr (ALIGN_EPI) { if (wr == 0) PG8_BAR; }
        if constexpr (!Epi::AFTER_DRAIN) { E(acc, cur, wr, wc, fr, fq); S.done(cur); }
        if (!has_next) break;
#pragma unroll
        for (int a = 0; a < 2; ++a)
#pragma unroll
            for (int b = 0; b < 2; ++b)
#pragma unroll
                for (int m = 0; m < 4; ++m)
#pragma unroll
                    for (int n = 0; n < 2; ++n) acc[a][b][m][n] = (f32x4){0.f, 0.f, 0.f, 0.f};
        cur = nxt; cA = nA; cB = nB; ++ui;
        if constexpr (ALIGN_EPI) { if (wr == 1) PG8_BAR; }
    }
    PG8_WAIT_V(0);
    if constexpr (!ALIGN_EPI) { if (wr == 0) PG8_BAR; }
    PG8_BAR;
    if constexpr (Epi::AFTER_DRAIN) { E.fused(acc, cur, wr, wc, fr, fq, lds, wid, lane); S.done(cur); }
#undef PG8_SA
#undef PG8_SB
#undef PG8_STAGE
#undef PG8_LDA
#undef PG8_LDB
#undef PG8_MMA
#undef PG8_WAIT_V
#undef PG8_WAIT_L
#undef PG8_BAR
#undef PG8_SCHED
}
}
typedef short bf16x8 __attribute__((ext_vector_type(8)));
constexpr int FR_NWK = 0, FR_QD = 16, FR_KTT = 32, FR_QK = 48, FR_N = 56;
__device__ __forceinline__ int kperm(int g, int j) { return j < 4 ? 4 * g + j : 16 + 4 * g + (j - 4); }

typedef float f32x2_t __attribute__((ext_vector_type(2))); typedef __bf16 bf16x2_t __attribute__((ext_vector_type(2)));
__device__ __forceinline__ unsigned cvtpk_c(float lo, float hi) { const f32x2_t v = {lo, hi}; const bf16x2_t b = __builtin_convertvector(v, bf16x2_t); return __builtin_bit_cast(unsigned, b); }
__device__ __forceinline__ bf16x8 pack8(const f32x4 a, const f32x4 b) {
    return __builtin_bit_cast(bf16x8, (u32x4){cvtpk_c(a[0], a[1]), cvtpk_c(a[2], a[3]), cvtpk_c(b[0], b[1]), cvtpk_c(b[2], b[3])});
}
constexpr int DP_KP = 136;
constexpr int DP_RP = 72;
constexpr int DP_QS = 0, DP_KS = DP_QS + 64 * DP_KP * 2, DP_RHST = DP_KS + 64 * DP_KP * 2, DP_AM = DP_RHST + 256 * DP_RP * 2, DP_AMP = 68,
              DP_QKM = DP_AM + 64 * DP_AMP * 4, DP_QKP = 72, DP_GS = DP_QKM + 64 * DP_QKP * 2, DP_DM = DP_GS + 4 * 64 * 4, DP_DMP = 20,
              DP_TB = DP_DM + 64 * DP_DMP * 4, DP_END = DP_TB + 64 * DP_RP * 2;
static_assert(DP_END <= 131072 && DP_AM % 16 == 0 && DP_DM % 16 == 0 && DP_TB % 16 == 0 && DP_RHST % 16 == 0, "dnprep LDS");
#ifndef DPS
#define DPS(k)
#endif
__device__ __forceinline__ void phase_dnprep(const P& p, LAS unsigned char* lds, unsigned long long& pr_prev, unsigned long long& pr_acc) {
    const int tid_ = otid();
    LAS bf16_t* QS = (LAS bf16_t*)(lds + DP_QS); LAS bf16_t* KS = (LAS bf16_t*)(lds + DP_KS); LAS bf16_t* RHST = (LAS bf16_t*)(lds + DP_RHST);
    LAS float* AM = (LAS float*)(lds + DP_AM); LAS bf16_t* QKM = (LAS bf16_t*)(lds + DP_QKM); LAS float* GS = (LAS float*)(lds + DP_GS);
    LAS float* DM = (LAS float*)(lds + DP_DM); LAS bf16_t* TB = (LAS bf16_t*)(lds + DP_TB);
    const bf16_t* PR = ws_h(p, WS_PROJ); const float* BG = ws_f(p, WS_BG);
    for (int i = tid_; i < 64 * DP_RP / 2; i += NTHR) ((LAS unsigned*)TB)[i] = 0u;
    float pgx = 0.f, pbx = 0.f, cw[3][4][2]; unsigned xr[3][11];
#define DP_FETCH(uid_, ln_, wv_) do { const int n_ = (uid_) % NCHUNK, bh_ = (uid_) / NCHUNK, h_ = bh_ & 3, m0_ = (bh_ >> 2) * SEQ + n_ * 64; \
        if ((wv_) == 0) { pgx = BG[(size_t)(m0_ + (ln_)) * 8 + 4 + h_]; pbx = BG[(size_t)(m0_ + (ln_)) * 8 + h_]; } \
        _Pragma("unroll") for (int part = 0; part < 3; ++part) _Pragma("unroll") for (int j = 0; j < 4; ++j) { const float* w = p.dn_conv_w + j * 1536 + part * 512 + h_ * 128 + 2 * (ln_); cw[part][j][0] = w[0]; cw[part][j][1] = w[1]; } \
        _Pragma("unroll") for (int rr = 0; rr < 11; ++rr) { const int t_ = n_ * 64 + (wv_) * 8 + rr - 3; \
            _Pragma("unroll") for (int part = 0; part < 3; ++part) { unsigned v_ = 0u; if (t_ >= 0) v_ = *(const unsigned*)(PR + (size_t)(m0_ + (wv_) * 8 + rr - 3) * PLD + part * 512 + h_ * 128 + 2 * (ln_)); xr[part][rr] = v_; } } } while (0)
    if ((int)blockIdx.x < NUNIT) { int t0 = tid_; asm volatile("" : "+v"(t0)); DP_FETCH((int)blockIdx.x, t0 & 63, t0 >> 6); }
    for (int uid = blockIdx.x; uid < NUNIT; uid += gridDim.x) {
        const int n = uid % NCHUNK;
        int tid = tid_; asm volatile("" : "+v"(tid));
        const int lane = tid & 63, wave = tid >> 6, r16 = lane & 15, g4 = lane >> 4;
        unsigned char* abu = p.ws + WS_DNF_AB + (size_t)uid * DNF_AB_UNIT;
        if (wave == 0) {
            float x = pgx;
#pragma unroll
            for (int o = 1; o < 64; o <<= 1) { const float t = __shfl_up(x, o); if (lane >= o) x += t; }
            const float gl = __shfl(x, 63);
            GS[lane] = x; GS[64 + lane] = pbx; GS[128 + lane] = __expf(x); GS[192 + lane] = __expf(gl - x);
            if (lane == 0) ws_f(p, WS_DNF_CD)[uid] = __expf(gl);
        }
        __syncthreads();
        {
            float c[8][3][2], ssum[16];
#pragma unroll
            for (int i = 0; i < 8; ++i) {
#pragma unroll
                for (int part = 0; part < 3; ++part)
#pragma unroll
                    for (int e = 0; e < 2; ++e) { float a = 0.f;
#pragma unroll
                        for (int j = 0; j < 4; ++j) a += cw[part][j][e] * (e == 0 ? __builtin_bit_cast(float, xr[part][i + j] << 16) : __builtin_bit_cast(float, xr[part][i + j] & 0xffff0000u));
                        c[i][part][e] = a * __builtin_amdgcn_rcpf(1.0f + __expf(-a)); }
                ssum[2 * i] = c[i][0][0] * c[i][0][0] + c[i][0][1] * c[i][0][1]; ssum[2 * i + 1] = c[i][1][0] * c[i][1][0] + c[i][1][1] * c[i][1][1]; }
#pragma unroll
            for (int o = 1; o < 64; o <<= 1) {
#pragma unroll
                for (int q = 0; q < 16; ++q) ssum[q] += __shfl_xor(ssum[q], o); }
#pragma unroll
            for (int i = 0; i < 8; ++i) { const int row = wave * 8 + i;
                const float rq = 0.08838834764831845f * __builtin_amdgcn_rsqf(ssum[2 * i] + EPS), rk = __builtin_amdgcn_rsqf(ssum[2 * i + 1] + EPS);
                const float beta = GS[64 + row], eg = GS[128 + row];
                const float q0 = c[i][0][0] * rq, q1 = c[i][0][1] * rq, k0 = c[i][1][0] * rk, k1 = c[i][1][1] * rk;
                *(LAS unsigned*)(QS + row * DP_KP + 2 * lane) = pk2(q0, q1);
                *(LAS unsigned*)(KS + row * DP_KP + 2 * lane) = pk2(k0, k1);
                RHST[(2 * lane) * DP_RP + row] = f2bf(beta * c[i][2][0]); RHST[(2 * lane + 1) * DP_RP + row] = f2bf(beta * c[i][2][1]);
                RHST[(128 + 2 * lane) * DP_RP + row] = f2bf(beta * eg * k0); RHST[(128 + 2 * lane + 1) * DP_RP + row] = f2bf(beta * eg * k1); }
        }
        if (uid + (int)gridDim.x < NUNIT) DP_FETCH(uid + (int)gridDim.x, lane, wave);
        __syncthreads(); DPS(16);
        {
            const int ti = wave >> 1;
            f32x4 akk[2], aqk[2];
#pragma unroll
            for (int c = 0; c < 2; ++c) { akk[c] = (f32x4){0.f, 0.f, 0.f, 0.f}; aqk[c] = (f32x4){0.f, 0.f, 0.f, 0.f}; }
#pragma unroll
            for (int kb = 0; kb < 4; ++kb) {
                const bf16x8 ak = *(const LAS bf16x8*)(KS + (16 * ti + r16) * DP_KP + 32 * kb + 8 * g4), aq = *(const LAS bf16x8*)(QS + (16 * ti + r16) * DP_KP + 32 * kb + 8 * g4);
#pragma unroll
                for (int c = 0; c < 2; ++c) { const int tj = 2 * (wave & 1) + c; const bf16x8 bk = *(const LAS bf16x8*)(KS + (16 * tj + r16) * DP_KP + 32 * kb + 8 * g4);
                    akk[c] = __builtin_amdgcn_mfma_f32_16x16x32_bf16(ak, bk, akk[c], 0, 0, 0); aqk[c] = __builtin_amdgcn_mfma_f32_16x16x32_bf16(aq, bk, aqk[c], 0, 0, 0); }
            }
#pragma unroll
            for (int c = 0; c < 2; ++c) { const int tj = 2 * (wave & 1) + c, J = 16 * tj + r16; const float gj = GS[J];
#pragma unroll
                for (int i = 0; i < 4; ++i) { const int I = 16 * ti + 4 * g4 + i; const float dec = I >= J ? __expf(GS[I] - gj) : 0.f;
                    AM[I * DP_AMP + J] = I > J ? GS[64 + I] * akk[c][i] * dec : 0.f; QKM[I * DP_QKP + J] = f2bf(aqk[c][i] * dec); } }
        }
        __syncthreads(); DPS(17);
        if (wave == 0) {
            const int bb = g4, cc = r16; float t[16];
            f32x4 tr[16][4];
#pragma unroll
            for (int i = 1; i < 16; ++i)
#pragma unroll
                for (int j4 = 0; j4 < (i + 3) / 4; ++j4) tr[i][j4] = *(const LAS f32x4*)(AM + (16 * bb + i) * DP_AMP + 16 * bb + 4 * j4);
            __builtin_amdgcn_sched_barrier(0);
#pragma unroll
            for (int i = 0; i < 16; ++i) { float acc = (i == cc) ? 1.f : 0.f;
#pragma unroll
                for (int j = 0; j < i; ++j) acc -= tr[i][j >> 2][j & 3] * t[j];
                t[i] = acc; }
#pragma unroll
            for (int i = 0; i < 16; ++i) { DM[(16 * bb + i) * DP_DMP + cc] = t[i]; TB[(16 * bb + i) * DP_RP + 16 * bb + cc] = f2bf(t[i]); }
        } else if (wave >= 4) {
            for (int f = FR_QD + (wave - 4); f < FR_N; f += 4) {
                u32x4 o;
                if (f < FR_KTT) { const int mt = (f - FR_QD) >> 2, kb = (f - FR_QD) & 3, row = 16 * mt + r16; const float sc = GS[128 + row];
                    const u32x2 lo = *(const LAS u32x2*)(QS + row * DP_KP + 32 * kb + 4 * g4), hi = *(const LAS u32x2*)(QS + row * DP_KP + 32 * kb + 16 + 4 * g4);
                    const unsigned w[4] = {lo.x, lo.y, hi.x, hi.y}; unsigned r[4];
#pragma unroll
                    for (int e = 0; e < 4; ++e) r[e] = cvtpk_c(__builtin_bit_cast(float, w[e] << 16) * sc, __builtin_bit_cast(float, w[e] & 0xffff0000u) * sc);
                    o = (u32x4){r[0], r[1], r[2], r[3]};
                } else if (f < FR_QK) { const int kt = (f - FR_KTT) >> 1, tb = (f - FR_KTT) & 1; float v[8];
#pragma unroll
                    for (int j = 0; j < 8; ++j) { const int tok = 32 * tb + kperm(g4, j); v[j] = bf2f(KS[tok * DP_KP + 16 * kt + r16]) * GS[192 + tok]; }
                    o = (u32x4){cvtpk_c(v[0], v[1]), cvtpk_c(v[2], v[3]), cvtpk_c(v[4], v[5]), cvtpk_c(v[6], v[7])};
                } else { const int mt = (f - FR_QK) >> 1, tb = (f - FR_QK) & 1, row = 16 * mt + r16;
                    const u32x2 lo = *(const LAS u32x2*)(QKM + row * DP_QKP + 32 * tb + 4 * g4), hi = *(const LAS u32x2*)(QKM + row * DP_QKP + 32 * tb + 16 + 4 * g4);
                    o = (u32x4){lo.x, lo.y, hi.x, hi.y}; }
                *(u32x4*)(abu + (size_t)f * 1024 + lane * 16) = o;
            }
        }
        __syncthreads(); DPS(18);
        if (wave < 3) {
            const int j = wave; f32x4 Tk[4];
#pragma unroll
            for (int kk = 0; kk < 4; ++kk) Tk[j][kk] = DM[(16 * j + 4 * g4 + kk) * DP_DMP + r16];
#pragma unroll
            for (int i = 1; i < 4; ++i) if (i > j) {
                f32x4 acc = (f32x4){0.f, 0.f, 0.f, 0.f};
#pragma unroll
                for (int k = 0; k < 3; ++k) if (k >= j && k < i) { const f32x4 a = *(const LAS f32x4*)(AM + (16 * i + r16) * DP_AMP + 16 * k + 4 * g4);
#pragma unroll
                    for (int kk = 0; kk < 4; ++kk) acc = __builtin_amdgcn_mfma_f32_16x16x4f32(a[kk], Tk[k][kk], acc, 0, 0, 0); }
                const f32x4 dd = *(const LAS f32x4*)(DM + (16 * i + r16) * DP_DMP + 4 * g4);
                f32x4 res = (f32x4){0.f, 0.f, 0.f, 0.f};
#pragma unroll
                for (int kk = 0; kk < 4; ++kk) res = __builtin_amdgcn_mfma_f32_16x16x4f32(dd[kk], acc[kk], res, 0, 0, 0);
                Tk[i] = -res;
#pragma unroll
                for (int e = 0; e < 4; ++e) TB[(16 * i + 4 * g4 + e) * DP_RP + 16 * j + r16] = f2bf(Tk[i][e]); }
        }
        __syncthreads(); DPS(19);
        {
            const int mt = wave & 3, half = wave >> 2;
            bf16x8 tf[2];
#pragma unroll
            for (int kb = 0; kb < 2; ++kb) tf[kb] = *(const LAS bf16x8*)(TB + (16 * mt + r16) * DP_RP + 32 * kb + 8 * g4);
            if (half == 0) {
                float* wv = (float*)(p.ws + WS_DNF_WV + (size_t)uid * DNF_WV_UNIT) + (size_t)mt * 256 + lane * 4;
#pragma unroll
                for (int vt = 0; vt < 8; ++vt) { f32x4 acc = (f32x4){0.f, 0.f, 0.f, 0.f};
#pragma unroll
                    for (int kb = 0; kb < 2; ++kb) acc = __builtin_amdgcn_mfma_f32_16x16x32_bf16(tf[kb], *(const LAS bf16x8*)(RHST + (16 * vt + r16) * DP_RP + 32 * kb + 8 * g4), acc, 0, 0, 0);
                    *(f32x4*)(wv + (size_t)vt * 1024) = acc; }
            } else {
#pragma unroll
                for (int kbp = 0; kbp < 4; ++kbp) { f32x4 xt[2];
#pragma unroll
                    for (int c2 = 0; c2 < 2; ++c2) { xt[c2] = (f32x4){0.f, 0.f, 0.f, 0.f};
#pragma unroll
                        for (int kb = 0; kb < 2; ++kb) xt[c2] = __builtin_amdgcn_mfma_f32_16x16x32_bf16(*(const LAS bf16x8*)(RHST + (128 + 16 * (2 * kbp + c2) + r16) * DP_RP + 32 * kb + 8 * g4), tf[kb], xt[c2], 0, 0, 0); }
                    *(u32x4*)(abu + (size_t)(FR_NWK + mt * 4 + kbp) * 1024 + lane * 16) = __builtin_bit_cast(u32x4, pack8(-xt[0], -xt[1])); }
            }
        }
        __syncthreads(); DPS(20);
    }
#undef DP_FETCH
}

constexpr size_t O_ODN = O_Y;
#define DN_SB() __builtin_amdgcn_sched_barrier(0)
__device__ __forceinline__ void dn_consume(const LAS unsigned char* fb, int wl, f32x4 (&S)[8], float cd, float* op) {
    f32x4 u[4], o[4];
    bf16x8 fa[16], fq[16], Sb[4], Ub[2];
#pragma unroll
    for (int mt = 0; mt < 4; ++mt) u[mt] = *(const LAS f32x4*)(fb + (FR_N + wl * 4 + mt) * 1024);
#pragma unroll
    for (int f = 0; f < 16; ++f) fa[f] = *(const LAS bf16x8*)(fb + (FR_NWK + f) * 1024);
#pragma unroll
    for (int f = 0; f < 8; ++f) fq[f] = *(const LAS bf16x8*)(fb + (FR_QD + f) * 1024);
    DN_SB();
#pragma unroll
    for (int kb = 0; kb < 4; ++kb) Sb[kb] = pack8(S[2 * kb], S[2 * kb + 1]);
#pragma unroll
    for (int mt = 0; mt < 4; ++mt)
#pragma unroll
        for (int kb = 0; kb < 4; ++kb) u[mt] = __builtin_amdgcn_mfma_f32_16x16x32_bf16(fa[mt * 4 + kb], Sb[kb], u[mt], 0, 0, 0);
    DN_SB();
#pragma unroll
    for (int f = 8; f < 16; ++f) fq[f] = *(const LAS bf16x8*)(fb + (FR_QD + f) * 1024);
#pragma unroll
    for (int f = 0; f < 8; ++f) fa[f] = *(const LAS bf16x8*)(fb + (FR_KTT + f) * 1024);
    DN_SB();
#pragma unroll
    for (int mt = 0; mt < 4; ++mt) { o[mt] = (f32x4){0.f, 0.f, 0.f, 0.f};
#pragma unroll
        for (int kb = 0; kb < 4; ++kb) o[mt] = __builtin_amdgcn_mfma_f32_16x16x32_bf16(fq[mt * 4 + kb], Sb[kb], o[mt], 0, 0, 0); }
    DN_SB();
#pragma unroll
    for (int f = 8; f < 16; ++f) fa[f] = *(const LAS bf16x8*)(fb + (FR_KTT + f) * 1024);
#pragma unroll
    for (int f = 0; f < 8; ++f) fq[f] = *(const LAS bf16x8*)(fb + (FR_QK + f) * 1024);
#pragma unroll
    for (int tb = 0; tb < 2; ++tb) Ub[tb] = pack8(u[2 * tb], u[2 * tb + 1]);
#pragma unroll
    for (int kt = 0; kt < 8; ++kt) S[kt] = S[kt] * cd;
    DN_SB();
#pragma unroll
    for (int kt = 0; kt < 8; ++kt)
#pragma unroll
        for (int tb = 0; tb < 2; ++tb) S[kt] = __builtin_amdgcn_mfma_f32_16x16x32_bf16(fa[kt * 2 + tb], Ub[tb], S[kt], 0, 0, 0);
#pragma unroll
    for (int mt = 0; mt < 4; ++mt) {
#pragma unroll
        for (int tb = 0; tb < 2; ++tb) o[mt] = __builtin_amdgcn_mfma_f32_16x16x32_bf16(fq[mt * 2 + tb], Ub[tb], o[mt], 0, 0, 0);
#pragma unroll
        for (int i = 0; i < 4; ++i) op[(size_t)(16 * mt + i) * 512] = o[mt][i]; }
}
constexpr int DN_SBUF = 73728;
__device__ __forceinline__ void phase_dnscan(const P& p, LAS unsigned char* lds) {
    if (blockIdx.x >= BATCH * 4 * 2) return;
    const int tid = otid(), lane = tid & 63, wave = __builtin_amdgcn_readfirstlane(tid >> 6), r16 = lane & 15, g4 = lane >> 4;
    const int bh = blockIdx.x >> 1, vh = blockIdx.x & 1, h = bh & 3, b = bh >> 2, wl = wave & 3, vs = vh * 4 + wl, v0 = vs * 16;
    const float* cdp = ws_f(p, WS_DNF_CD) + (size_t)bh * NCHUNK;
    float* odn = p.out + O_ODN;
#define DN_BAR() do { asm volatile("s_waitcnt lgkmcnt(0)" ::: "memory"); __builtin_amdgcn_s_barrier(); asm volatile("" ::: "memory"); } while (0)
    if (wave >= 4) {
        const unsigned char* ab = p.ws + WS_DNF_AB + (size_t)bh * NCHUNK * DNF_AB_UNIT + lane * 16;
        const unsigned char* wvb = p.ws + WS_DNF_WV + (size_t)bh * NCHUNK * DNF_WV_UNIT + (size_t)vh * 16 * 1024 + lane * 16;
        u32x4 R[3][18];
#define DN_SRC(n_, q_) ((q_) < FR_N ? ab + (size_t)(n_) * DNF_AB_UNIT + (q_) * 1024 : wvb + (size_t)(n_) * DNF_WV_UNIT + ((q_) - FR_N) * 1024)
#define DN_LD(n_, s_) do { if ((n_) < NCHUNK) { _Pragma("unroll") for (int i_ = 0; i_ < 18; ++i_) R[s_][i_] = *(const u32x4*)DN_SRC(n_, wl * 18 + i_); } } while (0)
#define DN_ST(n_, s_) do { if ((n_) < NCHUNK) { LAS unsigned char* d_ = lds + ((n_) & 1) * DN_SBUF + wl * 18 * 1024 + lane * 16; _Pragma("unroll") for (int i_ = 0; i_ < 18; ++i_) *(LAS u32x4*)(d_ + i_ * 1024) = R[s_][i_]; } } while (0)
        DN_LD(0, 0); DN_LD(1, 1); DN_LD(2, 2); DN_ST(0, 0);
        DN_BAR();
#define DN_LSTEP(n_, s_) do { const int n = (n_); if (n < NCHUNK) { DN_LD(n + 3, s_); DN_ST(n + 1, ((s_) + 1) % 3); DN_BAR(); } } while (0)
        for (int n3 = 0; n3 < NCHUNK; n3 += 3) { DN_LSTEP(n3, 0); DN_LSTEP(n3 + 1, 1); DN_LSTEP(n3 + 2, 2); }
#undef DN_LSTEP
#undef DN_LD
#undef DN_ST
#undef DN_SRC
        return;
    }
    f32x4 S[8];
#pragma unroll
    for (int t = 0; t < 8; ++t) S[t] = (f32x4){0.f, 0.f, 0.f, 0.f};
    float cd = cdp[0];
    DN_BAR();
    for (int n = 0; n < NCHUNK; ++n) {
        const float cdn = cdp[n + 1 < NCHUNK ? n + 1 : n];
        dn_consume(lds + (n & 1) * DN_SBUF + lane * 16, wl, S, cd, odn + (size_t)(b * SEQ + n * 64 + 4 * g4) * 512 + h * 128 + v0 + r16);
        cd = cdn;
        DN_BAR();
    }
#undef DN_BAR
    {
        float* so = p.out + O_PSSM + (size_t)bh * 128 * 128 + v0 + r16;
#pragma unroll
        for (int kt = 0; kt < 8; ++kt)
#pragma unroll
            for (int i = 0; i < 4; ++i) so[(size_t)(16 * kt + 4 * g4 + i) * 128] = S[kt][i];
    }
}
__device__ __forceinline__ void phase_dngate(const P& p) {
    const int tid_ = otid(), lane = tid_ & 63, wave = tid_ >> 6;
    const int gw = blockIdx.x * NWAVES + wave, NGW = gridDim.x * NWAVES;
    const f32x4 nw0 = *(const f32x4*)(p.dn_norm_w + (lane & 15) * 8), nw1 = *(const f32x4*)(p.dn_norm_w + (lane & 15) * 8 + 4);
    f32x4 a, c; u32x4 z;
#define DG_LOAD(m_) do { const float* o_ = p.out + O_ODN + (size_t)(m_) * 512 + lane * 8; a = *(const f32x4*)o_; c = *(const f32x4*)(o_ + 4); z = *(const u32x4*)(ws_h(p, WS_PROJ) + (size_t)(m_) * PLD + PC_Z + lane * 8); } while (0)
    if (gw < TP) DG_LOAD(gw);
    for (int m = gw; m < TP; m += NGW) {
        const f32x4 a0 = a, c0 = c; const u32x4 z0 = z;
        if (m + NGW < TP) DG_LOAD(m + NGW);
        float ss = (a0[0] * a0[0] + a0[1] * a0[1]) + (a0[2] * a0[2] + a0[3] * a0[3]) + (c0[0] * c0[0] + c0[1] * c0[1]) + (c0[2] * c0[2] + c0[3] * c0[3]);
#pragma unroll
        for (int off = 1; off < 16; off <<= 1) ss += __shfl_xor(ss, off);
        const float rstd = 1.0f / sqrtf(ss * (1.0f / 128.0f) + EPS);
        const unsigned zw[4] = {z0.x, z0.y, z0.z, z0.w}; const float ov[8] = {a0[0], a0[1], a0[2], a0[3], c0[0], c0[1], c0[2], c0[3]}; const float nwv[8] = {nw0[0], nw0[1], nw0[2], nw0[3], nw1[0], nw1[1], nw1[2], nw1[3]};
        unsigned r[4];
#pragma unroll
        for (int e = 0; e < 4; ++e) { const float z0f = __builtin_bit_cast(float, zw[e] << 16), z1f = __builtin_bit_cast(float, zw[e] & 0xffff0000u);
            r[e] = pk2(ov[2 * e] * rstd * nwv[2 * e] * silu_f(z0f), ov[2 * e + 1] * rstd * nwv[2 * e + 1] * silu_f(z1f)); }
        *(u32x4*)(ws_h(p, WS_MIX) + (size_t)m * 1024 + lane * 8) = (u32x4){r[0], r[1], r[2], r[3]};
    }
#undef DG_LOAD
}
__device__ __forceinline__ void phase_dnsample(const P& p, LAS unsigned char* lds, unsigned long long& pr_prev, unsigned long long& pr_acc) {
    const int tid = otid(), lane = tid & 63, us = tid >> 8, w4 = (tid >> 6) & 3, kh = lane >> 5, col_ = w4 * 32 + (lane & 31);
    LAS float* QH = (LAS float*)lds + us * 4352;
    LAS float* KH = QH + 1024; LAS float* VH = QH + 2048; LAS float* OH = QH + 3072; LAS float* RED = QH + 4096;
    const bf16_t* PR = ws_h(p, WS_PROJ); const float* BG = ws_f(p, WS_BG);
    for (int ub = blockIdx.x; ub < DEC_BATCH * 2; ub += gridDim.x) {
        const int uidx = ub * 2 + us, b = uidx >> 2, h = uidx & 3, m0 = TP + b * DEC_SEQ;
        int col = col_; asm volatile("" : "+v"(col));
        {
            float x0[11], x1[11];
            const int ch0 = kh * 512 + h * 128 + col;
#pragma unroll
            for (int rr = 0; rr < 11; ++rr) {
                if (rr < 3) { const float* st = p.state_dn_conv + ((size_t)b * 3 + rr) * 1536; x0[rr] = st[ch0]; x1[rr] = st[1024 + h * 128 + col]; }
                else { const bf16_t* pr = PR + (size_t)(m0 + rr - 3) * PLD; x0[rr] = bf2f(pr[ch0]); x1[rr] = bf2f(pr[1024 + h * 128 + col]); } }
            float w0[4], w1[4];
#pragma unroll
            for (int j = 0; j < 4; ++j) { w0[j] = p.dn_conv_w[j * 1536 + ch0]; w1[j] = p.dn_conv_w[j * 1536 + 1024 + h * 128 + col]; }
            float ssq[8], ssk[8];
#pragma unroll
            for (int t = 0; t < 8; ++t) { float a = 0.f, d = 0.f;
#pragma unroll
                for (int j = 0; j < 4; ++j) { a += w0[j] * x0[t + j]; d += w1[j] * x1[t + j]; }
                a = a * __builtin_amdgcn_rcpf(1.0f + __expf(-a)); d = d * __builtin_amdgcn_rcpf(1.0f + __expf(-d));
                if (kh == 0) { QH[t * 128 + col] = a; VH[t * 128 + col] = d; } else KH[t * 128 + col] = a;
                ssq[t] = kh == 0 ? a * a : 0.f; ssk[t] = kh == 1 ? a * a : 0.f; }
#pragma unroll
            for (int o = 1; o < 64; o <<= 1) {
#pragma unroll
                for (int t = 0; t < 8; ++t) { ssq[t] += __shfl_xor(ssq[t], o); ssk[t] += __shfl_xor(ssk[t], o); } }
            if (lane == 0) {
#pragma unroll
                for (int t = 0; t < 8; ++t) { RED[w4 * 16 + t] = ssq[t]; RED[w4 * 16 + 8 + t] = ssk[t]; } }
        }
        __syncthreads(); DPS(27);
#pragma unroll
        for (int t = 0; t < 8; ++t) {
            if (kh == 0) { const float sq = (RED[t] + RED[16 + t]) + (RED[32 + t] + RED[48 + t]); QH[t * 128 + col] *= 0.08838834764831845f / sqrtf(sq + EPS); }
            else { const float sk = (RED[8 + t] + RED[24 + t]) + (RED[40 + t] + RED[56 + t]); KH[t * 128 + col] *= 1.0f / sqrtf(sk + EPS); } }
        __syncthreads(); DPS(28);
        float S[64];
        const float* S0 = p.state_dn_ssm + ((size_t)b * 4 + h) * 128 * 128 + (size_t)kh * 64 * 128 + col;
#pragma unroll
        for (int k = 0; k < 64; ++k) { S[k] = *S0; S0 += 128; if ((k & 7) == 7) asm volatile("" : "+v"(S0)); }
#pragma unroll 1
        for (int t = 0; t < 8; ++t) {
            const float beta = BG[(size_t)(m0 + t) * 8 + h], eg = __expf(BG[(size_t)(m0 + t) * 8 + 4 + h]);
            const LAS float* kp = KH + t * 128 + kh * 64; const LAS float* qp = QH + t * 128 + kh * 64;
            f32x4 kk[16], qq[16];
#pragma unroll
            for (int k4 = 0; k4 < 16; ++k4) kk[k4] = *(const LAS f32x4*)(kp + 4 * k4);
#pragma unroll
            for (int k4 = 0; k4 < 16; ++k4) qq[k4] = *(const LAS f32x4*)(qp + 4 * k4);
            const float vt = VH[t * 128 + col];
            __builtin_amdgcn_sched_barrier(0);
            float kS = 0.f;
#pragma unroll
            for (int k4 = 0; k4 < 16; ++k4)
#pragma unroll
                for (int e = 0; e < 4; ++e) { S[4 * k4 + e] *= eg; kS += kk[k4][e] * S[4 * k4 + e]; }
            kS += __shfl_xor(kS, 32);
            const float u = beta * (vt - kS);
            float o = 0.f;
#pragma unroll
            for (int k4 = 0; k4 < 16; ++k4)
#pragma unroll
                for (int e = 0; e < 4; ++e) { S[4 * k4 + e] += kk[k4][e] * u; o += qq[k4][e] * S[4 * k4 + e]; }
            o += __shfl_xor(o, 32);
            if (kh == 0) OH[t * 128 + col] = o;
            __builtin_amdgcn_sched_barrier(0);
        }
        float* So = p.out + O_SSSM + ((size_t)b * 4 + h) * 128 * 128 + (size_t)kh * 64 * 128 + col;
#pragma unroll
        for (int k = 0; k < 64; ++k) { *So = S[k]; So += 128; if ((k & 7) == 7) asm volatile("" : "+v"(So)); }
        __syncthreads(); DPS(29);
#pragma unroll
        for (int t = 0; t < 8; ++t) { const float o = kh == 0 ? OH[t * 128 + col] : 0.f; const float s = wave_sum(o * o); if (lane == 0) RED[w4 * 16 + t] = s; }
        __syncthreads();
        if (kh == 0) {
            const float nw = p.dn_norm_w[col];
#pragma unroll
            for (int t = 0; t < 8; ++t) { const float rstd = 1.0f / sqrtf(((RED[t] + RED[16 + t]) + (RED[32 + t] + RED[48 + t])) * (1.0f / 128.0f) + EPS);
                const float z = bf2f(PR[(size_t)(m0 + t) * PLD + PC_Z + h * 128 + col]);
                ws_h(p, WS_MIX)[(size_t)(m0 + t) * 1024 + h * 128 + col] = f2bf(OH[t * 128 + col] * rstd * nw * silu_f(z)); }
        }
        __syncthreads(); DPS(30);
    }
}
constexpr int NSEG = 16, CSEG = NCHUNK / NSEG, NBH = BATCH * 4;
static_assert(NCHUNK % NSEG == 0, "segments");
constexpr size_t O_RFRAG = O_ODN + (size_t)TP * 512;
constexpr size_t O_BSEG = O_RFRAG + (size_t)NBH * NSEG * 8192;
constexpr size_t O_SSEG = O_BSEG + (size_t)NBH * NSEG * 16384;
constexpr size_t O_CPROD = O_SSEG + (size_t)NBH * NSEG * 16384;
static_assert(O_CPROD + NBH * NSEG <= (size_t)T * D, "segment scratch fits in the y region of d_out");

template <bool HASWV> __device__ __forceinline__ void dn_consume_map(const LAS unsigned char* fb, int wl, f32x4 (&X)[8], float cd) {
    f32x4 u[4]; bf16x8 f0[8], f1[8], Xb[4], Ub[2];
#pragma unroll
    for (int mt = 0; mt < 4; ++mt) u[mt] = HASWV ? *(const LAS f32x4*)(fb + (FR_N + wl * 4 + mt) * 1024) : (f32x4){0.f, 0.f, 0.f, 0.f};
#pragma unroll
    for (int f = 0; f < 8; ++f) f0[f] = *(const LAS bf16x8*)(fb + (FR_NWK + f) * 1024);
#pragma unroll
    for (int f = 0; f < 8; ++f) f1[f] = *(const LAS bf16x8*)(fb + (FR_NWK + 8 + f) * 1024);
    DN_SB();
#pragma unroll
    for (int kb = 0; kb < 4; ++kb) Xb[kb] = pack8(X[2 * kb], X[2 * kb + 1]);
#pragma unroll
    for (int mt = 0; mt < 2; ++mt)
#pragma unroll
        for (int kb = 0; kb < 4; ++kb) u[mt] = __builtin_amdgcn_mfma_f32_16x16x32_bf16(f0[mt * 4 + kb], Xb[kb], u[mt], 0, 0, 0);
    DN_SB();
#pragma unroll
    for (int f = 0; f < 8; ++f) f0[f] = *(const LAS bf16x8*)(fb + (FR_KTT + f) * 1024);
    DN_SB();
#pragma unroll
    for (int mt = 2; mt < 4; ++mt)
#pragma unroll
        for (int kb = 0; kb < 4; ++kb) u[mt] = __builtin_amdgcn_mfma_f32_16x16x32_bf16(f1[(mt - 2) * 4 + kb], Xb[kb], u[mt], 0, 0, 0);
    DN_SB();
#pragma unroll
    for (int f = 0; f < 8; ++f) f1[f] = *(const LAS bf16x8*)(fb + (FR_KTT + 8 + f) * 1024);
#pragma unroll
    for (int tb = 0; tb < 2; ++tb) Ub[tb] = pack8(u[2 * tb], u[2 * tb + 1]);
#pragma unroll
    for (int kt = 0; kt < 8; ++kt) X[kt] = X[kt] * cd;
    DN_SB();
#pragma unroll
    for (int kt = 0; kt < 4; ++kt)
#pragma unroll
        for (int tb = 0; tb < 2; ++tb) X[kt] = __builtin_amdgcn_mfma_f32_16x16x32_bf16(f0[kt * 2 + tb], Ub[tb], X[kt], 0, 0, 0);
#pragma unroll
    for (int kt = 4; kt < 8; ++kt)
#pragma unroll
        for (int tb = 0; tb < 2; ++tb) X[kt] = __builtin_amdgcn_mfma_f32_16x16x32_bf16(f1[(kt - 4) * 2 + tb], Ub[tb], X[kt], 0, 0, 0);
}
#define DNS_BAR() do { asm volatile("s_waitcnt lgkmcnt(0)" ::: "memory"); __builtin_amdgcn_s_barrier(); asm volatile("" ::: "memory"); } while (0)
template <int MODE> __device__ __forceinline__ void dns_loader(const P& p, LAS unsigned char* lds, int bh, int n0, int nsteps, int vh, int wl, int lane) {
    constexpr int NPW = MODE == 2 ? 18 : (MODE == 1 ? 12 : 8);
    const unsigned char* ab = p.ws + WS_DNF_AB + ((size_t)bh * NCHUNK + n0) * DNF_AB_UNIT + lane * 16;
    const unsigned char* wvb = p.ws + WS_DNF_WV + ((size_t)bh * NCHUNK + n0) * DNF_WV_UNIT + (size_t)vh * 16 * 1024 + lane * 16;
    u32x4 R[2][NPW];
#define DNS_FRAG(q_) (MODE == 2 ? (q_) : ((q_) < 16 ? (q_) : ((q_) < 32 ? FR_KTT + (q_) - 16 : FR_N + (q_) - 32)))
#define DNS_SRC(n_, q_) (DNS_FRAG(q_) < FR_N ? ab + (size_t)(n_) * DNF_AB_UNIT + DNS_FRAG(q_) * 1024 : wvb + (size_t)(n_) * DNF_WV_UNIT + (DNS_FRAG(q_) - FR_N) * 1024)
#define DNS_LD(n_, s_) do { if ((n_) < nsteps) { _Pragma("unroll") for (int i_ = 0; i_ < NPW; ++i_) R[s_][i_] = *(const u32x4*)DNS_SRC(n_, wl * NPW + i_); } } while (0)
#define DNS_ST(n_, s_) do { if ((n_) < nsteps) { LAS unsigned char* d_ = lds + ((n_) & 1) * DN_SBUF + lane * 16; _Pragma("unroll") for (int i_ = 0; i_ < NPW; ++i_) *(LAS u32x4*)(d_ + DNS_FRAG(wl * NPW + i_) * 1024) = R[s_][i_]; } } while (0)
    DNS_LD(0, 0); DNS_LD(1, 1); DNS_ST(0, 0);
    DNS_BAR();
#define DNS_LSTEP(n_, s_) do { const int n = (n_); if (n < nsteps) { DNS_LD(n + 2, s_); DNS_ST(n + 1, (s_) ^ 1); DNS_BAR(); } } while (0)
    for (int n2 = 0; n2 < nsteps; n2 += 2) { DNS_LSTEP(n2, 0); DNS_LSTEP(n2 + 1, 1); }
#undef DNS_LSTEP
#undef DNS_LD
#undef DNS_ST
#undef DNS_SRC
#undef DNS_FRAG
}
constexpr int PA_RTP = 72;
template <int MODE> __device__ __forceinline__ void dns_passA_task(const P& p, LAS unsigned char* lds, int bh, int seg, int q, int wave, int lane) {
    const int r16 = lane & 15, g4 = lane >> 4, wl = wave & 3, n0 = seg * CSEG;
    const float* cdp = ws_f(p, WS_DNF_CD) + (size_t)bh * NCHUNK + n0;
    LAS bf16_t* RT = (LAS bf16_t*)lds;
    if (wave >= 4) { dns_loader<MODE>(p, lds, bh, n0, CSEG, q & 1, wl, lane); }
    else {
        f32x4 X[8];
#pragma unroll
        for (int kt = 0; kt < 8; ++kt)
#pragma unroll
            for (int i = 0; i < 4; ++i) X[kt][i] = (MODE == 0 && 16 * kt + 4 * g4 + i == 64 * q + 16 * wl + r16) ? 1.f : 0.f;
        float cd = cdp[0], cprod = 1.f;
        DNS_BAR();
        for (int n = 0; n < CSEG; ++n) {
            const float cdn = cdp[n + 1 < CSEG ? n + 1 : n];
            dn_consume_map<MODE == 1>(lds + (n & 1) * DN_SBUF + lane * 16, wl, X, cd);
            cprod *= cd; cd = cdn;
            DNS_BAR();
        }
        if (MODE == 0) {
#pragma unroll
            for (int kt = 0; kt < 8; ++kt)
#pragma unroll
                for (int i = 0; i < 4; ++i) { const int row = 16 * kt + 4 * g4 + i, col = 16 * wl + r16; const float v = X[kt][i] - ((row == 64 * q + col) ? cprod : 0.f);
                    RT[row * PA_RTP + col] = f2bf(v); }
            if (q == 0 && wave == 0 && lane == 0) p.out[O_CPROD + bh * NSEG + seg] = cprod;
        } else {
            float* bo = p.out + O_BSEG + ((size_t)(bh * NSEG + seg) * 8 + (4 * (q & 1) + wl)) * 2048 + lane * 4;
#pragma unroll
            for (int kt = 0; kt < 8; ++kt) *(f32x4*)(bo + kt * 256) = X[kt];
        }
    }
    DNS_BAR();
    if (MODE == 0) {
#pragma unroll
        for (int j = 0; j < 2; ++j) { const int f = wave * 2 + j, mt = f >> 1, kbl = f & 1, row = 16 * mt + r16;
            const u32x2 lo = *(const LAS u32x2*)(RT + row * PA_RTP + 32 * kbl + 4 * g4), hi = *(const LAS u32x2*)(RT + row * PA_RTP + 32 * kbl + 16 + 4 * g4);
            *(u32x4*)((unsigned char*)(p.out + O_RFRAG) + ((size_t)(bh * NSEG + seg) * 32 + mt * 4 + 2 * q + kbl) * 1024 + lane * 16) = (u32x4){lo.x, lo.y, hi.x, hi.y}; }
        DNS_BAR();
    }
}
__device__ __forceinline__ void phase_dns_passA(const P& p, LAS unsigned char* lds) {
    const int tid = otid(), lane = tid & 63, wave = __builtin_amdgcn_readfirstlane(tid >> 6);
    const int vb = (gridDim.x % 8 == 0) ? (int)((blockIdx.x % 8) * (gridDim.x / 8) + blockIdx.x / 8) : (int)blockIdx.x;
    for (int t = vb; t < NBH * NSEG * 4; t += gridDim.x) {
        const int q = t & 3, seg = (t >> 2) % NSEG, bh = t / (4 * NSEG);
        if (q < 2) dns_passA_task<0>(p, lds, bh, seg, q, wave, lane); else dns_passA_task<1>(p, lds, bh, seg, q, wave, lane);
    }
}
__device__ __forceinline__ void phase_dns_passB(const P& p, LAS unsigned char* lds) {
    if ((int)blockIdx.x >= NBH * 8) return;
    const int tid = otid(), lane = tid & 63, w = __builtin_amdgcn_readfirstlane(tid >> 6), r16 = lane & 15, g4 = lane >> 4;
    const int bh = blockIdx.x & 7, vs = blockIdx.x >> 3;
    LAS u32x2* XB = (LAS u32x2*)lds;
    const unsigned char* rf0 = (const unsigned char*)(p.out + O_RFRAG) + ((size_t)bh * NSEG * 32 + w * 4) * 1024 + lane * 16;
    const float* bt0 = p.out + O_BSEG + ((size_t)bh * NSEG * 8 + vs) * 2048 + w * 256 + lane * 4;
    float* ss0 = p.out + O_SSEG + ((size_t)bh * NSEG * 8 + vs) * 2048 + w * 256 + lane * 4;
    const float* cp0 = p.out + O_CPROD + bh * NSEG;
    u32x4 rf[4][4]; f32x4 bt[4]; float cp[4];
#define PB_LD(s_, r_) do { if ((s_) < NSEG) { _Pragma("unroll") for (int kb = 0; kb < 4; ++kb) rf[r_][kb] = *(const u32x4*)(rf0 + (size_t)(s_) * 32768 + kb * 1024); bt[r_] = *(const f32x4*)(bt0 + (size_t)(s_) * 16384); cp[r_] = cp0[(s_)]; } } while (0)
    PB_LD(0, 0); PB_LD(1, 1); PB_LD(2, 2);
    f32x4 S = (f32x4){0.f, 0.f, 0.f, 0.f};
#pragma unroll
    for (int s = 0; s < NSEG; ++s) {
        PB_LD(s + 3, (s + 3) & 3);
        *(f32x4*)(ss0 + (size_t)s * 16384) = S;
        XB[((s & 1) * 8 + w) * 64 + lane] = (u32x2){cvtpk_c(S[0], S[1]), cvtpk_c(S[2], S[3])};
        DNS_BAR();
        f32x4 acc = S * cp[s & 3] + bt[s & 3];
#pragma unroll
        for (int kb = 0; kb < 4; ++kb) { const u32x2 lo = XB[((s & 1) * 8 + 2 * kb) * 64 + lane], hi = XB[((s & 1) * 8 + 2 * kb + 1) * 64 + lane];
            acc = __builtin_amdgcn_mfma_f32_16x16x32_bf16(__builtin_bit_cast(bf16x8, rf[s & 3][kb]), __builtin_bit_cast(bf16x8, (u32x4){lo.x, lo.y, hi.x, hi.y}), acc, 0, 0, 0); }
        S = acc;
    }
#undef PB_LD
    float* so = p.out + O_PSSM + (size_t)bh * 128 * 128 + vs * 16 + r16;
#pragma unroll
    for (int i = 0; i < 4; ++i) so[(size_t)(16 * w + 4 * g4 + i) * 128] = S[i];
    DNS_BAR();
}
__device__ __forceinline__ void phase_dns_passC(const P& p, LAS unsigned char* lds) {
    const int tid = otid(), lane = tid & 63, wave = __builtin_amdgcn_readfirstlane(tid >> 6), r16 = lane & 15, g4 = lane >> 4, wl = wave & 3;
    const int vb = (gridDim.x % 8 == 0) ? (int)((blockIdx.x % 8) * (gridDim.x / 8) + blockIdx.x / 8) : (int)blockIdx.x;
    for (int t = vb; t < NBH * NSEG * 2; t += gridDim.x) {
        const int vh = t & 1, seg = (t >> 1) % NSEG, bh = t / (2 * NSEG), h = bh & 3, b = bh >> 2, vs = vh * 4 + wl, n0 = seg * CSEG;
        if (wave >= 4) dns_loader<2>(p, lds, bh, n0, CSEG, vh, wl, lane);
        else {
            const float* cdp = ws_f(p, WS_DNF_CD) + (size_t)bh * NCHUNK + n0;
            const float* ss = p.out + O_SSEG + ((size_t)(bh * NSEG + seg) * 8 + vs) * 2048 + lane * 4;
            f32x4 S[8];
#pragma unroll
            for (int kt = 0; kt < 8; ++kt) S[kt] = *(const f32x4*)(ss + kt * 256);
            float cd = cdp[0];
            DNS_BAR();
            for (int n = 0; n < CSEG; ++n) {
                const float cdn = cdp[n + 1 < CSEG ? n + 1 : n];
                dn_consume(lds + (n & 1) * DN_SBUF + lane * 16, wl, S, cd, p.out + O_ODN + (size_t)(b * SEQ + (n0 + n) * 64 + 4 * g4) * 512 + h * 128 + vs * 16 + r16);
                cd = cdn;
                DNS_BAR();
            }
        }
        DNS_BAR();
    }
}
#undef DNS_BAR
constexpr size_t WS_EDGE = WS_FREE;
constexpr size_t WS_HEAD = al256(WS_EDGE + (size_t)(T / 256) * 2 * 2 * DFF * 4);
constexpr size_t WS_END = al256(WS_HEAD + (size_t)(T / 256) * 2 * 2 * DFF * 4);
constexpr int EX_OFF = 131072;
namespace pg8 {
typedef unsigned u32x2v __attribute__((ext_vector_type(2)));
__device__ __forceinline__ float dpp_shr1(float old, float src) { return __builtin_bit_cast(float, __builtin_amdgcn_update_dpp(__builtin_bit_cast(int, old), __builtin_bit_cast(int, src), 0x111, 0xf, 0xf, false)); }
__device__ __forceinline__ float dpp_shr2(float old, float src) { return __builtin_bit_cast(float, __builtin_amdgcn_update_dpp(__builtin_bit_cast(int, old), __builtin_bit_cast(int, src), 0x112, 0xf, 0xf, false)); }
__device__ __forceinline__ float dpp_ror1(float src) { return __builtin_bit_cast(float, __builtin_amdgcn_update_dpp(0, __builtin_bit_cast(int, src), 0x121, 0xf, 0xf, false)); }
__device__ __forceinline__ float dpp_ror2(float src) { return __builtin_bit_cast(float, __builtin_amdgcn_update_dpp(0, __builtin_bit_cast(int, src), 0x122, 0xf, 0xf, false)); }
struct EpiFfnUp {
    static constexpr bool PERM = false, AFTER_DRAIN = false;
    bf16_t* ACT; float* edge; float* head; const float* cw; const float* cb; const float* state; float* out_pfc; float* out_sfc; PG8_LAS unsigned char* lds;
    __device__ __forceinline__ void operator()(const f32x4 (&acc)[2][2][4][2], const Unit& u, int wr, int wc, int fr, int fq) const {
        PG8_LAS float* EX = (PG8_LAS float*)(lds + EX_OFF);
        const bool smp = u.pm >= TP / BM;
        const int cl = wc * 32 + 4 * fq;
        if (fr >= 14) {
#pragma unroll
            for (int ai = 0; ai < 2; ++ai)
#pragma unroll
                for (int bj = 0; bj < 2; ++bj)
#pragma unroll
                    for (int n = 0; n < 2; ++n) *(PG8_LAS f32x4*)(EX + ((2 * ai + wr) * 2 + (fr - 14)) * 256 + bj * HALF + cl + 16 * n) = acc[ai][bj][3][n];
            if (wr == 1) {
#pragma unroll
                for (int bj = 0; bj < 2; ++bj)
#pragma unroll
                    for (int n = 0; n < 2; ++n) { const int oc = bj * DFF + u.pn * HALF + cl + 16 * n;
                        *(f32x4*)(edge + ((size_t)u.pm * 2 + (fr - 14)) * 2 * DFF + oc) = acc[1][bj][3][n];
                        if (!smp && (u.pm & (SEQ / BM - 1)) == SEQ / BM - 1) *(f32x4*)(out_pfc + ((size_t)(u.pm / (SEQ / BM)) * 2 + (fr - 14)) * 2 * DFF + oc) = acc[1][bj][3][n]; }
            }
        }
        if (fr < 2 && wr == 0) {
#pragma unroll
            for (int bj = 0; bj < 2; ++bj)
#pragma unroll
                for (int n = 0; n < 2; ++n) *(f32x4*)(head + ((size_t)u.pm * 2 + fr) * 2 * DFF + bj * DFF + u.pn * HALF + cl + 16 * n) = acc[0][bj][0][n];
        }
        asm volatile("s_waitcnt lgkmcnt(0)" ::: "memory"); __builtin_amdgcn_s_barrier(); asm volatile("" ::: "memory");
#pragma unroll
        for (int n = 0; n < 2; ++n) {
            const int f0 = u.pn * HALF + cl + 16 * n;
            f32x4 wg[3], wu[3], bg, bu;
#pragma unroll
            for (int j = 0; j < 3; ++j) { wg[j] = *(const f32x4*)(cw + (size_t)j * 2 * DFF + f0); wu[j] = *(const f32x4*)(cw + (size_t)j * 2 * DFF + DFF + f0); }
            bg = *(const f32x4*)(cb + f0); bu = *(const f32x4*)(cb + DFF + f0);
#pragma unroll
            for (int ai = 0; ai < 2; ++ai) {
                const int s = 2 * ai + wr;
                f32x4 pg = (f32x4){0.f, 0.f, 0.f, 0.f}, pu = pg;
                if (!smp && s > 0 && fr >= 14) { pg = *(const PG8_LAS f32x4*)(EX + ((s - 1) * 2 + (fr - 14)) * 256 + cl + 16 * n); pu = *(const PG8_LAS f32x4*)(EX + ((s - 1) * 2 + (fr - 14)) * 256 + HALF + cl + 16 * n); }
#pragma unroll
                for (int m = 0; m < 4; ++m) {
                    const f32x4 cg = acc[ai][0][m][n], cu = acc[ai][1][m][n];
                    const int row = u.pm * BM + ai * HALF + wr * 64 + m * 16 + fr;
                    f32x4 g1, g2, u1, u2;
#pragma unroll
                    for (int e = 0; e < 4; ++e) { g1[e] = dpp_shr1(dpp_ror1(pg[e]), cg[e]); g2[e] = dpp_shr2(dpp_ror2(pg[e]), cg[e]); u1[e] = dpp_shr1(dpp_ror1(pu[e]), cu[e]); u2[e] = dpp_shr2(dpp_ror2(pu[e]), cu[e]); }
                    if (smp) {
                        const int t = fr & 7, b = (row - TP) >> 3;
                        if (t < 2) { const float* st = state + (size_t)b * 2 * 2 * DFF + f0; const f32x4 s1g = *(const f32x4*)(st + 2 * DFF), s1u = *(const f32x4*)(st + 2 * DFF + DFF);
                            if (t == 0) { g1 = s1g; u1 = s1u; g2 = *(const f32x4*)st; u2 = *(const f32x4*)(st + DFF); } else { g2 = s1g; u2 = s1u; } }
                        if (t >= 6) { float* o = out_sfc + ((size_t)b * 2 + (t - 6)) * 2 * DFF + f0; *(f32x4*)o = cg; *(f32x4*)(o + DFF) = cu; }
                    }
                    const f32x4 gc = wg[0] * g2 + wg[1] * g1 + wg[2] * cg + bg, uc = wu[0] * u2 + wu[1] * u1 + wu[2] * cu + bu;
                    u32x2v w;
                    { const float a0 = gc[0] * uc[0] * __builtin_amdgcn_rcpf(1.0f + __expf(-gc[0])), a1 = gc[1] * uc[1] * __builtin_amdgcn_rcpf(1.0f + __expf(-gc[1])), a2 = gc[2] * uc[2] * __builtin_amdgcn_rcpf(1.0f + __expf(-gc[2])), a3 = gc[3] * uc[3] * __builtin_amdgcn_rcpf(1.0f + __expf(-gc[3]));
                      w.x = cvt_pk_bf16(a0, a1); w.y = cvt_pk_bf16(a2, a3); }
                    *(u32x2v*)(ACT + (size_t)row * DFF + f0) = w;
                    pg = cg; pu = cu;
                }
            }
        }
    }
};
}
__device__ __forceinline__ void phase_ffn_fix(const P& p) {
    constexpr int TPS = SEQ / 256;
    const long n = (long)(BATCH * TPS) * DFF;
    const float* edge = ws_f(p, WS_EDGE); const float* head = ws_f(p, WS_HEAD);
    for (long i = blockIdx.x * (long)NTHR + otid(); i < n; i += (long)gridDim.x * NTHR) {
        const int pm = (int)(i / DFF), f = (int)(i % DFF);
        if (pm % TPS == 0) continue;
        float r0[2], r1[2];
#pragma unroll
        for (int gu = 0; gu < 2; ++gu) { const int c = gu * DFF + f;
            const float um2 = edge[((size_t)(pm - 1) * 2 + 0) * 2 * DFF + c], um1 = edge[((size_t)(pm - 1) * 2 + 1) * 2 * DFF + c], u0 = head[((size_t)pm * 2 + 0) * 2 * DFF + c], u1 = head[((size_t)pm * 2 + 1) * 2 * DFF + c];
            const float w0 = p.ffn_conv_w[c], w1 = p.ffn_conv_w[2 * DFF + c], w2 = p.ffn_conv_w[4 * DFF + c], bb = p.ffn_conv_b[c];
            r0[gu] = w0 * um2 + w1 * um1 + w2 * u0 + bb; r1[gu] = w0 * um1 + w1 * u0 + w2 * u1 + bb; }
        bf16_t* ACT = ws_h(p, WS_ACT) + (size_t)pm * 256 * DFF + f;
        ACT[0] = f2bf(silu_f(r0[0]) * r0[1]); ACT[DFF] = f2bf(silu_f(r1[0]) * r1[1]);
    }
}
constexpr int SW_KP = 72;
__device__ __forceinline__ void swa_bias(const LAS float* BT, int lane, float (&bv)[9][4]) {
    const int r16 = lane & 15, g4 = lane >> 4;
#pragma unroll
    for (int t = 0; t < 9; ++t)
#pragma unroll
        for (int e = 0; e < 4; ++e) { const int d = 128 + r16 - 16 * t - 4 * g4 - e; bv[t][e] = (d >= 0 && d <= 127) ? BT[d] * 1.4426950408889634f : -1e30f; }
}
__device__ __forceinline__ void swa_qtile(const LAS bf16_t* KS, const LAS bf16_t* VT, int vtp, int qt, const bf16x8 (&bq)[2], const float (&bv)[9][4], float sink2, bool first, bf16_t* optr, int nvalid_q, int lane) {
    const int r16 = lane & 15, g4 = lane >> 4, kt0 = qt;
    f32x4 s[10];
#pragma unroll
    for (int tb = 0; tb < 2; ++tb) {
        bf16x8 ka[5][2];
#pragma unroll
        for (int t = 0; t < 5; ++t)
#pragma unroll
            for (int ks = 0; ks < 2; ++ks) if (5 * tb + t < 9) ka[t][ks] = *(const LAS bf16x8*)(KS + (16 * (kt0 + 5 * tb + t) + r16) * SW_KP + 32 * ks + 8 * g4);
        __builtin_amdgcn_sched_barrier(0);
#pragma unroll
        for (int t = 0; t < 5; ++t) if (5 * tb + t < 9) { f32x4 a = (f32x4){0.f, 0.f, 0.f, 0.f};
#pragma unroll
            for (int ks = 0; ks < 2; ++ks) a = __builtin_amdgcn_mfma_f32_16x16x32_bf16(ka[t][ks], bq[ks], a, 0, 0, 0);
            s[5 * tb + t] = a; }
        __builtin_amdgcn_sched_barrier(0);
    }
    float mx = sink2;
#pragma unroll
    for (int t = 0; t < 9; ++t)
#pragma unroll
        for (int e = 0; e < 4; ++e) { float v = s[t][e] * 0.18033688011112042f + bv[t][e]; if (first && 16 * (kt0 + t) + 4 * g4 + e < 128) v = -1e30f; s[t][e] = v; mx = fmaxf(mx, v); }
    mx = fmaxf(mx, __shfl_xor(mx, 16)); mx = fmaxf(mx, __shfl_xor(mx, 32));
    float l = 0.f;
#pragma unroll
    for (int t = 0; t < 9; ++t)
#pragma unroll
        for (int e = 0; e < 4; ++e) { const float pv = __builtin_amdgcn_exp2f(s[t][e] - mx); s[t][e] = pv; l += pv; }
    s[9] = (f32x4){0.f, 0.f, 0.f, 0.f};
    l += __shfl_xor(l, 16); l += __shfl_xor(l, 32);
    l += __builtin_amdgcn_exp2f(sink2 - mx);
    const float rl = __builtin_amdgcn_rcpf(l);
    bf16x8 pb[5];
#pragma unroll
    for (int q = 0; q < 5; ++q) pb[q] = pack8(s[2 * q], s[2 * q + 1]);
#pragma unroll
    for (int dp = 0; dp < 2; ++dp) {
        u32x2 vl[2][5], vh[2][5];
#pragma unroll
        for (int d2 = 0; d2 < 2; ++d2)
#pragma unroll
            for (int q = 0; q < 5; ++q) { const LAS bf16_t* vp = VT + (16 * (2 * dp + d2) + r16) * vtp + 16 * (kt0 + 2 * q) + 4 * g4; vl[d2][q] = *(const LAS u32x2*)vp; vh[d2][q] = *(const LAS u32x2*)(vp + 16); }
        __builtin_amdgcn_sched_barrier(0);
#pragma unroll
        for (int d2 = 0; d2 < 2; ++d2) { const int dt = 2 * dp + d2; f32x4 o = (f32x4){0.f, 0.f, 0.f, 0.f};
#pragma unroll
            for (int q = 0; q < 5; ++q) o = __builtin_amdgcn_mfma_f32_16x16x32_bf16(__builtin_bit_cast(bf16x8, (u32x4){vl[d2][q].x, vl[d2][q].y, vh[d2][q].x, vh[d2][q].y}), pb[q], o, 0, 0, 0);
            if (r16 < nvalid_q) *(u32x2*)(optr + (size_t)r16 * 1024 + 16 * dt + 4 * g4) = (u32x2){cvtpk_c(o[0] * rl, o[1] * rl), cvtpk_c(o[2] * rl, o[3] * rl)}; }
        __builtin_amdgcn_sched_barrier(0);
    }
}
constexpr int SWP_VTP = 272, SWS_NK = 144, SWS_VTP = 168;
constexpr int SW_KS = 0, SW_VT = 43008, SW_BT = 86016, SW_END = SW_BT + 8 * 128 * 4;
static_assert(256 * SW_KP * 2 <= SW_VT && SW_VT + 64 * SWP_VTP * 2 <= SW_BT && SWS_NK * SW_KP * 2 <= SW_VT && SW_VT + 64 * SWS_VTP * 2 <= SW_BT, "swa LDS map");
__device__ __forceinline__ void phase_swa(const P& p, LAS unsigned char* lds, unsigned long long& pr_prev, unsigned long long& pr_acc) {
    const int tid = otid(), lane = tid & 63, wave = tid >> 6;
    LAS bf16_t* KS = (LAS bf16_t*)(lds + SW_KS); LAS bf16_t* VT = (LAS bf16_t*)(lds + SW_VT); LAS float* BT = (LAS float*)(lds + SW_BT);
    const bf16_t* PR = ws_h(p, WS_PROJ); bf16_t* MX = ws_h(p, WS_MIX);
    constexpr int NQB = SEQ / 128, NPU = BATCH * NQB * 2, NU = NPU + DEC_BATCH * 2;
    for (int i = tid; i < 8 * 128; i += NTHR) BT[i] = p.rel_bias[t5_bucket(i & 127) * 8 + (i >> 7)];
    const int vb = (gridDim.x % 8 == 0) ? (int)((blockIdx.x % 8) * (gridDim.x / 8) + blockIdx.x / 8) : (int)blockIdx.x;
    for (int u = vb; u < NU; u += gridDim.x) {
        __syncthreads(); DPS(22);
        if (u < NPU) {
            const int kvh = u & 1, qb = (u >> 1) % NQB, b = (u >> 1) / NQB, m0 = b * SEQ + qb * 128; const bool first = qb == 0;
            const bf16_t* qbase = PR + (size_t)(m0 + 64 * (wave & 1) + (lane & 15)) * PLD + PC_SQ + (kvh * 4 + (wave >> 1)) * 64 + 8 * (lane >> 4);
            bf16x8 bq[2], bqn[2];
#pragma unroll
            for (int ks = 0; ks < 2; ++ks) bq[ks] = *(const bf16x8*)(qbase + 32 * ks);
            {
                u32x4 kr[4], vr[5];
#pragma unroll
                for (int i = 0; i < 4; ++i) { const int it = tid + i * NTHR, jj = it >> 3, c = it & 7; kr[i] = (u32x4){0u, 0u, 0u, 0u};
                    if (!(first && jj < 128)) kr[i] = *(const u32x4*)(PR + (size_t)(m0 - 128 + jj) * PLD + PC_SK + kvh * 64 + 8 * c); }
#pragma unroll
                for (int i = 0; i < 5; ++i) { const int it = tid + i * NTHR, jj = it % 272, c = it / 272; vr[i] = (u32x4){0u, 0u, 0u, 0u};
                    if (it < 272 * 8 && jj < 256 && !(first && jj < 128)) vr[i] = *(const u32x4*)(PR + (size_t)(m0 - 128 + jj) * PLD + PC_SV + kvh * 64 + 8 * c); }
#pragma unroll
                for (int i = 0; i < 4; ++i) { const int it = tid + i * NTHR, jj = it >> 3, c = it & 7; *(LAS u32x4*)(KS + jj * SW_KP + 8 * c) = kr[i]; }
#pragma unroll
                for (int i = 0; i < 5; ++i) { const int it = tid + i * NTHR, jj = it % 272, c = it / 272;
                    if (it < 272 * 8) { const unsigned w[4] = {vr[i].x, vr[i].y, vr[i].z, vr[i].w};
#pragma unroll
                        for (int e = 0; e < 4; ++e) { VT[(8 * c + 2 * e) * SWP_VTP + jj] = (bf16_t)(w[e] & 0xffffu); VT[(8 * c + 2 * e + 1) * SWP_VTP + jj] = (bf16_t)(w[e] >> 16); } } }
            }
            __syncthreads(); DPS(23);
            const int hq = kvh * 4 + (wave >> 1), qh = wave & 1, r16 = lane & 15, g4 = lane >> 4;
            float bv[9][4]; swa_bias(BT + hq * 128, lane, bv);
            const float sink2 = p.swa_sinks[hq] * 1.4426950408889634f;
#pragma unroll 1
            for (int q4 = 0; q4 < 4; ++q4) { const int qt = 4 * qh + q4;
                if (q4 < 3) {
#pragma unroll
                    for (int ks = 0; ks < 2; ++ks) bqn[ks] = *(const bf16x8*)(qbase + (size_t)(16 * (q4 + 1)) * PLD + 32 * ks); }
                swa_qtile(KS, VT, SWP_VTP, qt, bq, bv, sink2, first, MX + (size_t)(m0 + 16 * qt) * 1024 + 512 + hq * 64, 16, lane);
                bq[0] = bqn[0]; bq[1] = bqn[1]; }
            DPS(24);
        } else {
            const int su = u - NPU, b = su >> 1, kvh = su & 1, m0 = TP + b * DEC_SEQ;
            bf16x8 bqs[2];
#pragma unroll
            for (int ks = 0; ks < 2; ++ks) bqs[ks] = *(const bf16x8*)(PR + (size_t)(m0 + (lane & 7)) * PLD + PC_SQ + (kvh * 4 + (wave & 3)) * 64 + 32 * ks + 8 * (lane >> 4));
            {
                f32x4 ka[3][2], va[3][2]; u32x4 kn[3], vn[3];
#pragma unroll
                for (int i = 0; i < 3; ++i) { const int it = tid + i * NTHR, jj = it >> 3, c = it & 7;
                    ka[i][0] = ka[i][1] = (f32x4){0.f, 0.f, 0.f, 0.f}; kn[i] = (u32x4){0u, 0u, 0u, 0u};
                    if (it < SWS_NK * 8) { if (jj < 128) { const float* src = p.cache_k + ((size_t)b * 128 + jj) * 128 + kvh * 64 + 8 * c; ka[i][0] = *(const f32x4*)src; ka[i][1] = *(const f32x4*)(src + 4); }
                        else if (jj < 128 + DEC_SEQ) kn[i] = *(const u32x4*)(PR + (size_t)(m0 + jj - 128) * PLD + PC_SK + kvh * 64 + 8 * c); } }
#pragma unroll
                for (int i = 0; i < 3; ++i) { const int it = tid + i * NTHR, jj = it % SWS_VTP, c = it / SWS_VTP;
                    va[i][0] = va[i][1] = (f32x4){0.f, 0.f, 0.f, 0.f}; vn[i] = (u32x4){0u, 0u, 0u, 0u};
                    if (it < SWS_VTP * 8) { if (jj < 128) { const float* src = p.cache_v + ((size_t)b * 128 + jj) * 128 + kvh * 64 + 8 * c; va[i][0] = *(const f32x4*)src; va[i][1] = *(const f32x4*)(src + 4); }
                        else if (jj < 128 + DEC_SEQ) vn[i] = *(const u32x4*)(PR + (size_t)(m0 + jj - 128) * PLD + PC_SV + kvh * 64 + 8 * c); } }
#pragma unroll
                for (int i = 0; i < 3; ++i) { const int it = tid + i * NTHR, jj = it >> 3, c = it & 7;
                    if (it < SWS_NK * 8) { u32x4 v = kn[i]; if (jj < 128) v = (u32x4){cvtpk_c(ka[i][0][0], ka[i][0][1]), cvtpk_c(ka[i][0][2], ka[i][0][3]), cvtpk_c(ka[i][1][0], ka[i][1][1]), cvtpk_c(ka[i][1][2], ka[i][1][3])};
                        *(LAS u32x4*)(KS + jj * SW_KP + 8 * c) = v; } }
#pragma unroll
                for (int i = 0; i < 3; ++i) { const int it = tid + i * NTHR, jj = it % SWS_VTP, c = it / SWS_VTP;
                    if (it < SWS_VTP * 8) { u32x4 v = vn[i]; if (jj < 128) v = (u32x4){cvtpk_c(va[i][0][0], va[i][0][1]), cvtpk_c(va[i][0][2], va[i][0][3]), cvtpk_c(va[i][1][0], va[i][1][1]), cvtpk_c(va[i][1][2], va[i][1][3])};
                        const unsigned w[4] = {v.x, v.y, v.z, v.w};
#pragma unroll
                        for (int e = 0; e < 4; ++e) { VT[(8 * c + 2 * e) * SWS_VTP + jj] = (bf16_t)(w[e] & 0xffffu); VT[(8 * c + 2 * e + 1) * SWS_VTP + jj] = (bf16_t)(w[e] >> 16); } } }
            }
            __syncthreads(); DPS(25);
            if (wave < 4) { const int hq = kvh * 4 + wave;
                float bv[9][4]; swa_bias(BT + hq * 128, lane, bv);
                swa_qtile(KS, VT, SWS_VTP, 0, bqs, bv, p.swa_sinks[hq] * 1.4426950408889634f, false, MX + (size_t)m0 * 1024 + 512 + hq * 64, 8, lane); }
        }
    }
    __syncthreads();
}
static void fill_params(P& p, void* const* d_in, void* d_out, void* d_ws) {
    const float** pp = (const float**)&p;
    for (int i = 0; i < 26; ++i) pp[i] = (const float*)d_in[i];
    p.out = (float*)d_out; p.ws = (unsigned char*)d_ws;
}
namespace cg = cooperative_groups;
constexpr int CW_BAR = 1024;
constexpr size_t CTL_ZERO_BYTES = 65536;

#ifndef PROBE_MASK
#define PROBE_MASK 0
#endif
#ifndef PROBE_K
#define PROBE_K 4
#endif
#ifndef PROBE_XSYNC
#define PROBE_XSYNC 0
#endif
#if PROBE_MASK
#define PROBE_SUB(k) do { xcd_barrier(bar); PROBE_STAMP(k); } while (0)
#define PROBE_DECL unsigned long long pr_prev = __builtin_amdgcn_s_memrealtime(), pr_acc = 0ull
#define PROBE_STAMP(k) do { const unsigned long long now_ = __builtin_amdgcn_s_memrealtime(); if ((PROBE_MASK >> (k)) & 1) pr_acc += now_ - pr_prev; pr_prev = now_; } while (0)
#define PROBE_END() do { xcd_barrier(bar); PROBE_STAMP(11); if (blockIdx.x == 0 && __builtin_amdgcn_mbcnt_hi(~0u, __builtin_amdgcn_mbcnt_lo(~0u, 0u)) == 0u) { const unsigned long long t0_ = __builtin_amdgcn_s_memrealtime(); while (__builtin_amdgcn_s_memrealtime() - t0_ < (unsigned long long)PROBE_K * pr_acc) __builtin_amdgcn_s_sleep(8); } } while (0)
#else
#define PROBE_DECL unsigned long long pr_prev = 0ull, pr_acc = 0ull
#define PROBE_SUB(k)
#define PROBE_STAMP(k)
#define PROBE_END() do { for (int i_ = 0; i_ < PROBE_XSYNC; ++i_) xcd_barrier(bar); } while (0)
#endif
__global__ void __launch_bounds__(512, 2) fwd_megakernel(P p) {
    extern __shared__ __attribute__((aligned(16))) unsigned char lds_raw[];
    LAS unsigned char* lds = (LAS unsigned char*)lds_raw;
    cg::grid_group grid = cg::this_grid();
    PROBE_DECL;
    volatile LAS unsigned* MISC = (volatile LAS unsigned*)(lds + LDS_BYTES - 64);
    if (threadIdx.x < 16) MISC[threadIdx.x] = 0u;
    __syncthreads();
    const XcdBarrier bar = xcd_barrier_post((unsigned*)(p.ws + WS_CTL) + CW_BAR, MISC);
    phase_mod(p, lds); PROBE_STAMP(31); phase_transposes(p, lds);
    if (p.ws == nullptr) grid.sync();
    xcd_barrier(bar); PROBE_STAMP(0);
    phase_norm<0>(p, lds);
    xcd_barrier(bar); PROBE_STAMP(1);
    { pg8::StaticOrder S; pg8::Gemm g{ws_h(p, WS_H), ws_h(p, WS_WT_IN), T, PLD, D}; S.init(T, PLD, gridDim.x, blockIdx.x, D); pg8::EpiStoreBf16 E{ws_h(p, WS_PROJ), PLD};
      pg8::gemm_phase<pg8::EpiStoreBf16, pg8::StaticOrder, true, true>(lds, g, S, E); }
    xcd_barrier(bar); PROBE_STAMP(2);
    phase_state_out(p);
    PROBE_STAMP(21);
    phase_dnprep(p, lds, pr_prev, pr_acc);
    PROBE_SUB(12);
    phase_dnsample(p, lds, pr_prev, pr_acc);
    PROBE_SUB(13);
    phase_swa(p, lds, pr_prev, pr_acc);
    xcd_barrier(bar); PROBE_STAMP(3);
    phase_dns_passA(p, lds);
    xcd_barrier(bar); PROBE_STAMP(14);
    phase_dns_passB(p, lds);
    xcd_barrier(bar); PROBE_STAMP(15);
    phase_dns_passC(p, lds);
    xcd_barrier(bar); PROBE_STAMP(4);
    phase_dngate(p);
    xcd_barrier(bar); PROBE_STAMP(5);
    { pg8::SplitOrder S; pg8::Gemm g{ws_h(p, WS_MIX), ws_h(p, WS_WT_OUT), T, D, 1024}; S.init(D, 1024, NS_OUT, gridDim.x, blockIdx.x); pg8::EpiGateRes<0> E{p.x_prompt, p.x_sample, ws_h(p, WS_XB), ws_f(p, WS_MOD) + 2 * D, p.out + O_Y, NS_OUT};
      pg8::gemm_phase<pg8::EpiGateRes<0>, pg8::SplitOrder, true, true>(lds, g, S, E); }
    xcd_barrier(bar); PROBE_STAMP(6);
    phase_norm<1>(p, lds);
    xcd_barrier(bar); PROBE_STAMP(7);
    { pg8::StaticOrder S; pg8::Gemm g{ws_h(p, WS_H), ws_h(p, WS_WT_UP), T, 2 * DFF, D}; S.init(T, 2 * DFF, gridDim.x, blockIdx.x, D);
      pg8::EpiFfnUp E{ws_h(p, WS_ACT), ws_f(p, WS_EDGE), ws_f(p, WS_HEAD), p.ffn_conv_w, p.ffn_conv_b, p.state_ffn, p.out + O_PFC, p.out + O_SFC, lds};
      pg8::gemm_phase<pg8::EpiFfnUp, pg8::StaticOrder, true, true>(lds, g, S, E); }
    xcd_barrier(bar); PROBE_STAMP(8);
    phase_ffn_fix(p);
    xcd_barrier(bar); PROBE_STAMP(9);
    { pg8::SplitOrder S; pg8::Gemm g{ws_h(p, WS_ACT), ws_h(p, WS_WT_DN), T, D, DFF}; S.init(D, DFF, NS_DN, gridDim.x, blockIdx.x); pg8::EpiGateRes<1> E{nullptr, nullptr, ws_h(p, WS_XB), ws_f(p, WS_MOD) + 5 * D, ws_f(p, WS_SLAB_DN), NS_DN};
      pg8::gemm_phase<pg8::EpiGateRes<1>, pg8::SplitOrder, true, true>(lds, g, S, E); }
    xcd_barrier(bar); PROBE_STAMP(10);
    phase_norm<2>(p, lds);
    PROBE_END();
}
extern "C" void kernel_launch(void* const* d_in, const int* in_sizes, int n_in, void* d_out, int out_size, void* d_ws, size_t ws_size, hipStream_t stream) {
    static int grid_blocks = 0;
    if (grid_blocks == 0) {
        if (n_in != 26 || (long)out_size != O_END || ws_size < WS_END) { fprintf(stderr, "kernel_launch: unexpected shapes n_in=%d out=%d ws=%zu (need %zu)\n", n_in, out_size, ws_size, (size_t)WS_END); grid_blocks = -1; return; }
        int dev = 0, cus = 0, per_cu = 0;
        if (hipGetDevice(&dev) != hipSuccess || hipDeviceGetAttribute(&cus, hipDeviceAttributeMultiprocessorCount, dev) != hipSuccess) { grid_blocks = -1; return; }
        if (hipFuncSetAttribute((const void*)fwd_megakernel, hipFuncAttributeMaxDynamicSharedMemorySize, LDS_BYTES) != hipSuccess) { fprintf(stderr, "kernel_launch: hipFuncSetAttribute failed\n"); grid_blocks = -1; return; }
        if (hipOccupancyMaxActiveBlocksPerMultiprocessor(&per_cu, (const void*)fwd_megakernel, NTHR, LDS_BYTES) != hipSuccess || per_cu < 1) { fprintf(stderr, "kernel_launch: occupancy query says %d\n", per_cu); grid_blocks = -1; return; }
        grid_blocks = cus;
        fprintf(stderr, "kernel_launch: grid %d (cus %d, per_cu %d)\n", grid_blocks, cus, per_cu);
    }
    if (grid_blocks < 0) return;
    P p{}; fill_params(p, d_in, d_out, d_ws);
    if (hipMemsetAsync((char*)d_ws + WS_CTL, 0, CTL_ZERO_BYTES, stream) != hipSuccess) { fprintf(stderr, "kernel_launch: memset of the control words failed\n"); return; }
    void* args[] = {&p};
    const hipError_t e = hipLaunchCooperativeKernel((const void*)fwd_megakernel, dim3(grid_blocks), dim3(NTHR), args, LDS_BYTES, stream);
    if (e != hipSuccess) fprintf(stderr, "cooperative launch failed: %s (grid %d)\n", hipGetErrorString(e), grid_blocks);
}
```

```cpp
#define PROBE_MASK 0
#define PROBE_XSYNC 0
#include <hip/hip_runtime.h>
#include <hip/hip_cooperative_groups.h>
#include <cstdio>
#include <cstdint>
#define HD __device__ __forceinline__
#if defined(PROBE_MASK) && PROBE_MASK
#define DPS(k) do { const unsigned long long now_ = __builtin_amdgcn_s_memrealtime(); if ((PROBE_MASK >> (k)) & 1) pr_acc += now_ - pr_prev; pr_prev = now_; } while (0)
#endif
#ifndef CFG_D_MODEL
#define CFG_D_MODEL 1024
#endif
#ifndef CFG_SEQ
#define CFG_SEQ 8192
#endif
#ifndef CFG_DEC_BATCH
#define CFG_DEC_BATCH 128
#endif
#ifndef CFG_D_FF
#define CFG_D_FF 2816
#endif

constexpr int D = CFG_D_MODEL, BATCH = 2, SEQ = CFG_SEQ, DEC_BATCH = CFG_DEC_BATCH, DEC_SEQ = 8, DFF = CFG_D_FF;
constexpr int TP = BATCH * SEQ, TS = DEC_BATCH * DEC_SEQ, T = TP + TS, NCB = BATCH + DEC_BATCH;
constexpr int IN_COLS = 2824, PLD = 2816;
constexpr int PC_QKV = 0, PC_Z = 1536, PC_SQ = 2048, PC_SK = 2560, PC_SV = 2688;
constexpr int WC_BA = 2048;
constexpr float EPS = 1e-6f;

constexpr long O_Y = 0;
constexpr long O_PDC = (long)T * D;
constexpr long O_SDC = O_PDC + (long)BATCH * 3 * 1536;
constexpr long O_PSSM = O_SDC + (long)DEC_BATCH * 3 * 1536;
constexpr long O_SSSM = O_PSSM + (long)BATCH * 4 * 128 * 128;
constexpr long O_PK = O_SSSM + (long)DEC_BATCH * 4 * 128 * 128;
constexpr long O_SK = O_PK + (long)BATCH * 128 * 128;
constexpr long O_PV = O_SK + (long)DEC_BATCH * 128 * 128;
constexpr long O_SV = O_PV + (long)BATCH * 128 * 128;
constexpr long O_PFC = O_SV + (long)DEC_BATCH * 128 * 128;
constexpr long O_SFC = O_PFC + (long)BATCH * 2 * 2 * DFF;
constexpr long O_END = O_SFC + (long)DEC_BATCH * 2 * 2 * DFF;

constexpr size_t al256(size_t x) { return (x + 255) & ~(size_t)255; }
constexpr size_t WS_CTL = 0;
constexpr size_t WS_MOD = 1u << 20;
constexpr size_t WS_BG = al256(WS_MOD + (size_t)NCB * 6 * D * 4);
constexpr size_t WS_WBAT = al256(WS_BG + (size_t)T * 8 * 4);
constexpr size_t WS_WT_IN = al256(WS_WBAT + (size_t)8 * D * 4);
constexpr size_t WS_WT_OUT = al256(WS_WT_IN + (size_t)PLD * D * 2);
constexpr size_t WS_WT_UP = al256(WS_WT_OUT + (size_t)D * 1024 * 2);
constexpr size_t WS_WT_DN = al256(WS_WT_UP + (size_t)2 * DFF * D * 2);
constexpr size_t WS_H = al256(WS_WT_DN + (size_t)D * DFF * 2);
constexpr int NCHUNK = SEQ / 64, NUNIT = BATCH * 4 * NCHUNK;
constexpr int DNF_AB_UNIT = 57344, DNF_WV_UNIT = 32768;
constexpr size_t WS_DNF_WV = WS_H;
constexpr size_t WS_DNF_AB = al256(WS_H + (size_t)T * (D > 1024 ? D : 1024) * 2);
constexpr size_t WS_DNF_CD = al256(WS_DNF_AB + (size_t)NUNIT * DNF_AB_UNIT);
constexpr size_t WS_QKVC = WS_DNF_AB;
constexpr size_t WS_PROJ = al256((WS_DNF_CD + (size_t)NUNIT * 4) > (WS_QKVC + (size_t)T * 1536 * 2) ? (WS_DNF_CD + (size_t)NUNIT * 4) : (WS_QKVC + (size_t)T * 1536 * 2));
constexpr size_t WS_MIX = al256(WS_PROJ + (size_t)T * PLD * 2);
constexpr size_t WS_FREE = al256(WS_MIX + (size_t)T * 1024 * 2);
constexpr size_t WS_ODN = WS_H, WS_ACT = WS_PROJ;
static_assert((size_t)NUNIT * DNF_WV_UNIT <= (size_t)T * 1024 * 2, "Wv tiles overlay H");

typedef unsigned short bf16_t;
HD unsigned f2bf_bits(float f) { unsigned u = __builtin_bit_cast(unsigned, f); return (u + 0x7fffu + ((u >> 16) & 1u)) >> 16; }
HD bf16_t f2bf(float f) { return (bf16_t)f2bf_bits(f); }
HD float bf2f(bf16_t b) { return __builtin_bit_cast(float, (unsigned)b << 16); }
HD float silu_f(float x) { return x / (1.0f + expf(-x)); }
HD float sigmoid_f(float x) { return 1.0f / (1.0f + expf(-x)); }
HD float softplus_f(float x) { return x > 20.f ? x : log1pf(expf(x)); }

struct P {
    const float *x_prompt, *x_sample, *state_dn_conv, *state_dn_ssm, *cache_k, *cache_v, *state_ffn, *c_prompt, *c_sample, *rel_bias,
        *final_norm_w, *w_ada, *b_ada, *norm_mix_w, *w_in, *dn_conv_w, *dn_A_log, *dn_dt_bias, *dn_norm_w, *swa_sinks, *w_out, *norm_ffn_w,
        *w_up, *ffn_conv_w, *ffn_conv_b, *w_down;
    float* out; unsigned char* ws;
};

HD const float* xrow(const P& p, int m) { return m < TP ? p.x_prompt + (size_t)m * D : p.x_sample + (size_t)(m - TP) * D; }
HD int cb_of(int m) { return m < TP ? m / SEQ : BATCH + (m - TP) / DEC_SEQ; }
HD int t_of(int m) { return m < TP ? m % SEQ : (m - TP) % DEC_SEQ; }
HD float* ws_f(const P& p, size_t off) { return (float*)(p.ws + off); }
HD bf16_t* ws_h(const P& p, size_t off) { return (bf16_t*)(p.ws + off); }

HD int t5_bucket(int d) {
    if (d < 16) return d;
    const float logv = logf((float)d / 16.0f) / 2.0794415416798357f;
    int b = 16 + (int)(logv * 16.0f);
    return b < 31 ? b : 31;
}

constexpr long N_R0A = (long)NCB * 6 * D;
HD void r0a_body(long idx, const P& p) {
    const int cb = (int)(idx / (6 * D)), e = (int)(idx % (6 * D));
    const float* c = cb < BATCH ? p.c_prompt + (size_t)cb * D : p.c_sample + (size_t)(cb - BATCH) * D;
    float acc = 0.f;
    for (int d = 0; d < D; ++d) acc += silu_f(c[d]) * p.w_ada[(size_t)d * 6 * D + e];
    ws_f(p, WS_MOD)[idx] = acc + p.b_ada[e];
}
constexpr long N_R1 = T;
template <int WHICH> HD void r1_body(long idx, const P& p) {
    const int m = (int)idx, cb = cb_of(m);
    const float* xr = WHICH == 0 ? xrow(p, m) : p.out + O_Y + (size_t)m * D;
    const float* nw = WHICH == 0 ? p.norm_mix_w : p.norm_ffn_w;
    const float* mod = ws_f(p, WS_MOD) + (size_t)cb * 6 * D;
    const float* sh = mod + (WHICH == 0 ? 0 : 3 * D); const float* sc = mod + (WHICH == 0 ? D : 4 * D);
    float ss = 0.f;
    for (int k = 0; k < D; ++k) ss += xr[k] * xr[k];
    const float rstd = 1.0f / sqrtf(ss / (float)D + EPS);
    float ba[8];
#pragma unroll
    for (int j = 0; j < 8; ++j) ba[j] = 0.f;
    bf16_t* H = ws_h(p, WS_H) + (size_t)m * D;
    for (int k = 0; k < D; ++k) {
        const float h = xr[k] * rstd * nw[k] * (1.0f + sc[k]) + sh[k];
        H[k] = f2bf(h);
        if (WHICH == 0) {
#pragma unroll
            for (int j = 0; j < 8; ++j) ba[j] += h * p.w_in[(size_t)k * IN_COLS + WC_BA + j];
        }
    }
    if (WHICH == 0) {
        float* bg = ws_f(p, WS_BG) + (size_t)m * 8;
#pragma unroll
        for (int j = 0; j < 4; ++j) {
            bg[j] = sigmoid_f(ba[j]);
            bg[4 + j] = -expf(p.dn_A_log[j]) * softplus_f(ba[4 + j] + p.dn_dt_bias[j]);
        }
    }
}
constexpr long N_R2 = (long)(T / 8) * PLD;
HD void r2_body(long idx, const P& p) {
    const int mg = (int)(idx / PLD), n = (int)(idx % PLD), oc = n < WC_BA ? n : n + 8;
    const bf16_t* H = ws_h(p, WS_H) + (size_t)mg * 8 * D;
    float acc[8];
#pragma unroll
    for (int i = 0; i < 8; ++i) acc[i] = 0.f;
    for (int k = 0; k < D; ++k) {
        const float w = bf2f(f2bf(p.w_in[(size_t)k * IN_COLS + oc]));
#pragma unroll
        for (int i = 0; i < 8; ++i) acc[i] += bf2f(H[(size_t)i * D + k]) * w;
    }
    bf16_t* PR = ws_h(p, WS_PROJ);
#pragma unroll
    for (int i = 0; i < 8; ++i) PR[(size_t)(mg * 8 + i) * PLD + n] = f2bf(acc[i]);
}
constexpr long N_R2B_1 = (long)BATCH * 3 * 1536, N_R2B_2 = (long)DEC_BATCH * 3 * 1536, N_R2B_3 = (long)BATCH * 128 * 128, N_R2B_4 = (long)DEC_BATCH * 128 * 128;
constexpr long N_R2B = N_R2B_1 + N_R2B_2 + 2 * (N_R2B_3 + N_R2B_4);
HD void r2b_body(long idx, const P& p) {
    const bf16_t* PR = ws_h(p, WS_PROJ);
    long r = idx;
    if (r < N_R2B_1) { const int b = (int)(r / (3 * 1536)), j = (int)(r / 1536 % 3), c = (int)(r % 1536);
        p.out[O_PDC + r] = bf2f(PR[(size_t)(b * SEQ + SEQ - 3 + j) * PLD + PC_QKV + c]); return; }
    r -= N_R2B_1;
    if (r < N_R2B_2) { const int b = (int)(r / (3 * 1536)), j = (int)(r / 1536 % 3), c = (int)(r % 1536);
        p.out[O_SDC + r] = bf2f(PR[(size_t)(TP + b * DEC_SEQ + DEC_SEQ - 3 + j) * PLD + PC_QKV + c]); return; }
    r -= N_R2B_2;
    for (int kv = 0; kv < 2; ++kv) {
        const int pc = kv == 0 ? PC_SK : PC_SV; const float* cache = kv == 0 ? p.cache_k : p.cache_v;
        if (r < N_R2B_3) { const int b = (int)(r / (128 * 128)), j = (int)(r / 128 % 128), c = (int)(r % 128);
            p.out[(kv == 0 ? O_PK : O_PV) + r] = bf2f(PR[(size_t)(b * SEQ + SEQ - 128 + j) * PLD + pc + c]); return; }
        r -= N_R2B_3;
        if (r < N_R2B_4) { const int b = (int)(r / (128 * 128)), j = (int)(r / 128 % 128), c = (int)(r % 128);
            float v;
            if (j < 128 - DEC_SEQ) v = cache[((size_t)b * 128 + j + DEC_SEQ) * 128 + c];
            else v = bf2f(PR[(size_t)(TP + b * DEC_SEQ + (j - (128 - DEC_SEQ))) * PLD + pc + c]);
            p.out[(kv == 0 ? O_SK : O_SV) + r] = v; return; }
        r -= N_R2B_4;
    }
}
constexpr long N_R3 = (long)T * 12;
HD float r3_conv(const P& p, int m, int t, int ch) {
    const bf16_t* PR = ws_h(p, WS_PROJ);
    float acc = 0.f;
#pragma unroll
    for (int j = 0; j < 4; ++j) {
        const int tt = t - 3 + j; float xv;
        if (tt >= 0) xv = bf2f(PR[(size_t)(m - (t - tt)) * PLD + PC_QKV + ch]);
        else xv = m < TP ? 0.f : p.state_dn_conv[((size_t)((m - TP) / DEC_SEQ) * 3 + (3 + tt)) * 1536 + ch];
        acc += p.dn_conv_w[j * 1536 + ch] * xv;
    }
    return silu_f(acc);
}
HD void r3_body(long idx, const P& p) {
    const int m = (int)(idx / 12), grp = (int)(idx % 12), part = grp / 4, cbase = grp * 128, t = t_of(m);
    float scale = 1.f;
    if (part < 2) {
        float ss = 0.f;
        for (int c = 0; c < 128; ++c) { const float v = r3_conv(p, m, t, cbase + c); ss += v * v; }
        scale = 1.0f / sqrtf(ss + EPS);
        if (part == 0) scale *= 0.08838834764831845f;
    }
    bf16_t* Q = ws_h(p, WS_QKVC) + (size_t)m * 1536 + cbase;
    for (int c = 0; c < 128; ++c) Q[c] = f2bf(r3_conv(p, m, t, cbase + c) * scale);
}
constexpr long N_R4 = (long)NCB * 4 * 128;
HD void r4_body(long idx, const P& p) {
    const int seq = (int)(idx / 512), h = (int)(idx / 128 % 4), v = (int)(idx % 128);
    const bool smp = seq >= BATCH; const int b = smp ? seq - BATCH : seq;
    float* S = p.out + (smp ? O_SSSM : O_PSSM) + ((size_t)b * 4 + h) * 128 * 128 + v;
    const float* S0 = smp ? p.state_dn_ssm + ((size_t)b * 4 + h) * 128 * 128 + v : nullptr;
    for (int k = 0; k < 128; ++k) S[(size_t)k * 128] = smp ? S0[(size_t)k * 128] : 0.f;
    const int L = smp ? DEC_SEQ : SEQ, m0 = smp ? TP + b * DEC_SEQ : b * SEQ;
    const bf16_t* QK = ws_h(p, WS_QKVC); const float* BG = ws_f(p, WS_BG); float* ODN = ws_f(p, WS_ODN);
    for (int t = 0; t < L; ++t) {
        const int m = m0 + t;
        const bf16_t* q = QK + (size_t)m * 1536 + h * 128; const bf16_t* kk = q + 512; const float vv = bf2f(q[1024 + v]);
        const float beta = BG[(size_t)m * 8 + h], eg = expf(BG[(size_t)m * 8 + 4 + h]);
        float kS = 0.f;
        for (int k = 0; k < 128; ++k) kS += bf2f(kk[k]) * (S[(size_t)k * 128] * eg);
        const float u = beta * (vv - kS);
        float o = 0.f;
        for (int k = 0; k < 128; ++k) { const float s = S[(size_t)k * 128] * eg + bf2f(kk[k]) * u; S[(size_t)k * 128] = s; o += bf2f(q[k]) * s; }
        ODN[(size_t)m * 512 + h * 128 + v] = o;
    }
}
constexpr long N_R5 = (long)T * 4;
HD void r5_body(long idx, const P& p) {
    const int m = (int)(idx / 4), h = (int)(idx % 4);
    const float* o = ws_f(p, WS_ODN) + (size_t)m * 512 + h * 128;
    float ss = 0.f;
    for (int v = 0; v < 128; ++v) ss += o[v] * o[v];
    const float rstd = 1.0f / sqrtf(ss / 128.0f + EPS);
    const bf16_t* z = ws_h(p, WS_PROJ) + (size_t)m * PLD + PC_Z + h * 128;
    bf16_t* mix = ws_h(p, WS_MIX) + (size_t)m * 1024 + h * 128;
    for (int v = 0; v < 128; ++v) mix[v] = f2bf(o[v] * rstd * p.dn_norm_w[v] * silu_f(bf2f(z[v])));
}
constexpr long N_R6 = (long)T * 8 * 8;
HD void r6_body(long idx, const P& p) {
    const int m = (int)(idx / 64), hq = (int)(idx / 8 % 8), dg = (int)(idx % 8), kvh = hq / 4, t = t_of(m);
    const bool smp = m >= TP; const int b = smp ? (m - TP) / DEC_SEQ : 0;
    const bf16_t* PR = ws_h(p, WS_PROJ);
    const bf16_t* q = PR + (size_t)m * PLD + PC_SQ + hq * 64;
    const float sink = p.swa_sinks[hq];
    const int nk = smp ? 128 : (t < 127 ? t + 1 : 128);
    float mx = sink;
    for (int pass = 0; pass < 2; ++pass) {
        float den = 0.f, acc[8];
#pragma unroll
        for (int i = 0; i < 8; ++i) acc[i] = 0.f;
        for (int jj = 0; jj < nk; ++jj) {
            int dist; const float* kf = nullptr; const float* vf = nullptr; const bf16_t* kb = nullptr; const bf16_t* vb = nullptr;
            if (smp) { const int j = t + 1 + jj; dist = 128 + t - j;
                if (j < 128) { kf = p.cache_k + ((size_t)b * 128 + j) * 128 + kvh * 64; vf = p.cache_v + ((size_t)b * 128 + j) * 128 + kvh * 64; }
                else { const size_t mm = (size_t)(TP + b * DEC_SEQ + (j - 128)); kb = PR + mm * PLD + PC_SK + kvh * 64; vb = PR + mm * PLD + PC_SV + kvh * 64; } }
            else { dist = nk - 1 - jj; const size_t mm = (size_t)(m - dist); kb = PR + mm * PLD + PC_SK + kvh * 64; vb = PR + mm * PLD + PC_SV + kvh * 64; }
            float s = 0.f;
            for (int d = 0; d < 64; ++d) s += bf2f(q[d]) * (kf ? kf[d] : bf2f(kb[d]));
            s = s * 0.125f + p.rel_bias[t5_bucket(dist) * 8 + hq];
            if (pass == 0) { mx = s > mx ? s : mx; }
            else { const float pr = expf(s - mx); den += pr;
#pragma unroll
                for (int i = 0; i < 8; ++i) acc[i] += pr * (vf ? vf[dg * 8 + i] : bf2f(vb[dg * 8 + i])); }
        }
        if (pass == 1) { den += expf(sink - mx); bf16_t* mix = ws_h(p, WS_MIX) + (size_t)m * 1024 + 512 + hq * 64 + dg * 8;
#pragma unroll
            for (int i = 0; i < 8; ++i) mix[i] = f2bf(acc[i] / den); }
    }
}
constexpr long N_R7 = (long)(T / 8) * D;
HD void r7_body(long idx, const P& p) {
    const int mg = (int)(idx / D), d = (int)(idx % D);
    const bf16_t* MX = ws_h(p, WS_MIX) + (size_t)mg * 8 * 1024;
    float acc[8];
#pragma unroll
    for (int i = 0; i < 8; ++i) acc[i] = 0.f;
    for (int e = 0; e < 1024; ++e) { const float w = bf2f(f2bf(p.w_out[(size_t)e * D + d]));
#pragma unroll
        for (int i = 0; i < 8; ++i) acc[i] += bf2f(MX[(size_t)i * 1024 + e]) * w; }
#pragma unroll
    for (int i = 0; i < 8; ++i) { const int m = mg * 8 + i; const float g1 = ws_f(p, WS_MOD)[(size_t)cb_of(m) * 6 * D + 2 * D + d];
        p.out[O_Y + (size_t)m * D + d] = xrow(p, m)[d] + g1 * acc[i]; }
}
constexpr long N_R9 = (long)(T / 8) * DFF;
HD void r9_body(long idx, const P& p) {
    const int mg = (int)(idx / DFF), f = (int)(idx % DFF), m0 = mg * 8, t0 = t_of(m0);
    const bool smp = m0 >= TP; const int b = smp ? (m0 - TP) / DEC_SEQ : m0 / SEQ;
    const bf16_t* H = ws_h(p, WS_H);
    float ug[10], uu[10];
#pragma unroll
    for (int i = 0; i < 10; ++i) { ug[i] = 0.f; uu[i] = 0.f; }
    const bool halo = (!smp && t0 > 0);
    for (int k = 0; k < D; ++k) {
        const float wg = bf2f(f2bf(p.w_up[(size_t)k * 2 * DFF + f])), wu = bf2f(f2bf(p.w_up[(size_t)k * 2 * DFF + DFF + f]));
#pragma unroll
        for (int i = 0; i < 10; ++i) { if (i < 2 && !halo) continue; const float h = bf2f(H[(size_t)(m0 - 2 + i) * D + k]); ug[i] += h * wg; uu[i] += h * wu; }
    }
    if (smp) {
#pragma unroll
        for (int i = 0; i < 2; ++i) { ug[i] = p.state_ffn[((size_t)b * 2 + i) * 2 * DFF + f]; uu[i] = p.state_ffn[((size_t)b * 2 + i) * 2 * DFF + DFF + f]; }
    }
    const float w0g = p.ffn_conv_w[f], w1g = p.ffn_conv_w[2 * DFF + f], w2g = p.ffn_conv_w[4 * DFF + f], bgt = p.ffn_conv_b[f];
    const float w0u = p.ffn_conv_w[DFF + f], w1u = p.ffn_conv_w[3 * DFF + f], w2u = p.ffn_conv_w[5 * DFF + f], bup = p.ffn_conv_b[DFF + f];
    bf16_t* ACT = ws_h(p, WS_ACT);
#pragma unroll
    for (int i = 0; i < 8; ++i) {
        const float gc = w0g * ug[i] + w1g * ug[i + 1] + w2g * ug[i + 2] + bgt, uc = w0u * uu[i] + w1u * uu[i + 1] + w2u * uu[i + 2] + bup;
        ACT[(size_t)(m0 + i) * DFF + f] = f2bf(silu_f(gc) * uc);
    }
    if (smp) {
#pragma unroll
        for (int j = 0; j < 2; ++j) { float* o = p.out + O_SFC + ((size_t)b * 2 + j) * 2 * DFF; o[f] = ug[8 + j]; o[DFF + f] = uu[8 + j]; }
    } else if (t0 == SEQ - 8) {
#pragma unroll
        for (int j = 0; j < 2; ++j) { float* o = p.out + O_PFC + ((size_t)b * 2 + j) * 2 * DFF; o[f] = ug[8 + j]; o[DFF + f] = uu[8 + j]; }
    }
}
constexpr long N_R10 = (long)(T / 8) * D;
HD void r10_body(long idx, const P& p) {
    const int mg = (int)(idx / D), d = (int)(idx % D);
    const bf16_t* A = ws_h(p, WS_ACT) + (size_t)mg * 8 * DFF;
    float acc[8];
#pragma unroll
    for (int i = 0; i < 8; ++i) acc[i] = 0.f;
    for (int f = 0; f < DFF; ++f) { const float w = bf2f(f2bf(p.w_down[(size_t)f * D + d]));
#pragma unroll
        for (int i = 0; i < 8; ++i) acc[i] += bf2f(A[(size_t)i * DFF + f]) * w; }
#pragma unroll
    for (int i = 0; i < 8; ++i) { const int m = mg * 8 + i; const float g2 = ws_f(p, WS_MOD)[(size_t)cb_of(m) * 6 * D + 5 * D + d];
        float* o = p.out + O_Y + (size_t)m * D + d; *o = *o + g2 * acc[i]; }
}
constexpr long N_R11 = T, N_R8 = T;
HD void r11_body(long idx, const P& p) {
    float* xr = p.out + O_Y + (size_t)idx * D;
    float ss = 0.f;
    for (int k = 0; k < D; ++k) ss += xr[k] * xr[k];
    const float rstd = 1.0f / sqrtf(ss / (float)D + EPS);
    for (int k = 0; k < D; ++k) xr[k] = xr[k] * rstd * p.final_norm_w[k];
}
#define LAS __attribute__((address_space(3)))
typedef float f32x4 __attribute__((ext_vector_type(4)));
typedef unsigned u32x4 __attribute__((ext_vector_type(4)));
typedef unsigned u32x2 __attribute__((ext_vector_type(2)));
constexpr int NWAVES = 8, NTHR = 512;
constexpr int LDS_BYTES = 163840;
__device__ __forceinline__ int otid() { int t = threadIdx.x; asm volatile("" : "+v"(t)); return t; }
__device__ __forceinline__ float wave_sum(float v) {
#pragma unroll
    for (int o = 1; o < 64; o <<= 1) v += __shfl_xor(v, o);
    return v;
}
__device__ __forceinline__ unsigned pk2(float lo, float hi) { return f2bf_bits(lo) | (f2bf_bits(hi) << 16); }

__device__ __forceinline__ void transpose_item(const float* W, int ldw, int K, bf16_t* WT, int dst_n0, int src_n0, int k0, LAS float* scr, int lane) {
#pragma unroll
    for (int i = 0; i < 32; ++i) { const int kk = 2 * i + (lane >> 5); scr[kk * 33 + (lane & 31)] = W[(size_t)(k0 + kk) * ldw + src_n0 + (lane & 31)]; }
    asm volatile("s_waitcnt lgkmcnt(0)" ::: "memory");
    const int c = lane & 7;
#pragma unroll
    for (int j = 0; j < 4; ++j) { const int n = (lane >> 3) + 8 * j; const LAS float* s = scr + (8 * c) * 33 + n;
        u32x4 o; o.x = pk2(s[0 * 33], s[1 * 33]); o.y = pk2(s[2 * 33], s[3 * 33]); o.z = pk2(s[4 * 33], s[5 * 33]); o.w = pk2(s[6 * 33], s[7 * 33]);
        *(u32x4*)(WT + (size_t)(dst_n0 + n) * K + k0 + 8 * c) = o; }
    asm volatile("s_waitcnt lgkmcnt(0)" ::: "memory");
}
constexpr int TI_IN = (PLD / 32) * (D / 64), TI_OUT = (D / 32) * (1024 / 64), TI_UP = (2 * DFF / 32) * (D / 64), TI_DN = (D / 32) * (DFF / 64), TI_ALL = TI_IN + TI_OUT + TI_UP + TI_DN;
__device__ __forceinline__ void phase_transposes(const P& p, LAS unsigned char* lds) {
    const int tid_ = otid(), lane = tid_ & 63, wave = tid_ >> 6;
    LAS float* scr = (LAS float*)(lds + wave * 16384);
    if (blockIdx.x == gridDim.x - 1) { for (int i = tid_; i < 8 * D; i += NTHR) ws_f(p, WS_WBAT)[i] = p.w_in[(size_t)(i % D) * IN_COLS + WC_BA + i / D]; }
    constexpr int NCG_MOD = 6 * D / 32;
    const bool split = (int)gridDim.x >= NCG_MOD + 32;
    if (split && (int)blockIdx.x < NCG_MOD) return;
    const int gw = (split ? (int)blockIdx.x - NCG_MOD : (int)blockIdx.x) * NWAVES + wave, NGW = (split ? (int)gridDim.x - NCG_MOD : (int)gridDim.x) * NWAVES;
    for (int it = gw; it < TI_ALL; it += NGW) {
        int r = it;
        if (r < TI_IN) { const int nb = r % (PLD / 32), kb = r / (PLD / 32), n0 = nb * 32; transpose_item(p.w_in, IN_COLS, D, ws_h(p, WS_WT_IN), n0, n0 < WC_BA ? n0 : n0 + 8, kb * 64, scr, lane); continue; } r -= TI_IN;
        if (r < TI_OUT) { const int nb = r % (D / 32), kb = r / (D / 32), n0 = nb * 32; transpose_item(p.w_out, D, 1024, ws_h(p, WS_WT_OUT), n0, n0, kb * 64, scr, lane); continue; } r -= TI_OUT;
        if (r < TI_UP) { const int nb = r % (2 * DFF / 32), kb = r / (2 * DFF / 32), n0 = nb * 32;
            const int pn = n0 >> 8, bj = (n0 >> 7) & 1, c = n0 & 127; transpose_item(p.w_up, 2 * DFF, D, ws_h(p, WS_WT_UP), n0, bj * DFF + 128 * pn + c, kb * 64, scr, lane); continue; } r -= TI_UP;
        { const int nb = r % (D / 32), kb = r / (D / 32), n0 = nb * 32; transpose_item(p.w_down, D, DFF, ws_h(p, WS_WT_DN), n0, n0, kb * 64, scr, lane); }
    }
}
typedef short bf16x8m __attribute__((ext_vector_type(8)));
typedef float f32x2m __attribute__((ext_vector_type(2))); typedef __bf16 bf16x2m __attribute__((ext_vector_type(2)));
__device__ __forceinline__ unsigned cvtpk_m(float lo, float hi) { const f32x2m v = {lo, hi}; return __builtin_bit_cast(unsigned, __builtin_convertvector(v, bf16x2m)); }
__device__ __forceinline__ void split8(const float (&x)[8], bf16x8m& hi, bf16x8m& lo) {
    unsigned h[4], l[4];
#pragma unroll
    for (int e = 0; e < 4; ++e) { h[e] = cvtpk_m(x[2 * e], x[2 * e + 1]);
        l[e] = cvtpk_m(x[2 * e] - __builtin_bit_cast(float, h[e] << 16), x[2 * e + 1] - __builtin_bit_cast(float, h[e] & 0xffff0000u)); }
    hi = __builtin_bit_cast(bf16x8m, (u32x4){h[0], h[1], h[2], h[3]}); lo = __builtin_bit_cast(bf16x8m, (u32x4){l[0], l[1], l[2], l[3]});
}
__device__ __forceinline__ float silu_fast(float x) { return x * __builtin_amdgcn_rcpf(1.0f + __expf(-x)); }
__device__ __forceinline__ void phase_mod(const P& p, LAS unsigned char* lds) {
    constexpr int KC = 256, NCG = 6 * D / 32, NCH = D / KC, NMT = (NCB + 15) / 16;
    static_assert(NMT <= 16, "two m-tiles per wave at most");
    LAS float* WB = (LAS float*)lds;
    const int tid = otid(), lane = tid & 63, wave = tid >> 6, r16 = lane & 15, g4 = lane >> 4;
    for (int cg = blockIdx.x; cg < NCG; cg += gridDim.x) {
        f32x4 acc[2][2];
#pragma unroll
        for (int s = 0; s < 2; ++s)
#pragma unroll
            for (int nt = 0; nt < 2; ++nt) acc[s][nt] = (f32x4){0.f, 0.f, 0.f, 0.f};
        f32x4 wreg[4];
#pragma unroll
        for (int j = 0; j < 4; ++j) { const int idx = tid + NTHR * j; wreg[j] = *(const f32x4*)(p.w_ada + (size_t)(idx >> 3) * 6 * D + cg * 32 + 4 * (idx & 7)); }
        __syncthreads();
        for (int ch = 0; ch < NCH; ++ch) {
            LAS float* wb = WB + (ch & 1) * KC * 32;
#pragma unroll
            for (int j = 0; j < 4; ++j) { const int idx = tid + NTHR * j; *(LAS f32x4*)(wb + (idx >> 3) * 32 + 4 * (idx & 7)) = wreg[j]; }
            if (ch + 1 < NCH) {
#pragma unroll
                for (int j = 0; j < 4; ++j) { const int idx = tid + NTHR * j; wreg[j] = *(const f32x4*)(p.w_ada + (size_t)((ch + 1) * KC + (idx >> 3)) * 6 * D + cg * 32 + 4 * (idx & 7)); }
            }
            f32x4 areg[KC / 32][2];
#define MOD_LDA(mt_) do { const int row_ = 16 * (mt_) + r16; if (row_ < NCB) { const float* c_ = (row_ < BATCH ? p.c_prompt + (size_t)row_ * D : p.c_sample + (size_t)(row_ - BATCH) * D) + ch * KC + 8 * g4; \
                _Pragma("unroll") for (int ks = 0; ks < KC / 32; ++ks) { areg[ks][0] = *(const f32x4*)(c_ + 32 * ks); areg[ks][1] = *(const f32x4*)(c_ + 32 * ks + 4); } } \
                else { _Pragma("unroll") for (int ks = 0; ks < KC / 32; ++ks) { areg[ks][0] = (f32x4){0.f, 0.f, 0.f, 0.f}; areg[ks][1] = (f32x4){0.f, 0.f, 0.f, 0.f}; } } } while (0)
            MOD_LDA(wave);
            __syncthreads();
#pragma unroll
            for (int s = 0; s < 2; ++s) { const int mt = wave + 8 * s; if (mt >= NMT) continue;
                if (s == 1) MOD_LDA(mt);
#pragma unroll
                for (int ks = 0; ks < KC / 32; ++ks) {
                    bf16x8m bh[2], bl[2];
#pragma unroll
                    for (int nt = 0; nt < 2; ++nt) { float x[8];
#pragma unroll
                        for (int j = 0; j < 8; ++j) x[j] = wb[(32 * ks + 8 * g4 + j) * 32 + 16 * nt + r16];
                        split8(x, bh[nt], bl[nt]); }
                    float x[8]; const f32x4 a = areg[ks][0], d = areg[ks][1];
                    x[0] = silu_fast(a[0]); x[1] = silu_fast(a[1]); x[2] = silu_fast(a[2]); x[3] = silu_fast(a[3]); x[4] = silu_fast(d[0]); x[5] = silu_fast(d[1]); x[6] = silu_fast(d[2]); x[7] = silu_fast(d[3]);
                    bf16x8m ah, al; split8(x, ah, al);
#pragma unroll
                    for (int nt = 0; nt < 2; ++nt) {
                        acc[s][nt] = __builtin_amdgcn_mfma_f32_16x16x32_bf16(ah, bh[nt], acc[s][nt], 0, 0, 0);
                        acc[s][nt] = __builtin_amdgcn_mfma_f32_16x16x32_bf16(ah, bl[nt], acc[s][nt], 0, 0, 0);
                        acc[s][nt] = __builtin_amdgcn_mfma_f32_16x16x32_bf16(al, bh[nt], acc[s][nt], 0, 0, 0); }
                }
            }
#undef MOD_LDA
        }
#pragma unroll
        for (int s = 0; s < 2; ++s) { const int mt = wave + 8 * s; if (mt >= NMT) continue;
#pragma unroll
            for (int nt = 0; nt < 2; ++nt) { const int e = cg * 32 + 16 * nt + r16; const float bb = p.b_ada[e];
#pragma unroll
                for (int i = 0; i < 4; ++i) { const int row = 16 * mt + 4 * g4 + i; if (row < NCB) ws_f(p, WS_MOD)[(size_t)row * 6 * D + e] = acc[s][nt][i] + bb; } } }
    }
    __syncthreads();
}
constexpr int NS_OUT = 4, NS_DN = 11;
constexpr size_t SLAB_DN_BYTES = (size_t)(TS / 256) * (D / 256) * NS_DN * 65536 * 4, WS_SLAB_DN = WS_H;
constexpr size_t WS_XB = al256(WS_SLAB_DN + SLAB_DN_BYTES);
static_assert(WS_XB >= WS_DNF_AB && WS_XB + (size_t)T * D * 2 <= WS_DNF_CD && (size_t)(TS / 256) * (D / 256) * NS_OUT * 65536 <= (size_t)T * D, "residual stream / slabs fit");
template <int WHICH> __device__ __forceinline__ void norm_row_tail(const P& p, int m, int lane, const f32x4 (&v)[4], const f32x4 (&nwv)[4], const LAS float* wbt, int& cbc, f32x4 (&scv)[4], f32x4 (&shv)[4]) {
    float ss = 0.f;
#pragma unroll
    for (int j = 0; j < 4; ++j) ss += (v[j][0] * v[j][0] + v[j][1] * v[j][1]) + (v[j][2] * v[j][2] + v[j][3] * v[j][3]);
    const float rstd = 1.0f / sqrtf(wave_sum(ss) * (1.0f / D) + EPS);
    if (WHICH == 2) {
#pragma unroll
        for (int j = 0; j < 4; ++j) ((f32x4*)(p.out + O_Y + (size_t)m * D))[lane + 64 * j] = v[j] * rstd * nwv[j];
        return;
    }
    const int cb = cb_of(m);
    if (cb != cbc) {
        const float* mod = ws_f(p, WS_MOD) + (size_t)cb * 6 * D;
        const float* sh = mod + (WHICH == 0 ? 0 : 3 * D); const float* sc = mod + (WHICH == 0 ? D : 4 * D);
#pragma unroll
        for (int j = 0; j < 4; ++j) { scv[j] = ((const f32x4*)sc)[lane + 64 * j] + 1.0f; shv[j] = ((const f32x4*)sh)[lane + 64 * j]; }
        cbc = cb;
    }
    float ba[8];
#pragma unroll
    for (int j = 0; j < 8; ++j) ba[j] = 0.f;
    unsigned long long* o8 = (unsigned long long*)(ws_h(p, WS_H) + (size_t)m * D);
#pragma unroll
    for (int j = 0; j < 4; ++j) {
        const f32x4 h = v[j] * rstd * nwv[j] * scv[j] + shv[j];
        o8[lane + 64 * j] = (unsigned long long)cvtpk_m(h[0], h[1]) | ((unsigned long long)cvtpk_m(h[2], h[3]) << 32);
        if (WHICH == 0) {
#pragma unroll
            for (int c = 0; c < 8; ++c) { const f32x4 w = *(const LAS f32x4*)(wbt + c * D + 4 * (lane + 64 * j)); ba[c] += (h[0] * w[0] + h[1] * w[1]) + (h[2] * w[2] + h[3] * w[3]); }
            asm volatile("" ::: "memory");
        }
    }
    if (WHICH == 0) {
#pragma unroll
        for (int j = 0; j < 8; ++j) ba[j] = wave_sum(ba[j]);
        float mine = 0.f;
#pragma unroll
        for (int j = 0; j < 8; ++j) mine = (lane == j) ? ba[j] : mine;
        if (lane < 8) { float* bg = ws_f(p, WS_BG) + (size_t)m * 8; const int j = lane & 3;
            bg[lane] = lane < 4 ? sigmoid_f(mine) : -expf(p.dn_A_log[j]) * softplus_f(mine + p.dn_dt_bias[j]); }
    }
}
template <int WHICH> __device__ __forceinline__ void phase_norm(const P& p, LAS unsigned char* lds) {
    static_assert(D == 1024, "one wave per 1024-element row");
    const int tid_ = otid(), lane = tid_ & 63, wave = tid_ >> 6;
    const int gw = blockIdx.x * NWAVES + wave, NGW = gridDim.x * NWAVES;
    const float* nwp = WHICH == 0 ? p.norm_mix_w : (WHICH == 1 ? p.norm_ffn_w : p.final_norm_w);
    f32x4 nwv[4];
#pragma unroll
    for (int j = 0; j < 4; ++j) nwv[j] = ((const f32x4*)nwp)[lane + 64 * j];
    const LAS float* wbt = (const LAS float*)lds;
    if (WHICH == 0) { for (int i = tid_; i < 8 * D / 4; i += NTHR) ((LAS f32x4*)lds)[i] = ((const f32x4*)ws_f(p, WS_WBAT))[i]; __syncthreads(); }
    const bf16_t* XB = ws_h(p, WS_XB);
    int cbc = -1; f32x4 scv[4], shv[4];
    constexpr int MEND = WHICH == 0 ? T : TP;
    typedef f32x4 rowbuf_t[4];
    rowbuf_t ra, rb, rc;
#define NR_LOAD(buf_, mm_) do { if ((mm_) < MEND) { if (WHICH == 0) { const float* xr_ = xrow(p, (mm_)); _Pragma("unroll") for (int j = 0; j < 4; ++j) buf_[j] = ((const f32x4*)xr_)[lane + 64 * j]; } \
        else { const u32x2* xr_ = (const u32x2*)(XB + (size_t)(mm_) * D); u32x2 w_[4]; _Pragma("unroll") for (int j = 0; j < 4; ++j) w_[j] = xr_[lane + 64 * j]; \
            buf_[0] = __builtin_bit_cast(f32x4, (u32x4){w_[0].x, w_[0].y, w_[1].x, w_[1].y}); buf_[1] = __builtin_bit_cast(f32x4, (u32x4){w_[2].x, w_[2].y, w_[3].x, w_[3].y}); } } } while (0)
#define NR_PROC(buf_, mm_) do { if ((mm_) < MEND) { f32x4 v_[4]; if (WHICH == 0) { _Pragma("unroll") for (int j = 0; j < 4; ++j) v_[j] = buf_[j]; } \
        else { const u32x4 a_ = __builtin_bit_cast(u32x4, buf_[0]), b_ = __builtin_bit_cast(u32x4, buf_[1]); const unsigned w_[8] = {a_.x, a_.y, a_.z, a_.w, b_.x, b_.y, b_.z, b_.w}; \
            _Pragma("unroll") for (int j = 0; j < 4; ++j) v_[j] = (f32x4){__builtin_bit_cast(float, w_[2 * j] << 16), __builtin_bit_cast(float, w_[2 * j] & 0xffff0000u), __builtin_bit_cast(float, w_[2 * j + 1] << 16), __builtin_bit_cast(float, w_[2 * j + 1] & 0xffff0000u)}; } \
        norm_row_tail<WHICH>(p, (mm_), lane, v_, nwv, wbt, cbc, scv, shv); } } while (0)
    NR_LOAD(ra, gw); NR_LOAD(rb, gw + NGW);
    for (int m = gw; m < MEND; m += 3 * NGW) {
        NR_LOAD(rc, m + 2 * NGW); NR_PROC(ra, m);
        NR_LOAD(ra, m + 3 * NGW); NR_PROC(rb, m + NGW);
        NR_LOAD(rb, m + 4 * NGW); NR_PROC(rc, m + 2 * NGW);
    }
#undef NR_LOAD
#undef NR_PROC
    if (WHICH != 0) {
        constexpr int NS = WHICH == 1 ? NS_OUT : NS_DN;
        const float* slabs = WHICH == 1 ? p.out + O_Y : ws_f(p, WS_SLAB_DN);
        for (int rs = gw; rs < TS; rs += NGW) { const int m = TP + rs, cbs = BATCH + (rs >> 3);
            const float* gt = ws_f(p, WS_MOD) + (size_t)cbs * 6 * D + (WHICH == 1 ? 2 * D : 5 * D);
            f32x4 vs[4];
#pragma unroll
            for (int j = 0; j < 4; ++j) { const float* sl = slabs + ((size_t)((rs >> 8) * 4 + j) * NS) * 65536 + (size_t)(rs & 255) * 256 + 4 * lane;
                f32x4 acc = (f32x4){0.f, 0.f, 0.f, 0.f};
#pragma unroll
                for (int ks = 0; ks < NS; ++ks) { acc += *(const f32x4*)sl; sl += 65536; asm volatile("" : "+v"(sl)); }
                f32x4 base;
                if (WHICH == 1) base = ((const f32x4*)(p.x_sample + (size_t)rs * D))[lane + 64 * j];
                else { const u32x2 w = ((const u32x2*)(XB + (size_t)m * D))[lane + 64 * j]; base = (f32x4){__builtin_bit_cast(float, w.x << 16), __builtin_bit_cast(float, w.x & 0xffff0000u), __builtin_bit_cast(float, w.y << 16), __builtin_bit_cast(float, w.y & 0xffff0000u)}; }
                vs[j] = base + ((const f32x4*)gt)[lane + 64 * j] * acc;
                if (WHICH == 1) ((u32x2*)(ws_h(p, WS_XB) + (size_t)m * D))[lane + 64 * j] = (u32x2){cvtpk_m(vs[j][0], vs[j][1]), cvtpk_m(vs[j][2], vs[j][3])};
                asm volatile("" ::: "memory"); }
            norm_row_tail<WHICH>(p, m, lane, vs, nwv, wbt, cbc, scv, shv);
        }
    }
}

constexpr long SO_1 = (long)BATCH * 3 * 1536 / 4, SO_2 = (long)DEC_BATCH * 3 * 1536 / 4, SO_3 = (long)BATCH * 128 * 128 / 4, SO_4 = (long)DEC_BATCH * 128 * 128 / 4, SO_N = SO_1 + SO_2 + 2 * (SO_3 + SO_4);
__device__ __forceinline__ void so_item(const P& p, long it, f32x4& val, float*& dst) {
    const bf16_t* PR = ws_h(p, WS_PROJ); const bf16_t* src = nullptr; const float* fsrc = nullptr;
    long r = it;
    if (r < SO_1) { const int b = (int)(r / (3 * 384)), j = (int)(r / 384 % 3), c = (int)(r % 384) * 4; src = PR + (size_t)(b * SEQ + SEQ - 3 + j) * PLD + PC_QKV + c; dst = p.out + O_PDC + r * 4; }
    else if ((r -= SO_1) < SO_2) { const int b = (int)(r / (3 * 384)), j = (int)(r / 384 % 3), c = (int)(r % 384) * 4; src = PR + (size_t)(TP + b * DEC_SEQ + DEC_SEQ - 3 + j) * PLD + PC_QKV + c; dst = p.out + O_SDC + r * 4; }
    else { r -= SO_2; const int kv = r >= SO_3 + SO_4; if (kv) r -= SO_3 + SO_4; const int pc = kv ? PC_SV : PC_SK; const float* cache = kv ? p.cache_v : p.cache_k;
        if (r < SO_3) { const int b = (int)(r / (128 * 32)), j = (int)(r / 32 % 128), c = (int)(r % 32) * 4; src = PR + (size_t)(b * SEQ + SEQ - 128 + j) * PLD + pc + c; dst = p.out + (kv ? O_PV : O_PK) + r * 4; }
        else { r -= SO_3; const int b = (int)(r / (128 * 32)), j = (int)(r / 32 % 128), c = (int)(r % 32) * 4; dst = p.out + (kv ? O_SV : O_SK) + r * 4;
            if (j < 128 - DEC_SEQ) fsrc = cache + ((size_t)b * 128 + j + DEC_SEQ) * 128 + c; else src = PR + (size_t)(TP + b * DEC_SEQ + (j - (128 - DEC_SEQ))) * PLD + pc + c; } }
    if (fsrc) val = *(const f32x4*)fsrc;
    else { const u32x2 w = *(const u32x2*)src; val = (f32x4){__builtin_bit_cast(float, w.x << 16), __builtin_bit_cast(float, w.x & 0xffff0000u), __builtin_bit_cast(float, w.y << 16), __builtin_bit_cast(float, w.y & 0xffff0000u)}; }
}
__device__ __forceinline__ void phase_state_out(const P& p) {
    const long gt = blockIdx.x * (long)NTHR + otid(), gs = (long)gridDim.x * NTHR;
    for (long it = gt; it < SO_N; it += 4 * gs) {
        f32x4 v[4]; float* d[4];
#pragma unroll
        for (int u = 0; u < 4; ++u) if (it + u * gs < SO_N) so_item(p, it + u * gs, v[u], d[u]);
#pragma unroll
        for (int u = 0; u < 4; ++u) if (it + u * gs < SO_N) *(f32x4*)d[u] = v[u];
    }
}
#define XB_TMO      128
#define XB_XCNT(j)  (256  + 64 * (j))
#define XB_XSUB(j)  (1280 + 64 * (j))
#define XB_XGEN(j)  (2304 + 64 * (j))
#define XB_TOP      3328
#define XB_TOPGEN   3392
#define XCD_BAR_WORDS 3456
#define XB_SPIN_CAP (1u << 18)

__device__ __forceinline__ unsigned xb_ld(unsigned* p)              { return __hip_atomic_load(p, __ATOMIC_RELAXED, __HIP_MEMORY_SCOPE_AGENT); }
__device__ __forceinline__ unsigned xb_add(unsigned* p, unsigned v) { return __hip_atomic_fetch_add(p, v, __ATOMIC_RELAXED, __HIP_MEMORY_SCOPE_AGENT); }
__device__ __forceinline__ unsigned xb_xcc_id() { return (unsigned)__builtin_amdgcn_s_getreg((3 << 11) | 20) & 0xFu; }
#define XB_SPIN(cond, bar) do { unsigned _sp = 0; while (cond) { __builtin_amdgcn_s_sleep(1); \
    if ((++_sp & 255u) == 0u) { if (xb_ld(&(bar)[XB_TMO])) break; if (_sp > XB_SPIN_CAP) { atomicAdd(&(bar)[XB_TMO], 1u); break; } } } } while (0)

struct XcdBarrier {
    unsigned* bar; unsigned x;
    volatile LAS unsigned* st;
};

__device__ __forceinline__ XcdBarrier xcd_barrier_post(unsigned* bar, volatile LAS unsigned* st) {
    XcdBarrier b; b.bar = bar; b.x = xb_xcc_id(); b.st = st;
    if (threadIdx.x == 0) (void)xb_add(&bar[XB_XCNT(b.x)], 1u);
    return b;
}
__device__ __forceinline__ void xcd_barrier_complete(unsigned* bar, unsigned x, unsigned& nloc, unsigned& nx) {
    const unsigned G = gridDim.x * gridDim.y * gridDim.z;
    unsigned sum, cnt, mine, sp = 0u;
    for (;;) {
        sum = 0u; cnt = 0u; mine = 0u;
#pragma unroll
        for (unsigned j = 0; j < 16; ++j) { const unsigned c = xb_ld(&bar[XB_XCNT(j)]); sum += c; cnt += (c > 0u) ? 1u : 0u; mine = (j == x) ? c : mine; }
        if (sum == G) break;
        __builtin_amdgcn_s_sleep(1);
        if ((++sp & 255u) == 0u) { if (xb_ld(&bar[XB_TMO])) break; if (sp > XB_SPIN_CAP) { atomicAdd(&bar[XB_TMO], 1u); break; } }
    }
    nloc = mine > 0u ? mine : 1u; nx = cnt > 0u ? cnt : 1u;
}

__device__ __forceinline__ void xcd_barrier(const XcdBarrier& b) {
    asm volatile("s_waitcnt vmcnt(0)" ::: "memory");
    __syncthreads();
    if (threadIdx.x == 0) {
        unsigned* bar = b.bar;
        __builtin_amdgcn_s_waitcnt(0);
        unsigned nloc = b.st[0], nx = b.st[1];
        if (nloc == 0u) { xcd_barrier_complete(bar, b.x, nloc, nx); b.st[0] = nloc; b.st[1] = nx; }
        const unsigned old = xb_add(&bar[XB_XSUB(b.x)], 1u);
        const unsigned gen = old / nloc;
        if (old + 1u == (gen + 1u) * nloc) {
            __builtin_amdgcn_fence(__ATOMIC_RELEASE, "agent");
            asm volatile("s_waitcnt vmcnt(0)" ::: "memory");
            const unsigned og = xb_add(&bar[XB_TOP], 1u);
            const unsigned tg = og / nx;
            if (og + 1u == (tg + 1u) * nx) xb_add(&bar[XB_TOPGEN], 1u);
            else XB_SPIN(xb_ld(&bar[XB_TOPGEN]) == tg, bar);
            __builtin_amdgcn_fence(__ATOMIC_ACQUIRE, "agent");
            xb_add(&bar[XB_XGEN(b.x)], 1u);
            asm volatile("s_waitcnt vmcnt(0)" ::: "memory");
        } else {
            XB_SPIN(xb_ld(&bar[XB_XGEN(b.x)]) == gen, bar);
            __builtin_amdgcn_fence(__ATOMIC_ACQUIRE, "agent");
            asm volatile("s_waitcnt vmcnt(0)" ::: "memory");
        }
    }
    __syncthreads();
}
namespace pg8 {
#define PG8_LAS __attribute__((address_space(3)))
typedef unsigned short bf16_t;
typedef short bf16x8 __attribute__((ext_vector_type(8)));
typedef float f32x4 __attribute__((ext_vector_type(4)));
typedef unsigned u32x4 __attribute__((ext_vector_type(4)));
constexpr int BM = 256, BK = 64, HALF = 128, HTB = HALF * BK * 2  , STAGE_BYTES = 8 * HTB, NXCD = 8, WGM = 8;

__host__ __device__ __forceinline__ int lds_byte(int r, int c) { const int st = (r >> 4) * 2 + (c >> 5), rr = r & 15, cc = c & 31, ob = rr * 64 + cc * 2; return st * 1024 + (ob ^ (((ob >> 9) & 1) << 5)); }
__host__ __device__ __forceinline__ void stage_rc(int b, int& R, int& C) { const int st = b / 1024, sb = b % 1024, swz = sb ^ (((sb >> 9) & 1) << 5); R = (st >> 1) * 16 + swz / 64; C = (st & 1) * 32 + (swz % 64) / 2; }
__host__ __device__ __forceinline__ int perm32(int rho) { const int n = rho >> 4, i = rho & 15; return 8 * (i >> 2) + 4 * n + (i & 3); }

struct Unit { int pm, pn, k0, nt, atomic; };
struct Gemm { const bf16_t* A; const bf16_t* Bt; int M, N, K; };

struct StaticOrder {
    int nM, nN, nwg, G, c, ntk;
    __host__ __device__ void init(int M, int N, int G_, int c_, int K_) { nM = M / BM; nN = N / BM; nwg = nM * nN; G = G_; c = c_; ntk = K_ / BK; }
    __host__ __device__ bool next(int i, Unit& u) const {
        const long L = (long)i * G + c; if (L >= nwg) return false;
        int wgid = (int)L; { const int q = nwg / NXCD, r = nwg % NXCD, xcd = wgid % NXCD, off = wgid / NXCD; wgid = (xcd < r ? xcd * (q + 1) : r * (q + 1) + (xcd - r) * q) + off; }
        const int nig = WGM * nN, gid = wgid / nig, fm = gid * WGM, gsz = (nM - fm) < WGM ? (nM - fm) : WGM;
        u.pm = fm + ((wgid % nig) % gsz); u.pn = (wgid % nig) / gsz; u.k0 = 0; u.nt = ntk; u.atomic = 0; return true;
    }
    __device__ __forceinline__ void a_ready(const Unit&) const {}
    __device__ __forceinline__ void done(const Unit&) const {}
};

struct SplitOrder {
    StaticOrder so; int nu1, ns, ntk_sub, npn, nsub, G, c;
    __device__ void init(int N, int K, int NS, int G_, int c_) { so.init(TP, N, G_, c_, K); nu1 = so.nwg; ns = NS; ntk_sub = K / BK / NS; npn = N / BM; nsub = (TS / BM) * npn * NS; G = G_; c = c_; }
    __device__ bool next(int i, Unit& u) const {
        const long L = (long)i * G + c; if (L < nu1) return so.next(i, u);
        const int s = (int)(L - nu1); if (s >= nsub) return false;
        const int ks = s % ns, t = s / ns; u.pm = TP / BM + t / npn; u.pn = t % npn; u.k0 = ks * ntk_sub * BK; u.nt = ntk_sub; u.atomic = 1; return true; }
    __device__ __forceinline__ void a_ready(const Unit&) const {}
    __device__ __forceinline__ void done(const Unit&) const {}
};
__device__ __forceinline__ unsigned cvt_pk_bf16(float lo, float hi) { unsigned r; asm volatile("v_cvt_pk_bf16_f32 %0, %1, %2" : "=v"(r) : "v"(lo), "v"(hi)); return r; }
struct EpiStoreBf16 {
    static constexpr bool PERM = true, AFTER_DRAIN = false;
    bf16_t* O; int ldc;
    __device__ __forceinline__ void operator()(const f32x4 (&acc)[2][2][4][2], const Unit& u, int wr, int wc, int fr, int fq) const {
        const int row0 = u.pm * BM + wr * 64 + fr, col0 = u.pn * BM + wc * 32 + 8 * fq;
#pragma unroll
        for (int ai = 0; ai < 2; ++ai)
#pragma unroll
            for (int m = 0; m < 4; ++m) { bf16_t* rowp = O + (size_t)(row0 + ai * HALF + m * 16) * ldc + col0;
#pragma unroll
                for (int bj = 0; bj < 2; ++bj) { const f32x4 v0 = acc[ai][bj][m][0], v1 = acc[ai][bj][m][1];
                    u32x4 w; w.x = cvt_pk_bf16(v0[0], v0[1]); w.y = cvt_pk_bf16(v0[2], v0[3]); w.z = cvt_pk_bf16(v1[0], v1[1]); w.w = cvt_pk_bf16(v1[2], v1[3]);
                    *(u32x4*)(rowp + bj * HALF) = w; } }
    }
};
template <int MODE> struct EpiGateRes {
    static constexpr bool PERM = false, AFTER_DRAIN = false;
    const float* base_p; const float* base_s; bf16_t* xb; const float* gate; float* slab; int ns;
    __device__ __forceinline__ void operator()(const f32x4 (&acc)[2][2][4][2], const Unit& u, int wr, int wc, int fr, int fq) const {
        typedef unsigned u32x2e __attribute__((ext_vector_type(2)));
        const int row0 = u.pm * BM + wr * 64 + fr, col0 = u.pn * BM + wc * 32 + 4 * fq;
        const bool smp = row0 >= TP; const float* base = smp ? base_s - (size_t)TP * D : base_p;
#pragma unroll
        for (int ai = 0; ai < 2; ++ai)
#pragma unroll
            for (int m = 0; m < 4; ++m) { const int r = row0 + ai * HALF + m * 16; const int cb = smp ? BATCH + ((r - TP) >> 3) : r / SEQ;
                const float* gp = gate + (size_t)cb * 6 * D + col0; const size_t off = (size_t)r * D + col0;
#pragma unroll
                for (int bj = 0; bj < 2; ++bj)
#pragma unroll
                    for (int n = 0; n < 2; ++n) {
                        if (u.atomic) { const int sidx = ((u.pm - TP / BM) * (D / BM) + u.pn) * ns + u.k0 / (u.nt * BK);
                            *(f32x4*)(slab + (size_t)sidx * 65536 + (size_t)(r - u.pm * BM) * 256 + (col0 - u.pn * BM) + bj * HALF + n * 16) = acc[ai][bj][m][n]; }
                        else { const f32x4 gv = *(const f32x4*)(gp + bj * HALF + n * 16); f32x4 bs;
                            if (MODE == 0) bs = *(const f32x4*)(base + off + bj * HALF + n * 16);
                            else { const u32x2e w = *(const u32x2e*)(xb + off + bj * HALF + n * 16); bs = (f32x4){__builtin_bit_cast(float, w.x << 16), __builtin_bit_cast(float, w.x & 0xffff0000u), __builtin_bit_cast(float, w.y << 16), __builtin_bit_cast(float, w.y & 0xffff0000u)}; }
                            const f32x4 v = bs + gv * acc[ai][bj][m][n];
                            *(u32x2e*)(xb + off + bj * HALF + n * 16) = (u32x2e){cvt_pk_bf16(v[0], v[1]), cvt_pk_bf16(v[2], v[3])}; } } }
    }
};
template <class Epi, class Sched, bool ALIGN_EPI = false, bool SP2 = false>
__device__ __forceinline__ void gemm_phase(PG8_LAS unsigned char* lds, const Gemm g, const Sched& S, const Epi& E) {
    const int tid = otid(), wid = __builtin_amdgcn_readfirstlane(tid >> 6), lane = tid & 63, wr = wid >> 2, wc = wid & 3, fr = lane & 15, fq = lane >> 4;
    const int K = g.K;
    unsigned voffA[2], voffB[2];
#pragma unroll
    for (int i = 0; i < 2; ++i) { int R, C; stage_rc(tid * 16 + i * 8192, R, C); const int Rb = Epi::PERM ? ((R & ~31) + perm32(R & 31)) : R;
        voffA[i] = (unsigned)(R * K + C) * 2u; voffB[i] = (unsigned)(Rb * K + C) * 2u; }
    const size_t kstep = (size_t)(BK * 2);
    const size_t hstep = (size_t)HALF * K * 2;
    const size_t tstep = 2 * hstep;
    const unsigned ldsw = (unsigned)wid * 1024u;
    const int aoff = lds_byte(wr * 64 + fr, fq * 8), boff = lds_byte(wc * 32 + fr, fq * 8);
#define PG8_SA(b, h) (((b) * 2 + (h)) * HTB)
#define PG8_SB(b, h) ((4 + (b) * 2 + (h)) * HTB)
#define PG8_STAGE(bufoff, gbase, voff) do { _Pragma("unroll") for (int _i = 0; _i < 2; ++_i) \
        __builtin_amdgcn_global_load_lds((const unsigned*)((const char*)(gbase) + (voff)[_i]), (PG8_LAS unsigned*)(lds + (bufoff) + ldsw + _i * 8192), 16, 0, 0); } while (0)
#define PG8_LDA(dst, b, h) do { _Pragma("unroll") for (int m = 0; m < 4; ++m) _Pragma("unroll") for (int k = 0; k < 2; ++k) dst[m][k] = *(const PG8_LAS bf16x8*)(lds + PG8_SA(b, h) + aoff + m * 2048 + k * 1024); } while (0)
#define PG8_LDB(dst, b, h) do { _Pragma("unroll") for (int n = 0; n < 2; ++n) _Pragma("unroll") for (int k = 0; k < 2; ++k) dst[n][k] = *(const PG8_LAS bf16x8*)(lds + PG8_SB(b, h) + boff + n * 2048 + k * 1024); } while (0)
#define PG8_MMA(ai, bj, At, Bt) do { __builtin_amdgcn_s_setprio(1); _Pragma("unroll") for (int m = 0; m < 4; ++m) _Pragma("unroll") for (int n = 0; n < 2; ++n) _Pragma("unroll") for (int k = 0; k < 2; ++k) \
        acc[ai][bj][m][n] = __builtin_amdgcn_mfma_f32_16x16x32_bf16(Bt[n][k], At[m][k], acc[ai][bj][m][n], 0, 0, 0); __builtin_amdgcn_s_setprio(0); } while (0)
#define PG8_WAIT_V(n) asm volatile("s_waitcnt vmcnt(" #n ")" ::: "memory")
#define PG8_WAIT_L(n) asm volatile("s_waitcnt lgkmcnt(" #n ")" ::: "memory")
#define PG8_BAR __builtin_amdgcn_s_barrier()
#define PG8_SCHED __builtin_amdgcn_sched_barrier(0)
    Unit cur, nxt; int ui = 0;
    if (!S.next(0, cur)) return;
    f32x4 acc[2][2][4][2];
#pragma unroll
    for (int a = 0; a < 2; ++a)
#pragma unroll
        for (int b = 0; b < 2; ++b)
#pragma unroll
            for (int m = 0; m < 4; ++m)
#pragma unroll
                for (int n = 0; n < 2; ++n) acc[a][b][m][n] = (f32x4){0.f, 0.f, 0.f, 0.f};
    bf16x8 At[4][2], B0[2][2], B1[2][2];
    const char* cA = (const char*)g.A + (size_t)cur.pm * tstep + (size_t)cur.k0 * 2; const char* cB = (const char*)g.Bt + (size_t)cur.pn * tstep + (size_t)cur.k0 * 2;
    S.a_ready(cur);
    if constexpr (SP2) {
        PG8_STAGE(PG8_SB(0, 0), cB, voffB); PG8_STAGE(PG8_SB(0, 1), cB + hstep, voffB); PG8_STAGE(PG8_SA(0, 0), cA, voffA); PG8_STAGE(PG8_SA(0, 1), cA + hstep, voffA);
        if (wr == 1) PG8_BAR;
        PG8_WAIT_V(2); PG8_BAR;
        PG8_STAGE(PG8_SB(1, 0), cB + kstep, voffB); PG8_STAGE(PG8_SA(1, 0), cA + kstep, voffA); PG8_STAGE(PG8_SB(1, 1), cB + hstep + kstep, voffB);
        PG8_WAIT_V(6); PG8_BAR;
    } else {
        PG8_STAGE(PG8_SB(0, 0), cB, voffB); PG8_STAGE(PG8_SA(0, 0), cA, voffA); PG8_STAGE(PG8_SB(0, 1), cB + hstep, voffB); PG8_STAGE(PG8_SA(0, 1), cA + hstep, voffA);
        if (wr == 1) PG8_BAR;
        PG8_WAIT_V(4); PG8_BAR;
        PG8_STAGE(PG8_SB(1, 0), cB + kstep, voffB); PG8_STAGE(PG8_SA(1, 0), cA + kstep, voffA); PG8_STAGE(PG8_SB(1, 1), cB + hstep + kstep, voffB);
        PG8_WAIT_V(6); PG8_BAR;
    }
    for (;;) {
        const bool has_next = S.next(ui + 1, nxt);
        const char* nA = has_next ? (const char*)g.A + (size_t)nxt.pm * tstep + (size_t)nxt.k0 * 2 : cA; const char* nB = has_next ? (const char*)g.Bt + (size_t)nxt.pn * tstep + (size_t)nxt.k0 * 2 : cB;
        const int nt = cur.nt;
        for (int t = 0; t < nt; t += 2) {
            const bool last = (t == nt - 2);
            const char* a1 = cA + (size_t)(t + 1) * kstep;
            const char* a2 = last ? nA : cA + (size_t)(t + 2) * kstep; const char* b2 = last ? nB : cB + (size_t)(t + 2) * kstep;
            const char* a3 = a2 + kstep; const char* b3 = b2 + kstep;
            if (last && has_next) S.a_ready(nxt);
            if constexpr (SP2) {
            PG8_LDB(B0, 0, 0); PG8_LDB(B1, 0, 1); PG8_SCHED; PG8_LDA(At, 0, 0); PG8_STAGE(PG8_SA(1, 1), a1 + hstep, voffA);
            PG8_WAIT_V(8); PG8_WAIT_L(0); PG8_BAR; PG8_MMA(0, 0, At, B0); PG8_MMA(0, 1, At, B1); PG8_BAR; PG8_SCHED;
            PG8_LDA(At, 0, 1); PG8_STAGE(PG8_SB(0, 0), b2, voffB); PG8_STAGE(PG8_SB(0, 1), b2 + hstep, voffB); PG8_STAGE(PG8_SA(0, 0), a2, voffA);
            PG8_WAIT_V(8); PG8_WAIT_L(0); PG8_BAR; PG8_MMA(1, 0, At, B0); PG8_MMA(1, 1, At, B1); PG8_BAR; PG8_SCHED;
            PG8_LDB(B0, 1, 0); PG8_LDB(B1, 1, 1); PG8_SCHED; PG8_LDA(At, 1, 0); PG8_STAGE(PG8_SA(0, 1), a2 + hstep, voffA);
            PG8_WAIT_V(8); PG8_WAIT_L(0); PG8_BAR; PG8_MMA(0, 0, At, B0); PG8_MMA(0, 1, At, B1); PG8_BAR; PG8_SCHED;
            PG8_LDA(At, 1, 1); PG8_STAGE(PG8_SB(1, 0), b3, voffB); PG8_STAGE(PG8_SB(1, 1), b3 + hstep, voffB); PG8_STAGE(PG8_SA(1, 0), a3, voffA);
            PG8_WAIT_V(8); PG8_WAIT_L(0); PG8_BAR; PG8_MMA(1, 0, At, B0); PG8_MMA(1, 1, At, B1); PG8_BAR; PG8_SCHED;
            } else {
            PG8_LDB(B0, 0, 0); PG8_SCHED; PG8_LDA(At, 0, 0); PG8_STAGE(PG8_SA(1, 1), a1 + hstep, voffA);
            PG8_WAIT_L(8); PG8_BAR; PG8_WAIT_L(0); PG8_MMA(0, 0, At, B0); PG8_BAR; PG8_SCHED;
            PG8_LDB(B1, 0, 1); PG8_STAGE(PG8_SB(0, 0), b2, voffB);
            PG8_BAR; PG8_WAIT_L(0); PG8_MMA(0, 1, At, B1); PG8_BAR;
            PG8_LDA(At, 0, 1); PG8_STAGE(PG8_SA(0, 0), a2, voffA);
            PG8_BAR; PG8_WAIT_L(0); PG8_MMA(1, 0, At, B0); PG8_BAR; PG8_SCHED;
            PG8_STAGE(PG8_SB(0, 1), b2 + hstep, voffB);
            PG8_WAIT_V(6); PG8_BAR; PG8_MMA(1, 1, At, B1); PG8_BAR;
            PG8_LDB(B0, 1, 0); PG8_SCHED; PG8_LDA(At, 1, 0); PG8_STAGE(PG8_SA(0, 1), a2 + hstep, voffA);
            PG8_WAIT_L(8); PG8_BAR; PG8_WAIT_L(0); PG8_MMA(0, 0, At, B0); PG8_BAR; PG8_SCHED;
            PG8_LDB(B1, 1, 1); PG8_STAGE(PG8_SB(1, 0), b3, voffB);
            PG8_BAR; PG8_WAIT_L(0); PG8_MMA(0, 1, At, B1); PG8_BAR;
            PG8_LDA(At, 1, 1); PG8_STAGE(PG8_SA(1, 0), a3, voffA);
            PG8_BAR; PG8_WAIT_L(0); PG8_MMA(1, 0, At, B0); PG8_BAR; PG8_SCHED;
            PG8_STAGE(PG8_SB(1, 1), b3 + hstep, voffB);
            PG8_WAIT_V(6); PG8_BAR; PG8_MMA(1, 1, At, B1); PG8_BAR;
            }
        }
        if constexpr (ALIGN_EPI) { if (wr == 0) PG8_BAR; }
        if constexpr (!Epi::AFTER_DRAIN) { E(acc, cur, wr, wc, fr, fq); S.done(cur); }
        if (!has_next) break;
#pragma unroll
        for (int a = 0; a < 2; ++a)
#pragma unroll
            for (int b = 0; b < 2; ++b)
#pragma unroll
                for (int m = 0; m < 4; ++m)
#pragma unroll
                    for (int n = 0; n < 2; ++n) acc[a][b][m][n] = (f32x4){0.f, 0.f, 0.f, 0.f};
        cur = nxt; cA = nA; cB = nB; ++ui;
        if constexpr (ALIGN_EPI) { if (wr == 1) PG8_BAR; }
    }
    PG8_WAIT_V(0);
    if constexpr (!ALIGN_EPI) { if (wr == 0) PG8_BAR; }
    PG8_BAR;
    if constexpr (Epi::AFTER_DRAIN) { E.fused(acc, cur, wr, wc, fr, fq, lds, wid, lane); S.done(cur); }
#undef PG8_SA
#undef PG8_SB
#undef PG8_STAGE
#undef PG8_LDA
#undef PG8_LDB
#undef PG8_MMA
#undef PG8_WAIT_V
#undef PG8_WAIT_L
#undef PG8_BAR
#undef PG8_SCHED
}
}
typedef short bf16x8 __attribute__((ext_vector_type(8)));
constexpr int FR_NWK = 0, FR_QD = 16, FR_KTT = 32, FR_QK = 48, FR_N = 56;
__device__ __forceinline__ int kperm(int g, int j) { return j < 4 ? 4 * g + j : 16 + 4 * g + (j - 4); }

typedef float f32x2_t __attribute__((ext_vector_type(2))); typedef __bf16 bf16x2_t __attribute__((ext_vector_type(2)));
__device__ __forceinline__ unsigned cvtpk_c(float lo, float hi) { const f32x2_t v = {lo, hi}; const bf16x2_t b = __builtin_convertvector(v, bf16x2_t); return __builtin_bit_cast(unsigned, b); }
__device__ __forceinline__ bf16x8 pack8(const f32x4 a, const f32x4 b) {
    return __builtin_bit_cast(bf16x8, (u32x4){cvtpk_c(a[0], a[1]), cvtpk_c(a[2], a[3]), cvtpk_c(b[0], b[1]), cvtpk_c(b[2], b[3])});
}
constexpr int DP_KP = 136;
constexpr int DP_RP = 72;
constexpr int DP_QS = 0, DP_KS = DP_QS + 64 * DP_KP * 2, DP_RHST = DP_KS + 64 * DP_KP * 2, DP_AM = DP_RHST + 256 * DP_RP * 2, DP_AMP = 68,
              DP_QKM = DP_AM + 64 * DP_AMP * 4, DP_QKP = 72, DP_GS = DP_QKM + 64 * DP_QKP * 2, DP_DM = DP_GS + 4 * 64 * 4, DP_DMP = 20,
              DP_TB = DP_DM + 64 * DP_DMP * 4, DP_END = DP_TB + 64 * DP_RP * 2;
static_assert(DP_END <= 131072 && DP_AM % 16 == 0 && DP_DM % 16 == 0 && DP_TB % 16 == 0 && DP_RHST % 16 == 0, "dnprep LDS");
#ifndef DPS
#define DPS(k)
#endif
__device__ __forceinline__ void phase_dnprep(const P& p, LAS unsigned char* lds, unsigned long long& pr_prev, unsigned long long& pr_acc) {
    const int tid_ = otid();
    LAS bf16_t* QS = (LAS bf16_t*)(lds + DP_QS); LAS bf16_t* KS = (LAS bf16_t*)(lds + DP_KS); LAS bf16_t* RHST = (LAS bf16_t*)(lds + DP_RHST);
    LAS float* AM = (LAS float*)(lds + DP_AM); LAS bf16_t* QKM = (LAS bf16_t*)(lds + DP_QKM); LAS float* GS = (LAS float*)(lds + DP_GS);
    LAS float* DM = (LAS float*)(lds + DP_DM); LAS bf16_t* TB = (LAS bf16_t*)(lds + DP_TB);
    const bf16_t* PR = ws_h(p, WS_PROJ); const float* BG = ws_f(p, WS_BG);
    for (int i = tid_; i < 64 * DP_RP / 2; i += NTHR) ((LAS unsigned*)TB)[i] = 0u;
    float pgx = 0.f, pbx = 0.f, cw[3][4][2]; unsigned xr[3][11];
#define DP_FETCH(uid_, ln_, wv_) do { const int n_ = (uid_) % NCHUNK, bh_ = (uid_) / NCHUNK, h_ = bh_ & 3, m0_ = (bh_ >> 2) * SEQ + n_ * 64; \
        if ((wv_) == 0) { pgx = BG[(size_t)(m0_ + (ln_)) * 8 + 4 + h_]; pbx = BG[(size_t)(m0_ + (ln_)) * 8 + h_]; } \
        _Pragma("unroll") for (int part = 0; part < 3; ++part) _Pragma("unroll") for (int j = 0; j < 4; ++j) { const float* w = p.dn_conv_w + j * 1536 + part * 512 + h_ * 128 + 2 * (ln_); cw[part][j][0] = w[0]; cw[part][j][1] = w[1]; } \
        _Pragma("unroll") for (int rr = 0; rr < 11; ++rr) { const int t_ = n_ * 64 + (wv_) * 8 + rr - 3; \
            _Pragma("unroll") for (int part = 0; part < 3; ++part) { unsigned v_ = 0u; if (t_ >= 0) v_ = *(const unsigned*)(PR + (size_t)(m0_ + (wv_) * 8 + rr - 3) * PLD + part * 512 + h_ * 128 + 2 * (ln_)); xr[part][rr] = v_; } } } while (0)
    if ((int)blockIdx.x < NUNIT) { int t0 = tid_; asm volatile("" : "+v"(t0)); DP_FETCH((int)blockIdx.x, t0 & 63, t0 >> 6); }
    for (int uid = blockIdx.x; uid < NUNIT; uid += gridDim.x) {
        const int n = uid % NCHUNK;
        int tid = tid_; asm volatile("" : "+v"(tid));
        const int lane = tid & 63, wave = tid >> 6, r16 = lane & 15, g4 = lane >> 4;
        unsigned char* abu = p.ws + WS_DNF_AB + (size_t)uid * DNF_AB_UNIT;
        if (wave == 0) {
            float x = pgx;
#pragma unroll
            for (int o = 1; o < 64; o <<= 1) { const float t = __shfl_up(x, o); if (lane >= o) x += t; }
            const float gl = __shfl(x, 63);
            GS[lane] = x; GS[64 + lane] = pbx; GS[128 + lane] = __expf(x); GS[192 + lane] = __expf(gl - x);
            if (lane == 0) ws_f(p, WS_DNF_CD)[uid] = __expf(gl);
        }
        __syncthreads();
        {
            float c[8][3][2], ssum[16];
#pragma unroll
            for (int i = 0; i < 8; ++i) {
#pragma unroll
                for (int part = 0; part < 3; ++part)
#pragma unroll
                    for (int e = 0; e < 2; ++e) { float a = 0.f;
#pragma unroll
                        for (int j = 0; j < 4; ++j) a += cw[part][j][e] * (e == 0 ? __builtin_bit_cast(float, xr[part][i + j] << 16) : __builtin_bit_cast(float, xr[part][i + j] & 0xffff0000u));
                        c[i][part][e] = a * __builtin_amdgcn_rcpf(1.0f + __expf(-a)); }
                ssum[2 * i] = c[i][0][0] * c[i][0][0] + c[i][0][1] * c[i][0][1]; ssum[2 * i + 1] = c[i][1][0] * c[i][1][0] + c[i][1][1] * c[i][1][1]; }
#pragma unroll
            for (int o = 1; o < 64; o <<= 1) {
#pragma unroll
                for (int q = 0; q < 16; ++q) ssum[q] += __shfl_xor(ssum[q], o); }
#pragma unroll
            for (int i = 0; i < 8; ++i) { const int row = wave * 8 + i;
                const float rq = 0.08838834764831845f * __builtin_amdgcn_rsqf(ssum[2 * i] + EPS), rk = __builtin_amdgcn_rsqf(ssum[2 * i + 1] + EPS);
                const float beta = GS[64 + row], eg = GS[128 + row];
                const float q0 = c[i][0][0] * rq, q1 = c[i][0][1] * rq, k0 = c[i][1][0] * rk, k1 = c[i][1][1] * rk;
                *(LAS unsigned*)(QS + row * DP_KP + 2 * lane) = pk2(q0, q1);
                *(LAS unsigned*)(KS + row * DP_KP + 2 * lane) = pk2(k0, k1);
                RHST[(2 * lane) * DP_RP + row] = f2bf(beta * c[i][2][0]); RHST[(2 * lane + 1) * DP_RP + row] = f2bf(beta * c[i][2][1]);
                RHST[(128 + 2 * lane) * DP_RP + row] = f2bf(beta * eg * k0); RHST[(128 + 2 * lane + 1) * DP_RP + row] = f2bf(beta * eg * k1); }
        }
        if (uid + (int)gridDim.x < NUNIT) DP_FETCH(uid + (int)gridDim.x, lane, wave);
        __syncthreads(); DPS(16);
        {
            const int ti = wave >> 1;
            f32x4 akk[2], aqk[2];
#pragma unroll
            for (int c = 0; c < 2; ++c) { akk[c] = (f32x4){0.f, 0.f, 0.f, 0.f}; aqk[c] = (f32x4){0.f, 0.f, 0.f, 0.f}; }
#pragma unroll
            for (int kb = 0; kb < 4; ++kb) {
                const bf16x8 ak = *(const LAS bf16x8*)(KS + (16 * ti + r16) * DP_KP + 32 * kb + 8 * g4), aq = *(const LAS bf16x8*)(QS + (16 * ti + r16) * DP_KP + 32 * kb + 8 * g4);
#pragma unroll
                for (int c = 0; c < 2; ++c) { const int tj = 2 * (wave & 1) + c; const bf16x8 bk = *(const LAS bf16x8*)(KS + (16 * tj + r16) * DP_KP + 32 * kb + 8 * g4);
                    akk[c] = __builtin_amdgcn_mfma_f32_16x16x32_bf16(ak, bk, akk[c], 0, 0, 0); aqk[c] = __builtin_amdgcn_mfma_f32_16x16x32_bf16(aq, bk, aqk[c], 0, 0, 0); }
            }
#pragma unroll
            for (int c = 0; c < 2; ++c) { const int tj = 2 * (wave & 1) + c, J = 16 * tj + r16; const float gj = GS[J];
#pragma unroll
                for (int i = 0; i < 4; ++i) { const int I = 16 * ti + 4 * g4 + i; const float dec = I >= J ? __expf(GS[I] - gj) : 0.f;
                    AM[I * DP_AMP + J] = I > J ? GS[64 + I] * akk[c][i] * dec : 0.f; QKM[I * DP_QKP + J] = f2bf(aqk[c][i] * dec); } }
        }
        __syncthreads(); DPS(17);
        if (wave == 0) {
            const int bb = g4, cc = r16; float t[16];
            f32x4 tr[16][4];
#pragma unroll
            for (int i = 1; i < 16; ++i)
#pragma unroll
                for (int j4 = 0; j4 < (i + 3) / 4; ++j4) tr[i][j4] = *(const LAS f32x4*)(AM + (16 * bb + i) * DP_AMP + 16 * bb + 4 * j4);
            __builtin_amdgcn_sched_barrier(0);
#pragma unroll
            for (int i = 0; i < 16; ++i) { float acc = (i == cc) ? 1.f : 0.f;
#pragma unroll
                for (int j = 0; j < i; ++j) acc -= tr[i][j >> 2][j & 3] * t[j];
                t[i] = acc; }
#pragma unroll
            for (int i = 0; i < 16; ++i) { DM[(16 * bb + i) * DP_DMP + cc] = t[i]; TB[(16 * bb + i) * DP_RP + 16 * bb + cc] = f2bf(t[i]); }
        } else if (wave >= 4) {
            for (int f = FR_QD + (wave - 4); f < FR_N; f += 4) {
                u32x4 o;
                if (f < FR_KTT) { const int mt = (f - FR_QD) >> 2, kb = (f - FR_QD) & 3, row = 16 * mt + r16; const float sc = GS[128 + row];
                    const u32x2 lo = *(const LAS u32x2*)(QS + row * DP_KP + 32 * kb + 4 * g4), hi = *(const LAS u32x2*)(QS + row * DP_KP + 32 * kb + 16 + 4 * g4);
                    const unsigned w[4] = {lo.x, lo.y, hi.x, hi.y}; unsigned r[4];
#pragma unroll
                    for (int e = 0; e < 4; ++e) r[e] = cvtpk_c(__builtin_bit_cast(float, w[e] << 16) * sc, __builtin_bit_cast(float, w[e] & 0xffff0000u) * sc);
                    o = (u32x4){r[0], r[1], r[2], r[3]};
                } else if (f < FR_QK) { const int kt = (f - FR_KTT) >> 1, tb = (f - FR_KTT) & 1; float v[8];
#pragma unroll
                    for (int j = 0; j < 8; ++j) { const int tok = 32 * tb + kperm(g4, j); v[j] = bf2f(KS[tok * DP_KP + 16 * kt + r16]) * GS[192 + tok]; }
                    o = (u32x4){cvtpk_c(v[0], v[1]), cvtpk_c(v[2], v[3]), cvtpk_c(v[4], v[5]), cvtpk_c(v[6], v[7])};
                } else { const int mt = (f - FR_QK) >> 1, tb = (f - FR_QK) & 1, row = 16 * mt + r16;
                    const u32x2 lo = *(const LAS u32x2*)(QKM + row * DP_QKP + 32 * tb + 4 * g4), hi = *(const LAS u32x2*)(QKM + row * DP_QKP + 32 * tb + 16 + 4 * g4);
                    o = (u32x4){lo.x, lo.y, hi.x, hi.y}; }
                *(u32x4*)(abu + (size_t)f * 1024 + lane * 16) = o;
            }
        }
        __syncthreads(); DPS(18);
        if (wave < 3) {
            const int j = wave; f32x4 Tk[4];
#pragma unroll
            for (int kk = 0; kk < 4; ++kk) Tk[j][kk] = DM[(16 * j + 4 * g4 + kk) * DP_DMP + r16];
#pragma unroll
            for (int i = 1; i < 4; ++i) if (i > j) {
                f32x4 acc = (f32x4){0.f, 0.f, 0.f, 0.f};
#pragma unroll
                for (int k = 0; k < 3; ++k) if (k >= j && k < i) { const f32x4 a = *(const LAS f32x4*)(AM + (16 * i + r16) * DP_AMP + 16 * k + 4 * g4);
#pragma unroll
                    for (int kk = 0; kk < 4; ++kk) acc = __builtin_amdgcn_mfma_f32_16x16x4f32(a[kk], Tk[k][kk], acc, 0, 0, 0); }
                const f32x4 dd = *(const LAS f32x4*)(DM + (16 * i + r16) * DP_DMP + 4 * g4);
                f32x4 res = (f32x4){0.f, 0.f, 0.f, 0.f};
#pragma unroll
                for (int kk = 0; kk < 4; ++kk) res = __builtin_amdgcn_mfma_f32_16x16x4f32(dd[kk], acc[kk], res, 0, 0, 0);
                Tk[i] = -res;
#pragma unroll
                for (int e = 0; e < 4; ++e) TB[(16 * i + 4 * g4 + e) * DP_RP + 16 * j + r16] = f2bf(Tk[i][e]); }
        }
        __syncthreads(); DPS(19);
        {
            const int mt = wave & 3, half = wave >> 2;
            bf16x8 tf[2];
#pragma unroll
            for (int kb = 0; kb < 2; ++kb) tf[kb] = *(const LAS bf16x8*)(TB + (16 * mt + r16) * DP_RP + 32 * kb + 8 * g4);
            if (half == 0) {
                float* wv = (float*)(p.ws + WS_DNF_WV + (size_t)uid * DNF_WV_UNIT) + (size_t)mt * 256 + lane * 4;
#pragma unroll
                for (int vt = 0; vt < 8; ++vt) { f32x4 acc = (f32x4){0.f, 0.f, 0.f, 0.f};
#pragma unroll
                    for (int kb = 0; kb < 2; ++kb) acc = __builtin_amdgcn_mfma_f32_16x16x32_bf16(tf[kb], *(const LAS bf16x8*)(RHST + (16 * vt + r16) * DP_RP + 32 * kb + 8 * g4), acc, 0, 0, 0);
                    *(f32x4*)(wv + (size_t)vt * 1024) = acc; }
            } else {
#pragma unroll
                for (int kbp = 0; kbp < 4; ++kbp) { f32x4 xt[2];
#pragma unroll
                    for (int c2 = 0; c2 < 2; ++c2) { xt[c2] = (f32x4){0.f, 0.f, 0.f, 0.f};
#pragma unroll
                        for (int kb = 0; kb < 2; ++kb) xt[c2] = __builtin_amdgcn_mfma_f32_16x16x32_bf16(*(const LAS bf16x8*)(RHST + (128 + 16 * (2 * kbp + c2) + r16) * DP_RP + 32 * kb + 8 * g4), tf[kb], xt[c2], 0, 0, 0); }
                    *(u32x4*)(abu + (size_t)(FR_NWK + mt * 4 + kbp) * 1024 + lane * 16) = __builtin_bit_cast(u32x4, pack8(-xt[0], -xt[1])); }
            }
        }
        __syncthreads(); DPS(20);
    }
#undef DP_FETCH
}

constexpr size_t O_ODN = O_Y;
#define DN_SB() __builtin_amdgcn_sched_barrier(0)
__device__ __forceinline__ void dn_consume(const LAS unsigned char* fb, int wl, f32x4 (&S)[8], float cd, float* op) {
    f32x4 u[4], o[4];
    bf16x8 fa[16], fq[16], Sb[4], Ub[2];
#pragma unroll
    for (int mt = 0; mt < 4; ++mt) u[mt] = *(const LAS f32x4*)(fb + (FR_N + wl * 4 + mt) * 1024);
#pragma unroll
    for (int f = 0; f < 16; ++f) fa[f] = *(const LAS bf16x8*)(fb + (FR_NWK + f) * 1024);
#pragma unroll
    for (int f = 0; f < 8; ++f) fq[f] = *(const LAS bf16x8*)(fb + (FR_QD + f) * 1024);
    DN_SB();
#pragma unroll
    for (int kb = 0; kb < 4; ++kb) Sb[kb] = pack8(S[2 * kb], S[2 * kb + 1]);
#pragma unroll
    for (int mt = 0; mt < 4; ++mt)
#pragma unroll
        for (int kb = 0; kb < 4; ++kb) u[mt] = __builtin_amdgcn_mfma_f32_16x16x32_bf16(fa[mt * 4 + kb], Sb[kb], u[mt], 0, 0, 0);
    DN_SB();
#pragma unroll
    for (int f = 8; f < 16; ++f) fq[f] = *(const LAS bf16x8*)(fb + (FR_QD + f) * 1024);
#pragma unroll
    for (int f = 0; f < 8; ++f) fa[f] = *(const LAS bf16x8*)(fb + (FR_KTT + f) * 1024);
    DN_SB();
#pragma unroll
    for (int mt = 0; mt < 4; ++mt) { o[mt] = (f32x4){0.f, 0.f, 0.f, 0.f};
#pragma unroll
        for (int kb = 0; kb < 4; ++kb) o[mt] = __builtin_amdgcn_mfma_f32_16x16x32_bf16(fq[mt * 4 + kb], Sb[kb], o[mt], 0, 0, 0); }
    DN_SB();
#pragma unroll
    for (int f = 8; f < 16; ++f) fa[f] = *(const LAS bf16x8*)(fb + (FR_KTT + f) * 1024);
#pragma unroll
    for (int f = 0; f < 8; ++f) fq[f] = *(const LAS bf16x8*)(fb + (FR_QK + f) * 1024);
#pragma unroll
    for (int tb = 0; tb < 2; ++tb) Ub[tb] = pack8(u[2 * tb], u[2 * tb + 1]);
#pragma unroll
    for (int kt = 0; kt < 8; ++kt) S[kt] = S[kt] * cd;
    DN_SB();
#pragma unroll
    for (int kt = 0; kt < 8; ++kt)
#pragma unroll
        for (int tb = 0; tb < 2; ++tb) S[kt] = __builtin_amdgcn_mfma_f32_16x16x32_bf16(fa[kt * 2 + tb], Ub[tb], S[kt], 0, 0, 0);
#pragma unroll
    for (int mt = 0; mt < 4; ++mt) {
#pragma unroll
        for (int tb = 0; tb < 2; ++tb) o[mt] = __builtin_amdgcn_mfma_f32_16x16x32_bf16(fq[mt * 2 + tb], Ub[tb], o[mt], 0, 0, 0);
#pragma unroll
        for (int i = 0; i < 4; ++i) op[(size_t)(16 * mt + i) * 512] = o[mt][i]; }
}
constexpr int DN_SBUF = 73728;
__device__ __forceinline__ void phase_dnscan(const P& p, LAS unsigned char* lds) {
    if (blockIdx.x >= BATCH * 4 * 2) return;
    const int tid = otid(), lane = tid & 63, wave = __builtin_amdgcn_readfirstlane(tid >> 6), r16 = lane & 15, g4 = lane >> 4;
    const int bh = blockIdx.x >> 1, vh = blockIdx.x & 1, h = bh & 3, b = bh >> 2, wl = wave & 3, vs = vh * 4 + wl, v0 = vs * 16;
    const float* cdp = ws_f(p, WS_DNF_CD) + (size_t)bh * NCHUNK;
    float* odn = p.out + O_ODN;
#define DN_BAR() do { asm volatile("s_waitcnt lgkmcnt(0)" ::: "memory"); __builtin_amdgcn_s_barrier(); asm volatile("" ::: "memory"); } while (0)
    if (wave >= 4) {
        const unsigned char* ab = p.ws + WS_DNF_AB + (size_t)bh * NCHUNK * DNF_AB_UNIT + lane * 16;
        const unsigned char* wvb = p.ws + WS_DNF_WV + (size_t)bh * NCHUNK * DNF_WV_UNIT + (size_t)vh * 16 * 1024 + lane * 16;
        u32x4 R[3][18];
#define DN_SRC(n_, q_) ((q_) < FR_N ? ab + (size_t)(n_) * DNF_AB_UNIT + (q_) * 1024 : wvb + (size_t)(n_) * DNF_WV_UNIT + ((q_) - FR_N) * 1024)
#define DN_LD(n_, s_) do { if ((n_) < NCHUNK) { _Pragma("unroll") for (int i_ = 0; i_ < 18; ++i_) R[s_][i_] = *(const u32x4*)DN_SRC(n_, wl * 18 + i_); } } while (0)
#define DN_ST(n_, s_) do { if ((n_) < NCHUNK) { LAS unsigned char* d_ = lds + ((n_) & 1) * DN_SBUF + wl * 18 * 1024 + lane * 16; _Pragma("unroll") for (int i_ = 0; i_ < 18; ++i_) *(LAS u32x4*)(d_ + i_ * 1024) = R[s_][i_]; } } while (0)
        DN_LD(0, 0); DN_LD(1, 1); DN_LD(2, 2); DN_ST(0, 0);
        DN_BAR();
#define DN_LSTEP(n_, s_) do { const int n = (n_); if (n < NCHUNK) { DN_LD(n + 3, s_); DN_ST(n + 1, ((s_) + 1) % 3); DN_BAR(); } } while (0)
        for (int n3 = 0; n3 < NCHUNK; n3 += 3) { DN_LSTEP(n3, 0); DN_LSTEP(n3 + 1, 1); DN_LSTEP(n3 + 2, 2); }
#undef DN_LSTEP
#undef DN_LD
#undef DN_ST
#undef DN_SRC
        return;
    }
    f32x4 S[8];
#pragma unroll
    for (int t = 0; t < 8; ++t) S[t] = (f32x4){0.f, 0.f, 0.f, 0.f};
    float cd = cdp[0];
    DN_BAR();
    for (int n = 0; n < NCHUNK; ++n) {
        const float cdn = cdp[n + 1 < NCHUNK ? n + 1 : n];
        dn_consume(lds + (n & 1) * DN_SBUF + lane * 16, wl, S, cd, odn + (size_t)(b * SEQ + n * 64 + 4 * g4) * 512 + h * 128 + v0 + r16);
        cd = cdn;
        DN_BAR();
    }
#undef DN_BAR
    {
        float* so = p.out + O_PSSM + (size_t)bh * 128 * 128 + v0 + r16;
#pragma unroll
        for (int kt = 0; kt < 8; ++kt)
#pragma unroll
            for (int i = 0; i < 4; ++i) so[(size_t)(16 * kt + 4 * g4 + i) * 128] = S[kt][i];
    }
}
__device__ __forceinline__ void phase_dngate(const P& p) {
    const int tid_ = otid(), lane = tid_ & 63, wave = tid_ >> 6;
    const int gw = blockIdx.x * NWAVES + wave, NGW = gridDim.x * NWAVES;
    const f32x4 nw0 = *(const f32x4*)(p.dn_norm_w + (lane & 15) * 8), nw1 = *(const f32x4*)(p.dn_norm_w + (lane & 15) * 8 + 4);
    f32x4 a, c; u32x4 z;
#define DG_LOAD(m_) do { const float* o_ = p.out + O_ODN + (size_t)(m_) * 512 + lane * 8; a = *(const f32x4*)o_; c = *(const f32x4*)(o_ + 4); z = *(const u32x4*)(ws_h(p, WS_PROJ) + (size_t)(m_) * PLD + PC_Z + lane * 8); } while (0)
    if (gw < TP) DG_LOAD(gw);
    for (int m = gw; m < TP; m += NGW) {
        const f32x4 a0 = a, c0 = c; const u32x4 z0 = z;
        if (m + NGW < TP) DG_LOAD(m + NGW);
        float ss = (a0[0] * a0[0] + a0[1] * a0[1]) + (a0[2] * a0[2] + a0[3] * a0[3]) + (c0[0] * c0[0] + c0[1] * c0[1]) + (c0[2] * c0[2] + c0[3] * c0[3]);
#pragma unroll
        for (int off = 1; off < 16; off <<= 1) ss += __shfl_xor(ss, off);
        const float rstd = 1.0f / sqrtf(ss * (1.0f / 128.0f) + EPS);
        const unsigned zw[4] = {z0.x, z0.y, z0.z, z0.w}; const float ov[8] = {a0[0], a0[1], a0[2], a0[3], c0[0], c0[1], c0[2], c0[3]}; const float nwv[8] = {nw0[0], nw0[1], nw0[2], nw0[3], nw1[0], nw1[1], nw1[2], nw1[3]};
        unsigned r[4];
#pragma unroll
        for (int e = 0; e < 4; ++e) { const float z0f = __builtin_bit_cast(float, zw[e] << 16), z1f = __builtin_bit_cast(float, zw[e] & 0xffff0000u);
            r[e] = pk2(ov[2 * e] * rstd * nwv[2 * e] * silu_f(z0f), ov[2 * e + 1] * rstd * nwv[2 * e + 1] * silu_f(z1f)); }
        *(u32x4*)(ws_h(p, WS_MIX) + (size_t)m * 1024 + lane * 8) = (u32x4){r[0], r[1], r[2], r[3]};
    }
#undef DG_LOAD
}
__device__ __forceinline__ void phase_dnsample(const P& p, LAS unsigned char* lds, unsigned long long& pr_prev, unsigned long long& pr_acc) {
    const int tid = otid(), lane = tid & 63, us = tid >> 8, w4 = (tid >> 6) & 3, kh = lane >> 5, col_ = w4 * 32 + (lane & 31);
    LAS float* QH = (LAS float*)lds + us * 4352;
    LAS float* KH = QH + 1024; LAS float* VH = QH + 2048; LAS float* OH = QH + 3072; LAS float* RED = QH + 4096;
    const bf16_t* PR = ws_h(p, WS_PROJ); const float* BG = ws_f(p, WS_BG);
    for (int ub = blockIdx.x; ub < DEC_BATCH * 2; ub += gridDim.x) {
        const int uidx = ub * 2 + us, b = uidx >> 2, h = uidx & 3, m0 = TP + b * DEC_SEQ;
        int col = col_; asm volatile("" : "+v"(col));
        {
            float x0[11], x1[11];
            const int ch0 = kh * 512 + h * 128 + col;
#pragma unroll
            for (int rr = 0; rr < 11; ++rr) {
                if (rr < 3) { const float* st = p.state_dn_conv + ((size_t)b * 3 + rr) * 1536; x0[rr] = st[ch0]; x1[rr] = st[1024 + h * 128 + col]; }
                else { const bf16_t* pr = PR + (size_t)(m0 + rr - 3) * PLD; x0[rr] = bf2f(pr[ch0]); x1[rr] = bf2f(pr[1024 + h * 128 + col]); } }
            float w0[4], w1[4];
#pragma unroll
            for (int j = 0; j < 4; ++j) { w0[j] = p.dn_conv_w[j * 1536 + ch0]; w1[j] = p.dn_conv_w[j * 1536 + 1024 + h * 128 + col]; }
            float ssq[8], ssk[8];
#pragma unroll
            for (int t = 0; t < 8; ++t) { float a = 0.f, d = 0.f;
#pragma unroll
                for (int j = 0; j < 4; ++j) { a += w0[j] * x0[t + j]; d += w1[j] * x1[t + j]; }
                a = a * __builtin_amdgcn_rcpf(1.0f + __expf(-a)); d = d * __builtin_amdgcn_rcpf(1.0f + __expf(-d));
                if (kh == 0) { QH[t * 128 + col] = a; VH[t * 128 + col] = d; } else KH[t * 128 + col] = a;
                ssq[t] = kh == 0 ? a * a : 0.f; ssk[t] = kh == 1 ? a * a : 0.f; }
#pragma unroll
            for (int o = 1; o < 64; o <<= 1) {
#pragma unroll
                for (int t = 0; t < 8; ++t) { ssq[t] += __shfl_xor(ssq[t], o); ssk[t] += __shfl_xor(ssk[t], o); } }
            if (lane == 0) {
#pragma unroll
                for (int t = 0; t < 8; ++t) { RED[w4 * 16 + t] = ssq[t]; RED[w4 * 16 + 8 + t] = ssk[t]; } }
        }
        __syncthreads(); DPS(27);
#pragma unroll
        for (int t = 0; t < 8; ++t) {
            if (kh == 0) { const float sq = (RED[t] + RED[16 + t]) + (RED[32 + t] + RED[48 + t]); QH[t * 128 + col] *= 0.08838834764831845f / sqrtf(sq + EPS); }
            else { const float sk = (RED[8 + t] + RED[24 + t]) + (RED[40 + t] + RED[56 + t]); KH[t * 128 + col] *= 1.0f / sqrtf(sk + EPS); } }
        __syncthreads(); DPS(28);
        float S[64];
        const float* S0 = p.state_dn_ssm + ((size_t)b * 4 + h) * 128 * 128 + (size_t)kh * 64 * 128 + col;
#pragma unroll
        for (int k = 0; k < 64; ++k) { S[k] = *S0; S0 += 128; if ((k & 7) == 7) asm volatile("" : "+v"(S0)); }
#pragma unroll 1
        for (int t = 0; t < 8; ++t) {
            const float beta = BG[(size_t)(m0 + t) * 8 + h], eg = __expf(BG[(size_t)(m0 + t) * 8 + 4 + h]);
            const LAS float* kp = KH + t * 128 + kh * 64; const LAS float* qp = QH + t * 128 + kh * 64;
            f32x4 kk[16], qq[16];
#pragma unroll
            for (int k4 = 0; k4 < 16; ++k4) kk[k4] = *(const LAS f32x4*)(kp + 4 * k4);
#pragma unroll
            for (int k4 = 0; k4 < 16; ++k4) qq[k4] = *(const LAS f32x4*)(qp + 4 * k4);
            const float vt = VH[t * 128 + col];
            __builtin_amdgcn_sched_barrier(0);
            float kS = 0.f;
#pragma unroll
            for (int k4 = 0; k4 < 16; ++k4)
#pragma unroll
                for (int e = 0; e < 4; ++e) { S[4 * k4 + e] *= eg; kS += kk[k4][e] * S[4 * k4 + e]; }
            kS += __shfl_xor(kS, 32);
            const float u = beta * (vt - kS);
            float o = 0.f;
#pragma unroll
            for (int k4 = 0; k4 < 16; ++k4)
#pragma unroll
                for (int e = 0; e < 4; ++e) { S[4 * k4 + e] += kk[k4][e] * u; o += qq[k4][e] * S[4 * k4 + e]; }
            o += __shfl_xor(o, 32);
            if (kh == 0) OH[t * 128 + col] = o;
            __builtin_amdgcn_sched_barrier(0);
        }
        float* So = p.out + O_SSSM + ((size_t)b * 4 + h) * 128 * 128 + (size_t)kh * 64 * 128 + col;
#pragma unroll
        for (int k = 0; k < 64; ++k) { *So = S[k]; So += 128; if ((k & 7) == 7) asm volatile("" : "+v"(So)); }
        __syncthreads(); DPS(29);
#pragma unroll
        for (int t = 0; t < 8; ++t) { const float o = kh == 0 ? OH[t * 128 + col] : 0.f; const float s = wave_sum(o * o); if (lane == 0) RED[w4 * 16 + t] = s; }
        __syncthreads();
        if (kh == 0) {
            const float nw = p.dn_norm_w[col];
#pragma unroll
            for (int t = 0; t < 8; ++t) { const float rstd = 1.0f / sqrtf(((RED[t] + RED[16 + t]) + (RED[32 + t] + RED[48 + t])) * (1.0f / 128.0f) + EPS);
                const float z = bf2f(PR[(size_t)(m0 + t) * PLD + PC_Z + h * 128 + col]);
                ws_h(p, WS_MIX)[(size_t)(m0 + t) * 1024 + h * 128 + col] = f2bf(OH[t * 128 + col] * rstd * nw * silu_f(z)); }
        }
        __syncthreads(); DPS(30);
    }
}
constexpr int NSEG = 16, CSEG = NCHUNK / NSEG, NBH = BATCH * 4;
static_assert(NCHUNK % NSEG == 0, "segments");
constexpr size_t O_RFRAG = O_ODN + (size_t)TP * 512;
constexpr size_t O_BSEG = O_RFRAG + (size_t)NBH * NSEG * 8192;
constexpr size_t O_SSEG = O_BSEG + (size_t)NBH * NSEG * 16384;
constexpr size_t O_CPROD = O_SSEG + (size_t)NBH * NSEG * 16384;
static_assert(O_CPROD + NBH * NSEG <= (size_t)T * D, "segment scratch fits in the y region of d_out");

template <bool HASWV> __device__ __forceinline__ void dn_consume_map(const LAS unsigned char* fb, int wl, f32x4 (&X)[8], float cd) {
    f32x4 u[4]; bf16x8 f0[8], f1[8], Xb[4], Ub[2];
#pragma unroll
    for (int mt = 0; mt < 4; ++mt) u[mt] = HASWV ? *(const LAS f32x4*)(fb + (FR_N + wl * 4 + mt) * 1024) : (f32x4){0.f, 0.f, 0.f, 0.f};
#pragma unroll
    for (int f = 0; f < 8; ++f) f0[f] = *(const LAS bf16x8*)(fb + (FR_NWK + f) * 1024);
#pragma unroll
    for (int f = 0; f < 8; ++f) f1[f] = *(const LAS bf16x8*)(fb + (FR_NWK + 8 + f) * 1024);
    DN_SB();
#pragma unroll
    for (int kb = 0; kb < 4; ++kb) Xb[kb] = pack8(X[2 * kb], X[2 * kb + 1]);
#pragma unroll
    for (int mt = 0; mt < 2; ++mt)
#pragma unroll
        for (int kb = 0; kb < 4; ++kb) u[mt] = __builtin_amdgcn_mfma_f32_16x16x32_bf16(f0[mt * 4 + kb], Xb[kb], u[mt], 0, 0, 0);
    DN_SB();
#pragma unroll
    for (int f = 0; f < 8; ++f) f0[f] = *(const LAS bf16x8*)(fb + (FR_KTT + f) * 1024);
    DN_SB();
#pragma unroll
    for (int mt = 2; mt < 4; ++mt)
#pragma unroll
        for (int kb = 0; kb < 4; ++kb) u[mt] = __builtin_amdgcn_mfma_f32_16x16x32_bf16(f1[(mt - 2) * 4 + kb], Xb[kb], u[mt], 0, 0, 0);
    DN_SB();
#pragma unroll
    for (int f = 0; f < 8; ++f) f1[f] = *(const LAS bf16x8*)(fb + (FR_KTT + 8 + f) * 1024);
#pragma unroll
    for (int tb = 0; tb < 2; ++tb) Ub[tb] = pack8(u[2 * tb], u[2 * tb + 1]);
#pragma unroll
    for (int kt = 0; kt < 8; ++kt) X[kt] = X[kt] * cd;
    DN_SB();
#pragma unroll
    for (int kt = 0; kt < 4; ++kt)
#pragma unroll
        for (int tb = 0; tb < 2; ++tb) X[kt] = __builtin_amdgcn_mfma_f32_16x16x32_bf16(f0[kt * 2 + tb], Ub[tb], X[kt], 0, 0, 0);
#pragma unroll
    for (int kt = 4; kt < 8; ++kt)
#pragma unroll
        for (int tb = 0; tb < 2; ++tb) X[kt] = __builtin_amdgcn_mfma_f32_16x16x32_bf16(f1[(kt - 4) * 2 + tb], Ub[tb], X[kt], 0, 0, 0);
}
#define DNS_BAR() do { asm volatile("s_waitcnt lgkmcnt(0)" ::: "memory"); __builtin_amdgcn_s_barrier(); asm volatile("" ::: "memory"); } while (0)
template <int MODE> __device__ __forceinline__ void dns_loader(const P& p, LAS unsigned char* lds, int bh, int n0, int nsteps, int vh, int wl, int lane) {
    constexpr int NPW = MODE == 2 ? 18 : (MODE == 1 ? 12 : 8);
    const unsigned char* ab = p.ws + WS_DNF_AB + ((size_t)bh * NCHUNK + n0) * DNF_AB_UNIT + lane * 16;
    const unsigned char* wvb = p.ws + WS_DNF_WV + ((size_t)bh * NCHUNK + n0) * DNF_WV_UNIT + (size_t)vh * 16 * 1024 + lane * 16;
    u32x4 R[2][NPW];
#define DNS_FRAG(q_) (MODE == 2 ? (q_) : ((q_) < 16 ? (q_) : ((q_) < 32 ? FR_KTT + (q_) - 16 : FR_N + (q_) - 32)))
#define DNS_SRC(n_, q_) (DNS_FRAG(q_) < FR_N ? ab + (size_t)(n_) * DNF_AB_UNIT + DNS_FRAG(q_) * 1024 : wvb + (size_t)(n_) * DNF_WV_UNIT + (DNS_FRAG(q_) - FR_N) * 1024)
#define DNS_LD(n_, s_) do { if ((n_) < nsteps) { _Pragma("unroll") for (int i_ = 0; i_ < NPW; ++i_) R[s_][i_] = *(const u32x4*)DNS_SRC(n_, wl * NPW + i_); } } while (0)
#define DNS_ST(n_, s_) do { if ((n_) < nsteps) { LAS unsigned char* d_ = lds + ((n_) & 1) * DN_SBUF + lane * 16; _Pragma("unroll") for (int i_ = 0; i_ < NPW; ++i_) *(LAS u32x4*)(d_ + DNS_FRAG(wl * NPW + i_) * 1024) = R[s_][i_]; } } while (0)
    DNS_LD(0, 0); DNS_LD(1, 1); DNS_ST(0, 0);
    DNS_BAR();
#define DNS_LSTEP(n_, s_) do { const int n = (n_); if (n < nsteps) { DNS_LD(n + 2, s_); DNS_ST(n + 1, (s_) ^ 1); DNS_BAR(); } } while (0)
    for (int n2 = 0; n2 < nsteps; n2 += 2) { DNS_LSTEP(n2, 0); DNS_LSTEP(n2 + 1, 1); }
#undef DNS_LSTEP
#undef DNS_LD
#undef DNS_ST
#undef DNS_SRC
#undef DNS_FRAG
}
constexpr int PA_RTP = 72;
template <int MODE> __device__ __forceinline__ void dns_passA_task(const P& p, LAS unsigned char* lds, int bh, int seg, int q, int wave, int lane) {
    const int r16 = lane & 15, g4 = lane >> 4, wl = wave & 3, n0 = seg * CSEG;
    const float* cdp = ws_f(p, WS_DNF_CD) + (size_t)bh * NCHUNK + n0;
    LAS bf16_t* RT = (LAS bf16_t*)lds;
    if (wave >= 4) { dns_loader<MODE>(p, lds, bh, n0, CSEG, q & 1, wl, lane); }
    else {
        f32x4 X[8];
#pragma unroll
        for (int kt = 0; kt < 8; ++kt)
#pragma unroll
            for (int i = 0; i < 4; ++i) X[kt][i] = (MODE == 0 && 16 * kt + 4 * g4 + i == 64 * q + 16 * wl + r16) ? 1.f : 0.f;
        float cd = cdp[0], cprod = 1.f;
        DNS_BAR();
        for (int n = 0; n < CSEG; ++n) {
            const float cdn = cdp[n + 1 < CSEG ? n + 1 : n];
            dn_consume_map<MODE == 1>(lds + (n & 1) * DN_SBUF + lane * 16, wl, X, cd);
            cprod *= cd; cd = cdn;
            DNS_BAR();
        }
        if (MODE == 0) {
#pragma unroll
            for (int kt = 0; kt < 8; ++kt)
#pragma unroll
                for (int i = 0; i < 4; ++i) { const int row = 16 * kt + 4 * g4 + i, col = 16 * wl + r16; const float v = X[kt][i] - ((row == 64 * q + col) ? cprod : 0.f);
                    RT[row * PA_RTP + col] = f2bf(v); }
            if (q == 0 && wave == 0 && lane == 0) p.out[O_CPROD + bh * NSEG + seg] = cprod;
        } else {
            float* bo = p.out + O_BSEG + ((size_t)(bh * NSEG + seg) * 8 + (4 * (q & 1) + wl)) * 2048 + lane * 4;
#pragma unroll
            for (int kt = 0; kt < 8; ++kt) *(f32x4*)(bo + kt * 256) = X[kt];
        }
    }
    DNS_BAR();
    if (MODE == 0) {
#pragma unroll
        for (int j = 0; j < 2; ++j) { const int f = wave * 2 + j, mt = f >> 1, kbl = f & 1, row = 16 * mt + r16;
            const u32x2 lo = *(const LAS u32x2*)(RT + row * PA_RTP + 32 * kbl + 4 * g4), hi = *(const LAS u32x2*)(RT + row * PA_RTP + 32 * kbl + 16 + 4 * g4);
            *(u32x4*)((unsigned char*)(p.out + O_RFRAG) + ((size_t)(bh * NSEG + seg) * 32 + mt * 4 + 2 * q + kbl) * 1024 + lane * 16) = (u32x4){lo.x, lo.y, hi.x, hi.y}; }
        DNS_BAR();
    }
}
__device__ __forceinline__ void phase_dns_passA(const P& p, LAS unsigned char* lds) {
    const int tid = otid(), lane = tid & 63, wave = __builtin_amdgcn_readfirstlane(tid >> 6);
    const int vb = (gridDim.x % 8 == 0) ? (int)((blockIdx.x % 8) * (gridDim.x / 8) + blockIdx.x / 8) : (int)blockIdx.x;
    for (int t = vb; t < NBH * NSEG * 4; t += gridDim.x) {
        const int q = t & 3, seg = (t >> 2) % NSEG, bh = t / (4 * NSEG);
        if (q < 2) dns_passA_task<0>(p, lds, bh, seg, q, wave, lane); else dns_passA_task<1>(p, lds, bh, seg, q, wave, lane);
    }
}
__device__ __forceinline__ void phase_dns_passB(const P& p, LAS unsigned char* lds) {
    if ((int)blockIdx.x >= NBH * 8) return;
    const int tid = otid(), lane = tid & 63, w = __builtin_amdgcn_readfirstlane(tid >> 6), r16 = lane & 15, g4 = lane >> 4;
    const int bh = blockIdx.x & 7, vs = blockIdx.x >> 3;
    LAS u32x2* XB = (LAS u32x2*)lds;
    const unsigned char* rf0 = (const unsigned char*)(p.out + O_RFRAG) + ((size_t)bh * NSEG * 32 + w * 4) * 1024 + lane * 16;
    const float* bt0 = p.out + O_BSEG + ((size_t)bh * NSEG * 8 + vs) * 2048 + w * 256 + lane * 4;
    float* ss0 = p.out + O_SSEG + ((size_t)bh * NSEG * 8 + vs) * 2048 + w * 256 + lane * 4;
    const float* cp0 = p.out + O_CPROD + bh * NSEG;
    u32x4 rf[4][4]; f32x4 bt[4]; float cp[4];
#define PB_LD(s_, r_) do { if ((s_) < NSEG) { _Pragma("unroll") for (int kb = 0; kb < 4; ++kb) rf[r_][kb] = *(const u32x4*)(rf0 + (size_t)(s_) * 32768 + kb * 1024); bt[r_] = *(const f32x4*)(bt0 + (size_t)(s_) * 16384); cp[r_] = cp0[(s_)]; } } while (0)
    PB_LD(0, 0); PB_LD(1, 1); PB_LD(2, 2);
    f32x4 S = (f32x4){0.f, 0.f, 0.f, 0.f};
#pragma unroll
    for (int s = 0; s < NSEG; ++s) {
        PB_LD(s + 3, (s + 3) & 3);
        *(f32x4*)(ss0 + (size_t)s * 16384) = S;
        XB[((s & 1) * 8 + w) * 64 + lane] = (u32x2){cvtpk_c(S[0], S[1]), cvtpk_c(S[2], S[3])};
        DNS_BAR();
        f32x4 acc = S * cp[s & 3] + bt[s & 3];
#pragma unroll
        for (int kb = 0; kb < 4; ++kb) { const u32x2 lo = XB[((s & 1) * 8 + 2 * kb) * 64 + lane], hi = XB[((s & 1) * 8 + 2 * kb + 1) * 64 + lane];
            acc = __builtin_amdgcn_mfma_f32_16x16x32_bf16(__builtin_bit_cast(bf16x8, rf[s & 3][kb]), __builtin_bit_cast(bf16x8, (u32x4){lo.x, lo.y, hi.x, hi.y}), acc, 0, 0, 0); }
        S = acc;
    }
#undef PB_LD
    float* so = p.out + O_PSSM + (size_t)bh * 128 * 128 + vs * 16 + r16;
#pragma unroll
    for (int i = 0; i < 4; ++i) so[(size_t)(16 * w + 4 * g4 + i) * 128] = S[i];
    DNS_BAR();
}
__device__ __forceinline__ void phase_dns_passC(const P& p, LAS unsigned char* lds) {
    const int tid = otid(), lane = tid & 63, wave = __builtin_amdgcn_readfirstlane(tid >> 6), r16 = lane & 15, g4 = lane >> 4, wl = wave & 3;
    const int vb = (gridDim.x % 8 == 0) ? (int)((blockIdx.x % 8) * (gridDim.x / 8) + blockIdx.x / 8) : (int)blockIdx.x;
    for (int t = vb; t < NBH * NSEG * 2; t += gridDim.x) {
        const int vh = t & 1, seg = (t >> 1) % NSEG, bh = t / (2 * NSEG), h = bh & 3, b = bh >> 2, vs = vh * 4 + wl, n0 = seg * CSEG;
        if (wave >= 4) dns_loader<2>(p, lds, bh, n0, CSEG, vh, wl, lane);
        else {
            const float* cdp = ws_f(p, WS_DNF_CD) + (size_t)bh * NCHUNK + n0;
            const float* ss = p.out + O_SSEG + ((size_t)(bh * NSEG + seg) * 8 + vs) * 2048 + lane * 4;
            f32x4 S[8];
#pragma unroll
            for (int kt = 0; kt < 8; ++kt) S[kt] = *(const f32x4*)(ss + kt * 256);
            float cd = cdp[0];
            DNS_BAR();
            for (int n = 0; n < CSEG; ++n) {
                const float cdn = cdp[n + 1 < CSEG ? n + 1 : n];
                dn_consume(lds + (n & 1) * DN_SBUF + lane * 16, wl, S, cd, p.out + O_ODN + (size_t)(b * SEQ + (n0 + n) * 64 + 4 * g4) * 512 + h * 128 + vs * 16 + r16);
                cd = cdn;
                DNS_BAR();
            }
        }
        DNS_BAR();
    }
}
#undef DNS_BAR
constexpr size_t WS_EDGE = WS_FREE;
constexpr size_t WS_HEAD = al256(WS_EDGE + (size_t)(T / 256) * 2 * 2 * DFF * 4);
constexpr size_t WS_END = al256(WS_HEAD + (size_t)(T / 256) * 2 * 2 * DFF * 4);
constexpr int EX_OFF = 131072;
namespace pg8 {
typedef unsigned u32x2v __attribute__((ext_vector_type(2)));
__device__ __forceinline__ float dpp_shr1(float old, float src) { return __builtin_bit_cast(float, __builtin_amdgcn_update_dpp(__builtin_bit_cast(int, old), __builtin_bit_cast(int, src), 0x111, 0xf, 0xf, false)); }
__device__ __forceinline__ float dpp_shr2(float old, float src) { return __builtin_bit_cast(float, __builtin_amdgcn_update_dpp(__builtin_bit_cast(int, old), __builtin_bit_cast(int, src), 0x112, 0xf, 0xf, false)); }
__device__ __forceinline__ float dpp_ror1(float src) { return __builtin_bit_cast(float, __builtin_amdgcn_update_dpp(0, __builtin_bit_cast(int, src), 0x121, 0xf, 0xf, false)); }
__device__ __forceinline__ float dpp_ror2(float src) { return __builtin_bit_cast(float, __builtin_amdgcn_update_dpp(0, __builtin_bit_cast(int, src), 0x122, 0xf, 0xf, false)); }
struct EpiFfnUp {
    static constexpr bool PERM = false, AFTER_DRAIN = false;
    bf16_t* ACT; float* edge; float* head; const float* cw; const float* cb; const float* state; float* out_pfc; float* out_sfc; PG8_LAS unsigned char* lds;
    __device__ __forceinline__ void operator()(const f32x4 (&acc)[2][2][4][2], const Unit& u, int wr, int wc, int fr, int fq) const {
        PG8_LAS float* EX = (PG8_LAS float*)(lds + EX_OFF);
        const bool smp = u.pm >= TP / BM;
        const int cl = wc * 32 + 4 * fq;
        if (fr >= 14) {
#pragma unroll
            for (int ai = 0; ai < 2; ++ai)
#pragma unroll
                for (int bj = 0; bj < 2; ++bj)
#pragma unroll
                    for (int n = 0; n < 2; ++n) *(PG8_LAS f32x4*)(EX + ((2 * ai + wr) * 2 + (fr - 14)) * 256 + bj * HALF + cl + 16 * n) = acc[ai][bj][3][n];
            if (wr == 1) {
#pragma unroll
                for (int bj = 0; bj < 2; ++bj)
#pragma unroll
                    for (int n = 0; n < 2; ++n) { const int oc = bj * DFF + u.pn * HALF + cl + 16 * n;
                        *(f32x4*)(edge + ((size_t)u.pm * 2 + (fr - 14)) * 2 * DFF + oc) = acc[1][bj][3][n];
                        if (!smp && (u.pm & (SEQ / BM - 1)) == SEQ / BM - 1) *(f32x4*)(out_pfc + ((size_t)(u.pm / (SEQ / BM)) * 2 + (fr - 14)) * 2 * DFF + oc) = acc[1][bj][3][n]; }
            }
        }
        if (fr < 2 && wr == 0) {
#pragma unroll
            for (int bj = 0; bj < 2; ++bj)
#pragma unroll
                for (int n = 0; n < 2; ++n) *(f32x4*)(head + ((size_t)u.pm * 2 + fr) * 2 * DFF + bj * DFF + u.pn * HALF + cl + 16 * n) = acc[0][bj][0][n];
        }
        asm volatile("s_waitcnt lgkmcnt(0)" ::: "memory"); __builtin_amdgcn_s_barrier(); asm volatile("" ::: "memory");
#pragma unroll
        for (int n = 0; n < 2; ++n) {
            const int f0 = u.pn * HALF + cl + 16 * n;
            f32x4 wg[3], wu[3], bg, bu;
#pragma unroll
            for (int j = 0; j < 3; ++j) { wg[j] = *(const f32x4*)(cw + (size_t)j * 2 * DFF + f0); wu[j] = *(const f32x4*)(cw + (size_t)j * 2 * DFF + DFF + f0); }
            bg = *(const f32x4*)(cb + f0); bu = *(const f32x4*)(cb + DFF + f0);
#pragma unroll
            for (int ai = 0; ai < 2; ++ai) {
                const int s = 2 * ai + wr;
                f32x4 pg = (f32x4){0.f, 0.f, 0.f, 0.f}, pu = pg;
                if (!smp && s > 0 && fr >= 14) { pg = *(const PG8_LAS f32x4*)(EX + ((s - 1) * 2 + (fr - 14)) * 256 + cl + 16 * n); pu = *(const PG8_LAS f32x4*)(EX + ((s - 1) * 2 + (fr - 14)) * 256 + HALF + cl + 16 * n); }
#pragma unroll
                for (int m = 0; m < 4; ++m) {
                    const f32x4 cg = acc[ai][0][m][n], cu = acc[ai][1][m][n];
                    const int row = u.pm * BM + ai * HALF + wr * 64 + m * 16 + fr;
                    f32x4 g1, g2, u1, u2;
#pragma unroll
                    for (int e = 0; e < 4; ++e) { g1[e] = dpp_shr1(dpp_ror1(pg[e]), cg[e]); g2[e] = dpp_shr2(dpp_ror2(pg[e]), cg[e]); u1[e] = dpp_shr1(dpp_ror1(pu[e]), cu[e]); u2[e] = dpp_shr2(dpp_ror2(pu[e]), cu[e]); }
                    if (smp) {
                        const int t = fr & 7, b = (row - TP) >> 3;
                        if (t < 2) { const float* st = state + (size_t)b * 2 * 2 * DFF + f0; const f32x4 s1g = *(const f32x4*)(st + 2 * DFF), s1u = *(const f32x4*)(st + 2 * DFF + DFF);
                            if (t == 0) { g1 = s1g; u1 = s1u; g2 = *(const f32x4*)st; u2 = *(const f32x4*)(st + DFF); } else { g2 = s1g; u2 = s1u; } }
                        if (t >= 6) { float* o = out_sfc + ((size_t)b * 2 + (t - 6)) * 2 * DFF + f0; *(f32x4*)o = cg; *(f32x4*)(o + DFF) = cu; }
                    }
                    const f32x4 gc = wg[0] * g2 + wg[1] * g1 + wg[2] * cg + bg, uc = wu[0] * u2 + wu[1] * u1 + wu[2] * cu + bu;
                    u32x2v w;
                    { const float a0 = gc[0] * uc[0] * __builtin_amdgcn_rcpf(1.0f + __expf(-gc[0])), a1 = gc[1] * uc[1] * __builtin_amdgcn_rcpf(1.0f + __expf(-gc[1])), a2 = gc[2] * uc[2] * __builtin_amdgcn_rcpf(1.0f + __expf(-gc[2])), a3 = gc[3] * uc[3] * __builtin_amdgcn_rcpf(1.0f + __expf(-gc[3]));
                      w.x = cvt_pk_bf16(a0, a1); w.y = cvt_pk_bf16(a2, a3); }
                    *(u32x2v*)(ACT + (size_t)row * DFF + f0) = w;
                    pg = cg; pu = cu;
                }
            }
        }
    }
};
}
__device__ __forceinline__ void phase_ffn_fix(const P& p) {
    constexpr int TPS = SEQ / 256;
    const long n = (long)(BATCH * TPS) * DFF;
    const float* edge = ws_f(p, WS_EDGE); const float* head = ws_f(p, WS_HEAD);
    for (long i = blockIdx.x * (long)NTHR + otid(); i < n; i += (long)gridDim.x * NTHR) {
        const int pm = (int)(i / DFF), f = (int)(i % DFF);
        if (pm % TPS == 0) continue;
        float r0[2], r1[2];
#pragma unroll
        for (int gu = 0; gu < 2; ++gu) { const int c = gu * DFF + f;
            const float um2 = edge[((size_t)(pm - 1) * 2 + 0) * 2 * DFF + c], um1 = edge[((size_t)(pm - 1) * 2 + 1) * 2 * DFF + c], u0 = head[((size_t)pm * 2 + 0) * 2 * DFF + c], u1 = head[((size_t)pm * 2 + 1) * 2 * DFF + c];
            const float w0 = p.ffn_conv_w[c], w1 = p.ffn_conv_w[2 * DFF + c], w2 = p.ffn_conv_w[4 * DFF + c], bb = p.ffn_conv_b[c];
            r0[gu] = w0 * um2 + w1 * um1 + w2 * u0 + bb; r1[gu] = w0 * um1 + w1 * u0 + w2 * u1 + bb; }
        bf16_t* ACT = ws_h(p, WS_ACT) + (size_t)pm * 256 * DFF + f;
        ACT[0] = f2bf(silu_f(r0[0]) * r0[1]); ACT[DFF] = f2bf(silu_f(r1[0]) * r1[1]);
    }
}

__device__ __forceinline__ void ffn_fix_tile(const P& p, int pm) {
    constexpr int TPS = SEQ / 256;
    if (pm >= BATCH * TPS || pm % TPS == 0) return;
    const float* edge = ws_f(p, WS_EDGE); const float* head = ws_f(p, WS_HEAD);
    for (int f = otid(); f < DFF; f += NTHR) {
        float r0[2], r1[2];
#pragma unroll
        for (int gu = 0; gu < 2; ++gu) { const int c = gu * DFF + f;
            const float um2 = edge[((size_t)(pm - 1) * 2 + 0) * 2 * DFF + c], um1 = edge[((size_t)(pm - 1) * 2 + 1) * 2 * DFF + c], u0 = head[((size_t)pm * 2 + 0) * 2 * DFF + c], u1 = head[((size_t)pm * 2 + 1) * 2 * DFF + c];
            const float w0 = p.ffn_conv_w[c], w1 = p.ffn_conv_w[2 * DFF + c], w2 = p.ffn_conv_w[4 * DFF + c], bb = p.ffn_conv_b[c];
            r0[gu] = w0 * um2 + w1 * um1 + w2 * u0 + bb; r1[gu] = w0 * um1 + w1 * u0 + w2 * u1 + bb; }
        bf16_t* ACT = ws_h(p, WS_ACT) + (size_t)pm * 256 * DFF + f;
        ACT[0] = f2bf(silu_f(r0[0]) * r0[1]); ACT[DFF] = f2bf(silu_f(r1[0]) * r1[1]);
    }
}
constexpr int SW_KP = 72;
__device__ __forceinline__ void swa_bias(const LAS float* BT, int lane, float (&bv)[9][4]) {
    const int r16 = lane & 15, g4 = lane >> 4;
#pragma unroll
    for (int t = 0; t < 9; ++t)
#pragma unroll
        for (int e = 0; e < 4; ++e) { const int d = 128 + r16 - 16 * t - 4 * g4 - e; bv[t][e] = (d >= 0 && d <= 127) ? BT[d] * 1.4426950408889634f : -1e30f; }
}
__device__ __forceinline__ void swa_qtile(const LAS bf16_t* KS, const LAS bf16_t* VT, int vtp, int qt, const bf16x8 (&bq)[2], const float (&bv)[9][4], float sink2, bool first, bf16_t* optr, int nvalid_q, int lane) {
    const int r16 = lane & 15, g4 = lane >> 4, kt0 = qt;
    f32x4 s[10];
#pragma unroll
    for (int tb = 0; tb < 2; ++tb) {
        bf16x8 ka[5][2];
#pragma unroll
        for (int t = 0; t < 5; ++t)
#pragma unroll
            for (int ks = 0; ks < 2; ++ks) if (5 * tb + t < 9) ka[t][ks] = *(const LAS bf16x8*)(KS + (16 * (kt0 + 5 * tb + t) + r16) * SW_KP + 32 * ks + 8 * g4);
        __builtin_amdgcn_sched_barrier(0);
#pragma unroll
        for (int t = 0; t < 5; ++t) if (5 * tb + t < 9) { f32x4 a = (f32x4){0.f, 0.f, 0.f, 0.f};
#pragma unroll
            for (int ks = 0; ks < 2; ++ks) a = __builtin_amdgcn_mfma_f32_16x16x32_bf16(ka[t][ks], bq[ks], a, 0, 0, 0);
            s[5 * tb + t] = a; }
        __builtin_amdgcn_sched_barrier(0);
    }
    float mx = sink2;
#pragma unroll
    for (int t = 0; t < 9; ++t)
#pragma unroll
        for (int e = 0; e < 4; ++e) { float v = s[t][e] * 0.18033688011112042f + bv[t][e]; if (first && 16 * (kt0 + t) + 4 * g4 + e < 128) v = -1e30f; s[t][e] = v; mx = fmaxf(mx, v); }
    mx = fmaxf(mx, __shfl_xor(mx, 16)); mx = fmaxf(mx, __shfl_xor(mx, 32));
    float l = 0.f;
#pragma unroll
    for (int t = 0; t < 9; ++t)
#pragma unroll
        for (int e = 0; e < 4; ++e) { const float pv = __builtin_amdgcn_exp2f(s[t][e] - mx); s[t][e] = pv; l += pv; }
    s[9] = (f32x4){0.f, 0.f, 0.f, 0.f};
    l += __shfl_xor(l, 16); l += __shfl_xor(l, 32);
    l += __builtin_amdgcn_exp2f(sink2 - mx);
    const float rl = __builtin_amdgcn_rcpf(l);
    bf16x8 pb[5];
#pragma unroll
    for (int q = 0; q < 5; ++q) pb[q] = pack8(s[2 * q], s[2 * q + 1]);
#pragma unroll
    for (int dp = 0; dp < 2; ++dp) {
        u32x2 vl[2][5], vh[2][5];
#pragma unroll
        for (int d2 = 0; d2 < 2; ++d2)
#pragma unroll
            for (int q = 0; q < 5; ++q) { const LAS bf16_t* vp = VT + (16 * (2 * dp + d2) + r16) * vtp + 16 * (kt0 + 2 * q) + 4 * g4; vl[d2][q] = *(const LAS u32x2*)vp; vh[d2][q] = *(const LAS u32x2*)(vp + 16); }
        __builtin_amdgcn_sched_barrier(0);
#pragma unroll
        for (int d2 = 0; d2 < 2; ++d2) { const int dt = 2 * dp + d2; f32x4 o = (f32x4){0.f, 0.f, 0.f, 0.f};
#pragma unroll
            for (int q = 0; q < 5; ++q) o = __builtin_amdgcn_mfma_f32_16x16x32_bf16(__builtin_bit_cast(bf16x8, (u32x4){vl[d2][q].x, vl[d2][q].y, vh[d2][q].x, vh[d2][q].y}), pb[q], o, 0, 0, 0);
            if (r16 < nvalid_q) *(u32x2*)(optr + (size_t)r16 * 1024 + 16 * dt + 4 * g4) = (u32x2){cvtpk_c(o[0] * rl, o[1] * rl), cvtpk_c(o[2] * rl, o[3] * rl)}; }
        __builtin_amdgcn_sched_barrier(0);
    }
}
constexpr int SWP_VTP = 272, SWS_NK = 144, SWS_VTP = 168;
constexpr int SW_KS = 0, SW_VT = 43008, SW_BT = 86016, SW_END = SW_BT + 8 * 128 * 4;
static_assert(256 * SW_KP * 2 <= SW_VT && SW_VT + 64 * SWP_VTP * 2 <= SW_BT && SWS_NK * SW_KP * 2 <= SW_VT && SW_VT + 64 * SWS_VTP * 2 <= SW_BT, "swa LDS map");
__device__ __forceinline__ void phase_swa(const P& p, LAS unsigned char* lds, unsigned long long& pr_prev, unsigned long long& pr_acc) {
    const int tid = otid(), lane = tid & 63, wave = tid >> 6;
    LAS bf16_t* KS = (LAS bf16_t*)(lds + SW_KS); LAS bf16_t* VT = (LAS bf16_t*)(lds + SW_VT); LAS float* BT = (LAS float*)(lds + SW_BT);
    const bf16_t* PR = ws_h(p, WS_PROJ); bf16_t* MX = ws_h(p, WS_MIX);
    constexpr int NQB = SEQ / 128, NPU = BATCH * NQB * 2, NU = NPU + DEC_BATCH * 2;
    for (int i = tid; i < 8 * 128; i += NTHR) BT[i] = p.rel_bias[t5_bucket(i & 127) * 8 + (i >> 7)];
    const int vb = (gridDim.x % 8 == 0) ? (int)((blockIdx.x % 8) * (gridDim.x / 8) + blockIdx.x / 8) : (int)blockIdx.x;
    for (int u = vb; u < NU; u += gridDim.x) {
        __syncthreads(); DPS(22);
        if (u < NPU) {
            const int kvh = u & 1, qb = (u >> 1) % NQB, b = (u >> 1) / NQB, m0 = b * SEQ + qb * 128; const bool first = qb == 0;
            const bf16_t* qbase = PR + (size_t)(m0 + 64 * (wave & 1) + (lane & 15)) * PLD + PC_SQ + (kvh * 4 + (wave >> 1)) * 64 + 8 * (lane >> 4);
            bf16x8 bq[2], bqn[2];
#pragma unroll
            for (int ks = 0; ks < 2; ++ks) bq[ks] = *(const bf16x8*)(qbase + 32 * ks);
            {
                u32x4 kr[4], vr[5];
#pragma unroll
                for (int i = 0; i < 4; ++i) { const int it = tid + i * NTHR, jj = it >> 3, c = it & 7; kr[i] = (u32x4){0u, 0u, 0u, 0u};
                    if (!(first && jj < 128)) kr[i] = *(const u32x4*)(PR + (size_t)(m0 - 128 + jj) * PLD + PC_SK + kvh * 64 + 8 * c); }
#pragma unroll
                for (int i = 0; i < 5; ++i) { const int it = tid + i * NTHR, jj = it % 272, c = it / 272; vr[i] = (u32x4){0u, 0u, 0u, 0u};
                    if (it < 272 * 8 && jj < 256 && !(first && jj < 128)) vr[i] = *(const u32x4*)(PR + (size_t)(m0 - 128 + jj) * PLD + PC_SV + kvh * 64 + 8 * c); }
#pragma unroll
                for (int i = 0; i < 4; ++i) { const int it = tid + i * NTHR, jj = it >> 3, c = it & 7; *(LAS u32x4*)(KS + jj * SW_KP + 8 * c) = kr[i]; }
#pragma unroll
                for (int i = 0; i < 5; ++i) { const int it = tid + i * NTHR, jj = it % 272, c = it / 272;
                    if (it < 272 * 8) { const unsigned w[4] = {vr[i].x, vr[i].y, vr[i].z, vr[i].w};
#pragma unroll
                        for (int e = 0; e < 4; ++e) { VT[(8 * c + 2 * e) * SWP_VTP + jj] = (bf16_t)(w[e] & 0xffffu); VT[(8 * c + 2 * e + 1) * SWP_VTP + jj] = (bf16_t)(w[e] >> 16); } } }
            }
            __syncthreads(); DPS(23);
            const int hq = kvh * 4 + (wave >> 1), qh = wave & 1, r16 = lane & 15, g4 = lane >> 4;
            float bv[9][4]; swa_bias(BT + hq * 128, lane, bv);
            const float sink2 = p.swa_sinks[hq] * 1.4426950408889634f;
#pragma unroll 1
            for (int q4 = 0; q4 < 4; ++q4) { const int qt = 4 * qh + q4;
                if (q4 < 3) {
#pragma unroll
                    for (int ks = 0; ks < 2; ++ks) bqn[ks] = *(const bf16x8*)(qbase + (size_t)(16 * (q4 + 1)) * PLD + 32 * ks); }
                swa_qtile(KS, VT, SWP_VTP, qt, bq, bv, sink2, first, MX + (size_t)(m0 + 16 * qt) * 1024 + 512 + hq * 64, 16, lane);
                bq[0] = bqn[0]; bq[1] = bqn[1]; }
            DPS(24);
        } else {
            const int su = u - NPU, b = su >> 1, kvh = su & 1, m0 = TP + b * DEC_SEQ;
            bf16x8 bqs[2];
#pragma unroll
            for (int ks = 0; ks < 2; ++ks) bqs[ks] = *(const bf16x8*)(PR + (size_t)(m0 + (lane & 7)) * PLD + PC_SQ + (kvh * 4 + (wave & 3)) * 64 + 32 * ks + 8 * (lane >> 4));
            {
                f32x4 ka[3][2], va[3][2]; u32x4 kn[3], vn[3];
#pragma unroll
                for (int i = 0; i < 3; ++i) { const int it = tid + i * NTHR, jj = it >> 3, c = it & 7;
                    ka[i][0] = ka[i][1] = (f32x4){0.f, 0.f, 0.f, 0.f}; kn[i] = (u32x4){0u, 0u, 0u, 0u};
                    if (it < SWS_NK * 8) { if (jj < 128) { const float* src = p.cache_k + ((size_t)b * 128 + jj) * 128 + kvh * 64 + 8 * c; ka[i][0] = *(const f32x4*)src; ka[i][1] = *(const f32x4*)(src + 4); }
                        else if (jj < 128 + DEC_SEQ) kn[i] = *(const u32x4*)(PR + (size_t)(m0 + jj - 128) * PLD + PC_SK + kvh * 64 + 8 * c); } }
#pragma unroll
                for (int i = 0; i < 3; ++i) { const int it = tid + i * NTHR, jj = it % SWS_VTP, c = it / SWS_VTP;
                    va[i][0] = va[i][1] = (f32x4){0.f, 0.f, 0.f, 0.f}; vn[i] = (u32x4){0u, 0u, 0u, 0u};
                    if (it < SWS_VTP * 8) { if (jj < 128) { const float* src = p.cache_v + ((size_t)b * 128 + jj) * 128 + kvh * 64 + 8 * c; va[i][0] = *(const f32x4*)src; va[i][1] = *(const f32x4*)(src + 4); }
                        else if (jj < 128 + DEC_SEQ) vn[i] = *(const u32x4*)(PR + (size_t)(m0 + jj - 128) * PLD + PC_SV + kvh * 64 + 8 * c); } }
#pragma unroll
                for (int i = 0; i < 3; ++i) { const int it = tid + i * NTHR, jj = it >> 3, c = it & 7;
                    if (it < SWS_NK * 8) { u32x4 v = kn[i]; if (jj < 128) v = (u32x4){cvtpk_c(ka[i][0][0], ka[i][0][1]), cvtpk_c(ka[i][0][2], ka[i][0][3]), cvtpk_c(ka[i][1][0], ka[i][1][1]), cvtpk_c(ka[i][1][2], ka[i][1][3])};
                        *(LAS u32x4*)(KS + jj * SW_KP + 8 * c) = v; } }
#pragma unroll
                for (int i = 0; i < 3; ++i) { const int it = tid + i * NTHR, jj = it % SWS_VTP, c = it / SWS_VTP;
                    if (it < SWS_VTP * 8) { u32x4 v = vn[i]; if (jj < 128) v = (u32x4){cvtpk_c(va[i][0][0], va[i][0][1]), cvtpk_c(va[i][0][2], va[i][0][3]), cvtpk_c(va[i][1][0], va[i][1][1]), cvtpk_c(va[i][1][2], va[i][1][3])};
                        const unsigned w[4] = {v.x, v.y, v.z, v.w};
#pragma unroll
                        for (int e = 0; e < 4; ++e) { VT[(8 * c + 2 * e) * SWS_VTP + jj] = (bf16_t)(w[e] & 0xffffu); VT[(8 * c + 2 * e + 1) * SWS_VTP + jj] = (bf16_t)(w[e] >> 16); } } }
            }
            __syncthreads(); DPS(25);
            if (wave < 4) { const int hq = kvh * 4 + wave;
                float bv[9][4]; swa_bias(BT + hq * 128, lane, bv);
                swa_qtile(KS, VT, SWS_VTP, 0, bqs, bv, p.swa_sinks[hq] * 1.4426950408889634f, false, MX + (size_t)m0 * 1024 + 512 + hq * 64, 8, lane); }
        }
    }
    __syncthreads();
}
static void fill_params(P& p, void* const* d_in, void* d_out, void* d_ws) {
    const float** pp = (const float**)&p;
    for (int i = 0; i < 26; ++i) pp[i] = (const float*)d_in[i];
    p.out = (float*)d_out; p.ws = (unsigned char*)d_ws;
}
namespace cg = cooperative_groups;
constexpr int CW_BAR = 1024;
constexpr size_t CTL_ZERO_BYTES = 65536;

#ifndef PROBE_MASK
#define PROBE_MASK 0
#endif
#ifndef PROBE_K
#define PROBE_K 4
#endif
#ifndef PROBE_XSYNC
#define PROBE_XSYNC 0
#endif
#if PROBE_MASK
#define PROBE_SUB(k) do { xcd_barrier(bar); PROBE_STAMP(k); } while (0)
#define PROBE_DECL unsigned long long pr_prev = __builtin_amdgcn_s_memrealtime(), pr_acc = 0ull
#define PROBE_STAMP(k) do { const unsigned long long now_ = __builtin_amdgcn_s_memrealtime(); if ((PROBE_MASK >> (k)) & 1) pr_acc += now_ - pr_prev; pr_prev = now_; } while (0)
#define PROBE_END() do { xcd_barrier(bar); PROBE_STAMP(11); if (blockIdx.x == 0 && __builtin_amdgcn_mbcnt_hi(~0u, __builtin_amdgcn_mbcnt_lo(~0u, 0u)) == 0u) { const unsigned long long t0_ = __builtin_amdgcn_s_memrealtime(); while (__builtin_amdgcn_s_memrealtime() - t0_ < (unsigned long long)PROBE_K * pr_acc) __builtin_amdgcn_s_sleep(8); } } while (0)
#else
#define PROBE_DECL unsigned long long pr_prev = 0ull, pr_acc = 0ull
#define PROBE_SUB(k)
#define PROBE_STAMP(k)
#define PROBE_END() do { for (int i_ = 0; i_ < PROBE_XSYNC; ++i_) xcd_barrier(bar); } while (0)
#endif
__global__ void __launch_bounds__(512, 2) fwd_megakernel(P p) {
    extern __shared__ __attribute__((aligned(16))) unsigned char lds_raw[];
    LAS unsigned char* lds = (LAS unsigned char*)lds_raw;
    cg::grid_group grid = cg::this_grid();
    PROBE_DECL;
    volatile LAS unsigned* MISC = (volatile LAS unsigned*)(lds + LDS_BYTES - 64);
    if (threadIdx.x < 16) MISC[threadIdx.x] = 0u;
    __syncthreads();
    const XcdBarrier bar = xcd_barrier_post((unsigned*)(p.ws + WS_CTL) + CW_BAR, MISC);
    phase_mod(p, lds); PROBE_STAMP(31); phase_transposes(p, lds);
    if (p.ws == nullptr) grid.sync();
    xcd_barrier(bar); PROBE_STAMP(0);
    phase_norm<0>(p, lds);
    xcd_barrier(bar); PROBE_STAMP(1);
    { pg8::StaticOrder S; pg8::Gemm g{ws_h(p, WS_H), ws_h(p, WS_WT_IN), T, PLD, D}; S.init(T, PLD, gridDim.x, blockIdx.x, D); pg8::EpiStoreBf16 E{ws_h(p, WS_PROJ), PLD};
      pg8::gemm_phase<pg8::EpiStoreBf16, pg8::StaticOrder, true, true>(lds, g, S, E); }
    xcd_barrier(bar); PROBE_STAMP(2);
    phase_state_out(p);
    PROBE_STAMP(21);
    phase_dnprep(p, lds, pr_prev, pr_acc);
    PROBE_SUB(12);
    phase_dnsample(p, lds, pr_prev, pr_acc);
    PROBE_SUB(13);
    phase_swa(p, lds, pr_prev, pr_acc);
    xcd_barrier(bar); PROBE_STAMP(3);
    phase_dns_passA(p, lds);
    xcd_barrier(bar); PROBE_STAMP(14);
    phase_dns_passB(p, lds);
    xcd_barrier(bar); PROBE_STAMP(15);
    phase_dns_passC(p, lds);
    xcd_barrier(bar); PROBE_STAMP(4);
    phase_dngate(p);
    xcd_barrier(bar); PROBE_STAMP(5);
    { pg8::SplitOrder S; pg8::Gemm g{ws_h(p, WS_MIX), ws_h(p, WS_WT_OUT), T, D, 1024}; S.init(D, 1024, NS_OUT, gridDim.x, blockIdx.x); pg8::EpiGateRes<0> E{p.x_prompt, p.x_sample, ws_h(p, WS_XB), ws_f(p, WS_MOD) + 2 * D, p.out + O_Y, NS_OUT};
      pg8::gemm_phase<pg8::EpiGateRes<0>, pg8::SplitOrder, true, true>(lds, g, S, E); }
    xcd_barrier(bar); PROBE_STAMP(6);
    phase_norm<1>(p, lds);
    xcd_barrier(bar); PROBE_STAMP(7);
    { pg8::StaticOrder S; pg8::Gemm g{ws_h(p, WS_H), ws_h(p, WS_WT_UP), T, 2 * DFF, D}; S.init(T, 2 * DFF, gridDim.x, blockIdx.x, D);
      pg8::EpiFfnUp E{ws_h(p, WS_ACT), ws_f(p, WS_EDGE), ws_f(p, WS_HEAD), p.ffn_conv_w, p.ffn_conv_b, p.state_ffn, p.out + O_PFC, p.out + O_SFC, lds};
      pg8::gemm_phase<pg8::EpiFfnUp, pg8::StaticOrder, true, true>(lds, g, S, E); }
    xcd_barrier(bar); PROBE_STAMP(8);
    { pg8::SplitOrder S; pg8::Gemm g{ws_h(p, WS_ACT), ws_h(p, WS_WT_DN), T, D, DFF}; S.init(D, DFF, NS_DN, gridDim.x, blockIdx.x);
      { constexpr int NU1 = (TP / 256) * (D / 256); for (int L = blockIdx.x; L < NU1; L += gridDim.x) { const int w1 = (L % 8) * (NU1 / 8) + L / 8, pm = (w1 / (8 * (D / 256))) * 8 + (w1 % (8 * (D / 256))) % 8; ffn_fix_tile(p, pm); }
        asm volatile("s_waitcnt vmcnt(0)" ::: "memory"); __syncthreads(); }
      pg8::EpiGateRes<1> E{nullptr, nullptr, ws_h(p, WS_XB), ws_f(p, WS_MOD) + 5 * D, ws_f(p, WS_SLAB_DN), NS_DN};
      pg8::gemm_phase<pg8::EpiGateRes<1>, pg8::SplitOrder, true, true>(lds, g, S, E); }
    xcd_barrier(bar); PROBE_STAMP(10);
    phase_norm<2>(p, lds);
    PROBE_END();
}
extern "C" void kernel_launch(void* const* d_in, const int* in_sizes, int n_in, void* d_out, int out_size, void* d_ws, size_t ws_size, hipStream_t stream) {
    static int grid_blocks = 0;
    if (grid_blocks == 0) {
        if (n_in != 26 || (long)out_size != O_END || ws_size < WS_END) { fprintf(stderr, "kernel_launch: unexpected shapes n_in=%d out=%d ws=%zu (need %zu)\n", n_in, out_size, ws_size, (size_t)WS_END); grid_blocks = -1; return; }
        int dev = 0, cus = 0, per_cu = 0;
        if (hipGetDevice(&dev) != hipSuccess || hipDeviceGetAttribute(&cus, hipDeviceAttributeMultiprocessorCount, dev) != hipSuccess) { grid_blocks = -1; return; }
        if (hipFuncSetAttribute((const void*)fwd_megakernel, hipFuncAttributeMaxDynamicSharedMemorySize, LDS_BYTES) != hipSuccess) { fprintf(stderr, "kernel_launch: hipFuncSetAttribute failed\n"); grid_blocks = -1; return; }
        if (hipOccupancyMaxActiveBlocksPerMultiprocessor(&per_cu, (const void*)fwd_megakernel, NTHR, LDS_BYTES) != hipSuccess || per_cu < 1) { fprintf(stderr, "kernel_launch: occupancy query says %d\n", per_cu); grid_blocks = -1; return; }
        grid_blocks = cus;
        fprintf(stderr, "kernel_launch: grid %d (cus %d, per_cu %d)\n", grid_blocks, cus, per_cu);
    }
    if (grid_blocks < 0) return;
    P p{}; fill_params(p, d_in, d_out, d_ws);
    if (hipMemsetAsync((char*)d_ws + WS_CTL, 0, CTL_ZERO_BYTES, stream) != hipSuccess) { fprintf(stderr, "kernel_launch: memset of the control words failed\n"); return; }
    void* args[] = {&p};
    const hipError_t e = hipLaunchCooperativeKernel((const void*)fwd_megakernel, dim3(grid_blocks), dim3(NTHR), args, LDS_BYTES, stream);
    if (e != hipSuccess) fprintf(stderr, "cooperative launch failed: %s (grid %d)\n", hipGetErrorString(e), grid_blocks);
}
```

```cpp
#include <hip/hip_runtime.h>
#include <hip/hip_cooperative_groups.h>
#include <cstdio>
#include <cstdint>
#define HD __device__ __forceinline__
#if defined(PROBE_MASK) && PROBE_MASK
#define DPS(k) do { const unsigned long long now_ = __builtin_amdgcn_s_memrealtime(); if ((PROBE_MASK >> (k)) & 1) pr_acc += now_ - pr_prev; pr_prev = now_; } while (0)
#endif
#ifndef CFG_D_MODEL
#define CFG_D_MODEL 1024
#endif
#ifndef CFG_SEQ
#define CFG_SEQ 8192
#endif
#ifndef CFG_DEC_BATCH
#define CFG_DEC_BATCH 128
#endif
#ifndef CFG_D_FF
#define CFG_D_FF 2816
#endif

constexpr int D = CFG_D_MODEL, BATCH = 2, SEQ = CFG_SEQ, DEC_BATCH = CFG_DEC_BATCH, DEC_SEQ = 8, DFF = CFG_D_FF;
constexpr int TP = BATCH * SEQ, TS = DEC_BATCH * DEC_SEQ, T = TP + TS, NCB = BATCH + DEC_BATCH;
constexpr int IN_COLS = 2824, PLD = 2816;
constexpr int PC_QKV = 0, PC_Z = 1536, PC_SQ = 2048, PC_SK = 2560, PC_SV = 2688;
constexpr int WC_BA = 2048;
constexpr float EPS = 1e-6f;

constexpr long O_Y = 0;
constexpr long O_PDC = (long)T * D;
constexpr long O_SDC = O_PDC + (long)BATCH * 3 * 1536;
constexpr long O_PSSM = O_SDC + (long)DEC_BATCH * 3 * 1536;
constexpr long O_SSSM = O_PSSM + (long)BATCH * 4 * 128 * 128;
constexpr long O_PK = O_SSSM + (long)DEC_BATCH * 4 * 128 * 128;
constexpr long O_SK = O_PK + (long)BATCH * 128 * 128;
constexpr long O_PV = O_SK + (long)DEC_BATCH * 128 * 128;
constexpr long O_SV = O_PV + (long)BATCH * 128 * 128;
constexpr long O_PFC = O_SV + (long)DEC_BATCH * 128 * 128;
constexpr long O_SFC = O_PFC + (long)BATCH * 2 * 2 * DFF;
constexpr long O_END = O_SFC + (long)DEC_BATCH * 2 * 2 * DFF;

constexpr size_t al256(size_t x) { return (x + 255) & ~(size_t)255; }
constexpr size_t WS_CTL = 0;
constexpr size_t WS_MOD = 1u << 20;
constexpr size_t WS_BG = al256(WS_MOD + (size_t)NCB * 6 * D * 4);
constexpr size_t WS_WBAT = al256(WS_BG + (size_t)T * 8 * 4);
constexpr size_t WS_WT_IN = al256(WS_WBAT + (size_t)8 * D * 4);
constexpr size_t WS_WT_OUT = al256(WS_WT_IN + (size_t)PLD * D * 2);
constexpr size_t WS_WT_UP = al256(WS_WT_OUT + (size_t)D * 1024 * 2);
constexpr size_t WS_WT_DN = al256(WS_WT_UP + (size_t)2 * DFF * D * 2);
constexpr size_t WS_H = al256(WS_WT_DN + (size_t)D * DFF * 2);
constexpr int NCHUNK = SEQ / 64, NUNIT = BATCH * 4 * NCHUNK;
constexpr int DNF_AB_UNIT = 57344, DNF_WV_UNIT = 32768;
constexpr size_t WS_DNF_WV = WS_H;
constexpr size_t WS_DNF_AB = al256(WS_H + (size_t)T * (D > 1024 ? D : 1024) * 2);
constexpr size_t WS_DNF_CD = al256(WS_DNF_AB + (size_t)NUNIT * DNF_AB_UNIT);
constexpr size_t WS_QKVC = WS_DNF_AB;
constexpr size_t WS_PROJ = al256((WS_DNF_CD + (size_t)NUNIT * 4) > (WS_QKVC + (size_t)T * 1536 * 2) ? (WS_DNF_CD + (size_t)NUNIT * 4) : (WS_QKVC + (size_t)T * 1536 * 2));
constexpr size_t WS_MIX = al256(WS_PROJ + (size_t)T * PLD * 2);
constexpr size_t WS_FREE = al256(WS_MIX + (size_t)T * 1024 * 2);
constexpr size_t WS_ODN = WS_H, WS_ACT = WS_PROJ;
static_assert((size_t)NUNIT * DNF_WV_UNIT <= (size_t)T * 1024 * 2, "Wv tiles overlay H");

typedef unsigned short bf16_t;
HD unsigned f2bf_bits(float f) { unsigned u = __builtin_bit_cast(unsigned, f); return (u + 0x7fffu + ((u >> 16) & 1u)) >> 16; }
HD bf16_t f2bf(float f) { return (bf16_t)f2bf_bits(f); }
HD float bf2f(bf16_t b) { return __builtin_bit_cast(float, (unsigned)b << 16); }
HD float silu_f(float x) { return x / (1.0f + expf(-x)); }
HD float sigmoid_f(float x) { return 1.0f / (1.0f + expf(-x)); }
HD float softplus_f(float x) { return x > 20.f ? x : log1pf(expf(x)); }

struct P {
    const float *x_prompt, *x_sample, *state_dn_conv, *state_dn_ssm, *cache_k, *cache_v, *state_ffn, *c_prompt, *c_sample, *rel_bias,
        *final_norm_w, *w_ada, *b_ada, *norm_mix_w, *w_in, *dn_conv_w, *dn_A_log, *dn_dt_bias, *dn_norm_w, *swa_sinks, *w_out, *norm_ffn_w,
        *w_up, *ffn_conv_w, *ffn_conv_b, *w_down;
    float* out; unsigned char* ws;
};

HD const float* xrow(const P& p, int m) { return m < TP ? p.x_prompt + (size_t)m * D : p.x_sample + (size_t)(m - TP) * D; }
HD int cb_of(int m) { return m < TP ? m / SEQ : BATCH + (m - TP) / DEC_SEQ; }
HD int t_of(int m) { return m < TP ? m % SEQ : (m - TP) % DEC_SEQ; }
HD float* ws_f(const P& p, size_t off) { return (float*)(p.ws + off); }
HD bf16_t* ws_h(const P& p, size_t off) { return (bf16_t*)(p.ws + off); }

HD int t5_bucket(int d) {
    if (d < 16) return d;
    const float logv = logf((float)d / 16.0f) / 2.0794415416798357f;
    int b = 16 + (int)(logv * 16.0f);
    return b < 31 ? b : 31;
}

#define LAS __attribute__((address_space(3)))
typedef float f32x4 __attribute__((ext_vector_type(4)));
typedef unsigned u32x4 __attribute__((ext_vector_type(4)));
typedef unsigned u32x2 __attribute__((ext_vector_type(2)));
constexpr int NWAVES = 8, NTHR = 512;
constexpr int LDS_BYTES = 163840;
__device__ __forceinline__ int otid() { int t = threadIdx.x; asm volatile("" : "+v"(t)); return t; }
__device__ __forceinline__ float wave_sum(float v) {
#pragma unroll
    for (int o = 1; o < 64; o <<= 1) v += __shfl_xor(v, o);
    return v;
}
__device__ __forceinline__ unsigned pk2(float lo, float hi) { return f2bf_bits(lo) | (f2bf_bits(hi) << 16); }

__device__ __forceinline__ void transpose_item(const float* W, int ldw, int K, bf16_t* WT, int dst_n0, int src_n0, int k0, LAS float* scr, int lane) {
#pragma unroll
    for (int i = 0; i < 32; ++i) { const int kk = 2 * i + (lane >> 5); scr[kk * 33 + (lane & 31)] = W[(size_t)(k0 + kk) * ldw + src_n0 + (lane & 31)]; }
    asm volatile("s_waitcnt lgkmcnt(0)" ::: "memory");
    const int c = lane & 7;
#pragma unroll
    for (int j = 0; j < 4; ++j) { const int n = (lane >> 3) + 8 * j; const LAS float* s = scr + (8 * c) * 33 + n;
        u32x4 o; o.x = pk2(s[0 * 33], s[1 * 33]); o.y = pk2(s[2 * 33], s[3 * 33]); o.z = pk2(s[4 * 33], s[5 * 33]); o.w = pk2(s[6 * 33], s[7 * 33]);
        *(u32x4*)(WT + (size_t)(dst_n0 + n) * K + k0 + 8 * c) = o; }
    asm volatile("s_waitcnt lgkmcnt(0)" ::: "memory");
}
constexpr int TI_IN = (PLD / 32) * (D / 64), TI_OUT = (D / 32) * (1024 / 64), TI_UP = (2 * DFF / 32) * (D / 64), TI_DN = (D / 32) * (DFF / 64), TI_ALL = TI_IN + TI_OUT + TI_UP + TI_DN;
__device__ __forceinline__ void phase_transposes(const P& p, LAS unsigned char* lds) {
    const int tid_ = otid(), lane = tid_ & 63, wave = tid_ >> 6;
    LAS float* scr = (LAS float*)(lds + wave * 16384);
    if (blockIdx.x == gridDim.x - 1) { for (int i = tid_; i < 8 * D; i += NTHR) ws_f(p, WS_WBAT)[i] = p.w_in[(size_t)(i % D) * IN_COLS + WC_BA + i / D]; }
    constexpr int NCG_MOD = 6 * D / 32;
    const bool split = (int)gridDim.x >= NCG_MOD + 32;
    if (split && (int)blockIdx.x < NCG_MOD) return;
    const int gw = (split ? (int)blockIdx.x - NCG_MOD : (int)blockIdx.x) * NWAVES + wave, NGW = (split ? (int)gridDim.x - NCG_MOD : (int)gridDim.x) * NWAVES;
    for (int it = gw; it < TI_ALL; it += NGW) {
        int r = it;
        if (r < TI_IN) { const int nb = r % (PLD / 32), kb = r / (PLD / 32), n0 = nb * 32; transpose_item(p.w_in, IN_COLS, D, ws_h(p, WS_WT_IN), n0, n0 < WC_BA ? n0 : n0 + 8, kb * 64, scr, lane); continue; } r -= TI_IN;
        if (r < TI_OUT) { const int nb = r % (D / 32), kb = r / (D / 32), n0 = nb * 32; transpose_item(p.w_out, D, 1024, ws_h(p, WS_WT_OUT), n0, n0, kb * 64, scr, lane); continue; } r -= TI_OUT;
        if (r < TI_UP) { const int nb = r % (2 * DFF / 32), kb = r / (2 * DFF / 32), n0 = nb * 32;
            const int pn = n0 >> 8, bj = (n0 >> 7) & 1, c = n0 & 127; transpose_item(p.w_up, 2 * DFF, D, ws_h(p, WS_WT_UP), n0, bj * DFF + 128 * pn + c, kb * 64, scr, lane); continue; } r -= TI_UP;
        { const int nb = r % (D / 32), kb = r / (D / 32), n0 = nb * 32; transpose_item(p.w_down, D, DFF, ws_h(p, WS_WT_DN), n0, n0, kb * 64, scr, lane); }
    }
}
typedef short bf16x8m __attribute__((ext_vector_type(8)));
typedef float f32x2m __attribute__((ext_vector_type(2))); typedef __bf16 bf16x2m __attribute__((ext_vector_type(2)));
__device__ __forceinline__ unsigned cvtpk_m(float lo, float hi) { const f32x2m v = {lo, hi}; return __builtin_bit_cast(unsigned, __builtin_convertvector(v, bf16x2m)); }
__device__ __forceinline__ void split8(const float (&x)[8], bf16x8m& hi, bf16x8m& lo) {
    unsigned h[4], l[4];
#pragma unroll
    for (int e = 0; e < 4; ++e) { h[e] = cvtpk_m(x[2 * e], x[2 * e + 1]);
        l[e] = cvtpk_m(x[2 * e] - __builtin_bit_cast(float, h[e] << 16), x[2 * e + 1] - __builtin_bit_cast(float, h[e] & 0xffff0000u)); }
    hi = __builtin_bit_cast(bf16x8m, (u32x4){h[0], h[1], h[2], h[3]}); lo = __builtin_bit_cast(bf16x8m, (u32x4){l[0], l[1], l[2], l[3]});
}
__device__ __forceinline__ float silu_fast(float x) { return x * __builtin_amdgcn_rcpf(1.0f + __expf(-x)); }
__device__ __forceinline__ void phase_mod(const P& p, LAS unsigned char* lds) {
    constexpr int KC = 256, NCG = 6 * D / 32, NCH = D / KC, NMT = (NCB + 15) / 16;
    static_assert(NMT <= 16, "two m-tiles per wave at most");
    LAS float* WB = (LAS float*)lds;
    const int tid = otid(), lane = tid & 63, wave = tid >> 6, r16 = lane & 15, g4 = lane >> 4;
    for (int cg = blockIdx.x; cg < NCG; cg += gridDim.x) {
        f32x4 acc[2][2];
#pragma unroll
        for (int s = 0; s < 2; ++s)
#pragma unroll
            for (int nt = 0; nt < 2; ++nt) acc[s][nt] = (f32x4){0.f, 0.f, 0.f, 0.f};
        f32x4 wreg[4];
#pragma unroll
        for (int j = 0; j < 4; ++j) { const int idx = tid + NTHR * j; wreg[j] = *(const f32x4*)(p.w_ada + (size_t)(idx >> 3) * 6 * D + cg * 32 + 4 * (idx & 7)); }
        __syncthreads();
        for (int ch = 0; ch < NCH; ++ch) {
            LAS float* wb = WB + (ch & 1) * KC * 32;
#pragma unroll
            for (int j = 0; j < 4; ++j) { const int idx = tid + NTHR * j; *(LAS f32x4*)(wb + (idx >> 3) * 32 + 4 * (idx & 7)) = wreg[j]; }
            if (ch + 1 < NCH) {
#pragma unroll
                for (int j = 0; j < 4; ++j) { const int idx = tid + NTHR * j; wreg[j] = *(const f32x4*)(p.w_ada + (size_t)((ch + 1) * KC + (idx >> 3)) * 6 * D + cg * 32 + 4 * (idx & 7)); }
            }
            f32x4 areg[KC / 32][2];
#define MOD_LDA(mt_) do { const int row_ = 16 * (mt_) + r16; if (row_ < NCB) { const float* c_ = (row_ < BATCH ? p.c_prompt + (size_t)row_ * D : p.c_sample + (size_t)(row_ - BATCH) * D) + ch * KC + 8 * g4; \
                _Pragma("unroll") for (int ks = 0; ks < KC / 32; ++ks) { areg[ks][0] = *(const f32x4*)(c_ + 32 * ks); areg[ks][1] = *(const f32x4*)(c_ + 32 * ks + 4); } } \
                else { _Pragma("unroll") for (int ks = 0; ks < KC / 32; ++ks) { areg[ks][0] = (f32x4){0.f, 0.f, 0.f, 0.f}; areg[ks][1] = (f32x4){0.f, 0.f, 0.f, 0.f}; } } } while (0)
            MOD_LDA(wave);
            __syncthreads();
#pragma unroll
            for (int s = 0; s < 2; ++s) { const int mt = wave + 8 * s; if (mt >= NMT) continue;
                if (s == 1) MOD_LDA(mt);
#pragma unroll
                for (int ks = 0; ks < KC / 32; ++ks) {
                    bf16x8m bh[2], bl[2];
#pragma unroll
                    for (int nt = 0; nt < 2; ++nt) { float x[8];
#pragma unroll
                        for (int j = 0; j < 8; ++j) x[j] = wb[(32 * ks + 8 * g4 + j) * 32 + 16 * nt + r16];
                        split8(x, bh[nt], bl[nt]); }
                    float x[8]; const f32x4 a = areg[ks][0], d = areg[ks][1];
                    x[0] = silu_fast(a[0]); x[1] = silu_fast(a[1]); x[2] = silu_fast(a[2]); x[3] = silu_fast(a[3]); x[4] = silu_fast(d[0]); x[5] = silu_fast(d[1]); x[6] = silu_fast(d[2]); x[7] = silu_fast(d[3]);
                    bf16x8m ah, al; split8(x, ah, al);
#pragma unroll
                    for (int nt = 0; nt < 2; ++nt) {
                        acc[s][nt] = __builtin_amdgcn_mfma_f32_16x16x32_bf16(ah, bh[nt], acc[s][nt], 0, 0, 0);
                        acc[s][nt] = __builtin_amdgcn_mfma_f32_16x16x32_bf16(ah, bl[nt], acc[s][nt], 0, 0, 0);
                        acc[s][nt] = __builtin_amdgcn_mfma_f32_16x16x32_bf16(al, bh[nt], acc[s][nt], 0, 0, 0); }
                }
            }
#undef MOD_LDA
        }
#pragma unroll
        for (int s = 0; s < 2; ++s) { const int mt = wave + 8 * s; if (mt >= NMT) continue;
#pragma unroll
            for (int nt = 0; nt < 2; ++nt) { const int e = cg * 32 + 16 * nt + r16; const float bb = p.b_ada[e];
#pragma unroll
                for (int i = 0; i < 4; ++i) { const int row = 16 * mt + 4 * g4 + i; if (row < NCB) ws_f(p, WS_MOD)[(size_t)row * 6 * D + e] = acc[s][nt][i] + bb; } } }
    }
    __syncthreads();
}
constexpr int NS_OUT = 4, NS_DN = 11;
constexpr size_t SLAB_DN_BYTES = (size_t)(TS / 256) * (D / 256) * NS_DN * 65536 * 4, WS_SLAB_DN = WS_H;
constexpr size_t WS_XB = al256(WS_SLAB_DN + SLAB_DN_BYTES);
static_assert(WS_XB >= WS_DNF_AB && WS_XB + (size_t)T * D * 2 <= WS_DNF_CD && (size_t)(TS / 256) * (D / 256) * NS_OUT * 65536 <= (size_t)T * D, "residual stream / slabs fit");
template <int WHICH> __device__ __forceinline__ void norm_row_tail(const P& p, int m, int lane, const f32x4 (&v)[4], const f32x4 (&nwv)[4], const LAS float* wbt, int& cbc, f32x4 (&scv)[4], f32x4 (&shv)[4]) {
    float ss = 0.f;
#pragma unroll
    for (int j = 0; j < 4; ++j) ss += (v[j][0] * v[j][0] + v[j][1] * v[j][1]) + (v[j][2] * v[j][2] + v[j][3] * v[j][3]);
    const float rstd = 1.0f / sqrtf(wave_sum(ss) * (1.0f / D) + EPS);
    if (WHICH == 2) {
#pragma unroll
        for (int j = 0; j < 4; ++j) ((f32x4*)(p.out + O_Y + (size_t)m * D))[lane + 64 * j] = v[j] * rstd * nwv[j];
        return;
    }
    const int cb = cb_of(m);
    if (cb != cbc) {
        const float* mod = ws_f(p, WS_MOD) + (size_t)cb * 6 * D;
        const float* sh = mod + (WHICH == 0 ? 0 : 3 * D); const float* sc = mod + (WHICH == 0 ? D : 4 * D);
#pragma unroll
        for (int j = 0; j < 4; ++j) { scv[j] = ((const f32x4*)sc)[lane + 64 * j] + 1.0f; shv[j] = ((const f32x4*)sh)[lane + 64 * j]; }
        cbc = cb;
    }
    float ba[8];
#pragma unroll
    for (int j = 0; j < 8; ++j) ba[j] = 0.f;
    unsigned long long* o8 = (unsigned long long*)(ws_h(p, WS_H) + (size_t)m * D);
#pragma unroll
    for (int j = 0; j < 4; ++j) {
        const f32x4 h = v[j] * rstd * nwv[j] * scv[j] + shv[j];
        o8[lane + 64 * j] = (unsigned long long)cvtpk_m(h[0], h[1]) | ((unsigned long long)cvtpk_m(h[2], h[3]) << 32);
        if (WHICH == 0) {
#pragma unroll
            for (int c = 0; c < 8; ++c) { const f32x4 w = *(const LAS f32x4*)(wbt + c * D + 4 * (lane + 64 * j)); ba[c] += (h[0] * w[0] + h[1] * w[1]) + (h[2] * w[2] + h[3] * w[3]); }
            asm volatile("" ::: "memory");
        }
    }
    if (WHICH == 0) {
        float t4[4], t2[2], t1;
        const bool h5 = lane & 32, h4 = lane & 16, h3 = lane & 8;
#pragma unroll
        for (int c = 0; c < 4; ++c) { const float snd = h5 ? ba[c] : ba[c + 4], kp = h5 ? ba[c + 4] : ba[c]; t4[c] = kp + __shfl_xor(snd, 32); }
#pragma unroll
        for (int c = 0; c < 2; ++c) { const float snd = h4 ? t4[c] : t4[c + 2], kp = h4 ? t4[c + 2] : t4[c]; t2[c] = kp + __shfl_xor(snd, 16); }
        { const float snd = h3 ? t2[0] : t2[1], kp = h3 ? t2[1] : t2[0]; t1 = kp + __shfl_xor(snd, 8); }
        t1 += __shfl_xor(t1, 4); t1 += __shfl_xor(t1, 2); t1 += __shfl_xor(t1, 1);
        if ((lane & 7) == 0) { const int c = lane >> 3, j = c & 3; float* bg = ws_f(p, WS_BG) + (size_t)m * 8;
            bg[c] = c < 4 ? sigmoid_f(t1) : -expf(p.dn_A_log[j]) * softplus_f(t1 + p.dn_dt_bias[j]); }
    }
}
template <int WHICH> __device__ __forceinline__ void phase_norm(const P& p, LAS unsigned char* lds) {
    static_assert(D == 1024, "one wave per 1024-element row");
    const int tid_ = otid(), lane = tid_ & 63, wave = tid_ >> 6;
    const int gw = blockIdx.x * NWAVES + wave, NGW = gridDim.x * NWAVES;
    const float* nwp = WHICH == 0 ? p.norm_mix_w : (WHICH == 1 ? p.norm_ffn_w : p.final_norm_w);
    f32x4 nwv[4];
#pragma unroll
    for (int j = 0; j < 4; ++j) nwv[j] = ((const f32x4*)nwp)[lane + 64 * j];
    const LAS float* wbt = (const LAS float*)lds;
    if (WHICH == 0) { for (int i = tid_; i < 8 * D / 4; i += NTHR) ((LAS f32x4*)lds)[i] = ((const f32x4*)ws_f(p, WS_WBAT))[i]; __syncthreads(); }
    const bf16_t* XB = ws_h(p, WS_XB);
    int cbc = -1; f32x4 scv[4], shv[4];
    constexpr int MEND = WHICH == 0 ? T : TP;
    typedef f32x4 rowbuf_t[4];
    rowbuf_t ra, rb, rc;
#define NR_LOAD(buf_, mm_) do { if ((mm_) < MEND) { if (WHICH == 0) { const float* xr_ = xrow(p, (mm_)); _Pragma("unroll") for (int j = 0; j < 4; ++j) buf_[j] = ((const f32x4*)xr_)[lane + 64 * j]; } \
        else { const u32x2* xr_ = (const u32x2*)(XB + (size_t)(mm_) * D); u32x2 w_[4]; _Pragma("unroll") for (int j = 0; j < 4; ++j) w_[j] = xr_[lane + 64 * j]; \
            buf_[0] = __builtin_bit_cast(f32x4, (u32x4){w_[0].x, w_[0].y, w_[1].x, w_[1].y}); buf_[1] = __builtin_bit_cast(f32x4, (u32x4){w_[2].x, w_[2].y, w_[3].x, w_[3].y}); } } } while (0)
#define NR_PROC(buf_, mm_) do { if ((mm_) < MEND) { f32x4 v_[4]; if (WHICH == 0) { _Pragma("unroll") for (int j = 0; j < 4; ++j) v_[j] = buf_[j]; } \
        else { const u32x4 a_ = __builtin_bit_cast(u32x4, buf_[0]), b_ = __builtin_bit_cast(u32x4, buf_[1]); const unsigned w_[8] = {a_.x, a_.y, a_.z, a_.w, b_.x, b_.y, b_.z, b_.w}; \
            _Pragma("unroll") for (int j = 0; j < 4; ++j) v_[j] = (f32x4){__builtin_bit_cast(float, w_[2 * j] << 16), __builtin_bit_cast(float, w_[2 * j] & 0xffff0000u), __builtin_bit_cast(float, w_[2 * j + 1] << 16), __builtin_bit_cast(float, w_[2 * j + 1] & 0xffff0000u)}; } \
        norm_row_tail<WHICH>(p, (mm_), lane, v_, nwv, wbt, cbc, scv, shv); } } while (0)
    NR_LOAD(ra, gw); NR_LOAD(rb, gw + NGW);
    for (int m = gw; m < MEND; m += 3 * NGW) {
        NR_LOAD(rc, m + 2 * NGW); NR_PROC(ra, m);
        NR_LOAD(ra, m + 3 * NGW); NR_PROC(rb, m + NGW);
        NR_LOAD(rb, m + 4 * NGW); NR_PROC(rc, m + 2 * NGW);
    }
#undef NR_LOAD
#undef NR_PROC
    if (WHICH != 0) {
        constexpr int NS = WHICH == 1 ? NS_OUT : NS_DN;
        const float* slabs = WHICH == 1 ? p.out + O_Y : ws_f(p, WS_SLAB_DN);
        for (int rs = gw; rs < TS; rs += NGW) { const int m = TP + rs, cbs = BATCH + (rs >> 3);
            const float* gt = ws_f(p, WS_MOD) + (size_t)cbs * 6 * D + (WHICH == 1 ? 2 * D : 5 * D);
            f32x4 vs[4];
#pragma unroll
            for (int j = 0; j < 4; ++j) { const float* sl = slabs + ((size_t)((rs >> 8) * 4 + j) * NS) * 65536 + (size_t)(rs & 255) * 256 + 4 * lane;
                f32x4 acc = (f32x4){0.f, 0.f, 0.f, 0.f};
#pragma unroll
                for (int ks = 0; ks < NS; ++ks) { acc += *(const f32x4*)sl; sl += 65536; asm volatile("" : "+v"(sl)); }
                f32x4 base;
                if (WHICH == 1) base = ((const f32x4*)(p.x_sample + (size_t)rs * D))[lane + 64 * j];
                else { const u32x2 w = ((const u32x2*)(XB + (size_t)m * D))[lane + 64 * j]; base = (f32x4){__builtin_bit_cast(float, w.x << 16), __builtin_bit_cast(float, w.x & 0xffff0000u), __builtin_bit_cast(float, w.y << 16), __builtin_bit_cast(float, w.y & 0xffff0000u)}; }
                vs[j] = base + ((const f32x4*)gt)[lane + 64 * j] * acc;
                if (WHICH == 1) ((u32x2*)(ws_h(p, WS_XB) + (size_t)m * D))[lane + 64 * j] = (u32x2){cvtpk_m(vs[j][0], vs[j][1]), cvtpk_m(vs[j][2], vs[j][3])};
                asm volatile("" ::: "memory"); }
            norm_row_tail<WHICH>(p, m, lane, vs, nwv, wbt, cbc, scv, shv);
        }
    }
}

constexpr long SO_1 = (long)BATCH * 3 * 1536 / 4, SO_2 = (long)DEC_BATCH * 3 * 1536 / 4, SO_3 = (long)BATCH * 128 * 128 / 4, SO_4 = (long)DEC_BATCH * 128 * 128 / 4, SO_N = SO_1 + SO_2 + 2 * (SO_3 + SO_4);
__device__ __forceinline__ void so_item(const P& p, long it, f32x4& val, float*& dst) {
    const bf16_t* PR = ws_h(p, WS_PROJ); const bf16_t* src = nullptr; const float* fsrc = nullptr;
    long r = it;
    if (r < SO_1) { const int b = (int)(r / (3 * 384)), j = (int)(r / 384 % 3), c = (int)(r % 384) * 4; src = PR + (size_t)(b * SEQ + SEQ - 3 + j) * PLD + PC_QKV + c; dst = p.out + O_PDC + r * 4; }
    else if ((r -= SO_1) < SO_2) { const int b = (int)(r / (3 * 384)), j = (int)(r / 384 % 3), c = (int)(r % 384) * 4; src = PR + (size_t)(TP + b * DEC_SEQ + DEC_SEQ - 3 + j) * PLD + PC_QKV + c; dst = p.out + O_SDC + r * 4; }
    else { r -= SO_2; const int kv = r >= SO_3 + SO_4; if (kv) r -= SO_3 + SO_4; const int pc = kv ? PC_SV : PC_SK; const float* cache = kv ? p.cache_v : p.cache_k;
        if (r < SO_3) { const int b = (int)(r / (128 * 32)), j = (int)(r / 32 % 128), c = (int)(r % 32) * 4; src = PR + (size_t)(b * SEQ + SEQ - 128 + j) * PLD + pc + c; dst = p.out + (kv ? O_PV : O_PK) + r * 4; }
        else { r -= SO_3; const int b = (int)(r / (128 * 32)), j = (int)(r / 32 % 128), c = (int)(r % 32) * 4; dst = p.out + (kv ? O_SV : O_SK) + r * 4;
            if (j < 128 - DEC_SEQ) fsrc = cache + ((size_t)b * 128 + j + DEC_SEQ) * 128 + c; else src = PR + (size_t)(TP + b * DEC_SEQ + (j - (128 - DEC_SEQ))) * PLD + pc + c; } }
    if (fsrc) val = *(const f32x4*)fsrc;
    else { const u32x2 w = *(const u32x2*)src; val = (f32x4){__builtin_bit_cast(float, w.x << 16), __builtin_bit_cast(float, w.x & 0xffff0000u), __builtin_bit_cast(float, w.y << 16), __builtin_bit_cast(float, w.y & 0xffff0000u)}; }
}
__device__ __forceinline__ void phase_state_out(const P& p) {
    const long gt = blockIdx.x * (long)NTHR + otid(), gs = (long)gridDim.x * NTHR;
    for (long it = gt; it < SO_N; it += 4 * gs) {
        f32x4 v[4]; float* d[4];
#pragma unroll
        for (int u = 0; u < 4; ++u) if (it + u * gs < SO_N) so_item(p, it + u * gs, v[u], d[u]);
#pragma unroll
        for (int u = 0; u < 4; ++u) if (it + u * gs < SO_N) *(f32x4*)d[u] = v[u];
    }
}
#define XB_TMO      128
#define XB_XCNT(j)  (256  + 64 * (j))
#define XB_XSUB(j)  (1280 + 64 * (j))
#define XB_XGEN(j)  (2304 + 64 * (j))
#define XB_TOP      3328
#define XB_TOPGEN   3392
#define XCD_BAR_WORDS 3456
#define XB_SPIN_CAP (1u << 18)

__device__ __forceinline__ unsigned xb_ld(unsigned* p)              { return __hip_atomic_load(p, __ATOMIC_RELAXED, __HIP_MEMORY_SCOPE_AGENT); }
__device__ __forceinline__ unsigned xb_add(unsigned* p, unsigned v) { return __hip_atomic_fetch_add(p, v, __ATOMIC_RELAXED, __HIP_MEMORY_SCOPE_AGENT); }
__device__ __forceinline__ unsigned xb_xcc_id() { return (unsigned)__builtin_amdgcn_s_getreg((3 << 11) | 20) & 0xFu; }
#define XB_SPIN(cond, bar) do { unsigned _sp = 0; while (cond) { __builtin_amdgcn_s_sleep(1); \
    if ((++_sp & 255u) == 0u) { if (xb_ld(&(bar)[XB_TMO])) break; if (_sp > XB_SPIN_CAP) { atomicAdd(&(bar)[XB_TMO], 1u); break; } } } } while (0)

struct XcdBarrier {
    unsigned* bar; unsigned x;
    volatile LAS unsigned* st;
};

__device__ __forceinline__ XcdBarrier xcd_barrier_post(unsigned* bar, volatile LAS unsigned* st) {
    XcdBarrier b; b.bar = bar; b.x = xb_xcc_id(); b.st = st;
    if (threadIdx.x == 0) (void)xb_add(&bar[XB_XCNT(b.x)], 1u);
    return b;
}
__device__ __forceinline__ void xcd_barrier_complete(unsigned* bar, unsigned x, unsigned& nloc, unsigned& nx) {
    const unsigned G = gridDim.x * gridDim.y * gridDim.z;
    unsigned sum, cnt, mine, sp = 0u;
    for (;;) {
        sum = 0u; cnt = 0u; mine = 0u;
#pragma unroll
        for (unsigned j = 0; j < 16; ++j) { const unsigned c = xb_ld(&bar[XB_XCNT(j)]); sum += c; cnt += (c > 0u) ? 1u : 0u; mine = (j == x) ? c : mine; }
        if (sum == G) break;
        __builtin_amdgcn_s_sleep(1);
        if ((++sp & 255u) == 0u) { if (xb_ld(&bar[XB_TMO])) break; if (sp > XB_SPIN_CAP) { atomicAdd(&bar[XB_TMO], 1u); break; } }
    }
    nloc = mine > 0u ? mine : 1u; nx = cnt > 0u ? cnt : 1u;
}

__device__ __forceinline__ void xcd_barrier(const XcdBarrier& b) {
    asm volatile("s_waitcnt vmcnt(0)" ::: "memory");
    __syncthreads();
    if (threadIdx.x == 0) {
        unsigned* bar = b.bar;
        __builtin_amdgcn_s_waitcnt(0);
        unsigned nloc = b.st[0], nx = b.st[1];
        if (nloc == 0u) { xcd_barrier_complete(bar, b.x, nloc, nx); b.st[0] = nloc; b.st[1] = nx; }
        const unsigned old = xb_add(&bar[XB_XSUB(b.x)], 1u);
        const unsigned gen = old / nloc;
        if (old + 1u == (gen + 1u) * nloc) {
            __builtin_amdgcn_fence(__ATOMIC_RELEASE, "agent");
            asm volatile("s_waitcnt vmcnt(0)" ::: "memory");
            const unsigned og = xb_add(&bar[XB_TOP], 1u);
            const unsigned tg = og / nx;
            if (og + 1u == (tg + 1u) * nx) xb_add(&bar[XB_TOPGEN], 1u);
            else XB_SPIN(xb_ld(&bar[XB_TOPGEN]) == tg, bar);
            __builtin_amdgcn_fence(__ATOMIC_ACQUIRE, "agent");
            xb_add(&bar[XB_XGEN(b.x)], 1u);
            asm volatile("s_waitcnt vmcnt(0)" ::: "memory");
        } else {
            XB_SPIN(xb_ld(&bar[XB_XGEN(b.x)]) == gen, bar);
            __builtin_amdgcn_fence(__ATOMIC_ACQUIRE, "agent");
            asm volatile("s_waitcnt vmcnt(0)" ::: "memory");
        }
    }
    __syncthreads();
}
namespace pg8 {
#define PG8_LAS __attribute__((address_space(3)))
typedef unsigned short bf16_t;
typedef short bf16x8 __attribute__((ext_vector_type(8)));
typedef float f32x4 __attribute__((ext_vector_type(4)));
typedef unsigned u32x4 __attribute__((ext_vector_type(4)));
constexpr int BM = 256, BK = 64, HALF = 128, HTB = HALF * BK * 2  , STAGE_BYTES = 8 * HTB, NXCD = 8, WGM = 8;

__host__ __device__ __forceinline__ int lds_byte(int r, int c) { const int st = (r >> 4) * 2 + (c >> 5), rr = r & 15, cc = c & 31, ob = rr * 64 + cc * 2; return st * 1024 + (ob ^ (((ob >> 9) & 1) << 5)); }
__host__ __device__ __forceinline__ void stage_rc(int b, int& R, int& C) { const int st = b / 1024, sb = b % 1024, swz = sb ^ (((sb >> 9) & 1) << 5); R = (st >> 1) * 16 + swz / 64; C = (st & 1) * 32 + (swz % 64) / 2; }
__host__ __device__ __forceinline__ int perm32(int rho) { const int n = rho >> 4, i = rho & 15; return 8 * (i >> 2) + 4 * n + (i & 3); }

struct Unit { int pm, pn, k0, nt, atomic; };
struct Gemm { const bf16_t* A; const bf16_t* Bt; int M, N, K; };

struct StaticOrder {
    int nM, nN, nwg, G, c, ntk;
    __host__ __device__ void init(int M, int N, int G_, int c_, int K_) { nM = M / BM; nN = N / BM; nwg = nM * nN; G = G_; c = c_; ntk = K_ / BK; }
    __host__ __device__ bool next(int i, Unit& u) const {
        const long L = (long)i * G + c; if (L >= nwg) return false;
        int wgid = (int)L; { const int q = nwg / NXCD, r = nwg % NXCD, xcd = wgid % NXCD, off = wgid / NXCD; wgid = (xcd < r ? xcd * (q + 1) : r * (q + 1) + (xcd - r) * q) + off; }
        const int nig = WGM * nN, gid = wgid / nig, fm = gid * WGM, gsz = (nM - fm) < WGM ? (nM - fm) : WGM;
        u.pm = fm + ((wgid % nig) % gsz); u.pn = (wgid % nig) / gsz; u.k0 = 0; u.nt = ntk; u.atomic = 0; return true;
    }
    __device__ __forceinline__ void a_ready(const Unit&) const {}
    __device__ __forceinline__ void done(const Unit&) const {}
};

struct SplitOrder {
    StaticOrder so; int nu1, ns, ntk_sub, npn, nsub, G, c;
    __device__ void init(int N, int K, int NS, int G_, int c_) { so.init(TP, N, G_, c_, K); nu1 = so.nwg; ns = NS; ntk_sub = K / BK / NS; npn = N / BM; nsub = (TS / BM) * npn * NS; G = G_; c = c_; }
    __device__ bool next(int i, Unit& u) const {
        const long L = (long)i * G + c; if (L < nu1) return so.next(i, u);
        const int s = (int)(L - nu1); if (s >= nsub) return false;
        const int ks = s % ns, t = s / ns; u.pm = TP / BM + t / npn; u.pn = t % npn; u.k0 = ks * ntk_sub * BK; u.nt = ntk_sub; u.atomic = 1; return true; }
    __device__ __forceinline__ void a_ready(const Unit&) const {}
    __device__ __forceinline__ void done(const Unit&) const {}
};
__device__ __forceinline__ unsigned cvt_pk_bf16(float lo, float hi) { unsigned r; asm volatile("v_cvt_pk_bf16_f32 %0, %1, %2" : "=v"(r) : "v"(lo), "v"(hi)); return r; }
struct EpiStoreBf16 {
    static constexpr bool PERM = true, AFTER_DRAIN = false;
    bf16_t* O; int ldc;
    __device__ __forceinline__ void operator()(const f32x4 (&acc)[2][2][4][2], const Unit& u, int wr, int wc, int fr, int fq) const {
        const int row0 = u.pm * BM + wr * 64 + fr, col0 = u.pn * BM + wc * 32 + 8 * fq;
#pragma unroll
        for (int ai = 0; ai < 2; ++ai)
#pragma unroll
            for (int m = 0; m < 4; ++m) { bf16_t* rowp = O + (size_t)(row0 + ai * HALF + m * 16) * ldc + col0;
#pragma unroll
                for (int bj = 0; bj < 2; ++bj) { const f32x4 v0 = acc[ai][bj][m][0], v1 = acc[ai][bj][m][1];
                    u32x4 w; w.x = cvt_pk_bf16(v0[0], v0[1]); w.y = cvt_pk_bf16(v0[2], v0[3]); w.z = cvt_pk_bf16(v1[0], v1[1]); w.w = cvt_pk_bf16(v1[2], v1[3]);
                    *(u32x4*)(rowp + bj * HALF) = w; } }
    }
};
template <int MODE> struct EpiGateRes {
    static constexpr bool PERM = false, AFTER_DRAIN = false;
    const float* base_p; const float* base_s; bf16_t* xb; const float* gate; float* slab; int ns;
    __device__ __forceinline__ void operator()(const f32x4 (&acc)[2][2][4][2], const Unit& u, int wr, int wc, int fr, int fq) const {
        typedef unsigned u32x2e __attribute__((ext_vector_type(2)));
        const int row0 = u.pm * BM + wr * 64 + fr, col0 = u.pn * BM + wc * 32 + 4 * fq;
        const bool smp = row0 >= TP; const float* base = smp ? base_s - (size_t)TP * D : base_p;
#pragma unroll
        for (int ai = 0; ai < 2; ++ai)
#pragma unroll
            for (int m = 0; m < 4; ++m) { const int r = row0 + ai * HALF + m * 16; const int cb = smp ? BATCH + ((r - TP) >> 3) : r / SEQ;
                const float* gp = gate + (size_t)cb * 6 * D + col0; const size_t off = (size_t)r * D + col0;
#pragma unroll
                for (int bj = 0; bj < 2; ++bj)
#pragma unroll
                    for (int n = 0; n < 2; ++n) {
                        if (u.atomic) { const int sidx = ((u.pm - TP / BM) * (D / BM) + u.pn) * ns + u.k0 / (u.nt * BK);
                            *(f32x4*)(slab + (size_t)sidx * 65536 + (size_t)(r - u.pm * BM) * 256 + (col0 - u.pn * BM) + bj * HALF + n * 16) = acc[ai][bj][m][n]; }
                        else { const f32x4 gv = *(const f32x4*)(gp + bj * HALF + n * 16); f32x4 bs;
                            if (MODE == 0) bs = *(const f32x4*)(base + off + bj * HALF + n * 16);
                            else { const u32x2e w = *(const u32x2e*)(xb + off + bj * HALF + n * 16); bs = (f32x4){__builtin_bit_cast(float, w.x << 16), __builtin_bit_cast(float, w.x & 0xffff0000u), __builtin_bit_cast(float, w.y << 16), __builtin_bit_cast(float, w.y & 0xffff0000u)}; }
                            const f32x4 v = bs + gv * acc[ai][bj][m][n];
                            *(u32x2e*)(xb + off + bj * HALF + n * 16) = (u32x2e){cvt_pk_bf16(v[0], v[1]), cvt_pk_bf16(v[2], v[3])}; } } }
    }
};
template <class Epi, class Sched, bool ALIGN_EPI = false, bool SP2 = false>
__device__ __forceinline__ void gemm_phase(PG8_LAS unsigned char* lds, const Gemm g, const Sched& S, const Epi& E) {
    const int tid = otid(), wid = __builtin_amdgcn_readfirstlane(tid >> 6), lane = tid & 63, wr = wid >> 2, wc = wid & 3, fr = lane & 15, fq = lane >> 4;
    const int K = g.K;
    unsigned voffA[2], voffB[2];
#pragma unroll
    for (int i = 0; i < 2; ++i) { int R, C; stage_rc(tid * 16 + i * 8192, R, C); const int Rb = Epi::PERM ? ((R & ~31) + perm32(R & 31)) : R;
        voffA[i] = (unsigned)(R * K + C) * 2u; voffB[i] = (unsigned)(Rb * K + C) * 2u; }
    const size_t kstep = (size_t)(BK * 2);
    const size_t hstep = (size_t)HALF * K * 2;
    const size_t tstep = 2 * hstep;
    const unsigned ldsw = (unsigned)wid * 1024u;
    const int aoff = lds_byte(wr * 64 + fr, fq * 8), boff = lds_byte(wc * 32 + fr, fq * 8);
#define PG8_SA(b, h) (((b) * 2 + (h)) * HTB)
#define PG8_SB(b, h) ((4 + (b) * 2 + (h)) * HTB)
#define PG8_STAGE(bufoff, gbase, voff) do { _Pragma("unroll") for (int _i = 0; _i < 2; ++_i) \
        __builtin_amdgcn_global_load_lds((const unsigned*)((const char*)(gbase) + (voff)[_i]), (PG8_LAS unsigned*)(lds + (bufoff) + ldsw + _i * 8192), 16, 0, 0); } while (0)
#define PG8_LDA(dst, b, h) do { _Pragma("unroll") for (int m = 0; m < 4; ++m) _Pragma("unroll") for (int k = 0; k < 2; ++k) dst[m][k] = *(const PG8_LAS bf16x8*)(lds + PG8_SA(b, h) + aoff + m * 2048 + k * 1024); } while (0)
#define PG8_LDB(dst, b, h) do { _Pragma("unroll") for (int n = 0; n < 2; ++n) _Pragma("unroll") for (int k = 0; k < 2; ++k) dst[n][k] = *(const PG8_LAS bf16x8*)(lds + PG8_SB(b, h) + boff + n * 2048 + k * 1024); } while (0)
#define PG8_MMA(ai, bj, At, Bt) do { __builtin_amdgcn_s_setprio(1); _Pragma("unroll") for (int m = 0; m < 4; ++m) _Pragma("unroll") for (int n = 0; n < 2; ++n) _Pragma("unroll") for (int k = 0; k < 2; ++k) \
        acc[ai][bj][m][n] = __builtin_amdgcn_mfma_f32_16x16x32_bf16(Bt[n][k], At[m][k], acc[ai][bj][m][n], 0, 0, 0); __builtin_amdgcn_s_setprio(0); } while (0)
#define PG8_WAIT_V(n) asm volatile("s_waitcnt vmcnt(" #n ")" ::: "memory")
#define PG8_WAIT_L(n) asm volatile("s_waitcnt lgkmcnt(" #n ")" ::: "memory")
#define PG8_BAR __builtin_amdgcn_s_barrier()
#define PG8_SCHED __builtin_amdgcn_sched_barrier(0)
    Unit cur, nxt; int ui = 0;
    if (!S.next(0, cur)) return;
    f32x4 acc[2][2][4][2];
#pragma unroll
    for (int a = 0; a < 2; ++a)
#pragma unroll
        for (int b = 0; b < 2; ++b)
#pragma unroll
            for (int m = 0; m < 4; ++m)
#pragma unroll
                for (int n = 0; n < 2; ++n) acc[a][b][m][n] = (f32x4){0.f, 0.f, 0.f, 0.f};
    bf16x8 At[4][2], B0[2][2], B1[2][2];
    const char* cA = (const char*)g.A + (size_t)cur.pm * tstep + (size_t)cur.k0 * 2; const char* cB = (const char*)g.Bt + (size_t)cur.pn * tstep + (size_t)cur.k0 * 2;
    S.a_ready(cur);
    if constexpr (SP2) {
        PG8_STAGE(PG8_SB(0, 0), cB, voffB); PG8_STAGE(PG8_SB(0, 1), cB + hstep, voffB); PG8_STAGE(PG8_SA(0, 0), cA, voffA); PG8_STAGE(PG8_SA(0, 1), cA + hstep, voffA);
        if (wr == 1) PG8_BAR;
        PG8_WAIT_V(2); PG8_BAR;
        PG8_STAGE(PG8_SB(1, 0), cB + kstep, voffB); PG8_STAGE(PG8_SA(1, 0), cA + kstep, voffA); PG8_STAGE(PG8_SB(1, 1), cB + hstep + kstep, voffB);
        PG8_WAIT_V(6); PG8_BAR;
    } else {
        PG8_STAGE(PG8_SB(0, 0), cB, voffB); PG8_STAGE(PG8_SA(0, 0), cA, voffA); PG8_STAGE(PG8_SB(0, 1), cB + hstep, voffB); PG8_STAGE(PG8_SA(0, 1), cA + hstep, voffA);
        if (wr == 1) PG8_BAR;
        PG8_WAIT_V(4); PG8_BAR;
        PG8_STAGE(PG8_SB(1, 0), cB + kstep, voffB); PG8_STAGE(PG8_SA(1, 0), cA + kstep, voffA); PG8_STAGE(PG8_SB(1, 1), cB + hstep + kstep, voffB);
        PG8_WAIT_V(6); PG8_BAR;
    }
    for (;;) {
        const bool has_next = S.next(ui + 1, nxt);
        const char* nA = has_next ? (const char*)g.A + (size_t)nxt.pm * tstep + (size_t)nxt.k0 * 2 : cA; const char* nB = has_next ? (const char*)g.Bt + (size_t)nxt.pn * tstep + (size_t)nxt.k0 * 2 : cB;
        const int nt = cur.nt;
        for (int t = 0; t < nt; t += 2) {
            const bool last = (t == nt - 2);
            const char* a1 = cA + (size_t)(t + 1) * kstep;
            const char* a2 = last ? nA : cA + (size_t)(t + 2) * kstep; const char* b2 = last ? nB : cB + (size_t)(t + 2) * kstep;
            const char* a3 = a2 + kstep; const char* b3 = b2 + kstep;
            if (last && has_next) S.a_ready(nxt);
            if constexpr (SP2) {
            PG8_LDB(B0, 0, 0); PG8_LDB(B1, 0, 1); PG8_SCHED; PG8_LDA(At, 0, 0); PG8_STAGE(PG8_SA(1, 1), a1 + hstep, voffA);
            PG8_WAIT_V(8); PG8_WAIT_L(0); PG8_BAR; PG8_MMA(0, 0, At, B0); PG8_MMA(0, 1, At, B1); PG8_BAR; PG8_SCHED;
            PG8_LDA(At, 0, 1); PG8_STAGE(PG8_SB(0, 0), b2, voffB); PG8_STAGE(PG8_SB(0, 1), b2 + hstep, voffB); PG8_STAGE(PG8_SA(0, 0), a2, voffA);
            PG8_WAIT_V(8); PG8_WAIT_L(0); PG8_BAR; PG8_MMA(1, 0, At, B0); PG8_MMA(1, 1, At, B1); PG8_BAR; PG8_SCHED;
            PG8_LDB(B0, 1, 0); PG8_LDB(B1, 1, 1); PG8_SCHED; PG8_LDA(At, 1, 0); PG8_STAGE(PG8_SA(0, 1), a2 + hstep, voffA);
            PG8_WAIT_V(8); PG8_WAIT_L(0); PG8_BAR; PG8_MMA(0, 0, At, B0); PG8_MMA(0, 1, At, B1); PG8_BAR; PG8_SCHED;
            PG8_LDA(At, 1, 1); PG8_STAGE(PG8_SB(1, 0), b3, voffB); PG8_STAGE(PG8_SB(1, 1), b3 + hstep, voffB); PG8_STAGE(PG8_SA(1, 0), a3, voffA);
            PG8_WAIT_V(8); PG8_WAIT_L(0); PG8_BAR; PG8_MMA(1, 0, At, B0); PG8_MMA(1, 1, At, B1); PG8_BAR; PG8_SCHED;
            } else {
            PG8_LDB(B0, 0, 0); PG8_SCHED; PG8_LDA(At, 0, 0); PG8_STAGE(PG8_SA(1, 1), a1 + hstep, voffA);
            PG8_WAIT_L(8); PG8_BAR; PG8_WAIT_L(0); PG8_MMA(0, 0, At, B0); PG8_BAR; PG8_SCHED;
            PG8_LDB(B1, 0, 1); PG8_STAGE(PG8_SB(0, 0), b2, voffB);
            PG8_BAR; PG8_WAIT_L(0); PG8_MMA(0, 1, At, B1); PG8_BAR;
            PG8_LDA(At, 0, 1); PG8_STAGE(PG8_SA(0, 0), a2, voffA);
            PG8_BAR; PG8_WAIT_L(0); PG8_MMA(1, 0, At, B0); PG8_BAR; PG8_SCHED;
            PG8_STAGE(PG8_SB(0, 1), b2 + hstep, voffB);
            PG8_WAIT_V(6); PG8_BAR; PG8_MMA(1, 1, At, B1); PG8_BAR;
            PG8_LDB(B0, 1, 0); PG8_SCHED; PG8_LDA(At, 1, 0); PG8_STAGE(PG8_SA(0, 1), a2 + hstep, voffA);
            PG8_WAIT_L(8); PG8_BAR; PG8_WAIT_L(0); PG8_MMA(0, 0, At, B0); PG8_BAR; PG8_SCHED;
            PG8_LDB(B1, 1, 1); PG8_STAGE(PG8_SB(1, 0), b3, voffB);
            PG8_BAR; PG8_WAIT_L(0); PG8_MMA(0, 1, At, B1); PG8_BAR;
            PG8_LDA(At, 1, 1); PG8_STAGE(PG8_SA(1, 0), a3, voffA);
            PG8_BAR; PG8_WAIT_L(0); PG8_MMA(1, 0, At, B0); PG8_BAR; PG8_SCHED;
            PG8_STAGE(PG8_SB(1, 1), b3 + hstep, voffB);
            PG8_WAIT_V(6); PG8_BAR; PG8_MMA(1, 1, At, B1); PG8_BAR;
            }
        }
        if constexpr (ALIGN_EPI) { if (wr == 0) PG8_BAR; }
        if constexpr (!Epi::AFTER_DRAIN) { E(acc, cur, wr, wc, fr, fq); S.done(cur); }
        if (!has_next) break;
#pragma unroll
        for (int a = 0; a < 2; ++a)
#pragma unroll
            for (int b = 0; b < 2; ++b)
#pragma unroll
                for (int m = 0; m < 4; ++m)
#pragma unroll
                    for (int n = 0; n < 2; ++n) acc[a][b][m][n] = (f32x4){0.f, 0.f, 0.f, 0.f};
        cur = nxt; cA = nA; cB = nB; ++ui;
        if constexpr (ALIGN_EPI) { if (wr == 1) PG8_BAR; }
    }
    PG8_WAIT_V(0);
    if constexpr (!ALIGN_EPI) { if (wr == 0) PG8_BAR; }
    PG8_BAR;
    if constexpr (Epi::AFTER_DRAIN) { E.fused(acc, cur, wr, wc, fr, fq, lds, wid, lane); S.done(cur); }
#undef PG8_SA
#undef PG8_SB
#undef PG8_STAGE
#undef PG8_LDA
#undef PG8_LDB
#undef PG8_MMA
#undef PG8_WAIT_V
#undef PG8_WAIT_L
#undef PG8_BAR
#undef PG8_SCHED
}
}
typedef short bf16x8 __attribute__((ext_vector_type(8)));
constexpr int FR_NWK = 0, FR_QD = 16, FR_KTT = 32, FR_QK = 48, FR_N = 56;
__device__ __forceinline__ int kperm(int g, int j) { return j < 4 ? 4 * g + j : 16 + 4 * g + (j - 4); }

typedef float f32x2_t __attribute__((ext_vector_type(2))); typedef __bf16 bf16x2_t __attribute__((ext_vector_type(2)));
__device__ __forceinline__ unsigned cvtpk_c(float lo, float hi) { const f32x2_t v = {lo, hi}; const bf16x2_t b = __builtin_convertvector(v, bf16x2_t); return __builtin_bit_cast(unsigned, b); }
__device__ __forceinline__ bf16x8 pack8(const f32x4 a, const f32x4 b) {
    return __builtin_bit_cast(bf16x8, (u32x4){cvtpk_c(a[0], a[1]), cvtpk_c(a[2], a[3]), cvtpk_c(b[0], b[1]), cvtpk_c(b[2], b[3])});
}
constexpr int DP_KP = 136;
constexpr int DP_RP = 72;
constexpr int DP_QS = 0, DP_KS = DP_QS + 64 * DP_KP * 2, DP_RHST = DP_KS + 64 * DP_KP * 2, DP_AM = DP_RHST + 256 * DP_RP * 2, DP_AMP = 68,
              DP_QKM = DP_AM + 64 * DP_AMP * 4, DP_QKP = 72, DP_GS = DP_QKM + 64 * DP_QKP * 2, DP_DM = DP_GS + 4 * 64 * 4, DP_DMP = 20,
              DP_TB = DP_DM + 64 * DP_DMP * 4, DP_END = DP_TB + 64 * DP_RP * 2;
static_assert(DP_END <= 131072 && DP_AM % 16 == 0 && DP_DM % 16 == 0 && DP_TB % 16 == 0 && DP_RHST % 16 == 0, "dnprep LDS");
#ifndef DPS
#define DPS(k)
#endif
__device__ __forceinline__ void phase_dnprep(const P& p, LAS unsigned char* lds, unsigned long long& pr_prev, unsigned long long& pr_acc) {
    const int tid_ = otid();
    LAS bf16_t* QS = (LAS bf16_t*)(lds + DP_QS); LAS bf16_t* KS = (LAS bf16_t*)(lds + DP_KS); LAS bf16_t* RHST = (LAS bf16_t*)(lds + DP_RHST);
    LAS float* AM = (LAS float*)(lds + DP_AM); LAS bf16_t* QKM = (LAS bf16_t*)(lds + DP_QKM); LAS float* GS = (LAS float*)(lds + DP_GS);
    LAS float* DM = (LAS float*)(lds + DP_DM); LAS bf16_t* TB = (LAS bf16_t*)(lds + DP_TB);
    const bf16_t* PR = ws_h(p, WS_PROJ); const float* BG = ws_f(p, WS_BG);
    for (int i = tid_; i < 64 * DP_RP / 2; i += NTHR) ((LAS unsigned*)TB)[i] = 0u;
    float pgx = 0.f, pbx = 0.f, cw[3][4][2]; unsigned xr[3][11];
#define DP_FETCH(uid_, ln_, wv_) do { const int n_ = (uid_) % NCHUNK, bh_ = (uid_) / NCHUNK, h_ = bh_ & 3, m0_ = (bh_ >> 2) * SEQ + n_ * 64; \
        if ((wv_) == 0) { pgx = BG[(size_t)(m0_ + (ln_)) * 8 + 4 + h_]; pbx = BG[(size_t)(m0_ + (ln_)) * 8 + h_]; } \
        _Pragma("unroll") for (int part = 0; part < 3; ++part) _Pragma("unroll") for (int j = 0; j < 4; ++j) { const float* w = p.dn_conv_w + j * 1536 + part * 512 + h_ * 128 + 2 * (ln_); cw[part][j][0] = w[0]; cw[part][j][1] = w[1]; } \
        _Pragma("unroll") for (int rr = 0; rr < 11; ++rr) { const int t_ = n_ * 64 + (wv_) * 8 + rr - 3; \
            _Pragma("unroll") for (int part = 0; part < 3; ++part) { unsigned v_ = 0u; if (t_ >= 0) v_ = *(const unsigned*)(PR + (size_t)(m0_ + (wv_) * 8 + rr - 3) * PLD + part * 512 + h_ * 128 + 2 * (ln_)); xr[part][rr] = v_; } } } while (0)
    if ((int)blockIdx.x < NUNIT) { int t0 = tid_; asm volatile("" : "+v"(t0)); DP_FETCH((int)blockIdx.x, t0 & 63, t0 >> 6); }
    for (int uid = blockIdx.x; uid < NUNIT; uid += gridDim.x) {
        const int n = uid % NCHUNK;
        int tid = tid_; asm volatile("" : "+v"(tid));
        const int lane = tid & 63, wave = tid >> 6, r16 = lane & 15, g4 = lane >> 4;
        unsigned char* abu = p.ws + WS_DNF_AB + (size_t)uid * DNF_AB_UNIT;
        if (wave == 0) {
            float x = pgx;
#pragma unroll
            for (int o = 1; o < 64; o <<= 1) { const float t = __shfl_up(x, o); if (lane >= o) x += t; }
            const float gl = __shfl(x, 63);
            GS[lane] = x; GS[64 + lane] = pbx; GS[128 + lane] = __expf(x); GS[192 + lane] = __expf(gl - x);
            if (lane == 0) ws_f(p, WS_DNF_CD)[uid] = __expf(gl);
        }
        __syncthreads();
        {
            float c[8][3][2], ssum[16];
#pragma unroll
            for (int i = 0; i < 8; ++i) {
#pragma unroll
                for (int part = 0; part < 3; ++part)
#pragma unroll
                    for (int e = 0; e < 2; ++e) { float a = 0.f;
#pragma unroll
                        for (int j = 0; j < 4; ++j) a += cw[part][j][e] * (e == 0 ? __builtin_bit_cast(float, xr[part][i + j] << 16) : __builtin_bit_cast(float, xr[part][i + j] & 0xffff0000u));
                        c[i][part][e] = a * __builtin_amdgcn_rcpf(1.0f + __expf(-a)); }
                ssum[2 * i] = c[i][0][0] * c[i][0][0] + c[i][0][1] * c[i][0][1]; ssum[2 * i + 1] = c[i][1][0] * c[i][1][0] + c[i][1][1] * c[i][1][1]; }
#pragma unroll
            for (int o = 1; o < 64; o <<= 1) {
#pragma unroll
                for (int q = 0; q < 16; ++q) ssum[q] += __shfl_xor(ssum[q], o); }
#pragma unroll
            for (int i = 0; i < 8; ++i) { const int row = wave * 8 + i;
                const float rq = 0.08838834764831845f * __builtin_amdgcn_rsqf(ssum[2 * i] + EPS), rk = __builtin_amdgcn_rsqf(ssum[2 * i + 1] + EPS);
                const float beta = GS[64 + row], eg = GS[128 + row];
                const float q0 = c[i][0][0] * rq, q1 = c[i][0][1] * rq, k0 = c[i][1][0] * rk, k1 = c[i][1][1] * rk;
                *(LAS unsigned*)(QS + row * DP_KP + 2 * lane) = pk2(q0, q1);
                *(LAS unsigned*)(KS + row * DP_KP + 2 * lane) = pk2(k0, k1);
                RHST[(2 * lane) * DP_RP + row] = f2bf(beta * c[i][2][0]); RHST[(2 * lane + 1) * DP_RP + row] = f2bf(beta * c[i][2][1]);
                RHST[(128 + 2 * lane) * DP_RP + row] = f2bf(beta * eg * k0); RHST[(128 + 2 * lane + 1) * DP_RP + row] = f2bf(beta * eg * k1); }
        }
        if (uid + (int)gridDim.x < NUNIT) DP_FETCH(uid + (int)gridDim.x, lane, wave);
        __syncthreads(); DPS(16);
        {
            const int ti = wave >> 1;
            f32x4 akk[2], aqk[2];
#pragma unroll
            for (int c = 0; c < 2; ++c) { akk[c] = (f32x4){0.f, 0.f, 0.f, 0.f}; aqk[c] = (f32x4){0.f, 0.f, 0.f, 0.f}; }
#pragma unroll
            for (int kb = 0; kb < 4; ++kb) {
                const bf16x8 ak = *(const LAS bf16x8*)(KS + (16 * ti + r16) * DP_KP + 32 * kb + 8 * g4), aq = *(const LAS bf16x8*)(QS + (16 * ti + r16) * DP_KP + 32 * kb + 8 * g4);
#pragma unroll
                for (int c = 0; c < 2; ++c) { const int tj = 2 * (wave & 1) + c; const bf16x8 bk = *(const LAS bf16x8*)(KS + (16 * tj + r16) * DP_KP + 32 * kb + 8 * g4);
                    akk[c] = __builtin_amdgcn_mfma_f32_16x16x32_bf16(ak, bk, akk[c], 0, 0, 0); aqk[c] = __builtin_amdgcn_mfma_f32_16x16x32_bf16(aq, bk, aqk[c], 0, 0, 0); }
            }
#pragma unroll
            for (int c = 0; c < 2; ++c) { const int tj = 2 * (wave & 1) + c, J = 16 * tj + r16; const float gj = GS[J];
#pragma unroll
                for (int i = 0; i < 4; ++i) { const int I = 16 * ti + 4 * g4 + i; const float dec = I >= J ? __expf(GS[I] - gj) : 0.f;
                    AM[I * DP_AMP + J] = I > J ? GS[64 + I] * akk[c][i] * dec : 0.f; QKM[I * DP_QKP + J] = f2bf(aqk[c][i] * dec); } }
        }
        __syncthreads(); DPS(17);
        if (wave == 0) {
            const int bb = g4, cc = r16; float t[16];
            f32x4 tr[16][4];
#pragma unroll
            for (int i = 1; i < 16; ++i)
#pragma unroll
                for (int j4 = 0; j4 < (i + 3) / 4; ++j4) tr[i][j4] = *(const LAS f32x4*)(AM + (16 * bb + i) * DP_AMP + 16 * bb + 4 * j4);
            __builtin_amdgcn_sched_barrier(0);
#pragma unroll
            for (int i = 0; i < 16; ++i) { float acc = (i == cc) ? 1.f : 0.f;
#pragma unroll
                for (int j = 0; j < i; ++j) acc -= tr[i][j >> 2][j & 3] * t[j];
                t[i] = acc; }
#pragma unroll
            for (int i = 0; i < 16; ++i) { DM[(16 * bb + i) * DP_DMP + cc] = t[i]; TB[(16 * bb + i) * DP_RP + 16 * bb + cc] = f2bf(t[i]); }
        } else if (wave >= 4) {
            for (int f = FR_QD + (wave - 4); f < FR_N; f += 4) {
                u32x4 o;
                if (f < FR_KTT) { const int mt = (f - FR_QD) >> 2, kb = (f - FR_QD) & 3, row = 16 * mt + r16; const float sc = GS[128 + row];
                    const u32x2 lo = *(const LAS u32x2*)(QS + row * DP_KP + 32 * kb + 4 * g4), hi = *(const LAS u32x2*)(QS + row * DP_KP + 32 * kb + 16 + 4 * g4);
                    const unsigned w[4] = {lo.x, lo.y, hi.x, hi.y}; unsigned r[4];
#pragma unroll
                    for (int e = 0; e < 4; ++e) r[e] = cvtpk_c(__builtin_bit_cast(float, w[e] << 16) * sc, __builtin_bit_cast(float, w[e] & 0xffff0000u) * sc);
                    o = (u32x4){r[0], r[1], r[2], r[3]};
                } else if (f < FR_QK) { const int kt = (f - FR_KTT) >> 1, tb = (f - FR_KTT) & 1; float v[8];
#pragma unroll
                    for (int j = 0; j < 8; ++j) { const int tok = 32 * tb + kperm(g4, j); v[j] = bf2f(KS[tok * DP_KP + 16 * kt + r16]) * GS[192 + tok]; }
                    o = (u32x4){cvtpk_c(v[0], v[1]), cvtpk_c(v[2], v[3]), cvtpk_c(v[4], v[5]), cvtpk_c(v[6], v[7])};
                } else { const int mt = (f - FR_QK) >> 1, tb = (f - FR_QK) & 1, row = 16 * mt + r16;
                    const u32x2 lo = *(const LAS u32x2*)(QKM + row * DP_QKP + 32 * tb + 4 * g4), hi = *(const LAS u32x2*)(QKM + row * DP_QKP + 32 * tb + 16 + 4 * g4);
                    o = (u32x4){lo.x, lo.y, hi.x, hi.y}; }
                *(u32x4*)(abu + (size_t)f * 1024 + lane * 16) = o;
            }
        }
        __syncthreads(); DPS(18);
        if (wave < 3) {
            const int j = wave; f32x4 Tk[4];
#pragma unroll
            for (int kk = 0; kk < 4; ++kk) Tk[j][kk] = DM[(16 * j + 4 * g4 + kk) * DP_DMP + r16];
#pragma unroll
            for (int i = 1; i < 4; ++i) if (i > j) {
                f32x4 acc = (f32x4){0.f, 0.f, 0.f, 0.f};
#pragma unroll
                for (int k = 0; k < 3; ++k) if (k >= j && k < i) { const f32x4 a = *(const LAS f32x4*)(AM + (16 * i + r16) * DP_AMP + 16 * k + 4 * g4);
#pragma unroll
                    for (int kk = 0; kk < 4; ++kk) acc = __builtin_amdgcn_mfma_f32_16x16x4f32(a[kk], Tk[k][kk], acc, 0, 0, 0); }
                const f32x4 dd = *(const LAS f32x4*)(DM + (16 * i + r16) * DP_DMP + 4 * g4);
                f32x4 res = (f32x4){0.f, 0.f, 0.f, 0.f};
#pragma unroll
                for (int kk = 0; kk < 4; ++kk) res = __builtin_amdgcn_mfma_f32_16x16x4f32(dd[kk], acc[kk], res, 0, 0, 0);
                Tk[i] = -res;
#pragma unroll
                for (int e = 0; e < 4; ++e) TB[(16 * i + 4 * g4 + e) * DP_RP + 16 * j + r16] = f2bf(Tk[i][e]); }
        }
        __syncthreads(); DPS(19);
        {
            const int mt = wave & 3, half = wave >> 2;
            bf16x8 tf[2];
#pragma unroll
            for (int kb = 0; kb < 2; ++kb) tf[kb] = *(const LAS bf16x8*)(TB + (16 * mt + r16) * DP_RP + 32 * kb + 8 * g4);
            if (half == 0) {
                float* wv = (float*)(p.ws + WS_DNF_WV + (size_t)uid * DNF_WV_UNIT) + (size_t)mt * 256 + lane * 4;
#pragma unroll
                for (int vt = 0; vt < 8; ++vt) { f32x4 acc = (f32x4){0.f, 0.f, 0.f, 0.f};
#pragma unroll
                    for (int kb = 0; kb < 2; ++kb) acc = __builtin_amdgcn_mfma_f32_16x16x32_bf16(tf[kb], *(const LAS bf16x8*)(RHST + (16 * vt + r16) * DP_RP + 32 * kb + 8 * g4), acc, 0, 0, 0);
                    *(f32x4*)(wv + (size_t)vt * 1024) = acc; }
            } else {
#pragma unroll
                for (int kbp = 0; kbp < 4; ++kbp) { f32x4 xt[2];
#pragma unroll
                    for (int c2 = 0; c2 < 2; ++c2) { xt[c2] = (f32x4){0.f, 0.f, 0.f, 0.f};
#pragma unroll
                        for (int kb = 0; kb < 2; ++kb) xt[c2] = __builtin_amdgcn_mfma_f32_16x16x32_bf16(*(const LAS bf16x8*)(RHST + (128 + 16 * (2 * kbp + c2) + r16) * DP_RP + 32 * kb + 8 * g4), tf[kb], xt[c2], 0, 0, 0); }
                    *(u32x4*)(abu + (size_t)(FR_NWK + mt * 4 + kbp) * 1024 + lane * 16) = __builtin_bit_cast(u32x4, pack8(-xt[0], -xt[1])); }
            }
        }
        __syncthreads(); DPS(20);
    }
#undef DP_FETCH
}

constexpr size_t O_ODN = O_Y;
#define DN_SB() __builtin_amdgcn_sched_barrier(0)
__device__ __forceinline__ void dn_consume(const LAS unsigned char* fb, int wl, f32x4 (&S)[8], float cd, float* op) {
    f32x4 u[4], o[4];
    bf16x8 fa[16], fq[16], Sb[4], Ub[2];
#pragma unroll
    for (int mt = 0; mt < 4; ++mt) u[mt] = *(const LAS f32x4*)(fb + (FR_N + wl * 4 + mt) * 1024);
#pragma unroll
    for (int f = 0; f < 16; ++f) fa[f] = *(const LAS bf16x8*)(fb + (FR_NWK + f) * 1024);
#pragma unroll
    for (int f = 0; f < 8; ++f) fq[f] = *(const LAS bf16x8*)(fb + (FR_QD + f) * 1024);
    DN_SB();
#pragma unroll
    for (int kb = 0; kb < 4; ++kb) Sb[kb] = pack8(S[2 * kb], S[2 * kb + 1]);
#pragma unroll
    for (int mt = 0; mt < 4; ++mt)
#pragma unroll
        for (int kb = 0; kb < 4; ++kb) u[mt] = __builtin_amdgcn_mfma_f32_16x16x32_bf16(fa[mt * 4 + kb], Sb[kb], u[mt], 0, 0, 0);
    DN_SB();
#pragma unroll
    for (int f = 8; f < 16; ++f) fq[f] = *(const LAS bf16x8*)(fb + (FR_QD + f) * 1024);
#pragma unroll
    for (int f = 0; f < 8; ++f) fa[f] = *(const LAS bf16x8*)(fb + (FR_KTT + f) * 1024);
    DN_SB();
#pragma unroll
    for (int mt = 0; mt < 4; ++mt) { o[mt] = (f32x4){0.f, 0.f, 0.f, 0.f};
#pragma unroll
        for (int kb = 0; kb < 4; ++kb) o[mt] = __builtin_amdgcn_mfma_f32_16x16x32_bf16(fq[mt * 4 + kb], Sb[kb], o[mt], 0, 0, 0); }
    DN_SB();
#pragma unroll
    for (int f = 8; f < 16; ++f) fa[f] = *(const LAS bf16x8*)(fb + (FR_KTT + f) * 1024);
#pragma unroll
    for (int f = 0; f < 8; ++f) fq[f] = *(const LAS bf16x8*)(fb + (FR_QK + f) * 1024);
#pragma unroll
    for (int tb = 0; tb < 2; ++tb) Ub[tb] = pack8(u[2 * tb], u[2 * tb + 1]);
#pragma unroll
    for (int kt = 0; kt < 8; ++kt) S[kt] = S[kt] * cd;
    DN_SB();
#pragma unroll
    for (int kt = 0; kt < 8; ++kt)
#pragma unroll
        for (int tb = 0; tb < 2; ++tb) S[kt] = __builtin_amdgcn_mfma_f32_16x16x32_bf16(fa[kt * 2 + tb], Ub[tb], S[kt], 0, 0, 0);
#pragma unroll
    for (int mt = 0; mt < 4; ++mt) {
#pragma unroll
        for (int tb = 0; tb < 2; ++tb) o[mt] = __builtin_amdgcn_mfma_f32_16x16x32_bf16(fq[mt * 2 + tb], Ub[tb], o[mt], 0, 0, 0);
#pragma unroll
        for (int i = 0; i < 4; ++i) op[(size_t)(16 * mt + i) * 512] = o[mt][i]; }
}
constexpr int DN_SBUF = 73728;
__device__ __forceinline__ void phase_dnscan(const P& p, LAS unsigned char* lds) {
    if (blockIdx.x >= BATCH * 4 * 2) return;
    const int tid = otid(), lane = tid & 63, wave = __builtin_amdgcn_readfirstlane(tid >> 6), r16 = lane & 15, g4 = lane >> 4;
    const int bh = blockIdx.x >> 1, vh = blockIdx.x & 1, h = bh & 3, b = bh >> 2, wl = wave & 3, vs = vh * 4 + wl, v0 = vs * 16;
    const float* cdp = ws_f(p, WS_DNF_CD) + (size_t)bh * NCHUNK;
    float* odn = p.out + O_ODN;
#define DN_BAR() do { asm volatile("s_waitcnt lgkmcnt(0)" ::: "memory"); __builtin_amdgcn_s_barrier(); asm volatile("" ::: "memory"); } while (0)
    if (wave >= 4) {
        const unsigned char* ab = p.ws + WS_DNF_AB + (size_t)bh * NCHUNK * DNF_AB_UNIT + lane * 16;
        const unsigned char* wvb = p.ws + WS_DNF_WV + (size_t)bh * NCHUNK * DNF_WV_UNIT + (size_t)vh * 16 * 1024 + lane * 16;
        u32x4 R[3][18];
#define DN_SRC(n_, q_) ((q_) < FR_N ? ab + (size_t)(n_) * DNF_AB_UNIT + (q_) * 1024 : wvb + (size_t)(n_) * DNF_WV_UNIT + ((q_) - FR_N) * 1024)
#define DN_LD(n_, s_) do { if ((n_) < NCHUNK) { _Pragma("unroll") for (int i_ = 0; i_ < 18; ++i_) R[s_][i_] = *(const u32x4*)DN_SRC(n_, wl * 18 + i_); } } while (0)
#define DN_ST(n_, s_) do { if ((n_) < NCHUNK) { LAS unsigned char* d_ = lds + ((n_) & 1) * DN_SBUF + wl * 18 * 1024 + lane * 16; _Pragma("unroll") for (int i_ = 0; i_ < 18; ++i_) *(LAS u32x4*)(d_ + i_ * 1024) = R[s_][i_]; } } while (0)
        DN_LD(0, 0); DN_LD(1, 1); DN_LD(2, 2); DN_ST(0, 0);
        DN_BAR();
#define DN_LSTEP(n_, s_) do { const int n = (n_); if (n < NCHUNK) { DN_LD(n + 3, s_); DN_ST(n + 1, ((s_) + 1) % 3); DN_BAR(); } } while (0)
        for (int n3 = 0; n3 < NCHUNK; n3 += 3) { DN_LSTEP(n3, 0); DN_LSTEP(n3 + 1, 1); DN_LSTEP(n3 + 2, 2); }
#undef DN_LSTEP
#undef DN_LD
#undef DN_ST
#undef DN_SRC
        return;
    }
    f32x4 S[8];
#pragma unroll
    for (int t = 0; t < 8; ++t) S[t] = (f32x4){0.f, 0.f, 0.f, 0.f};
    float cd = cdp[0];
    DN_BAR();
    for (int n = 0; n < NCHUNK; ++n) {
        const float cdn = cdp[n + 1 < NCHUNK ? n + 1 : n];
        dn_consume(lds + (n & 1) * DN_SBUF + lane * 16, wl, S, cd, odn + (size_t)(b * SEQ + n * 64 + 4 * g4) * 512 + h * 128 + v0 + r16);
        cd = cdn;
        DN_BAR();
    }
#undef DN_BAR
    {
        float* so = p.out + O_PSSM + (size_t)bh * 128 * 128 + v0 + r16;
#pragma unroll
        for (int kt = 0; kt < 8; ++kt)
#pragma unroll
            for (int i = 0; i < 4; ++i) so[(size_t)(16 * kt + 4 * g4 + i) * 128] = S[kt][i];
    }
}
__device__ __forceinline__ void phase_dngate(const P& p) {
    const int tid_ = otid(), lane = tid_ & 63, wave = tid_ >> 6;
    const int gw = blockIdx.x * NWAVES + wave, NGW = gridDim.x * NWAVES;
    const f32x4 nw0 = *(const f32x4*)(p.dn_norm_w + (lane & 15) * 8), nw1 = *(const f32x4*)(p.dn_norm_w + (lane & 15) * 8 + 4);
    f32x4 a, c; u32x4 z;
#define DG_LOAD(m_) do { const float* o_ = p.out + O_ODN + (size_t)(m_) * 512 + lane * 8; a = *(const f32x4*)o_; c = *(const f32x4*)(o_ + 4); z = *(const u32x4*)(ws_h(p, WS_PROJ) + (size_t)(m_) * PLD + PC_Z + lane * 8); } while (0)
    if (gw < TP) DG_LOAD(gw);
    for (int m = gw; m < TP; m += NGW) {
        const f32x4 a0 = a, c0 = c; const u32x4 z0 = z;
        if (m + NGW < TP) DG_LOAD(m + NGW);
        float ss = (a0[0] * a0[0] + a0[1] * a0[1]) + (a0[2] * a0[2] + a0[3] * a0[3]) + (c0[0] * c0[0] + c0[1] * c0[1]) + (c0[2] * c0[2] + c0[3] * c0[3]);
#pragma unroll
        for (int off = 1; off < 16; off <<= 1) ss += __shfl_xor(ss, off);
        const float rstd = 1.0f / sqrtf(ss * (1.0f / 128.0f) + EPS);
        const unsigned zw[4] = {z0.x, z0.y, z0.z, z0.w}; const float ov[8] = {a0[0], a0[1], a0[2], a0[3], c0[0], c0[1], c0[2], c0[3]}; const float nwv[8] = {nw0[0], nw0[1], nw0[2], nw0[3], nw1[0], nw1[1], nw1[2], nw1[3]};
        unsigned r[4];
#pragma unroll
        for (int e = 0; e < 4; ++e) { const float z0f = __builtin_bit_cast(float, zw[e] << 16), z1f = __builtin_bit_cast(float, zw[e] & 0xffff0000u);
            r[e] = pk2(ov[2 * e] * rstd * nwv[2 * e] * silu_f(z0f), ov[2 * e + 1] * rstd * nwv[2 * e + 1] * silu_f(z1f)); }
        *(u32x4*)(ws_h(p, WS_MIX) + (size_t)m * 1024 + lane * 8) = (u32x4){r[0], r[1], r[2], r[3]};
    }
#undef DG_LOAD
}
__device__ __forceinline__ void phase_dnsample(const P& p, LAS unsigned char* lds, unsigned long long& pr_prev, unsigned long long& pr_acc) {
    const int tid = otid(), lane = tid & 63, us = tid >> 8, w4 = (tid >> 6) & 3, kh = lane >> 5, col_ = w4 * 32 + (lane & 31);
    LAS float* QH = (LAS float*)lds + us * 4352;
    LAS float* KH = QH + 1024; LAS float* VH = QH + 2048; LAS float* OH = QH + 3072; LAS float* RED = QH + 4096;
    const bf16_t* PR = ws_h(p, WS_PROJ); const float* BG = ws_f(p, WS_BG);
    for (int ub = blockIdx.x; ub < DEC_BATCH * 2; ub += gridDim.x) {
        const int uidx = ub * 2 + us, b = uidx >> 2, h = uidx & 3, m0 = TP + b * DEC_SEQ;
        int col = col_; asm volatile("" : "+v"(col));
        {
            float x0[11], x1[11];
            const int ch0 = kh * 512 + h * 128 + col;
#pragma unroll
            for (int rr = 0; rr < 11; ++rr) {
                if (rr < 3) { const float* st = p.state_dn_conv + ((size_t)b * 3 + rr) * 1536; x0[rr] = st[ch0]; x1[rr] = st[1024 + h * 128 + col]; }
                else { const bf16_t* pr = PR + (size_t)(m0 + rr - 3) * PLD; x0[rr] = bf2f(pr[ch0]); x1[rr] = bf2f(pr[1024 + h * 128 + col]); } }
            float w0[4], w1[4];
#pragma unroll
            for (int j = 0; j < 4; ++j) { w0[j] = p.dn_conv_w[j * 1536 + ch0]; w1[j] = p.dn_conv_w[j * 1536 + 1024 + h * 128 + col]; }
            float ssq[8], ssk[8];
#pragma unroll
            for (int t = 0; t < 8; ++t) { float a = 0.f, d = 0.f;
#pragma unroll
                for (int j = 0; j < 4; ++j) { a += w0[j] * x0[t + j]; d += w1[j] * x1[t + j]; }
                a = a * __builtin_amdgcn_rcpf(1.0f + __expf(-a)); d = d * __builtin_amdgcn_rcpf(1.0f + __expf(-d));
                if (kh == 0) { QH[t * 128 + col] = a; VH[t * 128 + col] = d; } else KH[t * 128 + col] = a;
                ssq[t] = kh == 0 ? a * a : 0.f; ssk[t] = kh == 1 ? a * a : 0.f; }
#pragma unroll
            for (int o = 1; o < 64; o <<= 1) {
#pragma unroll
                for (int t = 0; t < 8; ++t) { ssq[t] += __shfl_xor(ssq[t], o); ssk[t] += __shfl_xor(ssk[t], o); } }
            if (lane == 0) {
#pragma unroll
                for (int t = 0; t < 8; ++t) { RED[w4 * 16 + t] = ssq[t]; RED[w4 * 16 + 8 + t] = ssk[t]; } }
        }
        __syncthreads(); DPS(27);
#pragma unroll
        for (int t = 0; t < 8; ++t) {
            if (kh == 0) { const float sq = (RED[t] + RED[16 + t]) + (RED[32 + t] + RED[48 + t]); QH[t * 128 + col] *= 0.08838834764831845f / sqrtf(sq + EPS); }
            else { const float sk = (RED[8 + t] + RED[24 + t]) + (RED[40 + t] + RED[56 + t]); KH[t * 128 + col] *= 1.0f / sqrtf(sk + EPS); } }
        __syncthreads(); DPS(28);
        float S[64];
        const float* S0 = p.state_dn_ssm + ((size_t)b * 4 + h) * 128 * 128 + (size_t)kh * 64 * 128 + col;
#pragma unroll
        for (int k = 0; k < 64; ++k) { S[k] = *S0; S0 += 128; if ((k & 7) == 7) asm volatile("" : "+v"(S0)); }
#pragma unroll 1
        for (int t = 0; t < 8; ++t) {
            const float beta = BG[(size_t)(m0 + t) * 8 + h], eg = __expf(BG[(size_t)(m0 + t) * 8 + 4 + h]);
            const LAS float* kp = KH + t * 128 + kh * 64; const LAS float* qp = QH + t * 128 + kh * 64;
            f32x4 kk[16], qq[16];
#pragma unroll
            for (int k4 = 0; k4 < 16; ++k4) kk[k4] = *(const LAS f32x4*)(kp + 4 * k4);
#pragma unroll
            for (int k4 = 0; k4 < 16; ++k4) qq[k4] = *(const LAS f32x4*)(qp + 4 * k4);
            const float vt = VH[t * 128 + col];
            __builtin_amdgcn_sched_barrier(0);
            float kS = 0.f;
#pragma unroll
            for (int k4 = 0; k4 < 16; ++k4)
#pragma unroll
                for (int e = 0; e < 4; ++e) { S[4 * k4 + e] *= eg; kS += kk[k4][e] * S[4 * k4 + e]; }
            kS += __shfl_xor(kS, 32);
            const float u = beta * (vt - kS);
            float o = 0.f;
#pragma unroll
            for (int k4 = 0; k4 < 16; ++k4)
#pragma unroll
                for (int e = 0; e < 4; ++e) { S[4 * k4 + e] += kk[k4][e] * u; o += qq[k4][e] * S[4 * k4 + e]; }
            o += __shfl_xor(o, 32);
            if (kh == 0) OH[t * 128 + col] = o;
            __builtin_amdgcn_sched_barrier(0);
        }
        float* So = p.out + O_SSSM + ((size_t)b * 4 + h) * 128 * 128 + (size_t)kh * 64 * 128 + col;
#pragma unroll
        for (int k = 0; k < 64; ++k) { *So = S[k]; So += 128; if ((k & 7) == 7) asm volatile("" : "+v"(So)); }
        __syncthreads(); DPS(29);
#pragma unroll
        for (int t = 0; t < 8; ++t) { const float o = kh == 0 ? OH[t * 128 + col] : 0.f; const float s = wave_sum(o * o); if (lane == 0) RED[w4 * 16 + t] = s; }
        __syncthreads();
        if (kh == 0) {
            const float nw = p.dn_norm_w[col];
#pragma unroll
            for (int t = 0; t < 8; ++t) { const float rstd = 1.0f / sqrtf(((RED[t] + RED[16 + t]) + (RED[32 + t] + RED[48 + t])) * (1.0f / 128.0f) + EPS);
                const float z = bf2f(PR[(size_t)(m0 + t) * PLD + PC_Z + h * 128 + col]);
                ws_h(p, WS_MIX)[(size_t)(m0 + t) * 1024 + h * 128 + col] = f2bf(OH[t * 128 + col] * rstd * nw * silu_f(z)); }
        }
        __syncthreads(); DPS(30);
    }
}
constexpr int NSEG = 16, CSEG = NCHUNK / NSEG, NBH = BATCH * 4;
static_assert(NCHUNK % NSEG == 0, "segments");
constexpr size_t O_RFRAG = O_ODN + (size_t)TP * 512;
constexpr size_t O_BSEG = O_RFRAG + (size_t)NBH * NSEG * 8192;
constexpr size_t O_SSEG = O_BSEG + (size_t)NBH * NSEG * 16384;
constexpr size_t O_CPROD = O_SSEG + (size_t)NBH * NSEG * 16384;
static_assert(O_CPROD + NBH * NSEG <= (size_t)T * D, "segment scratch fits in the y region of d_out");

template <bool HASWV> __device__ __forceinline__ void dn_consume_map(const LAS unsigned char* fb, int wl, f32x4 (&X)[8], float cd) {
    f32x4 u[4]; bf16x8 f0[8], f1[8], Xb[4], Ub[2];
#pragma unroll
    for (int mt = 0; mt < 4; ++mt) u[mt] = HASWV ? *(const LAS f32x4*)(fb + (FR_N + wl * 4 + mt) * 1024) : (f32x4){0.f, 0.f, 0.f, 0.f};
#pragma unroll
    for (int f = 0; f < 8; ++f) f0[f] = *(const LAS bf16x8*)(fb + (FR_NWK + f) * 1024);
#pragma unroll
    for (int f = 0; f < 8; ++f) f1[f] = *(const LAS bf16x8*)(fb + (FR_NWK + 8 + f) * 1024);
    DN_SB();
#pragma unroll
    for (int kb = 0; kb < 4; ++kb) Xb[kb] = pack8(X[2 * kb], X[2 * kb + 1]);
#pragma unroll
    for (int mt = 0; mt < 2; ++mt)
#pragma unroll
        for (int kb = 0; kb < 4; ++kb) u[mt] = __builtin_amdgcn_mfma_f32_16x16x32_bf16(f0[mt * 4 + kb], Xb[kb], u[mt], 0, 0, 0);
    DN_SB();
#pragma unroll
    for (int f = 0; f < 8; ++f) f0[f] = *(const LAS bf16x8*)(fb + (FR_KTT + f) * 1024);
    DN_SB();
#pragma unroll
    for (int mt = 2; mt < 4; ++mt)
#pragma unroll
        for (int kb = 0; kb < 4; ++kb) u[mt] = __builtin_amdgcn_mfma_f32_16x16x32_bf16(f1[(mt - 2) * 4 + kb], Xb[kb], u[mt], 0, 0, 0);
    DN_SB();
#pragma unroll
    for (int f = 0; f < 8; ++f) f1[f] = *(const LAS bf16x8*)(fb + (FR_KTT + 8 + f) * 1024);
#pragma unroll
    for (int tb = 0; tb < 2; ++tb) Ub[tb] = pack8(u[2 * tb], u[2 * tb + 1]);
#pragma unroll
    for (int kt = 0; kt < 8; ++kt) X[kt] = X[kt] * cd;
    DN_SB();
#pragma unroll
    for (int kt = 0; kt < 4; ++kt)
#pragma unroll
        for (int tb = 0; tb < 2; ++tb) X[kt] = __builtin_amdgcn_mfma_f32_16x16x32_bf16(f0[kt * 2 + tb], Ub[tb], X[kt], 0, 0, 0);
#pragma unroll
    for (int kt = 4; kt < 8; ++kt)
#pragma unroll
        for (int tb = 0; tb < 2; ++tb) X[kt] = __builtin_amdgcn_mfma_f32_16x16x32_bf16(f1[(kt - 4) * 2 + tb], Ub[tb], X[kt], 0, 0, 0);
}
#define DNS_BAR() do { asm volatile("s_waitcnt lgkmcnt(0)" ::: "memory"); __builtin_amdgcn_s_barrier(); asm volatile("" ::: "memory"); } while (0)
template <int MODE> __device__ __forceinline__ void dns_loader(const P& p, LAS unsigned char* lds, int bh, int n0, int nsteps, int vh, int wl, int lane) {
    constexpr int NPW = MODE == 2 ? 18 : (MODE == 1 ? 12 : 8);
    const unsigned char* ab = p.ws + WS_DNF_AB + ((size_t)bh * NCHUNK + n0) * DNF_AB_UNIT + lane * 16;
    const unsigned char* wvb = p.ws + WS_DNF_WV + ((size_t)bh * NCHUNK + n0) * DNF_WV_UNIT + (size_t)vh * 16 * 1024 + lane * 16;
    u32x4 R[2][NPW];
#define DNS_FRAG(q_) (MODE == 2 ? (q_) : ((q_) < 16 ? (q_) : ((q_) < 32 ? FR_KTT + (q_) - 16 : FR_N + (q_) - 32)))
#define DNS_SRC(n_, q_) (DNS_FRAG(q_) < FR_N ? ab + (size_t)(n_) * DNF_AB_UNIT + DNS_FRAG(q_) * 1024 : wvb + (size_t)(n_) * DNF_WV_UNIT + (DNS_FRAG(q_) - FR_N) * 1024)
#define DNS_LD(n_, s_) do { if ((n_) < nsteps) { _Pragma("unroll") for (int i_ = 0; i_ < NPW; ++i_) R[s_][i_] = *(const u32x4*)DNS_SRC(n_, wl * NPW + i_); } } while (0)
#define DNS_ST(n_, s_) do { if ((n_) < nsteps) { LAS unsigned char* d_ = lds + ((n_) & 1) * DN_SBUF + lane * 16; _Pragma("unroll") for (int i_ = 0; i_ < NPW; ++i_) *(LAS u32x4*)(d_ + DNS_FRAG(wl * NPW + i_) * 1024) = R[s_][i_]; } } while (0)
    DNS_LD(0, 0); DNS_LD(1, 1); DNS_ST(0, 0);
    DNS_BAR();
#define DNS_LSTEP(n_, s_) do { const int n = (n_); if (n < nsteps) { DNS_LD(n + 2, s_); DNS_ST(n + 1, (s_) ^ 1); DNS_BAR(); } } while (0)
    for (int n2 = 0; n2 < nsteps; n2 += 2) { DNS_LSTEP(n2, 0); DNS_LSTEP(n2 + 1, 1); }
#undef DNS_LSTEP
#undef DNS_LD
#undef DNS_ST
#undef DNS_SRC
#undef DNS_FRAG
}
constexpr int PA_RTP = 72;
template <int MODE> __device__ __forceinline__ void dns_passA_task(const P& p, LAS unsigned char* lds, int bh, int seg, int q, int wave, int lane) {
    const int r16 = lane & 15, g4 = lane >> 4, wl = wave & 3, n0 = seg * CSEG;
    const float* cdp = ws_f(p, WS_DNF_CD) + (size_t)bh * NCHUNK + n0;
    LAS bf16_t* RT = (LAS bf16_t*)lds;
    if (wave >= 4) { dns_loader<MODE>(p, lds, bh, n0, CSEG, q & 1, wl, lane); }
    else {
        f32x4 X[8];
#pragma unroll
        for (int kt = 0; kt < 8; ++kt)
#pragma unroll
            for (int i = 0; i < 4; ++i) X[kt][i] = (MODE == 0 && 16 * kt + 4 * g4 + i == 64 * q + 16 * wl + r16) ? 1.f : 0.f;
        float cd = cdp[0], cprod = 1.f;
        DNS_BAR();
        for (int n = 0; n < CSEG; ++n) {
            const float cdn = cdp[n + 1 < CSEG ? n + 1 : n];
            dn_consume_map<MODE == 1>(lds + (n & 1) * DN_SBUF + lane * 16, wl, X, cd);
            cprod *= cd; cd = cdn;
            DNS_BAR();
        }
        if (MODE == 0) {
#pragma unroll
            for (int kt = 0; kt < 8; ++kt)
#pragma unroll
                for (int i = 0; i < 4; ++i) { const int row = 16 * kt + 4 * g4 + i, col = 16 * wl + r16; const float v = X[kt][i] - ((row == 64 * q + col) ? cprod : 0.f);
                    RT[row * PA_RTP + col] = f2bf(v); }
            if (q == 0 && wave == 0 && lane == 0) p.out[O_CPROD + bh * NSEG + seg] = cprod;
        } else {
            float* bo = p.out + O_BSEG + ((size_t)(bh * NSEG + seg) * 8 + (4 * (q & 1) + wl)) * 2048 + lane * 4;
#pragma unroll
            for (int kt = 0; kt < 8; ++kt) *(f32x4*)(bo + kt * 256) = X[kt];
        }
    }
    DNS_BAR();
    if (MODE == 0) {
#pragma unroll
        for (int j = 0; j < 2; ++j) { const int f = wave * 2 + j, mt = f >> 1, kbl = f & 1, row = 16 * mt + r16;
            const u32x2 lo = *(const LAS u32x2*)(RT + row * PA_RTP + 32 * kbl + 4 * g4), hi = *(const LAS u32x2*)(RT + row * PA_RTP + 32 * kbl + 16 + 4 * g4);
            *(u32x4*)((unsigned char*)(p.out + O_RFRAG) + ((size_t)(bh * NSEG + seg) * 32 + mt * 4 + 2 * q + kbl) * 1024 + lane * 16) = (u32x4){lo.x, lo.y, hi.x, hi.y}; }
        DNS_BAR();
    }
}
__device__ __forceinline__ void phase_dns_passA(const P& p, LAS unsigned char* lds) {
    const int tid = otid(), lane = tid & 63, wave = __builtin_amdgcn_readfirstlane(tid >> 6);
    const int vb = (gridDim.x % 8 == 0) ? (int)((blockIdx.x % 8) * (gridDim.x / 8) + blockIdx.x / 8) : (int)blockIdx.x;
    for (int t = vb; t < NBH * NSEG * 4; t += gridDim.x) {
        const int q = t & 3, seg = (t >> 2) % NSEG, bh = t / (4 * NSEG);
        if (q < 2) dns_passA_task<0>(p, lds, bh, seg, q, wave, lane); else dns_passA_task<1>(p, lds, bh, seg, q, wave, lane);
    }
}
__device__ __forceinline__ void phase_dns_passB(const P& p, LAS unsigned char* lds) {
    if ((int)blockIdx.x >= NBH * 8) return;
    const int tid = otid(), lane = tid & 63, w = __builtin_amdgcn_readfirstlane(tid >> 6), r16 = lane & 15, g4 = lane >> 4;
    const int bh = blockIdx.x & 7, vs = blockIdx.x >> 3;
    LAS u32x2* XB = (LAS u32x2*)lds;
    const unsigned char* rf0 = (const unsigned char*)(p.out + O_RFRAG) + ((size_t)bh * NSEG * 32 + w * 4) * 1024 + lane * 16;
    const float* bt0 = p.out + O_BSEG + ((size_t)bh * NSEG * 8 + vs) * 2048 + w * 256 + lane * 4;
    float* ss0 = p.out + O_SSEG + ((size_t)bh * NSEG * 8 + vs) * 2048 + w * 256 + lane * 4;
    const float* cp0 = p.out + O_CPROD + bh * NSEG;
    u32x4 rf[4][4]; f32x4 bt[4]; float cp[4];
#define PB_LD(s_, r_) do { if ((s_) < NSEG) { _Pragma("unroll") for (int kb = 0; kb < 4; ++kb) rf[r_][kb] = *(const u32x4*)(rf0 + (size_t)(s_) * 32768 + kb * 1024); bt[r_] = *(const f32x4*)(bt0 + (size_t)(s_) * 16384); cp[r_] = cp0[(s_)]; } } while (0)
    PB_LD(0, 0); PB_LD(1, 1); PB_LD(2, 2);
    f32x4 S = (f32x4){0.f, 0.f, 0.f, 0.f};
#pragma unroll
    for (int s = 0; s < NSEG; ++s) {
        PB_LD(s + 3, (s + 3) & 3);
        *(f32x4*)(ss0 + (size_t)s * 16384) = S;
        XB[((s & 1) * 8 + w) * 64 + lane] = (u32x2){cvtpk_c(S[0], S[1]), cvtpk_c(S[2], S[3])};
        DNS_BAR();
        f32x4 acc = S * cp[s & 3] + bt[s & 3];
#pragma unroll
        for (int kb = 0; kb < 4; ++kb) { const u32x2 lo = XB[((s & 1) * 8 + 2 * kb) * 64 + lane], hi = XB[((s & 1) * 8 + 2 * kb + 1) * 64 + lane];
            acc = __builtin_amdgcn_mfma_f32_16x16x32_bf16(__builtin_bit_cast(bf16x8, rf[s & 3][kb]), __builtin_bit_cast(bf16x8, (u32x4){lo.x, lo.y, hi.x, hi.y}), acc, 0, 0, 0); }
        S = acc;
    }
#undef PB_LD
    float* so = p.out + O_PSSM + (size_t)bh * 128 * 128 + vs * 16 + r16;
#pragma unroll
    for (int i = 0; i < 4; ++i) so[(size_t)(16 * w + 4 * g4 + i) * 128] = S[i];
    DNS_BAR();
}
__device__ __forceinline__ void phase_dns_passC(const P& p, LAS unsigned char* lds) {
    const int tid = otid(), lane = tid & 63, wave = __builtin_amdgcn_readfirstlane(tid >> 6), r16 = lane & 15, g4 = lane >> 4, wl = wave & 3;
    const int vb = (gridDim.x % 8 == 0) ? (int)((blockIdx.x % 8) * (gridDim.x / 8) + blockIdx.x / 8) : (int)blockIdx.x;
    for (int t = vb; t < NBH * NSEG * 2; t += gridDim.x) {
        const int vh = t & 1, seg = (t >> 1) % NSEG, bh = t / (2 * NSEG), h = bh & 3, b = bh >> 2, vs = vh * 4 + wl, n0 = seg * CSEG;
        if (wave >= 4) dns_loader<2>(p, lds, bh, n0, CSEG, vh, wl, lane);
        else {
            const float* cdp = ws_f(p, WS_DNF_CD) + (size_t)bh * NCHUNK + n0;
            const float* ss = p.out + O_SSEG + ((size_t)(bh * NSEG + seg) * 8 + vs) * 2048 + lane * 4;
            f32x4 S[8];
#pragma unroll
            for (int kt = 0; kt < 8; ++kt) S[kt] = *(const f32x4*)(ss + kt * 256);
            float cd = cdp[0];
            DNS_BAR();
            for (int n = 0; n < CSEG; ++n) {
                const float cdn = cdp[n + 1 < CSEG ? n + 1 : n];
                dn_consume(lds + (n & 1) * DN_SBUF + lane * 16, wl, S, cd, p.out + O_ODN + (size_t)(b * SEQ + (n0 + n) * 64 + 4 * g4) * 512 + h * 128 + vs * 16 + r16);
                cd = cdn;
                DNS_BAR();
            }
        }
        DNS_BAR();
    }
}
#undef DNS_BAR
constexpr size_t WS_EDGE = WS_FREE;
constexpr size_t WS_HEAD = al256(WS_EDGE + (size_t)(T / 256) * 2 * 2 * DFF * 4);
constexpr size_t WS_END = al256(WS_HEAD + (size_t)(T / 256) * 2 * 2 * DFF * 4);
constexpr int EX_OFF = 131072;
namespace pg8 {
typedef unsigned u32x2v __attribute__((ext_vector_type(2)));
__device__ __forceinline__ float dpp_shr1(float old, float src) { return __builtin_bit_cast(float, __builtin_amdgcn_update_dpp(__builtin_bit_cast(int, old), __builtin_bit_cast(int, src), 0x111, 0xf, 0xf, false)); }
__device__ __forceinline__ float dpp_shr2(float old, float src) { return __builtin_bit_cast(float, __builtin_amdgcn_update_dpp(__builtin_bit_cast(int, old), __builtin_bit_cast(int, src), 0x112, 0xf, 0xf, false)); }
__device__ __forceinline__ float dpp_ror1(float src) { return __builtin_bit_cast(float, __builtin_amdgcn_update_dpp(0, __builtin_bit_cast(int, src), 0x121, 0xf, 0xf, false)); }
__device__ __forceinline__ float dpp_ror2(float src) { return __builtin_bit_cast(float, __builtin_amdgcn_update_dpp(0, __builtin_bit_cast(int, src), 0x122, 0xf, 0xf, false)); }
struct EpiFfnUp {
    static constexpr bool PERM = false, AFTER_DRAIN = false;
    bf16_t* ACT; float* edge; float* head; const float* cw; const float* cb; const float* state; float* out_pfc; float* out_sfc; PG8_LAS unsigned char* lds;
    __device__ __forceinline__ void operator()(const f32x4 (&acc)[2][2][4][2], const Unit& u, int wr, int wc, int fr, int fq) const {
        PG8_LAS float* EX = (PG8_LAS float*)(lds + EX_OFF);
        const bool smp = u.pm >= TP / BM;
        const int cl = wc * 32 + 4 * fq;
        if (fr >= 14) {
#pragma unroll
            for (int ai = 0; ai < 2; ++ai)
#pragma unroll
                for (int bj = 0; bj < 2; ++bj)
#pragma unroll
                    for (int n = 0; n < 2; ++n) *(PG8_LAS f32x4*)(EX + ((2 * ai + wr) * 2 + (fr - 14)) * 256 + bj * HALF + cl + 16 * n) = acc[ai][bj][3][n];
            if (wr == 1) {
#pragma unroll
                for (int bj = 0; bj < 2; ++bj)
#pragma unroll
                    for (int n = 0; n < 2; ++n) { const int oc = bj * DFF + u.pn * HALF + cl + 16 * n;
                        *(f32x4*)(edge + ((size_t)u.pm * 2 + (fr - 14)) * 2 * DFF + oc) = acc[1][bj][3][n];
                        if (!smp && (u.pm & (SEQ / BM - 1)) == SEQ / BM - 1) *(f32x4*)(out_pfc + ((size_t)(u.pm / (SEQ / BM)) * 2 + (fr - 14)) * 2 * DFF + oc) = acc[1][bj][3][n]; }
            }
        }
        if (fr < 2 && wr == 0) {
#pragma unroll
            for (int bj = 0; bj < 2; ++bj)
#pragma unroll
                for (int n = 0; n < 2; ++n) *(f32x4*)(head + ((size_t)u.pm * 2 + fr) * 2 * DFF + bj * DFF + u.pn * HALF + cl + 16 * n) = acc[0][bj][0][n];
        }
        asm volatile("s_waitcnt lgkmcnt(0)" ::: "memory"); __builtin_amdgcn_s_barrier(); asm volatile("" ::: "memory");
#pragma unroll
        for (int n = 0; n < 2; ++n) {
            const int f0 = u.pn * HALF + cl + 16 * n;
            f32x4 wg[3], wu[3], bg, bu;
#pragma unroll
            for (int j = 0; j < 3; ++j) { wg[j] = *(const f32x4*)(cw + (size_t)j * 2 * DFF + f0); wu[j] = *(const f32x4*)(cw + (size_t)j * 2 * DFF + DFF + f0); }
            bg = *(const f32x4*)(cb + f0); bu = *(const f32x4*)(cb + DFF + f0);
#pragma unroll
            for (int ai = 0; ai < 2; ++ai) {
                const int s = 2 * ai + wr;
                f32x4 pg = (f32x4){0.f, 0.f, 0.f, 0.f}, pu = pg;
                if (!smp && s > 0 && fr >= 14) { pg = *(const PG8_LAS f32x4*)(EX + ((s - 1) * 2 + (fr - 14)) * 256 + cl + 16 * n); pu = *(const PG8_LAS f32x4*)(EX + ((s - 1) * 2 + (fr - 14)) * 256 + HALF + cl + 16 * n); }
#pragma unroll
                for (int m = 0; m < 4; ++m) {
                    const f32x4 cg = acc[ai][0][m][n], cu = acc[ai][1][m][n];
                    const int row = u.pm * BM + ai * HALF + wr * 64 + m * 16 + fr;
                    f32x4 g1, g2, u1, u2;
#pragma unroll
                    for (int e = 0; e < 4; ++e) { g1[e] = dpp_shr1(dpp_ror1(pg[e]), cg[e]); g2[e] = dpp_shr2(dpp_ror2(pg[e]), cg[e]); u1[e] = dpp_shr1(dpp_ror1(pu[e]), cu[e]); u2[e] = dpp_shr2(dpp_ror2(pu[e]), cu[e]); }
                    if (smp) {
                        const int t = fr & 7, b = (row - TP) >> 3;
                        if (t < 2) { const float* st = state + (size_t)b * 2 * 2 * DFF + f0; const f32x4 s1g = *(const f32x4*)(st + 2 * DFF), s1u = *(const f32x4*)(st + 2 * DFF + DFF);
                            if (t == 0) { g1 = s1g; u1 = s1u; g2 = *(const f32x4*)st; u2 = *(const f32x4*)(st + DFF); } else { g2 = s1g; u2 = s1u; } }
                        if (t >= 6) { float* o = out_sfc + ((size_t)b * 2 + (t - 6)) * 2 * DFF + f0; *(f32x4*)o = cg; *(f32x4*)(o + DFF) = cu; }
                    }
                    const f32x4 gc = wg[0] * g2 + wg[1] * g1 + wg[2] * cg + bg, uc = wu[0] * u2 + wu[1] * u1 + wu[2] * cu + bu;
                    u32x2v w;
                    { const float a0 = gc[0] * uc[0] * __builtin_amdgcn_rcpf(1.0f + __expf(-gc[0])), a1 = gc[1] * uc[1] * __builtin_amdgcn_rcpf(1.0f + __expf(-gc[1])), a2 = gc[2] * uc[2] * __builtin_amdgcn_rcpf(1.0f + __expf(-gc[2])), a3 = gc[3] * uc[3] * __builtin_amdgcn_rcpf(1.0f + __expf(-gc[3]));
                      w.x = cvt_pk_bf16(a0, a1); w.y = cvt_pk_bf16(a2, a3); }
                    *(u32x2v*)(ACT + (size_t)row * DFF + f0) = w;
                    pg = cg; pu = cu;
                }
            }
        }
    }
};
}
__device__ __forceinline__ void phase_ffn_fix(const P& p) {
    constexpr int TPS = SEQ / 256;
    const long n = (long)(BATCH * TPS) * DFF;
    const float* edge = ws_f(p, WS_EDGE); const float* head = ws_f(p, WS_HEAD);
    for (long i = blockIdx.x * (long)NTHR + otid(); i < n; i += (long)gridDim.x * NTHR) {
        const int pm = (int)(i / DFF), f = (int)(i % DFF);
        if (pm % TPS == 0) continue;
        float r0[2], r1[2];
#pragma unroll
        for (int gu = 0; gu < 2; ++gu) { const int c = gu * DFF + f;
            const float um2 = edge[((size_t)(pm - 1) * 2 + 0) * 2 * DFF + c], um1 = edge[((size_t)(pm - 1) * 2 + 1) * 2 * DFF + c], u0 = head[((size_t)pm * 2 + 0) * 2 * DFF + c], u1 = head[((size_t)pm * 2 + 1) * 2 * DFF + c];
            const float w0 = p.ffn_conv_w[c], w1 = p.ffn_conv_w[2 * DFF + c], w2 = p.ffn_conv_w[4 * DFF + c], bb = p.ffn_conv_b[c];
            r0[gu] = w0 * um2 + w1 * um1 + w2 * u0 + bb; r1[gu] = w0 * um1 + w1 * u0 + w2 * u1 + bb; }
        bf16_t* ACT = ws_h(p, WS_ACT) + (size_t)pm * 256 * DFF + f;
        ACT[0] = f2bf(silu_f(r0[0]) * r0[1]); ACT[DFF] = f2bf(silu_f(r1[0]) * r1[1]);
    }
}

__device__ __forceinline__ void ffn_fix_tile(const P& p, int pm) {
    constexpr int TPS = SEQ / 256;
    if (pm >= BATCH * TPS || pm % TPS == 0) return;
    const float* edge = ws_f(p, WS_EDGE); const float* head = ws_f(p, WS_HEAD);
    for (int f = otid(); f < DFF; f += NTHR) {
        float r0[2], r1[2];
#pragma unroll
        for (int gu = 0; gu < 2; ++gu) { const int c = gu * DFF + f;
            const float um2 = edge[((size_t)(pm - 1) * 2 + 0) * 2 * DFF + c], um1 = edge[((size_t)(pm - 1) * 2 + 1) * 2 * DFF + c], u0 = head[((size_t)pm * 2 + 0) * 2 * DFF + c], u1 = head[((size_t)pm * 2 + 1) * 2 * DFF + c];
            const float w0 = p.ffn_conv_w[c], w1 = p.ffn_conv_w[2 * DFF + c], w2 = p.ffn_conv_w[4 * DFF + c], bb = p.ffn_conv_b[c];
            r0[gu] = w0 * um2 + w1 * um1 + w2 * u0 + bb; r1[gu] = w0 * um1 + w1 * u0 + w2 * u1 + bb; }
        bf16_t* ACT = ws_h(p, WS_ACT) + (size_t)pm * 256 * DFF + f;
        ACT[0] = f2bf(silu_f(r0[0]) * r0[1]); ACT[DFF] = f2bf(silu_f(r1[0]) * r1[1]);
    }
}
constexpr int SW_KP = 72;
__device__ __forceinline__ void swa_bias(const LAS float* BT, int lane, float (&bv)[9][4]) {
    const int r16 = lane & 15, g4 = lane >> 4;
#pragma unroll
    for (int t = 0; t < 9; ++t)
#pragma unroll
        for (int e = 0; e < 4; ++e) { const int d = 128 + r16 - 16 * t - 4 * g4 - e; bv[t][e] = (d >= 0 && d <= 127) ? BT[d] * 1.4426950408889634f : -1e30f; }
}
__device__ __forceinline__ void swa_qtile(const LAS bf16_t* KS, const LAS bf16_t* VT, int vtp, int qt, const bf16x8 (&bq)[2], const float (&bv)[9][4], float sink2, bool first, bf16_t* optr, int nvalid_q, int lane) {
    const int r16 = lane & 15, g4 = lane >> 4, kt0 = qt;
    f32x4 s[10];
#pragma unroll
    for (int tb = 0; tb < 2; ++tb) {
        bf16x8 ka[5][2];
#pragma unroll
        for (int t = 0; t < 5; ++t)
#pragma unroll
            for (int ks = 0; ks < 2; ++ks) if (5 * tb + t < 9) ka[t][ks] = *(const LAS bf16x8*)(KS + (16 * (kt0 + 5 * tb + t) + r16) * SW_KP + 32 * ks + 8 * g4);
        __builtin_amdgcn_sched_barrier(0);
#pragma unroll
        for (int t = 0; t < 5; ++t) if (5 * tb + t < 9) { f32x4 a = (f32x4){0.f, 0.f, 0.f, 0.f};
#pragma unroll
            for (int ks = 0; ks < 2; ++ks) a = __builtin_amdgcn_mfma_f32_16x16x32_bf16(ka[t][ks], bq[ks], a, 0, 0, 0);
            s[5 * tb + t] = a; }
        __builtin_amdgcn_sched_barrier(0);
    }
    float mx = sink2;
#pragma unroll
    for (int t = 0; t < 9; ++t)
#pragma unroll
        for (int e = 0; e < 4; ++e) { float v = s[t][e] * 0.18033688011112042f + bv[t][e]; if (first && 16 * (kt0 + t) + 4 * g4 + e < 128) v = -1e30f; s[t][e] = v; mx = fmaxf(mx, v); }
    mx = fmaxf(mx, __shfl_xor(mx, 16)); mx = fmaxf(mx, __shfl_xor(mx, 32));
    float l = 0.f;
#pragma unroll
    for (int t = 0; t < 9; ++t)
#pragma unroll
        for (int e = 0; e < 4; ++e) { const float pv = __builtin_amdgcn_exp2f(s[t][e] - mx); s[t][e] = pv; l += pv; }
    s[9] = (f32x4){0.f, 0.f, 0.f, 0.f};
    l += __shfl_xor(l, 16); l += __shfl_xor(l, 32);
    l += __builtin_amdgcn_exp2f(sink2 - mx);
    const float rl = __builtin_amdgcn_rcpf(l);
    bf16x8 pb[5];
#pragma unroll
    for (int q = 0; q < 5; ++q) pb[q] = pack8(s[2 * q], s[2 * q + 1]);
#pragma unroll
    for (int dp = 0; dp < 2; ++dp) {
        u32x2 vl[2][5], vh[2][5];
#pragma unroll
        for (int d2 = 0; d2 < 2; ++d2)
#pragma unroll
            for (int q = 0; q < 5; ++q) { const LAS bf16_t* vp = VT + (16 * (2 * dp + d2) + r16) * vtp + 16 * (kt0 + 2 * q) + 4 * g4; vl[d2][q] = *(const LAS u32x2*)vp; vh[d2][q] = *(const LAS u32x2*)(vp + 16); }
        __builtin_amdgcn_sched_barrier(0);
#pragma unroll
        for (int d2 = 0; d2 < 2; ++d2) { const int dt = 2 * dp + d2; f32x4 o = (f32x4){0.f, 0.f, 0.f, 0.f};
#pragma unroll
            for (int q = 0; q < 5; ++q) o = __builtin_amdgcn_mfma_f32_16x16x32_bf16(__builtin_bit_cast(bf16x8, (u32x4){vl[d2][q].x, vl[d2][q].y, vh[d2][q].x, vh[d2][q].y}), pb[q], o, 0, 0, 0);
            if (r16 < nvalid_q) *(u32x2*)(optr + (size_t)r16 * 1024 + 16 * dt + 4 * g4) = (u32x2){cvtpk_c(o[0] * rl, o[1] * rl), cvtpk_c(o[2] * rl, o[3] * rl)}; }
        __builtin_amdgcn_sched_barrier(0);
    }
}
constexpr int SWP_VTP = 272, SWS_NK = 144, SWS_VTP = 168;
constexpr int SW_KS = 0, SW_VT = 43008, SW_BT = 86016, SW_END = SW_BT + 8 * 128 * 4;
static_assert(256 * SW_KP * 2 <= SW_VT && SW_VT + 64 * SWP_VTP * 2 <= SW_BT && SWS_NK * SW_KP * 2 <= SW_VT && SW_VT + 64 * SWS_VTP * 2 <= SW_BT, "swa LDS map");
__device__ __forceinline__ void phase_swa(const P& p, LAS unsigned char* lds, unsigned long long& pr_prev, unsigned long long& pr_acc) {
    const int tid = otid(), lane = tid & 63, wave = tid >> 6;
    LAS bf16_t* KS = (LAS bf16_t*)(lds + SW_KS); LAS bf16_t* VT = (LAS bf16_t*)(lds + SW_VT); LAS float* BT = (LAS float*)(lds + SW_BT);
    const bf16_t* PR = ws_h(p, WS_PROJ); bf16_t* MX = ws_h(p, WS_MIX);
    constexpr int NQB = SEQ / 128, NPU = BATCH * NQB * 2, NU = NPU + DEC_BATCH * 2;
    for (int i = tid; i < 8 * 128; i += NTHR) BT[i] = p.rel_bias[t5_bucket(i & 127) * 8 + (i >> 7)];
    const int vb = (gridDim.x % 8 == 0) ? (int)((blockIdx.x % 8) * (gridDim.x / 8) + blockIdx.x / 8) : (int)blockIdx.x;
    for (int u = vb; u < NU; u += gridDim.x) {
        __syncthreads(); DPS(22);
        if (u < NPU) {
            const int kvh = u & 1, qb = (u >> 1) % NQB, b = (u >> 1) / NQB, m0 = b * SEQ + qb * 128; const bool first = qb == 0;
            const bf16_t* qbase = PR + (size_t)(m0 + 64 * (wave & 1) + (lane & 15)) * PLD + PC_SQ + (kvh * 4 + (wave >> 1)) * 64 + 8 * (lane >> 4);
            bf16x8 bq[2], bqn[2];
#pragma unroll
            for (int ks = 0; ks < 2; ++ks) bq[ks] = *(const bf16x8*)(qbase + 32 * ks);
            {
                u32x4 kr[4], vr[5];
#pragma unroll
                for (int i = 0; i < 4; ++i) { const int it = tid + i * NTHR, jj = it >> 3, c = it & 7; kr[i] = (u32x4){0u, 0u, 0u, 0u};
                    if (!(first && jj < 128)) kr[i] = *(const u32x4*)(PR + (size_t)(m0 - 128 + jj) * PLD + PC_SK + kvh * 64 + 8 * c); }
#pragma unroll
                for (int i = 0; i < 5; ++i) { const int it = tid + i * NTHR, jj = it % 272, c = it / 272; vr[i] = (u32x4){0u, 0u, 0u, 0u};
                    if (it < 272 * 8 && jj < 256 && !(first && jj < 128)) vr[i] = *(const u32x4*)(PR + (size_t)(m0 - 128 + jj) * PLD + PC_SV + kvh * 64 + 8 * c); }
#pragma unroll
                for (int i = 0; i < 4; ++i) { const int it = tid + i * NTHR, jj = it >> 3, c = it & 7; *(LAS u32x4*)(KS + jj * SW_KP + 8 * c) = kr[i]; }
#pragma unroll
                for (int i = 0; i < 5; ++i) { const int it = tid + i * NTHR, jj = it % 272, c = it / 272;
                    if (it < 272 * 8) { const unsigned w[4] = {vr[i].x, vr[i].y, vr[i].z, vr[i].w};
#pragma unroll
                        for (int e = 0; e < 4; ++e) { VT[(8 * c + 2 * e) * SWP_VTP + jj] = (bf16_t)(w[e] & 0xffffu); VT[(8 * c + 2 * e + 1) * SWP_VTP + jj] = (bf16_t)(w[e] >> 16); } } }
            }
            __syncthreads(); DPS(23);
            const int hq = kvh * 4 + (wave >> 1), qh = wave & 1, r16 = lane & 15, g4 = lane >> 4;
            float bv[9][4]; swa_bias(BT + hq * 128, lane, bv);
            const float sink2 = p.swa_sinks[hq] * 1.4426950408889634f;
#pragma unroll 1
            for (int q4 = 0; q4 < 4; ++q4) { const int qt = 4 * qh + q4;
                if (q4 < 3) {
#pragma unroll
                    for (int ks = 0; ks < 2; ++ks) bqn[ks] = *(const bf16x8*)(qbase + (size_t)(16 * (q4 + 1)) * PLD + 32 * ks); }
                swa_qtile(KS, VT, SWP_VTP, qt, bq, bv, sink2, first, MX + (size_t)(m0 + 16 * qt) * 1024 + 512 + hq * 64, 16, lane);
                bq[0] = bqn[0]; bq[1] = bqn[1]; }
            DPS(24);
        } else {
            const int su = u - NPU, b = su >> 1, kvh = su & 1, m0 = TP + b * DEC_SEQ;
            bf16x8 bqs[2];
#pragma unroll
            for (int ks = 0; ks < 2; ++ks) bqs[ks] = *(const bf16x8*)(PR + (size_t)(m0 + (lane & 7)) * PLD + PC_SQ + (kvh * 4 + (wave & 3)) * 64 + 32 * ks + 8 * (lane >> 4));
            {
                f32x4 ka[3][2], va[3][2]; u32x4 kn[3], vn[3];
#pragma unroll
                for (int i = 0; i < 3; ++i) { const int it = tid + i * NTHR, jj = it >> 3, c = it & 7;
                    ka[i][0] = ka[i][1] = (f32x4){0.f, 0.f, 0.f, 0.f}; kn[i] = (u32x4){0u, 0u, 0u, 0u};
                    if (it < SWS_NK * 8) { if (jj < 128) { const float* src = p.cache_k + ((size_t)b * 128 + jj) * 128 + kvh * 64 + 8 * c; ka[i][0] = *(const f32x4*)src; ka[i][1] = *(const f32x4*)(src + 4); }
                        else if (jj < 128 + DEC_SEQ) kn[i] = *(const u32x4*)(PR + (size_t)(m0 + jj - 128) * PLD + PC_SK + kvh * 64 + 8 * c); } }
#pragma unroll
                for (int i = 0; i < 3; ++i) { const int it = tid + i * NTHR, jj = it % SWS_VTP, c = it / SWS_VTP;
                    va[i][0] = va[i][1] = (f32x4){0.f, 0.f, 0.f, 0.f}; vn[i] = (u32x4){0u, 0u, 0u, 0u};
                    if (it < SWS_VTP * 8) { if (jj < 128) { const float* src = p.cache_v + ((size_t)b * 128 + jj) * 128 + kvh * 64 + 8 * c; va[i][0] = *(const f32x4*)src; va[i][1] = *(const f32x4*)(src + 4); }
                        else if (jj < 128 + DEC_SEQ) vn[i] = *(const u32x4*)(PR + (size_t)(m0 + jj - 128) * PLD + PC_SV + kvh * 64 + 8 * c); } }
#pragma unroll
                for (int i = 0; i < 3; ++i) { const int it = tid + i * NTHR, jj = it >> 3, c = it & 7;
                    if (it < SWS_NK * 8) { u32x4 v = kn[i]; if (jj < 128) v = (u32x4){cvtpk_c(ka[i][0][0], ka[i][0][1]), cvtpk_c(ka[i][0][2], ka[i][0][3]), cvtpk_c(ka[i][1][0], ka[i][1][1]), cvtpk_c(ka[i][1][2], ka[i][1][3])};
                        *(LAS u32x4*)(KS + jj * SW_KP + 8 * c) = v; } }
#pragma unroll
                for (int i = 0; i < 3; ++i) { const int it = tid + i * NTHR, jj = it % SWS_VTP, c = it / SWS_VTP;
                    if (it < SWS_VTP * 8) { u32x4 v = vn[i]; if (jj < 128) v = (u32x4){cvtpk_c(va[i][0][0], va[i][0][1]), cvtpk_c(va[i][0][2], va[i][0][3]), cvtpk_c(va[i][1][0], va[i][1][1]), cvtpk_c(va[i][1][2], va[i][1][3])};
                        const unsigned w[4] = {v.x, v.y, v.z, v.w};
#pragma unroll
                        for (int e = 0; e < 4; ++e) { VT[(8 * c + 2 * e) * SWS_VTP + jj] = (bf16_t)(w[e] & 0xffffu); VT[(8 * c + 2 * e + 1) * SWS_VTP + jj] = (bf16_t)(w[e] >> 16); } } }
            }
            __syncthreads(); DPS(25);
            if (wave < 4) { const int hq = kvh * 4 + wave;
                float bv[9][4]; swa_bias(BT + hq * 128, lane, bv);
                swa_qtile(KS, VT, SWS_VTP, 0, bqs, bv, p.swa_sinks[hq] * 1.4426950408889634f, false, MX + (size_t)m0 * 1024 + 512 + hq * 64, 8, lane); }
        }
    }
    __syncthreads();
}
static void fill_params(P& p, void* const* d_in, void* d_out, void* d_ws) {
    const float** pp = (const float**)&p;
    for (int i = 0; i < 26; ++i) pp[i] = (const float*)d_in[i];
    p.out = (float*)d_out; p.ws = (unsigned char*)d_ws;
}
namespace cg = cooperative_groups;
constexpr int CW_BAR = 1024;
constexpr size_t CTL_ZERO_BYTES = 65536;

#ifndef PROBE_MASK
#define PROBE_MASK 0
#endif
#ifndef PROBE_K
#define PROBE_K 4
#endif
#ifndef PROBE_XSYNC
#define PROBE_XSYNC 0
#endif
#if PROBE_MASK
#define PROBE_SUB(k) do { xcd_barrier(bar); PROBE_STAMP(k); } while (0)
#define PROBE_DECL unsigned long long pr_prev = __builtin_amdgcn_s_memrealtime(), pr_acc = 0ull
#define PROBE_STAMP(k) do { const unsigned long long now_ = __builtin_amdgcn_s_memrealtime(); if ((PROBE_MASK >> (k)) & 1) pr_acc += now_ - pr_prev; pr_prev = now_; } while (0)
#define PROBE_END() do { xcd_barrier(bar); PROBE_STAMP(11); if (blockIdx.x == 0 && __builtin_amdgcn_mbcnt_hi(~0u, __builtin_amdgcn_mbcnt_lo(~0u, 0u)) == 0u) { const unsigned long long t0_ = __builtin_amdgcn_s_memrealtime(); while (__builtin_amdgcn_s_memrealtime() - t0_ < (unsigned long long)PROBE_K * pr_acc) __builtin_amdgcn_s_sleep(8); } } while (0)
#else
#define PROBE_DECL unsigned long long pr_prev = 0ull, pr_acc = 0ull
#define PROBE_SUB(k)
#define PROBE_STAMP(k)
#define PROBE_END() do { for (int i_ = 0; i_ < PROBE_XSYNC; ++i_) xcd_barrier(bar); } while (0)
#endif
__global__ void __launch_bounds__(512, 2) fwd_megakernel(P p) {
    extern __shared__ __attribute__((aligned(16))) unsigned char lds_raw[];
    LAS unsigned char* lds = (LAS unsigned char*)lds_raw;
    cg::grid_group grid = cg::this_grid();
    PROBE_DECL;
    volatile LAS unsigned* MISC = (volatile LAS unsigned*)(lds + LDS_BYTES - 64);
    if (threadIdx.x < 16) MISC[threadIdx.x] = 0u;
    __syncthreads();
    const XcdBarrier bar = xcd_barrier_post((unsigned*)(p.ws + WS_CTL) + CW_BAR, MISC);
    phase_mod(p, lds); PROBE_STAMP(31); phase_transposes(p, lds);
    if (p.ws == nullptr) grid.sync();
    xcd_barrier(bar); PROBE_STAMP(0);
    phase_norm<0>(p, lds);
    xcd_barrier(bar); PROBE_STAMP(1);
    { pg8::StaticOrder S; pg8::Gemm g{ws_h(p, WS_H), ws_h(p, WS_WT_IN), T, PLD, D}; S.init(T, PLD, gridDim.x, blockIdx.x, D); pg8::EpiStoreBf16 E{ws_h(p, WS_PROJ), PLD};
      pg8::gemm_phase<pg8::EpiStoreBf16, pg8::StaticOrder, true, true>(lds, g, S, E); }
    xcd_barrier(bar); PROBE_STAMP(2);
    phase_state_out(p);
    PROBE_STAMP(21);
    phase_dnprep(p, lds, pr_prev, pr_acc);
    PROBE_SUB(12);
    phase_dnsample(p, lds, pr_prev, pr_acc);
    PROBE_SUB(13);
    phase_swa(p, lds, pr_prev, pr_acc);
    xcd_barrier(bar); PROBE_STAMP(3);
    phase_dns_passA(p, lds);
    xcd_barrier(bar); PROBE_STAMP(14);
    phase_dns_passB(p, lds);
    xcd_barrier(bar); PROBE_STAMP(15);
    phase_dns_passC(p, lds);
    xcd_barrier(bar); PROBE_STAMP(4);
    phase_dngate(p);
    xcd_barrier(bar); PROBE_STAMP(5);
    { pg8::SplitOrder S; pg8::Gemm g{ws_h(p, WS_MIX), ws_h(p, WS_WT_OUT), T, D, 1024}; S.init(D, 1024, NS_OUT, gridDim.x, blockIdx.x); pg8::EpiGateRes<0> E{p.x_prompt, p.x_sample, ws_h(p, WS_XB), ws_f(p, WS_MOD) + 2 * D, p.out + O_Y, NS_OUT};
      pg8::gemm_phase<pg8::EpiGateRes<0>, pg8::SplitOrder, true, true>(lds, g, S, E); }
    xcd_barrier(bar); PROBE_STAMP(6);
    phase_norm<1>(p, lds);
    xcd_barrier(bar); PROBE_STAMP(7);
    { pg8::StaticOrder S; pg8::Gemm g{ws_h(p, WS_H), ws_h(p, WS_WT_UP), T, 2 * DFF, D}; S.init(T, 2 * DFF, gridDim.x, blockIdx.x, D);
      pg8::EpiFfnUp E{ws_h(p, WS_ACT), ws_f(p, WS_EDGE), ws_f(p, WS_HEAD), p.ffn_conv_w, p.ffn_conv_b, p.state_ffn, p.out + O_PFC, p.out + O_SFC, lds};
      pg8::gemm_phase<pg8::EpiFfnUp, pg8::StaticOrder, true, true>(lds, g, S, E); }
    xcd_barrier(bar); PROBE_STAMP(8);
    { pg8::SplitOrder S; pg8::Gemm g{ws_h(p, WS_ACT), ws_h(p, WS_WT_DN), T, D, DFF}; S.init(D, DFF, NS_DN, gridDim.x, blockIdx.x);
      { constexpr int NU1 = (TP / 256) * (D / 256); for (int L = blockIdx.x; L < NU1; L += gridDim.x) { const int w1 = (L % 8) * (NU1 / 8) + L / 8, pm = (w1 / (8 * (D / 256))) * 8 + (w1 % (8 * (D / 256))) % 8; ffn_fix_tile(p, pm); }
        asm volatile("s_waitcnt vmcnt(0)" ::: "memory"); __syncthreads(); }
      pg8::EpiGateRes<1> E{nullptr, nullptr, ws_h(p, WS_XB), ws_f(p, WS_MOD) + 5 * D, ws_f(p, WS_SLAB_DN), NS_DN};
      pg8::gemm_phase<pg8::EpiGateRes<1>, pg8::SplitOrder, true, true>(lds, g, S, E); }
    xcd_barrier(bar); PROBE_STAMP(10);
    phase_norm<2>(p, lds);
    PROBE_END();
}
extern "C" void kernel_launch(void* const* d_in, const int* in_sizes, int n_in, void* d_out, int out_size, void* d_ws, size_t ws_size, hipStream_t stream) {
    static int grid_blocks = 0;
    if (grid_blocks == 0) {
        if (n_in != 26 || (long)out_size != O_END || ws_size < WS_END) { fprintf(stderr, "kernel_launch: unexpected shapes n_in=%d out=%d ws=%zu (need %zu)\n", n_in, out_size, ws_size, (size_t)WS_END); grid_blocks = -1; return; }
        int dev = 0, cus = 0, per_cu = 0;
        if (hipGetDevice(&dev) != hipSuccess || hipDeviceGetAttribute(&cus, hipDeviceAttributeMultiprocessorCount, dev) != hipSuccess) { grid_blocks = -1; return; }
        if (hipFuncSetAttribute((const void*)fwd_megakernel, hipFuncAttributeMaxDynamicSharedMemorySize, LDS_BYTES) != hipSuccess) { fprintf(stderr, "kernel_launch: hipFuncSetAttribute failed\n"); grid_blocks = -1; return; }
        if (hipOccupancyMaxActiveBlocksPerMultiprocessor(&per_cu, (const void*)fwd_megakernel, NTHR, LDS_BYTES) != hipSuccess || per_cu < 1) { fprintf(stderr, "kernel_launch: occupancy query says %d\n", per_cu); grid_blocks = -1; return; }
        grid_blocks = cus;
        fprintf(stderr, "kernel_launch: grid %d (cus %d, per_cu %d)\n", grid_blocks, cus, per_cu);
    }
    if (grid_blocks < 0) return;
    P p{}; fill_params(p, d_in, d_out, d_ws);
    if (hipMemsetAsync((char*)d_ws + WS_CTL, 0, CTL_ZERO_BYTES, stream) != hipSuccess) { fprintf(stderr, "kernel_launch: memset of the control words failed\n"); return; }
    void* args[] = {&p};
    const hipError_t e = hipLaunchCooperativeKernel((const void*)fwd_megakernel, dim3(grid_blocks), dim3(NTHR), args, LDS_BYTES, stream);
    if (e != hipSuccess) fprintf(stderr, "cooperative launch failed: %s (grid %d)\n", hipGetErrorString(e), grid_blocks);
}
```

```cpp
#include <hip/hip_runtime.h>
#include <hip/hip_cooperative_groups.h>
#include <cstdio>
#include <cstdint>
#define HD __device__ __forceinline__
#if defined(PROBE_MASK) && PROBE_MASK
#define DPS(k) do { const unsigned long long now_ = __builtin_amdgcn_s_memrealtime(); if ((PROBE_MASK >> (k)) & 1) pr_acc += now_ - pr_prev; pr_prev = now_; } while (0)
#endif
#ifndef CFG_D_MODEL
#define CFG_D_MODEL 1024
#endif
#ifndef CFG_SEQ
#define CFG_SEQ 8192
#endif
#ifndef CFG_DEC_BATCH
#define CFG_DEC_BATCH 128
#endif
#ifndef CFG_D_FF
#define CFG_D_FF 2816
#endif

constexpr int D = CFG_D_MODEL, BATCH = 2, SEQ = CFG_SEQ, DEC_BATCH = CFG_DEC_BATCH, DEC_SEQ = 8, DFF = CFG_D_FF;
constexpr int TP = BATCH * SEQ, TS = DEC_BATCH * DEC_SEQ, T = TP + TS, NCB = BATCH + DEC_BATCH;
constexpr int IN_COLS = 2824, PLD = 2816;
constexpr int PC_QKV = 0, PC_Z = 1536, PC_SQ = 2048, PC_SK = 2560, PC_SV = 2688;
constexpr int WC_BA = 2048;
constexpr float EPS = 1e-6f;

constexpr long O_Y = 0;
constexpr long O_PDC = (long)T * D;
constexpr long O_SDC = O_PDC + (long)BATCH * 3 * 1536;
constexpr long O_PSSM = O_SDC + (long)DEC_BATCH * 3 * 1536;
constexpr long O_SSSM = O_PSSM + (long)BATCH * 4 * 128 * 128;
constexpr long O_PK = O_SSSM + (long)DEC_BATCH * 4 * 128 * 128;
constexpr long O_SK = O_PK + (long)BATCH * 128 * 128;
constexpr long O_PV = O_SK + (long)DEC_BATCH * 128 * 128;
constexpr long O_SV = O_PV + (long)BATCH * 128 * 128;
constexpr long O_PFC = O_SV + (long)DEC_BATCH * 128 * 128;
constexpr long O_SFC = O_PFC + (long)BATCH * 2 * 2 * DFF;
constexpr long O_END = O_SFC + (long)DEC_BATCH * 2 * 2 * DFF;

constexpr size_t al256(size_t x) { return (x + 255) & ~(size_t)255; }
constexpr size_t WS_CTL = 0;
constexpr size_t WS_MOD = 1u << 20;
constexpr size_t WS_BG = al256(WS_MOD + (size_t)NCB * 6 * D * 4);
constexpr size_t WS_WBAT = al256(WS_BG + (size_t)T * 8 * 4);
constexpr size_t WS_WT_IN = al256(WS_WBAT + (size_t)8 * D * 4);
constexpr size_t WS_WT_OUT = al256(WS_WT_IN + (size_t)PLD * D * 2);
constexpr size_t WS_WT_UP = al256(WS_WT_OUT + (size_t)D * 1024 * 2);
constexpr size_t WS_WT_DN = al256(WS_WT_UP + (size_t)2 * DFF * D * 2);
constexpr size_t WS_H = al256(WS_WT_DN + (size_t)D * DFF * 2);
constexpr int NCHUNK = SEQ / 64, NUNIT = BATCH * 4 * NCHUNK;
constexpr int DNF_AB_UNIT = 57344, DNF_WV_UNIT = 32768;
constexpr size_t WS_DNF_WV = WS_H;
constexpr size_t WS_DNF_AB = al256(WS_H + (size_t)T * (D > 1024 ? D : 1024) * 2);
constexpr size_t WS_DNF_CD = al256(WS_DNF_AB + (size_t)NUNIT * DNF_AB_UNIT);
constexpr size_t WS_QKVC = WS_DNF_AB;
constexpr size_t WS_PROJ = al256((WS_DNF_CD + (size_t)NUNIT * 4) > (WS_QKVC + (size_t)T * 1536 * 2) ? (WS_DNF_CD + (size_t)NUNIT * 4) : (WS_QKVC + (size_t)T * 1536 * 2));
constexpr size_t WS_MIX = al256(WS_PROJ + (size_t)T * PLD * 2);
constexpr size_t WS_FREE = al256(WS_MIX + (size_t)T * 1024 * 2);
constexpr size_t WS_ODN = WS_H, WS_ACT = WS_PROJ;
static_assert((size_t)NUNIT * DNF_WV_UNIT <= (size_t)T * 1024 * 2, "Wv tiles overlay H");

typedef unsigned short bf16_t;
HD unsigned f2bf_bits(float f) { unsigned u = __builtin_bit_cast(unsigned, f); return (u + 0x7fffu + ((u >> 16) & 1u)) >> 16; }
HD bf16_t f2bf(float f) { return (bf16_t)f2bf_bits(f); }
HD float bf2f(bf16_t b) { return __builtin_bit_cast(float, (unsigned)b << 16); }
HD float silu_f(float x) { return x / (1.0f + expf(-x)); }
HD float sigmoid_f(float x) { return 1.0f / (1.0f + expf(-x)); }
HD float softplus_f(float x) { return x > 20.f ? x : log1pf(expf(x)); }

struct P {
    const float *x_prompt, *x_sample, *state_dn_conv, *state_dn_ssm, *cache_k, *cache_v, *state_ffn, *c_prompt, *c_sample, *rel_bias,
        *final_norm_w, *w_ada, *b_ada, *norm_mix_w, *w_in, *dn_conv_w, *dn_A_log, *dn_dt_bias, *dn_norm_w, *swa_sinks, *w_out, *norm_ffn_w,
        *w_up, *ffn_conv_w, *ffn_conv_b, *w_down;
    float* out; unsigned char* ws;
};

HD const float* xrow(const P& p, int m) { return m < TP ? p.x_prompt + (size_t)m * D : p.x_sample + (size_t)(m - TP) * D; }
HD int cb_of(int m) { return m < TP ? m / SEQ : BATCH + (m - TP) / DEC_SEQ; }
HD int t_of(int m) { return m < TP ? m % SEQ : (m - TP) % DEC_SEQ; }
HD float* ws_f(const P& p, size_t off) { return (float*)(p.ws + off); }
HD bf16_t* ws_h(const P& p, size_t off) { return (bf16_t*)(p.ws + off); }

HD int t5_bucket(int d) {
    if (d < 16) return d;
    const float logv = logf((float)d / 16.0f) / 2.0794415416798357f;
    int b = 16 + (int)(logv * 16.0f);
    return b < 31 ? b : 31;
}

#define LAS __attribute__((address_space(3)))
typedef float f32x4 __attribute__((ext_vector_type(4)));
typedef unsigned u32x4 __attribute__((ext_vector_type(4)));
typedef unsigned u32x2 __attribute__((ext_vector_type(2)));
constexpr int NWAVES = 8, NTHR = 512;
constexpr int LDS_BYTES = 163840;
__device__ __forceinline__ int otid() { int t = threadIdx.x; asm volatile("" : "+v"(t)); return t; }
#define LDS_BARRIER() do { asm volatile("s_waitcnt lgkmcnt(0)" ::: "memory"); __builtin_amdgcn_s_barrier(); asm volatile("" ::: "memory"); } while (0)
__device__ __forceinline__ float wave_sum(float v) {
#pragma unroll
    for (int o = 1; o < 64; o <<= 1) v += __shfl_xor(v, o);
    return v;
}
__device__ __forceinline__ unsigned pk2(float lo, float hi) { return f2bf_bits(lo) | (f2bf_bits(hi) << 16); }

__device__ __forceinline__ void transpose_item(const float* W, int ldw, int K, bf16_t* WT, int dst_n0, int src_n0, int k0, LAS float* scr, int lane) {
#pragma unroll
    for (int i = 0; i < 32; ++i) { const int kk = 2 * i + (lane >> 5); scr[kk * 33 + (lane & 31)] = W[(size_t)(k0 + kk) * ldw + src_n0 + (lane & 31)]; }
    asm volatile("s_waitcnt lgkmcnt(0)" ::: "memory");
    const int c = lane & 7;
#pragma unroll
    for (int j = 0; j < 4; ++j) { const int n = (lane >> 3) + 8 * j; const LAS float* s = scr + (8 * c) * 33 + n;
        u32x4 o; o.x = pk2(s[0 * 33], s[1 * 33]); o.y = pk2(s[2 * 33], s[3 * 33]); o.z = pk2(s[4 * 33], s[5 * 33]); o.w = pk2(s[6 * 33], s[7 * 33]);
        *(u32x4*)(WT + (size_t)(dst_n0 + n) * K + k0 + 8 * c) = o; }
    asm volatile("s_waitcnt lgkmcnt(0)" ::: "memory");
}
constexpr int TI_IN = (PLD / 32) * (D / 64), TI_OUT = (D / 32) * (1024 / 64), TI_UP = (2 * DFF / 32) * (D / 64), TI_DN = (D / 32) * (DFF / 64), TI_ALL = TI_IN + TI_OUT + TI_UP + TI_DN;
__device__ __forceinline__ void phase_transposes(const P& p, LAS unsigned char* lds) {
    const int tid_ = otid(), lane = tid_ & 63, wave = tid_ >> 6;
    LAS float* scr = (LAS float*)(lds + wave * 16384);
    if (blockIdx.x == gridDim.x - 1) { for (int i = tid_; i < 8 * D; i += NTHR) ws_f(p, WS_WBAT)[i] = p.w_in[(size_t)(i % D) * IN_COLS + WC_BA + i / D]; }
    constexpr int NCG_MOD = 6 * D / 32;
    const bool split = (int)gridDim.x >= NCG_MOD + 32;
    if (split && (int)blockIdx.x < NCG_MOD) return;
    const int gw = (split ? (int)blockIdx.x - NCG_MOD : (int)blockIdx.x) * NWAVES + wave, NGW = (split ? (int)gridDim.x - NCG_MOD : (int)gridDim.x) * NWAVES;
    for (int it = gw; it < TI_ALL; it += NGW) {
        int r = it;
        if (r < TI_IN) { const int nb = r % (PLD / 32), kb = r / (PLD / 32), n0 = nb * 32; transpose_item(p.w_in, IN_COLS, D, ws_h(p, WS_WT_IN), n0, n0 < WC_BA ? n0 : n0 + 8, kb * 64, scr, lane); continue; } r -= TI_IN;
        if (r < TI_OUT) { const int nb = r % (D / 32), kb = r / (D / 32), n0 = nb * 32; transpose_item(p.w_out, D, 1024, ws_h(p, WS_WT_OUT), n0, n0, kb * 64, scr, lane); continue; } r -= TI_OUT;
        if (r < TI_UP) { const int nb = r % (2 * DFF / 32), kb = r / (2 * DFF / 32), n0 = nb * 32;
            const int pn = n0 >> 8, bj = (n0 >> 7) & 1, c = n0 & 127; transpose_item(p.w_up, 2 * DFF, D, ws_h(p, WS_WT_UP), n0, bj * DFF + 128 * pn + c, kb * 64, scr, lane); continue; } r -= TI_UP;
        { const int nb = r % (D / 32), kb = r / (D / 32), n0 = nb * 32; transpose_item(p.w_down, D, DFF, ws_h(p, WS_WT_DN), n0, n0, kb * 64, scr, lane); }
    }
}
typedef short bf16x8m __attribute__((ext_vector_type(8)));
typedef float f32x2m __attribute__((ext_vector_type(2))); typedef __bf16 bf16x2m __attribute__((ext_vector_type(2)));
__device__ __forceinline__ unsigned cvtpk_m(float lo, float hi) { const f32x2m v = {lo, hi}; return __builtin_bit_cast(unsigned, __builtin_convertvector(v, bf16x2m)); }
__device__ __forceinline__ void split8(const float (&x)[8], bf16x8m& hi, bf16x8m& lo) {
    unsigned h[4], l[4];
#pragma unroll
    for (int e = 0; e < 4; ++e) { h[e] = cvtpk_m(x[2 * e], x[2 * e + 1]);
        l[e] = cvtpk_m(x[2 * e] - __builtin_bit_cast(float, h[e] << 16), x[2 * e + 1] - __builtin_bit_cast(float, h[e] & 0xffff0000u)); }
    hi = __builtin_bit_cast(bf16x8m, (u32x4){h[0], h[1], h[2], h[3]}); lo = __builtin_bit_cast(bf16x8m, (u32x4){l[0], l[1], l[2], l[3]});
}
__device__ __forceinline__ float silu_fast(float x) { return x * __builtin_amdgcn_rcpf(1.0f + __expf(-x)); }
#ifndef DPS
#define DPS(k)
#endif
__device__ __forceinline__ void phase_mod(const P& p, LAS unsigned char* lds, unsigned long long& pr_prev, unsigned long long& pr_acc) {
    constexpr int KC = 256, NCG = 6 * D / 32, NCH = D / KC, NMT = (NCB + 15) / 16;
    static_assert(NMT == 9 && KC / 32 == NWAVES, "eight full m-tiles + one k-split tile");
    constexpr int KCP = KC + 4;
    LAS float* WB = (LAS float*)lds;
    LAS float* RX = WB + 2 * 32 * KCP;
    const int tid = otid(), lane = tid & 63, wave = tid >> 6, r16 = lane & 15, g4 = lane >> 4;
    for (int cg = blockIdx.x; cg < NCG; cg += gridDim.x) {
        f32x4 acc[2][2];
#pragma unroll
        for (int s = 0; s < 2; ++s)
#pragma unroll
            for (int nt = 0; nt < 2; ++nt) acc[s][nt] = (f32x4){0.f, 0.f, 0.f, 0.f};
        f32x4 wreg[4];
#pragma unroll
        for (int j = 0; j < 4; ++j) { const int idx = tid + NTHR * j; wreg[j] = *(const f32x4*)(p.w_ada + (size_t)(idx >> 3) * 6 * D + cg * 32 + 4 * (idx & 7)); }
        LDS_BARRIER();
        const int row0 = 16 * wave + r16, row8 = 128 + r16;
        const float* c0 = (row0 < BATCH ? p.c_prompt + (size_t)row0 * D : p.c_sample + (size_t)(row0 - BATCH) * D) + 8 * g4;
        const float* c8 = p.c_sample + (size_t)((row8 < NCB ? row8 : NCB - 1) - BATCH) * D + 8 * g4;
#pragma unroll
        for (int ch = 0; ch < NCH; ++ch) {
            LAS float* wb = WB + (ch & 1) * 32 * KCP;
#pragma unroll
            for (int j = 0; j < 4; ++j) { const int idx = tid + NTHR * j;
#pragma unroll
                for (int e = 0; e < 4; ++e) wb[(4 * (idx & 7) + e) * KCP + (idx >> 3)] = wreg[j][e]; }
            f32x4 areg[KC / 32 + 1][2];
#pragma unroll
            for (int ks = 0; ks < KC / 32; ++ks) { areg[ks][0] = *(const f32x4*)(c0 + ch * KC + 32 * ks); areg[ks][1] = *(const f32x4*)(c0 + ch * KC + 32 * ks + 4); }
            areg[KC / 32][0] = *(const f32x4*)(c8 + ch * KC + 32 * wave); areg[KC / 32][1] = *(const f32x4*)(c8 + ch * KC + 32 * wave + 4);
            if (ch + 1 < NCH) {
#pragma unroll
                for (int j = 0; j < 4; ++j) { const int idx = tid + NTHR * j; wreg[j] = *(const f32x4*)(p.w_ada + (size_t)((ch + 1) * KC + (idx >> 3)) * 6 * D + cg * 32 + 4 * (idx & 7)); }
            }
            LDS_BARRIER(); DPS(16);
#pragma unroll
            for (int st = 0; st <= KC / 32; ++st) {
                const int ks = st < KC / 32 ? st : wave, s = st < KC / 32 ? 0 : 1;
                bf16x8m bh[2], bl[2];
#pragma unroll
                for (int nt = 0; nt < 2; ++nt) { const LAS float* wp = wb + (16 * nt + r16) * KCP + 32 * ks + 8 * g4; const f32x4 w0 = *(const LAS f32x4*)wp, w1 = *(const LAS f32x4*)(wp + 4);
                    const float x[8] = {w0[0], w0[1], w0[2], w0[3], w1[0], w1[1], w1[2], w1[3]};
                    split8(x, bh[nt], bl[nt]); }
                const bool valid = st < KC / 32 ? row0 < NCB : row8 < NCB;
                float x[8]; const f32x4 a = areg[st][0], d = areg[st][1];
                x[0] = silu_fast(a[0]); x[1] = silu_fast(a[1]); x[2] = silu_fast(a[2]); x[3] = silu_fast(a[3]); x[4] = silu_fast(d[0]); x[5] = silu_fast(d[1]); x[6] = silu_fast(d[2]); x[7] = silu_fast(d[3]);
#pragma unroll
                for (int j = 0; j < 8; ++j) x[j] = valid ? x[j] : 0.f;
                bf16x8m ah, al; split8(x, ah, al);
#pragma unroll
                for (int nt = 0; nt < 2; ++nt) {
                    acc[s][nt] = __builtin_amdgcn_mfma_f32_16x16x32_bf16(ah, bh[nt], acc[s][nt], 0, 0, 0);
                    acc[s][nt] = __builtin_amdgcn_mfma_f32_16x16x32_bf16(ah, bl[nt], acc[s][nt], 0, 0, 0);
                    acc[s][nt] = __builtin_amdgcn_mfma_f32_16x16x32_bf16(al, bh[nt], acc[s][nt], 0, 0, 0); }
            }
            DPS(17);
        }
#pragma unroll
        for (int nt = 0; nt < 2; ++nt) { *(LAS f32x4*)(RX + ((wave * 2 + nt) * 64 + lane) * 4) = acc[1][nt]; }
#pragma unroll
        for (int nt = 0; nt < 2; ++nt) { const int e = cg * 32 + 16 * nt + r16; const float bb = p.b_ada[e];
#pragma unroll
            for (int i = 0; i < 4; ++i) { const int row = 16 * wave + 4 * g4 + i; if (row < NCB) ws_f(p, WS_MOD)[(size_t)row * 6 * D + e] = acc[0][nt][i] + bb; } }
        LDS_BARRIER();
        if (wave == 0) {
#pragma unroll
            for (int nt = 0; nt < 2; ++nt) { f32x4 t = (f32x4){0.f, 0.f, 0.f, 0.f};
#pragma unroll
                for (int w = 0; w < NWAVES; ++w) t += *(const LAS f32x4*)(RX + ((w * 2 + nt) * 64 + lane) * 4);
                const int e = cg * 32 + 16 * nt + r16; const float bb = p.b_ada[e];
#pragma unroll
                for (int i = 0; i < 4; ++i) { const int row = 128 + 4 * g4 + i; if (row < NCB) ws_f(p, WS_MOD)[(size_t)row * 6 * D + e] = t[i] + bb; } }
        }
    }
    LDS_BARRIER();
}
constexpr int NS_OUT = 4, NS_DN = 11;
constexpr size_t SLAB_DN_BYTES = (size_t)(TS / 256) * (D / 256) * NS_DN * 65536 * 4, WS_SLAB_DN = WS_H;
constexpr size_t WS_XB = al256(WS_SLAB_DN + SLAB_DN_BYTES);
static_assert(WS_XB >= WS_DNF_AB && WS_XB + (size_t)T * D * 2 <= WS_DNF_CD && (size_t)(TS / 256) * (D / 256) * NS_OUT * 65536 <= (size_t)T * D, "residual stream / slabs fit");
template <int WHICH> __device__ __forceinline__ void norm_row_tail(const P& p, int m, int lane, const f32x4 (&v)[4], const f32x4 (&nwv)[4], const LAS float* wbt, int& cbc, f32x4 (&scv)[4], f32x4 (&shv)[4], float nalog, float dtb) {
    float ss = 0.f;
#pragma unroll
    for (int j = 0; j < 4; ++j) ss += (v[j][0] * v[j][0] + v[j][1] * v[j][1]) + (v[j][2] * v[j][2] + v[j][3] * v[j][3]);
    const float rstd = 1.0f / sqrtf(wave_sum(ss) * (1.0f / D) + EPS);
    if (WHICH == 2) {
#pragma unroll
        for (int j = 0; j < 4; ++j) ((f32x4*)(p.out + O_Y + (size_t)m * D))[lane + 64 * j] = v[j] * rstd * nwv[j];
        return;
    }
    const int cb = cb_of(m);
    if (cb != cbc) {
        const float* mod = ws_f(p, WS_MOD) + (size_t)cb * 6 * D;
        const float* sh = mod + (WHICH == 0 ? 0 : 3 * D); const float* sc = mod + (WHICH == 0 ? D : 4 * D);
#pragma unroll
        for (int j = 0; j < 4; ++j) { scv[j] = ((const f32x4*)sc)[lane + 64 * j] + 1.0f; shv[j] = ((const f32x4*)sh)[lane + 64 * j]; }
        cbc = cb;
    }
    float ba[8];
#pragma unroll
    for (int j = 0; j < 8; ++j) ba[j] = 0.f;
    unsigned long long* o8 = (unsigned long long*)(ws_h(p, WS_H) + (size_t)m * D);
#pragma unroll
    for (int j = 0; j < 4; ++j) {
        const f32x4 h = v[j] * rstd * nwv[j] * scv[j] + shv[j];
        o8[lane + 64 * j] = (unsigned long long)cvtpk_m(h[0], h[1]) | ((unsigned long long)cvtpk_m(h[2], h[3]) << 32);
        if (WHICH == 0) {
#pragma unroll
            for (int c = 0; c < 8; ++c) { const f32x4 w = *(const LAS f32x4*)(wbt + c * D + 4 * (lane + 64 * j)); ba[c] += (h[0] * w[0] + h[1] * w[1]) + (h[2] * w[2] + h[3] * w[3]); }
            asm volatile("" ::: "memory");
        }
    }
    if (WHICH == 0) {
        float t4[4], t2[2], t1;
        const bool h5 = lane & 32, h4 = lane & 16, h3 = lane & 8;
#pragma unroll
        for (int c = 0; c < 4; ++c) { const float snd = h5 ? ba[c] : ba[c + 4], kp = h5 ? ba[c + 4] : ba[c]; t4[c] = kp + __shfl_xor(snd, 32); }
#pragma unroll
        for (int c = 0; c < 2; ++c) { const float snd = h4 ? t4[c] : t4[c + 2], kp = h4 ? t4[c + 2] : t4[c]; t2[c] = kp + __shfl_xor(snd, 16); }
        { const float snd = h3 ? t2[0] : t2[1], kp = h3 ? t2[1] : t2[0]; t1 = kp + __shfl_xor(snd, 8); }
        t1 += __shfl_xor(t1, 4); t1 += __shfl_xor(t1, 2); t1 += __shfl_xor(t1, 1);
        if ((lane & 7) == 0) { const int c = lane >> 3; float* bg = ws_f(p, WS_BG) + (size_t)m * 8;
            bg[c] = c < 4 ? sigmoid_f(t1) : nalog * softplus_f(t1 + dtb); }
    }
}
template <int WHICH> __device__ __forceinline__ void phase_norm(const P& p, LAS unsigned char* lds) {
    static_assert(D == 1024, "one wave per 1024-element row");
    const int tid_ = otid(), lane = tid_ & 63, wave = tid_ >> 6;
    const int gw = blockIdx.x * NWAVES + wave, NGW = gridDim.x * NWAVES;
    const float* nwp = WHICH == 0 ? p.norm_mix_w : (WHICH == 1 ? p.norm_ffn_w : p.final_norm_w);
    f32x4 nwv[4];
#pragma unroll
    for (int j = 0; j < 4; ++j) nwv[j] = ((const f32x4*)nwp)[lane + 64 * j];
    const LAS float* wbt = (const LAS float*)lds;
    if (WHICH == 0) { for (int i = tid_; i < 8 * D / 4; i += NTHR) ((LAS f32x4*)lds)[i] = ((const f32x4*)ws_f(p, WS_WBAT))[i]; LDS_BARRIER(); }
    const bf16_t* XB = ws_h(p, WS_XB);
    int cbc = -1; f32x4 scv[4], shv[4];
    const float nalog = WHICH == 0 ? -expf(p.dn_A_log[(lane >> 3) & 3]) : 0.f, dtb = WHICH == 0 ? p.dn_dt_bias[(lane >> 3) & 3] : 0.f;
    constexpr int MEND = WHICH == 0 ? T : TP;
    typedef f32x4 rowbuf_t[4];
    rowbuf_t ra, rb, rc;
#define NR_LOAD(buf_, mm0_) do { const int mm_ = (mm0_) < MEND ? (mm0_) : MEND - 1; { if (WHICH == 0) { const float* xr_ = xrow(p, (mm_)); _Pragma("unroll") for (int j = 0; j < 4; ++j) buf_[j] = ((const f32x4*)xr_)[lane + 64 * j]; } \
        else { const u32x2* xr_ = (const u32x2*)(XB + (size_t)(mm_) * D); u32x2 w_[4]; _Pragma("unroll") for (int j = 0; j < 4; ++j) w_[j] = xr_[lane + 64 * j]; \
            buf_[0] = __builtin_bit_cast(f32x4, (u32x4){w_[0].x, w_[0].y, w_[1].x, w_[1].y}); buf_[1] = __builtin_bit_cast(f32x4, (u32x4){w_[2].x, w_[2].y, w_[3].x, w_[3].y}); } } } while (0)
#define NR_PROC(buf_, mm_) do { if ((mm_) < MEND) { f32x4 v_[4]; if (WHICH == 0) { _Pragma("unroll") for (int j = 0; j < 4; ++j) v_[j] = buf_[j]; } \
        else { const u32x4 a_ = __builtin_bit_cast(u32x4, buf_[0]), b_ = __builtin_bit_cast(u32x4, buf_[1]); const unsigned w_[8] = {a_.x, a_.y, a_.z, a_.w, b_.x, b_.y, b_.z, b_.w}; \
            _Pragma("unroll") for (int j = 0; j < 4; ++j) v_[j] = (f32x4){__builtin_bit_cast(float, w_[2 * j] << 16), __builtin_bit_cast(float, w_[2 * j] & 0xffff0000u), __builtin_bit_cast(float, w_[2 * j + 1] << 16), __builtin_bit_cast(float, w_[2 * j + 1] & 0xffff0000u)}; } \
        norm_row_tail<WHICH>(p, (mm_), lane, v_, nwv, wbt, cbc, scv, shv, nalog, dtb); } } while (0)
    NR_LOAD(ra, gw); NR_LOAD(rb, gw + NGW);
    for (int m = gw; m < MEND; m += 3 * NGW) {
        NR_LOAD(rc, m + 2 * NGW); NR_PROC(ra, m);
        NR_LOAD(ra, m + 3 * NGW); NR_PROC(rb, m + NGW);
        NR_LOAD(rb, m + 4 * NGW); NR_PROC(rc, m + 2 * NGW);
    }
#undef NR_LOAD
#undef NR_PROC
    if (WHICH != 0) {
        constexpr int NS = WHICH == 1 ? NS_OUT : NS_DN;
        const float* slabs = WHICH == 1 ? p.out + O_Y : ws_f(p, WS_SLAB_DN);
        for (int rs = gw; rs < TS; rs += NGW) { const int m = TP + rs, cbs = BATCH + (rs >> 3);
            const float* gt = ws_f(p, WS_MOD) + (size_t)cbs * 6 * D + (WHICH == 1 ? 2 * D : 5 * D);
            f32x4 vs[4];
#pragma unroll
            for (int j = 0; j < 4; ++j) { const float* sl = slabs + ((size_t)((rs >> 8) * 4 + j) * NS) * 65536 + (size_t)(rs & 255) * 256 + 4 * lane;
                f32x4 acc = (f32x4){0.f, 0.f, 0.f, 0.f};
#pragma unroll
                for (int ks = 0; ks < NS; ++ks) { acc += *(const f32x4*)sl; sl += 65536; asm volatile("" : "+v"(sl)); }
                f32x4 base;
                if (WHICH == 1) base = ((const f32x4*)(p.x_sample + (size_t)rs * D))[lane + 64 * j];
                else { const u32x2 w = ((const u32x2*)(XB + (size_t)m * D))[lane + 64 * j]; base = (f32x4){__builtin_bit_cast(float, w.x << 16), __builtin_bit_cast(float, w.x & 0xffff0000u), __builtin_bit_cast(float, w.y << 16), __builtin_bit_cast(float, w.y & 0xffff0000u)}; }
                vs[j] = base + ((const f32x4*)gt)[lane + 64 * j] * acc;
                if (WHICH == 1) ((u32x2*)(ws_h(p, WS_XB) + (size_t)m * D))[lane + 64 * j] = (u32x2){cvtpk_m(vs[j][0], vs[j][1]), cvtpk_m(vs[j][2], vs[j][3])};
                asm volatile("" ::: "memory"); }
            norm_row_tail<WHICH>(p, m, lane, vs, nwv, wbt, cbc, scv, shv, nalog, dtb);
        }
    }
}

constexpr long SO_1 = (long)BATCH * 3 * 1536 / 4, SO_2 = (long)DEC_BATCH * 3 * 1536 / 4, SO_3 = (long)BATCH * 128 * 128 / 4, SO_4 = (long)DEC_BATCH * 128 * 128 / 4, SO_N = SO_1 + SO_2 + 2 * (SO_3 + SO_4);
__device__ __forceinline__ void so_item(const P& p, long it, f32x4& val, float*& dst) {
    const bf16_t* PR = ws_h(p, WS_PROJ); const bf16_t* src = nullptr; const float* fsrc = nullptr;
    long r = it;
    if (r < SO_1) { const int b = (int)(r / (3 * 384)), j = (int)(r / 384 % 3), c = (int)(r % 384) * 4; src = PR + (size_t)(b * SEQ + SEQ - 3 + j) * PLD + PC_QKV + c; dst = p.out + O_PDC + r * 4; }
    else if ((r -= SO_1) < SO_2) { const int b = (int)(r / (3 * 384)), j = (int)(r / 384 % 3), c = (int)(r % 384) * 4; src = PR + (size_t)(TP + b * DEC_SEQ + DEC_SEQ - 3 + j) * PLD + PC_QKV + c; dst = p.out + O_SDC + r * 4; }
    else { r -= SO_2; const int kv = r >= SO_3 + SO_4; if (kv) r -= SO_3 + SO_4; const int pc = kv ? PC_SV : PC_SK; const float* cache = kv ? p.cache_v : p.cache_k;
        if (r < SO_3) { const int b = (int)(r / (128 * 32)), j = (int)(r / 32 % 128), c = (int)(r % 32) * 4; src = PR + (size_t)(b * SEQ + SEQ - 128 + j) * PLD + pc + c; dst = p.out + (kv ? O_PV : O_PK) + r * 4; }
        else { r -= SO_3; const int b = (int)(r / (128 * 32)), j = (int)(r / 32 % 128), c = (int)(r % 32) * 4; dst = p.out + (kv ? O_SV : O_SK) + r * 4;
            if (j < 128 - DEC_SEQ) fsrc = cache + ((size_t)b * 128 + j + DEC_SEQ) * 128 + c; else src = PR + (size_t)(TP + b * DEC_SEQ + (j - (128 - DEC_SEQ))) * PLD + pc + c; } }
    if (fsrc) val = *(const f32x4*)fsrc;
    else { const u32x2 w = *(const u32x2*)src; val = (f32x4){__builtin_bit_cast(float, w.x << 16), __builtin_bit_cast(float, w.x & 0xffff0000u), __builtin_bit_cast(float, w.y << 16), __builtin_bit_cast(float, w.y & 0xffff0000u)}; }
}
__device__ __forceinline__ void phase_state_out(const P& p) {
    const long gt = blockIdx.x * (long)NTHR + otid(), gs = (long)gridDim.x * NTHR;
    for (long it = gt; it < SO_N; it += 4 * gs) {
        f32x4 v[4]; float* d[4];
#pragma unroll
        for (int u = 0; u < 4; ++u) if (it + u * gs < SO_N) so_item(p, it + u * gs, v[u], d[u]);
#pragma unroll
        for (int u = 0; u < 4; ++u) if (it + u * gs < SO_N) *(f32x4*)d[u] = v[u];
    }
}
#define XB_TMO      128
#define XB_XCNT(j)  (256  + 64 * (j))
#define XB_XSUB(j)  (1280 + 64 * (j))
#define XB_XGEN(j)  (2304 + 64 * (j))
#define XB_TOP      3328
#define XB_TOPGEN   3392
#define XCD_BAR_WORDS 3456
#define XB_SPIN_CAP (1u << 18)

__device__ __forceinline__ unsigned xb_ld(unsigned* p)              { return __hip_atomic_load(p, __ATOMIC_RELAXED, __HIP_MEMORY_SCOPE_AGENT); }
__device__ __forceinline__ unsigned xb_add(unsigned* p, unsigned v) { return __hip_atomic_fetch_add(p, v, __ATOMIC_RELAXED, __HIP_MEMORY_SCOPE_AGENT); }
__device__ __forceinline__ unsigned xb_xcc_id() { return (unsigned)__builtin_amdgcn_s_getreg((3 << 11) | 20) & 0xFu; }
#define XB_SPIN(cond, bar) do { unsigned _sp = 0; while (cond) { __builtin_amdgcn_s_sleep(1); \
    if ((++_sp & 255u) == 0u) { if (xb_ld(&(bar)[XB_TMO])) break; if (_sp > XB_SPIN_CAP) { atomicAdd(&(bar)[XB_TMO], 1u); break; } } } } while (0)

struct XcdBarrier {
    unsigned* bar; unsigned x;
    volatile LAS unsigned* st;
};

__device__ __forceinline__ XcdBarrier xcd_barrier_post(unsigned* bar, volatile LAS unsigned* st) {
    XcdBarrier b; b.bar = bar; b.x = xb_xcc_id(); b.st = st;
    if (threadIdx.x == 0) (void)xb_add(&bar[XB_XCNT(b.x)], 1u);
    return b;
}
__device__ __forceinline__ void xcd_barrier_complete(unsigned* bar, unsigned x, unsigned& nloc, unsigned& nx) {
    const unsigned G = gridDim.x * gridDim.y * gridDim.z;
    unsigned sum, cnt, mine, sp = 0u;
    for (;;) {
        sum = 0u; cnt = 0u; mine = 0u;
#pragma unroll
        for (unsigned j = 0; j < 16; ++j) { const unsigned c = xb_ld(&bar[XB_XCNT(j)]); sum += c; cnt += (c > 0u) ? 1u : 0u; mine = (j == x) ? c : mine; }
        if (sum == G) break;
        __builtin_amdgcn_s_sleep(1);
        if ((++sp & 255u) == 0u) { if (xb_ld(&bar[XB_TMO])) break; if (sp > XB_SPIN_CAP) { atomicAdd(&bar[XB_TMO], 1u); break; } }
    }
    nloc = mine > 0u ? mine : 1u; nx = cnt > 0u ? cnt : 1u;
}

__device__ __forceinline__ void xcd_barrier(const XcdBarrier& b) {
    asm volatile("s_waitcnt vmcnt(0)" ::: "memory");
    __syncthreads();
    if (threadIdx.x == 0) {
        unsigned* bar = b.bar;
        __builtin_amdgcn_s_waitcnt(0);
        unsigned nloc = b.st[0], nx = b.st[1];
        if (nloc == 0u) { xcd_barrier_complete(bar, b.x, nloc, nx); b.st[0] = nloc; b.st[1] = nx; }
        const unsigned old = xb_add(&bar[XB_XSUB(b.x)], 1u);
        const unsigned gen = old / nloc;
        if (old + 1u == (gen + 1u) * nloc) {
            __builtin_amdgcn_fence(__ATOMIC_RELEASE, "agent");
            asm volatile("s_waitcnt vmcnt(0)" ::: "memory");
            const unsigned og = xb_add(&bar[XB_TOP], 1u);
            const unsigned tg = og / nx;
            if (og + 1u == (tg + 1u) * nx) xb_add(&bar[XB_TOPGEN], 1u);
            else XB_SPIN(xb_ld(&bar[XB_TOPGEN]) == tg, bar);
            __builtin_amdgcn_fence(__ATOMIC_ACQUIRE, "agent");
            xb_add(&bar[XB_XGEN(b.x)], 1u);
            asm volatile("s_waitcnt vmcnt(0)" ::: "memory");
        } else {
            XB_SPIN(xb_ld(&bar[XB_XGEN(b.x)]) == gen, bar);
            __builtin_amdgcn_fence(__ATOMIC_ACQUIRE, "agent");
            asm volatile("s_waitcnt vmcnt(0)" ::: "memory");
        }
    }
    __syncthreads();
}
namespace pg8 {
#define PG8_LAS __attribute__((address_space(3)))
typedef unsigned short bf16_t;
typedef short bf16x8 __attribute__((ext_vector_type(8)));
typedef float f32x4 __attribute__((ext_vector_type(4)));
typedef unsigned u32x4 __attribute__((ext_vector_type(4)));
constexpr int BM = 256, BK = 64, HALF = 128, HTB = HALF * BK * 2  , STAGE_BYTES = 8 * HTB, NXCD = 8, WGM = 8;

__host__ __device__ __forceinline__ int lds_byte(int r, int c) { const int st = (r >> 4) * 2 + (c >> 5), rr = r & 15, cc = c & 31, ob = rr * 64 + cc * 2; return st * 1024 + (ob ^ (((ob >> 9) & 1) << 5)); }
__host__ __device__ __forceinline__ void stage_rc(int b, int& R, int& C) { const int st = b / 1024, sb = b % 1024, swz = sb ^ (((sb >> 9) & 1) << 5); R = (st >> 1) * 16 + swz / 64; C = (st & 1) * 32 + (swz % 64) / 2; }
__host__ __device__ __forceinline__ int perm32(int rho) { const int n = rho >> 4, i = rho & 15; return 8 * (i >> 2) + 4 * n + (i & 3); }

struct Unit { int pm, pn, k0, nt, atomic; };
struct Gemm { const bf16_t* A; const bf16_t* Bt; int M, N, K; };

struct StaticOrder {
    int nM, nN, nwg, G, c, ntk;
    __host__ __device__ void init(int M, int N, int G_, int c_, int K_) { nM = M / BM; nN = N / BM; nwg = nM * nN; G = G_; c = c_; ntk = K_ / BK; }
    __host__ __device__ bool next(int i, Unit& u) const {
        const long L = (long)i * G + c; if (L >= nwg) return false;
        int wgid = (int)L; { const int q = nwg / NXCD, r = nwg % NXCD, xcd = wgid % NXCD, off = wgid / NXCD; wgid = (xcd < r ? xcd * (q + 1) : r * (q + 1) + (xcd - r) * q) + off; }
        const int nig = WGM * nN, gid = wgid / nig, fm = gid * WGM, gsz = (nM - fm) < WGM ? (nM - fm) : WGM;
        u.pm = fm + ((wgid % nig) % gsz); u.pn = (wgid % nig) / gsz; u.k0 = 0; u.nt = ntk; u.atomic = 0; return true;
    }
    __device__ __forceinline__ void a_ready(const Unit&) const {}
    __device__ __forceinline__ void done(const Unit&) const {}
};

struct SplitOrder {
    StaticOrder so; int nu1, ns, ntk_sub, npn, nsub, G, c;
    __device__ void init(int N, int K, int NS, int G_, int c_) { so.init(TP, N, G_, c_, K); nu1 = so.nwg; ns = NS; ntk_sub = K / BK / NS; npn = N / BM; nsub = (TS / BM) * npn * NS; G = G_; c = c_; }
    __device__ bool next(int i, Unit& u) const {
        const long L = (long)i * G + c; if (L < nu1) return so.next(i, u);
        const int s = (int)(L - nu1); if (s >= nsub) return false;
        const int ks = s % ns, t = s / ns; u.pm = TP / BM + t / npn; u.pn = t % npn; u.k0 = ks * ntk_sub * BK; u.nt = ntk_sub; u.atomic = 1; return true; }
    __device__ __forceinline__ void a_ready(const Unit&) const {}
    __device__ __forceinline__ void done(const Unit&) const {}
};
__device__ __forceinline__ unsigned cvt_pk_bf16(float lo, float hi) { unsigned r; asm volatile("v_cvt_pk_bf16_f32 %0, %1, %2" : "=v"(r) : "v"(lo), "v"(hi)); return r; }
struct EpiStoreBf16 {
    static constexpr bool PERM = true, AFTER_DRAIN = false;
    bf16_t* O; int ldc;
    __device__ __forceinline__ void operator()(const f32x4 (&acc)[2][2][4][2], const Unit& u, int wr, int wc, int fr, int fq) const {
        const int row0 = u.pm * BM + wr * 64 + fr, col0 = u.pn * BM + wc * 32 + 8 * fq;
#pragma unroll
        for (int ai = 0; ai < 2; ++ai)
#pragma unroll
            for (int m = 0; m < 4; ++m) { bf16_t* rowp = O + (size_t)(row0 + ai * HALF + m * 16) * ldc + col0;
#pragma unroll
                for (int bj = 0; bj < 2; ++bj) { const f32x4 v0 = acc[ai][bj][m][0], v1 = acc[ai][bj][m][1];
                    u32x4 w; w.x = cvt_pk_bf16(v0[0], v0[1]); w.y = cvt_pk_bf16(v0[2], v0[3]); w.z = cvt_pk_bf16(v1[0], v1[1]); w.w = cvt_pk_bf16(v1[2], v1[3]);
                    *(u32x4*)(rowp + bj * HALF) = w; } }
    }
};
template <int MODE> struct EpiGateRes {
    static constexpr bool PERM = false, AFTER_DRAIN = false;
    const float* base_p; const float* base_s; bf16_t* xb; const float* gate; float* slab; int ns;
    __device__ __forceinline__ void operator()(const f32x4 (&acc)[2][2][4][2], const Unit& u, int wr, int wc, int fr, int fq) const {
        typedef unsigned u32x2e __attribute__((ext_vector_type(2)));
        const int row0 = u.pm * BM + wr * 64 + fr, col0 = u.pn * BM + wc * 32 + 4 * fq;
        const bool smp = row0 >= TP; const float* base = smp ? base_s - (size_t)TP * D : base_p;
#pragma unroll
        for (int ai = 0; ai < 2; ++ai)
#pragma unroll
            for (int m = 0; m < 4; ++m) { const int r = row0 + ai * HALF + m * 16; const int cb = smp ? BATCH + ((r - TP) >> 3) : r / SEQ;
                const float* gp = gate + (size_t)cb * 6 * D + col0; const size_t off = (size_t)r * D + col0;
#pragma unroll
                for (int bj = 0; bj < 2; ++bj)
#pragma unroll
                    for (int n = 0; n < 2; ++n) {
                        if (u.atomic) { const int sidx = ((u.pm - TP / BM) * (D / BM) + u.pn) * ns + u.k0 / (u.nt * BK);
                            *(f32x4*)(slab + (size_t)sidx * 65536 + (size_t)(r - u.pm * BM) * 256 + (col0 - u.pn * BM) + bj * HALF + n * 16) = acc[ai][bj][m][n]; }
                        else { const f32x4 gv = *(const f32x4*)(gp + bj * HALF + n * 16); f32x4 bs;
                            if (MODE == 0) bs = *(const f32x4*)(base + off + bj * HALF + n * 16);
                            else { const u32x2e w = *(const u32x2e*)(xb + off + bj * HALF + n * 16); bs = (f32x4){__builtin_bit_cast(float, w.x << 16), __builtin_bit_cast(float, w.x & 0xffff0000u), __builtin_bit_cast(float, w.y << 16), __builtin_bit_cast(float, w.y & 0xffff0000u)}; }
                            const f32x4 v = bs + gv * acc[ai][bj][m][n];
                            *(u32x2e*)(xb + off + bj * HALF + n * 16) = (u32x2e){cvt_pk_bf16(v[0], v[1]), cvt_pk_bf16(v[2], v[3])}; } } }
    }
};
template <class Epi, class Sched, bool ALIGN_EPI = false, bool SP2 = false>
__device__ __forceinline__ void gemm_phase(PG8_LAS unsigned char* lds, const Gemm g, const Sched& S, const Epi& E) {
    const int tid = otid(), wid = __builtin_amdgcn_readfirstlane(tid >> 6), lane = tid & 63, wr = wid >> 2, wc = wid & 3, fr = lane & 15, fq = lane >> 4;
    const int K = g.K;
    unsigned voffA[2], voffB[2];
#pragma unroll
    for (int i = 0; i < 2; ++i) { int R, C; stage_rc(tid * 16 + i * 8192, R, C); const int Rb = Epi::PERM ? ((R & ~31) + perm32(R & 31)) : R;
        voffA[i] = (unsigned)(R * K + C) * 2u; voffB[i] = (unsigned)(Rb * K + C) * 2u; }
    const size_t kstep = (size_t)(BK * 2);
    const size_t hstep = (size_t)HALF * K * 2;
    const size_t tstep = 2 * hstep;
    const unsigned ldsw = (unsigned)wid * 1024u;
    const int aoff = lds_byte(wr * 64 + fr, fq * 8), boff = lds_byte(wc * 32 + fr, fq * 8);
#define PG8_SA(b, h) (((b) * 2 + (h)) * HTB)
#define PG8_SB(b, h) ((4 + (b) * 2 + (h)) * HTB)
#define PG8_STAGE(bufoff, gbase, voff) do { _Pragma("unroll") for (int _i = 0; _i < 2; ++_i) \
        __builtin_amdgcn_global_load_lds((const unsigned*)((const char*)(gbase) + (voff)[_i]), (PG8_LAS unsigned*)(lds + (bufoff) + ldsw + _i * 8192), 16, 0, 0); } while (0)
#define PG8_LDA(dst, b, h) do { _Pragma("unroll") for (int m = 0; m < 4; ++m) _Pragma("unroll") for (int k = 0; k < 2; ++k) dst[m][k] = *(const PG8_LAS bf16x8*)(lds + PG8_SA(b, h) + aoff + m * 2048 + k * 1024); } while (0)
#define PG8_LDB(dst, b, h) do { _Pragma("unroll") for (int n = 0; n < 2; ++n) _Pragma("unroll") for (int k = 0; k < 2; ++k) dst[n][k] = *(const PG8_LAS bf16x8*)(lds + PG8_SB(b, h) + boff + n * 2048 + k * 1024); } while (0)
#define PG8_MMA(ai, bj, At, Bt) do { __builtin_amdgcn_s_setprio(1); _Pragma("unroll") for (int m = 0; m < 4; ++m) _Pragma("unroll") for (int n = 0; n < 2; ++n) _Pragma("unroll") for (int k = 0; k < 2; ++k) \
        acc[ai][bj][m][n] = __builtin_amdgcn_mfma_f32_16x16x32_bf16(Bt[n][k], At[m][k], acc[ai][bj][m][n], 0, 0, 0); __builtin_amdgcn_s_setprio(0); } while (0)
#define PG8_WAIT_V(n) asm volatile("s_waitcnt vmcnt(" #n ")" ::: "memory")
#define PG8_WAIT_L(n) asm volatile("s_waitcnt lgkmcnt(" #n ")" ::: "memory")
#define PG8_BAR __builtin_amdgcn_s_barrier()
#define PG8_SCHED __builtin_amdgcn_sched_barrier(0)
    Unit cur, nxt; int ui = 0;
    if (!S.next(0, cur)) return;
    f32x4 acc[2][2][4][2];
#pragma unroll
    for (int a = 0; a < 2; ++a)
#pragma unroll
        for (int b = 0; b < 2; ++b)
#pragma unroll
            for (int m = 0; m < 4; ++m)
#pragma unroll
                for (int n = 0; n < 2; ++n) acc[a][b][m][n] = (f32x4){0.f, 0.f, 0.f, 0.f};
    bf16x8 At[4][2], B0[2][2], B1[2][2];
    const char* cA = (const char*)g.A + (size_t)cur.pm * tstep + (size_t)cur.k0 * 2; const char* cB = (const char*)g.Bt + (size_t)cur.pn * tstep + (size_t)cur.k0 * 2;
    S.a_ready(cur);
    if constexpr (SP2) {
        PG8_STAGE(PG8_SB(0, 0), cB, voffB); PG8_STAGE(PG8_SB(0, 1), cB + hstep, voffB); PG8_STAGE(PG8_SA(0, 0), cA, voffA); PG8_STAGE(PG8_SA(0, 1), cA + hstep, voffA);
        if (wr == 1) PG8_BAR;
        PG8_WAIT_V(2); PG8_BAR;
        PG8_STAGE(PG8_SB(1, 0), cB + kstep, voffB); PG8_STAGE(PG8_SA(1, 0), cA + kstep, voffA); PG8_STAGE(PG8_SB(1, 1), cB + hstep + kstep, voffB);
        PG8_WAIT_V(6); PG8_BAR;
    } else {
        PG8_STAGE(PG8_SB(0, 0), cB, voffB); PG8_STAGE(PG8_SA(0, 0), cA, voffA); PG8_STAGE(PG8_SB(0, 1), cB + hstep, voffB); PG8_STAGE(PG8_SA(0, 1), cA + hstep, voffA);
        if (wr == 1) PG8_BAR;
        PG8_WAIT_V(4); PG8_BAR;
        PG8_STAGE(PG8_SB(1, 0), cB + kstep, voffB); PG8_STAGE(PG8_SA(1, 0), cA + kstep, voffA); PG8_STAGE(PG8_SB(1, 1), cB + hstep + kstep, voffB);
        PG8_WAIT_V(6); PG8_BAR;
    }
    for (;;) {
        const bool has_next = S.next(ui + 1, nxt);
        const char* nA = has_next ? (const char*)g.A + (size_t)nxt.pm * tstep + (size_t)nxt.k0 * 2 : cA; const char* nB = has_next ? (const char*)g.Bt + (size_t)nxt.pn * tstep + (size_t)nxt.k0 * 2 : cB;
        const int nt = cur.nt;
        for (int t = 0; t < nt; t += 2) {
            const bool last = (t == nt - 2);
            const char* a1 = cA + (size_t)(t + 1) * kstep;
            const char* a2 = last ? nA : cA + (size_t)(t + 2) * kstep; const char* b2 = last ? nB : cB + (size_t)(t + 2) * kstep;
            const char* a3 = a2 + kstep; const char* b3 = b2 + kstep;
            if (last && has_next) S.a_ready(nxt);
            if constexpr (SP2) {
            PG8_LDB(B0, 0, 0); PG8_LDB(B1, 0, 1); PG8_SCHED; PG8_LDA(At, 0, 0); PG8_STAGE(PG8_SA(1, 1), a1 + hstep, voffA);
            PG8_WAIT_V(8); PG8_WAIT_L(0); PG8_BAR; PG8_MMA(0, 0, At, B0); PG8_MMA(0, 1, At, B1); PG8_BAR; PG8_SCHED;
            PG8_LDA(At, 0, 1); PG8_STAGE(PG8_SB(0, 0), b2, voffB); PG8_STAGE(PG8_SB(0, 1), b2 + hstep, voffB); PG8_STAGE(PG8_SA(0, 0), a2, voffA);
            PG8_WAIT_V(8); PG8_WAIT_L(0); PG8_BAR; PG8_MMA(1, 0, At, B0); PG8_MMA(1, 1, At, B1); PG8_BAR; PG8_SCHED;
            PG8_LDB(B0, 1, 0); PG8_LDB(B1, 1, 1); PG8_SCHED; PG8_LDA(At, 1, 0); PG8_STAGE(PG8_SA(0, 1), a2 + hstep, voffA);
            PG8_WAIT_V(8); PG8_WAIT_L(0); PG8_BAR; PG8_MMA(0, 0, At, B0); PG8_MMA(0, 1, At, B1); PG8_BAR; PG8_SCHED;
            PG8_LDA(At, 1, 1); PG8_STAGE(PG8_SB(1, 0), b3, voffB); PG8_STAGE(PG8_SB(1, 1), b3 + hstep, voffB); PG8_STAGE(PG8_SA(1, 0), a3, voffA);
            PG8_WAIT_V(8); PG8_WAIT_L(0); PG8_BAR; PG8_MMA(1, 0, At, B0); PG8_MMA(1, 1, At, B1); PG8_BAR; PG8_SCHED;
            } else {
            PG8_LDB(B0, 0, 0); PG8_SCHED; PG8_LDA(At, 0, 0); PG8_STAGE(PG8_SA(1, 1), a1 + hstep, voffA);
            PG8_WAIT_L(8); PG8_BAR; PG8_WAIT_L(0); PG8_MMA(0, 0, At, B0); PG8_BAR; PG8_SCHED;
            PG8_LDB(B1, 0, 1); PG8_STAGE(PG8_SB(0, 0), b2, voffB);
            PG8_BAR; PG8_WAIT_L(0); PG8_MMA(0, 1, At, B1); PG8_BAR;
            PG8_LDA(At, 0, 1); PG8_STAGE(PG8_SA(0, 0), a2, voffA);
            PG8_BAR; PG8_WAIT_L(0); PG8_MMA(1, 0, At, B0); PG8_BAR; PG8_SCHED;
            PG8_STAGE(PG8_SB(0, 1), b2 + hstep, voffB);
            PG8_WAIT_V(6); PG8_BAR; PG8_MMA(1, 1, At, B1); PG8_BAR;
            PG8_LDB(B0, 1, 0); PG8_SCHED; PG8_LDA(At, 1, 0); PG8_STAGE(PG8_SA(0, 1), a2 + hstep, voffA);
            PG8_WAIT_L(8); PG8_BAR; PG8_WAIT_L(0); PG8_MMA(0, 0, At, B0); PG8_BAR; PG8_SCHED;
            PG8_LDB(B1, 1, 1); PG8_STAGE(PG8_SB(1, 0), b3, voffB);
            PG8_BAR; PG8_WAIT_L(0); PG8_MMA(0, 1, At, B1); PG8_BAR;
            PG8_LDA(At, 1, 1); PG8_STAGE(PG8_SA(1, 0), a3, voffA);
            PG8_BAR; PG8_WAIT_L(0); PG8_MMA(1, 0, At, B0); PG8_BAR; PG8_SCHED;
            PG8_STAGE(PG8_SB(1, 1), b3 + hstep, voffB);
            PG8_WAIT_V(6); PG8_BAR; PG8_MMA(1, 1, At, B1); PG8_BAR;
            }
        }
        if constexpr (ALIGN_EPI) { if (wr == 0) PG8_BAR; }
        if constexpr (!Epi::AFTER_DRAIN) { E(acc, cur, wr, wc, fr, fq); S.done(cur); }
        if (!has_next) break;
#pragma unroll
        for (int a = 0; a < 2; ++a)
#pragma unroll
            for (int b = 0; b < 2; ++b)
#pragma unroll
                for (int m = 0; m < 4; ++m)
#pragma unroll
                    for (int n = 0; n < 2; ++n) acc[a][b][m][n] = (f32x4){0.f, 0.f, 0.f, 0.f};
        cur = nxt; cA = nA; cB = nB; ++ui;
        if constexpr (ALIGN_EPI) { if (wr == 1) PG8_BAR; }
    }
    PG8_WAIT_V(0);
    if constexpr (!ALIGN_EPI) { if (wr == 0) PG8_BAR; }
    PG8_BAR;
    if constexpr (Epi::AFTER_DRAIN) { E.fused(acc, cur, wr, wc, fr, fq, lds, wid, lane); S.done(cur); }
#undef PG8_SA
#undef PG8_SB
#undef PG8_STAGE
#undef PG8_LDA
#undef PG8_LDB
#undef PG8_MMA
#undef PG8_WAIT_V
#undef PG8_WAIT_L
#undef PG8_BAR
#undef PG8_SCHED
}
}
typedef short bf16x8 __attribute__((ext_vector_type(8)));
constexpr int FR_NWK = 0, FR_QD = 16, FR_KTT = 32, FR_QK = 48, FR_N = 56;
__device__ __forceinline__ int kperm(int g, int j) { return j < 4 ? 4 * g + j : 16 + 4 * g + (j - 4); }

typedef float f32x2_t __attribute__((ext_vector_type(2))); typedef __bf16 bf16x2_t __attribute__((ext_vector_type(2)));
__device__ __forceinline__ unsigned cvtpk_c(float lo, float hi) { const f32x2_t v = {lo, hi}; const bf16x2_t b = __builtin_convertvector(v, bf16x2_t); return __builtin_bit_cast(unsigned, b); }
__device__ __forceinline__ bf16x8 pack8(const f32x4 a, const f32x4 b) {
    return __builtin_bit_cast(bf16x8, (u32x4){cvtpk_c(a[0], a[1]), cvtpk_c(a[2], a[3]), cvtpk_c(b[0], b[1]), cvtpk_c(b[2], b[3])});
}
constexpr int DP_KP = 136;
constexpr int DP_RP = 72;
constexpr int DP_QS = 0, DP_KS = DP_QS + 64 * DP_KP * 2, DP_RHST = DP_KS + 64 * DP_KP * 2, DP_AM = DP_RHST + 256 * DP_RP * 2, DP_AMP = 68,
              DP_QKM = DP_AM + 64 * DP_AMP * 4, DP_QKP = 72, DP_GS = DP_QKM + 64 * DP_QKP * 2, DP_DM = DP_GS + 4 * 64 * 4, DP_DMP = 20,
              DP_TB = DP_DM + 64 * DP_DMP * 4, DP_END = DP_TB + 64 * DP_RP * 2;
static_assert(DP_END <= 131072 && DP_AM % 16 == 0 && DP_DM % 16 == 0 && DP_TB % 16 == 0 && DP_RHST % 16 == 0, "dnprep LDS");
#ifndef DPS
#define DPS(k)
#endif
__device__ __forceinline__ void phase_dnprep(const P& p, LAS unsigned char* lds, unsigned long long& pr_prev, unsigned long long& pr_acc) {
    const int tid_ = otid();
    LAS bf16_t* QS = (LAS bf16_t*)(lds + DP_QS); LAS bf16_t* KS = (LAS bf16_t*)(lds + DP_KS); LAS bf16_t* RHST = (LAS bf16_t*)(lds + DP_RHST);
    LAS float* AM = (LAS float*)(lds + DP_AM); LAS bf16_t* QKM = (LAS bf16_t*)(lds + DP_QKM); LAS float* GS = (LAS float*)(lds + DP_GS);
    LAS float* DM = (LAS float*)(lds + DP_DM); LAS bf16_t* TB = (LAS bf16_t*)(lds + DP_TB);
    const bf16_t* PR = ws_h(p, WS_PROJ); const float* BG = ws_f(p, WS_BG);
    for (int i = tid_; i < 64 * DP_RP / 2; i += NTHR) ((LAS unsigned*)TB)[i] = 0u;
    float pgx = 0.f, pbx = 0.f, cw[3][4][2]; unsigned xr[3][11];
#define DP_FETCH(uid_, ln_, wv_) do { const int n_ = (uid_) % NCHUNK, bh_ = (uid_) / NCHUNK, h_ = bh_ & 3, m0_ = (bh_ >> 2) * SEQ + n_ * 64; \
        if ((wv_) == 0) { pgx = BG[(size_t)(m0_ + (ln_)) * 8 + 4 + h_]; pbx = BG[(size_t)(m0_ + (ln_)) * 8 + h_]; } \
        _Pragma("unroll") for (int part = 0; part < 3; ++part) _Pragma("unroll") for (int j = 0; j < 4; ++j) { const float* w = p.dn_conv_w + j * 1536 + part * 512 + h_ * 128 + 2 * (ln_); cw[part][j][0] = w[0]; cw[part][j][1] = w[1]; } \
        _Pragma("unroll") for (int rr = 0; rr < 11; ++rr) { const int t_ = n_ * 64 + (wv_) * 8 + rr - 3; \
            _Pragma("unroll") for (int part = 0; part < 3; ++part) { unsigned v_ = 0u; if (t_ >= 0) v_ = *(const unsigned*)(PR + (size_t)(m0_ + (wv_) * 8 + rr - 3) * PLD + part * 512 + h_ * 128 + 2 * (ln_)); xr[part][rr] = v_; } } } while (0)
    if ((int)blockIdx.x < NUNIT) { int t0 = tid_; asm volatile("" : "+v"(t0)); DP_FETCH((int)blockIdx.x, t0 & 63, t0 >> 6); }
    for (int uid = blockIdx.x; uid < NUNIT; uid += gridDim.x) {
        const int n = uid % NCHUNK;
        int tid = tid_; asm volatile("" : "+v"(tid));
        const int lane = tid & 63, wave = tid >> 6, r16 = lane & 15, g4 = lane >> 4;
        unsigned char* abu = p.ws + WS_DNF_AB + (size_t)uid * DNF_AB_UNIT;
        if (wave == 0) {
            float x = pgx;
#pragma unroll
            for (int o = 1; o < 64; o <<= 1) { const float t = __shfl_up(x, o); if (lane >= o) x += t; }
            const float gl = __shfl(x, 63);
            GS[lane] = x; GS[64 + lane] = pbx; GS[128 + lane] = __expf(x); GS[192 + lane] = __expf(gl - x);
            if (lane == 0) ws_f(p, WS_DNF_CD)[uid] = __expf(gl);
        }
        LDS_BARRIER();
        {
            float c[8][3][2], ssum[16];
#pragma unroll
            for (int i = 0; i < 8; ++i) {
#pragma unroll
                for (int part = 0; part < 3; ++part)
#pragma unroll
                    for (int e = 0; e < 2; ++e) { float a = 0.f;
#pragma unroll
                        for (int j = 0; j < 4; ++j) a += cw[part][j][e] * (e == 0 ? __builtin_bit_cast(float, xr[part][i + j] << 16) : __builtin_bit_cast(float, xr[part][i + j] & 0xffff0000u));
                        c[i][part][e] = a * __builtin_amdgcn_rcpf(1.0f + __expf(-a)); }
                ssum[2 * i] = c[i][0][0] * c[i][0][0] + c[i][0][1] * c[i][0][1]; ssum[2 * i + 1] = c[i][1][0] * c[i][1][0] + c[i][1][1] * c[i][1][1]; }
#pragma unroll
            for (int o = 1; o < 64; o <<= 1) {
#pragma unroll
                for (int q = 0; q < 16; ++q) ssum[q] += __shfl_xor(ssum[q], o); }
#pragma unroll
            for (int i = 0; i < 8; ++i) { const int row = wave * 8 + i;
                const float rq = 0.08838834764831845f * __builtin_amdgcn_rsqf(ssum[2 * i] + EPS), rk = __builtin_amdgcn_rsqf(ssum[2 * i + 1] + EPS);
                const float beta = GS[64 + row], eg = GS[128 + row];
                const float q0 = c[i][0][0] * rq, q1 = c[i][0][1] * rq, k0 = c[i][1][0] * rk, k1 = c[i][1][1] * rk;
                *(LAS unsigned*)(QS + row * DP_KP + 2 * lane) = pk2(q0, q1);
                *(LAS unsigned*)(KS + row * DP_KP + 2 * lane) = pk2(k0, k1);
                RHST[(2 * lane) * DP_RP + row] = f2bf(beta * c[i][2][0]); RHST[(2 * lane + 1) * DP_RP + row] = f2bf(beta * c[i][2][1]);
                RHST[(128 + 2 * lane) * DP_RP + row] = f2bf(beta * eg * k0); RHST[(128 + 2 * lane + 1) * DP_RP + row] = f2bf(beta * eg * k1); }
        }
        if (uid + (int)gridDim.x < NUNIT) DP_FETCH(uid + (int)gridDim.x, lane, wave);
        LDS_BARRIER(); DPS(16);
        {
            const int ti = wave >> 1;
            f32x4 akk[2], aqk[2];
#pragma unroll
            for (int c = 0; c < 2; ++c) { akk[c] = (f32x4){0.f, 0.f, 0.f, 0.f}; aqk[c] = (f32x4){0.f, 0.f, 0.f, 0.f}; }
#pragma unroll
            for (int kb = 0; kb < 4; ++kb) {
                const bf16x8 ak = *(const LAS bf16x8*)(KS + (16 * ti + r16) * DP_KP + 32 * kb + 8 * g4), aq = *(const LAS bf16x8*)(QS + (16 * ti + r16) * DP_KP + 32 * kb + 8 * g4);
#pragma unroll
                for (int c = 0; c < 2; ++c) { const int tj = 2 * (wave & 1) + c; const bf16x8 bk = *(const LAS bf16x8*)(KS + (16 * tj + r16) * DP_KP + 32 * kb + 8 * g4);
                    akk[c] = __builtin_amdgcn_mfma_f32_16x16x32_bf16(ak, bk, akk[c], 0, 0, 0); aqk[c] = __builtin_amdgcn_mfma_f32_16x16x32_bf16(aq, bk, aqk[c], 0, 0, 0); }
            }
#pragma unroll
            for (int c = 0; c < 2; ++c) { const int tj = 2 * (wave & 1) + c, J = 16 * tj + r16; const float gj = GS[J];
#pragma unroll
                for (int i = 0; i < 4; ++i) { const int I = 16 * ti + 4 * g4 + i; const float dec = I >= J ? __expf(GS[I] - gj) : 0.f;
                    AM[I * DP_AMP + J] = I > J ? GS[64 + I] * akk[c][i] * dec : 0.f; QKM[I * DP_QKP + J] = f2bf(aqk[c][i] * dec); } }
        }
        LDS_BARRIER(); DPS(17);
        if (wave == 0) {
            const int bb = g4, cc = r16; float t[16];
            f32x4 tr[16][4];
#pragma unroll
            for (int i = 1; i < 16; ++i)
#pragma unroll
                for (int j4 = 0; j4 < (i + 3) / 4; ++j4) tr[i][j4] = *(const LAS f32x4*)(AM + (16 * bb + i) * DP_AMP + 16 * bb + 4 * j4);
            __builtin_amdgcn_sched_barrier(0);
#pragma unroll
            for (int i = 0; i < 16; ++i) { float acc = (i == cc) ? 1.f : 0.f;
#pragma unroll
                for (int j = 0; j < i; ++j) acc -= tr[i][j >> 2][j & 3] * t[j];
                t[i] = acc; }
#pragma unroll
            for (int i = 0; i < 16; ++i) { DM[(16 * bb + i) * DP_DMP + cc] = t[i]; TB[(16 * bb + i) * DP_RP + 16 * bb + cc] = f2bf(t[i]); }
        } else if (wave >= 4) {
            for (int f = FR_QD + (wave - 4); f < FR_N; f += 4) {
                u32x4 o;
                if (f < FR_KTT) { const int mt = (f - FR_QD) >> 2, kb = (f - FR_QD) & 3, row = 16 * mt + r16; const float sc = GS[128 + row];
                    const u32x2 lo = *(const LAS u32x2*)(QS + row * DP_KP + 32 * kb + 4 * g4), hi = *(const LAS u32x2*)(QS + row * DP_KP + 32 * kb + 16 + 4 * g4);
                    const unsigned w[4] = {lo.x, lo.y, hi.x, hi.y}; unsigned r[4];
#pragma unroll
                    for (int e = 0; e < 4; ++e) r[e] = cvtpk_c(__builtin_bit_cast(float, w[e] << 16) * sc, __builtin_bit_cast(float, w[e] & 0xffff0000u) * sc);
                    o = (u32x4){r[0], r[1], r[2], r[3]};
                } else if (f < FR_QK) { const int kt = (f - FR_KTT) >> 1, tb = (f - FR_KTT) & 1; float v[8];
#pragma unroll
                    for (int j = 0; j < 8; ++j) { const int tok = 32 * tb + kperm(g4, j); v[j] = bf2f(KS[tok * DP_KP + 16 * kt + r16]) * GS[192 + tok]; }
                    o = (u32x4){cvtpk_c(v[0], v[1]), cvtpk_c(v[2], v[3]), cvtpk_c(v[4], v[5]), cvtpk_c(v[6], v[7])};
                } else { const int mt = (f - FR_QK) >> 1, tb = (f - FR_QK) & 1, row = 16 * mt + r16;
                    const u32x2 lo = *(const LAS u32x2*)(QKM + row * DP_QKP + 32 * tb + 4 * g4), hi = *(const LAS u32x2*)(QKM + row * DP_QKP + 32 * tb + 16 + 4 * g4);
                    o = (u32x4){lo.x, lo.y, hi.x, hi.y}; }
                *(u32x4*)(abu + (size_t)f * 1024 + lane * 16) = o;
            }
        }
        LDS_BARRIER(); DPS(18);
        if (wave < 3) {
            const int j = wave; f32x4 Tk[4];
#pragma unroll
            for (int kk = 0; kk < 4; ++kk) Tk[j][kk] = DM[(16 * j + 4 * g4 + kk) * DP_DMP + r16];
#pragma unroll
            for (int i = 1; i < 4; ++i) if (i > j) {
                f32x4 acc = (f32x4){0.f, 0.f, 0.f, 0.f};
#pragma unroll
                for (int k = 0; k < 3; ++k) if (k >= j && k < i) { const f32x4 a = *(const LAS f32x4*)(AM + (16 * i + r16) * DP_AMP + 16 * k + 4 * g4);
#pragma unroll
                    for (int kk = 0; kk < 4; ++kk) acc = __builtin_amdgcn_mfma_f32_16x16x4f32(a[kk], Tk[k][kk], acc, 0, 0, 0); }
                const f32x4 dd = *(const LAS f32x4*)(DM + (16 * i + r16) * DP_DMP + 4 * g4);
                f32x4 res = (f32x4){0.f, 0.f, 0.f, 0.f};
#pragma unroll
                for (int kk = 0; kk < 4; ++kk) res = __builtin_amdgcn_mfma_f32_16x16x4f32(dd[kk], acc[kk], res, 0, 0, 0);
                Tk[i] = -res;
#pragma unroll
                for (int e = 0; e < 4; ++e) TB[(16 * i + 4 * g4 + e) * DP_RP + 16 * j + r16] = f2bf(Tk[i][e]); }
        }
        LDS_BARRIER(); DPS(19);
        {
            const int mt = wave & 3, half = wave >> 2;
            bf16x8 tf[2];
#pragma unroll
            for (int kb = 0; kb < 2; ++kb) tf[kb] = *(const LAS bf16x8*)(TB + (16 * mt + r16) * DP_RP + 32 * kb + 8 * g4);
            if (half == 0) {
                float* wv = (float*)(p.ws + WS_DNF_WV + (size_t)uid * DNF_WV_UNIT) + (size_t)mt * 256 + lane * 4;
#pragma unroll
                for (int vt = 0; vt < 8; ++vt) { f32x4 acc = (f32x4){0.f, 0.f, 0.f, 0.f};
#pragma unroll
                    for (int kb = 0; kb < 2; ++kb) acc = __builtin_amdgcn_mfma_f32_16x16x32_bf16(tf[kb], *(const LAS bf16x8*)(RHST + (16 * vt + r16) * DP_RP + 32 * kb + 8 * g4), acc, 0, 0, 0);
                    *(f32x4*)(wv + (size_t)vt * 1024) = acc; }
            } else {
#pragma unroll
                for (int kbp = 0; kbp < 4; ++kbp) { f32x4 xt[2];
#pragma unroll
                    for (int c2 = 0; c2 < 2; ++c2) { xt[c2] = (f32x4){0.f, 0.f, 0.f, 0.f};
#pragma unroll
                        for (int kb = 0; kb < 2; ++kb) xt[c2] = __builtin_amdgcn_mfma_f32_16x16x32_bf16(*(const LAS bf16x8*)(RHST + (128 + 16 * (2 * kbp + c2) + r16) * DP_RP + 32 * kb + 8 * g4), tf[kb], xt[c2], 0, 0, 0); }
                    *(u32x4*)(abu + (size_t)(FR_NWK + mt * 4 + kbp) * 1024 + lane * 16) = __builtin_bit_cast(u32x4, pack8(-xt[0], -xt[1])); }
            }
        }
        LDS_BARRIER(); DPS(20);
    }
#undef DP_FETCH
}

constexpr size_t O_ODN = O_Y;
#define DN_SB() __builtin_amdgcn_sched_barrier(0)
__device__ __forceinline__ void dn_consume(const LAS unsigned char* fb, int wl, f32x4 (&S)[8], float cd, float* op) {
    f32x4 u[4], o[4];
    bf16x8 fa[16], fq[16], Sb[4], Ub[2];
#pragma unroll
    for (int mt = 0; mt < 4; ++mt) u[mt] = *(const LAS f32x4*)(fb + (FR_N + wl * 4 + mt) * 1024);
#pragma unroll
    for (int f = 0; f < 16; ++f) fa[f] = *(const LAS bf16x8*)(fb + (FR_NWK + f) * 1024);
#pragma unroll
    for (int f = 0; f < 8; ++f) fq[f] = *(const LAS bf16x8*)(fb + (FR_QD + f) * 1024);
    DN_SB();
#pragma unroll
    for (int kb = 0; kb < 4; ++kb) Sb[kb] = pack8(S[2 * kb], S[2 * kb + 1]);
#pragma unroll
    for (int mt = 0; mt < 4; ++mt)
#pragma unroll
        for (int kb = 0; kb < 4; ++kb) u[mt] = __builtin_amdgcn_mfma_f32_16x16x32_bf16(fa[mt * 4 + kb], Sb[kb], u[mt], 0, 0, 0);
    DN_SB();
#pragma unroll
    for (int f = 8; f < 16; ++f) fq[f] = *(const LAS bf16x8*)(fb + (FR_QD + f) * 1024);
#pragma unroll
    for (int f = 0; f < 8; ++f) fa[f] = *(const LAS bf16x8*)(fb + (FR_KTT + f) * 1024);
    DN_SB();
#pragma unroll
    for (int mt = 0; mt < 4; ++mt) { o[mt] = (f32x4){0.f, 0.f, 0.f, 0.f};
#pragma unroll
        for (int kb = 0; kb < 4; ++kb) o[mt] = __builtin_amdgcn_mfma_f32_16x16x32_bf16(fq[mt * 4 + kb], Sb[kb], o[mt], 0, 0, 0); }
    DN_SB();
#pragma unroll
    for (int f = 8; f < 16; ++f) fa[f] = *(const LAS bf16x8*)(fb + (FR_KTT + f) * 1024);
#pragma unroll
    for (int f = 0; f < 8; ++f) fq[f] = *(const LAS bf16x8*)(fb + (FR_QK + f) * 1024);
#pragma unroll
    for (int tb = 0; tb < 2; ++tb) Ub[tb] = pack8(u[2 * tb], u[2 * tb + 1]);
#pragma unroll
    for (int kt = 0; kt < 8; ++kt) S[kt] = S[kt] * cd;
    DN_SB();
#pragma unroll
    for (int kt = 0; kt < 8; ++kt)
#pragma unroll
        for (int tb = 0; tb < 2; ++tb) S[kt] = __builtin_amdgcn_mfma_f32_16x16x32_bf16(fa[kt * 2 + tb], Ub[tb], S[kt], 0, 0, 0);
#pragma unroll
    for (int mt = 0; mt < 4; ++mt) {
#pragma unroll
        for (int tb = 0; tb < 2; ++tb) o[mt] = __builtin_amdgcn_mfma_f32_16x16x32_bf16(fq[mt * 2 + tb], Ub[tb], o[mt], 0, 0, 0);
#pragma unroll
        for (int i = 0; i < 4; ++i) op[(size_t)(16 * mt + i) * 512] = o[mt][i]; }
}
constexpr int DN_SBUF = 73728;
__device__ __forceinline__ void phase_dnscan(const P& p, LAS unsigned char* lds) {
    if (blockIdx.x >= BATCH * 4 * 2) return;
    const int tid = otid(), lane = tid & 63, wave = __builtin_amdgcn_readfirstlane(tid >> 6), r16 = lane & 15, g4 = lane >> 4;
    const int bh = blockIdx.x >> 1, vh = blockIdx.x & 1, h = bh & 3, b = bh >> 2, wl = wave & 3, vs = vh * 4 + wl, v0 = vs * 16;
    const float* cdp = ws_f(p, WS_DNF_CD) + (size_t)bh * NCHUNK;
    float* odn = p.out + O_ODN;
#define DN_BAR() do { asm volatile("s_waitcnt lgkmcnt(0)" ::: "memory"); __builtin_amdgcn_s_barrier(); asm volatile("" ::: "memory"); } while (0)
    if (wave >= 4) {
        const unsigned char* ab = p.ws + WS_DNF_AB + (size_t)bh * NCHUNK * DNF_AB_UNIT + lane * 16;
        const unsigned char* wvb = p.ws + WS_DNF_WV + (size_t)bh * NCHUNK * DNF_WV_UNIT + (size_t)vh * 16 * 1024 + lane * 16;
        u32x4 R[3][18];
#define DN_SRC(n_, q_) ((q_) < FR_N ? ab + (size_t)(n_) * DNF_AB_UNIT + (q_) * 1024 : wvb + (size_t)(n_) * DNF_WV_UNIT + ((q_) - FR_N) * 1024)
#define DN_LD(n_, s_) do { if ((n_) < NCHUNK) { _Pragma("unroll") for (int i_ = 0; i_ < 18; ++i_) R[s_][i_] = *(const u32x4*)DN_SRC(n_, wl * 18 + i_); } } while (0)
#define DN_ST(n_, s_) do { if ((n_) < NCHUNK) { LAS unsigned char* d_ = lds + ((n_) & 1) * DN_SBUF + wl * 18 * 1024 + lane * 16; _Pragma("unroll") for (int i_ = 0; i_ < 18; ++i_) *(LAS u32x4*)(d_ + i_ * 1024) = R[s_][i_]; } } while (0)
        DN_LD(0, 0); DN_LD(1, 1); DN_LD(2, 2); DN_ST(0, 0);
        DN_BAR();
#define DN_LSTEP(n_, s_) do { const int n = (n_); if (n < NCHUNK) { DN_LD(n + 3, s_); DN_ST(n + 1, ((s_) + 1) % 3); DN_BAR(); } } while (0)
        for (int n3 = 0; n3 < NCHUNK; n3 += 3) { DN_LSTEP(n3, 0); DN_LSTEP(n3 + 1, 1); DN_LSTEP(n3 + 2, 2); }
#undef DN_LSTEP
#undef DN_LD
#undef DN_ST
#undef DN_SRC
        return;
    }
    f32x4 S[8];
#pragma unroll
    for (int t = 0; t < 8; ++t) S[t] = (f32x4){0.f, 0.f, 0.f, 0.f};
    float cd = cdp[0];
    DN_BAR();
    for (int n = 0; n < NCHUNK; ++n) {
        const float cdn = cdp[n + 1 < NCHUNK ? n + 1 : n];
        dn_consume(lds + (n & 1) * DN_SBUF + lane * 16, wl, S, cd, odn + (size_t)(b * SEQ + n * 64 + 4 * g4) * 512 + h * 128 + v0 + r16);
        cd = cdn;
        DN_BAR();
    }
#undef DN_BAR
    {
        float* so = p.out + O_PSSM + (size_t)bh * 128 * 128 + v0 + r16;
#pragma unroll
        for (int kt = 0; kt < 8; ++kt)
#pragma unroll
            for (int i = 0; i < 4; ++i) so[(size_t)(16 * kt + 4 * g4 + i) * 128] = S[kt][i];
    }
}
__device__ __forceinline__ void phase_dngate(const P& p) {
    const int tid_ = otid(), lane = tid_ & 63, wave = tid_ >> 6;
    const int gw = blockIdx.x * NWAVES + wave, NGW = gridDim.x * NWAVES;
    const f32x4 nw0 = *(const f32x4*)(p.dn_norm_w + (lane & 15) * 8), nw1 = *(const f32x4*)(p.dn_norm_w + (lane & 15) * 8 + 4);
    f32x4 a, c; u32x4 z;
#define DG_LOAD(m_) do { const float* o_ = p.out + O_ODN + (size_t)(m_) * 512 + lane * 8; a = *(const f32x4*)o_; c = *(const f32x4*)(o_ + 4); z = *(const u32x4*)(ws_h(p, WS_PROJ) + (size_t)(m_) * PLD + PC_Z + lane * 8); } while (0)
    if (gw < TP) DG_LOAD(gw);
    for (int m = gw; m < TP; m += NGW) {
        const f32x4 a0 = a, c0 = c; const u32x4 z0 = z;
        if (m + NGW < TP) DG_LOAD(m + NGW);
        float ss = (a0[0] * a0[0] + a0[1] * a0[1]) + (a0[2] * a0[2] + a0[3] * a0[3]) + (c0[0] * c0[0] + c0[1] * c0[1]) + (c0[2] * c0[2] + c0[3] * c0[3]);
#pragma unroll
        for (int off = 1; off < 16; off <<= 1) ss += __shfl_xor(ss, off);
        const float rstd = 1.0f / sqrtf(ss * (1.0f / 128.0f) + EPS);
        const unsigned zw[4] = {z0.x, z0.y, z0.z, z0.w}; const float ov[8] = {a0[0], a0[1], a0[2], a0[3], c0[0], c0[1], c0[2], c0[3]}; const float nwv[8] = {nw0[0], nw0[1], nw0[2], nw0[3], nw1[0], nw1[1], nw1[2], nw1[3]};
        unsigned r[4];
#pragma unroll
        for (int e = 0; e < 4; ++e) { const float z0f = __builtin_bit_cast(float, zw[e] << 16), z1f = __builtin_bit_cast(float, zw[e] & 0xffff0000u);
            r[e] = pk2(ov[2 * e] * rstd * nwv[2 * e] * silu_f(z0f), ov[2 * e + 1] * rstd * nwv[2 * e + 1] * silu_f(z1f)); }
        *(u32x4*)(ws_h(p, WS_MIX) + (size_t)m * 1024 + lane * 8) = (u32x4){r[0], r[1], r[2], r[3]};
    }
#undef DG_LOAD
}
__device__ __forceinline__ void phase_dnsample(const P& p, LAS unsigned char* lds, unsigned long long& pr_prev, unsigned long long& pr_acc) {
    const int tid = otid(), lane = tid & 63, us = tid >> 8, w4 = (tid >> 6) & 3, kh = lane >> 5, col_ = w4 * 32 + (lane & 31);
    LAS float* QH = (LAS float*)lds + us * 4352;
    LAS float* KH = QH + 1024; LAS float* VH = QH + 2048; LAS float* OH = QH + 3072; LAS float* RED = QH + 4096;
    const bf16_t* PR = ws_h(p, WS_PROJ); const float* BG = ws_f(p, WS_BG);
    for (int ub = blockIdx.x; ub < DEC_BATCH * 2; ub += gridDim.x) {
        const int uidx = ub * 2 + us, b = uidx >> 2, h = uidx & 3, m0 = TP + b * DEC_SEQ;
        int col = col_; asm volatile("" : "+v"(col));
        {
            float x0[11], x1[11];
            const int ch0 = kh * 512 + h * 128 + col;
#pragma unroll
            for (int rr = 0; rr < 11; ++rr) {
                if (rr < 3) { const float* st = p.state_dn_conv + ((size_t)b * 3 + rr) * 1536; x0[rr] = st[ch0]; x1[rr] = st[1024 + h * 128 + col]; }
                else { const bf16_t* pr = PR + (size_t)(m0 + rr - 3) * PLD; x0[rr] = bf2f(pr[ch0]); x1[rr] = bf2f(pr[1024 + h * 128 + col]); } }
            float w0[4], w1[4];
#pragma unroll
            for (int j = 0; j < 4; ++j) { w0[j] = p.dn_conv_w[j * 1536 + ch0]; w1[j] = p.dn_conv_w[j * 1536 + 1024 + h * 128 + col]; }
            float ssq[8], ssk[8];
#pragma unroll
            for (int t = 0; t < 8; ++t) { float a = 0.f, d = 0.f;
#pragma unroll
                for (int j = 0; j < 4; ++j) { a += w0[j] * x0[t + j]; d += w1[j] * x1[t + j]; }
                a = a * __builtin_amdgcn_rcpf(1.0f + __expf(-a)); d = d * __builtin_amdgcn_rcpf(1.0f + __expf(-d));
                if (kh == 0) { QH[t * 128 + col] = a; VH[t * 128 + col] = d; } else KH[t * 128 + col] = a;
                ssq[t] = kh == 0 ? a * a : 0.f; ssk[t] = kh == 1 ? a * a : 0.f; }
#pragma unroll
            for (int o = 1; o < 64; o <<= 1) {
#pragma unroll
                for (int t = 0; t < 8; ++t) { ssq[t] += __shfl_xor(ssq[t], o); ssk[t] += __shfl_xor(ssk[t], o); } }
            if (lane == 0) {
#pragma unroll
                for (int t = 0; t < 8; ++t) { RED[w4 * 16 + t] = ssq[t]; RED[w4 * 16 + 8 + t] = ssk[t]; } }
        }
        LDS_BARRIER(); DPS(27);
#pragma unroll
        for (int t = 0; t < 8; ++t) {
            if (kh == 0) { const float sq = (RED[t] + RED[16 + t]) + (RED[32 + t] + RED[48 + t]); QH[t * 128 + col] *= 0.08838834764831845f / sqrtf(sq + EPS); }
            else { const float sk = (RED[8 + t] + RED[24 + t]) + (RED[40 + t] + RED[56 + t]); KH[t * 128 + col] *= 1.0f / sqrtf(sk + EPS); } }
        LDS_BARRIER(); DPS(28);
        float S[64];
        const float* S0 = p.state_dn_ssm + ((size_t)b * 4 + h) * 128 * 128 + (size_t)kh * 64 * 128 + col;
#pragma unroll
        for (int k = 0; k < 64; ++k) { S[k] = *S0; S0 += 128; if ((k & 7) == 7) asm volatile("" : "+v"(S0)); }
#pragma unroll 1
        for (int t = 0; t < 8; ++t) {
            const float beta = BG[(size_t)(m0 + t) * 8 + h], eg = __expf(BG[(size_t)(m0 + t) * 8 + 4 + h]);
            const LAS float* kp = KH + t * 128 + kh * 64; const LAS float* qp = QH + t * 128 + kh * 64;
            f32x4 kk[16], qq[16];
#pragma unroll
            for (int k4 = 0; k4 < 16; ++k4) kk[k4] = *(const LAS f32x4*)(kp + 4 * k4);
#pragma unroll
            for (int k4 = 0; k4 < 16; ++k4) qq[k4] = *(const LAS f32x4*)(qp + 4 * k4);
            const float vt = VH[t * 128 + col];
            __builtin_amdgcn_sched_barrier(0);
            float kS = 0.f;
#pragma unroll
            for (int k4 = 0; k4 < 16; ++k4)
#pragma unroll
                for (int e = 0; e < 4; ++e) { S[4 * k4 + e] *= eg; kS += kk[k4][e] * S[4 * k4 + e]; }
            kS += __shfl_xor(kS, 32);
            const float u = beta * (vt - kS);
            float o = 0.f;
#pragma unroll
            for (int k4 = 0; k4 < 16; ++k4)
#pragma unroll
                for (int e = 0; e < 4; ++e) { S[4 * k4 + e] += kk[k4][e] * u; o += qq[k4][e] * S[4 * k4 + e]; }
            o += __shfl_xor(o, 32);
            if (kh == 0) OH[t * 128 + col] = o;
            __builtin_amdgcn_sched_barrier(0);
        }
        float* So = p.out + O_SSSM + ((size_t)b * 4 + h) * 128 * 128 + (size_t)kh * 64 * 128 + col;
#pragma unroll
        for (int k = 0; k < 64; ++k) { *So = S[k]; So += 128; if ((k & 7) == 7) asm volatile("" : "+v"(So)); }
        LDS_BARRIER(); DPS(29);
#pragma unroll
        for (int t = 0; t < 8; ++t) { const float o = kh == 0 ? OH[t * 128 + col] : 0.f; const float s = wave_sum(o * o); if (lane == 0) RED[w4 * 16 + t] = s; }
        LDS_BARRIER();
        if (kh == 0) {
            const float nw = p.dn_norm_w[col];
#pragma unroll
            for (int t = 0; t < 8; ++t) { const float rstd = 1.0f / sqrtf(((RED[t] + RED[16 + t]) + (RED[32 + t] + RED[48 + t])) * (1.0f / 128.0f) + EPS);
                const float z = bf2f(PR[(size_t)(m0 + t) * PLD + PC_Z + h * 128 + col]);
                ws_h(p, WS_MIX)[(size_t)(m0 + t) * 1024 + h * 128 + col] = f2bf(OH[t * 128 + col] * rstd * nw * silu_f(z)); }
        }
        LDS_BARRIER(); DPS(30);
    }
}
constexpr int NSEG = 16, CSEG = NCHUNK / NSEG, NBH = BATCH * 4;
static_assert(NCHUNK % NSEG == 0, "segments");
constexpr size_t O_RFRAG = O_ODN + (size_t)TP * 512;
constexpr size_t O_BSEG = O_RFRAG + (size_t)NBH * NSEG * 8192;
constexpr size_t O_SSEG = O_BSEG + (size_t)NBH * NSEG * 16384;
constexpr size_t O_CPROD = O_SSEG + (size_t)NBH * NSEG * 16384;
static_assert(O_CPROD + NBH * NSEG <= (size_t)T * D, "segment scratch fits in the y region of d_out");

template <bool HASWV> __device__ __forceinline__ void dn_consume_map(const LAS unsigned char* fb, int wl, f32x4 (&X)[8], float cd) {
    f32x4 u[4]; bf16x8 f0[8], f1[8], Xb[4], Ub[2];
#pragma unroll
    for (int mt = 0; mt < 4; ++mt) u[mt] = HASWV ? *(const LAS f32x4*)(fb + (FR_N + wl * 4 + mt) * 1024) : (f32x4){0.f, 0.f, 0.f, 0.f};
#pragma unroll
    for (int f = 0; f < 8; ++f) f0[f] = *(const LAS bf16x8*)(fb + (FR_NWK + f) * 1024);
#pragma unroll
    for (int f = 0; f < 8; ++f) f1[f] = *(const LAS bf16x8*)(fb + (FR_NWK + 8 + f) * 1024);
    DN_SB();
#pragma unroll
    for (int kb = 0; kb < 4; ++kb) Xb[kb] = pack8(X[2 * kb], X[2 * kb + 1]);
#pragma unroll
    for (int mt = 0; mt < 2; ++mt)
#pragma unroll
        for (int kb = 0; kb < 4; ++kb) u[mt] = __builtin_amdgcn_mfma_f32_16x16x32_bf16(f0[mt * 4 + kb], Xb[kb], u[mt], 0, 0, 0);
    DN_SB();
#pragma unroll
    for (int f = 0; f < 8; ++f) f0[f] = *(const LAS bf16x8*)(fb + (FR_KTT + f) * 1024);
    DN_SB();
#pragma unroll
    for (int mt = 2; mt < 4; ++mt)
#pragma unroll
        for (int kb = 0; kb < 4; ++kb) u[mt] = __builtin_amdgcn_mfma_f32_16x16x32_bf16(f1[(mt - 2) * 4 + kb], Xb[kb], u[mt], 0, 0, 0);
    DN_SB();
#pragma unroll
    for (int f = 0; f < 8; ++f) f1[f] = *(const LAS bf16x8*)(fb + (FR_KTT + 8 + f) * 1024);
#pragma unroll
    for (int tb = 0; tb < 2; ++tb) Ub[tb] = pack8(u[2 * tb], u[2 * tb + 1]);
#pragma unroll
    for (int kt = 0; kt < 8; ++kt) X[kt] = X[kt] * cd;
    DN_SB();
#pragma unroll
    for (int kt = 0; kt < 4; ++kt)
#pragma unroll
        for (int tb = 0; tb < 2; ++tb) X[kt] = __builtin_amdgcn_mfma_f32_16x16x32_bf16(f0[kt * 2 + tb], Ub[tb], X[kt], 0, 0, 0);
#pragma unroll
    for (int kt = 4; kt < 8; ++kt)
#pragma unroll
        for (int tb = 0; tb < 2; ++tb) X[kt] = __builtin_amdgcn_mfma_f32_16x16x32_bf16(f1[(kt - 4) * 2 + tb], Ub[tb], X[kt], 0, 0, 0);
}
#define DNS_BAR() do { asm volatile("s_waitcnt lgkmcnt(0)" ::: "memory"); __builtin_amdgcn_s_barrier(); asm volatile("" ::: "memory"); } while (0)
template <int MODE, int nsteps> __device__ __forceinline__ void dns_loader(const P& p, LAS unsigned char* lds, int bh, int n0, int vh, int wl, int lane) {
    constexpr int NPW = MODE == 2 ? 18 : (MODE == 1 ? 12 : 8);
    const unsigned char* ab = p.ws + WS_DNF_AB + ((size_t)bh * NCHUNK + n0) * DNF_AB_UNIT + lane * 16;
    const unsigned char* wvb = p.ws + WS_DNF_WV + ((size_t)bh * NCHUNK + n0) * DNF_WV_UNIT + (size_t)vh * 16 * 1024 + lane * 16;
    u32x4 R[2][NPW];
#define DNS_FRAG(q_) (MODE == 2 ? (q_) : ((q_) < 16 ? (q_) : ((q_) < 32 ? FR_KTT + (q_) - 16 : FR_N + (q_) - 32)))
#define DNS_SRC(n_, q_) (DNS_FRAG(q_) < FR_N ? ab + (size_t)(n_) * DNF_AB_UNIT + DNS_FRAG(q_) * 1024 : wvb + (size_t)(n_) * DNF_WV_UNIT + (DNS_FRAG(q_) - FR_N) * 1024)
#define DNS_LD(n_, s_) do { if ((n_) < nsteps) { _Pragma("unroll") for (int i_ = 0; i_ < NPW; ++i_) R[s_][i_] = *(const u32x4*)DNS_SRC(n_, wl * NPW + i_); } } while (0)
#define DNS_ST(n_, s_) do { if ((n_) < nsteps) { LAS unsigned char* d_ = lds + ((n_) & 1) * DN_SBUF + lane * 16; _Pragma("unroll") for (int i_ = 0; i_ < NPW; ++i_) *(LAS u32x4*)(d_ + DNS_FRAG(wl * NPW + i_) * 1024) = R[s_][i_]; } } while (0)
    DNS_LD(0, 0); DNS_LD(1, 1); DNS_ST(0, 0);
    DNS_BAR();
#define DNS_LSTEP(n_, s_) do { const int n = (n_); if (n < nsteps) { DNS_LD(n + 2, s_); DNS_ST(n + 1, (s_) ^ 1); DNS_BAR(); } } while (0)
#pragma unroll
    for (int n2 = 0; n2 < nsteps; n2 += 2) { DNS_LSTEP(n2, 0); DNS_LSTEP(n2 + 1, 1); }
#undef DNS_LSTEP
#undef DNS_LD
#undef DNS_ST
#undef DNS_SRC
#undef DNS_FRAG
}
constexpr int PA_RTP = 72;
template <int MODE> __device__ __forceinline__ void dns_passA_task(const P& p, LAS unsigned char* lds, int bh, int seg, int q, int wave, int lane) {
    const int r16 = lane & 15, g4 = lane >> 4, wl = wave & 3, n0 = seg * CSEG;
    const float* cdp = ws_f(p, WS_DNF_CD) + (size_t)bh * NCHUNK + n0;
    LAS bf16_t* RT = (LAS bf16_t*)lds;
    if (wave >= 4) { dns_loader<MODE, CSEG>(p, lds, bh, n0, q & 1, wl, lane); }
    else {
        f32x4 X[8];
#pragma unroll
        for (int kt = 0; kt < 8; ++kt)
#pragma unroll
            for (int i = 0; i < 4; ++i) X[kt][i] = (MODE == 0 && 16 * kt + 4 * g4 + i == 64 * q + 16 * wl + r16) ? 1.f : 0.f;
        float cd = cdp[0], cprod = 1.f;
        DNS_BAR();
        for (int n = 0; n < CSEG; ++n) {
            const float cdn = cdp[n + 1 < CSEG ? n + 1 : n];
            dn_consume_map<MODE == 1>(lds + (n & 1) * DN_SBUF + lane * 16, wl, X, cd);
            cprod *= cd; cd = cdn;
            DNS_BAR();
        }
        if (MODE == 0) {
#pragma unroll
            for (int kt = 0; kt < 8; ++kt)
#pragma unroll
                for (int i = 0; i < 4; ++i) { const int row = 16 * kt + 4 * g4 + i, col = 16 * wl + r16; const float v = X[kt][i] - ((row == 64 * q + col) ? cprod : 0.f);
                    RT[row * PA_RTP + col] = f2bf(v); }
            if (q == 0 && wave == 0 && lane == 0) p.out[O_CPROD + bh * NSEG + seg] = cprod;
        } else {
            float* bo = p.out + O_BSEG + ((size_t)(bh * NSEG + seg) * 8 + (4 * (q & 1) + wl)) * 2048 + lane * 4;
#pragma unroll
            for (int kt = 0; kt < 8; ++kt) *(f32x4*)(bo + kt * 256) = X[kt];
        }
    }
    DNS_BAR();
    if (MODE == 0) {
#pragma unroll
        for (int j = 0; j < 2; ++j) { const int f = wave * 2 + j, mt = f >> 1, kbl = f & 1, row = 16 * mt + r16;
            const u32x2 lo = *(const LAS u32x2*)(RT + row * PA_RTP + 32 * kbl + 4 * g4), hi = *(const LAS u32x2*)(RT + row * PA_RTP + 32 * kbl + 16 + 4 * g4);
            *(u32x4*)((unsigned char*)(p.out + O_RFRAG) + ((size_t)(bh * NSEG + seg) * 32 + mt * 4 + 2 * q + kbl) * 1024 + lane * 16) = (u32x4){lo.x, lo.y, hi.x, hi.y}; }
        DNS_BAR();
    }
}
__device__ __forceinline__ void phase_dns_passA(const P& p, LAS unsigned char* lds) {
    const int tid = otid(), lane = tid & 63, wave = __builtin_amdgcn_readfirstlane(tid >> 6);
    const int vb = (gridDim.x % 8 == 0) ? (int)((blockIdx.x % 8) * (gridDim.x / 8) + blockIdx.x / 8) : (int)blockIdx.x;
    for (int t = vb; t < NBH * NSEG * 4; t += gridDim.x) {
        const int q = t & 3, seg = (t >> 2) % NSEG, bh = t / (4 * NSEG);
        if (q < 2) dns_passA_task<0>(p, lds, bh, seg, q, wave, lane); else dns_passA_task<1>(p, lds, bh, seg, q, wave, lane);
    }
}
__device__ __forceinline__ void phase_dns_passB(const P& p, LAS unsigned char* lds) {
    if ((int)blockIdx.x >= NBH * 8) return;
    const int tid = otid(), lane = tid & 63, w = __builtin_amdgcn_readfirstlane(tid >> 6), r16 = lane & 15, g4 = lane >> 4;
    const int bh = blockIdx.x & 7, vs = blockIdx.x >> 3;
    LAS u32x2* XB = (LAS u32x2*)lds;
    const unsigned char* rf0 = (const unsigned char*)(p.out + O_RFRAG) + ((size_t)bh * NSEG * 32 + w * 4) * 1024 + lane * 16;
    const float* bt0 = p.out + O_BSEG + ((size_t)bh * NSEG * 8 + vs) * 2048 + w * 256 + lane * 4;
    float* ss0 = p.out + O_SSEG + ((size_t)bh * NSEG * 8 + vs) * 2048 + w * 256 + lane * 4;
    const float* cp0 = p.out + O_CPROD + bh * NSEG;
    u32x4 rf[4][4]; f32x4 bt[4]; float cp[4];
#define PB_LD(s_, r_) do { if ((s_) < NSEG) { _Pragma("unroll") for (int kb = 0; kb < 4; ++kb) rf[r_][kb] = *(const u32x4*)(rf0 + (size_t)(s_) * 32768 + kb * 1024); bt[r_] = *(const f32x4*)(bt0 + (size_t)(s_) * 16384); cp[r_] = cp0[(s_)]; } } while (0)
    PB_LD(0, 0); PB_LD(1, 1); PB_LD(2, 2);
    f32x4 S = (f32x4){0.f, 0.f, 0.f, 0.f};
#pragma unroll
    for (int s = 0; s < NSEG; ++s) {
        PB_LD(s + 3, (s + 3) & 3);
        *(f32x4*)(ss0 + (size_t)s * 16384) = S;
        XB[((s & 1) * 8 + w) * 64 + lane] = (u32x2){cvtpk_c(S[0], S[1]), cvtpk_c(S[2], S[3])};
        DNS_BAR();
        f32x4 acc = S * cp[s & 3] + bt[s & 3];
#pragma unroll
        for (int kb = 0; kb < 4; ++kb) { const u32x2 lo = XB[((s & 1) * 8 + 2 * kb) * 64 + lane], hi = XB[((s & 1) * 8 + 2 * kb + 1) * 64 + lane];
            acc = __builtin_amdgcn_mfma_f32_16x16x32_bf16(__builtin_bit_cast(bf16x8, rf[s & 3][kb]), __builtin_bit_cast(bf16x8, (u32x4){lo.x, lo.y, hi.x, hi.y}), acc, 0, 0, 0); }
        S = acc;
    }
#undef PB_LD
    float* so = p.out + O_PSSM + (size_t)bh * 128 * 128 + vs * 16 + r16;
#pragma unroll
    for (int i = 0; i < 4; ++i) so[(size_t)(16 * w + 4 * g4 + i) * 128] = S[i];
    DNS_BAR();
}
__device__ __forceinline__ void phase_dns_passC(const P& p, LAS unsigned char* lds) {
    const int tid = otid(), lane = tid & 63, wave = __builtin_amdgcn_readfirstlane(tid >> 6), r16 = lane & 15, g4 = lane >> 4, wl = wave & 3;
    const int vb = (gridDim.x % 8 == 0) ? (int)((blockIdx.x % 8) * (gridDim.x / 8) + blockIdx.x / 8) : (int)blockIdx.x;
    for (int t = vb; t < NBH * NSEG * 2; t += gridDim.x) {
        const int vh = t & 1, seg = (t >> 1) % NSEG, bh = t / (2 * NSEG), h = bh & 3, b = bh >> 2, vs = vh * 4 + wl, n0 = seg * CSEG;
        if (wave >= 4) dns_loader<2, CSEG>(p, lds, bh, n0, vh, wl, lane);
        else {
            const float* cdp = ws_f(p, WS_DNF_CD) + (size_t)bh * NCHUNK + n0;
            const float* ss = p.out + O_SSEG + ((size_t)(bh * NSEG + seg) * 8 + vs) * 2048 + lane * 4;
            f32x4 S[8];
#pragma unroll
            for (int kt = 0; kt < 8; ++kt) S[kt] = *(const f32x4*)(ss + kt * 256);
            float cd = cdp[0];
            DNS_BAR();
            for (int n = 0; n < CSEG; ++n) {
                const float cdn = cdp[n + 1 < CSEG ? n + 1 : n];
                dn_consume(lds + (n & 1) * DN_SBUF + lane * 16, wl, S, cd, p.out + O_ODN + (size_t)(b * SEQ + (n0 + n) * 64 + 4 * g4) * 512 + h * 128 + vs * 16 + r16);
                cd = cdn;
                DNS_BAR();
            }
        }
        DNS_BAR();
    }
}
#undef DNS_BAR
constexpr size_t WS_EDGE = WS_FREE;
constexpr size_t WS_HEAD = al256(WS_EDGE + (size_t)(T / 256) * 2 * 2 * DFF * 4);
constexpr size_t WS_END = al256(WS_HEAD + (size_t)(T / 256) * 2 * 2 * DFF * 4);
constexpr int EX_OFF = 131072;
namespace pg8 {
typedef unsigned u32x2v __attribute__((ext_vector_type(2)));
__device__ __forceinline__ float dpp_shr1(float old, float src) { return __builtin_bit_cast(float, __builtin_amdgcn_update_dpp(__builtin_bit_cast(int, old), __builtin_bit_cast(int, src), 0x111, 0xf, 0xf, false)); }
__device__ __forceinline__ float dpp_shr2(float old, float src) { return __builtin_bit_cast(float, __builtin_amdgcn_update_dpp(__builtin_bit_cast(int, old), __builtin_bit_cast(int, src), 0x112, 0xf, 0xf, false)); }
__device__ __forceinline__ float dpp_ror1(float src) { return __builtin_bit_cast(float, __builtin_amdgcn_update_dpp(0, __builtin_bit_cast(int, src), 0x121, 0xf, 0xf, false)); }
__device__ __forceinline__ float dpp_ror2(float src) { return __builtin_bit_cast(float, __builtin_amdgcn_update_dpp(0, __builtin_bit_cast(int, src), 0x122, 0xf, 0xf, false)); }
struct EpiFfnUp {
    static constexpr bool PERM = false, AFTER_DRAIN = false;
    bf16_t* ACT; float* edge; float* head; const float* cw; const float* cb; const float* state; float* out_pfc; float* out_sfc; PG8_LAS unsigned char* lds;
    __device__ __forceinline__ void operator()(const f32x4 (&acc)[2][2][4][2], const Unit& u, int wr, int wc, int fr, int fq) const {
        PG8_LAS float* EX = (PG8_LAS float*)(lds + EX_OFF);
        const bool smp = u.pm >= TP / BM;
        const int cl = wc * 32 + 4 * fq;
        if (fr >= 14) {
#pragma unroll
            for (int ai = 0; ai < 2; ++ai)
#pragma unroll
                for (int bj = 0; bj < 2; ++bj)
#pragma unroll
                    for (int n = 0; n < 2; ++n) *(PG8_LAS f32x4*)(EX + ((2 * ai + wr) * 2 + (fr - 14)) * 256 + bj * HALF + cl + 16 * n) = acc[ai][bj][3][n];
            if (wr == 1) {
#pragma unroll
                for (int bj = 0; bj < 2; ++bj)
#pragma unroll
                    for (int n = 0; n < 2; ++n) { const int oc = bj * DFF + u.pn * HALF + cl + 16 * n;
                        *(f32x4*)(edge + ((size_t)u.pm * 2 + (fr - 14)) * 2 * DFF + oc) = acc[1][bj][3][n];
                        if (!smp && (u.pm & (SEQ / BM - 1)) == SEQ / BM - 1) *(f32x4*)(out_pfc + ((size_t)(u.pm / (SEQ / BM)) * 2 + (fr - 14)) * 2 * DFF + oc) = acc[1][bj][3][n]; }
            }
        }
        if (fr < 2 && wr == 0) {
#pragma unroll
            for (int bj = 0; bj < 2; ++bj)
#pragma unroll
                for (int n = 0; n < 2; ++n) *(f32x4*)(head + ((size_t)u.pm * 2 + fr) * 2 * DFF + bj * DFF + u.pn * HALF + cl + 16 * n) = acc[0][bj][0][n];
        }
        f32x4 cwg[1][3], cwu[1][3], cbg[1], cbu[1];
#define FF_LDC(n_) do { const int f0_ = u.pn * HALF + cl + 16 * (n_); _Pragma("unroll") for (int j = 0; j < 3; ++j) { cwg[0][j] = *(const f32x4*)(cw + (size_t)j * 2 * DFF + f0_); cwu[0][j] = *(const f32x4*)(cw + (size_t)j * 2 * DFF + DFF + f0_); } \
            cbg[0] = *(const f32x4*)(cb + f0_); cbu[0] = *(const f32x4*)(cb + DFF + f0_); } while (0)
        FF_LDC(0);
        asm volatile("s_waitcnt lgkmcnt(0)" ::: "memory"); __builtin_amdgcn_s_barrier(); asm volatile("" ::: "memory");
#pragma unroll
        for (int n = 0; n < 2; ++n) {
            const int f0 = u.pn * HALF + cl + 16 * n;
            if (n == 1) FF_LDC(1);
            const f32x4 (&wg)[3] = cwg[0]; const f32x4 (&wu)[3] = cwu[0]; const f32x4 bg = cbg[0], bu = cbu[0];
#pragma unroll
            for (int ai = 0; ai < 2; ++ai) {
                const int s = 2 * ai + wr;
                f32x4 pg = (f32x4){0.f, 0.f, 0.f, 0.f}, pu = pg;
                if (!smp && s > 0 && fr >= 14) { pg = *(const PG8_LAS f32x4*)(EX + ((s - 1) * 2 + (fr - 14)) * 256 + cl + 16 * n); pu = *(const PG8_LAS f32x4*)(EX + ((s - 1) * 2 + (fr - 14)) * 256 + HALF + cl + 16 * n); }
#pragma unroll
                for (int m = 0; m < 4; ++m) {
                    const f32x4 cg = acc[ai][0][m][n], cu = acc[ai][1][m][n];
                    const int row = u.pm * BM + ai * HALF + wr * 64 + m * 16 + fr;
                    f32x4 g1, g2, u1, u2;
#pragma unroll
                    for (int e = 0; e < 4; ++e) { g1[e] = dpp_shr1(dpp_ror1(pg[e]), cg[e]); g2[e] = dpp_shr2(dpp_ror2(pg[e]), cg[e]); u1[e] = dpp_shr1(dpp_ror1(pu[e]), cu[e]); u2[e] = dpp_shr2(dpp_ror2(pu[e]), cu[e]); }
                    if (smp) {
                        const int t = fr & 7, b = (row - TP) >> 3;
                        if (t < 2) { const float* st = state + (size_t)b * 2 * 2 * DFF + f0; const f32x4 s1g = *(const f32x4*)(st + 2 * DFF), s1u = *(const f32x4*)(st + 2 * DFF + DFF);
                            if (t == 0) { g1 = s1g; u1 = s1u; g2 = *(const f32x4*)st; u2 = *(const f32x4*)(st + DFF); } else { g2 = s1g; u2 = s1u; } }
                        if (t >= 6) { float* o = out_sfc + ((size_t)b * 2 + (t - 6)) * 2 * DFF + f0; *(f32x4*)o = cg; *(f32x4*)(o + DFF) = cu; }
                    }
                    const f32x4 gc = wg[0] * g2 + wg[1] * g1 + wg[2] * cg + bg, uc = wu[0] * u2 + wu[1] * u1 + wu[2] * cu + bu;
                    u32x2v w;
                    { const float a0 = gc[0] * uc[0] * __builtin_amdgcn_rcpf(1.0f + __expf(-gc[0])), a1 = gc[1] * uc[1] * __builtin_amdgcn_rcpf(1.0f + __expf(-gc[1])), a2 = gc[2] * uc[2] * __builtin_amdgcn_rcpf(1.0f + __expf(-gc[2])), a3 = gc[3] * uc[3] * __builtin_amdgcn_rcpf(1.0f + __expf(-gc[3]));
                      w.x = cvt_pk_bf16(a0, a1); w.y = cvt_pk_bf16(a2, a3); }
                    *(u32x2v*)(ACT + (size_t)row * DFF + f0) = w;
                    pg = cg; pu = cu;
                }
            }
        }
#undef FF_LDC
    }
};
}
__device__ __forceinline__ void phase_ffn_fix(const P& p) {
    constexpr int TPS = SEQ / 256;
    const long n = (long)(BATCH * TPS) * DFF;
    const float* edge = ws_f(p, WS_EDGE); const float* head = ws_f(p, WS_HEAD);
    for (long i = blockIdx.x * (long)NTHR + otid(); i < n; i += (long)gridDim.x * NTHR) {
        const int pm = (int)(i / DFF), f = (int)(i % DFF);
        if (pm % TPS == 0) continue;
        float r0[2], r1[2];
#pragma unroll
        for (int gu = 0; gu < 2; ++gu) { const int c = gu * DFF + f;
            const float um2 = edge[((size_t)(pm - 1) * 2 + 0) * 2 * DFF + c], um1 = edge[((size_t)(pm - 1) * 2 + 1) * 2 * DFF + c], u0 = head[((size_t)pm * 2 + 0) * 2 * DFF + c], u1 = head[((size_t)pm * 2 + 1) * 2 * DFF + c];
            const float w0 = p.ffn_conv_w[c], w1 = p.ffn_conv_w[2 * DFF + c], w2 = p.ffn_conv_w[4 * DFF + c], bb = p.ffn_conv_b[c];
            r0[gu] = w0 * um2 + w1 * um1 + w2 * u0 + bb; r1[gu] = w0 * um1 + w1 * u0 + w2 * u1 + bb; }
        bf16_t* ACT = ws_h(p, WS_ACT) + (size_t)pm * 256 * DFF + f;
        ACT[0] = f2bf(silu_f(r0[0]) * r0[1]); ACT[DFF] = f2bf(silu_f(r1[0]) * r1[1]);
    }
}

__device__ __forceinline__ void ffn_fix_tile(const P& p, int pm) {
    constexpr int TPS = SEQ / 256;
    if (pm >= BATCH * TPS || pm % TPS == 0) return;
    const float* edge = ws_f(p, WS_EDGE); const float* head = ws_f(p, WS_HEAD);
    for (int f = otid(); f < DFF; f += NTHR) {
        float r0[2], r1[2];
#pragma unroll
        for (int gu = 0; gu < 2; ++gu) { const int c = gu * DFF + f;
            const float um2 = edge[((size_t)(pm - 1) * 2 + 0) * 2 * DFF + c], um1 = edge[((size_t)(pm - 1) * 2 + 1) * 2 * DFF + c], u0 = head[((size_t)pm * 2 + 0) * 2 * DFF + c], u1 = head[((size_t)pm * 2 + 1) * 2 * DFF + c];
            const float w0 = p.ffn_conv_w[c], w1 = p.ffn_conv_w[2 * DFF + c], w2 = p.ffn_conv_w[4 * DFF + c], bb = p.ffn_conv_b[c];
            r0[gu] = w0 * um2 + w1 * um1 + w2 * u0 + bb; r1[gu] = w0 * um1 + w1 * u0 + w2 * u1 + bb; }
        bf16_t* ACT = ws_h(p, WS_ACT) + (size_t)pm * 256 * DFF + f;
        ACT[0] = f2bf(silu_f(r0[0]) * r0[1]); ACT[DFF] = f2bf(silu_f(r1[0]) * r1[1]);
    }
}
constexpr int SW_KP = 72;
__device__ __forceinline__ void swa_bias(const LAS float* BT, int lane, float (&bv)[9][4]) {
    const int r16 = lane & 15, g4 = lane >> 4;
#pragma unroll
    for (int t = 0; t < 9; ++t)
#pragma unroll
        for (int e = 0; e < 4; ++e) { const int d = 128 + r16 - 16 * t - 4 * g4 - e; bv[t][e] = (d >= 0 && d <= 127) ? BT[d] * 1.4426950408889634f : -1e30f; }
}
__device__ __forceinline__ void swa_qtile(const LAS bf16_t* KS, const LAS bf16_t* VT, int vtp, int qt, const bf16x8 (&bq)[2], const float (&bv)[9][4], float sink2, bool first, bf16_t* optr, int nvalid_q, int lane) {
    const int r16 = lane & 15, g4 = lane >> 4, kt0 = qt;
    f32x4 s[10];
#pragma unroll
    for (int tb = 0; tb < 2; ++tb) {
        bf16x8 ka[5][2];
#pragma unroll
        for (int t = 0; t < 5; ++t)
#pragma unroll
            for (int ks = 0; ks < 2; ++ks) if (5 * tb + t < 9) ka[t][ks] = *(const LAS bf16x8*)(KS + (16 * (kt0 + 5 * tb + t) + r16) * SW_KP + 32 * ks + 8 * g4);
        __builtin_amdgcn_sched_barrier(0);
#pragma unroll
        for (int t = 0; t < 5; ++t) if (5 * tb + t < 9) { f32x4 a = (f32x4){0.f, 0.f, 0.f, 0.f};
#pragma unroll
            for (int ks = 0; ks < 2; ++ks) a = __builtin_amdgcn_mfma_f32_16x16x32_bf16(ka[t][ks], bq[ks], a, 0, 0, 0);
            s[5 * tb + t] = a; }
        __builtin_amdgcn_sched_barrier(0);
    }
    float mx = sink2;
#pragma unroll
    for (int t = 0; t < 9; ++t)
#pragma unroll
        for (int e = 0; e < 4; ++e) { float v = s[t][e] * 0.18033688011112042f + bv[t][e]; if (first && 16 * (kt0 + t) + 4 * g4 + e < 128) v = -1e30f; s[t][e] = v; mx = fmaxf(mx, v); }
    mx = fmaxf(mx, __shfl_xor(mx, 16)); mx = fmaxf(mx, __shfl_xor(mx, 32));
    float l = 0.f;
#pragma unroll
    for (int t = 0; t < 9; ++t)
#pragma unroll
        for (int e = 0; e < 4; ++e) { const float pv = __builtin_amdgcn_exp2f(s[t][e] - mx); s[t][e] = pv; l += pv; }
    s[9] = (f32x4){0.f, 0.f, 0.f, 0.f};
    l += __shfl_xor(l, 16); l += __shfl_xor(l, 32);
    l += __builtin_amdgcn_exp2f(sink2 - mx);
    const float rl = __builtin_amdgcn_rcpf(l);
    bf16x8 pb[5];
#pragma unroll
    for (int q = 0; q < 5; ++q) pb[q] = pack8(s[2 * q], s[2 * q + 1]);
#pragma unroll
    for (int dp = 0; dp < 2; ++dp) {
        u32x2 vl[2][5], vh[2][5];
#pragma unroll
        for (int d2 = 0; d2 < 2; ++d2)
#pragma unroll
            for (int q = 0; q < 5; ++q) { const LAS bf16_t* vp = VT + (16 * (2 * dp + d2) + r16) * vtp + 16 * (kt0 + 2 * q) + 4 * g4; vl[d2][q] = *(const LAS u32x2*)vp; vh[d2][q] = *(const LAS u32x2*)(vp + 16); }
        __builtin_amdgcn_sched_barrier(0);
#pragma unroll
        for (int d2 = 0; d2 < 2; ++d2) { const int dt = 2 * dp + d2; f32x4 o = (f32x4){0.f, 0.f, 0.f, 0.f};
#pragma unroll
            for (int q = 0; q < 5; ++q) o = __builtin_amdgcn_mfma_f32_16x16x32_bf16(__builtin_bit_cast(bf16x8, (u32x4){vl[d2][q].x, vl[d2][q].y, vh[d2][q].x, vh[d2][q].y}), pb[q], o, 0, 0, 0);
            if (r16 < nvalid_q) *(u32x2*)(optr + (size_t)r16 * 1024 + 16 * dt + 4 * g4) = (u32x2){cvtpk_c(o[0] * rl, o[1] * rl), cvtpk_c(o[2] * rl, o[3] * rl)}; }
        __builtin_amdgcn_sched_barrier(0);
    }
}
constexpr int SWP_VTP = 272, SWS_NK = 144, SWS_VTP = 168;
constexpr int SW_KS = 0, SW_VT = 43008, SW_BT = 86016, SW_END = SW_BT + 8 * 128 * 4;
static_assert(256 * SW_KP * 2 <= SW_VT && SW_VT + 64 * SWP_VTP * 2 <= SW_BT && SWS_NK * SW_KP * 2 <= SW_VT && SW_VT + 64 * SWS_VTP * 2 <= SW_BT, "swa LDS map");
__device__ __forceinline__ void phase_swa(const P& p, LAS unsigned char* lds, unsigned long long& pr_prev, unsigned long long& pr_acc) {
    const int tid = otid(), lane = tid & 63, wave = tid >> 6;
    LAS bf16_t* KS = (LAS bf16_t*)(lds + SW_KS); LAS bf16_t* VT = (LAS bf16_t*)(lds + SW_VT); LAS float* BT = (LAS float*)(lds + SW_BT);
    const bf16_t* PR = ws_h(p, WS_PROJ); bf16_t* MX = ws_h(p, WS_MIX);
    constexpr int NQB = SEQ / 128, NPU = BATCH * NQB * 2, NU = NPU + DEC_BATCH * 2;
    for (int i = tid; i < 8 * 128; i += NTHR) BT[i] = p.rel_bias[t5_bucket(i & 127) * 8 + (i >> 7)];
    const int vb = (gridDim.x % 8 == 0) ? (int)((blockIdx.x % 8) * (gridDim.x / 8) + blockIdx.x / 8) : (int)blockIdx.x;
    for (int u = vb; u < NU; u += gridDim.x) {
        LDS_BARRIER(); DPS(22);
        if (u < NPU) {
            const int kvh = u & 1, qb = (u >> 1) % NQB, b = (u >> 1) / NQB, m0 = b * SEQ + qb * 128; const bool first = qb == 0;
            const bf16_t* qbase = PR + (size_t)(m0 + 64 * (wave & 1) + (lane & 15)) * PLD + PC_SQ + (kvh * 4 + (wave >> 1)) * 64 + 8 * (lane >> 4);
            bf16x8 bq[2], bqn[2];
#pragma unroll
            for (int ks = 0; ks < 2; ++ks) bq[ks] = *(const bf16x8*)(qbase + 32 * ks);
            {
                u32x4 kr[4], vr[5];
#pragma unroll
                for (int i = 0; i < 4; ++i) { const int it = tid + i * NTHR, jj = it >> 3, c = it & 7; kr[i] = (u32x4){0u, 0u, 0u, 0u};
                    if (!(first && jj < 128)) kr[i] = *(const u32x4*)(PR + (size_t)(m0 - 128 + jj) * PLD + PC_SK + kvh * 64 + 8 * c); }
#pragma unroll
                for (int i = 0; i < 5; ++i) { const int it = tid + i * NTHR, jj = it % 272, c = it / 272; vr[i] = (u32x4){0u, 0u, 0u, 0u};
                    if (it < 272 * 8 && jj < 256 && !(first && jj < 128)) vr[i] = *(const u32x4*)(PR + (size_t)(m0 - 128 + jj) * PLD + PC_SV + kvh * 64 + 8 * c); }
#pragma unroll
                for (int i = 0; i < 4; ++i) { const int it = tid + i * NTHR, jj = it >> 3, c = it & 7; *(LAS u32x4*)(KS + jj * SW_KP + 8 * c) = kr[i]; }
#pragma unroll
                for (int i = 0; i < 5; ++i) { const int it = tid + i * NTHR, jj = it % 272, c = it / 272;
                    if (it < 272 * 8) { const unsigned w[4] = {vr[i].x, vr[i].y, vr[i].z, vr[i].w};
#pragma unroll
                        for (int e = 0; e < 4; ++e) { VT[(8 * c + 2 * e) * SWP_VTP + jj] = (bf16_t)(w[e] & 0xffffu); VT[(8 * c + 2 * e + 1) * SWP_VTP + jj] = (bf16_t)(w[e] >> 16); } } }
            }
            LDS_BARRIER(); DPS(23);
            const int hq = kvh * 4 + (wave >> 1), qh = wave & 1, r16 = lane & 15, g4 = lane >> 4;
            float bv[9][4]; swa_bias(BT + hq * 128, lane, bv);
            const float sink2 = p.swa_sinks[hq] * 1.4426950408889634f;
#pragma unroll 1
            for (int q4 = 0; q4 < 4; ++q4) { const int qt = 4 * qh + q4;
                if (q4 < 3) {
#pragma unroll
                    for (int ks = 0; ks < 2; ++ks) bqn[ks] = *(const bf16x8*)(qbase + (size_t)(16 * (q4 + 1)) * PLD + 32 * ks); }
                swa_qtile(KS, VT, SWP_VTP, qt, bq, bv, sink2, first, MX + (size_t)(m0 + 16 * qt) * 1024 + 512 + hq * 64, 16, lane);
                bq[0] = bqn[0]; bq[1] = bqn[1]; }
            DPS(24);
        } else {
            const int su = u - NPU, b = su >> 1, kvh = su & 1, m0 = TP + b * DEC_SEQ;
            bf16x8 bqs[2];
#pragma unroll
            for (int ks = 0; ks < 2; ++ks) bqs[ks] = *(const bf16x8*)(PR + (size_t)(m0 + (lane & 7)) * PLD + PC_SQ + (kvh * 4 + (wave & 3)) * 64 + 32 * ks + 8 * (lane >> 4));
            {
                f32x4 ka[3][2], va[3][2]; u32x4 kn[3], vn[3];
#pragma unroll
                for (int i = 0; i < 3; ++i) { const int it = tid + i * NTHR, jj = it >> 3, c = it & 7;
                    ka[i][0] = ka[i][1] = (f32x4){0.f, 0.f, 0.f, 0.f}; kn[i] = (u32x4){0u, 0u, 0u, 0u};
                    if (it < SWS_NK * 8) { if (jj < 128) { const float* src = p.cache_k + ((size_t)b * 128 + jj) * 128 + kvh * 64 + 8 * c; ka[i][0] = *(const f32x4*)src; ka[i][1] = *(const f32x4*)(src + 4); }
                        else if (jj < 128 + DEC_SEQ) kn[i] = *(const u32x4*)(PR + (size_t)(m0 + jj - 128) * PLD + PC_SK + kvh * 64 + 8 * c); } }
#pragma unroll
                for (int i = 0; i < 3; ++i) { const int it = tid + i * NTHR, jj = it % SWS_VTP, c = it / SWS_VTP;
                    va[i][0] = va[i][1] = (f32x4){0.f, 0.f, 0.f, 0.f}; vn[i] = (u32x4){0u, 0u, 0u, 0u};
                    if (it < SWS_VTP * 8) { if (jj < 128) { const float* src = p.cache_v + ((size_t)b * 128 + jj) * 128 + kvh * 64 + 8 * c; va[i][0] = *(const f32x4*)src; va[i][1] = *(const f32x4*)(src + 4); }
                        else if (jj < 128 + DEC_SEQ) vn[i] = *(const u32x4*)(PR + (size_t)(m0 + jj - 128) * PLD + PC_SV + kvh * 64 + 8 * c); } }
#pragma unroll
                for (int i = 0; i < 3; ++i) { const int it = tid + i * NTHR, jj = it >> 3, c = it & 7;
                    if (it < SWS_NK * 8) { u32x4 v = kn[i]; if (jj < 128) v = (u32x4){cvtpk_c(ka[i][0][0], ka[i][0][1]), cvtpk_c(ka[i][0][2], ka[i][0][3]), cvtpk_c(ka[i][1][0], ka[i][1][1]), cvtpk_c(ka[i][1][2], ka[i][1][3])};
                        *(LAS u32x4*)(KS + jj * SW_KP + 8 * c) = v; } }
#pragma unroll
                for (int i = 0; i < 3; ++i) { const int it = tid + i * NTHR, jj = it % SWS_VTP, c = it / SWS_VTP;
                    if (it < SWS_VTP * 8) { u32x4 v = vn[i]; if (jj < 128) v = (u32x4){cvtpk_c(va[i][0][0], va[i][0][1]), cvtpk_c(va[i][0][2], va[i][0][3]), cvtpk_c(va[i][1][0], va[i][1][1]), cvtpk_c(va[i][1][2], va[i][1][3])};
                        const unsigned w[4] = {v.x, v.y, v.z, v.w};
#pragma unroll
                        for (int e = 0; e < 4; ++e) { VT[(8 * c + 2 * e) * SWS_VTP + jj] = (bf16_t)(w[e] & 0xffffu); VT[(8 * c + 2 * e + 1) * SWS_VTP + jj] = (bf16_t)(w[e] >> 16); } } }
            }
            LDS_BARRIER(); DPS(25);
            if (wave < 4) { const int hq = kvh * 4 + wave;
                float bv[9][4]; swa_bias(BT + hq * 128, lane, bv);
                swa_qtile(KS, VT, SWS_VTP, 0, bqs, bv, p.swa_sinks[hq] * 1.4426950408889634f, false, MX + (size_t)m0 * 1024 + 512 + hq * 64, 8, lane); }
        }
    }
    LDS_BARRIER();
}
static void fill_params(P& p, void* const* d_in, void* d_out, void* d_ws) {
    const float** pp = (const float**)&p;
    for (int i = 0; i < 26; ++i) pp[i] = (const float*)d_in[i];
    p.out = (float*)d_out; p.ws = (unsigned char*)d_ws;
}
namespace cg = cooperative_groups;
constexpr int CW_BAR = 1024;
constexpr size_t CTL_ZERO_BYTES = 65536;

#ifndef PROBE_MASK
#define PROBE_MASK 0
#endif
#ifndef PROBE_K
#define PROBE_K 4
#endif
#ifndef PROBE_XSYNC
#define PROBE_XSYNC 0
#endif
#if PROBE_MASK
#define PROBE_SUB(k) do { xcd_barrier(bar); PROBE_STAMP(k); } while (0)
#define PROBE_DECL unsigned long long pr_prev = __builtin_amdgcn_s_memrealtime(), pr_acc = 0ull
#define PROBE_STAMP(k) do { const unsigned long long now_ = __builtin_amdgcn_s_memrealtime(); if ((PROBE_MASK >> (k)) & 1) pr_acc += now_ - pr_prev; pr_prev = now_; } while (0)
#define PROBE_END() do { xcd_barrier(bar); PROBE_STAMP(11); if (blockIdx.x == 0 && __builtin_amdgcn_mbcnt_hi(~0u, __builtin_amdgcn_mbcnt_lo(~0u, 0u)) == 0u) { const unsigned long long t0_ = __builtin_amdgcn_s_memrealtime(); while (__builtin_amdgcn_s_memrealtime() - t0_ < (unsigned long long)PROBE_K * pr_acc) __builtin_amdgcn_s_sleep(8); } } while (0)
#else
#define PROBE_DECL unsigned long long pr_prev = 0ull, pr_acc = 0ull
#define PROBE_SUB(k)
#define PROBE_STAMP(k)
#define PROBE_END() do { for (int i_ = 0; i_ < PROBE_XSYNC; ++i_) xcd_barrier(bar); } while (0)
#endif
__global__ void __launch_bounds__(512, 2) fwd_megakernel(P p) {
    extern __shared__ __attribute__((aligned(16))) unsigned char lds_raw[];
    LAS unsigned char* lds = (LAS unsigned char*)lds_raw;
    cg::grid_group grid = cg::this_grid();
    PROBE_DECL;
    volatile LAS unsigned* MISC = (volatile LAS unsigned*)(lds + LDS_BYTES - 64);
    if (threadIdx.x < 16) MISC[threadIdx.x] = 0u;
    __syncthreads();
    const XcdBarrier bar = xcd_barrier_post((unsigned*)(p.ws + WS_CTL) + CW_BAR, MISC);
    phase_mod(p, lds, pr_prev, pr_acc); PROBE_STAMP(31); phase_transposes(p, lds);
    if (p.ws == nullptr) grid.sync();
    xcd_barrier(bar); PROBE_STAMP(0);
    phase_norm<0>(p, lds);
    xcd_barrier(bar); PROBE_STAMP(1);
    { pg8::StaticOrder S; pg8::Gemm g{ws_h(p, WS_H), ws_h(p, WS_WT_IN), T, PLD, D}; S.init(T, PLD, gridDim.x, blockIdx.x, D); pg8::EpiStoreBf16 E{ws_h(p, WS_PROJ), PLD};
      pg8::gemm_phase<pg8::EpiStoreBf16, pg8::StaticOrder, true, true>(lds, g, S, E); }
    xcd_barrier(bar); PROBE_STAMP(2);
    phase_state_out(p);
    PROBE_STAMP(21);
    phase_dnprep(p, lds, pr_prev, pr_acc);
    PROBE_SUB(12);
    phase_dnsample(p, lds, pr_prev, pr_acc);
    PROBE_SUB(13);
    phase_swa(p, lds, pr_prev, pr_acc);
    xcd_barrier(bar); PROBE_STAMP(3);
    phase_dns_passA(p, lds);
    xcd_barrier(bar); PROBE_STAMP(14);
    phase_dns_passB(p, lds);
    xcd_barrier(bar); PROBE_STAMP(15);
    phase_dns_passC(p, lds);
    xcd_barrier(bar); PROBE_STAMP(4);
    phase_dngate(p);
    xcd_barrier(bar); PROBE_STAMP(5);
    { pg8::SplitOrder S; pg8::Gemm g{ws_h(p, WS_MIX), ws_h(p, WS_WT_OUT), T, D, 1024}; S.init(D, 1024, NS_OUT, gridDim.x, blockIdx.x); pg8::EpiGateRes<0> E{p.x_prompt, p.x_sample, ws_h(p, WS_XB), ws_f(p, WS_MOD) + 2 * D, p.out + O_Y, NS_OUT};
      pg8::gemm_phase<pg8::EpiGateRes<0>, pg8::SplitOrder, true, true>(lds, g, S, E); }
    xcd_barrier(bar); PROBE_STAMP(6);
    phase_norm<1>(p, lds);
    xcd_barrier(bar); PROBE_STAMP(7);
    { pg8::StaticOrder S; pg8::Gemm g{ws_h(p, WS_H), ws_h(p, WS_WT_UP), T, 2 * DFF, D}; S.init(T, 2 * DFF, gridDim.x, blockIdx.x, D);
      pg8::EpiFfnUp E{ws_h(p, WS_ACT), ws_f(p, WS_EDGE), ws_f(p, WS_HEAD), p.ffn_conv_w, p.ffn_conv_b, p.state_ffn, p.out + O_PFC, p.out + O_SFC, lds};
      pg8::gemm_phase<pg8::EpiFfnUp, pg8::StaticOrder, true, true>(lds, g, S, E); }
    xcd_barrier(bar); PROBE_STAMP(8);
    { pg8::SplitOrder S; pg8::Gemm g{ws_h(p, WS_ACT), ws_h(p, WS_WT_DN), T, D, DFF}; S.init(D, DFF, NS_DN, gridDim.x, blockIdx.x);
      { constexpr int NU1 = (TP / 256) * (D / 256); for (int L = blockIdx.x; L < NU1; L += gridDim.x) { const int w1 = (L % 8) * (NU1 / 8) + L / 8, pm = (w1 / (8 * (D / 256))) * 8 + (w1 % (8 * (D / 256))) % 8; ffn_fix_tile(p, pm); }
        asm volatile("s_waitcnt vmcnt(0)" ::: "memory"); __syncthreads(); }
      pg8::EpiGateRes<1> E{nullptr, nullptr, ws_h(p, WS_XB), ws_f(p, WS_MOD) + 5 * D, ws_f(p, WS_SLAB_DN), NS_DN};
      pg8::gemm_phase<pg8::EpiGateRes<1>, pg8::SplitOrder, true, true>(lds, g, S, E); }
    xcd_barrier(bar); PROBE_STAMP(10);
    phase_norm<2>(p, lds);
    PROBE_END();
}
extern "C" void kernel_launch(void* const* d_in, const int* in_sizes, int n_in, void* d_out, int out_size, void* d_ws, size_t ws_size, hipStream_t stream) {
    static int grid_blocks = 0;
    if (grid_blocks == 0) {
        if (n_in != 26 || (long)out_size != O_END || ws_size < WS_END) { fprintf(stderr, "kernel_launch: unexpected shapes n_in=%d out=%d ws=%zu (need %zu)\n", n_in, out_size, ws_size, (size_t)WS_END); grid_blocks = -1; return; }
        int dev = 0, cus = 0, per_cu = 0;
        if (hipGetDevice(&dev) != hipSuccess || hipDeviceGetAttribute(&cus, hipDeviceAttributeMultiprocessorCount, dev) != hipSuccess) { grid_blocks = -1; return; }
        if (hipFuncSetAttribute((const void*)fwd_megakernel, hipFuncAttributeMaxDynamicSharedMemorySize, LDS_BYTES) != hipSuccess) { fprintf(stderr, "kernel_launch: hipFuncSetAttribute failed\n"); grid_blocks = -1; return; }
        if (hipOccupancyMaxActiveBlocksPerMultiprocessor(&per_cu, (const void*)fwd_megakernel, NTHR, LDS_BYTES) != hipSuccess || per_cu < 1) { fprintf(stderr, "kernel_launch: occupancy query says %d\n", per_cu); grid_blocks = -1; return; }
        grid_blocks = cus;
        fprintf(stderr, "kernel_launch: grid %d (cus %d, per_cu %d)\n", grid_blocks, cus, per_cu);
    }
    if (grid_blocks < 0) return;
    P p{}; fill_params(p, d_in, d_out, d_ws);
    if (hipMemsetAsync((char*)d_ws + WS_CTL, 0, CTL_ZERO_BYTES, stream) != hipSuccess) { fprintf(stderr, "kernel_launch: memset of the control words failed\n"); return; }
    void* args[] = {&p};
    const hipError_t e = hipLaunchCooperativeKernel((const void*)fwd_megakernel, dim3(grid_blocks), dim3(NTHR), args, LDS_BYTES, stream);
    if (e != hipSuccess) fprintf(stderr, "cooperative launch failed: %s (grid %d)\n", hipGetErrorString(e), grid_blocks);
}
```

```cpp
#include <hip/hip_runtime.h>
#include <hip/hip_cooperative_groups.h>
#include <cstdio>
#include <cstdint>
#define HD __device__ __forceinline__
#if defined(PROBE_MASK) && PROBE_MASK
#define DPS(k) do { const unsigned long long now_ = __builtin_amdgcn_s_memrealtime(); if ((PROBE_MASK >> (k)) & 1) pr_acc += now_ - pr_prev; pr_prev = now_; } while (0)
#endif
#ifndef CFG_D_MODEL
#define CFG_D_MODEL 1024
#endif
#ifndef CFG_SEQ
#define CFG_SEQ 8192
#endif
#ifndef CFG_DEC_BATCH
#define CFG_DEC_BATCH 128
#endif
#ifndef CFG_D_FF
#define CFG_D_FF 2816
#endif

constexpr int D = CFG_D_MODEL, BATCH = 2, SEQ = CFG_SEQ, DEC_BATCH = CFG_DEC_BATCH, DEC_SEQ = 8, DFF = CFG_D_FF;
constexpr int TP = BATCH * SEQ, TS = DEC_BATCH * DEC_SEQ, T = TP + TS, NCB = BATCH + DEC_BATCH;
constexpr int IN_COLS = 2824, PLD = 2816;
constexpr int PC_QKV = 0, PC_Z = 1536, PC_SQ = 2048, PC_SK = 2560, PC_SV = 2688;
constexpr int WC_BA = 2048;
constexpr float EPS = 1e-6f;

constexpr long O_Y = 0;
constexpr long O_PDC = (long)T * D;
constexpr long O_SDC = O_PDC + (long)BATCH * 3 * 1536;
constexpr long O_PSSM = O_SDC + (long)DEC_BATCH * 3 * 1536;
constexpr long O_SSSM = O_PSSM + (long)BATCH * 4 * 128 * 128;
constexpr long O_PK = O_SSSM + (long)DEC_BATCH * 4 * 128 * 128;
constexpr long O_SK = O_PK + (long)BATCH * 128 * 128;
constexpr long O_PV = O_SK + (long)DEC_BATCH * 128 * 128;
constexpr long O_SV = O_PV + (long)BATCH * 128 * 128;
constexpr long O_PFC = O_SV + (long)DEC_BATCH * 128 * 128;
constexpr long O_SFC = O_PFC + (long)BATCH * 2 * 2 * DFF;
constexpr long O_END = O_SFC + (long)DEC_BATCH * 2 * 2 * DFF;

constexpr size_t al256(size_t x) { return (x + 255) & ~(size_t)255; }
constexpr size_t WS_CTL = 0;
constexpr size_t WS_MOD = 1u << 20;
constexpr size_t WS_BG = al256(WS_MOD + (size_t)NCB * 6 * D * 4);
constexpr size_t WS_WBAT = al256(WS_BG + (size_t)T * 8 * 4);
constexpr size_t WS_WT_IN = al256(WS_WBAT + (size_t)8 * D * 4);
constexpr size_t WS_WT_OUT = al256(WS_WT_IN + (size_t)PLD * D * 2);
constexpr size_t WS_WT_UP = al256(WS_WT_OUT + (size_t)D * 1024 * 2);
constexpr size_t WS_WT_DN = al256(WS_WT_UP + (size_t)2 * DFF * D * 2);
constexpr size_t WS_H = al256(WS_WT_DN + (size_t)D * DFF * 2);
constexpr int NCHUNK = SEQ / 64, NUNIT = BATCH * 4 * NCHUNK;
constexpr int DNF_AB_UNIT = 57344, DNF_WV_UNIT = 32768;
constexpr size_t WS_DNF_WV = WS_H;
constexpr size_t WS_DNF_AB = al256(WS_H + (size_t)T * (D > 1024 ? D : 1024) * 2);
constexpr size_t WS_DNF_CD = al256(WS_DNF_AB + (size_t)NUNIT * DNF_AB_UNIT);
constexpr size_t WS_QKVC = WS_DNF_AB;
constexpr size_t WS_PROJ = al256((WS_DNF_CD + (size_t)NUNIT * 4) > (WS_QKVC + (size_t)T * 1536 * 2) ? (WS_DNF_CD + (size_t)NUNIT * 4) : (WS_QKVC + (size_t)T * 1536 * 2));
constexpr size_t WS_MIX = al256(WS_PROJ + (size_t)T * PLD * 2);
constexpr size_t WS_FREE = al256(WS_MIX + (size_t)T * 1024 * 2);
constexpr size_t WS_ODN = WS_H, WS_ACT = WS_PROJ;
static_assert((size_t)NUNIT * DNF_WV_UNIT <= (size_t)T * 1024 * 2, "Wv tiles overlay H");

typedef unsigned short bf16_t;
HD unsigned f2bf_bits(float f) { unsigned u = __builtin_bit_cast(unsigned, f); return (u + 0x7fffu + ((u >> 16) & 1u)) >> 16; }
HD bf16_t f2bf(float f) { return (bf16_t)f2bf_bits(f); }
HD float bf2f(bf16_t b) { return __builtin_bit_cast(float, (unsigned)b << 16); }
HD float silu_f(float x) { return x / (1.0f + expf(-x)); }
HD float sigmoid_f(float x) { return 1.0f / (1.0f + expf(-x)); }
HD float softplus_f(float x) { return x > 20.f ? x : log1pf(expf(x)); }

struct P {
    const float *x_prompt, *x_sample, *state_dn_conv, *state_dn_ssm, *cache_k, *cache_v, *state_ffn, *c_prompt, *c_sample, *rel_bias,
        *final_norm_w, *w_ada, *b_ada, *norm_mix_w, *w_in, *dn_conv_w, *dn_A_log, *dn_dt_bias, *dn_norm_w, *swa_sinks, *w_out, *norm_ffn_w,
        *w_up, *ffn_conv_w, *ffn_conv_b, *w_down;
    float* out; unsigned char* ws;
};

HD const float* xrow(const P& p, int m) { return m < TP ? p.x_prompt + (size_t)m * D : p.x_sample + (size_t)(m - TP) * D; }
HD int cb_of(int m) { return m < TP ? m / SEQ : BATCH + (m - TP) / DEC_SEQ; }
HD int t_of(int m) { return m < TP ? m % SEQ : (m - TP) % DEC_SEQ; }
HD float* ws_f(const P& p, size_t off) { return (float*)(p.ws + off); }
HD bf16_t* ws_h(const P& p, size_t off) { return (bf16_t*)(p.ws + off); }

HD int t5_bucket(int d) {
    if (d < 16) return d;
    const float logv = logf((float)d / 16.0f) / 2.0794415416798357f;
    int b = 16 + (int)(logv * 16.0f);
    return b < 31 ? b : 31;
}

#define LAS __attribute__((address_space(3)))
typedef float f32x4 __attribute__((ext_vector_type(4)));
typedef unsigned u32x4 __attribute__((ext_vector_type(4)));
typedef unsigned u32x2 __attribute__((ext_vector_type(2)));
constexpr int NWAVES = 8, NTHR = 512;
constexpr int LDS_BYTES = 163840;
__device__ __forceinline__ int otid() { int t = threadIdx.x; asm volatile("" : "+v"(t)); return t; }
#define LDS_BARRIER() do { asm volatile("s_waitcnt lgkmcnt(0)" ::: "memory"); __builtin_amdgcn_s_barrier(); asm volatile("" ::: "memory"); } while (0)
__device__ __forceinline__ float wave_sum(float v) {
#pragma unroll
    for (int o = 1; o < 64; o <<= 1) v += __shfl_xor(v, o);
    return v;
}
__device__ __forceinline__ unsigned pk2(float lo, float hi) { return f2bf_bits(lo) | (f2bf_bits(hi) << 16); }

__device__ __forceinline__ void transpose_item(const float* W, int ldw, int K, bf16_t* WT, int dst_n0, int src_n0, int k0, LAS float* scr, int lane) {
#pragma unroll
    for (int i = 0; i < 32; ++i) { const int kk = 2 * i + (lane >> 5); scr[kk * 33 + (lane & 31)] = W[(size_t)(k0 + kk) * ldw + src_n0 + (lane & 31)]; }
    asm volatile("s_waitcnt lgkmcnt(0)" ::: "memory");
    const int c = lane & 7;
#pragma unroll
    for (int j = 0; j < 4; ++j) { const int n = (lane >> 3) + 8 * j; const LAS float* s = scr + (8 * c) * 33 + n;
        u32x4 o; o.x = pk2(s[0 * 33], s[1 * 33]); o.y = pk2(s[2 * 33], s[3 * 33]); o.z = pk2(s[4 * 33], s[5 * 33]); o.w = pk2(s[6 * 33], s[7 * 33]);
        *(u32x4*)(WT + (size_t)(dst_n0 + n) * K + k0 + 8 * c) = o; }
    asm volatile("s_waitcnt lgkmcnt(0)" ::: "memory");
}
constexpr int TI_IN = (PLD / 32) * (D / 64), TI_OUT = (D / 32) * (1024 / 64), TI_UP = (2 * DFF / 32) * (D / 64), TI_DN = (D / 32) * (DFF / 64), TI_ALL = TI_IN + TI_OUT + TI_UP + TI_DN;
__device__ __forceinline__ void phase_transposes(const P& p, LAS unsigned char* lds) {
    const int tid_ = otid(), lane = tid_ & 63, wave = tid_ >> 6;
    LAS float* scr = (LAS float*)(lds + wave * 16384);
    if (blockIdx.x == gridDim.x - 1) { for (int i = tid_; i < 8 * D; i += NTHR) ws_f(p, WS_WBAT)[i] = p.w_in[(size_t)(i % D) * IN_COLS + WC_BA + i / D]; }
    constexpr int NCG_MOD = 6 * D / 32;
    const bool split = (int)gridDim.x >= NCG_MOD + 32;
    if (split && (int)blockIdx.x < NCG_MOD) return;
    const int gw = (split ? (int)blockIdx.x - NCG_MOD : (int)blockIdx.x) * NWAVES + wave, NGW = (split ? (int)gridDim.x - NCG_MOD : (int)gridDim.x) * NWAVES;
    for (int it = gw; it < TI_ALL; it += NGW) {
        int r = it;
        if (r < TI_IN) { const int nb = r % (PLD / 32), kb = r / (PLD / 32), n0 = nb * 32; transpose_item(p.w_in, IN_COLS, D, ws_h(p, WS_WT_IN), n0, n0 < WC_BA ? n0 : n0 + 8, kb * 64, scr, lane); continue; } r -= TI_IN;
        if (r < TI_OUT) { const int nb = r % (D / 32), kb = r / (D / 32), n0 = nb * 32; transpose_item(p.w_out, D, 1024, ws_h(p, WS_WT_OUT), n0, n0, kb * 64, scr, lane); continue; } r -= TI_OUT;
        if (r < TI_UP) { const int nb = r % (2 * DFF / 32), kb = r / (2 * DFF / 32), n0 = nb * 32;
            const int pn = n0 >> 8, bj = (n0 >> 7) & 1, c = n0 & 127; transpose_item(p.w_up, 2 * DFF, D, ws_h(p, WS_WT_UP), n0, bj * DFF + 128 * pn + c, kb * 64, scr, lane); continue; } r -= TI_UP;
        { const int nb = r % (D / 32), kb = r / (D / 32), n0 = nb * 32; transpose_item(p.w_down, D, DFF, ws_h(p, WS_WT_DN), n0, n0, kb * 64, scr, lane); }
    }
}
typedef short bf16x8m __attribute__((ext_vector_type(8)));
typedef float f32x2m __attribute__((ext_vector_type(2))); typedef __bf16 bf16x2m __attribute__((ext_vector_type(2)));
__device__ __forceinline__ unsigned cvtpk_m(float lo, float hi) { const f32x2m v = {lo, hi}; return __builtin_bit_cast(unsigned, __builtin_convertvector(v, bf16x2m)); }
__device__ __forceinline__ void split8(const float (&x)[8], bf16x8m& hi, bf16x8m& lo) {
    unsigned h[4], l[4];
#pragma unroll
    for (int e = 0; e < 4; ++e) { h[e] = cvtpk_m(x[2 * e], x[2 * e + 1]);
        l[e] = cvtpk_m(x[2 * e] - __builtin_bit_cast(float, h[e] << 16), x[2 * e + 1] - __builtin_bit_cast(float, h[e] & 0xffff0000u)); }
    hi = __builtin_bit_cast(bf16x8m, (u32x4){h[0], h[1], h[2], h[3]}); lo = __builtin_bit_cast(bf16x8m, (u32x4){l[0], l[1], l[2], l[3]});
}
__device__ __forceinline__ float silu_fast(float x) { return x * __builtin_amdgcn_rcpf(1.0f + __expf(-x)); }
#ifndef DPS
#define DPS(k)
#endif
__device__ __forceinline__ void phase_mod(const P& p, LAS unsigned char* lds, unsigned long long& pr_prev, unsigned long long& pr_acc) {
    constexpr int KC = 256, NCG = 6 * D / 32, NCH = D / KC, NMT = (NCB + 15) / 16;
    static_assert(NMT == 9 && KC / 32 == NWAVES, "eight full m-tiles + one k-split tile");
    constexpr int KCP = KC + 4;
    LAS float* WB = (LAS float*)lds;
    LAS float* RX = WB + 2 * 32 * KCP;
    const int tid = otid(), lane = tid & 63, wave = tid >> 6, r16 = lane & 15, g4 = lane >> 4;
    for (int cg = blockIdx.x; cg < NCG; cg += gridDim.x) {
        f32x4 acc[2][2];
#pragma unroll
        for (int s = 0; s < 2; ++s)
#pragma unroll
            for (int nt = 0; nt < 2; ++nt) acc[s][nt] = (f32x4){0.f, 0.f, 0.f, 0.f};
        f32x4 wreg[4];
#pragma unroll
        for (int j = 0; j < 4; ++j) { const int idx = tid + NTHR * j; wreg[j] = *(const f32x4*)(p.w_ada + (size_t)(idx >> 3) * 6 * D + cg * 32 + 4 * (idx & 7)); }
        LDS_BARRIER();
        const int row0 = 16 * wave + r16, row8 = 128 + r16;
        const float* c0 = (row0 < BATCH ? p.c_prompt + (size_t)row0 * D : p.c_sample + (size_t)(row0 - BATCH) * D) + 8 * g4;
        const float* c8 = p.c_sample + (size_t)((row8 < NCB ? row8 : NCB - 1) - BATCH) * D + 8 * g4;
#pragma unroll
        for (int ch = 0; ch < NCH; ++ch) {
            LAS float* wb = WB + (ch & 1) * 32 * KCP;
#pragma unroll
            for (int j = 0; j < 4; ++j) { const int idx = tid + NTHR * j;
#pragma unroll
                for (int e = 0; e < 4; ++e) wb[(4 * (idx & 7) + e) * KCP + (idx >> 3)] = wreg[j][e]; }
            f32x4 areg[KC / 32 + 1][2];
#pragma unroll
            for (int ks = 0; ks < KC / 32; ++ks) { areg[ks][0] = *(const f32x4*)(c0 + ch * KC + 32 * ks); areg[ks][1] = *(const f32x4*)(c0 + ch * KC + 32 * ks + 4); }
            areg[KC / 32][0] = *(const f32x4*)(c8 + ch * KC + 32 * wave); areg[KC / 32][1] = *(const f32x4*)(c8 + ch * KC + 32 * wave + 4);
            if (ch + 1 < NCH) {
#pragma unroll
                for (int j = 0; j < 4; ++j) { const int idx = tid + NTHR * j; wreg[j] = *(const f32x4*)(p.w_ada + (size_t)((ch + 1) * KC + (idx >> 3)) * 6 * D + cg * 32 + 4 * (idx & 7)); }
            }
            LDS_BARRIER(); DPS(16);
#pragma unroll
            for (int st = 0; st <= KC / 32; ++st) {
                const int ks = st < KC / 32 ? st : wave, s = st < KC / 32 ? 0 : 1;
                bf16x8m bh[2], bl[2];
#pragma unroll
                for (int nt = 0; nt < 2; ++nt) { const LAS float* wp = wb + (16 * nt + r16) * KCP + 32 * ks + 8 * g4; const f32x4 w0 = *(const LAS f32x4*)wp, w1 = *(const LAS f32x4*)(wp + 4);
                    const float x[8] = {w0[0], w0[1], w0[2], w0[3], w1[0], w1[1], w1[2], w1[3]};
                    split8(x, bh[nt], bl[nt]); }
                const bool valid = st < KC / 32 ? row0 < NCB : row8 < NCB;
                float x[8]; const f32x4 a = areg[st][0], d = areg[st][1];
                x[0] = silu_fast(a[0]); x[1] = silu_fast(a[1]); x[2] = silu_fast(a[2]); x[3] = silu_fast(a[3]); x[4] = silu_fast(d[0]); x[5] = silu_fast(d[1]); x[6] = silu_fast(d[2]); x[7] = silu_fast(d[3]);
#pragma unroll
                for (int j = 0; j < 8; ++j) x[j] = valid ? x[j] : 0.f;
                bf16x8m ah, al; split8(x, ah, al);
#pragma unroll
                for (int nt = 0; nt < 2; ++nt) {
                    acc[s][nt] = __builtin_amdgcn_mfma_f32_16x16x32_bf16(ah, bh[nt], acc[s][nt], 0, 0, 0);
                    acc[s][nt] = __builtin_amdgcn_mfma_f32_16x16x32_bf16(ah, bl[nt], acc[s][nt], 0, 0, 0);
                    acc[s][nt] = __builtin_amdgcn_mfma_f32_16x16x32_bf16(al, bh[nt], acc[s][nt], 0, 0, 0); }
            }
            DPS(17);
        }
#pragma unroll
        for (int nt = 0; nt < 2; ++nt) { *(LAS f32x4*)(RX + ((wave * 2 + nt) * 64 + lane) * 4) = acc[1][nt]; }
#pragma unroll
        for (int nt = 0; nt < 2; ++nt) { const int e = cg * 32 + 16 * nt + r16; const float bb = p.b_ada[e];
#pragma unroll
            for (int i = 0; i < 4; ++i) { const int row = 16 * wave + 4 * g4 + i; if (row < NCB) ws_f(p, WS_MOD)[(size_t)row * 6 * D + e] = acc[0][nt][i] + bb; } }
        LDS_BARRIER();
        if (wave == 0) {
#pragma unroll
            for (int nt = 0; nt < 2; ++nt) { f32x4 t = (f32x4){0.f, 0.f, 0.f, 0.f};
#pragma unroll
                for (int w = 0; w < NWAVES; ++w) t += *(const LAS f32x4*)(RX + ((w * 2 + nt) * 64 + lane) * 4);
                const int e = cg * 32 + 16 * nt + r16; const float bb = p.b_ada[e];
#pragma unroll
                for (int i = 0; i < 4; ++i) { const int row = 128 + 4 * g4 + i; if (row < NCB) ws_f(p, WS_MOD)[(size_t)row * 6 * D + e] = t[i] + bb; } }
        }
    }
    LDS_BARRIER();
}
constexpr int NS_OUT = 4, NS_DN = 11;
constexpr size_t SLAB_DN_BYTES = (size_t)(TS / 256) * (D / 256) * NS_DN * 65536 * 4, WS_SLAB_DN = WS_H;
constexpr size_t WS_XB = al256(WS_SLAB_DN + SLAB_DN_BYTES);
static_assert(WS_XB >= WS_DNF_AB && WS_XB + (size_t)T * D * 2 <= WS_DNF_CD && (size_t)(TS / 256) * (D / 256) * NS_OUT * 65536 <= (size_t)T * D, "residual stream / slabs fit");
template <int WHICH> __device__ __forceinline__ void norm_row_tail(const P& p, int m, int lane, const f32x4 (&v)[4], const f32x4 (&nwv)[4], const LAS float* wbt, int& cbc, f32x4 (&scv)[4], f32x4 (&shv)[4], float nalog, float dtb) {
    float ss = 0.f;
#pragma unroll
    for (int j = 0; j < 4; ++j) ss += (v[j][0] * v[j][0] + v[j][1] * v[j][1]) + (v[j][2] * v[j][2] + v[j][3] * v[j][3]);
    const float rstd = 1.0f / sqrtf(wave_sum(ss) * (1.0f / D) + EPS);
    if (WHICH == 2) {
#pragma unroll
        for (int j = 0; j < 4; ++j) ((f32x4*)(p.out + O_Y + (size_t)m * D))[lane + 64 * j] = v[j] * rstd * nwv[j];
        return;
    }
    const int cb = cb_of(m);
    if (cb != cbc) {
        const float* mod = ws_f(p, WS_MOD) + (size_t)cb * 6 * D;
        const float* sh = mod + (WHICH == 0 ? 0 : 3 * D); const float* sc = mod + (WHICH == 0 ? D : 4 * D);
#pragma unroll
        for (int j = 0; j < 4; ++j) { scv[j] = ((const f32x4*)sc)[lane + 64 * j] + 1.0f; shv[j] = ((const f32x4*)sh)[lane + 64 * j]; }
        cbc = cb;
    }
    float ba[8];
#pragma unroll
    for (int j = 0; j < 8; ++j) ba[j] = 0.f;
    unsigned long long* o8 = (unsigned long long*)(ws_h(p, WS_H) + (size_t)m * D);
#pragma unroll
    for (int j = 0; j < 4; ++j) {
        const f32x4 h = v[j] * rstd * nwv[j] * scv[j] + shv[j];
        o8[lane + 64 * j] = (unsigned long long)cvtpk_m(h[0], h[1]) | ((unsigned long long)cvtpk_m(h[2], h[3]) << 32);
        if (WHICH == 0) {
#pragma unroll
            for (int c = 0; c < 8; ++c) { const f32x4 w = *(const LAS f32x4*)(wbt + c * D + 4 * (lane + 64 * j)); ba[c] += (h[0] * w[0] + h[1] * w[1]) + (h[2] * w[2] + h[3] * w[3]); }
            asm volatile("" ::: "memory");
        }
    }
    if (WHICH == 0) {
        float t4[4], t2[2], t1;
        const bool h5 = lane & 32, h4 = lane & 16, h3 = lane & 8;
#pragma unroll
        for (int c = 0; c < 4; ++c) { const float snd = h5 ? ba[c] : ba[c + 4], kp = h5 ? ba[c + 4] : ba[c]; t4[c] = kp + __shfl_xor(snd, 32); }
#pragma unroll
        for (int c = 0; c < 2; ++c) { const float snd = h4 ? t4[c] : t4[c + 2], kp = h4 ? t4[c + 2] : t4[c]; t2[c] = kp + __shfl_xor(snd, 16); }
        { const float snd = h3 ? t2[0] : t2[1], kp = h3 ? t2[1] : t2[0]; t1 = kp + __shfl_xor(snd, 8); }
        t1 += __shfl_xor(t1, 4); t1 += __shfl_xor(t1, 2); t1 += __shfl_xor(t1, 1);
        if ((lane & 7) == 0) { const int c = lane >> 3; float* bg = ws_f(p, WS_BG) + (size_t)m * 8;
            bg[c] = c < 4 ? sigmoid_f(t1) : nalog * softplus_f(t1 + dtb); }
    }
}
template <int WHICH> __device__ __forceinline__ void phase_norm(const P& p, LAS unsigned char* lds) {
    static_assert(D == 1024, "one wave per 1024-element row");
    const int tid_ = otid(), lane = tid_ & 63, wave = tid_ >> 6;
    const int gw = blockIdx.x * NWAVES + wave, NGW = gridDim.x * NWAVES;
    const float* nwp = WHICH == 0 ? p.norm_mix_w : (WHICH == 1 ? p.norm_ffn_w : p.final_norm_w);
    f32x4 nwv[4];
#pragma unroll
    for (int j = 0; j < 4; ++j) nwv[j] = ((const f32x4*)nwp)[lane + 64 * j];
    const LAS float* wbt = (const LAS float*)lds;
    if (WHICH == 0) { for (int i = tid_; i < 8 * D / 4; i += NTHR) ((LAS f32x4*)lds)[i] = ((const f32x4*)ws_f(p, WS_WBAT))[i]; LDS_BARRIER(); }
    const bf16_t* XB = ws_h(p, WS_XB);
    int cbc = -1; f32x4 scv[4], shv[4];
    const float nalog = WHICH == 0 ? -expf(p.dn_A_log[(lane >> 3) & 3]) : 0.f, dtb = WHICH == 0 ? p.dn_dt_bias[(lane >> 3) & 3] : 0.f;
    constexpr int MEND = WHICH == 0 ? T : TP;
    typedef f32x4 rowbuf_t[4];
    rowbuf_t ra, rb, rc;
#define NR_LOAD(buf_, mm0_) do { const int mm_ = (mm0_) < MEND ? (mm0_) : MEND - 1; { if (WHICH == 0) { const float* xr_ = xrow(p, (mm_)); _Pragma("unroll") for (int j = 0; j < 4; ++j) buf_[j] = ((const f32x4*)xr_)[lane + 64 * j]; } \
        else { const u32x2* xr_ = (const u32x2*)(XB + (size_t)(mm_) * D); u32x2 w_[4]; _Pragma("unroll") for (int j = 0; j < 4; ++j) w_[j] = xr_[lane + 64 * j]; \
            buf_[0] = __builtin_bit_cast(f32x4, (u32x4){w_[0].x, w_[0].y, w_[1].x, w_[1].y}); buf_[1] = __builtin_bit_cast(f32x4, (u32x4){w_[2].x, w_[2].y, w_[3].x, w_[3].y}); } } } while (0)
#define NR_PROC(buf_, mm_) do { if ((mm_) < MEND) { f32x4 v_[4]; if (WHICH == 0) { _Pragma("unroll") for (int j = 0; j < 4; ++j) v_[j] = buf_[j]; } \
        else { const u32x4 a_ = __builtin_bit_cast(u32x4, buf_[0]), b_ = __builtin_bit_cast(u32x4, buf_[1]); const unsigned w_[8] = {a_.x, a_.y, a_.z, a_.w, b_.x, b_.y, b_.z, b_.w}; \
            _Pragma("unroll") for (int j = 0; j < 4; ++j) v_[j] = (f32x4){__builtin_bit_cast(float, w_[2 * j] << 16), __builtin_bit_cast(float, w_[2 * j] & 0xffff0000u), __builtin_bit_cast(float, w_[2 * j + 1] << 16), __builtin_bit_cast(float, w_[2 * j + 1] & 0xffff0000u)}; } \
        norm_row_tail<WHICH>(p, (mm_), lane, v_, nwv, wbt, cbc, scv, shv, nalog, dtb); } } while (0)
    NR_LOAD(ra, gw); NR_LOAD(rb, gw + NGW);
    for (int m = gw; m < MEND; m += 3 * NGW) {
        NR_LOAD(rc, m + 2 * NGW); NR_PROC(ra, m);
        NR_LOAD(ra, m + 3 * NGW); NR_PROC(rb, m + NGW);
        NR_LOAD(rb, m + 4 * NGW); NR_PROC(rc, m + 2 * NGW);
    }
#undef NR_LOAD
#undef NR_PROC
    if (WHICH != 0) {
        constexpr int NS = WHICH == 1 ? NS_OUT : NS_DN;
        const float* slabs = WHICH == 1 ? p.out + O_Y : ws_f(p, WS_SLAB_DN);
        for (int rs = gw; rs < TS; rs += NGW) { const int m = TP + rs, cbs = BATCH + (rs >> 3);
            const float* gt = ws_f(p, WS_MOD) + (size_t)cbs * 6 * D + (WHICH == 1 ? 2 * D : 5 * D);
            f32x4 vs[4];
#pragma unroll
            for (int j = 0; j < 4; ++j) { const float* sl = slabs + ((size_t)((rs >> 8) * 4 + j) * NS) * 65536 + (size_t)(rs & 255) * 256 + 4 * lane;
                f32x4 acc = (f32x4){0.f, 0.f, 0.f, 0.f};
#pragma unroll
                for (int ks = 0; ks < NS; ++ks) { acc += *(const f32x4*)sl; sl += 65536; asm volatile("" : "+v"(sl)); }
                f32x4 base;
                if (WHICH == 1) base = ((const f32x4*)(p.x_sample + (size_t)rs * D))[lane + 64 * j];
                else { const u32x2 w = ((const u32x2*)(XB + (size_t)m * D))[lane + 64 * j]; base = (f32x4){__builtin_bit_cast(float, w.x << 16), __builtin_bit_cast(float, w.x & 0xffff0000u), __builtin_bit_cast(float, w.y << 16), __builtin_bit_cast(float, w.y & 0xffff0000u)}; }
                vs[j] = base + ((const f32x4*)gt)[lane + 64 * j] * acc;
                if (WHICH == 1) ((u32x2*)(ws_h(p, WS_XB) + (size_t)m * D))[lane + 64 * j] = (u32x2){cvtpk_m(vs[j][0], vs[j][1]), cvtpk_m(vs[j][2], vs[j][3])};
                asm volatile("" ::: "memory"); }
            norm_row_tail<WHICH>(p, m, lane, vs, nwv, wbt, cbc, scv, shv, nalog, dtb);
        }
    }
}

constexpr long SO_1 = (long)BATCH * 3 * 1536 / 4, SO_2 = (long)DEC_BATCH * 3 * 1536 / 4, SO_3 = (long)BATCH * 128 * 128 / 4, SO_4 = (long)DEC_BATCH * 128 * 128 / 4, SO_N = SO_1 + SO_2 + 2 * (SO_3 + SO_4);
__device__ __forceinline__ void so_item(const P& p, long it, f32x4& val, float*& dst) {
    const bf16_t* PR = ws_h(p, WS_PROJ); const bf16_t* src = nullptr; const float* fsrc = nullptr;
    long r = it;
    if (r < SO_1) { const int b = (int)(r / (3 * 384)), j = (int)(r / 384 % 3), c = (int)(r % 384) * 4; src = PR + (size_t)(b * SEQ + SEQ - 3 + j) * PLD + PC_QKV + c; dst = p.out + O_PDC + r * 4; }
    else if ((r -= SO_1) < SO_2) { const int b = (int)(r / (3 * 384)), j = (int)(r / 384 % 3), c = (int)(r % 384) * 4; src = PR + (size_t)(TP + b * DEC_SEQ + DEC_SEQ - 3 + j) * PLD + PC_QKV + c; dst = p.out + O_SDC + r * 4; }
    else { r -= SO_2; const int kv = r >= SO_3 + SO_4; if (kv) r -= SO_3 + SO_4; const int pc = kv ? PC_SV : PC_SK; const float* cache = kv ? p.cache_v : p.cache_k;
        if (r < SO_3) { const int b = (int)(r / (128 * 32)), j = (int)(r / 32 % 128), c = (int)(r % 32) * 4; src = PR + (size_t)(b * SEQ + SEQ - 128 + j) * PLD + pc + c; dst = p.out + (kv ? O_PV : O_PK) + r * 4; }
        else { r -= SO_3; const int b = (int)(r / (128 * 32)), j = (int)(r / 32 % 128), c = (int)(r % 32) * 4; dst = p.out + (kv ? O_SV : O_SK) + r * 4;
            if (j < 128 - DEC_SEQ) fsrc = cache + ((size_t)b * 128 + j + DEC_SEQ) * 128 + c; else src = PR + (size_t)(TP + b * DEC_SEQ + (j - (128 - DEC_SEQ))) * PLD + pc + c; } }
    if (fsrc) val = *(const f32x4*)fsrc;
    else { const u32x2 w = *(const u32x2*)src; val = (f32x4){__builtin_bit_cast(float, w.x << 16), __builtin_bit_cast(float, w.x & 0xffff0000u), __builtin_bit_cast(float, w.y << 16), __builtin_bit_cast(float, w.y & 0xffff0000u)}; }
}
__device__ __forceinline__ void phase_state_out(const P& p, int vblk, int nblk) {
    const long gt = vblk * (long)NTHR + otid(), gs = (long)nblk * NTHR;
    for (long it = gt; it < SO_N; it += 4 * gs) {
        f32x4 v[4]; float* d[4];
#pragma unroll
        for (int u = 0; u < 4; ++u) if (it + u * gs < SO_N) so_item(p, it + u * gs, v[u], d[u]);
#pragma unroll
        for (int u = 0; u < 4; ++u) if (it + u * gs < SO_N) *(f32x4*)d[u] = v[u];
    }
}
#define XB_TMO      128
#define XB_XCNT(j)  (256  + 64 * (j))
#define XB_XSUB(j)  (1280 + 64 * (j))
#define XB_XGEN(j)  (2304 + 64 * (j))
#define XB_TOP      3328
#define XB_TOPGEN   3392
#define XCD_BAR_WORDS 3456
#define XB_SPIN_CAP (1u << 18)

__device__ __forceinline__ unsigned xb_ld(unsigned* p)              { return __hip_atomic_load(p, __ATOMIC_RELAXED, __HIP_MEMORY_SCOPE_AGENT); }
__device__ __forceinline__ unsigned xb_add(unsigned* p, unsigned v) { return __hip_atomic_fetch_add(p, v, __ATOMIC_RELAXED, __HIP_MEMORY_SCOPE_AGENT); }
__device__ __forceinline__ unsigned xb_xcc_id() { return (unsigned)__builtin_amdgcn_s_getreg((3 << 11) | 20) & 0xFu; }
#define XB_SPIN(cond, bar) do { unsigned _sp = 0; while (cond) { __builtin_amdgcn_s_sleep(1); \
    if ((++_sp & 255u) == 0u) { if (xb_ld(&(bar)[XB_TMO])) break; if (_sp > XB_SPIN_CAP) { atomicAdd(&(bar)[XB_TMO], 1u); break; } } } } while (0)

struct XcdBarrier {
    unsigned* bar; unsigned x;
    volatile LAS unsigned* st;
};

__device__ __forceinline__ XcdBarrier xcd_barrier_post(unsigned* bar, volatile LAS unsigned* st) {
    XcdBarrier b; b.bar = bar; b.x = xb_xcc_id(); b.st = st;
    if (threadIdx.x == 0) (void)xb_add(&bar[XB_XCNT(b.x)], 1u);
    return b;
}
__device__ __forceinline__ void xcd_barrier_complete(unsigned* bar, unsigned x, unsigned& nloc, unsigned& nx) {
    const unsigned G = gridDim.x * gridDim.y * gridDim.z;
    unsigned sum, cnt, mine, sp = 0u;
    for (;;) {
        sum = 0u; cnt = 0u; mine = 0u;
#pragma unroll
        for (unsigned j = 0; j < 16; ++j) { const unsigned c = xb_ld(&bar[XB_XCNT(j)]); sum += c; cnt += (c > 0u) ? 1u : 0u; mine = (j == x) ? c : mine; }
        if (sum == G) break;
        __builtin_amdgcn_s_sleep(1);
        if ((++sp & 255u) == 0u) { if (xb_ld(&bar[XB_TMO])) break; if (sp > XB_SPIN_CAP) { atomicAdd(&bar[XB_TMO], 1u); break; } }
    }
    nloc = mine > 0u ? mine : 1u; nx = cnt > 0u ? cnt : 1u;
}

__device__ __forceinline__ void xcd_barrier(const XcdBarrier& b) {
    asm volatile("s_waitcnt vmcnt(0)" ::: "memory");
    __syncthreads();
    if (threadIdx.x == 0) {
        unsigned* bar = b.bar;
        __builtin_amdgcn_s_waitcnt(0);
        unsigned nloc = b.st[0], nx = b.st[1];
        if (nloc == 0u) { xcd_barrier_complete(bar, b.x, nloc, nx); b.st[0] = nloc; b.st[1] = nx; }
        const unsigned old = xb_add(&bar[XB_XSUB(b.x)], 1u);
        const unsigned gen = old / nloc;
        if (old + 1u == (gen + 1u) * nloc) {
            __builtin_amdgcn_fence(__ATOMIC_RELEASE, "agent");
            asm volatile("s_waitcnt vmcnt(0)" ::: "memory");
            const unsigned og = xb_add(&bar[XB_TOP], 1u);
            const unsigned tg = og / nx;
            if (og + 1u == (tg + 1u) * nx) xb_add(&bar[XB_TOPGEN], 1u);
            else XB_SPIN(xb_ld(&bar[XB_TOPGEN]) == tg, bar);
            __builtin_amdgcn_fence(__ATOMIC_ACQUIRE, "agent");
            xb_add(&bar[XB_XGEN(b.x)], 1u);
            asm volatile("s_waitcnt vmcnt(0)" ::: "memory");
        } else {
            XB_SPIN(xb_ld(&bar[XB_XGEN(b.x)]) == gen, bar);
            __builtin_amdgcn_fence(__ATOMIC_ACQUIRE, "agent");
            asm volatile("s_waitcnt vmcnt(0)" ::: "memory");
        }
    }
    __syncthreads();
}
namespace pg8 {
#define PG8_LAS __attribute__((address_space(3)))
typedef unsigned short bf16_t;
typedef short bf16x8 __attribute__((ext_vector_type(8)));
typedef float f32x4 __attribute__((ext_vector_type(4)));
typedef unsigned u32x4 __attribute__((ext_vector_type(4)));
constexpr int BM = 256, BK = 64, HALF = 128, HTB = HALF * BK * 2  , STAGE_BYTES = 8 * HTB, NXCD = 8, WGM = 8;

__host__ __device__ __forceinline__ int lds_byte(int r, int c) { const int st = (r >> 4) * 2 + (c >> 5), rr = r & 15, cc = c & 31, ob = rr * 64 + cc * 2; return st * 1024 + (ob ^ (((ob >> 9) & 1) << 5)); }
__host__ __device__ __forceinline__ void stage_rc(int b, int& R, int& C) { const int st = b / 1024, sb = b % 1024, swz = sb ^ (((sb >> 9) & 1) << 5); R = (st >> 1) * 16 + swz / 64; C = (st & 1) * 32 + (swz % 64) / 2; }
__host__ __device__ __forceinline__ int perm32(int rho) { const int n = rho >> 4, i = rho & 15; return 8 * (i >> 2) + 4 * n + (i & 3); }

struct Unit { int pm, pn, k0, nt, atomic; };
struct Gemm { const bf16_t* A; const bf16_t* Bt; int M, N, K; };

struct StaticOrder {
    int nM, nN, nwg, G, c, ntk;
    __host__ __device__ void init(int M, int N, int G_, int c_, int K_) { nM = M / BM; nN = N / BM; nwg = nM * nN; G = G_; c = c_; ntk = K_ / BK; }
    __host__ __device__ bool next(int i, Unit& u) const {
        const long L = (long)i * G + c; if (L >= nwg) return false;
        int wgid = (int)L; { const int q = nwg / NXCD, r = nwg % NXCD, xcd = wgid % NXCD, off = wgid / NXCD; wgid = (xcd < r ? xcd * (q + 1) : r * (q + 1) + (xcd - r) * q) + off; }
        const int nig = WGM * nN, gid = wgid / nig, fm = gid * WGM, gsz = (nM - fm) < WGM ? (nM - fm) : WGM;
        u.pm = fm + ((wgid % nig) % gsz); u.pn = (wgid % nig) / gsz; u.k0 = 0; u.nt = ntk; u.atomic = 0; return true;
    }
    __device__ __forceinline__ void a_ready(const Unit&) const {}
    __device__ __forceinline__ void done(const Unit&) const {}
};

struct SplitOrder {
    StaticOrder so; int nu1, ns, ntk_sub, npn, nsub, G, c;
    __device__ void init(int N, int K, int NS, int G_, int c_) { so.init(TP, N, G_, c_, K); nu1 = so.nwg; ns = NS; ntk_sub = K / BK / NS; npn = N / BM; nsub = (TS / BM) * npn * NS; G = G_; c = c_; }
    __device__ bool next(int i, Unit& u) const {
        const long L = (long)i * G + c; if (L < nu1) return so.next(i, u);
        const int s = (int)(L - nu1); if (s >= nsub) return false;
        const int ks = s % ns, t = s / ns; u.pm = TP / BM + t / npn; u.pn = t % npn; u.k0 = ks * ntk_sub * BK; u.nt = ntk_sub; u.atomic = 1; return true; }
    __device__ __forceinline__ void a_ready(const Unit&) const {}
    __device__ __forceinline__ void done(const Unit&) const {}
};
__device__ __forceinline__ unsigned cvt_pk_bf16(float lo, float hi) { unsigned r; asm volatile("v_cvt_pk_bf16_f32 %0, %1, %2" : "=v"(r) : "v"(lo), "v"(hi)); return r; }
struct EpiStoreBf16 {
    static constexpr bool PERM = true, AFTER_DRAIN = false;
    bf16_t* O; int ldc;
    __device__ __forceinline__ void operator()(const f32x4 (&acc)[2][2][4][2], const Unit& u, int wr, int wc, int fr, int fq) const {
        const int row0 = u.pm * BM + wr * 64 + fr, col0 = u.pn * BM + wc * 32 + 8 * fq;
#pragma unroll
        for (int ai = 0; ai < 2; ++ai)
#pragma unroll
            for (int m = 0; m < 4; ++m) { bf16_t* rowp = O + (size_t)(row0 + ai * HALF + m * 16) * ldc + col0;
#pragma unroll
                for (int bj = 0; bj < 2; ++bj) { const f32x4 v0 = acc[ai][bj][m][0], v1 = acc[ai][bj][m][1];
                    u32x4 w; w.x = cvt_pk_bf16(v0[0], v0[1]); w.y = cvt_pk_bf16(v0[2], v0[3]); w.z = cvt_pk_bf16(v1[0], v1[1]); w.w = cvt_pk_bf16(v1[2], v1[3]);
                    *(u32x4*)(rowp + bj * HALF) = w; } }
    }
};
template <int MODE> struct EpiGateRes {
    static constexpr bool PERM = false, AFTER_DRAIN = false;
    const float* base_p; const float* base_s; bf16_t* xb; const float* gate; float* slab; int ns;
    __device__ __forceinline__ void operator()(const f32x4 (&acc)[2][2][4][2], const Unit& u, int wr, int wc, int fr, int fq) const {
        typedef unsigned u32x2e __attribute__((ext_vector_type(2)));
        const int row0 = u.pm * BM + wr * 64 + fr, col0 = u.pn * BM + wc * 32 + 4 * fq;
        const bool smp = row0 >= TP; const float* base = smp ? base_s - (size_t)TP * D : base_p;
#pragma unroll
        for (int ai = 0; ai < 2; ++ai)
#pragma unroll
            for (int m = 0; m < 4; ++m) { const int r = row0 + ai * HALF + m * 16; const int cb = smp ? BATCH + ((r - TP) >> 3) : r / SEQ;
                const float* gp = gate + (size_t)cb * 6 * D + col0; const size_t off = (size_t)r * D + col0;
#pragma unroll
                for (int bj = 0; bj < 2; ++bj)
#pragma unroll
                    for (int n = 0; n < 2; ++n) {
                        if (u.atomic) { const int sidx = ((u.pm - TP / BM) * (D / BM) + u.pn) * ns + u.k0 / (u.nt * BK);
                            *(f32x4*)(slab + (size_t)sidx * 65536 + (size_t)(r - u.pm * BM) * 256 + (col0 - u.pn * BM) + bj * HALF + n * 16) = acc[ai][bj][m][n]; }
                        else { const f32x4 gv = *(const f32x4*)(gp + bj * HALF + n * 16); f32x4 bs;
                            if (MODE == 0) bs = *(const f32x4*)(base + off + bj * HALF + n * 16);
                            else { const u32x2e w = *(const u32x2e*)(xb + off + bj * HALF + n * 16); bs = (f32x4){__builtin_bit_cast(float, w.x << 16), __builtin_bit_cast(float, w.x & 0xffff0000u), __builtin_bit_cast(float, w.y << 16), __builtin_bit_cast(float, w.y & 0xffff0000u)}; }
                            const f32x4 v = bs + gv * acc[ai][bj][m][n];
                            *(u32x2e*)(xb + off + bj * HALF + n * 16) = (u32x2e){cvt_pk_bf16(v[0], v[1]), cvt_pk_bf16(v[2], v[3])}; } } }
    }
};
template <class Epi, class Sched, bool ALIGN_EPI = false, bool SP2 = false>
__device__ __forceinline__ void gemm_phase(PG8_LAS unsigned char* lds, const Gemm g, const Sched& S, const Epi& E) {
    const int tid = otid(), wid = __builtin_amdgcn_readfirstlane(tid >> 6), lane = tid & 63, wr = wid >> 2, wc = wid & 3, fr = lane & 15, fq = lane >> 4;
    const int K = g.K;
    unsigned voffA[2], voffB[2];
#pragma unroll
    for (int i = 0; i < 2; ++i) { int R, C; stage_rc(tid * 16 + i * 8192, R, C); const int Rb = Epi::PERM ? ((R & ~31) + perm32(R & 31)) : R;
        voffA[i] = (unsigned)(R * K + C) * 2u; voffB[i] = (unsigned)(Rb * K + C) * 2u; }
    const size_t kstep = (size_t)(BK * 2);
    const size_t hstep = (size_t)HALF * K * 2;
    const size_t tstep = 2 * hstep;
    const unsigned ldsw = (unsigned)wid * 1024u;
    const int aoff = lds_byte(wr * 64 + fr, fq * 8), boff = lds_byte(wc * 32 + fr, fq * 8);
#define PG8_SA(b, h) (((b) * 2 + (h)) * HTB)
#define PG8_SB(b, h) ((4 + (b) * 2 + (h)) * HTB)
#define PG8_STAGE(bufoff, gbase, voff) do { _Pragma("unroll") for (int _i = 0; _i < 2; ++_i) \
        __builtin_amdgcn_global_load_lds((const unsigned*)((const char*)(gbase) + (voff)[_i]), (PG8_LAS unsigned*)(lds + (bufoff) + ldsw + _i * 8192), 16, 0, 0); } while (0)
#define PG8_LDA(dst, b, h) do { _Pragma("unroll") for (int m = 0; m < 4; ++m) _Pragma("unroll") for (int k = 0; k < 2; ++k) dst[m][k] = *(const PG8_LAS bf16x8*)(lds + PG8_SA(b, h) + aoff + m * 2048 + k * 1024); } while (0)
#define PG8_LDB(dst, b, h) do { _Pragma("unroll") for (int n = 0; n < 2; ++n) _Pragma("unroll") for (int k = 0; k < 2; ++k) dst[n][k] = *(const PG8_LAS bf16x8*)(lds + PG8_SB(b, h) + boff + n * 2048 + k * 1024); } while (0)
#define PG8_MMA(ai, bj, At, Bt) do { __builtin_amdgcn_s_setprio(1); _Pragma("unroll") for (int m = 0; m < 4; ++m) _Pragma("unroll") for (int n = 0; n < 2; ++n) _Pragma("unroll") for (int k = 0; k < 2; ++k) \
        acc[ai][bj][m][n] = __builtin_amdgcn_mfma_f32_16x16x32_bf16(Bt[n][k], At[m][k], acc[ai][bj][m][n], 0, 0, 0); __builtin_amdgcn_s_setprio(0); } while (0)
#define PG8_WAIT_V(n) asm volatile("s_waitcnt vmcnt(" #n ")" ::: "memory")
#define PG8_WAIT_L(n) asm volatile("s_waitcnt lgkmcnt(" #n ")" ::: "memory")
#define PG8_BAR __builtin_amdgcn_s_barrier()
#define PG8_SCHED __builtin_amdgcn_sched_barrier(0)
    Unit cur, nxt; int ui = 0;
    if (!S.next(0, cur)) return;
    f32x4 acc[2][2][4][2];
#pragma unroll
    for (int a = 0; a < 2; ++a)
#pragma unroll
        for (int b = 0; b < 2; ++b)
#pragma unroll
            for (int m = 0; m < 4; ++m)
#pragma unroll
                for (int n = 0; n < 2; ++n) acc[a][b][m][n] = (f32x4){0.f, 0.f, 0.f, 0.f};
    bf16x8 At[4][2], B0[2][2], B1[2][2];
    const char* cA = (const char*)g.A + (size_t)cur.pm * tstep + (size_t)cur.k0 * 2; const char* cB = (const char*)g.Bt + (size_t)cur.pn * tstep + (size_t)cur.k0 * 2;
    S.a_ready(cur);
    if constexpr (SP2) {
        PG8_STAGE(PG8_SB(0, 0), cB, voffB); PG8_STAGE(PG8_SB(0, 1), cB + hstep, voffB); PG8_STAGE(PG8_SA(0, 0), cA, voffA); PG8_STAGE(PG8_SA(0, 1), cA + hstep, voffA);
        if (wr == 1) PG8_BAR;
        PG8_WAIT_V(2); PG8_BAR;
        PG8_STAGE(PG8_SB(1, 0), cB + kstep, voffB); PG8_STAGE(PG8_SA(1, 0), cA + kstep, voffA); PG8_STAGE(PG8_SB(1, 1), cB + hstep + kstep, voffB);
        PG8_WAIT_V(6); PG8_BAR;
    } else {
        PG8_STAGE(PG8_SB(0, 0), cB, voffB); PG8_STAGE(PG8_SA(0, 0), cA, voffA); PG8_STAGE(PG8_SB(0, 1), cB + hstep, voffB); PG8_STAGE(PG8_SA(0, 1), cA + hstep, voffA);
        if (wr == 1) PG8_BAR;
        PG8_WAIT_V(4); PG8_BAR;
        PG8_STAGE(PG8_SB(1, 0), cB + kstep, voffB); PG8_STAGE(PG8_SA(1, 0), cA + kstep, voffA); PG8_STAGE(PG8_SB(1, 1), cB + hstep + kstep, voffB);
        PG8_WAIT_V(6); PG8_BAR;
    }
    for (;;) {
        const bool has_next = S.next(ui + 1, nxt);
        const char* nA = has_next ? (const char*)g.A + (size_t)nxt.pm * tstep + (size_t)nxt.k0 * 2 : cA; const char* nB = has_next ? (const char*)g.Bt + (size_t)nxt.pn * tstep + (size_t)nxt.k0 * 2 : cB;
        const int nt = cur.nt;
        for (int t = 0; t < nt; t += 2) {
            const bool last = (t == nt - 2);
            const char* a1 = cA + (size_t)(t + 1) * kstep;
            const char* a2 = last ? nA : cA + (size_t)(t + 2) * kstep; const char* b2 = last ? nB : cB + (size_t)(t + 2) * kstep;
            const char* a3 = a2 + kstep; const char* b3 = b2 + kstep;
            if (last && has_next) S.a_ready(nxt);
            if constexpr (SP2) {
            PG8_LDB(B0, 0, 0); PG8_LDB(B1, 0, 1); PG8_SCHED; PG8_LDA(At, 0, 0); PG8_STAGE(PG8_SA(1, 1), a1 + hstep, voffA);
            PG8_WAIT_V(8); PG8_WAIT_L(0); PG8_BAR; PG8_MMA(0, 0, At, B0); PG8_MMA(0, 1, At, B1); PG8_BAR; PG8_SCHED;
            PG8_LDA(At, 0, 1); PG8_STAGE(PG8_SB(0, 0), b2, voffB); PG8_STAGE(PG8_SB(0, 1), b2 + hstep, voffB); PG8_STAGE(PG8_SA(0, 0), a2, voffA);
            PG8_WAIT_V(8); PG8_WAIT_L(0); PG8_BAR; PG8_MMA(1, 0, At, B0); PG8_MMA(1, 1, At, B1); PG8_BAR; PG8_SCHED;
            PG8_LDB(B0, 1, 0); PG8_LDB(B1, 1, 1); PG8_SCHED; PG8_LDA(At, 1, 0); PG8_STAGE(PG8_SA(0, 1), a2 + hstep, voffA);
            PG8_WAIT_V(8); PG8_WAIT_L(0); PG8_BAR; PG8_MMA(0, 0, At, B0); PG8_MMA(0, 1, At, B1); PG8_BAR; PG8_SCHED;
            PG8_LDA(At, 1, 1); PG8_STAGE(PG8_SB(1, 0), b3, voffB); PG8_STAGE(PG8_SB(1, 1), b3 + hstep, voffB); PG8_STAGE(PG8_SA(1, 0), a3, voffA);
            PG8_WAIT_V(8); PG8_WAIT_L(0); PG8_BAR; PG8_MMA(1, 0, At, B0); PG8_MMA(1, 1, At, B1); PG8_BAR; PG8_SCHED;
            } else {
            PG8_LDB(B0, 0, 0); PG8_SCHED; PG8_LDA(At, 0, 0); PG8_STAGE(PG8_SA(1, 1), a1 + hstep, voffA);
            PG8_WAIT_L(8); PG8_BAR; PG8_WAIT_L(0); PG8_MMA(0, 0, At, B0); PG8_BAR; PG8_SCHED;
            PG8_LDB(B1, 0, 1); PG8_STAGE(PG8_SB(0, 0), b2, voffB);
            PG8_BAR; PG8_WAIT_L(0); PG8_MMA(0, 1, At, B1); PG8_BAR;
            PG8_LDA(At, 0, 1); PG8_STAGE(PG8_SA(0, 0), a2, voffA);
            PG8_BAR; PG8_WAIT_L(0); PG8_MMA(1, 0, At, B0); PG8_BAR; PG8_SCHED;
            PG8_STAGE(PG8_SB(0, 1), b2 + hstep, voffB);
            PG8_WAIT_V(6); PG8_BAR; PG8_MMA(1, 1, At, B1); PG8_BAR;
            PG8_LDB(B0, 1, 0); PG8_SCHED; PG8_LDA(At, 1, 0); PG8_STAGE(PG8_SA(0, 1), a2 + hstep, voffA);
            PG8_WAIT_L(8); PG8_BAR; PG8_WAIT_L(0); PG8_MMA(0, 0, At, B0); PG8_BAR; PG8_SCHED;
            PG8_LDB(B1, 1, 1); PG8_STAGE(PG8_SB(1, 0), b3, voffB);
            PG8_BAR; PG8_WAIT_L(0); PG8_MMA(0, 1, At, B1); PG8_BAR;
            PG8_LDA(At, 1, 1); PG8_STAGE(PG8_SA(1, 0), a3, voffA);
            PG8_BAR; PG8_WAIT_L(0); PG8_MMA(1, 0, At, B0); PG8_BAR; PG8_SCHED;
            PG8_STAGE(PG8_SB(1, 1), b3 + hstep, voffB);
            PG8_WAIT_V(6); PG8_BAR; PG8_MMA(1, 1, At, B1); PG8_BAR;
            }
        }
        if constexpr (ALIGN_EPI) { if (wr == 0) PG8_BAR; }
        if constexpr (!Epi::AFTER_DRAIN) { E(acc, cur, wr, wc, fr, fq); S.done(cur); }
        if (!has_next) break;
#pragma unroll
        for (int a = 0; a < 2; ++a)
#pragma unroll
            for (int b = 0; b < 2; ++b)
#pragma unroll
                for (int m = 0; m < 4; ++m)
#pragma unroll
                    for (int n = 0; n < 2; ++n) acc[a][b][m][n] = (f32x4){0.f, 0.f, 0.f, 0.f};
        cur = nxt; cA = nA; cB = nB; ++ui;
        if constexpr (ALIGN_EPI) { if (wr == 1) PG8_BAR; }
    }
    PG8_WAIT_V(0);
    if constexpr (!ALIGN_EPI) { if (wr == 0) PG8_BAR; }
    PG8_BAR;
    if constexpr (Epi::AFTER_DRAIN) { E.fused(acc, cur, wr, wc, fr, fq, lds, wid, lane); S.done(cur); }
#undef PG8_SA
#undef PG8_SB
#undef PG8_STAGE
#undef PG8_LDA
#undef PG8_LDB
#undef PG8_MMA
#undef PG8_WAIT_V
#undef PG8_WAIT_L
#undef PG8_BAR
#undef PG8_SCHED
}
}
typedef short bf16x8 __attribute__((ext_vector_type(8)));
constexpr int FR_NWK = 0, FR_QD = 16, FR_KTT = 32, FR_QK = 48, FR_N = 56;
__device__ __forceinline__ int kperm(int g, int j) { return j < 4 ? 4 * g + j : 16 + 4 * g + (j - 4); }

typedef float f32x2_t __attribute__((ext_vector_type(2))); typedef __bf16 bf16x2_t __attribute__((ext_vector_type(2)));
__device__ __forceinline__ unsigned cvtpk_c(float lo, float hi) { const f32x2_t v = {lo, hi}; const bf16x2_t b = __builtin_convertvector(v, bf16x2_t); return __builtin_bit_cast(unsigned, b); }
__device__ __forceinline__ bf16x8 pack8(const f32x4 a, const f32x4 b) {
    return __builtin_bit_cast(bf16x8, (u32x4){cvtpk_c(a[0], a[1]), cvtpk_c(a[2], a[3]), cvtpk_c(b[0], b[1]), cvtpk_c(b[2], b[3])});
}
constexpr int DP_KP = 136;
constexpr int DP_RP = 72;
constexpr int DP_QS = 0, DP_KS = DP_QS + 64 * DP_KP * 2, DP_RHST = DP_KS + 64 * DP_KP * 2, DP_AM = DP_RHST + 256 * DP_RP * 2, DP_AMP = 68,
              DP_QKM = DP_AM + 64 * DP_AMP * 4, DP_QKP = 72, DP_GS = DP_QKM + 64 * DP_QKP * 2, DP_DM = DP_GS + 4 * 64 * 4, DP_DMP = 20,
              DP_TB = DP_DM + 64 * DP_DMP * 4, DP_END = DP_TB + 64 * DP_RP * 2;
static_assert(DP_END <= 131072 && DP_AM % 16 == 0 && DP_DM % 16 == 0 && DP_TB % 16 == 0 && DP_RHST % 16 == 0, "dnprep LDS");
#ifndef DPS
#define DPS(k)
#endif
__device__ __forceinline__ void phase_dnprep(const P& p, LAS unsigned char* lds, unsigned long long& pr_prev, unsigned long long& pr_acc) {
    const int tid_ = otid();
    LAS bf16_t* QS = (LAS bf16_t*)(lds + DP_QS); LAS bf16_t* KS = (LAS bf16_t*)(lds + DP_KS); LAS bf16_t* RHST = (LAS bf16_t*)(lds + DP_RHST);
    LAS float* AM = (LAS float*)(lds + DP_AM); LAS bf16_t* QKM = (LAS bf16_t*)(lds + DP_QKM); LAS float* GS = (LAS float*)(lds + DP_GS);
    LAS float* DM = (LAS float*)(lds + DP_DM); LAS bf16_t* TB = (LAS bf16_t*)(lds + DP_TB);
    const bf16_t* PR = ws_h(p, WS_PROJ); const float* BG = ws_f(p, WS_BG);
    for (int i = tid_; i < 64 * DP_RP / 2; i += NTHR) ((LAS unsigned*)TB)[i] = 0u;
    float pgx = 0.f, pbx = 0.f, cw[3][4][2]; unsigned xr[3][11];
#define DP_FETCH(uid_, ln_, wv_) do { const int n_ = (uid_) % NCHUNK, bh_ = (uid_) / NCHUNK, h_ = bh_ & 3, m0_ = (bh_ >> 2) * SEQ + n_ * 64; \
        if ((wv_) == 0) { pgx = BG[(size_t)(m0_ + (ln_)) * 8 + 4 + h_]; pbx = BG[(size_t)(m0_ + (ln_)) * 8 + h_]; } \
        _Pragma("unroll") for (int part = 0; part < 3; ++part) _Pragma("unroll") for (int j = 0; j < 4; ++j) { const float* w = p.dn_conv_w + j * 1536 + part * 512 + h_ * 128 + 2 * (ln_); cw[part][j][0] = w[0]; cw[part][j][1] = w[1]; } \
        _Pragma("unroll") for (int rr = 0; rr < 11; ++rr) { const int t_ = n_ * 64 + (wv_) * 8 + rr - 3; \
            _Pragma("unroll") for (int part = 0; part < 3; ++part) { unsigned v_ = 0u; if (t_ >= 0) v_ = *(const unsigned*)(PR + (size_t)(m0_ + (wv_) * 8 + rr - 3) * PLD + part * 512 + h_ * 128 + 2 * (ln_)); xr[part][rr] = v_; } } } while (0)
    if ((int)blockIdx.x < NUNIT) { int t0 = tid_; asm volatile("" : "+v"(t0)); DP_FETCH((int)blockIdx.x, t0 & 63, t0 >> 6); }
    for (int uid = blockIdx.x; uid < NUNIT; uid += gridDim.x) {
        const int n = uid % NCHUNK;
        int tid = tid_; asm volatile("" : "+v"(tid));
        const int lane = tid & 63, wave = tid >> 6, r16 = lane & 15, g4 = lane >> 4;
        unsigned char* abu = p.ws + WS_DNF_AB + (size_t)uid * DNF_AB_UNIT;
        if (wave == 0) {
            float x = pgx;
#pragma unroll
            for (int o = 1; o < 64; o <<= 1) { const float t = __shfl_up(x, o); if (lane >= o) x += t; }
            const float gl = __shfl(x, 63);
            GS[lane] = x; GS[64 + lane] = pbx; GS[128 + lane] = __expf(x); GS[192 + lane] = __expf(gl - x);
            if (lane == 0) ws_f(p, WS_DNF_CD)[uid] = __expf(gl);
        }
        LDS_BARRIER();
        {
            float c[8][3][2], ssum[16];
#pragma unroll
            for (int i = 0; i < 8; ++i) {
#pragma unroll
                for (int part = 0; part < 3; ++part)
#pragma unroll
                    for (int e = 0; e < 2; ++e) { float a = 0.f;
#pragma unroll
                        for (int j = 0; j < 4; ++j) a += cw[part][j][e] * (e == 0 ? __builtin_bit_cast(float, xr[part][i + j] << 16) : __builtin_bit_cast(float, xr[part][i + j] & 0xffff0000u));
                        c[i][part][e] = a * __builtin_amdgcn_rcpf(1.0f + __expf(-a)); }
                ssum[2 * i] = c[i][0][0] * c[i][0][0] + c[i][0][1] * c[i][0][1]; ssum[2 * i + 1] = c[i][1][0] * c[i][1][0] + c[i][1][1] * c[i][1][1]; }
#pragma unroll
            for (int o = 1; o < 64; o <<= 1) {
#pragma unroll
                for (int q = 0; q < 16; ++q) ssum[q] += __shfl_xor(ssum[q], o); }
#pragma unroll
            for (int i = 0; i < 8; ++i) { const int row = wave * 8 + i;
                const float rq = 0.08838834764831845f * __builtin_amdgcn_rsqf(ssum[2 * i] + EPS), rk = __builtin_amdgcn_rsqf(ssum[2 * i + 1] + EPS);
                const float beta = GS[64 + row], eg = GS[128 + row];
                const float q0 = c[i][0][0] * rq, q1 = c[i][0][1] * rq, k0 = c[i][1][0] * rk, k1 = c[i][1][1] * rk;
                *(LAS unsigned*)(QS + row * DP_KP + 2 * lane) = pk2(q0, q1);
                *(LAS unsigned*)(KS + row * DP_KP + 2 * lane) = pk2(k0, k1);
                RHST[(2 * lane) * DP_RP + row] = f2bf(beta * c[i][2][0]); RHST[(2 * lane + 1) * DP_RP + row] = f2bf(beta * c[i][2][1]);
                RHST[(128 + 2 * lane) * DP_RP + row] = f2bf(beta * eg * k0); RHST[(128 + 2 * lane + 1) * DP_RP + row] = f2bf(beta * eg * k1); }
        }
        if (uid + (int)gridDim.x < NUNIT) DP_FETCH(uid + (int)gridDim.x, lane, wave);
        LDS_BARRIER(); DPS(16);
        {
            const int ti = wave >> 1;
            f32x4 akk[2], aqk[2];
#pragma unroll
            for (int c = 0; c < 2; ++c) { akk[c] = (f32x4){0.f, 0.f, 0.f, 0.f}; aqk[c] = (f32x4){0.f, 0.f, 0.f, 0.f}; }
#pragma unroll
            for (int kb = 0; kb < 4; ++kb) {
                const bf16x8 ak = *(const LAS bf16x8*)(KS + (16 * ti + r16) * DP_KP + 32 * kb + 8 * g4), aq = *(const LAS bf16x8*)(QS + (16 * ti + r16) * DP_KP + 32 * kb + 8 * g4);
#pragma unroll
                for (int c = 0; c < 2; ++c) { const int tj = 2 * (wave & 1) + c; const bf16x8 bk = *(const LAS bf16x8*)(KS + (16 * tj + r16) * DP_KP + 32 * kb + 8 * g4);
                    akk[c] = __builtin_amdgcn_mfma_f32_16x16x32_bf16(ak, bk, akk[c], 0, 0, 0); aqk[c] = __builtin_amdgcn_mfma_f32_16x16x32_bf16(aq, bk, aqk[c], 0, 0, 0); }
            }
#pragma unroll
            for (int c = 0; c < 2; ++c) { const int tj = 2 * (wave & 1) + c, J = 16 * tj + r16; const float gj = GS[J];
#pragma unroll
                for (int i = 0; i < 4; ++i) { const int I = 16 * ti + 4 * g4 + i; const float dec = I >= J ? __expf(GS[I] - gj) : 0.f;
                    AM[I * DP_AMP + J] = I > J ? GS[64 + I] * akk[c][i] * dec : 0.f; QKM[I * DP_QKP + J] = f2bf(aqk[c][i] * dec); } }
        }
        LDS_BARRIER(); DPS(17);
        if (wave == 0) {
            const int bb = g4, cc = r16; float t[16];
            f32x4 tr[16][4];
#pragma unroll
            for (int i = 1; i < 16; ++i)
#pragma unroll
                for (int j4 = 0; j4 < (i + 3) / 4; ++j4) tr[i][j4] = *(const LAS f32x4*)(AM + (16 * bb + i) * DP_AMP + 16 * bb + 4 * j4);
            __builtin_amdgcn_sched_barrier(0);
#pragma unroll
            for (int i = 0; i < 16; ++i) { float acc = (i == cc) ? 1.f : 0.f;
#pragma unroll
                for (int j = 0; j < i; ++j) acc -= tr[i][j >> 2][j & 3] * t[j];
                t[i] = acc; }
#pragma unroll
            for (int i = 0; i < 16; ++i) { DM[(16 * bb + i) * DP_DMP + cc] = t[i]; TB[(16 * bb + i) * DP_RP + 16 * bb + cc] = f2bf(t[i]); }
        } else if (wave >= 4) {
            for (int f = FR_QD + (wave - 4); f < FR_N; f += 4) {
                u32x4 o;
                if (f < FR_KTT) { const int mt = (f - FR_QD) >> 2, kb = (f - FR_QD) & 3, row = 16 * mt + r16; const float sc = GS[128 + row];
                    const u32x2 lo = *(const LAS u32x2*)(QS + row * DP_KP + 32 * kb + 4 * g4), hi = *(const LAS u32x2*)(QS + row * DP_KP + 32 * kb + 16 + 4 * g4);
                    const unsigned w[4] = {lo.x, lo.y, hi.x, hi.y}; unsigned r[4];
#pragma unroll
                    for (int e = 0; e < 4; ++e) r[e] = cvtpk_c(__builtin_bit_cast(float, w[e] << 16) * sc, __builtin_bit_cast(float, w[e] & 0xffff0000u) * sc);
                    o = (u32x4){r[0], r[1], r[2], r[3]};
                } else if (f < FR_QK) { const int kt = (f - FR_KTT) >> 1, tb = (f - FR_KTT) & 1; float v[8];
#pragma unroll
                    for (int j = 0; j < 8; ++j) { const int tok = 32 * tb + kperm(g4, j); v[j] = bf2f(KS[tok * DP_KP + 16 * kt + r16]) * GS[192 + tok]; }
                    o = (u32x4){cvtpk_c(v[0], v[1]), cvtpk_c(v[2], v[3]), cvtpk_c(v[4], v[5]), cvtpk_c(v[6], v[7])};
                } else { const int mt = (f - FR_QK) >> 1, tb = (f - FR_QK) & 1, row = 16 * mt + r16;
                    const u32x2 lo = *(const LAS u32x2*)(QKM + row * DP_QKP + 32 * tb + 4 * g4), hi = *(const LAS u32x2*)(QKM + row * DP_QKP + 32 * tb + 16 + 4 * g4);
                    o = (u32x4){lo.x, lo.y, hi.x, hi.y}; }
                *(u32x4*)(abu + (size_t)f * 1024 + lane * 16) = o;
            }
        }
        LDS_BARRIER(); DPS(18);
        if (wave < 3) {
            const int j = wave; f32x4 Tk[4];
#pragma unroll
            for (int kk = 0; kk < 4; ++kk) Tk[j][kk] = DM[(16 * j + 4 * g4 + kk) * DP_DMP + r16];
#pragma unroll
            for (int i = 1; i < 4; ++i) if (i > j) {
                f32x4 acc = (f32x4){0.f, 0.f, 0.f, 0.f};
#pragma unroll
                for (int k = 0; k < 3; ++k) if (k >= j && k < i) { const f32x4 a = *(const LAS f32x4*)(AM + (16 * i + r16) * DP_AMP + 16 * k + 4 * g4);
#pragma unroll
                    for (int kk = 0; kk < 4; ++kk) acc = __builtin_amdgcn_mfma_f32_16x16x4f32(a[kk], Tk[k][kk], acc, 0, 0, 0); }
                const f32x4 dd = *(const LAS f32x4*)(DM + (16 * i + r16) * DP_DMP + 4 * g4);
                f32x4 res = (f32x4){0.f, 0.f, 0.f, 0.f};
#pragma unroll
                for (int kk = 0; kk < 4; ++kk) res = __builtin_amdgcn_mfma_f32_16x16x4f32(dd[kk], acc[kk], res, 0, 0, 0);
                Tk[i] = -res;
#pragma unroll
                for (int e = 0; e < 4; ++e) TB[(16 * i + 4 * g4 + e) * DP_RP + 16 * j + r16] = f2bf(Tk[i][e]); }
        }
        LDS_BARRIER(); DPS(19);
        {
            const int mt = wave & 3, half = wave >> 2;
            bf16x8 tf[2];
#pragma unroll
            for (int kb = 0; kb < 2; ++kb) tf[kb] = *(const LAS bf16x8*)(TB + (16 * mt + r16) * DP_RP + 32 * kb + 8 * g4);
            if (half == 0) {
                float* wv = (float*)(p.ws + WS_DNF_WV + (size_t)uid * DNF_WV_UNIT) + (size_t)mt * 256 + lane * 4;
#pragma unroll
                for (int vt = 0; vt < 8; ++vt) { f32x4 acc = (f32x4){0.f, 0.f, 0.f, 0.f};
#pragma unroll
                    for (int kb = 0; kb < 2; ++kb) acc = __builtin_amdgcn_mfma_f32_16x16x32_bf16(tf[kb], *(const LAS bf16x8*)(RHST + (16 * vt + r16) * DP_RP + 32 * kb + 8 * g4), acc, 0, 0, 0);
                    *(f32x4*)(wv + (size_t)vt * 1024) = acc; }
            } else {
#pragma unroll
                for (int kbp = 0; kbp < 4; ++kbp) { f32x4 xt[2];
#pragma unroll
                    for (int c2 = 0; c2 < 2; ++c2) { xt[c2] = (f32x4){0.f, 0.f, 0.f, 0.f};
#pragma unroll
                        for (int kb = 0; kb < 2; ++kb) xt[c2] = __builtin_amdgcn_mfma_f32_16x16x32_bf16(*(const LAS bf16x8*)(RHST + (128 + 16 * (2 * kbp + c2) + r16) * DP_RP + 32 * kb + 8 * g4), tf[kb], xt[c2], 0, 0, 0); }
                    *(u32x4*)(abu + (size_t)(FR_NWK + mt * 4 + kbp) * 1024 + lane * 16) = __builtin_bit_cast(u32x4, pack8(-xt[0], -xt[1])); }
            }
        }
        LDS_BARRIER(); DPS(20);
    }
#undef DP_FETCH
}

constexpr size_t O_ODN = O_Y;
#define DN_SB() __builtin_amdgcn_sched_barrier(0)
__device__ __forceinline__ void dn_consume(const LAS unsigned char* fb, int wl, f32x4 (&S)[8], float cd, float* op) {
    f32x4 u[4], o[4];
    bf16x8 fa[16], fq[16], Sb[4], Ub[2];
#pragma unroll
    for (int mt = 0; mt < 4; ++mt) u[mt] = *(const LAS f32x4*)(fb + (FR_N + wl * 4 + mt) * 1024);
#pragma unroll
    for (int f = 0; f < 16; ++f) fa[f] = *(const LAS bf16x8*)(fb + (FR_NWK + f) * 1024);
#pragma unroll
    for (int f = 0; f < 8; ++f) fq[f] = *(const LAS bf16x8*)(fb + (FR_QD + f) * 1024);
    DN_SB();
#pragma unroll
    for (int kb = 0; kb < 4; ++kb) Sb[kb] = pack8(S[2 * kb], S[2 * kb + 1]);
#pragma unroll
    for (int mt = 0; mt < 4; ++mt)
#pragma unroll
        for (int kb = 0; kb < 4; ++kb) u[mt] = __builtin_amdgcn_mfma_f32_16x16x32_bf16(fa[mt * 4 + kb], Sb[kb], u[mt], 0, 0, 0);
    DN_SB();
#pragma unroll
    for (int f = 8; f < 16; ++f) fq[f] = *(const LAS bf16x8*)(fb + (FR_QD + f) * 1024);
#pragma unroll
    for (int f = 0; f < 8; ++f) fa[f] = *(const LAS bf16x8*)(fb + (FR_KTT + f) * 1024);
    DN_SB();
#pragma unroll
    for (int mt = 0; mt < 4; ++mt) { o[mt] = (f32x4){0.f, 0.f, 0.f, 0.f};
#pragma unroll
        for (int kb = 0; kb < 4; ++kb) o[mt] = __builtin_amdgcn_mfma_f32_16x16x32_bf16(fq[mt * 4 + kb], Sb[kb], o[mt], 0, 0, 0); }
    DN_SB();
#pragma unroll
    for (int f = 8; f < 16; ++f) fa[f] = *(const LAS bf16x8*)(fb + (FR_KTT + f) * 1024);
#pragma unroll
    for (int f = 0; f < 8; ++f) fq[f] = *(const LAS bf16x8*)(fb + (FR_QK + f) * 1024);
#pragma unroll
    for (int tb = 0; tb < 2; ++tb) Ub[tb] = pack8(u[2 * tb], u[2 * tb + 1]);
#pragma unroll
    for (int kt = 0; kt < 8; ++kt) S[kt] = S[kt] * cd;
    DN_SB();
#pragma unroll
    for (int kt = 0; kt < 8; ++kt)
#pragma unroll
        for (int tb = 0; tb < 2; ++tb) S[kt] = __builtin_amdgcn_mfma_f32_16x16x32_bf16(fa[kt * 2 + tb], Ub[tb], S[kt], 0, 0, 0);
#pragma unroll
    for (int mt = 0; mt < 4; ++mt) {
#pragma unroll
        for (int tb = 0; tb < 2; ++tb) o[mt] = __builtin_amdgcn_mfma_f32_16x16x32_bf16(fq[mt * 2 + tb], Ub[tb], o[mt], 0, 0, 0);
#pragma unroll
        for (int i = 0; i < 4; ++i) op[(size_t)(16 * mt + i) * 512] = o[mt][i]; }
}
constexpr int DN_SBUF = 73728;
__device__ __forceinline__ void phase_dnscan(const P& p, LAS unsigned char* lds) {
    if (blockIdx.x >= BATCH * 4 * 2) return;
    const int tid = otid(), lane = tid & 63, wave = __builtin_amdgcn_readfirstlane(tid >> 6), r16 = lane & 15, g4 = lane >> 4;
    const int bh = blockIdx.x >> 1, vh = blockIdx.x & 1, h = bh & 3, b = bh >> 2, wl = wave & 3, vs = vh * 4 + wl, v0 = vs * 16;
    const float* cdp = ws_f(p, WS_DNF_CD) + (size_t)bh * NCHUNK;
    float* odn = p.out + O_ODN;
#define DN_BAR() do { asm volatile("s_waitcnt lgkmcnt(0)" ::: "memory"); __builtin_amdgcn_s_barrier(); asm volatile("" ::: "memory"); } while (0)
    if (wave >= 4) {
        const unsigned char* ab = p.ws + WS_DNF_AB + (size_t)bh * NCHUNK * DNF_AB_UNIT + lane * 16;
        const unsigned char* wvb = p.ws + WS_DNF_WV + (size_t)bh * NCHUNK * DNF_WV_UNIT + (size_t)vh * 16 * 1024 + lane * 16;
        u32x4 R[3][18];
#define DN_SRC(n_, q_) ((q_) < FR_N ? ab + (size_t)(n_) * DNF_AB_UNIT + (q_) * 1024 : wvb + (size_t)(n_) * DNF_WV_UNIT + ((q_) - FR_N) * 1024)
#define DN_LD(n_, s_) do { if ((n_) < NCHUNK) { _Pragma("unroll") for (int i_ = 0; i_ < 18; ++i_) R[s_][i_] = *(const u32x4*)DN_SRC(n_, wl * 18 + i_); } } while (0)
#define DN_ST(n_, s_) do { if ((n_) < NCHUNK) { LAS unsigned char* d_ = lds + ((n_) & 1) * DN_SBUF + wl * 18 * 1024 + lane * 16; _Pragma("unroll") for (int i_ = 0; i_ < 18; ++i_) *(LAS u32x4*)(d_ + i_ * 1024) = R[s_][i_]; } } while (0)
        DN_LD(0, 0); DN_LD(1, 1); DN_LD(2, 2); DN_ST(0, 0);
        DN_BAR();
#define DN_LSTEP(n_, s_) do { const int n = (n_); if (n < NCHUNK) { DN_LD(n + 3, s_); DN_ST(n + 1, ((s_) + 1) % 3); DN_BAR(); } } while (0)
        for (int n3 = 0; n3 < NCHUNK; n3 += 3) { DN_LSTEP(n3, 0); DN_LSTEP(n3 + 1, 1); DN_LSTEP(n3 + 2, 2); }
#undef DN_LSTEP
#undef DN_LD
#undef DN_ST
#undef DN_SRC
        return;
    }
    f32x4 S[8];
#pragma unroll
    for (int t = 0; t < 8; ++t) S[t] = (f32x4){0.f, 0.f, 0.f, 0.f};
    float cd = cdp[0];
    DN_BAR();
    for (int n = 0; n < NCHUNK; ++n) {
        const float cdn = cdp[n + 1 < NCHUNK ? n + 1 : n];
        dn_consume(lds + (n & 1) * DN_SBUF + lane * 16, wl, S, cd, odn + (size_t)(b * SEQ + n * 64 + 4 * g4) * 512 + h * 128 + v0 + r16);
        cd = cdn;
        DN_BAR();
    }
#undef DN_BAR
    {
        float* so = p.out + O_PSSM + (size_t)bh * 128 * 128 + v0 + r16;
#pragma unroll
        for (int kt = 0; kt < 8; ++kt)
#pragma unroll
            for (int i = 0; i < 4; ++i) so[(size_t)(16 * kt + 4 * g4 + i) * 128] = S[kt][i];
    }
}
__device__ __forceinline__ void phase_dngate(const P& p) {
    const int tid_ = otid(), lane = tid_ & 63, wave = tid_ >> 6;
    const int gw = blockIdx.x * NWAVES + wave, NGW = gridDim.x * NWAVES;
    const f32x4 nw0 = *(const f32x4*)(p.dn_norm_w + (lane & 15) * 8), nw1 = *(const f32x4*)(p.dn_norm_w + (lane & 15) * 8 + 4);
    f32x4 a, c; u32x4 z;
#define DG_LOAD(m_) do { const float* o_ = p.out + O_ODN + (size_t)(m_) * 512 + lane * 8; a = *(const f32x4*)o_; c = *(const f32x4*)(o_ + 4); z = *(const u32x4*)(ws_h(p, WS_PROJ) + (size_t)(m_) * PLD + PC_Z + lane * 8); } while (0)
    if (gw < TP) DG_LOAD(gw);
    for (int m = gw; m < TP; m += NGW) {
        const f32x4 a0 = a, c0 = c; const u32x4 z0 = z;
        if (m + NGW < TP) DG_LOAD(m + NGW);
        float ss = (a0[0] * a0[0] + a0[1] * a0[1]) + (a0[2] * a0[2] + a0[3] * a0[3]) + (c0[0] * c0[0] + c0[1] * c0[1]) + (c0[2] * c0[2] + c0[3] * c0[3]);
#pragma unroll
        for (int off = 1; off < 16; off <<= 1) ss += __shfl_xor(ss, off);
        const float rstd = 1.0f / sqrtf(ss * (1.0f / 128.0f) + EPS);
        const unsigned zw[4] = {z0.x, z0.y, z0.z, z0.w}; const float ov[8] = {a0[0], a0[1], a0[2], a0[3], c0[0], c0[1], c0[2], c0[3]}; const float nwv[8] = {nw0[0], nw0[1], nw0[2], nw0[3], nw1[0], nw1[1], nw1[2], nw1[3]};
        unsigned r[4];
#pragma unroll
        for (int e = 0; e < 4; ++e) { const float z0f = __builtin_bit_cast(float, zw[e] << 16), z1f = __builtin_bit_cast(float, zw[e] & 0xffff0000u);
            r[e] = pk2(ov[2 * e] * rstd * nwv[2 * e] * silu_f(z0f), ov[2 * e + 1] * rstd * nwv[2 * e + 1] * silu_f(z1f)); }
        *(u32x4*)(ws_h(p, WS_MIX) + (size_t)m * 1024 + lane * 8) = (u32x4){r[0], r[1], r[2], r[3]};
    }
#undef DG_LOAD
}
__device__ __forceinline__ void phase_dnsample(const P& p, LAS unsigned char* lds, unsigned long long& pr_prev, unsigned long long& pr_acc) {
    const int tid = otid(), lane = tid & 63, us = tid >> 8, w4 = (tid >> 6) & 3, kh = lane >> 5, col_ = w4 * 32 + (lane & 31);
    LAS float* QH = (LAS float*)lds + us * 4352;
    LAS float* KH = QH + 1024; LAS float* VH = QH + 2048; LAS float* OH = QH + 3072; LAS float* RED = QH + 4096;
    const bf16_t* PR = ws_h(p, WS_PROJ); const float* BG = ws_f(p, WS_BG);
    for (int ub = blockIdx.x; ub < DEC_BATCH * 2; ub += gridDim.x) {
        const int uidx = ub * 2 + us, b = uidx >> 2, h = uidx & 3, m0 = TP + b * DEC_SEQ;
        int col = col_; asm volatile("" : "+v"(col));
        {
            float x0[11], x1[11];
            const int ch0 = kh * 512 + h * 128 + col;
#pragma unroll
            for (int rr = 0; rr < 11; ++rr) {
                if (rr < 3) { const float* st = p.state_dn_conv + ((size_t)b * 3 + rr) * 1536; x0[rr] = st[ch0]; x1[rr] = st[1024 + h * 128 + col]; }
                else { const bf16_t* pr = PR + (size_t)(m0 + rr - 3) * PLD; x0[rr] = bf2f(pr[ch0]); x1[rr] = bf2f(pr[1024 + h * 128 + col]); } }
            float w0[4], w1[4];
#pragma unroll
            for (int j = 0; j < 4; ++j) { w0[j] = p.dn_conv_w[j * 1536 + ch0]; w1[j] = p.dn_conv_w[j * 1536 + 1024 + h * 128 + col]; }
            float ssq[8], ssk[8];
#pragma unroll
            for (int t = 0; t < 8; ++t) { float a = 0.f, d = 0.f;
#pragma unroll
                for (int j = 0; j < 4; ++j) { a += w0[j] * x0[t + j]; d += w1[j] * x1[t + j]; }
                a = a * __builtin_amdgcn_rcpf(1.0f + __expf(-a)); d = d * __builtin_amdgcn_rcpf(1.0f + __expf(-d));
                if (kh == 0) { QH[t * 128 + col] = a; VH[t * 128 + col] = d; } else KH[t * 128 + col] = a;
                ssq[t] = kh == 0 ? a * a : 0.f; ssk[t] = kh == 1 ? a * a : 0.f; }
#pragma unroll
            for (int o = 1; o < 64; o <<= 1) {
#pragma unroll
                for (int t = 0; t < 8; ++t) { ssq[t] += __shfl_xor(ssq[t], o); ssk[t] += __shfl_xor(ssk[t], o); } }
            if (lane == 0) {
#pragma unroll
                for (int t = 0; t < 8; ++t) { RED[w4 * 16 + t] = ssq[t]; RED[w4 * 16 + 8 + t] = ssk[t]; } }
        }
        LDS_BARRIER(); DPS(27);
#pragma unroll
        for (int t = 0; t < 8; ++t) {
            if (kh == 0) { const float sq = (RED[t] + RED[16 + t]) + (RED[32 + t] + RED[48 + t]); QH[t * 128 + col] *= 0.08838834764831845f / sqrtf(sq + EPS); }
            else { const float sk = (RED[8 + t] + RED[24 + t]) + (RED[40 + t] + RED[56 + t]); KH[t * 128 + col] *= 1.0f / sqrtf(sk + EPS); } }
        LDS_BARRIER(); DPS(28);
        float S[64];
        const float* S0 = p.state_dn_ssm + ((size_t)b * 4 + h) * 128 * 128 + (size_t)kh * 64 * 128 + col;
#pragma unroll
        for (int k = 0; k < 64; ++k) { S[k] = *S0; S0 += 128; if ((k & 7) == 7) asm volatile("" : "+v"(S0)); }
#pragma unroll 1
        for (int t = 0; t < 8; ++t) {
            const float beta = BG[(size_t)(m0 + t) * 8 + h], eg = __expf(BG[(size_t)(m0 + t) * 8 + 4 + h]);
            const LAS float* kp = KH + t * 128 + kh * 64; const LAS float* qp = QH + t * 128 + kh * 64;
            f32x4 kk[16], qq[16];
#pragma unroll
            for (int k4 = 0; k4 < 16; ++k4) kk[k4] = *(const LAS f32x4*)(kp + 4 * k4);
#pragma unroll
            for (int k4 = 0; k4 < 16; ++k4) qq[k4] = *(const LAS f32x4*)(qp + 4 * k4);
            const float vt = VH[t * 128 + col];
            __builtin_amdgcn_sched_barrier(0);
            float kS = 0.f;
#pragma unroll
            for (int k4 = 0; k4 < 16; ++k4)
#pragma unroll
                for (int e = 0; e < 4; ++e) { S[4 * k4 + e] *= eg; kS += kk[k4][e] * S[4 * k4 + e]; }
            kS += __shfl_xor(kS, 32);
            const float u = beta * (vt - kS);
            float o = 0.f;
#pragma unroll
            for (int k4 = 0; k4 < 16; ++k4)
#pragma unroll
                for (int e = 0; e < 4; ++e) { S[4 * k4 + e] += kk[k4][e] * u; o += qq[k4][e] * S[4 * k4 + e]; }
            o += __shfl_xor(o, 32);
            if (kh == 0) OH[t * 128 + col] = o;
            __builtin_amdgcn_sched_barrier(0);
        }
        float* So = p.out + O_SSSM + ((size_t)b * 4 + h) * 128 * 128 + (size_t)kh * 64 * 128 + col;
#pragma unroll
        for (int k = 0; k < 64; ++k) { *So = S[k]; So += 128; if ((k & 7) == 7) asm volatile("" : "+v"(So)); }
        LDS_BARRIER(); DPS(29);
#pragma unroll
        for (int t = 0; t < 8; ++t) { const float o = kh == 0 ? OH[t * 128 + col] : 0.f; const float s = wave_sum(o * o); if (lane == 0) RED[w4 * 16 + t] = s; }
        LDS_BARRIER();
        if (kh == 0) {
            const float nw = p.dn_norm_w[col];
#pragma unroll
            for (int t = 0; t < 8; ++t) { const float rstd = 1.0f / sqrtf(((RED[t] + RED[16 + t]) + (RED[32 + t] + RED[48 + t])) * (1.0f / 128.0f) + EPS);
                const float z = bf2f(PR[(size_t)(m0 + t) * PLD + PC_Z + h * 128 + col]);
                ws_h(p, WS_MIX)[(size_t)(m0 + t) * 1024 + h * 128 + col] = f2bf(OH[t * 128 + col] * rstd * nw * silu_f(z)); }
        }
        LDS_BARRIER(); DPS(30);
    }
}
constexpr int NSEG = 16, CSEG = NCHUNK / NSEG, NBH = BATCH * 4;
static_assert(NCHUNK % NSEG == 0, "segments");
constexpr size_t O_RFRAG = O_ODN + (size_t)TP * 512;
constexpr size_t O_BSEG = O_RFRAG + (size_t)NBH * NSEG * 8192;
constexpr size_t O_SSEG = O_BSEG + (size_t)NBH * NSEG * 16384;
constexpr size_t O_CPROD = O_SSEG + (size_t)NBH * NSEG * 16384;
static_assert(O_CPROD + NBH * NSEG <= (size_t)T * D, "segment scratch fits in the y region of d_out");

template <bool HASWV> __device__ __forceinline__ void dn_consume_map(const LAS unsigned char* fb, int wl, f32x4 (&X)[8], float cd) {
    f32x4 u[4]; bf16x8 f0[8], f1[8], Xb[4], Ub[2];
#pragma unroll
    for (int mt = 0; mt < 4; ++mt) u[mt] = HASWV ? *(const LAS f32x4*)(fb + (FR_N + wl * 4 + mt) * 1024) : (f32x4){0.f, 0.f, 0.f, 0.f};
#pragma unroll
    for (int f = 0; f < 8; ++f) f0[f] = *(const LAS bf16x8*)(fb + (FR_NWK + f) * 1024);
#pragma unroll
    for (int f = 0; f < 8; ++f) f1[f] = *(const LAS bf16x8*)(fb + (FR_NWK + 8 + f) * 1024);
    DN_SB();
#pragma unroll
    for (int kb = 0; kb < 4; ++kb) Xb[kb] = pack8(X[2 * kb], X[2 * kb + 1]);
#pragma unroll
    for (int mt = 0; mt < 2; ++mt)
#pragma unroll
        for (int kb = 0; kb < 4; ++kb) u[mt] = __builtin_amdgcn_mfma_f32_16x16x32_bf16(f0[mt * 4 + kb], Xb[kb], u[mt], 0, 0, 0);
    DN_SB();
#pragma unroll
    for (int f = 0; f < 8; ++f) f0[f] = *(const LAS bf16x8*)(fb + (FR_KTT + f) * 1024);
    DN_SB();
#pragma unroll
    for (int mt = 2; mt < 4; ++mt)
#pragma unroll
        for (int kb = 0; kb < 4; ++kb) u[mt] = __builtin_amdgcn_mfma_f32_16x16x32_bf16(f1[(mt - 2) * 4 + kb], Xb[kb], u[mt], 0, 0, 0);
    DN_SB();
#pragma unroll
    for (int f = 0; f < 8; ++f) f1[f] = *(const LAS bf16x8*)(fb + (FR_KTT + 8 + f) * 1024);
#pragma unroll
    for (int tb = 0; tb < 2; ++tb) Ub[tb] = pack8(u[2 * tb], u[2 * tb + 1]);
#pragma unroll
    for (int kt = 0; kt < 8; ++kt) X[kt] = X[kt] * cd;
    DN_SB();
#pragma unroll
    for (int kt = 0; kt < 4; ++kt)
#pragma unroll
        for (int tb = 0; tb < 2; ++tb) X[kt] = __builtin_amdgcn_mfma_f32_16x16x32_bf16(f0[kt * 2 + tb], Ub[tb], X[kt], 0, 0, 0);
#pragma unroll
    for (int kt = 4; kt < 8; ++kt)
#pragma unroll
        for (int tb = 0; tb < 2; ++tb) X[kt] = __builtin_amdgcn_mfma_f32_16x16x32_bf16(f1[(kt - 4) * 2 + tb], Ub[tb], X[kt], 0, 0, 0);
}
#define DNS_BAR() do { asm volatile("s_waitcnt lgkmcnt(0)" ::: "memory"); __builtin_amdgcn_s_barrier(); asm volatile("" ::: "memory"); } while (0)
template <int MODE, int nsteps> __device__ __forceinline__ void dns_loader(const P& p, LAS unsigned char* lds, int bh, int n0, int vh, int wl, int lane) {
    constexpr int NPW = MODE == 2 ? 18 : (MODE == 1 ? 12 : 8);
    const unsigned char* ab = p.ws + WS_DNF_AB + ((size_t)bh * NCHUNK + n0) * DNF_AB_UNIT + lane * 16;
    const unsigned char* wvb = p.ws + WS_DNF_WV + ((size_t)bh * NCHUNK + n0) * DNF_WV_UNIT + (size_t)vh * 16 * 1024 + lane * 16;
    u32x4 R[2][NPW];
#define DNS_FRAG(q_) (MODE == 2 ? (q_) : ((q_) < 16 ? (q_) : ((q_) < 32 ? FR_KTT + (q_) - 16 : FR_N + (q_) - 32)))
#define DNS_SRC(n_, q_) (DNS_FRAG(q_) < FR_N ? ab + (size_t)(n_) * DNF_AB_UNIT + DNS_FRAG(q_) * 1024 : wvb + (size_t)(n_) * DNF_WV_UNIT + (DNS_FRAG(q_) - FR_N) * 1024)
#define DNS_LD(n_, s_) do { if ((n_) < nsteps) { _Pragma("unroll") for (int i_ = 0; i_ < NPW; ++i_) R[s_][i_] = *(const u32x4*)DNS_SRC(n_, wl * NPW + i_); } } while (0)
#define DNS_ST(n_, s_) do { if ((n_) < nsteps) { LAS unsigned char* d_ = lds + ((n_) & 1) * DN_SBUF + lane * 16; _Pragma("unroll") for (int i_ = 0; i_ < NPW; ++i_) *(LAS u32x4*)(d_ + DNS_FRAG(wl * NPW + i_) * 1024) = R[s_][i_]; } } while (0)
    DNS_LD(0, 0); DNS_LD(1, 1); DNS_ST(0, 0);
    DNS_BAR();
#define DNS_LSTEP(n_, s_) do { const int n = (n_); if (n < nsteps) { DNS_LD(n + 2, s_); DNS_ST(n + 1, (s_) ^ 1); DNS_BAR(); } } while (0)
#pragma unroll
    for (int n2 = 0; n2 < nsteps; n2 += 2) { DNS_LSTEP(n2, 0); DNS_LSTEP(n2 + 1, 1); }
#undef DNS_LSTEP
#undef DNS_LD
#undef DNS_ST
#undef DNS_SRC
#undef DNS_FRAG
}
constexpr int PA_RTP = 72;
template <int MODE> __device__ __forceinline__ void dns_passA_task(const P& p, LAS unsigned char* lds, int bh, int seg, int q, int wave, int lane) {
    const int r16 = lane & 15, g4 = lane >> 4, wl = wave & 3, n0 = seg * CSEG;
    const float* cdp = ws_f(p, WS_DNF_CD) + (size_t)bh * NCHUNK + n0;
    LAS bf16_t* RT = (LAS bf16_t*)lds;
    if (wave >= 4) { dns_loader<MODE, CSEG>(p, lds, bh, n0, q & 1, wl, lane); }
    else {
        f32x4 X[8];
#pragma unroll
        for (int kt = 0; kt < 8; ++kt)
#pragma unroll
            for (int i = 0; i < 4; ++i) X[kt][i] = (MODE == 0 && 16 * kt + 4 * g4 + i == 64 * q + 16 * wl + r16) ? 1.f : 0.f;
        float cd = cdp[0], cprod = 1.f;
        DNS_BAR();
        for (int n = 0; n < CSEG; ++n) {
            const float cdn = cdp[n + 1 < CSEG ? n + 1 : n];
            dn_consume_map<MODE == 1>(lds + (n & 1) * DN_SBUF + lane * 16, wl, X, cd);
            cprod *= cd; cd = cdn;
            DNS_BAR();
        }
        if (MODE == 0) {
#pragma unroll
            for (int kt = 0; kt < 8; ++kt)
#pragma unroll
                for (int i = 0; i < 4; ++i) { const int row = 16 * kt + 4 * g4 + i, col = 16 * wl + r16; const float v = X[kt][i] - ((row == 64 * q + col) ? cprod : 0.f);
                    RT[row * PA_RTP + col] = f2bf(v); }
            if (q == 0 && wave == 0 && lane == 0) p.out[O_CPROD + bh * NSEG + seg] = cprod;
        } else {
            float* bo = p.out + O_BSEG + ((size_t)(bh * NSEG + seg) * 8 + (4 * (q & 1) + wl)) * 2048 + lane * 4;
#pragma unroll
            for (int kt = 0; kt < 8; ++kt) *(f32x4*)(bo + kt * 256) = X[kt];
        }
    }
    DNS_BAR();
    if (MODE == 0) {
#pragma unroll
        for (int j = 0; j < 2; ++j) { const int f = wave * 2 + j, mt = f >> 1, kbl = f & 1, row = 16 * mt + r16;
            const u32x2 lo = *(const LAS u32x2*)(RT + row * PA_RTP + 32 * kbl + 4 * g4), hi = *(const LAS u32x2*)(RT + row * PA_RTP + 32 * kbl + 16 + 4 * g4);
            *(u32x4*)((unsigned char*)(p.out + O_RFRAG) + ((size_t)(bh * NSEG + seg) * 32 + mt * 4 + 2 * q + kbl) * 1024 + lane * 16) = (u32x4){lo.x, lo.y, hi.x, hi.y}; }
        DNS_BAR();
    }
}
__device__ __forceinline__ void phase_dns_passA(const P& p, LAS unsigned char* lds) {
    const int tid = otid(), lane = tid & 63, wave = __builtin_amdgcn_readfirstlane(tid >> 6);
    const int vb = (gridDim.x % 8 == 0) ? (int)((blockIdx.x % 8) * (gridDim.x / 8) + blockIdx.x / 8) : (int)blockIdx.x;
    for (int t = vb; t < NBH * NSEG * 4; t += gridDim.x) {
        const int q = t & 3, seg = (t >> 2) % NSEG, bh = t / (4 * NSEG);
        if (q < 2) dns_passA_task<0>(p, lds, bh, seg, q, wave, lane); else dns_passA_task<1>(p, lds, bh, seg, q, wave, lane);
    }
}
__device__ __forceinline__ void phase_dns_passB(const P& p, LAS unsigned char* lds) {
    if ((int)blockIdx.x >= NBH * 8) return;
    const int tid = otid(), lane = tid & 63, w = __builtin_amdgcn_readfirstlane(tid >> 6), r16 = lane & 15, g4 = lane >> 4;
    const int bh = blockIdx.x & 7, vs = blockIdx.x >> 3;
    LAS u32x2* XB = (LAS u32x2*)lds;
    const unsigned char* rf0 = (const unsigned char*)(p.out + O_RFRAG) + ((size_t)bh * NSEG * 32 + w * 4) * 1024 + lane * 16;
    const float* bt0 = p.out + O_BSEG + ((size_t)bh * NSEG * 8 + vs) * 2048 + w * 256 + lane * 4;
    float* ss0 = p.out + O_SSEG + ((size_t)bh * NSEG * 8 + vs) * 2048 + w * 256 + lane * 4;
    const float* cp0 = p.out + O_CPROD + bh * NSEG;
    u32x4 rf[4][4]; f32x4 bt[4]; float cp[4];
#define PB_LD(s_, r_) do { if ((s_) < NSEG) { _Pragma("unroll") for (int kb = 0; kb < 4; ++kb) rf[r_][kb] = *(const u32x4*)(rf0 + (size_t)(s_) * 32768 + kb * 1024); bt[r_] = *(const f32x4*)(bt0 + (size_t)(s_) * 16384); cp[r_] = cp0[(s_)]; } } while (0)
    PB_LD(0, 0); PB_LD(1, 1); PB_LD(2, 2);
    f32x4 S = (f32x4){0.f, 0.f, 0.f, 0.f};
#pragma unroll
    for (int s = 0; s < NSEG; ++s) {
        PB_LD(s + 3, (s + 3) & 3);
        *(f32x4*)(ss0 + (size_t)s * 16384) = S;
        XB[((s & 1) * 8 + w) * 64 + lane] = (u32x2){cvtpk_c(S[0], S[1]), cvtpk_c(S[2], S[3])};
        DNS_BAR();
        f32x4 acc = S * cp[s & 3] + bt[s & 3];
#pragma unroll
        for (int kb = 0; kb < 4; ++kb) { const u32x2 lo = XB[((s & 1) * 8 + 2 * kb) * 64 + lane], hi = XB[((s & 1) * 8 + 2 * kb + 1) * 64 + lane];
            acc = __builtin_amdgcn_mfma_f32_16x16x32_bf16(__builtin_bit_cast(bf16x8, rf[s & 3][kb]), __builtin_bit_cast(bf16x8, (u32x4){lo.x, lo.y, hi.x, hi.y}), acc, 0, 0, 0); }
        S = acc;
    }
#undef PB_LD
    float* so = p.out + O_PSSM + (size_t)bh * 128 * 128 + vs * 16 + r16;
#pragma unroll
    for (int i = 0; i < 4; ++i) so[(size_t)(16 * w + 4 * g4 + i) * 128] = S[i];
    DNS_BAR();
}
__device__ __forceinline__ void phase_dns_passC(const P& p, LAS unsigned char* lds) {
    const int tid = otid(), lane = tid & 63, wave = __builtin_amdgcn_readfirstlane(tid >> 6), r16 = lane & 15, g4 = lane >> 4, wl = wave & 3;
    const int vb = (gridDim.x % 8 == 0) ? (int)((blockIdx.x % 8) * (gridDim.x / 8) + blockIdx.x / 8) : (int)blockIdx.x;
    for (int t = vb; t < NBH * NSEG * 2; t += gridDim.x) {
        const int vh = t & 1, seg = (t >> 1) % NSEG, bh = t / (2 * NSEG), h = bh & 3, b = bh >> 2, vs = vh * 4 + wl, n0 = seg * CSEG;
        if (wave >= 4) dns_loader<2, CSEG>(p, lds, bh, n0, vh, wl, lane);
        else {
            const float* cdp = ws_f(p, WS_DNF_CD) + (size_t)bh * NCHUNK + n0;
            const float* ss = p.out + O_SSEG + ((size_t)(bh * NSEG + seg) * 8 + vs) * 2048 + lane * 4;
            f32x4 S[8];
#pragma unroll
            for (int kt = 0; kt < 8; ++kt) S[kt] = *(const f32x4*)(ss + kt * 256);
            float cd = cdp[0];
            DNS_BAR();
            for (int n = 0; n < CSEG; ++n) {
                const float cdn = cdp[n + 1 < CSEG ? n + 1 : n];
                dn_consume(lds + (n & 1) * DN_SBUF + lane * 16, wl, S, cd, p.out + O_ODN + (size_t)(b * SEQ + (n0 + n) * 64 + 4 * g4) * 512 + h * 128 + vs * 16 + r16);
                cd = cdn;
                DNS_BAR();
            }
        }
        DNS_BAR();
    }
}
#undef DNS_BAR
constexpr size_t WS_EDGE = WS_FREE;
constexpr size_t WS_HEAD = al256(WS_EDGE + (size_t)(T / 256) * 2 * 2 * DFF * 4);
constexpr size_t WS_END = al256(WS_HEAD + (size_t)(T / 256) * 2 * 2 * DFF * 4);
constexpr int EX_OFF = 131072;
namespace pg8 {
typedef unsigned u32x2v __attribute__((ext_vector_type(2)));
__device__ __forceinline__ float dpp_shr1(float old, float src) { return __builtin_bit_cast(float, __builtin_amdgcn_update_dpp(__builtin_bit_cast(int, old), __builtin_bit_cast(int, src), 0x111, 0xf, 0xf, false)); }
__device__ __forceinline__ float dpp_shr2(float old, float src) { return __builtin_bit_cast(float, __builtin_amdgcn_update_dpp(__builtin_bit_cast(int, old), __builtin_bit_cast(int, src), 0x112, 0xf, 0xf, false)); }
__device__ __forceinline__ float dpp_ror1(float src) { return __builtin_bit_cast(float, __builtin_amdgcn_update_dpp(0, __builtin_bit_cast(int, src), 0x121, 0xf, 0xf, false)); }
__device__ __forceinline__ float dpp_ror2(float src) { return __builtin_bit_cast(float, __builtin_amdgcn_update_dpp(0, __builtin_bit_cast(int, src), 0x122, 0xf, 0xf, false)); }
struct EpiFfnUp {
    static constexpr bool PERM = false, AFTER_DRAIN = false;
    bf16_t* ACT; float* edge; float* head; const float* cw; const float* cb; const float* state; float* out_pfc; float* out_sfc; PG8_LAS unsigned char* lds;
    __device__ __forceinline__ void operator()(const f32x4 (&acc)[2][2][4][2], const Unit& u, int wr, int wc, int fr, int fq) const {
        PG8_LAS float* EX = (PG8_LAS float*)(lds + EX_OFF);
        const bool smp = u.pm >= TP / BM;
        const int cl = wc * 32 + 4 * fq;
        if (fr >= 14) {
#pragma unroll
            for (int ai = 0; ai < 2; ++ai)
#pragma unroll
                for (int bj = 0; bj < 2; ++bj)
#pragma unroll
                    for (int n = 0; n < 2; ++n) *(PG8_LAS f32x4*)(EX + ((2 * ai + wr) * 2 + (fr - 14)) * 256 + bj * HALF + cl + 16 * n) = acc[ai][bj][3][n];
            if (wr == 1) {
#pragma unroll
                for (int bj = 0; bj < 2; ++bj)
#pragma unroll
                    for (int n = 0; n < 2; ++n) { const int oc = bj * DFF + u.pn * HALF + cl + 16 * n;
                        *(f32x4*)(edge + ((size_t)u.pm * 2 + (fr - 14)) * 2 * DFF + oc) = acc[1][bj][3][n];
                        if (!smp && (u.pm & (SEQ / BM - 1)) == SEQ / BM - 1) *(f32x4*)(out_pfc + ((size_t)(u.pm / (SEQ / BM)) * 2 + (fr - 14)) * 2 * DFF + oc) = acc[1][bj][3][n]; }
            }
        }
        if (fr < 2 && wr == 0) {
#pragma unroll
            for (int bj = 0; bj < 2; ++bj)
#pragma unroll
                for (int n = 0; n < 2; ++n) *(f32x4*)(head + ((size_t)u.pm * 2 + fr) * 2 * DFF + bj * DFF + u.pn * HALF + cl + 16 * n) = acc[0][bj][0][n];
        }
        f32x4 cwg[1][3], cwu[1][3], cbg[1], cbu[1];
#define FF_LDC(n_) do { const int f0_ = u.pn * HALF + cl + 16 * (n_); _Pragma("unroll") for (int j = 0; j < 3; ++j) { cwg[0][j] = *(const f32x4*)(cw + (size_t)j * 2 * DFF + f0_); cwu[0][j] = *(const f32x4*)(cw + (size_t)j * 2 * DFF + DFF + f0_); } \
            cbg[0] = *(const f32x4*)(cb + f0_); cbu[0] = *(const f32x4*)(cb + DFF + f0_); } while (0)
        FF_LDC(0);
        asm volatile("s_waitcnt lgkmcnt(0)" ::: "memory"); __builtin_amdgcn_s_barrier(); asm volatile("" ::: "memory");
#pragma unroll
        for (int n = 0; n < 2; ++n) {
            const int f0 = u.pn * HALF + cl + 16 * n;
            if (n == 1) FF_LDC(1);
            const f32x4 (&wg)[3] = cwg[0]; const f32x4 (&wu)[3] = cwu[0]; const f32x4 bg = cbg[0], bu = cbu[0];
#pragma unroll
            for (int ai = 0; ai < 2; ++ai) {
                const int s = 2 * ai + wr;
                f32x4 pg = (f32x4){0.f, 0.f, 0.f, 0.f}, pu = pg;
                if (!smp && s > 0 && fr >= 14) { pg = *(const PG8_LAS f32x4*)(EX + ((s - 1) * 2 + (fr - 14)) * 256 + cl + 16 * n); pu = *(const PG8_LAS f32x4*)(EX + ((s - 1) * 2 + (fr - 14)) * 256 + HALF + cl + 16 * n); }
#pragma unroll
                for (int m = 0; m < 4; ++m) {
                    const f32x4 cg = acc[ai][0][m][n], cu = acc[ai][1][m][n];
                    const int row = u.pm * BM + ai * HALF + wr * 64 + m * 16 + fr;
                    f32x4 g1, g2, u1, u2;
#pragma unroll
                    for (int e = 0; e < 4; ++e) { g1[e] = dpp_shr1(dpp_ror1(pg[e]), cg[e]); g2[e] = dpp_shr2(dpp_ror2(pg[e]), cg[e]); u1[e] = dpp_shr1(dpp_ror1(pu[e]), cu[e]); u2[e] = dpp_shr2(dpp_ror2(pu[e]), cu[e]); }
                    if (smp) {
                        const int t = fr & 7, b = (row - TP) >> 3;
                        if (t < 2) { const float* st = state + (size_t)b * 2 * 2 * DFF + f0; const f32x4 s1g = *(const f32x4*)(st + 2 * DFF), s1u = *(const f32x4*)(st + 2 * DFF + DFF);
                            if (t == 0) { g1 = s1g; u1 = s1u; g2 = *(const f32x4*)st; u2 = *(const f32x4*)(st + DFF); } else { g2 = s1g; u2 = s1u; } }
                        if (t >= 6) { float* o = out_sfc + ((size_t)b * 2 + (t - 6)) * 2 * DFF + f0; *(f32x4*)o = cg; *(f32x4*)(o + DFF) = cu; }
                    }
                    const f32x4 gc = wg[0] * g2 + wg[1] * g1 + wg[2] * cg + bg, uc = wu[0] * u2 + wu[1] * u1 + wu[2] * cu + bu;
                    u32x2v w;
                    { const float a0 = gc[0] * uc[0] * __builtin_amdgcn_rcpf(1.0f + __expf(-gc[0])), a1 = gc[1] * uc[1] * __builtin_amdgcn_rcpf(1.0f + __expf(-gc[1])), a2 = gc[2] * uc[2] * __builtin_amdgcn_rcpf(1.0f + __expf(-gc[2])), a3 = gc[3] * uc[3] * __builtin_amdgcn_rcpf(1.0f + __expf(-gc[3]));
                      w.x = cvt_pk_bf16(a0, a1); w.y = cvt_pk_bf16(a2, a3); }
                    *(u32x2v*)(ACT + (size_t)row * DFF + f0) = w;
                    pg = cg; pu = cu;
                }
            }
        }
#undef FF_LDC
    }
};
}
__device__ __forceinline__ void phase_ffn_fix(const P& p) {
    constexpr int TPS = SEQ / 256;
    const long n = (long)(BATCH * TPS) * DFF;
    const float* edge = ws_f(p, WS_EDGE); const float* head = ws_f(p, WS_HEAD);
    for (long i = blockIdx.x * (long)NTHR + otid(); i < n; i += (long)gridDim.x * NTHR) {
        const int pm = (int)(i / DFF), f = (int)(i % DFF);
        if (pm % TPS == 0) continue;
        float r0[2], r1[2];
#pragma unroll
        for (int gu = 0; gu < 2; ++gu) { const int c = gu * DFF + f;
            const float um2 = edge[((size_t)(pm - 1) * 2 + 0) * 2 * DFF + c], um1 = edge[((size_t)(pm - 1) * 2 + 1) * 2 * DFF + c], u0 = head[((size_t)pm * 2 + 0) * 2 * DFF + c], u1 = head[((size_t)pm * 2 + 1) * 2 * DFF + c];
            const float w0 = p.ffn_conv_w[c], w1 = p.ffn_conv_w[2 * DFF + c], w2 = p.ffn_conv_w[4 * DFF + c], bb = p.ffn_conv_b[c];
            r0[gu] = w0 * um2 + w1 * um1 + w2 * u0 + bb; r1[gu] = w0 * um1 + w1 * u0 + w2 * u1 + bb; }
        bf16_t* ACT = ws_h(p, WS_ACT) + (size_t)pm * 256 * DFF + f;
        ACT[0] = f2bf(silu_f(r0[0]) * r0[1]); ACT[DFF] = f2bf(silu_f(r1[0]) * r1[1]);
    }
}

__device__ __forceinline__ void ffn_fix_tile(const P& p, int pm) {
    constexpr int TPS = SEQ / 256;
    if (pm >= BATCH * TPS || pm % TPS == 0) return;
    const float* edge = ws_f(p, WS_EDGE); const float* head = ws_f(p, WS_HEAD);
    for (int f = otid(); f < DFF; f += NTHR) {
        float r0[2], r1[2];
#pragma unroll
        for (int gu = 0; gu < 2; ++gu) { const int c = gu * DFF + f;
            const float um2 = edge[((size_t)(pm - 1) * 2 + 0) * 2 * DFF + c], um1 = edge[((size_t)(pm - 1) * 2 + 1) * 2 * DFF + c], u0 = head[((size_t)pm * 2 + 0) * 2 * DFF + c], u1 = head[((size_t)pm * 2 + 1) * 2 * DFF + c];
            const float w0 = p.ffn_conv_w[c], w1 = p.ffn_conv_w[2 * DFF + c], w2 = p.ffn_conv_w[4 * DFF + c], bb = p.ffn_conv_b[c];
            r0[gu] = w0 * um2 + w1 * um1 + w2 * u0 + bb; r1[gu] = w0 * um1 + w1 * u0 + w2 * u1 + bb; }
        bf16_t* ACT = ws_h(p, WS_ACT) + (size_t)pm * 256 * DFF + f;
        ACT[0] = f2bf(silu_f(r0[0]) * r0[1]); ACT[DFF] = f2bf(silu_f(r1[0]) * r1[1]);
    }
}
constexpr int SW_KP = 72;
__device__ __forceinline__ void swa_bias(const LAS float* BT, int lane, float (&bv)[9][4]) {
    const int r16 = lane & 15, g4 = lane >> 4;
#pragma unroll
    for (int t = 0; t < 9; ++t)
#pragma unroll
        for (int e = 0; e < 4; ++e) { const int d = 128 + r16 - 16 * t - 4 * g4 - e; bv[t][e] = (d >= 0 && d <= 127) ? BT[d] * 1.4426950408889634f : -1e30f; }
}
__device__ __forceinline__ void swa_qtile(const LAS bf16_t* KS, const LAS bf16_t* VT, int vtp, int qt, const bf16x8 (&bq)[2], const float (&bv)[9][4], float sink2, bool first, bf16_t* optr, int nvalid_q, int lane) {
    const int r16 = lane & 15, g4 = lane >> 4, kt0 = qt;
    f32x4 s[10];
#pragma unroll
    for (int tb = 0; tb < 2; ++tb) {
        bf16x8 ka[5][2];
#pragma unroll
        for (int t = 0; t < 5; ++t)
#pragma unroll
            for (int ks = 0; ks < 2; ++ks) if (5 * tb + t < 9) ka[t][ks] = *(const LAS bf16x8*)(KS + (16 * (kt0 + 5 * tb + t) + r16) * SW_KP + 32 * ks + 8 * g4);
        __builtin_amdgcn_sched_barrier(0);
#pragma unroll
        for (int t = 0; t < 5; ++t) if (5 * tb + t < 9) { f32x4 a = (f32x4){0.f, 0.f, 0.f, 0.f};
#pragma unroll
            for (int ks = 0; ks < 2; ++ks) a = __builtin_amdgcn_mfma_f32_16x16x32_bf16(ka[t][ks], bq[ks], a, 0, 0, 0);
            s[5 * tb + t] = a; }
        __builtin_amdgcn_sched_barrier(0);
    }
    float mx = sink2;
#pragma unroll
    for (int t = 0; t < 9; ++t)
#pragma unroll
        for (int e = 0; e < 4; ++e) { float v = s[t][e] * 0.18033688011112042f + bv[t][e]; if (first && 16 * (kt0 + t) + 4 * g4 + e < 128) v = -1e30f; s[t][e] = v; mx = fmaxf(mx, v); }
    mx = fmaxf(mx, __shfl_xor(mx, 16)); mx = fmaxf(mx, __shfl_xor(mx, 32));
    float l = 0.f;
#pragma unroll
    for (int t = 0; t < 9; ++t)
#pragma unroll
        for (int e = 0; e < 4; ++e) { const float pv = __builtin_amdgcn_exp2f(s[t][e] - mx); s[t][e] = pv; l += pv; }
    s[9] = (f32x4){0.f, 0.f, 0.f, 0.f};
    l += __shfl_xor(l, 16); l += __shfl_xor(l, 32);
    l += __builtin_amdgcn_exp2f(sink2 - mx);
    const float rl = __builtin_amdgcn_rcpf(l);
    bf16x8 pb[5];
#pragma unroll
    for (int q = 0; q < 5; ++q) pb[q] = pack8(s[2 * q], s[2 * q + 1]);
#pragma unroll
    for (int dp = 0; dp < 2; ++dp) {
        u32x2 vl[2][5], vh[2][5];
#pragma unroll
        for (int d2 = 0; d2 < 2; ++d2)
#pragma unroll
            for (int q = 0; q < 5; ++q) { const LAS bf16_t* vp = VT + (16 * (2 * dp + d2) + r16) * vtp + 16 * (kt0 + 2 * q) + 4 * g4; vl[d2][q] = *(const LAS u32x2*)vp; vh[d2][q] = *(const LAS u32x2*)(vp + 16); }
        __builtin_amdgcn_sched_barrier(0);
#pragma unroll
        for (int d2 = 0; d2 < 2; ++d2) { const int dt = 2 * dp + d2; f32x4 o = (f32x4){0.f, 0.f, 0.f, 0.f};
#pragma unroll
            for (int q = 0; q < 5; ++q) o = __builtin_amdgcn_mfma_f32_16x16x32_bf16(__builtin_bit_cast(bf16x8, (u32x4){vl[d2][q].x, vl[d2][q].y, vh[d2][q].x, vh[d2][q].y}), pb[q], o, 0, 0, 0);
            if (r16 < nvalid_q) *(u32x2*)(optr + (size_t)r16 * 1024 + 16 * dt + 4 * g4) = (u32x2){cvtpk_c(o[0] * rl, o[1] * rl), cvtpk_c(o[2] * rl, o[3] * rl)}; }
        __builtin_amdgcn_sched_barrier(0);
    }
}
constexpr int SWP_VTP = 272, SWS_NK = 144, SWS_VTP = 168;
constexpr int SW_KS = 0, SW_VT = 43008, SW_BT = 86016, SW_END = SW_BT + 8 * 128 * 4;
static_assert(256 * SW_KP * 2 <= SW_VT && SW_VT + 64 * SWP_VTP * 2 <= SW_BT && SWS_NK * SW_KP * 2 <= SW_VT && SW_VT + 64 * SWS_VTP * 2 <= SW_BT, "swa LDS map");
__device__ __forceinline__ void phase_swa(const P& p, LAS unsigned char* lds, int vblk, int nblk, unsigned long long& pr_prev, unsigned long long& pr_acc) {
    const int tid = otid(), lane = tid & 63, wave = tid >> 6;
    LAS bf16_t* KS = (LAS bf16_t*)(lds + SW_KS); LAS bf16_t* VT = (LAS bf16_t*)(lds + SW_VT); LAS float* BT = (LAS float*)(lds + SW_BT);
    const bf16_t* PR = ws_h(p, WS_PROJ); bf16_t* MX = ws_h(p, WS_MIX);
    constexpr int NQB = SEQ / 128, NPU = BATCH * NQB * 2, NU = NPU + DEC_BATCH * 2;
    for (int i = tid; i < 8 * 128; i += NTHR) BT[i] = p.rel_bias[t5_bucket(i & 127) * 8 + (i >> 7)];
    const int vb = (nblk % 8 == 0) ? (vblk % 8) * (nblk / 8) + vblk / 8 : vblk;
    for (int u = vb; u < NU; u += nblk) {
        LDS_BARRIER(); DPS(22);
        if (u < NPU) {
            const int kvh = u & 1, qb = (u >> 1) % NQB, b = (u >> 1) / NQB, m0 = b * SEQ + qb * 128; const bool first = qb == 0;
            const bf16_t* qbase = PR + (size_t)(m0 + 64 * (wave & 1) + (lane & 15)) * PLD + PC_SQ + (kvh * 4 + (wave >> 1)) * 64 + 8 * (lane >> 4);
            bf16x8 bq[2], bqn[2];
#pragma unroll
            for (int ks = 0; ks < 2; ++ks) bq[ks] = *(const bf16x8*)(qbase + 32 * ks);
            {
                u32x4 kr[4], vr[5];
#pragma unroll
                for (int i = 0; i < 4; ++i) { const int it = tid + i * NTHR, jj = it >> 3, c = it & 7; kr[i] = (u32x4){0u, 0u, 0u, 0u};
                    if (!(first && jj < 128)) kr[i] = *(const u32x4*)(PR + (size_t)(m0 - 128 + jj) * PLD + PC_SK + kvh * 64 + 8 * c); }
#pragma unroll
                for (int i = 0; i < 5; ++i) { const int it = tid + i * NTHR, jj = it % 272, c = it / 272; vr[i] = (u32x4){0u, 0u, 0u, 0u};
                    if (it < 272 * 8 && jj < 256 && !(first && jj < 128)) vr[i] = *(const u32x4*)(PR + (size_t)(m0 - 128 + jj) * PLD + PC_SV + kvh * 64 + 8 * c); }
#pragma unroll
                for (int i = 0; i < 4; ++i) { const int it = tid + i * NTHR, jj = it >> 3, c = it & 7; *(LAS u32x4*)(KS + jj * SW_KP + 8 * c) = kr[i]; }
#pragma unroll
                for (int i = 0; i < 5; ++i) { const int it = tid + i * NTHR, jj = it % 272, c = it / 272;
                    if (it < 272 * 8) { const unsigned w[4] = {vr[i].x, vr[i].y, vr[i].z, vr[i].w};
#pragma unroll
                        for (int e = 0; e < 4; ++e) { VT[(8 * c + 2 * e) * SWP_VTP + jj] = (bf16_t)(w[e] & 0xffffu); VT[(8 * c + 2 * e + 1) * SWP_VTP + jj] = (bf16_t)(w[e] >> 16); } } }
            }
            LDS_BARRIER(); DPS(23);
            const int hq = kvh * 4 + (wave >> 1), qh = wave & 1, r16 = lane & 15, g4 = lane >> 4;
            float bv[9][4]; swa_bias(BT + hq * 128, lane, bv);
            const float sink2 = p.swa_sinks[hq] * 1.4426950408889634f;
#pragma unroll 1
            for (int q4 = 0; q4 < 4; ++q4) { const int qt = 4 * qh + q4;
                if (q4 < 3) {
#pragma unroll
                    for (int ks = 0; ks < 2; ++ks) bqn[ks] = *(const bf16x8*)(qbase + (size_t)(16 * (q4 + 1)) * PLD + 32 * ks); }
                swa_qtile(KS, VT, SWP_VTP, qt, bq, bv, sink2, first, MX + (size_t)(m0 + 16 * qt) * 1024 + 512 + hq * 64, 16, lane);
                bq[0] = bqn[0]; bq[1] = bqn[1]; }
            DPS(24);
        } else {
            const int su = u - NPU, b = su >> 1, kvh = su & 1, m0 = TP + b * DEC_SEQ;
            bf16x8 bqs[2];
#pragma unroll
            for (int ks = 0; ks < 2; ++ks) bqs[ks] = *(const bf16x8*)(PR + (size_t)(m0 + (lane & 7)) * PLD + PC_SQ + (kvh * 4 + (wave & 3)) * 64 + 32 * ks + 8 * (lane >> 4));
            {
                f32x4 ka[3][2], va[3][2]; u32x4 kn[3], vn[3];
#pragma unroll
                for (int i = 0; i < 3; ++i) { const int it = tid + i * NTHR, jj = it >> 3, c = it & 7;
                    ka[i][0] = ka[i][1] = (f32x4){0.f, 0.f, 0.f, 0.f}; kn[i] = (u32x4){0u, 0u, 0u, 0u};
                    if (it < SWS_NK * 8) { if (jj < 128) { const float* src = p.cache_k + ((size_t)b * 128 + jj) * 128 + kvh * 64 + 8 * c; ka[i][0] = *(const f32x4*)src; ka[i][1] = *(const f32x4*)(src + 4); }
                        else if (jj < 128 + DEC_SEQ) kn[i] = *(const u32x4*)(PR + (size_t)(m0 + jj - 128) * PLD + PC_SK + kvh * 64 + 8 * c); } }
#pragma unroll
                for (int i = 0; i < 3; ++i) { const int it = tid + i * NTHR, jj = it % SWS_VTP, c = it / SWS_VTP;
                    va[i][0] = va[i][1] = (f32x4){0.f, 0.f, 0.f, 0.f}; vn[i] = (u32x4){0u, 0u, 0u, 0u};
                    if (it < SWS_VTP * 8) { if (jj < 128) { const float* src = p.cache_v + ((size_t)b * 128 + jj) * 128 + kvh * 64 + 8 * c; va[i][0] = *(const f32x4*)src; va[i][1] = *(const f32x4*)(src + 4); }
                        else if (jj < 128 + DEC_SEQ) vn[i] = *(const u32x4*)(PR + (size_t)(m0 + jj - 128) * PLD + PC_SV + kvh * 64 + 8 * c); } }
#pragma unroll
                for (int i = 0; i < 3; ++i) { const int it = tid + i * NTHR, jj = it >> 3, c = it & 7;
                    if (it < SWS_NK * 8) { u32x4 v = kn[i]; if (jj < 128) v = (u32x4){cvtpk_c(ka[i][0][0], ka[i][0][1]), cvtpk_c(ka[i][0][2], ka[i][0][3]), cvtpk_c(ka[i][1][0], ka[i][1][1]), cvtpk_c(ka[i][1][2], ka[i][1][3])};
                        *(LAS u32x4*)(KS + jj * SW_KP + 8 * c) = v; } }
#pragma unroll
                for (int i = 0; i < 3; ++i) { const int it = tid + i * NTHR, jj = it % SWS_VTP, c = it / SWS_VTP;
                    if (it < SWS_VTP * 8) { u32x4 v = vn[i]; if (jj < 128) v = (u32x4){cvtpk_c(va[i][0][0], va[i][0][1]), cvtpk_c(va[i][0][2], va[i][0][3]), cvtpk_c(va[i][1][0], va[i][1][1]), cvtpk_c(va[i][1][2], va[i][1][3])};
                        const unsigned w[4] = {v.x, v.y, v.z, v.w};
#pragma unroll
                        for (int e = 0; e < 4; ++e) { VT[(8 * c + 2 * e) * SWS_VTP + jj] = (bf16_t)(w[e] & 0xffffu); VT[(8 * c + 2 * e + 1) * SWS_VTP + jj] = (bf16_t)(w[e] >> 16); } } }
            }
            LDS_BARRIER(); DPS(25);
            if (wave < 4) { const int hq = kvh * 4 + wave;
                float bv[9][4]; swa_bias(BT + hq * 128, lane, bv);
                swa_qtile(KS, VT, SWS_VTP, 0, bqs, bv, p.swa_sinks[hq] * 1.4426950408889634f, false, MX + (size_t)m0 * 1024 + 512 + hq * 64, 8, lane); }
        }
    }
    LDS_BARRIER();
}
static void fill_params(P& p, void* const* d_in, void* d_out, void* d_ws) {
    const float** pp = (const float**)&p;
    for (int i = 0; i < 26; ++i) pp[i] = (const float*)d_in[i];
    p.out = (float*)d_out; p.ws = (unsigned char*)d_ws;
}
namespace cg = cooperative_groups;
constexpr int CW_BAR = 1024;
constexpr size_t CTL_ZERO_BYTES = 65536;

#ifndef PROBE_MASK
#define PROBE_MASK 0
#endif
#ifndef PROBE_K
#define PROBE_K 4
#endif
#ifndef PROBE_XSYNC
#define PROBE_XSYNC 0
#endif
#if PROBE_MASK
#define PROBE_SUB(k) do { xcd_barrier(bar); PROBE_STAMP(k); } while (0)
#define PROBE_DECL unsigned long long pr_prev = __builtin_amdgcn_s_memrealtime(), pr_acc = 0ull
#define PROBE_STAMP(k) do { const unsigned long long now_ = __builtin_amdgcn_s_memrealtime(); if ((PROBE_MASK >> (k)) & 1) pr_acc += now_ - pr_prev; pr_prev = now_; } while (0)
#define PROBE_END() do { xcd_barrier(bar); PROBE_STAMP(11); if (blockIdx.x == 0 && __builtin_amdgcn_mbcnt_hi(~0u, __builtin_amdgcn_mbcnt_lo(~0u, 0u)) == 0u) { const unsigned long long t0_ = __builtin_amdgcn_s_memrealtime(); while (__builtin_amdgcn_s_memrealtime() - t0_ < (unsigned long long)PROBE_K * pr_acc) __builtin_amdgcn_s_sleep(8); } } while (0)
#else
#define PROBE_DECL unsigned long long pr_prev = 0ull, pr_acc = 0ull
#define PROBE_SUB(k)
#define PROBE_STAMP(k)
#define PROBE_END() do { for (int i_ = 0; i_ < PROBE_XSYNC; ++i_) xcd_barrier(bar); } while (0)
#endif
__global__ void __launch_bounds__(512, 2) fwd_megakernel(P p) {
    extern __shared__ __attribute__((aligned(16))) unsigned char lds_raw[];
    LAS unsigned char* lds = (LAS unsigned char*)lds_raw;
    cg::grid_group grid = cg::this_grid();
    PROBE_DECL;
    volatile LAS unsigned* MISC = (volatile LAS unsigned*)(lds + LDS_BYTES - 64);
    if (threadIdx.x < 16) MISC[threadIdx.x] = 0u;
    __syncthreads();
    const XcdBarrier bar = xcd_barrier_post((unsigned*)(p.ws + WS_CTL) + CW_BAR, MISC);
    phase_mod(p, lds, pr_prev, pr_acc); PROBE_STAMP(31); phase_transposes(p, lds);
    if (p.ws == nullptr) grid.sync();
    xcd_barrier(bar); PROBE_STAMP(0);
    phase_norm<0>(p, lds);
    xcd_barrier(bar); PROBE_STAMP(1);
    { pg8::StaticOrder S; pg8::Gemm g{ws_h(p, WS_H), ws_h(p, WS_WT_IN), T, PLD, D}; S.init(T, PLD, gridDim.x, blockIdx.x, D); pg8::EpiStoreBf16 E{ws_h(p, WS_PROJ), PLD};
      pg8::gemm_phase<pg8::EpiStoreBf16, pg8::StaticOrder, true, true>(lds, g, S, E); }
    xcd_barrier(bar); PROBE_STAMP(2);
    PROBE_STAMP(21);
    phase_dnprep(p, lds, pr_prev, pr_acc);
    PROBE_SUB(12);
    phase_dnsample(p, lds, pr_prev, pr_acc);
    PROBE_SUB(13);
    phase_swa(p, lds, (int)blockIdx.x, (int)gridDim.x, pr_prev, pr_acc);
    xcd_barrier(bar); PROBE_STAMP(3);
    phase_dns_passA(p, lds);
    xcd_barrier(bar); PROBE_STAMP(14);
    if ((int)gridDim.x >= NBH * 8 + 64) { if ((int)blockIdx.x >= NBH * 8) phase_state_out(p, (int)blockIdx.x - NBH * 8, (int)gridDim.x - NBH * 8); }
    else phase_state_out(p, (int)blockIdx.x, (int)gridDim.x);
    phase_dns_passB(p, lds);
    xcd_barrier(bar); PROBE_STAMP(15);
    phase_dns_passC(p, lds);
    xcd_barrier(bar); PROBE_STAMP(4);
    phase_dngate(p);
    xcd_barrier(bar); PROBE_STAMP(5);
    { pg8::SplitOrder S; pg8::Gemm g{ws_h(p, WS_MIX), ws_h(p, WS_WT_OUT), T, D, 1024}; S.init(D, 1024, NS_OUT, gridDim.x, blockIdx.x); pg8::EpiGateRes<0> E{p.x_prompt, p.x_sample, ws_h(p, WS_XB), ws_f(p, WS_MOD) + 2 * D, p.out + O_Y, NS_OUT};
      pg8::gemm_phase<pg8::EpiGateRes<0>, pg8::SplitOrder, true, true>(lds, g, S, E); }
    xcd_barrier(bar); PROBE_STAMP(6);
    phase_norm<1>(p, lds);
    xcd_barrier(bar); PROBE_STAMP(7);
    { pg8::StaticOrder S; pg8::Gemm g{ws_h(p, WS_H), ws_h(p, WS_WT_UP), T, 2 * DFF, D}; S.init(T, 2 * DFF, gridDim.x, blockIdx.x, D);
      pg8::EpiFfnUp E{ws_h(p, WS_ACT), ws_f(p, WS_EDGE), ws_f(p, WS_HEAD), p.ffn_conv_w, p.ffn_conv_b, p.state_ffn, p.out + O_PFC, p.out + O_SFC, lds};
      pg8::gemm_phase<pg8::EpiFfnUp, pg8::StaticOrder, true, true>(lds, g, S, E); }
    xcd_barrier(bar); PROBE_STAMP(8);
    { pg8::SplitOrder S; pg8::Gemm g{ws_h(p, WS_ACT), ws_h(p, WS_WT_DN), T, D, DFF}; S.init(D, DFF, NS_DN, gridDim.x, blockIdx.x);
      { constexpr int NU1 = (TP / 256) * (D / 256); for (int L = blockIdx.x; L < NU1; L += gridDim.x) { const int w1 = (L % 8) * (NU1 / 8) + L / 8, pm = (w1 / (8 * (D / 256))) * 8 + (w1 % (8 * (D / 256))) % 8; ffn_fix_tile(p, pm); }
        asm volatile("s_waitcnt vmcnt(0)" ::: "memory"); __syncthreads(); }
      pg8::EpiGateRes<1> E{nullptr, nullptr, ws_h(p, WS_XB), ws_f(p, WS_MOD) + 5 * D, ws_f(p, WS_SLAB_DN), NS_DN};
      pg8::gemm_phase<pg8::EpiGateRes<1>, pg8::SplitOrder, true, true>(lds, g, S, E); }
    xcd_barrier(bar); PROBE_STAMP(10);
    phase_norm<2>(p, lds);
    PROBE_END();
}
extern "C" void kernel_launch(void* const* d_in, const int* in_sizes, int n_in, void* d_out, int out_size, void* d_ws, size_t ws_size, hipStream_t stream) {
    static int grid_blocks = 0;
    if (grid_blocks == 0) {
        if (n_in != 26 || (long)out_size != O_END || ws_size < WS_END) { fprintf(stderr, "kernel_launch: unexpected shapes n_in=%d out=%d ws=%zu (need %zu)\n", n_in, out_size, ws_size, (size_t)WS_END); grid_blocks = -1; return; }
        int dev = 0, cus = 0, per_cu = 0;
        if (hipGetDevice(&dev) != hipSuccess || hipDeviceGetAttribute(&cus, hipDeviceAttributeMultiprocessorCount, dev) != hipSuccess) { grid_blocks = -1; return; }
        if (hipFuncSetAttribute((const void*)fwd_megakernel, hipFuncAttributeMaxDynamicSharedMemorySize, LDS_BYTES) != hipSuccess) { fprintf(stderr, "kernel_launch: hipFuncSetAttribute failed\n"); grid_blocks = -1; return; }
        if (hipOccupancyMaxActiveBlocksPerMultiprocessor(&per_cu, (const void*)fwd_megakernel, NTHR, LDS_BYTES) != hipSuccess || per_cu < 1) { fprintf(stderr, "kernel_launch: occupancy query says %d\n", per_cu); grid_blocks = -1; return; }
        grid_blocks = cus;
        fprintf(stderr, "kernel_launch: grid %d (cus %d, per_cu %d)\n", grid_blocks, cus, per_cu);
    }
    if (grid_blocks < 0) return;
    P p{}; fill_params(p, d_in, d_out, d_ws);
    if (hipMemsetAsync((char*)d_ws + WS_CTL, 0, CTL_ZERO_BYTES, stream) != hipSuccess) { fprintf(stderr, "kernel_launch: memset of the control words failed\n"); return; }
    void* args[] = {&p};
    const hipError_t e = hipLaunchCooperativeKernel((const void*)fwd_megakernel, dim3(grid_blocks), dim3(NTHR), args, LDS_BYTES, stream);
    if (e != hipSuccess) fprintf(stderr, "cooperative launch failed: %s (grid %d)\n", hipGetErrorString(e), grid_blocks);
}
```

```cpp
#include <hip/hip_runtime.h>
#include <hip/hip_cooperative_groups.h>
#include <cstdio>
#include <cstdint>
#define HD __device__ __forceinline__
#if defined(PROBE_MASK) && PROBE_MASK
#define DPS(k) do { const unsigned long long now_ = __builtin_amdgcn_s_memrealtime(); if ((PROBE_MASK >> (k)) & 1) pr_acc += now_ - pr_prev; pr_prev = now_; } while (0)
#endif
#ifndef CFG_D_MODEL
#define CFG_D_MODEL 1024
#endif
#ifndef CFG_SEQ
#define CFG_SEQ 8192
#endif
#ifndef CFG_DEC_BATCH
#define CFG_DEC_BATCH 128
#endif
#ifndef CFG_D_FF
#define CFG_D_FF 2816
#endif

constexpr int D = CFG_D_MODEL, BATCH = 2, SEQ = CFG_SEQ, DEC_BATCH = CFG_DEC_BATCH, DEC_SEQ = 8, DFF = CFG_D_FF;
constexpr int TP = BATCH * SEQ, TS = DEC_BATCH * DEC_SEQ, T = TP + TS, NCB = BATCH + DEC_BATCH;
constexpr int IN_COLS = 2824, PLD = 2816;
constexpr int PC_QKV = 0, PC_Z = 1536, PC_SQ = 2048, PC_SK = 2560, PC_SV = 2688;
constexpr int WC_BA = 2048;
constexpr float EPS = 1e-6f;

constexpr long O_Y = 0;
constexpr long O_PDC = (long)T * D;
constexpr long O_SDC = O_PDC + (long)BATCH * 3 * 1536;
constexpr long O_PSSM = O_SDC + (long)DEC_BATCH * 3 * 1536;
constexpr long O_SSSM = O_PSSM + (long)BATCH * 4 * 128 * 128;
constexpr long O_PK = O_SSSM + (long)DEC_BATCH * 4 * 128 * 128;
constexpr long O_SK = O_PK + (long)BATCH * 128 * 128;
constexpr long O_PV = O_SK + (long)DEC_BATCH * 128 * 128;
constexpr long O_SV = O_PV + (long)BATCH * 128 * 128;
constexpr long O_PFC = O_SV + (long)DEC_BATCH * 128 * 128;
constexpr long O_SFC = O_PFC + (long)BATCH * 2 * 2 * DFF;
constexpr long O_END = O_SFC + (long)DEC_BATCH * 2 * 2 * DFF;

constexpr size_t al256(size_t x) { return (x + 255) & ~(size_t)255; }
constexpr size_t WS_CTL = 0;
constexpr size_t WS_MOD = 1u << 20;
constexpr size_t WS_BG = al256(WS_MOD + (size_t)NCB * 6 * D * 4);
constexpr size_t WS_WBAT = al256(WS_BG + (size_t)T * 8 * 4);
constexpr size_t WS_WT_IN = al256(WS_WBAT + (size_t)8 * D * 4);
constexpr size_t WS_WT_OUT = al256(WS_WT_IN + (size_t)PLD * D * 2);
constexpr size_t WS_WT_UP = al256(WS_WT_OUT + (size_t)D * 1024 * 2);
constexpr size_t WS_WT_DN = al256(WS_WT_UP + (size_t)2 * DFF * D * 2);
constexpr size_t WS_H = al256(WS_WT_DN + (size_t)D * DFF * 2);
constexpr int NCHUNK = SEQ / 64, NUNIT = BATCH * 4 * NCHUNK;
constexpr int DNF_AB_UNIT = 57344, DNF_WV_UNIT = 32768;
constexpr size_t WS_DNF_WV = WS_H;
constexpr size_t WS_DNF_AB = al256(WS_H + (size_t)T * (D > 1024 ? D : 1024) * 2);
constexpr size_t WS_DNF_CD = al256(WS_DNF_AB + (size_t)NUNIT * DNF_AB_UNIT);
constexpr size_t WS_QKVC = WS_DNF_AB;
constexpr size_t WS_PROJ = al256((WS_DNF_CD + (size_t)NUNIT * 4) > (WS_QKVC + (size_t)T * 1536 * 2) ? (WS_DNF_CD + (size_t)NUNIT * 4) : (WS_QKVC + (size_t)T * 1536 * 2));
constexpr size_t WS_MIX = al256(WS_PROJ + (size_t)T * PLD * 2);
constexpr size_t WS_FREE = al256(WS_MIX + (size_t)T * 1024 * 2);
constexpr size_t WS_ODN = WS_H, WS_ACT = WS_PROJ;
static_assert((size_t)NUNIT * DNF_WV_UNIT <= (size_t)T * 1024 * 2, "Wv tiles overlay H");

typedef unsigned short bf16_t;
HD unsigned f2bf_bits(float f) { typedef float f2v_ __attribute__((ext_vector_type(2))); typedef __bf16 b2v_ __attribute__((ext_vector_type(2))); const f2v_ v = {f, 0.f}; return __builtin_bit_cast(unsigned, __builtin_convertvector(v, b2v_)) & 0xffffu; }
HD bf16_t f2bf(float f) { return (bf16_t)f2bf_bits(f); }
HD float bf2f(bf16_t b) { return __builtin_bit_cast(float, (unsigned)b << 16); }
HD float silu_f(float x) { return x / (1.0f + expf(-x)); }
HD float sigmoid_f(float x) { return 1.0f / (1.0f + expf(-x)); }
HD float softplus_f(float x) { return x > 20.f ? x : log1pf(expf(x)); }

struct P {
    const float *x_prompt, *x_sample, *state_dn_conv, *state_dn_ssm, *cache_k, *cache_v, *state_ffn, *c_prompt, *c_sample, *rel_bias,
        *final_norm_w, *w_ada, *b_ada, *norm_mix_w, *w_in, *dn_conv_w, *dn_A_log, *dn_dt_bias, *dn_norm_w, *swa_sinks, *w_out, *norm_ffn_w,
        *w_up, *ffn_conv_w, *ffn_conv_b, *w_down;
    float* out; unsigned char* ws;
};

HD const float* xrow(const P& p, int m) { return m < TP ? p.x_prompt + (size_t)m * D : p.x_sample + (size_t)(m - TP) * D; }
HD int cb_of(int m) { return m < TP ? m / SEQ : BATCH + (m - TP) / DEC_SEQ; }
HD int t_of(int m) { return m < TP ? m % SEQ : (m - TP) % DEC_SEQ; }
HD float* ws_f(const P& p, size_t off) { return (float*)(p.ws + off); }
HD bf16_t* ws_h(const P& p, size_t off) { return (bf16_t*)(p.ws + off); }

HD int t5_bucket(int d) {
    if (d < 16) return d;
    const float logv = logf((float)d / 16.0f) / 2.0794415416798357f;
    int b = 16 + (int)(logv * 16.0f);
    return b < 31 ? b : 31;
}

#define LAS __attribute__((address_space(3)))
typedef float f32x4 __attribute__((ext_vector_type(4)));
typedef unsigned u32x4 __attribute__((ext_vector_type(4)));
typedef unsigned u32x2 __attribute__((ext_vector_type(2)));
constexpr int NWAVES = 8, NTHR = 512;
constexpr int LDS_BYTES = 163840;
__device__ __forceinline__ int otid() { int t = threadIdx.x; asm volatile("" : "+v"(t)); return t; }
#define LDS_BARRIER() do { asm volatile("s_waitcnt lgkmcnt(0)" ::: "memory"); __builtin_amdgcn_s_barrier(); asm volatile("" ::: "memory"); } while (0)
__device__ __forceinline__ float row16_sum(float v) {
    v += __builtin_bit_cast(float, __builtin_amdgcn_update_dpp(0, __builtin_bit_cast(int, v), 0xB1, 0xf, 0xf, false));
    v += __builtin_bit_cast(float, __builtin_amdgcn_update_dpp(0, __builtin_bit_cast(int, v), 0x4E, 0xf, 0xf, false));
    v += __builtin_bit_cast(float, __builtin_amdgcn_update_dpp(0, __builtin_bit_cast(int, v), 0x124, 0xf, 0xf, false));
    v += __builtin_bit_cast(float, __builtin_amdgcn_update_dpp(0, __builtin_bit_cast(int, v), 0x128, 0xf, 0xf, false));
    return v;
}
__device__ __forceinline__ float wave_sum(float v) { v = row16_sum(v); v += __shfl_xor(v, 16); v += __shfl_xor(v, 32); return v; }
__device__ __forceinline__ unsigned pk2(float lo, float hi) { typedef float f2v_ __attribute__((ext_vector_type(2))); typedef __bf16 b2v_ __attribute__((ext_vector_type(2))); const f2v_ v = {lo, hi}; return __builtin_bit_cast(unsigned, __builtin_convertvector(v, b2v_)); }

__device__ __forceinline__ void transpose_item(const float* W, int ldw, int K, bf16_t* WT, int dst_n0, int src_n0, int k0, LAS float* scr, int lane) {
#pragma unroll
    for (int i = 0; i < 32; ++i) { const int kk = 2 * i + (lane >> 5); scr[kk * 33 + (lane & 31)] = W[(size_t)(k0 + kk) * ldw + src_n0 + (lane & 31)]; }
    asm volatile("s_waitcnt lgkmcnt(0)" ::: "memory");
    const int c = lane & 7;
#pragma unroll
    for (int j = 0; j < 4; ++j) { const int n = (lane >> 3) + 8 * j; const LAS float* s = scr + (8 * c) * 33 + n;
        u32x4 o; o.x = pk2(s[0 * 33], s[1 * 33]); o.y = pk2(s[2 * 33], s[3 * 33]); o.z = pk2(s[4 * 33], s[5 * 33]); o.w = pk2(s[6 * 33], s[7 * 33]);
        *(u32x4*)(WT + (size_t)(dst_n0 + n) * K + k0 + 8 * c) = o; }
    asm volatile("s_waitcnt lgkmcnt(0)" ::: "memory");
}
#ifndef TI_TAIL_NUM
#define TI_TAIL_NUM 3
#endif
constexpr int TI_IN = (PLD / 32) * (D / 64), TI_OUT = (D / 32) * (1024 / 64), TI_UP = (2 * DFF / 32) * (D / 64), TI_DN = (D / 32) * (DFF / 64), TI_ALL = TI_IN + TI_OUT + TI_UP + TI_DN;
__device__ __forceinline__ void phase_wbat(const P& p) {
    if (blockIdx.x == gridDim.x - 1) { for (int i = otid(); i < 8 * D; i += NTHR) ws_f(p, WS_WBAT)[i] = p.w_in[(size_t)(i % D) * IN_COLS + WC_BA + i / D]; }
}
__device__ __forceinline__ void phase_transposes(const P& p, LAS unsigned char* lds) {
    const int tid_ = otid(), lane = tid_ & 63, wave = tid_ >> 6;
    LAS float* scr = (LAS float*)(lds + wave * 16384);
    constexpr int NCG_MOD = 6 * D / 32;
    const bool split = (int)gridDim.x >= NCG_MOD + 32;
    constexpr int TI_TAIL = TI_ALL * TI_TAIL_NUM / 13;
    const bool modwg = split && (int)blockIdx.x < NCG_MOD;
    const int it0 = !split ? 0 : (modwg ? TI_ALL - TI_TAIL : 0), it1 = !split ? TI_ALL : (modwg ? TI_ALL : TI_ALL - TI_TAIL);
    const int gw = (!split ? (int)blockIdx.x : (modwg ? (int)blockIdx.x : (int)blockIdx.x - NCG_MOD)) * NWAVES + wave, NGW = (!split ? (int)gridDim.x : (modwg ? NCG_MOD : (int)gridDim.x - NCG_MOD)) * NWAVES;
    for (int it = it0 + gw; it < it1; it += NGW) {
        int r = it;
        if (r < TI_IN) { const int nb = r % (PLD / 32), kb = r / (PLD / 32), n0 = nb * 32; transpose_item(p.w_in, IN_COLS, D, ws_h(p, WS_WT_IN), n0, n0 < WC_BA ? n0 : n0 + 8, kb * 64, scr, lane); continue; } r -= TI_IN;
        if (r < TI_OUT) { const int nb = r % (D / 32), kb = r / (D / 32), n0 = nb * 32; transpose_item(p.w_out, D, 1024, ws_h(p, WS_WT_OUT), n0, n0, kb * 64, scr, lane); continue; } r -= TI_OUT;
        if (r < TI_UP) { const int nb = r % (2 * DFF / 32), kb = r / (2 * DFF / 32), n0 = nb * 32;
            const int pn = n0 >> 8, bj = (n0 >> 7) & 1, c = n0 & 127; transpose_item(p.w_up, 2 * DFF, D, ws_h(p, WS_WT_UP), n0, bj * DFF + 128 * pn + c, kb * 64, scr, lane); continue; } r -= TI_UP;
        { const int nb = r % (D / 32), kb = r / (D / 32), n0 = nb * 32; transpose_item(p.w_down, D, DFF, ws_h(p, WS_WT_DN), n0, n0, kb * 64, scr, lane); }
    }
}
typedef short bf16x8m __attribute__((ext_vector_type(8)));
typedef float f32x2m __attribute__((ext_vector_type(2))); typedef __bf16 bf16x2m __attribute__((ext_vector_type(2)));
__device__ __forceinline__ unsigned cvtpk_m(float lo, float hi) { const f32x2m v = {lo, hi}; return __builtin_bit_cast(unsigned, __builtin_convertvector(v, bf16x2m)); }
__device__ __forceinline__ void split8(const float (&x)[8], bf16x8m& hi, bf16x8m& lo) {
    unsigned h[4], l[4];
#pragma unroll
    for (int e = 0; e < 4; ++e) { h[e] = cvtpk_m(x[2 * e], x[2 * e + 1]);
        l[e] = cvtpk_m(x[2 * e] - __builtin_bit_cast(float, h[e] << 16), x[2 * e + 1] - __builtin_bit_cast(float, h[e] & 0xffff0000u)); }
    hi = __builtin_bit_cast(bf16x8m, (u32x4){h[0], h[1], h[2], h[3]}); lo = __builtin_bit_cast(bf16x8m, (u32x4){l[0], l[1], l[2], l[3]});
}
__device__ __forceinline__ float silu_fast(float x) { return x * __builtin_amdgcn_rcpf(1.0f + __expf(-x)); }
#ifndef DPS
#define DPS(k)
#endif
constexpr size_t WS_MODA_H = WS_PROJ, WS_MODA_L = WS_PROJ + (size_t)144 * D * 2;
__device__ __forceinline__ void phase_moda(const P& p) {
    constexpr int NCG_MOD = 6 * D / 32; const bool split = (int)gridDim.x >= NCG_MOD + 32;
    const int pb0 = split ? NCG_MOD : 0, npb = (int)gridDim.x - pb0;
    if ((int)blockIdx.x < pb0) return;
    for (int it = ((int)blockIdx.x - pb0) * NTHR + otid(); it < 144 * (D / 8); it += npb * NTHR) {
        const int row = it / (D / 8), k0 = (it % (D / 8)) * 8;
        float x[8];
#pragma unroll
        for (int j = 0; j < 8; ++j) x[j] = 0.f;
        if (row < NCB) { const float* c = (row < BATCH ? p.c_prompt + (size_t)row * D : p.c_sample + (size_t)(row - BATCH) * D) + k0; const f32x4 a = *(const f32x4*)c, d = *(const f32x4*)(c + 4);
            x[0] = silu_fast(a[0]); x[1] = silu_fast(a[1]); x[2] = silu_fast(a[2]); x[3] = silu_fast(a[3]); x[4] = silu_fast(d[0]); x[5] = silu_fast(d[1]); x[6] = silu_fast(d[2]); x[7] = silu_fast(d[3]); }
        bf16x8m hi, lo; split8(x, hi, lo);
        *(bf16x8m*)(ws_h(p, WS_MODA_H) + (size_t)row * D + k0) = hi; *(bf16x8m*)(ws_h(p, WS_MODA_L) + (size_t)row * D + k0) = lo;
    }
}
template <class Seam> __device__ __forceinline__ void phase_mod(const P& p, LAS unsigned char* lds, unsigned long long& pr_prev, unsigned long long& pr_acc, const Seam& seam) {
    constexpr int KC = 256, NCG = 6 * D / 32, NCH = D / KC, NMT = (NCB + 15) / 16;
    static_assert(NMT == 9 && KC / 32 == NWAVES, "eight full m-tiles + one k-split tile");
    constexpr int KCP = KC + 4;
    LAS float* WB = (LAS float*)lds;
    LAS float* RX = WB + 2 * 32 * KCP;
    const int tid = otid(), lane = tid & 63, wave = tid >> 6, r16 = lane & 15, g4 = lane >> 4;
    bool waited = false;
    for (int cg = blockIdx.x; cg < NCG; cg += gridDim.x) {
        f32x4 acc[2][2];
#pragma unroll
        for (int s = 0; s < 2; ++s)
#pragma unroll
            for (int nt = 0; nt < 2; ++nt) acc[s][nt] = (f32x4){0.f, 0.f, 0.f, 0.f};
        f32x4 wreg[4];
#pragma unroll
        for (int j = 0; j < 4; ++j) { const int idx = tid + NTHR * j; wreg[j] = *(const f32x4*)(p.w_ada + (size_t)(idx >> 3) * 6 * D + cg * 32 + 4 * (idx & 7)); }
        if (!waited) { seam(); waited = true; }
        LDS_BARRIER();
        const int row0 = 16 * wave + r16, row8 = 128 + r16;
        const bf16_t* ah0 = ws_h(p, WS_MODA_H) + (size_t)row0 * D + 8 * g4; const bf16_t* al0 = ws_h(p, WS_MODA_L) + (size_t)row0 * D + 8 * g4;
        const bf16_t* ah8 = ws_h(p, WS_MODA_H) + (size_t)row8 * D + 8 * g4; const bf16_t* al8 = ws_h(p, WS_MODA_L) + (size_t)row8 * D + 8 * g4;
#pragma unroll
        for (int ch = 0; ch < NCH; ++ch) {
            LAS float* wb = WB + (ch & 1) * 32 * KCP;
#pragma unroll
            for (int j = 0; j < 4; ++j) { const int idx = tid + NTHR * j;
#pragma unroll
                for (int e = 0; e < 4; ++e) wb[(4 * (idx & 7) + e) * KCP + (idx >> 3)] = wreg[j][e]; }
            u32x4 areg[KC / 32 + 1][2];
#pragma unroll
            for (int ks = 0; ks < KC / 32; ++ks) { areg[ks][0] = *(const u32x4*)(ah0 + ch * KC + 32 * ks); areg[ks][1] = *(const u32x4*)(al0 + ch * KC + 32 * ks); }
            areg[KC / 32][0] = *(const u32x4*)(ah8 + ch * KC + 32 * wave); areg[KC / 32][1] = *(const u32x4*)(al8 + ch * KC + 32 * wave);
            if (ch + 1 < NCH) {
#pragma unroll
                for (int j = 0; j < 4; ++j) { const int idx = tid + NTHR * j; wreg[j] = *(const f32x4*)(p.w_ada + (size_t)((ch + 1) * KC + (idx >> 3)) * 6 * D + cg * 32 + 4 * (idx & 7)); }
            }
            LDS_BARRIER(); if (ch == 0) { DPS(26); } else { DPS(26); }
#pragma unroll
            for (int st = 0; st <= KC / 32; ++st) {
                const int ks = st < KC / 32 ? st : wave, s = st < KC / 32 ? 0 : 1;
                bf16x8m bh[2], bl[2];
#pragma unroll
                for (int nt = 0; nt < 2; ++nt) { const LAS float* wp = wb + (16 * nt + r16) * KCP + 32 * ks + 8 * g4; const f32x4 w0 = *(const LAS f32x4*)wp, w1 = *(const LAS f32x4*)(wp + 4);
                    const float x[8] = {w0[0], w0[1], w0[2], w0[3], w1[0], w1[1], w1[2], w1[3]};
                    split8(x, bh[nt], bl[nt]); }
                const bf16x8m ah = __builtin_bit_cast(bf16x8m, areg[st][0]), al = __builtin_bit_cast(bf16x8m, areg[st][1]);
#pragma unroll
                for (int nt = 0; nt < 2; ++nt) {
                    acc[s][nt] = __builtin_amdgcn_mfma_f32_16x16x32_bf16(ah, bh[nt], acc[s][nt], 0, 0, 0);
                    acc[s][nt] = __builtin_amdgcn_mfma_f32_16x16x32_bf16(ah, bl[nt], acc[s][nt], 0, 0, 0);
                    acc[s][nt] = __builtin_amdgcn_mfma_f32_16x16x32_bf16(al, bh[nt], acc[s][nt], 0, 0, 0); }
            }
            DPS(26);
        }
#pragma unroll
        for (int nt = 0; nt < 2; ++nt) { *(LAS f32x4*)(RX + ((wave * 2 + nt) * 64 + lane) * 4) = acc[1][nt]; }
#pragma unroll
        for (int nt = 0; nt < 2; ++nt) { const int e = cg * 32 + 16 * nt + r16; const float bb = p.b_ada[e];
#pragma unroll
            for (int i = 0; i < 4; ++i) { const int row = 16 * wave + 4 * g4 + i; if (row < NCB) ws_f(p, WS_MOD)[(size_t)row * 6 * D + e] = acc[0][nt][i] + bb; } }
        LDS_BARRIER();
        if (wave == 0) {
#pragma unroll
            for (int nt = 0; nt < 2; ++nt) { f32x4 t = (f32x4){0.f, 0.f, 0.f, 0.f};
#pragma unroll
                for (int w = 0; w < NWAVES; ++w) t += *(const LAS f32x4*)(RX + ((w * 2 + nt) * 64 + lane) * 4);
                const int e = cg * 32 + 16 * nt + r16; const float bb = p.b_ada[e];
#pragma unroll
                for (int i = 0; i < 4; ++i) { const int row = 128 + 4 * g4 + i; if (row < NCB) ws_f(p, WS_MOD)[(size_t)row * 6 * D + e] = t[i] + bb; } }
        }
    }
    LDS_BARRIER();
}
constexpr int NS_OUT = 4, NS_DN = 11;
constexpr size_t O_SLAB_OUT = (size_t)T * D - (size_t)(TS / 256) * (D / 256) * NS_OUT * 65536;
constexpr size_t SLAB_DN_BYTES = (size_t)(TS / 256) * (D / 256) * NS_DN * 65536 * 4, WS_SLAB_DN = WS_H;
constexpr int SLAB_DN_SPLIT = 12;
constexpr size_t WS_XB = al256(WS_SLAB_DN + SLAB_DN_BYTES);
constexpr size_t WS_SLAB_DN_A = WS_MIX, WS_SLAB_DN_B = al256(WS_XB + (size_t)T * D * 2);
static_assert((size_t)SLAB_DN_SPLIT * NS_DN * 65536 * 4 <= (size_t)T * 1024 * 2 && WS_SLAB_DN_B + (size_t)((TS / 256) * (D / 256) - SLAB_DN_SPLIT) * NS_DN * 65536 * 4 <= WS_DNF_CD, "down-projection slabs fit in MIX + the tail of the fragment region");
static_assert(WS_XB >= WS_DNF_AB && WS_XB + (size_t)T * D * 2 <= WS_DNF_CD && (size_t)(TS / 256) * (D / 256) * NS_OUT * 65536 <= (size_t)T * D, "residual stream / slabs fit");
template <int WHICH> __device__ __forceinline__ void norm_row_tail(const P& p, int m, int lane, const f32x4 (&v)[4], const f32x4 (&nwv)[4], const LAS float* wbt, int& cbc, f32x4 (&scv)[4], f32x4 (&shv)[4], float nalog, float dtb) {
    float ss = 0.f;
#pragma unroll
    for (int j = 0; j < 4; ++j) ss += (v[j][0] * v[j][0] + v[j][1] * v[j][1]) + (v[j][2] * v[j][2] + v[j][3] * v[j][3]);
    const float rstd = __builtin_amdgcn_rsqf(wave_sum(ss) * (1.0f / D) + EPS);
    if (WHICH == 2) {
#pragma unroll
        for (int j = 0; j < 4; ++j) ((f32x4*)(p.out + O_Y + (size_t)m * D))[lane + 64 * j] = v[j] * rstd * nwv[j];
        return;
    }
    const int cb = cb_of(m);
    if (cb != cbc) {
        const float* mod = ws_f(p, WS_MOD) + (size_t)cb * 6 * D;
        const float* sh = mod + (WHICH == 0 ? 0 : 3 * D); const float* sc = mod + (WHICH == 0 ? D : 4 * D);
#pragma unroll
        for (int j = 0; j < 4; ++j) { scv[j] = ((const f32x4*)sc)[lane + 64 * j] + 1.0f; shv[j] = ((const f32x4*)sh)[lane + 64 * j]; }
        cbc = cb;
    }
    float ba[8];
#pragma unroll
    for (int j = 0; j < 8; ++j) ba[j] = 0.f;
    unsigned long long* o8 = (unsigned long long*)(ws_h(p, WS_H) + (size_t)m * D);
#pragma unroll
    for (int j = 0; j < 4; ++j) {
        const f32x4 h = v[j] * rstd * nwv[j] * scv[j] + shv[j];
        o8[lane + 64 * j] = (unsigned long long)cvtpk_m(h[0], h[1]) | ((unsigned long long)cvtpk_m(h[2], h[3]) << 32);
        if (WHICH == 0) {
#pragma unroll
            for (int c = 0; c < 8; ++c) { const f32x4 w = *(const LAS f32x4*)(wbt + c * D + 4 * (lane + 64 * j)); ba[c] += (h[0] * w[0] + h[1] * w[1]) + (h[2] * w[2] + h[3] * w[3]); }
            asm volatile("" ::: "memory");
        }
    }
    if (WHICH == 0) {
        float t4[4], t2[2], t1;
        const bool h5 = lane & 32, h4 = lane & 16, h3 = lane & 8;
#pragma unroll
        for (int c = 0; c < 4; ++c) { const float snd = h5 ? ba[c] : ba[c + 4], kp = h5 ? ba[c + 4] : ba[c]; t4[c] = kp + __shfl_xor(snd, 32); }
#pragma unroll
        for (int c = 0; c < 2; ++c) { const float snd = h4 ? t4[c] : t4[c + 2], kp = h4 ? t4[c + 2] : t4[c]; t2[c] = kp + __shfl_xor(snd, 16); }
        { const float snd = h3 ? t2[0] : t2[1], kp = h3 ? t2[1] : t2[0]; t1 = kp + __shfl_xor(snd, 8); }
        t1 += __shfl_xor(t1, 4); t1 += __shfl_xor(t1, 2); t1 += __shfl_xor(t1, 1);
        if ((lane & 7) == 0) { const int c = lane >> 3; float* bg = ws_f(p, WS_BG) + (size_t)m * 8;
            const float xs = c < 4 ? -t1 : t1 + dtb, ex = __expf(xs);
            const float sp = xs > 15.f ? xs : (ex < 0.03f ? ex * (1.0f - ex * (0.5f - ex * (0.33333334f - 0.25f * ex))) : __logf(1.0f + ex));
            bg[c] = c < 4 ? __builtin_amdgcn_rcpf(1.0f + ex) : nalog * sp; }
    }
}
struct NoSeam { __device__ __forceinline__ void operator()() const {} };
template <int WHICH, class Seam = NoSeam, int PART = 0> __device__ __forceinline__ void phase_norm(const P& p, LAS unsigned char* lds, const Seam& seam = Seam()) {
    static_assert(D == 1024, "one wave per 1024-element row");
    const int tid_ = otid(), lane = tid_ & 63, wave = tid_ >> 6;
    const int gw = blockIdx.x * NWAVES + wave, NGW = gridDim.x * NWAVES;
    const float* nwp = WHICH == 0 ? p.norm_mix_w : (WHICH == 1 ? p.norm_ffn_w : p.final_norm_w);
    f32x4 nwv[4];
#pragma unroll
    for (int j = 0; j < 4; ++j) nwv[j] = ((const f32x4*)nwp)[lane + 64 * j];
    const LAS float* wbt = (const LAS float*)lds;
    const bf16_t* XB = ws_h(p, WS_XB);
    int cbc = -1; f32x4 scv[4], shv[4];
    const float nalog = WHICH == 0 ? -expf(p.dn_A_log[(lane >> 3) & 3]) : 0.f, dtb = WHICH == 0 ? p.dn_dt_bias[(lane >> 3) & 3] : 0.f;
    constexpr int MEND = WHICH == 0 ? T : TP;
    typedef f32x4 rowbuf_t[4];
    rowbuf_t ra, rb, rc, rd;
#define NR_LOAD(buf_, mm0_) do { const int mm_ = (mm0_) < MEND ? (mm0_) : MEND - 1; { if (WHICH == 0) { const float* xr_ = xrow(p, (mm_)); _Pragma("unroll") for (int j = 0; j < 4; ++j) buf_[j] = ((const f32x4*)xr_)[lane + 64 * j]; } \
        else { const u32x2* xr_ = (const u32x2*)(XB + (size_t)(mm_) * D); u32x2 w_[4]; _Pragma("unroll") for (int j = 0; j < 4; ++j) w_[j] = xr_[lane + 64 * j]; \
            buf_[0] = __builtin_bit_cast(f32x4, (u32x4){w_[0].x, w_[0].y, w_[1].x, w_[1].y}); buf_[1] = __builtin_bit_cast(f32x4, (u32x4){w_[2].x, w_[2].y, w_[3].x, w_[3].y}); } } } while (0)
#define NR_PROC(buf_, mm_) do { if ((mm_) < MEND) { f32x4 v_[4]; if (WHICH == 0) { _Pragma("unroll") for (int j = 0; j < 4; ++j) v_[j] = buf_[j]; } \
        else { const u32x4 a_ = __builtin_bit_cast(u32x4, buf_[0]), b_ = __builtin_bit_cast(u32x4, buf_[1]); const unsigned w_[8] = {a_.x, a_.y, a_.z, a_.w, b_.x, b_.y, b_.z, b_.w}; \
            _Pragma("unroll") for (int j = 0; j < 4; ++j) v_[j] = (f32x4){__builtin_bit_cast(float, w_[2 * j] << 16), __builtin_bit_cast(float, w_[2 * j] & 0xffff0000u), __builtin_bit_cast(float, w_[2 * j + 1] << 16), __builtin_bit_cast(float, w_[2 * j + 1] & 0xffff0000u)}; } \
        norm_row_tail<WHICH>(p, (mm_), lane, v_, nwv, wbt, cbc, scv, shv, nalog, dtb); } } while (0)
    if (PART != 1) {
    NR_LOAD(ra, gw); NR_LOAD(rb, gw + NGW); NR_LOAD(rc, gw + 2 * NGW);
    seam();
    if (WHICH == 0) { for (int i = tid_; i < 8 * D / 4; i += NTHR) ((LAS f32x4*)lds)[i] = ((const f32x4*)ws_f(p, WS_WBAT))[i]; LDS_BARRIER(); }
#define NR_BODY(m_) do { NR_LOAD(rd, (m_) + 3 * NGW); NR_PROC(ra, (m_)); NR_LOAD(ra, (m_) + 4 * NGW); NR_PROC(rb, (m_) + NGW); NR_LOAD(rb, (m_) + 5 * NGW); NR_PROC(rc, (m_) + 2 * NGW); NR_LOAD(rc, (m_) + 6 * NGW); NR_PROC(rd, (m_) + 3 * NGW); } while (0)
    if (NGW == 2048) {
        __builtin_assume(gw >= 0 && gw < 2048);
        constexpr int NIT = (MEND + 4 * 2048 - 1) / (4 * 2048);
#pragma unroll
        for (int it = 0; it < NIT; ++it) NR_BODY(gw + it * 4 * 2048);
    } else {
        for (int m = gw; m < MEND; m += 4 * NGW) NR_BODY(m);
    }
#undef NR_BODY
    }
#undef NR_LOAD
#undef NR_PROC
    if (WHICH != 0 && PART != 2) {
        constexpr int NS = WHICH == 1 ? NS_OUT : NS_DN;
        const float* slabs = WHICH == 1 ? p.out + O_SLAB_OUT : ws_f(p, WS_SLAB_DN_A); const float* slabs2 = WHICH == 1 ? slabs : ws_f(p, WS_SLAB_DN_B); constexpr int SPLIT = WHICH == 1 ? 1 << 20 : SLAB_DN_SPLIT;
        for (int rs = gw; rs < TS; rs += NGW) { const int m = TP + rs, cbs = BATCH + (rs >> 3);
            const float* gt = ws_f(p, WS_MOD) + (size_t)cbs * 6 * D + (WHICH == 1 ? 2 * D : 5 * D);
            f32x4 vs[4];
#pragma unroll
            for (int j = 0; j < 4; ++j) { const int tile = (rs >> 8) * 4 + j; const bf16_t* sl = (tile < SPLIT ? (const bf16_t*)slabs + (size_t)tile * NS * 65536 : (const bf16_t*)slabs2 + (size_t)(tile - SPLIT) * NS * 65536) + (size_t)(rs & 255) * 256 + 4 * lane;
                f32x4 acc = (f32x4){0.f, 0.f, 0.f, 0.f};
#pragma unroll
                for (int ks = 0; ks < NS; ++ks) { const u32x2 w = *(const u32x2*)sl; acc += (f32x4){__builtin_bit_cast(float, w.x << 16), __builtin_bit_cast(float, w.x & 0xffff0000u), __builtin_bit_cast(float, w.y << 16), __builtin_bit_cast(float, w.y & 0xffff0000u)}; sl += 65536; asm volatile("" : "+v"(sl)); }
                f32x4 base;
                if (WHICH == 1) base = ((const f32x4*)(p.x_sample + (size_t)rs * D))[lane + 64 * j];
                else { const u32x2 w = ((const u32x2*)(XB + (size_t)m * D))[lane + 64 * j]; base = (f32x4){__builtin_bit_cast(float, w.x << 16), __builtin_bit_cast(float, w.x & 0xffff0000u), __builtin_bit_cast(float, w.y << 16), __builtin_bit_cast(float, w.y & 0xffff0000u)}; }
                vs[j] = base + ((const f32x4*)gt)[lane + 64 * j] * acc;
                if (WHICH == 1) ((u32x2*)(ws_h(p, WS_XB) + (size_t)m * D))[lane + 64 * j] = (u32x2){cvtpk_m(vs[j][0], vs[j][1]), cvtpk_m(vs[j][2], vs[j][3])};
                asm volatile("" ::: "memory"); }
            norm_row_tail<WHICH>(p, m, lane, vs, nwv, wbt, cbc, scv, shv, nalog, dtb);
        }
    }
}

constexpr long SO_1 = (long)BATCH * 3 * 1536 / 4, SO_2 = (long)DEC_BATCH * 3 * 1536 / 4, SO_3 = (long)BATCH * 128 * 128 / 4, SO_4 = (long)DEC_BATCH * DEC_SEQ * 128 / 4  , SO_N = SO_1 + SO_2 + 2 * (SO_3 + SO_4);
__device__ __forceinline__ void so_item(const P& p, long it, f32x4& val, float*& dst) {
    const bf16_t* PR = ws_h(p, WS_PROJ); const bf16_t* src = nullptr; const float* fsrc = nullptr;
    long r = it;
    if (r < SO_1) { const int b = (int)(r / (3 * 384)), j = (int)(r / 384 % 3), c = (int)(r % 384) * 4; src = PR + (size_t)(b * SEQ + SEQ - 3 + j) * PLD + PC_QKV + c; dst = p.out + O_PDC + r * 4; }
    else if ((r -= SO_1) < SO_2) { const int b = (int)(r / (3 * 384)), j = (int)(r / 384 % 3), c = (int)(r % 384) * 4; src = PR + (size_t)(TP + b * DEC_SEQ + DEC_SEQ - 3 + j) * PLD + PC_QKV + c; dst = p.out + O_SDC + r * 4; }
    else { r -= SO_2; const int kv = r >= SO_3 + SO_4; if (kv) r -= SO_3 + SO_4; const int pc = kv ? PC_SV : PC_SK; const float* cache = kv ? p.cache_v : p.cache_k;
        if (r < SO_3) { const int b = (int)(r / (128 * 32)), j = (int)(r / 32 % 128), c = (int)(r % 32) * 4; src = PR + (size_t)(b * SEQ + SEQ - 128 + j) * PLD + pc + c; dst = p.out + (kv ? O_PV : O_PK) + r * 4; }
        else { r -= SO_3; const int b = (int)(r / (DEC_SEQ * 32)), jj = (int)(r / 32 % DEC_SEQ), c = (int)(r % 32) * 4; dst = p.out + (kv ? O_SV : O_SK) + ((size_t)b * 128 + (128 - DEC_SEQ) + jj) * 128 + c;
            src = PR + (size_t)(TP + b * DEC_SEQ + jj) * PLD + pc + c; (void)cache; } }
    if (fsrc) val = *(const f32x4*)fsrc;
    else { const u32x2 w = *(const u32x2*)src; val = (f32x4){__builtin_bit_cast(float, w.x << 16), __builtin_bit_cast(float, w.x & 0xffff0000u), __builtin_bit_cast(float, w.y << 16), __builtin_bit_cast(float, w.y & 0xffff0000u)}; }
}
constexpr int CC_NSL = 2;
constexpr int CC_N = 2 * DEC_BATCH * (128 - DEC_SEQ) * 32;
__device__ __forceinline__ void phase_cache_copy(const P& p, int sl) {
    const int gs = (int)gridDim.x * NTHR, per = (CC_N + CC_NSL - 1) / CC_NSL, i0 = sl * per, i1 = i0 + per < CC_N ? i0 + per : CC_N;
    for (int it = i0 + (int)blockIdx.x * NTHR + otid(); it < i1; it += 4 * gs) {
        f32x4 v[4]; int so[4]; bool kvf[4];
#pragma unroll
        for (int u = 0; u < 4; ++u) { const int r = it + u * gs; kvf[u] = r >= CC_N / 2; const int q = kvf[u] ? r - CC_N / 2 : r, b = q / ((128 - DEC_SEQ) * 32), j = (q >> 5) % (128 - DEC_SEQ), c = (q & 31) * 4;
            so[u] = (b * 128 + j) * 128 + c;
            if (r < i1) v[u] = *(const f32x4*)((kvf[u] ? p.cache_v : p.cache_k) + so[u] + DEC_SEQ * 128); }
#pragma unroll
        for (int u = 0; u < 4; ++u) { const int r = it + u * gs; if (r < i1) *(f32x4*)(p.out + (kvf[u] ? O_SV : O_SK) + so[u]) = v[u]; }
    }
}
__device__ __forceinline__ void phase_state_out(const P& p, int vblk, int nblk) {
    const long gt = vblk * (long)NTHR + otid(), gs = (long)nblk * NTHR;
    for (long it = gt; it < SO_N; it += 4 * gs) {
        f32x4 v[4]; float* d[4];
#pragma unroll
        for (int u = 0; u < 4; ++u) if (it + u * gs < SO_N) so_item(p, it + u * gs, v[u], d[u]);
#pragma unroll
        for (int u = 0; u < 4; ++u) if (it + u * gs < SO_N) *(f32x4*)d[u] = v[u];
    }
}
#define XB_TMO      128
#define XB_XCNT(j)  (256  + 64 * (j))
#define XB_XSUB(j)  (1280 + 64 * (j))
#define XB_XGEN(j)  (2304 + 64 * (j))
#define XB_TOP      3328
#define XB_TOPGEN   3392
#define XCD_BAR_WORDS 3456
#define XB_SPIN_CAP (1u << 18)

__device__ __forceinline__ unsigned xb_ld(unsigned* p)              { return __hip_atomic_load(p, __ATOMIC_RELAXED, __HIP_MEMORY_SCOPE_AGENT); }
__device__ __forceinline__ unsigned xb_add(unsigned* p, unsigned v) { return __hip_atomic_fetch_add(p, v, __ATOMIC_RELAXED, __HIP_MEMORY_SCOPE_AGENT); }
__device__ __forceinline__ unsigned xb_xcc_id() { return (unsigned)__builtin_amdgcn_s_getreg((3 << 11) | 20) & 0xFu; }
#define XB_SPIN(cond, bar) do { unsigned _sp = 0; while (cond) { __builtin_amdgcn_s_sleep(1); \
    if ((++_sp & 255u) == 0u) { if (xb_ld(&(bar)[XB_TMO])) break; if (_sp > XB_SPIN_CAP) { atomicAdd(&(bar)[XB_TMO], 1u); break; } } } } while (0)

struct XcdBarrier {
    unsigned* bar; unsigned x;
    volatile LAS unsigned* st;
};

__device__ __forceinline__ XcdBarrier xcd_barrier_post(unsigned* bar, volatile LAS unsigned* st) {
    XcdBarrier b; b.bar = bar; b.x = xb_xcc_id(); b.st = st;
    if (threadIdx.x == 0) (void)xb_add(&bar[XB_XCNT(b.x)], 1u);
    return b;
}
__device__ __forceinline__ void xcd_barrier_complete(unsigned* bar, unsigned x, unsigned& nloc, unsigned& nx) {
    const unsigned G = gridDim.x * gridDim.y * gridDim.z;
    unsigned sum, cnt, mine, sp = 0u;
    for (;;) {
        sum = 0u; cnt = 0u; mine = 0u;
#pragma unroll
        for (unsigned j = 0; j < 16; ++j) { const unsigned c = xb_ld(&bar[XB_XCNT(j)]); sum += c; cnt += (c > 0u) ? 1u : 0u; mine = (j == x) ? c : mine; }
        if (sum == G) break;
        __builtin_amdgcn_s_sleep(1);
        if ((++sp & 255u) == 0u) { if (xb_ld(&bar[XB_TMO])) break; if (sp > XB_SPIN_CAP) { atomicAdd(&bar[XB_TMO], 1u); break; } }
    }
    nloc = mine > 0u ? mine : 1u; nx = cnt > 0u ? cnt : 1u;
}

__device__ __forceinline__ void xcd_barrier(const XcdBarrier& b) {
    asm volatile("s_waitcnt vmcnt(0)" ::: "memory");
    __syncthreads();
    if (threadIdx.x == 0) {
        unsigned* bar = b.bar;
        __builtin_amdgcn_s_waitcnt(0);
        unsigned nloc = b.st[0], nx = b.st[1];
        if (nloc == 0u) { xcd_barrier_complete(bar, b.x, nloc, nx); b.st[0] = nloc; b.st[1] = nx; }
        const unsigned old = xb_add(&bar[XB_XSUB(b.x)], 1u);
        const unsigned gen = old / nloc;
        if (old + 1u == (gen + 1u) * nloc) {
            __builtin_amdgcn_fence(__ATOMIC_RELEASE, "agent");
            asm volatile("s_waitcnt vmcnt(0)" ::: "memory");
            (void)xb_add(&bar[XB_TOP], 1u);
            XB_SPIN(xb_ld(&bar[XB_TOP]) < nx * (gen + 1u), bar);
            __builtin_amdgcn_fence(__ATOMIC_ACQUIRE, "agent");
            asm volatile("s_waitcnt vmcnt(0)" ::: "memory");
        } else {
            XB_SPIN(xb_ld(&bar[XB_TOP]) < nx * (gen + 1u), bar);
            __builtin_amdgcn_fence(__ATOMIC_ACQUIRE, "agent");
            asm volatile("s_waitcnt vmcnt(0)" ::: "memory");
        }
    }
    __syncthreads();
}

#define XS_SUB(k, j) (4096 + 1152 * (k) + 64 * (j))
#define XS_TOP(k)    (4096 + 1152 * (k) + 1024)
__device__ __forceinline__ void xcd_split_arrive(const XcdBarrier& b, int k) {
    asm volatile("s_waitcnt vmcnt(0)" ::: "memory");
    __syncthreads();
    if (threadIdx.x == 0) {
        unsigned* bar = b.bar;
        __builtin_amdgcn_s_waitcnt(0);
        unsigned nloc = b.st[0], nx = b.st[1];
        if (nloc == 0u) { xcd_barrier_complete(bar, b.x, nloc, nx); b.st[0] = nloc; b.st[1] = nx; }
        const unsigned old = xb_add(&bar[XS_SUB(k, b.x)], 1u);
        if (old + 1u == nloc) {
            __builtin_amdgcn_fence(__ATOMIC_RELEASE, "agent");
            asm volatile("s_waitcnt vmcnt(0)" ::: "memory");
            (void)xb_add(&bar[XS_TOP(k)], 1u);
        }
    }
}
__device__ __forceinline__ void xcd_split_wait(const XcdBarrier& b, int k) {
    __syncthreads();
    if (threadIdx.x == 0) {
        unsigned* bar = b.bar;
        const unsigned nx = b.st[1];
        XB_SPIN(xb_ld(&bar[XS_TOP(k)]) < nx, bar);
        __builtin_amdgcn_fence(__ATOMIC_ACQUIRE, "agent");
        asm volatile("s_waitcnt vmcnt(0)" ::: "memory");
    }
    __syncthreads();
}

#define XH_CNT 12032
__device__ __forceinline__ void xcd_handoff_post(unsigned* bar) {
    asm volatile("s_waitcnt vmcnt(0)" ::: "memory");
    __syncthreads();
    if (threadIdx.x == 0) {
        __builtin_amdgcn_fence(__ATOMIC_RELEASE, "agent");
        asm volatile("s_waitcnt vmcnt(0)" ::: "memory");
        (void)xb_add(&bar[XH_CNT], 1u);
    }
}
__device__ __forceinline__ void xcd_handoff_wait(const XcdBarrier& b, unsigned nprod) {
    __syncthreads();
    if (threadIdx.x == 0) {
        unsigned* bar = b.bar;
        XB_SPIN(xb_ld(&bar[XH_CNT]) < nprod, bar);
        __builtin_amdgcn_fence(__ATOMIC_ACQUIRE, "agent");
        asm volatile("s_waitcnt vmcnt(0)" ::: "memory");
        if (b.st[0] == 0u) { unsigned nloc, nx; xcd_barrier_complete(bar, b.x, nloc, nx); b.st[0] = nloc; b.st[1] = nx; }
    }
    __syncthreads();
}

__device__ __forceinline__ void xcd_barrier_arrive(const XcdBarrier& b) {
    asm volatile("s_waitcnt vmcnt(0)" ::: "memory");
    __syncthreads();
    if (threadIdx.x == 0) {
        unsigned* bar = b.bar;
        __builtin_amdgcn_s_waitcnt(0);
        unsigned nloc = b.st[0], nx = b.st[1];
        if (nloc == 0u) { xcd_barrier_complete(bar, b.x, nloc, nx); b.st[0] = nloc; b.st[1] = nx; }
        const unsigned old = xb_add(&bar[XB_XSUB(b.x)], 1u);
        const unsigned gen = old / nloc;
        b.st[2] = gen;
        if (old + 1u == (gen + 1u) * nloc) {
            __builtin_amdgcn_fence(__ATOMIC_RELEASE, "agent");
            asm volatile("s_waitcnt vmcnt(0)" ::: "memory");
            (void)xb_add(&bar[XB_TOP], 1u);
        }
    }
}
__device__ __forceinline__ void xcd_barrier_wait(const XcdBarrier& b) {
    __syncthreads();
    if (threadIdx.x == 0) {
        unsigned* bar = b.bar;
        const unsigned nx = b.st[1], gen = b.st[2];
        XB_SPIN(xb_ld(&bar[XB_TOP]) < nx * (gen + 1u), bar);
        __builtin_amdgcn_fence(__ATOMIC_ACQUIRE, "agent");
        asm volatile("s_waitcnt vmcnt(0)" ::: "memory");
    }
    __syncthreads();
}
namespace pg8 {
#define PG8_LAS __attribute__((address_space(3)))
typedef unsigned short bf16_t;
typedef short bf16x8 __attribute__((ext_vector_type(8)));
typedef float f32x4 __attribute__((ext_vector_type(4)));
typedef unsigned u32x4 __attribute__((ext_vector_type(4)));
constexpr int BM = 256, BK = 64, HALF = 128, HTB = HALF * BK * 2  , STAGE_BYTES = 8 * HTB, NXCD = 8, WGM = 8;

__host__ __device__ __forceinline__ int lds_byte(int r, int c) { const int st = (r >> 4) * 2 + (c >> 5), rr = r & 15, cc = c & 31, ob = rr * 64 + cc * 2; return st * 1024 + (ob ^ (((ob >> 9) & 1) << 5)); }
__host__ __device__ __forceinline__ void stage_rc(int b, int& R, int& C) { const int st = b / 1024, sb = b % 1024, swz = sb ^ (((sb >> 9) & 1) << 5); R = (st >> 1) * 16 + swz / 64; C = (st & 1) * 32 + (swz % 64) / 2; }
__host__ __device__ __forceinline__ int perm32(int rho) { const int n = rho >> 4, i = rho & 15; return 8 * (i >> 2) + 4 * n + (i & 3); }

struct Unit { int pm, pn, k0, nt, atomic; };
struct Gemm { const bf16_t* A; const bf16_t* Bt; int M, N, K; };

struct StaticOrder {
    int nM, nN, nwg, G, c, ntk;
    __host__ __device__ void init(int M, int N, int G_, int c_, int K_) { nM = M / BM; nN = N / BM; nwg = nM * nN; G = G_; c = c_; ntk = K_ / BK; }
    __host__ __device__ bool next(int i, Unit& u) const { return at((long)i * G + c, u); }
    __host__ __device__ bool at(long L, Unit& u) const {
        if (L >= nwg) return false;
        int wgid = (int)L; { const int q = nwg / NXCD, r = nwg % NXCD, xcd = wgid % NXCD, off = wgid / NXCD; wgid = (xcd < r ? xcd * (q + 1) : r * (q + 1) + (xcd - r) * q) + off; }
        const int nig = WGM * nN, gid = wgid / nig, fm = gid * WGM, gsz = (nM - fm) < WGM ? (nM - fm) : WGM;
        u.pm = fm + ((wgid % nig) % gsz); u.pn = (wgid % nig) / gsz; u.k0 = 0; u.nt = ntk; u.atomic = 0; return true;
    }
    __device__ __forceinline__ void a_ready(const Unit&) const {}
    __device__ __forceinline__ void done(const Unit&) const {}
};

struct SplitOrder {
    StaticOrder so; int nu1, ns, ntk_sub, npn, nsub, G, c;
    __device__ void init(int N, int K, int NS, int G_, int c_) { so.init(TP, N, G_, c_, K); nu1 = so.nwg; ns = NS; ntk_sub = K / BK / NS; npn = N / BM; nsub = (TS / BM) * npn * NS; G = G_; c = c_; }
    __device__ bool next(int i, Unit& u) const {
        const long L = (long)i * G + c; if (L < nu1) return so.next(i, u);
        const int s = (int)(L - nu1); if (s >= nsub) return false;
        const int ks = s % ns, t = s / ns; u.pm = TP / BM + t / npn; u.pn = t % npn; u.k0 = ks * ntk_sub * BK; u.nt = ntk_sub; u.atomic = 1; return true; }
    __device__ __forceinline__ void a_ready(const Unit&) const {}
    __device__ __forceinline__ void done(const Unit&) const {}
};
struct UpOrder {
    StaticOrder so; const XcdBarrier* bar; int nsu, nN, ntk, G, c; mutable int posted;
    __device__ void init(int N, int K, int G_, int c_, const XcdBarrier* b) { so.init(TP, N, G_, c_, K); bar = b; nN = N / BM; nsu = (TS / BM) * nN; ntk = K / BK; G = G_; c = c_; posted = 0; }
    __device__ bool next(int i, Unit& u) const {
        const long L = (long)i * G + c;
        if (L < nsu) { u.pm = TP / BM + (int)L / nN; u.pn = (int)L % nN; u.k0 = 0; u.nt = ntk; u.atomic = 0; return true; }
        return so.at(L - nsu, u); }
    __device__ __forceinline__ void a_ready(const Unit&) const {}
    __device__ __forceinline__ void done(const Unit&) const { if (!posted) { posted = 1; xcd_split_arrive(*bar, 2); } }
};
struct SlabOrder {
    int ns, ntk_sub, npn, nsub, G, c;
    __device__ void init(int N, int K, int NS, int G_, int c_) { ns = NS; ntk_sub = K / BK / NS; npn = N / BM; nsub = (TS / BM) * npn * NS; G = G_; c = c_; }
    __device__ bool next(int i, Unit& u) const {
        const int s = i * G + c; if (s >= nsub) return false;
        const int ks = s % ns, t = s / ns; u.pm = TP / BM + t / npn; u.pn = t % npn; u.k0 = ks * ntk_sub * BK; u.nt = ntk_sub; u.atomic = 1; return true; }
    __device__ __forceinline__ void a_ready(const Unit&) const {}
    __device__ __forceinline__ void done(const Unit&) const {}
};
__device__ __forceinline__ unsigned cvt_pk_bf16(float lo, float hi) { unsigned r; asm volatile("v_cvt_pk_bf16_f32 %0, %1, %2" : "=v"(r) : "v"(lo), "v"(hi)); return r; }
struct EpiStoreBf16 {
    static constexpr bool PERM = true, AFTER_DRAIN = false, APERM = false;
    bf16_t* O; int ldc;
    __device__ __forceinline__ void operator()(const f32x4 (&acc)[2][2][4][2], const Unit& u, int wr, int wc, int fr, int fq) const {
        const int row0 = u.pm * BM + wr * 64 + fr, col0 = u.pn * BM + wc * 32 + 8 * fq;
#pragma unroll
        for (int ai = 0; ai < 2; ++ai)
#pragma unroll
            for (int m = 0; m < 4; ++m) { bf16_t* rowp = O + (size_t)(row0 + ai * HALF + m * 16) * ldc + col0;
#pragma unroll
                for (int bj = 0; bj < 2; ++bj) { const f32x4 v0 = acc[ai][bj][m][0], v1 = acc[ai][bj][m][1];
                    u32x4 w; w.x = cvt_pk_bf16(v0[0], v0[1]); w.y = cvt_pk_bf16(v0[2], v0[3]); w.z = cvt_pk_bf16(v1[0], v1[1]); w.w = cvt_pk_bf16(v1[2], v1[3]);
                    *(u32x4*)(rowp + bj * HALF) = w; } }
    }
};
struct EpiSlab {
    static constexpr bool PERM = true, AFTER_DRAIN = false, APERM = false;
    bf16_t* slab; int ns; bf16_t* slab2; int split;
    __device__ __forceinline__ void operator()(const f32x4 (&acc)[2][2][4][2], const Unit& u, int wr, int wc, int fr, int fq) const {
        const int tile = (u.pm - TP / BM) * (D / BM) + u.pn;
        bf16_t* sl = (tile < split ? slab + (size_t)tile * ns * 65536 : slab2 + (size_t)(tile - split) * ns * 65536) + (size_t)(u.k0 / (u.nt * BK)) * 65536 + (size_t)(wr * 64 + fr) * 256 + wc * 32 + 8 * fq;
#pragma unroll
        for (int ai = 0; ai < 2; ++ai)
#pragma unroll
            for (int m = 0; m < 4; ++m) { bf16_t* rowp = sl + (size_t)(ai * HALF + m * 16) * 256;
#pragma unroll
                for (int bj = 0; bj < 2; ++bj) { const f32x4 v0 = acc[ai][bj][m][0], v1 = acc[ai][bj][m][1];
                    u32x4 w; w.x = cvt_pk_bf16(v0[0], v0[1]); w.y = cvt_pk_bf16(v0[2], v0[3]); w.z = cvt_pk_bf16(v1[0], v1[1]); w.w = cvt_pk_bf16(v1[2], v1[3]);
                    *(u32x4*)(rowp + bj * HALF) = w; } }
    }
};
template <int MODE> struct EpiGateRes {
    static constexpr bool PERM = true, AFTER_DRAIN = false, APERM = false;
    const float* base_p; bf16_t* xb; const float* gate;
    typedef f32x4 brow_t[2][2];
    __device__ __forceinline__ void ldbase(brow_t& b, size_t off) const {
#pragma unroll
        for (int bj = 0; bj < 2; ++bj) {
            if (MODE == 0) { b[bj][0] = *(const f32x4*)(base_p + off + bj * HALF); b[bj][1] = *(const f32x4*)(base_p + off + bj * HALF + 4); }
            else b[bj][0] = __builtin_bit_cast(f32x4, *(const u32x4*)(xb + off + bj * HALF)); }
    }
    __device__ __forceinline__ void operator()(const f32x4 (&acc)[2][2][4][2], const Unit& u, int wr, int wc, int fr, int fq) const {
        const int row0 = u.pm * BM + wr * 64 + fr, col0 = u.pn * BM + wc * 32 + 8 * fq;
        const float* gp = gate + (size_t)(row0 / SEQ) * 6 * D + col0;
        f32x4 gv[2][2];
#pragma unroll
        for (int bj = 0; bj < 2; ++bj)
#pragma unroll
            for (int n = 0; n < 2; ++n) gv[bj][n] = *(const f32x4*)(gp + bj * HALF + 4 * n);
        brow_t bcur, bnxt, bnx2;
        ldbase(bcur, (size_t)row0 * D + col0); ldbase(bnxt, (size_t)(row0 + 16) * D + col0);
#pragma unroll
        for (int it = 0; it < 8; ++it) { const int ai = it >> 2, m = it & 3; const size_t off = (size_t)(row0 + ai * HALF + m * 16) * D + col0;
            if (it + 2 < 8) ldbase(bnx2, (size_t)(row0 + ((it + 2) >> 2) * HALF + ((it + 2) & 3) * 16) * D + col0);
#pragma unroll
            for (int bj = 0; bj < 2; ++bj) { f32x4 v[2];
#pragma unroll
                for (int n = 0; n < 2; ++n) { f32x4 bs;
                    if (MODE == 0) bs = bcur[bj][n];
                    else { const u32x4 w = __builtin_bit_cast(u32x4, bcur[bj][0]); const unsigned lo = n == 0 ? w.x : w.z, hi = n == 0 ? w.y : w.w;
                        bs = (f32x4){__builtin_bit_cast(float, lo << 16), __builtin_bit_cast(float, lo & 0xffff0000u), __builtin_bit_cast(float, hi << 16), __builtin_bit_cast(float, hi & 0xffff0000u)}; }
                    v[n] = bs + gv[bj][n] * acc[ai][bj][m][n]; }
                *(u32x4*)(xb + off + bj * HALF) = (u32x4){cvt_pk_bf16(v[0][0], v[0][1]), cvt_pk_bf16(v[0][2], v[0][3]), cvt_pk_bf16(v[1][0], v[1][1]), cvt_pk_bf16(v[1][2], v[1][3])}; }
#pragma unroll
            for (int bj = 0; bj < 2; ++bj) { bcur[bj][0] = bnxt[bj][0]; bcur[bj][1] = bnxt[bj][1]; bnxt[bj][0] = bnx2[bj][0]; bnxt[bj][1] = bnx2[bj][1]; }
        }
    }
};
template <class Epi, class Sched, bool ALIGN_EPI = false, bool SP2 = false>
__device__ __forceinline__ void gemm_phase(PG8_LAS unsigned char* lds, const Gemm g, const Sched& S, const Epi& E) {
    const int tid = otid(), wid = __builtin_amdgcn_readfirstlane(tid >> 6), lane = tid & 63, wr = wid >> 2, wc = wid & 3, fr = lane & 15, fq = lane >> 4;
    const int K = g.K;
    unsigned voffA[2], voffB[2];
#pragma unroll
    for (int i = 0; i < 2; ++i) { int R, C; stage_rc(tid * 16 + i * 8192, R, C); const int Rb = Epi::PERM ? ((R & ~31) + perm32(R & 31)) : R;
        const int Ra = Epi::APERM ? ((R & ~63) + 4 * (R & 15) + ((R >> 4) & 3)) : R;
        voffA[i] = (unsigned)(Ra * K + C) * 2u; voffB[i] = (unsigned)(Rb * K + C) * 2u; }
    const size_t kstep = (size_t)(BK * 2);
    const size_t hstep = (size_t)HALF * K * 2;
    const size_t tstep = 2 * hstep;
    const unsigned ldsw = (unsigned)wid * 1024u;
    const int aoff = lds_byte(wr * 64 + fr, fq * 8), boff = lds_byte(wc * 32 + fr, fq * 8);
#define PG8_SA(b, h) (((b) * 2 + (h)) * HTB)
#define PG8_SB(b, h) ((4 + (b) * 2 + (h)) * HTB)
#define PG8_STAGE(bufoff, gbase, voff) do { _Pragma("unroll") for (int _i = 0; _i < 2; ++_i) \
        __builtin_amdgcn_global_load_lds((const unsigned*)((const char*)(gbase) + (voff)[_i]), (PG8_LAS unsigned*)(lds + (bufoff) + ldsw + _i * 8192), 16, 0, 0); } while (0)
#define PG8_LDA(dst, b, h) do { _Pragma("unroll") for (int m = 0; m < 4; ++m) _Pragma("unroll") for (int k = 0; k < 2; ++k) dst[m][k] = *(const PG8_LAS bf16x8*)(lds + PG8_SA(b, h) + aoff + m * 2048 + k * 1024); } while (0)
#define PG8_LDB(dst, b, h) do { _Pragma("unroll") for (int n = 0; n < 2; ++n) _Pragma("unroll") for (int k = 0; k < 2; ++k) dst[n][k] = *(const PG8_LAS bf16x8*)(lds + PG8_SB(b, h) + boff + n * 2048 + k * 1024); } while (0)
#define PG8_MMA(ai, bj, At, Bt) do { __builtin_amdgcn_s_setprio(1); _Pragma("unroll") for (int m = 0; m < 4; ++m) _Pragma("unroll") for (int n = 0; n < 2; ++n) _Pragma("unroll") for (int k = 0; k < 2; ++k) \
        acc[ai][bj][m][n] = __builtin_amdgcn_mfma_f32_16x16x32_bf16(Bt[n][k], At[m][k], acc[ai][bj][m][n], 0, 0, 0); __builtin_amdgcn_s_setprio(0); } while (0)
#define PG8_WAIT_V(n) asm volatile("s_waitcnt vmcnt(" #n ")" ::: "memory")
#define PG8_WAIT_L(n) asm volatile("s_waitcnt lgkmcnt(" #n ")" ::: "memory")
#define PG8_BAR __builtin_amdgcn_s_barrier()
#define PG8_SCHED __builtin_amdgcn_sched_barrier(0)
    Unit cur, nxt; int ui = 0;
    if (!S.next(0, cur)) return;
    f32x4 acc[2][2][4][2];
#pragma unroll
    for (int a = 0; a < 2; ++a)
#pragma unroll
        for (int b = 0; b < 2; ++b)
#pragma unroll
            for (int m = 0; m < 4; ++m)
#pragma unroll
                for (int n = 0; n < 2; ++n) acc[a][b][m][n] = (f32x4){0.f, 0.f, 0.f, 0.f};
    bf16x8 At[4][2], B0[2][2], B1[2][2];
    const char* cA = (const char*)g.A + (size_t)cur.pm * tstep + (size_t)cur.k0 * 2; const char* cB = (const char*)g.Bt + (size_t)cur.pn * tstep + (size_t)cur.k0 * 2;
    S.a_ready(cur);
    if constexpr (SP2) {
        PG8_STAGE(PG8_SB(0, 0), cB, voffB); PG8_STAGE(PG8_SB(0, 1), cB + hstep, voffB); PG8_STAGE(PG8_SA(0, 0), cA, voffA); PG8_STAGE(PG8_SA(0, 1), cA + hstep, voffA);
        if (wr == 1) PG8_BAR;
        PG8_WAIT_V(2); PG8_BAR;
        PG8_STAGE(PG8_SB(1, 0), cB + kstep, voffB); PG8_STAGE(PG8_SA(1, 0), cA + kstep, voffA); PG8_STAGE(PG8_SB(1, 1), cB + hstep + kstep, voffB);
        PG8_WAIT_V(6); PG8_BAR;
    } else {
        PG8_STAGE(PG8_SB(0, 0), cB, voffB); PG8_STAGE(PG8_SA(0, 0), cA, voffA); PG8_STAGE(PG8_SB(0, 1), cB + hstep, voffB); PG8_STAGE(PG8_SA(0, 1), cA + hstep, voffA);
        if (wr == 1) PG8_BAR;
        PG8_WAIT_V(4); PG8_BAR;
        PG8_STAGE(PG8_SB(1, 0), cB + kstep, voffB); PG8_STAGE(PG8_SA(1, 0), cA + kstep, voffA); PG8_STAGE(PG8_SB(1, 1), cB + hstep + kstep, voffB);
        PG8_WAIT_V(6); PG8_BAR;
    }
    for (;;) {
        const bool has_next = S.next(ui + 1, nxt);
        const char* nA = has_next ? (const char*)g.A + (size_t)nxt.pm * tstep + (size_t)nxt.k0 * 2 : cA; const char* nB = has_next ? (const char*)g.Bt + (size_t)nxt.pn * tstep + (size_t)nxt.k0 * 2 : cB;
        const int nt = cur.nt;
        for (int t = 0; t < nt; t += 2) {
            const bool last = (t == nt - 2);
            const char* a1 = cA + (size_t)(t + 1) * kstep;
            const char* a2 = last ? nA : cA + (size_t)(t + 2) * kstep; const char* b2 = last ? nB : cB + (size_t)(t + 2) * kstep;
            const char* a3 = a2 + kstep; const char* b3 = b2 + kstep;
            if (last && has_next) S.a_ready(nxt);
            if constexpr (SP2) {
            PG8_LDB(B0, 0, 0); PG8_LDB(B1, 0, 1); PG8_SCHED; PG8_LDA(At, 0, 0); PG8_STAGE(PG8_SA(1, 1), a1 + hstep, voffA);
            PG8_WAIT_V(8); PG8_WAIT_L(0); PG8_BAR; PG8_MMA(0, 0, At, B0); PG8_MMA(0, 1, At, B1); PG8_BAR; PG8_SCHED;
            PG8_LDA(At, 0, 1); PG8_STAGE(PG8_SB(0, 0), b2, voffB); PG8_STAGE(PG8_SB(0, 1), b2 + hstep, voffB); PG8_STAGE(PG8_SA(0, 0), a2, voffA);
            PG8_WAIT_V(8); PG8_WAIT_L(0); PG8_BAR; PG8_MMA(1, 0, At, B0); PG8_MMA(1, 1, At, B1); PG8_BAR; PG8_SCHED;
            PG8_LDB(B0, 1, 0); PG8_LDB(B1, 1, 1); PG8_SCHED; PG8_LDA(At, 1, 0); PG8_STAGE(PG8_SA(0, 1), a2 + hstep, voffA);
            PG8_WAIT_V(8); PG8_WAIT_L(0); PG8_BAR; PG8_MMA(0, 0, At, B0); PG8_MMA(0, 1, At, B1); PG8_BAR; PG8_SCHED;
            PG8_LDA(At, 1, 1); PG8_STAGE(PG8_SB(1, 0), b3, voffB); PG8_STAGE(PG8_SB(1, 1), b3 + hstep, voffB); PG8_STAGE(PG8_SA(1, 0), a3, voffA);
            PG8_WAIT_V(8); PG8_WAIT_L(0); PG8_BAR; PG8_MMA(1, 0, At, B0); PG8_MMA(1, 1, At, B1); PG8_BAR; PG8_SCHED;
            } else {
            PG8_LDB(B0, 0, 0); PG8_SCHED; PG8_LDA(At, 0, 0); PG8_STAGE(PG8_SA(1, 1), a1 + hstep, voffA);
            PG8_WAIT_L(8); PG8_BAR; PG8_WAIT_L(0); PG8_MMA(0, 0, At, B0); PG8_BAR; PG8_SCHED;
            PG8_LDB(B1, 0, 1); PG8_STAGE(PG8_SB(0, 0), b2, voffB);
            PG8_BAR; PG8_WAIT_L(0); PG8_MMA(0, 1, At, B1); PG8_BAR;
            PG8_LDA(At, 0, 1); PG8_STAGE(PG8_SA(0, 0), a2, voffA);
            PG8_BAR; PG8_WAIT_L(0); PG8_MMA(1, 0, At, B0); PG8_BAR; PG8_SCHED;
            PG8_STAGE(PG8_SB(0, 1), b2 + hstep, voffB);
            PG8_WAIT_V(6); PG8_BAR; PG8_MMA(1, 1, At, B1); PG8_BAR;
            PG8_LDB(B0, 1, 0); PG8_SCHED; PG8_LDA(At, 1, 0); PG8_STAGE(PG8_SA(0, 1), a2 + hstep, voffA);
            PG8_WAIT_L(8); PG8_BAR; PG8_WAIT_L(0); PG8_MMA(0, 0, At, B0); PG8_BAR; PG8_SCHED;
            PG8_LDB(B1, 1, 1); PG8_STAGE(PG8_SB(1, 0), b3, voffB);
            PG8_BAR; PG8_WAIT_L(0); PG8_MMA(0, 1, At, B1); PG8_BAR;
            PG8_LDA(At, 1, 1); PG8_STAGE(PG8_SA(1, 0), a3, voffA);
            PG8_BAR; PG8_WAIT_L(0); PG8_MMA(1, 0, At, B0); PG8_BAR; PG8_SCHED;
            PG8_STAGE(PG8_SB(1, 1), b3 + hstep, voffB);
            PG8_WAIT_V(6); PG8_BAR; PG8_MMA(1, 1, At, B1); PG8_BAR;
            }
        }
        if constexpr (ALIGN_EPI) { if (wr == 0) PG8_BAR; }
        if constexpr (!Epi::AFTER_DRAIN) { E(acc, cur, wr, wc, fr, fq); S.done(cur); }
        if (!has_next) break;
#pragma unroll
        for (int a = 0; a < 2; ++a)
#pragma unroll
            for (int b = 0; b < 2; ++b)
#pragma unroll
                for (int m = 0; m < 4; ++m)
#pragma unroll
                    for (int n = 0; n < 2; ++n) acc[a][b][m][n] = (f32x4){0.f, 0.f, 0.f, 0.f};
        cur = nxt; cA = nA; cB = nB; ++ui;
        if constexpr (ALIGN_EPI) { if (wr == 1) PG8_BAR; }
    }
    PG8_WAIT_V(0);
    if constexpr (!ALIGN_EPI) { if (wr == 0) PG8_BAR; }
    PG8_BAR;
    if constexpr (Epi::AFTER_DRAIN) { E.fused(acc, cur, wr, wc, fr, fq, lds, wid, lane); S.done(cur); }
#undef PG8_SA
#undef PG8_SB
#undef PG8_STAGE
#undef PG8_LDA
#undef PG8_LDB
#undef PG8_MMA
#undef PG8_WAIT_V
#undef PG8_WAIT_L
#undef PG8_BAR
#undef PG8_SCHED
}
}
typedef short bf16x8 __attribute__((ext_vector_type(8)));
constexpr int FR_NWK = 0, FR_QD = 16, FR_KTT = 32, FR_QK = 48, FR_N = 56;
__device__ __forceinline__ int kperm(int g, int j) { return j < 4 ? 4 * g + j : 16 + 4 * g + (j - 4); }

typedef float f32x2_t __attribute__((ext_vector_type(2))); typedef __bf16 bf16x2_t __attribute__((ext_vector_type(2)));
__device__ __forceinline__ unsigned cvtpk_c(float lo, float hi) { const f32x2_t v = {lo, hi}; const bf16x2_t b = __builtin_convertvector(v, bf16x2_t); return __builtin_bit_cast(unsigned, b); }
__device__ __forceinline__ bf16x8 pack8(const f32x4 a, const f32x4 b) {
    return __builtin_bit_cast(bf16x8, (u32x4){cvtpk_c(a[0], a[1]), cvtpk_c(a[2], a[3]), cvtpk_c(b[0], b[1]), cvtpk_c(b[2], b[3])});
}
constexpr int DP_KP = 136;
constexpr int DP_RP = 72;
constexpr int DP_QS = 0, DP_KS = DP_QS + 64 * DP_KP * 2, DP_RHST = DP_KS + 64 * DP_KP * 2, DP_AM = DP_RHST + 256 * DP_RP * 2, DP_AMP = 68,
              DP_QKM = DP_AM + 64 * DP_AMP * 4, DP_QKP = 72, DP_GS = DP_QKM + 64 * DP_QKP * 2, DP_DM = DP_GS + 4 * 64 * 4, DP_DMP = 20,
              DP_TB = DP_DM + 64 * DP_DMP * 4, DP_END = DP_TB + 64 * DP_RP * 2;
static_assert(DP_END <= 131072 && DP_AM % 16 == 0 && DP_DM % 16 == 0 && DP_TB % 16 == 0 && DP_RHST % 16 == 0, "dnprep LDS");
#ifndef DPS
#define DPS(k)
#endif
__device__ __forceinline__ void phase_dnprep(const P& p, LAS unsigned char* lds, unsigned long long& pr_prev, unsigned long long& pr_acc) {
    const int tid_ = otid();
    LAS bf16_t* QS = (LAS bf16_t*)(lds + DP_QS); LAS bf16_t* KS = (LAS bf16_t*)(lds + DP_KS); LAS bf16_t* RHST = (LAS bf16_t*)(lds + DP_RHST);
    LAS float* AM = (LAS float*)(lds + DP_AM); LAS bf16_t* QKM = (LAS bf16_t*)(lds + DP_QKM); LAS float* GS = (LAS float*)(lds + DP_GS);
    LAS float* DM = (LAS float*)(lds + DP_DM); LAS bf16_t* TB = (LAS bf16_t*)(lds + DP_TB);
    const bf16_t* PR = ws_h(p, WS_PROJ); const float* BG = ws_f(p, WS_BG);
    for (int i = tid_; i < 64 * DP_RP / 2; i += NTHR) ((LAS unsigned*)TB)[i] = 0u;
    float pgx = 0.f, pbx = 0.f, cw[3][4][2]; unsigned xr[3][11];
#define DP_FETCH(uid_, ln_, wv_) do { const int n_ = (uid_) % NCHUNK, bh_ = (uid_) / NCHUNK, h_ = bh_ & 3, m0_ = (bh_ >> 2) * SEQ + n_ * 64; \
        if ((wv_) == 0) { pgx = BG[(size_t)(m0_ + (ln_)) * 8 + 4 + h_]; pbx = BG[(size_t)(m0_ + (ln_)) * 8 + h_]; } \
        _Pragma("unroll") for (int part = 0; part < 3; ++part) _Pragma("unroll") for (int j = 0; j < 4; ++j) { const float* w = p.dn_conv_w + j * 1536 + part * 512 + h_ * 128 + 2 * (ln_); cw[part][j][0] = w[0]; cw[part][j][1] = w[1]; } \
        _Pragma("unroll") for (int rr = 0; rr < 11; ++rr) { const int t_ = n_ * 64 + (wv_) * 8 + rr - 3; \
            _Pragma("unroll") for (int part = 0; part < 3; ++part) { unsigned v_ = 0u; if (t_ >= 0) v_ = *(const unsigned*)(PR + (size_t)(m0_ + (wv_) * 8 + rr - 3) * PLD + part * 512 + h_ * 128 + 2 * (ln_)); xr[part][rr] = v_; } } } while (0)
    if ((int)blockIdx.x < NUNIT) { int t0 = tid_; asm volatile("" : "+v"(t0)); DP_FETCH((int)blockIdx.x, t0 & 63, t0 >> 6); }
    for (int uid = blockIdx.x; uid < NUNIT; uid += gridDim.x) {
        const int n = uid % NCHUNK;
        int tid = tid_; asm volatile("" : "+v"(tid));
        const int lane = tid & 63, wave = tid >> 6, r16 = lane & 15, g4 = lane >> 4;
        unsigned char* abu = p.ws + WS_DNF_AB + (size_t)uid * DNF_AB_UNIT;
        float cdv = 0.f;
        if (wave == 0) {
            float x = pgx;
#pragma unroll
            for (int o = 1; o < 64; o <<= 1) { const float t = __shfl_up(x, o); if (lane >= o) x += t; }
            const float gl = __shfl(x, 63);
            GS[lane] = x; GS[64 + lane] = pbx; GS[128 + lane] = __expf(x); GS[192 + lane] = __expf(gl - x);
            cdv = __expf(gl);
        }
        LDS_BARRIER();
        {
            float c[8][3][2], ssum[16];
#pragma unroll
            for (int i = 0; i < 8; ++i) {
#pragma unroll
                for (int part = 0; part < 3; ++part)
#pragma unroll
                    for (int e = 0; e < 2; ++e) { float a = 0.f;
#pragma unroll
                        for (int j = 0; j < 4; ++j) a += cw[part][j][e] * (e == 0 ? __builtin_bit_cast(float, xr[part][i + j] << 16) : __builtin_bit_cast(float, xr[part][i + j] & 0xffff0000u));
                        c[i][part][e] = a * __builtin_amdgcn_rcpf(1.0f + __expf(-a)); }
                ssum[2 * i] = c[i][0][0] * c[i][0][0] + c[i][0][1] * c[i][0][1]; ssum[2 * i + 1] = c[i][1][0] * c[i][1][0] + c[i][1][1] * c[i][1][1]; }
#define DPP_ADD(v_, ctrl_) v_ += __builtin_bit_cast(float, __builtin_amdgcn_update_dpp(0, __builtin_bit_cast(int, v_), ctrl_, 0xf, 0xf, false))
#pragma unroll
            for (int q = 0; q < 16; ++q) { DPP_ADD(ssum[q], 0xB1); DPP_ADD(ssum[q], 0x4E); DPP_ADD(ssum[q], 0x124); DPP_ADD(ssum[q], 0x128); }
#undef DPP_ADD
#pragma unroll
            for (int o = 16; o < 64; o <<= 1) {
#pragma unroll
                for (int q = 0; q < 16; ++q) ssum[q] += __shfl_xor(ssum[q], o); }
            unsigned rv[4][4];
#pragma unroll
            for (int i = 0; i < 8; ++i) { const int row = wave * 8 + i;
                const float rq = 0.08838834764831845f * __builtin_amdgcn_rsqf(ssum[2 * i] + EPS), rk = __builtin_amdgcn_rsqf(ssum[2 * i + 1] + EPS);
                const float beta = GS[64 + row], eg = GS[128 + row];
                const float q0 = c[i][0][0] * rq, q1 = c[i][0][1] * rq, k0 = c[i][1][0] * rk, k1 = c[i][1][1] * rk;
                *(LAS unsigned*)(QS + row * DP_KP + 2 * lane) = cvtpk_c(q0, q1);
                *(LAS unsigned*)(KS + row * DP_KP + 2 * lane) = cvtpk_c(k0, k1);
                const float r0 = beta * c[i][2][0], r1 = beta * c[i][2][1], r2 = beta * eg * k0, r3 = beta * eg * k1;
                if ((i & 1) == 0) { rv[0][i >> 1] = f2bf_bits(r0); rv[1][i >> 1] = f2bf_bits(r1); rv[2][i >> 1] = f2bf_bits(r2); rv[3][i >> 1] = f2bf_bits(r3); }
                else { rv[0][i >> 1] |= f2bf_bits(r0) << 16; rv[1][i >> 1] |= f2bf_bits(r1) << 16; rv[2][i >> 1] |= f2bf_bits(r2) << 16; rv[3][i >> 1] |= f2bf_bits(r3) << 16; } }
#pragma unroll
            for (int cc = 0; cc < 4; ++cc) { const int col = (cc >> 1) * 128 + 2 * lane + (cc & 1);
                *(LAS u32x4*)(RHST + col * DP_RP + wave * 8) = (u32x4){rv[cc][0], rv[cc][1], rv[cc][2], rv[cc][3]}; }
        }
        if (wave == 0 && lane == 0) ws_f(p, WS_DNF_CD)[uid] = cdv;
        if (uid + (int)gridDim.x < NUNIT) DP_FETCH(uid + (int)gridDim.x, lane, wave);
        LDS_BARRIER(); DPS(16);
        {
            const int ti = wave >> 1;
            f32x4 akk[2], aqk[2];
#pragma unroll
            for (int c = 0; c < 2; ++c) { akk[c] = (f32x4){0.f, 0.f, 0.f, 0.f}; aqk[c] = (f32x4){0.f, 0.f, 0.f, 0.f}; }
#pragma unroll
            for (int kb = 0; kb < 4; ++kb) {
                const bf16x8 ak = *(const LAS bf16x8*)(KS + (16 * ti + r16) * DP_KP + 32 * kb + 8 * g4), aq = *(const LAS bf16x8*)(QS + (16 * ti + r16) * DP_KP + 32 * kb + 8 * g4);
#pragma unroll
                for (int c = 0; c < 2; ++c) { const int tj = 2 * (wave & 1) + c; const bf16x8 bk = *(const LAS bf16x8*)(KS + (16 * tj + r16) * DP_KP + 32 * kb + 8 * g4);
                    akk[c] = __builtin_amdgcn_mfma_f32_16x16x32_bf16(ak, bk, akk[c], 0, 0, 0); aqk[c] = __builtin_amdgcn_mfma_f32_16x16x32_bf16(aq, bk, aqk[c], 0, 0, 0); }
            }
#pragma unroll
            for (int c = 0; c < 2; ++c) { const int tj = 2 * (wave & 1) + c, J = 16 * tj + r16; const float gj = GS[J];
#pragma unroll
                for (int i = 0; i < 4; ++i) { const int I = 16 * ti + 4 * g4 + i; const float dec = I >= J ? __expf(GS[I] - gj) : 0.f;
                    AM[I * DP_AMP + J] = I > J ? GS[64 + I] * akk[c][i] * dec : 0.f; QKM[I * DP_QKP + J] = f2bf(aqk[c][i] * dec); } }
        }
        LDS_BARRIER(); DPS(17);
        if (wave == 0) {
            const int bb = g4, cc = r16; float t[16];
            f32x4 tr[16][4];
#pragma unroll
            for (int i = 1; i < 16; ++i)
#pragma unroll
                for (int j4 = 0; j4 < (i + 3) / 4; ++j4) tr[i][j4] = *(const LAS f32x4*)(AM + (16 * bb + i) * DP_AMP + 16 * bb + 4 * j4);
            __builtin_amdgcn_sched_barrier(0);
#pragma unroll
            for (int i = 0; i < 16; ++i) { float acc = (i == cc) ? 1.f : 0.f;
#pragma unroll
                for (int j = 0; j < i; ++j) acc -= tr[i][j >> 2][j & 3] * t[j];
                t[i] = acc; }
#pragma unroll
            for (int i = 0; i < 16; ++i) { DM[(16 * bb + i) * DP_DMP + cc] = t[i]; TB[(16 * bb + i) * DP_RP + 16 * bb + cc] = f2bf(t[i]); }
        } else if (wave >= 4) {
            for (int f = FR_QD + (wave - 4); f < FR_N; f += 4) {
                u32x4 o;
                if (f < FR_KTT) { const int mt = (f - FR_QD) >> 2, kb = (f - FR_QD) & 3, row = 16 * mt + r16; const float sc = GS[128 + row];
                    const u32x2 lo = *(const LAS u32x2*)(QS + row * DP_KP + 32 * kb + 4 * g4), hi = *(const LAS u32x2*)(QS + row * DP_KP + 32 * kb + 16 + 4 * g4);
                    const unsigned w[4] = {lo.x, lo.y, hi.x, hi.y}; unsigned r[4];
#pragma unroll
                    for (int e = 0; e < 4; ++e) r[e] = cvtpk_c(__builtin_bit_cast(float, w[e] << 16) * sc, __builtin_bit_cast(float, w[e] & 0xffff0000u) * sc);
                    o = (u32x4){r[0], r[1], r[2], r[3]};
                } else if (f < FR_QK) { const int kt = (f - FR_KTT) >> 1, tb = (f - FR_KTT) & 1; float v[8];
#pragma unroll
                    for (int j = 0; j < 8; ++j) { const int tok = 32 * tb + kperm(g4, j); v[j] = bf2f(KS[tok * DP_KP + 16 * kt + r16]) * GS[192 + tok]; }
                    o = (u32x4){cvtpk_c(v[0], v[1]), cvtpk_c(v[2], v[3]), cvtpk_c(v[4], v[5]), cvtpk_c(v[6], v[7])};
                } else { const int mt = (f - FR_QK) >> 1, tb = (f - FR_QK) & 1, row = 16 * mt + r16;
                    const u32x2 lo = *(const LAS u32x2*)(QKM + row * DP_QKP + 32 * tb + 4 * g4), hi = *(const LAS u32x2*)(QKM + row * DP_QKP + 32 * tb + 16 + 4 * g4);
                    o = (u32x4){lo.x, lo.y, hi.x, hi.y}; }
                *(u32x4*)(abu + (size_t)f * 1024 + lane * 16) = o;
            }
        }
        LDS_BARRIER(); DPS(18);
        if (wave < 3) {
            const int j = wave; f32x4 Tk[4];
#pragma unroll
            for (int kk = 0; kk < 4; ++kk) Tk[j][kk] = DM[(16 * j + 4 * g4 + kk) * DP_DMP + r16];
#pragma unroll
            for (int i = 1; i < 4; ++i) if (i > j) {
                f32x4 acc = (f32x4){0.f, 0.f, 0.f, 0.f};
#pragma unroll
                for (int k = 0; k < 3; ++k) if (k >= j && k < i) { const f32x4 a = *(const LAS f32x4*)(AM + (16 * i + r16) * DP_AMP + 16 * k + 4 * g4);
#pragma unroll
                    for (int kk = 0; kk < 4; ++kk) acc = __builtin_amdgcn_mfma_f32_16x16x4f32(a[kk], Tk[k][kk], acc, 0, 0, 0); }
                const f32x4 dd = *(const LAS f32x4*)(DM + (16 * i + r16) * DP_DMP + 4 * g4);
                f32x4 res = (f32x4){0.f, 0.f, 0.f, 0.f};
#pragma unroll
                for (int kk = 0; kk < 4; ++kk) res = __builtin_amdgcn_mfma_f32_16x16x4f32(dd[kk], acc[kk], res, 0, 0, 0);
                Tk[i] = -res;
#pragma unroll
                for (int e = 0; e < 4; ++e) TB[(16 * i + 4 * g4 + e) * DP_RP + 16 * j + r16] = f2bf(Tk[i][e]); }
        }
        LDS_BARRIER(); DPS(19);
        {
            const int mt = wave & 3, half = wave >> 2;
            bf16x8 tf[2];
#pragma unroll
            for (int kb = 0; kb < 2; ++kb) tf[kb] = *(const LAS bf16x8*)(TB + (16 * mt + r16) * DP_RP + 32 * kb + 8 * g4);
            if (half == 0) {
                float* wv = (float*)(p.ws + WS_DNF_WV + (size_t)uid * DNF_WV_UNIT) + (size_t)mt * 256 + lane * 4;
#pragma unroll
                for (int vt = 0; vt < 8; ++vt) { f32x4 acc = (f32x4){0.f, 0.f, 0.f, 0.f};
#pragma unroll
                    for (int kb = 0; kb < 2; ++kb) acc = __builtin_amdgcn_mfma_f32_16x16x32_bf16(tf[kb], *(const LAS bf16x8*)(RHST + (16 * vt + r16) * DP_RP + 32 * kb + 8 * g4), acc, 0, 0, 0);
                    *(f32x4*)(wv + (size_t)vt * 1024) = acc; }
            } else {
#pragma unroll
                for (int kbp = 0; kbp < 4; ++kbp) { f32x4 xt[2];
#pragma unroll
                    for (int c2 = 0; c2 < 2; ++c2) { xt[c2] = (f32x4){0.f, 0.f, 0.f, 0.f};
#pragma unroll
                        for (int kb = 0; kb < 2; ++kb) xt[c2] = __builtin_amdgcn_mfma_f32_16x16x32_bf16(*(const LAS bf16x8*)(RHST + (128 + 16 * (2 * kbp + c2) + r16) * DP_RP + 32 * kb + 8 * g4), tf[kb], xt[c2], 0, 0, 0); }
                    *(u32x4*)(abu + (size_t)(FR_NWK + mt * 4 + kbp) * 1024 + lane * 16) = __builtin_bit_cast(u32x4, pack8(-xt[0], -xt[1])); }
            }
        }
        LDS_BARRIER(); DPS(20);
    }
#undef DP_FETCH
}

constexpr size_t O_ODN = O_Y;
#define DN_SB() __builtin_amdgcn_sched_barrier(0)
__device__ __forceinline__ void dn_consume(const LAS unsigned char* fb, int wl, f32x4 (&S)[8], float cd, bf16_t* op) {
    f32x4 u[4], o[4];
    bf16x8 fa[16], fq[16], Sb[4], Ub[2];
#pragma unroll
    for (int mt = 0; mt < 4; ++mt) u[mt] = *(const LAS f32x4*)(fb + (FR_N + wl * 4 + mt) * 1024);
#pragma unroll
    for (int f = 0; f < 16; ++f) fa[f] = *(const LAS bf16x8*)(fb + (FR_NWK + f) * 1024);
#pragma unroll
    for (int f = 0; f < 8; ++f) fq[f] = *(const LAS bf16x8*)(fb + (FR_QD + f) * 1024);
    DN_SB();
#pragma unroll
    for (int kb = 0; kb < 4; ++kb) Sb[kb] = pack8(S[2 * kb], S[2 * kb + 1]);
#pragma unroll
    for (int mt = 0; mt < 4; ++mt)
#pragma unroll
        for (int kb = 0; kb < 4; ++kb) u[mt] = __builtin_amdgcn_mfma_f32_16x16x32_bf16(fa[mt * 4 + kb], Sb[kb], u[mt], 0, 0, 0);
    DN_SB();
#pragma unroll
    for (int f = 8; f < 16; ++f) fq[f] = *(const LAS bf16x8*)(fb + (FR_QD + f) * 1024);
#pragma unroll
    for (int f = 0; f < 8; ++f) fa[f] = *(const LAS bf16x8*)(fb + (FR_KTT + f) * 1024);
    DN_SB();
#pragma unroll
    for (int mt = 0; mt < 4; ++mt) { o[mt] = (f32x4){0.f, 0.f, 0.f, 0.f};
#pragma unroll
        for (int kb = 0; kb < 4; ++kb) o[mt] = __builtin_amdgcn_mfma_f32_16x16x32_bf16(fq[mt * 4 + kb], Sb[kb], o[mt], 0, 0, 0); }
    DN_SB();
#pragma unroll
    for (int f = 8; f < 16; ++f) fa[f] = *(const LAS bf16x8*)(fb + (FR_KTT + f) * 1024);
#pragma unroll
    for (int f = 0; f < 8; ++f) fq[f] = *(const LAS bf16x8*)(fb + (FR_QK + f) * 1024);
#pragma unroll
    for (int tb = 0; tb < 2; ++tb) Ub[tb] = pack8(u[2 * tb], u[2 * tb + 1]);
#pragma unroll
    for (int kt = 0; kt < 8; ++kt) S[kt] = S[kt] * cd;
    DN_SB();
#pragma unroll
    for (int kt = 0; kt < 8; ++kt)
#pragma unroll
        for (int tb = 0; tb < 2; ++tb) S[kt] = __builtin_amdgcn_mfma_f32_16x16x32_bf16(fa[kt * 2 + tb], Ub[tb], S[kt], 0, 0, 0);
#pragma unroll
    for (int mt = 0; mt < 4; ++mt) {
#pragma unroll
        for (int tb = 0; tb < 2; ++tb) o[mt] = __builtin_amdgcn_mfma_f32_16x16x32_bf16(fq[mt * 2 + tb], Ub[tb], o[mt], 0, 0, 0);
        { const int e_ = (int)(__builtin_amdgcn_mbcnt_hi(~0u, __builtin_amdgcn_mbcnt_lo(~0u, 0u)) & 1u);
#pragma unroll
          for (int j = 0; j < 2; ++j) { const float a0 = o[mt][2 * j], a1 = o[mt][2 * j + 1];
              const float n0 = __builtin_bit_cast(float, __builtin_amdgcn_update_dpp(0, __builtin_bit_cast(int, a0), 0xB1, 0xf, 0xf, false)), n1 = __builtin_bit_cast(float, __builtin_amdgcn_update_dpp(0, __builtin_bit_cast(int, a1), 0xB1, 0xf, 0xf, false));
              const unsigned w = e_ ? cvtpk_c(n1, a1) : cvtpk_c(a0, n0);
              *(unsigned*)(op + (size_t)(16 * mt + 2 * j + e_) * 512) = w; } } }
}
constexpr int DN_SBUF = 73728;
__device__ __forceinline__ void phase_dnscan(const P& p, LAS unsigned char* lds) {
    if (blockIdx.x >= BATCH * 4 * 2) return;
    const int tid = otid(), lane = tid & 63, wave = __builtin_amdgcn_readfirstlane(tid >> 6), r16 = lane & 15, g4 = lane >> 4;
    const int bh = blockIdx.x >> 1, vh = blockIdx.x & 1, h = bh & 3, b = bh >> 2, wl = wave & 3, vs = vh * 4 + wl, v0 = vs * 16;
    const float* cdp = ws_f(p, WS_DNF_CD) + (size_t)bh * NCHUNK;
    bf16_t* odn = (bf16_t*)(p.out + O_ODN);
#define DN_BAR() do { asm volatile("s_waitcnt lgkmcnt(0)" ::: "memory"); __builtin_amdgcn_s_barrier(); asm volatile("" ::: "memory"); } while (0)
    if (wave >= 4) {
        const unsigned char* ab = p.ws + WS_DNF_AB + (size_t)bh * NCHUNK * DNF_AB_UNIT + lane * 16;
        const unsigned char* wvb = p.ws + WS_DNF_WV + (size_t)bh * NCHUNK * DNF_WV_UNIT + (size_t)vh * 16 * 1024 + lane * 16;
        u32x4 R[3][18];
#define DN_SRC(n_, q_) ((q_) < FR_N ? ab + (size_t)(n_) * DNF_AB_UNIT + (q_) * 1024 : wvb + (size_t)(n_) * DNF_WV_UNIT + ((q_) - FR_N) * 1024)
#define DN_LD(n_, s_) do { if ((n_) < NCHUNK) { _Pragma("unroll") for (int i_ = 0; i_ < 18; ++i_) R[s_][i_] = *(const u32x4*)DN_SRC(n_, wl * 18 + i_); } } while (0)
#define DN_ST(n_, s_) do { if ((n_) < NCHUNK) { LAS unsigned char* d_ = lds + ((n_) & 1) * DN_SBUF + wl * 18 * 1024 + lane * 16; _Pragma("unroll") for (int i_ = 0; i_ < 18; ++i_) *(LAS u32x4*)(d_ + i_ * 1024) = R[s_][i_]; } } while (0)
        DN_LD(0, 0); DN_LD(1, 1); DN_LD(2, 2); DN_ST(0, 0);
        DN_BAR();
#define DN_LSTEP(n_, s_) do { const int n = (n_); if (n < NCHUNK) { DN_LD(n + 3, s_); DN_ST(n + 1, ((s_) + 1) % 3); DN_BAR(); } } while (0)
        for (int n3 = 0; n3 < NCHUNK; n3 += 3) { DN_LSTEP(n3, 0); DN_LSTEP(n3 + 1, 1); DN_LSTEP(n3 + 2, 2); }
#undef DN_LSTEP
#undef DN_LD
#undef DN_ST
#undef DN_SRC
        return;
    }
    f32x4 S[8];
#pragma unroll
    for (int t = 0; t < 8; ++t) S[t] = (f32x4){0.f, 0.f, 0.f, 0.f};
    float cd = cdp[0];
    DN_BAR();
    for (int n = 0; n < NCHUNK; ++n) {
        const float cdn = cdp[n + 1 < NCHUNK ? n + 1 : n];
        dn_consume(lds + (n & 1) * DN_SBUF + lane * 16, wl, S, cd, odn + (size_t)(b * SEQ + n * 64 + 4 * g4) * 512 + h * 128 + v0 + (r16 & ~1));
        cd = cdn;
        DN_BAR();
    }
#undef DN_BAR
    {
        float* so = p.out + O_PSSM + (size_t)bh * 128 * 128 + v0 + r16;
#pragma unroll
        for (int kt = 0; kt < 8; ++kt)
#pragma unroll
            for (int i = 0; i < 4; ++i) so[(size_t)(16 * kt + 4 * g4 + i) * 128] = S[kt][i];
    }
}
__device__ __forceinline__ void phase_dngate(const P& p) {
    const int tid_ = otid(), lane = tid_ & 63, wave = tid_ >> 6;
    const int gw = blockIdx.x * NWAVES + wave, NGW = gridDim.x * NWAVES;
    const f32x4 nw0 = *(const f32x4*)(p.dn_norm_w + (lane & 15) * 8), nw1 = *(const f32x4*)(p.dn_norm_w + (lane & 15) * 8 + 4);
    u32x4 oq; u32x4 z;
#define DG_LOAD(m_) do { oq = *(const u32x4*)((const bf16_t*)(p.out + O_ODN) + (size_t)(m_) * 512 + lane * 8); z = *(const u32x4*)(ws_h(p, WS_PROJ) + (size_t)(m_) * PLD + PC_Z + lane * 8); } while (0)
    if (gw < TP) DG_LOAD(gw);
    for (int m = gw; m < TP; m += NGW) {
        const u32x4 q0 = oq; const u32x4 z0 = z;
        const f32x4 a0 = (f32x4){__builtin_bit_cast(float, q0.x << 16), __builtin_bit_cast(float, q0.x & 0xffff0000u), __builtin_bit_cast(float, q0.y << 16), __builtin_bit_cast(float, q0.y & 0xffff0000u)}, c0 = (f32x4){__builtin_bit_cast(float, q0.z << 16), __builtin_bit_cast(float, q0.z & 0xffff0000u), __builtin_bit_cast(float, q0.w << 16), __builtin_bit_cast(float, q0.w & 0xffff0000u)};
        if (m + NGW < TP) DG_LOAD(m + NGW);
        float ss = (a0[0] * a0[0] + a0[1] * a0[1]) + (a0[2] * a0[2] + a0[3] * a0[3]) + (c0[0] * c0[0] + c0[1] * c0[1]) + (c0[2] * c0[2] + c0[3] * c0[3]);
        ss = row16_sum(ss);
        const float rstd = __builtin_amdgcn_rsqf(ss * (1.0f / 128.0f) + EPS);
        const unsigned zw[4] = {z0.x, z0.y, z0.z, z0.w}; const float ov[8] = {a0[0], a0[1], a0[2], a0[3], c0[0], c0[1], c0[2], c0[3]}; const float nwv[8] = {nw0[0], nw0[1], nw0[2], nw0[3], nw1[0], nw1[1], nw1[2], nw1[3]};
        unsigned r[4];
#pragma unroll
        for (int e = 0; e < 4; ++e) { const float z0f = __builtin_bit_cast(float, zw[e] << 16), z1f = __builtin_bit_cast(float, zw[e] & 0xffff0000u);
            r[e] = pk2(ov[2 * e] * rstd * nwv[2 * e] * silu_fast(z0f), ov[2 * e + 1] * rstd * nwv[2 * e + 1] * silu_fast(z1f)); }
        *(u32x4*)(ws_h(p, WS_MIX) + (size_t)m * 1024 + lane * 8) = (u32x4){r[0], r[1], r[2], r[3]};
    }
#undef DG_LOAD
}
__device__ __forceinline__ void phase_dnsample(const P& p, LAS unsigned char* lds, unsigned long long& pr_prev, unsigned long long& pr_acc) {
    const int tid = otid(), lane = tid & 63, us = tid >> 8, w4 = (tid >> 6) & 3, kh = lane >> 5, col_ = w4 * 32 + (lane & 31);
    LAS float* QH = (LAS float*)lds + us * 4352;
    LAS float* KH = QH + 1024; LAS float* VH = QH + 2048; LAS float* OH = QH + 3072; LAS float* RED = QH + 4096;
    const bf16_t* PR = ws_h(p, WS_PROJ); const float* BG = ws_f(p, WS_BG);
    for (int ub = blockIdx.x; ub < DEC_BATCH * 2; ub += gridDim.x) {
        const int uidx = ub * 2 + us, b = uidx >> 2, h = uidx & 3, m0 = TP + b * DEC_SEQ;
        int col = col_; asm volatile("" : "+v"(col));
        float S[64];
        {
            float x0[11], x1[11];
            const int ch0 = kh * 512 + h * 128 + col;
#pragma unroll
            for (int rr = 0; rr < 11; ++rr) {
                if (rr < 3) { const float* st = p.state_dn_conv + ((size_t)b * 3 + rr) * 1536; x0[rr] = st[ch0]; x1[rr] = st[1024 + h * 128 + col]; }
                else { const bf16_t* pr = PR + (size_t)(m0 + rr - 3) * PLD; x0[rr] = bf2f(pr[ch0]); x1[rr] = bf2f(pr[1024 + h * 128 + col]); } }
            float w0[4], w1[4];
#pragma unroll
            for (int j = 0; j < 4; ++j) { w0[j] = p.dn_conv_w[j * 1536 + ch0]; w1[j] = p.dn_conv_w[j * 1536 + 1024 + h * 128 + col]; }
            { const float* S0 = p.state_dn_ssm + ((size_t)b * 4 + h) * 128 * 128 + (size_t)kh * 64 * 128 + col;
#pragma unroll
              for (int k = 0; k < 64; ++k) { S[k] = *S0; S0 += 128; if ((k & 7) == 7) asm volatile("" : "+v"(S0)); } }
            float ssq[8], ssk[8];
#pragma unroll
            for (int t = 0; t < 8; ++t) { float a = 0.f, d = 0.f;
#pragma unroll
                for (int j = 0; j < 4; ++j) { a += w0[j] * x0[t + j]; d += w1[j] * x1[t + j]; }
                a = a * __builtin_amdgcn_rcpf(1.0f + __expf(-a)); d = d * __builtin_amdgcn_rcpf(1.0f + __expf(-d));
                if (kh == 0) { QH[t * 128 + col] = a; VH[t * 128 + col] = d; } else KH[t * 128 + col] = a;
                ssq[t] = kh == 0 ? a * a : 0.f; ssk[t] = kh == 1 ? a * a : 0.f; }
#pragma unroll
            for (int t = 0; t < 8; ++t) { ssq[t] = row16_sum(ssq[t]); ssk[t] = row16_sum(ssk[t]); }
#pragma unroll
            for (int o = 16; o < 64; o <<= 1) {
#pragma unroll
                for (int t = 0; t < 8; ++t) { ssq[t] += __shfl_xor(ssq[t], o); ssk[t] += __shfl_xor(ssk[t], o); } }
            if (lane == 0) {
#pragma unroll
                for (int t = 0; t < 8; ++t) { RED[w4 * 16 + t] = ssq[t]; RED[w4 * 16 + 8 + t] = ssk[t]; } }
        }
        LDS_BARRIER(); DPS(27);
#pragma unroll
        for (int t = 0; t < 8; ++t) {
            if (kh == 0) { const float sq = (RED[t] + RED[16 + t]) + (RED[32 + t] + RED[48 + t]); QH[t * 128 + col] *= 0.08838834764831845f * __builtin_amdgcn_rsqf(sq + EPS); }
            else { const float sk = (RED[8 + t] + RED[24 + t]) + (RED[40 + t] + RED[56 + t]); KH[t * 128 + col] *= __builtin_amdgcn_rsqf(sk + EPS); } }
        if ((tid & 255) < 8) { const int t = tid & 255; RED[64 + t] = BG[(size_t)(m0 + t) * 8 + h]; RED[72 + t] = __expf(BG[(size_t)(m0 + t) * 8 + 4 + h]); }
        LDS_BARRIER(); DPS(28);
#pragma unroll 1
        for (int t = 0; t < 8; ++t) {
            const float beta = RED[64 + t], eg = RED[72 + t];
            const LAS float* kp = KH + t * 128 + kh * 64; const LAS float* qp = QH + t * 128 + kh * 64;
            f32x4 kk[16], qq[16];
#pragma unroll
            for (int k4 = 0; k4 < 16; ++k4) kk[k4] = *(const LAS f32x4*)(kp + 4 * k4);
#pragma unroll
            for (int k4 = 0; k4 < 16; ++k4) qq[k4] = *(const LAS f32x4*)(qp + 4 * k4);
            const float vt = VH[t * 128 + col];
            __builtin_amdgcn_sched_barrier(0);
            float ks4[2] = {0.f, 0.f};
#pragma unroll
            for (int k4 = 0; k4 < 16; ++k4)
#pragma unroll
                for (int e = 0; e < 4; ++e) { S[4 * k4 + e] *= eg; ks4[e & 1] += kk[k4][e] * S[4 * k4 + e]; }
            float kS = ks4[0] + ks4[1];
            kS += __shfl_xor(kS, 32);
            const float u = beta * (vt - kS);
            float o4[2] = {0.f, 0.f};
#pragma unroll
            for (int k4 = 0; k4 < 16; ++k4)
#pragma unroll
                for (int e = 0; e < 4; ++e) { S[4 * k4 + e] += kk[k4][e] * u; o4[e & 1] += qq[k4][e] * S[4 * k4 + e]; }
            float o = o4[0] + o4[1];
            o += __shfl_xor(o, 32);
            if (kh == 0) OH[t * 128 + col] = o;
            __builtin_amdgcn_sched_barrier(0);
        }
        float zv[8];
#pragma unroll
        for (int t = 0; t < 8; ++t) zv[t] = bf2f(PR[(size_t)(m0 + t) * PLD + PC_Z + h * 128 + col]);
        const float nwz = p.dn_norm_w[col];
        float* So = p.out + O_SSSM + ((size_t)b * 4 + h) * 128 * 128 + (size_t)kh * 64 * 128 + col;
#pragma unroll
        for (int k = 0; k < 64; ++k) { *So = S[k]; So += 128; if ((k & 7) == 7) asm volatile("" : "+v"(So)); }
        LDS_BARRIER(); DPS(29);
#pragma unroll
        for (int t = 0; t < 8; ++t) { const float o = kh == 0 ? OH[t * 128 + col] : 0.f; const float s = wave_sum(o * o); if (lane == 0) RED[w4 * 16 + t] = s; }
        LDS_BARRIER();
        if (kh == 0) {
            const float nw = nwz;
#pragma unroll
            for (int t = 0; t < 8; ++t) { const float rstd = __builtin_amdgcn_rsqf(((RED[t] + RED[16 + t]) + (RED[32 + t] + RED[48 + t])) * (1.0f / 128.0f) + EPS);
                const float z = zv[t];
                ws_h(p, WS_MIX)[(size_t)(m0 + t) * 1024 + h * 128 + col] = f2bf(OH[t * 128 + col] * rstd * nw * silu_fast(z)); }
        }
        LDS_BARRIER(); DPS(30);
    }
}
constexpr int NSEG = 16, CSEG = NCHUNK / NSEG, NBH = BATCH * 4;
static_assert(NCHUNK % NSEG == 0, "segments");
constexpr size_t O_RFRAG = O_ODN + (size_t)TP * 512;
constexpr size_t O_BSEG = O_RFRAG + (size_t)NBH * NSEG * 8192;
constexpr size_t O_SSEG = O_BSEG + (size_t)NBH * NSEG * 16384;
constexpr size_t O_SEGEND = O_SSEG + (size_t)NBH * NSEG * 16384;
constexpr size_t WS_CPROD = WS_CTL + 49152;
static_assert(O_SEGEND <= O_SLAB_OUT && NBH * NSEG * 4 <= 16384, "segment scratch fits in the y region of d_out below the out-proj slabs");

template <bool HASWV> __device__ __forceinline__ void dn_consume_map(const LAS unsigned char* fb, int wl, f32x4 (&X)[8], float cd) {
    f32x4 u[4]; bf16x8 f0[8], f1[8], Xb[4], Ub[2];
#pragma unroll
    for (int mt = 0; mt < 4; ++mt) u[mt] = HASWV ? *(const LAS f32x4*)(fb + (FR_N + wl * 4 + mt) * 1024) : (f32x4){0.f, 0.f, 0.f, 0.f};
#pragma unroll
    for (int f = 0; f < 8; ++f) f0[f] = *(const LAS bf16x8*)(fb + (FR_NWK + f) * 1024);
#pragma unroll
    for (int f = 0; f < 8; ++f) f1[f] = *(const LAS bf16x8*)(fb + (FR_NWK + 8 + f) * 1024);
    DN_SB();
#pragma unroll
    for (int kb = 0; kb < 4; ++kb) Xb[kb] = pack8(X[2 * kb], X[2 * kb + 1]);
#pragma unroll
    for (int mt = 0; mt < 2; ++mt)
#pragma unroll
        for (int kb = 0; kb < 4; ++kb) u[mt] = __builtin_amdgcn_mfma_f32_16x16x32_bf16(f0[mt * 4 + kb], Xb[kb], u[mt], 0, 0, 0);
    DN_SB();
#pragma unroll
    for (int f = 0; f < 8; ++f) f0[f] = *(const LAS bf16x8*)(fb + (FR_KTT + f) * 1024);
    DN_SB();
#pragma unroll
    for (int mt = 2; mt < 4; ++mt)
#pragma unroll
        for (int kb = 0; kb < 4; ++kb) u[mt] = __builtin_amdgcn_mfma_f32_16x16x32_bf16(f1[(mt - 2) * 4 + kb], Xb[kb], u[mt], 0, 0, 0);
    DN_SB();
#pragma unroll
    for (int f = 0; f < 8; ++f) f1[f] = *(const LAS bf16x8*)(fb + (FR_KTT + 8 + f) * 1024);
#pragma unroll
    for (int tb = 0; tb < 2; ++tb) Ub[tb] = pack8(u[2 * tb], u[2 * tb + 1]);
#pragma unroll
    for (int kt = 0; kt < 8; ++kt) X[kt] = X[kt] * cd;
    DN_SB();
#pragma unroll
    for (int kt = 0; kt < 4; ++kt)
#pragma unroll
        for (int tb = 0; tb < 2; ++tb) X[kt] = __builtin_amdgcn_mfma_f32_16x16x32_bf16(f0[kt * 2 + tb], Ub[tb], X[kt], 0, 0, 0);
#pragma unroll
    for (int kt = 4; kt < 8; ++kt)
#pragma unroll
        for (int tb = 0; tb < 2; ++tb) X[kt] = __builtin_amdgcn_mfma_f32_16x16x32_bf16(f1[(kt - 4) * 2 + tb], Ub[tb], X[kt], 0, 0, 0);
}
#define DNS_BAR() do { asm volatile("s_waitcnt lgkmcnt(0)" ::: "memory"); __builtin_amdgcn_s_barrier(); asm volatile("" ::: "memory"); } while (0)
template <int MODE, int nsteps> __device__ __forceinline__ void dns_loader(const P& p, LAS unsigned char* lds, int bh, int n0, int vh, int wl, int lane) {
    constexpr int NPW = MODE == 2 ? 18 : (MODE == 1 ? 12 : 8);
    const unsigned char* ab = p.ws + WS_DNF_AB + ((size_t)bh * NCHUNK + n0) * DNF_AB_UNIT + lane * 16;
    const unsigned char* wvb = p.ws + WS_DNF_WV + ((size_t)bh * NCHUNK + n0) * DNF_WV_UNIT + (size_t)vh * 16 * 1024 + lane * 16;
    u32x4 R[2][NPW];
#define DNS_FRAG(q_) (MODE == 2 ? (q_) : ((q_) < 16 ? (q_) : ((q_) < 32 ? FR_KTT + (q_) - 16 : FR_N + (q_) - 32)))
#define DNS_SRC(n_, q_) (DNS_FRAG(q_) < FR_N ? ab + (size_t)(n_) * DNF_AB_UNIT + DNS_FRAG(q_) * 1024 : wvb + (size_t)(n_) * DNF_WV_UNIT + (DNS_FRAG(q_) - FR_N) * 1024)
#define DNS_LD(n_, s_) do { if ((n_) < nsteps) { _Pragma("unroll") for (int i_ = 0; i_ < NPW; ++i_) R[s_][i_] = *(const u32x4*)DNS_SRC(n_, wl * NPW + i_); } } while (0)
#define DNS_ST(n_, s_) do { if ((n_) < nsteps) { LAS unsigned char* d_ = lds + ((n_) & 1) * DN_SBUF + lane * 16; _Pragma("unroll") for (int i_ = 0; i_ < NPW; ++i_) *(LAS u32x4*)(d_ + DNS_FRAG(wl * NPW + i_) * 1024) = R[s_][i_]; } } while (0)
    DNS_LD(0, 0); DNS_LD(1, 1); DNS_ST(0, 0);
    DNS_BAR();
#define DNS_LSTEP(n_, s_) do { const int n = (n_); if (n < nsteps) { DNS_LD(n + 2, s_); DNS_ST(n + 1, (s_) ^ 1); DNS_BAR(); } } while (0)
#pragma unroll
    for (int n2 = 0; n2 < nsteps; n2 += 2) { DNS_LSTEP(n2, 0); DNS_LSTEP(n2 + 1, 1); }
#undef DNS_LSTEP
#undef DNS_LD
#undef DNS_ST
#undef DNS_SRC
#undef DNS_FRAG
}
constexpr int PA_RTP = 72;
template <int MODE> __device__ __forceinline__ void dns_passA_task(const P& p, LAS unsigned char* lds, int bh, int seg, int q, int wave, int lane) {
    const int r16 = lane & 15, g4 = lane >> 4, wl = wave & 3, n0 = seg * CSEG;
    const float* cdp = ws_f(p, WS_DNF_CD) + (size_t)bh * NCHUNK + n0;
    LAS bf16_t* RT = (LAS bf16_t*)lds;
    if (wave >= 4) { dns_loader<MODE, CSEG>(p, lds, bh, n0, q & 1, wl, lane); }
    else {
        f32x4 X[8];
#pragma unroll
        for (int kt = 0; kt < 8; ++kt)
#pragma unroll
            for (int i = 0; i < 4; ++i) X[kt][i] = (MODE == 0 && 16 * kt + 4 * g4 + i == 64 * q + 16 * wl + r16) ? 1.f : 0.f;
        float cd = cdp[0], cprod = 1.f;
        DNS_BAR();
        for (int n = 0; n < CSEG; ++n) {
            const float cdn = cdp[n + 1 < CSEG ? n + 1 : n];
            dn_consume_map<MODE == 1>(lds + (n & 1) * DN_SBUF + lane * 16, wl, X, cd);
            cprod *= cd; cd = cdn;
            DNS_BAR();
        }
        if (MODE == 0) {
#pragma unroll
            for (int kt = 0; kt < 8; ++kt)
#pragma unroll
                for (int i = 0; i < 4; ++i) { const int row = 16 * kt + 4 * g4 + i, col = 16 * wl + r16; const float v = X[kt][i] - ((row == 64 * q + col) ? cprod : 0.f);
                    RT[row * PA_RTP + col] = f2bf(v); }
            if (q == 0 && wave == 0 && lane == 0) ws_f(p, WS_CPROD)[bh * NSEG + seg] = cprod;
        } else {
            float* bo = p.out + O_BSEG + ((size_t)(bh * NSEG + seg) * 8 + (4 * (q & 1) + wl)) * 2048 + lane * 4;
#pragma unroll
            for (int kt = 0; kt < 8; ++kt) *(f32x4*)(bo + kt * 256) = X[kt];
        }
    }
    DNS_BAR();
    if (MODE == 0) {
#pragma unroll
        for (int j = 0; j < 2; ++j) { const int f = wave * 2 + j, mt = f >> 1, kbl = f & 1, row = 16 * mt + r16;
            const u32x2 lo = *(const LAS u32x2*)(RT + row * PA_RTP + 32 * kbl + 4 * g4), hi = *(const LAS u32x2*)(RT + row * PA_RTP + 32 * kbl + 16 + 4 * g4);
            *(u32x4*)((unsigned char*)(p.out + O_RFRAG) + ((size_t)(bh * NSEG + seg) * 32 + mt * 4 + 2 * q + kbl) * 1024 + lane * 16) = (u32x4){lo.x, lo.y, hi.x, hi.y}; }
        DNS_BAR();
    }
}
__device__ __forceinline__ void phase_dns_passA(const P& p, LAS unsigned char* lds) {
    const int tid = otid(), lane = tid & 63, wave = __builtin_amdgcn_readfirstlane(tid >> 6);
    const int vb = (gridDim.x % 8 == 0) ? (int)((blockIdx.x % 8) * (gridDim.x / 8) + blockIdx.x / 8) : (int)blockIdx.x;
    for (int t = vb; t < NBH * NSEG * 4; t += gridDim.x) {
        const int q = t & 3, seg = (t >> 2) % NSEG, bh = t / (4 * NSEG);
        if (q < 2) dns_passA_task<0>(p, lds, bh, seg, q, wave, lane); else dns_passA_task<1>(p, lds, bh, seg, q, wave, lane);
    }
}
__device__ __forceinline__ void phase_dns_passB(const P& p, LAS unsigned char* lds) {
    if ((int)blockIdx.x >= NBH * 8) return;
    const int tid = otid(), lane = tid & 63, w = __builtin_amdgcn_readfirstlane(tid >> 6), r16 = lane & 15, g4 = lane >> 4;
    const int bh = blockIdx.x & 7, vs = blockIdx.x >> 3;
    LAS u32x2* XB = (LAS u32x2*)lds;
    const unsigned char* rf0 = (const unsigned char*)(p.out + O_RFRAG) + ((size_t)bh * NSEG * 32 + w * 4) * 1024 + lane * 16;
    const float* bt0 = p.out + O_BSEG + ((size_t)bh * NSEG * 8 + vs) * 2048 + w * 256 + lane * 4;
    float* ss0 = p.out + O_SSEG + ((size_t)bh * NSEG * 8 + vs) * 2048 + w * 256 + lane * 4;
    const float* cp0 = ws_f(p, WS_CPROD) + bh * NSEG;
    u32x4 rf[4][4]; f32x4 bt[4]; float cp[4];
#define PB_LD(s_, r_) do { if ((s_) < NSEG) { _Pragma("unroll") for (int kb = 0; kb < 4; ++kb) rf[r_][kb] = *(const u32x4*)(rf0 + (size_t)(s_) * 32768 + kb * 1024); bt[r_] = *(const f32x4*)(bt0 + (size_t)(s_) * 16384); cp[r_] = cp0[(s_)]; } } while (0)
    PB_LD(0, 0); PB_LD(1, 1); PB_LD(2, 2);
    f32x4 S = (f32x4){0.f, 0.f, 0.f, 0.f};
#pragma unroll
    for (int s = 0; s < NSEG; ++s) {
        PB_LD(s + 3, (s + 3) & 3);
        *(f32x4*)(ss0 + (size_t)s * 16384) = S;
        XB[((s & 1) * 8 + w) * 64 + lane] = (u32x2){cvtpk_c(S[0], S[1]), cvtpk_c(S[2], S[3])};
        DNS_BAR();
        f32x4 acc = S * cp[s & 3] + bt[s & 3];
#pragma unroll
        for (int kb = 0; kb < 4; ++kb) { const u32x2 lo = XB[((s & 1) * 8 + 2 * kb) * 64 + lane], hi = XB[((s & 1) * 8 + 2 * kb + 1) * 64 + lane];
            acc = __builtin_amdgcn_mfma_f32_16x16x32_bf16(__builtin_bit_cast(bf16x8, rf[s & 3][kb]), __builtin_bit_cast(bf16x8, (u32x4){lo.x, lo.y, hi.x, hi.y}), acc, 0, 0, 0); }
        S = acc;
    }
#undef PB_LD
    float* so = p.out + O_PSSM + (size_t)bh * 128 * 128 + vs * 16 + r16;
#pragma unroll
    for (int i = 0; i < 4; ++i) so[(size_t)(16 * w + 4 * g4 + i) * 128] = S[i];
    DNS_BAR();
}
__device__ __forceinline__ void phase_dns_passC(const P& p, LAS unsigned char* lds) {
    const int tid = otid(), lane = tid & 63, wave = __builtin_amdgcn_readfirstlane(tid >> 6), r16 = lane & 15, g4 = lane >> 4, wl = wave & 3;
    const int vb = (gridDim.x % 8 == 0) ? (int)((blockIdx.x % 8) * (gridDim.x / 8) + blockIdx.x / 8) : (int)blockIdx.x;
    for (int t = vb; t < NBH * NSEG * 2; t += gridDim.x) {
        const int vh = t & 1, seg = (t >> 1) % NSEG, bh = t / (2 * NSEG), h = bh & 3, b = bh >> 2, vs = vh * 4 + wl, n0 = seg * CSEG;
        if (wave >= 4) dns_loader<2, CSEG>(p, lds, bh, n0, vh, wl, lane);
        else {
            const float* cdp = ws_f(p, WS_DNF_CD) + (size_t)bh * NCHUNK + n0;
            const float* ss = p.out + O_SSEG + ((size_t)(bh * NSEG + seg) * 8 + vs) * 2048 + lane * 4;
            f32x4 S[8];
#pragma unroll
            for (int kt = 0; kt < 8; ++kt) S[kt] = *(const f32x4*)(ss + kt * 256);
            float cd = cdp[0];
            DNS_BAR();
            for (int n = 0; n < CSEG; ++n) {
                const float cdn = cdp[n + 1 < CSEG ? n + 1 : n];
                dn_consume(lds + (n & 1) * DN_SBUF + lane * 16, wl, S, cd, (bf16_t*)(p.out + O_ODN) + (size_t)(b * SEQ + (n0 + n) * 64 + 4 * g4) * 512 + h * 128 + vs * 16 + (r16 & ~1));
                cd = cdn;
                DNS_BAR();
            }
        }
        DNS_BAR();
    }
}
#undef DNS_BAR
constexpr size_t WS_EDGE = WS_FREE;
constexpr size_t WS_HEAD = al256(WS_EDGE + (size_t)(T / 256) * 2 * 2 * DFF * 4);
constexpr size_t WS_END = al256(WS_HEAD + (size_t)(T / 256) * 2 * 2 * DFF * 4);
constexpr int EX_OFF = 131072;
namespace pg8 {
typedef unsigned u32x2v __attribute__((ext_vector_type(2)));
__device__ __forceinline__ float dpp_shr1(float old, float src) { return __builtin_bit_cast(float, __builtin_amdgcn_update_dpp(__builtin_bit_cast(int, old), __builtin_bit_cast(int, src), 0x111, 0xf, 0xf, false)); }
__device__ __forceinline__ float dpp_shr2(float old, float src) { return __builtin_bit_cast(float, __builtin_amdgcn_update_dpp(__builtin_bit_cast(int, old), __builtin_bit_cast(int, src), 0x112, 0xf, 0xf, false)); }
__device__ __forceinline__ float dpp_ror1(float src) { return __builtin_bit_cast(float, __builtin_amdgcn_update_dpp(0, __builtin_bit_cast(int, src), 0x121, 0xf, 0xf, false)); }
__device__ __forceinline__ float dpp_ror2(float src) { return __builtin_bit_cast(float, __builtin_amdgcn_update_dpp(0, __builtin_bit_cast(int, src), 0x122, 0xf, 0xf, false)); }
struct EpiFfnUp {
    static constexpr bool PERM = true, AFTER_DRAIN = false, APERM = true;
    bf16_t* ACT; float* edge; float* head; const float* cw; const float* cb; const float* state; float* out_pfc; float* out_sfc; PG8_LAS unsigned char* lds;
    __device__ __forceinline__ void operator()(const f32x4 (&acc)[2][2][4][2], const Unit& u, int wr, int wc, int fr, int fq) const {
#if defined(PROBE_MASK) && PROBE_MASK
        const unsigned long long t0_ = __builtin_amdgcn_s_memrealtime();
#endif
        if (u.pm >= TP / BM) body<true>(acc, u, wr, wc, fr, fq); else body<false>(acc, u, wr, wc, fr, fq);
#if defined(PROBE_MASK) && PROBE_MASK
        if (threadIdx.x == 0) { *(PG8_LAS unsigned long long*)(lds + LDS_BYTES - 64 + 16) += __builtin_amdgcn_s_memrealtime() - t0_; }
#endif
    }
    template <bool smp> __device__ __forceinline__ void body(const f32x4 (&acc)[2][2][4][2], const Unit& u, int wr, int wc, int fr, int fq) const {
        PG8_LAS float* EX = (PG8_LAS float*)(lds + EX_OFF);
        const int cl = wc * 32 + 8 * fq;
        if (fr == 15) {
#pragma unroll
            for (int ai = 0; ai < 2; ++ai)
#pragma unroll
                for (int j = 0; j < 2; ++j)
#pragma unroll
                    for (int bj = 0; bj < 2; ++bj)
#pragma unroll
                        for (int n = 0; n < 2; ++n) *(PG8_LAS f32x4*)(EX + ((2 * ai + wr) * 2 + j) * 256 + bj * HALF + cl + 4 * n) = acc[ai][bj][2 + j][n];
            if (wr == 1) {
#pragma unroll
                for (int j = 0; j < 2; ++j)
#pragma unroll
                    for (int bj = 0; bj < 2; ++bj)
#pragma unroll
                        for (int n = 0; n < 2; ++n) { const int oc = bj * DFF + u.pn * HALF + cl + 4 * n;
                            *(f32x4*)(edge + ((size_t)u.pm * 2 + j) * 2 * DFF + oc) = acc[1][bj][2 + j][n];
                            if (!smp && (u.pm & (SEQ / BM - 1)) == SEQ / BM - 1) *(f32x4*)(out_pfc + ((size_t)(u.pm / (SEQ / BM)) * 2 + j) * 2 * DFF + oc) = acc[1][bj][2 + j][n]; }
            }
        }
        if (fr == 0 && wr == 0) {
#pragma unroll
            for (int j = 0; j < 2; ++j)
#pragma unroll
                for (int bj = 0; bj < 2; ++bj)
#pragma unroll
                    for (int n = 0; n < 2; ++n) *(f32x4*)(head + ((size_t)u.pm * 2 + j) * 2 * DFF + bj * DFF + u.pn * HALF + cl + 4 * n) = acc[0][bj][j][n];
        }
        f32x4 cwg[1][3], cwu[1][3], cbg[1], cbu[1];
#define FF_LDC(n_) do { const int f0_ = u.pn * HALF + cl + 4 * (n_); _Pragma("unroll") for (int j = 0; j < 3; ++j) { cwg[0][j] = *(const f32x4*)(cw + (size_t)j * 2 * DFF + f0_); cwu[0][j] = *(const f32x4*)(cw + (size_t)j * 2 * DFF + DFF + f0_); } \
            cbg[0] = *(const f32x4*)(cb + f0_); cbu[0] = *(const f32x4*)(cb + DFF + f0_); } while (0)
        FF_LDC(0);
        asm volatile("s_waitcnt lgkmcnt(0)" ::: "memory"); __builtin_amdgcn_s_barrier(); asm volatile("" ::: "memory");
        u32x2v w0[2][4];
#pragma unroll
        for (int n = 0; n < 2; ++n) {
            const int f0 = u.pn * HALF + cl + 4 * n;
            if (n == 1) FF_LDC(1);
            const f32x4 (&wg)[3] = cwg[0]; const f32x4 (&wu)[3] = cwu[0]; const f32x4 bg = cbg[0], bu = cbu[0];
            f32x4 stv[2][4];
            if (smp) {
#pragma unroll
                for (int ai = 0; ai < 2; ++ai) { const int b = (u.pm * BM + ai * HALF + wr * 64 + 4 * fr - TP) >> 3; const float* st = state + (size_t)b * 2 * 2 * DFF + f0;
                    stv[ai][0] = *(const f32x4*)st; stv[ai][1] = *(const f32x4*)(st + DFF); stv[ai][2] = *(const f32x4*)(st + 2 * DFF); stv[ai][3] = *(const f32x4*)(st + 2 * DFF + DFF); }
            }
#pragma unroll
            for (int ai = 0; ai < 2; ++ai) {
                const int s = 2 * ai + wr, row0 = u.pm * BM + ai * HALF + wr * 64 + 4 * fr;
                f32x4 eg1 = (f32x4){0.f, 0.f, 0.f, 0.f}, eg2 = eg1, eu1 = eg1, eu2 = eg1;
                if (!smp && s > 0 && fr == 0) { const PG8_LAS float* ex = EX + (s - 1) * 2 * 256 + cl + 4 * n;
                    eg2 = *(const PG8_LAS f32x4*)ex; eu2 = *(const PG8_LAS f32x4*)(ex + HALF); eg1 = *(const PG8_LAS f32x4*)(ex + 256); eu1 = *(const PG8_LAS f32x4*)(ex + 256 + HALF); }
                const f32x4 (&cg)[4][2] = acc[ai][0]; const f32x4 (&cu)[4][2] = acc[ai][1];
                f32x4 pg1, pg2, pu1, pu2;
#pragma unroll
                for (int e = 0; e < 4; ++e) { pg1[e] = dpp_shr1(eg1[e], cg[3][n][e]); pg2[e] = dpp_shr1(eg2[e], cg[2][n][e]); pu1[e] = dpp_shr1(eu1[e], cu[3][n][e]); pu2[e] = dpp_shr1(eu2[e], cu[2][n][e]); }
                if (smp) {
                    const int b = (row0 - TP) >> 3;
                    if ((fr & 1) == 0) { pg2 = stv[ai][0]; pu2 = stv[ai][1]; pg1 = stv[ai][2]; pu1 = stv[ai][3]; }
                    else { float* o = out_sfc + (size_t)b * 2 * 2 * DFF + f0; *(f32x4*)o = cg[2][n]; *(f32x4*)(o + DFF) = cu[2][n]; *(f32x4*)(o + 2 * DFF) = cg[3][n]; *(f32x4*)(o + 2 * DFF + DFF) = cu[3][n]; }
                }
#pragma unroll
                for (int m = 0; m < 4; ++m) {
                    const f32x4 g2 = m == 0 ? pg2 : (m == 1 ? pg1 : cg[m - 2 < 0 ? 0 : m - 2][n]), g1 = m == 0 ? pg1 : cg[m - 1 < 0 ? 0 : m - 1][n];
                    const f32x4 u2 = m == 0 ? pu2 : (m == 1 ? pu1 : cu[m - 2 < 0 ? 0 : m - 2][n]), u1 = m == 0 ? pu1 : cu[m - 1 < 0 ? 0 : m - 1][n];
                    const f32x4 gc = ((bg + wg[0] * g2) + wg[1] * g1) + wg[2] * cg[m][n], uc = ((bu + wu[0] * u2) + wu[1] * u1) + wu[2] * cu[m][n];
                    u32x2v w;
                    { const f32x4 tt = gc * uc, ex = gc * -1.4426950408889634f;
                      f32x4 dn = (f32x4){__builtin_amdgcn_exp2f(ex[0]), __builtin_amdgcn_exp2f(ex[1]), __builtin_amdgcn_exp2f(ex[2]), __builtin_amdgcn_exp2f(ex[3])} + 1.0f;
                      const f32x4 av = tt * (f32x4){__builtin_amdgcn_rcpf(dn[0]), __builtin_amdgcn_rcpf(dn[1]), __builtin_amdgcn_rcpf(dn[2]), __builtin_amdgcn_rcpf(dn[3])};
                      w.x = cvt_pk_bf16(av[0], av[1]); w.y = cvt_pk_bf16(av[2], av[3]); }
                    if (n == 0) w0[ai][m] = w; else *(u32x4*)(ACT + (size_t)(row0 + m) * DFF + f0 - 4) = (u32x4){w0[ai][m].x, w0[ai][m].y, w.x, w.y};
                }
            }
        }
#undef FF_LDC
    }
};
}
__device__ __forceinline__ void phase_ffn_fix(const P& p) {
    constexpr int TPS = SEQ / 256;
    const long n = (long)(BATCH * TPS) * DFF;
    const float* edge = ws_f(p, WS_EDGE); const float* head = ws_f(p, WS_HEAD);
    for (long i = blockIdx.x * (long)NTHR + otid(); i < n; i += (long)gridDim.x * NTHR) {
        const int pm = (int)(i / DFF), f = (int)(i % DFF);
        if (pm % TPS == 0) continue;
        float r0[2], r1[2];
#pragma unroll
        for (int gu = 0; gu < 2; ++gu) { const int c = gu * DFF + f;
            const float um2 = edge[((size_t)(pm - 1) * 2 + 0) * 2 * DFF + c], um1 = edge[((size_t)(pm - 1) * 2 + 1) * 2 * DFF + c], u0 = head[((size_t)pm * 2 + 0) * 2 * DFF + c], u1 = head[((size_t)pm * 2 + 1) * 2 * DFF + c];
            const float w0 = p.ffn_conv_w[c], w1 = p.ffn_conv_w[2 * DFF + c], w2 = p.ffn_conv_w[4 * DFF + c], bb = p.ffn_conv_b[c];
            r0[gu] = w0 * um2 + w1 * um1 + w2 * u0 + bb; r1[gu] = w0 * um1 + w1 * u0 + w2 * u1 + bb; }
        bf16_t* ACT = ws_h(p, WS_ACT) + (size_t)pm * 256 * DFF + f;
        ACT[0] = f2bf(silu_fast(r0[0]) * r0[1]); ACT[DFF] = f2bf(silu_fast(r1[0]) * r1[1]);
    }
}

__device__ __forceinline__ void ffn_fix_tile(const P& p, int pm) {
    constexpr int TPS = SEQ / 256;
    if (pm >= BATCH * TPS || pm % TPS == 0) return;
    const float* edge = ws_f(p, WS_EDGE); const float* head = ws_f(p, WS_HEAD);
    for (int f = otid(); f < DFF; f += NTHR) {
        float r0[2], r1[2];
#pragma unroll
        for (int gu = 0; gu < 2; ++gu) { const int c = gu * DFF + f;
            const float um2 = edge[((size_t)(pm - 1) * 2 + 0) * 2 * DFF + c], um1 = edge[((size_t)(pm - 1) * 2 + 1) * 2 * DFF + c], u0 = head[((size_t)pm * 2 + 0) * 2 * DFF + c], u1 = head[((size_t)pm * 2 + 1) * 2 * DFF + c];
            const float w0 = p.ffn_conv_w[c], w1 = p.ffn_conv_w[2 * DFF + c], w2 = p.ffn_conv_w[4 * DFF + c], bb = p.ffn_conv_b[c];
            r0[gu] = w0 * um2 + w1 * um1 + w2 * u0 + bb; r1[gu] = w0 * um1 + w1 * u0 + w2 * u1 + bb; }
        bf16_t* ACT = ws_h(p, WS_ACT) + (size_t)pm * 256 * DFF + f;
        ACT[0] = f2bf(silu_fast(r0[0]) * r0[1]); ACT[DFF] = f2bf(silu_fast(r1[0]) * r1[1]);
    }
}
constexpr int SW_KP = 72;
__device__ __forceinline__ void swa_bias(const LAS float* BT, int lane, float (&bv)[9][4]) {
    const int r16 = lane & 15, g4 = lane >> 4;
#pragma unroll
    for (int t = 0; t < 9; ++t)
#pragma unroll
        for (int e = 0; e < 4; ++e) { const int d = 128 + r16 - 16 * t - 4 * g4 - e; bv[t][e] = (d >= 0 && d <= 127) ? BT[d] * 1.4426950408889634f : -1e30f; }
}
__device__ __forceinline__ void swa_qtile(const LAS bf16_t* KS, const LAS bf16_t* VT, int vtp, int qt, const bf16x8 (&bq)[2], const float (&bv)[9][4], float sink2, bool first, bf16_t* optr, int nvalid_q, int lane) {
    const int r16 = lane & 15, g4 = lane >> 4, kt0 = qt;
    f32x4 s[10];
#pragma unroll
    for (int tb = 0; tb < 2; ++tb) {
        bf16x8 ka[5][2];
#pragma unroll
        for (int t = 0; t < 5; ++t)
#pragma unroll
            for (int ks = 0; ks < 2; ++ks) if (5 * tb + t < 9) ka[t][ks] = *(const LAS bf16x8*)(KS + (16 * (kt0 + 5 * tb + t) + r16) * SW_KP + 32 * ks + 8 * g4);
        __builtin_amdgcn_sched_barrier(0);
#pragma unroll
        for (int t = 0; t < 5; ++t) if (5 * tb + t < 9) { f32x4 a = (f32x4){0.f, 0.f, 0.f, 0.f};
#pragma unroll
            for (int ks = 0; ks < 2; ++ks) a = __builtin_amdgcn_mfma_f32_16x16x32_bf16(ka[t][ks], bq[ks], a, 0, 0, 0);
            s[5 * tb + t] = a; }
        __builtin_amdgcn_sched_barrier(0);
    }
    float mx = sink2;
#pragma unroll
    for (int t = 0; t < 9; ++t)
#pragma unroll
        for (int e = 0; e < 4; ++e) { float v = s[t][e] * 0.18033688011112042f + bv[t][e]; if (first && 16 * (kt0 + t) + 4 * g4 + e < 128) v = -1e30f; s[t][e] = v; mx = fmaxf(mx, v); }
    mx = fmaxf(mx, __shfl_xor(mx, 16)); mx = fmaxf(mx, __shfl_xor(mx, 32));
    float l = 0.f;
#pragma unroll
    for (int t = 0; t < 9; ++t)
#pragma unroll
        for (int e = 0; e < 4; ++e) { const float pv = __builtin_amdgcn_exp2f(s[t][e] - mx); s[t][e] = pv; l += pv; }
    s[9] = (f32x4){0.f, 0.f, 0.f, 0.f};
    l += __shfl_xor(l, 16); l += __shfl_xor(l, 32);
    l += __builtin_amdgcn_exp2f(sink2 - mx);
    const float rl = __builtin_amdgcn_rcpf(l);
    bf16x8 pb[5];
#pragma unroll
    for (int q = 0; q < 5; ++q) pb[q] = pack8(s[2 * q], s[2 * q + 1]);
#pragma unroll
    for (int dp = 0; dp < 2; ++dp) {
        u32x2 vl[2][5], vh[2][5];
#pragma unroll
        for (int d2 = 0; d2 < 2; ++d2)
#pragma unroll
            for (int q = 0; q < 5; ++q) { const LAS bf16_t* vp = VT + (16 * (2 * dp + d2) + r16) * vtp + 16 * (kt0 + 2 * q) + 4 * g4; vl[d2][q] = *(const LAS u32x2*)vp; vh[d2][q] = *(const LAS u32x2*)(vp + 16); }
        __builtin_amdgcn_sched_barrier(0);
#pragma unroll
        for (int d2 = 0; d2 < 2; ++d2) { const int dt = 2 * dp + d2; f32x4 o = (f32x4){0.f, 0.f, 0.f, 0.f};
#pragma unroll
            for (int q = 0; q < 5; ++q) o = __builtin_amdgcn_mfma_f32_16x16x32_bf16(__builtin_bit_cast(bf16x8, (u32x4){vl[d2][q].x, vl[d2][q].y, vh[d2][q].x, vh[d2][q].y}), pb[q], o, 0, 0, 0);
            if (r16 < nvalid_q) *(u32x2*)(optr + (size_t)r16 * 1024 + 16 * dt + 4 * g4) = (u32x2){cvtpk_c(o[0] * rl, o[1] * rl), cvtpk_c(o[2] * rl, o[3] * rl)}; }
        __builtin_amdgcn_sched_barrier(0);
    }
}
constexpr int SWP_VTP = 272, SWS_NK = 144, SWS_VTP = 168;
constexpr int SW_KS = 0, SW_VT = 43008, SW_BT = 86016, SW_END = SW_BT + 8 * 128 * 4;
static_assert(256 * SW_KP * 2 <= SW_VT && SW_VT + 64 * SWP_VTP * 2 <= SW_BT && SWS_NK * SW_KP * 2 <= SW_VT && SW_VT + 64 * SWS_VTP * 2 <= SW_BT, "swa LDS map");
__device__ __forceinline__ void phase_swa(const P& p, LAS unsigned char* lds, int vblk, int nblk, unsigned long long& pr_prev, unsigned long long& pr_acc) {
    const int tid = otid(), lane = tid & 63, wave = tid >> 6;
    LAS bf16_t* KS = (LAS bf16_t*)(lds + SW_KS); LAS bf16_t* VT = (LAS bf16_t*)(lds + SW_VT); LAS float* BT = (LAS float*)(lds + SW_BT);
    const bf16_t* PR = ws_h(p, WS_PROJ); bf16_t* MX = ws_h(p, WS_MIX);
    constexpr int NQB = SEQ / 128, NPU = BATCH * NQB * 2, NU = NPU + DEC_BATCH * 2;
    for (int i = tid; i < 8 * 128; i += NTHR) BT[i] = p.rel_bias[t5_bucket(i & 127) * 8 + (i >> 7)];
    const int vb = (nblk % 8 == 0) ? (vblk % 8) * (nblk / 8) + vblk / 8 : vblk;
    for (int u = vb; u < NU; u += nblk) {
        LDS_BARRIER(); DPS(22);
        if (u < NPU) {
            const int kvh = u & 1, qb = (u >> 1) % NQB, b = (u >> 1) / NQB, m0 = b * SEQ + qb * 128; const bool first = qb == 0;
            const bf16_t* qbase = PR + (size_t)(m0 + 64 * (wave & 1) + (lane & 15)) * PLD + PC_SQ + (kvh * 4 + (wave >> 1)) * 64 + 8 * (lane >> 4);
            bf16x8 bq[2], bqn[2];
#pragma unroll
            for (int ks = 0; ks < 2; ++ks) bq[ks] = *(const bf16x8*)(qbase + 32 * ks);
            {
                u32x4 kr[4], vr[5];
#pragma unroll
                for (int i = 0; i < 4; ++i) { const int it = tid + i * NTHR, jj = it >> 3, c = it & 7; kr[i] = (u32x4){0u, 0u, 0u, 0u};
                    if (!(first && jj < 128)) kr[i] = *(const u32x4*)(PR + (size_t)(m0 - 128 + jj) * PLD + PC_SK + kvh * 64 + 8 * c); }
#pragma unroll
                for (int i = 0; i < 5; ++i) { const int it = tid + i * NTHR, jj = it % 272, c = it / 272; vr[i] = (u32x4){0u, 0u, 0u, 0u};
                    if (it < 272 * 8 && jj < 256 && !(first && jj < 128)) vr[i] = *(const u32x4*)(PR + (size_t)(m0 - 128 + jj) * PLD + PC_SV + kvh * 64 + 8 * c); }
#pragma unroll
                for (int i = 0; i < 4; ++i) { const int it = tid + i * NTHR, jj = it >> 3, c = it & 7; *(LAS u32x4*)(KS + jj * SW_KP + 8 * c) = kr[i]; }
#pragma unroll
                for (int i = 0; i < 5; ++i) { const int it = tid + i * NTHR, jj = it % 272, c = it / 272;
                    if (it < 272 * 8) { const unsigned w[4] = {vr[i].x, vr[i].y, vr[i].z, vr[i].w};
#pragma unroll
                        for (int e = 0; e < 4; ++e) { VT[(8 * c + 2 * e) * SWP_VTP + jj] = (bf16_t)(w[e] & 0xffffu); VT[(8 * c + 2 * e + 1) * SWP_VTP + jj] = (bf16_t)(w[e] >> 16); } } }
            }
            LDS_BARRIER(); DPS(23);
            const int hq = kvh * 4 + (wave >> 1), qh = wave & 1, r16 = lane & 15, g4 = lane >> 4;
            float bv[9][4]; swa_bias(BT + hq * 128, lane, bv);
            const float sink2 = p.swa_sinks[hq] * 1.4426950408889634f;
#pragma unroll 1
            for (int q4 = 0; q4 < 4; ++q4) { const int qt = 4 * qh + q4;
                if (q4 < 3) {
#pragma unroll
                    for (int ks = 0; ks < 2; ++ks) bqn[ks] = *(const bf16x8*)(qbase + (size_t)(16 * (q4 + 1)) * PLD + 32 * ks); }
                swa_qtile(KS, VT, SWP_VTP, qt, bq, bv, sink2, first, MX + (size_t)(m0 + 16 * qt) * 1024 + 512 + hq * 64, 16, lane);
                bq[0] = bqn[0]; bq[1] = bqn[1]; }
            DPS(24);
        } else {
            const int su = u - NPU, b = su >> 1, kvh = su & 1, m0 = TP + b * DEC_SEQ;
            bf16x8 bqs[2];
#pragma unroll
            for (int ks = 0; ks < 2; ++ks) bqs[ks] = *(const bf16x8*)(PR + (size_t)(m0 + (lane & 7)) * PLD + PC_SQ + (kvh * 4 + (wave & 3)) * 64 + 32 * ks + 8 * (lane >> 4));
            {
                f32x4 ka[3][2], va[3][2]; u32x4 kn[3], vn[3];
#pragma unroll
                for (int i = 0; i < 3; ++i) { const int it = tid + i * NTHR, jj = it >> 3, c = it & 7;
                    ka[i][0] = ka[i][1] = (f32x4){0.f, 0.f, 0.f, 0.f}; kn[i] = (u32x4){0u, 0u, 0u, 0u};
                    if (it < SWS_NK * 8) { if (jj < 128) { const float* src = p.cache_k + ((size_t)b * 128 + jj) * 128 + kvh * 64 + 8 * c; ka[i][0] = *(const f32x4*)src; ka[i][1] = *(const f32x4*)(src + 4); }
                        else if (jj < 128 + DEC_SEQ) kn[i] = *(const u32x4*)(PR + (size_t)(m0 + jj - 128) * PLD + PC_SK + kvh * 64 + 8 * c); } }
#pragma unroll
                for (int i = 0; i < 3; ++i) { const int it = tid + i * NTHR, jj = it % SWS_VTP, c = it / SWS_VTP;
                    va[i][0] = va[i][1] = (f32x4){0.f, 0.f, 0.f, 0.f}; vn[i] = (u32x4){0u, 0u, 0u, 0u};
                    if (it < SWS_VTP * 8) { if (jj < 128) { const float* src = p.cache_v + ((size_t)b * 128 + jj) * 128 + kvh * 64 + 8 * c; va[i][0] = *(const f32x4*)src; va[i][1] = *(const f32x4*)(src + 4); }
                        else if (jj < 128 + DEC_SEQ) vn[i] = *(const u32x4*)(PR + (size_t)(m0 + jj - 128) * PLD + PC_SV + kvh * 64 + 8 * c); } }
#pragma unroll
                for (int i = 0; i < 3; ++i) { const int it = tid + i * NTHR, jj = it >> 3, c = it & 7;
                    if (it < SWS_NK * 8) { u32x4 v = kn[i]; if (jj < 128) v = (u32x4){cvtpk_c(ka[i][0][0], ka[i][0][1]), cvtpk_c(ka[i][0][2], ka[i][0][3]), cvtpk_c(ka[i][1][0], ka[i][1][1]), cvtpk_c(ka[i][1][2], ka[i][1][3])};
                        *(LAS u32x4*)(KS + jj * SW_KP + 8 * c) = v; } }
#pragma unroll
                for (int i = 0; i < 3; ++i) { const int it = tid + i * NTHR, jj = it % SWS_VTP, c = it / SWS_VTP;
                    if (it < SWS_VTP * 8) { u32x4 v = vn[i]; if (jj < 128) v = (u32x4){cvtpk_c(va[i][0][0], va[i][0][1]), cvtpk_c(va[i][0][2], va[i][0][3]), cvtpk_c(va[i][1][0], va[i][1][1]), cvtpk_c(va[i][1][2], va[i][1][3])};
                        const unsigned w[4] = {v.x, v.y, v.z, v.w};
#pragma unroll
                        for (int e = 0; e < 4; ++e) { VT[(8 * c + 2 * e) * SWS_VTP + jj] = (bf16_t)(w[e] & 0xffffu); VT[(8 * c + 2 * e + 1) * SWS_VTP + jj] = (bf16_t)(w[e] >> 16); } } }
            }
            LDS_BARRIER(); DPS(25);
            if (wave < 4) { const int hq = kvh * 4 + wave;
                float bv[9][4]; swa_bias(BT + hq * 128, lane, bv);
                swa_qtile(KS, VT, SWS_VTP, 0, bqs, bv, p.swa_sinks[hq] * 1.4426950408889634f, false, MX + (size_t)m0 * 1024 + 512 + hq * 64, 8, lane); }
        }
    }
    LDS_BARRIER();
}
static void fill_params(P& p, void* const* d_in, void* d_out, void* d_ws) {
    const float** pp = (const float**)&p;
    for (int i = 0; i < 26; ++i) pp[i] = (const float*)d_in[i];
    p.out = (float*)d_out; p.ws = (unsigned char*)d_ws;
}
namespace cg = cooperative_groups;
constexpr int CW_BAR = 1024;
constexpr size_t CTL_ZERO_BYTES = 65536;

#ifndef PROBE_MASK
#define PROBE_MASK 0
#endif
#ifndef PROBE_K
#define PROBE_K 4
#endif
#ifndef PROBE_XSYNC
#define PROBE_XSYNC 0
#endif
#if PROBE_MASK
#define PROBE_SUB(k) do { xcd_barrier(bar); PROBE_STAMP(k); } while (0)
#define PROBE_DECL unsigned long long pr_prev = __builtin_amdgcn_s_memrealtime(), pr_acc = 0ull
#define PROBE_STAMP(k) do { const unsigned long long now_ = __builtin_amdgcn_s_memrealtime(); if ((PROBE_MASK >> (k)) & 1) pr_acc += now_ - pr_prev; pr_prev = now_; } while (0)
#define PROBE_END() do { xcd_barrier(bar); PROBE_STAMP(11); if ((PROBE_MASK >> 9) & 1) pr_acc += *(volatile LAS unsigned long long*)(MISC + 4);  if (blockIdx.x == 0 && __builtin_amdgcn_mbcnt_hi(~0u, __builtin_amdgcn_mbcnt_lo(~0u, 0u)) == 0u) { const unsigned long long t0_ = __builtin_amdgcn_s_memrealtime(); while (__builtin_amdgcn_s_memrealtime() - t0_ < (unsigned long long)PROBE_K * pr_acc) __builtin_amdgcn_s_sleep(8); } } while (0)
#else
#define PROBE_DECL unsigned long long pr_prev = 0ull, pr_acc = 0ull
#define PROBE_SUB(k)
#define PROBE_STAMP(k)
#define PROBE_END() do { for (int i_ = 0; i_ < PROBE_XSYNC; ++i_) xcd_barrier(bar); } while (0)
#endif
__global__ void __launch_bounds__(512, 2) fwd_megakernel(P p) {
    extern __shared__ __attribute__((aligned(16))) unsigned char lds_raw[];
    LAS unsigned char* lds = (LAS unsigned char*)lds_raw;
    cg::grid_group grid = cg::this_grid();
    PROBE_DECL;
    volatile LAS unsigned* MISC = (volatile LAS unsigned*)(lds + LDS_BYTES - 64);
    if (threadIdx.x < 16) MISC[threadIdx.x] = 0u;
    __syncthreads();
    const XcdBarrier bar = xcd_barrier_post((unsigned*)(p.ws + WS_CTL) + CW_BAR, MISC);
    phase_moda(p); xcd_split_arrive(bar, 5);
    phase_mod(p, lds, pr_prev, pr_acc, [&]() { xcd_split_wait(bar, 5); }); PROBE_STAMP(31); phase_wbat(p);
    xcd_split_arrive(bar, 0);
    phase_transposes(p, lds);
    if (p.ws == nullptr) grid.sync();
    phase_norm<0>(p, lds, [&]() { xcd_split_wait(bar, 0); PROBE_STAMP(0); });
    xcd_barrier_arrive(bar); phase_cache_copy(p, 0); xcd_barrier_wait(bar); PROBE_STAMP(1);
    { pg8::StaticOrder S; pg8::Gemm g{ws_h(p, WS_H), ws_h(p, WS_WT_IN), T, PLD, D}; S.init(T, PLD, gridDim.x, blockIdx.x, D); pg8::EpiStoreBf16 E{ws_h(p, WS_PROJ), PLD};
      pg8::gemm_phase<pg8::EpiStoreBf16, pg8::StaticOrder, true, true>(lds, g, S, E); }
    xcd_barrier_arrive(bar); phase_cache_copy(p, 1); xcd_barrier_wait(bar); PROBE_STAMP(2);
    PROBE_STAMP(21);
    phase_dnprep(p, lds, pr_prev, pr_acc);
    xcd_split_arrive(bar, 1);
    PROBE_SUB(12);
    phase_dnsample(p, lds, pr_prev, pr_acc);
    PROBE_SUB(13);
    phase_swa(p, lds, (int)blockIdx.x, (int)gridDim.x, pr_prev, pr_acc);
    xcd_split_wait(bar, 1); PROBE_STAMP(3);
    phase_dns_passA(p, lds);
    xcd_barrier(bar); PROBE_STAMP(14);
    { const int G = (int)gridDim.x, c = (int)blockIdx.x; const bool wide = G >= NBH * 8 + 128; const int nso = wide ? G - NBH * 8 - 64 : G, so0 = wide ? NBH * 8 : 0, nsl = wide ? 64 : G, sl0 = wide ? G - 64 : 0;
      if (c >= so0 && c < so0 + nso) phase_state_out(p, c - so0, nso);
      if (c >= sl0) { pg8::SlabOrder S; pg8::Gemm g{ws_h(p, WS_MIX), ws_h(p, WS_WT_OUT), T, D, 1024}; S.init(D, 1024, NS_OUT, nsl, c - sl0); pg8::EpiSlab E{(bf16_t*)(p.out + O_SLAB_OUT), NS_OUT, nullptr, 1 << 20};
        pg8::gemm_phase<pg8::EpiSlab, pg8::SlabOrder, true, true>(lds, g, S, E); } }
    phase_dns_passB(p, lds);
    xcd_barrier(bar); PROBE_STAMP(15);
    phase_dns_passC(p, lds);
    xcd_barrier(bar); PROBE_STAMP(4);
    phase_dngate(p);
    xcd_barrier(bar); PROBE_STAMP(5);
    { pg8::StaticOrder S; pg8::Gemm g{ws_h(p, WS_MIX), ws_h(p, WS_WT_OUT), TP, D, 1024}; S.init(TP, D, gridDim.x, blockIdx.x, 1024); pg8::EpiGateRes<0> E{p.x_prompt, ws_h(p, WS_XB), ws_f(p, WS_MOD) + 2 * D};
      pg8::gemm_phase<pg8::EpiGateRes<0>, pg8::StaticOrder, true, true>(lds, g, S, E); }
    xcd_split_arrive(bar, 3); phase_norm<1, NoSeam, 1>(p, lds); xcd_split_wait(bar, 3); PROBE_STAMP(6);
    phase_norm<1, NoSeam, 2>(p, lds);
    xcd_barrier(bar); PROBE_STAMP(7);
    { pg8::UpOrder S; pg8::Gemm g{ws_h(p, WS_H), ws_h(p, WS_WT_UP), T, 2 * DFF, D}; S.init(2 * DFF, D, gridDim.x, blockIdx.x, &bar);
      pg8::EpiFfnUp E{ws_h(p, WS_ACT), ws_f(p, WS_EDGE), ws_f(p, WS_HEAD), p.ffn_conv_w, p.ffn_conv_b, p.state_ffn, p.out + O_PFC, p.out + O_SFC, lds};
      pg8::gemm_phase<pg8::EpiFfnUp, pg8::UpOrder, true, true>(lds, g, S, E); }
    { const int G = (int)gridDim.x, nwg = (T / 256) * (2 * DFF / 256), first = nwg % G, vblk = first == 0 ? (int)blockIdx.x : (int)blockIdx.x - first, nblk = first == 0 ? G : G - first;
      if (vblk >= 0) { xcd_split_wait(bar, 2);
        pg8::SlabOrder S; pg8::Gemm g{ws_h(p, WS_ACT), ws_h(p, WS_WT_DN), T, D, DFF}; S.init(D, DFF, NS_DN, nblk, vblk);
        pg8::EpiSlab E{ws_h(p, WS_SLAB_DN_A), NS_DN, ws_h(p, WS_SLAB_DN_B), SLAB_DN_SPLIT};
        pg8::gemm_phase<pg8::EpiSlab, pg8::SlabOrder, true, true>(lds, g, S, E); } }
    xcd_barrier(bar); PROBE_STAMP(8);
    { pg8::StaticOrder S; pg8::Gemm g{ws_h(p, WS_ACT), ws_h(p, WS_WT_DN), TP, D, DFF}; S.init(TP, D, gridDim.x, blockIdx.x, DFF);
      { constexpr int NU1 = (TP / 256) * (D / 256); for (int L = blockIdx.x; L < NU1; L += gridDim.x) { const int w1 = (L % 8) * (NU1 / 8) + L / 8, pm = (w1 / (8 * (D / 256))) * 8 + (w1 % (8 * (D / 256))) % 8; ffn_fix_tile(p, pm); }
        asm volatile("s_waitcnt vmcnt(0)" ::: "memory"); __syncthreads(); }
      pg8::EpiGateRes<1> E{nullptr, ws_h(p, WS_XB), ws_f(p, WS_MOD) + 5 * D};
      pg8::gemm_phase<pg8::EpiGateRes<1>, pg8::StaticOrder, true, true>(lds, g, S, E); }
    xcd_split_arrive(bar, 4); phase_norm<2, NoSeam, 1>(p, lds); xcd_split_wait(bar, 4); PROBE_STAMP(10);
    phase_norm<2, NoSeam, 2>(p, lds);
    PROBE_END();
}
extern "C" void kernel_launch(void* const* d_in, const int* in_sizes, int n_in, void* d_out, int out_size, void* d_ws, size_t ws_size, hipStream_t stream) {
    static int grid_blocks = 0;
    if (grid_blocks == 0) {
        if (n_in != 26 || (long)out_size != O_END || ws_size < WS_END) { fprintf(stderr, "kernel_launch: unexpected shapes n_in=%d out=%d ws=%zu (need %zu)\n", n_in, out_size, ws_size, (size_t)WS_END); grid_blocks = -1; return; }
        int dev = 0, cus = 0, per_cu = 0;
        if (hipGetDevice(&dev) != hipSuccess || hipDeviceGetAttribute(&cus, hipDeviceAttributeMultiprocessorCount, dev) != hipSuccess) { grid_blocks = -1; return; }
        if (hipFuncSetAttribute((const void*)fwd_megakernel, hipFuncAttributeMaxDynamicSharedMemorySize, LDS_BYTES) != hipSuccess) { fprintf(stderr, "kernel_launch: hipFuncSetAttribute failed\n"); grid_blocks = -1; return; }
        if (hipOccupancyMaxActiveBlocksPerMultiprocessor(&per_cu, (const void*)fwd_megakernel, NTHR, LDS_BYTES) != hipSuccess || per_cu < 1) { fprintf(stderr, "kernel_launch: occupancy query says %d\n", per_cu); grid_blocks = -1; return; }
        grid_blocks = cus;
        fprintf(stderr, "kernel_launch: grid %d (cus %d, per_cu %d)\n", grid_blocks, cus, per_cu);
    }
    if (grid_blocks < 0) return;
    P p{}; fill_params(p, d_in, d_out, d_ws);
    if (hipMemsetAsync((char*)d_ws + WS_CTL, 0, CTL_ZERO_BYTES, stream) != hipSuccess) { fprintf(stderr, "kernel_launch: memset of the control words failed\n"); return; }
    void* args[] = {&p};
    const hipError_t e = hipLaunchCooperativeKernel((const void*)fwd_megakernel, dim3(grid_blocks), dim3(NTHR), args, LDS_BYTES, stream);
    if (e != hipSuccess) fprintf(stderr, "cooperative launch failed: %s (grid %d)\n", hipGetErrorString(e), grid_blocks);
}
```
